# Optimizing an MI355X kernel written in HIP

```python
import math
import jax, jax.numpy as jnp
from jax import lax
import numpy as np

D_MODEL = 2048
BATCH = 4
SEQ = 2048
DEPTH = 1
DEC_BATCH = 128
DEC_SEQ = 8
PAST_LEN = 16384
PAGE_SIZE = 128

MIX_WIDTH = D_MODEL
GLA_WIDTH = MIX_WIDTH // 2
SSD_WIDTH = MIX_WIDTH - GLA_WIDTH
GLA_HEADS = 4
GLA_HEAD_V = GLA_WIDTH // GLA_HEADS
GLA_HEAD_K = GLA_HEAD_V // 2
GLA_KDIM = GLA_HEADS * GLA_HEAD_K
GLA_LOWRANK = 16
GLA_GATE_NORMALIZER = 16.0
SSD_HEADDIM = 64
SSD_HEADS = SSD_WIDTH // SSD_HEADDIM
SSD_STATE = 128
SSD_GROUPS = 2
SSD_HPG = SSD_HEADS // SSD_GROUPS
SSD_CONV = 4
SSD_CONV_CH = SSD_WIDTH + 2 * SSD_GROUPS * SSD_STATE
FFN_DIM = 5632
FFN_CONV = 3
CHUNK = 64
EPS = 1e-6

IN_SIZES = (GLA_KDIM, GLA_KDIM, GLA_WIDTH, GLA_WIDTH, GLA_LOWRANK,
            SSD_WIDTH, SSD_CONV_CH, SSD_HEADS)
IN_COLS = sum(IN_SIZES)

kernel_name = "hymba_gla_ssd_convffn_step"


def _rmsnorm(x, w):
    xf = x.astype(jnp.float32)
    y = xf * lax.rsqrt(jnp.mean(xf * xf, axis=-1, keepdims=True) + EPS)
    return (y * w.astype(jnp.float32)).astype(x.dtype)


def _causal_dwconv(x, buf, w, b):
    width = w.shape[0]
    L = x.shape[1]
    xp = jnp.concatenate([buf.astype(x.dtype), x], axis=1)
    out = b + sum(xp[:, j:j + L] * w[j] for j in range(width))
    return out, xp[:, xp.shape[1] - (width - 1):]


def _to_chunks(a, c):
    B, L = a.shape[:2]
    return jnp.moveaxis(a.reshape((B, L // c, c) + a.shape[2:]), 1, 0)


def _from_chunks(a):
    n, B, c = a.shape[:3]
    return jnp.moveaxis(a, 0, 1).reshape((B, n * c) + a.shape[3:])


def _gla_chunked(q, k, v, lg, s0):
    L = q.shape[1]
    c = math.gcd(L, CHUNK)
    causal = jnp.tril(jnp.ones((c, c), dtype=bool))[None, :, :, None, None]

    def step(S, inp):
        qc, kc, vc, gc = inp
        b = jnp.cumsum(gc, axis=1)
        o_inter = jnp.einsum('bthk,bhkv->bthv', qc * jnp.exp(b), S)
        diff = b[:, :, None] - b[:, None, :]
        dec = jnp.exp(jnp.where(causal, diff, -jnp.inf))
        att = jnp.einsum('bthk,btshk,bshk->bhts', qc, dec, kc)
        o_intra = jnp.einsum('bhts,bshv->bthv', att, vc)
        b_last = b[:, -1]
        k_dec = kc * jnp.exp(b_last[:, None] - b)
        S_new = jnp.exp(b_last)[..., None] * S + jnp.einsum('bshk,bshv->bhkv', k_dec, vc)
        return S_new, o_inter + o_intra

    S, o = lax.scan(step, s0, tuple(_to_chunks(a, c) for a in (q, k, v, lg)))
    return _from_chunks(o), S


def _ssd_chunked(x, dt, la, Bm, Cm, h0):
    L = x.shape[1]
    c = math.gcd(L, CHUNK)
    causal = jnp.tril(jnp.ones((c, c), dtype=bool))[None, :, :, None, None]

    def step(h, inp):
        xc, dtc, lac, bc, cc = inp
        cum = jnp.cumsum(lac, axis=1)
        y_inter = jnp.einsum('btgn,bghpn->btghp', cc, h) * jnp.exp(cum)[..., None]
        diff = cum[:, :, None] - cum[:, None, :]
        dec = jnp.exp(jnp.where(causal, diff, -jnp.inf))
        cb = jnp.einsum('btgn,bsgn->btsg', cc, bc)
        y_intra = jnp.einsum('btsg,btsgh,bsgh,bsghp->btghp', cb, dec, dtc, xc)
        last = cum[:, -1]
        wdec = jnp.exp(last[:, None] - cum) * dtc
        h_new = jnp.exp(last)[..., None, None] * h + jnp.einsum('bsgh,bsgn,bsghp->bghpn', wdec, bc, xc)
        return h_new, y_inter + y_intra

    h, y = lax.scan(step, h0, tuple(_to_chunks(a, c) for a in (x, dt, la, Bm, Cm)))
    return _from_chunks(y), h


def _mixer(xn, s_gla, s_ssd, s_conv, p):
    B, L, _ = xn.shape
    f32 = jnp.float32
    proj = xn @ p['w_in']
    split_pts = np.cumsum(IN_SIZES)[:-1].tolist()
    q, k, v, g, lr, z, xbc, dtr = jnp.split(proj, split_pts, axis=-1)

    q = q.reshape(B, L, GLA_HEADS, GLA_HEAD_K).astype(f32) * (GLA_HEAD_K ** -0.5)
    k = k.reshape(B, L, GLA_HEADS, GLA_HEAD_K).astype(f32)
    v = v.reshape(B, L, GLA_HEADS, GLA_HEAD_V).astype(f32)
    lg = jax.nn.log_sigmoid((lr @ p['gla_w_gate2'] + p['gla_b_gate']).astype(f32)) / GLA_GATE_NORMALIZER
    lg = lg.reshape(B, L, GLA_HEADS, GLA_HEAD_K)
    o, S = _gla_chunked(q, k, v, lg, s_gla.astype(f32))
    o = _rmsnorm(o, p['gla_norm']) * jax.nn.silu(g.reshape(B, L, GLA_HEADS, GLA_HEAD_V).astype(f32))
    o_gla = o.reshape(B, L, GLA_WIDTH)

    xbc, conv_new = _causal_dwconv(xbc, s_conv, p['ssd_conv_w'], p['ssd_conv_b'])
    xbc = jax.nn.silu(xbc)
    xs, Bm, Cm = jnp.split(xbc, [SSD_WIDTH, SSD_WIDTH + SSD_GROUPS * SSD_STATE], axis=-1)
    xs = xs.reshape(B, L, SSD_GROUPS, SSD_HPG, SSD_HEADDIM).astype(f32)
    Bm = Bm.reshape(B, L, SSD_GROUPS, SSD_STATE).astype(f32)
    Cm = Cm.reshape(B, L, SSD_GROUPS, SSD_STATE).astype(f32)
    dt = jax.nn.softplus(dtr.astype(f32) + p['ssd_dt_bias'].astype(f32)).reshape(B, L, SSD_GROUPS, SSD_HPG)
    A = -jnp.exp(p['ssd_A_log'].astype(f32)).reshape(SSD_GROUPS, SSD_HPG)
    h0 = s_ssd.astype(f32).reshape(B, SSD_GROUPS, SSD_HPG, SSD_HEADDIM, SSD_STATE)
    y, h = _ssd_chunked(xs, dt, dt * A, Bm, Cm, h0)
    y = y + p['ssd_D'].astype(f32).reshape(SSD_GROUPS, SSD_HPG)[..., None] * xs
    y = y.reshape(B, L, SSD_GROUPS, SSD_WIDTH // SSD_GROUPS) * jax.nn.silu(
        z.reshape(B, L, SSD_GROUPS, SSD_WIDTH // SSD_GROUPS).astype(f32))
    y = _rmsnorm(y, p['ssd_norm'].reshape(SSD_GROUPS, SSD_WIDTH // SSD_GROUPS)).reshape(B, L, SSD_WIDTH)

    mix = jnp.concatenate([o_gla, y], axis=-1).astype(xn.dtype) @ p['w_out']
    h = h.reshape(B, SSD_HEADS, SSD_HEADDIM, SSD_STATE)
    return mix, S.astype(xn.dtype), h.astype(xn.dtype), conv_new.astype(xn.dtype)


def _conv_ffn(xn, s_ffn, p):
    u = xn @ p['ffn_w_in']
    u, buf = _causal_dwconv(u, s_ffn, p['ffn_conv_w'], p['ffn_conv_b'])
    a, b = jnp.split(u, 2, axis=-1)
    return (jax.nn.silu(a) * b) @ p['ffn_w_out'], buf.astype(xn.dtype)


def _layer(x, s_gla, s_ssd, s_conv, s_ffn, p):
    xn = _rmsnorm(x, p['n_mix_pre'])
    mix, g_new, h_new, c_new = _mixer(xn, s_gla, s_ssd, s_conv, p)
    x = x + _rmsnorm(mix, p['n_mix_post'])
    xn = _rmsnorm(x, p['n_ffn_pre'])
    f, f_new = _conv_ffn(xn, s_ffn, p)
    x = x + _rmsnorm(f, p['n_ffn_post'])
    return x, g_new, h_new, c_new, f_new


def setup_inputs(seed: int = 0) -> dict:
    key = jax.random.key(seed)
    ks = jax.random.split(key, 26)
    nrm = jax.random.normal
    f32 = jnp.float32
    dt = jnp.exp(jax.random.uniform(ks[16], (DEPTH, SSD_HEADS), f32,
                                    minval=math.log(1e-3), maxval=math.log(1e-1)))
    return {
        'x_prompt': nrm(ks[0], (BATCH, SEQ, D_MODEL), f32),
        'x_sample': nrm(ks[1], (DEC_BATCH, DEC_SEQ, D_MODEL), f32),
        'state_gla': 0.5 * nrm(ks[2], (DEPTH, DEC_BATCH, GLA_HEADS, GLA_HEAD_K, GLA_HEAD_V), f32),
        'state_ssd': 0.5 * nrm(ks[3], (DEPTH, DEC_BATCH, SSD_HEADS, SSD_HEADDIM, SSD_STATE), f32),
        'state_ssd_conv': nrm(ks[4], (DEPTH, DEC_BATCH, SSD_CONV - 1, SSD_CONV_CH), f32),
        'state_ffn_conv': nrm(ks[5], (DEPTH, DEC_BATCH, FFN_CONV - 1, 2 * FFN_DIM), f32),
        'norm_mix_pre': 1.0 + 0.02 * nrm(ks[6], (DEPTH, D_MODEL), f32),
        'norm_mix_post': 1.0 + 0.02 * nrm(ks[7], (DEPTH, D_MODEL), f32),
        'norm_ffn_pre': 1.0 + 0.02 * nrm(ks[8], (DEPTH, D_MODEL), f32),
        'norm_ffn_post': 1.0 + 0.02 * nrm(ks[9], (DEPTH, D_MODEL), f32),
        'w_in': nrm(ks[10], (DEPTH, D_MODEL, IN_COLS), f32) * D_MODEL ** -0.5,
        'gla_w_gate2': nrm(ks[11], (DEPTH, GLA_LOWRANK, GLA_KDIM), f32) * GLA_LOWRANK ** -0.5,
        'gla_b_gate': 0.1 * nrm(ks[12], (DEPTH, GLA_KDIM), f32),
        'gla_norm': 1.0 + 0.02 * nrm(ks[13], (DEPTH, GLA_HEAD_V), f32),
        'ssd_conv_w': nrm(ks[14], (DEPTH, SSD_CONV, SSD_CONV_CH), f32) * SSD_CONV ** -0.5,
        'ssd_conv_b': 0.01 * nrm(ks[15], (DEPTH, SSD_CONV_CH), f32),
        'ssd_dt_bias': dt + jnp.log(-jnp.expm1(-dt)),
        'ssd_A_log': jnp.log(jax.random.uniform(ks[17], (DEPTH, SSD_HEADS), f32, minval=1.0, maxval=16.0)),
        'ssd_D': 1.0 + 0.1 * nrm(ks[18], (DEPTH, SSD_HEADS), f32),
        'ssd_norm': 1.0 + 0.02 * nrm(ks[19], (DEPTH, SSD_WIDTH), f32),
        'w_out': nrm(ks[20], (DEPTH, MIX_WIDTH, D_MODEL), f32) * MIX_WIDTH ** -0.5,
        'ffn_w_in': nrm(ks[21], (DEPTH, D_MODEL, 2 * FFN_DIM), f32) * D_MODEL ** -0.5,
        'ffn_conv_w': nrm(ks[22], (DEPTH, FFN_CONV, 2 * FFN_DIM), f32) * FFN_CONV ** -0.5,
        'ffn_conv_b': 0.01 * nrm(ks[23], (DEPTH, 2 * FFN_DIM), f32),
        'ffn_w_out': nrm(ks[24], (DEPTH, FFN_DIM, D_MODEL), f32) * FFN_DIM ** -0.5,
    }


def reference(x_prompt, x_sample, state_gla, state_ssd, state_ssd_conv, state_ffn_conv,
              norm_mix_pre, norm_mix_post, norm_ffn_pre, norm_ffn_post, w_in,
              gla_w_gate2, gla_b_gate, gla_norm, ssd_conv_w, ssd_conv_b, ssd_dt_bias,
              ssd_A_log, ssd_D, ssd_norm, w_out, ffn_w_in, ffn_conv_w, ffn_conv_b, ffn_w_out):
    dt_ = x_prompt.dtype
    xp, xs = x_prompt, x_sample
    gp, hp, cp, fp = [], [], [], []
    gs, hs, cs, fs = [], [], [], []
    for l in range(DEPTH):
        p = dict(n_mix_pre=norm_mix_pre[l], n_mix_post=norm_mix_post[l],
                 n_ffn_pre=norm_ffn_pre[l], n_ffn_post=norm_ffn_post[l], w_in=w_in[l],
                 gla_w_gate2=gla_w_gate2[l], gla_b_gate=gla_b_gate[l], gla_norm=gla_norm[l],
                 ssd_conv_w=ssd_conv_w[l], ssd_conv_b=ssd_conv_b[l], ssd_dt_bias=ssd_dt_bias[l],
                 ssd_A_log=ssd_A_log[l], ssd_D=ssd_D[l], ssd_norm=ssd_norm[l], w_out=w_out[l],
                 ffn_w_in=ffn_w_in[l], ffn_conv_w=ffn_conv_w[l], ffn_conv_b=ffn_conv_b[l],
                 ffn_w_out=ffn_w_out[l])
        B = xp.shape[0]
        xp, g1, h1, c1, f1 = _layer(
            xp,
            jnp.zeros((B, GLA_HEADS, GLA_HEAD_K, GLA_HEAD_V), dt_),
            jnp.zeros((B, SSD_HEADS, SSD_HEADDIM, SSD_STATE), dt_),
            jnp.zeros((B, SSD_CONV - 1, SSD_CONV_CH), dt_),
            jnp.zeros((B, FFN_CONV - 1, 2 * FFN_DIM), dt_),
            p)
        xs, g2, h2, c2, f2 = _layer(xs, state_gla[l], state_ssd[l], state_ssd_conv[l],
                                    state_ffn_conv[l], p)
        gp.append(g1); hp.append(h1); cp.append(c1); fp.append(f1)
        gs.append(g2); hs.append(h2); cs.append(c2); fs.append(f2)
    return (xp, xs,
            jnp.stack(gp), jnp.stack(hp), jnp.stack(cp), jnp.stack(fp),
            jnp.stack(gs), jnp.stack(hs), jnp.stack(cs), jnp.stack(fs))
```

```cpp
#include <hip/hip_runtime.h>
#include <hip/hip_cooperative_groups.h>
#include <cstdio>
#include <cstdint>
namespace cg = cooperative_groups;

#ifndef MK_PER_PHASE
#define MK_PER_PHASE 1
#endif

namespace pg8 {
#define PG8_LAS __attribute__((address_space(3)))
typedef unsigned short bf16_t;
typedef short bf16x8 __attribute__((ext_vector_type(8)));
typedef float f32x4 __attribute__((ext_vector_type(4)));
typedef unsigned u32x4 __attribute__((ext_vector_type(4)));
constexpr int BM = 256, BK = 64, HALF = 128, HTB = HALF * BK * 2  , STAGE_BYTES = 8 * HTB, NXCD = 8, WGM = 8;

__host__ __device__ __forceinline__ int lds_byte(int r, int c) { const int st = (r >> 4) * 2 + (c >> 5), rr = r & 15, cc = c & 31, ob = rr * 64 + cc * 2; return st * 1024 + (ob ^ (((ob >> 9) & 1) << 5)); }
__host__ __device__ __forceinline__ void stage_rc(int b, int& R, int& C) { const int st = b / 1024, sb = b % 1024, swz = sb ^ (((sb >> 9) & 1) << 5); R = (st >> 1) * 16 + swz / 64; C = (st & 1) * 32 + (swz % 64) / 2; }
__host__ __device__ __forceinline__ int perm32(int rho) { const int n = rho >> 4, i = rho & 15; return 8 * (i >> 2) + 4 * n + (i & 3); }

struct Unit { int pm, pn; };
struct Gemm { const bf16_t* A; const bf16_t* Bt; int M, N, K; };

struct StaticOrder {
    int nM, nN, nwg, G, c;
    __host__ __device__ void init(int M, int N, int G_, int c_) { nM = M / BM; nN = N / BM; nwg = nM * nN; G = G_; c = c_; }
    __host__ __device__ bool next(int i, Unit& u) const {
        const long L = (long)i * G + c; if (L >= nwg) return false;
        int wgid = (int)L; { const int q = nwg / NXCD, r = nwg % NXCD, xcd = wgid % NXCD, off = wgid / NXCD; wgid = (xcd < r ? xcd * (q + 1) : r * (q + 1) + (xcd - r) * q) + off; }
        const int nig = WGM * nN, gid = wgid / nig, fm = gid * WGM, gsz = (nM - fm) < WGM ? (nM - fm) : WGM;
        u.pm = fm + ((wgid % nig) % gsz); u.pn = (wgid % nig) / gsz; return true;
    }
    __device__ __forceinline__ void a_ready(const Unit&) const {}
    __device__ __forceinline__ void done(const Unit&) const {}
};

__device__ __forceinline__ unsigned cvt_pk_bf16(float lo, float hi) { unsigned r; asm volatile("v_cvt_pk_bf16_f32 %0, %1, %2" : "=v"(r) : "v"(lo), "v"(hi)); return r; }

struct EpiF32 {
    static constexpr bool PERM = false, AFTER_DRAIN = false;
    float* C; int ldc;
    __device__ __forceinline__ void operator()(const f32x4 (&acc)[2][2][4][2], const Unit& u, int wr, int wc, int fr, int fq) const {
        const int row0 = u.pm * BM + wr * 64 + fr, col0 = u.pn * BM + wc * 32 + 4 * fq;
#pragma unroll
        for (int ai = 0; ai < 2; ++ai)
#pragma unroll
            for (int m = 0; m < 4; ++m) { float* rowp = C + (size_t)(row0 + ai * HALF + m * 16) * ldc + col0;
#pragma unroll
                for (int bj = 0; bj < 2; ++bj)
#pragma unroll
                    for (int n = 0; n < 2; ++n) *(f32x4*)(rowp + bj * HALF + n * 16) = acc[ai][bj][m][n]; }
    }
};
struct EpiBf16 {
    static constexpr bool PERM = true, AFTER_DRAIN = false;
    bf16_t* O; int ldc; int nfull; float* X;
    __device__ __forceinline__ void operator()(const f32x4 (&acc)[2][2][4][2], const Unit& u, int wr, int wc, int fr, int fq) const {
        const int row0 = u.pm * BM + wr * 64 + fr;
        if (u.pn < nfull) {
            const int col0 = u.pn * BM + wc * 32 + 8 * fq;
#pragma unroll
            for (int ai = 0; ai < 2; ++ai)
#pragma unroll
                for (int m = 0; m < 4; ++m) { bf16_t* rowp = O + (size_t)(row0 + ai * HALF + m * 16) * ldc + col0;
#pragma unroll
                    for (int bj = 0; bj < 2; ++bj) { const f32x4 v0 = acc[ai][bj][m][0], v1 = acc[ai][bj][m][1];
                        u32x4 w; w.x = cvt_pk_bf16(v0[0], v0[1]); w.y = cvt_pk_bf16(v0[2], v0[3]); w.z = cvt_pk_bf16(v1[0], v1[1]); w.w = cvt_pk_bf16(v1[2], v1[3]);
                        *(u32x4*)(rowp + bj * HALF) = w; } }
        } else if (wc == 0) {
#pragma unroll
            for (int ai = 0; ai < 2; ++ai)
#pragma unroll
                for (int m = 0; m < 4; ++m) { float* rowp = X + (size_t)(row0 + ai * HALF + m * 16) * 32 + 8 * fq;
                    *(f32x4*)(rowp) = acc[ai][0][m][0]; *(f32x4*)(rowp + 4) = acc[ai][0][m][1]; }
        }
    }
};

template <class Epi, class Sched, bool ALIGN_EPI = false, bool SP2 = false>
__device__ __forceinline__ void gemm_phase(PG8_LAS unsigned char* lds, const Gemm g, const Sched& S, const Epi& E) {
    const int tid = threadIdx.x, wid = __builtin_amdgcn_readfirstlane(tid >> 6), lane = tid & 63, wr = wid >> 2, wc = wid & 3, fr = lane & 15, fq = lane >> 4;
    const int K = g.K, nt = K / BK;
    unsigned voffA[2], voffB[2];
#pragma unroll
    for (int i = 0; i < 2; ++i) { int R, C; stage_rc(tid * 16 + i * 8192, R, C); const int Rb = Epi::PERM ? ((R & ~31) + perm32(R & 31)) : R;
        voffA[i] = (unsigned)(R * K + C) * 2u; voffB[i] = (unsigned)(Rb * K + C) * 2u; }
    const size_t kstep = (size_t)(BK * 2);
    const size_t hstep = (size_t)HALF * K * 2;
    const size_t tstep = 2 * hstep;
    const unsigned ldsw = (unsigned)wid * 1024u;
    const int aoff = lds_byte(wr * 64 + fr, fq * 8), boff = lds_byte(wc * 32 + fr, fq * 8);
#define PG8_SA(b, h) (((b) * 2 + (h)) * HTB)
#define PG8_SB(b, h) ((4 + (b) * 2 + (h)) * HTB)
#define PG8_STAGE(bufoff, gbase, voff) do { _Pragma("unroll") for (int _i = 0; _i < 2; ++_i) \
        __builtin_amdgcn_global_load_lds((const unsigned*)((const char*)(gbase) + (voff)[_i]), (PG8_LAS unsigned*)(lds + (bufoff) + ldsw + _i * 8192), 16, 0, 0); } while (0)
#define PG8_LDA(dst, b, h) do { _Pragma("unroll") for (int m = 0; m < 4; ++m) _Pragma("unroll") for (int k = 0; k < 2; ++k) dst[m][k] = *(const PG8_LAS bf16x8*)(lds + PG8_SA(b, h) + aoff + m * 2048 + k * 1024); } while (0)
#define PG8_LDB(dst, b, h) do { _Pragma("unroll") for (int n = 0; n < 2; ++n) _Pragma("unroll") for (int k = 0; k < 2; ++k) dst[n][k] = *(const PG8_LAS bf16x8*)(lds + PG8_SB(b, h) + boff + n * 2048 + k * 1024); } while (0)
#define PG8_MMA(ai, bj, At, Bt) do { __builtin_amdgcn_s_setprio(1); _Pragma("unroll") for (int m = 0; m < 4; ++m) _Pragma("unroll") for (int n = 0; n < 2; ++n) _Pragma("unroll") for (int k = 0; k < 2; ++k) \
        acc[ai][bj][m][n] = __builtin_amdgcn_mfma_f32_16x16x32_bf16(Bt[n][k], At[m][k], acc[ai][bj][m][n], 0, 0, 0); __builtin_amdgcn_s_setprio(0); } while (0)
#define PG8_WAIT_V(n) asm volatile("s_waitcnt vmcnt(" #n ")" ::: "memory")
#define PG8_WAIT_L(n) asm volatile("s_waitcnt lgkmcnt(" #n ")" ::: "memory")
#define PG8_BAR __builtin_amdgcn_s_barrier()
#define PG8_SCHED __builtin_amdgcn_sched_barrier(0)
    Unit cur, nxt; int ui = 0;
    if (!S.next(0, cur)) return;
    f32x4 acc[2][2][4][2];
#pragma unroll
    for (int a = 0; a < 2; ++a)
#pragma unroll
        for (int b = 0; b < 2; ++b)
#pragma unroll
            for (int m = 0; m < 4; ++m)
#pragma unroll
                for (int n = 0; n < 2; ++n) acc[a][b][m][n] = (f32x4){0.f, 0.f, 0.f, 0.f};
    bf16x8 At[4][2], B0[2][2], B1[2][2];
    const char* cA = (const char*)g.A + (size_t)cur.pm * tstep; const char* cB = (const char*)g.Bt + (size_t)cur.pn * tstep;
    S.a_ready(cur);
    if constexpr (SP2) {
        PG8_STAGE(PG8_SB(0, 0), cB, voffB); PG8_STAGE(PG8_SB(0, 1), cB + hstep, voffB); PG8_STAGE(PG8_SA(0, 0), cA, voffA); PG8_STAGE(PG8_SA(0, 1), cA + hstep, voffA);
        if (wr == 1) PG8_BAR;
        PG8_WAIT_V(2); PG8_BAR;
        PG8_STAGE(PG8_SB(1, 0), cB + kstep, voffB); PG8_STAGE(PG8_SA(1, 0), cA + kstep, voffA); PG8_STAGE(PG8_SB(1, 1), cB + hstep + kstep, voffB);
        PG8_WAIT_V(6); PG8_BAR;
    } else {
        PG8_STAGE(PG8_SB(0, 0), cB, voffB); PG8_STAGE(PG8_SA(0, 0), cA, voffA); PG8_STAGE(PG8_SB(0, 1), cB + hstep, voffB); PG8_STAGE(PG8_SA(0, 1), cA + hstep, voffA);
        if (wr == 1) PG8_BAR;
        PG8_WAIT_V(4); PG8_BAR;
        PG8_STAGE(PG8_SB(1, 0), cB + kstep, voffB); PG8_STAGE(PG8_SA(1, 0), cA + kstep, voffA); PG8_STAGE(PG8_SB(1, 1), cB + hstep + kstep, voffB);
        PG8_WAIT_V(6); PG8_BAR;
    }
    for (;;) {
        const bool has_next = S.next(ui + 1, nxt);
        const char* nA = has_next ? (const char*)g.A + (size_t)nxt.pm * tstep : cA; const char* nB = has_next ? (const char*)g.Bt + (size_t)nxt.pn * tstep : cB;
        for (int t = 0; t < nt; t += 2) {
            const bool last = (t == nt - 2);
            const char* a1 = cA + (size_t)(t + 1) * kstep;
            const char* a2 = last ? nA : cA + (size_t)(t + 2) * kstep; const char* b2 = last ? nB : cB + (size_t)(t + 2) * kstep;
            const char* a3 = a2 + kstep; const char* b3 = b2 + kstep;
            if (last && has_next) S.a_ready(nxt);
            if constexpr (SP2) {
            PG8_LDB(B0, 0, 0); PG8_LDB(B1, 0, 1); PG8_SCHED; PG8_LDA(At, 0, 0); PG8_STAGE(PG8_SA(1, 1), a1 + hstep, voffA);
            PG8_WAIT_V(8); PG8_WAIT_L(0); PG8_BAR; PG8_MMA(0, 0, At, B0); PG8_MMA(0, 1, At, B1); PG8_BAR; PG8_SCHED;
            PG8_LDA(At, 0, 1); PG8_STAGE(PG8_SB(0, 0), b2, voffB); PG8_STAGE(PG8_SB(0, 1), b2 + hstep, voffB); PG8_STAGE(PG8_SA(0, 0), a2, voffA);
            PG8_WAIT_V(8); PG8_WAIT_L(0); PG8_BAR; PG8_MMA(1, 0, At, B0); PG8_MMA(1, 1, At, B1); PG8_BAR; PG8_SCHED;
            PG8_LDB(B0, 1, 0); PG8_LDB(B1, 1, 1); PG8_SCHED; PG8_LDA(At, 1, 0); PG8_STAGE(PG8_SA(0, 1), a2 + hstep, voffA);
            PG8_WAIT_V(8); PG8_WAIT_L(0); PG8_BAR; PG8_MMA(0, 0, At, B0); PG8_MMA(0, 1, At, B1); PG8_BAR; PG8_SCHED;
            PG8_LDA(At, 1, 1); PG8_STAGE(PG8_SB(1, 0), b3, voffB); PG8_STAGE(PG8_SB(1, 1), b3 + hstep, voffB); PG8_STAGE(PG8_SA(1, 0), a3, voffA);
            PG8_WAIT_V(8); PG8_WAIT_L(0); PG8_BAR; PG8_MMA(1, 0, At, B0); PG8_MMA(1, 1, At, B1); PG8_BAR; PG8_SCHED;
            } else {
            PG8_LDB(B0, 0, 0); PG8_SCHED; PG8_LDA(At, 0, 0); PG8_STAGE(PG8_SA(1, 1), a1 + hstep, voffA);
            PG8_WAIT_L(8); PG8_BAR; PG8_WAIT_L(0); PG8_MMA(0, 0, At, B0); PG8_BAR; PG8_SCHED;
            PG8_LDB(B1, 0, 1); PG8_STAGE(PG8_SB(0, 0), b2, voffB);
            PG8_BAR; PG8_WAIT_L(0); PG8_MMA(0, 1, At, B1); PG8_BAR;
            PG8_LDA(At, 0, 1); PG8_STAGE(PG8_SA(0, 0), a2, voffA);
            PG8_BAR; PG8_WAIT_L(0); PG8_MMA(1, 0, At, B0); PG8_BAR; PG8_SCHED;
            PG8_STAGE(PG8_SB(0, 1), b2 + hstep, voffB);
            PG8_WAIT_V(6); PG8_BAR; PG8_MMA(1, 1, At, B1); PG8_BAR;
            PG8_LDB(B0, 1, 0); PG8_SCHED; PG8_LDA(At, 1, 0); PG8_STAGE(PG8_SA(0, 1), a2 + hstep, voffA);
            PG8_WAIT_L(8); PG8_BAR; PG8_WAIT_L(0); PG8_MMA(0, 0, At, B0); PG8_BAR; PG8_SCHED;
            PG8_LDB(B1, 1, 1); PG8_STAGE(PG8_SB(1, 0), b3, voffB);
            PG8_BAR; PG8_WAIT_L(0); PG8_MMA(0, 1, At, B1); PG8_BAR;
            PG8_LDA(At, 1, 1); PG8_STAGE(PG8_SA(1, 0), a3, voffA);
            PG8_BAR; PG8_WAIT_L(0); PG8_MMA(1, 0, At, B0); PG8_BAR; PG8_SCHED;
            PG8_STAGE(PG8_SB(1, 1), b3 + hstep, voffB);
            PG8_WAIT_V(6); PG8_BAR; PG8_MMA(1, 1, At, B1); PG8_BAR;
            }
        }
        if constexpr (ALIGN_EPI) { if (wr == 0) PG8_BAR; }
        if constexpr (!Epi::AFTER_DRAIN) { E(acc, cur, wr, wc, fr, fq); S.done(cur); }
        if (!has_next) break;
#pragma unroll
        for (int a = 0; a < 2; ++a)
#pragma unroll
            for (int b = 0; b < 2; ++b)
#pragma unroll
                for (int m = 0; m < 4; ++m)
#pragma unroll
                    for (int n = 0; n < 2; ++n) acc[a][b][m][n] = (f32x4){0.f, 0.f, 0.f, 0.f};
        cur = nxt; cA = nA; cB = nB; ++ui;
        if constexpr (ALIGN_EPI) { if (wr == 1) PG8_BAR; }
    }
    PG8_WAIT_V(0);
    if constexpr (!ALIGN_EPI) { if (wr == 0) PG8_BAR; }
    PG8_BAR;
    if constexpr (Epi::AFTER_DRAIN) { E.fused(acc, cur, wr, wc, fr, fq, lds, wid, lane); S.done(cur); }
#undef PG8_SA
#undef PG8_SB
#undef PG8_STAGE
#undef PG8_LDA
#undef PG8_LDB
#undef PG8_MMA
#undef PG8_WAIT_V
#undef PG8_WAIT_L
#undef PG8_BAR
#undef PG8_SCHED
}
}

constexpr int NWAVES = 8, NTHR = 512;
constexpr int DM = 2048, PB = 4, PL = 2048, SB = 128, SL = 8;
constexpr int MP = PB * PL, MS = SB * SL, M = MP + MS;
constexpr int GH = 4, GK = 128, GV = 256, GKD = 512, LOWR = 16;
constexpr int SH = 16, SP = 64, SN = 128, SG = 2, SCH = 1536;
constexpr int FF = 5632, FF2 = 11264, INC = 5664;
constexpr int N1 = 5888, NP = 5632;
constexpr int CQ = 0, CK = 512, CV = 1024, CG = 2048, CZ = 3072, CX = 4096;
constexpr float EPS = 1e-6f;
constexpr int N_PHASES = 9;

constexpr size_t O_Y = 0, O_GLA_P = (size_t)M * DM, O_SSD_P = O_GLA_P + (size_t)PB * GH * GK * GV, O_SCONV_P = O_SSD_P + (size_t)PB * SH * SP * SN,
                 O_FCONV_P = O_SCONV_P + (size_t)PB * 3 * SCH, O_GLA_S = O_FCONV_P + (size_t)PB * 2 * FF2, O_SSD_S = O_GLA_S + (size_t)SB * GH * GK * GV,
                 O_SCONV_S = O_SSD_S + (size_t)SB * SH * SP * SN, O_FCONV_S = O_SCONV_S + (size_t)SB * 3 * SCH, O_END = O_FCONV_S + (size_t)SB * 2 * FF2;

constexpr size_t MiB = 1u << 20;
constexpr size_t WS_CTL = 0, CTL_ZERO_BYTES = 64 * 1024;
constexpr size_t WS_WF2 = 1 * MiB;
constexpr size_t WS_W1 = 24 * MiB;
constexpr size_t WS_WO = 48 * MiB;
constexpr size_t WS_WF1 = 56 * MiB;
constexpr size_t WS_XN = 101 * MiB;
constexpr size_t WS_ACT = 24 * MiB;
constexpr size_t WS_BIG = 141 * MiB;
constexpr size_t WS_PROJ = WS_BIG;
constexpr size_t WS_MIX = WS_BIG;
constexpr size_t WS_U = WS_BIG;
constexpr size_t WS_F = WS_BIG;
constexpr size_t WS_LRDT = WS_BIG + 100 * MiB;
constexpr size_t WS_MIXIN = WS_BIG + 104 * MiB;
constexpr size_t WS_END = WS_BIG + 200 * MiB;
static_assert(WS_WF2 + (size_t)DM * FF * 2 <= WS_W1 && WS_W1 + (size_t)N1 * DM * 2 <= WS_WO && WS_WO + (size_t)DM * DM * 2 <= WS_WF1 && WS_WF1 + (size_t)FF2 * DM * 2 <= WS_XN && WS_XN + (size_t)M * DM * 2 <= WS_BIG, "ws map 1");
static_assert(WS_ACT + (size_t)M * FF * 2 <= WS_BIG && WS_PROJ + (size_t)M * NP * 2 <= WS_LRDT && WS_LRDT + (size_t)M * 32 * 4 <= WS_MIXIN && WS_MIXIN + (size_t)M * DM * 2 <= WS_END && WS_U + (size_t)M * FF2 * 2 <= WS_END && WS_MIX + (size_t)M * DM * 4 <= WS_LRDT, "ws map 2");
constexpr int CW_BAR = 1024;

constexpr int RING_BYTES = 131072;
constexpr int LDSCTL_OFF = RING_BYTES, MISC_OFF = LDSCTL_OFF + 320;
constexpr int LDS_BYTES = 147456;

#define GAS __attribute__((address_space(1)))
#define LAS __attribute__((address_space(3)))
typedef unsigned short bf16;
typedef unsigned v4u __attribute__((ext_vector_type(4)));
typedef unsigned v2u __attribute__((ext_vector_type(2)));
typedef float f32x4 __attribute__((ext_vector_type(4)));
#define LDS_WAIT() asm volatile("s_waitcnt lgkmcnt(0)" ::: "memory")
#define VM_WAIT() asm volatile("s_waitcnt vmcnt(0)" ::: "memory")
__device__ __forceinline__ unsigned f2bf(float f) { unsigned u = __builtin_bit_cast(unsigned, f); return (u + 0x7fffu + ((u >> 16) & 1u)) >> 16; }
__device__ __forceinline__ unsigned pk2(float lo, float hi) { return f2bf(lo) | (f2bf(hi) << 16); }
__device__ __forceinline__ float bf2f(unsigned short b) { return __builtin_bit_cast(float, (unsigned)b << 16); }
__device__ __forceinline__ float bflo(unsigned w) { return __builtin_bit_cast(float, w << 16); }
__device__ __forceinline__ float bfhi(unsigned w) { return __builtin_bit_cast(float, w & 0xffff0000u); }
__device__ __forceinline__ float silu_f(float x) { return x / (1.f + __expf(-x)); }
__device__ __forceinline__ float softplus_f(float x) { return fmaxf(x, 0.f) + log1pf(__expf(-fabsf(x))); }
__device__ __forceinline__ float logsigmoid_f(float x) { return fminf(x, 0.f) - log1pf(__expf(-fabsf(x))); }
__device__ __forceinline__ float wave_sum(float v) {
#pragma unroll
    for (int o = 1; o < 64; o <<= 1) v += __shfl_xor(v, o);
    return v;
}

#define XB_TMO      128
#define XB_XCNT(j)  (256  + 64 * (j))
#define XB_XSUB(j)  (1280 + 64 * (j))
#define XB_XGEN(j)  (2304 + 64 * (j))
#define XB_TOP      3328
#define XB_TOPGEN   3392
#define XCD_BAR_WORDS 3456
#define XB_SPIN_CAP (1u << 18)

__device__ __forceinline__ unsigned xb_ld(unsigned* p)              { return __hip_atomic_load(p, __ATOMIC_RELAXED, __HIP_MEMORY_SCOPE_AGENT); }
__device__ __forceinline__ unsigned xb_add(unsigned* p, unsigned v) { return __hip_atomic_fetch_add(p, v, __ATOMIC_RELAXED, __HIP_MEMORY_SCOPE_AGENT); }
__device__ __forceinline__ unsigned xb_xcc_id() { return (unsigned)__builtin_amdgcn_s_getreg((3 << 11) | 20) & 0xFu; }
#define XB_SPIN(cond, bar) do { unsigned _sp = 0; while (cond) { __builtin_amdgcn_s_sleep(1); \
    if ((++_sp & 255u) == 0u) { if (xb_ld(&(bar)[XB_TMO])) break; if (_sp > XB_SPIN_CAP) { atomicAdd(&(bar)[XB_TMO], 1u); break; } } } } while (0)

struct XcdBarrier {
    unsigned* bar; unsigned x;
    volatile LAS unsigned* st;
};

__device__ __forceinline__ XcdBarrier xcd_barrier_post(unsigned* bar, volatile LAS unsigned* st) {
    XcdBarrier b; b.bar = bar; b.x = xb_xcc_id(); b.st = st;
    if (threadIdx.x == 0) (void)xb_add(&bar[XB_XCNT(b.x)], 1u);
    return b;
}
__device__ __forceinline__ void xcd_barrier_complete(unsigned* bar, unsigned x, unsigned& nloc, unsigned& nx) {
    const unsigned G = gridDim.x * gridDim.y * gridDim.z;
    unsigned sum, cnt, mine, sp = 0u;
    for (;;) {
        sum = 0u; cnt = 0u; mine = 0u;
#pragma unroll
        for (unsigned j = 0; j < 16; ++j) { const unsigned c = xb_ld(&bar[XB_XCNT(j)]); sum += c; cnt += (c > 0u) ? 1u : 0u; mine = (j == x) ? c : mine; }
        if (sum == G) break;
        __builtin_amdgcn_s_sleep(1);
        if ((++sp & 255u) == 0u) { if (xb_ld(&bar[XB_TMO])) break; if (sp > XB_SPIN_CAP) { atomicAdd(&bar[XB_TMO], 1u); break; } }
    }
    nloc = mine > 0u ? mine : 1u; nx = cnt > 0u ? cnt : 1u;
}

__device__ __forceinline__ void xcd_barrier(const XcdBarrier& b) {
    asm volatile("s_waitcnt vmcnt(0)" ::: "memory");
    __syncthreads();
    if (threadIdx.x == 0) {
        unsigned* bar = b.bar;
        __builtin_amdgcn_s_waitcnt(0);
        unsigned nloc = b.st[0], nx = b.st[1];
        if (nloc == 0u) { xcd_barrier_complete(bar, b.x, nloc, nx); b.st[0] = nloc; b.st[1] = nx; }
        const unsigned old = xb_add(&bar[XB_XSUB(b.x)], 1u);
        const unsigned gen = old / nloc;
        if (old + 1u == (gen + 1u) * nloc) {
            __builtin_amdgcn_fence(__ATOMIC_RELEASE, "agent");
            asm volatile("s_waitcnt vmcnt(0)" ::: "memory");
            const unsigned og = xb_add(&bar[XB_TOP], 1u);
            const unsigned tg = og / nx;
            if (og + 1u == (tg + 1u) * nx) xb_add(&bar[XB_TOPGEN], 1u);
            else XB_SPIN(xb_ld(&bar[XB_TOPGEN]) == tg, bar);
            __builtin_amdgcn_fence(__ATOMIC_ACQUIRE, "agent");
            xb_add(&bar[XB_XGEN(b.x)], 1u);
            asm volatile("s_waitcnt vmcnt(0)" ::: "memory");
        } else {
            XB_SPIN(xb_ld(&bar[XB_XGEN(b.x)]) == gen, bar);
            __builtin_amdgcn_fence(__ATOMIC_ACQUIRE, "agent");
            asm volatile("s_waitcnt vmcnt(0)" ::: "memory");
        }
    }
    __syncthreads();
}

struct Frame {
    LAS unsigned char* lds;
    int tid, lane, wave, G, bid;
    const float *x_p, *x_s, *st_gla, *st_ssd, *st_sconv, *st_fconv, *n_mix_pre, *n_mix_post, *n_ffn_pre, *n_ffn_post, *w_in, *w_gate2, *b_gate, *gla_norm,
                *sconv_w, *sconv_b, *dt_bias, *A_log, *ssd_D, *ssd_norm, *w_out, *ffn_w_in, *fconv_w, *fconv_b, *ffn_w_out;
    float* out;
    bf16 *W1, *WO, *WF1, *WF2, *XN, *PROJ, *MIXIN, *U, *ACT;
    float *LRDT, *MIX, *Fb;
};
__device__ __forceinline__ const float* x_row(const Frame& F, int row) { return row < MP ? F.x_p + (size_t)row * DM : F.x_s + (size_t)(row - MP) * DM; }

__device__ __forceinline__ int w1_src_col(int n) { return n < 3072 ? n : (n < 5632 ? n + 16 : (n < 5648 ? n - 2560 : (n < 5664 ? n : -1))); }
template <bool MAP>
__device__ __forceinline__ void p0_transpose_item(const float* W, int K, int Nsrc, int Ndst, bf16* WT, LAS float* scr, int item, int lane) {
    const int nblk = Ndst / 32, kb = item / nblk, nb = item % nblk, k0 = 64 * kb, n0 = 32 * nb;
    int sc = n0 + (lane & 31); if (MAP) sc = w1_src_col(sc);
#pragma unroll 8
    for (int i = 0; i < 32; ++i) { const int kk = 2 * i + (lane >> 5); scr[kk * 33 + (lane & 31)] = (sc >= 0) ? W[(size_t)(k0 + kk) * Nsrc + sc] : 0.f; }
    LDS_WAIT(); asm volatile("" ::: "memory");
    const int c = lane & 7;
#pragma unroll
    for (int j = 0; j < 4; ++j) { const int n = (lane >> 3) + 8 * j; const LAS float* s = scr + (8 * c) * 33 + n;
        v4u o; o.x = pk2(s[0 * 33], s[1 * 33]); o.y = pk2(s[2 * 33], s[3 * 33]); o.z = pk2(s[4 * 33], s[5 * 33]); o.w = pk2(s[6 * 33], s[7 * 33]);
        *(v4u*)(WT + (size_t)(n0 + n) * K + k0 + 8 * c) = o; }
    LDS_WAIT(); asm volatile("" ::: "memory");
}
__device__ __forceinline__ void rms_row_to_bf16(const float* xrow, const float* w, bf16* orow, int lane) {
    const f32x4* xr = (const f32x4*)xrow + lane; const f32x4* wr = (const f32x4*)w + lane;
    f32x4 v[8]; float s = 0.f;
#pragma unroll
    for (int j = 0; j < 8; ++j) { v[j] = xr[64 * j]; s += (v[j].x * v[j].x + v[j].y * v[j].y) + (v[j].z * v[j].z + v[j].w * v[j].w); }
    const float r = rsqrtf(wave_sum(s) * (1.f / DM) + EPS);
    v2u* o8 = (v2u*)orow + lane;
#pragma unroll
    for (int j = 0; j < 8; ++j) { const f32x4 ww = wr[64 * j]; v2u o; o.x = pk2(v[j].x * r * ww.x, v[j].y * r * ww.y); o.y = pk2(v[j].z * r * ww.z, v[j].w * r * ww.w); o8[64 * j] = o; }
}
__device__ __forceinline__ void p0_prologue(Frame& F) {
    LAS float* scr = (LAS float*)(F.lds + F.wave * 16384);
    const int gw = F.bid * NWAVES + F.wave, NGW = F.G * NWAVES;
    constexpr int I_1 = (DM / 64) * (N1 / 32), I_O = (DM / 64) * (DM / 32), I_F1 = (DM / 64) * (FF2 / 32), I_F2 = (FF / 64) * (DM / 32);
    constexpr int NITEMS = I_1 + I_O + I_F1 + I_F2;
    for (int it = gw; it < NITEMS; it += NGW) {
        int r = it;
        if (r < I_1) { p0_transpose_item<true>(F.w_in, DM, INC, N1, F.W1, scr, r, F.lane); continue; } r -= I_1;
        if (r < I_O) { p0_transpose_item<false>(F.w_out, DM, DM, DM, F.WO, scr, r, F.lane); continue; } r -= I_O;
        if (r < I_F1) { p0_transpose_item<false>(F.ffn_w_in, DM, FF2, FF2, F.WF1, scr, r, F.lane); continue; } r -= I_F1;
        p0_transpose_item<false>(F.ffn_w_out, FF, DM, DM, F.WF2, scr, r, F.lane);
    }
    for (int m = gw; m < M; m += NGW) rms_row_to_bf16(x_row(F, m), F.n_mix_pre, F.XN + (size_t)m * DM, F.lane);
}

template <int grp> __device__ __forceinline__ void gla_direct_unit(Frame& F, int b, int h) {
    const int tid = F.tid, v = tid & 255, kh = tid >> 8;
    const int L = grp ? SL : PL, row0 = grp ? MP + b * SL : b * PL;
    LAS float* Es = (LAS float*)F.lds; LAS float* Ks = Es + 1024; LAS float* Qs = Ks + 1024; LAS float* Os = Qs + 1024;
    float S[64];
    if (grp) { const float* s0 = F.st_gla + ((size_t)(b * GH + h) * GK + kh * 64) * GV + v;
#pragma unroll
        for (int i = 0; i < 64; ++i) S[i] = s0[(size_t)i * GV]; }
    else {
#pragma unroll
        for (int i = 0; i < 64; ++i) S[i] = 0.f; }
    for (int t0 = 0; t0 < L; t0 += 8) {
        for (int it = tid; it < 1024; it += NTHR) { const int t = it >> 7, k = it & 127, row = row0 + t0 + t, hk = h * GK + k;
            float x = F.b_gate[hk]; const float* lr = F.LRDT + (size_t)row * 32;
#pragma unroll
            for (int j = 0; j < LOWR; ++j) x += lr[j] * F.w_gate2[j * GKD + hk];
            const float lg = logsigmoid_f(x) * (1.f / 16.f);
            Es[it] = __expf(lg); Ks[it] = bf2f(F.PROJ[(size_t)row * NP + CK + hk]); Qs[it] = bf2f(F.PROJ[(size_t)row * NP + CQ + hk]) * 0.08838834764831845f; }
        __syncthreads();
#pragma unroll 1
        for (int t = 0; t < 8; ++t) { const float vv = bf2f(F.PROJ[(size_t)(row0 + t0 + t) * NP + CV + h * GV + v]); float acc = 0.f;
            const LAS float* e = Es + t * 128 + kh * 64; const LAS float* kk = Ks + t * 128 + kh * 64; const LAS float* qq = Qs + t * 128 + kh * 64;
#pragma unroll
            for (int i = 0; i < 64; ++i) { S[i] = e[i] * S[i] + kk[i] * vv; acc += qq[i] * S[i]; }
            Os[(kh * 8 + t) * 256 + v] = acc; }
        __syncthreads();
        { const int t = F.wave, v4 = F.lane * 4, row = row0 + t0 + t;
            const f32x4 a = *(const LAS f32x4*)(Os + t * 256 + v4), c = *(const LAS f32x4*)(Os + (8 + t) * 256 + v4); const f32x4 o = a + c;
            const float ss = wave_sum((o.x * o.x + o.y * o.y) + (o.z * o.z + o.w * o.w)); const float r = rsqrtf(ss * (1.f / GV) + EPS);
            const v2u gw = *(const v2u*)(F.PROJ + (size_t)row * NP + CG + h * GV + v4); const f32x4 nw = *(const f32x4*)(F.gla_norm + v4);
            v2u w; w.x = pk2(o.x * r * nw.x * silu_f(bflo(gw.x)), o.y * r * nw.y * silu_f(bfhi(gw.x))); w.y = pk2(o.z * r * nw.z * silu_f(bflo(gw.y)), o.w * r * nw.w * silu_f(bfhi(gw.y)));
            *(v2u*)(F.MIXIN + (size_t)row * DM + h * GV + v4) = w; }
        __syncthreads();
    }
    float* so = F.out + (grp ? O_GLA_S : O_GLA_P) + ((size_t)(b * GH + h) * GK + kh * 64) * GV + v;
#pragma unroll
    for (int i = 0; i < 64; ++i) so[(size_t)i * GV] = S[i];
}
__device__ __forceinline__ float xbc_raw(const Frame& F, int grp, int b, int row0, int tt, int c) {
    if (tt >= 0) return bf2f(F.PROJ[(size_t)(row0 + tt) * NP + CX + c]);
    return grp ? F.st_sconv[((size_t)b * 3 + (tt + 3)) * SCH + c] : 0.f;
}
template <int grp> __device__ __forceinline__ void ssd_direct_unit(Frame& F, int b, int g) {
    const int tid = F.tid, hd = g * 8 + (tid >> 6), p = tid & 63, ch = g * 512 + tid;
    const int L = grp ? SL : PL, row0 = grp ? MP + b * SL : b * PL;
    LAS float* Bs = (LAS float*)F.lds; LAS float* Cs = Bs + 1024; LAS float* red = Cs + 1024; LAS float* Ys = red + 64;
    float h[128];
    if (grp) { const f32x4* h0 = (const f32x4*)(F.st_ssd + ((size_t)(b * SH + hd) * SP + p) * SN);
#pragma unroll
        for (int i = 0; i < 32; ++i) { const f32x4 q = h0[i]; h[4 * i] = q.x; h[4 * i + 1] = q.y; h[4 * i + 2] = q.z; h[4 * i + 3] = q.w; } }
    else {
#pragma unroll
        for (int i = 0; i < 128; ++i) h[i] = 0.f; }
    const float A = -__expf(F.A_log[hd]), dtb = F.dt_bias[hd], Dh = F.ssd_D[hd], nw = F.ssd_norm[ch];
    const float cb = F.sconv_b[ch], cw0 = F.sconv_w[ch], cw1 = F.sconv_w[SCH + ch], cw2 = F.sconv_w[2 * SCH + ch], cw3 = F.sconv_w[3 * SCH + ch];
    const int c2 = 1024 + (tid < 128 ? g * 128 + tid : 256 + g * 128 + ((tid - 128) & 127));
    float xr0 = xbc_raw(F, grp, b, row0, -3, ch), xr1 = xbc_raw(F, grp, b, row0, -2, ch), xr2 = xbc_raw(F, grp, b, row0, -1, ch);
    for (int t0 = 0; t0 < L; t0 += 8) {
        if (tid < 256) {
            float xr[11]; const float cb2 = F.sconv_b[c2], d0 = F.sconv_w[c2], d1 = F.sconv_w[SCH + c2], d2 = F.sconv_w[2 * SCH + c2], d3 = F.sconv_w[3 * SCH + c2];
#pragma unroll
            for (int i = 0; i < 11; ++i) xr[i] = xbc_raw(F, grp, b, row0, t0 - 3 + i, c2);
#pragma unroll
            for (int t = 0; t < 8; ++t) Bs[(tid >> 7) * 1024 + t * 128 + (tid & 127)] = silu_f(cb2 + d0 * xr[t] + d1 * xr[t + 1] + d2 * xr[t + 2] + d3 * xr[t + 3]);
        }
        __syncthreads();
#pragma unroll 1
        for (int t = 0; t < 8; ++t) { const int row = row0 + t0 + t;
            const float xn = bf2f(F.PROJ[(size_t)row * NP + CX + ch]);
            const float x = silu_f(cb + cw0 * xr0 + cw1 * xr1 + cw2 * xr2 + cw3 * xn); xr0 = xr1; xr1 = xr2; xr2 = xn;
            const float dt = softplus_f(F.LRDT[(size_t)row * 32 + 16 + hd] + dtb), a = __expf(dt * A), dtx = dt * x;
            float acc = 0.f; const LAS float* bb = Bs + t * 128; const LAS float* cc = Cs + t * 128;
#pragma unroll
            for (int nb = 0; nb < 128; nb += 16) {
#pragma unroll
                for (int n = nb; n < nb + 16; ++n) { h[n] = a * h[n] + dtx * bb[n]; acc += h[n] * cc[n]; }
                asm volatile("" ::: "memory"); }
            const float z = bf2f(F.PROJ[(size_t)row * NP + CZ + ch]);
            const float y = (acc + Dh * x) * silu_f(z);
            Ys[t * 512 + tid] = y;
            const float ss = wave_sum(y * y); if (F.lane == 0) red[t * 8 + F.wave] = ss; }
        __syncthreads();
#pragma unroll
        for (int t = 0; t < 8; ++t) { float tot = 0.f;
#pragma unroll
            for (int w = 0; w < 8; ++w) tot += red[t * 8 + w];
            const float r = rsqrtf(tot * (1.f / 512.f) + EPS);
            F.MIXIN[(size_t)(row0 + t0 + t) * DM + 1024 + ch] = (bf16)f2bf(Ys[t * 512 + tid] * r * nw); }
        __syncthreads();
    }
    f32x4* ho = (f32x4*)(F.out + (grp ? O_SSD_S : O_SSD_P) + ((size_t)(b * SH + hd) * SP + p) * SN);
#pragma unroll
    for (int i = 0; i < 32; ++i) ho[i] = (f32x4){h[4 * i], h[4 * i + 1], h[4 * i + 2], h[4 * i + 3]};
}
__device__ __forceinline__ void p2_recurrence(Frame& F) {
    constexpr int U0 = PB * GH, U1 = U0 + PB * SG, U2 = U1 + SB * GH, U3 = U2 + SB * SG;
    for (int u = F.bid; u < U3; u += F.G) {
        if (u < U0) gla_direct_unit<0>(F, u / GH, u % GH);
        else if (u < U1) ssd_direct_unit<0>(F, (u - U0) / SG, (u - U0) % SG);
        else if (u < U2) gla_direct_unit<1>(F, (u - U1) / GH, (u - U1) % GH);
        else ssd_direct_unit<1>(F, (u - U2) / SG, (u - U2) % SG);
    }
    const int gt = F.bid * NTHR + F.tid, NT = F.G * NTHR;
    for (int i = gt; i < (PB + SB) * 3 * SCH; i += NT) { const int c = i % SCH, j = (i / SCH) % 3, s = i / (3 * SCH);
        const int grp = s >= PB, b = grp ? s - PB : s, L = grp ? SL : PL, row0 = grp ? MP + b * SL : b * PL;
        F.out[(grp ? O_SCONV_S : O_SCONV_P) + ((size_t)b * 3 + j) * SCH + c] = bf2f(F.PROJ[(size_t)(row0 + L - 3 + j) * NP + CX + c]); }
}

__device__ __forceinline__ void p4_post_mixer(Frame& F) {
    const int gw = F.bid * NWAVES + F.wave, NGW = F.G * NWAVES, lane = F.lane;
    for (int m = gw; m < M; m += NGW) {
        const f32x4* mr = (const f32x4*)(F.MIX + (size_t)m * DM) + lane; const f32x4* xr = (const f32x4*)x_row(F, m) + lane;
        const f32x4* w1 = (const f32x4*)F.n_mix_post + lane; const f32x4* w2 = (const f32x4*)F.n_ffn_pre + lane;
        f32x4 v[8]; float s = 0.f;
#pragma unroll
        for (int j = 0; j < 8; ++j) { v[j] = mr[64 * j]; s += (v[j].x * v[j].x + v[j].y * v[j].y) + (v[j].z * v[j].z + v[j].w * v[j].w); }
        const float r1 = rsqrtf(wave_sum(s) * (1.f / DM) + EPS); float s2 = 0.f;
        f32x4* ho = (f32x4*)(F.out + O_Y + (size_t)m * DM) + lane;
#pragma unroll
        for (int j = 0; j < 8; ++j) { v[j] = xr[64 * j] + v[j] * r1 * w1[64 * j]; ho[64 * j] = v[j]; s2 += (v[j].x * v[j].x + v[j].y * v[j].y) + (v[j].z * v[j].z + v[j].w * v[j].w); }
        const float r2 = rsqrtf(wave_sum(s2) * (1.f / DM) + EPS);
        v2u* o8 = (v2u*)(F.XN + (size_t)m * DM) + lane;
#pragma unroll
        for (int j = 0; j < 8; ++j) { const f32x4 ww = w2[64 * j]; v2u o; o.x = pk2(v[j].x * r2 * ww.x, v[j].y * r2 * ww.y); o.y = pk2(v[j].z * r2 * ww.z, v[j].w * r2 * ww.w); o8[64 * j] = o; }
    }
}
__device__ __forceinline__ float u_raw(const Frame& F, int grp, int b, int row0, int tt, int c) {
    if (tt >= 0) return bf2f(F.U[(size_t)(row0 + tt) * FF2 + c]);
    return grp ? F.st_fconv[((size_t)b * 2 + (tt + 2)) * FF2 + c] : 0.f;
}
__device__ __forceinline__ void p6_conv_act(Frame& F) {
    const int gt = F.bid * NTHR + F.tid, NT = F.G * NTHR;
    for (int i = gt; i < M * (FF / 2); i += NT) { const int c = (i % (FF / 2)) * 2, row = i / (FF / 2);
        const int grp = row >= MP, b = grp ? (row - MP) / SL : row / PL, row0 = grp ? MP + b * SL : b * PL, t = row - row0;
        float r[2];
#pragma unroll
        for (int e = 0; e < 2; ++e) { const int ca = c + e, cbb = FF + c + e; float a = F.fconv_b[ca], bb = F.fconv_b[cbb];
#pragma unroll
            for (int j = 0; j < 3; ++j) { a += F.fconv_w[j * FF2 + ca] * u_raw(F, grp, b, row0, t - 2 + j, ca); bb += F.fconv_w[j * FF2 + cbb] * u_raw(F, grp, b, row0, t - 2 + j, cbb); }
            r[e] = silu_f(a) * bb; }
        *(unsigned*)(F.ACT + (size_t)row * FF + c) = pk2(r[0], r[1]); }
    for (int i = gt; i < (PB + SB) * 2 * FF2; i += NT) { const int c = i % FF2, j = (i / FF2) % 2, s = i / (2 * FF2);
        const int grp = s >= PB, b = grp ? s - PB : s, L = grp ? SL : PL, row0 = grp ? MP + b * SL : b * PL;
        F.out[(grp ? O_FCONV_S : O_FCONV_P) + ((size_t)b * 2 + j) * FF2 + c] = bf2f(F.U[(size_t)(row0 + L - 2 + j) * FF2 + c]); }
}
__device__ __forceinline__ void p8_final(Frame& F) {
    const int gw = F.bid * NWAVES + F.wave, NGW = F.G * NWAVES, lane = F.lane;
    for (int m = gw; m < M; m += NGW) {
        const f32x4* fr = (const f32x4*)(F.Fb + (size_t)m * DM) + lane; const f32x4* w1 = (const f32x4*)F.n_ffn_post + lane;
        f32x4* ho = (f32x4*)(F.out + O_Y + (size_t)m * DM) + lane;
        f32x4 v[8]; float s = 0.f;
#pragma unroll
        for (int j = 0; j < 8; ++j) { v[j] = fr[64 * j]; s += (v[j].x * v[j].x + v[j].y * v[j].y) + (v[j].z * v[j].z + v[j].w * v[j].w); }
        const float r1 = rsqrtf(wave_sum(s) * (1.f / DM) + EPS);
#pragma unroll
        for (int j = 0; j < 8; ++j) ho[64 * j] = ho[64 * j] + v[j] * r1 * w1[64 * j];
    }
}

struct Args { const float* in[25]; float* out; unsigned char* ws; int ph_lo, ph_hi; };
__global__ void __launch_bounds__(NTHR, 2) fwd_kernel(Args args) {
    extern __shared__ __attribute__((aligned(16))) unsigned char lds[];
    Frame F;
    F.lds = (LAS unsigned char*)lds;
    F.tid = threadIdx.x; F.lane = F.tid & 63; F.wave = __builtin_amdgcn_readfirstlane(F.tid >> 6);
    F.G = gridDim.x; F.bid = blockIdx.x;
    unsigned char* ws = args.ws;
    F.x_p = args.in[0]; F.x_s = args.in[1]; F.st_gla = args.in[2]; F.st_ssd = args.in[3]; F.st_sconv = args.in[4]; F.st_fconv = args.in[5];
    F.n_mix_pre = args.in[6]; F.n_mix_post = args.in[7]; F.n_ffn_pre = args.in[8]; F.n_ffn_post = args.in[9]; F.w_in = args.in[10];
    F.w_gate2 = args.in[11]; F.b_gate = args.in[12]; F.gla_norm = args.in[13]; F.sconv_w = args.in[14]; F.sconv_b = args.in[15];
    F.dt_bias = args.in[16]; F.A_log = args.in[17]; F.ssd_D = args.in[18]; F.ssd_norm = args.in[19]; F.w_out = args.in[20];
    F.ffn_w_in = args.in[21]; F.fconv_w = args.in[22]; F.fconv_b = args.in[23]; F.ffn_w_out = args.in[24];
    F.out = args.out;
    F.W1 = (bf16*)(ws + WS_W1); F.WO = (bf16*)(ws + WS_WO); F.WF1 = (bf16*)(ws + WS_WF1); F.WF2 = (bf16*)(ws + WS_WF2);
    F.XN = (bf16*)(ws + WS_XN); F.PROJ = (bf16*)(ws + WS_PROJ); F.MIXIN = (bf16*)(ws + WS_MIXIN); F.U = (bf16*)(ws + WS_U); F.ACT = (bf16*)(ws + WS_ACT);
    F.LRDT = (float*)(ws + WS_LRDT); F.MIX = (float*)(ws + WS_MIX); F.Fb = (float*)(ws + WS_F);
    for (int u = F.tid; u < (LDS_BYTES - LDSCTL_OFF) / 4; u += NTHR) ((LAS unsigned*)(F.lds + LDSCTL_OFF))[u] = 0u;
    __syncthreads();
    const int lo = args.ph_lo, hi = args.ph_hi;
#if !MK_PER_PHASE
    XcdBarrier bar = xcd_barrier_post((unsigned*)(ws + WS_CTL) + CW_BAR, (volatile LAS unsigned*)(F.lds + MISC_OFF) + 8);
    bool first_bar = true;
#define GRID_BAR() do { if (first_bar) { first_bar = false; cg::this_grid().sync(); } xcd_barrier(bar); } while (0)
#else
#define GRID_BAR() do { } while (0)
#endif
#define IN(k) (lo <= (k) && (k) < hi)
#define SEAM(k) do { if (IN(k) && IN((k) + 1)) GRID_BAR(); } while (0)
    if (IN(0)) { p0_prologue(F); SEAM(0); }
    if (IN(1)) { pg8::Gemm g{F.XN, F.W1, M, N1, DM}; pg8::StaticOrder S; S.init(M, N1, F.G, F.bid);
        pg8::EpiBf16 E{F.PROJ, NP, NP / 256, F.LRDT};
        pg8::gemm_phase<pg8::EpiBf16, pg8::StaticOrder, true, true>(F.lds, g, S, E); SEAM(1); }
    if (IN(2)) { p2_recurrence(F); SEAM(2); }
    if (IN(3)) { pg8::Gemm g{F.MIXIN, F.WO, M, DM, DM}; pg8::StaticOrder S; S.init(M, DM, F.G, F.bid);
        pg8::EpiF32 E{F.MIX, DM};
        pg8::gemm_phase<pg8::EpiF32, pg8::StaticOrder, true, true>(F.lds, g, S, E); SEAM(3); }
    if (IN(4)) { p4_post_mixer(F); SEAM(4); }
    if (IN(5)) { pg8::Gemm g{F.XN, F.WF1, M, FF2, DM}; pg8::StaticOrder S; S.init(M, FF2, F.G, F.bid);
        pg8::EpiBf16 E{F.U, FF2, FF2 / 256, nullptr};
        pg8::gemm_phase<pg8::EpiBf16, pg8::StaticOrder, true, true>(F.lds, g, S, E); SEAM(5); }
    if (IN(6)) { p6_conv_act(F); SEAM(6); }
    if (IN(7)) { pg8::Gemm g{F.ACT, F.WF2, M, DM, FF}; pg8::StaticOrder S; S.init(M, DM, F.G, F.bid);
        pg8::EpiF32 E{F.Fb, DM};
        pg8::gemm_phase<pg8::EpiF32, pg8::StaticOrder, true, true>(F.lds, g, S, E); SEAM(7); }
    if (IN(8)) { p8_final(F); }
#undef IN
#undef SEAM
}

extern "C" void kernel_launch(void* const* d_in, const int* in_sizes, int n_in, void* d_out, int out_size, void* d_ws, size_t ws_size, hipStream_t stream) {
    static int grid = 0;
    if (grid == 0) {
        if (n_in != 25 || (size_t)out_size != O_END || ws_size < WS_END) { fprintf(stderr, "kernel_launch: unexpected sizes n_in %d out %d ws %zu (need out %zu ws %zu)\n", n_in, out_size, ws_size, (size_t)O_END, (size_t)WS_END); grid = -1; return; }
        int dev = 0, cus = 0, per_cu = 0;
        hipGetDevice(&dev); hipDeviceGetAttribute(&cus, hipDeviceAttributeMultiprocessorCount, dev);
        if (hipFuncSetAttribute((const void*)fwd_kernel, hipFuncAttributeMaxDynamicSharedMemorySize, LDS_BYTES) != hipSuccess) { fprintf(stderr, "kernel_launch: hipFuncSetAttribute failed\n"); grid = -1; return; }
        hipOccupancyMaxActiveBlocksPerMultiprocessor(&per_cu, (const void*)fwd_kernel, NTHR, LDS_BYTES);
        if (per_cu < 1) { fprintf(stderr, "kernel_launch: occupancy query says %d blocks per CU\n", per_cu); grid = -1; return; }
        grid = cus;
        (void)hipGetLastError();
    }
    if (grid < 0) return;
    Args a{};
    for (int i = 0; i < 25; ++i) a.in[i] = (const float*)d_in[i];
    a.out = (float*)d_out; a.ws = (unsigned char*)d_ws;
#if MK_PER_PHASE
    for (int p = 0; p < N_PHASES; ++p) { a.ph_lo = p; a.ph_hi = p + 1; hipLaunchKernelGGL(fwd_kernel, dim3(grid), dim3(NTHR), LDS_BYTES, stream, a); }
#else
    hipMemsetAsync((char*)d_ws + WS_CTL, 0, CTL_ZERO_BYTES, stream);
    a.ph_lo = 0; a.ph_hi = N_PHASES;
    void* kargs[] = {&a};
    hipError_t e = hipLaunchCooperativeKernel((const void*)fwd_kernel, dim3(grid), dim3(NTHR), kargs, LDS_BYTES, stream);
    if (e != hipSuccess) fprintf(stderr, "kernel_launch: cooperative launch failed: %s (grid %d)\n", hipGetErrorString(e), grid);
#endif
}
```

```cpp
#include <hip/hip_runtime.h>
#include <hip/hip_cooperative_groups.h>
#include <cstdio>
#include <cstdint>
namespace cg = cooperative_groups;

#ifndef MK_PER_PHASE
#define MK_PER_PHASE 0
#endif

namespace pg8 {
#define PG8_LAS __attribute__((address_space(3)))
typedef unsigned short bf16_t;
typedef short bf16x8 __attribute__((ext_vector_type(8)));
typedef float f32x4 __attribute__((ext_vector_type(4)));
typedef unsigned u32x4 __attribute__((ext_vector_type(4)));
constexpr int BM = 256, BK = 64, HALF = 128, HTB = HALF * BK * 2  , STAGE_BYTES = 8 * HTB, NXCD = 8, WGM = 8;

__host__ __device__ __forceinline__ int lds_byte(int r, int c) { const int st = (r >> 4) * 2 + (c >> 5), rr = r & 15, cc = c & 31, ob = rr * 64 + cc * 2; return st * 1024 + (ob ^ (((ob >> 9) & 1) << 5)); }
__host__ __device__ __forceinline__ void stage_rc(int b, int& R, int& C) { const int st = b / 1024, sb = b % 1024, swz = sb ^ (((sb >> 9) & 1) << 5); R = (st >> 1) * 16 + swz / 64; C = (st & 1) * 32 + (swz % 64) / 2; }
__host__ __device__ __forceinline__ int perm32(int rho) { const int n = rho >> 4, i = rho & 15; return 8 * (i >> 2) + 4 * n + (i & 3); }

struct Unit { int pm, pn; };
struct Gemm { const bf16_t* A; const bf16_t* Bt; int M, N, K; };

struct StaticOrder {
    int nM, nN, nwg, G, c;
    __host__ __device__ void init(int M, int N, int G_, int c_) { nM = M / BM; nN = N / BM; nwg = nM * nN; G = G_; c = c_; }
    __host__ __device__ bool next(int i, Unit& u) const {
        const long L = (long)i * G + c; if (L >= nwg) return false;
        int wgid = (int)L; { const int q = nwg / NXCD, r = nwg % NXCD, xcd = wgid % NXCD, off = wgid / NXCD; wgid = (xcd < r ? xcd * (q + 1) : r * (q + 1) + (xcd - r) * q) + off; }
        const int nig = WGM * nN, gid = wgid / nig, fm = gid * WGM, gsz = (nM - fm) < WGM ? (nM - fm) : WGM;
        u.pm = fm + ((wgid % nig) % gsz); u.pn = (wgid % nig) / gsz; return true;
    }
    __device__ __forceinline__ void a_ready(const Unit&) const {}
    __device__ __forceinline__ void done(const Unit&) const {}
};

__device__ __forceinline__ unsigned cvt_pk_bf16(float lo, float hi) { unsigned r; asm volatile("v_cvt_pk_bf16_f32 %0, %1, %2" : "=v"(r) : "v"(lo), "v"(hi)); return r; }

struct EpiF32 {
    static constexpr bool PERM = false, AFTER_DRAIN = false;
    float* C; int ldc;
    __device__ __forceinline__ void operator()(const f32x4 (&acc)[2][2][4][2], const Unit& u, int wr, int wc, int fr, int fq) const {
        const int row0 = u.pm * BM + wr * 64 + fr, col0 = u.pn * BM + wc * 32 + 4 * fq;
#pragma unroll
        for (int ai = 0; ai < 2; ++ai)
#pragma unroll
            for (int m = 0; m < 4; ++m) { float* rowp = C + (size_t)(row0 + ai * HALF + m * 16) * ldc + col0;
#pragma unroll
                for (int bj = 0; bj < 2; ++bj)
#pragma unroll
                    for (int n = 0; n < 2; ++n) *(f32x4*)(rowp + bj * HALF + n * 16) = acc[ai][bj][m][n]; }
    }
};
struct EpiBf16 {
    static constexpr bool PERM = true, AFTER_DRAIN = false;
    bf16_t* O; int ldc; int nfull; float* X;
    __device__ __forceinline__ void operator()(const f32x4 (&acc)[2][2][4][2], const Unit& u, int wr, int wc, int fr, int fq) const {
        const int row0 = u.pm * BM + wr * 64 + fr;
        if (u.pn < nfull) {
            const int col0 = u.pn * BM + wc * 32 + 8 * fq;
#pragma unroll
            for (int ai = 0; ai < 2; ++ai)
#pragma unroll
                for (int m = 0; m < 4; ++m) { bf16_t* rowp = O + (size_t)(row0 + ai * HALF + m * 16) * ldc + col0;
#pragma unroll
                    for (int bj = 0; bj < 2; ++bj) { const f32x4 v0 = acc[ai][bj][m][0], v1 = acc[ai][bj][m][1];
                        u32x4 w; w.x = cvt_pk_bf16(v0[0], v0[1]); w.y = cvt_pk_bf16(v0[2], v0[3]); w.z = cvt_pk_bf16(v1[0], v1[1]); w.w = cvt_pk_bf16(v1[2], v1[3]);
                        *(u32x4*)(rowp + bj * HALF) = w; } }
        } else if (wc == 0) {
#pragma unroll
            for (int ai = 0; ai < 2; ++ai)
#pragma unroll
                for (int m = 0; m < 4; ++m) { float* rowp = X + (size_t)(row0 + ai * HALF + m * 16) * 32 + 8 * fq;
                    *(f32x4*)(rowp) = acc[ai][0][m][0]; *(f32x4*)(rowp + 4) = acc[ai][0][m][1]; }
        }
    }
};

template <class Epi, class Sched, bool ALIGN_EPI = false, bool SP2 = false>
__device__ __forceinline__ void gemm_phase(PG8_LAS unsigned char* lds, const Gemm g, const Sched& S, const Epi& E) {
    const int tid = threadIdx.x, wid = __builtin_amdgcn_readfirstlane(tid >> 6), lane = tid & 63, wr = wid >> 2, wc = wid & 3, fr = lane & 15, fq = lane >> 4;
    const int K = g.K, nt = K / BK;
    unsigned voffA[2], voffB[2];
#pragma unroll
    for (int i = 0; i < 2; ++i) { int R, C; stage_rc(tid * 16 + i * 8192, R, C); const int Rb = Epi::PERM ? ((R & ~31) + perm32(R & 31)) : R;
        voffA[i] = (unsigned)(R * K + C) * 2u; voffB[i] = (unsigned)(Rb * K + C) * 2u; }
    const size_t kstep = (size_t)(BK * 2);
    const size_t hstep = (size_t)HALF * K * 2;
    const size_t tstep = 2 * hstep;
    const unsigned ldsw = (unsigned)wid * 1024u;
    const int aoff = lds_byte(wr * 64 + fr, fq * 8), boff = lds_byte(wc * 32 + fr, fq * 8);
#define PG8_SA(b, h) (((b) * 2 + (h)) * HTB)
#define PG8_SB(b, h) ((4 + (b) * 2 + (h)) * HTB)
#define PG8_STAGE(bufoff, gbase, voff) do { _Pragma("unroll") for (int _i = 0; _i < 2; ++_i) \
        __builtin_amdgcn_global_load_lds((const unsigned*)((const char*)(gbase) + (voff)[_i]), (PG8_LAS unsigned*)(lds + (bufoff) + ldsw + _i * 8192), 16, 0, 0); } while (0)
#define PG8_LDA(dst, b, h) do { _Pragma("unroll") for (int m = 0; m < 4; ++m) _Pragma("unroll") for (int k = 0; k < 2; ++k) dst[m][k] = *(const PG8_LAS bf16x8*)(lds + PG8_SA(b, h) + aoff + m * 2048 + k * 1024); } while (0)
#define PG8_LDB(dst, b, h) do { _Pragma("unroll") for (int n = 0; n < 2; ++n) _Pragma("unroll") for (int k = 0; k < 2; ++k) dst[n][k] = *(const PG8_LAS bf16x8*)(lds + PG8_SB(b, h) + boff + n * 2048 + k * 1024); } while (0)
#define PG8_MMA(ai, bj, At, Bt) do { __builtin_amdgcn_s_setprio(1); _Pragma("unroll") for (int m = 0; m < 4; ++m) _Pragma("unroll") for (int n = 0; n < 2; ++n) _Pragma("unroll") for (int k = 0; k < 2; ++k) \
        acc[ai][bj][m][n] = __builtin_amdgcn_mfma_f32_16x16x32_bf16(Bt[n][k], At[m][k], acc[ai][bj][m][n], 0, 0, 0); __builtin_amdgcn_s_setprio(0); } while (0)
#define PG8_WAIT_V(n) asm volatile("s_waitcnt vmcnt(" #n ")" ::: "memory")
#define PG8_WAIT_L(n) asm volatile("s_waitcnt lgkmcnt(" #n ")" ::: "memory")
#define PG8_BAR __builtin_amdgcn_s_barrier()
#define PG8_SCHED __builtin_amdgcn_sched_barrier(0)
    Unit cur, nxt; int ui = 0;
    if (!S.next(0, cur)) return;
    f32x4 acc[2][2][4][2];
#pragma unroll
    for (int a = 0; a < 2; ++a)
#pragma unroll
        for (int b = 0; b < 2; ++b)
#pragma unroll
            for (int m = 0; m < 4; ++m)
#pragma unroll
                for (int n = 0; n < 2; ++n) acc[a][b][m][n] = (f32x4){0.f, 0.f, 0.f, 0.f};
    bf16x8 At[4][2], B0[2][2], B1[2][2];
    const char* cA = (const char*)g.A + (size_t)cur.pm * tstep; const char* cB = (const char*)g.Bt + (size_t)cur.pn * tstep;
    S.a_ready(cur);
    if constexpr (SP2) {
        PG8_STAGE(PG8_SB(0, 0), cB, voffB); PG8_STAGE(PG8_SB(0, 1), cB + hstep, voffB); PG8_STAGE(PG8_SA(0, 0), cA, voffA); PG8_STAGE(PG8_SA(0, 1), cA + hstep, voffA);
        if (wr == 1) PG8_BAR;
        PG8_WAIT_V(2); PG8_BAR;
        PG8_STAGE(PG8_SB(1, 0), cB + kstep, voffB); PG8_STAGE(PG8_SA(1, 0), cA + kstep, voffA); PG8_STAGE(PG8_SB(1, 1), cB + hstep + kstep, voffB);
        PG8_WAIT_V(6); PG8_BAR;
    } else {
        PG8_STAGE(PG8_SB(0, 0), cB, voffB); PG8_STAGE(PG8_SA(0, 0), cA, voffA); PG8_STAGE(PG8_SB(0, 1), cB + hstep, voffB); PG8_STAGE(PG8_SA(0, 1), cA + hstep, voffA);
        if (wr == 1) PG8_BAR;
        PG8_WAIT_V(4); PG8_BAR;
        PG8_STAGE(PG8_SB(1, 0), cB + kstep, voffB); PG8_STAGE(PG8_SA(1, 0), cA + kstep, voffA); PG8_STAGE(PG8_SB(1, 1), cB + hstep + kstep, voffB);
        PG8_WAIT_V(6); PG8_BAR;
    }
    for (;;) {
        const bool has_next = S.next(ui + 1, nxt);
        const char* nA = has_next ? (const char*)g.A + (size_t)nxt.pm * tstep : cA; const char* nB = has_next ? (const char*)g.Bt + (size_t)nxt.pn * tstep : cB;
        for (int t = 0; t < nt; t += 2) {
            const bool last = (t == nt - 2);
            const char* a1 = cA + (size_t)(t + 1) * kstep;
            const char* a2 = last ? nA : cA + (size_t)(t + 2) * kstep; const char* b2 = last ? nB : cB + (size_t)(t + 2) * kstep;
            const char* a3 = a2 + kstep; const char* b3 = b2 + kstep;
            if (last && has_next) S.a_ready(nxt);
            if constexpr (SP2) {
            PG8_LDB(B0, 0, 0); PG8_LDB(B1, 0, 1); PG8_SCHED; PG8_LDA(At, 0, 0); PG8_STAGE(PG8_SA(1, 1), a1 + hstep, voffA);
            PG8_WAIT_V(8); PG8_WAIT_L(0); PG8_BAR; PG8_MMA(0, 0, At, B0); PG8_MMA(0, 1, At, B1); PG8_BAR; PG8_SCHED;
            PG8_LDA(At, 0, 1); PG8_STAGE(PG8_SB(0, 0), b2, voffB); PG8_STAGE(PG8_SB(0, 1), b2 + hstep, voffB); PG8_STAGE(PG8_SA(0, 0), a2, voffA);
            PG8_WAIT_V(8); PG8_WAIT_L(0); PG8_BAR; PG8_MMA(1, 0, At, B0); PG8_MMA(1, 1, At, B1); PG8_BAR; PG8_SCHED;
            PG8_LDB(B0, 1, 0); PG8_LDB(B1, 1, 1); PG8_SCHED; PG8_LDA(At, 1, 0); PG8_STAGE(PG8_SA(0, 1), a2 + hstep, voffA);
            PG8_WAIT_V(8); PG8_WAIT_L(0); PG8_BAR; PG8_MMA(0, 0, At, B0); PG8_MMA(0, 1, At, B1); PG8_BAR; PG8_SCHED;
            PG8_LDA(At, 1, 1); PG8_STAGE(PG8_SB(1, 0), b3, voffB); PG8_STAGE(PG8_SB(1, 1), b3 + hstep, voffB); PG8_STAGE(PG8_SA(1, 0), a3, voffA);
            PG8_WAIT_V(8); PG8_WAIT_L(0); PG8_BAR; PG8_MMA(1, 0, At, B0); PG8_MMA(1, 1, At, B1); PG8_BAR; PG8_SCHED;
            } else {
            PG8_LDB(B0, 0, 0); PG8_SCHED; PG8_LDA(At, 0, 0); PG8_STAGE(PG8_SA(1, 1), a1 + hstep, voffA);
            PG8_WAIT_L(8); PG8_BAR; PG8_WAIT_L(0); PG8_MMA(0, 0, At, B0); PG8_BAR; PG8_SCHED;
            PG8_LDB(B1, 0, 1); PG8_STAGE(PG8_SB(0, 0), b2, voffB);
            PG8_BAR; PG8_WAIT_L(0); PG8_MMA(0, 1, At, B1); PG8_BAR;
            PG8_LDA(At, 0, 1); PG8_STAGE(PG8_SA(0, 0), a2, voffA);
            PG8_BAR; PG8_WAIT_L(0); PG8_MMA(1, 0, At, B0); PG8_BAR; PG8_SCHED;
            PG8_STAGE(PG8_SB(0, 1), b2 + hstep, voffB);
            PG8_WAIT_V(6); PG8_BAR; PG8_MMA(1, 1, At, B1); PG8_BAR;
            PG8_LDB(B0, 1, 0); PG8_SCHED; PG8_LDA(At, 1, 0); PG8_STAGE(PG8_SA(0, 1), a2 + hstep, voffA);
            PG8_WAIT_L(8); PG8_BAR; PG8_WAIT_L(0); PG8_MMA(0, 0, At, B0); PG8_BAR; PG8_SCHED;
            PG8_LDB(B1, 1, 1); PG8_STAGE(PG8_SB(1, 0), b3, voffB);
            PG8_BAR; PG8_WAIT_L(0); PG8_MMA(0, 1, At, B1); PG8_BAR;
            PG8_LDA(At, 1, 1); PG8_STAGE(PG8_SA(1, 0), a3, voffA);
            PG8_BAR; PG8_WAIT_L(0); PG8_MMA(1, 0, At, B0); PG8_BAR; PG8_SCHED;
            PG8_STAGE(PG8_SB(1, 1), b3 + hstep, voffB);
            PG8_WAIT_V(6); PG8_BAR; PG8_MMA(1, 1, At, B1); PG8_BAR;
            }
        }
        if constexpr (ALIGN_EPI) { if (wr == 0) PG8_BAR; }
        if constexpr (!Epi::AFTER_DRAIN) { E(acc, cur, wr, wc, fr, fq); S.done(cur); }
        if (!has_next) break;
#pragma unroll
        for (int a = 0; a < 2; ++a)
#pragma unroll
            for (int b = 0; b < 2; ++b)
#pragma unroll
                for (int m = 0; m < 4; ++m)
#pragma unroll
                    for (int n = 0; n < 2; ++n) acc[a][b][m][n] = (f32x4){0.f, 0.f, 0.f, 0.f};
        cur = nxt; cA = nA; cB = nB; ++ui;
        if constexpr (ALIGN_EPI) { if (wr == 1) PG8_BAR; }
    }
    PG8_WAIT_V(0);
    if constexpr (!ALIGN_EPI) { if (wr == 0) PG8_BAR; }
    PG8_BAR;
    if constexpr (Epi::AFTER_DRAIN) { E.fused(acc, cur, wr, wc, fr, fq, lds, wid, lane); S.done(cur); }
#undef PG8_SA
#undef PG8_SB
#undef PG8_STAGE
#undef PG8_LDA
#undef PG8_LDB
#undef PG8_MMA
#undef PG8_WAIT_V
#undef PG8_WAIT_L
#undef PG8_BAR
#undef PG8_SCHED
}
}

constexpr int NWAVES = 8, NTHR = 512;
constexpr int DM = 2048, PB = 4, PL = 2048, SB = 128, SL = 8;
constexpr int MP = PB * PL, MS = SB * SL, M = MP + MS;
constexpr int GH = 4, GK = 128, GV = 256, GKD = 512, LOWR = 16;
constexpr int SH = 16, SP = 64, SN = 128, SG = 2, SCH = 1536;
constexpr int FF = 5632, FF2 = 11264, INC = 5664;
constexpr int N1 = 5888, NP = 5632;
constexpr int CQ = 0, CK = 512, CV = 1024, CG = 2048, CZ = 3072, CX = 4096;
constexpr float EPS = 1e-6f;
constexpr int N_PHASES = 9;

constexpr size_t O_Y = 0, O_GLA_P = (size_t)M * DM, O_SSD_P = O_GLA_P + (size_t)PB * GH * GK * GV, O_SCONV_P = O_SSD_P + (size_t)PB * SH * SP * SN,
                 O_FCONV_P = O_SCONV_P + (size_t)PB * 3 * SCH, O_GLA_S = O_FCONV_P + (size_t)PB * 2 * FF2, O_SSD_S = O_GLA_S + (size_t)SB * GH * GK * GV,
                 O_SCONV_S = O_SSD_S + (size_t)SB * SH * SP * SN, O_FCONV_S = O_SCONV_S + (size_t)SB * 3 * SCH, O_END = O_FCONV_S + (size_t)SB * 2 * FF2;

constexpr size_t MiB = 1u << 20;
constexpr size_t WS_CTL = 0, CTL_ZERO_BYTES = 64 * 1024;
constexpr size_t WS_WF2 = 1 * MiB;
constexpr size_t WS_W1 = 24 * MiB;
constexpr size_t WS_WO = 48 * MiB;
constexpr size_t WS_WF1 = 56 * MiB;
constexpr size_t WS_XN = 101 * MiB;
constexpr size_t WS_ACT = 24 * MiB;
constexpr size_t WS_BIG = 141 * MiB;
constexpr size_t WS_PROJ = WS_BIG;
constexpr size_t WS_MIX = WS_BIG;
constexpr size_t WS_U = WS_BIG;
constexpr size_t WS_F = WS_BIG;
constexpr size_t WS_LRDT = WS_BIG + 100 * MiB;
constexpr size_t WS_MIXIN = WS_BIG + 104 * MiB;
constexpr size_t WS_END = WS_BIG + 200 * MiB;
static_assert(WS_WF2 + (size_t)DM * FF * 2 <= WS_W1 && WS_W1 + (size_t)N1 * DM * 2 <= WS_WO && WS_WO + (size_t)DM * DM * 2 <= WS_WF1 && WS_WF1 + (size_t)FF2 * DM * 2 <= WS_XN && WS_XN + (size_t)M * DM * 2 <= WS_BIG, "ws map 1");
static_assert(WS_ACT + (size_t)M * FF * 2 <= WS_BIG && WS_PROJ + (size_t)M * NP * 2 <= WS_LRDT && WS_LRDT + (size_t)M * 32 * 4 <= WS_MIXIN && WS_MIXIN + (size_t)M * DM * 2 <= WS_END && WS_U + (size_t)M * FF2 * 2 <= WS_END && WS_MIX + (size_t)M * DM * 4 <= WS_LRDT, "ws map 2");
constexpr int CW_BAR = 1024;

constexpr int RING_BYTES = 131072;
constexpr int LDSCTL_OFF = RING_BYTES, MISC_OFF = LDSCTL_OFF + 320;
constexpr int LDS_BYTES = 147456;

#define GAS __attribute__((address_space(1)))
#define LAS __attribute__((address_space(3)))
typedef unsigned short bf16;
typedef unsigned v4u __attribute__((ext_vector_type(4)));
typedef unsigned v2u __attribute__((ext_vector_type(2)));
typedef float f32x4 __attribute__((ext_vector_type(4)));
#define LDS_WAIT() asm volatile("s_waitcnt lgkmcnt(0)" ::: "memory")
#define VM_WAIT() asm volatile("s_waitcnt vmcnt(0)" ::: "memory")
__device__ __forceinline__ unsigned f2bf(float f) { unsigned u = __builtin_bit_cast(unsigned, f); return (u + 0x7fffu + ((u >> 16) & 1u)) >> 16; }
__device__ __forceinline__ unsigned pk2(float lo, float hi) { return f2bf(lo) | (f2bf(hi) << 16); }
__device__ __forceinline__ float bf2f(unsigned short b) { return __builtin_bit_cast(float, (unsigned)b << 16); }
__device__ __forceinline__ float bflo(unsigned w) { return __builtin_bit_cast(float, w << 16); }
__device__ __forceinline__ float bfhi(unsigned w) { return __builtin_bit_cast(float, w & 0xffff0000u); }
__device__ __forceinline__ float silu_f(float x) { return x / (1.f + __expf(-x)); }
__device__ __forceinline__ float softplus_f(float x) { return fmaxf(x, 0.f) + log1pf(__expf(-fabsf(x))); }
__device__ __forceinline__ float logsigmoid_f(float x) { return fminf(x, 0.f) - log1pf(__expf(-fabsf(x))); }
__device__ __forceinline__ float wave_sum(float v) {
#pragma unroll
    for (int o = 1; o < 64; o <<= 1) v += __shfl_xor(v, o);
    return v;
}

#define XB_TMO      128
#define XB_XCNT(j)  (256  + 64 * (j))
#define XB_XSUB(j)  (1280 + 64 * (j))
#define XB_XGEN(j)  (2304 + 64 * (j))
#define XB_TOP      3328
#define XB_TOPGEN   3392
#define XCD_BAR_WORDS 3456
#define XB_SPIN_CAP (1u << 18)

__device__ __forceinline__ unsigned xb_ld(unsigned* p)              { return __hip_atomic_load(p, __ATOMIC_RELAXED, __HIP_MEMORY_SCOPE_AGENT); }
__device__ __forceinline__ unsigned xb_add(unsigned* p, unsigned v) { return __hip_atomic_fetch_add(p, v, __ATOMIC_RELAXED, __HIP_MEMORY_SCOPE_AGENT); }
__device__ __forceinline__ unsigned xb_xcc_id() { return (unsigned)__builtin_amdgcn_s_getreg((3 << 11) | 20) & 0xFu; }
#define XB_SPIN(cond, bar) do { unsigned _sp = 0; while (cond) { __builtin_amdgcn_s_sleep(1); \
    if ((++_sp & 255u) == 0u) { if (xb_ld(&(bar)[XB_TMO])) break; if (_sp > XB_SPIN_CAP) { atomicAdd(&(bar)[XB_TMO], 1u); break; } } } } while (0)

struct XcdBarrier {
    unsigned* bar; unsigned x;
    volatile LAS unsigned* st;
};

__device__ __forceinline__ XcdBarrier xcd_barrier_post(unsigned* bar, volatile LAS unsigned* st) {
    XcdBarrier b; b.bar = bar; b.x = xb_xcc_id(); b.st = st;
    if (threadIdx.x == 0) (void)xb_add(&bar[XB_XCNT(b.x)], 1u);
    return b;
}
__device__ __forceinline__ void xcd_barrier_complete(unsigned* bar, unsigned x, unsigned& nloc, unsigned& nx) {
    const unsigned G = gridDim.x * gridDim.y * gridDim.z;
    unsigned sum, cnt, mine, sp = 0u;
    for (;;) {
        sum = 0u; cnt = 0u; mine = 0u;
#pragma unroll
        for (unsigned j = 0; j < 16; ++j) { const unsigned c = xb_ld(&bar[XB_XCNT(j)]); sum += c; cnt += (c > 0u) ? 1u : 0u; mine = (j == x) ? c : mine; }
        if (sum == G) break;
        __builtin_amdgcn_s_sleep(1);
        if ((++sp & 255u) == 0u) { if (xb_ld(&bar[XB_TMO])) break; if (sp > XB_SPIN_CAP) { atomicAdd(&bar[XB_TMO], 1u); break; } }
    }
    nloc = mine > 0u ? mine : 1u; nx = cnt > 0u ? cnt : 1u;
}

__device__ __forceinline__ void xcd_barrier(const XcdBarrier& b) {
    asm volatile("s_waitcnt vmcnt(0)" ::: "memory");
    __syncthreads();
    if (threadIdx.x == 0) {
        unsigned* bar = b.bar;
        __builtin_amdgcn_s_waitcnt(0);
        unsigned nloc = b.st[0], nx = b.st[1];
        if (nloc == 0u) { xcd_barrier_complete(bar, b.x, nloc, nx); b.st[0] = nloc; b.st[1] = nx; }
        const unsigned old = xb_add(&bar[XB_XSUB(b.x)], 1u);
        const unsigned gen = old / nloc;
        if (old + 1u == (gen + 1u) * nloc) {
            __builtin_amdgcn_fence(__ATOMIC_RELEASE, "agent");
            asm volatile("s_waitcnt vmcnt(0)" ::: "memory");
            const unsigned og = xb_add(&bar[XB_TOP], 1u);
            const unsigned tg = og / nx;
            if (og + 1u == (tg + 1u) * nx) xb_add(&bar[XB_TOPGEN], 1u);
            else XB_SPIN(xb_ld(&bar[XB_TOPGEN]) == tg, bar);
            __builtin_amdgcn_fence(__ATOMIC_ACQUIRE, "agent");
            xb_add(&bar[XB_XGEN(b.x)], 1u);
            asm volatile("s_waitcnt vmcnt(0)" ::: "memory");
        } else {
            XB_SPIN(xb_ld(&bar[XB_XGEN(b.x)]) == gen, bar);
            __builtin_amdgcn_fence(__ATOMIC_ACQUIRE, "agent");
            asm volatile("s_waitcnt vmcnt(0)" ::: "memory");
        }
    }
    __syncthreads();
}

struct Frame {
    LAS unsigned char* lds;
    int tid, lane, wave, G, bid;
    const float *x_p, *x_s, *st_gla, *st_ssd, *st_sconv, *st_fconv, *n_mix_pre, *n_mix_post, *n_ffn_pre, *n_ffn_post, *w_in, *w_gate2, *b_gate, *gla_norm,
                *sconv_w, *sconv_b, *dt_bias, *A_log, *ssd_D, *ssd_norm, *w_out, *ffn_w_in, *fconv_w, *fconv_b, *ffn_w_out;
    float* out;
    bf16 *W1, *WO, *WF1, *WF2, *XN, *PROJ, *MIXIN, *U, *ACT;
    float *LRDT, *MIX, *Fb;
};
__device__ __forceinline__ const float* x_row(const Frame& F, int row) { return row < MP ? F.x_p + (size_t)row * DM : F.x_s + (size_t)(row - MP) * DM; }

__device__ __forceinline__ int w1_src_col(int n) { return n < 3072 ? n : (n < 5632 ? n + 16 : (n < 5648 ? n - 2560 : (n < 5664 ? n : -1))); }
template <bool MAP>
__device__ __forceinline__ void p0_transpose_item(const float* W, int K, int Nsrc, int Ndst, bf16* WT, LAS float* scr, int item, int lane) {
    const int nblk = Ndst / 32, kb = item / nblk, nb = item % nblk, k0 = 64 * kb, n0 = 32 * nb;
    int sc = n0 + (lane & 31); if (MAP) sc = w1_src_col(sc);
#pragma unroll 8
    for (int i = 0; i < 32; ++i) { const int kk = 2 * i + (lane >> 5); scr[kk * 33 + (lane & 31)] = (sc >= 0) ? W[(size_t)(k0 + kk) * Nsrc + sc] : 0.f; }
    LDS_WAIT(); asm volatile("" ::: "memory");
    const int c = lane & 7;
#pragma unroll
    for (int j = 0; j < 4; ++j) { const int n = (lane >> 3) + 8 * j; const LAS float* s = scr + (8 * c) * 33 + n;
        v4u o; o.x = pk2(s[0 * 33], s[1 * 33]); o.y = pk2(s[2 * 33], s[3 * 33]); o.z = pk2(s[4 * 33], s[5 * 33]); o.w = pk2(s[6 * 33], s[7 * 33]);
        *(v4u*)(WT + (size_t)(n0 + n) * K + k0 + 8 * c) = o; }
    LDS_WAIT(); asm volatile("" ::: "memory");
}
__device__ __forceinline__ void rms_row_to_bf16(const float* xrow, const float* w, bf16* orow, int lane) {
    const f32x4* xr = (const f32x4*)xrow + lane; const f32x4* wr = (const f32x4*)w + lane;
    f32x4 v[8]; float s = 0.f;
#pragma unroll
    for (int j = 0; j < 8; ++j) { v[j] = xr[64 * j]; s += (v[j].x * v[j].x + v[j].y * v[j].y) + (v[j].z * v[j].z + v[j].w * v[j].w); }
    const float r = rsqrtf(wave_sum(s) * (1.f / DM) + EPS);
    v2u* o8 = (v2u*)orow + lane;
#pragma unroll
    for (int j = 0; j < 8; ++j) { const f32x4 ww = wr[64 * j]; v2u o; o.x = pk2(v[j].x * r * ww.x, v[j].y * r * ww.y); o.y = pk2(v[j].z * r * ww.z, v[j].w * r * ww.w); o8[64 * j] = o; }
}
__device__ __forceinline__ void p0_prologue(Frame& F) {
    LAS float* scr = (LAS float*)(F.lds + F.wave * 16384);
    const int gw = F.bid * NWAVES + F.wave, NGW = F.G * NWAVES;
    constexpr int I_1 = (DM / 64) * (N1 / 32), I_O = (DM / 64) * (DM / 32), I_F1 = (DM / 64) * (FF2 / 32), I_F2 = (FF / 64) * (DM / 32);
    constexpr int NITEMS = I_1 + I_O + I_F1 + I_F2;
    for (int it = gw; it < NITEMS; it += NGW) {
        int r = it;
        if (r < I_1) { p0_transpose_item<true>(F.w_in, DM, INC, N1, F.W1, scr, r, F.lane); continue; } r -= I_1;
        if (r < I_O) { p0_transpose_item<false>(F.w_out, DM, DM, DM, F.WO, scr, r, F.lane); continue; } r -= I_O;
        if (r < I_F1) { p0_transpose_item<false>(F.ffn_w_in, DM, FF2, FF2, F.WF1, scr, r, F.lane); continue; } r -= I_F1;
        p0_transpose_item<false>(F.ffn_w_out, FF, DM, DM, F.WF2, scr, r, F.lane);
    }
    for (int m = gw; m < M; m += NGW) rms_row_to_bf16(x_row(F, m), F.n_mix_pre, F.XN + (size_t)m * DM, F.lane);
}

template <int grp> __device__ __forceinline__ void gla_direct_unit(Frame& F, int b, int h) {
    const int tid = F.tid, v = tid & 255, kh = tid >> 8;
    const int L = grp ? SL : PL, row0 = grp ? MP + b * SL : b * PL;
    LAS float* Es = (LAS float*)F.lds; LAS float* Ks = Es + 1024; LAS float* Qs = Ks + 1024; LAS float* Os = Qs + 1024;
    float S[64];
    if (grp) { const float* s0 = F.st_gla + ((size_t)(b * GH + h) * GK + kh * 64) * GV + v;
#pragma unroll
        for (int i = 0; i < 64; ++i) S[i] = s0[(size_t)i * GV]; }
    else {
#pragma unroll
        for (int i = 0; i < 64; ++i) S[i] = 0.f; }
    for (int t0 = 0; t0 < L; t0 += 8) {
        for (int it = tid; it < 1024; it += NTHR) { const int t = it >> 7, k = it & 127, row = row0 + t0 + t, hk = h * GK + k;
            float x = F.b_gate[hk]; const float* lr = F.LRDT + (size_t)row * 32;
#pragma unroll
            for (int j = 0; j < LOWR; ++j) x += lr[j] * F.w_gate2[j * GKD + hk];
            const float lg = logsigmoid_f(x) * (1.f / 16.f);
            Es[it] = __expf(lg); Ks[it] = bf2f(F.PROJ[(size_t)row * NP + CK + hk]); Qs[it] = bf2f(F.PROJ[(size_t)row * NP + CQ + hk]) * 0.08838834764831845f; }
        __syncthreads();
#pragma unroll 1
        for (int t = 0; t < 8; ++t) { const float vv = bf2f(F.PROJ[(size_t)(row0 + t0 + t) * NP + CV + h * GV + v]); float acc = 0.f;
            const LAS float* e = Es + t * 128 + kh * 64; const LAS float* kk = Ks + t * 128 + kh * 64; const LAS float* qq = Qs + t * 128 + kh * 64;
#pragma unroll
            for (int i = 0; i < 64; ++i) { S[i] = e[i] * S[i] + kk[i] * vv; acc += qq[i] * S[i]; }
            Os[(kh * 8 + t) * 256 + v] = acc; }
        __syncthreads();
        { const int t = F.wave, v4 = F.lane * 4, row = row0 + t0 + t;
            const f32x4 a = *(const LAS f32x4*)(Os + t * 256 + v4), c = *(const LAS f32x4*)(Os + (8 + t) * 256 + v4); const f32x4 o = a + c;
            const float ss = wave_sum((o.x * o.x + o.y * o.y) + (o.z * o.z + o.w * o.w)); const float r = rsqrtf(ss * (1.f / GV) + EPS);
            const v2u gw = *(const v2u*)(F.PROJ + (size_t)row * NP + CG + h * GV + v4); const f32x4 nw = *(const f32x4*)(F.gla_norm + v4);
            v2u w; w.x = pk2(o.x * r * nw.x * silu_f(bflo(gw.x)), o.y * r * nw.y * silu_f(bfhi(gw.x))); w.y = pk2(o.z * r * nw.z * silu_f(bflo(gw.y)), o.w * r * nw.w * silu_f(bfhi(gw.y)));
            *(v2u*)(F.MIXIN + (size_t)row * DM + h * GV + v4) = w; }
        __syncthreads();
    }
    float* so = F.out + (grp ? O_GLA_S : O_GLA_P) + ((size_t)(b * GH + h) * GK + kh * 64) * GV + v;
#pragma unroll
    for (int i = 0; i < 64; ++i) so[(size_t)i * GV] = S[i];
}
__device__ __forceinline__ float xbc_raw(const Frame& F, int grp, int b, int row0, int tt, int c) {
    if (tt >= 0) return bf2f(F.PROJ[(size_t)(row0 + tt) * NP + CX + c]);
    return grp ? F.st_sconv[((size_t)b * 3 + (tt + 3)) * SCH + c] : 0.f;
}
template <int grp> __device__ __forceinline__ void ssd_direct_unit(Frame& F, int b, int g) {
    const int tid = F.tid, hd = g * 8 + (tid >> 6), p = tid & 63, ch = g * 512 + tid;
    const int L = grp ? SL : PL, row0 = grp ? MP + b * SL : b * PL;
    LAS float* Bs = (LAS float*)F.lds; LAS float* Cs = Bs + 1024; LAS float* red = Cs + 1024; LAS float* Ys = red + 64;
    float h[128];
    if (grp) { const f32x4* h0 = (const f32x4*)(F.st_ssd + ((size_t)(b * SH + hd) * SP + p) * SN);
#pragma unroll
        for (int i = 0; i < 32; ++i) { const f32x4 q = h0[i]; h[4 * i] = q.x; h[4 * i + 1] = q.y; h[4 * i + 2] = q.z; h[4 * i + 3] = q.w; } }
    else {
#pragma unroll
        for (int i = 0; i < 128; ++i) h[i] = 0.f; }
    const float A = -__expf(F.A_log[hd]), dtb = F.dt_bias[hd], Dh = F.ssd_D[hd], nw = F.ssd_norm[ch];
    const float cb = F.sconv_b[ch], cw0 = F.sconv_w[ch], cw1 = F.sconv_w[SCH + ch], cw2 = F.sconv_w[2 * SCH + ch], cw3 = F.sconv_w[3 * SCH + ch];
    const int c2 = 1024 + (tid < 128 ? g * 128 + tid : 256 + g * 128 + ((tid - 128) & 127));
    float xr0 = xbc_raw(F, grp, b, row0, -3, ch), xr1 = xbc_raw(F, grp, b, row0, -2, ch), xr2 = xbc_raw(F, grp, b, row0, -1, ch);
    for (int t0 = 0; t0 < L; t0 += 8) {
        if (tid < 256) {
            float xr[11]; const float cb2 = F.sconv_b[c2], d0 = F.sconv_w[c2], d1 = F.sconv_w[SCH + c2], d2 = F.sconv_w[2 * SCH + c2], d3 = F.sconv_w[3 * SCH + c2];
#pragma unroll
            for (int i = 0; i < 11; ++i) xr[i] = xbc_raw(F, grp, b, row0, t0 - 3 + i, c2);
#pragma unroll
            for (int t = 0; t < 8; ++t) Bs[(tid >> 7) * 1024 + t * 128 + (tid & 127)] = silu_f(cb2 + d0 * xr[t] + d1 * xr[t + 1] + d2 * xr[t + 2] + d3 * xr[t + 3]);
        }
        __syncthreads();
#pragma unroll 1
        for (int t = 0; t < 8; ++t) { const int row = row0 + t0 + t;
            const float xn = bf2f(F.PROJ[(size_t)row * NP + CX + ch]);
            const float x = silu_f(cb + cw0 * xr0 + cw1 * xr1 + cw2 * xr2 + cw3 * xn); xr0 = xr1; xr1 = xr2; xr2 = xn;
            const float dt = softplus_f(F.LRDT[(size_t)row * 32 + 16 + hd] + dtb), a = __expf(dt * A), dtx = dt * x;
            float acc = 0.f; const LAS float* bb = Bs + t * 128; const LAS float* cc = Cs + t * 128;
#pragma unroll
            for (int nb = 0; nb < 128; nb += 16) {
#pragma unroll
                for (int n = nb; n < nb + 16; ++n) { h[n] = a * h[n] + dtx * bb[n]; acc += h[n] * cc[n]; }
                asm volatile("" ::: "memory"); }
            const float z = bf2f(F.PROJ[(size_t)row * NP + CZ + ch]);
            const float y = (acc + Dh * x) * silu_f(z);
            Ys[t * 512 + tid] = y;
            const float ss = wave_sum(y * y); if (F.lane == 0) red[t * 8 + F.wave] = ss; }
        __syncthreads();
#pragma unroll
        for (int t = 0; t < 8; ++t) { float tot = 0.f;
#pragma unroll
            for (int w = 0; w < 8; ++w) tot += red[t * 8 + w];
            const float r = rsqrtf(tot * (1.f / 512.f) + EPS);
            F.MIXIN[(size_t)(row0 + t0 + t) * DM + 1024 + ch] = (bf16)f2bf(Ys[t * 512 + tid] * r * nw); }
        __syncthreads();
    }
    f32x4* ho = (f32x4*)(F.out + (grp ? O_SSD_S : O_SSD_P) + ((size_t)(b * SH + hd) * SP + p) * SN);
#pragma unroll
    for (int i = 0; i < 32; ++i) ho[i] = (f32x4){h[4 * i], h[4 * i + 1], h[4 * i + 2], h[4 * i + 3]};
}
__device__ __forceinline__ void p2_recurrence(Frame& F) {
    constexpr int U0 = PB * GH, U1 = U0 + PB * SG, U2 = U1 + SB * GH, U3 = U2 + SB * SG;
    for (int u = F.bid; u < U3; u += F.G) {
        if (u < U0) gla_direct_unit<0>(F, u / GH, u % GH);
        else if (u < U1) ssd_direct_unit<0>(F, (u - U0) / SG, (u - U0) % SG);
        else if (u < U2) gla_direct_unit<1>(F, (u - U1) / GH, (u - U1) % GH);
        else ssd_direct_unit<1>(F, (u - U2) / SG, (u - U2) % SG);
    }
    const int gt = F.bid * NTHR + F.tid, NT = F.G * NTHR;
    for (int i = gt; i < (PB + SB) * 3 * SCH; i += NT) { const int c = i % SCH, j = (i / SCH) % 3, s = i / (3 * SCH);
        const int grp = s >= PB, b = grp ? s - PB : s, L = grp ? SL : PL, row0 = grp ? MP + b * SL : b * PL;
        F.out[(grp ? O_SCONV_S : O_SCONV_P) + ((size_t)b * 3 + j) * SCH + c] = bf2f(F.PROJ[(size_t)(row0 + L - 3 + j) * NP + CX + c]); }
}

__device__ __forceinline__ void p4_post_mixer(Frame& F) {
    const int gw = F.bid * NWAVES + F.wave, NGW = F.G * NWAVES, lane = F.lane;
    for (int m = gw; m < M; m += NGW) {
        const f32x4* mr = (const f32x4*)(F.MIX + (size_t)m * DM) + lane; const f32x4* xr = (const f32x4*)x_row(F, m) + lane;
        const f32x4* w1 = (const f32x4*)F.n_mix_post + lane; const f32x4* w2 = (const f32x4*)F.n_ffn_pre + lane;
        f32x4 v[8]; float s = 0.f;
#pragma unroll
        for (int j = 0; j < 8; ++j) { v[j] = mr[64 * j]; s += (v[j].x * v[j].x + v[j].y * v[j].y) + (v[j].z * v[j].z + v[j].w * v[j].w); }
        const float r1 = rsqrtf(wave_sum(s) * (1.f / DM) + EPS); float s2 = 0.f;
        f32x4* ho = (f32x4*)(F.out + O_Y + (size_t)m * DM) + lane;
#pragma unroll
        for (int j = 0; j < 8; ++j) { v[j] = xr[64 * j] + v[j] * r1 * w1[64 * j]; ho[64 * j] = v[j]; s2 += (v[j].x * v[j].x + v[j].y * v[j].y) + (v[j].z * v[j].z + v[j].w * v[j].w); }
        const float r2 = rsqrtf(wave_sum(s2) * (1.f / DM) + EPS);
        v2u* o8 = (v2u*)(F.XN + (size_t)m * DM) + lane;
#pragma unroll
        for (int j = 0; j < 8; ++j) { const f32x4 ww = w2[64 * j]; v2u o; o.x = pk2(v[j].x * r2 * ww.x, v[j].y * r2 * ww.y); o.y = pk2(v[j].z * r2 * ww.z, v[j].w * r2 * ww.w); o8[64 * j] = o; }
    }
}
__device__ __forceinline__ float u_raw(const Frame& F, int grp, int b, int row0, int tt, int c) {
    if (tt >= 0) return bf2f(F.U[(size_t)(row0 + tt) * FF2 + c]);
    return grp ? F.st_fconv[((size_t)b * 2 + (tt + 2)) * FF2 + c] : 0.f;
}
__device__ __forceinline__ void p6_conv_act(Frame& F) {
    const int gt = F.bid * NTHR + F.tid, NT = F.G * NTHR;
    for (int i = gt; i < M * (FF / 2); i += NT) { const int c = (i % (FF / 2)) * 2, row = i / (FF / 2);
        const int grp = row >= MP, b = grp ? (row - MP) / SL : row / PL, row0 = grp ? MP + b * SL : b * PL, t = row - row0;
        float r[2];
#pragma unroll
        for (int e = 0; e < 2; ++e) { const int ca = c + e, cbb = FF + c + e; float a = F.fconv_b[ca], bb = F.fconv_b[cbb];
#pragma unroll
            for (int j = 0; j < 3; ++j) { a += F.fconv_w[j * FF2 + ca] * u_raw(F, grp, b, row0, t - 2 + j, ca); bb += F.fconv_w[j * FF2 + cbb] * u_raw(F, grp, b, row0, t - 2 + j, cbb); }
            r[e] = silu_f(a) * bb; }
        *(unsigned*)(F.ACT + (size_t)row * FF + c) = pk2(r[0], r[1]); }
    for (int i = gt; i < (PB + SB) * 2 * FF2; i += NT) { const int c = i % FF2, j = (i / FF2) % 2, s = i / (2 * FF2);
        const int grp = s >= PB, b = grp ? s - PB : s, L = grp ? SL : PL, row0 = grp ? MP + b * SL : b * PL;
        F.out[(grp ? O_FCONV_S : O_FCONV_P) + ((size_t)b * 2 + j) * FF2 + c] = bf2f(F.U[(size_t)(row0 + L - 2 + j) * FF2 + c]); }
}
__device__ __forceinline__ void p8_final(Frame& F) {
    const int gw = F.bid * NWAVES + F.wave, NGW = F.G * NWAVES, lane = F.lane;
    for (int m = gw; m < M; m += NGW) {
        const f32x4* fr = (const f32x4*)(F.Fb + (size_t)m * DM) + lane; const f32x4* w1 = (const f32x4*)F.n_ffn_post + lane;
        f32x4* ho = (f32x4*)(F.out + O_Y + (size_t)m * DM) + lane;
        f32x4 v[8]; float s = 0.f;
#pragma unroll
        for (int j = 0; j < 8; ++j) { v[j] = fr[64 * j]; s += (v[j].x * v[j].x + v[j].y * v[j].y) + (v[j].z * v[j].z + v[j].w * v[j].w); }
        const float r1 = rsqrtf(wave_sum(s) * (1.f / DM) + EPS);
#pragma unroll
        for (int j = 0; j < 8; ++j) ho[64 * j] = ho[64 * j] + v[j] * r1 * w1[64 * j];
    }
}

struct Args { const float* in[25]; float* out; unsigned char* ws; int ph_lo, ph_hi; };
__global__ void __launch_bounds__(NTHR, 2) fwd_kernel(Args args) {
    extern __shared__ __attribute__((aligned(16))) unsigned char lds[];
    Frame F;
    F.lds = (LAS unsigned char*)lds;
    F.tid = threadIdx.x; F.lane = F.tid & 63; F.wave = __builtin_amdgcn_readfirstlane(F.tid >> 6);
    F.G = gridDim.x; F.bid = blockIdx.x;
    unsigned char* ws = args.ws;
    F.x_p = args.in[0]; F.x_s = args.in[1]; F.st_gla = args.in[2]; F.st_ssd = args.in[3]; F.st_sconv = args.in[4]; F.st_fconv = args.in[5];
    F.n_mix_pre = args.in[6]; F.n_mix_post = args.in[7]; F.n_ffn_pre = args.in[8]; F.n_ffn_post = args.in[9]; F.w_in = args.in[10];
    F.w_gate2 = args.in[11]; F.b_gate = args.in[12]; F.gla_norm = args.in[13]; F.sconv_w = args.in[14]; F.sconv_b = args.in[15];
    F.dt_bias = args.in[16]; F.A_log = args.in[17]; F.ssd_D = args.in[18]; F.ssd_norm = args.in[19]; F.w_out = args.in[20];
    F.ffn_w_in = args.in[21]; F.fconv_w = args.in[22]; F.fconv_b = args.in[23]; F.ffn_w_out = args.in[24];
    F.out = args.out;
    F.W1 = (bf16*)(ws + WS_W1); F.WO = (bf16*)(ws + WS_WO); F.WF1 = (bf16*)(ws + WS_WF1); F.WF2 = (bf16*)(ws + WS_WF2);
    F.XN = (bf16*)(ws + WS_XN); F.PROJ = (bf16*)(ws + WS_PROJ); F.MIXIN = (bf16*)(ws + WS_MIXIN); F.U = (bf16*)(ws + WS_U); F.ACT = (bf16*)(ws + WS_ACT);
    F.LRDT = (float*)(ws + WS_LRDT); F.MIX = (float*)(ws + WS_MIX); F.Fb = (float*)(ws + WS_F);
    for (int u = F.tid; u < (LDS_BYTES - LDSCTL_OFF) / 4; u += NTHR) ((LAS unsigned*)(F.lds + LDSCTL_OFF))[u] = 0u;
    __syncthreads();
    const int lo = args.ph_lo, hi = args.ph_hi;
#if !MK_PER_PHASE
    XcdBarrier bar = xcd_barrier_post((unsigned*)(ws + WS_CTL) + CW_BAR, (volatile LAS unsigned*)(F.lds + MISC_OFF) + 8);
    bool first_bar = true;
#define GRID_BAR() do { if (first_bar) { first_bar = false; cg::this_grid().sync(); } xcd_barrier(bar); } while (0)
#else
#define GRID_BAR() do { } while (0)
#endif
#define IN(k) (lo <= (k) && (k) < hi)
#define SEAM(k) do { if (IN(k) && IN((k) + 1)) GRID_BAR(); } while (0)
    if (IN(0)) { p0_prologue(F); SEAM(0); }
    if (IN(1)) { pg8::Gemm g{F.XN, F.W1, M, N1, DM}; pg8::StaticOrder S; S.init(M, N1, F.G, F.bid);
        pg8::EpiBf16 E{F.PROJ, NP, NP / 256, F.LRDT};
        pg8::gemm_phase<pg8::EpiBf16, pg8::StaticOrder, true, true>(F.lds, g, S, E); SEAM(1); }
    if (IN(2)) { p2_recurrence(F); SEAM(2); }
    if (IN(3)) { pg8::Gemm g{F.MIXIN, F.WO, M, DM, DM}; pg8::StaticOrder S; S.init(M, DM, F.G, F.bid);
        pg8::EpiF32 E{F.MIX, DM};
        pg8::gemm_phase<pg8::EpiF32, pg8::StaticOrder, true, true>(F.lds, g, S, E); SEAM(3); }
    if (IN(4)) { p4_post_mixer(F); SEAM(4); }
    if (IN(5)) { pg8::Gemm g{F.XN, F.WF1, M, FF2, DM}; pg8::StaticOrder S; S.init(M, FF2, F.G, F.bid);
        pg8::EpiBf16 E{F.U, FF2, FF2 / 256, nullptr};
        pg8::gemm_phase<pg8::EpiBf16, pg8::StaticOrder, true, true>(F.lds, g, S, E); SEAM(5); }
    if (IN(6)) { p6_conv_act(F); SEAM(6); }
    if (IN(7)) { pg8::Gemm g{F.ACT, F.WF2, M, DM, FF}; pg8::StaticOrder S; S.init(M, DM, F.G, F.bid);
        pg8::EpiF32 E{F.Fb, DM};
        pg8::gemm_phase<pg8::EpiF32, pg8::StaticOrder, true, true>(F.lds, g, S, E); SEAM(7); }
    if (IN(8)) { p8_final(F); }
#undef IN
#undef SEAM
}

extern "C" void kernel_launch(void* const* d_in, const int* in_sizes, int n_in, void* d_out, int out_size, void* d_ws, size_t ws_size, hipStream_t stream) {
    static int grid = 0;
    if (grid == 0) {
        if (n_in != 25 || (size_t)out_size != O_END || ws_size < WS_END) { fprintf(stderr, "kernel_launch: unexpected sizes n_in %d out %d ws %zu (need out %zu ws %zu)\n", n_in, out_size, ws_size, (size_t)O_END, (size_t)WS_END); grid = -1; return; }
        int dev = 0, cus = 0, per_cu = 0;
        hipGetDevice(&dev); hipDeviceGetAttribute(&cus, hipDeviceAttributeMultiprocessorCount, dev);
        if (hipFuncSetAttribute((const void*)fwd_kernel, hipFuncAttributeMaxDynamicSharedMemorySize, LDS_BYTES) != hipSuccess) { fprintf(stderr, "kernel_launch: hipFuncSetAttribute failed\n"); grid = -1; return; }
        hipOccupancyMaxActiveBlocksPerMultiprocessor(&per_cu, (const void*)fwd_kernel, NTHR, LDS_BYTES);
        if (per_cu < 1) { fprintf(stderr, "kernel_launch: occupancy query says %d blocks per CU\n", per_cu); grid = -1; return; }
        grid = cus;
        (void)hipGetLastError();
    }
    if (grid < 0) return;
    Args a{};
    for (int i = 0; i < 25; ++i) a.in[i] = (const float*)d_in[i];
    a.out = (float*)d_out; a.ws = (unsigned char*)d_ws;
#if MK_PER_PHASE
    for (int p = 0; p < N_PHASES; ++p) { a.ph_lo = p; a.ph_hi = p + 1; hipLaunchKernelGGL(fwd_kernel, dim3(grid), dim3(NTHR), LDS_BYTES, stream, a); }
#else
    hipMemsetAsync((char*)d_ws + WS_CTL, 0, CTL_ZERO_BYTES, stream);
    a.ph_lo = 0; a.ph_hi = N_PHASES;
    void* kargs[] = {&a};
    hipError_t e = hipLaunchCooperativeKernel((const void*)fwd_kernel, dim3(grid), dim3(NTHR), kargs, LDS_BYTES, stream);
    if (e != hipSuccess) fprintf(stderr, "kernel_launch: cooperative launch failed: %s (grid %d)\n", hipGetErrorString(e), grid);
#endif
}
```

```cpp
#include <hip/hip_runtime.h>
#include <hip/hip_cooperative_groups.h>
#include <cstdio>
#include <cstdint>
namespace cg = cooperative_groups;

#ifndef MK_PER_PHASE
#define MK_PER_PHASE 0
#endif

namespace pg8 {
#define PG8_LAS __attribute__((address_space(3)))
typedef unsigned short bf16_t;
typedef short bf16x8 __attribute__((ext_vector_type(8)));
typedef float f32x4 __attribute__((ext_vector_type(4)));
typedef unsigned u32x4 __attribute__((ext_vector_type(4)));
constexpr int BM = 256, BK = 64, HALF = 128, HTB = HALF * BK * 2  , STAGE_BYTES = 8 * HTB, NXCD = 8, WGM = 8;

__host__ __device__ __forceinline__ int lds_byte(int r, int c) { const int st = (r >> 4) * 2 + (c >> 5), rr = r & 15, cc = c & 31, ob = rr * 64 + cc * 2; return st * 1024 + (ob ^ (((ob >> 9) & 1) << 5)); }
__host__ __device__ __forceinline__ void stage_rc(int b, int& R, int& C) { const int st = b / 1024, sb = b % 1024, swz = sb ^ (((sb >> 9) & 1) << 5); R = (st >> 1) * 16 + swz / 64; C = (st & 1) * 32 + (swz % 64) / 2; }
__host__ __device__ __forceinline__ int perm32(int rho) { const int n = rho >> 4, i = rho & 15; return 8 * (i >> 2) + 4 * n + (i & 3); }

struct Unit { int pm, pn; };
struct Gemm { const bf16_t* A; const bf16_t* Bt; int M, N, K; };

struct StaticOrder {
    int nM, nN, nwg, G, c;
    __host__ __device__ void init(int M, int N, int G_, int c_) { nM = M / BM; nN = N / BM; nwg = nM * nN; G = G_; c = c_; }
    __host__ __device__ bool next(int i, Unit& u) const {
        const long L = (long)i * G + c; if (L >= nwg) return false;
        int wgid = (int)L; { const int q = nwg / NXCD, r = nwg % NXCD, xcd = wgid % NXCD, off = wgid / NXCD; wgid = (xcd < r ? xcd * (q + 1) : r * (q + 1) + (xcd - r) * q) + off; }
        const int nig = WGM * nN, gid = wgid / nig, fm = gid * WGM, gsz = (nM - fm) < WGM ? (nM - fm) : WGM;
        u.pm = fm + ((wgid % nig) % gsz); u.pn = (wgid % nig) / gsz; return true;
    }
    __device__ __forceinline__ void a_ready(const Unit&) const {}
    __device__ __forceinline__ void done(const Unit&) const {}
};

__device__ __forceinline__ unsigned cvt_pk_bf16(float lo, float hi) { unsigned r; asm volatile("v_cvt_pk_bf16_f32 %0, %1, %2" : "=v"(r) : "v"(lo), "v"(hi)); return r; }

struct EpiF32 {
    static constexpr bool PERM = false, AFTER_DRAIN = false;
    float* C; int ldc;
    __device__ __forceinline__ void operator()(const f32x4 (&acc)[2][2][4][2], const Unit& u, int wr, int wc, int fr, int fq) const {
        const int row0 = u.pm * BM + wr * 64 + fr, col0 = u.pn * BM + wc * 32 + 4 * fq;
#pragma unroll
        for (int ai = 0; ai < 2; ++ai)
#pragma unroll
            for (int m = 0; m < 4; ++m) { float* rowp = C + (size_t)(row0 + ai * HALF + m * 16) * ldc + col0;
#pragma unroll
                for (int bj = 0; bj < 2; ++bj)
#pragma unroll
                    for (int n = 0; n < 2; ++n) *(f32x4*)(rowp + bj * HALF + n * 16) = acc[ai][bj][m][n]; }
    }
};
struct EpiBf16 {
    static constexpr bool PERM = true, AFTER_DRAIN = false;
    bf16_t* O; int ldc; int nfull; float* X;
    __device__ __forceinline__ void operator()(const f32x4 (&acc)[2][2][4][2], const Unit& u, int wr, int wc, int fr, int fq) const {
        const int row0 = u.pm * BM + wr * 64 + fr;
        if (u.pn < nfull) {
            const int col0 = u.pn * BM + wc * 32 + 8 * fq;
#pragma unroll
            for (int ai = 0; ai < 2; ++ai)
#pragma unroll
                for (int m = 0; m < 4; ++m) { bf16_t* rowp = O + (size_t)(row0 + ai * HALF + m * 16) * ldc + col0;
#pragma unroll
                    for (int bj = 0; bj < 2; ++bj) { const f32x4 v0 = acc[ai][bj][m][0], v1 = acc[ai][bj][m][1];
                        u32x4 w; w.x = cvt_pk_bf16(v0[0], v0[1]); w.y = cvt_pk_bf16(v0[2], v0[3]); w.z = cvt_pk_bf16(v1[0], v1[1]); w.w = cvt_pk_bf16(v1[2], v1[3]);
                        *(u32x4*)(rowp + bj * HALF) = w; } }
        } else if (wc == 0) {
#pragma unroll
            for (int ai = 0; ai < 2; ++ai)
#pragma unroll
                for (int m = 0; m < 4; ++m) { float* rowp = X + (size_t)(row0 + ai * HALF + m * 16) * 32 + 8 * fq;
                    *(f32x4*)(rowp) = acc[ai][0][m][0]; *(f32x4*)(rowp + 4) = acc[ai][0][m][1]; }
        }
    }
};

template <class Epi, class Sched, bool ALIGN_EPI = false, bool SP2 = false>
__device__ __forceinline__ void gemm_phase(PG8_LAS unsigned char* lds, const Gemm g, const Sched& S, const Epi& E) {
    const int tid = threadIdx.x, wid = __builtin_amdgcn_readfirstlane(tid >> 6), lane = tid & 63, wr = wid >> 2, wc = wid & 3, fr = lane & 15, fq = lane >> 4;
    const int K = g.K, nt = K / BK;
    unsigned voffA[2], voffB[2];
#pragma unroll
    for (int i = 0; i < 2; ++i) { int R, C; stage_rc(tid * 16 + i * 8192, R, C); const int Rb = Epi::PERM ? ((R & ~31) + perm32(R & 31)) : R;
        voffA[i] = (unsigned)(R * K + C) * 2u; voffB[i] = (unsigned)(Rb * K + C) * 2u; }
    const size_t kstep = (size_t)(BK * 2);
    const size_t hstep = (size_t)HALF * K * 2;
    const size_t tstep = 2 * hstep;
    const unsigned ldsw = (unsigned)wid * 1024u;
    const int aoff = lds_byte(wr * 64 + fr, fq * 8), boff = lds_byte(wc * 32 + fr, fq * 8);
#define PG8_SA(b, h) (((b) * 2 + (h)) * HTB)
#define PG8_SB(b, h) ((4 + (b) * 2 + (h)) * HTB)
#define PG8_STAGE(bufoff, gbase, voff) do { _Pragma("unroll") for (int _i = 0; _i < 2; ++_i) \
        __builtin_amdgcn_global_load_lds((const unsigned*)((const char*)(gbase) + (voff)[_i]), (PG8_LAS unsigned*)(lds + (bufoff) + ldsw + _i * 8192), 16, 0, 0); } while (0)
#define PG8_LDA(dst, b, h) do { _Pragma("unroll") for (int m = 0; m < 4; ++m) _Pragma("unroll") for (int k = 0; k < 2; ++k) dst[m][k] = *(const PG8_LAS bf16x8*)(lds + PG8_SA(b, h) + aoff + m * 2048 + k * 1024); } while (0)
#define PG8_LDB(dst, b, h) do { _Pragma("unroll") for (int n = 0; n < 2; ++n) _Pragma("unroll") for (int k = 0; k < 2; ++k) dst[n][k] = *(const PG8_LAS bf16x8*)(lds + PG8_SB(b, h) + boff + n * 2048 + k * 1024); } while (0)
#define PG8_MMA(ai, bj, At, Bt) do { __builtin_amdgcn_s_setprio(1); _Pragma("unroll") for (int m = 0; m < 4; ++m) _Pragma("unroll") for (int n = 0; n < 2; ++n) _Pragma("unroll") for (int k = 0; k < 2; ++k) \
        acc[ai][bj][m][n] = __builtin_amdgcn_mfma_f32_16x16x32_bf16(Bt[n][k], At[m][k], acc[ai][bj][m][n], 0, 0, 0); __builtin_amdgcn_s_setprio(0); } while (0)
#define PG8_WAIT_V(n) asm volatile("s_waitcnt vmcnt(" #n ")" ::: "memory")
#define PG8_WAIT_L(n) asm volatile("s_waitcnt lgkmcnt(" #n ")" ::: "memory")
#define PG8_BAR __builtin_amdgcn_s_barrier()
#define PG8_SCHED __builtin_amdgcn_sched_barrier(0)
    Unit cur, nxt; int ui = 0;
    if (!S.next(0, cur)) return;
    f32x4 acc[2][2][4][2];
#pragma unroll
    for (int a = 0; a < 2; ++a)
#pragma unroll
        for (int b = 0; b < 2; ++b)
#pragma unroll
            for (int m = 0; m < 4; ++m)
#pragma unroll
                for (int n = 0; n < 2; ++n) acc[a][b][m][n] = (f32x4){0.f, 0.f, 0.f, 0.f};
    bf16x8 At[4][2], B0[2][2], B1[2][2];
    const char* cA = (const char*)g.A + (size_t)cur.pm * tstep; const char* cB = (const char*)g.Bt + (size_t)cur.pn * tstep;
    S.a_ready(cur);
    if constexpr (SP2) {
        PG8_STAGE(PG8_SB(0, 0), cB, voffB); PG8_STAGE(PG8_SB(0, 1), cB + hstep, voffB); PG8_STAGE(PG8_SA(0, 0), cA, voffA); PG8_STAGE(PG8_SA(0, 1), cA + hstep, voffA);
        if (wr == 1) PG8_BAR;
        PG8_WAIT_V(2); PG8_BAR;
        PG8_STAGE(PG8_SB(1, 0), cB + kstep, voffB); PG8_STAGE(PG8_SA(1, 0), cA + kstep, voffA); PG8_STAGE(PG8_SB(1, 1), cB + hstep + kstep, voffB);
        PG8_WAIT_V(6); PG8_BAR;
    } else {
        PG8_STAGE(PG8_SB(0, 0), cB, voffB); PG8_STAGE(PG8_SA(0, 0), cA, voffA); PG8_STAGE(PG8_SB(0, 1), cB + hstep, voffB); PG8_STAGE(PG8_SA(0, 1), cA + hstep, voffA);
        if (wr == 1) PG8_BAR;
        PG8_WAIT_V(4); PG8_BAR;
        PG8_STAGE(PG8_SB(1, 0), cB + kstep, voffB); PG8_STAGE(PG8_SA(1, 0), cA + kstep, voffA); PG8_STAGE(PG8_SB(1, 1), cB + hstep + kstep, voffB);
        PG8_WAIT_V(6); PG8_BAR;
    }
    for (;;) {
        const bool has_next = S.next(ui + 1, nxt);
        const char* nA = has_next ? (const char*)g.A + (size_t)nxt.pm * tstep : cA; const char* nB = has_next ? (const char*)g.Bt + (size_t)nxt.pn * tstep : cB;
        for (int t = 0; t < nt; t += 2) {
            const bool last = (t == nt - 2);
            const char* a1 = cA + (size_t)(t + 1) * kstep;
            const char* a2 = last ? nA : cA + (size_t)(t + 2) * kstep; const char* b2 = last ? nB : cB + (size_t)(t + 2) * kstep;
            const char* a3 = a2 + kstep; const char* b3 = b2 + kstep;
            if (last && has_next) S.a_ready(nxt);
            if constexpr (SP2) {
            PG8_LDB(B0, 0, 0); PG8_LDB(B1, 0, 1); PG8_SCHED; PG8_LDA(At, 0, 0); PG8_STAGE(PG8_SA(1, 1), a1 + hstep, voffA);
            PG8_WAIT_V(8); PG8_WAIT_L(0); PG8_BAR; PG8_MMA(0, 0, At, B0); PG8_MMA(0, 1, At, B1); PG8_BAR; PG8_SCHED;
            PG8_LDA(At, 0, 1); PG8_STAGE(PG8_SB(0, 0), b2, voffB); PG8_STAGE(PG8_SB(0, 1), b2 + hstep, voffB); PG8_STAGE(PG8_SA(0, 0), a2, voffA);
            PG8_WAIT_V(8); PG8_WAIT_L(0); PG8_BAR; PG8_MMA(1, 0, At, B0); PG8_MMA(1, 1, At, B1); PG8_BAR; PG8_SCHED;
            PG8_LDB(B0, 1, 0); PG8_LDB(B1, 1, 1); PG8_SCHED; PG8_LDA(At, 1, 0); PG8_STAGE(PG8_SA(0, 1), a2 + hstep, voffA);
            PG8_WAIT_V(8); PG8_WAIT_L(0); PG8_BAR; PG8_MMA(0, 0, At, B0); PG8_MMA(0, 1, At, B1); PG8_BAR; PG8_SCHED;
            PG8_LDA(At, 1, 1); PG8_STAGE(PG8_SB(1, 0), b3, voffB); PG8_STAGE(PG8_SB(1, 1), b3 + hstep, voffB); PG8_STAGE(PG8_SA(1, 0), a3, voffA);
            PG8_WAIT_V(8); PG8_WAIT_L(0); PG8_BAR; PG8_MMA(1, 0, At, B0); PG8_MMA(1, 1, At, B1); PG8_BAR; PG8_SCHED;
            } else {
            PG8_LDB(B0, 0, 0); PG8_SCHED; PG8_LDA(At, 0, 0); PG8_STAGE(PG8_SA(1, 1), a1 + hstep, voffA);
            PG8_WAIT_L(8); PG8_BAR; PG8_WAIT_L(0); PG8_MMA(0, 0, At, B0); PG8_BAR; PG8_SCHED;
            PG8_LDB(B1, 0, 1); PG8_STAGE(PG8_SB(0, 0), b2, voffB);
            PG8_BAR; PG8_WAIT_L(0); PG8_MMA(0, 1, At, B1); PG8_BAR;
            PG8_LDA(At, 0, 1); PG8_STAGE(PG8_SA(0, 0), a2, voffA);
            PG8_BAR; PG8_WAIT_L(0); PG8_MMA(1, 0, At, B0); PG8_BAR; PG8_SCHED;
            PG8_STAGE(PG8_SB(0, 1), b2 + hstep, voffB);
            PG8_WAIT_V(6); PG8_BAR; PG8_MMA(1, 1, At, B1); PG8_BAR;
            PG8_LDB(B0, 1, 0); PG8_SCHED; PG8_LDA(At, 1, 0); PG8_STAGE(PG8_SA(0, 1), a2 + hstep, voffA);
            PG8_WAIT_L(8); PG8_BAR; PG8_WAIT_L(0); PG8_MMA(0, 0, At, B0); PG8_BAR; PG8_SCHED;
            PG8_LDB(B1, 1, 1); PG8_STAGE(PG8_SB(1, 0), b3, voffB);
            PG8_BAR; PG8_WAIT_L(0); PG8_MMA(0, 1, At, B1); PG8_BAR;
            PG8_LDA(At, 1, 1); PG8_STAGE(PG8_SA(1, 0), a3, voffA);
            PG8_BAR; PG8_WAIT_L(0); PG8_MMA(1, 0, At, B0); PG8_BAR; PG8_SCHED;
            PG8_STAGE(PG8_SB(1, 1), b3 + hstep, voffB);
            PG8_WAIT_V(6); PG8_BAR; PG8_MMA(1, 1, At, B1); PG8_BAR;
            }
        }
        if constexpr (ALIGN_EPI) { if (wr == 0) PG8_BAR; }
        if constexpr (!Epi::AFTER_DRAIN) { E(acc, cur, wr, wc, fr, fq); S.done(cur); }
        if (!has_next) break;
#pragma unroll
        for (int a = 0; a < 2; ++a)
#pragma unroll
            for (int b = 0; b < 2; ++b)
#pragma unroll
                for (int m = 0; m < 4; ++m)
#pragma unroll
                    for (int n = 0; n < 2; ++n) acc[a][b][m][n] = (f32x4){0.f, 0.f, 0.f, 0.f};
        cur = nxt; cA = nA; cB = nB; ++ui;
        if constexpr (ALIGN_EPI) { if (wr == 1) PG8_BAR; }
    }
    PG8_WAIT_V(0);
    if constexpr (!ALIGN_EPI) { if (wr == 0) PG8_BAR; }
    PG8_BAR;
    if constexpr (Epi::AFTER_DRAIN) { E.fused(acc, cur, wr, wc, fr, fq, lds, wid, lane); S.done(cur); }
#undef PG8_SA
#undef PG8_SB
#undef PG8_STAGE
#undef PG8_LDA
#undef PG8_LDB
#undef PG8_MMA
#undef PG8_WAIT_V
#undef PG8_WAIT_L
#undef PG8_BAR
#undef PG8_SCHED
}
}

constexpr int NWAVES = 8, NTHR = 512;
constexpr int DM = 2048, PB = 4, PL = 2048, SB = 128, SL = 8;
constexpr int MP = PB * PL, MS = SB * SL, M = MP + MS;
constexpr int GH = 4, GK = 128, GV = 256, GKD = 512, LOWR = 16;
constexpr int SH = 16, SP = 64, SN = 128, SG = 2, SCH = 1536;
constexpr int FF = 5632, FF2 = 11264, INC = 5664;
constexpr int N1 = 5888, NP = 5632;
constexpr int CQ = 0, CK = 512, CV = 1024, CG = 2048, CZ = 3072, CX = 4096;
constexpr float EPS = 1e-6f;
constexpr int N_PHASES = 11;

constexpr size_t O_Y = 0, O_GLA_P = (size_t)M * DM, O_SSD_P = O_GLA_P + (size_t)PB * GH * GK * GV, O_SCONV_P = O_SSD_P + (size_t)PB * SH * SP * SN,
                 O_FCONV_P = O_SCONV_P + (size_t)PB * 3 * SCH, O_GLA_S = O_FCONV_P + (size_t)PB * 2 * FF2, O_SSD_S = O_GLA_S + (size_t)SB * GH * GK * GV,
                 O_SCONV_S = O_SSD_S + (size_t)SB * SH * SP * SN, O_FCONV_S = O_SCONV_S + (size_t)SB * 3 * SCH, O_END = O_FCONV_S + (size_t)SB * 2 * FF2;

constexpr size_t MiB = 1u << 20;
constexpr size_t WS_CTL = 0, CTL_ZERO_BYTES = 64 * 1024;
constexpr size_t WS_WF2 = 1 * MiB;
constexpr size_t WS_W1 = 24 * MiB;
constexpr size_t WS_WO = 48 * MiB;
constexpr size_t WS_WF1 = 56 * MiB;
constexpr size_t WS_XN = 101 * MiB;
constexpr size_t WS_ACT = 24 * MiB;
constexpr size_t WS_BIG = 141 * MiB;
constexpr size_t WS_PROJ = WS_BIG;
constexpr size_t WS_MIX = WS_BIG;
constexpr size_t WS_U = WS_BIG;
constexpr size_t WS_F = WS_BIG;
constexpr size_t WS_LRDT = WS_BIG + 100 * MiB;
constexpr size_t WS_MIXIN = WS_BIG + 104 * MiB;
constexpr size_t WS_DS = WS_XN;
constexpr size_t WS_SC = WS_BIG + 140 * MiB, WS_DH = WS_BIG + 172 * MiB, WS_HC = WS_BIG + 204 * MiB;
constexpr size_t WS_EBL = WS_BIG + 236 * MiB, WS_AL = WS_EBL + 512 * 1024;
constexpr size_t WS_END = WS_BIG + 238 * MiB;
static_assert(WS_WF2 + (size_t)DM * FF * 2 <= WS_W1 && WS_W1 + (size_t)N1 * DM * 2 <= WS_WO && WS_WO + (size_t)DM * DM * 2 <= WS_WF1 && WS_WF1 + (size_t)FF2 * DM * 2 <= WS_XN && WS_XN + (size_t)M * DM * 2 <= WS_BIG, "ws map 1");
static_assert(WS_ACT + (size_t)M * FF * 2 <= WS_BIG && WS_PROJ + (size_t)M * NP * 2 <= WS_LRDT && WS_LRDT + (size_t)M * 32 * 4 <= WS_MIXIN && WS_MIXIN + (size_t)M * DM * 2 <= WS_SC && WS_U + (size_t)M * FF2 * 2 <= WS_END && WS_MIX + (size_t)M * DM * 4 <= WS_LRDT, "ws map 2");
constexpr int CW_BAR = 1024;

constexpr int RING_BYTES = 131072;
constexpr int LDSCTL_OFF = RING_BYTES, MISC_OFF = LDSCTL_OFF + 320;
constexpr int LDS_BYTES = 147456;

#define GAS __attribute__((address_space(1)))
#define LAS __attribute__((address_space(3)))
typedef unsigned short bf16;
typedef unsigned v4u __attribute__((ext_vector_type(4)));
typedef unsigned v2u __attribute__((ext_vector_type(2)));
typedef float f32x4 __attribute__((ext_vector_type(4)));
#define LDS_WAIT() asm volatile("s_waitcnt lgkmcnt(0)" ::: "memory")
#define VM_WAIT() asm volatile("s_waitcnt vmcnt(0)" ::: "memory")
__device__ __forceinline__ unsigned f2bf(float f) { unsigned u = __builtin_bit_cast(unsigned, f); return (u + 0x7fffu + ((u >> 16) & 1u)) >> 16; }
__device__ __forceinline__ unsigned pk2(float lo, float hi) { return f2bf(lo) | (f2bf(hi) << 16); }
__device__ __forceinline__ float bf2f(unsigned short b) { return __builtin_bit_cast(float, (unsigned)b << 16); }
__device__ __forceinline__ float bflo(unsigned w) { return __builtin_bit_cast(float, w << 16); }
__device__ __forceinline__ float bfhi(unsigned w) { return __builtin_bit_cast(float, w & 0xffff0000u); }
__device__ __forceinline__ float silu_f(float x) { return x / (1.f + __expf(-x)); }
__device__ __forceinline__ float softplus_f(float x) { return fmaxf(x, 0.f) + log1pf(__expf(-fabsf(x))); }
__device__ __forceinline__ float logsigmoid_f(float x) { return fminf(x, 0.f) - log1pf(__expf(-fabsf(x))); }
__device__ __forceinline__ float wave_sum(float v) {
#pragma unroll
    for (int o = 1; o < 64; o <<= 1) v += __shfl_xor(v, o);
    return v;
}

#define XB_TMO      128
#define XB_XCNT(j)  (256  + 64 * (j))
#define XB_XSUB(j)  (1280 + 64 * (j))
#define XB_XGEN(j)  (2304 + 64 * (j))
#define XB_TOP      3328
#define XB_TOPGEN   3392
#define XCD_BAR_WORDS 3456
#define XB_SPIN_CAP (1u << 18)

__device__ __forceinline__ unsigned xb_ld(unsigned* p)              { return __hip_atomic_load(p, __ATOMIC_RELAXED, __HIP_MEMORY_SCOPE_AGENT); }
__device__ __forceinline__ unsigned xb_add(unsigned* p, unsigned v) { return __hip_atomic_fetch_add(p, v, __ATOMIC_RELAXED, __HIP_MEMORY_SCOPE_AGENT); }
__device__ __forceinline__ unsigned xb_xcc_id() { return (unsigned)__builtin_amdgcn_s_getreg((3 << 11) | 20) & 0xFu; }
#define XB_SPIN(cond, bar) do { unsigned _sp = 0; while (cond) { __builtin_amdgcn_s_sleep(1); \
    if ((++_sp & 255u) == 0u) { if (xb_ld(&(bar)[XB_TMO])) break; if (_sp > XB_SPIN_CAP) { atomicAdd(&(bar)[XB_TMO], 1u); break; } } } } while (0)

struct XcdBarrier {
    unsigned* bar; unsigned x;
    volatile LAS unsigned* st;
};

__device__ __forceinline__ XcdBarrier xcd_barrier_post(unsigned* bar, volatile LAS unsigned* st) {
    XcdBarrier b; b.bar = bar; b.x = xb_xcc_id(); b.st = st;
    if (threadIdx.x == 0) (void)xb_add(&bar[XB_XCNT(b.x)], 1u);
    return b;
}
__device__ __forceinline__ void xcd_barrier_complete(unsigned* bar, unsigned x, unsigned& nloc, unsigned& nx) {
    const unsigned G = gridDim.x * gridDim.y * gridDim.z;
    unsigned sum, cnt, mine, sp = 0u;
    for (;;) {
        sum = 0u; cnt = 0u; mine = 0u;
#pragma unroll
        for (unsigned j = 0; j < 16; ++j) { const unsigned c = xb_ld(&bar[XB_XCNT(j)]); sum += c; cnt += (c > 0u) ? 1u : 0u; mine = (j == x) ? c : mine; }
        if (sum == G) break;
        __builtin_amdgcn_s_sleep(1);
        if ((++sp & 255u) == 0u) { if (xb_ld(&bar[XB_TMO])) break; if (sp > XB_SPIN_CAP) { atomicAdd(&bar[XB_TMO], 1u); break; } }
    }
    nloc = mine > 0u ? mine : 1u; nx = cnt > 0u ? cnt : 1u;
}

__device__ __forceinline__ void xcd_barrier(const XcdBarrier& b) {
    asm volatile("s_waitcnt vmcnt(0)" ::: "memory");
    __syncthreads();
    if (threadIdx.x == 0) {
        unsigned* bar = b.bar;
        __builtin_amdgcn_s_waitcnt(0);
        unsigned nloc = b.st[0], nx = b.st[1];
        if (nloc == 0u) { xcd_barrier_complete(bar, b.x, nloc, nx); b.st[0] = nloc; b.st[1] = nx; }
        const unsigned old = xb_add(&bar[XB_XSUB(b.x)], 1u);
        const unsigned gen = old / nloc;
        if (old + 1u == (gen + 1u) * nloc) {
            __builtin_amdgcn_fence(__ATOMIC_RELEASE, "agent");
            asm volatile("s_waitcnt vmcnt(0)" ::: "memory");
            const unsigned og = xb_add(&bar[XB_TOP], 1u);
            const unsigned tg = og / nx;
            if (og + 1u == (tg + 1u) * nx) xb_add(&bar[XB_TOPGEN], 1u);
            else XB_SPIN(xb_ld(&bar[XB_TOPGEN]) == tg, bar);
            __builtin_amdgcn_fence(__ATOMIC_ACQUIRE, "agent");
            xb_add(&bar[XB_XGEN(b.x)], 1u);
            asm volatile("s_waitcnt vmcnt(0)" ::: "memory");
        } else {
            XB_SPIN(xb_ld(&bar[XB_XGEN(b.x)]) == gen, bar);
            __builtin_amdgcn_fence(__ATOMIC_ACQUIRE, "agent");
            asm volatile("s_waitcnt vmcnt(0)" ::: "memory");
        }
    }
    __syncthreads();
}

struct Frame {
    LAS unsigned char* lds;
    int tid, lane, wave, G, bid;
    const float *x_p, *x_s, *st_gla, *st_ssd, *st_sconv, *st_fconv, *n_mix_pre, *n_mix_post, *n_ffn_pre, *n_ffn_post, *w_in, *w_gate2, *b_gate, *gla_norm,
                *sconv_w, *sconv_b, *dt_bias, *A_log, *ssd_D, *ssd_norm, *w_out, *ffn_w_in, *fconv_w, *fconv_b, *ffn_w_out;
    float* out;
    bf16 *W1, *WO, *WF1, *WF2, *XN, *PROJ, *MIXIN, *U, *ACT, *DS, *SC, *DH, *HC;
    float *LRDT, *MIX, *Fb, *EBL, *AL;
};
__device__ __forceinline__ const float* x_row(const Frame& F, int row) { return row < MP ? F.x_p + (size_t)row * DM : F.x_s + (size_t)(row - MP) * DM; }

__device__ __forceinline__ int w1_src_col(int n) { return n < 3072 ? n : (n < 5632 ? n + 16 : (n < 5648 ? n - 2560 : (n < 5664 ? n : -1))); }
template <bool MAP>
__device__ __forceinline__ void p0_transpose_item(const float* W, int K, int Nsrc, int Ndst, bf16* WT, LAS float* scr, int item, int lane) {
    const int nblk = Ndst / 32, kb = item / nblk, nb = item % nblk, k0 = 64 * kb, n0 = 32 * nb;
    int sc = n0 + (lane & 31); if (MAP) sc = w1_src_col(sc);
#pragma unroll 8
    for (int i = 0; i < 32; ++i) { const int kk = 2 * i + (lane >> 5); scr[kk * 33 + (lane & 31)] = (sc >= 0) ? W[(size_t)(k0 + kk) * Nsrc + sc] : 0.f; }
    LDS_WAIT(); asm volatile("" ::: "memory");
    const int c = lane & 7;
#pragma unroll
    for (int j = 0; j < 4; ++j) { const int n = (lane >> 3) + 8 * j; const LAS float* s = scr + (8 * c) * 33 + n;
        v4u o; o.x = pk2(s[0 * 33], s[1 * 33]); o.y = pk2(s[2 * 33], s[3 * 33]); o.z = pk2(s[4 * 33], s[5 * 33]); o.w = pk2(s[6 * 33], s[7 * 33]);
        *(v4u*)(WT + (size_t)(n0 + n) * K + k0 + 8 * c) = o; }
    LDS_WAIT(); asm volatile("" ::: "memory");
}
__device__ __forceinline__ void rms_row_to_bf16(const float* xrow, const float* w, bf16* orow, int lane) {
    const f32x4* xr = (const f32x4*)xrow + lane; const f32x4* wr = (const f32x4*)w + lane;
    f32x4 v[8]; float s = 0.f;
#pragma unroll
    for (int j = 0; j < 8; ++j) { v[j] = xr[64 * j]; s += (v[j].x * v[j].x + v[j].y * v[j].y) + (v[j].z * v[j].z + v[j].w * v[j].w); }
    const float r = rsqrtf(wave_sum(s) * (1.f / DM) + EPS);
    v2u* o8 = (v2u*)orow + lane;
#pragma unroll
    for (int j = 0; j < 8; ++j) { const f32x4 ww = wr[64 * j]; v2u o; o.x = pk2(v[j].x * r * ww.x, v[j].y * r * ww.y); o.y = pk2(v[j].z * r * ww.z, v[j].w * r * ww.w); o8[64 * j] = o; }
}
__device__ __forceinline__ void p0_prologue(Frame& F) {
    LAS float* scr = (LAS float*)(F.lds + F.wave * 16384);
    const int gw = F.bid * NWAVES + F.wave, NGW = F.G * NWAVES;
    constexpr int I_1 = (DM / 64) * (N1 / 32), I_O = (DM / 64) * (DM / 32), I_F1 = (DM / 64) * (FF2 / 32), I_F2 = (FF / 64) * (DM / 32);
    constexpr int NITEMS = I_1 + I_O + I_F1 + I_F2;
    for (int it = gw; it < NITEMS; it += NGW) {
        int r = it;
        if (r < I_1) { p0_transpose_item<true>(F.w_in, DM, INC, N1, F.W1, scr, r, F.lane); continue; } r -= I_1;
        if (r < I_O) { p0_transpose_item<false>(F.w_out, DM, DM, DM, F.WO, scr, r, F.lane); continue; } r -= I_O;
        if (r < I_F1) { p0_transpose_item<false>(F.ffn_w_in, DM, FF2, FF2, F.WF1, scr, r, F.lane); continue; } r -= I_F1;
        p0_transpose_item<false>(F.ffn_w_out, FF, DM, DM, F.WF2, scr, r, F.lane);
    }
    for (int m = gw; m < M; m += NGW) rms_row_to_bf16(x_row(F, m), F.n_mix_pre, F.XN + (size_t)m * DM, F.lane);
}

template <int grp> __device__ __forceinline__ void gla_direct_unit(Frame& F, int b, int h) {
    const int tid = F.tid, v = tid & 255, kh = tid >> 8;
    const int L = grp ? SL : PL, row0 = grp ? MP + b * SL : b * PL;
    LAS float* Es = (LAS float*)F.lds; LAS float* Ks = Es + 1024; LAS float* Qs = Ks + 1024; LAS float* Os = Qs + 1024;
    float S[64];
    if (grp) { const float* s0 = F.st_gla + ((size_t)(b * GH + h) * GK + kh * 64) * GV + v;
#pragma unroll
        for (int i = 0; i < 64; ++i) S[i] = s0[(size_t)i * GV]; }
    else {
#pragma unroll
        for (int i = 0; i < 64; ++i) S[i] = 0.f; }
    for (int t0 = 0; t0 < L; t0 += 8) {
        for (int it = tid; it < 1024; it += NTHR) { const int t = it >> 7, k = it & 127, row = row0 + t0 + t, hk = h * GK + k;
            float x = F.b_gate[hk]; const float* lr = F.LRDT + (size_t)row * 32;
#pragma unroll
            for (int j = 0; j < LOWR; ++j) x += lr[j] * F.w_gate2[j * GKD + hk];
            const float lg = logsigmoid_f(x) * (1.f / 16.f);
            Es[it] = __expf(lg); Ks[it] = bf2f(F.PROJ[(size_t)row * NP + CK + hk]); Qs[it] = bf2f(F.PROJ[(size_t)row * NP + CQ + hk]) * 0.08838834764831845f; }
        __syncthreads();
#pragma unroll 1
        for (int t = 0; t < 8; ++t) { const float vv = bf2f(F.PROJ[(size_t)(row0 + t0 + t) * NP + CV + h * GV + v]); float acc = 0.f;
            const LAS float* e = Es + t * 128 + kh * 64; const LAS float* kk = Ks + t * 128 + kh * 64; const LAS float* qq = Qs + t * 128 + kh * 64;
#pragma unroll
            for (int i = 0; i < 64; ++i) { S[i] = e[i] * S[i] + kk[i] * vv; acc += qq[i] * S[i]; }
            Os[(kh * 8 + t) * 256 + v] = acc; }
        __syncthreads();
        { const int t = F.wave, v4 = F.lane * 4, row = row0 + t0 + t;
            const f32x4 a = *(const LAS f32x4*)(Os + t * 256 + v4), c = *(const LAS f32x4*)(Os + (8 + t) * 256 + v4); const f32x4 o = a + c;
            const float ss = wave_sum((o.x * o.x + o.y * o.y) + (o.z * o.z + o.w * o.w)); const float r = rsqrtf(ss * (1.f / GV) + EPS);
            const v2u gw = *(const v2u*)(F.PROJ + (size_t)row * NP + CG + h * GV + v4); const f32x4 nw = *(const f32x4*)(F.gla_norm + v4);
            v2u w; w.x = pk2(o.x * r * nw.x * silu_f(bflo(gw.x)), o.y * r * nw.y * silu_f(bfhi(gw.x))); w.y = pk2(o.z * r * nw.z * silu_f(bflo(gw.y)), o.w * r * nw.w * silu_f(bfhi(gw.y)));
            *(v2u*)(F.MIXIN + (size_t)row * DM + h * GV + v4) = w; }
        __syncthreads();
    }
    float* so = F.out + (grp ? O_GLA_S : O_GLA_P) + ((size_t)(b * GH + h) * GK + kh * 64) * GV + v;
#pragma unroll
    for (int i = 0; i < 64; ++i) so[(size_t)i * GV] = S[i];
}
__device__ __forceinline__ float xbc_raw(const Frame& F, int grp, int b, int row0, int tt, int c) {
    if (tt >= 0) return bf2f(F.PROJ[(size_t)(row0 + tt) * NP + CX + c]);
    return grp ? F.st_sconv[((size_t)b * 3 + (tt + 3)) * SCH + c] : 0.f;
}
template <int grp> __device__ __forceinline__ void ssd_direct_unit(Frame& F, int b, int g) {
    const int tid = F.tid, hd = g * 8 + (tid >> 6), p = tid & 63, ch = g * 512 + tid;
    const int L = grp ? SL : PL, row0 = grp ? MP + b * SL : b * PL;
    LAS float* Bs = (LAS float*)F.lds; LAS float* Cs = Bs + 1024; LAS float* red = Cs + 1024; LAS float* Ys = red + 64;
    float h[128];
    if (grp) { const f32x4* h0 = (const f32x4*)(F.st_ssd + ((size_t)(b * SH + hd) * SP + p) * SN);
#pragma unroll
        for (int i = 0; i < 32; ++i) { const f32x4 q = h0[i]; h[4 * i] = q.x; h[4 * i + 1] = q.y; h[4 * i + 2] = q.z; h[4 * i + 3] = q.w; } }
    else {
#pragma unroll
        for (int i = 0; i < 128; ++i) h[i] = 0.f; }
    const float A = -__expf(F.A_log[hd]), dtb = F.dt_bias[hd], Dh = F.ssd_D[hd], nw = F.ssd_norm[ch];
    const float cb = F.sconv_b[ch], cw0 = F.sconv_w[ch], cw1 = F.sconv_w[SCH + ch], cw2 = F.sconv_w[2 * SCH + ch], cw3 = F.sconv_w[3 * SCH + ch];
    const int c2 = 1024 + (tid < 128 ? g * 128 + tid : 256 + g * 128 + ((tid - 128) & 127));
    float xr0 = xbc_raw(F, grp, b, row0, -3, ch), xr1 = xbc_raw(F, grp, b, row0, -2, ch), xr2 = xbc_raw(F, grp, b, row0, -1, ch);
    for (int t0 = 0; t0 < L; t0 += 8) {
        if (tid < 256) {
            float xr[11]; const float cb2 = F.sconv_b[c2], d0 = F.sconv_w[c2], d1 = F.sconv_w[SCH + c2], d2 = F.sconv_w[2 * SCH + c2], d3 = F.sconv_w[3 * SCH + c2];
#pragma unroll
            for (int i = 0; i < 11; ++i) xr[i] = xbc_raw(F, grp, b, row0, t0 - 3 + i, c2);
#pragma unroll
            for (int t = 0; t < 8; ++t) Bs[(tid >> 7) * 1024 + t * 128 + (tid & 127)] = silu_f(cb2 + d0 * xr[t] + d1 * xr[t + 1] + d2 * xr[t + 2] + d3 * xr[t + 3]);
        }
        __syncthreads();
#pragma unroll 1
        for (int t = 0; t < 8; ++t) { const int row = row0 + t0 + t;
            const float xn = bf2f(F.PROJ[(size_t)row * NP + CX + ch]);
            const float x = silu_f(cb + cw0 * xr0 + cw1 * xr1 + cw2 * xr2 + cw3 * xn); xr0 = xr1; xr1 = xr2; xr2 = xn;
            const float dt = softplus_f(F.LRDT[(size_t)row * 32 + 16 + hd] + dtb), a = __expf(dt * A), dtx = dt * x;
            float acc = 0.f; const LAS float* bb = Bs + t * 128; const LAS float* cc = Cs + t * 128;
#pragma unroll
            for (int nb = 0; nb < 128; nb += 16) {
#pragma unroll
                for (int n = nb; n < nb + 16; ++n) { h[n] = a * h[n] + dtx * bb[n]; acc += h[n] * cc[n]; }
                asm volatile("" ::: "memory"); }
            const float z = bf2f(F.PROJ[(size_t)row * NP + CZ + ch]);
            const float y = (acc + Dh * x) * silu_f(z);
            Ys[t * 512 + tid] = y;
            const float ss = wave_sum(y * y); if (F.lane == 0) red[t * 8 + F.wave] = ss; }
        __syncthreads();
#pragma unroll
        for (int t = 0; t < 8; ++t) { float tot = 0.f;
#pragma unroll
            for (int w = 0; w < 8; ++w) tot += red[t * 8 + w];
            const float r = rsqrtf(tot * (1.f / 512.f) + EPS);
            F.MIXIN[(size_t)(row0 + t0 + t) * DM + 1024 + ch] = (bf16)f2bf(Ys[t * 512 + tid] * r * nw); }
        __syncthreads();
    }
    f32x4* ho = (f32x4*)(F.out + (grp ? O_SSD_S : O_SSD_P) + ((size_t)(b * SH + hd) * SP + p) * SN);
#pragma unroll
    for (int i = 0; i < 32; ++i) ho[i] = (f32x4){h[4 * i], h[4 * i + 1], h[4 * i + 2], h[4 * i + 3]};
}
typedef short bf16x8v __attribute__((ext_vector_type(8)));
typedef short s16x4v __attribute__((ext_vector_type(4)));
constexpr int CH = 64, NCH = PL / CH;
constexpr int QE_ST = 272, KDT_ST = 144, V_ST = 544, ATT_ST = 144, X_ST = 1056, BC_ST = 288;
#define MFMA16(a, b, c) __builtin_amdgcn_mfma_f32_16x16x32_bf16((a), (b), (c), 0, 0, 0)
__device__ __forceinline__ bf16x8v frag_k(const LAS unsigned char* T, int stride, int idx0, int kk0, int r, int q) { return *(const LAS bf16x8v*)(T + (idx0 + r) * stride + (kk0 + 8 * q) * 2); }
__device__ __forceinline__ bf16x8v frag_t(const LAS unsigned char* T, int stride, int kk0, int idx0, int r, int q) {
    const LAS unsigned char* p = T + (kk0 + 8 * q + (r >> 2)) * stride + (idx0 + 4 * (r & 3)) * 2;
    const s16x4v lo = __builtin_amdgcn_ds_read_tr16_b64_v4i16((LAS s16x4v*)p), hi = __builtin_amdgcn_ds_read_tr16_b64_v4i16((LAS s16x4v*)(p + 4 * stride));
    return (bf16x8v){lo[0], lo[1], lo[2], lo[3], hi[0], hi[1], hi[2], hi[3]};
}
__device__ __forceinline__ v2u pk4(const f32x4 v) { v2u o; o.x = pk2(v.x, v.y); o.y = pk2(v.z, v.w); return o; }

template <int PASS>
__device__ __forceinline__ void gla_chunk_elem(Frame& F, int h, int row0, LAS unsigned char* T0, LAS unsigned char* T1, LAS float* tot, float* ebl_out) {
    const int tid = F.tid, k = tid & 127, tq = tid >> 7, hk = h * GK + k;
    float w2[16];
#pragma unroll
    for (int j = 0; j < 16; ++j) w2[j] = F.w_gate2[j * GKD + hk];
    const float bg = F.b_gate[hk];
    float lg[16]; float run = 0.f;
#pragma unroll
    for (int i = 0; i < 16; ++i) { const float* lr = F.LRDT + (size_t)(row0 + 16 * tq + i) * 32; float x = bg;
#pragma unroll
        for (int j = 0; j < 16; ++j) x += lr[j] * w2[j];
        run += logsigmoid_f(x) * (1.f / 16.f); lg[i] = run; }
    tot[tq * 128 + k] = run;
    __syncthreads();
    float off = 0.f, all = 0.f;
#pragma unroll
    for (int qq = 0; qq < 4; ++qq) { const float v = tot[qq * 128 + k]; all += v; off += (qq < tq) ? v : 0.f; }
    if (PASS == 0) {
        unsigned pk[8];
#pragma unroll
        for (int i = 0; i < 8; ++i) { const size_t ro = (size_t)(row0 + 16 * tq + 2 * i) * NP + CK + hk;
            const float k0 = bf2f(F.PROJ[ro]) * __expf(all - (off + lg[2 * i])), k1 = bf2f(F.PROJ[ro + NP]) * __expf(all - (off + lg[2 * i + 1])); pk[i] = pk2(k0, k1); }
        LAS v4u* d = (LAS v4u*)(T0 + k * KDT_ST + 32 * tq);
        d[0] = (v4u){pk[0], pk[1], pk[2], pk[3]}; d[1] = (v4u){pk[4], pk[5], pk[6], pk[7]};
        if (tq == 0) ebl_out[k] = __expf(all);
    } else {
#pragma unroll
        for (int i = 0; i < 16; ++i) { const int t = 16 * tq + i; const size_t ro = (size_t)(row0 + t) * NP + hk; const float bb = off + lg[i];
            *(LAS bf16*)(T0 + t * QE_ST + k * 2) = (bf16)f2bf(bf2f(F.PROJ[ro + CQ]) * 0.08838834764831845f * __expf(bb));
            *(LAS bf16*)(T1 + t * QE_ST + k * 2) = (bf16)f2bf(bf2f(F.PROJ[ro + CK]) * __expf(-bb)); }
    }
}
__device__ __forceinline__ void gla_load_v(Frame& F, int h, int row0, LAS unsigned char* V) {
#pragma unroll
    for (int i = 0; i < 4; ++i) { const int piece = F.tid + NTHR * i, row = piece >> 5, c16 = piece & 31;
        *(LAS v4u*)(V + row * V_ST + c16 * 16) = *(const v4u*)(F.PROJ + (size_t)(row0 + row) * NP + CV + h * GV + c16 * 8); }
}
__device__ __forceinline__ void gla_passA_unit(Frame& F, int u) {
    const int c = u & 31, bh = u >> 5, b = bh >> 2, h = bh & 3, row0 = b * PL + c * CH;
    LAS unsigned char* KDT = F.lds; LAS unsigned char* V = KDT + 128 * KDT_ST; LAS float* tot = (LAS float*)(V + 64 * V_ST);
    gla_load_v(F, h, row0, V);
    gla_chunk_elem<0>(F, h, row0, KDT, nullptr, tot, F.EBL + (size_t)u * 128);
    __syncthreads();
    const int w = F.wave, r = F.lane & 15, q = F.lane >> 4;
    f32x4 acc[8][2];
#pragma unroll
    for (int kf = 0; kf < 8; ++kf) { acc[kf][0] = (f32x4){0.f, 0.f, 0.f, 0.f}; acc[kf][1] = (f32x4){0.f, 0.f, 0.f, 0.f}; }
#pragma unroll
    for (int ks = 0; ks < 2; ++ks) { const bf16x8v b0 = frag_t(V, V_ST, 32 * ks, 32 * w, r, q), b1 = frag_t(V, V_ST, 32 * ks, 32 * w + 16, r, q);
#pragma unroll
        for (int kf = 0; kf < 8; ++kf) { const bf16x8v a = frag_k(KDT, KDT_ST, 16 * kf, 32 * ks, r, q); acc[kf][0] = MFMA16(a, b0, acc[kf][0]); acc[kf][1] = MFMA16(a, b1, acc[kf][1]); } }
#pragma unroll
    for (int kf = 0; kf < 8; ++kf)
#pragma unroll
        for (int vf = 0; vf < 2; ++vf) *(v2u*)(F.DS + ((size_t)u * GV + 32 * w + 16 * vf + r) * GK + 16 * kf + 4 * q) = pk4(acc[kf][vf]);
    __syncthreads();
}
__device__ __forceinline__ void gla_scan(Frame& F) {
    for (int it = F.bid * NTHR + F.tid; it < PB * GH * GV * 32; it += F.G * NTHR) { const int k4 = it & 31, v = (it >> 5) & 255, bh = it >> 13;
        f32x4 S = (f32x4){0.f, 0.f, 0.f, 0.f};
#pragma unroll 4
        for (int c = 0; c < NCH; ++c) { const int u = bh * NCH + c; const size_t off = ((size_t)u * GV + v) * GK + 4 * k4;
            const v2u d = *(const v2u*)(F.DS + off); const f32x4 e = *(const f32x4*)(F.EBL + (size_t)u * 128 + 4 * k4);
            *(v2u*)(F.SC + off) = pk4(S);
            S.x = e.x * S.x + bflo(d.x); S.y = e.y * S.y + bfhi(d.x); S.z = e.z * S.z + bflo(d.y); S.w = e.w * S.w + bfhi(d.y); }
        float* o = F.out + O_GLA_P + ((size_t)bh * GK + 4 * k4) * GV + v; o[0] = S.x; o[GV] = S.y; o[2 * GV] = S.z; o[3 * GV] = S.w; }
}
__device__ __forceinline__ void gla_passC_unit(Frame& F, int u) {
    const int c = u & 31, bh = u >> 5, b = bh >> 2, h = bh & 3, row0 = b * PL + c * CH;
    LAS unsigned char* QE = F.lds; LAS unsigned char* KE = QE + 64 * QE_ST; LAS unsigned char* V = KE + 64 * QE_ST; LAS unsigned char* ATT = V + 64 * V_ST;
    LAS float* tot = (LAS float*)(ATT + 64 * ATT_ST); LAS float* red = tot + 512;
    gla_load_v(F, h, row0, V);
    gla_chunk_elem<1>(F, h, row0, QE, KE, tot, nullptr);
    __syncthreads();
    const int w = F.wave, r = F.lane & 15, q = F.lane >> 4;
#pragma unroll
    for (int ff = 0; ff < 2; ++ff) { const int f = 2 * w + ff, sf = f >> 2, tf = f & 3; f32x4 a4 = (f32x4){0.f, 0.f, 0.f, 0.f};
        if (sf <= tf) {
#pragma unroll
            for (int ks = 0; ks < 4; ++ks) a4 = MFMA16(frag_k(KE, QE_ST, 16 * sf, 32 * ks, r, q), frag_k(QE, QE_ST, 16 * tf, 32 * ks, r, q), a4); }
        const int s0 = 16 * sf + 4 * q, t = 16 * tf + r;
        f32x4 m; m.x = (s0 <= t) ? a4.x : 0.f; m.y = (s0 + 1 <= t) ? a4.y : 0.f; m.z = (s0 + 2 <= t) ? a4.z : 0.f; m.w = (s0 + 3 <= t) ? a4.w : 0.f;
        *(LAS v2u*)(ATT + t * ATT_ST + s0 * 2) = pk4(m); }
    __syncthreads();
    const int tf = w & 3, vh = w >> 2;
    f32x4 acc[8];
#pragma unroll
    for (int i = 0; i < 8; ++i) acc[i] = (f32x4){0.f, 0.f, 0.f, 0.f};
    const bf16* Sc = F.SC + ((size_t)u * GV + 128 * vh) * GK;
#pragma unroll
    for (int ks = 0; ks < 4; ++ks) { const bf16x8v bq = frag_k(QE, QE_ST, 16 * tf, 32 * ks, r, q);
#pragma unroll
        for (int i = 0; i < 8; ++i) { const bf16x8v a = *(const bf16x8v*)(Sc + (size_t)(16 * i + r) * GK + 32 * ks + 8 * q); acc[i] = MFMA16(a, bq, acc[i]); } }
#pragma unroll
    for (int ks = 0; ks < 2; ++ks) { const bf16x8v ba = frag_k(ATT, ATT_ST, 16 * tf, 32 * ks, r, q);
#pragma unroll
        for (int i = 0; i < 8; ++i) { const bf16x8v a = frag_t(V, V_ST, 32 * ks, 128 * vh + 16 * i, r, q); acc[i] = MFMA16(a, ba, acc[i]); } }
    float ss = 0.f;
#pragma unroll
    for (int i = 0; i < 8; ++i) ss += (acc[i].x * acc[i].x + acc[i].y * acc[i].y) + (acc[i].z * acc[i].z + acc[i].w * acc[i].w);
    ss += __shfl_xor(ss, 16); ss += __shfl_xor(ss, 32);
    const int t = 16 * tf + r;
    if (q == 0) red[vh * 64 + t] = ss;
    __syncthreads();
    const float rr = rsqrtf((red[t] + red[64 + t]) * (1.f / GV) + EPS); const size_t row = (size_t)(row0 + t);
#pragma unroll
    for (int i = 0; i < 8; ++i) { const int v = 128 * vh + 16 * i + 4 * q;
        const v2u gw = *(const v2u*)(F.PROJ + row * NP + CG + h * GV + v); const f32x4 nw = *(const f32x4*)(F.gla_norm + v);
        f32x4 o; o.x = acc[i].x * rr * nw.x * silu_f(bflo(gw.x)); o.y = acc[i].y * rr * nw.y * silu_f(bfhi(gw.x)); o.z = acc[i].z * rr * nw.z * silu_f(bflo(gw.y)); o.w = acc[i].w * rr * nw.w * silu_f(bfhi(gw.y));
        *(v2u*)(F.MIXIN + row * DM + h * GV + v) = pk4(o); }
    __syncthreads();
}

template <bool SCALE>
__device__ __forceinline__ void ssd_conv_item(Frame& F, int b, int g, int c, int cg, int tb, LAS unsigned char* X, LAS unsigned char* BT, LAS unsigned char* CT, const LAS float* WDEC) {
    const int xc = cg < 64 ? g * 512 + 8 * cg : (cg < 80 ? 1024 + g * 128 + 8 * (cg - 64) : 1280 + g * 128 + 8 * (cg - 80));
    float w[4][8], bias[8];
#pragma unroll
    for (int j = 0; j < 4; ++j) { const f32x4 a = *(const f32x4*)(F.sconv_w + j * SCH + xc), bq = *(const f32x4*)(F.sconv_w + j * SCH + xc + 4);
        w[j][0] = a.x; w[j][1] = a.y; w[j][2] = a.z; w[j][3] = a.w; w[j][4] = bq.x; w[j][5] = bq.y; w[j][6] = bq.z; w[j][7] = bq.w; }
    { const f32x4 a = *(const f32x4*)(F.sconv_b + xc), bq = *(const f32x4*)(F.sconv_b + xc + 4); bias[0] = a.x; bias[1] = a.y; bias[2] = a.z; bias[3] = a.w; bias[4] = bq.x; bias[5] = bq.y; bias[6] = bq.z; bias[7] = bq.w; }
    v4u raw[11];
#pragma unroll
    for (int i = 0; i < 11; ++i) { const int tt = c * CH + tb * 8 - 3 + i;
        raw[i] = (tt >= 0) ? *(const v4u*)(F.PROJ + (size_t)(b * PL + tt) * NP + CX + xc) : (v4u){0u, 0u, 0u, 0u}; }
#pragma unroll
    for (int t = 0; t < 8; ++t) { float o[8];
#pragma unroll
        for (int e = 0; e < 8; ++e) { float a = bias[e];
#pragma unroll
            for (int j = 0; j < 4; ++j) { const unsigned wd = raw[t + j][e >> 1]; a += w[j][e] * ((e & 1) ? bfhi(wd) : bflo(wd)); }
            o[e] = silu_f(a); }
        const int tl = tb * 8 + t;
        if (SCALE && cg < 64) { const float sc = WDEC[(cg >> 3) * 64 + tl];
#pragma unroll
            for (int e = 0; e < 8; ++e) o[e] *= sc; }
        const v4u pkd = (v4u){pk2(o[0], o[1]), pk2(o[2], o[3]), pk2(o[4], o[5]), pk2(o[6], o[7])};
        LAS unsigned char* dst = cg < 64 ? X + tl * X_ST + cg * 16 : (cg < 80 ? BT + tl * BC_ST + (cg - 64) * 16 : CT + tl * BC_ST + (cg - 80) * 16);
        *(LAS v4u*)dst = pkd; }
}
__device__ __forceinline__ float ssd_head_scan(Frame& F, int hd, int row0, float& dt_out, float& last) {
    const float dt = softplus_f(F.LRDT[(size_t)(row0 + F.lane) * 32 + 16 + hd] + F.dt_bias[hd]);
    float cum = dt * (-__expf(F.A_log[hd]));
#pragma unroll
    for (int o = 1; o < 64; o <<= 1) { const float v = __shfl_up(cum, o); cum += (F.lane >= o) ? v : 0.f; }
    dt_out = dt; last = __shfl(cum, 63); return cum;
}
__device__ __forceinline__ void ssd_passA_unit(Frame& F, int u) {
    const int c = u & 31, bg = u >> 5, b = bg >> 1, g = bg & 1, row0 = b * PL + c * CH;
    LAS unsigned char* X = F.lds; LAS unsigned char* BT = X + 64 * X_ST; LAS float* WDEC = (LAS float*)(BT + 64 * BC_ST);
    const int w = F.wave, r = F.lane & 15, q = F.lane >> 4;
    { float dt, last; const float cum = ssd_head_scan(F, g * 8 + w, row0, dt, last);
        WDEC[w * 64 + F.lane] = __expf(last - cum) * dt; if (F.lane == 63) F.AL[(size_t)u * 8 + w] = __expf(last); }
    __syncthreads();
    for (int it = F.tid; it < 80 * 8; it += NTHR) ssd_conv_item<true>(F, b, g, c, it % 80, it / 80, X, BT, nullptr, WDEC);
    __syncthreads();
#pragma unroll 1
    for (int nh = 0; nh < 2; ++nh) {
        f32x4 acc[4][4];
#pragma unroll
        for (int i = 0; i < 4; ++i)
#pragma unroll
            for (int j = 0; j < 4; ++j) acc[i][j] = (f32x4){0.f, 0.f, 0.f, 0.f};
#pragma unroll
        for (int ks = 0; ks < 2; ++ks) { bf16x8v bp[4];
#pragma unroll
            for (int pf = 0; pf < 4; ++pf) bp[pf] = frag_t(X, X_ST, 32 * ks, 64 * w + 16 * pf, r, q);
#pragma unroll
            for (int nf = 0; nf < 4; ++nf) { const bf16x8v a = frag_t(BT, BC_ST, 32 * ks, 64 * nh + 16 * nf, r, q);
#pragma unroll
                for (int pf = 0; pf < 4; ++pf) acc[nf][pf] = MFMA16(a, bp[pf], acc[nf][pf]); } }
#pragma unroll
        for (int nf = 0; nf < 4; ++nf)
#pragma unroll
            for (int pf = 0; pf < 4; ++pf) *(v2u*)(F.DH + (((size_t)u * 8 + w) * SP + 16 * pf + r) * SN + 64 * nh + 16 * nf + 4 * q) = pk4(acc[nf][pf]);
    }
    __syncthreads();
}
__device__ __forceinline__ void ssd_scan(Frame& F) {
    for (int it = F.bid * NTHR + F.tid; it < PB * SH * SP * 32; it += F.G * NTHR) { const int n4 = it & 31, p = (it >> 5) & 63, bhd = it >> 11, b = bhd >> 4, hd = bhd & 15, g = hd >> 3, hl = hd & 7;
        f32x4 H = (f32x4){0.f, 0.f, 0.f, 0.f};
#pragma unroll 4
        for (int c = 0; c < NCH; ++c) { const int u = (b * 2 + g) * NCH + c; const size_t off = (((size_t)u * 8 + hl) * SP + p) * SN + 4 * n4;
            const v2u d = *(const v2u*)(F.DH + off); const float a = F.AL[(size_t)u * 8 + hl];
            *(v2u*)(F.HC + off) = pk4(H);
            H.x = a * H.x + bflo(d.x); H.y = a * H.y + bfhi(d.x); H.z = a * H.z + bflo(d.y); H.w = a * H.w + bfhi(d.y); }
        *(f32x4*)(F.out + O_SSD_P + ((size_t)bhd * SP + p) * SN + 4 * n4) = H; }
}
__device__ __forceinline__ void ssd_passC_unit(Frame& F, int u) {
    const int c = u & 31, bg = u >> 5, b = bg >> 1, g = bg & 1, row0 = b * PL + c * CH;
    LAS unsigned char* X = F.lds; LAS unsigned char* BT = X + 64 * X_ST; LAS unsigned char* CT = BT + 64 * BC_ST; LAS unsigned char* CB = CT + 64 * BC_ST;
    LAS float* DT = (LAS float*)(CB + 64 * ATT_ST); LAS float* CUM = DT + 512; LAS float* red = CUM + 512;
    const int w = F.wave, r = F.lane & 15, q = F.lane >> 4, hd = g * 8 + w;
    { float dt, last; const float cum = ssd_head_scan(F, hd, row0, dt, last); DT[w * 64 + F.lane] = dt; CUM[w * 64 + F.lane] = cum; }
    for (int it = F.tid; it < 96 * 8; it += NTHR) ssd_conv_item<false>(F, b, g, c, it % 96, it / 96, X, BT, CT, nullptr);
    __syncthreads();
#pragma unroll
    for (int ff = 0; ff < 2; ++ff) { const int f = 2 * w + ff, sf = f >> 2, tf = f & 3; f32x4 a4 = (f32x4){0.f, 0.f, 0.f, 0.f};
        if (sf <= tf) {
#pragma unroll
            for (int ks = 0; ks < 4; ++ks) a4 = MFMA16(frag_k(BT, BC_ST, 16 * sf, 32 * ks, r, q), frag_k(CT, BC_ST, 16 * tf, 32 * ks, r, q), a4); }
        *(LAS v2u*)(CB + (16 * tf + r) * ATT_ST + (16 * sf + 4 * q) * 2) = pk4(a4); }
    __syncthreads();
    f32x4 acc[4][4];
#pragma unroll
    for (int i = 0; i < 4; ++i)
#pragma unroll
        for (int j = 0; j < 4; ++j) acc[i][j] = (f32x4){0.f, 0.f, 0.f, 0.f};
    const bf16* Hc = F.HC + ((size_t)u * 8 + w) * SP * SN;
#pragma unroll
    for (int ks = 0; ks < 4; ++ks) { bf16x8v bc[4];
#pragma unroll
        for (int tf = 0; tf < 4; ++tf) bc[tf] = frag_k(CT, BC_ST, 16 * tf, 32 * ks, r, q);
#pragma unroll
        for (int pf = 0; pf < 4; ++pf) { const bf16x8v a = *(const bf16x8v*)(Hc + (size_t)(16 * pf + r) * SN + 32 * ks + 8 * q);
#pragma unroll
            for (int tf = 0; tf < 4; ++tf) acc[pf][tf] = MFMA16(a, bc[tf], acc[pf][tf]); } }
    float ct[4];
#pragma unroll
    for (int tf = 0; tf < 4; ++tf) { ct[tf] = CUM[w * 64 + 16 * tf + r]; const float e = __expf(ct[tf]);
#pragma unroll
        for (int pf = 0; pf < 4; ++pf) acc[pf][tf] = acc[pf][tf] * e; }
#pragma unroll
    for (int ks = 0; ks < 2; ++ks) { bf16x8v ax[4];
#pragma unroll
        for (int pf = 0; pf < 4; ++pf) ax[pf] = frag_t(X, X_ST, 32 * ks, 64 * w + 16 * pf, r, q);
        const int s0 = 32 * ks + 8 * q;
        const f32x4 cs0 = *(const LAS f32x4*)(CUM + w * 64 + s0), cs1 = *(const LAS f32x4*)(CUM + w * 64 + s0 + 4), ds0 = *(const LAS f32x4*)(DT + w * 64 + s0), ds1 = *(const LAS f32x4*)(DT + w * 64 + s0 + 4);
        const float cs[8] = {cs0.x, cs0.y, cs0.z, cs0.w, cs1.x, cs1.y, cs1.z, cs1.w}, ds[8] = {ds0.x, ds0.y, ds0.z, ds0.w, ds1.x, ds1.y, ds1.z, ds1.w};
#pragma unroll
        for (int tf = 0; tf < 4; ++tf) { if (32 * ks > 16 * tf + 15) continue;
            const int t = 16 * tf + r; const v4u cb8 = *(const LAS v4u*)(CB + t * ATT_ST + s0 * 2); float l[8];
#pragma unroll
            for (int e = 0; e < 8; ++e) { const unsigned wd = cb8[e >> 1]; const float cbv = (e & 1) ? bfhi(wd) : bflo(wd); l[e] = (s0 + e <= t) ? cbv * __expf(ct[tf] - cs[e]) * ds[e] : 0.f; }
            const v4u lp = (v4u){pk2(l[0], l[1]), pk2(l[2], l[3]), pk2(l[4], l[5]), pk2(l[6], l[7])}; const bf16x8v bl = __builtin_bit_cast(bf16x8v, lp);
#pragma unroll
            for (int pf = 0; pf < 4; ++pf) acc[pf][tf] = MFMA16(ax[pf], bl, acc[pf][tf]); } }
    const float Dh = F.ssd_D[hd];
#pragma unroll
    for (int tf = 0; tf < 4; ++tf) { const int t = 16 * tf + r; const size_t row = (size_t)(row0 + t); float ss = 0.f;
#pragma unroll
        for (int pf = 0; pf < 4; ++pf) { const int p4 = 64 * w + 16 * pf + 4 * q;
            const v2u xv = *(const LAS v2u*)(X + t * X_ST + p4 * 2); const v2u zv = *(const v2u*)(F.PROJ + row * NP + CZ + g * 512 + p4);
            f32x4 y = acc[pf][tf];
            y.x = (y.x + Dh * bflo(xv.x)) * silu_f(bflo(zv.x)); y.y = (y.y + Dh * bfhi(xv.x)) * silu_f(bfhi(zv.x)); y.z = (y.z + Dh * bflo(xv.y)) * silu_f(bflo(zv.y)); y.w = (y.w + Dh * bfhi(xv.y)) * silu_f(bfhi(zv.y));
            acc[pf][tf] = y; ss += (y.x * y.x + y.y * y.y) + (y.z * y.z + y.w * y.w); }
        ss += __shfl_xor(ss, 16); ss += __shfl_xor(ss, 32);
        if (q == 0) red[w * 64 + t] = ss; }
    __syncthreads();
#pragma unroll
    for (int tf = 0; tf < 4; ++tf) { const int t = 16 * tf + r; const size_t row = (size_t)(row0 + t); float tot = 0.f;
#pragma unroll
        for (int ww = 0; ww < 8; ++ww) tot += red[ww * 64 + t];
        const float rr = rsqrtf(tot * (1.f / 512.f) + EPS);
#pragma unroll
        for (int pf = 0; pf < 4; ++pf) { const int p4 = g * 512 + 64 * w + 16 * pf + 4 * q; const f32x4 nw = *(const f32x4*)(F.ssd_norm + p4);
            f32x4 o = acc[pf][tf]; o.x *= rr * nw.x; o.y *= rr * nw.y; o.z *= rr * nw.z; o.w *= rr * nw.w;
            *(v2u*)(F.MIXIN + row * DM + 1024 + p4) = pk4(o); } }
    __syncthreads();
}

__device__ __forceinline__ void p2a_chunk_states(Frame& F) {
    for (int idx = F.bid; idx < 768; idx += F.G) { if (idx < 256) ssd_passA_unit(F, idx); else gla_passA_unit(F, idx - 256); }
}
__device__ __forceinline__ void p2b_scans_and_sample(Frame& F) {
    gla_scan(F); ssd_scan(F);
    for (int idx = F.bid; idx < SB * GH + SB * SG; idx += F.G) { if (idx < SB * GH) gla_direct_unit<1>(F, idx / GH, idx % GH); else ssd_direct_unit<1>(F, (idx - SB * GH) / SG, (idx - SB * GH) % SG); }
}
__device__ __forceinline__ void p2c_outputs(Frame& F) {
    for (int idx = F.bid; idx < 768; idx += F.G) { if (idx < 256) ssd_passC_unit(F, idx); else gla_passC_unit(F, idx - 256); }
    const int gt = F.bid * NTHR + F.tid, NT = F.G * NTHR;
    for (int i = gt; i < (PB + SB) * 3 * SCH; i += NT) { const int c = i % SCH, j = (i / SCH) % 3, s = i / (3 * SCH);
        const int grp = s >= PB, b = grp ? s - PB : s, L = grp ? SL : PL, row0 = grp ? MP + b * SL : b * PL;
        F.out[(grp ? O_SCONV_S : O_SCONV_P) + ((size_t)b * 3 + j) * SCH + c] = bf2f(F.PROJ[(size_t)(row0 + L - 3 + j) * NP + CX + c]); }
}

__device__ __forceinline__ void p4_post_mixer(Frame& F) {
    const int gw = F.bid * NWAVES + F.wave, NGW = F.G * NWAVES, lane = F.lane;
    for (int m = gw; m < M; m += NGW) {
        const f32x4* mr = (const f32x4*)(F.MIX + (size_t)m * DM) + lane; const f32x4* xr = (const f32x4*)x_row(F, m) + lane;
        const f32x4* w1 = (const f32x4*)F.n_mix_post + lane; const f32x4* w2 = (const f32x4*)F.n_ffn_pre + lane;
        f32x4 v[8]; float s = 0.f;
#pragma unroll
        for (int j = 0; j < 8; ++j) { v[j] = mr[64 * j]; s += (v[j].x * v[j].x + v[j].y * v[j].y) + (v[j].z * v[j].z + v[j].w * v[j].w); }
        const float r1 = rsqrtf(wave_sum(s) * (1.f / DM) + EPS); float s2 = 0.f;
        f32x4* ho = (f32x4*)(F.out + O_Y + (size_t)m * DM) + lane;
#pragma unroll
        for (int j = 0; j < 8; ++j) { v[j] = xr[64 * j] + v[j] * r1 * w1[64 * j]; ho[64 * j] = v[j]; s2 += (v[j].x * v[j].x + v[j].y * v[j].y) + (v[j].z * v[j].z + v[j].w * v[j].w); }
        const float r2 = rsqrtf(wave_sum(s2) * (1.f / DM) + EPS);
        v2u* o8 = (v2u*)(F.XN + (size_t)m * DM) + lane;
#pragma unroll
        for (int j = 0; j < 8; ++j) { const f32x4 ww = w2[64 * j]; v2u o; o.x = pk2(v[j].x * r2 * ww.x, v[j].y * r2 * ww.y); o.y = pk2(v[j].z * r2 * ww.z, v[j].w * r2 * ww.w); o8[64 * j] = o; }
    }
}
__device__ __forceinline__ float u_raw(const Frame& F, int grp, int b, int row0, int tt, int c) {
    if (tt >= 0) return bf2f(F.U[(size_t)(row0 + tt) * FF2 + c]);
    return grp ? F.st_fconv[((size_t)b * 2 + (tt + 2)) * FF2 + c] : 0.f;
}
__device__ __forceinline__ void p6_conv_act(Frame& F) {
    const int gt = F.bid * NTHR + F.tid, NT = F.G * NTHR;
    for (int i = gt; i < M * (FF / 2); i += NT) { const int c = (i % (FF / 2)) * 2, row = i / (FF / 2);
        const int grp = row >= MP, b = grp ? (row - MP) / SL : row / PL, row0 = grp ? MP + b * SL : b * PL, t = row - row0;
        float r[2];
#pragma unroll
        for (int e = 0; e < 2; ++e) { const int ca = c + e, cbb = FF + c + e; float a = F.fconv_b[ca], bb = F.fconv_b[cbb];
#pragma unroll
            for (int j = 0; j < 3; ++j) { a += F.fconv_w[j * FF2 + ca] * u_raw(F, grp, b, row0, t - 2 + j, ca); bb += F.fconv_w[j * FF2 + cbb] * u_raw(F, grp, b, row0, t - 2 + j, cbb); }
            r[e] = silu_f(a) * bb; }
        *(unsigned*)(F.ACT + (size_t)row * FF + c) = pk2(r[0], r[1]); }
    for (int i = gt; i < (PB + SB) * 2 * FF2; i += NT) { const int c = i % FF2, j = (i / FF2) % 2, s = i / (2 * FF2);
        const int grp = s >= PB, b = grp ? s - PB : s, L = grp ? SL : PL, row0 = grp ? MP + b * SL : b * PL;
        F.out[(grp ? O_FCONV_S : O_FCONV_P) + ((size_t)b * 2 + j) * FF2 + c] = bf2f(F.U[(size_t)(row0 + L - 2 + j) * FF2 + c]); }
}
__device__ __forceinline__ void p8_final(Frame& F) {
    const int gw = F.bid * NWAVES + F.wave, NGW = F.G * NWAVES, lane = F.lane;
    for (int m = gw; m < M; m += NGW) {
        const f32x4* fr = (const f32x4*)(F.Fb + (size_t)m * DM) + lane; const f32x4* w1 = (const f32x4*)F.n_ffn_post + lane;
        f32x4* ho = (f32x4*)(F.out + O_Y + (size_t)m * DM) + lane;
        f32x4 v[8]; float s = 0.f;
#pragma unroll
        for (int j = 0; j < 8; ++j) { v[j] = fr[64 * j]; s += (v[j].x * v[j].x + v[j].y * v[j].y) + (v[j].z * v[j].z + v[j].w * v[j].w); }
        const float r1 = rsqrtf(wave_sum(s) * (1.f / DM) + EPS);
#pragma unroll
        for (int j = 0; j < 8; ++j) ho[64 * j] = ho[64 * j] + v[j] * r1 * w1[64 * j];
    }
}

struct Args { const float* in[25]; float* out; unsigned char* ws; int ph_lo, ph_hi; };
__global__ void __launch_bounds__(NTHR, 2) fwd_kernel(Args args) {
    extern __shared__ __attribute__((aligned(16))) unsigned char lds[];
    Frame F;
    F.lds = (LAS unsigned char*)lds;
    F.tid = threadIdx.x; F.lane = F.tid & 63; F.wave = __builtin_amdgcn_readfirstlane(F.tid >> 6);
    F.G = gridDim.x; F.bid = blockIdx.x;
    unsigned char* ws = args.ws;
    F.x_p = args.in[0]; F.x_s = args.in[1]; F.st_gla = args.in[2]; F.st_ssd = args.in[3]; F.st_sconv = args.in[4]; F.st_fconv = args.in[5];
    F.n_mix_pre = args.in[6]; F.n_mix_post = args.in[7]; F.n_ffn_pre = args.in[8]; F.n_ffn_post = args.in[9]; F.w_in = args.in[10];
    F.w_gate2 = args.in[11]; F.b_gate = args.in[12]; F.gla_norm = args.in[13]; F.sconv_w = args.in[14]; F.sconv_b = args.in[15];
    F.dt_bias = args.in[16]; F.A_log = args.in[17]; F.ssd_D = args.in[18]; F.ssd_norm = args.in[19]; F.w_out = args.in[20];
    F.ffn_w_in = args.in[21]; F.fconv_w = args.in[22]; F.fconv_b = args.in[23]; F.ffn_w_out = args.in[24];
    F.out = args.out;
    F.W1 = (bf16*)(ws + WS_W1); F.WO = (bf16*)(ws + WS_WO); F.WF1 = (bf16*)(ws + WS_WF1); F.WF2 = (bf16*)(ws + WS_WF2);
    F.XN = (bf16*)(ws + WS_XN); F.PROJ = (bf16*)(ws + WS_PROJ); F.MIXIN = (bf16*)(ws + WS_MIXIN); F.U = (bf16*)(ws + WS_U); F.ACT = (bf16*)(ws + WS_ACT);
    F.LRDT = (float*)(ws + WS_LRDT); F.MIX = (float*)(ws + WS_MIX); F.Fb = (float*)(ws + WS_F);
    F.DS = (bf16*)(ws + WS_DS); F.SC = (bf16*)(ws + WS_SC); F.DH = (bf16*)(ws + WS_DH); F.HC = (bf16*)(ws + WS_HC); F.EBL = (float*)(ws + WS_EBL); F.AL = (float*)(ws + WS_AL);
    for (int u = F.tid; u < (LDS_BYTES - LDSCTL_OFF) / 4; u += NTHR) ((LAS unsigned*)(F.lds + LDSCTL_OFF))[u] = 0u;
    __syncthreads();
    const int lo = args.ph_lo, hi = args.ph_hi;
#if !MK_PER_PHASE
    XcdBarrier bar = xcd_barrier_post((unsigned*)(ws + WS_CTL) + CW_BAR, (volatile LAS unsigned*)(F.lds + MISC_OFF) + 8);
    bool first_bar = true;
#define GRID_BAR() do { if (first_bar) { first_bar = false; cg::this_grid().sync(); } xcd_barrier(bar); } while (0)
#else
#define GRID_BAR() do { } while (0)
#endif
#define IN(k) (lo <= (k) && (k) < hi)
#define SEAM(k) do { if (IN(k) && IN((k) + 1)) GRID_BAR(); } while (0)
    if (IN(0)) { p0_prologue(F); SEAM(0); }
    if (IN(1)) { pg8::Gemm g{F.XN, F.W1, M, N1, DM}; pg8::StaticOrder S; S.init(M, N1, F.G, F.bid);
        pg8::EpiBf16 E{F.PROJ, NP, NP / 256, F.LRDT};
        pg8::gemm_phase<pg8::EpiBf16, pg8::StaticOrder, true, true>(F.lds, g, S, E); SEAM(1); }
    if (IN(2)) { p2a_chunk_states(F); SEAM(2); }
    if (IN(3)) { p2b_scans_and_sample(F); SEAM(3); }
    if (IN(4)) { p2c_outputs(F); SEAM(4); }
    if (IN(5)) { pg8::Gemm g{F.MIXIN, F.WO, M, DM, DM}; pg8::StaticOrder S; S.init(M, DM, F.G, F.bid);
        pg8::EpiF32 E{F.MIX, DM};
        pg8::gemm_phase<pg8::EpiF32, pg8::StaticOrder, true, true>(F.lds, g, S, E); SEAM(5); }
    if (IN(6)) { p4_post_mixer(F); SEAM(6); }
    if (IN(7)) { pg8::Gemm g{F.XN, F.WF1, M, FF2, DM}; pg8::StaticOrder S; S.init(M, FF2, F.G, F.bid);
        pg8::EpiBf16 E{F.U, FF2, FF2 / 256, nullptr};
        pg8::gemm_phase<pg8::EpiBf16, pg8::StaticOrder, true, true>(F.lds, g, S, E); SEAM(7); }
    if (IN(8)) { p6_conv_act(F); SEAM(8); }
    if (IN(9)) { pg8::Gemm g{F.ACT, F.WF2, M, DM, FF}; pg8::StaticOrder S; S.init(M, DM, F.G, F.bid);
        pg8::EpiF32 E{F.Fb, DM};
        pg8::gemm_phase<pg8::EpiF32, pg8::StaticOrder, true, true>(F.lds, g, S, E); SEAM(9); }
    if (IN(10)) { p8_final(F); }
#undef IN
#undef SEAM
}

extern "C" void kernel_launch(void* const* d_in, const int* in_sizes, int n_in, void* d_out, int out_size, void* d_ws, size_t ws_size, hipStream_t stream) {
    static int grid = 0;
    if (grid == 0) {
        if (n_in != 25 || (size_t)out_size != O_END || ws_size < WS_END) { fprintf(stderr, "kernel_launch: unexpected sizes n_in %d out %d ws %zu (need out %zu ws %zu)\n", n_in, out_size, ws_size, (size_t)O_END, (size_t)WS_END); grid = -1; return; }
        int dev = 0, cus = 0, per_cu = 0;
        hipGetDevice(&dev); hipDeviceGetAttribute(&cus, hipDeviceAttributeMultiprocessorCount, dev);
        if (hipFuncSetAttribute((const void*)fwd_kernel, hipFuncAttributeMaxDynamicSharedMemorySize, LDS_BYTES) != hipSuccess) { fprintf(stderr, "kernel_launch: hipFuncSetAttribute failed\n"); grid = -1; return; }
        hipOccupancyMaxActiveBlocksPerMultiprocessor(&per_cu, (const void*)fwd_kernel, NTHR, LDS_BYTES);
        if (per_cu < 1) { fprintf(stderr, "kernel_launch: occupancy query says %d blocks per CU\n", per_cu); grid = -1; return; }
        grid = cus;
        (void)hipGetLastError();
    }
    if (grid < 0) return;
    Args a{};
    for (int i = 0; i < 25; ++i) a.in[i] = (const float*)d_in[i];
    a.out = (float*)d_out; a.ws = (unsigned char*)d_ws;
#if MK_PER_PHASE
    for (int p = 0; p < N_PHASES; ++p) { a.ph_lo = p; a.ph_hi = p + 1; hipLaunchKernelGGL(fwd_kernel, dim3(grid), dim3(NTHR), LDS_BYTES, stream, a); }
#else
    hipMemsetAsync((char*)d_ws + WS_CTL, 0, CTL_ZERO_BYTES, stream);
    a.ph_lo = 0; a.ph_hi = N_PHASES;
    void* kargs[] = {&a};
    hipError_t e = hipLaunchCooperativeKernel((const void*)fwd_kernel, dim3(grid), dim3(NTHR), kargs, LDS_BYTES, stream);
    if (e != hipSuccess) fprintf(stderr, "kernel_launch: cooperative launch failed: %s (grid %d)\n", hipGetErrorString(e), grid);
#endif
}
```

```cpp
#include <hip/hip_runtime.h>
#include <hip/hip_cooperative_groups.h>
#include <cstdio>
#include <cstdint>
namespace cg = cooperative_groups;

#ifndef MK_PER_PHASE
#define MK_PER_PHASE 0
#endif

namespace pg8 {
#define PG8_LAS __attribute__((address_space(3)))
typedef unsigned short bf16_t;
typedef short bf16x8 __attribute__((ext_vector_type(8)));
typedef float f32x4 __attribute__((ext_vector_type(4)));
typedef unsigned u32x4 __attribute__((ext_vector_type(4)));
constexpr int BM = 256, BK = 64, HALF = 128, HTB = HALF * BK * 2  , STAGE_BYTES = 8 * HTB, NXCD = 8, WGM = 8;

__host__ __device__ __forceinline__ int lds_byte(int r, int c) { const int st = (r >> 4) * 2 + (c >> 5), rr = r & 15, cc = c & 31, ob = rr * 64 + cc * 2; return st * 1024 + (ob ^ (((ob >> 9) & 1) << 5)); }
__host__ __device__ __forceinline__ void stage_rc(int b, int& R, int& C) { const int st = b / 1024, sb = b % 1024, swz = sb ^ (((sb >> 9) & 1) << 5); R = (st >> 1) * 16 + swz / 64; C = (st & 1) * 32 + (swz % 64) / 2; }
__host__ __device__ __forceinline__ int perm32(int rho) { const int n = rho >> 4, i = rho & 15; return 8 * (i >> 2) + 4 * n + (i & 3); }

struct Unit { int pm, pn; };
struct Gemm { const bf16_t* A; const bf16_t* Bt; int M, N, K; };

struct StaticOrder {
    int nM, nN, nwg, G, c;
    __host__ __device__ void init(int M, int N, int G_, int c_) { nM = M / BM; nN = N / BM; nwg = nM * nN; G = G_; c = c_; }
    __host__ __device__ bool next(int i, Unit& u) const {
        const long L = (long)i * G + c; if (L >= nwg) return false;
        int wgid = (int)L; { const int q = nwg / NXCD, r = nwg % NXCD, xcd = wgid % NXCD, off = wgid / NXCD; wgid = (xcd < r ? xcd * (q + 1) : r * (q + 1) + (xcd - r) * q) + off; }
        const int nig = WGM * nN, gid = wgid / nig, fm = gid * WGM, gsz = (nM - fm) < WGM ? (nM - fm) : WGM;
        u.pm = fm + ((wgid % nig) % gsz); u.pn = (wgid % nig) / gsz; return true;
    }
    __device__ __forceinline__ void a_ready(const Unit&) const {}
    __device__ __forceinline__ void done(const Unit&) const {}
};

__device__ __forceinline__ unsigned cvt_pk_bf16(float lo, float hi) { unsigned r; asm volatile("v_cvt_pk_bf16_f32 %0, %1, %2" : "=v"(r) : "v"(lo), "v"(hi)); return r; }

struct EpiF32 {
    static constexpr bool PERM = false, AFTER_DRAIN = false;
    float* C; int ldc;
    __device__ __forceinline__ void operator()(const f32x4 (&acc)[2][2][4][2], const Unit& u, int wr, int wc, int fr, int fq) const {
        const int row0 = u.pm * BM + wr * 64 + fr, col0 = u.pn * BM + wc * 32 + 4 * fq;
#pragma unroll
        for (int ai = 0; ai < 2; ++ai)
#pragma unroll
            for (int m = 0; m < 4; ++m) { float* rowp = C + (size_t)(row0 + ai * HALF + m * 16) * ldc + col0;
#pragma unroll
                for (int bj = 0; bj < 2; ++bj)
#pragma unroll
                    for (int n = 0; n < 2; ++n) *(f32x4*)(rowp + bj * HALF + n * 16) = acc[ai][bj][m][n]; }
    }
};
struct EpiBf16 {
    static constexpr bool PERM = true, AFTER_DRAIN = false;
    bf16_t* O; int ldc; int nfull; float* X;
    __device__ __forceinline__ void operator()(const f32x4 (&acc)[2][2][4][2], const Unit& u, int wr, int wc, int fr, int fq) const {
        const int row0 = u.pm * BM + wr * 64 + fr;
        if (u.pn < nfull) {
            const int col0 = u.pn * BM + wc * 32 + 8 * fq;
#pragma unroll
            for (int ai = 0; ai < 2; ++ai)
#pragma unroll
                for (int m = 0; m < 4; ++m) { bf16_t* rowp = O + (size_t)(row0 + ai * HALF + m * 16) * ldc + col0;
#pragma unroll
                    for (int bj = 0; bj < 2; ++bj) { const f32x4 v0 = acc[ai][bj][m][0], v1 = acc[ai][bj][m][1];
                        u32x4 w; w.x = cvt_pk_bf16(v0[0], v0[1]); w.y = cvt_pk_bf16(v0[2], v0[3]); w.z = cvt_pk_bf16(v1[0], v1[1]); w.w = cvt_pk_bf16(v1[2], v1[3]);
                        *(u32x4*)(rowp + bj * HALF) = w; } }
        } else if (wc == 0) {
#pragma unroll
            for (int ai = 0; ai < 2; ++ai)
#pragma unroll
                for (int m = 0; m < 4; ++m) { float* rowp = X + (size_t)(row0 + ai * HALF + m * 16) * 32 + 8 * fq;
                    *(f32x4*)(rowp) = acc[ai][0][m][0]; *(f32x4*)(rowp + 4) = acc[ai][0][m][1]; }
        }
    }
};

template <class Epi, class Sched, bool ALIGN_EPI = false, bool SP2 = false>
__device__ __forceinline__ void gemm_phase(PG8_LAS unsigned char* lds, const Gemm g, const Sched& S, const Epi& E) {
    const int tid = threadIdx.x, wid = __builtin_amdgcn_readfirstlane(tid >> 6), lane = tid & 63, wr = wid >> 2, wc = wid & 3, fr = lane & 15, fq = lane >> 4;
    const int K = g.K, nt = K / BK;
    unsigned voffA[2], voffB[2];
#pragma unroll
    for (int i = 0; i < 2; ++i) { int R, C; stage_rc(tid * 16 + i * 8192, R, C); const int Rb = Epi::PERM ? ((R & ~31) + perm32(R & 31)) : R;
        voffA[i] = (unsigned)(R * K + C) * 2u; voffB[i] = (unsigned)(Rb * K + C) * 2u; }
    const size_t kstep = (size_t)(BK * 2);
    const size_t hstep = (size_t)HALF * K * 2;
    const size_t tstep = 2 * hstep;
    const unsigned ldsw = (unsigned)wid * 1024u;
    const int aoff = lds_byte(wr * 64 + fr, fq * 8), boff = lds_byte(wc * 32 + fr, fq * 8);
#define PG8_SA(b, h) (((b) * 2 + (h)) * HTB)
#define PG8_SB(b, h) ((4 + (b) * 2 + (h)) * HTB)
#define PG8_STAGE(bufoff, gbase, voff) do { _Pragma("unroll") for (int _i = 0; _i < 2; ++_i) \
        __builtin_amdgcn_global_load_lds((const unsigned*)((const char*)(gbase) + (voff)[_i]), (PG8_LAS unsigned*)(lds + (bufoff) + ldsw + _i * 8192), 16, 0, 0); } while (0)
#define PG8_LDA(dst, b, h) do { _Pragma("unroll") for (int m = 0; m < 4; ++m) _Pragma("unroll") for (int k = 0; k < 2; ++k) dst[m][k] = *(const PG8_LAS bf16x8*)(lds + PG8_SA(b, h) + aoff + m * 2048 + k * 1024); } while (0)
#define PG8_LDB(dst, b, h) do { _Pragma("unroll") for (int n = 0; n < 2; ++n) _Pragma("unroll") for (int k = 0; k < 2; ++k) dst[n][k] = *(const PG8_LAS bf16x8*)(lds + PG8_SB(b, h) + boff + n * 2048 + k * 1024); } while (0)
#define PG8_MMA(ai, bj, At, Bt) do { __builtin_amdgcn_s_setprio(1); _Pragma("unroll") for (int m = 0; m < 4; ++m) _Pragma("unroll") for (int n = 0; n < 2; ++n) _Pragma("unroll") for (int k = 0; k < 2; ++k) \
        acc[ai][bj][m][n] = __builtin_amdgcn_mfma_f32_16x16x32_bf16(Bt[n][k], At[m][k], acc[ai][bj][m][n], 0, 0, 0); __builtin_amdgcn_s_setprio(0); } while (0)
#define PG8_WAIT_V(n) asm volatile("s_waitcnt vmcnt(" #n ")" ::: "memory")
#define PG8_WAIT_L(n) asm volatile("s_waitcnt lgkmcnt(" #n ")" ::: "memory")
#define PG8_BAR __builtin_amdgcn_s_barrier()
#define PG8_SCHED __builtin_amdgcn_sched_barrier(0)
    Unit cur, nxt; int ui = 0;
    if (!S.next(0, cur)) return;
    f32x4 acc[2][2][4][2];
#pragma unroll
    for (int a = 0; a < 2; ++a)
#pragma unroll
        for (int b = 0; b < 2; ++b)
#pragma unroll
            for (int m = 0; m < 4; ++m)
#pragma unroll
                for (int n = 0; n < 2; ++n) acc[a][b][m][n] = (f32x4){0.f, 0.f, 0.f, 0.f};
    bf16x8 At[4][2], B0[2][2], B1[2][2];
    const char* cA = (const char*)g.A + (size_t)cur.pm * tstep; const char* cB = (const char*)g.Bt + (size_t)cur.pn * tstep;
    S.a_ready(cur);
    if constexpr (SP2) {
        PG8_STAGE(PG8_SB(0, 0), cB, voffB); PG8_STAGE(PG8_SB(0, 1), cB + hstep, voffB); PG8_STAGE(PG8_SA(0, 0), cA, voffA); PG8_STAGE(PG8_SA(0, 1), cA + hstep, voffA);
        if (wr == 1) PG8_BAR;
        PG8_WAIT_V(2); PG8_BAR;
        PG8_STAGE(PG8_SB(1, 0), cB + kstep, voffB); PG8_STAGE(PG8_SA(1, 0), cA + kstep, voffA); PG8_STAGE(PG8_SB(1, 1), cB + hstep + kstep, voffB);
        PG8_WAIT_V(6); PG8_BAR;
    } else {
        PG8_STAGE(PG8_SB(0, 0), cB, voffB); PG8_STAGE(PG8_SA(0, 0), cA, voffA); PG8_STAGE(PG8_SB(0, 1), cB + hstep, voffB); PG8_STAGE(PG8_SA(0, 1), cA + hstep, voffA);
        if (wr == 1) PG8_BAR;
        PG8_WAIT_V(4); PG8_BAR;
        PG8_STAGE(PG8_SB(1, 0), cB + kstep, voffB); PG8_STAGE(PG8_SA(1, 0), cA + kstep, voffA); PG8_STAGE(PG8_SB(1, 1), cB + hstep + kstep, voffB);
        PG8_WAIT_V(6); PG8_BAR;
    }
    for (;;) {
        const bool has_next = S.next(ui + 1, nxt);
        const char* nA = has_next ? (const char*)g.A + (size_t)nxt.pm * tstep : cA; const char* nB = has_next ? (const char*)g.Bt + (size_t)nxt.pn * tstep : cB;
        for (int t = 0; t < nt; t += 2) {
            const bool last = (t == nt - 2);
            const char* a1 = cA + (size_t)(t + 1) * kstep;
            const char* a2 = last ? nA : cA + (size_t)(t + 2) * kstep; const char* b2 = last ? nB : cB + (size_t)(t + 2) * kstep;
            const char* a3 = a2 + kstep; const char* b3 = b2 + kstep;
            if (last && has_next) S.a_ready(nxt);
            if constexpr (SP2) {
            PG8_LDB(B0, 0, 0); PG8_LDB(B1, 0, 1); PG8_SCHED; PG8_LDA(At, 0, 0); PG8_STAGE(PG8_SA(1, 1), a1 + hstep, voffA);
            PG8_WAIT_V(8); PG8_WAIT_L(0); PG8_BAR; PG8_MMA(0, 0, At, B0); PG8_MMA(0, 1, At, B1); PG8_BAR; PG8_SCHED;
            PG8_LDA(At, 0, 1); PG8_STAGE(PG8_SB(0, 0), b2, voffB); PG8_STAGE(PG8_SB(0, 1), b2 + hstep, voffB); PG8_STAGE(PG8_SA(0, 0), a2, voffA);
            PG8_WAIT_V(8); PG8_WAIT_L(0); PG8_BAR; PG8_MMA(1, 0, At, B0); PG8_MMA(1, 1, At, B1); PG8_BAR; PG8_SCHED;
            PG8_LDB(B0, 1, 0); PG8_LDB(B1, 1, 1); PG8_SCHED; PG8_LDA(At, 1, 0); PG8_STAGE(PG8_SA(0, 1), a2 + hstep, voffA);
            PG8_WAIT_V(8); PG8_WAIT_L(0); PG8_BAR; PG8_MMA(0, 0, At, B0); PG8_MMA(0, 1, At, B1); PG8_BAR; PG8_SCHED;
            PG8_LDA(At, 1, 1); PG8_STAGE(PG8_SB(1, 0), b3, voffB); PG8_STAGE(PG8_SB(1, 1), b3 + hstep, voffB); PG8_STAGE(PG8_SA(1, 0), a3, voffA);
            PG8_WAIT_V(8); PG8_WAIT_L(0); PG8_BAR; PG8_MMA(1, 0, At, B0); PG8_MMA(1, 1, At, B1); PG8_BAR; PG8_SCHED;
            } else {
            PG8_LDB(B0, 0, 0); PG8_SCHED; PG8_LDA(At, 0, 0); PG8_STAGE(PG8_SA(1, 1), a1 + hstep, voffA);
            PG8_WAIT_L(8); PG8_BAR; PG8_WAIT_L(0); PG8_MMA(0, 0, At, B0); PG8_BAR; PG8_SCHED;
            PG8_LDB(B1, 0, 1); PG8_STAGE(PG8_SB(0, 0), b2, voffB);
            PG8_BAR; PG8_WAIT_L(0); PG8_MMA(0, 1, At, B1); PG8_BAR;
            PG8_LDA(At, 0, 1); PG8_STAGE(PG8_SA(0, 0), a2, voffA);
            PG8_BAR; PG8_WAIT_L(0); PG8_MMA(1, 0, At, B0); PG8_BAR; PG8_SCHED;
            PG8_STAGE(PG8_SB(0, 1), b2 + hstep, voffB);
            PG8_WAIT_V(6); PG8_BAR; PG8_MMA(1, 1, At, B1); PG8_BAR;
            PG8_LDB(B0, 1, 0); PG8_SCHED; PG8_LDA(At, 1, 0); PG8_STAGE(PG8_SA(0, 1), a2 + hstep, voffA);
            PG8_WAIT_L(8); PG8_BAR; PG8_WAIT_L(0); PG8_MMA(0, 0, At, B0); PG8_BAR; PG8_SCHED;
            PG8_LDB(B1, 1, 1); PG8_STAGE(PG8_SB(1, 0), b3, voffB);
            PG8_BAR; PG8_WAIT_L(0); PG8_MMA(0, 1, At, B1); PG8_BAR;
            PG8_LDA(At, 1, 1); PG8_STAGE(PG8_SA(1, 0), a3, voffA);
            PG8_BAR; PG8_WAIT_L(0); PG8_MMA(1, 0, At, B0); PG8_BAR; PG8_SCHED;
            PG8_STAGE(PG8_SB(1, 1), b3 + hstep, voffB);
            PG8_WAIT_V(6); PG8_BAR; PG8_MMA(1, 1, At, B1); PG8_BAR;
            }
        }
        if constexpr (ALIGN_EPI) { if (wr == 0) PG8_BAR; }
        if constexpr (!Epi::AFTER_DRAIN) { E(acc, cur, wr, wc, fr, fq); S.done(cur); }
        if (!has_next) break;
#pragma unroll
        for (int a = 0; a < 2; ++a)
#pragma unroll
            for (int b = 0; b < 2; ++b)
#pragma unroll
                for (int m = 0; m < 4; ++m)
#pragma unroll
                    for (int n = 0; n < 2; ++n) acc[a][b][m][n] = (f32x4){0.f, 0.f, 0.f, 0.f};
        cur = nxt; cA = nA; cB = nB; ++ui;
        if constexpr (ALIGN_EPI) { if (wr == 1) PG8_BAR; }
    }
    PG8_WAIT_V(0);
    if constexpr (!ALIGN_EPI) { if (wr == 0) PG8_BAR; }
    PG8_BAR;
    if constexpr (Epi::AFTER_DRAIN) { E.fused(acc, cur, wr, wc, fr, fq, lds, wid, lane); S.done(cur); }
#undef PG8_SA
#undef PG8_SB
#undef PG8_STAGE
#undef PG8_LDA
#undef PG8_LDB
#undef PG8_MMA
#undef PG8_WAIT_V
#undef PG8_WAIT_L
#undef PG8_BAR
#undef PG8_SCHED
}
}

constexpr int NWAVES = 8, NTHR = 512;
constexpr int DM = 2048, PB = 4, PL = 2048, SB = 128, SL = 8;
constexpr int MP = PB * PL, MS = SB * SL, M = MP + MS;
constexpr int GH = 4, GK = 128, GV = 256, GKD = 512, LOWR = 16;
constexpr int SH = 16, SP = 64, SN = 128, SG = 2, SCH = 1536;
constexpr int FF = 5632, FF2 = 11264, INC = 5664;
constexpr int N1 = 5888, NP = 5632;
constexpr int CQ = 0, CK = 512, CV = 1024, CG = 2048, CZ = 3072, CX = 4096;
constexpr float EPS = 1e-6f;
constexpr int N_PHASES = 11;

constexpr size_t O_Y = 0, O_GLA_P = (size_t)M * DM, O_SSD_P = O_GLA_P + (size_t)PB * GH * GK * GV, O_SCONV_P = O_SSD_P + (size_t)PB * SH * SP * SN,
                 O_FCONV_P = O_SCONV_P + (size_t)PB * 3 * SCH, O_GLA_S = O_FCONV_P + (size_t)PB * 2 * FF2, O_SSD_S = O_GLA_S + (size_t)SB * GH * GK * GV,
                 O_SCONV_S = O_SSD_S + (size_t)SB * SH * SP * SN, O_FCONV_S = O_SCONV_S + (size_t)SB * 3 * SCH, O_END = O_FCONV_S + (size_t)SB * 2 * FF2;

constexpr size_t MiB = 1u << 20;
constexpr size_t WS_CTL = 0, CTL_ZERO_BYTES = 64 * 1024;
constexpr size_t WS_WF2 = 1 * MiB;
constexpr size_t WS_W1 = 24 * MiB;
constexpr size_t WS_WO = 48 * MiB;
constexpr size_t WS_WF1 = 56 * MiB;
constexpr size_t WS_XN = 101 * MiB;
constexpr size_t WS_ACT = 24 * MiB;
constexpr size_t WS_BIG = 141 * MiB;
constexpr size_t WS_PROJ = WS_BIG;
constexpr size_t WS_MIX = WS_BIG;
constexpr size_t WS_U = WS_BIG;
constexpr size_t WS_F = WS_BIG;
constexpr size_t WS_LRDT = WS_BIG + 100 * MiB;
constexpr size_t WS_MIXIN = WS_BIG + 104 * MiB;
constexpr size_t WS_DS = WS_XN;
constexpr size_t WS_SC = WS_BIG + 140 * MiB, WS_DH = WS_BIG + 172 * MiB, WS_HC = WS_BIG + 204 * MiB;
constexpr size_t WS_EBL = WS_BIG + 236 * MiB, WS_AL = WS_EBL + 512 * 1024;
constexpr size_t WS_END = WS_BIG + 238 * MiB;
static_assert(WS_WF2 + (size_t)DM * FF * 2 <= WS_W1 && WS_W1 + (size_t)N1 * DM * 2 <= WS_WO && WS_WO + (size_t)DM * DM * 2 <= WS_WF1 && WS_WF1 + (size_t)FF2 * DM * 2 <= WS_XN && WS_XN + (size_t)M * DM * 2 <= WS_BIG, "ws map 1");
static_assert(WS_ACT + (size_t)M * FF * 2 <= WS_BIG && WS_PROJ + (size_t)M * NP * 2 <= WS_LRDT && WS_LRDT + (size_t)M * 32 * 4 <= WS_MIXIN && WS_MIXIN + (size_t)M * DM * 2 <= WS_SC && WS_U + (size_t)M * FF2 * 2 <= WS_END && WS_MIX + (size_t)M * DM * 4 <= WS_LRDT, "ws map 2");
constexpr int CW_BAR = 1024;

constexpr int RING_BYTES = 131072;
constexpr int LDSCTL_OFF = RING_BYTES, MISC_OFF = LDSCTL_OFF + 320;
constexpr int LDS_BYTES = 147456;

#define GAS __attribute__((address_space(1)))
#define LAS __attribute__((address_space(3)))
typedef unsigned short bf16;
typedef unsigned v4u __attribute__((ext_vector_type(4)));
typedef unsigned v2u __attribute__((ext_vector_type(2)));
typedef float f32x4 __attribute__((ext_vector_type(4)));
#define LDS_WAIT() asm volatile("s_waitcnt lgkmcnt(0)" ::: "memory")
#define VM_WAIT() asm volatile("s_waitcnt vmcnt(0)" ::: "memory")
__device__ __forceinline__ unsigned f2bf(float f) { unsigned u = __builtin_bit_cast(unsigned, f); return (u + 0x7fffu + ((u >> 16) & 1u)) >> 16; }
__device__ __forceinline__ unsigned pk2(float lo, float hi) { return f2bf(lo) | (f2bf(hi) << 16); }
__device__ __forceinline__ float bf2f(unsigned short b) { return __builtin_bit_cast(float, (unsigned)b << 16); }
__device__ __forceinline__ float bflo(unsigned w) { return __builtin_bit_cast(float, w << 16); }
__device__ __forceinline__ float bfhi(unsigned w) { return __builtin_bit_cast(float, w & 0xffff0000u); }
__device__ __forceinline__ float silu_f(float x) { return x / (1.f + __expf(-x)); }
__device__ __forceinline__ float softplus_f(float x) { return fmaxf(x, 0.f) + log1pf(__expf(-fabsf(x))); }
__device__ __forceinline__ float logsigmoid_f(float x) { return fminf(x, 0.f) - log1pf(__expf(-fabsf(x))); }
__device__ __forceinline__ float wave_sum(float v) {
#pragma unroll
    for (int o = 1; o < 64; o <<= 1) v += __shfl_xor(v, o);
    return v;
}

#define XB_TMO      128
#define XB_XCNT(j)  (256  + 64 * (j))
#define XB_XSUB(j)  (1280 + 64 * (j))
#define XB_XGEN(j)  (2304 + 64 * (j))
#define XB_TOP      3328
#define XB_TOPGEN   3392
#define XCD_BAR_WORDS 3456
#define XB_SPIN_CAP (1u << 18)

__device__ __forceinline__ unsigned xb_ld(unsigned* p)              { return __hip_atomic_load(p, __ATOMIC_RELAXED, __HIP_MEMORY_SCOPE_AGENT); }
__device__ __forceinline__ unsigned xb_add(unsigned* p, unsigned v) { return __hip_atomic_fetch_add(p, v, __ATOMIC_RELAXED, __HIP_MEMORY_SCOPE_AGENT); }
__device__ __forceinline__ unsigned xb_xcc_id() { return (unsigned)__builtin_amdgcn_s_getreg((3 << 11) | 20) & 0xFu; }
#define XB_SPIN(cond, bar) do { unsigned _sp = 0; while (cond) { __builtin_amdgcn_s_sleep(1); \
    if ((++_sp & 255u) == 0u) { if (xb_ld(&(bar)[XB_TMO])) break; if (_sp > XB_SPIN_CAP) { atomicAdd(&(bar)[XB_TMO], 1u); break; } } } } while (0)

struct XcdBarrier {
    unsigned* bar; unsigned x;
    volatile LAS unsigned* st;
};

__device__ __forceinline__ XcdBarrier xcd_barrier_post(unsigned* bar, volatile LAS unsigned* st) {
    XcdBarrier b; b.bar = bar; b.x = xb_xcc_id(); b.st = st;
    if (threadIdx.x == 0) (void)xb_add(&bar[XB_XCNT(b.x)], 1u);
    return b;
}
__device__ __forceinline__ void xcd_barrier_complete(unsigned* bar, unsigned x, unsigned& nloc, unsigned& nx) {
    const unsigned G = gridDim.x * gridDim.y * gridDim.z;
    unsigned sum, cnt, mine, sp = 0u;
    for (;;) {
        sum = 0u; cnt = 0u; mine = 0u;
#pragma unroll
        for (unsigned j = 0; j < 16; ++j) { const unsigned c = xb_ld(&bar[XB_XCNT(j)]); sum += c; cnt += (c > 0u) ? 1u : 0u; mine = (j == x) ? c : mine; }
        if (sum == G) break;
        __builtin_amdgcn_s_sleep(1);
        if ((++sp & 255u) == 0u) { if (xb_ld(&bar[XB_TMO])) break; if (sp > XB_SPIN_CAP) { atomicAdd(&bar[XB_TMO], 1u); break; } }
    }
    nloc = mine > 0u ? mine : 1u; nx = cnt > 0u ? cnt : 1u;
}

__device__ __forceinline__ void xcd_barrier(const XcdBarrier& b) {
    asm volatile("s_waitcnt vmcnt(0)" ::: "memory");
    __syncthreads();
    if (threadIdx.x == 0) {
        unsigned* bar = b.bar;
        __builtin_amdgcn_s_waitcnt(0);
        unsigned nloc = b.st[0], nx = b.st[1];
        if (nloc == 0u) { xcd_barrier_complete(bar, b.x, nloc, nx); b.st[0] = nloc; b.st[1] = nx; }
        const unsigned old = xb_add(&bar[XB_XSUB(b.x)], 1u);
        const unsigned gen = old / nloc;
        if (old + 1u == (gen + 1u) * nloc) {
            __builtin_amdgcn_fence(__ATOMIC_RELEASE, "agent");
            asm volatile("s_waitcnt vmcnt(0)" ::: "memory");
            const unsigned og = xb_add(&bar[XB_TOP], 1u);
            const unsigned tg = og / nx;
            if (og + 1u == (tg + 1u) * nx) xb_add(&bar[XB_TOPGEN], 1u);
            else XB_SPIN(xb_ld(&bar[XB_TOPGEN]) == tg, bar);
            __builtin_amdgcn_fence(__ATOMIC_ACQUIRE, "agent");
            xb_add(&bar[XB_XGEN(b.x)], 1u);
            asm volatile("s_waitcnt vmcnt(0)" ::: "memory");
        } else {
            XB_SPIN(xb_ld(&bar[XB_XGEN(b.x)]) == gen, bar);
            __builtin_amdgcn_fence(__ATOMIC_ACQUIRE, "agent");
            asm volatile("s_waitcnt vmcnt(0)" ::: "memory");
        }
    }
    __syncthreads();
}

struct Frame {
    LAS unsigned char* lds;
    int tid, lane, wave, G, bid;
    const float *x_p, *x_s, *st_gla, *st_ssd, *st_sconv, *st_fconv, *n_mix_pre, *n_mix_post, *n_ffn_pre, *n_ffn_post, *w_in, *w_gate2, *b_gate, *gla_norm,
                *sconv_w, *sconv_b, *dt_bias, *A_log, *ssd_D, *ssd_norm, *w_out, *ffn_w_in, *fconv_w, *fconv_b, *ffn_w_out;
    float* out;
    bf16 *W1, *WO, *WF1, *WF2, *XN, *PROJ, *MIXIN, *U, *ACT, *DS, *SC, *DH, *HC;
    float *LRDT, *MIX, *Fb, *EBL, *AL;
};
__device__ __forceinline__ const float* x_row(const Frame& F, int row) { return row < MP ? F.x_p + (size_t)row * DM : F.x_s + (size_t)(row - MP) * DM; }

__device__ __forceinline__ int w1_src_col(int n) { return n < 3072 ? n : (n < 5632 ? n + 16 : (n < 5648 ? n - 2560 : (n < 5664 ? n : -1))); }
template <bool MAP>
__device__ __forceinline__ void p0_transpose_item(const float* W, int K, int Nsrc, int Ndst, bf16* WT, LAS float* scr, int item, int lane) {
    const int nblk = Ndst / 32, kb = item / nblk, nb = item % nblk, k0 = 64 * kb, n0 = 32 * nb;
    int sc = n0 + (lane & 31); if (MAP) sc = w1_src_col(sc);
#pragma unroll 8
    for (int i = 0; i < 32; ++i) { const int kk = 2 * i + (lane >> 5); scr[kk * 33 + (lane & 31)] = (sc >= 0) ? W[(size_t)(k0 + kk) * Nsrc + sc] : 0.f; }
    LDS_WAIT(); asm volatile("" ::: "memory");
    const int c = lane & 7;
#pragma unroll
    for (int j = 0; j < 4; ++j) { const int n = (lane >> 3) + 8 * j; const LAS float* s = scr + (8 * c) * 33 + n;
        v4u o; o.x = pk2(s[0 * 33], s[1 * 33]); o.y = pk2(s[2 * 33], s[3 * 33]); o.z = pk2(s[4 * 33], s[5 * 33]); o.w = pk2(s[6 * 33], s[7 * 33]);
        *(v4u*)(WT + (size_t)(n0 + n) * K + k0 + 8 * c) = o; }
    LDS_WAIT(); asm volatile("" ::: "memory");
}
__device__ __forceinline__ void rms_row_to_bf16(const float* xrow, const float* w, bf16* orow, int lane) {
    const f32x4* xr = (const f32x4*)xrow + lane; const f32x4* wr = (const f32x4*)w + lane;
    f32x4 v[8]; float s = 0.f;
#pragma unroll
    for (int j = 0; j < 8; ++j) { v[j] = xr[64 * j]; s += (v[j].x * v[j].x + v[j].y * v[j].y) + (v[j].z * v[j].z + v[j].w * v[j].w); }
    const float r = rsqrtf(wave_sum(s) * (1.f / DM) + EPS);
    v2u* o8 = (v2u*)orow + lane;
#pragma unroll
    for (int j = 0; j < 8; ++j) { const f32x4 ww = wr[64 * j]; v2u o; o.x = pk2(v[j].x * r * ww.x, v[j].y * r * ww.y); o.y = pk2(v[j].z * r * ww.z, v[j].w * r * ww.w); o8[64 * j] = o; }
}
__device__ __forceinline__ void p0_prologue(Frame& F) {
    LAS float* scr = (LAS float*)(F.lds + F.wave * 16384);
    const int gw = F.bid * NWAVES + F.wave, NGW = F.G * NWAVES;
    constexpr int I_1 = (DM / 64) * (N1 / 32), I_O = (DM / 64) * (DM / 32), I_F1 = (DM / 64) * (FF2 / 32), I_F2 = (FF / 64) * (DM / 32);
    constexpr int NITEMS = I_1 + I_O + I_F1 + I_F2;
    for (int it = gw; it < NITEMS; it += NGW) {
        int r = it;
        if (r < I_1) { p0_transpose_item<true>(F.w_in, DM, INC, N1, F.W1, scr, r, F.lane); continue; } r -= I_1;
        if (r < I_O) { p0_transpose_item<false>(F.w_out, DM, DM, DM, F.WO, scr, r, F.lane); continue; } r -= I_O;
        if (r < I_F1) { p0_transpose_item<false>(F.ffn_w_in, DM, FF2, FF2, F.WF1, scr, r, F.lane); continue; } r -= I_F1;
        p0_transpose_item<false>(F.ffn_w_out, FF, DM, DM, F.WF2, scr, r, F.lane);
    }
    for (int m = gw; m < M; m += NGW) rms_row_to_bf16(x_row(F, m), F.n_mix_pre, F.XN + (size_t)m * DM, F.lane);
}

template <int grp> __device__ __forceinline__ void gla_direct_unit(Frame& F, int b, int h) {
    const int tid = F.tid, v = tid & 255, kh = tid >> 8;
    const int L = grp ? SL : PL, row0 = grp ? MP + b * SL : b * PL;
    LAS float* Es = (LAS float*)F.lds; LAS float* Ks = Es + 1024; LAS float* Qs = Ks + 1024; LAS float* Os = Qs + 1024;
    float S[64];
    if (grp) { const float* s0 = F.st_gla + ((size_t)(b * GH + h) * GK + kh * 64) * GV + v;
#pragma unroll
        for (int i = 0; i < 64; ++i) S[i] = s0[(size_t)i * GV]; }
    else {
#pragma unroll
        for (int i = 0; i < 64; ++i) S[i] = 0.f; }
    for (int t0 = 0; t0 < L; t0 += 8) {
        for (int it = tid; it < 1024; it += NTHR) { const int t = it >> 7, k = it & 127, row = row0 + t0 + t, hk = h * GK + k;
            float x = F.b_gate[hk]; const float* lr = F.LRDT + (size_t)row * 32;
#pragma unroll
            for (int j = 0; j < LOWR; ++j) x += lr[j] * F.w_gate2[j * GKD + hk];
            const float lg = logsigmoid_f(x) * (1.f / 16.f);
            Es[it] = __expf(lg); Ks[it] = bf2f(F.PROJ[(size_t)row * NP + CK + hk]); Qs[it] = bf2f(F.PROJ[(size_t)row * NP + CQ + hk]) * 0.08838834764831845f; }
        __syncthreads();
#pragma unroll 1
        for (int t = 0; t < 8; ++t) { const float vv = bf2f(F.PROJ[(size_t)(row0 + t0 + t) * NP + CV + h * GV + v]); float acc = 0.f;
            const LAS float* e = Es + t * 128 + kh * 64; const LAS float* kk = Ks + t * 128 + kh * 64; const LAS float* qq = Qs + t * 128 + kh * 64;
#pragma unroll
            for (int i = 0; i < 64; ++i) { S[i] = e[i] * S[i] + kk[i] * vv; acc += qq[i] * S[i]; }
            Os[(kh * 8 + t) * 256 + v] = acc; }
        __syncthreads();
        { const int t = F.wave, v4 = F.lane * 4, row = row0 + t0 + t;
            const f32x4 a = *(const LAS f32x4*)(Os + t * 256 + v4), c = *(const LAS f32x4*)(Os + (8 + t) * 256 + v4); const f32x4 o = a + c;
            const float ss = wave_sum((o.x * o.x + o.y * o.y) + (o.z * o.z + o.w * o.w)); const float r = rsqrtf(ss * (1.f / GV) + EPS);
            const v2u gw = *(const v2u*)(F.PROJ + (size_t)row * NP + CG + h * GV + v4); const f32x4 nw = *(const f32x4*)(F.gla_norm + v4);
            v2u w; w.x = pk2(o.x * r * nw.x * silu_f(bflo(gw.x)), o.y * r * nw.y * silu_f(bfhi(gw.x))); w.y = pk2(o.z * r * nw.z * silu_f(bflo(gw.y)), o.w * r * nw.w * silu_f(bfhi(gw.y)));
            *(v2u*)(F.MIXIN + (size_t)row * DM + h * GV + v4) = w; }
        __syncthreads();
    }
    float* so = F.out + (grp ? O_GLA_S : O_GLA_P) + ((size_t)(b * GH + h) * GK + kh * 64) * GV + v;
#pragma unroll
    for (int i = 0; i < 64; ++i) so[(size_t)i * GV] = S[i];
}
__device__ __forceinline__ float xbc_raw(const Frame& F, int grp, int b, int row0, int tt, int c) {
    if (tt >= 0) return bf2f(F.PROJ[(size_t)(row0 + tt) * NP + CX + c]);
    return grp ? F.st_sconv[((size_t)b * 3 + (tt + 3)) * SCH + c] : 0.f;
}
template <int grp> __device__ __forceinline__ void ssd_direct_unit(Frame& F, int b, int g) {
    const int tid = F.tid, hd = g * 8 + (tid >> 6), p = tid & 63, ch = g * 512 + tid;
    const int L = grp ? SL : PL, row0 = grp ? MP + b * SL : b * PL;
    LAS float* Bs = (LAS float*)F.lds; LAS float* Cs = Bs + 1024; LAS float* red = Cs + 1024; LAS float* Ys = red + 64;
    float h[128];
    if (grp) { const f32x4* h0 = (const f32x4*)(F.st_ssd + ((size_t)(b * SH + hd) * SP + p) * SN);
#pragma unroll
        for (int i = 0; i < 32; ++i) { const f32x4 q = h0[i]; h[4 * i] = q.x; h[4 * i + 1] = q.y; h[4 * i + 2] = q.z; h[4 * i + 3] = q.w; } }
    else {
#pragma unroll
        for (int i = 0; i < 128; ++i) h[i] = 0.f; }
    const float A = -__expf(F.A_log[hd]), dtb = F.dt_bias[hd], Dh = F.ssd_D[hd], nw = F.ssd_norm[ch];
    const float cb = F.sconv_b[ch], cw0 = F.sconv_w[ch], cw1 = F.sconv_w[SCH + ch], cw2 = F.sconv_w[2 * SCH + ch], cw3 = F.sconv_w[3 * SCH + ch];
    const int c2 = 1024 + (tid < 128 ? g * 128 + tid : 256 + g * 128 + ((tid - 128) & 127));
    float xr0 = xbc_raw(F, grp, b, row0, -3, ch), xr1 = xbc_raw(F, grp, b, row0, -2, ch), xr2 = xbc_raw(F, grp, b, row0, -1, ch);
    for (int t0 = 0; t0 < L; t0 += 8) {
        if (tid < 256) {
            float xr[11]; const float cb2 = F.sconv_b[c2], d0 = F.sconv_w[c2], d1 = F.sconv_w[SCH + c2], d2 = F.sconv_w[2 * SCH + c2], d3 = F.sconv_w[3 * SCH + c2];
#pragma unroll
            for (int i = 0; i < 11; ++i) xr[i] = xbc_raw(F, grp, b, row0, t0 - 3 + i, c2);
#pragma unroll
            for (int t = 0; t < 8; ++t) Bs[(tid >> 7) * 1024 + t * 128 + (tid & 127)] = silu_f(cb2 + d0 * xr[t] + d1 * xr[t + 1] + d2 * xr[t + 2] + d3 * xr[t + 3]);
        }
        __syncthreads();
#pragma unroll 1
        for (int t = 0; t < 8; ++t) { const int row = row0 + t0 + t;
            const float xn = bf2f(F.PROJ[(size_t)row * NP + CX + ch]);
            const float x = silu_f(cb + cw0 * xr0 + cw1 * xr1 + cw2 * xr2 + cw3 * xn); xr0 = xr1; xr1 = xr2; xr2 = xn;
            const float dt = softplus_f(F.LRDT[(size_t)row * 32 + 16 + hd] + dtb), a = __expf(dt * A), dtx = dt * x;
            float acc = 0.f; const LAS float* bb = Bs + t * 128; const LAS float* cc = Cs + t * 128;
#pragma unroll
            for (int nb = 0; nb < 128; nb += 16) {
#pragma unroll
                for (int n = nb; n < nb + 16; ++n) { h[n] = a * h[n] + dtx * bb[n]; acc += h[n] * cc[n]; }
                asm volatile("" ::: "memory"); }
            const float z = bf2f(F.PROJ[(size_t)row * NP + CZ + ch]);
            const float y = (acc + Dh * x) * silu_f(z);
            Ys[t * 512 + tid] = y;
            const float ss = wave_sum(y * y); if (F.lane == 0) red[t * 8 + F.wave] = ss; }
        __syncthreads();
#pragma unroll
        for (int t = 0; t < 8; ++t) { float tot = 0.f;
#pragma unroll
            for (int w = 0; w < 8; ++w) tot += red[t * 8 + w];
            const float r = rsqrtf(tot * (1.f / 512.f) + EPS);
            F.MIXIN[(size_t)(row0 + t0 + t) * DM + 1024 + ch] = (bf16)f2bf(Ys[t * 512 + tid] * r * nw); }
        __syncthreads();
    }
    f32x4* ho = (f32x4*)(F.out + (grp ? O_SSD_S : O_SSD_P) + ((size_t)(b * SH + hd) * SP + p) * SN);
#pragma unroll
    for (int i = 0; i < 32; ++i) ho[i] = (f32x4){h[4 * i], h[4 * i + 1], h[4 * i + 2], h[4 * i + 3]};
}
typedef short bf16x8v __attribute__((ext_vector_type(8)));
typedef short s16x4v __attribute__((ext_vector_type(4)));
constexpr int CH = 64, NCH = PL / CH;
constexpr int QE_ST = 272, KDT_ST = 144, V_ST = 544, ATT_ST = 144, X_ST = 1056, BC_ST = 288;
#define MFMA16(a, b, c) __builtin_amdgcn_mfma_f32_16x16x32_bf16((a), (b), (c), 0, 0, 0)
__device__ __forceinline__ bf16x8v frag_k(const LAS unsigned char* T, int stride, int idx0, int kk0, int r, int q) { return *(const LAS bf16x8v*)(T + (idx0 + r) * stride + (kk0 + 8 * q) * 2); }
__device__ __forceinline__ bf16x8v frag_t(const LAS unsigned char* T, int stride, int kk0, int idx0, int r, int q) {
    const LAS unsigned char* p = T + (kk0 + 8 * q + (r >> 2)) * stride + (idx0 + 4 * (r & 3)) * 2;
    const s16x4v lo = __builtin_amdgcn_ds_read_tr16_b64_v4i16((LAS s16x4v*)p), hi = __builtin_amdgcn_ds_read_tr16_b64_v4i16((LAS s16x4v*)(p + 4 * stride));
    return (bf16x8v){lo[0], lo[1], lo[2], lo[3], hi[0], hi[1], hi[2], hi[3]};
}
__device__ __forceinline__ v2u pk4(const f32x4 v) { v2u o; o.x = pk2(v.x, v.y); o.y = pk2(v.z, v.w); return o; }

template <int PASS>
__device__ __forceinline__ void gla_chunk_elem(Frame& F, int h, int row0, LAS unsigned char* T0, LAS unsigned char* T1, LAS float* tot, float* ebl_out) {
    const int tid = F.tid, k = tid & 127, tq = tid >> 7, hk = h * GK + k;
    float w2[16];
#pragma unroll
    for (int j = 0; j < 16; ++j) w2[j] = F.w_gate2[j * GKD + hk];
    const float bg = F.b_gate[hk];
    float lg[16]; float run = 0.f;
#pragma unroll
    for (int i = 0; i < 16; ++i) { const float* lr = F.LRDT + (size_t)(row0 + 16 * tq + i) * 32; float x = bg;
#pragma unroll
        for (int j = 0; j < 16; ++j) x += lr[j] * w2[j];
        run += logsigmoid_f(x) * (1.f / 16.f); lg[i] = run; }
    tot[tq * 128 + k] = run;
    __syncthreads();
    float off = 0.f, all = 0.f;
#pragma unroll
    for (int qq = 0; qq < 4; ++qq) { const float v = tot[qq * 128 + k]; all += v; off += (qq < tq) ? v : 0.f; }
    if (PASS == 0) {
        unsigned pk[8];
#pragma unroll
        for (int i = 0; i < 8; ++i) { const size_t ro = (size_t)(row0 + 16 * tq + 2 * i) * NP + CK + hk;
            const float k0 = bf2f(F.PROJ[ro]) * __expf(all - (off + lg[2 * i])), k1 = bf2f(F.PROJ[ro + NP]) * __expf(all - (off + lg[2 * i + 1])); pk[i] = pk2(k0, k1); }
        LAS v4u* d = (LAS v4u*)(T0 + k * KDT_ST + 32 * tq);
        d[0] = (v4u){pk[0], pk[1], pk[2], pk[3]}; d[1] = (v4u){pk[4], pk[5], pk[6], pk[7]};
        if (tq == 0) ebl_out[k] = __expf(all);
    } else {
#pragma unroll
        for (int i = 0; i < 16; ++i) { const int t = 16 * tq + i; const size_t ro = (size_t)(row0 + t) * NP + hk; const float bb = off + lg[i];
            *(LAS bf16*)(T0 + t * QE_ST + k * 2) = (bf16)f2bf(bf2f(F.PROJ[ro + CQ]) * 0.08838834764831845f * __expf(bb));
            *(LAS bf16*)(T1 + t * QE_ST + k * 2) = (bf16)f2bf(bf2f(F.PROJ[ro + CK]) * __expf(-bb)); }
    }
}
__device__ __forceinline__ void gla_load_v(Frame& F, int h, int row0, LAS unsigned char* V) {
#pragma unroll
    for (int i = 0; i < 4; ++i) { const int piece = F.tid + NTHR * i, row = piece >> 5, c16 = piece & 31;
        *(LAS v4u*)(V + row * V_ST + c16 * 16) = *(const v4u*)(F.PROJ + (size_t)(row0 + row) * NP + CV + h * GV + c16 * 8); }
}
__device__ __forceinline__ void gla_passA_unit(Frame& F, int u) {
    const int c = u & 31, bh = u >> 5, b = bh >> 2, h = bh & 3, row0 = b * PL + c * CH;
    LAS unsigned char* KDT = F.lds; LAS unsigned char* V = KDT + 128 * KDT_ST; LAS float* tot = (LAS float*)(V + 64 * V_ST);
    gla_load_v(F, h, row0, V);
    gla_chunk_elem<0>(F, h, row0, KDT, nullptr, tot, F.EBL + (size_t)u * 128);
    __syncthreads();
    const int w = F.wave, r = F.lane & 15, q = F.lane >> 4;
    f32x4 acc[8][2];
#pragma unroll
    for (int kf = 0; kf < 8; ++kf) { acc[kf][0] = (f32x4){0.f, 0.f, 0.f, 0.f}; acc[kf][1] = (f32x4){0.f, 0.f, 0.f, 0.f}; }
#pragma unroll
    for (int ks = 0; ks < 2; ++ks) { const bf16x8v b0 = frag_t(V, V_ST, 32 * ks, 32 * w, r, q), b1 = frag_t(V, V_ST, 32 * ks, 32 * w + 16, r, q);
#pragma unroll
        for (int kf = 0; kf < 8; ++kf) { const bf16x8v a = frag_k(KDT, KDT_ST, 16 * kf, 32 * ks, r, q); acc[kf][0] = MFMA16(a, b0, acc[kf][0]); acc[kf][1] = MFMA16(a, b1, acc[kf][1]); } }
#pragma unroll
    for (int kf = 0; kf < 8; ++kf)
#pragma unroll
        for (int vf = 0; vf < 2; ++vf) *(v2u*)(F.DS + ((size_t)u * GV + 32 * w + 16 * vf + r) * GK + 16 * kf + 4 * q) = pk4(acc[kf][vf]);
    __syncthreads();
}
__device__ __forceinline__ void gla_scan(Frame& F) {
    for (int it = F.bid * NTHR + F.tid; it < PB * GH * GV * 32; it += F.G * NTHR) { const int k4 = it & 31, v = (it >> 5) & 255, bh = it >> 13;
        f32x4 S = (f32x4){0.f, 0.f, 0.f, 0.f};
#pragma unroll 4
        for (int c = 0; c < NCH; ++c) { const int u = bh * NCH + c; const size_t off = ((size_t)u * GV + v) * GK + 4 * k4;
            const v2u d = *(const v2u*)(F.DS + off); const f32x4 e = *(const f32x4*)(F.EBL + (size_t)u * 128 + 4 * k4);
            *(v2u*)(F.SC + off) = pk4(S);
            S.x = e.x * S.x + bflo(d.x); S.y = e.y * S.y + bfhi(d.x); S.z = e.z * S.z + bflo(d.y); S.w = e.w * S.w + bfhi(d.y); }
        float* o = F.out + O_GLA_P + ((size_t)bh * GK + 4 * k4) * GV + v; o[0] = S.x; o[GV] = S.y; o[2 * GV] = S.z; o[3 * GV] = S.w; }
}
__device__ __forceinline__ void gla_passC_unit(Frame& F, int u) {
    const int c = u & 31, bh = u >> 5, b = bh >> 2, h = bh & 3, row0 = b * PL + c * CH;
    LAS unsigned char* QE = F.lds; LAS unsigned char* KE = QE + 64 * QE_ST; LAS unsigned char* V = KE + 64 * QE_ST; LAS unsigned char* ATT = V + 64 * V_ST;
    LAS float* tot = (LAS float*)(ATT + 64 * ATT_ST); LAS float* red = tot + 512;
    gla_load_v(F, h, row0, V);
    gla_chunk_elem<1>(F, h, row0, QE, KE, tot, nullptr);
    __syncthreads();
    const int w = F.wave, r = F.lane & 15, q = F.lane >> 4;
#pragma unroll
    for (int ff = 0; ff < 2; ++ff) { const int f = 2 * w + ff, sf = f >> 2, tf = f & 3; f32x4 a4 = (f32x4){0.f, 0.f, 0.f, 0.f};
        if (sf <= tf) {
#pragma unroll
            for (int ks = 0; ks < 4; ++ks) a4 = MFMA16(frag_k(KE, QE_ST, 16 * sf, 32 * ks, r, q), frag_k(QE, QE_ST, 16 * tf, 32 * ks, r, q), a4); }
        const int s0 = 16 * sf + 4 * q, t = 16 * tf + r;
        f32x4 m; m.x = (s0 <= t) ? a4.x : 0.f; m.y = (s0 + 1 <= t) ? a4.y : 0.f; m.z = (s0 + 2 <= t) ? a4.z : 0.f; m.w = (s0 + 3 <= t) ? a4.w : 0.f;
        *(LAS v2u*)(ATT + t * ATT_ST + s0 * 2) = pk4(m); }
    __syncthreads();
    const int tf = w & 3, vh = w >> 2;
    f32x4 acc[8];
#pragma unroll
    for (int i = 0; i < 8; ++i) acc[i] = (f32x4){0.f, 0.f, 0.f, 0.f};
    const bf16* Sc = F.SC + ((size_t)u * GV + 128 * vh) * GK;
#pragma unroll
    for (int ks = 0; ks < 4; ++ks) { const bf16x8v bq = frag_k(QE, QE_ST, 16 * tf, 32 * ks, r, q);
#pragma unroll
        for (int i = 0; i < 8; ++i) { const bf16x8v a = *(const bf16x8v*)(Sc + (size_t)(16 * i + r) * GK + 32 * ks + 8 * q); acc[i] = MFMA16(a, bq, acc[i]); } }
#pragma unroll
    for (int ks = 0; ks < 2; ++ks) { const bf16x8v ba = frag_k(ATT, ATT_ST, 16 * tf, 32 * ks, r, q);
#pragma unroll
        for (int i = 0; i < 8; ++i) { const bf16x8v a = frag_t(V, V_ST, 32 * ks, 128 * vh + 16 * i, r, q); acc[i] = MFMA16(a, ba, acc[i]); } }
    float ss = 0.f;
#pragma unroll
    for (int i = 0; i < 8; ++i) ss += (acc[i].x * acc[i].x + acc[i].y * acc[i].y) + (acc[i].z * acc[i].z + acc[i].w * acc[i].w);
    ss += __shfl_xor(ss, 16); ss += __shfl_xor(ss, 32);
    const int t = 16 * tf + r;
    if (q == 0) red[vh * 64 + t] = ss;
    __syncthreads();
    const float rr = rsqrtf((red[t] + red[64 + t]) * (1.f / GV) + EPS); const size_t row = (size_t)(row0 + t);
#pragma unroll
    for (int i = 0; i < 8; ++i) { const int v = 128 * vh + 16 * i + 4 * q;
        const v2u gw = *(const v2u*)(F.PROJ + row * NP + CG + h * GV + v); const f32x4 nw = *(const f32x4*)(F.gla_norm + v);
        f32x4 o; o.x = acc[i].x * rr * nw.x * silu_f(bflo(gw.x)); o.y = acc[i].y * rr * nw.y * silu_f(bfhi(gw.x)); o.z = acc[i].z * rr * nw.z * silu_f(bflo(gw.y)); o.w = acc[i].w * rr * nw.w * silu_f(bfhi(gw.y));
        *(v2u*)(F.MIXIN + row * DM + h * GV + v) = pk4(o); }
    __syncthreads();
}

template <bool SCALE>
__device__ __forceinline__ void ssd_conv_item(Frame& F, int b, int g, int c, int cg, int tb, LAS unsigned char* X, LAS unsigned char* BT, LAS unsigned char* CT, const LAS float* WDEC) {
    const int xc = cg < 64 ? g * 512 + 8 * cg : (cg < 80 ? 1024 + g * 128 + 8 * (cg - 64) : 1280 + g * 128 + 8 * (cg - 80));
    float w[4][8], bias[8];
#pragma unroll
    for (int j = 0; j < 4; ++j) { const f32x4 a = *(const f32x4*)(F.sconv_w + j * SCH + xc), bq = *(const f32x4*)(F.sconv_w + j * SCH + xc + 4);
        w[j][0] = a.x; w[j][1] = a.y; w[j][2] = a.z; w[j][3] = a.w; w[j][4] = bq.x; w[j][5] = bq.y; w[j][6] = bq.z; w[j][7] = bq.w; }
    { const f32x4 a = *(const f32x4*)(F.sconv_b + xc), bq = *(const f32x4*)(F.sconv_b + xc + 4); bias[0] = a.x; bias[1] = a.y; bias[2] = a.z; bias[3] = a.w; bias[4] = bq.x; bias[5] = bq.y; bias[6] = bq.z; bias[7] = bq.w; }
    v4u raw[11];
#pragma unroll
    for (int i = 0; i < 11; ++i) { const int tt = c * CH + tb * 8 - 3 + i;
        raw[i] = (tt >= 0) ? *(const v4u*)(F.PROJ + (size_t)(b * PL + tt) * NP + CX + xc) : (v4u){0u, 0u, 0u, 0u}; }
#pragma unroll
    for (int t = 0; t < 8; ++t) { float o[8];
#pragma unroll
        for (int e = 0; e < 8; ++e) { float a = bias[e];
#pragma unroll
            for (int j = 0; j < 4; ++j) { const unsigned wd = raw[t + j][e >> 1]; a += w[j][e] * ((e & 1) ? bfhi(wd) : bflo(wd)); }
            o[e] = silu_f(a); }
        const int tl = tb * 8 + t;
        if (SCALE && cg < 64) { const float sc = WDEC[(cg >> 3) * 64 + tl];
#pragma unroll
            for (int e = 0; e < 8; ++e) o[e] *= sc; }
        const v4u pkd = (v4u){pk2(o[0], o[1]), pk2(o[2], o[3]), pk2(o[4], o[5]), pk2(o[6], o[7])};
        LAS unsigned char* dst = cg < 64 ? X + tl * X_ST + cg * 16 : (cg < 80 ? BT + tl * BC_ST + (cg - 64) * 16 : CT + tl * BC_ST + (cg - 80) * 16);
        *(LAS v4u*)dst = pkd; }
}
__device__ __forceinline__ float ssd_head_scan(Frame& F, int hd, int row0, float& dt_out, float& last) {
    const float dt = softplus_f(F.LRDT[(size_t)(row0 + F.lane) * 32 + 16 + hd] + F.dt_bias[hd]);
    float cum = dt * (-__expf(F.A_log[hd]));
#pragma unroll
    for (int o = 1; o < 64; o <<= 1) { const float v = __shfl_up(cum, o); cum += (F.lane >= o) ? v : 0.f; }
    dt_out = dt; last = __shfl(cum, 63); return cum;
}
__device__ __forceinline__ void ssd_passA_unit(Frame& F, int u) {
    const int c = u & 31, bg = u >> 5, b = bg >> 1, g = bg & 1, row0 = b * PL + c * CH;
    LAS unsigned char* X = F.lds; LAS unsigned char* BT = X + 64 * X_ST; LAS float* WDEC = (LAS float*)(BT + 64 * BC_ST);
    const int w = F.wave, r = F.lane & 15, q = F.lane >> 4;
    { float dt, last; const float cum = ssd_head_scan(F, g * 8 + w, row0, dt, last);
        WDEC[w * 64 + F.lane] = __expf(last - cum) * dt; if (F.lane == 63) F.AL[(size_t)u * 8 + w] = __expf(last); }
    __syncthreads();
    for (int it = F.tid; it < 80 * 8; it += NTHR) ssd_conv_item<true>(F, b, g, c, it % 80, it / 80, X, BT, nullptr, WDEC);
    __syncthreads();
#pragma unroll 1
    for (int nh = 0; nh < 2; ++nh) {
        f32x4 acc[4][4];
#pragma unroll
        for (int i = 0; i < 4; ++i)
#pragma unroll
            for (int j = 0; j < 4; ++j) acc[i][j] = (f32x4){0.f, 0.f, 0.f, 0.f};
#pragma unroll
        for (int ks = 0; ks < 2; ++ks) { bf16x8v bp[4];
#pragma unroll
            for (int pf = 0; pf < 4; ++pf) bp[pf] = frag_t(X, X_ST, 32 * ks, 64 * w + 16 * pf, r, q);
#pragma unroll
            for (int nf = 0; nf < 4; ++nf) { const bf16x8v a = frag_t(BT, BC_ST, 32 * ks, 64 * nh + 16 * nf, r, q);
#pragma unroll
                for (int pf = 0; pf < 4; ++pf) acc[nf][pf] = MFMA16(a, bp[pf], acc[nf][pf]); } }
#pragma unroll
        for (int nf = 0; nf < 4; ++nf)
#pragma unroll
            for (int pf = 0; pf < 4; ++pf) *(v2u*)(F.DH + (((size_t)u * 8 + w) * SP + 16 * pf + r) * SN + 64 * nh + 16 * nf + 4 * q) = pk4(acc[nf][pf]);
    }
    __syncthreads();
}
__device__ __forceinline__ void ssd_scan(Frame& F) {
    for (int it = F.bid * NTHR + F.tid; it < PB * SH * SP * 32; it += F.G * NTHR) { const int n4 = it & 31, p = (it >> 5) & 63, bhd = it >> 11, b = bhd >> 4, hd = bhd & 15, g = hd >> 3, hl = hd & 7;
        f32x4 H = (f32x4){0.f, 0.f, 0.f, 0.f};
#pragma unroll 4
        for (int c = 0; c < NCH; ++c) { const int u = (b * 2 + g) * NCH + c; const size_t off = (((size_t)u * 8 + hl) * SP + p) * SN + 4 * n4;
            const v2u d = *(const v2u*)(F.DH + off); const float a = F.AL[(size_t)u * 8 + hl];
            *(v2u*)(F.HC + off) = pk4(H);
            H.x = a * H.x + bflo(d.x); H.y = a * H.y + bfhi(d.x); H.z = a * H.z + bflo(d.y); H.w = a * H.w + bfhi(d.y); }
        *(f32x4*)(F.out + O_SSD_P + ((size_t)bhd * SP + p) * SN + 4 * n4) = H; }
}
__device__ __forceinline__ void ssd_passC_unit(Frame& F, int u) {
    const int c = u & 31, bg = u >> 5, b = bg >> 1, g = bg & 1, row0 = b * PL + c * CH;
    LAS unsigned char* X = F.lds; LAS unsigned char* BT = X + 64 * X_ST; LAS unsigned char* CT = BT + 64 * BC_ST; LAS unsigned char* CB = CT + 64 * BC_ST;
    LAS float* DT = (LAS float*)(CB + 64 * ATT_ST); LAS float* CUM = DT + 512; LAS float* red = CUM + 512;
    const int w = F.wave, r = F.lane & 15, q = F.lane >> 4, hd = g * 8 + w;
    { float dt, last; const float cum = ssd_head_scan(F, hd, row0, dt, last); DT[w * 64 + F.lane] = dt; CUM[w * 64 + F.lane] = cum; }
    for (int it = F.tid; it < 96 * 8; it += NTHR) ssd_conv_item<false>(F, b, g, c, it % 96, it / 96, X, BT, CT, nullptr);
    __syncthreads();
#pragma unroll
    for (int ff = 0; ff < 2; ++ff) { const int f = 2 * w + ff, sf = f >> 2, tf = f & 3; f32x4 a4 = (f32x4){0.f, 0.f, 0.f, 0.f};
        if (sf <= tf) {
#pragma unroll
            for (int ks = 0; ks < 4; ++ks) a4 = MFMA16(frag_k(BT, BC_ST, 16 * sf, 32 * ks, r, q), frag_k(CT, BC_ST, 16 * tf, 32 * ks, r, q), a4); }
        *(LAS v2u*)(CB + (16 * tf + r) * ATT_ST + (16 * sf + 4 * q) * 2) = pk4(a4); }
    __syncthreads();
    f32x4 acc[4][4];
#pragma unroll
    for (int i = 0; i < 4; ++i)
#pragma unroll
        for (int j = 0; j < 4; ++j) acc[i][j] = (f32x4){0.f, 0.f, 0.f, 0.f};
    const bf16* Hc = F.HC + ((size_t)u * 8 + w) * SP * SN;
#pragma unroll
    for (int ks = 0; ks < 4; ++ks) { bf16x8v bc[4];
#pragma unroll
        for (int tf = 0; tf < 4; ++tf) bc[tf] = frag_k(CT, BC_ST, 16 * tf, 32 * ks, r, q);
#pragma unroll
        for (int pf = 0; pf < 4; ++pf) { const bf16x8v a = *(const bf16x8v*)(Hc + (size_t)(16 * pf + r) * SN + 32 * ks + 8 * q);
#pragma unroll
            for (int tf = 0; tf < 4; ++tf) acc[pf][tf] = MFMA16(a, bc[tf], acc[pf][tf]); } }
    float ct[4];
#pragma unroll
    for (int tf = 0; tf < 4; ++tf) { ct[tf] = CUM[w * 64 + 16 * tf + r]; const float e = __expf(ct[tf]);
#pragma unroll
        for (int pf = 0; pf < 4; ++pf) acc[pf][tf] = acc[pf][tf] * e; }
#pragma unroll
    for (int ks = 0; ks < 2; ++ks) { bf16x8v ax[4];
#pragma unroll
        for (int pf = 0; pf < 4; ++pf) ax[pf] = frag_t(X, X_ST, 32 * ks, 64 * w + 16 * pf, r, q);
        const int s0 = 32 * ks + 8 * q;
        const f32x4 cs0 = *(const LAS f32x4*)(CUM + w * 64 + s0), cs1 = *(const LAS f32x4*)(CUM + w * 64 + s0 + 4), ds0 = *(const LAS f32x4*)(DT + w * 64 + s0), ds1 = *(const LAS f32x4*)(DT + w * 64 + s0 + 4);
        const float cs[8] = {cs0.x, cs0.y, cs0.z, cs0.w, cs1.x, cs1.y, cs1.z, cs1.w}, ds[8] = {ds0.x, ds0.y, ds0.z, ds0.w, ds1.x, ds1.y, ds1.z, ds1.w};
#pragma unroll
        for (int tf = 0; tf < 4; ++tf) { if (32 * ks > 16 * tf + 15) continue;
            const int t = 16 * tf + r; const v4u cb8 = *(const LAS v4u*)(CB + t * ATT_ST + s0 * 2); float l[8];
#pragma unroll
            for (int e = 0; e < 8; ++e) { const unsigned wd = cb8[e >> 1]; const float cbv = (e & 1) ? bfhi(wd) : bflo(wd); l[e] = (s0 + e <= t) ? cbv * __expf(ct[tf] - cs[e]) * ds[e] : 0.f; }
            const v4u lp = (v4u){pk2(l[0], l[1]), pk2(l[2], l[3]), pk2(l[4], l[5]), pk2(l[6], l[7])}; const bf16x8v bl = __builtin_bit_cast(bf16x8v, lp);
#pragma unroll
            for (int pf = 0; pf < 4; ++pf) acc[pf][tf] = MFMA16(ax[pf], bl, acc[pf][tf]); } }
    const float Dh = F.ssd_D[hd];
#pragma unroll
    for (int tf = 0; tf < 4; ++tf) { const int t = 16 * tf + r; const size_t row = (size_t)(row0 + t); float ss = 0.f;
#pragma unroll
        for (int pf = 0; pf < 4; ++pf) { const int p4 = 64 * w + 16 * pf + 4 * q;
            const v2u xv = *(const LAS v2u*)(X + t * X_ST + p4 * 2); const v2u zv = *(const v2u*)(F.PROJ + row * NP + CZ + g * 512 + p4);
            f32x4 y = acc[pf][tf];
            y.x = (y.x + Dh * bflo(xv.x)) * silu_f(bflo(zv.x)); y.y = (y.y + Dh * bfhi(xv.x)) * silu_f(bfhi(zv.x)); y.z = (y.z + Dh * bflo(xv.y)) * silu_f(bflo(zv.y)); y.w = (y.w + Dh * bfhi(xv.y)) * silu_f(bfhi(zv.y));
            acc[pf][tf] = y; ss += (y.x * y.x + y.y * y.y) + (y.z * y.z + y.w * y.w); }
        ss += __shfl_xor(ss, 16); ss += __shfl_xor(ss, 32);
        if (q == 0) red[w * 64 + t] = ss; }
    __syncthreads();
#pragma unroll
    for (int tf = 0; tf < 4; ++tf) { const int t = 16 * tf + r; const size_t row = (size_t)(row0 + t); float tot = 0.f;
#pragma unroll
        for (int ww = 0; ww < 8; ++ww) tot += red[ww * 64 + t];
        const float rr = rsqrtf(tot * (1.f / 512.f) + EPS);
#pragma unroll
        for (int pf = 0; pf < 4; ++pf) { const int p4 = g * 512 + 64 * w + 16 * pf + 4 * q; const f32x4 nw = *(const f32x4*)(F.ssd_norm + p4);
            f32x4 o = acc[pf][tf]; o.x *= rr * nw.x; o.y *= rr * nw.y; o.z *= rr * nw.z; o.w *= rr * nw.w;
            *(v2u*)(F.MIXIN + row * DM + 1024 + p4) = pk4(o); } }
    __syncthreads();
}

__device__ __forceinline__ void p2a_chunk_states(Frame& F) {
    for (int idx = F.bid; idx < 768; idx += F.G) { if (idx < 256) ssd_passA_unit(F, idx); else gla_passA_unit(F, idx - 256); }
}
__device__ __forceinline__ void p2b_scans_and_sample(Frame& F) {
    gla_scan(F); ssd_scan(F);
    for (int idx = F.bid; idx < SB * GH + SB * SG; idx += F.G) { if (idx < SB * GH) gla_direct_unit<1>(F, idx / GH, idx % GH); else ssd_direct_unit<1>(F, (idx - SB * GH) / SG, (idx - SB * GH) % SG); }
}
__device__ __forceinline__ void p2c_outputs(Frame& F) {
    for (int idx = F.bid; idx < 768; idx += F.G) { if (idx < 256) ssd_passC_unit(F, idx); else gla_passC_unit(F, idx - 256); }
    const int gt = F.bid * NTHR + F.tid, NT = F.G * NTHR;
    for (int i = gt; i < (PB + SB) * 3 * SCH; i += NT) { const int c = i % SCH, j = (i / SCH) % 3, s = i / (3 * SCH);
        const int grp = s >= PB, b = grp ? s - PB : s, L = grp ? SL : PL, row0 = grp ? MP + b * SL : b * PL;
        F.out[(grp ? O_SCONV_S : O_SCONV_P) + ((size_t)b * 3 + j) * SCH + c] = bf2f(F.PROJ[(size_t)(row0 + L - 3 + j) * NP + CX + c]); }
}

__device__ __forceinline__ void p4_post_mixer(Frame& F) {
    const int gw = F.bid * NWAVES + F.wave, NGW = F.G * NWAVES, lane = F.lane;
    for (int m = gw; m < M; m += NGW) {
        const f32x4* mr = (const f32x4*)(F.MIX + (size_t)m * DM) + lane; const f32x4* xr = (const f32x4*)x_row(F, m) + lane;
        const f32x4* w1 = (const f32x4*)F.n_mix_post + lane; const f32x4* w2 = (const f32x4*)F.n_ffn_pre + lane;
        f32x4 v[8]; float s = 0.f;
#pragma unroll
        for (int j = 0; j < 8; ++j) { v[j] = mr[64 * j]; s += (v[j].x * v[j].x + v[j].y * v[j].y) + (v[j].z * v[j].z + v[j].w * v[j].w); }
        const float r1 = rsqrtf(wave_sum(s) * (1.f / DM) + EPS); float s2 = 0.f;
        f32x4* ho = (f32x4*)(F.out + O_Y + (size_t)m * DM) + lane;
#pragma unroll
        for (int j = 0; j < 8; ++j) { v[j] = xr[64 * j] + v[j] * r1 * w1[64 * j]; ho[64 * j] = v[j]; s2 += (v[j].x * v[j].x + v[j].y * v[j].y) + (v[j].z * v[j].z + v[j].w * v[j].w); }
        const float r2 = rsqrtf(wave_sum(s2) * (1.f / DM) + EPS);
        v2u* o8 = (v2u*)(F.XN + (size_t)m * DM) + lane;
#pragma unroll
        for (int j = 0; j < 8; ++j) { const f32x4 ww = w2[64 * j]; v2u o; o.x = pk2(v[j].x * r2 * ww.x, v[j].y * r2 * ww.y); o.y = pk2(v[j].z * r2 * ww.z, v[j].w * r2 * ww.w); o8[64 * j] = o; }
    }
}
__device__ __forceinline__ void u_row8(const Frame& F, int grp, int b, int row0, int tt, int c, float* o) {
    if (tt >= 0) { const v4u r = *(const v4u*)(F.U + (size_t)(row0 + tt) * FF2 + c);
        o[0] = bflo(r.x); o[1] = bfhi(r.x); o[2] = bflo(r.y); o[3] = bfhi(r.y); o[4] = bflo(r.z); o[5] = bfhi(r.z); o[6] = bflo(r.w); o[7] = bfhi(r.w); }
    else if (grp) { const f32x4* s = (const f32x4*)(F.st_fconv + ((size_t)b * 2 + (tt + 2)) * FF2 + c); const f32x4 a = s[0], d = s[1];
        o[0] = a.x; o[1] = a.y; o[2] = a.z; o[3] = a.w; o[4] = d.x; o[5] = d.y; o[6] = d.z; o[7] = d.w; }
    else {
#pragma unroll
        for (int e = 0; e < 8; ++e) o[e] = 0.f; }
}
__device__ __forceinline__ void ld8(const float* p, float* o) { const f32x4 a = *(const f32x4*)p, d = *(const f32x4*)(p + 4); o[0] = a.x; o[1] = a.y; o[2] = a.z; o[3] = a.w; o[4] = d.x; o[5] = d.y; o[6] = d.z; o[7] = d.w; }
__device__ __forceinline__ void p6_conv_act(Frame& F) {
    const int gt = F.bid * NTHR + F.tid, NT = F.G * NTHR;
    constexpr int NCG = FF / 8, NTB = M / 8;
    for (int it = gt; it < NTB * NCG; it += NT) { const int cg = it % NCG, tb = it / NCG, c = cg * 8, rowb = tb * 8;
        const int grp = rowb >= MP, b = grp ? (rowb - MP) / SL : rowb / PL, row0 = grp ? MP + b * SL : b * PL, t0 = rowb - row0;
        float wa[3][8], wb[3][8], ba[8], bb[8];
#pragma unroll
        for (int j = 0; j < 3; ++j) { ld8(F.fconv_w + j * FF2 + c, wa[j]); ld8(F.fconv_w + j * FF2 + FF + c, wb[j]); }
        ld8(F.fconv_b + c, ba); ld8(F.fconv_b + FF + c, bb);
        float a0[8], a1[8], a2[8], b0[8], b1[8], b2[8];
        u_row8(F, grp, b, row0, t0 - 2, c, a0); u_row8(F, grp, b, row0, t0 - 1, c, a1);
        u_row8(F, grp, b, row0, t0 - 2, FF + c, b0); u_row8(F, grp, b, row0, t0 - 1, FF + c, b1);
#pragma unroll
        for (int t = 0; t < 8; ++t) { u_row8(F, grp, b, row0, t0 + t, c, a2); u_row8(F, grp, b, row0, t0 + t, FF + c, b2);
            float r[8];
#pragma unroll
            for (int e = 0; e < 8; ++e) { const float a = ba[e] + wa[0][e] * a0[e] + wa[1][e] * a1[e] + wa[2][e] * a2[e], g = bb[e] + wb[0][e] * b0[e] + wb[1][e] * b1[e] + wb[2][e] * b2[e];
                r[e] = silu_f(a) * g; a0[e] = a1[e]; a1[e] = a2[e]; b0[e] = b1[e]; b1[e] = b2[e]; }
            *(v4u*)(F.ACT + (size_t)(rowb + t) * FF + c) = (v4u){pk2(r[0], r[1]), pk2(r[2], r[3]), pk2(r[4], r[5]), pk2(r[6], r[7])}; } }
    for (int i = gt; i < (PB + SB) * 2 * FF2; i += NT) { const int c = i % FF2, j = (i / FF2) % 2, s = i / (2 * FF2);
        const int grp = s >= PB, b = grp ? s - PB : s, L = grp ? SL : PL, row0 = grp ? MP + b * SL : b * PL;
        F.out[(grp ? O_FCONV_S : O_FCONV_P) + ((size_t)b * 2 + j) * FF2 + c] = bf2f(F.U[(size_t)(row0 + L - 2 + j) * FF2 + c]); }
}
__device__ __forceinline__ void p8_final(Frame& F) {
    const int gw = F.bid * NWAVES + F.wave, NGW = F.G * NWAVES, lane = F.lane;
    for (int m = gw; m < M; m += NGW) {
        const f32x4* fr = (const f32x4*)(F.Fb + (size_t)m * DM) + lane; const f32x4* w1 = (const f32x4*)F.n_ffn_post + lane;
        f32x4* ho = (f32x4*)(F.out + O_Y + (size_t)m * DM) + lane;
        f32x4 v[8]; float s = 0.f;
#pragma unroll
        for (int j = 0; j < 8; ++j) { v[j] = fr[64 * j]; s += (v[j].x * v[j].x + v[j].y * v[j].y) + (v[j].z * v[j].z + v[j].w * v[j].w); }
        const float r1 = rsqrtf(wave_sum(s) * (1.f / DM) + EPS);
#pragma unroll
        for (int j = 0; j < 8; ++j) ho[64 * j] = ho[64 * j] + v[j] * r1 * w1[64 * j];
    }
}

struct Args { const float* in[25]; float* out; unsigned char* ws; int ph_lo, ph_hi; };
__global__ void __launch_bounds__(NTHR, 2) fwd_kernel(Args args) {
    extern __shared__ __attribute__((aligned(16))) unsigned char lds[];
    Frame F;
    F.lds = (LAS unsigned char*)lds;
    F.tid = threadIdx.x; F.lane = F.tid & 63; F.wave = __builtin_amdgcn_readfirstlane(F.tid >> 6);
    F.G = gridDim.x; F.bid = blockIdx.x;
    unsigned char* ws = args.ws;
    F.x_p = args.in[0]; F.x_s = args.in[1]; F.st_gla = args.in[2]; F.st_ssd = args.in[3]; F.st_sconv = args.in[4]; F.st_fconv = args.in[5];
    F.n_mix_pre = args.in[6]; F.n_mix_post = args.in[7]; F.n_ffn_pre = args.in[8]; F.n_ffn_post = args.in[9]; F.w_in = args.in[10];
    F.w_gate2 = args.in[11]; F.b_gate = args.in[12]; F.gla_norm = args.in[13]; F.sconv_w = args.in[14]; F.sconv_b = args.in[15];
    F.dt_bias = args.in[16]; F.A_log = args.in[17]; F.ssd_D = args.in[18]; F.ssd_norm = args.in[19]; F.w_out = args.in[20];
    F.ffn_w_in = args.in[21]; F.fconv_w = args.in[22]; F.fconv_b = args.in[23]; F.ffn_w_out = args.in[24];
    F.out = args.out;
    F.W1 = (bf16*)(ws + WS_W1); F.WO = (bf16*)(ws + WS_WO); F.WF1 = (bf16*)(ws + WS_WF1); F.WF2 = (bf16*)(ws + WS_WF2);
    F.XN = (bf16*)(ws + WS_XN); F.PROJ = (bf16*)(ws + WS_PROJ); F.MIXIN = (bf16*)(ws + WS_MIXIN); F.U = (bf16*)(ws + WS_U); F.ACT = (bf16*)(ws + WS_ACT);
    F.LRDT = (float*)(ws + WS_LRDT); F.MIX = (float*)(ws + WS_MIX); F.Fb = (float*)(ws + WS_F);
    F.DS = (bf16*)(ws + WS_DS); F.SC = (bf16*)(ws + WS_SC); F.DH = (bf16*)(ws + WS_DH); F.HC = (bf16*)(ws + WS_HC); F.EBL = (float*)(ws + WS_EBL); F.AL = (float*)(ws + WS_AL);
    for (int u = F.tid; u < (LDS_BYTES - LDSCTL_OFF) / 4; u += NTHR) ((LAS unsigned*)(F.lds + LDSCTL_OFF))[u] = 0u;
    __syncthreads();
    const int lo = args.ph_lo, hi = args.ph_hi;
#if !MK_PER_PHASE
    XcdBarrier bar = xcd_barrier_post((unsigned*)(ws + WS_CTL) + CW_BAR, (volatile LAS unsigned*)(F.lds + MISC_OFF) + 8);
    bool first_bar = true;
#define GRID_BAR() do { if (first_bar) { first_bar = false; cg::this_grid().sync(); } xcd_barrier(bar); } while (0)
#else
#define GRID_BAR() do { } while (0)
#endif
#define IN(k) (lo <= (k) && (k) < hi)
#define SEAM(k) do { if (IN(k) && IN((k) + 1)) GRID_BAR(); } while (0)
#ifndef MK_REP_PHASE
#define MK_REP_PHASE (-1)
#endif
#define PHASE(k, ...) do { if (IN(k)) { if (MK_REP_PHASE == (k)) { __VA_ARGS__; GRID_BAR(); } __VA_ARGS__; SEAM(k); } } while (0)
    PHASE(0, p0_prologue(F));
    PHASE(1, { pg8::Gemm g{F.XN, F.W1, M, N1, DM}; pg8::StaticOrder S; S.init(M, N1, F.G, F.bid);
        pg8::EpiBf16 E{F.PROJ, NP, NP / 256, F.LRDT};
        pg8::gemm_phase<pg8::EpiBf16, pg8::StaticOrder, true, true>(F.lds, g, S, E); });
    PHASE(2, p2a_chunk_states(F));
    PHASE(3, p2b_scans_and_sample(F));
    PHASE(4, p2c_outputs(F));
    PHASE(5, { pg8::Gemm g{F.MIXIN, F.WO, M, DM, DM}; pg8::StaticOrder S; S.init(M, DM, F.G, F.bid);
        pg8::EpiF32 E{F.MIX, DM};
        pg8::gemm_phase<pg8::EpiF32, pg8::StaticOrder, true, true>(F.lds, g, S, E); });
    PHASE(6, p4_post_mixer(F));
    PHASE(7, { pg8::Gemm g{F.XN, F.WF1, M, FF2, DM}; pg8::StaticOrder S; S.init(M, FF2, F.G, F.bid);
        pg8::EpiBf16 E{F.U, FF2, FF2 / 256, nullptr};
        pg8::gemm_phase<pg8::EpiBf16, pg8::StaticOrder, true, true>(F.lds, g, S, E); });
    PHASE(8, p6_conv_act(F));
    PHASE(9, { pg8::Gemm g{F.ACT, F.WF2, M, DM, FF}; pg8::StaticOrder S; S.init(M, DM, F.G, F.bid);
        pg8::EpiF32 E{F.Fb, DM};
        pg8::gemm_phase<pg8::EpiF32, pg8::StaticOrder, true, true>(F.lds, g, S, E); });
    if (IN(10)) { p8_final(F); }
#undef IN
#undef SEAM
}

extern "C" void kernel_launch(void* const* d_in, const int* in_sizes, int n_in, void* d_out, int out_size, void* d_ws, size_t ws_size, hipStream_t stream) {
    static int grid = 0;
    if (grid == 0) {
        if (n_in != 25 || (size_t)out_size != O_END || ws_size < WS_END) { fprintf(stderr, "kernel_launch: unexpected sizes n_in %d out %d ws %zu (need out %zu ws %zu)\n", n_in, out_size, ws_size, (size_t)O_END, (size_t)WS_END); grid = -1; return; }
        int dev = 0, cus = 0, per_cu = 0;
        hipGetDevice(&dev); hipDeviceGetAttribute(&cus, hipDeviceAttributeMultiprocessorCount, dev);
        if (hipFuncSetAttribute((const void*)fwd_kernel, hipFuncAttributeMaxDynamicSharedMemorySize, LDS_BYTES) != hipSuccess) { fprintf(stderr, "kernel_launch: hipFuncSetAttribute failed\n"); grid = -1; return; }
        hipOccupancyMaxActiveBlocksPerMultiprocessor(&per_cu, (const void*)fwd_kernel, NTHR, LDS_BYTES);
        if (per_cu < 1) { fprintf(stderr, "kernel_launch: occupancy query says %d blocks per CU\n", per_cu); grid = -1; return; }
        grid = cus;
        (void)hipGetLastError();
    }
    if (grid < 0) return;
    Args a{};
    for (int i = 0; i < 25; ++i) a.in[i] = (const float*)d_in[i];
    a.out = (float*)d_out; a.ws = (unsigned char*)d_ws;
#if MK_PER_PHASE
    for (int p = 0; p < N_PHASES; ++p) { a.ph_lo = p; a.ph_hi = p + 1; hipLaunchKernelGGL(fwd_kernel, dim3(grid), dim3(NTHR), LDS_BYTES, stream, a); }
#else
    hipMemsetAsync((char*)d_ws + WS_CTL, 0, CTL_ZERO_BYTES, stream);
    a.ph_lo = 0; a.ph_hi = N_PHASES;
    void* kargs[] = {&a};
    hipError_t e = hipLaunchCooperativeKernel((const void*)fwd_kernel, dim3(grid), dim3(NTHR), kargs, LDS_BYTES, stream);
    if (e != hipSuccess) fprintf(stderr, "kernel_launch: cooperative launch failed: %s (grid %d)\n", hipGetErrorString(e), grid);
#endif
}
```

```cpp
#include <hip/hip_runtime.h>
#include <hip/hip_cooperative_groups.h>
#include <cstdio>
#include <cstdint>
namespace cg = cooperative_groups;

#ifndef MK_PER_PHASE
#define MK_PER_PHASE 0
#endif

namespace pg8 {
#define PG8_LAS __attribute__((address_space(3)))
typedef unsigned short bf16_t;
typedef short bf16x8 __attribute__((ext_vector_type(8)));
typedef float f32x4 __attribute__((ext_vector_type(4)));
typedef unsigned u32x4 __attribute__((ext_vector_type(4)));
constexpr int BM = 256, BK = 64, HALF = 128, HTB = HALF * BK * 2  , STAGE_BYTES = 8 * HTB, NXCD = 8, WGM = 8;

__host__ __device__ __forceinline__ int lds_byte(int r, int c) { const int st = (r >> 4) * 2 + (c >> 5), rr = r & 15, cc = c & 31, ob = rr * 64 + cc * 2; return st * 1024 + (ob ^ (((ob >> 9) & 1) << 5)); }
__host__ __device__ __forceinline__ void stage_rc(int b, int& R, int& C) { const int st = b / 1024, sb = b % 1024, swz = sb ^ (((sb >> 9) & 1) << 5); R = (st >> 1) * 16 + swz / 64; C = (st & 1) * 32 + (swz % 64) / 2; }
__host__ __device__ __forceinline__ int perm32(int rho) { const int n = rho >> 4, i = rho & 15; return 8 * (i >> 2) + 4 * n + (i & 3); }

struct Unit { int pm, pn, k0, nk, slice, nsl, tix; };
struct Gemm { const bf16_t* A; const bf16_t* Bt; int M, N, K; };

struct StaticOrder {
    int nM, nN, nwg, G, c, rounds, rem, S, ntK;
    __host__ __device__ __forceinline__ void init(int M, int N, int K, int G_, int c_, int Smax) { nM = M / BM; nN = N / BM; nwg = nM * nN; G = G_; c = c_; ntK = K / BK; rounds = nwg / G; rem = nwg - rounds * G; S = 1;
        if (rem) { while (S < Smax && rem * (S * 2) <= G && (ntK / 2) >= S * 2) S *= 2; } }
    __host__ __device__ __forceinline__ void tile(int L, Unit& u) const {
        int wgid = L; { const int q = nwg / NXCD, r = nwg % NXCD, xcd = wgid % NXCD, off = wgid / NXCD; wgid = (xcd < r ? xcd * (q + 1) : r * (q + 1) + (xcd - r) * q) + off; }
        const int nig = WGM * nN, gid = wgid / nig, fm = gid * WGM, gsz = (nM - fm) < WGM ? (nM - fm) : WGM;
        u.pm = fm + ((wgid % nig) % gsz); u.pn = (wgid % nig) / gsz; }
    __host__ __device__ __forceinline__ bool next(int i, Unit& u) const {
        if (i < rounds) { tile(i * G + c, u); u.k0 = 0; u.nk = ntK; u.slice = 0; u.nsl = 1; u.tix = 0; return true; }
        if (i == rounds && c < rem * S) { const int tix = c % rem, sl = c / rem; tile(rounds * G + tix, u);
            const int pairs = ntK / 2, base = pairs / S, extra = pairs % S, np = base + (sl < extra ? 1 : 0), p0 = sl * base + (sl < extra ? sl : extra);
            u.k0 = 2 * p0; u.nk = 2 * np; u.slice = sl; u.nsl = S; u.tix = tix; return true; }
        return false;
    }
    __device__ __forceinline__ void a_ready(const Unit&) const {}
    __device__ __forceinline__ void done(const Unit&) const {}
};
struct SplitCtx { f32x4* slabs; unsigned* cnt; volatile PG8_LAS unsigned* flag; };
__device__ __forceinline__ int split_reduce(f32x4 (&acc)[2][2][4][2], const Unit& u, const SplitCtx& X, int tid) {
    const __amdgpu_buffer_rsrc_t rs = __builtin_amdgcn_make_buffer_rsrc((void*)X.slabs, (short)0, (int)0x7fffffff, 0x00020000);
    const unsigned mine = (unsigned)((u.tix * u.nsl + u.slice) * 32) * 8192u + (unsigned)tid * 16u;
#pragma unroll
    for (int a = 0; a < 2; ++a)
#pragma unroll
        for (int b = 0; b < 2; ++b)
#pragma unroll
            for (int m = 0; m < 4; ++m)
#pragma unroll
                for (int n = 0; n < 2; ++n) __builtin_amdgcn_raw_buffer_store_b128(__builtin_bit_cast(u32x4, acc[a][b][m][n]), rs, mine + (unsigned)((((a * 2 + b) * 4 + m) * 2 + n) * 8192), 0,   16);
    asm volatile("s_waitcnt vmcnt(0)" ::: "memory");
    __syncthreads();
    if (tid == 0) {
        unsigned* c = X.cnt + 16 * u.tix;
        (void)__hip_atomic_fetch_add(c, 1u, __ATOMIC_RELAXED, __HIP_MEMORY_SCOPE_AGENT);
        unsigned spins = 0;
        while (__hip_atomic_load(c, __ATOMIC_RELAXED, __HIP_MEMORY_SCOPE_AGENT) < (unsigned)u.nsl) { __builtin_amdgcn_s_sleep(2); if (++spins > (1u << 22)) break; }
        __builtin_amdgcn_fence(__ATOMIC_ACQUIRE, "agent");
        asm volatile("s_waitcnt vmcnt(0)" ::: "memory");
    }
    __syncthreads();
    const int shift = u.nsl == 8 ? 2 : (u.nsl == 4 ? 3 : 4);
    for (int s = 0; s < u.nsl; ++s) { if (s == u.slice) continue;
        const f32x4* o = X.slabs + ((size_t)(u.tix * u.nsl + s) * 32) * 512 + tid;
#pragma unroll
        for (int a = 0; a < 2; ++a)
#pragma unroll
            for (int b = 0; b < 2; ++b)
#pragma unroll
                for (int m = 0; m < 4; ++m)
#pragma unroll
                    for (int n = 0; n < 2; ++n) { const int r4 = ((a * 2 + b) * 4 + m) * 2 + n; if ((r4 >> shift) == u.slice) acc[a][b][m][n] += o[(size_t)r4 * 512]; } }
    return shift;
}

__device__ __forceinline__ unsigned cvt_pk_bf16(float lo, float hi) { unsigned r; asm volatile("v_cvt_pk_bf16_f32 %0, %1, %2" : "=v"(r) : "v"(lo), "v"(hi)); return r; }

struct EpiF32 {
    static constexpr bool PERM = false, AFTER_DRAIN = false;
    float* C; int ldc;
    __device__ __forceinline__ void operator()(const f32x4 (&acc)[2][2][4][2], const Unit& u, int wr, int wc, int fr, int fq, int shift, int part) const {
        const int row0 = u.pm * BM + wr * 64 + fr, col0 = u.pn * BM + wc * 32 + 4 * fq;
#pragma unroll
        for (int ai = 0; ai < 2; ++ai)
#pragma unroll
            for (int m = 0; m < 4; ++m) { float* rowp = C + (size_t)(row0 + ai * HALF + m * 16) * ldc + col0;
#pragma unroll
                for (int bj = 0; bj < 2; ++bj)
#pragma unroll
                    for (int n = 0; n < 2; ++n) if ((((((ai * 2 + bj) * 4 + m) * 2 + n)) >> shift) == part) *(f32x4*)(rowp + bj * HALF + n * 16) = acc[ai][bj][m][n]; }
    }
};
struct EpiBf16 {
    static constexpr bool PERM = true, AFTER_DRAIN = false;
    bf16_t* O; int ldc; int nfull; float* X;
    __device__ __forceinline__ void operator()(const f32x4 (&acc)[2][2][4][2], const Unit& u, int wr, int wc, int fr, int fq, int shift, int part) const {
        const int row0 = u.pm * BM + wr * 64 + fr;
        if (u.pn < nfull) {
            const int col0 = u.pn * BM + wc * 32 + 8 * fq;
#pragma unroll
            for (int ai = 0; ai < 2; ++ai)
#pragma unroll
                for (int m = 0; m < 4; ++m) { bf16_t* rowp = O + (size_t)(row0 + ai * HALF + m * 16) * ldc + col0;
#pragma unroll
                    for (int bj = 0; bj < 2; ++bj) { if ((((((ai * 2 + bj) * 4 + m) * 2)) >> shift) != part) continue; const f32x4 v0 = acc[ai][bj][m][0], v1 = acc[ai][bj][m][1];
                        u32x4 w; w.x = cvt_pk_bf16(v0[0], v0[1]); w.y = cvt_pk_bf16(v0[2], v0[3]); w.z = cvt_pk_bf16(v1[0], v1[1]); w.w = cvt_pk_bf16(v1[2], v1[3]);
                        *(u32x4*)(rowp + bj * HALF) = w; } }
        } else if (wc == 0) {
#pragma unroll
            for (int ai = 0; ai < 2; ++ai)
#pragma unroll
                for (int m = 0; m < 4; ++m) { if ((((((ai * 2) * 4 + m) * 2)) >> shift) != part) continue; float* rowp = X + (size_t)(row0 + ai * HALF + m * 16) * 32 + 8 * fq;
                    *(f32x4*)(rowp) = acc[ai][0][m][0]; *(f32x4*)(rowp + 4) = acc[ai][0][m][1]; }
        }
    }
};

template <class Epi, class Sched, bool ALIGN_EPI = false, bool SP2 = false>
__device__ __forceinline__ void gemm_phase(PG8_LAS unsigned char* lds, const Gemm g, const Sched& S, const Epi& E, const SplitCtx& X) {
    const int tid = threadIdx.x, wid = __builtin_amdgcn_readfirstlane(tid >> 6), lane = tid & 63, wr = wid >> 2, wc = wid & 3, fr = lane & 15, fq = lane >> 4;
    const int K = g.K;
    unsigned voffA[2], voffB[2];
#pragma unroll
    for (int i = 0; i < 2; ++i) { int R, C; stage_rc(tid * 16 + i * 8192, R, C); const int Rb = Epi::PERM ? ((R & ~31) + perm32(R & 31)) : R;
        voffA[i] = (unsigned)(R * K + C) * 2u; voffB[i] = (unsigned)(Rb * K + C) * 2u; }
    const size_t kstep = (size_t)(BK * 2);
    const size_t hstep = (size_t)HALF * K * 2;
    const size_t tstep = 2 * hstep;
    const unsigned ldsw = (unsigned)wid * 1024u;
    const int aoff = lds_byte(wr * 64 + fr, fq * 8), boff = lds_byte(wc * 32 + fr, fq * 8);
#define PG8_SA(b, h) (((b) * 2 + (h)) * HTB)
#define PG8_SB(b, h) ((4 + (b) * 2 + (h)) * HTB)
#define PG8_STAGE(bufoff, gbase, voff) do { _Pragma("unroll") for (int _i = 0; _i < 2; ++_i) \
        __builtin_amdgcn_global_load_lds((const unsigned*)((const char*)(gbase) + (voff)[_i]), (PG8_LAS unsigned*)(lds + (bufoff) + ldsw + _i * 8192), 16, 0, 0); } while (0)
#define PG8_LDA(dst, b, h) do { _Pragma("unroll") for (int m = 0; m < 4; ++m) _Pragma("unroll") for (int k = 0; k < 2; ++k) dst[m][k] = *(const PG8_LAS bf16x8*)(lds + PG8_SA(b, h) + aoff + m * 2048 + k * 1024); } while (0)
#define PG8_LDB(dst, b, h) do { _Pragma("unroll") for (int n = 0; n < 2; ++n) _Pragma("unroll") for (int k = 0; k < 2; ++k) dst[n][k] = *(const PG8_LAS bf16x8*)(lds + PG8_SB(b, h) + boff + n * 2048 + k * 1024); } while (0)
#define PG8_MMA(ai, bj, At, Bt) do { __builtin_amdgcn_s_setprio(1); _Pragma("unroll") for (int m = 0; m < 4; ++m) _Pragma("unroll") for (int n = 0; n < 2; ++n) _Pragma("unroll") for (int k = 0; k < 2; ++k) \
        acc[ai][bj][m][n] = __builtin_amdgcn_mfma_f32_16x16x32_bf16(Bt[n][k], At[m][k], acc[ai][bj][m][n], 0, 0, 0); __builtin_amdgcn_s_setprio(0); } while (0)
#define PG8_WAIT_V(n) asm volatile("s_waitcnt vmcnt(" #n ")" ::: "memory")
#define PG8_WAIT_L(n) asm volatile("s_waitcnt lgkmcnt(" #n ")" ::: "memory")
#define PG8_BAR __builtin_amdgcn_s_barrier()
#define PG8_SCHED __builtin_amdgcn_sched_barrier(0)
    Unit cur, nxt; int ui = 0;
    if (!S.next(0, cur)) return;
    f32x4 acc[2][2][4][2];
#pragma unroll
    for (int a = 0; a < 2; ++a)
#pragma unroll
        for (int b = 0; b < 2; ++b)
#pragma unroll
            for (int m = 0; m < 4; ++m)
#pragma unroll
                for (int n = 0; n < 2; ++n) acc[a][b][m][n] = (f32x4){0.f, 0.f, 0.f, 0.f};
    bf16x8 At[4][2], B0[2][2], B1[2][2];
    const char* cA = (const char*)g.A + (size_t)cur.pm * tstep + (size_t)cur.k0 * kstep; const char* cB = (const char*)g.Bt + (size_t)cur.pn * tstep + (size_t)cur.k0 * kstep;
    S.a_ready(cur);
    if constexpr (SP2) {
        PG8_STAGE(PG8_SB(0, 0), cB, voffB); PG8_STAGE(PG8_SB(0, 1), cB + hstep, voffB); PG8_STAGE(PG8_SA(0, 0), cA, voffA); PG8_STAGE(PG8_SA(0, 1), cA + hstep, voffA);
        if (wr == 1) PG8_BAR;
        PG8_WAIT_V(2); PG8_BAR;
        PG8_STAGE(PG8_SB(1, 0), cB + kstep, voffB); PG8_STAGE(PG8_SA(1, 0), cA + kstep, voffA); PG8_STAGE(PG8_SB(1, 1), cB + hstep + kstep, voffB);
        PG8_WAIT_V(6); PG8_BAR;
    } else {
        PG8_STAGE(PG8_SB(0, 0), cB, voffB); PG8_STAGE(PG8_SA(0, 0), cA, voffA); PG8_STAGE(PG8_SB(0, 1), cB + hstep, voffB); PG8_STAGE(PG8_SA(0, 1), cA + hstep, voffA);
        if (wr == 1) PG8_BAR;
        PG8_WAIT_V(4); PG8_BAR;
        PG8_STAGE(PG8_SB(1, 0), cB + kstep, voffB); PG8_STAGE(PG8_SA(1, 0), cA + kstep, voffA); PG8_STAGE(PG8_SB(1, 1), cB + hstep + kstep, voffB);
        PG8_WAIT_V(6); PG8_BAR;
    }
    for (;;) {
        const bool has_next = S.next(ui + 1, nxt);
        const char* nA = has_next ? (const char*)g.A + (size_t)nxt.pm * tstep + (size_t)nxt.k0 * kstep : cA; const char* nB = has_next ? (const char*)g.Bt + (size_t)nxt.pn * tstep + (size_t)nxt.k0 * kstep : cB;
        const int nt = cur.nk;
        for (int t = 0; t < nt; t += 2) {
            const bool last = (t == nt - 2);
            const char* a1 = cA + (size_t)(t + 1) * kstep;
            const char* a2 = last ? nA : cA + (size_t)(t + 2) * kstep; const char* b2 = last ? nB : cB + (size_t)(t + 2) * kstep;
            const char* a3 = a2 + kstep; const char* b3 = b2 + kstep;
            if (last && has_next) S.a_ready(nxt);
            if constexpr (SP2) {
            PG8_LDB(B0, 0, 0); PG8_LDB(B1, 0, 1); PG8_SCHED; PG8_LDA(At, 0, 0); PG8_STAGE(PG8_SA(1, 1), a1 + hstep, voffA);
            PG8_WAIT_V(8); PG8_WAIT_L(0); PG8_BAR; PG8_MMA(0, 0, At, B0); PG8_MMA(0, 1, At, B1); PG8_BAR; PG8_SCHED;
            PG8_LDA(At, 0, 1); PG8_STAGE(PG8_SB(0, 0), b2, voffB); PG8_STAGE(PG8_SB(0, 1), b2 + hstep, voffB); PG8_STAGE(PG8_SA(0, 0), a2, voffA);
            PG8_WAIT_V(8); PG8_WAIT_L(0); PG8_BAR; PG8_MMA(1, 0, At, B0); PG8_MMA(1, 1, At, B1); PG8_BAR; PG8_SCHED;
            PG8_LDB(B0, 1, 0); PG8_LDB(B1, 1, 1); PG8_SCHED; PG8_LDA(At, 1, 0); PG8_STAGE(PG8_SA(0, 1), a2 + hstep, voffA);
            PG8_WAIT_V(8); PG8_WAIT_L(0); PG8_BAR; PG8_MMA(0, 0, At, B0); PG8_MMA(0, 1, At, B1); PG8_BAR; PG8_SCHED;
            PG8_LDA(At, 1, 1); PG8_STAGE(PG8_SB(1, 0), b3, voffB); PG8_STAGE(PG8_SB(1, 1), b3 + hstep, voffB); PG8_STAGE(PG8_SA(1, 0), a3, voffA);
            PG8_WAIT_V(8); PG8_WAIT_L(0); PG8_BAR; PG8_MMA(1, 0, At, B0); PG8_MMA(1, 1, At, B1); PG8_BAR; PG8_SCHED;
            } else {
            PG8_LDB(B0, 0, 0); PG8_SCHED; PG8_LDA(At, 0, 0); PG8_STAGE(PG8_SA(1, 1), a1 + hstep, voffA);
            PG8_WAIT_L(8); PG8_BAR; PG8_WAIT_L(0); PG8_MMA(0, 0, At, B0); PG8_BAR; PG8_SCHED;
            PG8_LDB(B1, 0, 1); PG8_STAGE(PG8_SB(0, 0), b2, voffB);
            PG8_BAR; PG8_WAIT_L(0); PG8_MMA(0, 1, At, B1); PG8_BAR;
            PG8_LDA(At, 0, 1); PG8_STAGE(PG8_SA(0, 0), a2, voffA);
            PG8_BAR; PG8_WAIT_L(0); PG8_MMA(1, 0, At, B0); PG8_BAR; PG8_SCHED;
            PG8_STAGE(PG8_SB(0, 1), b2 + hstep, voffB);
            PG8_WAIT_V(6); PG8_BAR; PG8_MMA(1, 1, At, B1); PG8_BAR;
            PG8_LDB(B0, 1, 0); PG8_SCHED; PG8_LDA(At, 1, 0); PG8_STAGE(PG8_SA(0, 1), a2 + hstep, voffA);
            PG8_WAIT_L(8); PG8_BAR; PG8_WAIT_L(0); PG8_MMA(0, 0, At, B0); PG8_BAR; PG8_SCHED;
            PG8_LDB(B1, 1, 1); PG8_STAGE(PG8_SB(1, 0), b3, voffB);
            PG8_BAR; PG8_WAIT_L(0); PG8_MMA(0, 1, At, B1); PG8_BAR;
            PG8_LDA(At, 1, 1); PG8_STAGE(PG8_SA(1, 0), a3, voffA);
            PG8_BAR; PG8_WAIT_L(0); PG8_MMA(1, 0, At, B0); PG8_BAR; PG8_SCHED;
            PG8_STAGE(PG8_SB(1, 1), b3 + hstep, voffB);
            PG8_WAIT_V(6); PG8_BAR; PG8_MMA(1, 1, At, B1); PG8_BAR;
            }
        }
        if constexpr (ALIGN_EPI) { if (wr == 0) PG8_BAR; }
        if constexpr (!Epi::AFTER_DRAIN) { static_assert(ALIGN_EPI, "split_reduce needs the halves aligned"); if (cur.nsl > 1) { const int shift = split_reduce(acc, cur, X, tid); E(acc, cur, wr, wc, fr, fq, shift, cur.slice); } else E(acc, cur, wr, wc, fr, fq, 5, 0); S.done(cur); }
        if (!has_next) break;
#pragma unroll
        for (int a = 0; a < 2; ++a)
#pragma unroll
            for (int b = 0; b < 2; ++b)
#pragma unroll
                for (int m = 0; m < 4; ++m)
#pragma unroll
                    for (int n = 0; n < 2; ++n) acc[a][b][m][n] = (f32x4){0.f, 0.f, 0.f, 0.f};
        cur = nxt; cA = nA; cB = nB; ++ui;
        if constexpr (ALIGN_EPI) { if (wr == 1) PG8_BAR; }
    }
    PG8_WAIT_V(0);
    if constexpr (!ALIGN_EPI) { if (wr == 0) PG8_BAR; }
    PG8_BAR;
    if constexpr (Epi::AFTER_DRAIN) { E.fused(acc, cur, wr, wc, fr, fq, lds, wid, lane); S.done(cur); }
#undef PG8_SA
#undef PG8_SB
#undef PG8_STAGE
#undef PG8_LDA
#undef PG8_LDB
#undef PG8_MMA
#undef PG8_WAIT_V
#undef PG8_WAIT_L
#undef PG8_BAR
#undef PG8_SCHED
}
}

constexpr int NWAVES = 8, NTHR = 512;
constexpr int DM = 2048, PB = 4, PL = 2048, SB = 128, SL = 8;
constexpr int MP = PB * PL, MS = SB * SL, M = MP + MS;
constexpr int GH = 4, GK = 128, GV = 256, GKD = 512, LOWR = 16;
constexpr int SH = 16, SP = 64, SN = 128, SG = 2, SCH = 1536;
constexpr int FF = 5632, FF2 = 11264, INC = 5664;
constexpr int N1 = 5888, NP = 5632;
constexpr int CQ = 0, CK = 512, CV = 1024, CG = 2048, CZ = 3072, CX = 4096;
constexpr float EPS = 1e-6f;
constexpr int N_PHASES = 11;

constexpr size_t O_Y = 0, O_GLA_P = (size_t)M * DM, O_SSD_P = O_GLA_P + (size_t)PB * GH * GK * GV, O_SCONV_P = O_SSD_P + (size_t)PB * SH * SP * SN,
                 O_FCONV_P = O_SCONV_P + (size_t)PB * 3 * SCH, O_GLA_S = O_FCONV_P + (size_t)PB * 2 * FF2, O_SSD_S = O_GLA_S + (size_t)SB * GH * GK * GV,
                 O_SCONV_S = O_SSD_S + (size_t)SB * SH * SP * SN, O_FCONV_S = O_SCONV_S + (size_t)SB * 3 * SCH, O_END = O_FCONV_S + (size_t)SB * 2 * FF2;

constexpr size_t MiB = 1u << 20;
constexpr size_t WS_CTL = 0, CTL_ZERO_BYTES = 64 * 1024;
constexpr size_t WS_WF2 = 1 * MiB;
constexpr size_t WS_W1 = 24 * MiB;
constexpr size_t WS_WO = 48 * MiB;
constexpr size_t WS_WF1 = 56 * MiB;
constexpr size_t WS_XN = 101 * MiB;
constexpr size_t WS_ACT = 24 * MiB;
constexpr size_t WS_BIG = 141 * MiB;
constexpr size_t WS_PROJ = WS_BIG;
constexpr size_t WS_MIX = WS_BIG;
constexpr size_t WS_U = WS_BIG;
constexpr size_t WS_F = WS_BIG;
constexpr size_t WS_LRDT = WS_BIG + 100 * MiB;
constexpr size_t WS_MIXIN = WS_BIG + 104 * MiB;
constexpr size_t WS_DS = WS_XN;
constexpr size_t WS_SC = WS_BIG + 140 * MiB, WS_DH = WS_BIG + 172 * MiB, WS_HC = WS_BIG + 204 * MiB;
constexpr size_t WS_EBL = WS_BIG + 236 * MiB, WS_AL = WS_EBL + 512 * 1024;
constexpr size_t WS_SLAB = WS_BIG + 140 * MiB;
constexpr size_t WS_SLAB_F1 = WS_BIG + 198 * MiB;
constexpr size_t WS_END = WS_BIG + 247 * MiB;
static_assert(WS_WF2 + (size_t)DM * FF * 2 <= WS_W1 && WS_W1 + (size_t)N1 * DM * 2 <= WS_WO && WS_WO + (size_t)DM * DM * 2 <= WS_WF1 && WS_WF1 + (size_t)FF2 * DM * 2 <= WS_XN && WS_XN + (size_t)M * DM * 2 <= WS_BIG, "ws map 1");
static_assert(WS_ACT + (size_t)M * FF * 2 <= WS_BIG && WS_PROJ + (size_t)M * NP * 2 <= WS_LRDT && WS_LRDT + (size_t)M * 32 * 4 <= WS_MIXIN && WS_MIXIN + (size_t)M * DM * 2 <= WS_SC && WS_U + (size_t)M * FF2 * 2 <= WS_END && WS_MIX + (size_t)M * DM * 4 <= WS_LRDT, "ws map 2");
constexpr int CW_BAR = 1024;
constexpr int CW_SPLIT = 8192;

constexpr int RING_BYTES = 131072;
constexpr int LDSCTL_OFF = RING_BYTES, MISC_OFF = LDSCTL_OFF + 320;
constexpr int LDS_BYTES = 147456;

#define GAS __attribute__((address_space(1)))
#define LAS __attribute__((address_space(3)))
typedef unsigned short bf16;
typedef unsigned v4u __attribute__((ext_vector_type(4)));
typedef unsigned v2u __attribute__((ext_vector_type(2)));
typedef float f32x4 __attribute__((ext_vector_type(4)));
#define LDS_WAIT() asm volatile("s_waitcnt lgkmcnt(0)" ::: "memory")
#define VM_WAIT() asm volatile("s_waitcnt vmcnt(0)" ::: "memory")
__device__ __forceinline__ unsigned f2bf(float f) { unsigned u = __builtin_bit_cast(unsigned, f); return (u + 0x7fffu + ((u >> 16) & 1u)) >> 16; }
__device__ __forceinline__ unsigned pk2(float lo, float hi) { return f2bf(lo) | (f2bf(hi) << 16); }
__device__ __forceinline__ float bf2f(unsigned short b) { return __builtin_bit_cast(float, (unsigned)b << 16); }
__device__ __forceinline__ float bflo(unsigned w) { return __builtin_bit_cast(float, w << 16); }
__device__ __forceinline__ float bfhi(unsigned w) { return __builtin_bit_cast(float, w & 0xffff0000u); }
__device__ __forceinline__ float silu_f(float x) { return x / (1.f + __expf(-x)); }
__device__ __forceinline__ float softplus_f(float x) { return fmaxf(x, 0.f) + log1pf(__expf(-fabsf(x))); }
__device__ __forceinline__ float logsigmoid_f(float x) { return fminf(x, 0.f) - log1pf(__expf(-fabsf(x))); }
__device__ __forceinline__ float wave_sum(float v) {
#pragma unroll
    for (int o = 1; o < 64; o <<= 1) v += __shfl_xor(v, o);
    return v;
}

#define XB_TMO      128
#define XB_XCNT(j)  (256  + 64 * (j))
#define XB_XSUB(j)  (1280 + 64 * (j))
#define XB_XGEN(j)  (2304 + 64 * (j))
#define XB_TOP      3328
#define XB_TOPGEN   3392
#define XCD_BAR_WORDS 3456
#define XB_SPIN_CAP (1u << 18)

__device__ __forceinline__ unsigned xb_ld(unsigned* p)              { return __hip_atomic_load(p, __ATOMIC_RELAXED, __HIP_MEMORY_SCOPE_AGENT); }
__device__ __forceinline__ unsigned xb_add(unsigned* p, unsigned v) { return __hip_atomic_fetch_add(p, v, __ATOMIC_RELAXED, __HIP_MEMORY_SCOPE_AGENT); }
__device__ __forceinline__ unsigned xb_xcc_id() { return (unsigned)__builtin_amdgcn_s_getreg((3 << 11) | 20) & 0xFu; }
#define XB_SPIN(cond, bar) do { unsigned _sp = 0; while (cond) { __builtin_amdgcn_s_sleep(1); \
    if ((++_sp & 255u) == 0u) { if (xb_ld(&(bar)[XB_TMO])) break; if (_sp > XB_SPIN_CAP) { atomicAdd(&(bar)[XB_TMO], 1u); break; } } } } while (0)

struct XcdBarrier {
    unsigned* bar; unsigned x;
    volatile LAS unsigned* st;
};

__device__ __forceinline__ XcdBarrier xcd_barrier_post(unsigned* bar, volatile LAS unsigned* st) {
    XcdBarrier b; b.bar = bar; b.x = xb_xcc_id(); b.st = st;
    if (threadIdx.x == 0) (void)xb_add(&bar[XB_XCNT(b.x)], 1u);
    return b;
}
__device__ __forceinline__ void xcd_barrier_complete(unsigned* bar, unsigned x, unsigned& nloc, unsigned& nx) {
    const unsigned G = gridDim.x * gridDim.y * gridDim.z;
    unsigned sum, cnt, mine, sp = 0u;
    for (;;) {
        sum = 0u; cnt = 0u; mine = 0u;
#pragma unroll
        for (unsigned j = 0; j < 16; ++j) { const unsigned c = xb_ld(&bar[XB_XCNT(j)]); sum += c; cnt += (c > 0u) ? 1u : 0u; mine = (j == x) ? c : mine; }
        if (sum == G) break;
        __builtin_amdgcn_s_sleep(1);
        if ((++sp & 255u) == 0u) { if (xb_ld(&bar[XB_TMO])) break; if (sp > XB_SPIN_CAP) { atomicAdd(&bar[XB_TMO], 1u); break; } }
    }
    nloc = mine > 0u ? mine : 1u; nx = cnt > 0u ? cnt : 1u;
}

__device__ __forceinline__ void xcd_barrier(const XcdBarrier& b) {
    asm volatile("s_waitcnt vmcnt(0)" ::: "memory");
    __syncthreads();
    if (threadIdx.x == 0) {
        unsigned* bar = b.bar;
        __builtin_amdgcn_s_waitcnt(0);
        unsigned nloc = b.st[0], nx = b.st[1];
        if (nloc == 0u) { xcd_barrier_complete(bar, b.x, nloc, nx); b.st[0] = nloc; b.st[1] = nx; }
        const unsigned old = xb_add(&bar[XB_XSUB(b.x)], 1u);
        const unsigned gen = old / nloc;
        if (old + 1u == (gen + 1u) * nloc) {
            __builtin_amdgcn_fence(__ATOMIC_RELEASE, "agent");
            asm volatile("s_waitcnt vmcnt(0)" ::: "memory");
            const unsigned og = xb_add(&bar[XB_TOP], 1u);
            const unsigned tg = og / nx;
            if (og + 1u == (tg + 1u) * nx) xb_add(&bar[XB_TOPGEN], 1u);
            else XB_SPIN(xb_ld(&bar[XB_TOPGEN]) == tg, bar);
            __builtin_amdgcn_fence(__ATOMIC_ACQUIRE, "agent");
            xb_add(&bar[XB_XGEN(b.x)], 1u);
            asm volatile("s_waitcnt vmcnt(0)" ::: "memory");
        } else {
            XB_SPIN(xb_ld(&bar[XB_XGEN(b.x)]) == gen, bar);
            __builtin_amdgcn_fence(__ATOMIC_ACQUIRE, "agent");
            asm volatile("s_waitcnt vmcnt(0)" ::: "memory");
        }
    }
    __syncthreads();
}

struct Frame {
    LAS unsigned char* lds;
    int tid, lane, wave, G, bid;
    const float *x_p, *x_s, *st_gla, *st_ssd, *st_sconv, *st_fconv, *n_mix_pre, *n_mix_post, *n_ffn_pre, *n_ffn_post, *w_in, *w_gate2, *b_gate, *gla_norm,
                *sconv_w, *sconv_b, *dt_bias, *A_log, *ssd_D, *ssd_norm, *w_out, *ffn_w_in, *fconv_w, *fconv_b, *ffn_w_out;
    float* out;
    bf16 *W1, *WO, *WF1, *WF2, *XN, *PROJ, *MIXIN, *U, *ACT, *DS, *SC, *DH, *HC;
    float *LRDT, *MIX, *Fb, *EBL, *AL;
};
__device__ __forceinline__ const float* x_row(const Frame& F, int row) { return row < MP ? F.x_p + (size_t)row * DM : F.x_s + (size_t)(row - MP) * DM; }

__device__ __forceinline__ int w1_src_col(int n) { return n < 3072 ? n : (n < 5632 ? n + 16 : (n < 5648 ? n - 2560 : (n < 5664 ? n : -1))); }
template <bool MAP>
__device__ __forceinline__ void p0_transpose_item(const float* W, int K, int Nsrc, int Ndst, bf16* WT, LAS float* scr, int item, int lane) {
    const int nblk = Ndst / 32, kb = item / nblk, nb = item % nblk, k0 = 64 * kb, n0 = 32 * nb;
    int sc = n0 + (lane & 31); if (MAP) sc = w1_src_col(sc);
#pragma unroll 8
    for (int i = 0; i < 32; ++i) { const int kk = 2 * i + (lane >> 5); scr[kk * 33 + (lane & 31)] = (sc >= 0) ? W[(size_t)(k0 + kk) * Nsrc + sc] : 0.f; }
    LDS_WAIT(); asm volatile("" ::: "memory");
    const int c = lane & 7;
#pragma unroll
    for (int j = 0; j < 4; ++j) { const int n = (lane >> 3) + 8 * j; const LAS float* s = scr + (8 * c) * 33 + n;
        v4u o; o.x = pk2(s[0 * 33], s[1 * 33]); o.y = pk2(s[2 * 33], s[3 * 33]); o.z = pk2(s[4 * 33], s[5 * 33]); o.w = pk2(s[6 * 33], s[7 * 33]);
        *(v4u*)(WT + (size_t)(n0 + n) * K + k0 + 8 * c) = o; }
    LDS_WAIT(); asm volatile("" ::: "memory");
}
__device__ __forceinline__ void rms_row_to_bf16(const float* xrow, const float* w, bf16* orow, int lane) {
    const f32x4* xr = (const f32x4*)xrow + lane; const f32x4* wr = (const f32x4*)w + lane;
    f32x4 v[8]; float s = 0.f;
#pragma unroll
    for (int j = 0; j < 8; ++j) { v[j] = xr[64 * j]; s += (v[j].x * v[j].x + v[j].y * v[j].y) + (v[j].z * v[j].z + v[j].w * v[j].w); }
    const float r = rsqrtf(wave_sum(s) * (1.f / DM) + EPS);
    v2u* o8 = (v2u*)orow + lane;
#pragma unroll
    for (int j = 0; j < 8; ++j) { const f32x4 ww = wr[64 * j]; v2u o; o.x = pk2(v[j].x * r * ww.x, v[j].y * r * ww.y); o.y = pk2(v[j].z * r * ww.z, v[j].w * r * ww.w); o8[64 * j] = o; }
}
__device__ __forceinline__ void p0_prologue(Frame& F) {
    LAS float* scr = (LAS float*)(F.lds + F.wave * 16384);
    const int gw = F.bid * NWAVES + F.wave, NGW = F.G * NWAVES;
    constexpr int I_1 = (DM / 64) * (N1 / 32), I_O = (DM / 64) * (DM / 32), I_F1 = (DM / 64) * (FF2 / 32), I_F2 = (FF / 64) * (DM / 32);
    constexpr int NITEMS = I_1 + I_O + I_F1 + I_F2;
    for (int it = gw; it < NITEMS; it += NGW) {
        int r = it;
        if (r < I_1) { p0_transpose_item<true>(F.w_in, DM, INC, N1, F.W1, scr, r, F.lane); continue; } r -= I_1;
        if (r < I_O) { p0_transpose_item<false>(F.w_out, DM, DM, DM, F.WO, scr, r, F.lane); continue; } r -= I_O;
        if (r < I_F1) { p0_transpose_item<false>(F.ffn_w_in, DM, FF2, FF2, F.WF1, scr, r, F.lane); continue; } r -= I_F1;
        p0_transpose_item<false>(F.ffn_w_out, FF, DM, DM, F.WF2, scr, r, F.lane);
    }
    for (int m = gw; m < M; m += NGW) rms_row_to_bf16(x_row(F, m), F.n_mix_pre, F.XN + (size_t)m * DM, F.lane);
}

template <int grp> __device__ __forceinline__ void gla_direct_unit(Frame& F, int b, int h) {
    const int tid = F.tid, v = tid & 255, kh = tid >> 8;
    const int L = grp ? SL : PL, row0 = grp ? MP + b * SL : b * PL;
    LAS float* Es = (LAS float*)F.lds; LAS float* Ks = Es + 1024; LAS float* Qs = Ks + 1024; LAS float* Os = Qs + 1024;
    float S[64];
    if (grp) { const float* s0 = F.st_gla + ((size_t)(b * GH + h) * GK + kh * 64) * GV + v;
#pragma unroll
        for (int i = 0; i < 64; ++i) S[i] = s0[(size_t)i * GV]; }
    else {
#pragma unroll
        for (int i = 0; i < 64; ++i) S[i] = 0.f; }
    for (int t0 = 0; t0 < L; t0 += 8) {
        for (int it = tid; it < 1024; it += NTHR) { const int t = it >> 7, k = it & 127, row = row0 + t0 + t, hk = h * GK + k;
            float x = F.b_gate[hk]; const float* lr = F.LRDT + (size_t)row * 32;
#pragma unroll
            for (int j = 0; j < LOWR; ++j) x += lr[j] * F.w_gate2[j * GKD + hk];
            const float lg = logsigmoid_f(x) * (1.f / 16.f);
            Es[it] = __expf(lg); Ks[it] = bf2f(F.PROJ[(size_t)row * NP + CK + hk]); Qs[it] = bf2f(F.PROJ[(size_t)row * NP + CQ + hk]) * 0.08838834764831845f; }
        __syncthreads();
#pragma unroll 1
        for (int t = 0; t < 8; ++t) { const float vv = bf2f(F.PROJ[(size_t)(row0 + t0 + t) * NP + CV + h * GV + v]); float acc = 0.f;
            const LAS float* e = Es + t * 128 + kh * 64; const LAS float* kk = Ks + t * 128 + kh * 64; const LAS float* qq = Qs + t * 128 + kh * 64;
#pragma unroll
            for (int i = 0; i < 64; ++i) { S[i] = e[i] * S[i] + kk[i] * vv; acc += qq[i] * S[i]; }
            Os[(kh * 8 + t) * 256 + v] = acc; }
        __syncthreads();
        { const int t = F.wave, v4 = F.lane * 4, row = row0 + t0 + t;
            const f32x4 a = *(const LAS f32x4*)(Os + t * 256 + v4), c = *(const LAS f32x4*)(Os + (8 + t) * 256 + v4); const f32x4 o = a + c;
            const float ss = wave_sum((o.x * o.x + o.y * o.y) + (o.z * o.z + o.w * o.w)); const float r = rsqrtf(ss * (1.f / GV) + EPS);
            const v2u gw = *(const v2u*)(F.PROJ + (size_t)row * NP + CG + h * GV + v4); const f32x4 nw = *(const f32x4*)(F.gla_norm + v4);
            v2u w; w.x = pk2(o.x * r * nw.x * silu_f(bflo(gw.x)), o.y * r * nw.y * silu_f(bfhi(gw.x))); w.y = pk2(o.z * r * nw.z * silu_f(bflo(gw.y)), o.w * r * nw.w * silu_f(bfhi(gw.y)));
            *(v2u*)(F.MIXIN + (size_t)row * DM + h * GV + v4) = w; }
        __syncthreads();
    }
    float* so = F.out + (grp ? O_GLA_S : O_GLA_P) + ((size_t)(b * GH + h) * GK + kh * 64) * GV + v;
#pragma unroll
    for (int i = 0; i < 64; ++i) so[(size_t)i * GV] = S[i];
}
__device__ __forceinline__ float xbc_raw(const Frame& F, int grp, int b, int row0, int tt, int c) {
    if (tt >= 0) return bf2f(F.PROJ[(size_t)(row0 + tt) * NP + CX + c]);
    return grp ? F.st_sconv[((size_t)b * 3 + (tt + 3)) * SCH + c] : 0.f;
}
template <int grp> __device__ __forceinline__ void ssd_direct_unit(Frame& F, int b, int g) {
    const int tid = F.tid, hd = g * 8 + (tid >> 6), p = tid & 63, ch = g * 512 + tid;
    const int L = grp ? SL : PL, row0 = grp ? MP + b * SL : b * PL;
    LAS float* Bs = (LAS float*)F.lds; LAS float* Cs = Bs + 1024; LAS float* red = Cs + 1024; LAS float* Ys = red + 64;
    float h[128];
    if (grp) { const f32x4* h0 = (const f32x4*)(F.st_ssd + ((size_t)(b * SH + hd) * SP + p) * SN);
#pragma unroll
        for (int i = 0; i < 32; ++i) { const f32x4 q = h0[i]; h[4 * i] = q.x; h[4 * i + 1] = q.y; h[4 * i + 2] = q.z; h[4 * i + 3] = q.w; } }
    else {
#pragma unroll
        for (int i = 0; i < 128; ++i) h[i] = 0.f; }
    const float A = -__expf(F.A_log[hd]), dtb = F.dt_bias[hd], Dh = F.ssd_D[hd], nw = F.ssd_norm[ch];
    const float cb = F.sconv_b[ch], cw0 = F.sconv_w[ch], cw1 = F.sconv_w[SCH + ch], cw2 = F.sconv_w[2 * SCH + ch], cw3 = F.sconv_w[3 * SCH + ch];
    const int c2 = 1024 + (tid < 128 ? g * 128 + tid : 256 + g * 128 + ((tid - 128) & 127));
    float xr0 = xbc_raw(F, grp, b, row0, -3, ch), xr1 = xbc_raw(F, grp, b, row0, -2, ch), xr2 = xbc_raw(F, grp, b, row0, -1, ch);
    for (int t0 = 0; t0 < L; t0 += 8) {
        if (tid < 256) {
            float xr[11]; const float cb2 = F.sconv_b[c2], d0 = F.sconv_w[c2], d1 = F.sconv_w[SCH + c2], d2 = F.sconv_w[2 * SCH + c2], d3 = F.sconv_w[3 * SCH + c2];
#pragma unroll
            for (int i = 0; i < 11; ++i) xr[i] = xbc_raw(F, grp, b, row0, t0 - 3 + i, c2);
#pragma unroll
            for (int t = 0; t < 8; ++t) Bs[(tid >> 7) * 1024 + t * 128 + (tid & 127)] = silu_f(cb2 + d0 * xr[t] + d1 * xr[t + 1] + d2 * xr[t + 2] + d3 * xr[t + 3]);
        }
        __syncthreads();
#pragma unroll 1
        for (int t = 0; t < 8; ++t) { const int row = row0 + t0 + t;
            const float xn = bf2f(F.PROJ[(size_t)row * NP + CX + ch]);
            const float x = silu_f(cb + cw0 * xr0 + cw1 * xr1 + cw2 * xr2 + cw3 * xn); xr0 = xr1; xr1 = xr2; xr2 = xn;
            const float dt = softplus_f(F.LRDT[(size_t)row * 32 + 16 + hd] + dtb), a = __expf(dt * A), dtx = dt * x;
            float acc = 0.f; const LAS float* bb = Bs + t * 128; const LAS float* cc = Cs + t * 128;
#pragma unroll
            for (int nb = 0; nb < 128; nb += 16) {
#pragma unroll
                for (int n = nb; n < nb + 16; ++n) { h[n] = a * h[n] + dtx * bb[n]; acc += h[n] * cc[n]; }
                asm volatile("" ::: "memory"); }
            const float z = bf2f(F.PROJ[(size_t)row * NP + CZ + ch]);
            const float y = (acc + Dh * x) * silu_f(z);
            Ys[t * 512 + tid] = y;
            const float ss = wave_sum(y * y); if (F.lane == 0) red[t * 8 + F.wave] = ss; }
        __syncthreads();
#pragma unroll
        for (int t = 0; t < 8; ++t) { float tot = 0.f;
#pragma unroll
            for (int w = 0; w < 8; ++w) tot += red[t * 8 + w];
            const float r = rsqrtf(tot * (1.f / 512.f) + EPS);
            F.MIXIN[(size_t)(row0 + t0 + t) * DM + 1024 + ch] = (bf16)f2bf(Ys[t * 512 + tid] * r * nw); }
        __syncthreads();
    }
    f32x4* ho = (f32x4*)(F.out + (grp ? O_SSD_S : O_SSD_P) + ((size_t)(b * SH + hd) * SP + p) * SN);
#pragma unroll
    for (int i = 0; i < 32; ++i) ho[i] = (f32x4){h[4 * i], h[4 * i + 1], h[4 * i + 2], h[4 * i + 3]};
}
typedef short bf16x8v __attribute__((ext_vector_type(8)));
typedef short s16x4v __attribute__((ext_vector_type(4)));
constexpr int CH = 64, NCH = PL / CH;
constexpr int QE_ST = 272, KDT_ST = 144, V_ST = 544, ATT_ST = 144, X_ST = 1056, BC_ST = 288;
#define MFMA16(a, b, c) __builtin_amdgcn_mfma_f32_16x16x32_bf16((a), (b), (c), 0, 0, 0)
__device__ __forceinline__ bf16x8v frag_k(const LAS unsigned char* T, int stride, int idx0, int kk0, int r, int q) { return *(const LAS bf16x8v*)(T + (idx0 + r) * stride + (kk0 + 8 * q) * 2); }
__device__ __forceinline__ bf16x8v frag_t(const LAS unsigned char* T, int stride, int kk0, int idx0, int r, int q) {
    const LAS unsigned char* p = T + (kk0 + 8 * q + (r >> 2)) * stride + (idx0 + 4 * (r & 3)) * 2;
    const s16x4v lo = __builtin_amdgcn_ds_read_tr16_b64_v4i16((LAS s16x4v*)p), hi = __builtin_amdgcn_ds_read_tr16_b64_v4i16((LAS s16x4v*)(p + 4 * stride));
    return (bf16x8v){lo[0], lo[1], lo[2], lo[3], hi[0], hi[1], hi[2], hi[3]};
}
__device__ __forceinline__ v2u pk4(const f32x4 v) { v2u o; o.x = pk2(v.x, v.y); o.y = pk2(v.z, v.w); return o; }

template <int PASS>
__device__ __forceinline__ void gla_chunk_elem(Frame& F, int h, int row0, LAS unsigned char* T0, LAS unsigned char* T1, LAS float* tot, float* ebl_out) {
    const int tid = F.tid, k = tid & 127, tq = tid >> 7, hk = h * GK + k;
    float w2[16];
#pragma unroll
    for (int j = 0; j < 16; ++j) w2[j] = F.w_gate2[j * GKD + hk];
    const float bg = F.b_gate[hk];
    float lg[16]; float run = 0.f;
#pragma unroll
    for (int i = 0; i < 16; ++i) { const float* lr = F.LRDT + (size_t)(row0 + 16 * tq + i) * 32; float x = bg;
#pragma unroll
        for (int j = 0; j < 16; ++j) x += lr[j] * w2[j];
        run += logsigmoid_f(x) * (1.f / 16.f); lg[i] = run; }
    tot[tq * 128 + k] = run;
    __syncthreads();
    float off = 0.f, all = 0.f;
#pragma unroll
    for (int qq = 0; qq < 4; ++qq) { const float v = tot[qq * 128 + k]; all += v; off += (qq < tq) ? v : 0.f; }
    if (PASS == 0) {
        unsigned pk[8];
#pragma unroll
        for (int i = 0; i < 8; ++i) { const size_t ro = (size_t)(row0 + 16 * tq + 2 * i) * NP + CK + hk;
            const float k0 = bf2f(F.PROJ[ro]) * __expf(all - (off + lg[2 * i])), k1 = bf2f(F.PROJ[ro + NP]) * __expf(all - (off + lg[2 * i + 1])); pk[i] = pk2(k0, k1); }
        LAS v4u* d = (LAS v4u*)(T0 + k * KDT_ST + 32 * tq);
        d[0] = (v4u){pk[0], pk[1], pk[2], pk[3]}; d[1] = (v4u){pk[4], pk[5], pk[6], pk[7]};
        if (tq == 0) ebl_out[k] = __expf(all);
    } else {
#pragma unroll
        for (int i = 0; i < 16; ++i) { const int t = 16 * tq + i; const size_t ro = (size_t)(row0 + t) * NP + hk; const float bb = off + lg[i];
            *(LAS bf16*)(T0 + t * QE_ST + k * 2) = (bf16)f2bf(bf2f(F.PROJ[ro + CQ]) * 0.08838834764831845f * __expf(bb));
            *(LAS bf16*)(T1 + t * QE_ST + k * 2) = (bf16)f2bf(bf2f(F.PROJ[ro + CK]) * __expf(-bb)); }
    }
}
__device__ __forceinline__ void gla_load_v(Frame& F, int h, int row0, LAS unsigned char* V) {
#pragma unroll
    for (int i = 0; i < 4; ++i) { const int piece = F.tid + NTHR * i, row = piece >> 5, c16 = piece & 31;
        *(LAS v4u*)(V + row * V_ST + c16 * 16) = *(const v4u*)(F.PROJ + (size_t)(row0 + row) * NP + CV + h * GV + c16 * 8); }
}
__device__ __forceinline__ void gla_passA_unit(Frame& F, int u) {
    const int c = u & 31, bh = u >> 5, b = bh >> 2, h = bh & 3, row0 = b * PL + c * CH;
    LAS unsigned char* KDT = F.lds; LAS unsigned char* V = KDT + 128 * KDT_ST; LAS float* tot = (LAS float*)(V + 64 * V_ST);
    gla_load_v(F, h, row0, V);
    gla_chunk_elem<0>(F, h, row0, KDT, nullptr, tot, F.EBL + (size_t)u * 128);
    __syncthreads();
    const int w = F.wave, r = F.lane & 15, q = F.lane >> 4;
    f32x4 acc[8][2];
#pragma unroll
    for (int kf = 0; kf < 8; ++kf) { acc[kf][0] = (f32x4){0.f, 0.f, 0.f, 0.f}; acc[kf][1] = (f32x4){0.f, 0.f, 0.f, 0.f}; }
#pragma unroll
    for (int ks = 0; ks < 2; ++ks) { const bf16x8v b0 = frag_t(V, V_ST, 32 * ks, 32 * w, r, q), b1 = frag_t(V, V_ST, 32 * ks, 32 * w + 16, r, q);
#pragma unroll
        for (int kf = 0; kf < 8; ++kf) { const bf16x8v a = frag_k(KDT, KDT_ST, 16 * kf, 32 * ks, r, q); acc[kf][0] = MFMA16(a, b0, acc[kf][0]); acc[kf][1] = MFMA16(a, b1, acc[kf][1]); } }
#pragma unroll
    for (int kf = 0; kf < 8; ++kf)
#pragma unroll
        for (int vf = 0; vf < 2; ++vf) *(v2u*)(F.DS + ((size_t)u * GV + 32 * w + 16 * vf + r) * GK + 16 * kf + 4 * q) = pk4(acc[kf][vf]);
    __syncthreads();
}
__device__ __forceinline__ void gla_scan(Frame& F) {
    for (int it = F.bid * NTHR + F.tid; it < PB * GH * GV * 32; it += F.G * NTHR) { const int k4 = it & 31, v = (it >> 5) & 255, bh = it >> 13;
        f32x4 S = (f32x4){0.f, 0.f, 0.f, 0.f};
#pragma unroll 4
        for (int c = 0; c < NCH; ++c) { const int u = bh * NCH + c; const size_t off = ((size_t)u * GV + v) * GK + 4 * k4;
            const v2u d = *(const v2u*)(F.DS + off); const f32x4 e = *(const f32x4*)(F.EBL + (size_t)u * 128 + 4 * k4);
            *(v2u*)(F.SC + off) = pk4(S);
            S.x = e.x * S.x + bflo(d.x); S.y = e.y * S.y + bfhi(d.x); S.z = e.z * S.z + bflo(d.y); S.w = e.w * S.w + bfhi(d.y); }
        float* o = F.out + O_GLA_P + ((size_t)bh * GK + 4 * k4) * GV + v; o[0] = S.x; o[GV] = S.y; o[2 * GV] = S.z; o[3 * GV] = S.w; }
}
__device__ __forceinline__ void gla_passC_unit(Frame& F, int u) {
    const int c = u & 31, bh = u >> 5, b = bh >> 2, h = bh & 3, row0 = b * PL + c * CH;
    LAS unsigned char* QE = F.lds; LAS unsigned char* KE = QE + 64 * QE_ST; LAS unsigned char* V = KE + 64 * QE_ST; LAS unsigned char* ATT = V + 64 * V_ST;
    LAS float* tot = (LAS float*)(ATT + 64 * ATT_ST); LAS float* red = tot + 512;
    gla_load_v(F, h, row0, V);
    gla_chunk_elem<1>(F, h, row0, QE, KE, tot, nullptr);
    __syncthreads();
    const int w = F.wave, r = F.lane & 15, q = F.lane >> 4;
#pragma unroll
    for (int ff = 0; ff < 2; ++ff) { const int f = 2 * w + ff, sf = f >> 2, tf = f & 3; f32x4 a4 = (f32x4){0.f, 0.f, 0.f, 0.f};
        if (sf <= tf) {
#pragma unroll
            for (int ks = 0; ks < 4; ++ks) a4 = MFMA16(frag_k(KE, QE_ST, 16 * sf, 32 * ks, r, q), frag_k(QE, QE_ST, 16 * tf, 32 * ks, r, q), a4); }
        const int s0 = 16 * sf + 4 * q, t = 16 * tf + r;
        f32x4 m; m.x = (s0 <= t) ? a4.x : 0.f; m.y = (s0 + 1 <= t) ? a4.y : 0.f; m.z = (s0 + 2 <= t) ? a4.z : 0.f; m.w = (s0 + 3 <= t) ? a4.w : 0.f;
        *(LAS v2u*)(ATT + t * ATT_ST + s0 * 2) = pk4(m); }
    __syncthreads();
    const int tf = w & 3, vh = w >> 2;
    f32x4 acc[8];
#pragma unroll
    for (int i = 0; i < 8; ++i) acc[i] = (f32x4){0.f, 0.f, 0.f, 0.f};
    const bf16* Sc = F.SC + ((size_t)u * GV + 128 * vh) * GK;
#pragma unroll
    for (int ks = 0; ks < 4; ++ks) { const bf16x8v bq = frag_k(QE, QE_ST, 16 * tf, 32 * ks, r, q);
#pragma unroll
        for (int i = 0; i < 8; ++i) { const bf16x8v a = *(const bf16x8v*)(Sc + (size_t)(16 * i + r) * GK + 32 * ks + 8 * q); acc[i] = MFMA16(a, bq, acc[i]); } }
#pragma unroll
    for (int ks = 0; ks < 2; ++ks) { const bf16x8v ba = frag_k(ATT, ATT_ST, 16 * tf, 32 * ks, r, q);
#pragma unroll
        for (int i = 0; i < 8; ++i) { const bf16x8v a = frag_t(V, V_ST, 32 * ks, 128 * vh + 16 * i, r, q); acc[i] = MFMA16(a, ba, acc[i]); } }
    float ss = 0.f;
#pragma unroll
    for (int i = 0; i < 8; ++i) ss += (acc[i].x * acc[i].x + acc[i].y * acc[i].y) + (acc[i].z * acc[i].z + acc[i].w * acc[i].w);
    ss += __shfl_xor(ss, 16); ss += __shfl_xor(ss, 32);
    const int t = 16 * tf + r;
    if (q == 0) red[vh * 64 + t] = ss;
    __syncthreads();
    const float rr = rsqrtf((red[t] + red[64 + t]) * (1.f / GV) + EPS); const size_t row = (size_t)(row0 + t);
#pragma unroll
    for (int i = 0; i < 8; ++i) { const int v = 128 * vh + 16 * i + 4 * q;
        const v2u gw = *(const v2u*)(F.PROJ + row * NP + CG + h * GV + v); const f32x4 nw = *(const f32x4*)(F.gla_norm + v);
        f32x4 o; o.x = acc[i].x * rr * nw.x * silu_f(bflo(gw.x)); o.y = acc[i].y * rr * nw.y * silu_f(bfhi(gw.x)); o.z = acc[i].z * rr * nw.z * silu_f(bflo(gw.y)); o.w = acc[i].w * rr * nw.w * silu_f(bfhi(gw.y));
        *(v2u*)(F.MIXIN + row * DM + h * GV + v) = pk4(o); }
    __syncthreads();
}

template <bool SCALE>
__device__ __forceinline__ void ssd_conv_item(Frame& F, int b, int g, int c, int cg, int tb, LAS unsigned char* X, LAS unsigned char* BT, LAS unsigned char* CT, const LAS float* WDEC) {
    const int xc = cg < 64 ? g * 512 + 8 * cg : (cg < 80 ? 1024 + g * 128 + 8 * (cg - 64) : 1280 + g * 128 + 8 * (cg - 80));
    float w[4][8], bias[8];
#pragma unroll
    for (int j = 0; j < 4; ++j) { const f32x4 a = *(const f32x4*)(F.sconv_w + j * SCH + xc), bq = *(const f32x4*)(F.sconv_w + j * SCH + xc + 4);
        w[j][0] = a.x; w[j][1] = a.y; w[j][2] = a.z; w[j][3] = a.w; w[j][4] = bq.x; w[j][5] = bq.y; w[j][6] = bq.z; w[j][7] = bq.w; }
    { const f32x4 a = *(const f32x4*)(F.sconv_b + xc), bq = *(const f32x4*)(F.sconv_b + xc + 4); bias[0] = a.x; bias[1] = a.y; bias[2] = a.z; bias[3] = a.w; bias[4] = bq.x; bias[5] = bq.y; bias[6] = bq.z; bias[7] = bq.w; }
    v4u raw[11];
#pragma unroll
    for (int i = 0; i < 11; ++i) { const int tt = c * CH + tb * 8 - 3 + i;
        raw[i] = (tt >= 0) ? *(const v4u*)(F.PROJ + (size_t)(b * PL + tt) * NP + CX + xc) : (v4u){0u, 0u, 0u, 0u}; }
#pragma unroll
    for (int t = 0; t < 8; ++t) { float o[8];
#pragma unroll
        for (int e = 0; e < 8; ++e) { float a = bias[e];
#pragma unroll
            for (int j = 0; j < 4; ++j) { const unsigned wd = raw[t + j][e >> 1]; a += w[j][e] * ((e & 1) ? bfhi(wd) : bflo(wd)); }
            o[e] = silu_f(a); }
        const int tl = tb * 8 + t;
        if (SCALE && cg < 64) { const float sc = WDEC[(cg >> 3) * 64 + tl];
#pragma unroll
            for (int e = 0; e < 8; ++e) o[e] *= sc; }
        const v4u pkd = (v4u){pk2(o[0], o[1]), pk2(o[2], o[3]), pk2(o[4], o[5]), pk2(o[6], o[7])};
        LAS unsigned char* dst = cg < 64 ? X + tl * X_ST + cg * 16 : (cg < 80 ? BT + tl * BC_ST + (cg - 64) * 16 : CT + tl * BC_ST + (cg - 80) * 16);
        *(LAS v4u*)dst = pkd; }
}
__device__ __forceinline__ float ssd_head_scan(Frame& F, int hd, int row0, float& dt_out, float& last) {
    const float dt = softplus_f(F.LRDT[(size_t)(row0 + F.lane) * 32 + 16 + hd] + F.dt_bias[hd]);
    float cum = dt * (-__expf(F.A_log[hd]));
#pragma unroll
    for (int o = 1; o < 64; o <<= 1) { const float v = __shfl_up(cum, o); cum += (F.lane >= o) ? v : 0.f; }
    dt_out = dt; last = __shfl(cum, 63); return cum;
}
__device__ __forceinline__ void ssd_passA_unit(Frame& F, int u) {
    const int c = u & 31, bg = u >> 5, b = bg >> 1, g = bg & 1, row0 = b * PL + c * CH;
    LAS unsigned char* X = F.lds; LAS unsigned char* BT = X + 64 * X_ST; LAS float* WDEC = (LAS float*)(BT + 64 * BC_ST);
    const int w = F.wave, r = F.lane & 15, q = F.lane >> 4;
    { float dt, last; const float cum = ssd_head_scan(F, g * 8 + w, row0, dt, last);
        WDEC[w * 64 + F.lane] = __expf(last - cum) * dt; if (F.lane == 63) F.AL[(size_t)u * 8 + w] = __expf(last); }
    __syncthreads();
    for (int it = F.tid; it < 80 * 8; it += NTHR) ssd_conv_item<true>(F, b, g, c, it % 80, it / 80, X, BT, nullptr, WDEC);
    __syncthreads();
#pragma unroll 1
    for (int nh = 0; nh < 2; ++nh) {
        f32x4 acc[4][4];
#pragma unroll
        for (int i = 0; i < 4; ++i)
#pragma unroll
            for (int j = 0; j < 4; ++j) acc[i][j] = (f32x4){0.f, 0.f, 0.f, 0.f};
#pragma unroll
        for (int ks = 0; ks < 2; ++ks) { bf16x8v bp[4];
#pragma unroll
            for (int pf = 0; pf < 4; ++pf) bp[pf] = frag_t(X, X_ST, 32 * ks, 64 * w + 16 * pf, r, q);
#pragma unroll
            for (int nf = 0; nf < 4; ++nf) { const bf16x8v a = frag_t(BT, BC_ST, 32 * ks, 64 * nh + 16 * nf, r, q);
#pragma unroll
                for (int pf = 0; pf < 4; ++pf) acc[nf][pf] = MFMA16(a, bp[pf], acc[nf][pf]); } }
#pragma unroll
        for (int nf = 0; nf < 4; ++nf)
#pragma unroll
            for (int pf = 0; pf < 4; ++pf) *(v2u*)(F.DH + (((size_t)u * 8 + w) * SP + 16 * pf + r) * SN + 64 * nh + 16 * nf + 4 * q) = pk4(acc[nf][pf]);
    }
    __syncthreads();
}
__device__ __forceinline__ void ssd_scan(Frame& F) {
    for (int it = F.bid * NTHR + F.tid; it < PB * SH * SP * 32; it += F.G * NTHR) { const int n4 = it & 31, p = (it >> 5) & 63, bhd = it >> 11, b = bhd >> 4, hd = bhd & 15, g = hd >> 3, hl = hd & 7;
        f32x4 H = (f32x4){0.f, 0.f, 0.f, 0.f};
#pragma unroll 4
        for (int c = 0; c < NCH; ++c) { const int u = (b * 2 + g) * NCH + c; const size_t off = (((size_t)u * 8 + hl) * SP + p) * SN + 4 * n4;
            const v2u d = *(const v2u*)(F.DH + off); const float a = F.AL[(size_t)u * 8 + hl];
            *(v2u*)(F.HC + off) = pk4(H);
            H.x = a * H.x + bflo(d.x); H.y = a * H.y + bfhi(d.x); H.z = a * H.z + bflo(d.y); H.w = a * H.w + bfhi(d.y); }
        *(f32x4*)(F.out + O_SSD_P + ((size_t)bhd * SP + p) * SN + 4 * n4) = H; }
}
__device__ __forceinline__ void ssd_passC_unit(Frame& F, int u) {
    const int c = u & 31, bg = u >> 5, b = bg >> 1, g = bg & 1, row0 = b * PL + c * CH;
    LAS unsigned char* X = F.lds; LAS unsigned char* BT = X + 64 * X_ST; LAS unsigned char* CT = BT + 64 * BC_ST; LAS unsigned char* CB = CT + 64 * BC_ST;
    LAS float* DT = (LAS float*)(CB + 64 * ATT_ST); LAS float* CUM = DT + 512; LAS float* red = CUM + 512;
    const int w = F.wave, r = F.lane & 15, q = F.lane >> 4, hd = g * 8 + w;
    { float dt, last; const float cum = ssd_head_scan(F, hd, row0, dt, last); DT[w * 64 + F.lane] = dt; CUM[w * 64 + F.lane] = cum; }
    for (int it = F.tid; it < 96 * 8; it += NTHR) ssd_conv_item<false>(F, b, g, c, it % 96, it / 96, X, BT, CT, nullptr);
    __syncthreads();
#pragma unroll
    for (int ff = 0; ff < 2; ++ff) { const int f = 2 * w + ff, sf = f >> 2, tf = f & 3; f32x4 a4 = (f32x4){0.f, 0.f, 0.f, 0.f};
        if (sf <= tf) {
#pragma unroll
            for (int ks = 0; ks < 4; ++ks) a4 = MFMA16(frag_k(BT, BC_ST, 16 * sf, 32 * ks, r, q), frag_k(CT, BC_ST, 16 * tf, 32 * ks, r, q), a4); }
        *(LAS v2u*)(CB + (16 * tf + r) * ATT_ST + (16 * sf + 4 * q) * 2) = pk4(a4); }
    __syncthreads();
    f32x4 acc[4][4];
#pragma unroll
    for (int i = 0; i < 4; ++i)
#pragma unroll
        for (int j = 0; j < 4; ++j) acc[i][j] = (f32x4){0.f, 0.f, 0.f, 0.f};
    const bf16* Hc = F.HC + ((size_t)u * 8 + w) * SP * SN;
#pragma unroll
    for (int ks = 0; ks < 4; ++ks) { bf16x8v bc[4];
#pragma unroll
        for (int tf = 0; tf < 4; ++tf) bc[tf] = frag_k(CT, BC_ST, 16 * tf, 32 * ks, r, q);
#pragma unroll
        for (int pf = 0; pf < 4; ++pf) { const bf16x8v a = *(const bf16x8v*)(Hc + (size_t)(16 * pf + r) * SN + 32 * ks + 8 * q);
#pragma unroll
            for (int tf = 0; tf < 4; ++tf) acc[pf][tf] = MFMA16(a, bc[tf], acc[pf][tf]); } }
    float ct[4];
#pragma unroll
    for (int tf = 0; tf < 4; ++tf) { ct[tf] = CUM[w * 64 + 16 * tf + r]; const float e = __expf(ct[tf]);
#pragma unroll
        for (int pf = 0; pf < 4; ++pf) acc[pf][tf] = acc[pf][tf] * e; }
#pragma unroll
    for (int ks = 0; ks < 2; ++ks) { bf16x8v ax[4];
#pragma unroll
        for (int pf = 0; pf < 4; ++pf) ax[pf] = frag_t(X, X_ST, 32 * ks, 64 * w + 16 * pf, r, q);
        const int s0 = 32 * ks + 8 * q;
        const f32x4 cs0 = *(const LAS f32x4*)(CUM + w * 64 + s0), cs1 = *(const LAS f32x4*)(CUM + w * 64 + s0 + 4), ds0 = *(const LAS f32x4*)(DT + w * 64 + s0), ds1 = *(const LAS f32x4*)(DT + w * 64 + s0 + 4);
        const float cs[8] = {cs0.x, cs0.y, cs0.z, cs0.w, cs1.x, cs1.y, cs1.z, cs1.w}, ds[8] = {ds0.x, ds0.y, ds0.z, ds0.w, ds1.x, ds1.y, ds1.z, ds1.w};
#pragma unroll
        for (int tf = 0; tf < 4; ++tf) { if (32 * ks > 16 * tf + 15) continue;
            const int t = 16 * tf + r; const v4u cb8 = *(const LAS v4u*)(CB + t * ATT_ST + s0 * 2); float l[8];
#pragma unroll
            for (int e = 0; e < 8; ++e) { const unsigned wd = cb8[e >> 1]; const float cbv = (e & 1) ? bfhi(wd) : bflo(wd); l[e] = (s0 + e <= t) ? cbv * __expf(ct[tf] - cs[e]) * ds[e] : 0.f; }
            const v4u lp = (v4u){pk2(l[0], l[1]), pk2(l[2], l[3]), pk2(l[4], l[5]), pk2(l[6], l[7])}; const bf16x8v bl = __builtin_bit_cast(bf16x8v, lp);
#pragma unroll
            for (int pf = 0; pf < 4; ++pf) acc[pf][tf] = MFMA16(ax[pf], bl, acc[pf][tf]); } }
    const float Dh = F.ssd_D[hd];
#pragma unroll
    for (int tf = 0; tf < 4; ++tf) { const int t = 16 * tf + r; const size_t row = (size_t)(row0 + t); float ss = 0.f;
#pragma unroll
        for (int pf = 0; pf < 4; ++pf) { const int p4 = 64 * w + 16 * pf + 4 * q;
            const v2u xv = *(const LAS v2u*)(X + t * X_ST + p4 * 2); const v2u zv = *(const v2u*)(F.PROJ + row * NP + CZ + g * 512 + p4);
            f32x4 y = acc[pf][tf];
            y.x = (y.x + Dh * bflo(xv.x)) * silu_f(bflo(zv.x)); y.y = (y.y + Dh * bfhi(xv.x)) * silu_f(bfhi(zv.x)); y.z = (y.z + Dh * bflo(xv.y)) * silu_f(bflo(zv.y)); y.w = (y.w + Dh * bfhi(xv.y)) * silu_f(bfhi(zv.y));
            acc[pf][tf] = y; ss += (y.x * y.x + y.y * y.y) + (y.z * y.z + y.w * y.w); }
        ss += __shfl_xor(ss, 16); ss += __shfl_xor(ss, 32);
        if (q == 0) red[w * 64 + t] = ss; }
    __syncthreads();
#pragma unroll
    for (int tf = 0; tf < 4; ++tf) { const int t = 16 * tf + r; const size_t row = (size_t)(row0 + t); float tot = 0.f;
#pragma unroll
        for (int ww = 0; ww < 8; ++ww) tot += red[ww * 64 + t];
        const float rr = rsqrtf(tot * (1.f / 512.f) + EPS);
#pragma unroll
        for (int pf = 0; pf < 4; ++pf) { const int p4 = g * 512 + 64 * w + 16 * pf + 4 * q; const f32x4 nw = *(const f32x4*)(F.ssd_norm + p4);
            f32x4 o = acc[pf][tf]; o.x *= rr * nw.x; o.y *= rr * nw.y; o.z *= rr * nw.z; o.w *= rr * nw.w;
            *(v2u*)(F.MIXIN + row * DM + 1024 + p4) = pk4(o); } }
    __syncthreads();
}

__device__ __forceinline__ void p2a_chunk_states(Frame& F) {
    for (int idx = F.bid; idx < 768; idx += F.G) { if (idx < 256) ssd_passA_unit(F, idx); else gla_passA_unit(F, idx - 256); }
}
__device__ __forceinline__ void p2b_scans_and_sample(Frame& F) {
    gla_scan(F); ssd_scan(F);
    for (int idx = F.bid; idx < SB * GH + SB * SG; idx += F.G) { if (idx < SB * GH) gla_direct_unit<1>(F, idx / GH, idx % GH); else ssd_direct_unit<1>(F, (idx - SB * GH) / SG, (idx - SB * GH) % SG); }
}
__device__ __forceinline__ void p2c_outputs(Frame& F) {
    for (int idx = F.bid; idx < 768; idx += F.G) { if (idx < 256) ssd_passC_unit(F, idx); else gla_passC_unit(F, idx - 256); }
    const int gt = F.bid * NTHR + F.tid, NT = F.G * NTHR;
    for (int i = gt; i < (PB + SB) * 3 * SCH; i += NT) { const int c = i % SCH, j = (i / SCH) % 3, s = i / (3 * SCH);
        const int grp = s >= PB, b = grp ? s - PB : s, L = grp ? SL : PL, row0 = grp ? MP + b * SL : b * PL;
        F.out[(grp ? O_SCONV_S : O_SCONV_P) + ((size_t)b * 3 + j) * SCH + c] = bf2f(F.PROJ[(size_t)(row0 + L - 3 + j) * NP + CX + c]); }
}

__device__ __forceinline__ void p4_post_mixer(Frame& F) {
    const int gw = F.bid * NWAVES + F.wave, NGW = F.G * NWAVES, lane = F.lane;
    for (int m = gw; m < M; m += NGW) {
        const f32x4* mr = (const f32x4*)(F.MIX + (size_t)m * DM) + lane; const f32x4* xr = (const f32x4*)x_row(F, m) + lane;
        const f32x4* w1 = (const f32x4*)F.n_mix_post + lane; const f32x4* w2 = (const f32x4*)F.n_ffn_pre + lane;
        f32x4 v[8]; float s = 0.f;
#pragma unroll
        for (int j = 0; j < 8; ++j) { v[j] = mr[64 * j]; s += (v[j].x * v[j].x + v[j].y * v[j].y) + (v[j].z * v[j].z + v[j].w * v[j].w); }
        const float r1 = rsqrtf(wave_sum(s) * (1.f / DM) + EPS); float s2 = 0.f;
        f32x4* ho = (f32x4*)(F.out + O_Y + (size_t)m * DM) + lane;
#pragma unroll
        for (int j = 0; j < 8; ++j) { v[j] = xr[64 * j] + v[j] * r1 * w1[64 * j]; ho[64 * j] = v[j]; s2 += (v[j].x * v[j].x + v[j].y * v[j].y) + (v[j].z * v[j].z + v[j].w * v[j].w); }
        const float r2 = rsqrtf(wave_sum(s2) * (1.f / DM) + EPS);
        v2u* o8 = (v2u*)(F.XN + (size_t)m * DM) + lane;
#pragma unroll
        for (int j = 0; j < 8; ++j) { const f32x4 ww = w2[64 * j]; v2u o; o.x = pk2(v[j].x * r2 * ww.x, v[j].y * r2 * ww.y); o.y = pk2(v[j].z * r2 * ww.z, v[j].w * r2 * ww.w); o8[64 * j] = o; }
    }
}
__device__ __forceinline__ void u_row8(const Frame& F, int grp, int b, int row0, int tt, int c, float* o) {
    if (tt >= 0) { const v4u r = *(const v4u*)(F.U + (size_t)(row0 + tt) * FF2 + c);
        o[0] = bflo(r.x); o[1] = bfhi(r.x); o[2] = bflo(r.y); o[3] = bfhi(r.y); o[4] = bflo(r.z); o[5] = bfhi(r.z); o[6] = bflo(r.w); o[7] = bfhi(r.w); }
    else if (grp) { const f32x4* s = (const f32x4*)(F.st_fconv + ((size_t)b * 2 + (tt + 2)) * FF2 + c); const f32x4 a = s[0], d = s[1];
        o[0] = a.x; o[1] = a.y; o[2] = a.z; o[3] = a.w; o[4] = d.x; o[5] = d.y; o[6] = d.z; o[7] = d.w; }
    else {
#pragma unroll
        for (int e = 0; e < 8; ++e) o[e] = 0.f; }
}
__device__ __forceinline__ void ld8(const float* p, float* o) { const f32x4 a = *(const f32x4*)p, d = *(const f32x4*)(p + 4); o[0] = a.x; o[1] = a.y; o[2] = a.z; o[3] = a.w; o[4] = d.x; o[5] = d.y; o[6] = d.z; o[7] = d.w; }
__device__ __forceinline__ void p6_conv_act(Frame& F) {
    const int gt = F.bid * NTHR + F.tid, NT = F.G * NTHR;
    constexpr int NCG = FF / 8, NTB = M / 8;
    for (int it = gt; it < NTB * NCG; it += NT) { const int cg = it % NCG, tb = it / NCG, c = cg * 8, rowb = tb * 8;
        const int grp = rowb >= MP, b = grp ? (rowb - MP) / SL : rowb / PL, row0 = grp ? MP + b * SL : b * PL, t0 = rowb - row0;
        float wa[3][8], wb[3][8], ba[8], bb[8];
#pragma unroll
        for (int j = 0; j < 3; ++j) { ld8(F.fconv_w + j * FF2 + c, wa[j]); ld8(F.fconv_w + j * FF2 + FF + c, wb[j]); }
        ld8(F.fconv_b + c, ba); ld8(F.fconv_b + FF + c, bb);
        float a0[8], a1[8], a2[8], b0[8], b1[8], b2[8];
        u_row8(F, grp, b, row0, t0 - 2, c, a0); u_row8(F, grp, b, row0, t0 - 1, c, a1);
        u_row8(F, grp, b, row0, t0 - 2, FF + c, b0); u_row8(F, grp, b, row0, t0 - 1, FF + c, b1);
#pragma unroll
        for (int t = 0; t < 8; ++t) { u_row8(F, grp, b, row0, t0 + t, c, a2); u_row8(F, grp, b, row0, t0 + t, FF + c, b2);
            float r[8];
#pragma unroll
            for (int e = 0; e < 8; ++e) { const float a = ba[e] + wa[0][e] * a0[e] + wa[1][e] * a1[e] + wa[2][e] * a2[e], g = bb[e] + wb[0][e] * b0[e] + wb[1][e] * b1[e] + wb[2][e] * b2[e];
                r[e] = silu_f(a) * g; a0[e] = a1[e]; a1[e] = a2[e]; b0[e] = b1[e]; b1[e] = b2[e]; }
            *(v4u*)(F.ACT + (size_t)(rowb + t) * FF + c) = (v4u){pk2(r[0], r[1]), pk2(r[2], r[3]), pk2(r[4], r[5]), pk2(r[6], r[7])}; } }
    for (int i = gt; i < (PB + SB) * 2 * FF2; i += NT) { const int c = i % FF2, j = (i / FF2) % 2, s = i / (2 * FF2);
        const int grp = s >= PB, b = grp ? s - PB : s, L = grp ? SL : PL, row0 = grp ? MP + b * SL : b * PL;
        F.out[(grp ? O_FCONV_S : O_FCONV_P) + ((size_t)b * 2 + j) * FF2 + c] = bf2f(F.U[(size_t)(row0 + L - 2 + j) * FF2 + c]); }
}
__device__ __forceinline__ void p8_final(Frame& F) {
    const int gw = F.bid * NWAVES + F.wave, NGW = F.G * NWAVES, lane = F.lane;
    for (int m = gw; m < M; m += NGW) {
        const f32x4* fr = (const f32x4*)(F.Fb + (size_t)m * DM) + lane; const f32x4* w1 = (const f32x4*)F.n_ffn_post + lane;
        f32x4* ho = (f32x4*)(F.out + O_Y + (size_t)m * DM) + lane;
        f32x4 v[8]; float s = 0.f;
#pragma unroll
        for (int j = 0; j < 8; ++j) { v[j] = fr[64 * j]; s += (v[j].x * v[j].x + v[j].y * v[j].y) + (v[j].z * v[j].z + v[j].w * v[j].w); }
        const float r1 = rsqrtf(wave_sum(s) * (1.f / DM) + EPS);
#pragma unroll
        for (int j = 0; j < 8; ++j) ho[64 * j] = ho[64 * j] + v[j] * r1 * w1[64 * j];
    }
}

__device__ __forceinline__ pg8::SplitCtx split_ctx(const Frame& F, unsigned char* ws, size_t slab_off, int bank) {
    pg8::SplitCtx X; X.slabs = (pg8::f32x4*)(ws + slab_off); X.cnt = (unsigned*)(ws + WS_CTL) + CW_SPLIT + bank * 1024; X.flag = (volatile LAS unsigned*)(F.lds + MISC_OFF) + 16; return X; }

struct Args { const float* in[25]; float* out; unsigned char* ws; int ph_lo, ph_hi; };
__global__ void __launch_bounds__(NTHR, 2) fwd_kernel(Args args) {
    extern __shared__ __attribute__((aligned(16))) unsigned char lds[];
    Frame F;
    F.lds = (LAS unsigned char*)lds;
    F.tid = threadIdx.x; F.lane = F.tid & 63; F.wave = __builtin_amdgcn_readfirstlane(F.tid >> 6);
    F.G = gridDim.x; F.bid = blockIdx.x;
    unsigned char* ws = args.ws;
    F.x_p = args.in[0]; F.x_s = args.in[1]; F.st_gla = args.in[2]; F.st_ssd = args.in[3]; F.st_sconv = args.in[4]; F.st_fconv = args.in[5];
    F.n_mix_pre = args.in[6]; F.n_mix_post = args.in[7]; F.n_ffn_pre = args.in[8]; F.n_ffn_post = args.in[9]; F.w_in = args.in[10];
    F.w_gate2 = args.in[11]; F.b_gate = args.in[12]; F.gla_norm = args.in[13]; F.sconv_w = args.in[14]; F.sconv_b = args.in[15];
    F.dt_bias = args.in[16]; F.A_log = args.in[17]; F.ssd_D = args.in[18]; F.ssd_norm = args.in[19]; F.w_out = args.in[20];
    F.ffn_w_in = args.in[21]; F.fconv_w = args.in[22]; F.fconv_b = args.in[23]; F.ffn_w_out = args.in[24];
    F.out = args.out;
    F.W1 = (bf16*)(ws + WS_W1); F.WO = (bf16*)(ws + WS_WO); F.WF1 = (bf16*)(ws + WS_WF1); F.WF2 = (bf16*)(ws + WS_WF2);
    F.XN = (bf16*)(ws + WS_XN); F.PROJ = (bf16*)(ws + WS_PROJ); F.MIXIN = (bf16*)(ws + WS_MIXIN); F.U = (bf16*)(ws + WS_U); F.ACT = (bf16*)(ws + WS_ACT);
    F.LRDT = (float*)(ws + WS_LRDT); F.MIX = (float*)(ws + WS_MIX); F.Fb = (float*)(ws + WS_F);
    F.DS = (bf16*)(ws + WS_DS); F.SC = (bf16*)(ws + WS_SC); F.DH = (bf16*)(ws + WS_DH); F.HC = (bf16*)(ws + WS_HC); F.EBL = (float*)(ws + WS_EBL); F.AL = (float*)(ws + WS_AL);
    for (int u = F.tid; u < (LDS_BYTES - LDSCTL_OFF) / 4; u += NTHR) ((LAS unsigned*)(F.lds + LDSCTL_OFF))[u] = 0u;
    __syncthreads();
    const int lo = args.ph_lo, hi = args.ph_hi;
#if !MK_PER_PHASE
    XcdBarrier bar = xcd_barrier_post((unsigned*)(ws + WS_CTL) + CW_BAR, (volatile LAS unsigned*)(F.lds + MISC_OFF) + 8);
    bool first_bar = true;
#define GRID_BAR() do { if (first_bar) { first_bar = false; cg::this_grid().sync(); } xcd_barrier(bar); } while (0)
#else
#define GRID_BAR() do { } while (0)
#endif
#define IN(k) (lo <= (k) && (k) < hi)
#define SEAM(k) do { if (IN(k) && IN((k) + 1)) GRID_BAR(); } while (0)
#ifndef MK_REP_PHASE
#define MK_REP_PHASE (-1)
#endif
#define PHASE(k, ...) do { if (IN(k)) { if (MK_REP_PHASE == (k)) { __VA_ARGS__; GRID_BAR(); } __VA_ARGS__; SEAM(k); } } while (0)
    PHASE(0, p0_prologue(F));
    PHASE(1, { pg8::Gemm g{F.XN, F.W1, M, N1, DM}; pg8::StaticOrder S; S.init(M, N1, DM, F.G, F.bid, 4);
        pg8::EpiBf16 E{F.PROJ, NP, NP / 256, F.LRDT};
        pg8::gemm_phase<pg8::EpiBf16, pg8::StaticOrder, true, true>(F.lds, g, S, E, split_ctx(F, ws, WS_SLAB, 0)); });
    PHASE(2, p2a_chunk_states(F));
    PHASE(3, p2b_scans_and_sample(F));
    PHASE(4, p2c_outputs(F));
    PHASE(5, { pg8::Gemm g{F.MIXIN, F.WO, M, DM, DM}; pg8::StaticOrder S; S.init(M, DM, DM, F.G, F.bid, 8);
        pg8::EpiF32 E{F.MIX, DM};
        pg8::gemm_phase<pg8::EpiF32, pg8::StaticOrder, true, true>(F.lds, g, S, E, split_ctx(F, ws, WS_SLAB, 1)); });
    PHASE(6, p4_post_mixer(F));
    PHASE(7, { pg8::Gemm g{F.XN, F.WF1, M, FF2, DM}; pg8::StaticOrder S; S.init(M, FF2, DM, F.G, F.bid, 4);
        pg8::EpiBf16 E{F.U, FF2, FF2 / 256, nullptr};
        pg8::gemm_phase<pg8::EpiBf16, pg8::StaticOrder, true, true>(F.lds, g, S, E, split_ctx(F, ws, WS_SLAB_F1, 2)); });
    PHASE(8, p6_conv_act(F));
    PHASE(9, { pg8::Gemm g{F.ACT, F.WF2, M, DM, FF}; pg8::StaticOrder S; S.init(M, DM, FF, F.G, F.bid, 8);
        pg8::EpiF32 E{F.Fb, DM};
        pg8::gemm_phase<pg8::EpiF32, pg8::StaticOrder, true, true>(F.lds, g, S, E, split_ctx(F, ws, WS_SLAB, 3)); });
    if (IN(10)) { p8_final(F); }
#undef IN
#undef SEAM
}

extern "C" void kernel_launch(void* const* d_in, const int* in_sizes, int n_in, void* d_out, int out_size, void* d_ws, size_t ws_size, hipStream_t stream) {
    static int grid = 0;
    if (grid == 0) {
        if (n_in != 25 || (size_t)out_size != O_END || ws_size < WS_END) { fprintf(stderr, "kernel_launch: unexpected sizes n_in %d out %d ws %zu (need out %zu ws %zu)\n", n_in, out_size, ws_size, (size_t)O_END, (size_t)WS_END); grid = -1; return; }
        int dev = 0, cus = 0, per_cu = 0;
        hipGetDevice(&dev); hipDeviceGetAttribute(&cus, hipDeviceAttributeMultiprocessorCount, dev);
        if (hipFuncSetAttribute((const void*)fwd_kernel, hipFuncAttributeMaxDynamicSharedMemorySize, LDS_BYTES) != hipSuccess) { fprintf(stderr, "kernel_launch: hipFuncSetAttribute failed\n"); grid = -1; return; }
        hipOccupancyMaxActiveBlocksPerMultiprocessor(&per_cu, (const void*)fwd_kernel, NTHR, LDS_BYTES);
        if (per_cu < 1) { fprintf(stderr, "kernel_launch: occupancy query says %d blocks per CU\n", per_cu); grid = -1; return; }
        grid = cus;
        (void)hipGetLastError();
    }
    if (grid < 0) return;
    Args a{};
    for (int i = 0; i < 25; ++i) a.in[i] = (const float*)d_in[i];
    a.out = (float*)d_out; a.ws = (unsigned char*)d_ws;
#if MK_PER_PHASE
    hipMemsetAsync((char*)d_ws + WS_CTL, 0, CTL_ZERO_BYTES, stream);
    for (int p = 0; p < N_PHASES; ++p) { a.ph_lo = p; a.ph_hi = p + 1; hipLaunchKernelGGL(fwd_kernel, dim3(grid), dim3(NTHR), LDS_BYTES, stream, a); }
#else
    hipMemsetAsync((char*)d_ws + WS_CTL, 0, CTL_ZERO_BYTES, stream);
    a.ph_lo = 0; a.ph_hi = N_PHASES;
    void* kargs[] = {&a};
    hipError_t e = hipLaunchCooperativeKernel((const void*)fwd_kernel, dim3(grid), dim3(NTHR), kargs, LDS_BYTES, stream);
    if (e != hipSuccess) fprintf(stderr, "kernel_launch: cooperative launch failed: %s (grid %d)\n", hipGetErrorString(e), grid);
#endif
}
```

```cpp
#include <hip/hip_runtime.h>
#include <hip/hip_cooperative_groups.h>
#include <cstdio>
#include <cstdint>
namespace cg = cooperative_groups;

#ifndef MK_PER_PHASE
#define MK_PER_PHASE 0
#endif

namespace pg8 {
#define PG8_LAS __attribute__((address_space(3)))
typedef unsigned short bf16_t;
typedef short bf16x8 __attribute__((ext_vector_type(8)));
typedef float f32x4 __attribute__((ext_vector_type(4)));
typedef unsigned u32x4 __attribute__((ext_vector_type(4)));
constexpr int BM = 256, BK = 64, HALF = 128, HTB = HALF * BK * 2  , STAGE_BYTES = 8 * HTB, NXCD = 8, WGM = 8;

__host__ __device__ __forceinline__ int lds_byte(int r, int c) { const int st = (r >> 4) * 2 + (c >> 5), rr = r & 15, cc = c & 31, ob = rr * 64 + cc * 2; return st * 1024 + (ob ^ (((ob >> 9) & 1) << 5)); }
__host__ __device__ __forceinline__ void stage_rc(int b, int& R, int& C) { const int st = b / 1024, sb = b % 1024, swz = sb ^ (((sb >> 9) & 1) << 5); R = (st >> 1) * 16 + swz / 64; C = (st & 1) * 32 + (swz % 64) / 2; }
__host__ __device__ __forceinline__ int perm32(int rho) { const int n = rho >> 4, i = rho & 15; return 8 * (i >> 2) + 4 * n + (i & 3); }

struct Unit { int pm, pn, k0, nk, slice, nsl, tix; };
struct Gemm { const bf16_t* A; const bf16_t* Bt; int M, N, K; };

struct StaticOrder {
    int nM, nN, nwg, G, c, rounds, rem, S, ntK;
    __host__ __device__ __forceinline__ void init(int M, int N, int K, int G_, int c_, int Smax) { nM = M / BM; nN = N / BM; nwg = nM * nN; G = G_; c = c_; ntK = K / BK; rounds = nwg / G; rem = nwg - rounds * G; S = 1;
        if (rem) { while (S < Smax && rem * (S * 2) <= G && (ntK / 2) >= S * 2) S *= 2; } }
    __host__ __device__ __forceinline__ void tile(int L, Unit& u) const {
        int wgid = L; { const int q = nwg / NXCD, r = nwg % NXCD, xcd = wgid % NXCD, off = wgid / NXCD; wgid = (xcd < r ? xcd * (q + 1) : r * (q + 1) + (xcd - r) * q) + off; }
        const int nig = WGM * nN, gid = wgid / nig, fm = gid * WGM, gsz = (nM - fm) < WGM ? (nM - fm) : WGM;
        u.pm = fm + ((wgid % nig) % gsz); u.pn = (wgid % nig) / gsz; }
    __host__ __device__ __forceinline__ bool next(int i, Unit& u) const {
        if (i < rounds) { tile(i * G + c, u); u.k0 = 0; u.nk = ntK; u.slice = 0; u.nsl = 1; u.tix = 0; return true; }
        if (i == rounds && c < rem * S) { const int tix = c % rem, sl = c / rem; tile(rounds * G + tix, u);
            const int pairs = ntK / 2, base = pairs / S, extra = pairs % S, np = base + (sl < extra ? 1 : 0), p0 = sl * base + (sl < extra ? sl : extra);
            u.k0 = 2 * p0; u.nk = 2 * np; u.slice = sl; u.nsl = S; u.tix = tix; return true; }
        return false;
    }
    __device__ __forceinline__ void a_ready(const Unit&) const {}
    __device__ __forceinline__ void done(const Unit&) const {}
};
struct SplitCtx { f32x4* slabs; unsigned* cnt; volatile PG8_LAS unsigned* flag; };
__device__ __forceinline__ int split_reduce(f32x4 (&acc)[2][2][4][2], const Unit& u, const SplitCtx& X, int tid) {
    const __amdgpu_buffer_rsrc_t rs = __builtin_amdgcn_make_buffer_rsrc((void*)X.slabs, (short)0, (int)0x7fffffff, 0x00020000);
    const unsigned mine = (unsigned)((u.tix * u.nsl + u.slice) * 32) * 8192u + (unsigned)tid * 16u;
#pragma unroll
    for (int a = 0; a < 2; ++a)
#pragma unroll
        for (int b = 0; b < 2; ++b)
#pragma unroll
            for (int m = 0; m < 4; ++m)
#pragma unroll
                for (int n = 0; n < 2; ++n) __builtin_amdgcn_raw_buffer_store_b128(__builtin_bit_cast(u32x4, acc[a][b][m][n]), rs, mine + (unsigned)((((a * 2 + b) * 4 + m) * 2 + n) * 8192), 0,   16);
    asm volatile("s_waitcnt vmcnt(0)" ::: "memory");
    __syncthreads();
    if (tid == 0) {
        unsigned* c = X.cnt + 16 * u.tix;
        (void)__hip_atomic_fetch_add(c, 1u, __ATOMIC_RELAXED, __HIP_MEMORY_SCOPE_AGENT);
        unsigned spins = 0;
        while (__hip_atomic_load(c, __ATOMIC_RELAXED, __HIP_MEMORY_SCOPE_AGENT) < (unsigned)u.nsl) { __builtin_amdgcn_s_sleep(2); if (++spins > (1u << 22)) break; }
        __builtin_amdgcn_fence(__ATOMIC_ACQUIRE, "agent");
        asm volatile("s_waitcnt vmcnt(0)" ::: "memory");
    }
    __syncthreads();
    const int shift = u.nsl == 8 ? 2 : (u.nsl == 4 ? 3 : 4);
    for (int s = 0; s < u.nsl; ++s) { if (s == u.slice) continue;
        const f32x4* o = X.slabs + ((size_t)(u.tix * u.nsl + s) * 32) * 512 + tid;
#pragma unroll
        for (int a = 0; a < 2; ++a)
#pragma unroll
            for (int b = 0; b < 2; ++b)
#pragma unroll
                for (int m = 0; m < 4; ++m)
#pragma unroll
                    for (int n = 0; n < 2; ++n) { const int r4 = ((a * 2 + b) * 4 + m) * 2 + n; if ((r4 >> shift) == u.slice) acc[a][b][m][n] += o[(size_t)r4 * 512]; } }
    return shift;
}

__device__ __forceinline__ unsigned cvt_pk_bf16(float lo, float hi) { unsigned r; asm volatile("v_cvt_pk_bf16_f32 %0, %1, %2" : "=v"(r) : "v"(lo), "v"(hi)); return r; }

struct EpiF32 {
    static constexpr bool PERM = false, AFTER_DRAIN = false;
    float* C; int ldc;
    __device__ __forceinline__ void operator()(const f32x4 (&acc)[2][2][4][2], const Unit& u, int wr, int wc, int fr, int fq, int shift, int part) const {
        const int row0 = u.pm * BM + wr * 64 + fr, col0 = u.pn * BM + wc * 32 + 4 * fq;
#pragma unroll
        for (int ai = 0; ai < 2; ++ai)
#pragma unroll
            for (int m = 0; m < 4; ++m) { float* rowp = C + (size_t)(row0 + ai * HALF + m * 16) * ldc + col0;
#pragma unroll
                for (int bj = 0; bj < 2; ++bj)
#pragma unroll
                    for (int n = 0; n < 2; ++n) if ((((((ai * 2 + bj) * 4 + m) * 2 + n)) >> shift) == part) *(f32x4*)(rowp + bj * HALF + n * 16) = acc[ai][bj][m][n]; }
    }
};
struct EpiBf16 {
    static constexpr bool PERM = true, AFTER_DRAIN = false;
    bf16_t* O; int ldc; int nfull; float* X;
    __device__ __forceinline__ void operator()(const f32x4 (&acc)[2][2][4][2], const Unit& u, int wr, int wc, int fr, int fq, int shift, int part) const {
        const int row0 = u.pm * BM + wr * 64 + fr;
        if (u.pn < nfull) {
            const int col0 = u.pn * BM + wc * 32 + 8 * fq;
#pragma unroll
            for (int ai = 0; ai < 2; ++ai)
#pragma unroll
                for (int m = 0; m < 4; ++m) { bf16_t* rowp = O + (size_t)(row0 + ai * HALF + m * 16) * ldc + col0;
#pragma unroll
                    for (int bj = 0; bj < 2; ++bj) { if ((((((ai * 2 + bj) * 4 + m) * 2)) >> shift) != part) continue; const f32x4 v0 = acc[ai][bj][m][0], v1 = acc[ai][bj][m][1];
                        u32x4 w; w.x = cvt_pk_bf16(v0[0], v0[1]); w.y = cvt_pk_bf16(v0[2], v0[3]); w.z = cvt_pk_bf16(v1[0], v1[1]); w.w = cvt_pk_bf16(v1[2], v1[3]);
                        *(u32x4*)(rowp + bj * HALF) = w; } }
        } else if (wc == 0) {
#pragma unroll
            for (int ai = 0; ai < 2; ++ai)
#pragma unroll
                for (int m = 0; m < 4; ++m) { if ((((((ai * 2) * 4 + m) * 2)) >> shift) != part) continue; float* rowp = X + (size_t)(row0 + ai * HALF + m * 16) * 32 + 8 * fq;
                    *(f32x4*)(rowp) = acc[ai][0][m][0]; *(f32x4*)(rowp + 4) = acc[ai][0][m][1]; }
        }
    }
};

template <class Epi, class Sched, bool ALIGN_EPI = false, bool SP2 = false>
__device__ __forceinline__ void gemm_phase(PG8_LAS unsigned char* lds, const Gemm g, const Sched& S, const Epi& E, const SplitCtx& X) {
    const int tid = threadIdx.x, wid = __builtin_amdgcn_readfirstlane(tid >> 6), lane = tid & 63, wr = wid >> 2, wc = wid & 3, fr = lane & 15, fq = lane >> 4;
    const int K = g.K;
    unsigned voffA[2], voffB[2];
#pragma unroll
    for (int i = 0; i < 2; ++i) { int R, C; stage_rc(tid * 16 + i * 8192, R, C); const int Rb = Epi::PERM ? ((R & ~31) + perm32(R & 31)) : R;
        voffA[i] = (unsigned)(R * K + C) * 2u; voffB[i] = (unsigned)(Rb * K + C) * 2u; }
    const size_t kstep = (size_t)(BK * 2);
    const size_t hstep = (size_t)HALF * K * 2;
    const size_t tstep = 2 * hstep;
    const unsigned ldsw = (unsigned)wid * 1024u;
    const int aoff = lds_byte(wr * 64 + fr, fq * 8), boff = lds_byte(wc * 32 + fr, fq * 8);
#define PG8_SA(b, h) (((b) * 2 + (h)) * HTB)
#define PG8_SB(b, h) ((4 + (b) * 2 + (h)) * HTB)
#define PG8_STAGE(bufoff, gbase, voff) do { _Pragma("unroll") for (int _i = 0; _i < 2; ++_i) \
        __builtin_amdgcn_global_load_lds((const unsigned*)((const char*)(gbase) + (voff)[_i]), (PG8_LAS unsigned*)(lds + (bufoff) + ldsw + _i * 8192), 16, 0, 0); } while (0)
#define PG8_LDA(dst, b, h) do { _Pragma("unroll") for (int m = 0; m < 4; ++m) _Pragma("unroll") for (int k = 0; k < 2; ++k) dst[m][k] = *(const PG8_LAS bf16x8*)(lds + PG8_SA(b, h) + aoff + m * 2048 + k * 1024); } while (0)
#define PG8_LDB(dst, b, h) do { _Pragma("unroll") for (int n = 0; n < 2; ++n) _Pragma("unroll") for (int k = 0; k < 2; ++k) dst[n][k] = *(const PG8_LAS bf16x8*)(lds + PG8_SB(b, h) + boff + n * 2048 + k * 1024); } while (0)
#define PG8_MMA(ai, bj, At, Bt) do { __builtin_amdgcn_s_setprio(1); _Pragma("unroll") for (int m = 0; m < 4; ++m) _Pragma("unroll") for (int n = 0; n < 2; ++n) _Pragma("unroll") for (int k = 0; k < 2; ++k) \
        acc[ai][bj][m][n] = __builtin_amdgcn_mfma_f32_16x16x32_bf16(Bt[n][k], At[m][k], acc[ai][bj][m][n], 0, 0, 0); __builtin_amdgcn_s_setprio(0); } while (0)
#define PG8_WAIT_V(n) asm volatile("s_waitcnt vmcnt(" #n ")" ::: "memory")
#define PG8_WAIT_L(n) asm volatile("s_waitcnt lgkmcnt(" #n ")" ::: "memory")
#define PG8_BAR __builtin_amdgcn_s_barrier()
#define PG8_SCHED __builtin_amdgcn_sched_barrier(0)
    Unit cur, nxt; int ui = 0;
    if (!S.next(0, cur)) return;
    f32x4 acc[2][2][4][2];
#pragma unroll
    for (int a = 0; a < 2; ++a)
#pragma unroll
        for (int b = 0; b < 2; ++b)
#pragma unroll
            for (int m = 0; m < 4; ++m)
#pragma unroll
                for (int n = 0; n < 2; ++n) acc[a][b][m][n] = (f32x4){0.f, 0.f, 0.f, 0.f};
    bf16x8 At[4][2], B0[2][2], B1[2][2];
    const char* cA = (const char*)g.A + (size_t)cur.pm * tstep + (size_t)cur.k0 * kstep; const char* cB = (const char*)g.Bt + (size_t)cur.pn * tstep + (size_t)cur.k0 * kstep;
    S.a_ready(cur);
    if constexpr (SP2) {
        PG8_STAGE(PG8_SB(0, 0), cB, voffB); PG8_STAGE(PG8_SB(0, 1), cB + hstep, voffB); PG8_STAGE(PG8_SA(0, 0), cA, voffA); PG8_STAGE(PG8_SA(0, 1), cA + hstep, voffA);
        if (wr == 1) PG8_BAR;
        PG8_WAIT_V(2); PG8_BAR;
        PG8_STAGE(PG8_SB(1, 0), cB + kstep, voffB); PG8_STAGE(PG8_SA(1, 0), cA + kstep, voffA); PG8_STAGE(PG8_SB(1, 1), cB + hstep + kstep, voffB);
        PG8_WAIT_V(6); PG8_BAR;
    } else {
        PG8_STAGE(PG8_SB(0, 0), cB, voffB); PG8_STAGE(PG8_SA(0, 0), cA, voffA); PG8_STAGE(PG8_SB(0, 1), cB + hstep, voffB); PG8_STAGE(PG8_SA(0, 1), cA + hstep, voffA);
        if (wr == 1) PG8_BAR;
        PG8_WAIT_V(4); PG8_BAR;
        PG8_STAGE(PG8_SB(1, 0), cB + kstep, voffB); PG8_STAGE(PG8_SA(1, 0), cA + kstep, voffA); PG8_STAGE(PG8_SB(1, 1), cB + hstep + kstep, voffB);
        PG8_WAIT_V(6); PG8_BAR;
    }
    for (;;) {
        const bool has_next = S.next(ui + 1, nxt);
        const char* nA = has_next ? (const char*)g.A + (size_t)nxt.pm * tstep + (size_t)nxt.k0 * kstep : cA; const char* nB = has_next ? (const char*)g.Bt + (size_t)nxt.pn * tstep + (size_t)nxt.k0 * kstep : cB;
        const int nt = cur.nk;
        for (int t = 0; t < nt; t += 2) {
            const bool last = (t == nt - 2);
            const char* a1 = cA + (size_t)(t + 1) * kstep;
            const char* a2 = last ? nA : cA + (size_t)(t + 2) * kstep; const char* b2 = last ? nB : cB + (size_t)(t + 2) * kstep;
            const char* a3 = a2 + kstep; const char* b3 = b2 + kstep;
            if (last && has_next) S.a_ready(nxt);
            if constexpr (SP2) {
            PG8_LDB(B0, 0, 0); PG8_LDB(B1, 0, 1); PG8_SCHED; PG8_LDA(At, 0, 0); PG8_STAGE(PG8_SA(1, 1), a1 + hstep, voffA);
            PG8_WAIT_V(8); PG8_WAIT_L(0); PG8_BAR; PG8_MMA(0, 0, At, B0); PG8_MMA(0, 1, At, B1); PG8_BAR; PG8_SCHED;
            PG8_LDA(At, 0, 1); PG8_STAGE(PG8_SB(0, 0), b2, voffB); PG8_STAGE(PG8_SB(0, 1), b2 + hstep, voffB); PG8_STAGE(PG8_SA(0, 0), a2, voffA);
            PG8_WAIT_V(8); PG8_WAIT_L(0); PG8_BAR; PG8_MMA(1, 0, At, B0); PG8_MMA(1, 1, At, B1); PG8_BAR; PG8_SCHED;
            PG8_LDB(B0, 1, 0); PG8_LDB(B1, 1, 1); PG8_SCHED; PG8_LDA(At, 1, 0); PG8_STAGE(PG8_SA(0, 1), a2 + hstep, voffA);
            PG8_WAIT_V(8); PG8_WAIT_L(0); PG8_BAR; PG8_MMA(0, 0, At, B0); PG8_MMA(0, 1, At, B1); PG8_BAR; PG8_SCHED;
            PG8_LDA(At, 1, 1); PG8_STAGE(PG8_SB(1, 0), b3, voffB); PG8_STAGE(PG8_SB(1, 1), b3 + hstep, voffB); PG8_STAGE(PG8_SA(1, 0), a3, voffA);
            PG8_WAIT_V(8); PG8_WAIT_L(0); PG8_BAR; PG8_MMA(1, 0, At, B0); PG8_MMA(1, 1, At, B1); PG8_BAR; PG8_SCHED;
            } else {
            PG8_LDB(B0, 0, 0); PG8_SCHED; PG8_LDA(At, 0, 0); PG8_STAGE(PG8_SA(1, 1), a1 + hstep, voffA);
            PG8_WAIT_L(8); PG8_BAR; PG8_WAIT_L(0); PG8_MMA(0, 0, At, B0); PG8_BAR; PG8_SCHED;
            PG8_LDB(B1, 0, 1); PG8_STAGE(PG8_SB(0, 0), b2, voffB);
            PG8_BAR; PG8_WAIT_L(0); PG8_MMA(0, 1, At, B1); PG8_BAR;
            PG8_LDA(At, 0, 1); PG8_STAGE(PG8_SA(0, 0), a2, voffA);
            PG8_BAR; PG8_WAIT_L(0); PG8_MMA(1, 0, At, B0); PG8_BAR; PG8_SCHED;
            PG8_STAGE(PG8_SB(0, 1), b2 + hstep, voffB);
            PG8_WAIT_V(6); PG8_BAR; PG8_MMA(1, 1, At, B1); PG8_BAR;
            PG8_LDB(B0, 1, 0); PG8_SCHED; PG8_LDA(At, 1, 0); PG8_STAGE(PG8_SA(0, 1), a2 + hstep, voffA);
            PG8_WAIT_L(8); PG8_BAR; PG8_WAIT_L(0); PG8_MMA(0, 0, At, B0); PG8_BAR; PG8_SCHED;
            PG8_LDB(B1, 1, 1); PG8_STAGE(PG8_SB(1, 0), b3, voffB);
            PG8_BAR; PG8_WAIT_L(0); PG8_MMA(0, 1, At, B1); PG8_BAR;
            PG8_LDA(At, 1, 1); PG8_STAGE(PG8_SA(1, 0), a3, voffA);
            PG8_BAR; PG8_WAIT_L(0); PG8_MMA(1, 0, At, B0); PG8_BAR; PG8_SCHED;
            PG8_STAGE(PG8_SB(1, 1), b3 + hstep, voffB);
            PG8_WAIT_V(6); PG8_BAR; PG8_MMA(1, 1, At, B1); PG8_BAR;
            }
        }
        if constexpr (ALIGN_EPI) { if (wr == 0) PG8_BAR; }
        if constexpr (!Epi::AFTER_DRAIN) { static_assert(ALIGN_EPI, "split_reduce needs the halves aligned"); if (cur.nsl > 1) { const int shift = split_reduce(acc, cur, X, tid); E(acc, cur, wr, wc, fr, fq, shift, cur.slice); } else E(acc, cur, wr, wc, fr, fq, 5, 0); S.done(cur); }
        if (!has_next) break;
#pragma unroll
        for (int a = 0; a < 2; ++a)
#pragma unroll
            for (int b = 0; b < 2; ++b)
#pragma unroll
                for (int m = 0; m < 4; ++m)
#pragma unroll
                    for (int n = 0; n < 2; ++n) acc[a][b][m][n] = (f32x4){0.f, 0.f, 0.f, 0.f};
        cur = nxt; cA = nA; cB = nB; ++ui;
        if constexpr (ALIGN_EPI) { if (wr == 1) PG8_BAR; }
    }
    PG8_WAIT_V(0);
    if constexpr (!ALIGN_EPI) { if (wr == 0) PG8_BAR; }
    PG8_BAR;
    if constexpr (Epi::AFTER_DRAIN) { E.fused(acc, cur, wr, wc, fr, fq, lds, wid, lane); S.done(cur); }
#undef PG8_SA
#undef PG8_SB
#undef PG8_STAGE
#undef PG8_LDA
#undef PG8_LDB
#undef PG8_MMA
#undef PG8_WAIT_V
#undef PG8_WAIT_L
#undef PG8_BAR
#undef PG8_SCHED
}
}

constexpr int NWAVES = 8, NTHR = 512;
constexpr int DM = 2048, PB = 4, PL = 2048, SB = 128, SL = 8;
constexpr int MP = PB * PL, MS = SB * SL, M = MP + MS;
constexpr int GH = 4, GK = 128, GV = 256, GKD = 512, LOWR = 16;
constexpr int SH = 16, SP = 64, SN = 128, SG = 2, SCH = 1536;
constexpr int FF = 5632, FF2 = 11264, INC = 5664;
constexpr int N1 = 5888, NP = 5632;
constexpr int CQ = 0, CK = 512, CV = 1024, CG = 2048, CZ = 3072, CX = 4096;
constexpr float EPS = 1e-6f;
constexpr int N_PHASES = 11;

constexpr size_t O_Y = 0, O_GLA_P = (size_t)M * DM, O_SSD_P = O_GLA_P + (size_t)PB * GH * GK * GV, O_SCONV_P = O_SSD_P + (size_t)PB * SH * SP * SN,
                 O_FCONV_P = O_SCONV_P + (size_t)PB * 3 * SCH, O_GLA_S = O_FCONV_P + (size_t)PB * 2 * FF2, O_SSD_S = O_GLA_S + (size_t)SB * GH * GK * GV,
                 O_SCONV_S = O_SSD_S + (size_t)SB * SH * SP * SN, O_FCONV_S = O_SCONV_S + (size_t)SB * 3 * SCH, O_END = O_FCONV_S + (size_t)SB * 2 * FF2;

constexpr size_t MiB = 1u << 20;
constexpr size_t WS_CTL = 0, CTL_ZERO_BYTES = 64 * 1024;
constexpr size_t WS_WF2 = 1 * MiB;
constexpr size_t WS_W1 = 24 * MiB;
constexpr size_t WS_WO = 48 * MiB;
constexpr size_t WS_WF1 = 56 * MiB;
constexpr size_t WS_XN = 101 * MiB;
constexpr size_t WS_ACT = 24 * MiB;
constexpr size_t WS_BIG = 141 * MiB;
constexpr size_t WS_PROJ = WS_BIG;
constexpr size_t WS_MIX = WS_BIG;
constexpr size_t WS_U = WS_BIG;
constexpr size_t WS_F = WS_BIG;
constexpr size_t WS_LRDT = WS_BIG + 100 * MiB;
constexpr size_t WS_MIXIN = WS_BIG + 104 * MiB;
constexpr size_t WS_DS = WS_XN;
constexpr size_t WS_SC = WS_BIG + 140 * MiB, WS_DH = WS_BIG + 172 * MiB, WS_HC = WS_BIG + 204 * MiB;
constexpr size_t WS_EBL = WS_BIG + 236 * MiB, WS_AL = WS_EBL + 512 * 1024;
constexpr size_t WS_SLAB = WS_BIG + 140 * MiB;
constexpr size_t WS_SLAB_F1 = WS_BIG + 198 * MiB;
constexpr size_t WS_END = WS_BIG + 247 * MiB;
static_assert(WS_WF2 + (size_t)DM * FF * 2 <= WS_W1 && WS_W1 + (size_t)N1 * DM * 2 <= WS_WO && WS_WO + (size_t)DM * DM * 2 <= WS_WF1 && WS_WF1 + (size_t)FF2 * DM * 2 <= WS_XN && WS_XN + (size_t)M * DM * 2 <= WS_BIG, "ws map 1");
static_assert(WS_ACT + (size_t)M * FF * 2 <= WS_BIG && WS_PROJ + (size_t)M * NP * 2 <= WS_LRDT && WS_LRDT + (size_t)M * 32 * 4 <= WS_MIXIN && WS_MIXIN + (size_t)M * DM * 2 <= WS_SC && WS_U + (size_t)M * FF2 * 2 <= WS_END && WS_MIX + (size_t)M * DM * 4 <= WS_LRDT, "ws map 2");
constexpr int CW_BAR = 1024;
constexpr int CW_SPLIT = 8192;

constexpr int RING_BYTES = 131072;
constexpr int SCRATCH_BYTES = 8 * 16640;
constexpr int LDSCTL_OFF = 133632, MISC_OFF = LDSCTL_OFF + 320;
constexpr int LDS_BYTES = 150016;

#define GAS __attribute__((address_space(1)))
#define LAS __attribute__((address_space(3)))
typedef unsigned short bf16;
typedef unsigned v4u __attribute__((ext_vector_type(4)));
typedef unsigned v2u __attribute__((ext_vector_type(2)));
typedef float f32x4 __attribute__((ext_vector_type(4)));
#define LDS_WAIT() asm volatile("s_waitcnt lgkmcnt(0)" ::: "memory")
#define VM_WAIT() asm volatile("s_waitcnt vmcnt(0)" ::: "memory")
__device__ __forceinline__ unsigned f2bf(float f) { unsigned u = __builtin_bit_cast(unsigned, f); return (u + 0x7fffu + ((u >> 16) & 1u)) >> 16; }
__device__ __forceinline__ unsigned pk2(float lo, float hi) { return f2bf(lo) | (f2bf(hi) << 16); }
__device__ __forceinline__ float bf2f(unsigned short b) { return __builtin_bit_cast(float, (unsigned)b << 16); }
__device__ __forceinline__ float bflo(unsigned w) { return __builtin_bit_cast(float, w << 16); }
__device__ __forceinline__ float bfhi(unsigned w) { return __builtin_bit_cast(float, w & 0xffff0000u); }
__device__ __forceinline__ float silu_f(float x) { return x / (1.f + __expf(-x)); }
__device__ __forceinline__ float softplus_f(float x) { return fmaxf(x, 0.f) + log1pf(__expf(-fabsf(x))); }
__device__ __forceinline__ float logsigmoid_f(float x) { return fminf(x, 0.f) - log1pf(__expf(-fabsf(x))); }
__device__ __forceinline__ float wave_sum(float v) {
#pragma unroll
    for (int o = 1; o < 64; o <<= 1) v += __shfl_xor(v, o);
    return v;
}

#define XB_TMO      128
#define XB_XCNT(j)  (256  + 64 * (j))
#define XB_XSUB(j)  (1280 + 64 * (j))
#define XB_XGEN(j)  (2304 + 64 * (j))
#define XB_TOP      3328
#define XB_TOPGEN   3392
#define XCD_BAR_WORDS 3456
#define XB_SPIN_CAP (1u << 18)

__device__ __forceinline__ unsigned xb_ld(unsigned* p)              { return __hip_atomic_load(p, __ATOMIC_RELAXED, __HIP_MEMORY_SCOPE_AGENT); }
__device__ __forceinline__ unsigned xb_add(unsigned* p, unsigned v) { return __hip_atomic_fetch_add(p, v, __ATOMIC_RELAXED, __HIP_MEMORY_SCOPE_AGENT); }
__device__ __forceinline__ unsigned xb_xcc_id() { return (unsigned)__builtin_amdgcn_s_getreg((3 << 11) | 20) & 0xFu; }
#define XB_SPIN(cond, bar) do { unsigned _sp = 0; while (cond) { __builtin_amdgcn_s_sleep(1); \
    if ((++_sp & 255u) == 0u) { if (xb_ld(&(bar)[XB_TMO])) break; if (_sp > XB_SPIN_CAP) { atomicAdd(&(bar)[XB_TMO], 1u); break; } } } } while (0)

struct XcdBarrier {
    unsigned* bar; unsigned x;
    volatile LAS unsigned* st;
};

__device__ __forceinline__ XcdBarrier xcd_barrier_post(unsigned* bar, volatile LAS unsigned* st) {
    XcdBarrier b; b.bar = bar; b.x = xb_xcc_id(); b.st = st;
    if (threadIdx.x == 0) (void)xb_add(&bar[XB_XCNT(b.x)], 1u);
    return b;
}
__device__ __forceinline__ void xcd_barrier_complete(unsigned* bar, unsigned x, unsigned& nloc, unsigned& nx) {
    const unsigned G = gridDim.x * gridDim.y * gridDim.z;
    unsigned sum, cnt, mine, sp = 0u;
    for (;;) {
        sum = 0u; cnt = 0u; mine = 0u;
#pragma unroll
        for (unsigned j = 0; j < 16; ++j) { const unsigned c = xb_ld(&bar[XB_XCNT(j)]); sum += c; cnt += (c > 0u) ? 1u : 0u; mine = (j == x) ? c : mine; }
        if (sum == G) break;
        __builtin_amdgcn_s_sleep(1);
        if ((++sp & 255u) == 0u) { if (xb_ld(&bar[XB_TMO])) break; if (sp > XB_SPIN_CAP) { atomicAdd(&bar[XB_TMO], 1u); break; } }
    }
    nloc = mine > 0u ? mine : 1u; nx = cnt > 0u ? cnt : 1u;
}

__device__ __forceinline__ void xcd_barrier(const XcdBarrier& b) {
    asm volatile("s_waitcnt vmcnt(0)" ::: "memory");
    __syncthreads();
    if (threadIdx.x == 0) {
        unsigned* bar = b.bar;
        __builtin_amdgcn_s_waitcnt(0);
        unsigned nloc = b.st[0], nx = b.st[1];
        if (nloc == 0u) { xcd_barrier_complete(bar, b.x, nloc, nx); b.st[0] = nloc; b.st[1] = nx; }
        const unsigned old = xb_add(&bar[XB_XSUB(b.x)], 1u);
        const unsigned gen = old / nloc;
        if (old + 1u == (gen + 1u) * nloc) {
            __builtin_amdgcn_fence(__ATOMIC_RELEASE, "agent");
            asm volatile("s_waitcnt vmcnt(0)" ::: "memory");
            const unsigned og = xb_add(&bar[XB_TOP], 1u);
            const unsigned tg = og / nx;
            if (og + 1u == (tg + 1u) * nx) xb_add(&bar[XB_TOPGEN], 1u);
            else XB_SPIN(xb_ld(&bar[XB_TOPGEN]) == tg, bar);
            __builtin_amdgcn_fence(__ATOMIC_ACQUIRE, "agent");
            xb_add(&bar[XB_XGEN(b.x)], 1u);
            asm volatile("s_waitcnt vmcnt(0)" ::: "memory");
        } else {
            XB_SPIN(xb_ld(&bar[XB_XGEN(b.x)]) == gen, bar);
            __builtin_amdgcn_fence(__ATOMIC_ACQUIRE, "agent");
            asm volatile("s_waitcnt vmcnt(0)" ::: "memory");
        }
    }
    __syncthreads();
}

struct Frame {
    LAS unsigned char* lds;
    int tid, lane, wave, G, bid;
    const float *x_p, *x_s, *st_gla, *st_ssd, *st_sconv, *st_fconv, *n_mix_pre, *n_mix_post, *n_ffn_pre, *n_ffn_post, *w_in, *w_gate2, *b_gate, *gla_norm,
                *sconv_w, *sconv_b, *dt_bias, *A_log, *ssd_D, *ssd_norm, *w_out, *ffn_w_in, *fconv_w, *fconv_b, *ffn_w_out;
    float* out;
    bf16 *W1, *WO, *WF1, *WF2, *XN, *PROJ, *MIXIN, *U, *ACT, *DS, *SC, *DH, *HC;
    float *LRDT, *MIX, *Fb, *EBL, *AL;
};
__device__ __forceinline__ const float* x_row(const Frame& F, int row) { return row < MP ? F.x_p + (size_t)row * DM : F.x_s + (size_t)(row - MP) * DM; }

__device__ __forceinline__ int w1_src_col(int n) { return n < 3072 ? n : (n < 5632 ? n + 16 : (n < 5648 ? n - 2560 : (n < 5664 ? n : -1))); }
template <bool MAP>
__device__ __forceinline__ void p0_transpose_item(const float* W, int K, int Nsrc, int Ndst, bf16* WT, LAS float* scr, int item, int lane) {
    const int nblk = Ndst / 64, kb = item / nblk, nb = item % nblk, k0 = 64 * kb, n0 = 64 * nb;
    int sc = n0 + 4 * (lane & 15); if (MAP) sc = w1_src_col(sc);
    f32x4 v[16];
#pragma unroll
    for (int i = 0; i < 16; ++i) { const int kk = 4 * i + (lane >> 4); v[i] = (sc >= 0) ? *(const f32x4*)(W + (size_t)(k0 + kk) * Nsrc + sc) : (f32x4){0.f, 0.f, 0.f, 0.f}; }
#pragma unroll
    for (int i = 0; i < 16; ++i) { const int kk = 4 * i + (lane >> 4); LAS float* d = scr + kk * 65 + 4 * (lane & 15); d[0] = v[i].x; d[1] = v[i].y; d[2] = v[i].z; d[3] = v[i].w; }
    LDS_WAIT(); asm volatile("" ::: "memory");
    const int c = lane & 7;
#pragma unroll
    for (int j = 0; j < 8; ++j) { const int n = (lane >> 3) + 8 * j; const LAS float* s = scr + (8 * c) * 65 + n;
        v4u o; o.x = pk2(s[0 * 65], s[1 * 65]); o.y = pk2(s[2 * 65], s[3 * 65]); o.z = pk2(s[4 * 65], s[5 * 65]); o.w = pk2(s[6 * 65], s[7 * 65]);
        *(v4u*)(WT + (size_t)(n0 + n) * K + k0 + 8 * c) = o; }
    LDS_WAIT(); asm volatile("" ::: "memory");
}
__device__ __forceinline__ void rms_row_to_bf16(const float* xrow, const float* w, bf16* orow, int lane) {
    const f32x4* xr = (const f32x4*)xrow + lane; const f32x4* wr = (const f32x4*)w + lane;
    f32x4 v[8]; float s = 0.f;
#pragma unroll
    for (int j = 0; j < 8; ++j) { v[j] = xr[64 * j]; s += (v[j].x * v[j].x + v[j].y * v[j].y) + (v[j].z * v[j].z + v[j].w * v[j].w); }
    const float r = rsqrtf(wave_sum(s) * (1.f / DM) + EPS);
    v2u* o8 = (v2u*)orow + lane;
#pragma unroll
    for (int j = 0; j < 8; ++j) { const f32x4 ww = wr[64 * j]; v2u o; o.x = pk2(v[j].x * r * ww.x, v[j].y * r * ww.y); o.y = pk2(v[j].z * r * ww.z, v[j].w * r * ww.w); o8[64 * j] = o; }
}
__device__ __forceinline__ void p0_prologue(Frame& F) {
    LAS float* scr = (LAS float*)(F.lds + F.wave * 16640);
    const int gw = F.bid * NWAVES + F.wave, NGW = F.G * NWAVES;
    constexpr int I_1 = (DM / 64) * (N1 / 64);
    for (int it = gw; it < I_1; it += NGW) p0_transpose_item<true>(F.w_in, DM, INC, N1, F.W1, scr, it, F.lane);
    for (int m = gw; m < M; m += NGW) rms_row_to_bf16(x_row(F, m), F.n_mix_pre, F.XN + (size_t)m * DM, F.lane);
}
__device__ __forceinline__ void p0_convert_rest(Frame& F, int vb, int nb) {
    LAS float* scr = (LAS float*)(F.lds + F.wave * 16640);
    const int gw = vb * NWAVES + F.wave, NGW = nb * NWAVES;
    constexpr int I_O = (DM / 64) * (DM / 64), I_F1 = (DM / 64) * (FF2 / 64), I_F2 = (FF / 64) * (DM / 64);
    for (int it = gw; it < I_O + I_F1 + I_F2; it += NGW) {
        int r = it;
        if (r < I_O) { p0_transpose_item<false>(F.w_out, DM, DM, DM, F.WO, scr, r, F.lane); continue; } r -= I_O;
        if (r < I_F1) { p0_transpose_item<false>(F.ffn_w_in, DM, FF2, FF2, F.WF1, scr, r, F.lane); continue; } r -= I_F1;
        p0_transpose_item<false>(F.ffn_w_out, FF, DM, DM, F.WF2, scr, r, F.lane);
    }
}

template <int grp> __device__ __forceinline__ void gla_direct_unit(Frame& F, int b, int h) {
    const int tid = F.tid, v = tid & 255, kh = tid >> 8;
    const int L = grp ? SL : PL, row0 = grp ? MP + b * SL : b * PL;
    LAS float* Es = (LAS float*)F.lds; LAS float* Ks = Es + 1024; LAS float* Qs = Ks + 1024; LAS float* Os = Qs + 1024;
    float S[64];
    if (grp) { const float* s0 = F.st_gla + ((size_t)(b * GH + h) * GK + kh * 64) * GV + v;
#pragma unroll
        for (int i = 0; i < 64; ++i) S[i] = s0[(size_t)i * GV]; }
    else {
#pragma unroll
        for (int i = 0; i < 64; ++i) S[i] = 0.f; }
    for (int t0 = 0; t0 < L; t0 += 8) {
        for (int it = tid; it < 1024; it += NTHR) { const int t = it >> 7, k = it & 127, row = row0 + t0 + t, hk = h * GK + k;
            float x = F.b_gate[hk]; const float* lr = F.LRDT + (size_t)row * 32;
#pragma unroll
            for (int j = 0; j < LOWR; ++j) x += lr[j] * F.w_gate2[j * GKD + hk];
            const float lg = logsigmoid_f(x) * (1.f / 16.f);
            Es[it] = __expf(lg); Ks[it] = bf2f(F.PROJ[(size_t)row * NP + CK + hk]); Qs[it] = bf2f(F.PROJ[(size_t)row * NP + CQ + hk]) * 0.08838834764831845f; }
        __syncthreads();
#pragma unroll 1
        for (int t = 0; t < 8; ++t) { const float vv = bf2f(F.PROJ[(size_t)(row0 + t0 + t) * NP + CV + h * GV + v]); float acc = 0.f;
            const LAS float* e = Es + t * 128 + kh * 64; const LAS float* kk = Ks + t * 128 + kh * 64; const LAS float* qq = Qs + t * 128 + kh * 64;
#pragma unroll
            for (int i = 0; i < 64; ++i) { S[i] = e[i] * S[i] + kk[i] * vv; acc += qq[i] * S[i]; }
            Os[(kh * 8 + t) * 256 + v] = acc; }
        __syncthreads();
        { const int t = F.wave, v4 = F.lane * 4, row = row0 + t0 + t;
            const f32x4 a = *(const LAS f32x4*)(Os + t * 256 + v4), c = *(const LAS f32x4*)(Os + (8 + t) * 256 + v4); const f32x4 o = a + c;
            const float ss = wave_sum((o.x * o.x + o.y * o.y) + (o.z * o.z + o.w * o.w)); const float r = rsqrtf(ss * (1.f / GV) + EPS);
            const v2u gw = *(const v2u*)(F.PROJ + (size_t)row * NP + CG + h * GV + v4); const f32x4 nw = *(const f32x4*)(F.gla_norm + v4);
            v2u w; w.x = pk2(o.x * r * nw.x * silu_f(bflo(gw.x)), o.y * r * nw.y * silu_f(bfhi(gw.x))); w.y = pk2(o.z * r * nw.z * silu_f(bflo(gw.y)), o.w * r * nw.w * silu_f(bfhi(gw.y)));
            *(v2u*)(F.MIXIN + (size_t)row * DM + h * GV + v4) = w; }
        __syncthreads();
    }
    float* so = F.out + (grp ? O_GLA_S : O_GLA_P) + ((size_t)(b * GH + h) * GK + kh * 64) * GV + v;
#pragma unroll
    for (int i = 0; i < 64; ++i) so[(size_t)i * GV] = S[i];
}
__device__ __forceinline__ float xbc_raw(const Frame& F, int grp, int b, int row0, int tt, int c) {
    if (tt >= 0) return bf2f(F.PROJ[(size_t)(row0 + tt) * NP + CX + c]);
    return grp ? F.st_sconv[((size_t)b * 3 + (tt + 3)) * SCH + c] : 0.f;
}
template <int grp> __device__ __forceinline__ void ssd_direct_unit(Frame& F, int b, int g) {
    const int tid = F.tid, hd = g * 8 + (tid >> 6), p = tid & 63, ch = g * 512 + tid;
    const int L = grp ? SL : PL, row0 = grp ? MP + b * SL : b * PL;
    LAS float* Bs = (LAS float*)F.lds; LAS float* Cs = Bs + 1024; LAS float* red = Cs + 1024; LAS float* Ys = red + 64;
    float h[128];
    if (grp) { const f32x4* h0 = (const f32x4*)(F.st_ssd + ((size_t)(b * SH + hd) * SP + p) * SN);
#pragma unroll
        for (int i = 0; i < 32; ++i) { const f32x4 q = h0[i]; h[4 * i] = q.x; h[4 * i + 1] = q.y; h[4 * i + 2] = q.z; h[4 * i + 3] = q.w; } }
    else {
#pragma unroll
        for (int i = 0; i < 128; ++i) h[i] = 0.f; }
    const float A = -__expf(F.A_log[hd]), dtb = F.dt_bias[hd], Dh = F.ssd_D[hd], nw = F.ssd_norm[ch];
    const float cb = F.sconv_b[ch], cw0 = F.sconv_w[ch], cw1 = F.sconv_w[SCH + ch], cw2 = F.sconv_w[2 * SCH + ch], cw3 = F.sconv_w[3 * SCH + ch];
    const int c2 = 1024 + (tid < 128 ? g * 128 + tid : 256 + g * 128 + ((tid - 128) & 127));
    float xr0 = xbc_raw(F, grp, b, row0, -3, ch), xr1 = xbc_raw(F, grp, b, row0, -2, ch), xr2 = xbc_raw(F, grp, b, row0, -1, ch);
    for (int t0 = 0; t0 < L; t0 += 8) {
        if (tid < 256) {
            float xr[11]; const float cb2 = F.sconv_b[c2], d0 = F.sconv_w[c2], d1 = F.sconv_w[SCH + c2], d2 = F.sconv_w[2 * SCH + c2], d3 = F.sconv_w[3 * SCH + c2];
#pragma unroll
            for (int i = 0; i < 11; ++i) xr[i] = xbc_raw(F, grp, b, row0, t0 - 3 + i, c2);
#pragma unroll
            for (int t = 0; t < 8; ++t) Bs[(tid >> 7) * 1024 + t * 128 + (tid & 127)] = silu_f(cb2 + d0 * xr[t] + d1 * xr[t + 1] + d2 * xr[t + 2] + d3 * xr[t + 3]);
        }
        __syncthreads();
#pragma unroll 1
        for (int t = 0; t < 8; ++t) { const int row = row0 + t0 + t;
            const float xn = bf2f(F.PROJ[(size_t)row * NP + CX + ch]);
            const float x = silu_f(cb + cw0 * xr0 + cw1 * xr1 + cw2 * xr2 + cw3 * xn); xr0 = xr1; xr1 = xr2; xr2 = xn;
            const float dt = softplus_f(F.LRDT[(size_t)row * 32 + 16 + hd] + dtb), a = __expf(dt * A), dtx = dt * x;
            float acc = 0.f; const LAS float* bb = Bs + t * 128; const LAS float* cc = Cs + t * 128;
#pragma unroll
            for (int nb = 0; nb < 128; nb += 16) {
#pragma unroll
                for (int n = nb; n < nb + 16; ++n) { h[n] = a * h[n] + dtx * bb[n]; acc += h[n] * cc[n]; }
                asm volatile("" ::: "memory"); }
            const float z = bf2f(F.PROJ[(size_t)row * NP + CZ + ch]);
            const float y = (acc + Dh * x) * silu_f(z);
            Ys[t * 512 + tid] = y;
            const float ss = wave_sum(y * y); if (F.lane == 0) red[t * 8 + F.wave] = ss; }
        __syncthreads();
#pragma unroll
        for (int t = 0; t < 8; ++t) { float tot = 0.f;
#pragma unroll
            for (int w = 0; w < 8; ++w) tot += red[t * 8 + w];
            const float r = rsqrtf(tot * (1.f / 512.f) + EPS);
            F.MIXIN[(size_t)(row0 + t0 + t) * DM + 1024 + ch] = (bf16)f2bf(Ys[t * 512 + tid] * r * nw); }
        __syncthreads();
    }
    f32x4* ho = (f32x4*)(F.out + (grp ? O_SSD_S : O_SSD_P) + ((size_t)(b * SH + hd) * SP + p) * SN);
#pragma unroll
    for (int i = 0; i < 32; ++i) ho[i] = (f32x4){h[4 * i], h[4 * i + 1], h[4 * i + 2], h[4 * i + 3]};
}
typedef short bf16x8v __attribute__((ext_vector_type(8)));
typedef short s16x4v __attribute__((ext_vector_type(4)));
constexpr int CH = 64, NCH = PL / CH;
constexpr int QE_ST = 272, KDT_ST = 144, V_ST = 544, ATT_ST = 144, X_ST = 1056, BC_ST = 288;
#define MFMA16(a, b, c) __builtin_amdgcn_mfma_f32_16x16x32_bf16((a), (b), (c), 0, 0, 0)
__device__ __forceinline__ bf16x8v frag_k(const LAS unsigned char* T, int stride, int idx0, int kk0, int r, int q) { return *(const LAS bf16x8v*)(T + (idx0 + r) * stride + (kk0 + 8 * q) * 2); }
__device__ __forceinline__ bf16x8v frag_t(const LAS unsigned char* T, int stride, int kk0, int idx0, int r, int q) {
    const LAS unsigned char* p = T + (kk0 + 8 * q + (r >> 2)) * stride + (idx0 + 4 * (r & 3)) * 2;
    const s16x4v lo = __builtin_amdgcn_ds_read_tr16_b64_v4i16((LAS s16x4v*)p), hi = __builtin_amdgcn_ds_read_tr16_b64_v4i16((LAS s16x4v*)(p + 4 * stride));
    return (bf16x8v){lo[0], lo[1], lo[2], lo[3], hi[0], hi[1], hi[2], hi[3]};
}
__device__ __forceinline__ v2u pk4(const f32x4 v) { v2u o; o.x = pk2(v.x, v.y); o.y = pk2(v.z, v.w); return o; }

template <int PASS>
__device__ __forceinline__ void gla_chunk_elem(Frame& F, int h, int row0, LAS unsigned char* T0, LAS unsigned char* T1, LAS float* tot, float* ebl_out) {
    const int tid = F.tid, k = tid & 127, tq = tid >> 7, hk = h * GK + k;
    float w2[16];
#pragma unroll
    for (int j = 0; j < 16; ++j) w2[j] = F.w_gate2[j * GKD + hk];
    const float bg = F.b_gate[hk];
    float lg[16]; float run = 0.f;
#pragma unroll
    for (int i = 0; i < 16; ++i) { const float* lr = F.LRDT + (size_t)(row0 + 16 * tq + i) * 32; float x = bg;
#pragma unroll
        for (int j = 0; j < 16; ++j) x += lr[j] * w2[j];
        run += logsigmoid_f(x) * (1.f / 16.f); lg[i] = run; }
    tot[tq * 128 + k] = run;
    __syncthreads();
    float off = 0.f, all = 0.f;
#pragma unroll
    for (int qq = 0; qq < 4; ++qq) { const float v = tot[qq * 128 + k]; all += v; off += (qq < tq) ? v : 0.f; }
    if (PASS == 0) {
        unsigned pk[8];
#pragma unroll
        for (int i = 0; i < 8; ++i) { const size_t ro = (size_t)(row0 + 16 * tq + 2 * i) * NP + CK + hk;
            const float k0 = bf2f(F.PROJ[ro]) * __expf(all - (off + lg[2 * i])), k1 = bf2f(F.PROJ[ro + NP]) * __expf(all - (off + lg[2 * i + 1])); pk[i] = pk2(k0, k1); }
        LAS v4u* d = (LAS v4u*)(T0 + k * KDT_ST + 32 * tq);
        d[0] = (v4u){pk[0], pk[1], pk[2], pk[3]}; d[1] = (v4u){pk[4], pk[5], pk[6], pk[7]};
        if (tq == 0) ebl_out[k] = __expf(all);
    } else {
#pragma unroll
        for (int i = 0; i < 16; ++i) { const int t = 16 * tq + i; const size_t ro = (size_t)(row0 + t) * NP + hk; const float bb = off + lg[i];
            *(LAS bf16*)(T0 + t * QE_ST + k * 2) = (bf16)f2bf(bf2f(F.PROJ[ro + CQ]) * 0.08838834764831845f * __expf(bb));
            *(LAS bf16*)(T1 + t * QE_ST + k * 2) = (bf16)f2bf(bf2f(F.PROJ[ro + CK]) * __expf(-bb)); }
    }
}
__device__ __forceinline__ void gla_load_v(Frame& F, int h, int row0, LAS unsigned char* V) {
#pragma unroll
    for (int i = 0; i < 4; ++i) { const int piece = F.tid + NTHR * i, row = piece >> 5, c16 = piece & 31;
        *(LAS v4u*)(V + row * V_ST + c16 * 16) = *(const v4u*)(F.PROJ + (size_t)(row0 + row) * NP + CV + h * GV + c16 * 8); }
}
__device__ __forceinline__ void gla_passA_unit(Frame& F, int u) {
    const int c = u & 31, bh = u >> 5, b = bh >> 2, h = bh & 3, row0 = b * PL + c * CH;
    LAS unsigned char* KDT = F.lds; LAS unsigned char* V = KDT + 128 * KDT_ST; LAS float* tot = (LAS float*)(V + 64 * V_ST);
    gla_load_v(F, h, row0, V);
    gla_chunk_elem<0>(F, h, row0, KDT, nullptr, tot, F.EBL + (size_t)u * 128);
    __syncthreads();
    const int w = F.wave, r = F.lane & 15, q = F.lane >> 4;
    f32x4 acc[8][2];
#pragma unroll
    for (int kf = 0; kf < 8; ++kf) { acc[kf][0] = (f32x4){0.f, 0.f, 0.f, 0.f}; acc[kf][1] = (f32x4){0.f, 0.f, 0.f, 0.f}; }
#pragma unroll
    for (int ks = 0; ks < 2; ++ks) { const bf16x8v b0 = frag_t(V, V_ST, 32 * ks, 32 * w, r, q), b1 = frag_t(V, V_ST, 32 * ks, 32 * w + 16, r, q);
#pragma unroll
        for (int kf = 0; kf < 8; ++kf) { const bf16x8v a = frag_k(KDT, KDT_ST, 16 * kf, 32 * ks, r, q); acc[kf][0] = MFMA16(a, b0, acc[kf][0]); acc[kf][1] = MFMA16(a, b1, acc[kf][1]); } }
#pragma unroll
    for (int kf = 0; kf < 8; ++kf)
#pragma unroll
        for (int vf = 0; vf < 2; ++vf) *(v2u*)(F.DS + ((size_t)u * GV + 32 * w + 16 * vf + r) * GK + 16 * kf + 4 * q) = pk4(acc[kf][vf]);
    __syncthreads();
}
__device__ __forceinline__ void gla_scan(Frame& F) {
    for (int it = F.bid * NTHR + F.tid; it < PB * GH * GV * 32; it += F.G * NTHR) { const int k4 = it & 31, v = (it >> 5) & 255, bh = it >> 13;
        f32x4 S = (f32x4){0.f, 0.f, 0.f, 0.f};
#pragma unroll 4
        for (int c = 0; c < NCH; ++c) { const int u = bh * NCH + c; const size_t off = ((size_t)u * GV + v) * GK + 4 * k4;
            const v2u d = *(const v2u*)(F.DS + off); const f32x4 e = *(const f32x4*)(F.EBL + (size_t)u * 128 + 4 * k4);
            *(v2u*)(F.SC + off) = pk4(S);
            S.x = e.x * S.x + bflo(d.x); S.y = e.y * S.y + bfhi(d.x); S.z = e.z * S.z + bflo(d.y); S.w = e.w * S.w + bfhi(d.y); }
        float* o = F.out + O_GLA_P + ((size_t)bh * GK + 4 * k4) * GV + v; o[0] = S.x; o[GV] = S.y; o[2 * GV] = S.z; o[3 * GV] = S.w; }
}
__device__ __forceinline__ void gla_passC_unit(Frame& F, int u) {
    const int c = u & 31, bh = u >> 5, b = bh >> 2, h = bh & 3, row0 = b * PL + c * CH;
    LAS unsigned char* QE = F.lds; LAS unsigned char* KE = QE + 64 * QE_ST; LAS unsigned char* V = KE + 64 * QE_ST; LAS unsigned char* ATT = V + 64 * V_ST;
    LAS float* tot = (LAS float*)(ATT + 64 * ATT_ST); LAS float* red = tot + 512;
    gla_load_v(F, h, row0, V);
    gla_chunk_elem<1>(F, h, row0, QE, KE, tot, nullptr);
    __syncthreads();
    const int w = F.wave, r = F.lane & 15, q = F.lane >> 4;
#pragma unroll
    for (int ff = 0; ff < 2; ++ff) { const int f = 2 * w + ff, sf = f >> 2, tf = f & 3; f32x4 a4 = (f32x4){0.f, 0.f, 0.f, 0.f};
        if (sf <= tf) {
#pragma unroll
            for (int ks = 0; ks < 4; ++ks) a4 = MFMA16(frag_k(KE, QE_ST, 16 * sf, 32 * ks, r, q), frag_k(QE, QE_ST, 16 * tf, 32 * ks, r, q), a4); }
        const int s0 = 16 * sf + 4 * q, t = 16 * tf + r;
        f32x4 m; m.x = (s0 <= t) ? a4.x : 0.f; m.y = (s0 + 1 <= t) ? a4.y : 0.f; m.z = (s0 + 2 <= t) ? a4.z : 0.f; m.w = (s0 + 3 <= t) ? a4.w : 0.f;
        *(LAS v2u*)(ATT + t * ATT_ST + s0 * 2) = pk4(m); }
    __syncthreads();
    const int tf = w & 3, vh = w >> 2;
    f32x4 acc[8];
#pragma unroll
    for (int i = 0; i < 8; ++i) acc[i] = (f32x4){0.f, 0.f, 0.f, 0.f};
    const bf16* Sc = F.SC + ((size_t)u * GV + 128 * vh) * GK;
#pragma unroll
    for (int ks = 0; ks < 4; ++ks) { const bf16x8v bq = frag_k(QE, QE_ST, 16 * tf, 32 * ks, r, q);
#pragma unroll
        for (int i = 0; i < 8; ++i) { const bf16x8v a = *(const bf16x8v*)(Sc + (size_t)(16 * i + r) * GK + 32 * ks + 8 * q); acc[i] = MFMA16(a, bq, acc[i]); } }
#pragma unroll
    for (int ks = 0; ks < 2; ++ks) { const bf16x8v ba = frag_k(ATT, ATT_ST, 16 * tf, 32 * ks, r, q);
#pragma unroll
        for (int i = 0; i < 8; ++i) { const bf16x8v a = frag_t(V, V_ST, 32 * ks, 128 * vh + 16 * i, r, q); acc[i] = MFMA16(a, ba, acc[i]); } }
    float ss = 0.f;
#pragma unroll
    for (int i = 0; i < 8; ++i) ss += (acc[i].x * acc[i].x + acc[i].y * acc[i].y) + (acc[i].z * acc[i].z + acc[i].w * acc[i].w);
    ss += __shfl_xor(ss, 16); ss += __shfl_xor(ss, 32);
    const int t = 16 * tf + r;
    if (q == 0) red[vh * 64 + t] = ss;
    __syncthreads();
    const float rr = rsqrtf((red[t] + red[64 + t]) * (1.f / GV) + EPS); const size_t row = (size_t)(row0 + t);
#pragma unroll
    for (int i = 0; i < 8; ++i) { const int v = 128 * vh + 16 * i + 4 * q;
        const v2u gw = *(const v2u*)(F.PROJ + row * NP + CG + h * GV + v); const f32x4 nw = *(const f32x4*)(F.gla_norm + v);
        f32x4 o; o.x = acc[i].x * rr * nw.x * silu_f(bflo(gw.x)); o.y = acc[i].y * rr * nw.y * silu_f(bfhi(gw.x)); o.z = acc[i].z * rr * nw.z * silu_f(bflo(gw.y)); o.w = acc[i].w * rr * nw.w * silu_f(bfhi(gw.y));
        *(v2u*)(F.MIXIN + row * DM + h * GV + v) = pk4(o); }
    __syncthreads();
}

template <bool SCALE>
__device__ __forceinline__ void ssd_conv_item(Frame& F, int b, int g, int c, int cg, int tb, LAS unsigned char* X, LAS unsigned char* BT, LAS unsigned char* CT, const LAS float* WDEC) {
    const int xc = cg < 64 ? g * 512 + 8 * cg : (cg < 80 ? 1024 + g * 128 + 8 * (cg - 64) : 1280 + g * 128 + 8 * (cg - 80));
    float w[4][8], bias[8];
#pragma unroll
    for (int j = 0; j < 4; ++j) { const f32x4 a = *(const f32x4*)(F.sconv_w + j * SCH + xc), bq = *(const f32x4*)(F.sconv_w + j * SCH + xc + 4);
        w[j][0] = a.x; w[j][1] = a.y; w[j][2] = a.z; w[j][3] = a.w; w[j][4] = bq.x; w[j][5] = bq.y; w[j][6] = bq.z; w[j][7] = bq.w; }
    { const f32x4 a = *(const f32x4*)(F.sconv_b + xc), bq = *(const f32x4*)(F.sconv_b + xc + 4); bias[0] = a.x; bias[1] = a.y; bias[2] = a.z; bias[3] = a.w; bias[4] = bq.x; bias[5] = bq.y; bias[6] = bq.z; bias[7] = bq.w; }
    v4u raw[11];
#pragma unroll
    for (int i = 0; i < 11; ++i) { const int tt = c * CH + tb * 8 - 3 + i;
        raw[i] = (tt >= 0) ? *(const v4u*)(F.PROJ + (size_t)(b * PL + tt) * NP + CX + xc) : (v4u){0u, 0u, 0u, 0u}; }
#pragma unroll
    for (int t = 0; t < 8; ++t) { float o[8];
#pragma unroll
        for (int e = 0; e < 8; ++e) { float a = bias[e];
#pragma unroll
            for (int j = 0; j < 4; ++j) { const unsigned wd = raw[t + j][e >> 1]; a += w[j][e] * ((e & 1) ? bfhi(wd) : bflo(wd)); }
            o[e] = silu_f(a); }
        const int tl = tb * 8 + t;
        if (SCALE && cg < 64) { const float sc = WDEC[(cg >> 3) * 64 + tl];
#pragma unroll
            for (int e = 0; e < 8; ++e) o[e] *= sc; }
        const v4u pkd = (v4u){pk2(o[0], o[1]), pk2(o[2], o[3]), pk2(o[4], o[5]), pk2(o[6], o[7])};
        LAS unsigned char* dst = cg < 64 ? X + tl * X_ST + cg * 16 : (cg < 80 ? BT + tl * BC_ST + (cg - 64) * 16 : CT + tl * BC_ST + (cg - 80) * 16);
        *(LAS v4u*)dst = pkd; }
}
__device__ __forceinline__ float ssd_head_scan(Frame& F, int hd, int row0, float& dt_out, float& last) {
    const float dt = softplus_f(F.LRDT[(size_t)(row0 + F.lane) * 32 + 16 + hd] + F.dt_bias[hd]);
    float cum = dt * (-__expf(F.A_log[hd]));
#pragma unroll
    for (int o = 1; o < 64; o <<= 1) { const float v = __shfl_up(cum, o); cum += (F.lane >= o) ? v : 0.f; }
    dt_out = dt; last = __shfl(cum, 63); return cum;
}
__device__ __forceinline__ void ssd_passA_unit(Frame& F, int u) {
    const int c = u & 31, bg = u >> 5, b = bg >> 1, g = bg & 1, row0 = b * PL + c * CH;
    LAS unsigned char* X = F.lds; LAS unsigned char* BT = X + 64 * X_ST; LAS float* WDEC = (LAS float*)(BT + 64 * BC_ST);
    const int w = F.wave, r = F.lane & 15, q = F.lane >> 4;
    { float dt, last; const float cum = ssd_head_scan(F, g * 8 + w, row0, dt, last);
        WDEC[w * 64 + F.lane] = __expf(last - cum) * dt; if (F.lane == 63) F.AL[(size_t)u * 8 + w] = __expf(last); }
    __syncthreads();
    for (int it = F.tid; it < 80 * 8; it += NTHR) ssd_conv_item<true>(F, b, g, c, it % 80, it / 80, X, BT, nullptr, WDEC);
    __syncthreads();
#pragma unroll 1
    for (int nh = 0; nh < 2; ++nh) {
        f32x4 acc[4][4];
#pragma unroll
        for (int i = 0; i < 4; ++i)
#pragma unroll
            for (int j = 0; j < 4; ++j) acc[i][j] = (f32x4){0.f, 0.f, 0.f, 0.f};
#pragma unroll
        for (int ks = 0; ks < 2; ++ks) { bf16x8v bp[4];
#pragma unroll
            for (int pf = 0; pf < 4; ++pf) bp[pf] = frag_t(X, X_ST, 32 * ks, 64 * w + 16 * pf, r, q);
#pragma unroll
            for (int nf = 0; nf < 4; ++nf) { const bf16x8v a = frag_t(BT, BC_ST, 32 * ks, 64 * nh + 16 * nf, r, q);
#pragma unroll
                for (int pf = 0; pf < 4; ++pf) acc[nf][pf] = MFMA16(a, bp[pf], acc[nf][pf]); } }
#pragma unroll
        for (int nf = 0; nf < 4; ++nf)
#pragma unroll
            for (int pf = 0; pf < 4; ++pf) *(v2u*)(F.DH + (((size_t)u * 8 + w) * SP + 16 * pf + r) * SN + 64 * nh + 16 * nf + 4 * q) = pk4(acc[nf][pf]);
    }
    __syncthreads();
}
__device__ __forceinline__ void ssd_scan(Frame& F) {
    for (int it = F.bid * NTHR + F.tid; it < PB * SH * SP * 32; it += F.G * NTHR) { const int n4 = it & 31, p = (it >> 5) & 63, bhd = it >> 11, b = bhd >> 4, hd = bhd & 15, g = hd >> 3, hl = hd & 7;
        f32x4 H = (f32x4){0.f, 0.f, 0.f, 0.f};
#pragma unroll 4
        for (int c = 0; c < NCH; ++c) { const int u = (b * 2 + g) * NCH + c; const size_t off = (((size_t)u * 8 + hl) * SP + p) * SN + 4 * n4;
            const v2u d = *(const v2u*)(F.DH + off); const float a = F.AL[(size_t)u * 8 + hl];
            *(v2u*)(F.HC + off) = pk4(H);
            H.x = a * H.x + bflo(d.x); H.y = a * H.y + bfhi(d.x); H.z = a * H.z + bflo(d.y); H.w = a * H.w + bfhi(d.y); }
        *(f32x4*)(F.out + O_SSD_P + ((size_t)bhd * SP + p) * SN + 4 * n4) = H; }
}
__device__ __forceinline__ void ssd_passC_unit(Frame& F, int u) {
    const int c = u & 31, bg = u >> 5, b = bg >> 1, g = bg & 1, row0 = b * PL + c * CH;
    LAS unsigned char* X = F.lds; LAS unsigned char* BT = X + 64 * X_ST; LAS unsigned char* CT = BT + 64 * BC_ST; LAS unsigned char* CB = CT + 64 * BC_ST;
    LAS float* DT = (LAS float*)(CB + 64 * ATT_ST); LAS float* CUM = DT + 512; LAS float* red = CUM + 512;
    const int w = F.wave, r = F.lane & 15, q = F.lane >> 4, hd = g * 8 + w;
    { float dt, last; const float cum = ssd_head_scan(F, hd, row0, dt, last); DT[w * 64 + F.lane] = dt; CUM[w * 64 + F.lane] = cum; }
    for (int it = F.tid; it < 96 * 8; it += NTHR) ssd_conv_item<false>(F, b, g, c, it % 96, it / 96, X, BT, CT, nullptr);
    __syncthreads();
#pragma unroll
    for (int ff = 0; ff < 2; ++ff) { const int f = 2 * w + ff, sf = f >> 2, tf = f & 3; f32x4 a4 = (f32x4){0.f, 0.f, 0.f, 0.f};
        if (sf <= tf) {
#pragma unroll
            for (int ks = 0; ks < 4; ++ks) a4 = MFMA16(frag_k(BT, BC_ST, 16 * sf, 32 * ks, r, q), frag_k(CT, BC_ST, 16 * tf, 32 * ks, r, q), a4); }
        *(LAS v2u*)(CB + (16 * tf + r) * ATT_ST + (16 * sf + 4 * q) * 2) = pk4(a4); }
    __syncthreads();
    f32x4 acc[4][4];
#pragma unroll
    for (int i = 0; i < 4; ++i)
#pragma unroll
        for (int j = 0; j < 4; ++j) acc[i][j] = (f32x4){0.f, 0.f, 0.f, 0.f};
    const bf16* Hc = F.HC + ((size_t)u * 8 + w) * SP * SN;
#pragma unroll
    for (int ks = 0; ks < 4; ++ks) { bf16x8v bc[4];
#pragma unroll
        for (int tf = 0; tf < 4; ++tf) bc[tf] = frag_k(CT, BC_ST, 16 * tf, 32 * ks, r, q);
#pragma unroll
        for (int pf = 0; pf < 4; ++pf) { const bf16x8v a = *(const bf16x8v*)(Hc + (size_t)(16 * pf + r) * SN + 32 * ks + 8 * q);
#pragma unroll
            for (int tf = 0; tf < 4; ++tf) acc[pf][tf] = MFMA16(a, bc[tf], acc[pf][tf]); } }
    float ct[4];
#pragma unroll
    for (int tf = 0; tf < 4; ++tf) { ct[tf] = CUM[w * 64 + 16 * tf + r]; const float e = __expf(ct[tf]);
#pragma unroll
        for (int pf = 0; pf < 4; ++pf) acc[pf][tf] = acc[pf][tf] * e; }
#pragma unroll
    for (int ks = 0; ks < 2; ++ks) { bf16x8v ax[4];
#pragma unroll
        for (int pf = 0; pf < 4; ++pf) ax[pf] = frag_t(X, X_ST, 32 * ks, 64 * w + 16 * pf, r, q);
        const int s0 = 32 * ks + 8 * q;
        const f32x4 cs0 = *(const LAS f32x4*)(CUM + w * 64 + s0), cs1 = *(const LAS f32x4*)(CUM + w * 64 + s0 + 4), ds0 = *(const LAS f32x4*)(DT + w * 64 + s0), ds1 = *(const LAS f32x4*)(DT + w * 64 + s0 + 4);
        const float cs[8] = {cs0.x, cs0.y, cs0.z, cs0.w, cs1.x, cs1.y, cs1.z, cs1.w}, ds[8] = {ds0.x, ds0.y, ds0.z, ds0.w, ds1.x, ds1.y, ds1.z, ds1.w};
#pragma unroll
        for (int tf = 0; tf < 4; ++tf) { if (32 * ks > 16 * tf + 15) continue;
            const int t = 16 * tf + r; const v4u cb8 = *(const LAS v4u*)(CB + t * ATT_ST + s0 * 2); float l[8];
#pragma unroll
            for (int e = 0; e < 8; ++e) { const unsigned wd = cb8[e >> 1]; const float cbv = (e & 1) ? bfhi(wd) : bflo(wd); l[e] = (s0 + e <= t) ? cbv * __expf(ct[tf] - cs[e]) * ds[e] : 0.f; }
            const v4u lp = (v4u){pk2(l[0], l[1]), pk2(l[2], l[3]), pk2(l[4], l[5]), pk2(l[6], l[7])}; const bf16x8v bl = __builtin_bit_cast(bf16x8v, lp);
#pragma unroll
            for (int pf = 0; pf < 4; ++pf) acc[pf][tf] = MFMA16(ax[pf], bl, acc[pf][tf]); } }
    const float Dh = F.ssd_D[hd];
#pragma unroll
    for (int tf = 0; tf < 4; ++tf) { const int t = 16 * tf + r; const size_t row = (size_t)(row0 + t); float ss = 0.f;
#pragma unroll
        for (int pf = 0; pf < 4; ++pf) { const int p4 = 64 * w + 16 * pf + 4 * q;
            const v2u xv = *(const LAS v2u*)(X + t * X_ST + p4 * 2); const v2u zv = *(const v2u*)(F.PROJ + row * NP + CZ + g * 512 + p4);
            f32x4 y = acc[pf][tf];
            y.x = (y.x + Dh * bflo(xv.x)) * silu_f(bflo(zv.x)); y.y = (y.y + Dh * bfhi(xv.x)) * silu_f(bfhi(zv.x)); y.z = (y.z + Dh * bflo(xv.y)) * silu_f(bflo(zv.y)); y.w = (y.w + Dh * bfhi(xv.y)) * silu_f(bfhi(zv.y));
            acc[pf][tf] = y; ss += (y.x * y.x + y.y * y.y) + (y.z * y.z + y.w * y.w); }
        ss += __shfl_xor(ss, 16); ss += __shfl_xor(ss, 32);
        if (q == 0) red[w * 64 + t] = ss; }
    __syncthreads();
#pragma unroll
    for (int tf = 0; tf < 4; ++tf) { const int t = 16 * tf + r; const size_t row = (size_t)(row0 + t); float tot = 0.f;
#pragma unroll
        for (int ww = 0; ww < 8; ++ww) tot += red[ww * 64 + t];
        const float rr = rsqrtf(tot * (1.f / 512.f) + EPS);
#pragma unroll
        for (int pf = 0; pf < 4; ++pf) { const int p4 = g * 512 + 64 * w + 16 * pf + 4 * q; const f32x4 nw = *(const f32x4*)(F.ssd_norm + p4);
            f32x4 o = acc[pf][tf]; o.x *= rr * nw.x; o.y *= rr * nw.y; o.z *= rr * nw.z; o.w *= rr * nw.w;
            *(v2u*)(F.MIXIN + row * DM + 1024 + p4) = pk4(o); } }
    __syncthreads();
}

__device__ __forceinline__ void p2a_chunk_states(Frame& F) {
    for (int idx = F.bid; idx < 768; idx += F.G) { if (idx < 256) ssd_passA_unit(F, idx); else gla_passA_unit(F, idx - 256); }
}
__device__ __forceinline__ void p2b_scans_and_sample(Frame& F) {
    gla_scan(F); ssd_scan(F);
    for (int idx = F.bid; idx < SB * GH + SB * SG; idx += F.G) { if (idx < SB * GH) gla_direct_unit<1>(F, idx / GH, idx % GH); else ssd_direct_unit<1>(F, (idx - SB * GH) / SG, (idx - SB * GH) % SG); }
}
__device__ __forceinline__ void p2c_outputs(Frame& F) {
    for (int idx = F.bid; idx < 768; idx += F.G) { if (idx < 256) ssd_passC_unit(F, idx); else gla_passC_unit(F, idx - 256); }
    const int gt = F.bid * NTHR + F.tid, NT = F.G * NTHR;
    for (int i = gt; i < (PB + SB) * 3 * SCH; i += NT) { const int c = i % SCH, j = (i / SCH) % 3, s = i / (3 * SCH);
        const int grp = s >= PB, b = grp ? s - PB : s, L = grp ? SL : PL, row0 = grp ? MP + b * SL : b * PL;
        F.out[(grp ? O_SCONV_S : O_SCONV_P) + ((size_t)b * 3 + j) * SCH + c] = bf2f(F.PROJ[(size_t)(row0 + L - 3 + j) * NP + CX + c]); }
}

__device__ __forceinline__ void p4_post_mixer(Frame& F) {
    const int gw = F.bid * NWAVES + F.wave, NGW = F.G * NWAVES, lane = F.lane;
    for (int m = gw; m < M; m += NGW) {
        const f32x4* mr = (const f32x4*)(F.MIX + (size_t)m * DM) + lane; const f32x4* xr = (const f32x4*)x_row(F, m) + lane;
        const f32x4* w1 = (const f32x4*)F.n_mix_post + lane; const f32x4* w2 = (const f32x4*)F.n_ffn_pre + lane;
        f32x4 v[8]; float s = 0.f;
#pragma unroll
        for (int j = 0; j < 8; ++j) { v[j] = mr[64 * j]; s += (v[j].x * v[j].x + v[j].y * v[j].y) + (v[j].z * v[j].z + v[j].w * v[j].w); }
        const float r1 = rsqrtf(wave_sum(s) * (1.f / DM) + EPS); float s2 = 0.f;
        f32x4* ho = (f32x4*)(F.out + O_Y + (size_t)m * DM) + lane;
#pragma unroll
        for (int j = 0; j < 8; ++j) { v[j] = xr[64 * j] + v[j] * r1 * w1[64 * j]; ho[64 * j] = v[j]; s2 += (v[j].x * v[j].x + v[j].y * v[j].y) + (v[j].z * v[j].z + v[j].w * v[j].w); }
        const float r2 = rsqrtf(wave_sum(s2) * (1.f / DM) + EPS);
        v2u* o8 = (v2u*)(F.XN + (size_t)m * DM) + lane;
#pragma unroll
        for (int j = 0; j < 8; ++j) { const f32x4 ww = w2[64 * j]; v2u o; o.x = pk2(v[j].x * r2 * ww.x, v[j].y * r2 * ww.y); o.y = pk2(v[j].z * r2 * ww.z, v[j].w * r2 * ww.w); o8[64 * j] = o; }
    }
}
__device__ __forceinline__ void u_row8(const Frame& F, int grp, int b, int row0, int tt, int c, float* o) {
    if (tt >= 0) { const v4u r = *(const v4u*)(F.U + (size_t)(row0 + tt) * FF2 + c);
        o[0] = bflo(r.x); o[1] = bfhi(r.x); o[2] = bflo(r.y); o[3] = bfhi(r.y); o[4] = bflo(r.z); o[5] = bfhi(r.z); o[6] = bflo(r.w); o[7] = bfhi(r.w); }
    else if (grp) { const f32x4* s = (const f32x4*)(F.st_fconv + ((size_t)b * 2 + (tt + 2)) * FF2 + c); const f32x4 a = s[0], d = s[1];
        o[0] = a.x; o[1] = a.y; o[2] = a.z; o[3] = a.w; o[4] = d.x; o[5] = d.y; o[6] = d.z; o[7] = d.w; }
    else {
#pragma unroll
        for (int e = 0; e < 8; ++e) o[e] = 0.f; }
}
__device__ __forceinline__ void ld8(const float* p, float* o) { const f32x4 a = *(const f32x4*)p, d = *(const f32x4*)(p + 4); o[0] = a.x; o[1] = a.y; o[2] = a.z; o[3] = a.w; o[4] = d.x; o[5] = d.y; o[6] = d.z; o[7] = d.w; }
__device__ __forceinline__ void p6_conv_act(Frame& F) {
    const int gt = F.bid * NTHR + F.tid, NT = F.G * NTHR;
    constexpr int NCG = FF / 8, NTB = M / 8;
    const int tpc = NT / NCG;
    if (gt < tpc * NCG) { const int cg = gt % NCG, c = cg * 8;
        float wa[3][8], wb[3][8], ba[8], bb[8];
#pragma unroll
        for (int j = 0; j < 3; ++j) { ld8(F.fconv_w + j * FF2 + c, wa[j]); ld8(F.fconv_w + j * FF2 + FF + c, wb[j]); }
        ld8(F.fconv_b + c, ba); ld8(F.fconv_b + FF + c, bb);
        for (int tb = gt / NCG; tb < NTB; tb += tpc) { const int rowb = tb * 8;
            const int grp = rowb >= MP, b = grp ? (rowb - MP) / SL : rowb / PL, row0 = grp ? MP + b * SL : b * PL, t0 = rowb - row0;
            float a0[8], a1[8], a2[8], b0[8], b1[8], b2[8];
            u_row8(F, grp, b, row0, t0 - 2, c, a0); u_row8(F, grp, b, row0, t0 - 1, c, a1);
            u_row8(F, grp, b, row0, t0 - 2, FF + c, b0); u_row8(F, grp, b, row0, t0 - 1, FF + c, b1);
#pragma unroll
            for (int t = 0; t < 8; ++t) { u_row8(F, grp, b, row0, t0 + t, c, a2); u_row8(F, grp, b, row0, t0 + t, FF + c, b2);
                float r[8];
#pragma unroll
                for (int e = 0; e < 8; ++e) { const float a = ba[e] + wa[0][e] * a0[e] + wa[1][e] * a1[e] + wa[2][e] * a2[e], g = bb[e] + wb[0][e] * b0[e] + wb[1][e] * b1[e] + wb[2][e] * b2[e];
                    r[e] = silu_f(a) * g; a0[e] = a1[e]; a1[e] = a2[e]; b0[e] = b1[e]; b1[e] = b2[e]; }
                *(v4u*)(F.ACT + (size_t)(rowb + t) * FF + c) = (v4u){pk2(r[0], r[1]), pk2(r[2], r[3]), pk2(r[4], r[5]), pk2(r[6], r[7])}; } } }
    for (int i = gt; i < (PB + SB) * 2 * FF2; i += NT) { const int c = i % FF2, j = (i / FF2) % 2, s = i / (2 * FF2);
        const int grp = s >= PB, b = grp ? s - PB : s, L = grp ? SL : PL, row0 = grp ? MP + b * SL : b * PL;
        F.out[(grp ? O_FCONV_S : O_FCONV_P) + ((size_t)b * 2 + j) * FF2 + c] = bf2f(F.U[(size_t)(row0 + L - 2 + j) * FF2 + c]); }
}
__device__ __forceinline__ void p8_final(Frame& F) {
    const int gw = F.bid * NWAVES + F.wave, NGW = F.G * NWAVES, lane = F.lane;
    for (int m = gw; m < M; m += NGW) {
        const f32x4* fr = (const f32x4*)(F.Fb + (size_t)m * DM) + lane; const f32x4* w1 = (const f32x4*)F.n_ffn_post + lane;
        f32x4* ho = (f32x4*)(F.out + O_Y + (size_t)m * DM) + lane;
        f32x4 v[8]; float s = 0.f;
#pragma unroll
        for (int j = 0; j < 8; ++j) { v[j] = fr[64 * j]; s += (v[j].x * v[j].x + v[j].y * v[j].y) + (v[j].z * v[j].z + v[j].w * v[j].w); }
        const float r1 = rsqrtf(wave_sum(s) * (1.f / DM) + EPS);
#pragma unroll
        for (int j = 0; j < 8; ++j) ho[64 * j] = ho[64 * j] + v[j] * r1 * w1[64 * j];
    }
}

__device__ __forceinline__ pg8::SplitCtx split_ctx(const Frame& F, unsigned char* ws, size_t slab_off, int bank) {
    pg8::SplitCtx X; X.slabs = (pg8::f32x4*)(ws + slab_off); X.cnt = (unsigned*)(ws + WS_CTL) + CW_SPLIT + bank * 1024; X.flag = (volatile LAS unsigned*)(F.lds + MISC_OFF) + 16; return X; }

struct Args { const float* in[25]; float* out; unsigned char* ws; int ph_lo, ph_hi; };
__global__ void __launch_bounds__(NTHR, 2) fwd_kernel(Args args) {
    extern __shared__ __attribute__((aligned(16))) unsigned char lds[];
    Frame F;
    F.lds = (LAS unsigned char*)lds;
    F.tid = threadIdx.x; F.lane = F.tid & 63; F.wave = __builtin_amdgcn_readfirstlane(F.tid >> 6);
    F.G = gridDim.x; F.bid = blockIdx.x;
    unsigned char* ws = args.ws;
    F.x_p = args.in[0]; F.x_s = args.in[1]; F.st_gla = args.in[2]; F.st_ssd = args.in[3]; F.st_sconv = args.in[4]; F.st_fconv = args.in[5];
    F.n_mix_pre = args.in[6]; F.n_mix_post = args.in[7]; F.n_ffn_pre = args.in[8]; F.n_ffn_post = args.in[9]; F.w_in = args.in[10];
    F.w_gate2 = args.in[11]; F.b_gate = args.in[12]; F.gla_norm = args.in[13]; F.sconv_w = args.in[14]; F.sconv_b = args.in[15];
    F.dt_bias = args.in[16]; F.A_log = args.in[17]; F.ssd_D = args.in[18]; F.ssd_norm = args.in[19]; F.w_out = args.in[20];
    F.ffn_w_in = args.in[21]; F.fconv_w = args.in[22]; F.fconv_b = args.in[23]; F.ffn_w_out = args.in[24];
    F.out = args.out;
    F.W1 = (bf16*)(ws + WS_W1); F.WO = (bf16*)(ws + WS_WO); F.WF1 = (bf16*)(ws + WS_WF1); F.WF2 = (bf16*)(ws + WS_WF2);
    F.XN = (bf16*)(ws + WS_XN); F.PROJ = (bf16*)(ws + WS_PROJ); F.MIXIN = (bf16*)(ws + WS_MIXIN); F.U = (bf16*)(ws + WS_U); F.ACT = (bf16*)(ws + WS_ACT);
    F.LRDT = (float*)(ws + WS_LRDT); F.MIX = (float*)(ws + WS_MIX); F.Fb = (float*)(ws + WS_F);
    F.DS = (bf16*)(ws + WS_DS); F.SC = (bf16*)(ws + WS_SC); F.DH = (bf16*)(ws + WS_DH); F.HC = (bf16*)(ws + WS_HC); F.EBL = (float*)(ws + WS_EBL); F.AL = (float*)(ws + WS_AL);
    for (int u = F.tid; u < (LDS_BYTES - LDSCTL_OFF) / 4; u += NTHR) ((LAS unsigned*)(F.lds + LDSCTL_OFF))[u] = 0u;
    __syncthreads();
    const int lo = args.ph_lo, hi = args.ph_hi;
#if !MK_PER_PHASE
    XcdBarrier bar = xcd_barrier_post((unsigned*)(ws + WS_CTL) + CW_BAR, (volatile LAS unsigned*)(F.lds + MISC_OFF) + 8);
#define GRID_BAR() do { if (args.ph_hi > 1000) cg::this_grid().sync(); xcd_barrier(bar); } while (0)
#else
#define GRID_BAR() do { } while (0)
#endif
#define IN(k) (lo <= (k) && (k) < hi)
#define SEAM(k) do { if (IN(k) && IN((k) + 1)) GRID_BAR(); } while (0)
#ifndef MK_REP_PHASE
#define MK_REP_PHASE (-1)
#endif
#define PHASE(k, ...) do { if (IN(k)) { if (MK_REP_PHASE == (k)) { __VA_ARGS__; GRID_BAR(); } __VA_ARGS__; SEAM(k); } } while (0)
    PHASE(0, p0_prologue(F));
    PHASE(1, { pg8::Gemm g{F.XN, F.W1, M, N1, DM}; pg8::StaticOrder S; S.init(M, N1, DM, F.G, F.bid, 1);
        pg8::EpiBf16 E{F.PROJ, NP, NP / 256, F.LRDT};
        pg8::gemm_phase<pg8::EpiBf16, pg8::StaticOrder, true, true>(F.lds, g, S, E, split_ctx(F, ws, WS_SLAB, 0));
        if (S.rem && F.bid >= S.rem * S.S) p0_convert_rest(F, F.bid - S.rem * S.S, F.G - S.rem * S.S); else if (!S.rem) p0_convert_rest(F, F.bid, F.G); });
    PHASE(2, p2a_chunk_states(F));
    PHASE(3, p2b_scans_and_sample(F));
    PHASE(4, p2c_outputs(F));
    PHASE(5, { pg8::Gemm g{F.MIXIN, F.WO, M, DM, DM}; pg8::StaticOrder S; S.init(M, DM, DM, F.G, F.bid, 8);
        pg8::EpiF32 E{F.MIX, DM};
        pg8::gemm_phase<pg8::EpiF32, pg8::StaticOrder, true, true>(F.lds, g, S, E, split_ctx(F, ws, WS_SLAB, 1)); });
    PHASE(6, p4_post_mixer(F));
    PHASE(7, { pg8::Gemm g{F.XN, F.WF1, M, FF2, DM}; pg8::StaticOrder S; S.init(M, FF2, DM, F.G, F.bid, 4);
        pg8::EpiBf16 E{F.U, FF2, FF2 / 256, nullptr};
        pg8::gemm_phase<pg8::EpiBf16, pg8::StaticOrder, true, true>(F.lds, g, S, E, split_ctx(F, ws, WS_SLAB_F1, 2)); });
    PHASE(8, p6_conv_act(F));
    PHASE(9, { pg8::Gemm g{F.ACT, F.WF2, M, DM, FF}; pg8::StaticOrder S; S.init(M, DM, FF, F.G, F.bid, 8);
        pg8::EpiF32 E{F.Fb, DM};
        pg8::gemm_phase<pg8::EpiF32, pg8::StaticOrder, true, true>(F.lds, g, S, E, split_ctx(F, ws, WS_SLAB, 3)); });
    if (IN(10)) { p8_final(F); }
#undef IN
#undef SEAM
}

extern "C" void kernel_launch(void* const* d_in, const int* in_sizes, int n_in, void* d_out, int out_size, void* d_ws, size_t ws_size, hipStream_t stream) {
    static int grid = 0;
    if (grid == 0) {
        if (n_in != 25 || (size_t)out_size != O_END || ws_size < WS_END) { fprintf(stderr, "kernel_launch: unexpected sizes n_in %d out %d ws %zu (need out %zu ws %zu)\n", n_in, out_size, ws_size, (size_t)O_END, (size_t)WS_END); grid = -1; return; }
        int dev = 0, cus = 0, per_cu = 0;
        hipGetDevice(&dev); hipDeviceGetAttribute(&cus, hipDeviceAttributeMultiprocessorCount, dev);
        if (hipFuncSetAttribute((const void*)fwd_kernel, hipFuncAttributeMaxDynamicSharedMemorySize, LDS_BYTES) != hipSuccess) { fprintf(stderr, "kernel_launch: hipFuncSetAttribute failed\n"); grid = -1; return; }
        hipOccupancyMaxActiveBlocksPerMultiprocessor(&per_cu, (const void*)fwd_kernel, NTHR, LDS_BYTES);
        if (per_cu < 1) { fprintf(stderr, "kernel_launch: occupancy query says %d blocks per CU\n", per_cu); grid = -1; return; }
        grid = cus;
        (void)hipGetLastError();
    }
    if (grid < 0) return;
    Args a{};
    for (int i = 0; i < 25; ++i) a.in[i] = (const float*)d_in[i];
    a.out = (float*)d_out; a.ws = (unsigned char*)d_ws;
#if MK_PER_PHASE
    hipMemsetAsync((char*)d_ws + WS_CTL, 0, CTL_ZERO_BYTES, stream);
    for (int p = 0; p < N_PHASES; ++p) { a.ph_lo = p; a.ph_hi = p + 1; hipLaunchKernelGGL(fwd_kernel, dim3(grid), dim3(NTHR), LDS_BYTES, stream, a); }
#else
    hipMemsetAsync((char*)d_ws + WS_CTL, 0, CTL_ZERO_BYTES, stream);
    a.ph_lo = 0; a.ph_hi = N_PHASES;
    void* kargs[] = {&a};
    hipError_t e = hipLaunchCooperativeKernel((const void*)fwd_kernel, dim3(grid), dim3(NTHR), kargs, LDS_BYTES, stream);
    if (e != hipSuccess) fprintf(stderr, "kernel_launch: cooperative launch failed: %s (grid %d)\n", hipGetErrorString(e), grid);
#endif
}
```

```cpp
#include <hip/hip_runtime.h>
#include <hip/hip_cooperative_groups.h>
#include <cstdio>
#include <cstdint>
namespace cg = cooperative_groups;

#ifndef MK_PER_PHASE
#define MK_PER_PHASE 0
#endif

namespace pg8 {
#define PG8_LAS __attribute__((address_space(3)))
typedef unsigned short bf16_t;
typedef short bf16x8 __attribute__((ext_vector_type(8)));
typedef float f32x4 __attribute__((ext_vector_type(4)));
typedef unsigned u32x4 __attribute__((ext_vector_type(4)));
constexpr int BM = 256, BK = 64, HALF = 128, HTB = HALF * BK * 2  , STAGE_BYTES = 8 * HTB, NXCD = 8, WGM = 8;

__host__ __device__ __forceinline__ int lds_byte(int r, int c) { const int st = (r >> 4) * 2 + (c >> 5), rr = r & 15, cc = c & 31, ob = rr * 64 + cc * 2; return st * 1024 + (ob ^ (((ob >> 9) & 1) << 5)); }
__host__ __device__ __forceinline__ void stage_rc(int b, int& R, int& C) { const int st = b / 1024, sb = b % 1024, swz = sb ^ (((sb >> 9) & 1) << 5); R = (st >> 1) * 16 + swz / 64; C = (st & 1) * 32 + (swz % 64) / 2; }
__host__ __device__ __forceinline__ int perm32(int rho) { const int n = rho >> 4, i = rho & 15; return 8 * (i >> 2) + 4 * n + (i & 3); }

struct Unit { int pm, pn, k0, nk, slice, nsl, tix; };
struct Gemm { const bf16_t* A; const bf16_t* Bt; int M, N, K; };

struct StaticOrder {
    int nM, nN, nwg, G, c, rounds, rem, S, ntK;
    __host__ __device__ __forceinline__ void init(int M, int N, int K, int G_, int c_, int Smax) { nM = M / BM; nN = N / BM; nwg = nM * nN; G = G_; c = c_; ntK = K / BK; rounds = nwg / G; rem = nwg - rounds * G; S = 1;
        if (rem) { while (S < Smax && rem * (S * 2) <= G && (ntK / 2) >= S * 2) S *= 2; } }
    __host__ __device__ __forceinline__ void tile(int L, Unit& u) const {
        int wgid = L; { const int q = nwg / NXCD, r = nwg % NXCD, xcd = wgid % NXCD, off = wgid / NXCD; wgid = (xcd < r ? xcd * (q + 1) : r * (q + 1) + (xcd - r) * q) + off; }
        const int nig = WGM * nN, gid = wgid / nig, fm = gid * WGM, gsz = (nM - fm) < WGM ? (nM - fm) : WGM;
        u.pm = fm + ((wgid % nig) % gsz); u.pn = (wgid % nig) / gsz; }
    __host__ __device__ __forceinline__ bool next(int i, Unit& u) const {
        if (i < rounds) { tile(i * G + c, u); u.k0 = 0; u.nk = ntK; u.slice = 0; u.nsl = 1; u.tix = 0; return true; }
        if (i == rounds && c < rem * S) { const int tix = c % rem, sl = c / rem; tile(rounds * G + tix, u);
            const int pairs = ntK / 2, base = pairs / S, extra = pairs % S, np = base + (sl < extra ? 1 : 0), p0 = sl * base + (sl < extra ? sl : extra);
            u.k0 = 2 * p0; u.nk = 2 * np; u.slice = sl; u.nsl = S; u.tix = tix; return true; }
        return false;
    }
    __device__ __forceinline__ void a_ready(const Unit&) const {}
    __device__ __forceinline__ void done(const Unit&) const {}
};
struct SplitCtx { f32x4* slabs; unsigned* cnt; volatile PG8_LAS unsigned* flag; };
__device__ __forceinline__ int split_reduce(f32x4 (&acc)[2][2][4][2], const Unit& u, const SplitCtx& X, int tid) {
    const __amdgpu_buffer_rsrc_t rs = __builtin_amdgcn_make_buffer_rsrc((void*)X.slabs, (short)0, (int)0x7fffffff, 0x00020000);
    const unsigned mine = (unsigned)((u.tix * u.nsl + u.slice) * 32) * 8192u + (unsigned)tid * 16u;
#pragma unroll
    for (int a = 0; a < 2; ++a)
#pragma unroll
        for (int b = 0; b < 2; ++b)
#pragma unroll
            for (int m = 0; m < 4; ++m)
#pragma unroll
                for (int n = 0; n < 2; ++n) __builtin_amdgcn_raw_buffer_store_b128(__builtin_bit_cast(u32x4, acc[a][b][m][n]), rs, mine + (unsigned)((((a * 2 + b) * 4 + m) * 2 + n) * 8192), 0,   16);
    asm volatile("s_waitcnt vmcnt(0)" ::: "memory");
    __syncthreads();
    if (tid == 0) {
        unsigned* c = X.cnt + 16 * u.tix;
        (void)__hip_atomic_fetch_add(c, 1u, __ATOMIC_RELAXED, __HIP_MEMORY_SCOPE_AGENT);
        unsigned spins = 0;
        while (__hip_atomic_load(c, __ATOMIC_RELAXED, __HIP_MEMORY_SCOPE_AGENT) < (unsigned)u.nsl) { __builtin_amdgcn_s_sleep(2); if (++spins > (1u << 22)) break; }
        __builtin_amdgcn_fence(__ATOMIC_ACQUIRE, "agent");
        asm volatile("s_waitcnt vmcnt(0)" ::: "memory");
    }
    __syncthreads();
    const int shift = u.nsl == 8 ? 2 : (u.nsl == 4 ? 3 : 4);
    for (int s = 0; s < u.nsl; ++s) { if (s == u.slice) continue;
        const f32x4* o = X.slabs + ((size_t)(u.tix * u.nsl + s) * 32) * 512 + tid;
#pragma unroll
        for (int a = 0; a < 2; ++a)
#pragma unroll
            for (int b = 0; b < 2; ++b)
#pragma unroll
                for (int m = 0; m < 4; ++m)
#pragma unroll
                    for (int n = 0; n < 2; ++n) { const int r4 = ((a * 2 + b) * 4 + m) * 2 + n; if ((r4 >> shift) == u.slice) acc[a][b][m][n] += o[(size_t)r4 * 512]; } }
    return shift;
}

__device__ __forceinline__ unsigned cvt_pk_bf16(float lo, float hi) { unsigned r; asm volatile("v_cvt_pk_bf16_f32 %0, %1, %2" : "=v"(r) : "v"(lo), "v"(hi)); return r; }

struct EpiF32 {
    static constexpr bool PERM = false, AFTER_DRAIN = false;
    float* C; int ldc;
    __device__ __forceinline__ void operator()(const f32x4 (&acc)[2][2][4][2], const Unit& u, int wr, int wc, int fr, int fq, int shift, int part) const {
        const int row0 = u.pm * BM + wr * 64 + fr, col0 = u.pn * BM + wc * 32 + 4 * fq;
#pragma unroll
        for (int ai = 0; ai < 2; ++ai)
#pragma unroll
            for (int m = 0; m < 4; ++m) { float* rowp = C + (size_t)(row0 + ai * HALF + m * 16) * ldc + col0;
#pragma unroll
                for (int bj = 0; bj < 2; ++bj)
#pragma unroll
                    for (int n = 0; n < 2; ++n) if ((((((ai * 2 + bj) * 4 + m) * 2 + n)) >> shift) == part) *(f32x4*)(rowp + bj * HALF + n * 16) = acc[ai][bj][m][n]; }
    }
};
struct EpiBf16 {
    static constexpr bool PERM = true, AFTER_DRAIN = false;
    bf16_t* O; int ldc; int nfull; float* X;
    __device__ __forceinline__ void operator()(const f32x4 (&acc)[2][2][4][2], const Unit& u, int wr, int wc, int fr, int fq, int shift, int part) const {
        const int row0 = u.pm * BM + wr * 64 + fr;
        if (u.pn < nfull) {
            const int col0 = u.pn * BM + wc * 32 + 8 * fq;
#pragma unroll
            for (int ai = 0; ai < 2; ++ai)
#pragma unroll
                for (int m = 0; m < 4; ++m) { bf16_t* rowp = O + (size_t)(row0 + ai * HALF + m * 16) * ldc + col0;
#pragma unroll
                    for (int bj = 0; bj < 2; ++bj) { if ((((((ai * 2 + bj) * 4 + m) * 2)) >> shift) != part) continue; const f32x4 v0 = acc[ai][bj][m][0], v1 = acc[ai][bj][m][1];
                        u32x4 w; w.x = cvt_pk_bf16(v0[0], v0[1]); w.y = cvt_pk_bf16(v0[2], v0[3]); w.z = cvt_pk_bf16(v1[0], v1[1]); w.w = cvt_pk_bf16(v1[2], v1[3]);
                        *(u32x4*)(rowp + bj * HALF) = w; } }
        } else if (wc == 0) {
#pragma unroll
            for (int ai = 0; ai < 2; ++ai)
#pragma unroll
                for (int m = 0; m < 4; ++m) { if ((((((ai * 2) * 4 + m) * 2)) >> shift) != part) continue; float* rowp = X + (size_t)(row0 + ai * HALF + m * 16) * 32 + 8 * fq;
                    *(f32x4*)(rowp) = acc[ai][0][m][0]; *(f32x4*)(rowp + 4) = acc[ai][0][m][1]; }
        }
    }
};

template <class Epi, class Sched, bool ALIGN_EPI = false, bool SP2 = false>
__device__ __forceinline__ void gemm_phase(PG8_LAS unsigned char* lds, const Gemm g, const Sched& S, const Epi& E, const SplitCtx& X) {
    const int tid = threadIdx.x, wid = __builtin_amdgcn_readfirstlane(tid >> 6), lane = tid & 63, wr = wid >> 2, wc = wid & 3, fr = lane & 15, fq = lane >> 4;
    const int K = g.K;
    unsigned voffA[2], voffB[2];
#pragma unroll
    for (int i = 0; i < 2; ++i) { int R, C; stage_rc(tid * 16 + i * 8192, R, C); const int Rb = Epi::PERM ? ((R & ~31) + perm32(R & 31)) : R;
        voffA[i] = (unsigned)(R * K + C) * 2u; voffB[i] = (unsigned)(Rb * K + C) * 2u; }
    const size_t kstep = (size_t)(BK * 2);
    const size_t hstep = (size_t)HALF * K * 2;
    const size_t tstep = 2 * hstep;
    const unsigned ldsw = (unsigned)wid * 1024u;
    const int aoff = lds_byte(wr * 64 + fr, fq * 8), boff = lds_byte(wc * 32 + fr, fq * 8);
#define PG8_SA(b, h) (((b) * 2 + (h)) * HTB)
#define PG8_SB(b, h) ((4 + (b) * 2 + (h)) * HTB)
#define PG8_STAGE(bufoff, gbase, voff) do { _Pragma("unroll") for (int _i = 0; _i < 2; ++_i) \
        __builtin_amdgcn_global_load_lds((const unsigned*)((const char*)(gbase) + (voff)[_i]), (PG8_LAS unsigned*)(lds + (bufoff) + ldsw + _i * 8192), 16, 0, 0); } while (0)
#define PG8_LDA(dst, b, h) do { _Pragma("unroll") for (int m = 0; m < 4; ++m) _Pragma("unroll") for (int k = 0; k < 2; ++k) dst[m][k] = *(const PG8_LAS bf16x8*)(lds + PG8_SA(b, h) + aoff + m * 2048 + k * 1024); } while (0)
#define PG8_LDB(dst, b, h) do { _Pragma("unroll") for (int n = 0; n < 2; ++n) _Pragma("unroll") for (int k = 0; k < 2; ++k) dst[n][k] = *(const PG8_LAS bf16x8*)(lds + PG8_SB(b, h) + boff + n * 2048 + k * 1024); } while (0)
#define PG8_MMA(ai, bj, At, Bt) do { __builtin_amdgcn_s_setprio(1); _Pragma("unroll") for (int m = 0; m < 4; ++m) _Pragma("unroll") for (int n = 0; n < 2; ++n) _Pragma("unroll") for (int k = 0; k < 2; ++k) \
        acc[ai][bj][m][n] = __builtin_amdgcn_mfma_f32_16x16x32_bf16(Bt[n][k], At[m][k], acc[ai][bj][m][n], 0, 0, 0); __builtin_amdgcn_s_setprio(0); } while (0)
#define PG8_WAIT_V(n) asm volatile("s_waitcnt vmcnt(" #n ")" ::: "memory")
#define PG8_WAIT_L(n) asm volatile("s_waitcnt lgkmcnt(" #n ")" ::: "memory")
#define PG8_BAR __builtin_amdgcn_s_barrier()
#define PG8_SCHED __builtin_amdgcn_sched_barrier(0)
    Unit cur, nxt; int ui = 0;
    if (!S.next(0, cur)) return;
    f32x4 acc[2][2][4][2];
#pragma unroll
    for (int a = 0; a < 2; ++a)
#pragma unroll
        for (int b = 0; b < 2; ++b)
#pragma unroll
            for (int m = 0; m < 4; ++m)
#pragma unroll
                for (int n = 0; n < 2; ++n) acc[a][b][m][n] = (f32x4){0.f, 0.f, 0.f, 0.f};
    bf16x8 At[4][2], B0[2][2], B1[2][2];
    const char* cA = (const char*)g.A + (size_t)cur.pm * tstep + (size_t)cur.k0 * kstep; const char* cB = (const char*)g.Bt + (size_t)cur.pn * tstep + (size_t)cur.k0 * kstep;
    S.a_ready(cur);
    if constexpr (SP2) {
        PG8_STAGE(PG8_SB(0, 0), cB, voffB); PG8_STAGE(PG8_SB(0, 1), cB + hstep, voffB); PG8_STAGE(PG8_SA(0, 0), cA, voffA); PG8_STAGE(PG8_SA(0, 1), cA + hstep, voffA);
        if (wr == 1) PG8_BAR;
        PG8_WAIT_V(2); PG8_BAR;
        PG8_STAGE(PG8_SB(1, 0), cB + kstep, voffB); PG8_STAGE(PG8_SA(1, 0), cA + kstep, voffA); PG8_STAGE(PG8_SB(1, 1), cB + hstep + kstep, voffB);
        PG8_WAIT_V(6); PG8_BAR;
    } else {
        PG8_STAGE(PG8_SB(0, 0), cB, voffB); PG8_STAGE(PG8_SA(0, 0), cA, voffA); PG8_STAGE(PG8_SB(0, 1), cB + hstep, voffB); PG8_STAGE(PG8_SA(0, 1), cA + hstep, voffA);
        if (wr == 1) PG8_BAR;
        PG8_WAIT_V(4); PG8_BAR;
        PG8_STAGE(PG8_SB(1, 0), cB + kstep, voffB); PG8_STAGE(PG8_SA(1, 0), cA + kstep, voffA); PG8_STAGE(PG8_SB(1, 1), cB + hstep + kstep, voffB);
        PG8_WAIT_V(6); PG8_BAR;
    }
    for (;;) {
        const bool has_next = S.next(ui + 1, nxt);
        const char* nA = has_next ? (const char*)g.A + (size_t)nxt.pm * tstep + (size_t)nxt.k0 * kstep : cA; const char* nB = has_next ? (const char*)g.Bt + (size_t)nxt.pn * tstep + (size_t)nxt.k0 * kstep : cB;
        const int nt = cur.nk;
        for (int t = 0; t < nt; t += 2) {
            const bool last = (t == nt - 2);
            const char* a1 = cA + (size_t)(t + 1) * kstep;
            const char* a2 = last ? nA : cA + (size_t)(t + 2) * kstep; const char* b2 = last ? nB : cB + (size_t)(t + 2) * kstep;
            const char* a3 = a2 + kstep; const char* b3 = b2 + kstep;
            if (last && has_next) S.a_ready(nxt);
            if constexpr (SP2) {
            PG8_LDB(B0, 0, 0); PG8_LDB(B1, 0, 1); PG8_SCHED; PG8_LDA(At, 0, 0); PG8_STAGE(PG8_SA(1, 1), a1 + hstep, voffA);
            PG8_WAIT_V(8); PG8_WAIT_L(0); PG8_BAR; PG8_MMA(0, 0, At, B0); PG8_MMA(0, 1, At, B1); PG8_BAR; PG8_SCHED;
            PG8_LDA(At, 0, 1); PG8_STAGE(PG8_SB(0, 0), b2, voffB); PG8_STAGE(PG8_SB(0, 1), b2 + hstep, voffB); PG8_STAGE(PG8_SA(0, 0), a2, voffA);
            PG8_WAIT_V(8); PG8_WAIT_L(0); PG8_BAR; PG8_MMA(1, 0, At, B0); PG8_MMA(1, 1, At, B1); PG8_BAR; PG8_SCHED;
            PG8_LDB(B0, 1, 0); PG8_LDB(B1, 1, 1); PG8_SCHED; PG8_LDA(At, 1, 0); PG8_STAGE(PG8_SA(0, 1), a2 + hstep, voffA);
            PG8_WAIT_V(8); PG8_WAIT_L(0); PG8_BAR; PG8_MMA(0, 0, At, B0); PG8_MMA(0, 1, At, B1); PG8_BAR; PG8_SCHED;
            PG8_LDA(At, 1, 1); PG8_STAGE(PG8_SB(1, 0), b3, voffB); PG8_STAGE(PG8_SB(1, 1), b3 + hstep, voffB); PG8_STAGE(PG8_SA(1, 0), a3, voffA);
            PG8_WAIT_V(8); PG8_WAIT_L(0); PG8_BAR; PG8_MMA(1, 0, At, B0); PG8_MMA(1, 1, At, B1); PG8_BAR; PG8_SCHED;
            } else {
            PG8_LDB(B0, 0, 0); PG8_SCHED; PG8_LDA(At, 0, 0); PG8_STAGE(PG8_SA(1, 1), a1 + hstep, voffA);
            PG8_WAIT_L(8); PG8_BAR; PG8_WAIT_L(0); PG8_MMA(0, 0, At, B0); PG8_BAR; PG8_SCHED;
            PG8_LDB(B1, 0, 1); PG8_STAGE(PG8_SB(0, 0), b2, voffB);
            PG8_BAR; PG8_WAIT_L(0); PG8_MMA(0, 1, At, B1); PG8_BAR;
            PG8_LDA(At, 0, 1); PG8_STAGE(PG8_SA(0, 0), a2, voffA);
            PG8_BAR; PG8_WAIT_L(0); PG8_MMA(1, 0, At, B0); PG8_BAR; PG8_SCHED;
            PG8_STAGE(PG8_SB(0, 1), b2 + hstep, voffB);
            PG8_WAIT_V(6); PG8_BAR; PG8_MMA(1, 1, At, B1); PG8_BAR;
            PG8_LDB(B0, 1, 0); PG8_SCHED; PG8_LDA(At, 1, 0); PG8_STAGE(PG8_SA(0, 1), a2 + hstep, voffA);
            PG8_WAIT_L(8); PG8_BAR; PG8_WAIT_L(0); PG8_MMA(0, 0, At, B0); PG8_BAR; PG8_SCHED;
            PG8_LDB(B1, 1, 1); PG8_STAGE(PG8_SB(1, 0), b3, voffB);
            PG8_BAR; PG8_WAIT_L(0); PG8_MMA(0, 1, At, B1); PG8_BAR;
            PG8_LDA(At, 1, 1); PG8_STAGE(PG8_SA(1, 0), a3, voffA);
            PG8_BAR; PG8_WAIT_L(0); PG8_MMA(1, 0, At, B0); PG8_BAR; PG8_SCHED;
            PG8_STAGE(PG8_SB(1, 1), b3 + hstep, voffB);
            PG8_WAIT_V(6); PG8_BAR; PG8_MMA(1, 1, At, B1); PG8_BAR;
            }
        }
        if constexpr (ALIGN_EPI) { if (wr == 0) PG8_BAR; }
        if constexpr (!Epi::AFTER_DRAIN) { static_assert(ALIGN_EPI, "split_reduce needs the halves aligned"); if (cur.nsl > 1) { const int shift = split_reduce(acc, cur, X, tid); E(acc, cur, wr, wc, fr, fq, shift, cur.slice); } else E(acc, cur, wr, wc, fr, fq, 5, 0); S.done(cur); }
        if (!has_next) break;
#pragma unroll
        for (int a = 0; a < 2; ++a)
#pragma unroll
            for (int b = 0; b < 2; ++b)
#pragma unroll
                for (int m = 0; m < 4; ++m)
#pragma unroll
                    for (int n = 0; n < 2; ++n) acc[a][b][m][n] = (f32x4){0.f, 0.f, 0.f, 0.f};
        cur = nxt; cA = nA; cB = nB; ++ui;
        if constexpr (ALIGN_EPI) { if (wr == 1) PG8_BAR; }
    }
    PG8_WAIT_V(0);
    if constexpr (!ALIGN_EPI) { if (wr == 0) PG8_BAR; }
    PG8_BAR;
    if constexpr (Epi::AFTER_DRAIN) { E.fused(acc, cur, wr, wc, fr, fq, lds, wid, lane); S.done(cur); }
#undef PG8_SA
#undef PG8_SB
#undef PG8_STAGE
#undef PG8_LDA
#undef PG8_LDB
#undef PG8_MMA
#undef PG8_WAIT_V
#undef PG8_WAIT_L
#undef PG8_BAR
#undef PG8_SCHED
}
}

constexpr int NWAVES = 8, NTHR = 512;
constexpr int DM = 2048, PB = 4, PL = 2048, SB = 128, SL = 8;
constexpr int MP = PB * PL, MS = SB * SL, M = MP + MS;
constexpr int GH = 4, GK = 128, GV = 256, GKD = 512, LOWR = 16;
constexpr int SH = 16, SP = 64, SN = 128, SG = 2, SCH = 1536;
constexpr int FF = 5632, FF2 = 11264, INC = 5664;
constexpr int N1 = 5888, NP = 5632;
constexpr int CQ = 0, CK = 512, CV = 1024, CG = 2048, CZ = 3072, CX = 4096;
constexpr float EPS = 1e-6f;
constexpr int N_PHASES = 11;

constexpr size_t O_Y = 0, O_GLA_P = (size_t)M * DM, O_SSD_P = O_GLA_P + (size_t)PB * GH * GK * GV, O_SCONV_P = O_SSD_P + (size_t)PB * SH * SP * SN,
                 O_FCONV_P = O_SCONV_P + (size_t)PB * 3 * SCH, O_GLA_S = O_FCONV_P + (size_t)PB * 2 * FF2, O_SSD_S = O_GLA_S + (size_t)SB * GH * GK * GV,
                 O_SCONV_S = O_SSD_S + (size_t)SB * SH * SP * SN, O_FCONV_S = O_SCONV_S + (size_t)SB * 3 * SCH, O_END = O_FCONV_S + (size_t)SB * 2 * FF2;

constexpr size_t MiB = 1u << 20;
constexpr size_t WS_CTL = 0, CTL_ZERO_BYTES = 64 * 1024;
constexpr size_t WS_WF2 = 1 * MiB;
constexpr size_t WS_W1 = 24 * MiB;
constexpr size_t WS_WO = 48 * MiB;
constexpr size_t WS_WF1 = 56 * MiB;
constexpr size_t WS_XN = 101 * MiB;
constexpr size_t WS_ACT = 24 * MiB;
constexpr size_t WS_BIG = 141 * MiB;
constexpr size_t WS_PROJ = WS_BIG;
constexpr size_t WS_MIX = WS_BIG;
constexpr size_t WS_U = WS_BIG;
constexpr size_t WS_F = WS_BIG;
constexpr size_t WS_LRDT = WS_BIG + 100 * MiB;
constexpr size_t WS_MIXIN = WS_BIG + 104 * MiB;
constexpr size_t WS_DS = WS_XN;
constexpr size_t WS_SC = WS_BIG + 140 * MiB, WS_DH = WS_BIG + 172 * MiB, WS_HC = WS_BIG + 204 * MiB;
constexpr size_t WS_EBL = WS_BIG + 236 * MiB, WS_AL = WS_EBL + 512 * 1024;
constexpr size_t WS_SLAB = WS_BIG + 140 * MiB;
constexpr size_t WS_SLAB_F1 = WS_BIG + 198 * MiB;
constexpr size_t WS_END = WS_BIG + 247 * MiB;
static_assert(WS_WF2 + (size_t)DM * FF * 2 <= WS_W1 && WS_W1 + (size_t)N1 * DM * 2 <= WS_WO && WS_WO + (size_t)DM * DM * 2 <= WS_WF1 && WS_WF1 + (size_t)FF2 * DM * 2 <= WS_XN && WS_XN + (size_t)M * DM * 2 <= WS_BIG, "ws map 1");
static_assert(WS_ACT + (size_t)M * FF * 2 <= WS_BIG && WS_PROJ + (size_t)M * NP * 2 <= WS_LRDT && WS_LRDT + (size_t)M * 32 * 4 <= WS_MIXIN && WS_MIXIN + (size_t)M * DM * 2 <= WS_SC && WS_U + (size_t)M * FF2 * 2 <= WS_END && WS_MIX + (size_t)M * DM * 4 <= WS_LRDT, "ws map 2");
constexpr int CW_BAR = 1024;
constexpr int CW_SPLIT = 8192;

constexpr int RING_BYTES = 131072;
constexpr int SCRATCH_BYTES = 8 * 16640;
constexpr int LDSCTL_OFF = 133632, MISC_OFF = LDSCTL_OFF + 320;
constexpr int LDS_BYTES = 150016;

#define GAS __attribute__((address_space(1)))
#define LAS __attribute__((address_space(3)))
typedef unsigned short bf16;
typedef unsigned v4u __attribute__((ext_vector_type(4)));
typedef unsigned v2u __attribute__((ext_vector_type(2)));
typedef float f32x4 __attribute__((ext_vector_type(4)));
#define LDS_WAIT() asm volatile("s_waitcnt lgkmcnt(0)" ::: "memory")
#define VM_WAIT() asm volatile("s_waitcnt vmcnt(0)" ::: "memory")
__device__ __forceinline__ unsigned f2bf(float f) { unsigned u = __builtin_bit_cast(unsigned, f); return (u + 0x7fffu + ((u >> 16) & 1u)) >> 16; }
__device__ __forceinline__ unsigned pk2(float lo, float hi) { return f2bf(lo) | (f2bf(hi) << 16); }
__device__ __forceinline__ float bf2f(unsigned short b) { return __builtin_bit_cast(float, (unsigned)b << 16); }
__device__ __forceinline__ float bflo(unsigned w) { return __builtin_bit_cast(float, w << 16); }
__device__ __forceinline__ float bfhi(unsigned w) { return __builtin_bit_cast(float, w & 0xffff0000u); }
__device__ __forceinline__ float silu_f(float x) { return x / (1.f + __expf(-x)); }
__device__ __forceinline__ float softplus_f(float x) { return fmaxf(x, 0.f) + log1pf(__expf(-fabsf(x))); }
__device__ __forceinline__ float logsigmoid_f(float x) { return fminf(x, 0.f) - log1pf(__expf(-fabsf(x))); }
__device__ __forceinline__ float wave_sum(float v) {
#pragma unroll
    for (int o = 1; o < 64; o <<= 1) v += __shfl_xor(v, o);
    return v;
}

#define XB_TMO      128
#define XB_XCNT(j)  (256  + 64 * (j))
#define XB_XSUB(j)  (1280 + 64 * (j))
#define XB_XGEN(j)  (2304 + 64 * (j))
#define XB_TOP      3328
#define XB_TOPGEN   3392
#define XCD_BAR_WORDS 3456
#define XB_SPIN_CAP (1u << 18)

__device__ __forceinline__ unsigned xb_ld(unsigned* p)              { return __hip_atomic_load(p, __ATOMIC_RELAXED, __HIP_MEMORY_SCOPE_AGENT); }
__device__ __forceinline__ unsigned xb_add(unsigned* p, unsigned v) { return __hip_atomic_fetch_add(p, v, __ATOMIC_RELAXED, __HIP_MEMORY_SCOPE_AGENT); }
__device__ __forceinline__ unsigned xb_xcc_id() { return (unsigned)__builtin_amdgcn_s_getreg((3 << 11) | 20) & 0xFu; }
#define XB_SPIN(cond, bar) do { unsigned _sp = 0; while (cond) { __builtin_amdgcn_s_sleep(1); \
    if ((++_sp & 255u) == 0u) { if (xb_ld(&(bar)[XB_TMO])) break; if (_sp > XB_SPIN_CAP) { atomicAdd(&(bar)[XB_TMO], 1u); break; } } } } while (0)

struct XcdBarrier {
    unsigned* bar; unsigned x;
    volatile LAS unsigned* st;
};

__device__ __forceinline__ XcdBarrier xcd_barrier_post(unsigned* bar, volatile LAS unsigned* st) {
    XcdBarrier b; b.bar = bar; b.x = xb_xcc_id(); b.st = st;
    if (threadIdx.x == 0) (void)xb_add(&bar[XB_XCNT(b.x)], 1u);
    return b;
}
__device__ __forceinline__ void xcd_barrier_complete(unsigned* bar, unsigned x, unsigned& nloc, unsigned& nx) {
    const unsigned G = gridDim.x * gridDim.y * gridDim.z;
    unsigned sum, cnt, mine, sp = 0u;
    for (;;) {
        sum = 0u; cnt = 0u; mine = 0u;
#pragma unroll
        for (unsigned j = 0; j < 16; ++j) { const unsigned c = xb_ld(&bar[XB_XCNT(j)]); sum += c; cnt += (c > 0u) ? 1u : 0u; mine = (j == x) ? c : mine; }
        if (sum == G) break;
        __builtin_amdgcn_s_sleep(1);
        if ((++sp & 255u) == 0u) { if (xb_ld(&bar[XB_TMO])) break; if (sp > XB_SPIN_CAP) { atomicAdd(&bar[XB_TMO], 1u); break; } }
    }
    nloc = mine > 0u ? mine : 1u; nx = cnt > 0u ? cnt : 1u;
}

__device__ __forceinline__ void xcd_barrier(const XcdBarrier& b) {
    asm volatile("s_waitcnt vmcnt(0)" ::: "memory");
    __syncthreads();
    if (threadIdx.x == 0) {
        unsigned* bar = b.bar;
        __builtin_amdgcn_s_waitcnt(0);
        unsigned nloc = b.st[0], nx = b.st[1];
        if (nloc == 0u) { xcd_barrier_complete(bar, b.x, nloc, nx); b.st[0] = nloc; b.st[1] = nx; }
        const unsigned old = xb_add(&bar[XB_XSUB(b.x)], 1u);
        const unsigned gen = old / nloc;
        if (old + 1u == (gen + 1u) * nloc) {
            __builtin_amdgcn_fence(__ATOMIC_RELEASE, "agent");
            asm volatile("s_waitcnt vmcnt(0)" ::: "memory");
            const unsigned og = xb_add(&bar[XB_TOP], 1u);
            const unsigned tg = og / nx;
            if (og + 1u == (tg + 1u) * nx) xb_add(&bar[XB_TOPGEN], 1u);
            else XB_SPIN(xb_ld(&bar[XB_TOPGEN]) == tg, bar);
            __builtin_amdgcn_fence(__ATOMIC_ACQUIRE, "agent");
            xb_add(&bar[XB_XGEN(b.x)], 1u);
            asm volatile("s_waitcnt vmcnt(0)" ::: "memory");
        } else {
            XB_SPIN(xb_ld(&bar[XB_XGEN(b.x)]) == gen, bar);
            __builtin_amdgcn_fence(__ATOMIC_ACQUIRE, "agent");
            asm volatile("s_waitcnt vmcnt(0)" ::: "memory");
        }
    }
    __syncthreads();
}

struct Frame {
    LAS unsigned char* lds;
    int tid, lane, wave, G, bid;
    const float *x_p, *x_s, *st_gla, *st_ssd, *st_sconv, *st_fconv, *n_mix_pre, *n_mix_post, *n_ffn_pre, *n_ffn_post, *w_in, *w_gate2, *b_gate, *gla_norm,
                *sconv_w, *sconv_b, *dt_bias, *A_log, *ssd_D, *ssd_norm, *w_out, *ffn_w_in, *fconv_w, *fconv_b, *ffn_w_out;
    float* out;
    bf16 *W1, *WO, *WF1, *WF2, *XN, *PROJ, *MIXIN, *U, *ACT, *DS, *SC, *DH, *HC;
    float *LRDT, *MIX, *Fb, *EBL, *AL;
};
__device__ __forceinline__ const float* x_row(const Frame& F, int row) { return row < MP ? F.x_p + (size_t)row * DM : F.x_s + (size_t)(row - MP) * DM; }

__device__ __forceinline__ int w1_src_col(int n) { return n < 3072 ? n : (n < 5632 ? n + 16 : (n < 5648 ? n - 2560 : (n < 5664 ? n : -1))); }
template <bool MAP>
__device__ __forceinline__ void p0_transpose_item(const float* W, int K, int Nsrc, int Ndst, bf16* WT, LAS float* scr, int item, int lane) {
    const int nblk = Ndst / 64, kb = item / nblk, nb = item % nblk, k0 = 64 * kb, n0 = 64 * nb;
    int sc = n0 + 4 * (lane & 15); if (MAP) sc = w1_src_col(sc);
    f32x4 v[16];
#pragma unroll
    for (int i = 0; i < 16; ++i) { const int kk = 4 * i + (lane >> 4); v[i] = (sc >= 0) ? *(const f32x4*)(W + (size_t)(k0 + kk) * Nsrc + sc) : (f32x4){0.f, 0.f, 0.f, 0.f}; }
#pragma unroll
    for (int i = 0; i < 16; ++i) { const int kk = 4 * i + (lane >> 4); LAS float* d = scr + kk * 65 + 4 * (lane & 15); d[0] = v[i].x; d[1] = v[i].y; d[2] = v[i].z; d[3] = v[i].w; }
    LDS_WAIT(); asm volatile("" ::: "memory");
    const int c = lane & 7;
#pragma unroll
    for (int j = 0; j < 8; ++j) { const int n = (lane >> 3) + 8 * j; const LAS float* s = scr + (8 * c) * 65 + n;
        v4u o; o.x = pk2(s[0 * 65], s[1 * 65]); o.y = pk2(s[2 * 65], s[3 * 65]); o.z = pk2(s[4 * 65], s[5 * 65]); o.w = pk2(s[6 * 65], s[7 * 65]);
        *(v4u*)(WT + (size_t)(n0 + n) * K + k0 + 8 * c) = o; }
    LDS_WAIT(); asm volatile("" ::: "memory");
}
__device__ __forceinline__ void rms_row_to_bf16(const float* xrow, const float* w, bf16* orow, int lane) {
    const f32x4* xr = (const f32x4*)xrow + lane; const f32x4* wr = (const f32x4*)w + lane;
    f32x4 v[8]; float s = 0.f;
#pragma unroll
    for (int j = 0; j < 8; ++j) { v[j] = xr[64 * j]; s += (v[j].x * v[j].x + v[j].y * v[j].y) + (v[j].z * v[j].z + v[j].w * v[j].w); }
    const float r = rsqrtf(wave_sum(s) * (1.f / DM) + EPS);
    v2u* o8 = (v2u*)orow + lane;
#pragma unroll
    for (int j = 0; j < 8; ++j) { const f32x4 ww = wr[64 * j]; v2u o; o.x = pk2(v[j].x * r * ww.x, v[j].y * r * ww.y); o.y = pk2(v[j].z * r * ww.z, v[j].w * r * ww.w); o8[64 * j] = o; }
}
__device__ __forceinline__ void p0_prologue(Frame& F) {
    LAS float* scr = (LAS float*)(F.lds + F.wave * 16640);
    const int gw = F.bid * NWAVES + F.wave, NGW = F.G * NWAVES;
    constexpr int I_1 = (DM / 64) * (N1 / 64);
    for (int it = gw; it < I_1; it += NGW) p0_transpose_item<true>(F.w_in, DM, INC, N1, F.W1, scr, it, F.lane);
    for (int m = gw; m < M; m += NGW) rms_row_to_bf16(x_row(F, m), F.n_mix_pre, F.XN + (size_t)m * DM, F.lane);
}
__device__ __forceinline__ void p0_convert_rest(Frame& F, int vb, int nb) {
    LAS float* scr = (LAS float*)(F.lds + F.wave * 16640);
    const int gw = vb * NWAVES + F.wave, NGW = nb * NWAVES;
    constexpr int I_O = (DM / 64) * (DM / 64), I_F1 = (DM / 64) * (FF2 / 64), I_F2 = (FF / 64) * (DM / 64);
    for (int it = gw; it < I_O + I_F1 + I_F2; it += NGW) {
        int r = it;
        if (r < I_O) { p0_transpose_item<false>(F.w_out, DM, DM, DM, F.WO, scr, r, F.lane); continue; } r -= I_O;
        if (r < I_F1) { p0_transpose_item<false>(F.ffn_w_in, DM, FF2, FF2, F.WF1, scr, r, F.lane); continue; } r -= I_F1;
        p0_transpose_item<false>(F.ffn_w_out, FF, DM, DM, F.WF2, scr, r, F.lane);
    }
}

template <int grp> __device__ __forceinline__ void gla_direct_unit(Frame& F, int b, int h) {
    const int tid = F.tid, v = tid & 255, kh = tid >> 8;
    const int L = grp ? SL : PL, row0 = grp ? MP + b * SL : b * PL;
    LAS float* Es = (LAS float*)F.lds; LAS float* Ks = Es + 1024; LAS float* Qs = Ks + 1024; LAS float* Os = Qs + 1024;
    float S[64];
    if (grp) { const float* s0 = F.st_gla + ((size_t)(b * GH + h) * GK + kh * 64) * GV + v;
#pragma unroll
        for (int i = 0; i < 64; ++i) S[i] = s0[(size_t)i * GV]; }
    else {
#pragma unroll
        for (int i = 0; i < 64; ++i) S[i] = 0.f; }
    for (int t0 = 0; t0 < L; t0 += 8) {
        for (int it = tid; it < 1024; it += NTHR) { const int t = it >> 7, k = it & 127, row = row0 + t0 + t, hk = h * GK + k;
            float x = F.b_gate[hk]; const float* lr = F.LRDT + (size_t)row * 32;
#pragma unroll
            for (int j = 0; j < LOWR; ++j) x += lr[j] * F.w_gate2[j * GKD + hk];
            const float lg = logsigmoid_f(x) * (1.f / 16.f);
            Es[it] = __expf(lg); Ks[it] = bf2f(F.PROJ[(size_t)row * NP + CK + hk]); Qs[it] = bf2f(F.PROJ[(size_t)row * NP + CQ + hk]) * 0.08838834764831845f; }
        __syncthreads();
#pragma unroll 1
        for (int t = 0; t < 8; ++t) { const float vv = bf2f(F.PROJ[(size_t)(row0 + t0 + t) * NP + CV + h * GV + v]); float acc = 0.f;
            const LAS float* e = Es + t * 128 + kh * 64; const LAS float* kk = Ks + t * 128 + kh * 64; const LAS float* qq = Qs + t * 128 + kh * 64;
#pragma unroll
            for (int i = 0; i < 64; ++i) { S[i] = e[i] * S[i] + kk[i] * vv; acc += qq[i] * S[i]; }
            Os[(kh * 8 + t) * 256 + v] = acc; }
        __syncthreads();
        { const int t = F.wave, v4 = F.lane * 4, row = row0 + t0 + t;
            const f32x4 a = *(const LAS f32x4*)(Os + t * 256 + v4), c = *(const LAS f32x4*)(Os + (8 + t) * 256 + v4); const f32x4 o = a + c;
            const float ss = wave_sum((o.x * o.x + o.y * o.y) + (o.z * o.z + o.w * o.w)); const float r = rsqrtf(ss * (1.f / GV) + EPS);
            const v2u gw = *(const v2u*)(F.PROJ + (size_t)row * NP + CG + h * GV + v4); const f32x4 nw = *(const f32x4*)(F.gla_norm + v4);
            v2u w; w.x = pk2(o.x * r * nw.x * silu_f(bflo(gw.x)), o.y * r * nw.y * silu_f(bfhi(gw.x))); w.y = pk2(o.z * r * nw.z * silu_f(bflo(gw.y)), o.w * r * nw.w * silu_f(bfhi(gw.y)));
            *(v2u*)(F.MIXIN + (size_t)row * DM + h * GV + v4) = w; }
        __syncthreads();
    }
    float* so = F.out + (grp ? O_GLA_S : O_GLA_P) + ((size_t)(b * GH + h) * GK + kh * 64) * GV + v;
#pragma unroll
    for (int i = 0; i < 64; ++i) so[(size_t)i * GV] = S[i];
}
__device__ __forceinline__ float xbc_raw(const Frame& F, int grp, int b, int row0, int tt, int c) {
    if (tt >= 0) return bf2f(F.PROJ[(size_t)(row0 + tt) * NP + CX + c]);
    return grp ? F.st_sconv[((size_t)b * 3 + (tt + 3)) * SCH + c] : 0.f;
}
template <int grp> __device__ __forceinline__ void ssd_direct_unit(Frame& F, int b, int g) {
    const int tid = F.tid, hd = g * 8 + (tid >> 6), p = tid & 63, ch = g * 512 + tid;
    const int L = grp ? SL : PL, row0 = grp ? MP + b * SL : b * PL;
    LAS float* Bs = (LAS float*)F.lds; LAS float* Cs = Bs + 1024; LAS float* red = Cs + 1024; LAS float* Ys = red + 64;
    float h[128];
    if (grp) { const f32x4* h0 = (const f32x4*)(F.st_ssd + ((size_t)(b * SH + hd) * SP + p) * SN);
#pragma unroll
        for (int i = 0; i < 32; ++i) { const f32x4 q = h0[i]; h[4 * i] = q.x; h[4 * i + 1] = q.y; h[4 * i + 2] = q.z; h[4 * i + 3] = q.w; } }
    else {
#pragma unroll
        for (int i = 0; i < 128; ++i) h[i] = 0.f; }
    const float A = -__expf(F.A_log[hd]), dtb = F.dt_bias[hd], Dh = F.ssd_D[hd], nw = F.ssd_norm[ch];
    const float cb = F.sconv_b[ch], cw0 = F.sconv_w[ch], cw1 = F.sconv_w[SCH + ch], cw2 = F.sconv_w[2 * SCH + ch], cw3 = F.sconv_w[3 * SCH + ch];
    const int c2 = 1024 + (tid < 128 ? g * 128 + tid : 256 + g * 128 + ((tid - 128) & 127));
    float xr0 = xbc_raw(F, grp, b, row0, -3, ch), xr1 = xbc_raw(F, grp, b, row0, -2, ch), xr2 = xbc_raw(F, grp, b, row0, -1, ch);
    for (int t0 = 0; t0 < L; t0 += 8) {
        if (tid < 256) {
            float xr[11]; const float cb2 = F.sconv_b[c2], d0 = F.sconv_w[c2], d1 = F.sconv_w[SCH + c2], d2 = F.sconv_w[2 * SCH + c2], d3 = F.sconv_w[3 * SCH + c2];
#pragma unroll
            for (int i = 0; i < 11; ++i) xr[i] = xbc_raw(F, grp, b, row0, t0 - 3 + i, c2);
#pragma unroll
            for (int t = 0; t < 8; ++t) Bs[(tid >> 7) * 1024 + t * 128 + (tid & 127)] = silu_f(cb2 + d0 * xr[t] + d1 * xr[t + 1] + d2 * xr[t + 2] + d3 * xr[t + 3]);
        }
        __syncthreads();
#pragma unroll 1
        for (int t = 0; t < 8; ++t) { const int row = row0 + t0 + t;
            const float xn = bf2f(F.PROJ[(size_t)row * NP + CX + ch]);
            const float x = silu_f(cb + cw0 * xr0 + cw1 * xr1 + cw2 * xr2 + cw3 * xn); xr0 = xr1; xr1 = xr2; xr2 = xn;
            const float dt = softplus_f(F.LRDT[(size_t)row * 32 + 16 + hd] + dtb), a = __expf(dt * A), dtx = dt * x;
            float acc = 0.f; const LAS float* bb = Bs + t * 128; const LAS float* cc = Cs + t * 128;
#pragma unroll
            for (int nb = 0; nb < 128; nb += 16) {
#pragma unroll
                for (int n = nb; n < nb + 16; ++n) { h[n] = a * h[n] + dtx * bb[n]; acc += h[n] * cc[n]; }
                asm volatile("" ::: "memory"); }
            const float z = bf2f(F.PROJ[(size_t)row * NP + CZ + ch]);
            const float y = (acc + Dh * x) * silu_f(z);
            Ys[t * 512 + tid] = y;
            const float ss = wave_sum(y * y); if (F.lane == 0) red[t * 8 + F.wave] = ss; }
        __syncthreads();
#pragma unroll
        for (int t = 0; t < 8; ++t) { float tot = 0.f;
#pragma unroll
            for (int w = 0; w < 8; ++w) tot += red[t * 8 + w];
            const float r = rsqrtf(tot * (1.f / 512.f) + EPS);
            F.MIXIN[(size_t)(row0 + t0 + t) * DM + 1024 + ch] = (bf16)f2bf(Ys[t * 512 + tid] * r * nw); }
        __syncthreads();
    }
    f32x4* ho = (f32x4*)(F.out + (grp ? O_SSD_S : O_SSD_P) + ((size_t)(b * SH + hd) * SP + p) * SN);
#pragma unroll
    for (int i = 0; i < 32; ++i) ho[i] = (f32x4){h[4 * i], h[4 * i + 1], h[4 * i + 2], h[4 * i + 3]};
}
typedef short bf16x8v __attribute__((ext_vector_type(8)));
typedef short s16x4v __attribute__((ext_vector_type(4)));
constexpr int CH = 64, NCH = PL / CH;
constexpr int QE_ST = 272, KDT_ST = 144, V_ST = 544, ATT_ST = 144, X_ST = 1056, BC_ST = 288;
#define MFMA16(a, b, c) __builtin_amdgcn_mfma_f32_16x16x32_bf16((a), (b), (c), 0, 0, 0)
__device__ __forceinline__ bf16x8v frag_k(const LAS unsigned char* T, int stride, int idx0, int kk0, int r, int q) { return *(const LAS bf16x8v*)(T + (idx0 + r) * stride + (kk0 + 8 * q) * 2); }
__device__ __forceinline__ bf16x8v frag_t(const LAS unsigned char* T, int stride, int kk0, int idx0, int r, int q) {
    const LAS unsigned char* p = T + (kk0 + 8 * q + (r >> 2)) * stride + (idx0 + 4 * (r & 3)) * 2;
    const s16x4v lo = __builtin_amdgcn_ds_read_tr16_b64_v4i16((LAS s16x4v*)p), hi = __builtin_amdgcn_ds_read_tr16_b64_v4i16((LAS s16x4v*)(p + 4 * stride));
    return (bf16x8v){lo[0], lo[1], lo[2], lo[3], hi[0], hi[1], hi[2], hi[3]};
}
__device__ __forceinline__ v2u pk4(const f32x4 v) { v2u o; o.x = pk2(v.x, v.y); o.y = pk2(v.z, v.w); return o; }

template <int PASS>
__device__ __forceinline__ void gla_chunk_elem(Frame& F, int h, int row0, LAS unsigned char* T0, LAS unsigned char* T1, LAS float* tot, float* ebl_out) {
    const int tid = F.tid, k = tid & 127, tq = tid >> 7, hk = h * GK + k;
    float w2[16];
#pragma unroll
    for (int j = 0; j < 16; ++j) w2[j] = F.w_gate2[j * GKD + hk];
    const float bg = F.b_gate[hk];
    float lg[16]; float run = 0.f;
#pragma unroll
    for (int i = 0; i < 16; ++i) { const float* lr = F.LRDT + (size_t)(row0 + 16 * tq + i) * 32; float x = bg;
#pragma unroll
        for (int j = 0; j < 16; ++j) x += lr[j] * w2[j];
        run += logsigmoid_f(x) * (1.f / 16.f); lg[i] = run; }
    tot[tq * 128 + k] = run;
    __syncthreads();
    float off = 0.f, all = 0.f;
#pragma unroll
    for (int qq = 0; qq < 4; ++qq) { const float v = tot[qq * 128 + k]; all += v; off += (qq < tq) ? v : 0.f; }
    if (PASS == 0) {
        unsigned pk[8];
#pragma unroll
        for (int i = 0; i < 8; ++i) { const size_t ro = (size_t)(row0 + 16 * tq + 2 * i) * NP + CK + hk;
            const float k0 = bf2f(F.PROJ[ro]) * __expf(all - (off + lg[2 * i])), k1 = bf2f(F.PROJ[ro + NP]) * __expf(all - (off + lg[2 * i + 1])); pk[i] = pk2(k0, k1); }
        LAS v4u* d = (LAS v4u*)(T0 + k * KDT_ST + 32 * tq);
        d[0] = (v4u){pk[0], pk[1], pk[2], pk[3]}; d[1] = (v4u){pk[4], pk[5], pk[6], pk[7]};
        if (tq == 0) ebl_out[k] = __expf(all);
    } else {
#pragma unroll
        for (int i = 0; i < 16; ++i) { const int t = 16 * tq + i; const size_t ro = (size_t)(row0 + t) * NP + hk; const float bb = off + lg[i];
            *(LAS bf16*)(T0 + t * QE_ST + k * 2) = (bf16)f2bf(bf2f(F.PROJ[ro + CQ]) * 0.08838834764831845f * __expf(bb));
            *(LAS bf16*)(T1 + t * QE_ST + k * 2) = (bf16)f2bf(bf2f(F.PROJ[ro + CK]) * __expf(-bb)); }
    }
}
__device__ __forceinline__ void gla_load_v(Frame& F, int h, int row0, LAS unsigned char* V) {
#pragma unroll
    for (int i = 0; i < 4; ++i) { const int piece = F.tid + NTHR * i, row = piece >> 5, c16 = piece & 31;
        *(LAS v4u*)(V + row * V_ST + c16 * 16) = *(const v4u*)(F.PROJ + (size_t)(row0 + row) * NP + CV + h * GV + c16 * 8); }
}
__device__ __forceinline__ void gla_passA_unit(Frame& F, int u) {
    const int c = u & 31, bh = u >> 5, b = bh >> 2, h = bh & 3, row0 = b * PL + c * CH;
    LAS unsigned char* KDT = F.lds; LAS unsigned char* V = KDT + 128 * KDT_ST; LAS float* tot = (LAS float*)(V + 64 * V_ST);
    gla_load_v(F, h, row0, V);
    gla_chunk_elem<0>(F, h, row0, KDT, nullptr, tot, F.EBL + (size_t)u * 128);
    __syncthreads();
    const int w = F.wave, r = F.lane & 15, q = F.lane >> 4;
    f32x4 acc[8][2];
#pragma unroll
    for (int kf = 0; kf < 8; ++kf) { acc[kf][0] = (f32x4){0.f, 0.f, 0.f, 0.f}; acc[kf][1] = (f32x4){0.f, 0.f, 0.f, 0.f}; }
#pragma unroll
    for (int ks = 0; ks < 2; ++ks) { const bf16x8v b0 = frag_t(V, V_ST, 32 * ks, 32 * w, r, q), b1 = frag_t(V, V_ST, 32 * ks, 32 * w + 16, r, q);
#pragma unroll
        for (int kf = 0; kf < 8; ++kf) { const bf16x8v a = frag_k(KDT, KDT_ST, 16 * kf, 32 * ks, r, q); acc[kf][0] = MFMA16(a, b0, acc[kf][0]); acc[kf][1] = MFMA16(a, b1, acc[kf][1]); } }
#pragma unroll
    for (int kf = 0; kf < 8; ++kf)
#pragma unroll
        for (int vf = 0; vf < 2; ++vf) *(v2u*)(F.DS + ((size_t)u * GV + 32 * w + 16 * vf + r) * GK + 16 * kf + 4 * q) = pk4(acc[kf][vf]);
    __syncthreads();
}
__device__ __forceinline__ void gla_scan(Frame& F) {
    for (int it = F.bid * NTHR + F.tid; it < PB * GH * GV * 32; it += F.G * NTHR) { const int k4 = it & 31, v = (it >> 5) & 255, bh = it >> 13;
        f32x4 S = (f32x4){0.f, 0.f, 0.f, 0.f};
#pragma unroll 4
        for (int c = 0; c < NCH; ++c) { const int u = bh * NCH + c; const size_t off = ((size_t)u * GV + v) * GK + 4 * k4;
            const v2u d = *(const v2u*)(F.DS + off); const f32x4 e = *(const f32x4*)(F.EBL + (size_t)u * 128 + 4 * k4);
            *(v2u*)(F.SC + off) = pk4(S);
            S.x = e.x * S.x + bflo(d.x); S.y = e.y * S.y + bfhi(d.x); S.z = e.z * S.z + bflo(d.y); S.w = e.w * S.w + bfhi(d.y); }
        float* o = F.out + O_GLA_P + ((size_t)bh * GK + 4 * k4) * GV + v; o[0] = S.x; o[GV] = S.y; o[2 * GV] = S.z; o[3 * GV] = S.w; }
}
__device__ __forceinline__ void gla_passC_unit(Frame& F, int u) {
    const int c = u & 31, bh = u >> 5, b = bh >> 2, h = bh & 3, row0 = b * PL + c * CH;
    LAS unsigned char* QE = F.lds; LAS unsigned char* KE = QE + 64 * QE_ST; LAS unsigned char* V = KE + 64 * QE_ST; LAS unsigned char* ATT = V + 64 * V_ST;
    LAS float* tot = (LAS float*)(ATT + 64 * ATT_ST); LAS float* red = tot + 512;
    gla_load_v(F, h, row0, V);
    gla_chunk_elem<1>(F, h, row0, QE, KE, tot, nullptr);
    __syncthreads();
    const int w = F.wave, r = F.lane & 15, q = F.lane >> 4;
#pragma unroll
    for (int ff = 0; ff < 2; ++ff) { const int f = 2 * w + ff, sf = f >> 2, tf = f & 3; f32x4 a4 = (f32x4){0.f, 0.f, 0.f, 0.f};
        if (sf <= tf) {
#pragma unroll
            for (int ks = 0; ks < 4; ++ks) a4 = MFMA16(frag_k(KE, QE_ST, 16 * sf, 32 * ks, r, q), frag_k(QE, QE_ST, 16 * tf, 32 * ks, r, q), a4); }
        const int s0 = 16 * sf + 4 * q, t = 16 * tf + r;
        f32x4 m; m.x = (s0 <= t) ? a4.x : 0.f; m.y = (s0 + 1 <= t) ? a4.y : 0.f; m.z = (s0 + 2 <= t) ? a4.z : 0.f; m.w = (s0 + 3 <= t) ? a4.w : 0.f;
        *(LAS v2u*)(ATT + t * ATT_ST + s0 * 2) = pk4(m); }
    __syncthreads();
    const int tf = w & 3, vh = w >> 2;
    f32x4 acc[8];
#pragma unroll
    for (int i = 0; i < 8; ++i) acc[i] = (f32x4){0.f, 0.f, 0.f, 0.f};
    const bf16* Sc = F.SC + ((size_t)u * GV + 128 * vh) * GK;
#pragma unroll
    for (int ks = 0; ks < 4; ++ks) { const bf16x8v bq = frag_k(QE, QE_ST, 16 * tf, 32 * ks, r, q);
#pragma unroll
        for (int i = 0; i < 8; ++i) { const bf16x8v a = *(const bf16x8v*)(Sc + (size_t)(16 * i + r) * GK + 32 * ks + 8 * q); acc[i] = MFMA16(a, bq, acc[i]); } }
#pragma unroll
    for (int ks = 0; ks < 2; ++ks) { const bf16x8v ba = frag_k(ATT, ATT_ST, 16 * tf, 32 * ks, r, q);
#pragma unroll
        for (int i = 0; i < 8; ++i) { const bf16x8v a = frag_t(V, V_ST, 32 * ks, 128 * vh + 16 * i, r, q); acc[i] = MFMA16(a, ba, acc[i]); } }
    float ss = 0.f;
#pragma unroll
    for (int i = 0; i < 8; ++i) ss += (acc[i].x * acc[i].x + acc[i].y * acc[i].y) + (acc[i].z * acc[i].z + acc[i].w * acc[i].w);
    ss += __shfl_xor(ss, 16); ss += __shfl_xor(ss, 32);
    const int t = 16 * tf + r;
    if (q == 0) red[vh * 64 + t] = ss;
    __syncthreads();
    const float rr = rsqrtf((red[t] + red[64 + t]) * (1.f / GV) + EPS); const size_t row = (size_t)(row0 + t);
#pragma unroll
    for (int i = 0; i < 8; ++i) { const int v = 128 * vh + 16 * i + 4 * q;
        const v2u gw = *(const v2u*)(F.PROJ + row * NP + CG + h * GV + v); const f32x4 nw = *(const f32x4*)(F.gla_norm + v);
        f32x4 o; o.x = acc[i].x * rr * nw.x * silu_f(bflo(gw.x)); o.y = acc[i].y * rr * nw.y * silu_f(bfhi(gw.x)); o.z = acc[i].z * rr * nw.z * silu_f(bflo(gw.y)); o.w = acc[i].w * rr * nw.w * silu_f(bfhi(gw.y));
        *(v2u*)(F.MIXIN + row * DM + h * GV + v) = pk4(o); }
    __syncthreads();
}

template <bool SCALE>
__device__ __forceinline__ void ssd_conv_item(Frame& F, int b, int g, int c, int cg, int tb, LAS unsigned char* X, LAS unsigned char* BT, LAS unsigned char* CT, const LAS float* WDEC) {
    const int xc = cg < 64 ? g * 512 + 8 * cg : (cg < 80 ? 1024 + g * 128 + 8 * (cg - 64) : 1280 + g * 128 + 8 * (cg - 80));
    float w[4][8], bias[8];
#pragma unroll
    for (int j = 0; j < 4; ++j) { const f32x4 a = *(const f32x4*)(F.sconv_w + j * SCH + xc), bq = *(const f32x4*)(F.sconv_w + j * SCH + xc + 4);
        w[j][0] = a.x; w[j][1] = a.y; w[j][2] = a.z; w[j][3] = a.w; w[j][4] = bq.x; w[j][5] = bq.y; w[j][6] = bq.z; w[j][7] = bq.w; }
    { const f32x4 a = *(const f32x4*)(F.sconv_b + xc), bq = *(const f32x4*)(F.sconv_b + xc + 4); bias[0] = a.x; bias[1] = a.y; bias[2] = a.z; bias[3] = a.w; bias[4] = bq.x; bias[5] = bq.y; bias[6] = bq.z; bias[7] = bq.w; }
    v4u raw[11];
#pragma unroll
    for (int i = 0; i < 11; ++i) { const int tt = c * CH + tb * 8 - 3 + i;
        raw[i] = (tt >= 0) ? *(const v4u*)(F.PROJ + (size_t)(b * PL + tt) * NP + CX + xc) : (v4u){0u, 0u, 0u, 0u}; }
#pragma unroll
    for (int t = 0; t < 8; ++t) { float o[8];
#pragma unroll
        for (int e = 0; e < 8; ++e) { float a = bias[e];
#pragma unroll
            for (int j = 0; j < 4; ++j) { const unsigned wd = raw[t + j][e >> 1]; a += w[j][e] * ((e & 1) ? bfhi(wd) : bflo(wd)); }
            o[e] = silu_f(a); }
        const int tl = tb * 8 + t;
        if (SCALE && cg < 64) { const float sc = WDEC[(cg >> 3) * 64 + tl];
#pragma unroll
            for (int e = 0; e < 8; ++e) o[e] *= sc; }
        const v4u pkd = (v4u){pk2(o[0], o[1]), pk2(o[2], o[3]), pk2(o[4], o[5]), pk2(o[6], o[7])};
        LAS unsigned char* dst = cg < 64 ? X + tl * X_ST + cg * 16 : (cg < 80 ? BT + tl * BC_ST + (cg - 64) * 16 : CT + tl * BC_ST + (cg - 80) * 16);
        *(LAS v4u*)dst = pkd; }
}
__device__ __forceinline__ float ssd_head_scan(Frame& F, int hd, int row0, float& dt_out, float& last) {
    const float dt = softplus_f(F.LRDT[(size_t)(row0 + F.lane) * 32 + 16 + hd] + F.dt_bias[hd]);
    float cum = dt * (-__expf(F.A_log[hd]));
#pragma unroll
    for (int o = 1; o < 64; o <<= 1) { const float v = __shfl_up(cum, o); cum += (F.lane >= o) ? v : 0.f; }
    dt_out = dt; last = __shfl(cum, 63); return cum;
}
__device__ __forceinline__ void ssd_passA_unit(Frame& F, int u) {
    const int c = u & 31, bg = u >> 5, b = bg >> 1, g = bg & 1, row0 = b * PL + c * CH;
    LAS unsigned char* X = F.lds; LAS unsigned char* BT = X + 64 * X_ST; LAS float* WDEC = (LAS float*)(BT + 64 * BC_ST);
    const int w = F.wave, r = F.lane & 15, q = F.lane >> 4;
    { float dt, last; const float cum = ssd_head_scan(F, g * 8 + w, row0, dt, last);
        WDEC[w * 64 + F.lane] = __expf(last - cum) * dt; if (F.lane == 63) F.AL[(size_t)u * 8 + w] = __expf(last); }
    __syncthreads();
    for (int it = F.tid; it < 80 * 8; it += NTHR) ssd_conv_item<true>(F, b, g, c, it % 80, it / 80, X, BT, nullptr, WDEC);
    __syncthreads();
#pragma unroll 1
    for (int nh = 0; nh < 2; ++nh) {
        f32x4 acc[4][4];
#pragma unroll
        for (int i = 0; i < 4; ++i)
#pragma unroll
            for (int j = 0; j < 4; ++j) acc[i][j] = (f32x4){0.f, 0.f, 0.f, 0.f};
#pragma unroll
        for (int ks = 0; ks < 2; ++ks) { bf16x8v bp[4];
#pragma unroll
            for (int pf = 0; pf < 4; ++pf) bp[pf] = frag_t(X, X_ST, 32 * ks, 64 * w + 16 * pf, r, q);
#pragma unroll
            for (int nf = 0; nf < 4; ++nf) { const bf16x8v a = frag_t(BT, BC_ST, 32 * ks, 64 * nh + 16 * nf, r, q);
#pragma unroll
                for (int pf = 0; pf < 4; ++pf) acc[nf][pf] = MFMA16(a, bp[pf], acc[nf][pf]); } }
#pragma unroll
        for (int nf = 0; nf < 4; ++nf)
#pragma unroll
            for (int pf = 0; pf < 4; ++pf) *(v2u*)(F.DH + (((size_t)u * 8 + w) * SP + 16 * pf + r) * SN + 64 * nh + 16 * nf + 4 * q) = pk4(acc[nf][pf]);
    }
    __syncthreads();
}
__device__ __forceinline__ void ssd_scan(Frame& F) {
    for (int it = F.bid * NTHR + F.tid; it < PB * SH * SP * 32; it += F.G * NTHR) { const int n4 = it & 31, p = (it >> 5) & 63, bhd = it >> 11, b = bhd >> 4, hd = bhd & 15, g = hd >> 3, hl = hd & 7;
        f32x4 H = (f32x4){0.f, 0.f, 0.f, 0.f};
#pragma unroll 4
        for (int c = 0; c < NCH; ++c) { const int u = (b * 2 + g) * NCH + c; const size_t off = (((size_t)u * 8 + hl) * SP + p) * SN + 4 * n4;
            const v2u d = *(const v2u*)(F.DH + off); const float a = F.AL[(size_t)u * 8 + hl];
            *(v2u*)(F.HC + off) = pk4(H);
            H.x = a * H.x + bflo(d.x); H.y = a * H.y + bfhi(d.x); H.z = a * H.z + bflo(d.y); H.w = a * H.w + bfhi(d.y); }
        *(f32x4*)(F.out + O_SSD_P + ((size_t)bhd * SP + p) * SN + 4 * n4) = H; }
}
__device__ __forceinline__ void ssd_passC_unit(Frame& F, int u) {
    const int c = u & 31, bg = u >> 5, b = bg >> 1, g = bg & 1, row0 = b * PL + c * CH;
    LAS unsigned char* X = F.lds; LAS unsigned char* BT = X + 64 * X_ST; LAS unsigned char* CT = BT + 64 * BC_ST; LAS unsigned char* CB = CT + 64 * BC_ST;
    LAS float* DT = (LAS float*)(CB + 64 * ATT_ST); LAS float* CUM = DT + 512; LAS float* red = CUM + 512;
    const int w = F.wave, r = F.lane & 15, q = F.lane >> 4, hd = g * 8 + w;
    { float dt, last; const float cum = ssd_head_scan(F, hd, row0, dt, last); DT[w * 64 + F.lane] = dt; CUM[w * 64 + F.lane] = cum; }
    for (int it = F.tid; it < 96 * 8; it += NTHR) ssd_conv_item<false>(F, b, g, c, it % 96, it / 96, X, BT, CT, nullptr);
    __syncthreads();
#pragma unroll
    for (int ff = 0; ff < 2; ++ff) { const int f = 2 * w + ff, sf = f >> 2, tf = f & 3; f32x4 a4 = (f32x4){0.f, 0.f, 0.f, 0.f};
        if (sf <= tf) {
#pragma unroll
            for (int ks = 0; ks < 4; ++ks) a4 = MFMA16(frag_k(BT, BC_ST, 16 * sf, 32 * ks, r, q), frag_k(CT, BC_ST, 16 * tf, 32 * ks, r, q), a4); }
        *(LAS v2u*)(CB + (16 * tf + r) * ATT_ST + (16 * sf + 4 * q) * 2) = pk4(a4); }
    __syncthreads();
    f32x4 acc[4][4];
#pragma unroll
    for (int i = 0; i < 4; ++i)
#pragma unroll
        for (int j = 0; j < 4; ++j) acc[i][j] = (f32x4){0.f, 0.f, 0.f, 0.f};
    const bf16* Hc = F.HC + ((size_t)u * 8 + w) * SP * SN;
#pragma unroll
    for (int ks = 0; ks < 4; ++ks) { bf16x8v bc[4];
#pragma unroll
        for (int tf = 0; tf < 4; ++tf) bc[tf] = frag_k(CT, BC_ST, 16 * tf, 32 * ks, r, q);
#pragma unroll
        for (int pf = 0; pf < 4; ++pf) { const bf16x8v a = *(const bf16x8v*)(Hc + (size_t)(16 * pf + r) * SN + 32 * ks + 8 * q);
#pragma unroll
            for (int tf = 0; tf < 4; ++tf) acc[pf][tf] = MFMA16(a, bc[tf], acc[pf][tf]); } }
    float ct[4];
#pragma unroll
    for (int tf = 0; tf < 4; ++tf) { ct[tf] = CUM[w * 64 + 16 * tf + r]; const float e = __expf(ct[tf]);
#pragma unroll
        for (int pf = 0; pf < 4; ++pf) acc[pf][tf] = acc[pf][tf] * e; }
#pragma unroll
    for (int ks = 0; ks < 2; ++ks) { bf16x8v ax[4];
#pragma unroll
        for (int pf = 0; pf < 4; ++pf) ax[pf] = frag_t(X, X_ST, 32 * ks, 64 * w + 16 * pf, r, q);
        const int s0 = 32 * ks + 8 * q;
        const f32x4 cs0 = *(const LAS f32x4*)(CUM + w * 64 + s0), cs1 = *(const LAS f32x4*)(CUM + w * 64 + s0 + 4), ds0 = *(const LAS f32x4*)(DT + w * 64 + s0), ds1 = *(const LAS f32x4*)(DT + w * 64 + s0 + 4);
        const float cs[8] = {cs0.x, cs0.y, cs0.z, cs0.w, cs1.x, cs1.y, cs1.z, cs1.w}, ds[8] = {ds0.x, ds0.y, ds0.z, ds0.w, ds1.x, ds1.y, ds1.z, ds1.w};
#pragma unroll
        for (int tf = 0; tf < 4; ++tf) { if (32 * ks > 16 * tf + 15) continue;
            const int t = 16 * tf + r; const v4u cb8 = *(const LAS v4u*)(CB + t * ATT_ST + s0 * 2); float l[8];
#pragma unroll
            for (int e = 0; e < 8; ++e) { const unsigned wd = cb8[e >> 1]; const float cbv = (e & 1) ? bfhi(wd) : bflo(wd); l[e] = (s0 + e <= t) ? cbv * __expf(ct[tf] - cs[e]) * ds[e] : 0.f; }
            const v4u lp = (v4u){pk2(l[0], l[1]), pk2(l[2], l[3]), pk2(l[4], l[5]), pk2(l[6], l[7])}; const bf16x8v bl = __builtin_bit_cast(bf16x8v, lp);
#pragma unroll
            for (int pf = 0; pf < 4; ++pf) acc[pf][tf] = MFMA16(ax[pf], bl, acc[pf][tf]); } }
    const float Dh = F.ssd_D[hd];
#pragma unroll
    for (int tf = 0; tf < 4; ++tf) { const int t = 16 * tf + r; const size_t row = (size_t)(row0 + t); float ss = 0.f;
#pragma unroll
        for (int pf = 0; pf < 4; ++pf) { const int p4 = 64 * w + 16 * pf + 4 * q;
            const v2u xv = *(const LAS v2u*)(X + t * X_ST + p4 * 2); const v2u zv = *(const v2u*)(F.PROJ + row * NP + CZ + g * 512 + p4);
            f32x4 y = acc[pf][tf];
            y.x = (y.x + Dh * bflo(xv.x)) * silu_f(bflo(zv.x)); y.y = (y.y + Dh * bfhi(xv.x)) * silu_f(bfhi(zv.x)); y.z = (y.z + Dh * bflo(xv.y)) * silu_f(bflo(zv.y)); y.w = (y.w + Dh * bfhi(xv.y)) * silu_f(bfhi(zv.y));
            acc[pf][tf] = y; ss += (y.x * y.x + y.y * y.y) + (y.z * y.z + y.w * y.w); }
        ss += __shfl_xor(ss, 16); ss += __shfl_xor(ss, 32);
        if (q == 0) red[w * 64 + t] = ss; }
    __syncthreads();
#pragma unroll
    for (int tf = 0; tf < 4; ++tf) { const int t = 16 * tf + r; const size_t row = (size_t)(row0 + t); float tot = 0.f;
#pragma unroll
        for (int ww = 0; ww < 8; ++ww) tot += red[ww * 64 + t];
        const float rr = rsqrtf(tot * (1.f / 512.f) + EPS);
#pragma unroll
        for (int pf = 0; pf < 4; ++pf) { const int p4 = g * 512 + 64 * w + 16 * pf + 4 * q; const f32x4 nw = *(const f32x4*)(F.ssd_norm + p4);
            f32x4 o = acc[pf][tf]; o.x *= rr * nw.x; o.y *= rr * nw.y; o.z *= rr * nw.z; o.w *= rr * nw.w;
            *(v2u*)(F.MIXIN + row * DM + 1024 + p4) = pk4(o); } }
    __syncthreads();
}

constexpr int ATT8_ST = 80;
__device__ __forceinline__ void gla_sample_unit(Frame& F, int b, int h) {
    const int tid = F.tid, w = F.wave, lane = F.lane, r = lane & 15, q = lane >> 4, row0 = MP + b * SL;
    LAS unsigned char* S0b = F.lds;
    LAS unsigned char* Vt = S0b + 128 * V_ST;
    LAS unsigned char* QE = Vt + 32 * V_ST;
    LAS unsigned char* KE = QE + 16 * QE_ST;
    LAS unsigned char* ATT = KE + 16 * QE_ST;
    LAS float* KD = (LAS float*)(ATT + 16 * ATT8_ST);
    LAS float* EL = KD + 1024;
    LAS float* red = EL + 128;
    const f32x4* s0 = (const f32x4*)(F.st_gla + ((size_t)(b * GH + h) * GK + 16 * w) * GV) + lane;
    f32x4 S[16];
#pragma unroll
    for (int i = 0; i < 16; ++i) S[i] = s0[i * 64];
    f32x4 Vf[8];
#pragma unroll
    for (int s = 0; s < 8; ++s) { const v2u vv = *(const v2u*)(F.PROJ + (size_t)(row0 + s) * NP + CV + h * GV + 4 * lane); Vf[s] = (f32x4){bflo(vv.x), bfhi(vv.x), bflo(vv.y), bfhi(vv.y)}; }
    if (tid < 256) { const int t = tid >> 5, c16 = tid & 31; *(LAS v4u*)(Vt + t * V_ST + c16 * 16) = *(const v4u*)(F.PROJ + (size_t)(row0 + t) * NP + CV + h * GV + c16 * 8); }
    for (int i = tid; i < 24 * 32; i += NTHR) *(LAS v4u*)(Vt + (8 + (i >> 5)) * V_ST + (i & 31) * 16) = (v4u){0u, 0u, 0u, 0u};
    if (tid < 128) { const int k = tid, hk = h * GK + k;
        float bcum[8], kv[8]; float run = 0.f; const float bg = F.b_gate[hk];
        float w2[16];
#pragma unroll
        for (int j = 0; j < 16; ++j) w2[j] = F.w_gate2[j * GKD + hk];
#pragma unroll
        for (int t = 0; t < 8; ++t) { const float* lr = F.LRDT + (size_t)(row0 + t) * 32; float x = bg;
#pragma unroll
            for (int j = 0; j < 16; ++j) x += lr[j] * w2[j];
            run += logsigmoid_f(x) * (1.f / 16.f); bcum[t] = run;
            const size_t ro = (size_t)(row0 + t) * NP + hk; kv[t] = bf2f(F.PROJ[ro + CK]);
            *(LAS bf16*)(QE + t * QE_ST + k * 2) = (bf16)f2bf(bf2f(F.PROJ[ro + CQ]) * 0.08838834764831845f * __expf(run));
            *(LAS bf16*)(KE + t * QE_ST + k * 2) = (bf16)f2bf(kv[t] * __expf(-run)); }
        f32x4 d0, d1; d0.x = kv[0] * __expf(run - bcum[0]); d0.y = kv[1] * __expf(run - bcum[1]); d0.z = kv[2] * __expf(run - bcum[2]); d0.w = kv[3] * __expf(run - bcum[3]);
        d1.x = kv[4] * __expf(run - bcum[4]); d1.y = kv[5] * __expf(run - bcum[5]); d1.z = kv[6] * __expf(run - bcum[6]); d1.w = kv[7];
        *(LAS f32x4*)(KD + k * 8) = d0; *(LAS f32x4*)(KD + k * 8 + 4) = d1; EL[k] = __expf(run);
    } else if (tid < 384) { const int i = tid - 128, which = i >> 7, j = i & 127;
        *(LAS v4u*)((which ? KE : QE) + (8 + (j >> 4)) * QE_ST + (j & 15) * 16) = (v4u){0u, 0u, 0u, 0u};
    } else if (tid < 384 + 80) { *(LAS v4u*)(ATT + (tid - 384) * 16) = (v4u){0u, 0u, 0u, 0u}; }
#pragma unroll
    for (int i = 0; i < 16; ++i) *(LAS v2u*)(S0b + (16 * w + i) * V_ST + lane * 8) = pk4(S[i]);
    __syncthreads();
    if (w == 0) { f32x4 a4 = (f32x4){0.f, 0.f, 0.f, 0.f};
#pragma unroll
        for (int ks = 0; ks < 4; ++ks) a4 = MFMA16(frag_k(KE, QE_ST, 0, 32 * ks, r, q), frag_k(QE, QE_ST, 0, 32 * ks, r, q), a4);
        const int s0i = 4 * q; f32x4 m; m.x = (s0i <= r) ? a4.x : 0.f; m.y = (s0i + 1 <= r) ? a4.y : 0.f; m.z = (s0i + 2 <= r) ? a4.z : 0.f; m.w = (s0i + 3 <= r) ? a4.w : 0.f;
        if (r >= 8) m = (f32x4){0.f, 0.f, 0.f, 0.f};
        *(LAS v2u*)(ATT + r * ATT8_ST + s0i * 2) = pk4(m); }
    { f32x4* so = (f32x4*)(F.out + O_GLA_S + ((size_t)(b * GH + h) * GK + 16 * w) * GV) + lane;
#pragma unroll
        for (int i = 0; i < 16; ++i) { const int k = 16 * w + i; const float e = EL[k]; const f32x4 k0 = *(const LAS f32x4*)(KD + k * 8), k1 = *(const LAS f32x4*)(KD + k * 8 + 4);
            f32x4 n = S[i] * e; n = n + Vf[0] * k0.x; n = n + Vf[1] * k0.y; n = n + Vf[2] * k0.z; n = n + Vf[3] * k0.w; n = n + Vf[4] * k1.x; n = n + Vf[5] * k1.y; n = n + Vf[6] * k1.z; n = n + Vf[7] * k1.w;
            so[i * 64] = n; } }
    f32x4 acc[2] = {(f32x4){0.f, 0.f, 0.f, 0.f}, (f32x4){0.f, 0.f, 0.f, 0.f}};
#pragma unroll
    for (int ks = 0; ks < 4; ++ks) { const bf16x8v bq = frag_k(QE, QE_ST, 0, 32 * ks, r, q);
#pragma unroll
        for (int vf = 0; vf < 2; ++vf) acc[vf] = MFMA16(frag_t(S0b, V_ST, 32 * ks, 32 * w + 16 * vf, r, q), bq, acc[vf]); }
    __syncthreads();
    { const bf16x8v ba = *(const LAS bf16x8v*)(ATT + r * ATT8_ST + 16 * q);
#pragma unroll
        for (int vf = 0; vf < 2; ++vf) acc[vf] = MFMA16(frag_t(Vt, V_ST, 0, 32 * w + 16 * vf, r, q), ba, acc[vf]); }
    float ss = (acc[0].x * acc[0].x + acc[0].y * acc[0].y) + (acc[0].z * acc[0].z + acc[0].w * acc[0].w) + (acc[1].x * acc[1].x + acc[1].y * acc[1].y) + (acc[1].z * acc[1].z + acc[1].w * acc[1].w);
    ss += __shfl_xor(ss, 16); ss += __shfl_xor(ss, 32);
    if (q == 0) red[w * 16 + r] = ss;
    __syncthreads();
    float tot = 0.f;
#pragma unroll
    for (int ww = 0; ww < 8; ++ww) tot += red[ww * 16 + r];
    const float rr = rsqrtf(tot * (1.f / GV) + EPS);
    if (r < 8) { const size_t row = (size_t)(row0 + r);
#pragma unroll
        for (int vf = 0; vf < 2; ++vf) { const int v = 32 * w + 16 * vf + 4 * q;
            const v2u gw = *(const v2u*)(F.PROJ + row * NP + CG + h * GV + v); const f32x4 nw = *(const f32x4*)(F.gla_norm + v);
            f32x4 o; o.x = acc[vf].x * rr * nw.x * silu_f(bflo(gw.x)); o.y = acc[vf].y * rr * nw.y * silu_f(bfhi(gw.x)); o.z = acc[vf].z * rr * nw.z * silu_f(bflo(gw.y)); o.w = acc[vf].w * rr * nw.w * silu_f(bfhi(gw.y));
            *(v2u*)(F.MIXIN + row * DM + h * GV + v) = pk4(o); } }
    __syncthreads();
}
__device__ __forceinline__ void ssd_sample_unit(Frame& F, int b, int g) {
    const int tid = F.tid, w = F.wave, lane = F.lane, r = lane & 15, q = lane >> 4, row0 = MP + b * SL, hd = g * 8 + w, ch = g * 512 + tid;
    LAS float* Xs = (LAS float*)F.lds;
    LAS float* XW = Xs + 4096;
    LAS float* Bs = XW + 4096;
    LAS unsigned char* Cb = (LAS unsigned char*)(Bs + 1024);
    LAS unsigned char* Bb = Cb + 16 * QE_ST;
    LAS float* CBm = (LAS float*)(Bb + 16 * QE_ST);
    LAS float* CD = CBm + 256;
    LAS float* red = CD + 128;
    float dt[8], cum[8]; { const float A = -__expf(F.A_log[hd]), dtb = F.dt_bias[hd]; float run = 0.f;
#pragma unroll
        for (int t = 0; t < 8; ++t) { dt[t] = softplus_f(F.LRDT[(size_t)(row0 + t) * 32 + 16 + hd] + dtb); run += dt[t] * A; cum[t] = run; } }
    const float last = cum[7], elast = __expf(last);
    if (lane < 8) { float cv = cum[0], dv = dt[0];
#pragma unroll
        for (int t = 1; t < 8; ++t) { cv = (lane == t) ? cum[t] : cv; dv = (lane == t) ? dt[t] : dv; }
        CD[w * 16 + lane] = cv; CD[w * 16 + 8 + lane] = dv; }
    { float xr[11]; const float cb = F.sconv_b[ch], c0 = F.sconv_w[ch], c1 = F.sconv_w[SCH + ch], c2 = F.sconv_w[2 * SCH + ch], c3 = F.sconv_w[3 * SCH + ch];
#pragma unroll
        for (int i = 0; i < 11; ++i) xr[i] = xbc_raw(F, 1, b, row0, i - 3, ch);
        float xw[8];
#pragma unroll
        for (int t = 0; t < 8; ++t) { const float x = silu_f(cb + c0 * xr[t] + c1 * xr[t + 1] + c2 * xr[t + 2] + c3 * xr[t + 3]); Xs[t * 512 + tid] = x; xw[t] = x * __expf(last - cum[t]) * dt[t]; }
        *(LAS f32x4*)(XW + tid * 8) = (f32x4){xw[0], xw[1], xw[2], xw[3]}; *(LAS f32x4*)(XW + tid * 8 + 4) = (f32x4){xw[4], xw[5], xw[6], xw[7]}; }
    if (tid < 256) { const int n = tid & 127, isC = tid >> 7, cc = 1024 + isC * 256 + g * 128 + n;
        float xr[11]; const float cb = F.sconv_b[cc], c0 = F.sconv_w[cc], c1 = F.sconv_w[SCH + cc], c2 = F.sconv_w[2 * SCH + cc], c3 = F.sconv_w[3 * SCH + cc];
#pragma unroll
        for (int i = 0; i < 11; ++i) xr[i] = xbc_raw(F, 1, b, row0, i - 3, cc);
#pragma unroll
        for (int t = 0; t < 8; ++t) { const float x = silu_f(cb + c0 * xr[t] + c1 * xr[t + 1] + c2 * xr[t + 2] + c3 * xr[t + 3]);
            if (!isC) Bs[t * 128 + n] = x;
            *(LAS bf16*)((isC ? Cb : Bb) + t * QE_ST + n * 2) = (bf16)f2bf(x); }
    } else { const int i = tid - 256, which = i >> 7, j = i & 127; *(LAS v4u*)((which ? Bb : Cb) + (8 + (j >> 4)) * QE_ST + (j & 15) * 16) = (v4u){0u, 0u, 0u, 0u}; }
    __syncthreads();
    if (w == 0) { f32x4 a4 = (f32x4){0.f, 0.f, 0.f, 0.f};
#pragma unroll
        for (int ks = 0; ks < 4; ++ks) a4 = MFMA16(frag_k(Bb, QE_ST, 0, 32 * ks, r, q), frag_k(Cb, QE_ST, 0, 32 * ks, r, q), a4);
        *(LAS f32x4*)(CBm + r * 16 + 4 * q) = a4; }
    bf16x8v bc[4];
#pragma unroll
    for (int ks = 0; ks < 4; ++ks) bc[ks] = frag_k(Cb, QE_ST, 0, 32 * ks, r, q);
    f32x4 acc[4];
#pragma unroll
    for (int pf = 0; pf < 4; ++pf) acc[pf] = (f32x4){0.f, 0.f, 0.f, 0.f};
    const float* h0base = F.st_ssd + ((size_t)(b * SH + hd) * SP) * SN; float* hobase = F.out + O_SSD_S + ((size_t)(b * SH + hd) * SP) * SN;
    f32x4 hbuf[4][2];
#pragma unroll
    for (int i = 0; i < 4; ++i) { const size_t off = (size_t)(16 * (i & 3) + r) * SN + 32 * (i >> 2) + 8 * q; hbuf[i][0] = *(const f32x4*)(h0base + off); hbuf[i][1] = *(const f32x4*)(h0base + off + 4); }
    f32x4 Bv[8][2];
#pragma unroll
    for (int st = 0; st < 16; ++st) { const int ks = st >> 2, pf = st & 3;
        if (pf == 0) {
#pragma unroll
            for (int s = 0; s < 8; ++s) { Bv[s][0] = *(const LAS f32x4*)(Bs + s * 128 + 32 * ks + 8 * q); Bv[s][1] = *(const LAS f32x4*)(Bs + s * 128 + 32 * ks + 8 * q + 4); } }
        const int p = 16 * pf + r; const size_t off = (size_t)p * SN + 32 * ks + 8 * q;
        const f32x4 ha = hbuf[st & 3][0], hb = hbuf[st & 3][1];
        if (st + 4 < 16) { const int st2 = st + 4; const size_t off2 = (size_t)(16 * (st2 & 3) + r) * SN + 32 * (st2 >> 2) + 8 * q; hbuf[st & 3][0] = *(const f32x4*)(h0base + off2); hbuf[st & 3][1] = *(const f32x4*)(h0base + off2 + 4); }
        asm volatile("" ::: "memory");
        const f32x4 x0 = *(const LAS f32x4*)(XW + (64 * w + p) * 8), x1 = *(const LAS f32x4*)(XW + (64 * w + p) * 8 + 4);
        f32x4 na = ha * elast, nb = hb * elast;
        na = na + Bv[0][0] * x0.x; nb = nb + Bv[0][1] * x0.x; na = na + Bv[1][0] * x0.y; nb = nb + Bv[1][1] * x0.y; na = na + Bv[2][0] * x0.z; nb = nb + Bv[2][1] * x0.z; na = na + Bv[3][0] * x0.w; nb = nb + Bv[3][1] * x0.w;
        na = na + Bv[4][0] * x1.x; nb = nb + Bv[4][1] * x1.x; na = na + Bv[5][0] * x1.y; nb = nb + Bv[5][1] * x1.y; na = na + Bv[6][0] * x1.z; nb = nb + Bv[6][1] * x1.z; na = na + Bv[7][0] * x1.w; nb = nb + Bv[7][1] * x1.w;
        *(f32x4*)(hobase + off) = na; *(f32x4*)(hobase + off + 4) = nb;
        const v4u ap = (v4u){pk2(ha.x, ha.y), pk2(ha.z, ha.w), pk2(hb.x, hb.y), pk2(hb.z, hb.w)};
        acc[pf] = MFMA16(__builtin_bit_cast(bf16x8v, ap), bc[ks], acc[pf]); }
    __syncthreads();
    const int tc = r & 7; const float ct = CD[w * 16 + tc], ect = __expf(ct), Dh = F.ssd_D[hd];
    float L[8]; { const f32x4 c0 = *(const LAS f32x4*)(CBm + r * 16), c1 = *(const LAS f32x4*)(CBm + r * 16 + 4); const float cbv[8] = {c0.x, c0.y, c0.z, c0.w, c1.x, c1.y, c1.z, c1.w};
        const f32x4 q0 = *(const LAS f32x4*)(CD + w * 16), q1 = *(const LAS f32x4*)(CD + w * 16 + 4), d0 = *(const LAS f32x4*)(CD + w * 16 + 8), d1 = *(const LAS f32x4*)(CD + w * 16 + 12);
        const float cu[8] = {q0.x, q0.y, q0.z, q0.w, q1.x, q1.y, q1.z, q1.w}, dd[8] = {d0.x, d0.y, d0.z, d0.w, d1.x, d1.y, d1.z, d1.w};
#pragma unroll
        for (int s = 0; s < 8; ++s) L[s] = (s <= tc) ? cbv[s] * __expf(ct - cu[s]) * dd[s] : 0.f; }
    float ss = 0.f; const size_t row = (size_t)(row0 + tc);
#pragma unroll
    for (int pf = 0; pf < 4; ++pf) { const int p4 = 64 * w + 16 * pf + 4 * q;
        f32x4 y = acc[pf] * ect;
#pragma unroll
        for (int s = 0; s < 8; ++s) y = y + *(const LAS f32x4*)(Xs + s * 512 + p4) * L[s];
        const f32x4 xt = *(const LAS f32x4*)(Xs + tc * 512 + p4); const v2u zv = *(const v2u*)(F.PROJ + row * NP + CZ + g * 512 + p4);
        y.x = (y.x + Dh * xt.x) * silu_f(bflo(zv.x)); y.y = (y.y + Dh * xt.y) * silu_f(bfhi(zv.x)); y.z = (y.z + Dh * xt.z) * silu_f(bflo(zv.y)); y.w = (y.w + Dh * xt.w) * silu_f(bfhi(zv.y));
        acc[pf] = y; ss += (y.x * y.x + y.y * y.y) + (y.z * y.z + y.w * y.w); }
    ss += __shfl_xor(ss, 16); ss += __shfl_xor(ss, 32);
    if (q == 0) red[w * 16 + r] = ss;
    __syncthreads();
    float tot = 0.f;
#pragma unroll
    for (int ww = 0; ww < 8; ++ww) tot += red[ww * 16 + r];
    const float rr = rsqrtf(tot * (1.f / 512.f) + EPS);
    if (r < 8) {
#pragma unroll
        for (int pf = 0; pf < 4; ++pf) { const int p4 = g * 512 + 64 * w + 16 * pf + 4 * q; const f32x4 nw = *(const f32x4*)(F.ssd_norm + p4);
            f32x4 o = acc[pf]; o.x *= rr * nw.x; o.y *= rr * nw.y; o.z *= rr * nw.z; o.w *= rr * nw.w;
            *(v2u*)(F.MIXIN + row * DM + 1024 + p4) = pk4(o); } }
    __syncthreads();
}

__device__ __forceinline__ void p2a_chunk_states(Frame& F) {
    for (int idx = F.bid; idx < 768; idx += F.G) { if (idx < 256) ssd_passA_unit(F, idx); else gla_passA_unit(F, idx - 256); }
}
#ifndef MK_REP_PHASE
#define MK_REP_PHASE (-1)
#endif
__device__ __forceinline__ void p2b_scans_and_sample(Frame& F) {
    for (int rep = 0; rep < (MK_REP_PHASE == 30 ? 2 : 1); ++rep) { gla_scan(F); ssd_scan(F); }
    for (int rep = 0; rep < (MK_REP_PHASE == 31 ? 2 : 1); ++rep)
        for (int idx = F.bid; idx < SB * GH; idx += F.G) gla_sample_unit(F, idx / GH, idx % GH);
    for (int rep = 0; rep < (MK_REP_PHASE == 32 ? 2 : 1); ++rep)
        for (int idx = F.bid; idx < SB * SG; idx += F.G) ssd_sample_unit(F, idx / SG, idx % SG);
}
__device__ __forceinline__ void p2c_outputs(Frame& F) {
    for (int idx = F.bid; idx < 768; idx += F.G) { if (idx < 256) ssd_passC_unit(F, idx); else gla_passC_unit(F, idx - 256); }
    const int gt = F.bid * NTHR + F.tid, NT = F.G * NTHR;
    for (int i = gt; i < (PB + SB) * 3 * SCH; i += NT) { const int c = i % SCH, j = (i / SCH) % 3, s = i / (3 * SCH);
        const int grp = s >= PB, b = grp ? s - PB : s, L = grp ? SL : PL, row0 = grp ? MP + b * SL : b * PL;
        F.out[(grp ? O_SCONV_S : O_SCONV_P) + ((size_t)b * 3 + j) * SCH + c] = bf2f(F.PROJ[(size_t)(row0 + L - 3 + j) * NP + CX + c]); }
}

__device__ __forceinline__ void p4_post_mixer(Frame& F) {
    const int gw = F.bid * NWAVES + F.wave, NGW = F.G * NWAVES, lane = F.lane;
    for (int m = gw; m < M; m += NGW) {
        const f32x4* mr = (const f32x4*)(F.MIX + (size_t)m * DM) + lane; const f32x4* xr = (const f32x4*)x_row(F, m) + lane;
        const f32x4* w1 = (const f32x4*)F.n_mix_post + lane; const f32x4* w2 = (const f32x4*)F.n_ffn_pre + lane;
        f32x4 v[8]; float s = 0.f;
#pragma unroll
        for (int j = 0; j < 8; ++j) { v[j] = mr[64 * j]; s += (v[j].x * v[j].x + v[j].y * v[j].y) + (v[j].z * v[j].z + v[j].w * v[j].w); }
        const float r1 = rsqrtf(wave_sum(s) * (1.f / DM) + EPS); float s2 = 0.f;
        f32x4* ho = (f32x4*)(F.out + O_Y + (size_t)m * DM) + lane;
#pragma unroll
        for (int j = 0; j < 8; ++j) { v[j] = xr[64 * j] + v[j] * r1 * w1[64 * j]; ho[64 * j] = v[j]; s2 += (v[j].x * v[j].x + v[j].y * v[j].y) + (v[j].z * v[j].z + v[j].w * v[j].w); }
        const float r2 = rsqrtf(wave_sum(s2) * (1.f / DM) + EPS);
        v2u* o8 = (v2u*)(F.XN + (size_t)m * DM) + lane;
#pragma unroll
        for (int j = 0; j < 8; ++j) { const f32x4 ww = w2[64 * j]; v2u o; o.x = pk2(v[j].x * r2 * ww.x, v[j].y * r2 * ww.y); o.y = pk2(v[j].z * r2 * ww.z, v[j].w * r2 * ww.w); o8[64 * j] = o; }
    }
}
__device__ __forceinline__ void u_row8(const Frame& F, int grp, int b, int row0, int tt, int c, float* o) {
    if (tt >= 0) { const v4u r = *(const v4u*)(F.U + (size_t)(row0 + tt) * FF2 + c);
        o[0] = bflo(r.x); o[1] = bfhi(r.x); o[2] = bflo(r.y); o[3] = bfhi(r.y); o[4] = bflo(r.z); o[5] = bfhi(r.z); o[6] = bflo(r.w); o[7] = bfhi(r.w); }
    else if (grp) { const f32x4* s = (const f32x4*)(F.st_fconv + ((size_t)b * 2 + (tt + 2)) * FF2 + c); const f32x4 a = s[0], d = s[1];
        o[0] = a.x; o[1] = a.y; o[2] = a.z; o[3] = a.w; o[4] = d.x; o[5] = d.y; o[6] = d.z; o[7] = d.w; }
    else {
#pragma unroll
        for (int e = 0; e < 8; ++e) o[e] = 0.f; }
}
__device__ __forceinline__ void ld8(const float* p, float* o) { const f32x4 a = *(const f32x4*)p, d = *(const f32x4*)(p + 4); o[0] = a.x; o[1] = a.y; o[2] = a.z; o[3] = a.w; o[4] = d.x; o[5] = d.y; o[6] = d.z; o[7] = d.w; }
__device__ __forceinline__ void p6_conv_act(Frame& F) {
    const int gt = F.bid * NTHR + F.tid, NT = F.G * NTHR;
    constexpr int NCG = FF / 8, NTB = M / 8;
    const int tpc = NT / NCG;
    if (gt < tpc * NCG) { const int cg = gt % NCG, c = cg * 8;
        float wa[3][8], wb[3][8], ba[8], bb[8];
#pragma unroll
        for (int j = 0; j < 3; ++j) { ld8(F.fconv_w + j * FF2 + c, wa[j]); ld8(F.fconv_w + j * FF2 + FF + c, wb[j]); }
        ld8(F.fconv_b + c, ba); ld8(F.fconv_b + FF + c, bb);
        for (int tb = gt / NCG; tb < NTB; tb += tpc) { const int rowb = tb * 8;
            const int grp = rowb >= MP, b = grp ? (rowb - MP) / SL : rowb / PL, row0 = grp ? MP + b * SL : b * PL, t0 = rowb - row0;
            float a0[8], a1[8], a2[8], b0[8], b1[8], b2[8];
            u_row8(F, grp, b, row0, t0 - 2, c, a0); u_row8(F, grp, b, row0, t0 - 1, c, a1);
            u_row8(F, grp, b, row0, t0 - 2, FF + c, b0); u_row8(F, grp, b, row0, t0 - 1, FF + c, b1);
#pragma unroll
            for (int t = 0; t < 8; ++t) { u_row8(F, grp, b, row0, t0 + t, c, a2); u_row8(F, grp, b, row0, t0 + t, FF + c, b2);
                float r[8];
#pragma unroll
                for (int e = 0; e < 8; ++e) { const float a = ba[e] + wa[0][e] * a0[e] + wa[1][e] * a1[e] + wa[2][e] * a2[e], g = bb[e] + wb[0][e] * b0[e] + wb[1][e] * b1[e] + wb[2][e] * b2[e];
                    r[e] = silu_f(a) * g; a0[e] = a1[e]; a1[e] = a2[e]; b0[e] = b1[e]; b1[e] = b2[e]; }
                *(v4u*)(F.ACT + (size_t)(rowb + t) * FF + c) = (v4u){pk2(r[0], r[1]), pk2(r[2], r[3]), pk2(r[4], r[5]), pk2(r[6], r[7])}; } } }
    for (int i = gt; i < (PB + SB) * 2 * FF2; i += NT) { const int c = i % FF2, j = (i / FF2) % 2, s = i / (2 * FF2);
        const int grp = s >= PB, b = grp ? s - PB : s, L = grp ? SL : PL, row0 = grp ? MP + b * SL : b * PL;
        F.out[(grp ? O_FCONV_S : O_FCONV_P) + ((size_t)b * 2 + j) * FF2 + c] = bf2f(F.U[(size_t)(row0 + L - 2 + j) * FF2 + c]); }
}
__device__ __forceinline__ void p8_final(Frame& F) {
    const int gw = F.bid * NWAVES + F.wave, NGW = F.G * NWAVES, lane = F.lane;
    for (int m = gw; m < M; m += NGW) {
        const f32x4* fr = (const f32x4*)(F.Fb + (size_t)m * DM) + lane; const f32x4* w1 = (const f32x4*)F.n_ffn_post + lane;
        f32x4* ho = (f32x4*)(F.out + O_Y + (size_t)m * DM) + lane;
        f32x4 v[8]; float s = 0.f;
#pragma unroll
        for (int j = 0; j < 8; ++j) { v[j] = fr[64 * j]; s += (v[j].x * v[j].x + v[j].y * v[j].y) + (v[j].z * v[j].z + v[j].w * v[j].w); }
        const float r1 = rsqrtf(wave_sum(s) * (1.f / DM) + EPS);
#pragma unroll
        for (int j = 0; j < 8; ++j) ho[64 * j] = ho[64 * j] + v[j] * r1 * w1[64 * j];
    }
}

__device__ __forceinline__ pg8::SplitCtx split_ctx(const Frame& F, unsigned char* ws, size_t slab_off, int bank) {
    pg8::SplitCtx X; X.slabs = (pg8::f32x4*)(ws + slab_off); X.cnt = (unsigned*)(ws + WS_CTL) + CW_SPLIT + bank * 1024; X.flag = (volatile LAS unsigned*)(F.lds + MISC_OFF) + 16; return X; }

struct Args { const float* in[25]; float* out; unsigned char* ws; int ph_lo, ph_hi; };
__global__ void __launch_bounds__(NTHR, 2) fwd_kernel(Args args) {
    extern __shared__ __attribute__((aligned(16))) unsigned char lds[];
    Frame F;
    F.lds = (LAS unsigned char*)lds;
    F.tid = threadIdx.x; F.lane = F.tid & 63; F.wave = __builtin_amdgcn_readfirstlane(F.tid >> 6);
    F.G = gridDim.x; F.bid = blockIdx.x;
    unsigned char* ws = args.ws;
    F.x_p = args.in[0]; F.x_s = args.in[1]; F.st_gla = args.in[2]; F.st_ssd = args.in[3]; F.st_sconv = args.in[4]; F.st_fconv = args.in[5];
    F.n_mix_pre = args.in[6]; F.n_mix_post = args.in[7]; F.n_ffn_pre = args.in[8]; F.n_ffn_post = args.in[9]; F.w_in = args.in[10];
    F.w_gate2 = args.in[11]; F.b_gate = args.in[12]; F.gla_norm = args.in[13]; F.sconv_w = args.in[14]; F.sconv_b = args.in[15];
    F.dt_bias = args.in[16]; F.A_log = args.in[17]; F.ssd_D = args.in[18]; F.ssd_norm = args.in[19]; F.w_out = args.in[20];
    F.ffn_w_in = args.in[21]; F.fconv_w = args.in[22]; F.fconv_b = args.in[23]; F.ffn_w_out = args.in[24];
    F.out = args.out;
    F.W1 = (bf16*)(ws + WS_W1); F.WO = (bf16*)(ws + WS_WO); F.WF1 = (bf16*)(ws + WS_WF1); F.WF2 = (bf16*)(ws + WS_WF2);
    F.XN = (bf16*)(ws + WS_XN); F.PROJ = (bf16*)(ws + WS_PROJ); F.MIXIN = (bf16*)(ws + WS_MIXIN); F.U = (bf16*)(ws + WS_U); F.ACT = (bf16*)(ws + WS_ACT);
    F.LRDT = (float*)(ws + WS_LRDT); F.MIX = (float*)(ws + WS_MIX); F.Fb = (float*)(ws + WS_F);
    F.DS = (bf16*)(ws + WS_DS); F.SC = (bf16*)(ws + WS_SC); F.DH = (bf16*)(ws + WS_DH); F.HC = (bf16*)(ws + WS_HC); F.EBL = (float*)(ws + WS_EBL); F.AL = (float*)(ws + WS_AL);
    for (int u = F.tid; u < (LDS_BYTES - LDSCTL_OFF) / 4; u += NTHR) ((LAS unsigned*)(F.lds + LDSCTL_OFF))[u] = 0u;
    __syncthreads();
    const int lo = args.ph_lo, hi = args.ph_hi;
#if !MK_PER_PHASE
    XcdBarrier bar = xcd_barrier_post((unsigned*)(ws + WS_CTL) + CW_BAR, (volatile LAS unsigned*)(F.lds + MISC_OFF) + 8);
#define GRID_BAR() do { if (args.ph_hi > 1000) cg::this_grid().sync(); xcd_barrier(bar); } while (0)
#else
#define GRID_BAR() do { } while (0)
#endif
#define IN(k) (lo <= (k) && (k) < hi)
#define SEAM(k) do { if (IN(k) && IN((k) + 1)) GRID_BAR(); } while (0)
#define PHASE(k, ...) do { if (IN(k)) { if (MK_REP_PHASE == (k)) { __VA_ARGS__; GRID_BAR(); } __VA_ARGS__; SEAM(k); } } while (0)
    PHASE(0, p0_prologue(F));
    PHASE(1, { pg8::Gemm g{F.XN, F.W1, M, N1, DM}; pg8::StaticOrder S; S.init(M, N1, DM, F.G, F.bid, 1);
        pg8::EpiBf16 E{F.PROJ, NP, NP / 256, F.LRDT};
        pg8::gemm_phase<pg8::EpiBf16, pg8::StaticOrder, true, true>(F.lds, g, S, E, split_ctx(F, ws, WS_SLAB, 0));
        if (S.rem && F.bid >= S.rem * S.S) p0_convert_rest(F, F.bid - S.rem * S.S, F.G - S.rem * S.S); else if (!S.rem) p0_convert_rest(F, F.bid, F.G); });
    PHASE(2, p2a_chunk_states(F));
    PHASE(3, p2b_scans_and_sample(F));
    PHASE(4, p2c_outputs(F));
    PHASE(5, { pg8::Gemm g{F.MIXIN, F.WO, M, DM, DM}; pg8::StaticOrder S; S.init(M, DM, DM, F.G, F.bid, 8);
        pg8::EpiF32 E{F.MIX, DM};
        pg8::gemm_phase<pg8::EpiF32, pg8::StaticOrder, true, true>(F.lds, g, S, E, split_ctx(F, ws, WS_SLAB, 1)); });
    PHASE(6, p4_post_mixer(F));
    PHASE(7, { pg8::Gemm g{F.XN, F.WF1, M, FF2, DM}; pg8::StaticOrder S; S.init(M, FF2, DM, F.G, F.bid, 4);
        pg8::EpiBf16 E{F.U, FF2, FF2 / 256, nullptr};
        pg8::gemm_phase<pg8::EpiBf16, pg8::StaticOrder, true, true>(F.lds, g, S, E, split_ctx(F, ws, WS_SLAB_F1, 2)); });
    PHASE(8, p6_conv_act(F));
    PHASE(9, { pg8::Gemm g{F.ACT, F.WF2, M, DM, FF}; pg8::StaticOrder S; S.init(M, DM, FF, F.G, F.bid, 8);
        pg8::EpiF32 E{F.Fb, DM};
        pg8::gemm_phase<pg8::EpiF32, pg8::StaticOrder, true, true>(F.lds, g, S, E, split_ctx(F, ws, WS_SLAB, 3)); });
    if (IN(10)) { p8_final(F); }
#undef IN
#undef SEAM
}

extern "C" void kernel_launch(void* const* d_in, const int* in_sizes, int n_in, void* d_out, int out_size, void* d_ws, size_t ws_size, hipStream_t stream) {
    static int grid = 0;
    if (grid == 0) {
        if (n_in != 25 || (size_t)out_size != O_END || ws_size < WS_END) { fprintf(stderr, "kernel_launch: unexpected sizes n_in %d out %d ws %zu (need out %zu ws %zu)\n", n_in, out_size, ws_size, (size_t)O_END, (size_t)WS_END); grid = -1; return; }
        int dev = 0, cus = 0, per_cu = 0;
        hipGetDevice(&dev); hipDeviceGetAttribute(&cus, hipDeviceAttributeMultiprocessorCount, dev);
        if (hipFuncSetAttribute((const void*)fwd_kernel, hipFuncAttributeMaxDynamicSharedMemorySize, LDS_BYTES) != hipSuccess) { fprintf(stderr, "kernel_launch: hipFuncSetAttribute failed\n"); grid = -1; return; }
        hipOccupancyMaxActiveBlocksPerMultiprocessor(&per_cu, (const void*)fwd_kernel, NTHR, LDS_BYTES);
        if (per_cu < 1) { fprintf(stderr, "kernel_launch: occupancy query says %d blocks per CU\n", per_cu); grid = -1; return; }
        grid = cus;
        (void)hipGetLastError();
    }
    if (grid < 0) return;
    Args a{};
    for (int i = 0; i < 25; ++i) a.in[i] = (const float*)d_in[i];
    a.out = (float*)d_out; a.ws = (unsigned char*)d_ws;
#if MK_PER_PHASE
    hipMemsetAsync((char*)d_ws + WS_CTL, 0, CTL_ZERO_BYTES, stream);
    for (int p = 0; p < N_PHASES; ++p) { a.ph_lo = p; a.ph_hi = p + 1; hipLaunchKernelGGL(fwd_kernel, dim3(grid), dim3(NTHR), LDS_BYTES, stream, a); }
#else
    hipMemsetAsync((char*)d_ws + WS_CTL, 0, CTL_ZERO_BYTES, stream);
    a.ph_lo = 0; a.ph_hi = N_PHASES;
    void* kargs[] = {&a};
    hipError_t e = hipLaunchCooperativeKernel((const void*)fwd_kernel, dim3(grid), dim3(NTHR), kargs, LDS_BYTES, stream);
    if (e != hipSuccess) fprintf(stderr, "kernel_launch: cooperative launch failed: %s (grid %d)\n", hipGetErrorString(e), grid);
#endif
}
```

```cpp
#include <hip/hip_runtime.h>
#include <hip/hip_cooperative_groups.h>
#include <cstdio>
#include <cstdint>
namespace cg = cooperative_groups;

#ifndef MK_PER_PHASE
#define MK_PER_PHASE 0
#endif

namespace pg8 {
#define PG8_LAS __attribute__((address_space(3)))
typedef unsigned short bf16_t;
typedef short bf16x8 __attribute__((ext_vector_type(8)));
typedef float f32x4 __attribute__((ext_vector_type(4)));
typedef unsigned u32x4 __attribute__((ext_vector_type(4)));
constexpr int BM = 256, BK = 64, HALF = 128, HTB = HALF * BK * 2  , STAGE_BYTES = 8 * HTB, NXCD = 8, WGM = 8;

__host__ __device__ __forceinline__ int lds_byte(int r, int c) { const int st = (r >> 4) * 2 + (c >> 5), rr = r & 15, cc = c & 31, ob = rr * 64 + cc * 2; return st * 1024 + (ob ^ (((ob >> 9) & 1) << 5)); }
__host__ __device__ __forceinline__ void stage_rc(int b, int& R, int& C) { const int st = b / 1024, sb = b % 1024, swz = sb ^ (((sb >> 9) & 1) << 5); R = (st >> 1) * 16 + swz / 64; C = (st & 1) * 32 + (swz % 64) / 2; }
__host__ __device__ __forceinline__ int perm32(int rho) { const int n = rho >> 4, i = rho & 15; return 8 * (i >> 2) + 4 * n + (i & 3); }

struct Unit { int pm, pn, k0, nk, slice, nsl, tix; };
struct Gemm { const bf16_t* A; const bf16_t* Bt; int M, N, K; };

struct StaticOrder {
    int nM, nN, nwg, G, c, rounds, rem, S, ntK;
    __host__ __device__ __forceinline__ void init(int M, int N, int K, int G_, int c_, int Smax) { nM = M / BM; nN = N / BM; nwg = nM * nN; G = G_; c = c_; ntK = K / BK; rounds = nwg / G; rem = nwg - rounds * G; S = 1;
        if (rem) { while (S < Smax && rem * (S * 2) <= G && (ntK / 2) >= S * 2) S *= 2; } }
    __host__ __device__ __forceinline__ void tile(int L, Unit& u) const {
        int wgid = L; { const int q = nwg / NXCD, r = nwg % NXCD, xcd = wgid % NXCD, off = wgid / NXCD; wgid = (xcd < r ? xcd * (q + 1) : r * (q + 1) + (xcd - r) * q) + off; }
        const int nig = WGM * nN, gid = wgid / nig, fm = gid * WGM, gsz = (nM - fm) < WGM ? (nM - fm) : WGM;
        u.pm = fm + ((wgid % nig) % gsz); u.pn = (wgid % nig) / gsz; }
    __host__ __device__ __forceinline__ bool next(int i, Unit& u) const {
        if (i < rounds) { tile(i * G + c, u); u.k0 = 0; u.nk = ntK; u.slice = 0; u.nsl = 1; u.tix = 0; return true; }
        if (i == rounds && c < rem * S) { const int tix = c % rem, sl = c / rem; tile(rounds * G + tix, u);
            const int pairs = ntK / 2, base = pairs / S, extra = pairs % S, np = base + (sl < extra ? 1 : 0), p0 = sl * base + (sl < extra ? sl : extra);
            u.k0 = 2 * p0; u.nk = 2 * np; u.slice = sl; u.nsl = S; u.tix = tix; return true; }
        return false;
    }
    __device__ __forceinline__ void a_ready(const Unit&) const {}
    __device__ __forceinline__ void done(const Unit&) const {}
};
struct SplitCtx { f32x4* slabs; unsigned* cnt; volatile PG8_LAS unsigned* flag; };
__device__ __forceinline__ int split_reduce(f32x4 (&acc)[2][2][4][2], const Unit& u, const SplitCtx& X, int tid) {
    const __amdgpu_buffer_rsrc_t rs = __builtin_amdgcn_make_buffer_rsrc((void*)X.slabs, (short)0, (int)0x7fffffff, 0x00020000);
    const unsigned mine = (unsigned)((u.tix * u.nsl + u.slice) * 32) * 8192u + (unsigned)tid * 16u;
#pragma unroll
    for (int a = 0; a < 2; ++a)
#pragma unroll
        for (int b = 0; b < 2; ++b)
#pragma unroll
            for (int m = 0; m < 4; ++m)
#pragma unroll
                for (int n = 0; n < 2; ++n) __builtin_amdgcn_raw_buffer_store_b128(__builtin_bit_cast(u32x4, acc[a][b][m][n]), rs, mine + (unsigned)((((a * 2 + b) * 4 + m) * 2 + n) * 8192), 0,   16);
    asm volatile("s_waitcnt vmcnt(0)" ::: "memory");
    __syncthreads();
    if (tid == 0) {
        unsigned* c = X.cnt + 16 * u.tix;
        (void)__hip_atomic_fetch_add(c, 1u, __ATOMIC_RELAXED, __HIP_MEMORY_SCOPE_AGENT);
        unsigned spins = 0;
        while (__hip_atomic_load(c, __ATOMIC_RELAXED, __HIP_MEMORY_SCOPE_AGENT) < (unsigned)u.nsl) { __builtin_amdgcn_s_sleep(2); if (++spins > (1u << 22)) break; }
        __builtin_amdgcn_fence(__ATOMIC_ACQUIRE, "agent");
        asm volatile("s_waitcnt vmcnt(0)" ::: "memory");
    }
    __syncthreads();
    const int shift = u.nsl == 8 ? 2 : (u.nsl == 4 ? 3 : 4);
    for (int s = 0; s < u.nsl; ++s) { if (s == u.slice) continue;
        const f32x4* o = X.slabs + ((size_t)(u.tix * u.nsl + s) * 32) * 512 + tid;
#pragma unroll
        for (int a = 0; a < 2; ++a)
#pragma unroll
            for (int b = 0; b < 2; ++b)
#pragma unroll
                for (int m = 0; m < 4; ++m)
#pragma unroll
                    for (int n = 0; n < 2; ++n) { const int r4 = ((a * 2 + b) * 4 + m) * 2 + n; if ((r4 >> shift) == u.slice) acc[a][b][m][n] += o[(size_t)r4 * 512]; } }
    return shift;
}

__device__ __forceinline__ unsigned cvt_pk_bf16(float lo, float hi) { unsigned r; asm volatile("v_cvt_pk_bf16_f32 %0, %1, %2" : "=v"(r) : "v"(lo), "v"(hi)); return r; }

struct EpiF32 {
    static constexpr bool PERM = false, AFTER_DRAIN = false;
    float* C; int ldc;
    __device__ __forceinline__ void operator()(const f32x4 (&acc)[2][2][4][2], const Unit& u, int wr, int wc, int fr, int fq, int shift, int part) const {
        const int row0 = u.pm * BM + wr * 64 + fr, col0 = u.pn * BM + wc * 32 + 4 * fq;
#pragma unroll
        for (int ai = 0; ai < 2; ++ai)
#pragma unroll
            for (int m = 0; m < 4; ++m) { float* rowp = C + (size_t)(row0 + ai * HALF + m * 16) * ldc + col0;
#pragma unroll
                for (int bj = 0; bj < 2; ++bj)
#pragma unroll
                    for (int n = 0; n < 2; ++n) if ((((((ai * 2 + bj) * 4 + m) * 2 + n)) >> shift) == part) *(f32x4*)(rowp + bj * HALF + n * 16) = acc[ai][bj][m][n]; }
    }
};
struct EpiBf16 {
    static constexpr bool PERM = true, AFTER_DRAIN = false;
    bf16_t* O; int ldc; int nfull; float* X;
    __device__ __forceinline__ void operator()(const f32x4 (&acc)[2][2][4][2], const Unit& u, int wr, int wc, int fr, int fq, int shift, int part) const {
        const int row0 = u.pm * BM + wr * 64 + fr;
        if (u.pn < nfull) {
            const int col0 = u.pn * BM + wc * 32 + 8 * fq;
#pragma unroll
            for (int ai = 0; ai < 2; ++ai)
#pragma unroll
                for (int m = 0; m < 4; ++m) { bf16_t* rowp = O + (size_t)(row0 + ai * HALF + m * 16) * ldc + col0;
#pragma unroll
                    for (int bj = 0; bj < 2; ++bj) { if ((((((ai * 2 + bj) * 4 + m) * 2)) >> shift) != part) continue; const f32x4 v0 = acc[ai][bj][m][0], v1 = acc[ai][bj][m][1];
                        u32x4 w; w.x = cvt_pk_bf16(v0[0], v0[1]); w.y = cvt_pk_bf16(v0[2], v0[3]); w.z = cvt_pk_bf16(v1[0], v1[1]); w.w = cvt_pk_bf16(v1[2], v1[3]);
                        *(u32x4*)(rowp + bj * HALF) = w; } }
        } else if (wc == 0) {
#pragma unroll
            for (int ai = 0; ai < 2; ++ai)
#pragma unroll
                for (int m = 0; m < 4; ++m) { if ((((((ai * 2) * 4 + m) * 2)) >> shift) != part) continue; float* rowp = X + (size_t)(row0 + ai * HALF + m * 16) * 32 + 8 * fq;
                    *(f32x4*)(rowp) = acc[ai][0][m][0]; *(f32x4*)(rowp + 4) = acc[ai][0][m][1]; }
        }
    }
};

template <class Epi, class Sched, bool ALIGN_EPI = false, bool SP2 = false>
__device__ __forceinline__ void gemm_phase(PG8_LAS unsigned char* lds, const Gemm g, const Sched& S, const Epi& E, const SplitCtx& X) {
    const int tid = threadIdx.x, wid = __builtin_amdgcn_readfirstlane(tid >> 6), lane = tid & 63, wr = wid >> 2, wc = wid & 3, fr = lane & 15, fq = lane >> 4;
    const int K = g.K;
    unsigned voffA[2], voffB[2];
#pragma unroll
    for (int i = 0; i < 2; ++i) { int R, C; stage_rc(tid * 16 + i * 8192, R, C); const int Rb = Epi::PERM ? ((R & ~31) + perm32(R & 31)) : R;
        voffA[i] = (unsigned)(R * K + C) * 2u; voffB[i] = (unsigned)(Rb * K + C) * 2u; }
    const size_t kstep = (size_t)(BK * 2);
    const size_t hstep = (size_t)HALF * K * 2;
    const size_t tstep = 2 * hstep;
    const unsigned ldsw = (unsigned)wid * 1024u;
    const int aoff = lds_byte(wr * 64 + fr, fq * 8), boff = lds_byte(wc * 32 + fr, fq * 8);
#define PG8_SA(b, h) (((b) * 2 + (h)) * HTB)
#define PG8_SB(b, h) ((4 + (b) * 2 + (h)) * HTB)
#define PG8_STAGE(bufoff, gbase, voff) do { _Pragma("unroll") for (int _i = 0; _i < 2; ++_i) \
        __builtin_amdgcn_global_load_lds((const unsigned*)((const char*)(gbase) + (voff)[_i]), (PG8_LAS unsigned*)(lds + (bufoff) + ldsw + _i * 8192), 16, 0, 0); } while (0)
#define PG8_LDA(dst, b, h) do { _Pragma("unroll") for (int m = 0; m < 4; ++m) _Pragma("unroll") for (int k = 0; k < 2; ++k) dst[m][k] = *(const PG8_LAS bf16x8*)(lds + PG8_SA(b, h) + aoff + m * 2048 + k * 1024); } while (0)
#define PG8_LDB(dst, b, h) do { _Pragma("unroll") for (int n = 0; n < 2; ++n) _Pragma("unroll") for (int k = 0; k < 2; ++k) dst[n][k] = *(const PG8_LAS bf16x8*)(lds + PG8_SB(b, h) + boff + n * 2048 + k * 1024); } while (0)
#define PG8_MMA(ai, bj, At, Bt) do { __builtin_amdgcn_s_setprio(1); _Pragma("unroll") for (int m = 0; m < 4; ++m) _Pragma("unroll") for (int n = 0; n < 2; ++n) _Pragma("unroll") for (int k = 0; k < 2; ++k) \
        acc[ai][bj][m][n] = __builtin_amdgcn_mfma_f32_16x16x32_bf16(Bt[n][k], At[m][k], acc[ai][bj][m][n], 0, 0, 0); __builtin_amdgcn_s_setprio(0); } while (0)
#define PG8_WAIT_V(n) asm volatile("s_waitcnt vmcnt(" #n ")" ::: "memory")
#define PG8_WAIT_L(n) asm volatile("s_waitcnt lgkmcnt(" #n ")" ::: "memory")
#define PG8_BAR __builtin_amdgcn_s_barrier()
#define PG8_SCHED __builtin_amdgcn_sched_barrier(0)
    Unit cur, nxt; int ui = 0;
    if (!S.next(0, cur)) return;
    f32x4 acc[2][2][4][2];
#pragma unroll
    for (int a = 0; a < 2; ++a)
#pragma unroll
        for (int b = 0; b < 2; ++b)
#pragma unroll
            for (int m = 0; m < 4; ++m)
#pragma unroll
                for (int n = 0; n < 2; ++n) acc[a][b][m][n] = (f32x4){0.f, 0.f, 0.f, 0.f};
    bf16x8 At[4][2], B0[2][2], B1[2][2];
    const char* cA = (const char*)g.A + (size_t)cur.pm * tstep + (size_t)cur.k0 * kstep; const char* cB = (const char*)g.Bt + (size_t)cur.pn * tstep + (size_t)cur.k0 * kstep;
    S.a_ready(cur);
    if constexpr (SP2) {
        PG8_STAGE(PG8_SB(0, 0), cB, voffB); PG8_STAGE(PG8_SB(0, 1), cB + hstep, voffB); PG8_STAGE(PG8_SA(0, 0), cA, voffA); PG8_STAGE(PG8_SA(0, 1), cA + hstep, voffA);
        if (wr == 1) PG8_BAR;
        PG8_WAIT_V(2); PG8_BAR;
        PG8_STAGE(PG8_SB(1, 0), cB + kstep, voffB); PG8_STAGE(PG8_SA(1, 0), cA + kstep, voffA); PG8_STAGE(PG8_SB(1, 1), cB + hstep + kstep, voffB);
        PG8_WAIT_V(6); PG8_BAR;
    } else {
        PG8_STAGE(PG8_SB(0, 0), cB, voffB); PG8_STAGE(PG8_SA(0, 0), cA, voffA); PG8_STAGE(PG8_SB(0, 1), cB + hstep, voffB); PG8_STAGE(PG8_SA(0, 1), cA + hstep, voffA);
        if (wr == 1) PG8_BAR;
        PG8_WAIT_V(4); PG8_BAR;
        PG8_STAGE(PG8_SB(1, 0), cB + kstep, voffB); PG8_STAGE(PG8_SA(1, 0), cA + kstep, voffA); PG8_STAGE(PG8_SB(1, 1), cB + hstep + kstep, voffB);
        PG8_WAIT_V(6); PG8_BAR;
    }
    for (;;) {
        const bool has_next = S.next(ui + 1, nxt);
        const char* nA = has_next ? (const char*)g.A + (size_t)nxt.pm * tstep + (size_t)nxt.k0 * kstep : cA; const char* nB = has_next ? (const char*)g.Bt + (size_t)nxt.pn * tstep + (size_t)nxt.k0 * kstep : cB;
        const int nt = cur.nk;
        for (int t = 0; t < nt; t += 2) {
            const bool last = (t == nt - 2);
            const char* a1 = cA + (size_t)(t + 1) * kstep;
            const char* a2 = last ? nA : cA + (size_t)(t + 2) * kstep; const char* b2 = last ? nB : cB + (size_t)(t + 2) * kstep;
            const char* a3 = a2 + kstep; const char* b3 = b2 + kstep;
            if (last && has_next) S.a_ready(nxt);
            if constexpr (SP2) {
            PG8_LDB(B0, 0, 0); PG8_LDB(B1, 0, 1); PG8_SCHED; PG8_LDA(At, 0, 0); PG8_STAGE(PG8_SA(1, 1), a1 + hstep, voffA);
            PG8_WAIT_V(8); PG8_WAIT_L(0); PG8_BAR; PG8_MMA(0, 0, At, B0); PG8_MMA(0, 1, At, B1); PG8_BAR; PG8_SCHED;
            PG8_LDA(At, 0, 1); PG8_STAGE(PG8_SB(0, 0), b2, voffB); PG8_STAGE(PG8_SB(0, 1), b2 + hstep, voffB); PG8_STAGE(PG8_SA(0, 0), a2, voffA);
            PG8_WAIT_V(8); PG8_WAIT_L(0); PG8_BAR; PG8_MMA(1, 0, At, B0); PG8_MMA(1, 1, At, B1); PG8_BAR; PG8_SCHED;
            PG8_LDB(B0, 1, 0); PG8_LDB(B1, 1, 1); PG8_SCHED; PG8_LDA(At, 1, 0); PG8_STAGE(PG8_SA(0, 1), a2 + hstep, voffA);
            PG8_WAIT_V(8); PG8_WAIT_L(0); PG8_BAR; PG8_MMA(0, 0, At, B0); PG8_MMA(0, 1, At, B1); PG8_BAR; PG8_SCHED;
            PG8_LDA(At, 1, 1); PG8_STAGE(PG8_SB(1, 0), b3, voffB); PG8_STAGE(PG8_SB(1, 1), b3 + hstep, voffB); PG8_STAGE(PG8_SA(1, 0), a3, voffA);
            PG8_WAIT_V(8); PG8_WAIT_L(0); PG8_BAR; PG8_MMA(1, 0, At, B0); PG8_MMA(1, 1, At, B1); PG8_BAR; PG8_SCHED;
            } else {
            PG8_LDB(B0, 0, 0); PG8_SCHED; PG8_LDA(At, 0, 0); PG8_STAGE(PG8_SA(1, 1), a1 + hstep, voffA);
            PG8_WAIT_L(8); PG8_BAR; PG8_WAIT_L(0); PG8_MMA(0, 0, At, B0); PG8_BAR; PG8_SCHED;
            PG8_LDB(B1, 0, 1); PG8_STAGE(PG8_SB(0, 0), b2, voffB);
            PG8_BAR; PG8_WAIT_L(0); PG8_MMA(0, 1, At, B1); PG8_BAR;
            PG8_LDA(At, 0, 1); PG8_STAGE(PG8_SA(0, 0), a2, voffA);
            PG8_BAR; PG8_WAIT_L(0); PG8_MMA(1, 0, At, B0); PG8_BAR; PG8_SCHED;
            PG8_STAGE(PG8_SB(0, 1), b2 + hstep, voffB);
            PG8_WAIT_V(6); PG8_BAR; PG8_MMA(1, 1, At, B1); PG8_BAR;
            PG8_LDB(B0, 1, 0); PG8_SCHED; PG8_LDA(At, 1, 0); PG8_STAGE(PG8_SA(0, 1), a2 + hstep, voffA);
            PG8_WAIT_L(8); PG8_BAR; PG8_WAIT_L(0); PG8_MMA(0, 0, At, B0); PG8_BAR; PG8_SCHED;
            PG8_LDB(B1, 1, 1); PG8_STAGE(PG8_SB(1, 0), b3, voffB);
            PG8_BAR; PG8_WAIT_L(0); PG8_MMA(0, 1, At, B1); PG8_BAR;
            PG8_LDA(At, 1, 1); PG8_STAGE(PG8_SA(1, 0), a3, voffA);
            PG8_BAR; PG8_WAIT_L(0); PG8_MMA(1, 0, At, B0); PG8_BAR; PG8_SCHED;
            PG8_STAGE(PG8_SB(1, 1), b3 + hstep, voffB);
            PG8_WAIT_V(6); PG8_BAR; PG8_MMA(1, 1, At, B1); PG8_BAR;
            }
        }
        if constexpr (ALIGN_EPI) { if (wr == 0) PG8_BAR; }
        if constexpr (!Epi::AFTER_DRAIN) { static_assert(ALIGN_EPI, "split_reduce needs the halves aligned"); if (cur.nsl > 1) { const int shift = split_reduce(acc, cur, X, tid); E(acc, cur, wr, wc, fr, fq, shift, cur.slice); } else E(acc, cur, wr, wc, fr, fq, 5, 0); S.done(cur); }
        if (!has_next) break;
#pragma unroll
        for (int a = 0; a < 2; ++a)
#pragma unroll
            for (int b = 0; b < 2; ++b)
#pragma unroll
                for (int m = 0; m < 4; ++m)
#pragma unroll
                    for (int n = 0; n < 2; ++n) acc[a][b][m][n] = (f32x4){0.f, 0.f, 0.f, 0.f};
        cur = nxt; cA = nA; cB = nB; ++ui;
        if constexpr (ALIGN_EPI) { if (wr == 1) PG8_BAR; }
    }
    PG8_WAIT_V(0);
    if constexpr (!ALIGN_EPI) { if (wr == 0) PG8_BAR; }
    PG8_BAR;
    if constexpr (Epi::AFTER_DRAIN) { E.fused(acc, cur, wr, wc, fr, fq, lds, wid, lane); S.done(cur); }
#undef PG8_SA
#undef PG8_SB
#undef PG8_STAGE
#undef PG8_LDA
#undef PG8_LDB
#undef PG8_MMA
#undef PG8_WAIT_V
#undef PG8_WAIT_L
#undef PG8_BAR
#undef PG8_SCHED
}
}

constexpr int NWAVES = 8, NTHR = 512;
constexpr int DM = 2048, PB = 4, PL = 2048, SB = 128, SL = 8;
constexpr int MP = PB * PL, MS = SB * SL, M = MP + MS;
constexpr int GH = 4, GK = 128, GV = 256, GKD = 512, LOWR = 16;
constexpr int SH = 16, SP = 64, SN = 128, SG = 2, SCH = 1536;
constexpr int FF = 5632, FF2 = 11264, INC = 5664;
constexpr int N1 = 5888, NP = 5632;
constexpr int CQ = 0, CK = 512, CV = 1024, CG = 2048, CZ = 3072, CX = 4096;
constexpr float EPS = 1e-6f;
constexpr int N_PHASES = 11;

constexpr size_t O_Y = 0, O_GLA_P = (size_t)M * DM, O_SSD_P = O_GLA_P + (size_t)PB * GH * GK * GV, O_SCONV_P = O_SSD_P + (size_t)PB * SH * SP * SN,
                 O_FCONV_P = O_SCONV_P + (size_t)PB * 3 * SCH, O_GLA_S = O_FCONV_P + (size_t)PB * 2 * FF2, O_SSD_S = O_GLA_S + (size_t)SB * GH * GK * GV,
                 O_SCONV_S = O_SSD_S + (size_t)SB * SH * SP * SN, O_FCONV_S = O_SCONV_S + (size_t)SB * 3 * SCH, O_END = O_FCONV_S + (size_t)SB * 2 * FF2;

constexpr size_t MiB = 1u << 20;
constexpr size_t WS_CTL = 0, CTL_ZERO_BYTES = 64 * 1024;
constexpr size_t WS_WF2 = 1 * MiB;
constexpr size_t WS_W1 = 24 * MiB;
constexpr size_t WS_WO = 48 * MiB;
constexpr size_t WS_WF1 = 56 * MiB;
constexpr size_t WS_XN = 101 * MiB;
constexpr size_t WS_ACT = 24 * MiB;
constexpr size_t WS_BIG = 141 * MiB;
constexpr size_t WS_PROJ = WS_BIG;
constexpr size_t WS_MIX = WS_BIG;
constexpr size_t WS_U = WS_BIG;
constexpr size_t WS_F = WS_BIG;
constexpr size_t WS_LRDT = WS_BIG + 100 * MiB;
constexpr size_t WS_MIXIN = WS_BIG + 104 * MiB;
constexpr size_t WS_DS = WS_XN;
constexpr size_t WS_SC = WS_BIG + 140 * MiB, WS_DH = WS_BIG + 172 * MiB, WS_HC = WS_BIG + 204 * MiB;
constexpr size_t WS_EBL = WS_BIG + 236 * MiB, WS_AL = WS_EBL + 512 * 1024;
constexpr size_t WS_SLAB = WS_BIG + 140 * MiB;
constexpr size_t WS_SLAB_F1 = WS_BIG + 198 * MiB;
constexpr size_t WS_END = WS_BIG + 247 * MiB;
static_assert(WS_WF2 + (size_t)DM * FF * 2 <= WS_W1 && WS_W1 + (size_t)N1 * DM * 2 <= WS_WO && WS_WO + (size_t)DM * DM * 2 <= WS_WF1 && WS_WF1 + (size_t)FF2 * DM * 2 <= WS_XN && WS_XN + (size_t)M * DM * 2 <= WS_BIG, "ws map 1");
static_assert(WS_ACT + (size_t)M * FF * 2 <= WS_BIG && WS_PROJ + (size_t)M * NP * 2 <= WS_LRDT && WS_LRDT + (size_t)M * 32 * 4 <= WS_MIXIN && WS_MIXIN + (size_t)M * DM * 2 <= WS_SC && WS_U + (size_t)M * FF2 * 2 <= WS_END && WS_MIX + (size_t)M * DM * 4 <= WS_LRDT, "ws map 2");
constexpr int CW_BAR = 1024;
constexpr int CW_SPLIT = 8192;

constexpr int RING_BYTES = 131072;
constexpr int SCRATCH_BYTES = 8 * 16640;
constexpr int LDSCTL_OFF = 133632, MISC_OFF = LDSCTL_OFF + 320;
constexpr int LDS_BYTES = 150016;

#ifndef MK_TIME_PHASE
#define MK_TIME_PHASE (-1)
#endif
#define TBEGIN(F, id) do { if (MK_TIME_PHASE == (id)) (F).tmark = __builtin_amdgcn_s_memrealtime(); } while (0)
#define TEND(F, id) do { if (MK_TIME_PHASE == (id)) (F).tacc += __builtin_amdgcn_s_memrealtime() - (F).tmark; } while (0)
#define GAS __attribute__((address_space(1)))
#define LAS __attribute__((address_space(3)))
typedef unsigned short bf16;
typedef unsigned v4u __attribute__((ext_vector_type(4)));
typedef unsigned v2u __attribute__((ext_vector_type(2)));
typedef float f32x4 __attribute__((ext_vector_type(4)));
#define LDS_WAIT() asm volatile("s_waitcnt lgkmcnt(0)" ::: "memory")
#define VM_WAIT() asm volatile("s_waitcnt vmcnt(0)" ::: "memory")
__device__ __forceinline__ unsigned f2bf(float f) { unsigned u = __builtin_bit_cast(unsigned, f); return (u + 0x7fffu + ((u >> 16) & 1u)) >> 16; }
__device__ __forceinline__ unsigned pk2(float lo, float hi) { return f2bf(lo) | (f2bf(hi) << 16); }
__device__ __forceinline__ float bf2f(unsigned short b) { return __builtin_bit_cast(float, (unsigned)b << 16); }
__device__ __forceinline__ float bflo(unsigned w) { return __builtin_bit_cast(float, w << 16); }
__device__ __forceinline__ float bfhi(unsigned w) { return __builtin_bit_cast(float, w & 0xffff0000u); }
__device__ __forceinline__ float silu_f(float x) { return x / (1.f + __expf(-x)); }
__device__ __forceinline__ float softplus_f(float x) { return fmaxf(x, 0.f) + log1pf(__expf(-fabsf(x))); }
__device__ __forceinline__ float logsigmoid_f(float x) { return fminf(x, 0.f) - log1pf(__expf(-fabsf(x))); }
__device__ __forceinline__ float wave_sum(float v) {
#pragma unroll
    for (int o = 1; o < 64; o <<= 1) v += __shfl_xor(v, o);
    return v;
}

#define XB_TMO      128
#define XB_XCNT(j)  (256  + 64 * (j))
#define XB_XSUB(j)  (1280 + 64 * (j))
#define XB_XGEN(j)  (2304 + 64 * (j))
#define XB_TOP      3328
#define XB_TOPGEN   3392
#define XCD_BAR_WORDS 3456
#define XB_SPIN_CAP (1u << 18)

__device__ __forceinline__ unsigned xb_ld(unsigned* p)              { return __hip_atomic_load(p, __ATOMIC_RELAXED, __HIP_MEMORY_SCOPE_AGENT); }
__device__ __forceinline__ unsigned xb_add(unsigned* p, unsigned v) { return __hip_atomic_fetch_add(p, v, __ATOMIC_RELAXED, __HIP_MEMORY_SCOPE_AGENT); }
__device__ __forceinline__ unsigned xb_xcc_id() { return (unsigned)__builtin_amdgcn_s_getreg((3 << 11) | 20) & 0xFu; }
#define XB_SPIN(cond, bar) do { unsigned _sp = 0; while (cond) { __builtin_amdgcn_s_sleep(1); \
    if ((++_sp & 255u) == 0u) { if (xb_ld(&(bar)[XB_TMO])) break; if (_sp > XB_SPIN_CAP) { atomicAdd(&(bar)[XB_TMO], 1u); break; } } } } while (0)

struct XcdBarrier {
    unsigned* bar; unsigned x;
    volatile LAS unsigned* st;
};

__device__ __forceinline__ XcdBarrier xcd_barrier_post(unsigned* bar, volatile LAS unsigned* st) {
    XcdBarrier b; b.bar = bar; b.x = xb_xcc_id(); b.st = st;
    if (threadIdx.x == 0) (void)xb_add(&bar[XB_XCNT(b.x)], 1u);
    return b;
}
__device__ __forceinline__ void xcd_barrier_complete(unsigned* bar, unsigned x, unsigned& nloc, unsigned& nx) {
    const unsigned G = gridDim.x * gridDim.y * gridDim.z;
    unsigned sum, cnt, mine, sp = 0u;
    for (;;) {
        sum = 0u; cnt = 0u; mine = 0u;
#pragma unroll
        for (unsigned j = 0; j < 16; ++j) { const unsigned c = xb_ld(&bar[XB_XCNT(j)]); sum += c; cnt += (c > 0u) ? 1u : 0u; mine = (j == x) ? c : mine; }
        if (sum == G) break;
        __builtin_amdgcn_s_sleep(1);
        if ((++sp & 255u) == 0u) { if (xb_ld(&bar[XB_TMO])) break; if (sp > XB_SPIN_CAP) { atomicAdd(&bar[XB_TMO], 1u); break; } }
    }
    nloc = mine > 0u ? mine : 1u; nx = cnt > 0u ? cnt : 1u;
}

__device__ __forceinline__ void xcd_barrier(const XcdBarrier& b) {
    asm volatile("s_waitcnt vmcnt(0)" ::: "memory");
    __syncthreads();
    if (threadIdx.x == 0) {
        unsigned* bar = b.bar;
        __builtin_amdgcn_s_waitcnt(0);
        unsigned nloc = b.st[0], nx = b.st[1];
        if (nloc == 0u) { xcd_barrier_complete(bar, b.x, nloc, nx); b.st[0] = nloc; b.st[1] = nx; }
        const unsigned old = xb_add(&bar[XB_XSUB(b.x)], 1u);
        const unsigned gen = old / nloc;
        if (old + 1u == (gen + 1u) * nloc) {
            __builtin_amdgcn_fence(__ATOMIC_RELEASE, "agent");
            asm volatile("s_waitcnt vmcnt(0)" ::: "memory");
            const unsigned og = xb_add(&bar[XB_TOP], 1u);
            const unsigned tg = og / nx;
            if (og + 1u == (tg + 1u) * nx) xb_add(&bar[XB_TOPGEN], 1u);
            else XB_SPIN(xb_ld(&bar[XB_TOPGEN]) == tg, bar);
            __builtin_amdgcn_fence(__ATOMIC_ACQUIRE, "agent");
            xb_add(&bar[XB_XGEN(b.x)], 1u);
            asm volatile("s_waitcnt vmcnt(0)" ::: "memory");
        } else {
            XB_SPIN(xb_ld(&bar[XB_XGEN(b.x)]) == gen, bar);
            __builtin_amdgcn_fence(__ATOMIC_ACQUIRE, "agent");
            asm volatile("s_waitcnt vmcnt(0)" ::: "memory");
        }
    }
    __syncthreads();
}

struct Frame {
    LAS unsigned char* lds;
    int tid, lane, wave, G, bid;
    unsigned long long tacc, tmark;
    const float *x_p, *x_s, *st_gla, *st_ssd, *st_sconv, *st_fconv, *n_mix_pre, *n_mix_post, *n_ffn_pre, *n_ffn_post, *w_in, *w_gate2, *b_gate, *gla_norm,
                *sconv_w, *sconv_b, *dt_bias, *A_log, *ssd_D, *ssd_norm, *w_out, *ffn_w_in, *fconv_w, *fconv_b, *ffn_w_out;
    float* out;
    bf16 *W1, *WO, *WF1, *WF2, *XN, *PROJ, *MIXIN, *U, *ACT, *DS, *SC, *DH, *HC;
    float *LRDT, *MIX, *Fb, *EBL, *AL;
};
__device__ __forceinline__ const float* x_row(const Frame& F, int row) { return row < MP ? F.x_p + (size_t)row * DM : F.x_s + (size_t)(row - MP) * DM; }

__device__ __forceinline__ int w1_src_col(int n) { return n < 3072 ? n : (n < 5632 ? n + 16 : (n < 5648 ? n - 2560 : (n < 5664 ? n : -1))); }
template <bool MAP>
__device__ __forceinline__ void p0_transpose_item(const float* W, int K, int Nsrc, int Ndst, bf16* WT, LAS float* scr, int item, int lane) {
    const int nblk = Ndst / 64, kb = item / nblk, nb = item % nblk, k0 = 64 * kb, n0 = 64 * nb;
    int sc = n0 + 4 * (lane & 15); if (MAP) sc = w1_src_col(sc);
    f32x4 v[16];
#pragma unroll
    for (int i = 0; i < 16; ++i) { const int kk = 4 * i + (lane >> 4); v[i] = (sc >= 0) ? *(const f32x4*)(W + (size_t)(k0 + kk) * Nsrc + sc) : (f32x4){0.f, 0.f, 0.f, 0.f}; }
#pragma unroll
    for (int i = 0; i < 16; ++i) { const int kk = 4 * i + (lane >> 4); LAS float* d = scr + kk * 65 + 4 * (lane & 15); d[0] = v[i].x; d[1] = v[i].y; d[2] = v[i].z; d[3] = v[i].w; }
    LDS_WAIT(); asm volatile("" ::: "memory");
    const int c = lane & 7;
#pragma unroll
    for (int j = 0; j < 8; ++j) { const int n = (lane >> 3) + 8 * j; const LAS float* s = scr + (8 * c) * 65 + n;
        v4u o; o.x = pk2(s[0 * 65], s[1 * 65]); o.y = pk2(s[2 * 65], s[3 * 65]); o.z = pk2(s[4 * 65], s[5 * 65]); o.w = pk2(s[6 * 65], s[7 * 65]);
        *(v4u*)(WT + (size_t)(n0 + n) * K + k0 + 8 * c) = o; }
    LDS_WAIT(); asm volatile("" ::: "memory");
}
__device__ __forceinline__ void rms_row_to_bf16(const float* xrow, const float* w, bf16* orow, int lane) {
    const f32x4* xr = (const f32x4*)xrow + lane; const f32x4* wr = (const f32x4*)w + lane;
    f32x4 v[8]; float s = 0.f;
#pragma unroll
    for (int j = 0; j < 8; ++j) { v[j] = xr[64 * j]; s += (v[j].x * v[j].x + v[j].y * v[j].y) + (v[j].z * v[j].z + v[j].w * v[j].w); }
    const float r = rsqrtf(wave_sum(s) * (1.f / DM) + EPS);
    v2u* o8 = (v2u*)orow + lane;
#pragma unroll
    for (int j = 0; j < 8; ++j) { const f32x4 ww = wr[64 * j]; v2u o; o.x = pk2(v[j].x * r * ww.x, v[j].y * r * ww.y); o.y = pk2(v[j].z * r * ww.z, v[j].w * r * ww.w); o8[64 * j] = o; }
}
__device__ __forceinline__ void p0_prologue(Frame& F) {
    LAS float* scr = (LAS float*)(F.lds + F.wave * 16640);
    const int gw = F.bid * NWAVES + F.wave, NGW = F.G * NWAVES;
    constexpr int I_1 = (DM / 64) * (N1 / 64);
    for (int it = gw; it < I_1; it += NGW) p0_transpose_item<true>(F.w_in, DM, INC, N1, F.W1, scr, it, F.lane);
    for (int m = gw; m < M; m += NGW) rms_row_to_bf16(x_row(F, m), F.n_mix_pre, F.XN + (size_t)m * DM, F.lane);
}
__device__ __forceinline__ void p0_convert_rest(Frame& F, int vb, int nb) {
    LAS float* scr = (LAS float*)(F.lds + F.wave * 16640);
    const int gw = vb * NWAVES + F.wave, NGW = nb * NWAVES;
    constexpr int I_O = (DM / 64) * (DM / 64), I_F1 = (DM / 64) * (FF2 / 64), I_F2 = (FF / 64) * (DM / 64);
    for (int it = gw; it < I_O + I_F1 + I_F2; it += NGW) {
        int r = it;
        if (r < I_O) { p0_transpose_item<false>(F.w_out, DM, DM, DM, F.WO, scr, r, F.lane); continue; } r -= I_O;
        if (r < I_F1) { p0_transpose_item<false>(F.ffn_w_in, DM, FF2, FF2, F.WF1, scr, r, F.lane); continue; } r -= I_F1;
        p0_transpose_item<false>(F.ffn_w_out, FF, DM, DM, F.WF2, scr, r, F.lane);
    }
}

template <int grp> __device__ __forceinline__ void gla_direct_unit(Frame& F, int b, int h) {
    const int tid = F.tid, v = tid & 255, kh = tid >> 8;
    const int L = grp ? SL : PL, row0 = grp ? MP + b * SL : b * PL;
    LAS float* Es = (LAS float*)F.lds; LAS float* Ks = Es + 1024; LAS float* Qs = Ks + 1024; LAS float* Os = Qs + 1024;
    float S[64];
    if (grp) { const float* s0 = F.st_gla + ((size_t)(b * GH + h) * GK + kh * 64) * GV + v;
#pragma unroll
        for (int i = 0; i < 64; ++i) S[i] = s0[(size_t)i * GV]; }
    else {
#pragma unroll
        for (int i = 0; i < 64; ++i) S[i] = 0.f; }
    for (int t0 = 0; t0 < L; t0 += 8) {
        for (int it = tid; it < 1024; it += NTHR) { const int t = it >> 7, k = it & 127, row = row0 + t0 + t, hk = h * GK + k;
            float x = F.b_gate[hk]; const float* lr = F.LRDT + (size_t)row * 32;
#pragma unroll
            for (int j = 0; j < LOWR; ++j) x += lr[j] * F.w_gate2[j * GKD + hk];
            const float lg = logsigmoid_f(x) * (1.f / 16.f);
            Es[it] = __expf(lg); Ks[it] = bf2f(F.PROJ[(size_t)row * NP + CK + hk]); Qs[it] = bf2f(F.PROJ[(size_t)row * NP + CQ + hk]) * 0.08838834764831845f; }
        __syncthreads();
#pragma unroll 1
        for (int t = 0; t < 8; ++t) { const float vv = bf2f(F.PROJ[(size_t)(row0 + t0 + t) * NP + CV + h * GV + v]); float acc = 0.f;
            const LAS float* e = Es + t * 128 + kh * 64; const LAS float* kk = Ks + t * 128 + kh * 64; const LAS float* qq = Qs + t * 128 + kh * 64;
#pragma unroll
            for (int i = 0; i < 64; ++i) { S[i] = e[i] * S[i] + kk[i] * vv; acc += qq[i] * S[i]; }
            Os[(kh * 8 + t) * 256 + v] = acc; }
        __syncthreads();
        { const int t = F.wave, v4 = F.lane * 4, row = row0 + t0 + t;
            const f32x4 a = *(const LAS f32x4*)(Os + t * 256 + v4), c = *(const LAS f32x4*)(Os + (8 + t) * 256 + v4); const f32x4 o = a + c;
            const float ss = wave_sum((o.x * o.x + o.y * o.y) + (o.z * o.z + o.w * o.w)); const float r = rsqrtf(ss * (1.f / GV) + EPS);
            const v2u gw = *(const v2u*)(F.PROJ + (size_t)row * NP + CG + h * GV + v4); const f32x4 nw = *(const f32x4*)(F.gla_norm + v4);
            v2u w; w.x = pk2(o.x * r * nw.x * silu_f(bflo(gw.x)), o.y * r * nw.y * silu_f(bfhi(gw.x))); w.y = pk2(o.z * r * nw.z * silu_f(bflo(gw.y)), o.w * r * nw.w * silu_f(bfhi(gw.y)));
            *(v2u*)(F.MIXIN + (size_t)row * DM + h * GV + v4) = w; }
        __syncthreads();
    }
    float* so = F.out + (grp ? O_GLA_S : O_GLA_P) + ((size_t)(b * GH + h) * GK + kh * 64) * GV + v;
#pragma unroll
    for (int i = 0; i < 64; ++i) so[(size_t)i * GV] = S[i];
}
__device__ __forceinline__ float xbc_raw(const Frame& F, int grp, int b, int row0, int tt, int c) {
    if (tt >= 0) return bf2f(F.PROJ[(size_t)(row0 + tt) * NP + CX + c]);
    return grp ? F.st_sconv[((size_t)b * 3 + (tt + 3)) * SCH + c] : 0.f;
}
template <int grp> __device__ __forceinline__ void ssd_direct_unit(Frame& F, int b, int g) {
    const int tid = F.tid, hd = g * 8 + (tid >> 6), p = tid & 63, ch = g * 512 + tid;
    const int L = grp ? SL : PL, row0 = grp ? MP + b * SL : b * PL;
    LAS float* Bs = (LAS float*)F.lds; LAS float* Cs = Bs + 1024; LAS float* red = Cs + 1024; LAS float* Ys = red + 64;
    float h[128];
    if (grp) { const f32x4* h0 = (const f32x4*)(F.st_ssd + ((size_t)(b * SH + hd) * SP + p) * SN);
#pragma unroll
        for (int i = 0; i < 32; ++i) { const f32x4 q = h0[i]; h[4 * i] = q.x; h[4 * i + 1] = q.y; h[4 * i + 2] = q.z; h[4 * i + 3] = q.w; } }
    else {
#pragma unroll
        for (int i = 0; i < 128; ++i) h[i] = 0.f; }
    const float A = -__expf(F.A_log[hd]), dtb = F.dt_bias[hd], Dh = F.ssd_D[hd], nw = F.ssd_norm[ch];
    const float cb = F.sconv_b[ch], cw0 = F.sconv_w[ch], cw1 = F.sconv_w[SCH + ch], cw2 = F.sconv_w[2 * SCH + ch], cw3 = F.sconv_w[3 * SCH + ch];
    const int c2 = 1024 + (tid < 128 ? g * 128 + tid : 256 + g * 128 + ((tid - 128) & 127));
    float xr0 = xbc_raw(F, grp, b, row0, -3, ch), xr1 = xbc_raw(F, grp, b, row0, -2, ch), xr2 = xbc_raw(F, grp, b, row0, -1, ch);
    for (int t0 = 0; t0 < L; t0 += 8) {
        if (tid < 256) {
            float xr[11]; const float cb2 = F.sconv_b[c2], d0 = F.sconv_w[c2], d1 = F.sconv_w[SCH + c2], d2 = F.sconv_w[2 * SCH + c2], d3 = F.sconv_w[3 * SCH + c2];
#pragma unroll
            for (int i = 0; i < 11; ++i) xr[i] = xbc_raw(F, grp, b, row0, t0 - 3 + i, c2);
#pragma unroll
            for (int t = 0; t < 8; ++t) Bs[(tid >> 7) * 1024 + t * 128 + (tid & 127)] = silu_f(cb2 + d0 * xr[t] + d1 * xr[t + 1] + d2 * xr[t + 2] + d3 * xr[t + 3]);
        }
        __syncthreads();
#pragma unroll 1
        for (int t = 0; t < 8; ++t) { const int row = row0 + t0 + t;
            const float xn = bf2f(F.PROJ[(size_t)row * NP + CX + ch]);
            const float x = silu_f(cb + cw0 * xr0 + cw1 * xr1 + cw2 * xr2 + cw3 * xn); xr0 = xr1; xr1 = xr2; xr2 = xn;
            const float dt = softplus_f(F.LRDT[(size_t)row * 32 + 16 + hd] + dtb), a = __expf(dt * A), dtx = dt * x;
            float acc = 0.f; const LAS float* bb = Bs + t * 128; const LAS float* cc = Cs + t * 128;
#pragma unroll
            for (int nb = 0; nb < 128; nb += 16) {
#pragma unroll
                for (int n = nb; n < nb + 16; ++n) { h[n] = a * h[n] + dtx * bb[n]; acc += h[n] * cc[n]; }
                asm volatile("" ::: "memory"); }
            const float z = bf2f(F.PROJ[(size_t)row * NP + CZ + ch]);
            const float y = (acc + Dh * x) * silu_f(z);
            Ys[t * 512 + tid] = y;
            const float ss = wave_sum(y * y); if (F.lane == 0) red[t * 8 + F.wave] = ss; }
        __syncthreads();
#pragma unroll
        for (int t = 0; t < 8; ++t) { float tot = 0.f;
#pragma unroll
            for (int w = 0; w < 8; ++w) tot += red[t * 8 + w];
            const float r = rsqrtf(tot * (1.f / 512.f) + EPS);
            F.MIXIN[(size_t)(row0 + t0 + t) * DM + 1024 + ch] = (bf16)f2bf(Ys[t * 512 + tid] * r * nw); }
        __syncthreads();
    }
    f32x4* ho = (f32x4*)(F.out + (grp ? O_SSD_S : O_SSD_P) + ((size_t)(b * SH + hd) * SP + p) * SN);
#pragma unroll
    for (int i = 0; i < 32; ++i) ho[i] = (f32x4){h[4 * i], h[4 * i + 1], h[4 * i + 2], h[4 * i + 3]};
}
typedef short bf16x8v __attribute__((ext_vector_type(8)));
typedef short s16x4v __attribute__((ext_vector_type(4)));
constexpr int CH = 64, NCH = PL / CH;
constexpr int QE_ST = 272, KDT_ST = 144, V_ST = 544, ATT_ST = 144, X_ST = 1056, BC_ST = 288;
#define MFMA16(a, b, c) __builtin_amdgcn_mfma_f32_16x16x32_bf16((a), (b), (c), 0, 0, 0)
__device__ __forceinline__ bf16x8v frag_k(const LAS unsigned char* T, int stride, int idx0, int kk0, int r, int q) { return *(const LAS bf16x8v*)(T + (idx0 + r) * stride + (kk0 + 8 * q) * 2); }
__device__ __forceinline__ bf16x8v frag_t(const LAS unsigned char* T, int stride, int kk0, int idx0, int r, int q) {
    const LAS unsigned char* p = T + (kk0 + 8 * q + (r >> 2)) * stride + (idx0 + 4 * (r & 3)) * 2;
    const s16x4v lo = __builtin_amdgcn_ds_read_tr16_b64_v4i16((LAS s16x4v*)p), hi = __builtin_amdgcn_ds_read_tr16_b64_v4i16((LAS s16x4v*)(p + 4 * stride));
    return (bf16x8v){lo[0], lo[1], lo[2], lo[3], hi[0], hi[1], hi[2], hi[3]};
}
__device__ __forceinline__ v2u pk4(const f32x4 v) { v2u o; o.x = pk2(v.x, v.y); o.y = pk2(v.z, v.w); return o; }

struct GlaStage { v4u v[4], qk[4], lr; };
template <int PASS>
__device__ __forceinline__ void gla_stage_load(const Frame& F, int h, int row0, GlaStage& g) {
    const int tid = F.tid;
#pragma unroll
    for (int i = 0; i < 4; ++i) { const int piece = tid + NTHR * i, row = piece >> 5, c16 = piece & 31; g.v[i] = *(const v4u*)(F.PROJ + (size_t)(row0 + row) * NP + CV + h * GV + c16 * 8); }
#pragma unroll
    for (int i = 0; i < 2; ++i) { const int piece = tid + NTHR * i, row = piece >> 4, c16 = piece & 15;
        g.qk[i] = *(const v4u*)(F.PROJ + (size_t)(row0 + row) * NP + CK + h * GK + c16 * 8);
        if (PASS == 1) g.qk[2 + i] = *(const v4u*)(F.PROJ + (size_t)(row0 + row) * NP + CQ + h * GK + c16 * 8); }
    if (tid < 256) g.lr = *(const v4u*)(F.LRDT + (size_t)(row0 + (tid >> 2)) * 32 + (tid & 3) * 4);
}
template <int PASS>
__device__ __forceinline__ void gla_stage_store(const Frame& F, const GlaStage& g, LAS unsigned char* V, LAS unsigned char* Kt, LAS unsigned char* Qt, LAS float* LR) {
    const int tid = F.tid;
#pragma unroll
    for (int i = 0; i < 4; ++i) { const int piece = tid + NTHR * i, row = piece >> 5, c16 = piece & 31; *(LAS v4u*)(V + row * V_ST + c16 * 16) = g.v[i]; }
#pragma unroll
    for (int i = 0; i < 2; ++i) { const int piece = tid + NTHR * i, row = piece >> 4, c16 = piece & 15;
        *(LAS v4u*)(Kt + row * QE_ST + c16 * 16) = g.qk[i]; if (PASS == 1) *(LAS v4u*)(Qt + row * QE_ST + c16 * 16) = g.qk[2 + i]; }
    if (tid < 256) *(LAS v4u*)(LR + (tid >> 2) * 16 + (tid & 3) * 4) = g.lr;
}
template <int PASS>
__device__ __forceinline__ void gla_chunk_elem(Frame& F, int h, LAS unsigned char* Kt, LAS unsigned char* Qt, LAS unsigned char* KDT, const LAS float* LR, LAS float* tot, float* ebl_out) {
    const int tid = F.tid, k = tid & 127, tq = tid >> 7, hk = h * GK + k;
    float w2[16];
#pragma unroll
    for (int j = 0; j < 16; ++j) w2[j] = F.w_gate2[j * GKD + hk];
    const float bg = F.b_gate[hk];
    float lg[16]; float run = 0.f;
#pragma unroll
    for (int i = 0; i < 16; ++i) { const LAS f32x4* lr = (const LAS f32x4*)(LR + (16 * tq + i) * 16); const f32x4 a = lr[0], b = lr[1], c = lr[2], d = lr[3];
        float x = bg + a.x * w2[0] + a.y * w2[1] + a.z * w2[2] + a.w * w2[3] + b.x * w2[4] + b.y * w2[5] + b.z * w2[6] + b.w * w2[7]
                     + c.x * w2[8] + c.y * w2[9] + c.z * w2[10] + c.w * w2[11] + d.x * w2[12] + d.y * w2[13] + d.z * w2[14] + d.w * w2[15];
        run += logsigmoid_f(x) * (1.f / 16.f); lg[i] = run; }
    tot[tq * 128 + k] = run;
    __syncthreads();
    float off = 0.f, all = 0.f;
#pragma unroll
    for (int qq = 0; qq < 4; ++qq) { const float v = tot[qq * 128 + k]; all += v; off += (qq < tq) ? v : 0.f; }
    if (PASS == 0) {
        unsigned pk[8];
#pragma unroll
        for (int i = 0; i < 8; ++i) { const int t = 16 * tq + 2 * i;
            const float k0 = bf2f(*(const LAS bf16*)(Kt + t * QE_ST + k * 2)) * __expf(all - (off + lg[2 * i])), k1 = bf2f(*(const LAS bf16*)(Kt + (t + 1) * QE_ST + k * 2)) * __expf(all - (off + lg[2 * i + 1])); pk[i] = pk2(k0, k1); }
        LAS v4u* d = (LAS v4u*)(KDT + k * KDT_ST + 32 * tq);
        d[0] = (v4u){pk[0], pk[1], pk[2], pk[3]}; d[1] = (v4u){pk[4], pk[5], pk[6], pk[7]};
        if (tq == 0) ebl_out[k] = __expf(all);
    } else {
#pragma unroll
        for (int i = 0; i < 16; ++i) { const int t = 16 * tq + i; const float bb = off + lg[i];
            LAS bf16* qp = (LAS bf16*)(Qt + t * QE_ST + k * 2); LAS bf16* kp = (LAS bf16*)(Kt + t * QE_ST + k * 2);
            *qp = (bf16)f2bf(bf2f(*qp) * 0.08838834764831845f * __expf(bb)); *kp = (bf16)f2bf(bf2f(*kp) * __expf(-bb)); }
    }
}
__device__ __forceinline__ void gla_passA_unit(Frame& F, int u) {
    const int c = u & 31, bh = u >> 5, b = bh >> 2, h = bh & 3, row0 = b * PL + c * CH;
    LAS unsigned char* KDT = F.lds; LAS unsigned char* V = KDT + 128 * KDT_ST; LAS unsigned char* Kt = V + 64 * V_ST; LAS float* LR = (LAS float*)(Kt + 64 * QE_ST); LAS float* tot = LR + 1024;
    { GlaStage g; gla_stage_load<0>(F, h, row0, g); gla_stage_store<0>(F, g, V, Kt, nullptr, LR); }
    __syncthreads();
    gla_chunk_elem<0>(F, h, Kt, nullptr, KDT, LR, tot, F.EBL + (size_t)u * 128);
    __syncthreads();
    const int w = F.wave, r = F.lane & 15, q = F.lane >> 4;
    f32x4 acc[8][2];
#pragma unroll
    for (int kf = 0; kf < 8; ++kf) { acc[kf][0] = (f32x4){0.f, 0.f, 0.f, 0.f}; acc[kf][1] = (f32x4){0.f, 0.f, 0.f, 0.f}; }
#pragma unroll
    for (int ks = 0; ks < 2; ++ks) { const bf16x8v b0 = frag_t(V, V_ST, 32 * ks, 32 * w, r, q), b1 = frag_t(V, V_ST, 32 * ks, 32 * w + 16, r, q);
#pragma unroll
        for (int kf = 0; kf < 8; ++kf) { const bf16x8v a = frag_k(KDT, KDT_ST, 16 * kf, 32 * ks, r, q); acc[kf][0] = MFMA16(a, b0, acc[kf][0]); acc[kf][1] = MFMA16(a, b1, acc[kf][1]); } }
#pragma unroll
    for (int kf = 0; kf < 8; ++kf)
#pragma unroll
        for (int vf = 0; vf < 2; ++vf) *(v2u*)(F.DS + ((size_t)u * GV + 32 * w + 16 * vf + r) * GK + 16 * kf + 4 * q) = pk4(acc[kf][vf]);
    __syncthreads();
}
__device__ __forceinline__ void gla_scan(Frame& F) {
    for (int it = F.bid * NTHR + F.tid; it < PB * GH * GV * 32; it += F.G * NTHR) { const int k4 = it & 31, v = (it >> 5) & 255, bh = it >> 13;
        f32x4 S = (f32x4){0.f, 0.f, 0.f, 0.f};
#pragma unroll 8
        for (int c = 0; c < NCH; ++c) { const int u = bh * NCH + c; const size_t off = ((size_t)u * GV + v) * GK + 4 * k4;
            const v2u d = *(const v2u*)(F.DS + off); const f32x4 e = *(const f32x4*)(F.EBL + (size_t)u * 128 + 4 * k4);
            *(v2u*)(F.SC + off) = pk4(S);
            S.x = e.x * S.x + bflo(d.x); S.y = e.y * S.y + bfhi(d.x); S.z = e.z * S.z + bflo(d.y); S.w = e.w * S.w + bfhi(d.y); }
        float* o = F.out + O_GLA_P + ((size_t)bh * GK + 4 * k4) * GV + v; o[0] = S.x; o[GV] = S.y; o[2 * GV] = S.z; o[3 * GV] = S.w; }
}
__device__ __forceinline__ void gla_passC_unit(Frame& F, int u) {
    const int c = u & 31, bh = u >> 5, b = bh >> 2, h = bh & 3, row0 = b * PL + c * CH;
    LAS unsigned char* QE = F.lds; LAS unsigned char* KE = QE + 64 * QE_ST; LAS unsigned char* V = KE + 64 * QE_ST; LAS unsigned char* ATT = V + 64 * V_ST;
    LAS float* tot = (LAS float*)(ATT + 64 * ATT_ST); LAS float* red = tot + 512; LAS float* LR = red + 128;
    { GlaStage g; gla_stage_load<1>(F, h, row0, g); gla_stage_store<1>(F, g, V, KE, QE, LR); }
    __syncthreads();
    gla_chunk_elem<1>(F, h, KE, QE, nullptr, LR, tot, nullptr);
    __syncthreads();
    const int w = F.wave, r = F.lane & 15, q = F.lane >> 4;
#pragma unroll
    for (int ff = 0; ff < 2; ++ff) { const int f = 2 * w + ff, sf = f >> 2, tf = f & 3; f32x4 a4 = (f32x4){0.f, 0.f, 0.f, 0.f};
        if (sf <= tf) {
#pragma unroll
            for (int ks = 0; ks < 4; ++ks) a4 = MFMA16(frag_k(KE, QE_ST, 16 * sf, 32 * ks, r, q), frag_k(QE, QE_ST, 16 * tf, 32 * ks, r, q), a4); }
        const int s0 = 16 * sf + 4 * q, t = 16 * tf + r;
        f32x4 m; m.x = (s0 <= t) ? a4.x : 0.f; m.y = (s0 + 1 <= t) ? a4.y : 0.f; m.z = (s0 + 2 <= t) ? a4.z : 0.f; m.w = (s0 + 3 <= t) ? a4.w : 0.f;
        *(LAS v2u*)(ATT + t * ATT_ST + s0 * 2) = pk4(m); }
    __syncthreads();
    const int tf = w & 3, vh = w >> 2;
    f32x4 acc[8];
#pragma unroll
    for (int i = 0; i < 8; ++i) acc[i] = (f32x4){0.f, 0.f, 0.f, 0.f};
    const bf16* Sc = F.SC + ((size_t)u * GV + 128 * vh) * GK;
#pragma unroll
    for (int ks = 0; ks < 4; ++ks) { const bf16x8v bq = frag_k(QE, QE_ST, 16 * tf, 32 * ks, r, q);
#pragma unroll
        for (int i = 0; i < 8; ++i) { const bf16x8v a = *(const bf16x8v*)(Sc + (size_t)(16 * i + r) * GK + 32 * ks + 8 * q); acc[i] = MFMA16(a, bq, acc[i]); } }
#pragma unroll
    for (int ks = 0; ks < 2; ++ks) { const bf16x8v ba = frag_k(ATT, ATT_ST, 16 * tf, 32 * ks, r, q);
#pragma unroll
        for (int i = 0; i < 8; ++i) { const bf16x8v a = frag_t(V, V_ST, 32 * ks, 128 * vh + 16 * i, r, q); acc[i] = MFMA16(a, ba, acc[i]); } }
    float ss = 0.f;
#pragma unroll
    for (int i = 0; i < 8; ++i) ss += (acc[i].x * acc[i].x + acc[i].y * acc[i].y) + (acc[i].z * acc[i].z + acc[i].w * acc[i].w);
    ss += __shfl_xor(ss, 16); ss += __shfl_xor(ss, 32);
    const int t = 16 * tf + r;
    if (q == 0) red[vh * 64 + t] = ss;
    __syncthreads();
    const float rr = rsqrtf((red[t] + red[64 + t]) * (1.f / GV) + EPS); const size_t row = (size_t)(row0 + t);
#pragma unroll
    for (int i = 0; i < 8; ++i) { const int v = 128 * vh + 16 * i + 4 * q;
        const v2u gw = *(const v2u*)(F.PROJ + row * NP + CG + h * GV + v); const f32x4 nw = *(const f32x4*)(F.gla_norm + v);
        f32x4 o; o.x = acc[i].x * rr * nw.x * silu_f(bflo(gw.x)); o.y = acc[i].y * rr * nw.y * silu_f(bfhi(gw.x)); o.z = acc[i].z * rr * nw.z * silu_f(bflo(gw.y)); o.w = acc[i].w * rr * nw.w * silu_f(bfhi(gw.y));
        *(v2u*)(F.MIXIN + row * DM + h * GV + v) = pk4(o); }
    __syncthreads();
}

template <bool SCALE>
__device__ __forceinline__ void ssd_conv_item(Frame& F, int b, int g, int c, int cg, int tb, LAS unsigned char* X, LAS unsigned char* BT, LAS unsigned char* CT, const LAS float* WDEC) {
    const int xc = cg < 64 ? g * 512 + 8 * cg : (cg < 80 ? 1024 + g * 128 + 8 * (cg - 64) : 1280 + g * 128 + 8 * (cg - 80));
    float w[4][8], bias[8];
#pragma unroll
    for (int j = 0; j < 4; ++j) { const f32x4 a = *(const f32x4*)(F.sconv_w + j * SCH + xc), bq = *(const f32x4*)(F.sconv_w + j * SCH + xc + 4);
        w[j][0] = a.x; w[j][1] = a.y; w[j][2] = a.z; w[j][3] = a.w; w[j][4] = bq.x; w[j][5] = bq.y; w[j][6] = bq.z; w[j][7] = bq.w; }
    { const f32x4 a = *(const f32x4*)(F.sconv_b + xc), bq = *(const f32x4*)(F.sconv_b + xc + 4); bias[0] = a.x; bias[1] = a.y; bias[2] = a.z; bias[3] = a.w; bias[4] = bq.x; bias[5] = bq.y; bias[6] = bq.z; bias[7] = bq.w; }
    v4u raw[11];
#pragma unroll
    for (int i = 0; i < 11; ++i) { const int tt = c * CH + tb * 8 - 3 + i;
        raw[i] = (tt >= 0) ? *(const v4u*)(F.PROJ + (size_t)(b * PL + tt) * NP + CX + xc) : (v4u){0u, 0u, 0u, 0u}; }
#pragma unroll
    for (int t = 0; t < 8; ++t) { float o[8];
#pragma unroll
        for (int e = 0; e < 8; ++e) { float a = bias[e];
#pragma unroll
            for (int j = 0; j < 4; ++j) { const unsigned wd = raw[t + j][e >> 1]; a += w[j][e] * ((e & 1) ? bfhi(wd) : bflo(wd)); }
            o[e] = silu_f(a); }
        const int tl = tb * 8 + t;
        if (SCALE && cg < 64) { const float sc = WDEC[(cg >> 3) * 64 + tl];
#pragma unroll
            for (int e = 0; e < 8; ++e) o[e] *= sc; }
        const v4u pkd = (v4u){pk2(o[0], o[1]), pk2(o[2], o[3]), pk2(o[4], o[5]), pk2(o[6], o[7])};
        LAS unsigned char* dst = cg < 64 ? X + tl * X_ST + cg * 16 : (cg < 80 ? BT + tl * BC_ST + (cg - 64) * 16 : CT + tl * BC_ST + (cg - 80) * 16);
        *(LAS v4u*)dst = pkd; }
}
__device__ __forceinline__ float ssd_head_scan(Frame& F, int hd, int row0, float& dt_out, float& last) {
    const float dt = softplus_f(F.LRDT[(size_t)(row0 + F.lane) * 32 + 16 + hd] + F.dt_bias[hd]);
    float cum = dt * (-__expf(F.A_log[hd]));
#pragma unroll
    for (int o = 1; o < 64; o <<= 1) { const float v = __shfl_up(cum, o); cum += (F.lane >= o) ? v : 0.f; }
    dt_out = dt; last = __shfl(cum, 63); return cum;
}
__device__ __forceinline__ void ssd_passA_unit(Frame& F, int u) {
    const int c = u & 31, bg = u >> 5, b = bg >> 1, g = bg & 1, row0 = b * PL + c * CH;
    LAS unsigned char* X = F.lds; LAS unsigned char* BT = X + 64 * X_ST; LAS float* WDEC = (LAS float*)(BT + 64 * BC_ST);
    const int w = F.wave, r = F.lane & 15, q = F.lane >> 4;
    { float dt, last; const float cum = ssd_head_scan(F, g * 8 + w, row0, dt, last);
        WDEC[w * 64 + F.lane] = __expf(last - cum) * dt; if (F.lane == 63) F.AL[(size_t)u * 8 + w] = __expf(last); }
    __syncthreads();
    for (int it = F.tid; it < 80 * 8; it += NTHR) ssd_conv_item<true>(F, b, g, c, it % 80, it / 80, X, BT, nullptr, WDEC);
    __syncthreads();
#pragma unroll 1
    for (int nh = 0; nh < 2; ++nh) {
        f32x4 acc[4][4];
#pragma unroll
        for (int i = 0; i < 4; ++i)
#pragma unroll
            for (int j = 0; j < 4; ++j) acc[i][j] = (f32x4){0.f, 0.f, 0.f, 0.f};
#pragma unroll
        for (int ks = 0; ks < 2; ++ks) { bf16x8v bp[4];
#pragma unroll
            for (int pf = 0; pf < 4; ++pf) bp[pf] = frag_t(X, X_ST, 32 * ks, 64 * w + 16 * pf, r, q);
#pragma unroll
            for (int nf = 0; nf < 4; ++nf) { const bf16x8v a = frag_t(BT, BC_ST, 32 * ks, 64 * nh + 16 * nf, r, q);
#pragma unroll
                for (int pf = 0; pf < 4; ++pf) acc[nf][pf] = MFMA16(a, bp[pf], acc[nf][pf]); } }
#pragma unroll
        for (int nf = 0; nf < 4; ++nf)
#pragma unroll
            for (int pf = 0; pf < 4; ++pf) *(v2u*)(F.DH + (((size_t)u * 8 + w) * SP + 16 * pf + r) * SN + 64 * nh + 16 * nf + 4 * q) = pk4(acc[nf][pf]);
    }
    __syncthreads();
}
__device__ __forceinline__ void ssd_scan(Frame& F) {
    for (int it = F.bid * NTHR + F.tid; it < PB * SH * SP * 32; it += F.G * NTHR) { const int n4 = it & 31, p = (it >> 5) & 63, bhd = it >> 11, b = bhd >> 4, hd = bhd & 15, g = hd >> 3, hl = hd & 7;
        f32x4 H = (f32x4){0.f, 0.f, 0.f, 0.f};
#pragma unroll 8
        for (int c = 0; c < NCH; ++c) { const int u = (b * 2 + g) * NCH + c; const size_t off = (((size_t)u * 8 + hl) * SP + p) * SN + 4 * n4;
            const v2u d = *(const v2u*)(F.DH + off); const float a = F.AL[(size_t)u * 8 + hl];
            *(v2u*)(F.HC + off) = pk4(H);
            H.x = a * H.x + bflo(d.x); H.y = a * H.y + bfhi(d.x); H.z = a * H.z + bflo(d.y); H.w = a * H.w + bfhi(d.y); }
        *(f32x4*)(F.out + O_SSD_P + ((size_t)bhd * SP + p) * SN + 4 * n4) = H; }
}
__device__ __forceinline__ void ssd_passC_unit(Frame& F, int u) {
    const int c = u & 31, bg = u >> 5, b = bg >> 1, g = bg & 1, row0 = b * PL + c * CH;
    LAS unsigned char* X = F.lds; LAS unsigned char* BT = X + 64 * X_ST; LAS unsigned char* CT = BT + 64 * BC_ST; LAS unsigned char* CB = CT + 64 * BC_ST;
    LAS float* DT = (LAS float*)(CB + 64 * ATT_ST); LAS float* CUM = DT + 512; LAS float* red = CUM + 512;
    const int w = F.wave, r = F.lane & 15, q = F.lane >> 4, hd = g * 8 + w;
    { float dt, last; const float cum = ssd_head_scan(F, hd, row0, dt, last); DT[w * 64 + F.lane] = dt; CUM[w * 64 + F.lane] = cum; }
    for (int it = F.tid; it < 96 * 8; it += NTHR) ssd_conv_item<false>(F, b, g, c, it % 96, it / 96, X, BT, CT, nullptr);
    __syncthreads();
#pragma unroll
    for (int ff = 0; ff < 2; ++ff) { const int f = 2 * w + ff, sf = f >> 2, tf = f & 3; f32x4 a4 = (f32x4){0.f, 0.f, 0.f, 0.f};
        if (sf <= tf) {
#pragma unroll
            for (int ks = 0; ks < 4; ++ks) a4 = MFMA16(frag_k(BT, BC_ST, 16 * sf, 32 * ks, r, q), frag_k(CT, BC_ST, 16 * tf, 32 * ks, r, q), a4); }
        *(LAS v2u*)(CB + (16 * tf + r) * ATT_ST + (16 * sf + 4 * q) * 2) = pk4(a4); }
    __syncthreads();
    f32x4 acc[4][4];
#pragma unroll
    for (int i = 0; i < 4; ++i)
#pragma unroll
        for (int j = 0; j < 4; ++j) acc[i][j] = (f32x4){0.f, 0.f, 0.f, 0.f};
    const bf16* Hc = F.HC + ((size_t)u * 8 + w) * SP * SN;
#pragma unroll
    for (int ks = 0; ks < 4; ++ks) { bf16x8v bc[4];
#pragma unroll
        for (int tf = 0; tf < 4; ++tf) bc[tf] = frag_k(CT, BC_ST, 16 * tf, 32 * ks, r, q);
#pragma unroll
        for (int pf = 0; pf < 4; ++pf) { const bf16x8v a = *(const bf16x8v*)(Hc + (size_t)(16 * pf + r) * SN + 32 * ks + 8 * q);
#pragma unroll
            for (int tf = 0; tf < 4; ++tf) acc[pf][tf] = MFMA16(a, bc[tf], acc[pf][tf]); } }
    float ct[4];
#pragma unroll
    for (int tf = 0; tf < 4; ++tf) { ct[tf] = CUM[w * 64 + 16 * tf + r]; const float e = __expf(ct[tf]);
#pragma unroll
        for (int pf = 0; pf < 4; ++pf) acc[pf][tf] = acc[pf][tf] * e; }
#pragma unroll
    for (int ks = 0; ks < 2; ++ks) { bf16x8v ax[4];
#pragma unroll
        for (int pf = 0; pf < 4; ++pf) ax[pf] = frag_t(X, X_ST, 32 * ks, 64 * w + 16 * pf, r, q);
        const int s0 = 32 * ks + 8 * q;
        const f32x4 cs0 = *(const LAS f32x4*)(CUM + w * 64 + s0), cs1 = *(const LAS f32x4*)(CUM + w * 64 + s0 + 4), ds0 = *(const LAS f32x4*)(DT + w * 64 + s0), ds1 = *(const LAS f32x4*)(DT + w * 64 + s0 + 4);
        const float cs[8] = {cs0.x, cs0.y, cs0.z, cs0.w, cs1.x, cs1.y, cs1.z, cs1.w}, ds[8] = {ds0.x, ds0.y, ds0.z, ds0.w, ds1.x, ds1.y, ds1.z, ds1.w};
#pragma unroll
        for (int tf = 0; tf < 4; ++tf) { if (32 * ks > 16 * tf + 15) continue;
            const int t = 16 * tf + r; const v4u cb8 = *(const LAS v4u*)(CB + t * ATT_ST + s0 * 2); float l[8];
#pragma unroll
            for (int e = 0; e < 8; ++e) { const unsigned wd = cb8[e >> 1]; const float cbv = (e & 1) ? bfhi(wd) : bflo(wd); l[e] = (s0 + e <= t) ? cbv * __expf(ct[tf] - cs[e]) * ds[e] : 0.f; }
            const v4u lp = (v4u){pk2(l[0], l[1]), pk2(l[2], l[3]), pk2(l[4], l[5]), pk2(l[6], l[7])}; const bf16x8v bl = __builtin_bit_cast(bf16x8v, lp);
#pragma unroll
            for (int pf = 0; pf < 4; ++pf) acc[pf][tf] = MFMA16(ax[pf], bl, acc[pf][tf]); } }
    const float Dh = F.ssd_D[hd];
#pragma unroll
    for (int tf = 0; tf < 4; ++tf) { const int t = 16 * tf + r; const size_t row = (size_t)(row0 + t); float ss = 0.f;
#pragma unroll
        for (int pf = 0; pf < 4; ++pf) { const int p4 = 64 * w + 16 * pf + 4 * q;
            const v2u xv = *(const LAS v2u*)(X + t * X_ST + p4 * 2); const v2u zv = *(const v2u*)(F.PROJ + row * NP + CZ + g * 512 + p4);
            f32x4 y = acc[pf][tf];
            y.x = (y.x + Dh * bflo(xv.x)) * silu_f(bflo(zv.x)); y.y = (y.y + Dh * bfhi(xv.x)) * silu_f(bfhi(zv.x)); y.z = (y.z + Dh * bflo(xv.y)) * silu_f(bflo(zv.y)); y.w = (y.w + Dh * bfhi(xv.y)) * silu_f(bfhi(zv.y));
            acc[pf][tf] = y; ss += (y.x * y.x + y.y * y.y) + (y.z * y.z + y.w * y.w); }
        ss += __shfl_xor(ss, 16); ss += __shfl_xor(ss, 32);
        if (q == 0) red[w * 64 + t] = ss; }
    __syncthreads();
#pragma unroll
    for (int tf = 0; tf < 4; ++tf) { const int t = 16 * tf + r; const size_t row = (size_t)(row0 + t); float tot = 0.f;
#pragma unroll
        for (int ww = 0; ww < 8; ++ww) tot += red[ww * 64 + t];
        const float rr = rsqrtf(tot * (1.f / 512.f) + EPS);
#pragma unroll
        for (int pf = 0; pf < 4; ++pf) { const int p4 = g * 512 + 64 * w + 16 * pf + 4 * q; const f32x4 nw = *(const f32x4*)(F.ssd_norm + p4);
            f32x4 o = acc[pf][tf]; o.x *= rr * nw.x; o.y *= rr * nw.y; o.z *= rr * nw.z; o.w *= rr * nw.w;
            *(v2u*)(F.MIXIN + row * DM + 1024 + p4) = pk4(o); } }
    __syncthreads();
}

constexpr int ATT8_ST = 80;
__device__ __forceinline__ void gla_sample_unit(Frame& F, int b, int h, f32x4 (&S)[16], int nb, int nh, bool has_next) {
    const int tid = F.tid, w = F.wave, lane = F.lane, r = lane & 15, q = lane >> 4, row0 = MP + b * SL;
    LAS unsigned char* S0b = F.lds;
    LAS unsigned char* Vt = S0b + 128 * V_ST;
    LAS unsigned char* QE = Vt + 32 * V_ST;
    LAS unsigned char* KE = QE + 16 * QE_ST;
    LAS unsigned char* ATT = KE + 16 * QE_ST;
    LAS float* KD = (LAS float*)(ATT + 16 * ATT8_ST);
    LAS float* EL = KD + 1024;
    LAS float* red = EL + 128;
    f32x4 Vf[8];
#pragma unroll
    for (int s = 0; s < 8; ++s) { const v2u vv = *(const v2u*)(F.PROJ + (size_t)(row0 + s) * NP + CV + h * GV + 4 * lane); Vf[s] = (f32x4){bflo(vv.x), bfhi(vv.x), bflo(vv.y), bfhi(vv.y)}; }
    if (tid < 256) { const int t = tid >> 5, c16 = tid & 31; *(LAS v4u*)(Vt + t * V_ST + c16 * 16) = *(const v4u*)(F.PROJ + (size_t)(row0 + t) * NP + CV + h * GV + c16 * 8); }
    for (int i = tid; i < 24 * 32; i += NTHR) *(LAS v4u*)(Vt + (8 + (i >> 5)) * V_ST + (i & 31) * 16) = (v4u){0u, 0u, 0u, 0u};
    { LAS unsigned char* KR = (LAS unsigned char*)(red + 128); LAS unsigned char* QR = KR + 8 * 256; LAS float* LR = (LAS float*)(QR + 8 * 256); LAS float* LG = LR + 128;
        if (tid < 256) { const int which = tid >> 7, j = tid & 127, t = j >> 4, c16 = j & 15;
            *(LAS v4u*)((which ? QR : KR) + t * 256 + c16 * 16) = *(const v4u*)(F.PROJ + (size_t)(row0 + t) * NP + (which ? CQ : CK) + h * GK + c16 * 8); }
        else if (tid < 288) { const int j = tid - 256; *(LAS v4u*)(LR + (j >> 2) * 16 + (j & 3) * 4) = *(const v4u*)(F.LRDT + (size_t)(row0 + (j >> 2)) * 32 + (j & 3) * 4); }
        __syncthreads();
        { const int k = tid & 127, tp = tid >> 7, hk = h * GK + k; const float bg = F.b_gate[hk];
            float w2[16];
#pragma unroll
            for (int j = 0; j < 16; ++j) w2[j] = F.w_gate2[j * GKD + hk];
#pragma unroll
            for (int tt = 0; tt < 2; ++tt) { const int t = 2 * tp + tt; const LAS f32x4* lr = (const LAS f32x4*)(LR + t * 16); const f32x4 a = lr[0], bq = lr[1], c = lr[2], d = lr[3];
                const float x = bg + a.x * w2[0] + a.y * w2[1] + a.z * w2[2] + a.w * w2[3] + bq.x * w2[4] + bq.y * w2[5] + bq.z * w2[6] + bq.w * w2[7]
                              + c.x * w2[8] + c.y * w2[9] + c.z * w2[10] + c.w * w2[11] + d.x * w2[12] + d.y * w2[13] + d.z * w2[14] + d.w * w2[15];
                LG[t * 128 + k] = logsigmoid_f(x) * (1.f / 16.f); } }
        __syncthreads();
        if (tid < 128) { const int k = tid;
            float bcum[8], kv[8]; float run = 0.f;
#pragma unroll
            for (int t = 0; t < 8; ++t) { run += LG[t * 128 + k]; bcum[t] = run; kv[t] = bf2f(*(const LAS bf16*)(KR + t * 256 + k * 2));
                *(LAS bf16*)(QE + t * QE_ST + k * 2) = (bf16)f2bf(bf2f(*(const LAS bf16*)(QR + t * 256 + k * 2)) * 0.08838834764831845f * __expf(run));
                *(LAS bf16*)(KE + t * QE_ST + k * 2) = (bf16)f2bf(kv[t] * __expf(-run)); }
            f32x4 d0, d1; d0.x = kv[0] * __expf(run - bcum[0]); d0.y = kv[1] * __expf(run - bcum[1]); d0.z = kv[2] * __expf(run - bcum[2]); d0.w = kv[3] * __expf(run - bcum[3]);
            d1.x = kv[4] * __expf(run - bcum[4]); d1.y = kv[5] * __expf(run - bcum[5]); d1.z = kv[6] * __expf(run - bcum[6]); d1.w = kv[7];
            *(LAS f32x4*)(KD + k * 8) = d0; *(LAS f32x4*)(KD + k * 8 + 4) = d1; EL[k] = __expf(run); } }
    if (tid < 128) {
    } else if (tid < 384) { const int i = tid - 128, which = i >> 7, j = i & 127;
        *(LAS v4u*)((which ? KE : QE) + (8 + (j >> 4)) * QE_ST + (j & 15) * 16) = (v4u){0u, 0u, 0u, 0u};
    } else if (tid < 384 + 80) { *(LAS v4u*)(ATT + (tid - 384) * 16) = (v4u){0u, 0u, 0u, 0u}; }
#pragma unroll
    for (int i = 0; i < 16; ++i) *(LAS v2u*)(S0b + (16 * w + i) * V_ST + lane * 8) = pk4(S[i]);
    __syncthreads();
    if (w == 0) { f32x4 a4 = (f32x4){0.f, 0.f, 0.f, 0.f};
#pragma unroll
        for (int ks = 0; ks < 4; ++ks) a4 = MFMA16(frag_k(KE, QE_ST, 0, 32 * ks, r, q), frag_k(QE, QE_ST, 0, 32 * ks, r, q), a4);
        const int s0i = 4 * q; f32x4 m; m.x = (s0i <= r) ? a4.x : 0.f; m.y = (s0i + 1 <= r) ? a4.y : 0.f; m.z = (s0i + 2 <= r) ? a4.z : 0.f; m.w = (s0i + 3 <= r) ? a4.w : 0.f;
        if (r >= 8) m = (f32x4){0.f, 0.f, 0.f, 0.f};
        *(LAS v2u*)(ATT + r * ATT8_ST + s0i * 2) = pk4(m); }
    { f32x4* so = (f32x4*)(F.out + O_GLA_S + ((size_t)(b * GH + h) * GK + 16 * w) * GV) + lane;
#pragma unroll
        for (int i = 0; i < 16; ++i) { const int k = 16 * w + i; const float e = EL[k]; const f32x4 k0 = *(const LAS f32x4*)(KD + k * 8), k1 = *(const LAS f32x4*)(KD + k * 8 + 4);
            f32x4 n = S[i] * e; n = n + Vf[0] * k0.x; n = n + Vf[1] * k0.y; n = n + Vf[2] * k0.z; n = n + Vf[3] * k0.w; n = n + Vf[4] * k1.x; n = n + Vf[5] * k1.y; n = n + Vf[6] * k1.z; n = n + Vf[7] * k1.w;
            so[i * 64] = n; } }
    if (has_next) { const f32x4* s1 = (const f32x4*)(F.st_gla + ((size_t)(nb * GH + nh) * GK + 16 * w) * GV) + lane;
#pragma unroll
        for (int i = 0; i < 16; ++i) S[i] = s1[i * 64]; }
    f32x4 acc[2] = {(f32x4){0.f, 0.f, 0.f, 0.f}, (f32x4){0.f, 0.f, 0.f, 0.f}};
#pragma unroll
    for (int ks = 0; ks < 4; ++ks) { const bf16x8v bq = frag_k(QE, QE_ST, 0, 32 * ks, r, q);
#pragma unroll
        for (int vf = 0; vf < 2; ++vf) acc[vf] = MFMA16(frag_t(S0b, V_ST, 32 * ks, 32 * w + 16 * vf, r, q), bq, acc[vf]); }
    __syncthreads();
    { const bf16x8v ba = *(const LAS bf16x8v*)(ATT + r * ATT8_ST + 16 * q);
#pragma unroll
        for (int vf = 0; vf < 2; ++vf) acc[vf] = MFMA16(frag_t(Vt, V_ST, 0, 32 * w + 16 * vf, r, q), ba, acc[vf]); }
    float ss = (acc[0].x * acc[0].x + acc[0].y * acc[0].y) + (acc[0].z * acc[0].z + acc[0].w * acc[0].w) + (acc[1].x * acc[1].x + acc[1].y * acc[1].y) + (acc[1].z * acc[1].z + acc[1].w * acc[1].w);
    ss += __shfl_xor(ss, 16); ss += __shfl_xor(ss, 32);
    if (q == 0) red[w * 16 + r] = ss;
    __syncthreads();
    float tot = 0.f;
#pragma unroll
    for (int ww = 0; ww < 8; ++ww) tot += red[ww * 16 + r];
    const float rr = rsqrtf(tot * (1.f / GV) + EPS);
    if (r < 8) { const size_t row = (size_t)(row0 + r);
#pragma unroll
        for (int vf = 0; vf < 2; ++vf) { const int v = 32 * w + 16 * vf + 4 * q;
            const v2u gw = *(const v2u*)(F.PROJ + row * NP + CG + h * GV + v); const f32x4 nw = *(const f32x4*)(F.gla_norm + v);
            f32x4 o; o.x = acc[vf].x * rr * nw.x * silu_f(bflo(gw.x)); o.y = acc[vf].y * rr * nw.y * silu_f(bfhi(gw.x)); o.z = acc[vf].z * rr * nw.z * silu_f(bflo(gw.y)); o.w = acc[vf].w * rr * nw.w * silu_f(bfhi(gw.y));
            *(v2u*)(F.MIXIN + row * DM + h * GV + v) = pk4(o); } }
    __syncthreads();
}
__device__ __forceinline__ void ssd_sample_unit(Frame& F, int b, int g) {
    const int tid = F.tid, w = F.wave, lane = F.lane, r = lane & 15, q = lane >> 4, row0 = MP + b * SL, hd = g * 8 + w, ch = g * 512 + tid;
    LAS float* Xs = (LAS float*)F.lds;
    LAS float* XW = Xs + 4096;
    LAS float* Bs = XW + 4096;
    LAS unsigned char* Cb = (LAS unsigned char*)(Bs + 1024);
    LAS unsigned char* Bb = Cb + 16 * QE_ST;
    LAS float* CBm = (LAS float*)(Bb + 16 * QE_ST);
    LAS float* CD = CBm + 256;
    LAS float* red = CD + 128;
    const float* h0base = F.st_ssd + ((size_t)(b * SH + hd) * SP) * SN; float* hobase = F.out + O_SSD_S + ((size_t)(b * SH + hd) * SP) * SN;
    f32x4 hbuf[4][2];
#pragma unroll
    for (int i = 0; i < 4; ++i) { const size_t off = (size_t)(16 * (i & 3) + r) * SN + 32 * (i >> 2) + 8 * q; hbuf[i][0] = *(const f32x4*)(h0base + off); hbuf[i][1] = *(const f32x4*)(h0base + off + 4); }
    float dt[8], cum[8]; { const float A = -__expf(F.A_log[hd]), dtb = F.dt_bias[hd]; float run = 0.f;
#pragma unroll
        for (int t = 0; t < 8; ++t) { dt[t] = softplus_f(F.LRDT[(size_t)(row0 + t) * 32 + 16 + hd] + dtb); run += dt[t] * A; cum[t] = run; } }
    const float last = cum[7], elast = __expf(last);
    if (lane < 8) { float cv = cum[0], dv = dt[0];
#pragma unroll
        for (int t = 1; t < 8; ++t) { cv = (lane == t) ? cum[t] : cv; dv = (lane == t) ? dt[t] : dv; }
        CD[w * 16 + lane] = cv; CD[w * 16 + 8 + lane] = dv; }
    { float xr[11]; const float cb = F.sconv_b[ch], c0 = F.sconv_w[ch], c1 = F.sconv_w[SCH + ch], c2 = F.sconv_w[2 * SCH + ch], c3 = F.sconv_w[3 * SCH + ch];
#pragma unroll
        for (int i = 0; i < 11; ++i) xr[i] = xbc_raw(F, 1, b, row0, i - 3, ch);
        float xw[8];
#pragma unroll
        for (int t = 0; t < 8; ++t) { const float x = silu_f(cb + c0 * xr[t] + c1 * xr[t + 1] + c2 * xr[t + 2] + c3 * xr[t + 3]); Xs[t * 512 + tid] = x; xw[t] = x * __expf(last - cum[t]) * dt[t]; }
        *(LAS f32x4*)(XW + tid * 8) = (f32x4){xw[0], xw[1], xw[2], xw[3]}; *(LAS f32x4*)(XW + tid * 8 + 4) = (f32x4){xw[4], xw[5], xw[6], xw[7]}; }
    if (tid < 256) { const int n = tid & 127, isC = tid >> 7, cc = 1024 + isC * 256 + g * 128 + n;
        float xr[11]; const float cb = F.sconv_b[cc], c0 = F.sconv_w[cc], c1 = F.sconv_w[SCH + cc], c2 = F.sconv_w[2 * SCH + cc], c3 = F.sconv_w[3 * SCH + cc];
#pragma unroll
        for (int i = 0; i < 11; ++i) xr[i] = xbc_raw(F, 1, b, row0, i - 3, cc);
#pragma unroll
        for (int t = 0; t < 8; ++t) { const float x = silu_f(cb + c0 * xr[t] + c1 * xr[t + 1] + c2 * xr[t + 2] + c3 * xr[t + 3]);
            if (!isC) Bs[t * 128 + n] = x;
            *(LAS bf16*)((isC ? Cb : Bb) + t * QE_ST + n * 2) = (bf16)f2bf(x); }
    } else { const int i = tid - 256, which = i >> 7, j = i & 127; *(LAS v4u*)((which ? Bb : Cb) + (8 + (j >> 4)) * QE_ST + (j & 15) * 16) = (v4u){0u, 0u, 0u, 0u}; }
    __syncthreads();
    if (w == 0) { f32x4 a4 = (f32x4){0.f, 0.f, 0.f, 0.f};
#pragma unroll
        for (int ks = 0; ks < 4; ++ks) a4 = MFMA16(frag_k(Bb, QE_ST, 0, 32 * ks, r, q), frag_k(Cb, QE_ST, 0, 32 * ks, r, q), a4);
        *(LAS f32x4*)(CBm + r * 16 + 4 * q) = a4; }
    bf16x8v bc[4];
#pragma unroll
    for (int ks = 0; ks < 4; ++ks) bc[ks] = frag_k(Cb, QE_ST, 0, 32 * ks, r, q);
    f32x4 acc[4];
#pragma unroll
    for (int pf = 0; pf < 4; ++pf) acc[pf] = (f32x4){0.f, 0.f, 0.f, 0.f};
    f32x4 Bv[8][2];
#pragma unroll
    for (int st = 0; st < 16; ++st) { const int ks = st >> 2, pf = st & 3;
        if (pf == 0) {
#pragma unroll
            for (int s = 0; s < 8; ++s) { Bv[s][0] = *(const LAS f32x4*)(Bs + s * 128 + 32 * ks + 8 * q); Bv[s][1] = *(const LAS f32x4*)(Bs + s * 128 + 32 * ks + 8 * q + 4); } }
        const int p = 16 * pf + r; const size_t off = (size_t)p * SN + 32 * ks + 8 * q;
        const f32x4 ha = hbuf[st & 3][0], hb = hbuf[st & 3][1];
        if (st + 4 < 16) { const int st2 = st + 4; const size_t off2 = (size_t)(16 * (st2 & 3) + r) * SN + 32 * (st2 >> 2) + 8 * q; hbuf[st & 3][0] = *(const f32x4*)(h0base + off2); hbuf[st & 3][1] = *(const f32x4*)(h0base + off2 + 4); }
        asm volatile("" ::: "memory");
        const f32x4 x0 = *(const LAS f32x4*)(XW + (64 * w + p) * 8), x1 = *(const LAS f32x4*)(XW + (64 * w + p) * 8 + 4);
        f32x4 na = ha * elast, nb = hb * elast;
        na = na + Bv[0][0] * x0.x; nb = nb + Bv[0][1] * x0.x; na = na + Bv[1][0] * x0.y; nb = nb + Bv[1][1] * x0.y; na = na + Bv[2][0] * x0.z; nb = nb + Bv[2][1] * x0.z; na = na + Bv[3][0] * x0.w; nb = nb + Bv[3][1] * x0.w;
        na = na + Bv[4][0] * x1.x; nb = nb + Bv[4][1] * x1.x; na = na + Bv[5][0] * x1.y; nb = nb + Bv[5][1] * x1.y; na = na + Bv[6][0] * x1.z; nb = nb + Bv[6][1] * x1.z; na = na + Bv[7][0] * x1.w; nb = nb + Bv[7][1] * x1.w;
        *(f32x4*)(hobase + off) = na; *(f32x4*)(hobase + off + 4) = nb;
        const v4u ap = (v4u){pk2(ha.x, ha.y), pk2(ha.z, ha.w), pk2(hb.x, hb.y), pk2(hb.z, hb.w)};
        acc[pf] = MFMA16(__builtin_bit_cast(bf16x8v, ap), bc[ks], acc[pf]); }
    __syncthreads();
    const int tc = r & 7; const float ct = CD[w * 16 + tc], ect = __expf(ct), Dh = F.ssd_D[hd];
    float L[8]; { const f32x4 c0 = *(const LAS f32x4*)(CBm + r * 16), c1 = *(const LAS f32x4*)(CBm + r * 16 + 4); const float cbv[8] = {c0.x, c0.y, c0.z, c0.w, c1.x, c1.y, c1.z, c1.w};
        const f32x4 q0 = *(const LAS f32x4*)(CD + w * 16), q1 = *(const LAS f32x4*)(CD + w * 16 + 4), d0 = *(const LAS f32x4*)(CD + w * 16 + 8), d1 = *(const LAS f32x4*)(CD + w * 16 + 12);
        const float cu[8] = {q0.x, q0.y, q0.z, q0.w, q1.x, q1.y, q1.z, q1.w}, dd[8] = {d0.x, d0.y, d0.z, d0.w, d1.x, d1.y, d1.z, d1.w};
#pragma unroll
        for (int s = 0; s < 8; ++s) L[s] = (s <= tc) ? cbv[s] * __expf(ct - cu[s]) * dd[s] : 0.f; }
    float ss = 0.f; const size_t row = (size_t)(row0 + tc);
#pragma unroll
    for (int pf = 0; pf < 4; ++pf) { const int p4 = 64 * w + 16 * pf + 4 * q;
        f32x4 y = acc[pf] * ect;
#pragma unroll
        for (int s = 0; s < 8; ++s) y = y + *(const LAS f32x4*)(Xs + s * 512 + p4) * L[s];
        const f32x4 xt = *(const LAS f32x4*)(Xs + tc * 512 + p4); const v2u zv = *(const v2u*)(F.PROJ + row * NP + CZ + g * 512 + p4);
        y.x = (y.x + Dh * xt.x) * silu_f(bflo(zv.x)); y.y = (y.y + Dh * xt.y) * silu_f(bfhi(zv.x)); y.z = (y.z + Dh * xt.z) * silu_f(bflo(zv.y)); y.w = (y.w + Dh * xt.w) * silu_f(bfhi(zv.y));
        acc[pf] = y; ss += (y.x * y.x + y.y * y.y) + (y.z * y.z + y.w * y.w); }
    ss += __shfl_xor(ss, 16); ss += __shfl_xor(ss, 32);
    if (q == 0) red[w * 16 + r] = ss;
    __syncthreads();
    float tot = 0.f;
#pragma unroll
    for (int ww = 0; ww < 8; ++ww) tot += red[ww * 16 + r];
    const float rr = rsqrtf(tot * (1.f / 512.f) + EPS);
    if (r < 8) {
#pragma unroll
        for (int pf = 0; pf < 4; ++pf) { const int p4 = g * 512 + 64 * w + 16 * pf + 4 * q; const f32x4 nw = *(const f32x4*)(F.ssd_norm + p4);
            f32x4 o = acc[pf]; o.x *= rr * nw.x; o.y *= rr * nw.y; o.z *= rr * nw.z; o.w *= rr * nw.w;
            *(v2u*)(F.MIXIN + row * DM + 1024 + p4) = pk4(o); } }
    __syncthreads();
}

__device__ __forceinline__ void p2a_chunk_states(Frame& F) {
    for (int idx = F.bid; idx < 768; idx += F.G) { if (idx < 256) { TBEGIN(F, 20); ssd_passA_unit(F, idx); TEND(F, 20); } else { TBEGIN(F, 21); gla_passA_unit(F, idx - 256); TEND(F, 21); } }
}
#ifndef MK_REP_PHASE
#define MK_REP_PHASE (-1)
#endif
__device__ __forceinline__ void p2b_scans_and_sample(Frame& F) {
    TBEGIN(F, 30); for (int rep = 0; rep < (MK_REP_PHASE == 30 ? 2 : 1); ++rep) { gla_scan(F); ssd_scan(F); } TEND(F, 30);
    TBEGIN(F, 31);
    for (int rep = 0; rep < (MK_REP_PHASE == 31 ? 2 : 1); ++rep)
    { f32x4 S[16]; int idx = F.bid;
            if (idx < SB * GH) { const f32x4* s0 = (const f32x4*)(F.st_gla + ((size_t)idx * GK + 16 * F.wave) * GV) + F.lane;
#pragma unroll
                for (int i = 0; i < 16; ++i) S[i] = s0[i * 64]; }
            for (; idx < SB * GH; idx += F.G) { const int nx = idx + F.G; gla_sample_unit(F, idx / GH, idx % GH, S, nx / GH, nx % GH, nx < SB * GH); } }
    TEND(F, 31); TBEGIN(F, 32);
    for (int rep = 0; rep < (MK_REP_PHASE == 32 ? 2 : 1); ++rep)
        for (int idx = F.bid; idx < SB * SG; idx += F.G) ssd_sample_unit(F, idx / SG, idx % SG);
    TEND(F, 32);
}
__device__ __forceinline__ void p2c_outputs(Frame& F) {
    for (int idx = F.bid; idx < 768; idx += F.G) { if (idx < 256) { TBEGIN(F, 40); ssd_passC_unit(F, idx); TEND(F, 40); } else { TBEGIN(F, 41); gla_passC_unit(F, idx - 256); TEND(F, 41); } }
    TBEGIN(F, 42);
    const int gt = F.bid * NTHR + F.tid, NT = F.G * NTHR;
    for (int i = gt; i < (PB + SB) * 3 * SCH; i += NT) { const int c = i % SCH, j = (i / SCH) % 3, s = i / (3 * SCH);
        const int grp = s >= PB, b = grp ? s - PB : s, L = grp ? SL : PL, row0 = grp ? MP + b * SL : b * PL;
        F.out[(grp ? O_SCONV_S : O_SCONV_P) + ((size_t)b * 3 + j) * SCH + c] = bf2f(F.PROJ[(size_t)(row0 + L - 3 + j) * NP + CX + c]); }
    TEND(F, 42);
}

__device__ __forceinline__ void p4_post_mixer(Frame& F) {
    const int gw = F.bid * NWAVES + F.wave, NGW = F.G * NWAVES, lane = F.lane;
    for (int m = gw; m < M; m += NGW) {
        const f32x4* mr = (const f32x4*)(F.MIX + (size_t)m * DM) + lane; const f32x4* xr = (const f32x4*)x_row(F, m) + lane;
        const f32x4* w1 = (const f32x4*)F.n_mix_post + lane; const f32x4* w2 = (const f32x4*)F.n_ffn_pre + lane;
        f32x4 v[8]; float s = 0.f;
#pragma unroll
        for (int j = 0; j < 8; ++j) { v[j] = mr[64 * j]; s += (v[j].x * v[j].x + v[j].y * v[j].y) + (v[j].z * v[j].z + v[j].w * v[j].w); }
        const float r1 = rsqrtf(wave_sum(s) * (1.f / DM) + EPS); float s2 = 0.f;
        f32x4* ho = (f32x4*)(F.out + O_Y + (size_t)m * DM) + lane;
#pragma unroll
        for (int j = 0; j < 8; ++j) { v[j] = xr[64 * j] + v[j] * r1 * w1[64 * j]; ho[64 * j] = v[j]; s2 += (v[j].x * v[j].x + v[j].y * v[j].y) + (v[j].z * v[j].z + v[j].w * v[j].w); }
        const float r2 = rsqrtf(wave_sum(s2) * (1.f / DM) + EPS);
        v2u* o8 = (v2u*)(F.XN + (size_t)m * DM) + lane;
#pragma unroll
        for (int j = 0; j < 8; ++j) { const f32x4 ww = w2[64 * j]; v2u o; o.x = pk2(v[j].x * r2 * ww.x, v[j].y * r2 * ww.y); o.y = pk2(v[j].z * r2 * ww.z, v[j].w * r2 * ww.w); o8[64 * j] = o; }
    }
}
__device__ __forceinline__ void u_row8(const Frame& F, int grp, int b, int row0, int tt, int c, float* o) {
    if (tt >= 0) { const v4u r = *(const v4u*)(F.U + (size_t)(row0 + tt) * FF2 + c);
        o[0] = bflo(r.x); o[1] = bfhi(r.x); o[2] = bflo(r.y); o[3] = bfhi(r.y); o[4] = bflo(r.z); o[5] = bfhi(r.z); o[6] = bflo(r.w); o[7] = bfhi(r.w); }
    else if (grp) { const f32x4* s = (const f32x4*)(F.st_fconv + ((size_t)b * 2 + (tt + 2)) * FF2 + c); const f32x4 a = s[0], d = s[1];
        o[0] = a.x; o[1] = a.y; o[2] = a.z; o[3] = a.w; o[4] = d.x; o[5] = d.y; o[6] = d.z; o[7] = d.w; }
    else {
#pragma unroll
        for (int e = 0; e < 8; ++e) o[e] = 0.f; }
}
__device__ __forceinline__ void ld8(const float* p, float* o) { const f32x4 a = *(const f32x4*)p, d = *(const f32x4*)(p + 4); o[0] = a.x; o[1] = a.y; o[2] = a.z; o[3] = a.w; o[4] = d.x; o[5] = d.y; o[6] = d.z; o[7] = d.w; }
__device__ __forceinline__ void p6_conv_act(Frame& F) {
    const int gt = F.bid * NTHR + F.tid, NT = F.G * NTHR;
    constexpr int NCG = FF / 8, NTB = M / 8;
    const int tpc = NT / NCG;
    if (gt < tpc * NCG) { const int cg = gt % NCG, c = cg * 8;
        float wa[3][8], wb[3][8], ba[8], bb[8];
#pragma unroll
        for (int j = 0; j < 3; ++j) { ld8(F.fconv_w + j * FF2 + c, wa[j]); ld8(F.fconv_w + j * FF2 + FF + c, wb[j]); }
        ld8(F.fconv_b + c, ba); ld8(F.fconv_b + FF + c, bb);
        for (int tb = gt / NCG; tb < NTB; tb += tpc) { const int rowb = tb * 8;
            const int grp = rowb >= MP, b = grp ? (rowb - MP) / SL : rowb / PL, row0 = grp ? MP + b * SL : b * PL, t0 = rowb - row0;
            float a0[8], a1[8], a2[8], b0[8], b1[8], b2[8];
            u_row8(F, grp, b, row0, t0 - 2, c, a0); u_row8(F, grp, b, row0, t0 - 1, c, a1);
            u_row8(F, grp, b, row0, t0 - 2, FF + c, b0); u_row8(F, grp, b, row0, t0 - 1, FF + c, b1);
#pragma unroll
            for (int t = 0; t < 8; ++t) { u_row8(F, grp, b, row0, t0 + t, c, a2); u_row8(F, grp, b, row0, t0 + t, FF + c, b2);
                float r[8];
#pragma unroll
                for (int e = 0; e < 8; ++e) { const float a = ba[e] + wa[0][e] * a0[e] + wa[1][e] * a1[e] + wa[2][e] * a2[e], g = bb[e] + wb[0][e] * b0[e] + wb[1][e] * b1[e] + wb[2][e] * b2[e];
                    r[e] = silu_f(a) * g; a0[e] = a1[e]; a1[e] = a2[e]; b0[e] = b1[e]; b1[e] = b2[e]; }
                *(v4u*)(F.ACT + (size_t)(rowb + t) * FF + c) = (v4u){pk2(r[0], r[1]), pk2(r[2], r[3]), pk2(r[4], r[5]), pk2(r[6], r[7])}; } } }
    for (int i = gt; i < (PB + SB) * 2 * FF2; i += NT) { const int c = i % FF2, j = (i / FF2) % 2, s = i / (2 * FF2);
        const int grp = s >= PB, b = grp ? s - PB : s, L = grp ? SL : PL, row0 = grp ? MP + b * SL : b * PL;
        F.out[(grp ? O_FCONV_S : O_FCONV_P) + ((size_t)b * 2 + j) * FF2 + c] = bf2f(F.U[(size_t)(row0 + L - 2 + j) * FF2 + c]); }
}
__device__ __forceinline__ void p8_final(Frame& F) {
    const int gw = F.bid * NWAVES + F.wave, NGW = F.G * NWAVES, lane = F.lane;
    for (int m = gw; m < M; m += NGW) {
        const f32x4* fr = (const f32x4*)(F.Fb + (size_t)m * DM) + lane; const f32x4* w1 = (const f32x4*)F.n_ffn_post + lane;
        f32x4* ho = (f32x4*)(F.out + O_Y + (size_t)m * DM) + lane;
        f32x4 v[8]; float s = 0.f;
#pragma unroll
        for (int j = 0; j < 8; ++j) { v[j] = fr[64 * j]; s += (v[j].x * v[j].x + v[j].y * v[j].y) + (v[j].z * v[j].z + v[j].w * v[j].w); }
        const float r1 = rsqrtf(wave_sum(s) * (1.f / DM) + EPS);
#pragma unroll
        for (int j = 0; j < 8; ++j) ho[64 * j] = ho[64 * j] + v[j] * r1 * w1[64 * j];
    }
}

__device__ __forceinline__ pg8::SplitCtx split_ctx(const Frame& F, unsigned char* ws, size_t slab_off, int bank) {
    pg8::SplitCtx X; X.slabs = (pg8::f32x4*)(ws + slab_off); X.cnt = (unsigned*)(ws + WS_CTL) + CW_SPLIT + bank * 1024; X.flag = (volatile LAS unsigned*)(F.lds + MISC_OFF) + 16; return X; }

struct Args { const float* in[25]; float* out; unsigned char* ws; int ph_lo, ph_hi; };
__global__ void __launch_bounds__(NTHR, 2) fwd_kernel(Args args) {
    extern __shared__ __attribute__((aligned(16))) unsigned char lds[];
    Frame F;
    F.lds = (LAS unsigned char*)lds;
    F.tid = threadIdx.x; F.lane = F.tid & 63; F.wave = __builtin_amdgcn_readfirstlane(F.tid >> 6);
    F.G = gridDim.x; F.bid = blockIdx.x;
    unsigned char* ws = args.ws;
    F.x_p = args.in[0]; F.x_s = args.in[1]; F.st_gla = args.in[2]; F.st_ssd = args.in[3]; F.st_sconv = args.in[4]; F.st_fconv = args.in[5];
    F.n_mix_pre = args.in[6]; F.n_mix_post = args.in[7]; F.n_ffn_pre = args.in[8]; F.n_ffn_post = args.in[9]; F.w_in = args.in[10];
    F.w_gate2 = args.in[11]; F.b_gate = args.in[12]; F.gla_norm = args.in[13]; F.sconv_w = args.in[14]; F.sconv_b = args.in[15];
    F.dt_bias = args.in[16]; F.A_log = args.in[17]; F.ssd_D = args.in[18]; F.ssd_norm = args.in[19]; F.w_out = args.in[20];
    F.ffn_w_in = args.in[21]; F.fconv_w = args.in[22]; F.fconv_b = args.in[23]; F.ffn_w_out = args.in[24];
    F.out = args.out;
    F.W1 = (bf16*)(ws + WS_W1); F.WO = (bf16*)(ws + WS_WO); F.WF1 = (bf16*)(ws + WS_WF1); F.WF2 = (bf16*)(ws + WS_WF2);
    F.XN = (bf16*)(ws + WS_XN); F.PROJ = (bf16*)(ws + WS_PROJ); F.MIXIN = (bf16*)(ws + WS_MIXIN); F.U = (bf16*)(ws + WS_U); F.ACT = (bf16*)(ws + WS_ACT);
    F.LRDT = (float*)(ws + WS_LRDT); F.MIX = (float*)(ws + WS_MIX); F.Fb = (float*)(ws + WS_F);
    F.DS = (bf16*)(ws + WS_DS); F.SC = (bf16*)(ws + WS_SC); F.DH = (bf16*)(ws + WS_DH); F.HC = (bf16*)(ws + WS_HC); F.EBL = (float*)(ws + WS_EBL); F.AL = (float*)(ws + WS_AL);
    for (int u = F.tid; u < (LDS_BYTES - LDSCTL_OFF) / 4; u += NTHR) ((LAS unsigned*)(F.lds + LDSCTL_OFF))[u] = 0u;
    __syncthreads();
    const int lo = args.ph_lo, hi = args.ph_hi;
#if !MK_PER_PHASE
    XcdBarrier bar = xcd_barrier_post((unsigned*)(ws + WS_CTL) + CW_BAR, (volatile LAS unsigned*)(F.lds + MISC_OFF) + 8);
#define GRID_BAR() do { if (args.ph_hi > 1000) cg::this_grid().sync(); xcd_barrier(bar); } while (0)
#else
#define GRID_BAR() do { } while (0)
#endif
#define IN(k) (lo <= (k) && (k) < hi)
#define SEAM(k) do { if (IN(k) && IN((k) + 1)) GRID_BAR(); } while (0)
    F.tacc = 0; F.tmark = 0;
#define PHASE(k, ...) do { if (IN(k)) { TBEGIN(F, k); if (MK_REP_PHASE == (k)) { __VA_ARGS__; GRID_BAR(); } __VA_ARGS__; SEAM(k); TEND(F, k); } } while (0)
    PHASE(0, p0_prologue(F));
    PHASE(1, { pg8::Gemm g{F.XN, F.W1, M, N1, DM}; pg8::StaticOrder S; S.init(M, N1, DM, F.G, F.bid, 1);
        pg8::EpiBf16 E{F.PROJ, NP, NP / 256, F.LRDT};
        pg8::gemm_phase<pg8::EpiBf16, pg8::StaticOrder, true, true>(F.lds, g, S, E, split_ctx(F, ws, WS_SLAB, 0));
        if (S.rem && F.bid >= S.rem * S.S) p0_convert_rest(F, F.bid - S.rem * S.S, F.G - S.rem * S.S); else if (!S.rem) p0_convert_rest(F, F.bid, F.G); });
    PHASE(2, p2a_chunk_states(F));
    PHASE(3, p2b_scans_and_sample(F));
    PHASE(4, p2c_outputs(F));
    PHASE(5, { pg8::Gemm g{F.MIXIN, F.WO, M, DM, DM}; pg8::StaticOrder S; S.init(M, DM, DM, F.G, F.bid, 8);
        pg8::EpiF32 E{F.MIX, DM};
        pg8::gemm_phase<pg8::EpiF32, pg8::StaticOrder, true, true>(F.lds, g, S, E, split_ctx(F, ws, WS_SLAB, 1)); });
    PHASE(6, p4_post_mixer(F));
    PHASE(7, { pg8::Gemm g{F.XN, F.WF1, M, FF2, DM}; pg8::StaticOrder S; S.init(M, FF2, DM, F.G, F.bid, 4);
        pg8::EpiBf16 E{F.U, FF2, FF2 / 256, nullptr};
        pg8::gemm_phase<pg8::EpiBf16, pg8::StaticOrder, true, true>(F.lds, g, S, E, split_ctx(F, ws, WS_SLAB_F1, 2)); });
    PHASE(8, p6_conv_act(F));
    PHASE(9, { pg8::Gemm g{F.ACT, F.WF2, M, DM, FF}; pg8::StaticOrder S; S.init(M, DM, FF, F.G, F.bid, 8);
        pg8::EpiF32 E{F.Fb, DM};
        pg8::gemm_phase<pg8::EpiF32, pg8::StaticOrder, true, true>(F.lds, g, S, E, split_ctx(F, ws, WS_SLAB, 3)); });
    if (IN(10)) { TBEGIN(F, 10); p8_final(F); if (MK_TIME_PHASE == 10) { asm volatile("s_waitcnt vmcnt(0)" ::: "memory"); __syncthreads(); } TEND(F, 10); }
    if (MK_TIME_PHASE >= 0 && F.bid == 0) { const unsigned long long te = __builtin_amdgcn_s_memrealtime(), d = 8ull * F.tacc; while (__builtin_amdgcn_s_memrealtime() - te < d) __builtin_amdgcn_s_sleep(16); }
#undef IN
#undef SEAM
}

extern "C" void kernel_launch(void* const* d_in, const int* in_sizes, int n_in, void* d_out, int out_size, void* d_ws, size_t ws_size, hipStream_t stream) {
    static int grid = 0;
    if (grid == 0) {
        if (n_in != 25 || (size_t)out_size != O_END || ws_size < WS_END) { fprintf(stderr, "kernel_launch: unexpected sizes n_in %d out %d ws %zu (need out %zu ws %zu)\n", n_in, out_size, ws_size, (size_t)O_END, (size_t)WS_END); grid = -1; return; }
        int dev = 0, cus = 0, per_cu = 0;
        hipGetDevice(&dev); hipDeviceGetAttribute(&cus, hipDeviceAttributeMultiprocessorCount, dev);
        if (hipFuncSetAttribute((const void*)fwd_kernel, hipFuncAttributeMaxDynamicSharedMemorySize, LDS_BYTES) != hipSuccess) { fprintf(stderr, "kernel_launch: hipFuncSetAttribute failed\n"); grid = -1; return; }
        hipOccupancyMaxActiveBlocksPerMultiprocessor(&per_cu, (const void*)fwd_kernel, NTHR, LDS_BYTES);
        if (per_cu < 1) { fprintf(stderr, "kernel_launch: occupancy query says %d blocks per CU\n", per_cu); grid = -1; return; }
        grid = cus;
        (void)hipGetLastError();
    }
    if (grid < 0) return;
    Args a{};
    for (int i = 0; i < 25; ++i) a.in[i] = (const float*)d_in[i];
    a.out = (float*)d_out; a.ws = (unsigned char*)d_ws;
#if MK_PER_PHASE
    hipMemsetAsync((char*)d_ws + WS_CTL, 0, CTL_ZERO_BYTES, stream);
    for (int p = 0; p < N_PHASES; ++p) { a.ph_lo = p; a.ph_hi = p + 1; hipLaunchKernelGGL(fwd_kernel, dim3(grid), dim3(NTHR), LDS_BYTES, stream, a); }
#else
    hipMemsetAsync((char*)d_ws + WS_CTL, 0, CTL_ZERO_BYTES, stream);
    a.ph_lo = 0; a.ph_hi = N_PHASES;
    void* kargs[] = {&a};
    hipError_t e = hipLaunchCooperativeKernel((const void*)fwd_kernel, dim3(grid), dim3(NTHR), kargs, LDS_BYTES, stream);
    if (e != hipSuccess) fprintf(stderr, "kernel_launch: cooperative launch failed: %s (grid %d)\n", hipGetErrorString(e), grid);
#endif
}
```

```cpp
#include <hip/hip_runtime.h>
#include <hip/hip_cooperative_groups.h>
#include <cstdio>
#include <cstdint>
namespace cg = cooperative_groups;

#ifndef MK_PER_PHASE
#define MK_PER_PHASE 0
#endif

namespace pg8 {
#define PG8_LAS __attribute__((address_space(3)))
typedef unsigned short bf16_t;
typedef short bf16x8 __attribute__((ext_vector_type(8)));
typedef float f32x4 __attribute__((ext_vector_type(4)));
typedef unsigned u32x4 __attribute__((ext_vector_type(4)));
constexpr int BM = 256, BK = 64, HALF = 128, HTB = HALF * BK * 2  , STAGE_BYTES = 8 * HTB, NXCD = 8, WGM = 8;

__host__ __device__ __forceinline__ int lds_byte(int r, int c) { const int st = (r >> 4) * 2 + (c >> 5), rr = r & 15, cc = c & 31, ob = rr * 64 + cc * 2; return st * 1024 + (ob ^ (((ob >> 9) & 1) << 5)); }
__host__ __device__ __forceinline__ void stage_rc(int b, int& R, int& C) { const int st = b / 1024, sb = b % 1024, swz = sb ^ (((sb >> 9) & 1) << 5); R = (st >> 1) * 16 + swz / 64; C = (st & 1) * 32 + (swz % 64) / 2; }
__host__ __device__ __forceinline__ int perm32(int rho) { const int n = rho >> 4, i = rho & 15; return 8 * (i >> 2) + 4 * n + (i & 3); }

struct Unit { int pm, pn, k0, nk, slice, nsl, tix; };
struct Gemm { const bf16_t* A; const bf16_t* Bt; int M, N, K; };

struct StaticOrder {
    int nM, nN, nwg, G, c, rounds, rem, S, ntK;
    __host__ __device__ __forceinline__ void init(int M, int N, int K, int G_, int c_, int Smax) { nM = M / BM; nN = N / BM; nwg = nM * nN; G = G_; c = c_; ntK = K / BK; rounds = nwg / G; rem = nwg - rounds * G; S = 1;
        if (rem) { while (S < Smax && rem * (S * 2) <= G && (ntK / 2) >= S * 2) S *= 2; } }
    __host__ __device__ __forceinline__ void tile(int L, Unit& u) const {
        int wgid = L; { const int q = nwg / NXCD, r = nwg % NXCD, xcd = wgid % NXCD, off = wgid / NXCD; wgid = (xcd < r ? xcd * (q + 1) : r * (q + 1) + (xcd - r) * q) + off; }
        const int nig = WGM * nN, gid = wgid / nig, fm = gid * WGM, gsz = (nM - fm) < WGM ? (nM - fm) : WGM;
        u.pm = fm + ((wgid % nig) % gsz); u.pn = (wgid % nig) / gsz; }
    __host__ __device__ __forceinline__ bool next(int i, Unit& u) const {
        if (i < rounds) { tile(i * G + c, u); u.k0 = 0; u.nk = ntK; u.slice = 0; u.nsl = 1; u.tix = 0; return true; }
        if (i == rounds && c < rem * S) { const int tix = c % rem, sl = c / rem; tile(rounds * G + tix, u);
            const int pairs = ntK / 2, base = pairs / S, extra = pairs % S, np = base + (sl < extra ? 1 : 0), p0 = sl * base + (sl < extra ? sl : extra);
            u.k0 = 2 * p0; u.nk = 2 * np; u.slice = sl; u.nsl = S; u.tix = tix; return true; }
        return false;
    }
    __device__ __forceinline__ void a_ready(const Unit&) const {}
    __device__ __forceinline__ void done(const Unit&) const {}
};
struct SplitCtx { f32x4* slabs; unsigned* cnt; volatile PG8_LAS unsigned* flag; };
__device__ __forceinline__ int split_reduce(f32x4 (&acc)[2][2][4][2], const Unit& u, const SplitCtx& X, int tid) {
    const __amdgpu_buffer_rsrc_t rs = __builtin_amdgcn_make_buffer_rsrc((void*)X.slabs, (short)0, (int)0x7fffffff, 0x00020000);
    const unsigned mine = (unsigned)((u.tix * u.nsl + u.slice) * 32) * 8192u + (unsigned)tid * 16u;
#pragma unroll
    for (int a = 0; a < 2; ++a)
#pragma unroll
        for (int b = 0; b < 2; ++b)
#pragma unroll
            for (int m = 0; m < 4; ++m)
#pragma unroll
                for (int n = 0; n < 2; ++n) __builtin_amdgcn_raw_buffer_store_b128(__builtin_bit_cast(u32x4, acc[a][b][m][n]), rs, mine + (unsigned)((((a * 2 + b) * 4 + m) * 2 + n) * 8192), 0,   16);
    asm volatile("s_waitcnt vmcnt(0)" ::: "memory");
    __syncthreads();
    if (tid == 0) {
        unsigned* c = X.cnt + 16 * u.tix;
        (void)__hip_atomic_fetch_add(c, 1u, __ATOMIC_RELAXED, __HIP_MEMORY_SCOPE_AGENT);
        unsigned spins = 0;
        while (__hip_atomic_load(c, __ATOMIC_RELAXED, __HIP_MEMORY_SCOPE_AGENT) < (unsigned)u.nsl) { __builtin_amdgcn_s_sleep(2); if (++spins > (1u << 22)) break; }
        __builtin_amdgcn_fence(__ATOMIC_ACQUIRE, "agent");
        asm volatile("s_waitcnt vmcnt(0)" ::: "memory");
    }
    __syncthreads();
    const int shift = u.nsl == 8 ? 2 : (u.nsl == 4 ? 3 : 4);
    for (int s = 0; s < u.nsl; ++s) { if (s == u.slice) continue;
        const f32x4* o = X.slabs + ((size_t)(u.tix * u.nsl + s) * 32) * 512 + tid;
#pragma unroll
        for (int a = 0; a < 2; ++a)
#pragma unroll
            for (int b = 0; b < 2; ++b)
#pragma unroll
                for (int m = 0; m < 4; ++m)
#pragma unroll
                    for (int n = 0; n < 2; ++n) { const int r4 = ((a * 2 + b) * 4 + m) * 2 + n; if ((r4 >> shift) == u.slice) acc[a][b][m][n] += o[(size_t)r4 * 512]; } }
    return shift;
}

__device__ __forceinline__ unsigned cvt_pk_bf16(float lo, float hi) { unsigned r; asm volatile("v_cvt_pk_bf16_f32 %0, %1, %2" : "=v"(r) : "v"(lo), "v"(hi)); return r; }

struct EpiF32 {
    static constexpr bool PERM = false, AFTER_DRAIN = false;
    float* C; int ldc;
    __device__ __forceinline__ void operator()(const f32x4 (&acc)[2][2][4][2], const Unit& u, int wr, int wc, int fr, int fq, int shift, int part) const {
        const int row0 = u.pm * BM + wr * 64 + fr, col0 = u.pn * BM + wc * 32 + 4 * fq;
#pragma unroll
        for (int ai = 0; ai < 2; ++ai)
#pragma unroll
            for (int m = 0; m < 4; ++m) { float* rowp = C + (size_t)(row0 + ai * HALF + m * 16) * ldc + col0;
#pragma unroll
                for (int bj = 0; bj < 2; ++bj)
#pragma unroll
                    for (int n = 0; n < 2; ++n) if ((((((ai * 2 + bj) * 4 + m) * 2 + n)) >> shift) == part) *(f32x4*)(rowp + bj * HALF + n * 16) = acc[ai][bj][m][n]; }
    }
};
struct EpiBf16 {
    static constexpr bool PERM = true, AFTER_DRAIN = false;
    bf16_t* O; int ldc; int nfull; float* X;
    __device__ __forceinline__ void operator()(const f32x4 (&acc)[2][2][4][2], const Unit& u, int wr, int wc, int fr, int fq, int shift, int part) const {
        const int row0 = u.pm * BM + wr * 64 + fr;
        if (u.pn < nfull) {
            const int col0 = u.pn * BM + wc * 32 + 8 * fq;
#pragma unroll
            for (int ai = 0; ai < 2; ++ai)
#pragma unroll
                for (int m = 0; m < 4; ++m) { bf16_t* rowp = O + (size_t)(row0 + ai * HALF + m * 16) * ldc + col0;
#pragma unroll
                    for (int bj = 0; bj < 2; ++bj) { if ((((((ai * 2 + bj) * 4 + m) * 2)) >> shift) != part) continue; const f32x4 v0 = acc[ai][bj][m][0], v1 = acc[ai][bj][m][1];
                        u32x4 w; w.x = cvt_pk_bf16(v0[0], v0[1]); w.y = cvt_pk_bf16(v0[2], v0[3]); w.z = cvt_pk_bf16(v1[0], v1[1]); w.w = cvt_pk_bf16(v1[2], v1[3]);
                        *(u32x4*)(rowp + bj * HALF) = w; } }
        } else if (wc == 0) {
#pragma unroll
            for (int ai = 0; ai < 2; ++ai)
#pragma unroll
                for (int m = 0; m < 4; ++m) { if ((((((ai * 2) * 4 + m) * 2)) >> shift) != part) continue; float* rowp = X + (size_t)(row0 + ai * HALF + m * 16) * 32 + 8 * fq;
                    *(f32x4*)(rowp) = acc[ai][0][m][0]; *(f32x4*)(rowp + 4) = acc[ai][0][m][1]; }
        }
    }
};

__device__ __forceinline__ float dpp_ror1(float x) { return __builtin_bit_cast(float, __builtin_amdgcn_update_dpp(0, __builtin_bit_cast(int, x), 0x121, 0xF, 0xF, false)); }
__device__ __forceinline__ float dpp_ror2(float x) { return __builtin_bit_cast(float, __builtin_amdgcn_update_dpp(0, __builtin_bit_cast(int, x), 0x122, 0xF, 0xF, false)); }
struct EpiConvAct {
    static constexpr bool PERM = true, AFTER_DRAIN = false;
    static constexpr int FFD = 5632, FFD2 = 11264, MPR = 8192, NPT = 32;
    bf16_t* ACT; float* HG; const float* cw; const float* cbias; const float* st; float* fconv_s; PG8_LAS float* halo;
    __device__ __forceinline__ void operator()(const f32x4 (&acc)[2][2][4][2], const Unit& u, int wr, int wc, int fr, int fq, int, int) const {
        const int pm = u.pm, pn = u.pn, cl = wc * 32 + 8 * fq, c0 = pn * 128 + cl; const bool sample = pm >= NPT;
        if (fr >= 14) {
#pragma unroll
            for (int ai = 0; ai < 2; ++ai)
#pragma unroll
                for (int bj = 0; bj < 2; ++bj)
#pragma unroll
                    for (int n = 0; n < 2; ++n) *(PG8_LAS f32x4*)(halo + ((ai * 2 + wr) * 2 + (fr - 14)) * 256 + bj * 128 + cl + 4 * n) = acc[ai][bj][3][n];
            if (!sample && wr == 1) {
#pragma unroll
                for (int bj = 0; bj < 2; ++bj)
#pragma unroll
                    for (int n = 0; n < 2; ++n) *(f32x4*)(HG + ((size_t)pm * 4 + 2 + (fr - 14)) * FFD2 + bj * FFD + c0 + 4 * n) = acc[1][bj][3][n]; }
        }
        if (fr < 2 && !sample && wr == 0) {
#pragma unroll
            for (int bj = 0; bj < 2; ++bj)
#pragma unroll
                for (int n = 0; n < 2; ++n) *(f32x4*)(HG + ((size_t)pm * 4 + fr) * FFD2 + bj * FFD + c0 + 4 * n) = acc[0][bj][0][n]; }
        __syncthreads();
        const int t8 = fr & 7;
        typedef unsigned u32x2 __attribute__((ext_vector_type(2)));
        u32x2 pk0[2][4];
#pragma unroll
        for (int n = 0; n < 2; ++n) {
            f32x4 w[2][3], bs[2];
#pragma unroll
            for (int bj = 0; bj < 2; ++bj) { bs[bj] = *(const f32x4*)(cbias + bj * FFD + c0 + 4 * n);
#pragma unroll
                for (int j = 0; j < 3; ++j) w[bj][j] = *(const f32x4*)(cw + j * FFD2 + bj * FFD + c0 + 4 * n); }
#pragma unroll
            for (int ai = 0; ai < 2; ++ai) {
                f32x4 r1p[2], r2p[2];
#pragma unroll
                for (int bj = 0; bj < 2; ++bj) { f32x4 pv = (f32x4){0.f, 0.f, 0.f, 0.f};
                    if (fr >= 14 && (wr == 1 || ai == 1)) { const int pa = (wr == 1) ? ai : 0, pw = (wr == 1) ? 0 : 1; pv = *(const PG8_LAS f32x4*)(halo + ((pa * 2 + pw) * 2 + (fr - 14)) * 256 + bj * 128 + cl + 4 * n); }
#pragma unroll
                    for (int j = 0; j < 4; ++j) { r1p[bj][j] = dpp_ror1(pv[j]); r2p[bj][j] = dpp_ror2(pv[j]); } }
#pragma unroll
                for (int m = 0; m < 4; ++m) { const int row = pm * BM + ai * HALF + wr * 64 + m * 16 + fr;
                    f32x4 o[2];
#pragma unroll
                    for (int bj = 0; bj < 2; ++bj) { const f32x4 cur = acc[ai][bj][m][n]; f32x4 p1, p2;
#pragma unroll
                        for (int j = 0; j < 4; ++j) { const float c1 = dpp_ror1(cur[j]), c2 = dpp_ror2(cur[j]); p1[j] = (fr == 0) ? r1p[bj][j] : c1; p2[j] = (fr < 2) ? r2p[bj][j] : c2; r1p[bj][j] = c1; r2p[bj][j] = c2; }
                        if (sample && t8 < 2) { const int sb = (row - MPR) >> 3; const f32x4 s1 = *(const f32x4*)(st + ((size_t)sb * 2 + 1) * FFD2 + bj * FFD + c0 + 4 * n);
                            if (t8 == 0) { p1 = s1; p2 = *(const f32x4*)(st + ((size_t)sb * 2) * FFD2 + bj * FFD + c0 + 4 * n); } else p2 = s1; }
                        o[bj] = bs[bj] + w[bj][0] * p2 + w[bj][1] * p1 + w[bj][2] * cur; }
                    f32x4 g; g.x = o[0].x * __builtin_amdgcn_rcpf(1.f + __expf(-o[0].x)) * o[1].x; g.y = o[0].y * __builtin_amdgcn_rcpf(1.f + __expf(-o[0].y)) * o[1].y;
                    g.z = o[0].z * __builtin_amdgcn_rcpf(1.f + __expf(-o[0].z)) * o[1].z; g.w = o[0].w * __builtin_amdgcn_rcpf(1.f + __expf(-o[0].w)) * o[1].w;
                    const u32x2 pk = (u32x2){cvt_pk_bf16(g.x, g.y), cvt_pk_bf16(g.z, g.w)};
                    if (n == 0) pk0[ai][m] = pk;
                    else *(u32x4*)(ACT + (size_t)row * FFD + c0) = (u32x4){pk0[ai][m].x, pk0[ai][m].y, pk.x, pk.y};
                    if (sample && t8 >= 6) { const int sb = (row - MPR) >> 3;
#pragma unroll
                        for (int bj = 0; bj < 2; ++bj) *(f32x4*)(fconv_s + ((size_t)sb * 2 + (t8 - 6)) * FFD2 + bj * FFD + c0 + 4 * n) = acc[ai][bj][m][n]; }
                }
            }
        }
    }
};

template <class Epi, class Sched, bool ALIGN_EPI = false, bool SP2 = false>
__device__ __forceinline__ void gemm_phase(PG8_LAS unsigned char* lds, const Gemm g, const Sched& S, const Epi& E, const SplitCtx& X) {
    const int tid = threadIdx.x, wid = __builtin_amdgcn_readfirstlane(tid >> 6), lane = tid & 63, wr = wid >> 2, wc = wid & 3, fr = lane & 15, fq = lane >> 4;
    const int K = g.K;
    unsigned voffA[2], voffB[2];
#pragma unroll
    for (int i = 0; i < 2; ++i) { int R, C; stage_rc(tid * 16 + i * 8192, R, C); const int Rb = Epi::PERM ? ((R & ~31) + perm32(R & 31)) : R;
        voffA[i] = (unsigned)(R * K + C) * 2u; voffB[i] = (unsigned)(Rb * K + C) * 2u; }
    const size_t kstep = (size_t)(BK * 2);
    const size_t hstep = (size_t)HALF * K * 2;
    const size_t tstep = 2 * hstep;
    const unsigned ldsw = (unsigned)wid * 1024u;
    const int aoff = lds_byte(wr * 64 + fr, fq * 8), boff = lds_byte(wc * 32 + fr, fq * 8);
#define PG8_SA(b, h) (((b) * 2 + (h)) * HTB)
#define PG8_SB(b, h) ((4 + (b) * 2 + (h)) * HTB)
#define PG8_STAGE(bufoff, gbase, voff) do { _Pragma("unroll") for (int _i = 0; _i < 2; ++_i) \
        __builtin_amdgcn_global_load_lds((const unsigned*)((const char*)(gbase) + (voff)[_i]), (PG8_LAS unsigned*)(lds + (bufoff) + ldsw + _i * 8192), 16, 0, 0); } while (0)
#define PG8_LDA(dst, b, h) do { _Pragma("unroll") for (int m = 0; m < 4; ++m) _Pragma("unroll") for (int k = 0; k < 2; ++k) dst[m][k] = *(const PG8_LAS bf16x8*)(lds + PG8_SA(b, h) + aoff + m * 2048 + k * 1024); } while (0)
#define PG8_LDB(dst, b, h) do { _Pragma("unroll") for (int n = 0; n < 2; ++n) _Pragma("unroll") for (int k = 0; k < 2; ++k) dst[n][k] = *(const PG8_LAS bf16x8*)(lds + PG8_SB(b, h) + boff + n * 2048 + k * 1024); } while (0)
#define PG8_MMA(ai, bj, At, Bt) do { __builtin_amdgcn_s_setprio(1); _Pragma("unroll") for (int m = 0; m < 4; ++m) _Pragma("unroll") for (int n = 0; n < 2; ++n) _Pragma("unroll") for (int k = 0; k < 2; ++k) \
        acc[ai][bj][m][n] = __builtin_amdgcn_mfma_f32_16x16x32_bf16(Bt[n][k], At[m][k], acc[ai][bj][m][n], 0, 0, 0); __builtin_amdgcn_s_setprio(0); } while (0)
#define PG8_WAIT_V(n) asm volatile("s_waitcnt vmcnt(" #n ")" ::: "memory")
#define PG8_WAIT_L(n) asm volatile("s_waitcnt lgkmcnt(" #n ")" ::: "memory")
#define PG8_BAR __builtin_amdgcn_s_barrier()
#define PG8_SCHED __builtin_amdgcn_sched_barrier(0)
    Unit cur, nxt; int ui = 0;
    if (!S.next(0, cur)) return;
    f32x4 acc[2][2][4][2];
#pragma unroll
    for (int a = 0; a < 2; ++a)
#pragma unroll
        for (int b = 0; b < 2; ++b)
#pragma unroll
            for (int m = 0; m < 4; ++m)
#pragma unroll
                for (int n = 0; n < 2; ++n) acc[a][b][m][n] = (f32x4){0.f, 0.f, 0.f, 0.f};
    bf16x8 At[4][2], B0[2][2], B1[2][2];
    const char* cA = (const char*)g.A + (size_t)cur.pm * tstep + (size_t)cur.k0 * kstep; const char* cB = (const char*)g.Bt + (size_t)cur.pn * tstep + (size_t)cur.k0 * kstep;
    S.a_ready(cur);
    if constexpr (SP2) {
        PG8_STAGE(PG8_SB(0, 0), cB, voffB); PG8_STAGE(PG8_SB(0, 1), cB + hstep, voffB); PG8_STAGE(PG8_SA(0, 0), cA, voffA); PG8_STAGE(PG8_SA(0, 1), cA + hstep, voffA);
        if (wr == 1) PG8_BAR;
        PG8_WAIT_V(2); PG8_BAR;
        PG8_STAGE(PG8_SB(1, 0), cB + kstep, voffB); PG8_STAGE(PG8_SA(1, 0), cA + kstep, voffA); PG8_STAGE(PG8_SB(1, 1), cB + hstep + kstep, voffB);
        PG8_WAIT_V(6); PG8_BAR;
    } else {
        PG8_STAGE(PG8_SB(0, 0), cB, voffB); PG8_STAGE(PG8_SA(0, 0), cA, voffA); PG8_STAGE(PG8_SB(0, 1), cB + hstep, voffB); PG8_STAGE(PG8_SA(0, 1), cA + hstep, voffA);
        if (wr == 1) PG8_BAR;
        PG8_WAIT_V(4); PG8_BAR;
        PG8_STAGE(PG8_SB(1, 0), cB + kstep, voffB); PG8_STAGE(PG8_SA(1, 0), cA + kstep, voffA); PG8_STAGE(PG8_SB(1, 1), cB + hstep + kstep, voffB);
        PG8_WAIT_V(6); PG8_BAR;
    }
    for (;;) {
        const bool has_next = S.next(ui + 1, nxt);
        const char* nA = has_next ? (const char*)g.A + (size_t)nxt.pm * tstep + (size_t)nxt.k0 * kstep : cA; const char* nB = has_next ? (const char*)g.Bt + (size_t)nxt.pn * tstep + (size_t)nxt.k0 * kstep : cB;
        const int nt = cur.nk;
        for (int t = 0; t < nt; t += 2) {
            const bool last = (t == nt - 2);
            const char* a1 = cA + (size_t)(t + 1) * kstep;
            const char* a2 = last ? nA : cA + (size_t)(t + 2) * kstep; const char* b2 = last ? nB : cB + (size_t)(t + 2) * kstep;
            const char* a3 = a2 + kstep; const char* b3 = b2 + kstep;
            if (last && has_next) S.a_ready(nxt);
            if constexpr (SP2) {
            PG8_LDB(B0, 0, 0); PG8_LDB(B1, 0, 1); PG8_SCHED; PG8_LDA(At, 0, 0); PG8_STAGE(PG8_SA(1, 1), a1 + hstep, voffA);
            PG8_WAIT_V(8); PG8_WAIT_L(0); PG8_BAR; PG8_MMA(0, 0, At, B0); PG8_MMA(0, 1, At, B1); PG8_BAR; PG8_SCHED;
            PG8_LDA(At, 0, 1); PG8_STAGE(PG8_SB(0, 0), b2, voffB); PG8_STAGE(PG8_SB(0, 1), b2 + hstep, voffB); PG8_STAGE(PG8_SA(0, 0), a2, voffA);
            PG8_WAIT_V(8); PG8_WAIT_L(0); PG8_BAR; PG8_MMA(1, 0, At, B0); PG8_MMA(1, 1, At, B1); PG8_BAR; PG8_SCHED;
            PG8_LDB(B0, 1, 0); PG8_LDB(B1, 1, 1); PG8_SCHED; PG8_LDA(At, 1, 0); PG8_STAGE(PG8_SA(0, 1), a2 + hstep, voffA);
            PG8_WAIT_V(8); PG8_WAIT_L(0); PG8_BAR; PG8_MMA(0, 0, At, B0); PG8_MMA(0, 1, At, B1); PG8_BAR; PG8_SCHED;
            PG8_LDA(At, 1, 1); PG8_STAGE(PG8_SB(1, 0), b3, voffB); PG8_STAGE(PG8_SB(1, 1), b3 + hstep, voffB); PG8_STAGE(PG8_SA(1, 0), a3, voffA);
            PG8_WAIT_V(8); PG8_WAIT_L(0); PG8_BAR; PG8_MMA(1, 0, At, B0); PG8_MMA(1, 1, At, B1); PG8_BAR; PG8_SCHED;
            } else {
            PG8_LDB(B0, 0, 0); PG8_SCHED; PG8_LDA(At, 0, 0); PG8_STAGE(PG8_SA(1, 1), a1 + hstep, voffA);
            PG8_WAIT_L(8); PG8_BAR; PG8_WAIT_L(0); PG8_MMA(0, 0, At, B0); PG8_BAR; PG8_SCHED;
            PG8_LDB(B1, 0, 1); PG8_STAGE(PG8_SB(0, 0), b2, voffB);
            PG8_BAR; PG8_WAIT_L(0); PG8_MMA(0, 1, At, B1); PG8_BAR;
            PG8_LDA(At, 0, 1); PG8_STAGE(PG8_SA(0, 0), a2, voffA);
            PG8_BAR; PG8_WAIT_L(0); PG8_MMA(1, 0, At, B0); PG8_BAR; PG8_SCHED;
            PG8_STAGE(PG8_SB(0, 1), b2 + hstep, voffB);
            PG8_WAIT_V(6); PG8_BAR; PG8_MMA(1, 1, At, B1); PG8_BAR;
            PG8_LDB(B0, 1, 0); PG8_SCHED; PG8_LDA(At, 1, 0); PG8_STAGE(PG8_SA(0, 1), a2 + hstep, voffA);
            PG8_WAIT_L(8); PG8_BAR; PG8_WAIT_L(0); PG8_MMA(0, 0, At, B0); PG8_BAR; PG8_SCHED;
            PG8_LDB(B1, 1, 1); PG8_STAGE(PG8_SB(1, 0), b3, voffB);
            PG8_BAR; PG8_WAIT_L(0); PG8_MMA(0, 1, At, B1); PG8_BAR;
            PG8_LDA(At, 1, 1); PG8_STAGE(PG8_SA(1, 0), a3, voffA);
            PG8_BAR; PG8_WAIT_L(0); PG8_MMA(1, 0, At, B0); PG8_BAR; PG8_SCHED;
            PG8_STAGE(PG8_SB(1, 1), b3 + hstep, voffB);
            PG8_WAIT_V(6); PG8_BAR; PG8_MMA(1, 1, At, B1); PG8_BAR;
            }
        }
        if constexpr (ALIGN_EPI) { if (wr == 0) PG8_BAR; }
        if constexpr (!Epi::AFTER_DRAIN) { static_assert(ALIGN_EPI, "split_reduce needs the halves aligned"); if (cur.nsl > 1) { const int shift = split_reduce(acc, cur, X, tid); E(acc, cur, wr, wc, fr, fq, shift, cur.slice); } else E(acc, cur, wr, wc, fr, fq, 5, 0); S.done(cur); }
        if (!has_next) break;
#pragma unroll
        for (int a = 0; a < 2; ++a)
#pragma unroll
            for (int b = 0; b < 2; ++b)
#pragma unroll
                for (int m = 0; m < 4; ++m)
#pragma unroll
                    for (int n = 0; n < 2; ++n) acc[a][b][m][n] = (f32x4){0.f, 0.f, 0.f, 0.f};
        cur = nxt; cA = nA; cB = nB; ++ui;
        if constexpr (ALIGN_EPI) { if (wr == 1) PG8_BAR; }
    }
    PG8_WAIT_V(0);
    if constexpr (!ALIGN_EPI) { if (wr == 0) PG8_BAR; }
    PG8_BAR;
    if constexpr (Epi::AFTER_DRAIN) { E.fused(acc, cur, wr, wc, fr, fq, lds, wid, lane); S.done(cur); }
#undef PG8_SA
#undef PG8_SB
#undef PG8_STAGE
#undef PG8_LDA
#undef PG8_LDB
#undef PG8_MMA
#undef PG8_WAIT_V
#undef PG8_WAIT_L
#undef PG8_BAR
#undef PG8_SCHED
}
}

constexpr int NWAVES = 8, NTHR = 512;
constexpr int DM = 2048, PB = 4, PL = 2048, SB = 128, SL = 8;
constexpr int MP = PB * PL, MS = SB * SL, M = MP + MS;
constexpr int GH = 4, GK = 128, GV = 256, GKD = 512, LOWR = 16;
constexpr int SH = 16, SP = 64, SN = 128, SG = 2, SCH = 1536;
constexpr int FF = 5632, FF2 = 11264, INC = 5664;
constexpr int N1 = 5888, NP = 5632;
constexpr int CQ = 0, CK = 512, CV = 1024, CG = 2048, CZ = 3072, CX = 4096;
constexpr float EPS = 1e-6f;
constexpr int N_PHASES = 11;

constexpr size_t O_Y = 0, O_GLA_P = (size_t)M * DM, O_SSD_P = O_GLA_P + (size_t)PB * GH * GK * GV, O_SCONV_P = O_SSD_P + (size_t)PB * SH * SP * SN,
                 O_FCONV_P = O_SCONV_P + (size_t)PB * 3 * SCH, O_GLA_S = O_FCONV_P + (size_t)PB * 2 * FF2, O_SSD_S = O_GLA_S + (size_t)SB * GH * GK * GV,
                 O_SCONV_S = O_SSD_S + (size_t)SB * SH * SP * SN, O_FCONV_S = O_SCONV_S + (size_t)SB * 3 * SCH, O_END = O_FCONV_S + (size_t)SB * 2 * FF2;

constexpr size_t MiB = 1u << 20;
constexpr size_t WS_CTL = 0, CTL_ZERO_BYTES = 64 * 1024;
constexpr size_t WS_WF2 = 1 * MiB;
constexpr size_t WS_W1 = 24 * MiB;
constexpr size_t WS_WO = 48 * MiB;
constexpr size_t WS_WF1 = 56 * MiB;
constexpr size_t WS_XN = 101 * MiB;
constexpr size_t WS_F = 24 * MiB;
constexpr size_t WS_BIG = 141 * MiB;
constexpr size_t WS_PROJ = WS_BIG;
constexpr size_t WS_MIX = WS_BIG;
constexpr size_t WS_ACT = WS_BIG;
constexpr size_t WS_HG = WS_BIG + 104 * MiB;
constexpr size_t WS_LRDT = WS_BIG + 100 * MiB;
constexpr size_t WS_MIXIN = WS_BIG + 104 * MiB;
constexpr size_t WS_DS = WS_XN;
constexpr size_t WS_SC = WS_BIG + 140 * MiB, WS_DH = WS_BIG + 172 * MiB, WS_HC = WS_BIG + 204 * MiB;
constexpr size_t WS_EBL = WS_BIG + 236 * MiB, WS_AL = WS_EBL + 512 * 1024;
constexpr size_t WS_SLAB = WS_BIG + 140 * MiB;
constexpr size_t WS_SLAB_F1 = WS_BIG + 198 * MiB;
constexpr size_t WS_END = WS_BIG + 247 * MiB;
static_assert(WS_WF2 + (size_t)DM * FF * 2 <= WS_W1 && WS_W1 + (size_t)N1 * DM * 2 <= WS_WO && WS_WO + (size_t)DM * DM * 2 <= WS_WF1 && WS_WF1 + (size_t)FF2 * DM * 2 <= WS_XN && WS_XN + (size_t)M * DM * 2 <= WS_BIG, "ws map 1");
static_assert(WS_F + (size_t)M * DM * 4 <= WS_XN && WS_ACT + (size_t)M * FF * 2 <= WS_HG && WS_PROJ + (size_t)M * NP * 2 <= WS_LRDT && WS_LRDT + (size_t)M * 32 * 4 <= WS_MIXIN && WS_MIXIN + (size_t)M * DM * 2 <= WS_SC && WS_HG + (size_t)32 * 4 * FF2 * 4 <= WS_SC && WS_MIX + (size_t)M * DM * 4 <= WS_LRDT, "ws map 2");
constexpr int CW_BAR = 1024;
constexpr int CW_SPLIT = 8192;

constexpr int RING_BYTES = 131072;
constexpr int SCRATCH_BYTES = 8 * 16640;
constexpr int LDSCTL_OFF = 133632, MISC_OFF = LDSCTL_OFF + 320;
constexpr int LDS_BYTES = 150016;

#ifndef MK_TIME_PHASE
#define MK_TIME_PHASE (-1)
#endif
#define TBEGIN(F, id) do { if (MK_TIME_PHASE == (id)) (F).tmark = __builtin_amdgcn_s_memrealtime(); } while (0)
#define TEND(F, id) do { if (MK_TIME_PHASE == (id)) (F).tacc += __builtin_amdgcn_s_memrealtime() - (F).tmark; } while (0)
#define GAS __attribute__((address_space(1)))
#define LAS __attribute__((address_space(3)))
typedef unsigned short bf16;
typedef unsigned v4u __attribute__((ext_vector_type(4)));
typedef unsigned v2u __attribute__((ext_vector_type(2)));
typedef float f32x4 __attribute__((ext_vector_type(4)));
#define LDS_WAIT() asm volatile("s_waitcnt lgkmcnt(0)" ::: "memory")
#define VM_WAIT() asm volatile("s_waitcnt vmcnt(0)" ::: "memory")
__device__ __forceinline__ unsigned f2bf(float f) { unsigned u = __builtin_bit_cast(unsigned, f); return (u + 0x7fffu + ((u >> 16) & 1u)) >> 16; }
__device__ __forceinline__ unsigned pk2(float lo, float hi) { return f2bf(lo) | (f2bf(hi) << 16); }
__device__ __forceinline__ float bf2f(unsigned short b) { return __builtin_bit_cast(float, (unsigned)b << 16); }
__device__ __forceinline__ float bflo(unsigned w) { return __builtin_bit_cast(float, w << 16); }
__device__ __forceinline__ float bfhi(unsigned w) { return __builtin_bit_cast(float, w & 0xffff0000u); }
__device__ __forceinline__ float silu_f(float x) { return x * __builtin_amdgcn_rcpf(1.f + __expf(-x)); }
__device__ __forceinline__ float softplus_f(float x) { return fmaxf(x, 0.f) + __logf(1.f + __expf(-fabsf(x))); }
__device__ __forceinline__ float logsigmoid_f(float x) { return fminf(x, 0.f) - __logf(1.f + __expf(-fabsf(x))); }
__device__ __forceinline__ float wave_sum(float v) {
#pragma unroll
    for (int o = 1; o < 64; o <<= 1) v += __shfl_xor(v, o);
    return v;
}

#define XB_TMO      128
#define XB_XCNT(j)  (256  + 64 * (j))
#define XB_XSUB(j)  (1280 + 64 * (j))
#define XB_XGEN(j)  (2304 + 64 * (j))
#define XB_TOP      3328
#define XB_TOPGEN   3392
#define XCD_BAR_WORDS 3456
#define XB_SPIN_CAP (1u << 18)

__device__ __forceinline__ unsigned xb_ld(unsigned* p)              { return __hip_atomic_load(p, __ATOMIC_RELAXED, __HIP_MEMORY_SCOPE_AGENT); }
__device__ __forceinline__ unsigned xb_add(unsigned* p, unsigned v) { return __hip_atomic_fetch_add(p, v, __ATOMIC_RELAXED, __HIP_MEMORY_SCOPE_AGENT); }
__device__ __forceinline__ unsigned xb_xcc_id() { return (unsigned)__builtin_amdgcn_s_getreg((3 << 11) | 20) & 0xFu; }
#define XB_SPIN(cond, bar) do { unsigned _sp = 0; while (cond) { __builtin_amdgcn_s_sleep(1); \
    if ((++_sp & 255u) == 0u) { if (xb_ld(&(bar)[XB_TMO])) break; if (_sp > XB_SPIN_CAP) { atomicAdd(&(bar)[XB_TMO], 1u); break; } } } } while (0)

struct XcdBarrier {
    unsigned* bar; unsigned x;
    volatile LAS unsigned* st;
};

__device__ __forceinline__ XcdBarrier xcd_barrier_post(unsigned* bar, volatile LAS unsigned* st) {
    XcdBarrier b; b.bar = bar; b.x = xb_xcc_id(); b.st = st;
    if (threadIdx.x == 0) (void)xb_add(&bar[XB_XCNT(b.x)], 1u);
    return b;
}
__device__ __forceinline__ void xcd_barrier_complete(unsigned* bar, unsigned x, unsigned& nloc, unsigned& nx) {
    const unsigned G = gridDim.x * gridDim.y * gridDim.z;
    unsigned sum, cnt, mine, sp = 0u;
    for (;;) {
        sum = 0u; cnt = 0u; mine = 0u;
#pragma unroll
        for (unsigned j = 0; j < 16; ++j) { const unsigned c = xb_ld(&bar[XB_XCNT(j)]); sum += c; cnt += (c > 0u) ? 1u : 0u; mine = (j == x) ? c : mine; }
        if (sum == G) break;
        __builtin_amdgcn_s_sleep(1);
        if ((++sp & 255u) == 0u) { if (xb_ld(&bar[XB_TMO])) break; if (sp > XB_SPIN_CAP) { atomicAdd(&bar[XB_TMO], 1u); break; } }
    }
    nloc = mine > 0u ? mine : 1u; nx = cnt > 0u ? cnt : 1u;
}

__device__ __forceinline__ void xcd_barrier(const XcdBarrier& b) {
    asm volatile("s_waitcnt vmcnt(0)" ::: "memory");
    __syncthreads();
    if (threadIdx.x == 0) {
        unsigned* bar = b.bar;
        __builtin_amdgcn_s_waitcnt(0);
        unsigned nloc = b.st[0], nx = b.st[1];
        if (nloc == 0u) { xcd_barrier_complete(bar, b.x, nloc, nx); b.st[0] = nloc; b.st[1] = nx; }
        const unsigned old = xb_add(&bar[XB_XSUB(b.x)], 1u);
        const unsigned gen = old / nloc;
        if (old + 1u == (gen + 1u) * nloc) {
            __builtin_amdgcn_fence(__ATOMIC_RELEASE, "agent");
            asm volatile("s_waitcnt vmcnt(0)" ::: "memory");
            const unsigned og = xb_add(&bar[XB_TOP], 1u);
            const unsigned tg = og / nx;
            if (og + 1u == (tg + 1u) * nx) xb_add(&bar[XB_TOPGEN], 1u);
            else XB_SPIN(xb_ld(&bar[XB_TOPGEN]) == tg, bar);
            __builtin_amdgcn_fence(__ATOMIC_ACQUIRE, "agent");
            xb_add(&bar[XB_XGEN(b.x)], 1u);
            asm volatile("s_waitcnt vmcnt(0)" ::: "memory");
        } else {
            XB_SPIN(xb_ld(&bar[XB_XGEN(b.x)]) == gen, bar);
            __builtin_amdgcn_fence(__ATOMIC_ACQUIRE, "agent");
            asm volatile("s_waitcnt vmcnt(0)" ::: "memory");
        }
    }
    __syncthreads();
}

struct Frame {
    LAS unsigned char* lds;
    int tid, lane, wave, G, bid;
    unsigned long long tacc, tmark;
    const float *x_p, *x_s, *st_gla, *st_ssd, *st_sconv, *st_fconv, *n_mix_pre, *n_mix_post, *n_ffn_pre, *n_ffn_post, *w_in, *w_gate2, *b_gate, *gla_norm,
                *sconv_w, *sconv_b, *dt_bias, *A_log, *ssd_D, *ssd_norm, *w_out, *ffn_w_in, *fconv_w, *fconv_b, *ffn_w_out;
    float* out;
    bf16 *W1, *WO, *WF1, *WF2, *XN, *PROJ, *MIXIN, *ACT, *DS, *SC, *DH, *HC;
    float *LRDT, *MIX, *Fb, *EBL, *AL, *HG;
};
__device__ __forceinline__ const float* x_row(const Frame& F, int row) { return row < MP ? F.x_p + (size_t)row * DM : F.x_s + (size_t)(row - MP) * DM; }

__device__ __forceinline__ int w1_src_col(int n) { return n < 3072 ? n : (n < 5632 ? n + 16 : (n < 5648 ? n - 2560 : (n < 5664 ? n : -1))); }
template <int MAP>
__device__ __forceinline__ void p0_transpose_item(const float* W, int K, int Nsrc, int Ndst, bf16* WT, LAS float* scr, int item, int lane) {
    const int nblk = Ndst / 64, kb = item / nblk, nb = item % nblk, k0 = 64 * kb, n0 = 64 * nb;
    int sc = n0 + 4 * (lane & 15); if (MAP == 1) sc = w1_src_col(sc); if (MAP == 2) sc = ((sc >> 7) & 1) * FF + 128 * (sc >> 8) + (sc & 127);
    f32x4 v[16];
#pragma unroll
    for (int i = 0; i < 16; ++i) { const int kk = 4 * i + (lane >> 4); v[i] = (sc >= 0) ? *(const f32x4*)(W + (size_t)(k0 + kk) * Nsrc + sc) : (f32x4){0.f, 0.f, 0.f, 0.f}; }
#pragma unroll
    for (int i = 0; i < 16; ++i) { const int kk = 4 * i + (lane >> 4); LAS float* d = scr + kk * 65 + 4 * (lane & 15); d[0] = v[i].x; d[1] = v[i].y; d[2] = v[i].z; d[3] = v[i].w; }
    LDS_WAIT(); asm volatile("" ::: "memory");
    const int c = lane & 7;
#pragma unroll
    for (int j = 0; j < 8; ++j) { const int n = (lane >> 3) + 8 * j; const LAS float* s = scr + (8 * c) * 65 + n;
        v4u o; o.x = pk2(s[0 * 65], s[1 * 65]); o.y = pk2(s[2 * 65], s[3 * 65]); o.z = pk2(s[4 * 65], s[5 * 65]); o.w = pk2(s[6 * 65], s[7 * 65]);
        *(v4u*)(WT + (size_t)(n0 + n) * K + k0 + 8 * c) = o; }
    LDS_WAIT(); asm volatile("" ::: "memory");
}
__device__ __forceinline__ void rms_row_to_bf16(const float* xrow, const float* w, bf16* orow, int lane) {
    const f32x4* xr = (const f32x4*)xrow + lane; const f32x4* wr = (const f32x4*)w + lane;
    f32x4 v[8]; float s = 0.f;
#pragma unroll
    for (int j = 0; j < 8; ++j) { v[j] = xr[64 * j]; s += (v[j].x * v[j].x + v[j].y * v[j].y) + (v[j].z * v[j].z + v[j].w * v[j].w); }
    const float r = rsqrtf(wave_sum(s) * (1.f / DM) + EPS);
    v2u* o8 = (v2u*)orow + lane;
#pragma unroll
    for (int j = 0; j < 8; ++j) { const f32x4 ww = wr[64 * j]; v2u o; o.x = pk2(v[j].x * r * ww.x, v[j].y * r * ww.y); o.y = pk2(v[j].z * r * ww.z, v[j].w * r * ww.w); o8[64 * j] = o; }
}
__device__ __forceinline__ void p0_prologue(Frame& F) {
    LAS float* scr = (LAS float*)(F.lds + F.wave * 16640);
    const int gw = F.bid * NWAVES + F.wave, NGW = F.G * NWAVES;
    constexpr int I_1 = (DM / 64) * (N1 / 64);
    for (int it = gw; it < I_1; it += NGW) p0_transpose_item<1>(F.w_in, DM, INC, N1, F.W1, scr, it, F.lane);
    for (int m = gw; m < M; m += NGW) rms_row_to_bf16(x_row(F, m), F.n_mix_pre, F.XN + (size_t)m * DM, F.lane);
}
__device__ __forceinline__ void p0_convert_rest(Frame& F, int vb, int nb) {
    LAS float* scr = (LAS float*)(F.lds + F.wave * 16640);
    const int gw = vb * NWAVES + F.wave, NGW = nb * NWAVES;
    constexpr int I_O = (DM / 64) * (DM / 64), I_F1 = (DM / 64) * (FF2 / 64), I_F2 = (FF / 64) * (DM / 64);
    for (int it = gw; it < I_O + I_F1 + I_F2; it += NGW) {
        int r = it;
        if (r < I_O) { p0_transpose_item<0>(F.w_out, DM, DM, DM, F.WO, scr, r, F.lane); continue; } r -= I_O;
        if (r < I_F1) { p0_transpose_item<2>(F.ffn_w_in, DM, FF2, FF2, F.WF1, scr, r, F.lane); continue; } r -= I_F1;
        p0_transpose_item<0>(F.ffn_w_out, FF, DM, DM, F.WF2, scr, r, F.lane);
    }
}

template <int grp> __device__ __forceinline__ void gla_direct_unit(Frame& F, int b, int h) {
    const int tid = F.tid, v = tid & 255, kh = tid >> 8;
    const int L = grp ? SL : PL, row0 = grp ? MP + b * SL : b * PL;
    LAS float* Es = (LAS float*)F.lds; LAS float* Ks = Es + 1024; LAS float* Qs = Ks + 1024; LAS float* Os = Qs + 1024;
    float S[64];
    if (grp) { const float* s0 = F.st_gla + ((size_t)(b * GH + h) * GK + kh * 64) * GV + v;
#pragma unroll
        for (int i = 0; i < 64; ++i) S[i] = s0[(size_t)i * GV]; }
    else {
#pragma unroll
        for (int i = 0; i < 64; ++i) S[i] = 0.f; }
    for (int t0 = 0; t0 < L; t0 += 8) {
        for (int it = tid; it < 1024; it += NTHR) { const int t = it >> 7, k = it & 127, row = row0 + t0 + t, hk = h * GK + k;
            float x = F.b_gate[hk]; const float* lr = F.LRDT + (size_t)row * 32;
#pragma unroll
            for (int j = 0; j < LOWR; ++j) x += lr[j] * F.w_gate2[j * GKD + hk];
            const float lg = logsigmoid_f(x) * (1.f / 16.f);
            Es[it] = __expf(lg); Ks[it] = bf2f(F.PROJ[(size_t)row * NP + CK + hk]); Qs[it] = bf2f(F.PROJ[(size_t)row * NP + CQ + hk]) * 0.08838834764831845f; }
        __syncthreads();
#pragma unroll 1
        for (int t = 0; t < 8; ++t) { const float vv = bf2f(F.PROJ[(size_t)(row0 + t0 + t) * NP + CV + h * GV + v]); float acc = 0.f;
            const LAS float* e = Es + t * 128 + kh * 64; const LAS float* kk = Ks + t * 128 + kh * 64; const LAS float* qq = Qs + t * 128 + kh * 64;
#pragma unroll
            for (int i = 0; i < 64; ++i) { S[i] = e[i] * S[i] + kk[i] * vv; acc += qq[i] * S[i]; }
            Os[(kh * 8 + t) * 256 + v] = acc; }
        __syncthreads();
        { const int t = F.wave, v4 = F.lane * 4, row = row0 + t0 + t;
            const f32x4 a = *(const LAS f32x4*)(Os + t * 256 + v4), c = *(const LAS f32x4*)(Os + (8 + t) * 256 + v4); const f32x4 o = a + c;
            const float ss = wave_sum((o.x * o.x + o.y * o.y) + (o.z * o.z + o.w * o.w)); const float r = rsqrtf(ss * (1.f / GV) + EPS);
            const v2u gw = *(const v2u*)(F.PROJ + (size_t)row * NP + CG + h * GV + v4); const f32x4 nw = *(const f32x4*)(F.gla_norm + v4);
            v2u w; w.x = pk2(o.x * r * nw.x * silu_f(bflo(gw.x)), o.y * r * nw.y * silu_f(bfhi(gw.x))); w.y = pk2(o.z * r * nw.z * silu_f(bflo(gw.y)), o.w * r * nw.w * silu_f(bfhi(gw.y)));
            *(v2u*)(F.MIXIN + (size_t)row * DM + h * GV + v4) = w; }
        __syncthreads();
    }
    float* so = F.out + (grp ? O_GLA_S : O_GLA_P) + ((size_t)(b * GH + h) * GK + kh * 64) * GV + v;
#pragma unroll
    for (int i = 0; i < 64; ++i) so[(size_t)i * GV] = S[i];
}
__device__ __forceinline__ float xbc_raw(const Frame& F, int grp, int b, int row0, int tt, int c) {
    if (tt >= 0) return bf2f(F.PROJ[(size_t)(row0 + tt) * NP + CX + c]);
    return grp ? F.st_sconv[((size_t)b * 3 + (tt + 3)) * SCH + c] : 0.f;
}
template <int grp> __device__ __forceinline__ void ssd_direct_unit(Frame& F, int b, int g) {
    const int tid = F.tid, hd = g * 8 + (tid >> 6), p = tid & 63, ch = g * 512 + tid;
    const int L = grp ? SL : PL, row0 = grp ? MP + b * SL : b * PL;
    LAS float* Bs = (LAS float*)F.lds; LAS float* Cs = Bs + 1024; LAS float* red = Cs + 1024; LAS float* Ys = red + 64;
    float h[128];
    if (grp) { const f32x4* h0 = (const f32x4*)(F.st_ssd + ((size_t)(b * SH + hd) * SP + p) * SN);
#pragma unroll
        for (int i = 0; i < 32; ++i) { const f32x4 q = h0[i]; h[4 * i] = q.x; h[4 * i + 1] = q.y; h[4 * i + 2] = q.z; h[4 * i + 3] = q.w; } }
    else {
#pragma unroll
        for (int i = 0; i < 128; ++i) h[i] = 0.f; }
    const float A = -__expf(F.A_log[hd]), dtb = F.dt_bias[hd], Dh = F.ssd_D[hd], nw = F.ssd_norm[ch];
    const float cb = F.sconv_b[ch], cw0 = F.sconv_w[ch], cw1 = F.sconv_w[SCH + ch], cw2 = F.sconv_w[2 * SCH + ch], cw3 = F.sconv_w[3 * SCH + ch];
    const int c2 = 1024 + (tid < 128 ? g * 128 + tid : 256 + g * 128 + ((tid - 128) & 127));
    float xr0 = xbc_raw(F, grp, b, row0, -3, ch), xr1 = xbc_raw(F, grp, b, row0, -2, ch), xr2 = xbc_raw(F, grp, b, row0, -1, ch);
    for (int t0 = 0; t0 < L; t0 += 8) {
        if (tid < 256) {
            float xr[11]; const float cb2 = F.sconv_b[c2], d0 = F.sconv_w[c2], d1 = F.sconv_w[SCH + c2], d2 = F.sconv_w[2 * SCH + c2], d3 = F.sconv_w[3 * SCH + c2];
#pragma unroll
            for (int i = 0; i < 11; ++i) xr[i] = xbc_raw(F, grp, b, row0, t0 - 3 + i, c2);
#pragma unroll
            for (int t = 0; t < 8; ++t) Bs[(tid >> 7) * 1024 + t * 128 + (tid & 127)] = silu_f(cb2 + d0 * xr[t] + d1 * xr[t + 1] + d2 * xr[t + 2] + d3 * xr[t + 3]);
        }
        __syncthreads();
#pragma unroll 1
        for (int t = 0; t < 8; ++t) { const int row = row0 + t0 + t;
            const float xn = bf2f(F.PROJ[(size_t)row * NP + CX + ch]);
            const float x = silu_f(cb + cw0 * xr0 + cw1 * xr1 + cw2 * xr2 + cw3 * xn); xr0 = xr1; xr1 = xr2; xr2 = xn;
            const float dt = softplus_f(F.LRDT[(size_t)row * 32 + 16 + hd] + dtb), a = __expf(dt * A), dtx = dt * x;
            float acc = 0.f; const LAS float* bb = Bs + t * 128; const LAS float* cc = Cs + t * 128;
#pragma unroll
            for (int nb = 0; nb < 128; nb += 16) {
#pragma unroll
                for (int n = nb; n < nb + 16; ++n) { h[n] = a * h[n] + dtx * bb[n]; acc += h[n] * cc[n]; }
                asm volatile("" ::: "memory"); }
            const float z = bf2f(F.PROJ[(size_t)row * NP + CZ + ch]);
            const float y = (acc + Dh * x) * silu_f(z);
            Ys[t * 512 + tid] = y;
            const float ss = wave_sum(y * y); if (F.lane == 0) red[t * 8 + F.wave] = ss; }
        __syncthreads();
#pragma unroll
        for (int t = 0; t < 8; ++t) { float tot = 0.f;
#pragma unroll
            for (int w = 0; w < 8; ++w) tot += red[t * 8 + w];
            const float r = rsqrtf(tot * (1.f / 512.f) + EPS);
            F.MIXIN[(size_t)(row0 + t0 + t) * DM + 1024 + ch] = (bf16)f2bf(Ys[t * 512 + tid] * r * nw); }
        __syncthreads();
    }
    f32x4* ho = (f32x4*)(F.out + (grp ? O_SSD_S : O_SSD_P) + ((size_t)(b * SH + hd) * SP + p) * SN);
#pragma unroll
    for (int i = 0; i < 32; ++i) ho[i] = (f32x4){h[4 * i], h[4 * i + 1], h[4 * i + 2], h[4 * i + 3]};
}
typedef short bf16x8v __attribute__((ext_vector_type(8)));
typedef short s16x4v __attribute__((ext_vector_type(4)));
constexpr int CH = 64, NCH = PL / CH;
constexpr int QE_ST = 272, KDT_ST = 144, V_ST = 544, ATT_ST = 144, X_ST = 1056, BC_ST = 288;
#define MFMA16(a, b, c) __builtin_amdgcn_mfma_f32_16x16x32_bf16((a), (b), (c), 0, 0, 0)
__device__ __forceinline__ bf16x8v frag_k(const LAS unsigned char* T, int stride, int idx0, int kk0, int r, int q) { return *(const LAS bf16x8v*)(T + (idx0 + r) * stride + (kk0 + 8 * q) * 2); }
__device__ __forceinline__ bf16x8v frag_t(const LAS unsigned char* T, int stride, int kk0, int idx0, int r, int q) {
    const LAS unsigned char* p = T + (kk0 + 8 * q + (r >> 2)) * stride + (idx0 + 4 * (r & 3)) * 2;
    const s16x4v lo = __builtin_amdgcn_ds_read_tr16_b64_v4i16((LAS s16x4v*)p), hi = __builtin_amdgcn_ds_read_tr16_b64_v4i16((LAS s16x4v*)(p + 4 * stride));
    return (bf16x8v){lo[0], lo[1], lo[2], lo[3], hi[0], hi[1], hi[2], hi[3]};
}
__device__ __forceinline__ v2u pk4(const f32x4 v) { v2u o; o.x = pk2(v.x, v.y); o.y = pk2(v.z, v.w); return o; }

struct GlaStage { v4u v[4], qk[4], lr; };
template <int PASS>
__device__ __forceinline__ void gla_stage_load(const Frame& F, int h, int row0, GlaStage& g) {
    const int tid = F.tid;
#pragma unroll
    for (int i = 0; i < 4; ++i) { const int piece = tid + NTHR * i, row = piece >> 5, c16 = piece & 31; g.v[i] = *(const v4u*)(F.PROJ + (size_t)(row0 + row) * NP + CV + h * GV + c16 * 8); }
#pragma unroll
    for (int i = 0; i < 2; ++i) { const int piece = tid + NTHR * i, row = piece >> 4, c16 = piece & 15;
        g.qk[i] = *(const v4u*)(F.PROJ + (size_t)(row0 + row) * NP + CK + h * GK + c16 * 8);
        if (PASS == 1) g.qk[2 + i] = *(const v4u*)(F.PROJ + (size_t)(row0 + row) * NP + CQ + h * GK + c16 * 8); }
    if (tid < 256) g.lr = *(const v4u*)(F.LRDT + (size_t)(row0 + (tid >> 2)) * 32 + (tid & 3) * 4);
}
template <int PASS>
__device__ __forceinline__ void gla_stage_store(const Frame& F, const GlaStage& g, LAS unsigned char* V, LAS unsigned char* Kt, LAS unsigned char* Qt, LAS float* LR) {
    const int tid = F.tid;
#pragma unroll
    for (int i = 0; i < 4; ++i) { const int piece = tid + NTHR * i, row = piece >> 5, c16 = piece & 31; *(LAS v4u*)(V + row * V_ST + c16 * 16) = g.v[i]; }
#pragma unroll
    for (int i = 0; i < 2; ++i) { const int piece = tid + NTHR * i, row = piece >> 4, c16 = piece & 15;
        *(LAS v4u*)(Kt + row * QE_ST + c16 * 16) = g.qk[i]; if (PASS == 1) *(LAS v4u*)(Qt + row * QE_ST + c16 * 16) = g.qk[2 + i]; }
    if (tid < 256) *(LAS v4u*)(LR + (tid >> 2) * 16 + (tid & 3) * 4) = g.lr;
}
template <int PASS>
__device__ __forceinline__ void gla_chunk_elem(Frame& F, int h, LAS unsigned char* Kt, LAS unsigned char* Qt, LAS unsigned char* KDT, const LAS float* LR, LAS float* tot, float* ebl_out) {
    const int tid = F.tid, k = tid & 127, tq = tid >> 7, hk = h * GK + k;
    float w2[16];
#pragma unroll
    for (int j = 0; j < 16; ++j) w2[j] = F.w_gate2[j * GKD + hk];
    const float bg = F.b_gate[hk];
    float lg[16]; float run = 0.f;
#pragma unroll
    for (int i = 0; i < 16; ++i) { const LAS f32x4* lr = (const LAS f32x4*)(LR + (16 * tq + i) * 16); const f32x4 a = lr[0], b = lr[1], c = lr[2], d = lr[3];
        float x = bg + a.x * w2[0] + a.y * w2[1] + a.z * w2[2] + a.w * w2[3] + b.x * w2[4] + b.y * w2[5] + b.z * w2[6] + b.w * w2[7]
                     + c.x * w2[8] + c.y * w2[9] + c.z * w2[10] + c.w * w2[11] + d.x * w2[12] + d.y * w2[13] + d.z * w2[14] + d.w * w2[15];
        run += logsigmoid_f(x) * (1.f / 16.f); lg[i] = run; }
    tot[tq * 128 + k] = run;
    __syncthreads();
    float off = 0.f, all = 0.f;
#pragma unroll
    for (int qq = 0; qq < 4; ++qq) { const float v = tot[qq * 128 + k]; all += v; off += (qq < tq) ? v : 0.f; }
    if (PASS == 0) {
        unsigned pk[8];
#pragma unroll
        for (int i = 0; i < 8; ++i) { const int t = 16 * tq + 2 * i;
            const float k0 = bf2f(*(const LAS bf16*)(Kt + t * QE_ST + k * 2)) * __expf(all - (off + lg[2 * i])), k1 = bf2f(*(const LAS bf16*)(Kt + (t + 1) * QE_ST + k * 2)) * __expf(all - (off + lg[2 * i + 1])); pk[i] = pk2(k0, k1); }
        LAS v4u* d = (LAS v4u*)(KDT + k * KDT_ST + 32 * tq);
        d[0] = (v4u){pk[0], pk[1], pk[2], pk[3]}; d[1] = (v4u){pk[4], pk[5], pk[6], pk[7]};
        if (tq == 0) ebl_out[k] = __expf(all);
    } else {
#pragma unroll
        for (int i = 0; i < 16; ++i) { const int t = 16 * tq + i; const float bb = off + lg[i];
            LAS bf16* qp = (LAS bf16*)(Qt + t * QE_ST + k * 2); LAS bf16* kp = (LAS bf16*)(Kt + t * QE_ST + k * 2);
            *qp = (bf16)f2bf(bf2f(*qp) * 0.08838834764831845f * __expf(bb)); *kp = (bf16)f2bf(bf2f(*kp) * __expf(-bb)); }
    }
}
__device__ __forceinline__ void gla_passA_unit(Frame& F, int u) {
    const int c = u & 31, bh = u >> 5, b = bh >> 2, h = bh & 3, row0 = b * PL + c * CH;
    LAS unsigned char* KDT = F.lds; LAS unsigned char* V = KDT + 128 * KDT_ST; LAS unsigned char* Kt = V + 64 * V_ST; LAS float* LR = (LAS float*)(Kt + 64 * QE_ST); LAS float* tot = LR + 1024;
    { GlaStage g; gla_stage_load<0>(F, h, row0, g); gla_stage_store<0>(F, g, V, Kt, nullptr, LR); }
    __syncthreads();
    gla_chunk_elem<0>(F, h, Kt, nullptr, KDT, LR, tot, F.EBL + (size_t)u * 128);
    __syncthreads();
    const int w = F.wave, r = F.lane & 15, q = F.lane >> 4;
    f32x4 acc[8][2];
#pragma unroll
    for (int kf = 0; kf < 8; ++kf) { acc[kf][0] = (f32x4){0.f, 0.f, 0.f, 0.f}; acc[kf][1] = (f32x4){0.f, 0.f, 0.f, 0.f}; }
#pragma unroll
    for (int ks = 0; ks < 2; ++ks) { const bf16x8v b0 = frag_t(V, V_ST, 32 * ks, 32 * w, r, q), b1 = frag_t(V, V_ST, 32 * ks, 32 * w + 16, r, q);
#pragma unroll
        for (int kf = 0; kf < 8; ++kf) { const bf16x8v a = frag_k(KDT, KDT_ST, 16 * kf, 32 * ks, r, q); acc[kf][0] = MFMA16(a, b0, acc[kf][0]); acc[kf][1] = MFMA16(a, b1, acc[kf][1]); } }
#pragma unroll
    for (int kf = 0; kf < 8; ++kf)
#pragma unroll
        for (int vf = 0; vf < 2; ++vf) *(v2u*)(F.DS + ((size_t)u * GV + 32 * w + 16 * vf + r) * GK + 16 * kf + 4 * q) = pk4(acc[kf][vf]);
    __syncthreads();
}
__device__ __forceinline__ void gla_scan(Frame& F) {
    for (int it = F.bid * NTHR + F.tid; it < PB * GH * GV * 32; it += F.G * NTHR) { const int k4 = it & 31, v = (it >> 5) & 255, bh = it >> 13;
        f32x4 S = (f32x4){0.f, 0.f, 0.f, 0.f};
#pragma unroll 8
        for (int c = 0; c < NCH; ++c) { const int u = bh * NCH + c; const size_t off = ((size_t)u * GV + v) * GK + 4 * k4;
            const v2u d = *(const v2u*)(F.DS + off); const f32x4 e = *(const f32x4*)(F.EBL + (size_t)u * 128 + 4 * k4);
            *(v2u*)(F.SC + off) = pk4(S);
            S.x = e.x * S.x + bflo(d.x); S.y = e.y * S.y + bfhi(d.x); S.z = e.z * S.z + bflo(d.y); S.w = e.w * S.w + bfhi(d.y); }
        float* o = F.out + O_GLA_P + ((size_t)bh * GK + 4 * k4) * GV + v; o[0] = S.x; o[GV] = S.y; o[2 * GV] = S.z; o[3 * GV] = S.w; }
}
__device__ __forceinline__ void gla_passC_unit(Frame& F, int u) {
    const int c = u & 31, bh = u >> 5, b = bh >> 2, h = bh & 3, row0 = b * PL + c * CH;
    LAS unsigned char* QE = F.lds; LAS unsigned char* KE = QE + 64 * QE_ST; LAS unsigned char* V = KE + 64 * QE_ST; LAS unsigned char* ATT = V + 64 * V_ST;
    LAS float* tot = (LAS float*)(ATT + 64 * ATT_ST); LAS float* red = tot + 512; LAS float* LR = red + 128;
    { GlaStage g; gla_stage_load<1>(F, h, row0, g); gla_stage_store<1>(F, g, V, KE, QE, LR); }
    __syncthreads();
    gla_chunk_elem<1>(F, h, KE, QE, nullptr, LR, tot, nullptr);
    __syncthreads();
    const int w = F.wave, r = F.lane & 15, q = F.lane >> 4;
#pragma unroll
    for (int ff = 0; ff < 2; ++ff) { const int f = 2 * w + ff, sf = f >> 2, tf = f & 3; f32x4 a4 = (f32x4){0.f, 0.f, 0.f, 0.f};
        if (sf <= tf) {
#pragma unroll
            for (int ks = 0; ks < 4; ++ks) a4 = MFMA16(frag_k(KE, QE_ST, 16 * sf, 32 * ks, r, q), frag_k(QE, QE_ST, 16 * tf, 32 * ks, r, q), a4); }
        const int s0 = 16 * sf + 4 * q, t = 16 * tf + r;
        f32x4 m; m.x = (s0 <= t) ? a4.x : 0.f; m.y = (s0 + 1 <= t) ? a4.y : 0.f; m.z = (s0 + 2 <= t) ? a4.z : 0.f; m.w = (s0 + 3 <= t) ? a4.w : 0.f;
        *(LAS v2u*)(ATT + t * ATT_ST + s0 * 2) = pk4(m); }
    __syncthreads();
    const int tf = w & 3, vh = w >> 2;
    f32x4 acc[8];
#pragma unroll
    for (int i = 0; i < 8; ++i) acc[i] = (f32x4){0.f, 0.f, 0.f, 0.f};
    const bf16* Sc = F.SC + ((size_t)u * GV + 128 * vh) * GK;
#pragma unroll
    for (int ks = 0; ks < 4; ++ks) { const bf16x8v bq = frag_k(QE, QE_ST, 16 * tf, 32 * ks, r, q);
#pragma unroll
        for (int i = 0; i < 8; ++i) { const bf16x8v a = *(const bf16x8v*)(Sc + (size_t)(16 * i + r) * GK + 32 * ks + 8 * q); acc[i] = MFMA16(a, bq, acc[i]); } }
#pragma unroll
    for (int ks = 0; ks < 2; ++ks) { const bf16x8v ba = frag_k(ATT, ATT_ST, 16 * tf, 32 * ks, r, q);
#pragma unroll
        for (int i = 0; i < 8; ++i) { const bf16x8v a = frag_t(V, V_ST, 32 * ks, 128 * vh + 16 * i, r, q); acc[i] = MFMA16(a, ba, acc[i]); } }
    float ss = 0.f;
#pragma unroll
    for (int i = 0; i < 8; ++i) ss += (acc[i].x * acc[i].x + acc[i].y * acc[i].y) + (acc[i].z * acc[i].z + acc[i].w * acc[i].w);
    ss += __shfl_xor(ss, 16); ss += __shfl_xor(ss, 32);
    const int t = 16 * tf + r;
    if (q == 0) red[vh * 64 + t] = ss;
    __syncthreads();
    const float rr = rsqrtf((red[t] + red[64 + t]) * (1.f / GV) + EPS); const size_t row = (size_t)(row0 + t);
#pragma unroll
    for (int i = 0; i < 8; ++i) { const int v = 128 * vh + 16 * i + 4 * q;
        const v2u gw = *(const v2u*)(F.PROJ + row * NP + CG + h * GV + v); const f32x4 nw = *(const f32x4*)(F.gla_norm + v);
        f32x4 o; o.x = acc[i].x * rr * nw.x * silu_f(bflo(gw.x)); o.y = acc[i].y * rr * nw.y * silu_f(bfhi(gw.x)); o.z = acc[i].z * rr * nw.z * silu_f(bflo(gw.y)); o.w = acc[i].w * rr * nw.w * silu_f(bfhi(gw.y));
        *(v2u*)(F.MIXIN + row * DM + h * GV + v) = pk4(o); }
    __syncthreads();
}

template <bool SCALE>
__device__ __forceinline__ void ssd_conv_item(Frame& F, int b, int g, int c, int cg, int tb, LAS unsigned char* X, LAS unsigned char* BT, LAS unsigned char* CT, const LAS float* WDEC) {
    const int xc = cg < 64 ? g * 512 + 8 * cg : (cg < 80 ? 1024 + g * 128 + 8 * (cg - 64) : 1280 + g * 128 + 8 * (cg - 80));
    float w[4][8], bias[8];
#pragma unroll
    for (int j = 0; j < 4; ++j) { const f32x4 a = *(const f32x4*)(F.sconv_w + j * SCH + xc), bq = *(const f32x4*)(F.sconv_w + j * SCH + xc + 4);
        w[j][0] = a.x; w[j][1] = a.y; w[j][2] = a.z; w[j][3] = a.w; w[j][4] = bq.x; w[j][5] = bq.y; w[j][6] = bq.z; w[j][7] = bq.w; }
    { const f32x4 a = *(const f32x4*)(F.sconv_b + xc), bq = *(const f32x4*)(F.sconv_b + xc + 4); bias[0] = a.x; bias[1] = a.y; bias[2] = a.z; bias[3] = a.w; bias[4] = bq.x; bias[5] = bq.y; bias[6] = bq.z; bias[7] = bq.w; }
    v4u raw[11];
#pragma unroll
    for (int i = 0; i < 11; ++i) { const int tt = c * CH + tb * 8 - 3 + i;
        raw[i] = (tt >= 0) ? *(const v4u*)(F.PROJ + (size_t)(b * PL + tt) * NP + CX + xc) : (v4u){0u, 0u, 0u, 0u}; }
#pragma unroll
    for (int t = 0; t < 8; ++t) { float o[8];
#pragma unroll
        for (int e = 0; e < 8; ++e) { float a = bias[e];
#pragma unroll
            for (int j = 0; j < 4; ++j) { const unsigned wd = raw[t + j][e >> 1]; a += w[j][e] * ((e & 1) ? bfhi(wd) : bflo(wd)); }
            o[e] = silu_f(a); }
        const int tl = tb * 8 + t;
        if (SCALE && cg < 64) { const float sc = WDEC[(cg >> 3) * 64 + tl];
#pragma unroll
            for (int e = 0; e < 8; ++e) o[e] *= sc; }
        const v4u pkd = (v4u){pk2(o[0], o[1]), pk2(o[2], o[3]), pk2(o[4], o[5]), pk2(o[6], o[7])};
        LAS unsigned char* dst = cg < 64 ? X + tl * X_ST + cg * 16 : (cg < 80 ? BT + tl * BC_ST + (cg - 64) * 16 : CT + tl * BC_ST + (cg - 80) * 16);
        *(LAS v4u*)dst = pkd; }
}
__device__ __forceinline__ float ssd_head_scan(Frame& F, int hd, int row0, float& dt_out, float& last) {
    const float dt = softplus_f(F.LRDT[(size_t)(row0 + F.lane) * 32 + 16 + hd] + F.dt_bias[hd]);
    float cum = dt * (-__expf(F.A_log[hd]));
#pragma unroll
    for (int o = 1; o < 64; o <<= 1) { const float v = __shfl_up(cum, o); cum += (F.lane >= o) ? v : 0.f; }
    dt_out = dt; last = __shfl(cum, 63); return cum;
}
__device__ __forceinline__ void ssd_passA_unit(Frame& F, int u) {
    const int c = u & 31, bg = u >> 5, b = bg >> 1, g = bg & 1, row0 = b * PL + c * CH;
    LAS unsigned char* X = F.lds; LAS unsigned char* BT = X + 64 * X_ST; LAS float* WDEC = (LAS float*)(BT + 64 * BC_ST);
    const int w = F.wave, r = F.lane & 15, q = F.lane >> 4;
    { float dt, last; const float cum = ssd_head_scan(F, g * 8 + w, row0, dt, last);
        WDEC[w * 64 + F.lane] = __expf(last - cum) * dt; if (F.lane == 63) F.AL[(size_t)u * 8 + w] = __expf(last); }
    __syncthreads();
    for (int it = F.tid; it < 80 * 8; it += NTHR) ssd_conv_item<true>(F, b, g, c, it % 80, it / 80, X, BT, nullptr, WDEC);
    __syncthreads();
#pragma unroll 1
    for (int nh = 0; nh < 2; ++nh) {
        f32x4 acc[4][4];
#pragma unroll
        for (int i = 0; i < 4; ++i)
#pragma unroll
            for (int j = 0; j < 4; ++j) acc[i][j] = (f32x4){0.f, 0.f, 0.f, 0.f};
#pragma unroll
        for (int ks = 0; ks < 2; ++ks) { bf16x8v bp[4];
#pragma unroll
            for (int pf = 0; pf < 4; ++pf) bp[pf] = frag_t(X, X_ST, 32 * ks, 64 * w + 16 * pf, r, q);
#pragma unroll
            for (int nf = 0; nf < 4; ++nf) { const bf16x8v a = frag_t(BT, BC_ST, 32 * ks, 64 * nh + 16 * nf, r, q);
#pragma unroll
                for (int pf = 0; pf < 4; ++pf) acc[nf][pf] = MFMA16(a, bp[pf], acc[nf][pf]); } }
#pragma unroll
        for (int nf = 0; nf < 4; ++nf)
#pragma unroll
            for (int pf = 0; pf < 4; ++pf) *(v2u*)(F.DH + (((size_t)u * 8 + w) * SP + 16 * pf + r) * SN + 64 * nh + 16 * nf + 4 * q) = pk4(acc[nf][pf]);
    }
    __syncthreads();
}
__device__ __forceinline__ void ssd_scan(Frame& F) {
    for (int it = F.bid * NTHR + F.tid; it < PB * SH * SP * 32; it += F.G * NTHR) { const int n4 = it & 31, p = (it >> 5) & 63, bhd = it >> 11, b = bhd >> 4, hd = bhd & 15, g = hd >> 3, hl = hd & 7;
        f32x4 H = (f32x4){0.f, 0.f, 0.f, 0.f};
#pragma unroll 8
        for (int c = 0; c < NCH; ++c) { const int u = (b * 2 + g) * NCH + c; const size_t off = (((size_t)u * 8 + hl) * SP + p) * SN + 4 * n4;
            const v2u d = *(const v2u*)(F.DH + off); const float a = F.AL[(size_t)u * 8 + hl];
            *(v2u*)(F.HC + off) = pk4(H);
            H.x = a * H.x + bflo(d.x); H.y = a * H.y + bfhi(d.x); H.z = a * H.z + bflo(d.y); H.w = a * H.w + bfhi(d.y); }
        *(f32x4*)(F.out + O_SSD_P + ((size_t)bhd * SP + p) * SN + 4 * n4) = H; }
}
__device__ __forceinline__ void ssd_passC_unit(Frame& F, int u) {
    const int c = u & 31, bg = u >> 5, b = bg >> 1, g = bg & 1, row0 = b * PL + c * CH;
    LAS unsigned char* X = F.lds; LAS unsigned char* BT = X + 64 * X_ST; LAS unsigned char* CT = BT + 64 * BC_ST; LAS unsigned char* CB = CT + 64 * BC_ST;
    LAS float* DT = (LAS float*)(CB + 64 * ATT_ST); LAS float* CUM = DT + 512; LAS float* red = CUM + 512;
    const int w = F.wave, r = F.lane & 15, q = F.lane >> 4, hd = g * 8 + w;
    { float dt, last; const float cum = ssd_head_scan(F, hd, row0, dt, last); DT[w * 64 + F.lane] = dt; CUM[w * 64 + F.lane] = cum; }
    for (int it = F.tid; it < 96 * 8; it += NTHR) ssd_conv_item<false>(F, b, g, c, it % 96, it / 96, X, BT, CT, nullptr);
    __syncthreads();
#pragma unroll
    for (int ff = 0; ff < 2; ++ff) { const int f = 2 * w + ff, sf = f >> 2, tf = f & 3; f32x4 a4 = (f32x4){0.f, 0.f, 0.f, 0.f};
        if (sf <= tf) {
#pragma unroll
            for (int ks = 0; ks < 4; ++ks) a4 = MFMA16(frag_k(BT, BC_ST, 16 * sf, 32 * ks, r, q), frag_k(CT, BC_ST, 16 * tf, 32 * ks, r, q), a4); }
        *(LAS v2u*)(CB + (16 * tf + r) * ATT_ST + (16 * sf + 4 * q) * 2) = pk4(a4); }
    __syncthreads();
    f32x4 acc[4][4];
#pragma unroll
    for (int i = 0; i < 4; ++i)
#pragma unroll
        for (int j = 0; j < 4; ++j) acc[i][j] = (f32x4){0.f, 0.f, 0.f, 0.f};
    const bf16* Hc = F.HC + ((size_t)u * 8 + w) * SP * SN;
#pragma unroll
    for (int ks = 0; ks < 4; ++ks) { bf16x8v bc[4];
#pragma unroll
        for (int tf = 0; tf < 4; ++tf) bc[tf] = frag_k(CT, BC_ST, 16 * tf, 32 * ks, r, q);
#pragma unroll
        for (int pf = 0; pf < 4; ++pf) { const bf16x8v a = *(const bf16x8v*)(Hc + (size_t)(16 * pf + r) * SN + 32 * ks + 8 * q);
#pragma unroll
            for (int tf = 0; tf < 4; ++tf) acc[pf][tf] = MFMA16(a, bc[tf], acc[pf][tf]); } }
    float ct[4];
#pragma unroll
    for (int tf = 0; tf < 4; ++tf) { ct[tf] = CUM[w * 64 + 16 * tf + r]; const float e = __expf(ct[tf]);
#pragma unroll
        for (int pf = 0; pf < 4; ++pf) acc[pf][tf] = acc[pf][tf] * e; }
#pragma unroll
    for (int ks = 0; ks < 2; ++ks) { bf16x8v ax[4];
#pragma unroll
        for (int pf = 0; pf < 4; ++pf) ax[pf] = frag_t(X, X_ST, 32 * ks, 64 * w + 16 * pf, r, q);
        const int s0 = 32 * ks + 8 * q;
        const f32x4 cs0 = *(const LAS f32x4*)(CUM + w * 64 + s0), cs1 = *(const LAS f32x4*)(CUM + w * 64 + s0 + 4), ds0 = *(const LAS f32x4*)(DT + w * 64 + s0), ds1 = *(const LAS f32x4*)(DT + w * 64 + s0 + 4);
        const float cs[8] = {cs0.x, cs0.y, cs0.z, cs0.w, cs1.x, cs1.y, cs1.z, cs1.w}, ds[8] = {ds0.x, ds0.y, ds0.z, ds0.w, ds1.x, ds1.y, ds1.z, ds1.w};
#pragma unroll
        for (int tf = 0; tf < 4; ++tf) { if (32 * ks > 16 * tf + 15) continue;
            const int t = 16 * tf + r; const v4u cb8 = *(const LAS v4u*)(CB + t * ATT_ST + s0 * 2); float l[8];
#pragma unroll
            for (int e = 0; e < 8; ++e) { const unsigned wd = cb8[e >> 1]; const float cbv = (e & 1) ? bfhi(wd) : bflo(wd); l[e] = (s0 + e <= t) ? cbv * __expf(ct[tf] - cs[e]) * ds[e] : 0.f; }
            const v4u lp = (v4u){pk2(l[0], l[1]), pk2(l[2], l[3]), pk2(l[4], l[5]), pk2(l[6], l[7])}; const bf16x8v bl = __builtin_bit_cast(bf16x8v, lp);
#pragma unroll
            for (int pf = 0; pf < 4; ++pf) acc[pf][tf] = MFMA16(ax[pf], bl, acc[pf][tf]); } }
    const float Dh = F.ssd_D[hd];
#pragma unroll
    for (int tf = 0; tf < 4; ++tf) { const int t = 16 * tf + r; const size_t row = (size_t)(row0 + t); float ss = 0.f;
#pragma unroll
        for (int pf = 0; pf < 4; ++pf) { const int p4 = 64 * w + 16 * pf + 4 * q;
            const v2u xv = *(const LAS v2u*)(X + t * X_ST + p4 * 2); const v2u zv = *(const v2u*)(F.PROJ + row * NP + CZ + g * 512 + p4);
            f32x4 y = acc[pf][tf];
            y.x = (y.x + Dh * bflo(xv.x)) * silu_f(bflo(zv.x)); y.y = (y.y + Dh * bfhi(xv.x)) * silu_f(bfhi(zv.x)); y.z = (y.z + Dh * bflo(xv.y)) * silu_f(bflo(zv.y)); y.w = (y.w + Dh * bfhi(xv.y)) * silu_f(bfhi(zv.y));
            acc[pf][tf] = y; ss += (y.x * y.x + y.y * y.y) + (y.z * y.z + y.w * y.w); }
        ss += __shfl_xor(ss, 16); ss += __shfl_xor(ss, 32);
        if (q == 0) red[w * 64 + t] = ss; }
    __syncthreads();
#pragma unroll
    for (int tf = 0; tf < 4; ++tf) { const int t = 16 * tf + r; const size_t row = (size_t)(row0 + t); float tot = 0.f;
#pragma unroll
        for (int ww = 0; ww < 8; ++ww) tot += red[ww * 64 + t];
        const float rr = rsqrtf(tot * (1.f / 512.f) + EPS);
#pragma unroll
        for (int pf = 0; pf < 4; ++pf) { const int p4 = g * 512 + 64 * w + 16 * pf + 4 * q; const f32x4 nw = *(const f32x4*)(F.ssd_norm + p4);
            f32x4 o = acc[pf][tf]; o.x *= rr * nw.x; o.y *= rr * nw.y; o.z *= rr * nw.z; o.w *= rr * nw.w;
            *(v2u*)(F.MIXIN + row * DM + 1024 + p4) = pk4(o); } }
    __syncthreads();
}

constexpr int ATT8_ST = 80;
__device__ __forceinline__ void gla_sample_unit(Frame& F, int b, int h, f32x4 (&S)[16], int nb, int nh, bool has_next) {
    const int tid = F.tid, w = F.wave, lane = F.lane, r = lane & 15, q = lane >> 4, row0 = MP + b * SL;
    LAS unsigned char* S0b = F.lds;
    LAS unsigned char* Vt = S0b + 128 * V_ST;
    LAS unsigned char* QE = Vt + 32 * V_ST;
    LAS unsigned char* KE = QE + 16 * QE_ST;
    LAS unsigned char* ATT = KE + 16 * QE_ST;
    LAS float* KD = (LAS float*)(ATT + 16 * ATT8_ST);
    LAS float* EL = KD + 1024;
    LAS float* red = EL + 128;
    f32x4 Vf[8];
#pragma unroll
    for (int s = 0; s < 8; ++s) { const v2u vv = *(const v2u*)(F.PROJ + (size_t)(row0 + s) * NP + CV + h * GV + 4 * lane); Vf[s] = (f32x4){bflo(vv.x), bfhi(vv.x), bflo(vv.y), bfhi(vv.y)}; }
    if (tid < 256) { const int t = tid >> 5, c16 = tid & 31; *(LAS v4u*)(Vt + t * V_ST + c16 * 16) = *(const v4u*)(F.PROJ + (size_t)(row0 + t) * NP + CV + h * GV + c16 * 8); }
    for (int i = tid; i < 24 * 32; i += NTHR) *(LAS v4u*)(Vt + (8 + (i >> 5)) * V_ST + (i & 31) * 16) = (v4u){0u, 0u, 0u, 0u};
    { LAS unsigned char* KR = (LAS unsigned char*)(red + 128); LAS unsigned char* QR = KR + 8 * 256; LAS float* LR = (LAS float*)(QR + 8 * 256); LAS float* LG = LR + 128;
        if (tid < 256) { const int which = tid >> 7, j = tid & 127, t = j >> 4, c16 = j & 15;
            *(LAS v4u*)((which ? QR : KR) + t * 256 + c16 * 16) = *(const v4u*)(F.PROJ + (size_t)(row0 + t) * NP + (which ? CQ : CK) + h * GK + c16 * 8); }
        else if (tid < 288) { const int j = tid - 256; *(LAS v4u*)(LR + (j >> 2) * 16 + (j & 3) * 4) = *(const v4u*)(F.LRDT + (size_t)(row0 + (j >> 2)) * 32 + (j & 3) * 4); }
        __syncthreads();
        { const int k = tid & 127, tp = tid >> 7, hk = h * GK + k; const float bg = F.b_gate[hk];
            float w2[16];
#pragma unroll
            for (int j = 0; j < 16; ++j) w2[j] = F.w_gate2[j * GKD + hk];
#pragma unroll
            for (int tt = 0; tt < 2; ++tt) { const int t = 2 * tp + tt; const LAS f32x4* lr = (const LAS f32x4*)(LR + t * 16); const f32x4 a = lr[0], bq = lr[1], c = lr[2], d = lr[3];
                const float x = bg + a.x * w2[0] + a.y * w2[1] + a.z * w2[2] + a.w * w2[3] + bq.x * w2[4] + bq.y * w2[5] + bq.z * w2[6] + bq.w * w2[7]
                              + c.x * w2[8] + c.y * w2[9] + c.z * w2[10] + c.w * w2[11] + d.x * w2[12] + d.y * w2[13] + d.z * w2[14] + d.w * w2[15];
                LG[t * 128 + k] = logsigmoid_f(x) * (1.f / 16.f); } }
        __syncthreads();
        if (tid < 128) { const int k = tid;
            float bcum[8], kv[8]; float run = 0.f;
#pragma unroll
            for (int t = 0; t < 8; ++t) { run += LG[t * 128 + k]; bcum[t] = run; kv[t] = bf2f(*(const LAS bf16*)(KR + t * 256 + k * 2));
                *(LAS bf16*)(QE + t * QE_ST + k * 2) = (bf16)f2bf(bf2f(*(const LAS bf16*)(QR + t * 256 + k * 2)) * 0.08838834764831845f * __expf(run));
                *(LAS bf16*)(KE + t * QE_ST + k * 2) = (bf16)f2bf(kv[t] * __expf(-run)); }
            f32x4 d0, d1; d0.x = kv[0] * __expf(run - bcum[0]); d0.y = kv[1] * __expf(run - bcum[1]); d0.z = kv[2] * __expf(run - bcum[2]); d0.w = kv[3] * __expf(run - bcum[3]);
            d1.x = kv[4] * __expf(run - bcum[4]); d1.y = kv[5] * __expf(run - bcum[5]); d1.z = kv[6] * __expf(run - bcum[6]); d1.w = kv[7];
            *(LAS f32x4*)(KD + k * 8) = d0; *(LAS f32x4*)(KD + k * 8 + 4) = d1; EL[k] = __expf(run); } }
    if (tid < 128) {
    } else if (tid < 384) { const int i = tid - 128, which = i >> 7, j = i & 127;
        *(LAS v4u*)((which ? KE : QE) + (8 + (j >> 4)) * QE_ST + (j & 15) * 16) = (v4u){0u, 0u, 0u, 0u};
    } else if (tid < 384 + 80) { *(LAS v4u*)(ATT + (tid - 384) * 16) = (v4u){0u, 0u, 0u, 0u}; }
#pragma unroll
    for (int i = 0; i < 16; ++i) *(LAS v2u*)(S0b + (16 * w + i) * V_ST + lane * 8) = pk4(S[i]);
    __syncthreads();
    if (w == 0) { f32x4 a4 = (f32x4){0.f, 0.f, 0.f, 0.f};
#pragma unroll
        for (int ks = 0; ks < 4; ++ks) a4 = MFMA16(frag_k(KE, QE_ST, 0, 32 * ks, r, q), frag_k(QE, QE_ST, 0, 32 * ks, r, q), a4);
        const int s0i = 4 * q; f32x4 m; m.x = (s0i <= r) ? a4.x : 0.f; m.y = (s0i + 1 <= r) ? a4.y : 0.f; m.z = (s0i + 2 <= r) ? a4.z : 0.f; m.w = (s0i + 3 <= r) ? a4.w : 0.f;
        if (r >= 8) m = (f32x4){0.f, 0.f, 0.f, 0.f};
        *(LAS v2u*)(ATT + r * ATT8_ST + s0i * 2) = pk4(m); }
    { f32x4* so = (f32x4*)(F.out + O_GLA_S + ((size_t)(b * GH + h) * GK + 16 * w) * GV) + lane;
#pragma unroll
        for (int i = 0; i < 16; ++i) { const int k = 16 * w + i; const float e = EL[k]; const f32x4 k0 = *(const LAS f32x4*)(KD + k * 8), k1 = *(const LAS f32x4*)(KD + k * 8 + 4);
            f32x4 n = S[i] * e; n = n + Vf[0] * k0.x; n = n + Vf[1] * k0.y; n = n + Vf[2] * k0.z; n = n + Vf[3] * k0.w; n = n + Vf[4] * k1.x; n = n + Vf[5] * k1.y; n = n + Vf[6] * k1.z; n = n + Vf[7] * k1.w;
            so[i * 64] = n; } }
    if (has_next) { const f32x4* s1 = (const f32x4*)(F.st_gla + ((size_t)(nb * GH + nh) * GK + 16 * w) * GV) + lane;
#pragma unroll
        for (int i = 0; i < 16; ++i) S[i] = s1[i * 64]; }
    f32x4 acc[2] = {(f32x4){0.f, 0.f, 0.f, 0.f}, (f32x4){0.f, 0.f, 0.f, 0.f}};
#pragma unroll
    for (int ks = 0; ks < 4; ++ks) { const bf16x8v bq = frag_k(QE, QE_ST, 0, 32 * ks, r, q);
#pragma unroll
        for (int vf = 0; vf < 2; ++vf) acc[vf] = MFMA16(frag_t(S0b, V_ST, 32 * ks, 32 * w + 16 * vf, r, q), bq, acc[vf]); }
    __syncthreads();
    { const bf16x8v ba = *(const LAS bf16x8v*)(ATT + r * ATT8_ST + 16 * q);
#pragma unroll
        for (int vf = 0; vf < 2; ++vf) acc[vf] = MFMA16(frag_t(Vt, V_ST, 0, 32 * w + 16 * vf, r, q), ba, acc[vf]); }
    float ss = (acc[0].x * acc[0].x + acc[0].y * acc[0].y) + (acc[0].z * acc[0].z + acc[0].w * acc[0].w) + (acc[1].x * acc[1].x + acc[1].y * acc[1].y) + (acc[1].z * acc[1].z + acc[1].w * acc[1].w);
    ss += __shfl_xor(ss, 16); ss += __shfl_xor(ss, 32);
    if (q == 0) red[w * 16 + r] = ss;
    __syncthreads();
    float tot = 0.f;
#pragma unroll
    for (int ww = 0; ww < 8; ++ww) tot += red[ww * 16 + r];
    const float rr = rsqrtf(tot * (1.f / GV) + EPS);
    if (r < 8) { const size_t row = (size_t)(row0 + r);
#pragma unroll
        for (int vf = 0; vf < 2; ++vf) { const int v = 32 * w + 16 * vf + 4 * q;
            const v2u gw = *(const v2u*)(F.PROJ + row * NP + CG + h * GV + v); const f32x4 nw = *(const f32x4*)(F.gla_norm + v);
            f32x4 o; o.x = acc[vf].x * rr * nw.x * silu_f(bflo(gw.x)); o.y = acc[vf].y * rr * nw.y * silu_f(bfhi(gw.x)); o.z = acc[vf].z * rr * nw.z * silu_f(bflo(gw.y)); o.w = acc[vf].w * rr * nw.w * silu_f(bfhi(gw.y));
            *(v2u*)(F.MIXIN + row * DM + h * GV + v) = pk4(o); } }
    __syncthreads();
}
__device__ __forceinline__ void ssd_sample_unit(Frame& F, int b, int g) {
    const int tid = F.tid, w = F.wave, lane = F.lane, r = lane & 15, q = lane >> 4, row0 = MP + b * SL, hd = g * 8 + w, ch = g * 512 + tid;
    LAS float* Xs = (LAS float*)F.lds;
    LAS float* XW = Xs + 4096;
    LAS float* Bs = XW + 4096;
    LAS unsigned char* Cb = (LAS unsigned char*)(Bs + 1024);
    LAS unsigned char* Bb = Cb + 16 * QE_ST;
    LAS float* CBm = (LAS float*)(Bb + 16 * QE_ST);
    LAS float* CD = CBm + 256;
    LAS float* red = CD + 128;
    const float* h0base = F.st_ssd + ((size_t)(b * SH + hd) * SP) * SN; float* hobase = F.out + O_SSD_S + ((size_t)(b * SH + hd) * SP) * SN;
    f32x4 hbuf[4][2];
#pragma unroll
    for (int i = 0; i < 4; ++i) { const size_t off = (size_t)(16 * (i & 3) + r) * SN + 32 * (i >> 2) + 8 * q; hbuf[i][0] = *(const f32x4*)(h0base + off); hbuf[i][1] = *(const f32x4*)(h0base + off + 4); }
    float dt[8], cum[8]; { const float A = -__expf(F.A_log[hd]), dtb = F.dt_bias[hd]; float run = 0.f;
#pragma unroll
        for (int t = 0; t < 8; ++t) { dt[t] = softplus_f(F.LRDT[(size_t)(row0 + t) * 32 + 16 + hd] + dtb); run += dt[t] * A; cum[t] = run; } }
    const float last = cum[7], elast = __expf(last);
    if (lane < 8) { float cv = cum[0], dv = dt[0];
#pragma unroll
        for (int t = 1; t < 8; ++t) { cv = (lane == t) ? cum[t] : cv; dv = (lane == t) ? dt[t] : dv; }
        CD[w * 16 + lane] = cv; CD[w * 16 + 8 + lane] = dv; }
    { float xr[11]; const float cb = F.sconv_b[ch], c0 = F.sconv_w[ch], c1 = F.sconv_w[SCH + ch], c2 = F.sconv_w[2 * SCH + ch], c3 = F.sconv_w[3 * SCH + ch];
#pragma unroll
        for (int i = 0; i < 11; ++i) xr[i] = xbc_raw(F, 1, b, row0, i - 3, ch);
        float xw[8];
#pragma unroll
        for (int t = 0; t < 8; ++t) { const float x = silu_f(cb + c0 * xr[t] + c1 * xr[t + 1] + c2 * xr[t + 2] + c3 * xr[t + 3]); Xs[t * 512 + tid] = x; xw[t] = x * __expf(last - cum[t]) * dt[t]; }
        *(LAS f32x4*)(XW + tid * 8) = (f32x4){xw[0], xw[1], xw[2], xw[3]}; *(LAS f32x4*)(XW + tid * 8 + 4) = (f32x4){xw[4], xw[5], xw[6], xw[7]}; }
    if (tid < 256) { const int n = tid & 127, isC = tid >> 7, cc = 1024 + isC * 256 + g * 128 + n;
        float xr[11]; const float cb = F.sconv_b[cc], c0 = F.sconv_w[cc], c1 = F.sconv_w[SCH + cc], c2 = F.sconv_w[2 * SCH + cc], c3 = F.sconv_w[3 * SCH + cc];
#pragma unroll
        for (int i = 0; i < 11; ++i) xr[i] = xbc_raw(F, 1, b, row0, i - 3, cc);
#pragma unroll
        for (int t = 0; t < 8; ++t) { const float x = silu_f(cb + c0 * xr[t] + c1 * xr[t + 1] + c2 * xr[t + 2] + c3 * xr[t + 3]);
            if (!isC) Bs[t * 128 + n] = x;
            *(LAS bf16*)((isC ? Cb : Bb) + t * QE_ST + n * 2) = (bf16)f2bf(x); }
    } else { const int i = tid - 256, which = i >> 7, j = i & 127; *(LAS v4u*)((which ? Bb : Cb) + (8 + (j >> 4)) * QE_ST + (j & 15) * 16) = (v4u){0u, 0u, 0u, 0u}; }
    __syncthreads();
    if (w == 0) { f32x4 a4 = (f32x4){0.f, 0.f, 0.f, 0.f};
#pragma unroll
        for (int ks = 0; ks < 4; ++ks) a4 = MFMA16(frag_k(Bb, QE_ST, 0, 32 * ks, r, q), frag_k(Cb, QE_ST, 0, 32 * ks, r, q), a4);
        *(LAS f32x4*)(CBm + r * 16 + 4 * q) = a4; }
    bf16x8v bc[4];
#pragma unroll
    for (int ks = 0; ks < 4; ++ks) bc[ks] = frag_k(Cb, QE_ST, 0, 32 * ks, r, q);
    f32x4 acc[4];
#pragma unroll
    for (int pf = 0; pf < 4; ++pf) acc[pf] = (f32x4){0.f, 0.f, 0.f, 0.f};
    f32x4 Bv[8][2];
#pragma unroll
    for (int st = 0; st < 16; ++st) { const int ks = st >> 2, pf = st & 3;
        if (pf == 0) {
#pragma unroll
            for (int s = 0; s < 8; ++s) { Bv[s][0] = *(const LAS f32x4*)(Bs + s * 128 + 32 * ks + 8 * q); Bv[s][1] = *(const LAS f32x4*)(Bs + s * 128 + 32 * ks + 8 * q + 4); } }
        const int p = 16 * pf + r; const size_t off = (size_t)p * SN + 32 * ks + 8 * q;
        const f32x4 ha = hbuf[st & 3][0], hb = hbuf[st & 3][1];
        if (st + 4 < 16) { const int st2 = st + 4; const size_t off2 = (size_t)(16 * (st2 & 3) + r) * SN + 32 * (st2 >> 2) + 8 * q; hbuf[st & 3][0] = *(const f32x4*)(h0base + off2); hbuf[st & 3][1] = *(const f32x4*)(h0base + off2 + 4); }
        asm volatile("" ::: "memory");
        const f32x4 x0 = *(const LAS f32x4*)(XW + (64 * w + p) * 8), x1 = *(const LAS f32x4*)(XW + (64 * w + p) * 8 + 4);
        f32x4 na = ha * elast, nb = hb * elast;
        na = na + Bv[0][0] * x0.x; nb = nb + Bv[0][1] * x0.x; na = na + Bv[1][0] * x0.y; nb = nb + Bv[1][1] * x0.y; na = na + Bv[2][0] * x0.z; nb = nb + Bv[2][1] * x0.z; na = na + Bv[3][0] * x0.w; nb = nb + Bv[3][1] * x0.w;
        na = na + Bv[4][0] * x1.x; nb = nb + Bv[4][1] * x1.x; na = na + Bv[5][0] * x1.y; nb = nb + Bv[5][1] * x1.y; na = na + Bv[6][0] * x1.z; nb = nb + Bv[6][1] * x1.z; na = na + Bv[7][0] * x1.w; nb = nb + Bv[7][1] * x1.w;
        *(f32x4*)(hobase + off) = na; *(f32x4*)(hobase + off + 4) = nb;
        const v4u ap = (v4u){pk2(ha.x, ha.y), pk2(ha.z, ha.w), pk2(hb.x, hb.y), pk2(hb.z, hb.w)};
        acc[pf] = MFMA16(__builtin_bit_cast(bf16x8v, ap), bc[ks], acc[pf]); }
    __syncthreads();
    const int tc = r & 7; const float ct = CD[w * 16 + tc], ect = __expf(ct), Dh = F.ssd_D[hd];
    float L[8]; { const f32x4 c0 = *(const LAS f32x4*)(CBm + r * 16), c1 = *(const LAS f32x4*)(CBm + r * 16 + 4); const float cbv[8] = {c0.x, c0.y, c0.z, c0.w, c1.x, c1.y, c1.z, c1.w};
        const f32x4 q0 = *(const LAS f32x4*)(CD + w * 16), q1 = *(const LAS f32x4*)(CD + w * 16 + 4), d0 = *(const LAS f32x4*)(CD + w * 16 + 8), d1 = *(const LAS f32x4*)(CD + w * 16 + 12);
        const float cu[8] = {q0.x, q0.y, q0.z, q0.w, q1.x, q1.y, q1.z, q1.w}, dd[8] = {d0.x, d0.y, d0.z, d0.w, d1.x, d1.y, d1.z, d1.w};
#pragma unroll
        for (int s = 0; s < 8; ++s) L[s] = (s <= tc) ? cbv[s] * __expf(ct - cu[s]) * dd[s] : 0.f; }
    float ss = 0.f; const size_t row = (size_t)(row0 + tc);
#pragma unroll
    for (int pf = 0; pf < 4; ++pf) { const int p4 = 64 * w + 16 * pf + 4 * q;
        f32x4 y = acc[pf] * ect;
#pragma unroll
        for (int s = 0; s < 8; ++s) y = y + *(const LAS f32x4*)(Xs + s * 512 + p4) * L[s];
        const f32x4 xt = *(const LAS f32x4*)(Xs + tc * 512 + p4); const v2u zv = *(const v2u*)(F.PROJ + row * NP + CZ + g * 512 + p4);
        y.x = (y.x + Dh * xt.x) * silu_f(bflo(zv.x)); y.y = (y.y + Dh * xt.y) * silu_f(bfhi(zv.x)); y.z = (y.z + Dh * xt.z) * silu_f(bflo(zv.y)); y.w = (y.w + Dh * xt.w) * silu_f(bfhi(zv.y));
        acc[pf] = y; ss += (y.x * y.x + y.y * y.y) + (y.z * y.z + y.w * y.w); }
    ss += __shfl_xor(ss, 16); ss += __shfl_xor(ss, 32);
    if (q == 0) red[w * 16 + r] = ss;
    __syncthreads();
    float tot = 0.f;
#pragma unroll
    for (int ww = 0; ww < 8; ++ww) tot += red[ww * 16 + r];
    const float rr = rsqrtf(tot * (1.f / 512.f) + EPS);
    if (r < 8) {
#pragma unroll
        for (int pf = 0; pf < 4; ++pf) { const int p4 = g * 512 + 64 * w + 16 * pf + 4 * q; const f32x4 nw = *(const f32x4*)(F.ssd_norm + p4);
            f32x4 o = acc[pf]; o.x *= rr * nw.x; o.y *= rr * nw.y; o.z *= rr * nw.z; o.w *= rr * nw.w;
            *(v2u*)(F.MIXIN + row * DM + 1024 + p4) = pk4(o); } }
    __syncthreads();
}

__device__ __forceinline__ void p2a_chunk_states(Frame& F) {
    for (int idx = F.bid; idx < 768; idx += F.G) { if (idx < 256) { TBEGIN(F, 20); ssd_passA_unit(F, idx); TEND(F, 20); } else { TBEGIN(F, 21); gla_passA_unit(F, idx - 256); TEND(F, 21); } }
}
#ifndef MK_REP_PHASE
#define MK_REP_PHASE (-1)
#endif
__device__ __forceinline__ void p2b_scans_and_sample(Frame& F) {
    TBEGIN(F, 30); for (int rep = 0; rep < (MK_REP_PHASE == 30 ? 2 : 1); ++rep) { gla_scan(F); ssd_scan(F); } TEND(F, 30);
    TBEGIN(F, 31);
    for (int rep = 0; rep < (MK_REP_PHASE == 31 ? 2 : 1); ++rep)
    { f32x4 S[16]; int idx = F.bid;
            if (idx < SB * GH) { const f32x4* s0 = (const f32x4*)(F.st_gla + ((size_t)idx * GK + 16 * F.wave) * GV) + F.lane;
#pragma unroll
                for (int i = 0; i < 16; ++i) S[i] = s0[i * 64]; }
            for (; idx < SB * GH; idx += F.G) { const int nx = idx + F.G; gla_sample_unit(F, idx / GH, idx % GH, S, nx / GH, nx % GH, nx < SB * GH); } }
    TEND(F, 31); TBEGIN(F, 32);
    for (int rep = 0; rep < (MK_REP_PHASE == 32 ? 2 : 1); ++rep)
        for (int idx = F.bid; idx < SB * SG; idx += F.G) ssd_sample_unit(F, idx / SG, idx % SG);
    TEND(F, 32);
}
__device__ __forceinline__ void p2c_outputs(Frame& F) {
    for (int idx = F.bid; idx < 768; idx += F.G) { if (idx < 256) { TBEGIN(F, 40); ssd_passC_unit(F, idx); TEND(F, 40); } else { TBEGIN(F, 41); gla_passC_unit(F, idx - 256); TEND(F, 41); } }
    TBEGIN(F, 42);
    const int gt = F.bid * NTHR + F.tid, NT = F.G * NTHR;
    for (int i = gt; i < (PB + SB) * 3 * SCH; i += NT) { const int c = i % SCH, j = (i / SCH) % 3, s = i / (3 * SCH);
        const int grp = s >= PB, b = grp ? s - PB : s, L = grp ? SL : PL, row0 = grp ? MP + b * SL : b * PL;
        F.out[(grp ? O_SCONV_S : O_SCONV_P) + ((size_t)b * 3 + j) * SCH + c] = bf2f(F.PROJ[(size_t)(row0 + L - 3 + j) * NP + CX + c]); }
    TEND(F, 42);
}

__device__ __forceinline__ void p4_post_mixer(Frame& F) {
    const int gw = F.bid * NWAVES + F.wave, NGW = F.G * NWAVES, lane = F.lane;
    for (int m = gw; m < M; m += NGW) {
        const f32x4* mr = (const f32x4*)(F.MIX + (size_t)m * DM) + lane; const f32x4* xr = (const f32x4*)x_row(F, m) + lane;
        const f32x4* w1 = (const f32x4*)F.n_mix_post + lane; const f32x4* w2 = (const f32x4*)F.n_ffn_pre + lane;
        f32x4 v[8]; float s = 0.f;
#pragma unroll
        for (int j = 0; j < 8; ++j) { v[j] = mr[64 * j]; s += (v[j].x * v[j].x + v[j].y * v[j].y) + (v[j].z * v[j].z + v[j].w * v[j].w); }
        const float r1 = rsqrtf(wave_sum(s) * (1.f / DM) + EPS); float s2 = 0.f;
        f32x4* ho = (f32x4*)(F.out + O_Y + (size_t)m * DM) + lane;
#pragma unroll
        for (int j = 0; j < 8; ++j) { v[j] = xr[64 * j] + v[j] * r1 * w1[64 * j]; ho[64 * j] = v[j]; s2 += (v[j].x * v[j].x + v[j].y * v[j].y) + (v[j].z * v[j].z + v[j].w * v[j].w); }
        const float r2 = rsqrtf(wave_sum(s2) * (1.f / DM) + EPS);
        v2u* o8 = (v2u*)(F.XN + (size_t)m * DM) + lane;
#pragma unroll
        for (int j = 0; j < 8; ++j) { const f32x4 ww = w2[64 * j]; v2u o; o.x = pk2(v[j].x * r2 * ww.x, v[j].y * r2 * ww.y); o.y = pk2(v[j].z * r2 * ww.z, v[j].w * r2 * ww.w); o8[64 * j] = o; }
    }
}
__device__ __forceinline__ void p6_conv_fixup(Frame& F) {
    const int gt = F.bid * NTHR + F.tid, NT = F.G * NTHR;
    constexpr int NQ = FF / 4;
    for (int it = gt; it < 28 * 2 * NQ; it += NT) { const int c = (it % NQ) * 4, rr = (it / NQ) & 1, bi = it / (2 * NQ), pm = (bi / 7) * 8 + 1 + (bi % 7);
        f32x4 o[2];
#pragma unroll
        for (int hf = 0; hf < 2; ++hf) { const int cc = hf * FF + c;
            const f32x4 w0 = *(const f32x4*)(F.fconv_w + cc), w1 = *(const f32x4*)(F.fconv_w + FF2 + cc), w2 = *(const f32x4*)(F.fconv_w + 2 * FF2 + cc), bs = *(const f32x4*)(F.fconv_b + cc);
            const f32x4 um2 = *(const f32x4*)(F.HG + ((size_t)(pm - 1) * 4 + 2 + rr) * FF2 + cc);
            const f32x4 um1 = rr ? *(const f32x4*)(F.HG + ((size_t)pm * 4) * FF2 + cc) : *(const f32x4*)(F.HG + ((size_t)(pm - 1) * 4 + 3) * FF2 + cc);
            const f32x4 u0 = *(const f32x4*)(F.HG + ((size_t)pm * 4 + rr) * FF2 + cc);
            o[hf] = bs + w0 * um2 + w1 * um1 + w2 * u0; }
        v2u pk; pk.x = pk2(silu_f(o[0].x) * o[1].x, silu_f(o[0].y) * o[1].y); pk.y = pk2(silu_f(o[0].z) * o[1].z, silu_f(o[0].w) * o[1].w);
        *(v2u*)(F.ACT + (size_t)(pm * 256 + rr) * FF + c) = pk; }
    for (int i = gt; i < PB * 2 * (FF2 / 4); i += NT) { const int c = (i % (FF2 / 4)) * 4, j = (i / (FF2 / 4)) & 1, b = i / (2 * (FF2 / 4));
        *(f32x4*)(F.out + O_FCONV_P + ((size_t)b * 2 + j) * FF2 + c) = *(const f32x4*)(F.HG + ((size_t)(b * 8 + 7) * 4 + 2 + j) * FF2 + c); }
}
__device__ __forceinline__ void p8_final(Frame& F) {
    const int gw = F.bid * NWAVES + F.wave, NGW = F.G * NWAVES, lane = F.lane;
    for (int m = gw; m < M; m += NGW) {
        const f32x4* fr = (const f32x4*)(F.Fb + (size_t)m * DM) + lane; const f32x4* w1 = (const f32x4*)F.n_ffn_post + lane;
        f32x4* ho = (f32x4*)(F.out + O_Y + (size_t)m * DM) + lane;
        f32x4 v[8]; float s = 0.f;
#pragma unroll
        for (int j = 0; j < 8; ++j) { v[j] = fr[64 * j]; s += (v[j].x * v[j].x + v[j].y * v[j].y) + (v[j].z * v[j].z + v[j].w * v[j].w); }
        const float r1 = rsqrtf(wave_sum(s) * (1.f / DM) + EPS);
#pragma unroll
        for (int j = 0; j < 8; ++j) ho[64 * j] = ho[64 * j] + v[j] * r1 * w1[64 * j];
    }
}

__device__ __forceinline__ pg8::SplitCtx split_ctx(const Frame& F, unsigned char* ws, size_t slab_off, int bank) {
    pg8::SplitCtx X; X.slabs = (pg8::f32x4*)(ws + slab_off); X.cnt = (unsigned*)(ws + WS_CTL) + CW_SPLIT + bank * 1024; X.flag = (volatile LAS unsigned*)(F.lds + MISC_OFF) + 16; return X; }

struct Args { const float* in[25]; float* out; unsigned char* ws; int ph_lo, ph_hi; };
__global__ void __launch_bounds__(NTHR, 2) fwd_kernel(Args args) {
    extern __shared__ __attribute__((aligned(16))) unsigned char lds[];
    Frame F;
    F.lds = (LAS unsigned char*)lds;
    F.tid = threadIdx.x; F.lane = F.tid & 63; F.wave = __builtin_amdgcn_readfirstlane(F.tid >> 6);
    F.G = gridDim.x; F.bid = blockIdx.x;
    unsigned char* ws = args.ws;
    F.x_p = args.in[0]; F.x_s = args.in[1]; F.st_gla = args.in[2]; F.st_ssd = args.in[3]; F.st_sconv = args.in[4]; F.st_fconv = args.in[5];
    F.n_mix_pre = args.in[6]; F.n_mix_post = args.in[7]; F.n_ffn_pre = args.in[8]; F.n_ffn_post = args.in[9]; F.w_in = args.in[10];
    F.w_gate2 = args.in[11]; F.b_gate = args.in[12]; F.gla_norm = args.in[13]; F.sconv_w = args.in[14]; F.sconv_b = args.in[15];
    F.dt_bias = args.in[16]; F.A_log = args.in[17]; F.ssd_D = args.in[18]; F.ssd_norm = args.in[19]; F.w_out = args.in[20];
    F.ffn_w_in = args.in[21]; F.fconv_w = args.in[22]; F.fconv_b = args.in[23]; F.ffn_w_out = args.in[24];
    F.out = args.out;
    F.W1 = (bf16*)(ws + WS_W1); F.WO = (bf16*)(ws + WS_WO); F.WF1 = (bf16*)(ws + WS_WF1); F.WF2 = (bf16*)(ws + WS_WF2);
    F.XN = (bf16*)(ws + WS_XN); F.PROJ = (bf16*)(ws + WS_PROJ); F.MIXIN = (bf16*)(ws + WS_MIXIN); F.ACT = (bf16*)(ws + WS_ACT); F.HG = (float*)(ws + WS_HG);
    F.LRDT = (float*)(ws + WS_LRDT); F.MIX = (float*)(ws + WS_MIX); F.Fb = (float*)(ws + WS_F);
    F.DS = (bf16*)(ws + WS_DS); F.SC = (bf16*)(ws + WS_SC); F.DH = (bf16*)(ws + WS_DH); F.HC = (bf16*)(ws + WS_HC); F.EBL = (float*)(ws + WS_EBL); F.AL = (float*)(ws + WS_AL);
    for (int u = F.tid; u < (LDS_BYTES - LDSCTL_OFF) / 4; u += NTHR) ((LAS unsigned*)(F.lds + LDSCTL_OFF))[u] = 0u;
    __syncthreads();
    const int lo = args.ph_lo, hi = args.ph_hi;
#if !MK_PER_PHASE
    XcdBarrier bar = xcd_barrier_post((unsigned*)(ws + WS_CTL) + CW_BAR, (volatile LAS unsigned*)(F.lds + MISC_OFF) + 8);
#define GRID_BAR() do { if (args.ph_hi > 1000) cg::this_grid().sync(); xcd_barrier(bar); } while (0)
#else
#define GRID_BAR() do { } while (0)
#endif
#define IN(k) (lo <= (k) && (k) < hi)
#define SEAM(k) do { if (IN(k) && IN((k) + 1)) GRID_BAR(); } while (0)
    F.tacc = 0; F.tmark = 0;
#define PHASE(k, ...) do { if (IN(k)) { TBEGIN(F, k); if (MK_REP_PHASE == (k)) { __VA_ARGS__; GRID_BAR(); } __VA_ARGS__; SEAM(k); TEND(F, k); } } while (0)
    PHASE(0, p0_prologue(F));
    PHASE(1, { pg8::Gemm g{F.XN, F.W1, M, N1, DM}; pg8::StaticOrder S; S.init(M, N1, DM, F.G, F.bid, 1);
        pg8::EpiBf16 E{F.PROJ, NP, NP / 256, F.LRDT};
        pg8::gemm_phase<pg8::EpiBf16, pg8::StaticOrder, true, true>(F.lds, g, S, E, split_ctx(F, ws, WS_SLAB, 0));
        if (S.rem && F.bid >= S.rem * S.S) p0_convert_rest(F, F.bid - S.rem * S.S, F.G - S.rem * S.S); else if (!S.rem) p0_convert_rest(F, F.bid, F.G); });
    PHASE(2, p2a_chunk_states(F));
    PHASE(3, p2b_scans_and_sample(F));
    PHASE(4, p2c_outputs(F));
    PHASE(5, { pg8::Gemm g{F.MIXIN, F.WO, M, DM, DM}; pg8::StaticOrder S; S.init(M, DM, DM, F.G, F.bid, 8);
        pg8::EpiF32 E{F.MIX, DM};
        pg8::gemm_phase<pg8::EpiF32, pg8::StaticOrder, true, true>(F.lds, g, S, E, split_ctx(F, ws, WS_SLAB, 1)); });
    PHASE(6, p4_post_mixer(F));
    PHASE(7, { pg8::Gemm g{F.XN, F.WF1, M, FF2, DM}; pg8::StaticOrder S; S.init(M, FF2, DM, F.G, F.bid, 1);
        pg8::EpiConvAct E{F.ACT, F.HG, F.fconv_w, F.fconv_b, F.st_fconv, F.out + O_FCONV_S, (LAS float*)(F.lds + MISC_OFF + 512)};
        pg8::gemm_phase<pg8::EpiConvAct, pg8::StaticOrder, true, true>(F.lds, g, S, E, split_ctx(F, ws, WS_SLAB, 2)); });
    PHASE(8, p6_conv_fixup(F));
    PHASE(9, { pg8::Gemm g{F.ACT, F.WF2, M, DM, FF}; pg8::StaticOrder S; S.init(M, DM, FF, F.G, F.bid, 8);
        pg8::EpiF32 E{F.Fb, DM};
        pg8::gemm_phase<pg8::EpiF32, pg8::StaticOrder, true, true>(F.lds, g, S, E, split_ctx(F, ws, WS_SLAB, 3)); });
    if (IN(10)) { TBEGIN(F, 10); p8_final(F); if (MK_TIME_PHASE == 10) { asm volatile("s_waitcnt vmcnt(0)" ::: "memory"); __syncthreads(); } TEND(F, 10); }
    if (MK_TIME_PHASE >= 0 && F.bid == 0) { const unsigned long long te = __builtin_amdgcn_s_memrealtime(), d = 8ull * F.tacc; while (__builtin_amdgcn_s_memrealtime() - te < d) __builtin_amdgcn_s_sleep(16); }
#undef IN
#undef SEAM
}

extern "C" void kernel_launch(void* const* d_in, const int* in_sizes, int n_in, void* d_out, int out_size, void* d_ws, size_t ws_size, hipStream_t stream) {
    static int grid = 0;
    if (grid == 0) {
        if (n_in != 25 || (size_t)out_size != O_END || ws_size < WS_END) { fprintf(stderr, "kernel_launch: unexpected sizes n_in %d out %d ws %zu (need out %zu ws %zu)\n", n_in, out_size, ws_size, (size_t)O_END, (size_t)WS_END); grid = -1; return; }
        int dev = 0, cus = 0, per_cu = 0;
        hipGetDevice(&dev); hipDeviceGetAttribute(&cus, hipDeviceAttributeMultiprocessorCount, dev);
        if (hipFuncSetAttribute((const void*)fwd_kernel, hipFuncAttributeMaxDynamicSharedMemorySize, LDS_BYTES) != hipSuccess) { fprintf(stderr, "kernel_launch: hipFuncSetAttribute failed\n"); grid = -1; return; }
        hipOccupancyMaxActiveBlocksPerMultiprocessor(&per_cu, (const void*)fwd_kernel, NTHR, LDS_BYTES);
        if (per_cu < 1) { fprintf(stderr, "kernel_launch: occupancy query says %d blocks per CU\n", per_cu); grid = -1; return; }
        grid = cus;
        (void)hipGetLastError();
    }
    if (grid < 0) return;
    Args a{};
    for (int i = 0; i < 25; ++i) a.in[i] = (const float*)d_in[i];
    a.out = (float*)d_out; a.ws = (unsigned char*)d_ws;
#if MK_PER_PHASE
    hipMemsetAsync((char*)d_ws + WS_CTL, 0, CTL_ZERO_BYTES, stream);
    for (int p = 0; p < N_PHASES; ++p) { a.ph_lo = p; a.ph_hi = p + 1; hipLaunchKernelGGL(fwd_kernel, dim3(grid), dim3(NTHR), LDS_BYTES, stream, a); }
#else
    hipMemsetAsync((char*)d_ws + WS_CTL, 0, CTL_ZERO_BYTES, stream);
    a.ph_lo = 0; a.ph_hi = N_PHASES;
    void* kargs[] = {&a};
    hipError_t e = hipLaunchCooperativeKernel((const void*)fwd_kernel, dim3(grid), dim3(NTHR), kargs, LDS_BYTES, stream);
    if (e != hipSuccess) fprintf(stderr, "kernel_launch: cooperative launch failed: %s (grid %d)\n", hipGetErrorString(e), grid);
#endif
}
```

```cpp
#include <hip/hip_runtime.h>
#include <hip/hip_cooperative_groups.h>
#include <cstdio>
#include <cstdint>
namespace cg = cooperative_groups;

#ifndef MK_PER_PHASE
#define MK_PER_PHASE 0
#endif

namespace pg8 {
#define PG8_LAS __attribute__((address_space(3)))
typedef unsigned short bf16_t;
typedef short bf16x8 __attribute__((ext_vector_type(8)));
typedef float f32x4 __attribute__((ext_vector_type(4)));
typedef unsigned u32x4 __attribute__((ext_vector_type(4)));
constexpr int BM = 256, BK = 64, HALF = 128, HTB = HALF * BK * 2  , STAGE_BYTES = 8 * HTB, NXCD = 8, WGM = 8;

__host__ __device__ __forceinline__ int lds_byte(int r, int c) { const int st = (r >> 4) * 2 + (c >> 5), rr = r & 15, cc = c & 31, ob = rr * 64 + cc * 2; return st * 1024 + (ob ^ (((ob >> 9) & 1) << 5)); }
__host__ __device__ __forceinline__ void stage_rc(int b, int& R, int& C) { const int st = b / 1024, sb = b % 1024, swz = sb ^ (((sb >> 9) & 1) << 5); R = (st >> 1) * 16 + swz / 64; C = (st & 1) * 32 + (swz % 64) / 2; }
__host__ __device__ __forceinline__ int perm32(int rho) { const int n = rho >> 4, i = rho & 15; return 8 * (i >> 2) + 4 * n + (i & 3); }

struct Unit { int pm, pn, k0, nk, slice, nsl, tix; };
struct Gemm { const bf16_t* A; const bf16_t* Bt; int M, N, K; };

struct StaticOrder {
    int nM, nN, nwg, G, c, rounds, rem, S, ntK;
    __host__ __device__ __forceinline__ void init(int M, int N, int K, int G_, int c_, int Smax) { nM = M / BM; nN = N / BM; nwg = nM * nN; G = G_; c = c_; ntK = K / BK; rounds = nwg / G; rem = nwg - rounds * G; S = 1;
        if (rem) { while (S < Smax && rem * (S * 2) <= G && (ntK / 2) >= S * 2) S *= 2; } }
    __host__ __device__ __forceinline__ void tile(int L, Unit& u) const {
        int wgid = L; { const int q = nwg / NXCD, r = nwg % NXCD, xcd = wgid % NXCD, off = wgid / NXCD; wgid = (xcd < r ? xcd * (q + 1) : r * (q + 1) + (xcd - r) * q) + off; }
        const int nig = WGM * nN, gid = wgid / nig, fm = gid * WGM, gsz = (nM - fm) < WGM ? (nM - fm) : WGM;
        u.pm = fm + ((wgid % nig) % gsz); u.pn = (wgid % nig) / gsz; }
    __host__ __device__ __forceinline__ bool next(int i, Unit& u) const {
        if (i < rounds) { tile(i * G + c, u); u.k0 = 0; u.nk = ntK; u.slice = 0; u.nsl = 1; u.tix = 0; return true; }
        if (i == rounds && c < rem * S) { const int tix = c % rem, sl = c / rem; tile(rounds * G + tix, u);
            const int pairs = ntK / 2, base = pairs / S, extra = pairs % S, np = base + (sl < extra ? 1 : 0), p0 = sl * base + (sl < extra ? sl : extra);
            u.k0 = 2 * p0; u.nk = 2 * np; u.slice = sl; u.nsl = S; u.tix = tix; return true; }
        return false;
    }
    __device__ __forceinline__ void a_ready(const Unit&) const {}
    __device__ __forceinline__ void done(const Unit&) const {}
};
struct SplitCtx { f32x4* slabs; unsigned* cnt; volatile PG8_LAS unsigned* flag; };
__device__ __forceinline__ int split_reduce(f32x4 (&acc)[2][2][4][2], const Unit& u, const SplitCtx& X, int tid) {
    const __amdgpu_buffer_rsrc_t rs = __builtin_amdgcn_make_buffer_rsrc((void*)X.slabs, (short)0, (int)0x7fffffff, 0x00020000);
    const unsigned mine = (unsigned)((u.tix * u.nsl + u.slice) * 32) * 8192u + (unsigned)tid * 16u;
#pragma unroll
    for (int a = 0; a < 2; ++a)
#pragma unroll
        for (int b = 0; b < 2; ++b)
#pragma unroll
            for (int m = 0; m < 4; ++m)
#pragma unroll
                for (int n = 0; n < 2; ++n) __builtin_amdgcn_raw_buffer_store_b128(__builtin_bit_cast(u32x4, acc[a][b][m][n]), rs, mine + (unsigned)((((a * 2 + b) * 4 + m) * 2 + n) * 8192), 0,   16);
    asm volatile("s_waitcnt vmcnt(0)" ::: "memory");
    __syncthreads();
    if (tid == 0) {
        unsigned* c = X.cnt + 16 * u.tix;
        (void)__hip_atomic_fetch_add(c, 1u, __ATOMIC_RELAXED, __HIP_MEMORY_SCOPE_AGENT);
        unsigned spins = 0;
        while (__hip_atomic_load(c, __ATOMIC_RELAXED, __HIP_MEMORY_SCOPE_AGENT) < (unsigned)u.nsl) { __builtin_amdgcn_s_sleep(2); if (++spins > (1u << 22)) break; }
        __builtin_amdgcn_fence(__ATOMIC_ACQUIRE, "agent");
        asm volatile("s_waitcnt vmcnt(0)" ::: "memory");
    }
    __syncthreads();
    const int shift = u.nsl == 8 ? 2 : (u.nsl == 4 ? 3 : 4);
    for (int s = 0; s < u.nsl; ++s) { if (s == u.slice) continue;
        const f32x4* o = X.slabs + ((size_t)(u.tix * u.nsl + s) * 32) * 512 + tid;
#pragma unroll
        for (int a = 0; a < 2; ++a)
#pragma unroll
            for (int b = 0; b < 2; ++b)
#pragma unroll
                for (int m = 0; m < 4; ++m)
#pragma unroll
                    for (int n = 0; n < 2; ++n) { const int r4 = ((a * 2 + b) * 4 + m) * 2 + n; if ((r4 >> shift) == u.slice) acc[a][b][m][n] += o[(size_t)r4 * 512]; } }
    return shift;
}

__device__ __forceinline__ unsigned cvt_pk_bf16(float lo, float hi) { unsigned r; asm volatile("v_cvt_pk_bf16_f32 %0, %1, %2" : "=v"(r) : "v"(lo), "v"(hi)); return r; }

struct EpiF32 {
    static constexpr bool PERM = false, AFTER_DRAIN = false;
    float* C; int ldc;
    __device__ __forceinline__ void operator()(const f32x4 (&acc)[2][2][4][2], const Unit& u, int wr, int wc, int fr, int fq, int shift, int part) const {
        const int row0 = u.pm * BM + wr * 64 + fr, col0 = u.pn * BM + wc * 32 + 4 * fq;
#pragma unroll
        for (int ai = 0; ai < 2; ++ai)
#pragma unroll
            for (int m = 0; m < 4; ++m) { float* rowp = C + (size_t)(row0 + ai * HALF + m * 16) * ldc + col0;
#pragma unroll
                for (int bj = 0; bj < 2; ++bj)
#pragma unroll
                    for (int n = 0; n < 2; ++n) if ((((((ai * 2 + bj) * 4 + m) * 2 + n)) >> shift) == part) *(f32x4*)(rowp + bj * HALF + n * 16) = acc[ai][bj][m][n]; }
    }
};
struct EpiBf16 {
    static constexpr bool PERM = true, AFTER_DRAIN = false;
    bf16_t* O; int ldc; int nfull; float* X;
    __device__ __forceinline__ void operator()(const f32x4 (&acc)[2][2][4][2], const Unit& u, int wr, int wc, int fr, int fq, int shift, int part) const {
        const int row0 = u.pm * BM + wr * 64 + fr;
        if (u.pn < nfull) {
            const int col0 = u.pn * BM + wc * 32 + 8 * fq;
#pragma unroll
            for (int ai = 0; ai < 2; ++ai)
#pragma unroll
                for (int m = 0; m < 4; ++m) { bf16_t* rowp = O + (size_t)(row0 + ai * HALF + m * 16) * ldc + col0;
#pragma unroll
                    for (int bj = 0; bj < 2; ++bj) { if ((((((ai * 2 + bj) * 4 + m) * 2)) >> shift) != part) continue; const f32x4 v0 = acc[ai][bj][m][0], v1 = acc[ai][bj][m][1];
                        u32x4 w; w.x = cvt_pk_bf16(v0[0], v0[1]); w.y = cvt_pk_bf16(v0[2], v0[3]); w.z = cvt_pk_bf16(v1[0], v1[1]); w.w = cvt_pk_bf16(v1[2], v1[3]);
                        *(u32x4*)(rowp + bj * HALF) = w; } }
        } else if (wc == 0) {
#pragma unroll
            for (int ai = 0; ai < 2; ++ai)
#pragma unroll
                for (int m = 0; m < 4; ++m) { if ((((((ai * 2) * 4 + m) * 2)) >> shift) != part) continue; float* rowp = X + (size_t)(row0 + ai * HALF + m * 16) * 32 + 8 * fq;
                    *(f32x4*)(rowp) = acc[ai][0][m][0]; *(f32x4*)(rowp + 4) = acc[ai][0][m][1]; }
        }
    }
};

__device__ __forceinline__ float dpp_ror1(float x) { return __builtin_bit_cast(float, __builtin_amdgcn_update_dpp(0, __builtin_bit_cast(int, x), 0x121, 0xF, 0xF, false)); }
__device__ __forceinline__ float dpp_ror2(float x) { return __builtin_bit_cast(float, __builtin_amdgcn_update_dpp(0, __builtin_bit_cast(int, x), 0x122, 0xF, 0xF, false)); }
struct EpiConvAct {
    static constexpr bool PERM = true, AFTER_DRAIN = false;
    static constexpr int FFD = 5632, FFD2 = 11264, MPR = 8192, NPT = 32;
    bf16_t* ACT; float* HG; const float* cw; const float* cbias; const float* st; float* fconv_s; PG8_LAS float* halo;
    __device__ __forceinline__ void operator()(const f32x4 (&acc)[2][2][4][2], const Unit& u, int wr, int wc, int fr, int fq, int, int) const {
        if (u.pm >= NPT) body<true>(acc, u, wr, wc, fr, fq); else body<false>(acc, u, wr, wc, fr, fq); }
    template <bool sample> __device__ __forceinline__ void body(const f32x4 (&acc)[2][2][4][2], const Unit& u, int wr, int wc, int fr, int fq) const {
        const int pm = u.pm, pn = u.pn, cl = wc * 32 + 8 * fq, c0 = pn * 128 + cl;
        if (fr >= 14) {
#pragma unroll
            for (int ai = 0; ai < 2; ++ai)
#pragma unroll
                for (int bj = 0; bj < 2; ++bj)
#pragma unroll
                    for (int n = 0; n < 2; ++n) *(PG8_LAS f32x4*)(halo + ((ai * 2 + wr) * 2 + (fr - 14)) * 256 + bj * 128 + cl + 4 * n) = acc[ai][bj][3][n];
            if (!sample && wr == 1) {
#pragma unroll
                for (int bj = 0; bj < 2; ++bj)
#pragma unroll
                    for (int n = 0; n < 2; ++n) *(f32x4*)(HG + ((size_t)pm * 4 + 2 + (fr - 14)) * FFD2 + bj * FFD + c0 + 4 * n) = acc[1][bj][3][n]; }
        }
        if (fr < 2 && !sample && wr == 0) {
#pragma unroll
            for (int bj = 0; bj < 2; ++bj)
#pragma unroll
                for (int n = 0; n < 2; ++n) *(f32x4*)(HG + ((size_t)pm * 4 + fr) * FFD2 + bj * FFD + c0 + 4 * n) = acc[0][bj][0][n]; }
        __syncthreads();
        const int t8 = fr & 7;
        typedef unsigned u32x2 __attribute__((ext_vector_type(2)));
        u32x2 pk0[2][4];
#pragma unroll
        for (int n = 0; n < 2; ++n) {
            f32x4 w[2][3], bs[2];
#pragma unroll
            for (int bj = 0; bj < 2; ++bj) { bs[bj] = *(const f32x4*)(cbias + bj * FFD + c0 + 4 * n);
#pragma unroll
                for (int j = 0; j < 3; ++j) w[bj][j] = *(const f32x4*)(cw + j * FFD2 + bj * FFD + c0 + 4 * n); }
#pragma unroll
            for (int ai = 0; ai < 2; ++ai) {
                f32x4 r1p[2], r2p[2];
#pragma unroll
                for (int bj = 0; bj < 2; ++bj) { f32x4 pv = (f32x4){0.f, 0.f, 0.f, 0.f};
                    if (fr >= 14 && (wr == 1 || ai == 1)) { const int pa = (wr == 1) ? ai : 0, pw = (wr == 1) ? 0 : 1; pv = *(const PG8_LAS f32x4*)(halo + ((pa * 2 + pw) * 2 + (fr - 14)) * 256 + bj * 128 + cl + 4 * n); }
#pragma unroll
                    for (int j = 0; j < 4; ++j) { r1p[bj][j] = dpp_ror1(pv[j]); r2p[bj][j] = dpp_ror2(pv[j]); } }
#pragma unroll
                for (int m = 0; m < 4; ++m) { const int row = pm * BM + ai * HALF + wr * 64 + m * 16 + fr;
                    f32x4 o[2];
#pragma unroll
                    for (int bj = 0; bj < 2; ++bj) { const f32x4 cur = acc[ai][bj][m][n]; f32x4 p1, p2;
#pragma unroll
                        for (int j = 0; j < 4; ++j) { const float c1 = dpp_ror1(cur[j]), c2 = dpp_ror2(cur[j]); p1[j] = (fr == 0) ? r1p[bj][j] : c1; p2[j] = (fr < 2) ? r2p[bj][j] : c2; r1p[bj][j] = c1; r2p[bj][j] = c2; }
                        if (sample && t8 < 2) { const int sb = (row - MPR) >> 3; const f32x4 s1 = *(const f32x4*)(st + ((size_t)sb * 2 + 1) * FFD2 + bj * FFD + c0 + 4 * n);
                            if (t8 == 0) { p1 = s1; p2 = *(const f32x4*)(st + ((size_t)sb * 2) * FFD2 + bj * FFD + c0 + 4 * n); } else p2 = s1; }
                        o[bj] = bs[bj] + w[bj][0] * p2 + w[bj][1] * p1 + w[bj][2] * cur; }
                    f32x4 g; g.x = o[0].x * __builtin_amdgcn_rcpf(1.f + __expf(-o[0].x)) * o[1].x; g.y = o[0].y * __builtin_amdgcn_rcpf(1.f + __expf(-o[0].y)) * o[1].y;
                    g.z = o[0].z * __builtin_amdgcn_rcpf(1.f + __expf(-o[0].z)) * o[1].z; g.w = o[0].w * __builtin_amdgcn_rcpf(1.f + __expf(-o[0].w)) * o[1].w;
                    const u32x2 pk = (u32x2){cvt_pk_bf16(g.x, g.y), cvt_pk_bf16(g.z, g.w)};
                    if (n == 0) pk0[ai][m] = pk;
                    else *(u32x4*)(ACT + (size_t)row * FFD + c0) = (u32x4){pk0[ai][m].x, pk0[ai][m].y, pk.x, pk.y};
                    if (sample && t8 >= 6) { const int sb = (row - MPR) >> 3;
#pragma unroll
                        for (int bj = 0; bj < 2; ++bj) *(f32x4*)(fconv_s + ((size_t)sb * 2 + (t8 - 6)) * FFD2 + bj * FFD + c0 + 4 * n) = acc[ai][bj][m][n]; }
                }
            }
        }
    }
};

template <class Epi, class Sched, bool ALIGN_EPI = false, bool SP2 = false>
__device__ __forceinline__ void gemm_phase(PG8_LAS unsigned char* lds, const Gemm g, const Sched& S, const Epi& E, const SplitCtx& X) {
    const int tid = threadIdx.x, wid = __builtin_amdgcn_readfirstlane(tid >> 6), lane = tid & 63, wr = wid >> 2, wc = wid & 3, fr = lane & 15, fq = lane >> 4;
    const int K = g.K;
    unsigned voffA[2], voffB[2];
#pragma unroll
    for (int i = 0; i < 2; ++i) { int R, C; stage_rc(tid * 16 + i * 8192, R, C); const int Rb = Epi::PERM ? ((R & ~31) + perm32(R & 31)) : R;
        voffA[i] = (unsigned)(R * K + C) * 2u; voffB[i] = (unsigned)(Rb * K + C) * 2u; }
    const size_t kstep = (size_t)(BK * 2);
    const size_t hstep = (size_t)HALF * K * 2;
    const size_t tstep = 2 * hstep;
    const unsigned ldsw = (unsigned)wid * 1024u;
    const int aoff = lds_byte(wr * 64 + fr, fq * 8), boff = lds_byte(wc * 32 + fr, fq * 8);
#define PG8_SA(b, h) (((b) * 2 + (h)) * HTB)
#define PG8_SB(b, h) ((4 + (b) * 2 + (h)) * HTB)
#define PG8_STAGE(bufoff, gbase, voff) do { _Pragma("unroll") for (int _i = 0; _i < 2; ++_i) \
        __builtin_amdgcn_global_load_lds((const unsigned*)((const char*)(gbase) + (voff)[_i]), (PG8_LAS unsigned*)(lds + (bufoff) + ldsw + _i * 8192), 16, 0, 0); } while (0)
#define PG8_LDA(dst, b, h) do { _Pragma("unroll") for (int m = 0; m < 4; ++m) _Pragma("unroll") for (int k = 0; k < 2; ++k) dst[m][k] = *(const PG8_LAS bf16x8*)(lds + PG8_SA(b, h) + aoff + m * 2048 + k * 1024); } while (0)
#define PG8_LDB(dst, b, h) do { _Pragma("unroll") for (int n = 0; n < 2; ++n) _Pragma("unroll") for (int k = 0; k < 2; ++k) dst[n][k] = *(const PG8_LAS bf16x8*)(lds + PG8_SB(b, h) + boff + n * 2048 + k * 1024); } while (0)
#define PG8_MMA(ai, bj, At, Bt) do { __builtin_amdgcn_s_setprio(1); _Pragma("unroll") for (int m = 0; m < 4; ++m) _Pragma("unroll") for (int n = 0; n < 2; ++n) _Pragma("unroll") for (int k = 0; k < 2; ++k) \
        acc[ai][bj][m][n] = __builtin_amdgcn_mfma_f32_16x16x32_bf16(Bt[n][k], At[m][k], acc[ai][bj][m][n], 0, 0, 0); __builtin_amdgcn_s_setprio(0); } while (0)
#define PG8_WAIT_V(n) asm volatile("s_waitcnt vmcnt(" #n ")" ::: "memory")
#define PG8_WAIT_L(n) asm volatile("s_waitcnt lgkmcnt(" #n ")" ::: "memory")
#define PG8_BAR __builtin_amdgcn_s_barrier()
#define PG8_SCHED __builtin_amdgcn_sched_barrier(0)
    Unit cur, nxt; int ui = 0;
    if (!S.next(0, cur)) return;
    f32x4 acc[2][2][4][2];
#pragma unroll
    for (int a = 0; a < 2; ++a)
#pragma unroll
        for (int b = 0; b < 2; ++b)
#pragma unroll
            for (int m = 0; m < 4; ++m)
#pragma unroll
                for (int n = 0; n < 2; ++n) acc[a][b][m][n] = (f32x4){0.f, 0.f, 0.f, 0.f};
    bf16x8 At[4][2], B0[2][2], B1[2][2];
    const char* cA = (const char*)g.A + (size_t)cur.pm * tstep + (size_t)cur.k0 * kstep; const char* cB = (const char*)g.Bt + (size_t)cur.pn * tstep + (size_t)cur.k0 * kstep;
    S.a_ready(cur);
    if constexpr (SP2) {
        PG8_STAGE(PG8_SB(0, 0), cB, voffB); PG8_STAGE(PG8_SB(0, 1), cB + hstep, voffB); PG8_STAGE(PG8_SA(0, 0), cA, voffA); PG8_STAGE(PG8_SA(0, 1), cA + hstep, voffA);
        if (wr == 1) PG8_BAR;
        PG8_WAIT_V(2); PG8_BAR;
        PG8_STAGE(PG8_SB(1, 0), cB + kstep, voffB); PG8_STAGE(PG8_SA(1, 0), cA + kstep, voffA); PG8_STAGE(PG8_SB(1, 1), cB + hstep + kstep, voffB);
        PG8_WAIT_V(6); PG8_BAR;
    } else {
        PG8_STAGE(PG8_SB(0, 0), cB, voffB); PG8_STAGE(PG8_SA(0, 0), cA, voffA); PG8_STAGE(PG8_SB(0, 1), cB + hstep, voffB); PG8_STAGE(PG8_SA(0, 1), cA + hstep, voffA);
        if (wr == 1) PG8_BAR;
        PG8_WAIT_V(4); PG8_BAR;
        PG8_STAGE(PG8_SB(1, 0), cB + kstep, voffB); PG8_STAGE(PG8_SA(1, 0), cA + kstep, voffA); PG8_STAGE(PG8_SB(1, 1), cB + hstep + kstep, voffB);
        PG8_WAIT_V(6); PG8_BAR;
    }
    for (;;) {
        const bool has_next = S.next(ui + 1, nxt);
        const char* nA = has_next ? (const char*)g.A + (size_t)nxt.pm * tstep + (size_t)nxt.k0 * kstep : cA; const char* nB = has_next ? (const char*)g.Bt + (size_t)nxt.pn * tstep + (size_t)nxt.k0 * kstep : cB;
        const int nt = cur.nk;
        for (int t = 0; t < nt; t += 2) {
            const bool last = (t == nt - 2);
            const char* a1 = cA + (size_t)(t + 1) * kstep;
            const char* a2 = last ? nA : cA + (size_t)(t + 2) * kstep; const char* b2 = last ? nB : cB + (size_t)(t + 2) * kstep;
            const char* a3 = a2 + kstep; const char* b3 = b2 + kstep;
            if (last && has_next) S.a_ready(nxt);
            if constexpr (SP2) {
            PG8_LDB(B0, 0, 0); PG8_LDB(B1, 0, 1); PG8_SCHED; PG8_LDA(At, 0, 0); PG8_STAGE(PG8_SA(1, 1), a1 + hstep, voffA);
            PG8_WAIT_V(8); PG8_WAIT_L(0); PG8_BAR; PG8_MMA(0, 0, At, B0); PG8_MMA(0, 1, At, B1); PG8_BAR; PG8_SCHED;
            PG8_LDA(At, 0, 1); PG8_STAGE(PG8_SB(0, 0), b2, voffB); PG8_STAGE(PG8_SB(0, 1), b2 + hstep, voffB); PG8_STAGE(PG8_SA(0, 0), a2, voffA);
            PG8_WAIT_V(8); PG8_WAIT_L(0); PG8_BAR; PG8_MMA(1, 0, At, B0); PG8_MMA(1, 1, At, B1); PG8_BAR; PG8_SCHED;
            PG8_LDB(B0, 1, 0); PG8_LDB(B1, 1, 1); PG8_SCHED; PG8_LDA(At, 1, 0); PG8_STAGE(PG8_SA(0, 1), a2 + hstep, voffA);
            PG8_WAIT_V(8); PG8_WAIT_L(0); PG8_BAR; PG8_MMA(0, 0, At, B0); PG8_MMA(0, 1, At, B1); PG8_BAR; PG8_SCHED;
            PG8_LDA(At, 1, 1); PG8_STAGE(PG8_SB(1, 0), b3, voffB); PG8_STAGE(PG8_SB(1, 1), b3 + hstep, voffB); PG8_STAGE(PG8_SA(1, 0), a3, voffA);
            PG8_WAIT_V(8); PG8_WAIT_L(0); PG8_BAR; PG8_MMA(1, 0, At, B0); PG8_MMA(1, 1, At, B1); PG8_BAR; PG8_SCHED;
            } else {
            PG8_LDB(B0, 0, 0); PG8_SCHED; PG8_LDA(At, 0, 0); PG8_STAGE(PG8_SA(1, 1), a1 + hstep, voffA);
            PG8_WAIT_L(8); PG8_BAR; PG8_WAIT_L(0); PG8_MMA(0, 0, At, B0); PG8_BAR; PG8_SCHED;
            PG8_LDB(B1, 0, 1); PG8_STAGE(PG8_SB(0, 0), b2, voffB);
            PG8_BAR; PG8_WAIT_L(0); PG8_MMA(0, 1, At, B1); PG8_BAR;
            PG8_LDA(At, 0, 1); PG8_STAGE(PG8_SA(0, 0), a2, voffA);
            PG8_BAR; PG8_WAIT_L(0); PG8_MMA(1, 0, At, B0); PG8_BAR; PG8_SCHED;
            PG8_STAGE(PG8_SB(0, 1), b2 + hstep, voffB);
            PG8_WAIT_V(6); PG8_BAR; PG8_MMA(1, 1, At, B1); PG8_BAR;
            PG8_LDB(B0, 1, 0); PG8_SCHED; PG8_LDA(At, 1, 0); PG8_STAGE(PG8_SA(0, 1), a2 + hstep, voffA);
            PG8_WAIT_L(8); PG8_BAR; PG8_WAIT_L(0); PG8_MMA(0, 0, At, B0); PG8_BAR; PG8_SCHED;
            PG8_LDB(B1, 1, 1); PG8_STAGE(PG8_SB(1, 0), b3, voffB);
            PG8_BAR; PG8_WAIT_L(0); PG8_MMA(0, 1, At, B1); PG8_BAR;
            PG8_LDA(At, 1, 1); PG8_STAGE(PG8_SA(1, 0), a3, voffA);
            PG8_BAR; PG8_WAIT_L(0); PG8_MMA(1, 0, At, B0); PG8_BAR; PG8_SCHED;
            PG8_STAGE(PG8_SB(1, 1), b3 + hstep, voffB);
            PG8_WAIT_V(6); PG8_BAR; PG8_MMA(1, 1, At, B1); PG8_BAR;
            }
        }
        if constexpr (ALIGN_EPI) { if (wr == 0) PG8_BAR; }
        if constexpr (!Epi::AFTER_DRAIN) { static_assert(ALIGN_EPI, "split_reduce needs the halves aligned"); if (cur.nsl > 1) { const int shift = split_reduce(acc, cur, X, tid); E(acc, cur, wr, wc, fr, fq, shift, cur.slice); } else E(acc, cur, wr, wc, fr, fq, 5, 0); S.done(cur); }
        if (!has_next) break;
#pragma unroll
        for (int a = 0; a < 2; ++a)
#pragma unroll
            for (int b = 0; b < 2; ++b)
#pragma unroll
                for (int m = 0; m < 4; ++m)
#pragma unroll
                    for (int n = 0; n < 2; ++n) acc[a][b][m][n] = (f32x4){0.f, 0.f, 0.f, 0.f};
        cur = nxt; cA = nA; cB = nB; ++ui;
        if constexpr (ALIGN_EPI) { if (wr == 1) PG8_BAR; }
    }
    PG8_WAIT_V(0);
    if constexpr (!ALIGN_EPI) { if (wr == 0) PG8_BAR; }
    PG8_BAR;
    if constexpr (Epi::AFTER_DRAIN) { E.fused(acc, cur, wr, wc, fr, fq, lds, wid, lane); S.done(cur); }
#undef PG8_SA
#undef PG8_SB
#undef PG8_STAGE
#undef PG8_LDA
#undef PG8_LDB
#undef PG8_MMA
#undef PG8_WAIT_V
#undef PG8_WAIT_L
#undef PG8_BAR
#undef PG8_SCHED
}
}

constexpr int NWAVES = 8, NTHR = 512;
constexpr int DM = 2048, PB = 4, PL = 2048, SB = 128, SL = 8;
constexpr int MP = PB * PL, MS = SB * SL, M = MP + MS;
constexpr int GH = 4, GK = 128, GV = 256, GKD = 512, LOWR = 16;
constexpr int SH = 16, SP = 64, SN = 128, SG = 2, SCH = 1536;
constexpr int FF = 5632, FF2 = 11264, INC = 5664;
constexpr int N1 = 5888, NP = 5632;
constexpr int CQ = 0, CK = 512, CV = 1024, CG = 2048, CZ = 3072, CX = 4096;
constexpr float EPS = 1e-6f;
constexpr int N_PHASES = 11;

constexpr size_t O_Y = 0, O_GLA_P = (size_t)M * DM, O_SSD_P = O_GLA_P + (size_t)PB * GH * GK * GV, O_SCONV_P = O_SSD_P + (size_t)PB * SH * SP * SN,
                 O_FCONV_P = O_SCONV_P + (size_t)PB * 3 * SCH, O_GLA_S = O_FCONV_P + (size_t)PB * 2 * FF2, O_SSD_S = O_GLA_S + (size_t)SB * GH * GK * GV,
                 O_SCONV_S = O_SSD_S + (size_t)SB * SH * SP * SN, O_FCONV_S = O_SCONV_S + (size_t)SB * 3 * SCH, O_END = O_FCONV_S + (size_t)SB * 2 * FF2;

constexpr size_t MiB = 1u << 20;
constexpr size_t WS_CTL = 0, CTL_ZERO_BYTES = 64 * 1024;
constexpr size_t WS_WF2 = 1 * MiB;
constexpr size_t WS_W1 = 24 * MiB;
constexpr size_t WS_WO = 48 * MiB;
constexpr size_t WS_WF1 = 56 * MiB;
constexpr size_t WS_XN = 101 * MiB;
constexpr size_t WS_F = 24 * MiB;
constexpr size_t WS_BIG = 141 * MiB;
constexpr size_t WS_PROJ = WS_BIG;
constexpr size_t WS_MIX = WS_BIG;
constexpr size_t WS_ACT = WS_BIG;
constexpr size_t WS_HG = WS_BIG + 104 * MiB;
constexpr size_t WS_LRDT = WS_BIG + 100 * MiB;
constexpr size_t WS_MIXIN = WS_BIG + 104 * MiB;
constexpr size_t WS_DS = WS_XN;
constexpr size_t WS_SC = WS_BIG + 140 * MiB, WS_DH = WS_BIG + 172 * MiB, WS_HC = WS_BIG + 204 * MiB;
constexpr size_t WS_EBL = WS_BIG + 236 * MiB, WS_AL = WS_EBL + 512 * 1024;
constexpr size_t WS_SLAB = WS_BIG + 140 * MiB;
constexpr size_t WS_SLAB_F1 = WS_BIG + 198 * MiB;
constexpr size_t WS_END = WS_BIG + 247 * MiB;
static_assert(WS_WF2 + (size_t)DM * FF * 2 <= WS_W1 && WS_W1 + (size_t)N1 * DM * 2 <= WS_WO && WS_WO + (size_t)DM * DM * 2 <= WS_WF1 && WS_WF1 + (size_t)FF2 * DM * 2 <= WS_XN && WS_XN + (size_t)M * DM * 2 <= WS_BIG, "ws map 1");
static_assert(WS_F + (size_t)M * DM * 4 <= WS_XN && WS_ACT + (size_t)M * FF * 2 <= WS_HG && WS_PROJ + (size_t)M * NP * 2 <= WS_LRDT && WS_LRDT + (size_t)M * 32 * 4 <= WS_MIXIN && WS_MIXIN + (size_t)M * DM * 2 <= WS_SC && WS_HG + (size_t)32 * 4 * FF2 * 4 <= WS_SC && WS_MIX + (size_t)M * DM * 4 <= WS_LRDT, "ws map 2");
constexpr int CW_BAR = 1024;
constexpr int CW_SPLIT = 8192;

constexpr int RING_BYTES = 131072;
constexpr int SCRATCH_BYTES = 8 * 16640;
constexpr int LDSCTL_OFF = 133632, MISC_OFF = LDSCTL_OFF + 320;
constexpr int LDS_BYTES = 150016;

#ifndef MK_TIME_PHASE
#define MK_TIME_PHASE (-1)
#endif
#define TBEGIN(F, id) do { if (MK_TIME_PHASE == (id)) (F).tmark = __builtin_amdgcn_s_memrealtime(); } while (0)
#define TEND(F, id) do { if (MK_TIME_PHASE == (id)) (F).tacc += __builtin_amdgcn_s_memrealtime() - (F).tmark; } while (0)
#define GAS __attribute__((address_space(1)))
#define LAS __attribute__((address_space(3)))
typedef unsigned short bf16;
typedef unsigned v4u __attribute__((ext_vector_type(4)));
typedef unsigned v2u __attribute__((ext_vector_type(2)));
typedef float f32x4 __attribute__((ext_vector_type(4)));
#define LDS_WAIT() asm volatile("s_waitcnt lgkmcnt(0)" ::: "memory")
#define VM_WAIT() asm volatile("s_waitcnt vmcnt(0)" ::: "memory")
__device__ __forceinline__ unsigned f2bf(float f) { unsigned u = __builtin_bit_cast(unsigned, f); return (u + 0x7fffu + ((u >> 16) & 1u)) >> 16; }
__device__ __forceinline__ unsigned pk2(float lo, float hi) { return f2bf(lo) | (f2bf(hi) << 16); }
__device__ __forceinline__ float bf2f(unsigned short b) { return __builtin_bit_cast(float, (unsigned)b << 16); }
__device__ __forceinline__ float bflo(unsigned w) { return __builtin_bit_cast(float, w << 16); }
__device__ __forceinline__ float bfhi(unsigned w) { return __builtin_bit_cast(float, w & 0xffff0000u); }
__device__ __forceinline__ float silu_f(float x) { return x * __builtin_amdgcn_rcpf(1.f + __expf(-x)); }
__device__ __forceinline__ float softplus_f(float x) { return fmaxf(x, 0.f) + __logf(1.f + __expf(-fabsf(x))); }
__device__ __forceinline__ float logsigmoid_f(float x) { return fminf(x, 0.f) - __logf(1.f + __expf(-fabsf(x))); }
__device__ __forceinline__ float wave_sum(float v) {
#pragma unroll
    for (int o = 1; o < 64; o <<= 1) v += __shfl_xor(v, o);
    return v;
}

#define XB_TMO      128
#define XB_XCNT(j)  (256  + 64 * (j))
#define XB_XSUB(j)  (1280 + 64 * (j))
#define XB_XGEN(j)  (2304 + 64 * (j))
#define XB_TOP      3328
#define XB_TOPGEN   3392
#define XCD_BAR_WORDS 3456
#define XB_SPIN_CAP (1u << 18)

__device__ __forceinline__ unsigned xb_ld(unsigned* p)              { return __hip_atomic_load(p, __ATOMIC_RELAXED, __HIP_MEMORY_SCOPE_AGENT); }
__device__ __forceinline__ unsigned xb_add(unsigned* p, unsigned v) { return __hip_atomic_fetch_add(p, v, __ATOMIC_RELAXED, __HIP_MEMORY_SCOPE_AGENT); }
__device__ __forceinline__ unsigned xb_xcc_id() { return (unsigned)__builtin_amdgcn_s_getreg((3 << 11) | 20) & 0xFu; }
#define XB_SPIN(cond, bar) do { unsigned _sp = 0; while (cond) { __builtin_amdgcn_s_sleep(1); \
    if ((++_sp & 255u) == 0u) { if (xb_ld(&(bar)[XB_TMO])) break; if (_sp > XB_SPIN_CAP) { atomicAdd(&(bar)[XB_TMO], 1u); break; } } } } while (0)

struct XcdBarrier {
    unsigned* bar; unsigned x;
    volatile LAS unsigned* st;
};

__device__ __forceinline__ XcdBarrier xcd_barrier_post(unsigned* bar, volatile LAS unsigned* st) {
    XcdBarrier b; b.bar = bar; b.x = xb_xcc_id(); b.st = st;
    if (threadIdx.x == 0) (void)xb_add(&bar[XB_XCNT(b.x)], 1u);
    return b;
}
__device__ __forceinline__ void xcd_barrier_complete(unsigned* bar, unsigned x, unsigned& nloc, unsigned& nx) {
    const unsigned G = gridDim.x * gridDim.y * gridDim.z;
    unsigned sum, cnt, mine, sp = 0u;
    for (;;) {
        sum = 0u; cnt = 0u; mine = 0u;
#pragma unroll
        for (unsigned j = 0; j < 16; ++j) { const unsigned c = xb_ld(&bar[XB_XCNT(j)]); sum += c; cnt += (c > 0u) ? 1u : 0u; mine = (j == x) ? c : mine; }
        if (sum == G) break;
        __builtin_amdgcn_s_sleep(1);
        if ((++sp & 255u) == 0u) { if (xb_ld(&bar[XB_TMO])) break; if (sp > XB_SPIN_CAP) { atomicAdd(&bar[XB_TMO], 1u); break; } }
    }
    nloc = mine > 0u ? mine : 1u; nx = cnt > 0u ? cnt : 1u;
}

__device__ __forceinline__ void xcd_barrier(const XcdBarrier& b) {
    asm volatile("s_waitcnt vmcnt(0)" ::: "memory");
    __syncthreads();
    if (threadIdx.x == 0) {
        unsigned* bar = b.bar;
        __builtin_amdgcn_s_waitcnt(0);
        unsigned nloc = b.st[0], nx = b.st[1];
        if (nloc == 0u) { xcd_barrier_complete(bar, b.x, nloc, nx); b.st[0] = nloc; b.st[1] = nx; }
        const unsigned old = xb_add(&bar[XB_XSUB(b.x)], 1u);
        const unsigned gen = old / nloc;
        if (old + 1u == (gen + 1u) * nloc) {
            __builtin_amdgcn_fence(__ATOMIC_RELEASE, "agent");
            asm volatile("s_waitcnt vmcnt(0)" ::: "memory");
            const unsigned og = xb_add(&bar[XB_TOP], 1u);
            const unsigned tg = og / nx;
            if (og + 1u == (tg + 1u) * nx) xb_add(&bar[XB_TOPGEN], 1u);
            else XB_SPIN(xb_ld(&bar[XB_TOPGEN]) == tg, bar);
            __builtin_amdgcn_fence(__ATOMIC_ACQUIRE, "agent");
            xb_add(&bar[XB_XGEN(b.x)], 1u);
            asm volatile("s_waitcnt vmcnt(0)" ::: "memory");
        } else {
            XB_SPIN(xb_ld(&bar[XB_XGEN(b.x)]) == gen, bar);
            __builtin_amdgcn_fence(__ATOMIC_ACQUIRE, "agent");
            asm volatile("s_waitcnt vmcnt(0)" ::: "memory");
        }
    }
    __syncthreads();
}

struct Frame {
    LAS unsigned char* lds;
    int tid, lane, wave, G, bid;
    unsigned long long tacc, tmark;
    const float *x_p, *x_s, *st_gla, *st_ssd, *st_sconv, *st_fconv, *n_mix_pre, *n_mix_post, *n_ffn_pre, *n_ffn_post, *w_in, *w_gate2, *b_gate, *gla_norm,
                *sconv_w, *sconv_b, *dt_bias, *A_log, *ssd_D, *ssd_norm, *w_out, *ffn_w_in, *fconv_w, *fconv_b, *ffn_w_out;
    float* out;
    bf16 *W1, *WO, *WF1, *WF2, *XN, *PROJ, *MIXIN, *ACT, *DS, *SC, *DH, *HC;
    float *LRDT, *MIX, *Fb, *EBL, *AL, *HG;
};
__device__ __forceinline__ const float* x_row(const Frame& F, int row) { return row < MP ? F.x_p + (size_t)row * DM : F.x_s + (size_t)(row - MP) * DM; }

__device__ __forceinline__ int w1_src_col(int n) { return n < 3072 ? n : (n < 5632 ? n + 16 : (n < 5648 ? n - 2560 : (n < 5664 ? n : -1))); }
template <int MAP>
__device__ __forceinline__ void p0_transpose_item(const float* W, int K, int Nsrc, int Ndst, bf16* WT, LAS float* scr, int item, int lane) {
    const int nblk = Ndst / 64, kb = item / nblk, nb = item % nblk, k0 = 64 * kb, n0 = 64 * nb;
    int sc = n0 + 4 * (lane & 15); if (MAP == 1) sc = w1_src_col(sc); if (MAP == 2) sc = ((sc >> 7) & 1) * FF + 128 * (sc >> 8) + (sc & 127);
    f32x4 v[16];
#pragma unroll
    for (int i = 0; i < 16; ++i) { const int kk = 4 * i + (lane >> 4); v[i] = (sc >= 0) ? *(const f32x4*)(W + (size_t)(k0 + kk) * Nsrc + sc) : (f32x4){0.f, 0.f, 0.f, 0.f}; }
#pragma unroll
    for (int i = 0; i < 16; ++i) { const int kk = 4 * i + (lane >> 4); LAS float* d = scr + kk * 65 + 4 * (lane & 15); d[0] = v[i].x; d[1] = v[i].y; d[2] = v[i].z; d[3] = v[i].w; }
    LDS_WAIT(); asm volatile("" ::: "memory");
    const int c = lane & 7;
#pragma unroll
    for (int j = 0; j < 8; ++j) { const int n = (lane >> 3) + 8 * j; const LAS float* s = scr + (8 * c) * 65 + n;
        v4u o; o.x = pk2(s[0 * 65], s[1 * 65]); o.y = pk2(s[2 * 65], s[3 * 65]); o.z = pk2(s[4 * 65], s[5 * 65]); o.w = pk2(s[6 * 65], s[7 * 65]);
        *(v4u*)(WT + (size_t)(n0 + n) * K + k0 + 8 * c) = o; }
    LDS_WAIT(); asm volatile("" ::: "memory");
}
__device__ __forceinline__ void rms_row_to_bf16(const float* xrow, const float* w, bf16* orow, int lane) {
    const f32x4* xr = (const f32x4*)xrow + lane; const f32x4* wr = (const f32x4*)w + lane;
    f32x4 v[8]; float s = 0.f;
#pragma unroll
    for (int j = 0; j < 8; ++j) { v[j] = xr[64 * j]; s += (v[j].x * v[j].x + v[j].y * v[j].y) + (v[j].z * v[j].z + v[j].w * v[j].w); }
    const float r = rsqrtf(wave_sum(s) * (1.f / DM) + EPS);
    v2u* o8 = (v2u*)orow + lane;
#pragma unroll
    for (int j = 0; j < 8; ++j) { const f32x4 ww = wr[64 * j]; v2u o; o.x = pk2(v[j].x * r * ww.x, v[j].y * r * ww.y); o.y = pk2(v[j].z * r * ww.z, v[j].w * r * ww.w); o8[64 * j] = o; }
}
__device__ __forceinline__ void p0_prologue(Frame& F) {
    LAS float* scr = (LAS float*)(F.lds + F.wave * 16640);
    const int gw = F.bid * NWAVES + F.wave, NGW = F.G * NWAVES;
    constexpr int I_1 = (DM / 64) * (N1 / 64);
    for (int it = gw; it < I_1; it += NGW) p0_transpose_item<1>(F.w_in, DM, INC, N1, F.W1, scr, it, F.lane);
    for (int m = gw; m < M; m += NGW) rms_row_to_bf16(x_row(F, m), F.n_mix_pre, F.XN + (size_t)m * DM, F.lane);
}
__device__ __forceinline__ void p0_convert_rest(Frame& F, int vb, int nb) {
    LAS float* scr = (LAS float*)(F.lds + F.wave * 16640);
    const int gw = vb * NWAVES + F.wave, NGW = nb * NWAVES;
    constexpr int I_O = (DM / 64) * (DM / 64), I_F1 = (DM / 64) * (FF2 / 64), I_F2 = (FF / 64) * (DM / 64);
    for (int it = gw; it < I_O + I_F1 + I_F2; it += NGW) {
        int r = it;
        if (r < I_O) { p0_transpose_item<0>(F.w_out, DM, DM, DM, F.WO, scr, r, F.lane); continue; } r -= I_O;
        if (r < I_F1) { p0_transpose_item<2>(F.ffn_w_in, DM, FF2, FF2, F.WF1, scr, r, F.lane); continue; } r -= I_F1;
        p0_transpose_item<0>(F.ffn_w_out, FF, DM, DM, F.WF2, scr, r, F.lane);
    }
}

template <int grp> __device__ __forceinline__ void gla_direct_unit(Frame& F, int b, int h) {
    const int tid = F.tid, v = tid & 255, kh = tid >> 8;
    const int L = grp ? SL : PL, row0 = grp ? MP + b * SL : b * PL;
    LAS float* Es = (LAS float*)F.lds; LAS float* Ks = Es + 1024; LAS float* Qs = Ks + 1024; LAS float* Os = Qs + 1024;
    float S[64];
    if (grp) { const float* s0 = F.st_gla + ((size_t)(b * GH + h) * GK + kh * 64) * GV + v;
#pragma unroll
        for (int i = 0; i < 64; ++i) S[i] = s0[(size_t)i * GV]; }
    else {
#pragma unroll
        for (int i = 0; i < 64; ++i) S[i] = 0.f; }
    for (int t0 = 0; t0 < L; t0 += 8) {
        for (int it = tid; it < 1024; it += NTHR) { const int t = it >> 7, k = it & 127, row = row0 + t0 + t, hk = h * GK + k;
            float x = F.b_gate[hk]; const float* lr = F.LRDT + (size_t)row * 32;
#pragma unroll
            for (int j = 0; j < LOWR; ++j) x += lr[j] * F.w_gate2[j * GKD + hk];
            const float lg = logsigmoid_f(x) * (1.f / 16.f);
            Es[it] = __expf(lg); Ks[it] = bf2f(F.PROJ[(size_t)row * NP + CK + hk]); Qs[it] = bf2f(F.PROJ[(size_t)row * NP + CQ + hk]) * 0.08838834764831845f; }
        __syncthreads();
#pragma unroll 1
        for (int t = 0; t < 8; ++t) { const float vv = bf2f(F.PROJ[(size_t)(row0 + t0 + t) * NP + CV + h * GV + v]); float acc = 0.f;
            const LAS float* e = Es + t * 128 + kh * 64; const LAS float* kk = Ks + t * 128 + kh * 64; const LAS float* qq = Qs + t * 128 + kh * 64;
#pragma unroll
            for (int i = 0; i < 64; ++i) { S[i] = e[i] * S[i] + kk[i] * vv; acc += qq[i] * S[i]; }
            Os[(kh * 8 + t) * 256 + v] = acc; }
        __syncthreads();
        { const int t = F.wave, v4 = F.lane * 4, row = row0 + t0 + t;
            const f32x4 a = *(const LAS f32x4*)(Os + t * 256 + v4), c = *(const LAS f32x4*)(Os + (8 + t) * 256 + v4); const f32x4 o = a + c;
            const float ss = wave_sum((o.x * o.x + o.y * o.y) + (o.z * o.z + o.w * o.w)); const float r = rsqrtf(ss * (1.f / GV) + EPS);
            const v2u gw = *(const v2u*)(F.PROJ + (size_t)row * NP + CG + h * GV + v4); const f32x4 nw = *(const f32x4*)(F.gla_norm + v4);
            v2u w; w.x = pk2(o.x * r * nw.x * silu_f(bflo(gw.x)), o.y * r * nw.y * silu_f(bfhi(gw.x))); w.y = pk2(o.z * r * nw.z * silu_f(bflo(gw.y)), o.w * r * nw.w * silu_f(bfhi(gw.y)));
            *(v2u*)(F.MIXIN + (size_t)row * DM + h * GV + v4) = w; }
        __syncthreads();
    }
    float* so = F.out + (grp ? O_GLA_S : O_GLA_P) + ((size_t)(b * GH + h) * GK + kh * 64) * GV + v;
#pragma unroll
    for (int i = 0; i < 64; ++i) so[(size_t)i * GV] = S[i];
}
__device__ __forceinline__ float xbc_raw(const Frame& F, int grp, int b, int row0, int tt, int c) {
    if (tt >= 0) return bf2f(F.PROJ[(size_t)(row0 + tt) * NP + CX + c]);
    return grp ? F.st_sconv[((size_t)b * 3 + (tt + 3)) * SCH + c] : 0.f;
}
template <int grp> __device__ __forceinline__ void ssd_direct_unit(Frame& F, int b, int g) {
    const int tid = F.tid, hd = g * 8 + (tid >> 6), p = tid & 63, ch = g * 512 + tid;
    const int L = grp ? SL : PL, row0 = grp ? MP + b * SL : b * PL;
    LAS float* Bs = (LAS float*)F.lds; LAS float* Cs = Bs + 1024; LAS float* red = Cs + 1024; LAS float* Ys = red + 64;
    float h[128];
    if (grp) { const f32x4* h0 = (const f32x4*)(F.st_ssd + ((size_t)(b * SH + hd) * SP + p) * SN);
#pragma unroll
        for (int i = 0; i < 32; ++i) { const f32x4 q = h0[i]; h[4 * i] = q.x; h[4 * i + 1] = q.y; h[4 * i + 2] = q.z; h[4 * i + 3] = q.w; } }
    else {
#pragma unroll
        for (int i = 0; i < 128; ++i) h[i] = 0.f; }
    const float A = -__expf(F.A_log[hd]), dtb = F.dt_bias[hd], Dh = F.ssd_D[hd], nw = F.ssd_norm[ch];
    const float cb = F.sconv_b[ch], cw0 = F.sconv_w[ch], cw1 = F.sconv_w[SCH + ch], cw2 = F.sconv_w[2 * SCH + ch], cw3 = F.sconv_w[3 * SCH + ch];
    const int c2 = 1024 + (tid < 128 ? g * 128 + tid : 256 + g * 128 + ((tid - 128) & 127));
    float xr0 = xbc_raw(F, grp, b, row0, -3, ch), xr1 = xbc_raw(F, grp, b, row0, -2, ch), xr2 = xbc_raw(F, grp, b, row0, -1, ch);
    for (int t0 = 0; t0 < L; t0 += 8) {
        if (tid < 256) {
            float xr[11]; const float cb2 = F.sconv_b[c2], d0 = F.sconv_w[c2], d1 = F.sconv_w[SCH + c2], d2 = F.sconv_w[2 * SCH + c2], d3 = F.sconv_w[3 * SCH + c2];
#pragma unroll
            for (int i = 0; i < 11; ++i) xr[i] = xbc_raw(F, grp, b, row0, t0 - 3 + i, c2);
#pragma unroll
            for (int t = 0; t < 8; ++t) Bs[(tid >> 7) * 1024 + t * 128 + (tid & 127)] = silu_f(cb2 + d0 * xr[t] + d1 * xr[t + 1] + d2 * xr[t + 2] + d3 * xr[t + 3]);
        }
        __syncthreads();
#pragma unroll 1
        for (int t = 0; t < 8; ++t) { const int row = row0 + t0 + t;
            const float xn = bf2f(F.PROJ[(size_t)row * NP + CX + ch]);
            const float x = silu_f(cb + cw0 * xr0 + cw1 * xr1 + cw2 * xr2 + cw3 * xn); xr0 = xr1; xr1 = xr2; xr2 = xn;
            const float dt = softplus_f(F.LRDT[(size_t)row * 32 + 16 + hd] + dtb), a = __expf(dt * A), dtx = dt * x;
            float acc = 0.f; const LAS float* bb = Bs + t * 128; const LAS float* cc = Cs + t * 128;
#pragma unroll
            for (int nb = 0; nb < 128; nb += 16) {
#pragma unroll
                for (int n = nb; n < nb + 16; ++n) { h[n] = a * h[n] + dtx * bb[n]; acc += h[n] * cc[n]; }
                asm volatile("" ::: "memory"); }
            const float z = bf2f(F.PROJ[(size_t)row * NP + CZ + ch]);
            const float y = (acc + Dh * x) * silu_f(z);
            Ys[t * 512 + tid] = y;
            const float ss = wave_sum(y * y); if (F.lane == 0) red[t * 8 + F.wave] = ss; }
        __syncthreads();
#pragma unroll
        for (int t = 0; t < 8; ++t) { float tot = 0.f;
#pragma unroll
            for (int w = 0; w < 8; ++w) tot += red[t * 8 + w];
            const float r = rsqrtf(tot * (1.f / 512.f) + EPS);
            F.MIXIN[(size_t)(row0 + t0 + t) * DM + 1024 + ch] = (bf16)f2bf(Ys[t * 512 + tid] * r * nw); }
        __syncthreads();
    }
    f32x4* ho = (f32x4*)(F.out + (grp ? O_SSD_S : O_SSD_P) + ((size_t)(b * SH + hd) * SP + p) * SN);
#pragma unroll
    for (int i = 0; i < 32; ++i) ho[i] = (f32x4){h[4 * i], h[4 * i + 1], h[4 * i + 2], h[4 * i + 3]};
}
typedef short bf16x8v __attribute__((ext_vector_type(8)));
typedef short s16x4v __attribute__((ext_vector_type(4)));
constexpr int CH = 64, NCH = PL / CH;
constexpr int QE_ST = 272, KDT_ST = 144, V_ST = 544, ATT_ST = 144, X_ST = 1056, BC_ST = 288;
#define MFMA16(a, b, c) __builtin_amdgcn_mfma_f32_16x16x32_bf16((a), (b), (c), 0, 0, 0)
__device__ __forceinline__ bf16x8v frag_k(const LAS unsigned char* T, int stride, int idx0, int kk0, int r, int q) { return *(const LAS bf16x8v*)(T + (idx0 + r) * stride + (kk0 + 8 * q) * 2); }
__device__ __forceinline__ bf16x8v frag_t(const LAS unsigned char* T, int stride, int kk0, int idx0, int r, int q) {
    const LAS unsigned char* p = T + (kk0 + 8 * q + (r >> 2)) * stride + (idx0 + 4 * (r & 3)) * 2;
    const s16x4v lo = __builtin_amdgcn_ds_read_tr16_b64_v4i16((LAS s16x4v*)p), hi = __builtin_amdgcn_ds_read_tr16_b64_v4i16((LAS s16x4v*)(p + 4 * stride));
    return (bf16x8v){lo[0], lo[1], lo[2], lo[3], hi[0], hi[1], hi[2], hi[3]};
}
__device__ __forceinline__ v2u pk4(const f32x4 v) { v2u o; o.x = pk2(v.x, v.y); o.y = pk2(v.z, v.w); return o; }

struct GlaStage { v4u v[4], qk[4], lr; };
template <int PASS>
__device__ __forceinline__ void gla_stage_load(const Frame& F, int h, int row0, GlaStage& g) {
    const int tid = F.tid;
#pragma unroll
    for (int i = 0; i < 4; ++i) { const int piece = tid + NTHR * i, row = piece >> 5, c16 = piece & 31; g.v[i] = *(const v4u*)(F.PROJ + (size_t)(row0 + row) * NP + CV + h * GV + c16 * 8); }
#pragma unroll
    for (int i = 0; i < 2; ++i) { const int piece = tid + NTHR * i, row = piece >> 4, c16 = piece & 15;
        g.qk[i] = *(const v4u*)(F.PROJ + (size_t)(row0 + row) * NP + CK + h * GK + c16 * 8);
        if (PASS == 1) g.qk[2 + i] = *(const v4u*)(F.PROJ + (size_t)(row0 + row) * NP + CQ + h * GK + c16 * 8); }
    if (tid < 256) g.lr = *(const v4u*)(F.LRDT + (size_t)(row0 + (tid >> 2)) * 32 + (tid & 3) * 4);
}
template <int PASS>
__device__ __forceinline__ void gla_stage_store(const Frame& F, const GlaStage& g, LAS unsigned char* V, LAS unsigned char* Kt, LAS unsigned char* Qt, LAS float* LR) {
    const int tid = F.tid;
#pragma unroll
    for (int i = 0; i < 4; ++i) { const int piece = tid + NTHR * i, row = piece >> 5, c16 = piece & 31; *(LAS v4u*)(V + row * V_ST + c16 * 16) = g.v[i]; }
#pragma unroll
    for (int i = 0; i < 2; ++i) { const int piece = tid + NTHR * i, row = piece >> 4, c16 = piece & 15;
        *(LAS v4u*)(Kt + row * QE_ST + c16 * 16) = g.qk[i]; if (PASS == 1) *(LAS v4u*)(Qt + row * QE_ST + c16 * 16) = g.qk[2 + i]; }
    if (tid < 256) *(LAS v4u*)(LR + (tid >> 2) * 16 + (tid & 3) * 4) = g.lr;
}
template <int PASS>
__device__ __forceinline__ void gla_chunk_elem(Frame& F, int h, LAS unsigned char* Kt, LAS unsigned char* Qt, LAS unsigned char* KDT, const LAS float* LR, LAS float* tot, float* ebl_out) {
    const int tid = F.tid, k = tid & 127, tq = tid >> 7, hk = h * GK + k;
    float w2[16];
#pragma unroll
    for (int j = 0; j < 16; ++j) w2[j] = F.w_gate2[j * GKD + hk];
    const float bg = F.b_gate[hk];
    float lg[16]; float run = 0.f;
#pragma unroll
    for (int i = 0; i < 16; ++i) { const LAS f32x4* lr = (const LAS f32x4*)(LR + (16 * tq + i) * 16); const f32x4 a = lr[0], b = lr[1], c = lr[2], d = lr[3];
        float x = bg + a.x * w2[0] + a.y * w2[1] + a.z * w2[2] + a.w * w2[3] + b.x * w2[4] + b.y * w2[5] + b.z * w2[6] + b.w * w2[7]
                     + c.x * w2[8] + c.y * w2[9] + c.z * w2[10] + c.w * w2[11] + d.x * w2[12] + d.y * w2[13] + d.z * w2[14] + d.w * w2[15];
        run += logsigmoid_f(x) * (1.f / 16.f); lg[i] = run; }
    tot[tq * 128 + k] = run;
    __syncthreads();
    float off = 0.f, all = 0.f;
#pragma unroll
    for (int qq = 0; qq < 4; ++qq) { const float v = tot[qq * 128 + k]; all += v; off += (qq < tq) ? v : 0.f; }
    if (PASS == 0) {
        unsigned pk[8];
#pragma unroll
        for (int i = 0; i < 8; ++i) { const int t = 16 * tq + 2 * i;
            const float k0 = bf2f(*(const LAS bf16*)(Kt + t * QE_ST + k * 2)) * __expf(all - (off + lg[2 * i])), k1 = bf2f(*(const LAS bf16*)(Kt + (t + 1) * QE_ST + k * 2)) * __expf(all - (off + lg[2 * i + 1])); pk[i] = pk2(k0, k1); }
        LAS v4u* d = (LAS v4u*)(KDT + k * KDT_ST + 32 * tq);
        d[0] = (v4u){pk[0], pk[1], pk[2], pk[3]}; d[1] = (v4u){pk[4], pk[5], pk[6], pk[7]};
        if (tq == 0) ebl_out[k] = __expf(all);
    } else {
#pragma unroll
        for (int i = 0; i < 16; ++i) { const int t = 16 * tq + i; const float bb = off + lg[i];
            LAS bf16* qp = (LAS bf16*)(Qt + t * QE_ST + k * 2); LAS bf16* kp = (LAS bf16*)(Kt + t * QE_ST + k * 2);
            *qp = (bf16)f2bf(bf2f(*qp) * 0.08838834764831845f * __expf(bb)); *kp = (bf16)f2bf(bf2f(*kp) * __expf(-bb)); }
    }
}
__device__ __forceinline__ void gla_passA_unit(Frame& F, int u) {
    const int c = u & 31, bh = u >> 5, b = bh >> 2, h = bh & 3, row0 = b * PL + c * CH;
    LAS unsigned char* KDT = F.lds; LAS unsigned char* V = KDT + 128 * KDT_ST; LAS unsigned char* Kt = V + 64 * V_ST; LAS float* LR = (LAS float*)(Kt + 64 * QE_ST); LAS float* tot = LR + 1024;
    { GlaStage g; gla_stage_load<0>(F, h, row0, g); gla_stage_store<0>(F, g, V, Kt, nullptr, LR); }
    __syncthreads();
    gla_chunk_elem<0>(F, h, Kt, nullptr, KDT, LR, tot, F.EBL + (size_t)u * 128);
    __syncthreads();
    const int w = F.wave, r = F.lane & 15, q = F.lane >> 4;
    f32x4 acc[8][2];
#pragma unroll
    for (int kf = 0; kf < 8; ++kf) { acc[kf][0] = (f32x4){0.f, 0.f, 0.f, 0.f}; acc[kf][1] = (f32x4){0.f, 0.f, 0.f, 0.f}; }
#pragma unroll
    for (int ks = 0; ks < 2; ++ks) { const bf16x8v b0 = frag_t(V, V_ST, 32 * ks, 32 * w, r, q), b1 = frag_t(V, V_ST, 32 * ks, 32 * w + 16, r, q);
#pragma unroll
        for (int kf = 0; kf < 8; ++kf) { const bf16x8v a = frag_k(KDT, KDT_ST, 16 * kf, 32 * ks, r, q); acc[kf][0] = MFMA16(a, b0, acc[kf][0]); acc[kf][1] = MFMA16(a, b1, acc[kf][1]); } }
#pragma unroll
    for (int kf = 0; kf < 8; ++kf)
#pragma unroll
        for (int vf = 0; vf < 2; ++vf) *(v2u*)(F.DS + ((size_t)u * GV + 32 * w + 16 * vf + r) * GK + 16 * kf + 4 * q) = pk4(acc[kf][vf]);
    __syncthreads();
}
__device__ __forceinline__ void gla_scan(Frame& F) {
    for (int it = F.bid * NTHR + F.tid; it < PB * GH * GV * 32; it += F.G * NTHR) { const int k4 = it & 31, v = (it >> 5) & 255, bh = it >> 13;
        f32x4 S = (f32x4){0.f, 0.f, 0.f, 0.f};
#pragma unroll 8
        for (int c = 0; c < NCH; ++c) { const int u = bh * NCH + c; const size_t off = ((size_t)u * GV + v) * GK + 4 * k4;
            const v2u d = *(const v2u*)(F.DS + off); const f32x4 e = *(const f32x4*)(F.EBL + (size_t)u * 128 + 4 * k4);
            *(v2u*)(F.SC + off) = pk4(S);
            S.x = e.x * S.x + bflo(d.x); S.y = e.y * S.y + bfhi(d.x); S.z = e.z * S.z + bflo(d.y); S.w = e.w * S.w + bfhi(d.y); }
        float* o = F.out + O_GLA_P + ((size_t)bh * GK + 4 * k4) * GV + v; o[0] = S.x; o[GV] = S.y; o[2 * GV] = S.z; o[3 * GV] = S.w; }
}
__device__ __forceinline__ void gla_passC_unit(Frame& F, int u) {
    const int c = u & 31, bh = u >> 5, b = bh >> 2, h = bh & 3, row0 = b * PL + c * CH;
    LAS unsigned char* QE = F.lds; LAS unsigned char* KE = QE + 64 * QE_ST; LAS unsigned char* V = KE + 64 * QE_ST; LAS unsigned char* ATT = V + 64 * V_ST;
    LAS float* tot = (LAS float*)(ATT + 64 * ATT_ST); LAS float* red = tot + 512; LAS float* LR = red + 128;
    { GlaStage g; gla_stage_load<1>(F, h, row0, g); gla_stage_store<1>(F, g, V, KE, QE, LR); }
    __syncthreads();
    gla_chunk_elem<1>(F, h, KE, QE, nullptr, LR, tot, nullptr);
    __syncthreads();
    const int w = F.wave, r = F.lane & 15, q = F.lane >> 4;
#pragma unroll
    for (int ff = 0; ff < 2; ++ff) { const int f = 2 * w + ff, sf = f >> 2, tf = f & 3; f32x4 a4 = (f32x4){0.f, 0.f, 0.f, 0.f};
        if (sf <= tf) {
#pragma unroll
            for (int ks = 0; ks < 4; ++ks) a4 = MFMA16(frag_k(KE, QE_ST, 16 * sf, 32 * ks, r, q), frag_k(QE, QE_ST, 16 * tf, 32 * ks, r, q), a4); }
        const int s0 = 16 * sf + 4 * q, t = 16 * tf + r;
        f32x4 m; m.x = (s0 <= t) ? a4.x : 0.f; m.y = (s0 + 1 <= t) ? a4.y : 0.f; m.z = (s0 + 2 <= t) ? a4.z : 0.f; m.w = (s0 + 3 <= t) ? a4.w : 0.f;
        *(LAS v2u*)(ATT + t * ATT_ST + s0 * 2) = pk4(m); }
    __syncthreads();
    const int tf = w & 3, vh = w >> 2;
    f32x4 acc[8];
#pragma unroll
    for (int i = 0; i < 8; ++i) acc[i] = (f32x4){0.f, 0.f, 0.f, 0.f};
    const bf16* Sc = F.SC + ((size_t)u * GV + 128 * vh) * GK;
#pragma unroll
    for (int ks = 0; ks < 4; ++ks) { const bf16x8v bq = frag_k(QE, QE_ST, 16 * tf, 32 * ks, r, q);
#pragma unroll
        for (int i = 0; i < 8; ++i) { const bf16x8v a = *(const bf16x8v*)(Sc + (size_t)(16 * i + r) * GK + 32 * ks + 8 * q); acc[i] = MFMA16(a, bq, acc[i]); } }
#pragma unroll
    for (int ks = 0; ks < 2; ++ks) { const bf16x8v ba = frag_k(ATT, ATT_ST, 16 * tf, 32 * ks, r, q);
#pragma unroll
        for (int i = 0; i < 8; ++i) { const bf16x8v a = frag_t(V, V_ST, 32 * ks, 128 * vh + 16 * i, r, q); acc[i] = MFMA16(a, ba, acc[i]); } }
    float ss = 0.f;
#pragma unroll
    for (int i = 0; i < 8; ++i) ss += (acc[i].x * acc[i].x + acc[i].y * acc[i].y) + (acc[i].z * acc[i].z + acc[i].w * acc[i].w);
    ss += __shfl_xor(ss, 16); ss += __shfl_xor(ss, 32);
    const int t = 16 * tf + r;
    if (q == 0) red[vh * 64 + t] = ss;
    __syncthreads();
    const float rr = rsqrtf((red[t] + red[64 + t]) * (1.f / GV) + EPS); const size_t row = (size_t)(row0 + t);
#pragma unroll
    for (int i = 0; i < 8; ++i) { const int v = 128 * vh + 16 * i + 4 * q;
        const v2u gw = *(const v2u*)(F.PROJ + row * NP + CG + h * GV + v); const f32x4 nw = *(const f32x4*)(F.gla_norm + v);
        f32x4 o; o.x = acc[i].x * rr * nw.x * silu_f(bflo(gw.x)); o.y = acc[i].y * rr * nw.y * silu_f(bfhi(gw.x)); o.z = acc[i].z * rr * nw.z * silu_f(bflo(gw.y)); o.w = acc[i].w * rr * nw.w * silu_f(bfhi(gw.y));
        *(v2u*)(F.MIXIN + row * DM + h * GV + v) = pk4(o); }
    __syncthreads();
}

template <bool SCALE>
__device__ __forceinline__ void ssd_conv_item(Frame& F, int b, int g, int c, int cg, int tb, LAS unsigned char* X, LAS unsigned char* BT, LAS unsigned char* CT, const LAS float* WDEC) {
    const int xc = cg < 64 ? g * 512 + 8 * cg : (cg < 80 ? 1024 + g * 128 + 8 * (cg - 64) : 1280 + g * 128 + 8 * (cg - 80));
    float w[4][8], bias[8];
#pragma unroll
    for (int j = 0; j < 4; ++j) { const f32x4 a = *(const f32x4*)(F.sconv_w + j * SCH + xc), bq = *(const f32x4*)(F.sconv_w + j * SCH + xc + 4);
        w[j][0] = a.x; w[j][1] = a.y; w[j][2] = a.z; w[j][3] = a.w; w[j][4] = bq.x; w[j][5] = bq.y; w[j][6] = bq.z; w[j][7] = bq.w; }
    { const f32x4 a = *(const f32x4*)(F.sconv_b + xc), bq = *(const f32x4*)(F.sconv_b + xc + 4); bias[0] = a.x; bias[1] = a.y; bias[2] = a.z; bias[3] = a.w; bias[4] = bq.x; bias[5] = bq.y; bias[6] = bq.z; bias[7] = bq.w; }
    v4u raw[11];
#pragma unroll
    for (int i = 0; i < 11; ++i) { const int tt = c * CH + tb * 8 - 3 + i;
        raw[i] = (tt >= 0) ? *(const v4u*)(F.PROJ + (size_t)(b * PL + tt) * NP + CX + xc) : (v4u){0u, 0u, 0u, 0u}; }
#pragma unroll
    for (int t = 0; t < 8; ++t) { float o[8];
#pragma unroll
        for (int e = 0; e < 8; ++e) { float a = bias[e];
#pragma unroll
            for (int j = 0; j < 4; ++j) { const unsigned wd = raw[t + j][e >> 1]; a += w[j][e] * ((e & 1) ? bfhi(wd) : bflo(wd)); }
            o[e] = silu_f(a); }
        const int tl = tb * 8 + t;
        if (SCALE && cg < 64) { const float sc = WDEC[(cg >> 3) * 64 + tl];
#pragma unroll
            for (int e = 0; e < 8; ++e) o[e] *= sc; }
        const v4u pkd = (v4u){pk2(o[0], o[1]), pk2(o[2], o[3]), pk2(o[4], o[5]), pk2(o[6], o[7])};
        LAS unsigned char* dst = cg < 64 ? X + tl * X_ST + cg * 16 : (cg < 80 ? BT + tl * BC_ST + (cg - 64) * 16 : CT + tl * BC_ST + (cg - 80) * 16);
        *(LAS v4u*)dst = pkd; }
}
__device__ __forceinline__ float ssd_head_scan(Frame& F, int hd, int row0, float& dt_out, float& last) {
    const float dt = softplus_f(F.LRDT[(size_t)(row0 + F.lane) * 32 + 16 + hd] + F.dt_bias[hd]);
    float cum = dt * (-__expf(F.A_log[hd]));
#pragma unroll
    for (int o = 1; o < 64; o <<= 1) { const float v = __shfl_up(cum, o); cum += (F.lane >= o) ? v : 0.f; }
    dt_out = dt; last = __shfl(cum, 63); return cum;
}
__device__ __forceinline__ void ssd_passA_unit(Frame& F, int u) {
    const int c = u & 31, bg = u >> 5, b = bg >> 1, g = bg & 1, row0 = b * PL + c * CH;
    LAS unsigned char* X = F.lds; LAS unsigned char* BT = X + 64 * X_ST; LAS float* WDEC = (LAS float*)(BT + 64 * BC_ST);
    const int w = F.wave, r = F.lane & 15, q = F.lane >> 4;
    { float dt, last; const float cum = ssd_head_scan(F, g * 8 + w, row0, dt, last);
        WDEC[w * 64 + F.lane] = __expf(last - cum) * dt; if (F.lane == 63) F.AL[(size_t)u * 8 + w] = __expf(last); }
    __syncthreads();
    for (int it = F.tid; it < 80 * 8; it += NTHR) ssd_conv_item<true>(F, b, g, c, it % 80, it / 80, X, BT, nullptr, WDEC);
    __syncthreads();
#pragma unroll 1
    for (int nh = 0; nh < 2; ++nh) {
        f32x4 acc[4][4];
#pragma unroll
        for (int i = 0; i < 4; ++i)
#pragma unroll
            for (int j = 0; j < 4; ++j) acc[i][j] = (f32x4){0.f, 0.f, 0.f, 0.f};
#pragma unroll
        for (int ks = 0; ks < 2; ++ks) { bf16x8v bp[4];
#pragma unroll
            for (int pf = 0; pf < 4; ++pf) bp[pf] = frag_t(X, X_ST, 32 * ks, 64 * w + 16 * pf, r, q);
#pragma unroll
            for (int nf = 0; nf < 4; ++nf) { const bf16x8v a = frag_t(BT, BC_ST, 32 * ks, 64 * nh + 16 * nf, r, q);
#pragma unroll
                for (int pf = 0; pf < 4; ++pf) acc[nf][pf] = MFMA16(a, bp[pf], acc[nf][pf]); } }
#pragma unroll
        for (int nf = 0; nf < 4; ++nf)
#pragma unroll
            for (int pf = 0; pf < 4; ++pf) *(v2u*)(F.DH + (((size_t)u * 8 + w) * SP + 16 * pf + r) * SN + 64 * nh + 16 * nf + 4 * q) = pk4(acc[nf][pf]);
    }
    __syncthreads();
}
__device__ __forceinline__ void ssd_scan(Frame& F) {
    for (int it = F.bid * NTHR + F.tid; it < PB * SH * SP * 32; it += F.G * NTHR) { const int n4 = it & 31, p = (it >> 5) & 63, bhd = it >> 11, b = bhd >> 4, hd = bhd & 15, g = hd >> 3, hl = hd & 7;
        f32x4 H = (f32x4){0.f, 0.f, 0.f, 0.f};
#pragma unroll 8
        for (int c = 0; c < NCH; ++c) { const int u = (b * 2 + g) * NCH + c; const size_t off = (((size_t)u * 8 + hl) * SP + p) * SN + 4 * n4;
            const v2u d = *(const v2u*)(F.DH + off); const float a = F.AL[(size_t)u * 8 + hl];
            *(v2u*)(F.HC + off) = pk4(H);
            H.x = a * H.x + bflo(d.x); H.y = a * H.y + bfhi(d.x); H.z = a * H.z + bflo(d.y); H.w = a * H.w + bfhi(d.y); }
        *(f32x4*)(F.out + O_SSD_P + ((size_t)bhd * SP + p) * SN + 4 * n4) = H; }
}
__device__ __forceinline__ void ssd_passC_unit(Frame& F, int u) {
    const int c = u & 31, bg = u >> 5, b = bg >> 1, g = bg & 1, row0 = b * PL + c * CH;
    LAS unsigned char* X = F.lds; LAS unsigned char* BT = X + 64 * X_ST; LAS unsigned char* CT = BT + 64 * BC_ST; LAS unsigned char* CB = CT + 64 * BC_ST;
    LAS float* DT = (LAS float*)(CB + 64 * ATT_ST); LAS float* CUM = DT + 512; LAS float* red = CUM + 512;
    const int w = F.wave, r = F.lane & 15, q = F.lane >> 4, hd = g * 8 + w;
    { float dt, last; const float cum = ssd_head_scan(F, hd, row0, dt, last); DT[w * 64 + F.lane] = dt; CUM[w * 64 + F.lane] = cum; }
    for (int it = F.tid; it < 96 * 8; it += NTHR) ssd_conv_item<false>(F, b, g, c, it % 96, it / 96, X, BT, CT, nullptr);
    __syncthreads();
#pragma unroll
    for (int ff = 0; ff < 2; ++ff) { const int f = 2 * w + ff, sf = f >> 2, tf = f & 3; f32x4 a4 = (f32x4){0.f, 0.f, 0.f, 0.f};
        if (sf <= tf) {
#pragma unroll
            for (int ks = 0; ks < 4; ++ks) a4 = MFMA16(frag_k(BT, BC_ST, 16 * sf, 32 * ks, r, q), frag_k(CT, BC_ST, 16 * tf, 32 * ks, r, q), a4); }
        *(LAS v2u*)(CB + (16 * tf + r) * ATT_ST + (16 * sf + 4 * q) * 2) = pk4(a4); }
    __syncthreads();
    f32x4 acc[4][4];
#pragma unroll
    for (int i = 0; i < 4; ++i)
#pragma unroll
        for (int j = 0; j < 4; ++j) acc[i][j] = (f32x4){0.f, 0.f, 0.f, 0.f};
    const bf16* Hc = F.HC + ((size_t)u * 8 + w) * SP * SN;
#pragma unroll
    for (int ks = 0; ks < 4; ++ks) { bf16x8v bc[4];
#pragma unroll
        for (int tf = 0; tf < 4; ++tf) bc[tf] = frag_k(CT, BC_ST, 16 * tf, 32 * ks, r, q);
#pragma unroll
        for (int pf = 0; pf < 4; ++pf) { const bf16x8v a = *(const bf16x8v*)(Hc + (size_t)(16 * pf + r) * SN + 32 * ks + 8 * q);
#pragma unroll
            for (int tf = 0; tf < 4; ++tf) acc[pf][tf] = MFMA16(a, bc[tf], acc[pf][tf]); } }
    float ct[4];
#pragma unroll
    for (int tf = 0; tf < 4; ++tf) { ct[tf] = CUM[w * 64 + 16 * tf + r]; const float e = __expf(ct[tf]);
#pragma unroll
        for (int pf = 0; pf < 4; ++pf) acc[pf][tf] = acc[pf][tf] * e; }
#pragma unroll
    for (int ks = 0; ks < 2; ++ks) { bf16x8v ax[4];
#pragma unroll
        for (int pf = 0; pf < 4; ++pf) ax[pf] = frag_t(X, X_ST, 32 * ks, 64 * w + 16 * pf, r, q);
        const int s0 = 32 * ks + 8 * q;
        const f32x4 cs0 = *(const LAS f32x4*)(CUM + w * 64 + s0), cs1 = *(const LAS f32x4*)(CUM + w * 64 + s0 + 4), ds0 = *(const LAS f32x4*)(DT + w * 64 + s0), ds1 = *(const LAS f32x4*)(DT + w * 64 + s0 + 4);
        const float cs[8] = {cs0.x, cs0.y, cs0.z, cs0.w, cs1.x, cs1.y, cs1.z, cs1.w}, ds[8] = {ds0.x, ds0.y, ds0.z, ds0.w, ds1.x, ds1.y, ds1.z, ds1.w};
#pragma unroll
        for (int tf = 0; tf < 4; ++tf) { if (32 * ks > 16 * tf + 15) continue;
            const int t = 16 * tf + r; const v4u cb8 = *(const LAS v4u*)(CB + t * ATT_ST + s0 * 2); float l[8];
#pragma unroll
            for (int e = 0; e < 8; ++e) { const unsigned wd = cb8[e >> 1]; const float cbv = (e & 1) ? bfhi(wd) : bflo(wd); l[e] = (s0 + e <= t) ? cbv * __expf(ct[tf] - cs[e]) * ds[e] : 0.f; }
            const v4u lp = (v4u){pk2(l[0], l[1]), pk2(l[2], l[3]), pk2(l[4], l[5]), pk2(l[6], l[7])}; const bf16x8v bl = __builtin_bit_cast(bf16x8v, lp);
#pragma unroll
            for (int pf = 0; pf < 4; ++pf) acc[pf][tf] = MFMA16(ax[pf], bl, acc[pf][tf]); } }
    const float Dh = F.ssd_D[hd];
#pragma unroll
    for (int tf = 0; tf < 4; ++tf) { const int t = 16 * tf + r; const size_t row = (size_t)(row0 + t); float ss = 0.f;
#pragma unroll
        for (int pf = 0; pf < 4; ++pf) { const int p4 = 64 * w + 16 * pf + 4 * q;
            const v2u xv = *(const LAS v2u*)(X + t * X_ST + p4 * 2); const v2u zv = *(const v2u*)(F.PROJ + row * NP + CZ + g * 512 + p4);
            f32x4 y = acc[pf][tf];
            y.x = (y.x + Dh * bflo(xv.x)) * silu_f(bflo(zv.x)); y.y = (y.y + Dh * bfhi(xv.x)) * silu_f(bfhi(zv.x)); y.z = (y.z + Dh * bflo(xv.y)) * silu_f(bflo(zv.y)); y.w = (y.w + Dh * bfhi(xv.y)) * silu_f(bfhi(zv.y));
            acc[pf][tf] = y; ss += (y.x * y.x + y.y * y.y) + (y.z * y.z + y.w * y.w); }
        ss += __shfl_xor(ss, 16); ss += __shfl_xor(ss, 32);
        if (q == 0) red[w * 64 + t] = ss; }
    __syncthreads();
#pragma unroll
    for (int tf = 0; tf < 4; ++tf) { const int t = 16 * tf + r; const size_t row = (size_t)(row0 + t); float tot = 0.f;
#pragma unroll
        for (int ww = 0; ww < 8; ++ww) tot += red[ww * 64 + t];
        const float rr = rsqrtf(tot * (1.f / 512.f) + EPS);
#pragma unroll
        for (int pf = 0; pf < 4; ++pf) { const int p4 = g * 512 + 64 * w + 16 * pf + 4 * q; const f32x4 nw = *(const f32x4*)(F.ssd_norm + p4);
            f32x4 o = acc[pf][tf]; o.x *= rr * nw.x; o.y *= rr * nw.y; o.z *= rr * nw.z; o.w *= rr * nw.w;
            *(v2u*)(F.MIXIN + row * DM + 1024 + p4) = pk4(o); } }
    __syncthreads();
}

constexpr int ATT8_ST = 80;
__device__ __forceinline__ void gla_sample_unit(Frame& F, int b, int h, f32x4 (&S)[16], int nb, int nh, bool has_next) {
    const int tid = F.tid, w = F.wave, lane = F.lane, r = lane & 15, q = lane >> 4, row0 = MP + b * SL;
    LAS unsigned char* S0b = F.lds;
    LAS unsigned char* Vt = S0b + 128 * V_ST;
    LAS unsigned char* QE = Vt + 32 * V_ST;
    LAS unsigned char* KE = QE + 16 * QE_ST;
    LAS unsigned char* ATT = KE + 16 * QE_ST;
    LAS float* KD = (LAS float*)(ATT + 16 * ATT8_ST);
    LAS float* EL = KD + 1024;
    LAS float* red = EL + 128;
    f32x4 Vf[8];
#pragma unroll
    for (int s = 0; s < 8; ++s) { const v2u vv = *(const v2u*)(F.PROJ + (size_t)(row0 + s) * NP + CV + h * GV + 4 * lane); Vf[s] = (f32x4){bflo(vv.x), bfhi(vv.x), bflo(vv.y), bfhi(vv.y)}; }
    if (tid < 256) { const int t = tid >> 5, c16 = tid & 31; *(LAS v4u*)(Vt + t * V_ST + c16 * 16) = *(const v4u*)(F.PROJ + (size_t)(row0 + t) * NP + CV + h * GV + c16 * 8); }
    for (int i = tid; i < 24 * 32; i += NTHR) *(LAS v4u*)(Vt + (8 + (i >> 5)) * V_ST + (i & 31) * 16) = (v4u){0u, 0u, 0u, 0u};
    { LAS unsigned char* KR = (LAS unsigned char*)(red + 128); LAS unsigned char* QR = KR + 8 * 256; LAS float* LR = (LAS float*)(QR + 8 * 256); LAS float* LG = LR + 128;
        if (tid < 256) { const int which = tid >> 7, j = tid & 127, t = j >> 4, c16 = j & 15;
            *(LAS v4u*)((which ? QR : KR) + t * 256 + c16 * 16) = *(const v4u*)(F.PROJ + (size_t)(row0 + t) * NP + (which ? CQ : CK) + h * GK + c16 * 8); }
        else if (tid < 288) { const int j = tid - 256; *(LAS v4u*)(LR + (j >> 2) * 16 + (j & 3) * 4) = *(const v4u*)(F.LRDT + (size_t)(row0 + (j >> 2)) * 32 + (j & 3) * 4); }
        __syncthreads();
        { const int k = tid & 127, tp = tid >> 7, hk = h * GK + k; const float bg = F.b_gate[hk];
            float w2[16];
#pragma unroll
            for (int j = 0; j < 16; ++j) w2[j] = F.w_gate2[j * GKD + hk];
#pragma unroll
            for (int tt = 0; tt < 2; ++tt) { const int t = 2 * tp + tt; const LAS f32x4* lr = (const LAS f32x4*)(LR + t * 16); const f32x4 a = lr[0], bq = lr[1], c = lr[2], d = lr[3];
                const float x = bg + a.x * w2[0] + a.y * w2[1] + a.z * w2[2] + a.w * w2[3] + bq.x * w2[4] + bq.y * w2[5] + bq.z * w2[6] + bq.w * w2[7]
                              + c.x * w2[8] + c.y * w2[9] + c.z * w2[10] + c.w * w2[11] + d.x * w2[12] + d.y * w2[13] + d.z * w2[14] + d.w * w2[15];
                LG[t * 128 + k] = logsigmoid_f(x) * (1.f / 16.f); } }
        __syncthreads();
        if (tid < 128) { const int k = tid;
            float bcum[8], kv[8]; float run = 0.f;
#pragma unroll
            for (int t = 0; t < 8; ++t) { run += LG[t * 128 + k]; bcum[t] = run; kv[t] = bf2f(*(const LAS bf16*)(KR + t * 256 + k * 2));
                *(LAS bf16*)(QE + t * QE_ST + k * 2) = (bf16)f2bf(bf2f(*(const LAS bf16*)(QR + t * 256 + k * 2)) * 0.08838834764831845f * __expf(run));
                *(LAS bf16*)(KE + t * QE_ST + k * 2) = (bf16)f2bf(kv[t] * __expf(-run)); }
            f32x4 d0, d1; d0.x = kv[0] * __expf(run - bcum[0]); d0.y = kv[1] * __expf(run - bcum[1]); d0.z = kv[2] * __expf(run - bcum[2]); d0.w = kv[3] * __expf(run - bcum[3]);
            d1.x = kv[4] * __expf(run - bcum[4]); d1.y = kv[5] * __expf(run - bcum[5]); d1.z = kv[6] * __expf(run - bcum[6]); d1.w = kv[7];
            *(LAS f32x4*)(KD + k * 8) = d0; *(LAS f32x4*)(KD + k * 8 + 4) = d1; EL[k] = __expf(run); } }
    if (tid < 128) {
    } else if (tid < 384) { const int i = tid - 128, which = i >> 7, j = i & 127;
        *(LAS v4u*)((which ? KE : QE) + (8 + (j >> 4)) * QE_ST + (j & 15) * 16) = (v4u){0u, 0u, 0u, 0u};
    } else if (tid < 384 + 80) { *(LAS v4u*)(ATT + (tid - 384) * 16) = (v4u){0u, 0u, 0u, 0u}; }
#pragma unroll
    for (int i = 0; i < 16; ++i) *(LAS v2u*)(S0b + (16 * w + i) * V_ST + lane * 8) = pk4(S[i]);
    __syncthreads();
    if (w == 0) { f32x4 a4 = (f32x4){0.f, 0.f, 0.f, 0.f};
#pragma unroll
        for (int ks = 0; ks < 4; ++ks) a4 = MFMA16(frag_k(KE, QE_ST, 0, 32 * ks, r, q), frag_k(QE, QE_ST, 0, 32 * ks, r, q), a4);
        const int s0i = 4 * q; f32x4 m; m.x = (s0i <= r) ? a4.x : 0.f; m.y = (s0i + 1 <= r) ? a4.y : 0.f; m.z = (s0i + 2 <= r) ? a4.z : 0.f; m.w = (s0i + 3 <= r) ? a4.w : 0.f;
        if (r >= 8) m = (f32x4){0.f, 0.f, 0.f, 0.f};
        *(LAS v2u*)(ATT + r * ATT8_ST + s0i * 2) = pk4(m); }
    { f32x4* so = (f32x4*)(F.out + O_GLA_S + ((size_t)(b * GH + h) * GK + 16 * w) * GV) + lane;
#pragma unroll
        for (int i = 0; i < 16; ++i) { const int k = 16 * w + i; const float e = EL[k]; const f32x4 k0 = *(const LAS f32x4*)(KD + k * 8), k1 = *(const LAS f32x4*)(KD + k * 8 + 4);
            f32x4 n = S[i] * e; n = n + Vf[0] * k0.x; n = n + Vf[1] * k0.y; n = n + Vf[2] * k0.z; n = n + Vf[3] * k0.w; n = n + Vf[4] * k1.x; n = n + Vf[5] * k1.y; n = n + Vf[6] * k1.z; n = n + Vf[7] * k1.w;
            so[i * 64] = n; } }
    if (has_next) { const f32x4* s1 = (const f32x4*)(F.st_gla + ((size_t)(nb * GH + nh) * GK + 16 * w) * GV) + lane;
#pragma unroll
        for (int i = 0; i < 16; ++i) S[i] = s1[i * 64]; }
    f32x4 acc[2] = {(f32x4){0.f, 0.f, 0.f, 0.f}, (f32x4){0.f, 0.f, 0.f, 0.f}};
#pragma unroll
    for (int ks = 0; ks < 4; ++ks) { const bf16x8v bq = frag_k(QE, QE_ST, 0, 32 * ks, r, q);
#pragma unroll
        for (int vf = 0; vf < 2; ++vf) acc[vf] = MFMA16(frag_t(S0b, V_ST, 32 * ks, 32 * w + 16 * vf, r, q), bq, acc[vf]); }
    __syncthreads();
    { const bf16x8v ba = *(const LAS bf16x8v*)(ATT + r * ATT8_ST + 16 * q);
#pragma unroll
        for (int vf = 0; vf < 2; ++vf) acc[vf] = MFMA16(frag_t(Vt, V_ST, 0, 32 * w + 16 * vf, r, q), ba, acc[vf]); }
    float ss = (acc[0].x * acc[0].x + acc[0].y * acc[0].y) + (acc[0].z * acc[0].z + acc[0].w * acc[0].w) + (acc[1].x * acc[1].x + acc[1].y * acc[1].y) + (acc[1].z * acc[1].z + acc[1].w * acc[1].w);
    ss += __shfl_xor(ss, 16); ss += __shfl_xor(ss, 32);
    if (q == 0) red[w * 16 + r] = ss;
    __syncthreads();
    float tot = 0.f;
#pragma unroll
    for (int ww = 0; ww < 8; ++ww) tot += red[ww * 16 + r];
    const float rr = rsqrtf(tot * (1.f / GV) + EPS);
    if (r < 8) { const size_t row = (size_t)(row0 + r);
#pragma unroll
        for (int vf = 0; vf < 2; ++vf) { const int v = 32 * w + 16 * vf + 4 * q;
            const v2u gw = *(const v2u*)(F.PROJ + row * NP + CG + h * GV + v); const f32x4 nw = *(const f32x4*)(F.gla_norm + v);
            f32x4 o; o.x = acc[vf].x * rr * nw.x * silu_f(bflo(gw.x)); o.y = acc[vf].y * rr * nw.y * silu_f(bfhi(gw.x)); o.z = acc[vf].z * rr * nw.z * silu_f(bflo(gw.y)); o.w = acc[vf].w * rr * nw.w * silu_f(bfhi(gw.y));
            *(v2u*)(F.MIXIN + row * DM + h * GV + v) = pk4(o); } }
    __syncthreads();
}
__device__ __forceinline__ void ssd_sample_unit(Frame& F, int b, int g) {
    const int tid = F.tid, w = F.wave, lane = F.lane, r = lane & 15, q = lane >> 4, row0 = MP + b * SL, hd = g * 8 + w, ch = g * 512 + tid;
    LAS float* Xs = (LAS float*)F.lds;
    LAS float* XW = Xs + 4096;
    LAS float* Bs = XW + 4096;
    LAS unsigned char* Cb = (LAS unsigned char*)(Bs + 1024);
    LAS unsigned char* Bb = Cb + 16 * QE_ST;
    LAS float* CBm = (LAS float*)(Bb + 16 * QE_ST);
    LAS float* CD = CBm + 256;
    LAS float* red = CD + 128;
    const float* h0base = F.st_ssd + ((size_t)(b * SH + hd) * SP) * SN; float* hobase = F.out + O_SSD_S + ((size_t)(b * SH + hd) * SP) * SN;
    f32x4 hbuf[4][2];
#pragma unroll
    for (int i = 0; i < 4; ++i) { const size_t off = (size_t)(16 * (i & 3) + r) * SN + 32 * (i >> 2) + 8 * q; hbuf[i][0] = *(const f32x4*)(h0base + off); hbuf[i][1] = *(const f32x4*)(h0base + off + 4); }
    float dt[8], cum[8]; { const float A = -__expf(F.A_log[hd]), dtb = F.dt_bias[hd]; float run = 0.f;
#pragma unroll
        for (int t = 0; t < 8; ++t) { dt[t] = softplus_f(F.LRDT[(size_t)(row0 + t) * 32 + 16 + hd] + dtb); run += dt[t] * A; cum[t] = run; } }
    const float last = cum[7], elast = __expf(last);
    if (lane < 8) { float cv = cum[0], dv = dt[0];
#pragma unroll
        for (int t = 1; t < 8; ++t) { cv = (lane == t) ? cum[t] : cv; dv = (lane == t) ? dt[t] : dv; }
        CD[w * 16 + lane] = cv; CD[w * 16 + 8 + lane] = dv; }
    { float xr[11]; const float cb = F.sconv_b[ch], c0 = F.sconv_w[ch], c1 = F.sconv_w[SCH + ch], c2 = F.sconv_w[2 * SCH + ch], c3 = F.sconv_w[3 * SCH + ch];
#pragma unroll
        for (int i = 0; i < 11; ++i) xr[i] = xbc_raw(F, 1, b, row0, i - 3, ch);
        float xw[8];
#pragma unroll
        for (int t = 0; t < 8; ++t) { const float x = silu_f(cb + c0 * xr[t] + c1 * xr[t + 1] + c2 * xr[t + 2] + c3 * xr[t + 3]); Xs[t * 512 + tid] = x; xw[t] = x * __expf(last - cum[t]) * dt[t]; }
        *(LAS f32x4*)(XW + tid * 8) = (f32x4){xw[0], xw[1], xw[2], xw[3]}; *(LAS f32x4*)(XW + tid * 8 + 4) = (f32x4){xw[4], xw[5], xw[6], xw[7]}; }
    if (tid < 256) { const int n = tid & 127, isC = tid >> 7, cc = 1024 + isC * 256 + g * 128 + n;
        float xr[11]; const float cb = F.sconv_b[cc], c0 = F.sconv_w[cc], c1 = F.sconv_w[SCH + cc], c2 = F.sconv_w[2 * SCH + cc], c3 = F.sconv_w[3 * SCH + cc];
#pragma unroll
        for (int i = 0; i < 11; ++i) xr[i] = xbc_raw(F, 1, b, row0, i - 3, cc);
#pragma unroll
        for (int t = 0; t < 8; ++t) { const float x = silu_f(cb + c0 * xr[t] + c1 * xr[t + 1] + c2 * xr[t + 2] + c3 * xr[t + 3]);
            if (!isC) Bs[t * 128 + n] = x;
            *(LAS bf16*)((isC ? Cb : Bb) + t * QE_ST + n * 2) = (bf16)f2bf(x); }
    } else { const int i = tid - 256, which = i >> 7, j = i & 127; *(LAS v4u*)((which ? Bb : Cb) + (8 + (j >> 4)) * QE_ST + (j & 15) * 16) = (v4u){0u, 0u, 0u, 0u}; }
    __syncthreads();
    if (w == 0) { f32x4 a4 = (f32x4){0.f, 0.f, 0.f, 0.f};
#pragma unroll
        for (int ks = 0; ks < 4; ++ks) a4 = MFMA16(frag_k(Bb, QE_ST, 0, 32 * ks, r, q), frag_k(Cb, QE_ST, 0, 32 * ks, r, q), a4);
        *(LAS f32x4*)(CBm + r * 16 + 4 * q) = a4; }
    bf16x8v bc[4];
#pragma unroll
    for (int ks = 0; ks < 4; ++ks) bc[ks] = frag_k(Cb, QE_ST, 0, 32 * ks, r, q);
    f32x4 acc[4];
#pragma unroll
    for (int pf = 0; pf < 4; ++pf) acc[pf] = (f32x4){0.f, 0.f, 0.f, 0.f};
    f32x4 Bv[8][2];
#pragma unroll
    for (int st = 0; st < 16; ++st) { const int ks = st >> 2, pf = st & 3;
        if (pf == 0) {
#pragma unroll
            for (int s = 0; s < 8; ++s) { Bv[s][0] = *(const LAS f32x4*)(Bs + s * 128 + 32 * ks + 8 * q); Bv[s][1] = *(const LAS f32x4*)(Bs + s * 128 + 32 * ks + 8 * q + 4); } }
        const int p = 16 * pf + r; const size_t off = (size_t)p * SN + 32 * ks + 8 * q;
        const f32x4 ha = hbuf[st & 3][0], hb = hbuf[st & 3][1];
        if (st + 4 < 16) { const int st2 = st + 4; const size_t off2 = (size_t)(16 * (st2 & 3) + r) * SN + 32 * (st2 >> 2) + 8 * q; hbuf[st & 3][0] = *(const f32x4*)(h0base + off2); hbuf[st & 3][1] = *(const f32x4*)(h0base + off2 + 4); }
        asm volatile("" ::: "memory");
        const f32x4 x0 = *(const LAS f32x4*)(XW + (64 * w + p) * 8), x1 = *(const LAS f32x4*)(XW + (64 * w + p) * 8 + 4);
        f32x4 na = ha * elast, nb = hb * elast;
        na = na + Bv[0][0] * x0.x; nb = nb + Bv[0][1] * x0.x; na = na + Bv[1][0] * x0.y; nb = nb + Bv[1][1] * x0.y; na = na + Bv[2][0] * x0.z; nb = nb + Bv[2][1] * x0.z; na = na + Bv[3][0] * x0.w; nb = nb + Bv[3][1] * x0.w;
        na = na + Bv[4][0] * x1.x; nb = nb + Bv[4][1] * x1.x; na = na + Bv[5][0] * x1.y; nb = nb + Bv[5][1] * x1.y; na = na + Bv[6][0] * x1.z; nb = nb + Bv[6][1] * x1.z; na = na + Bv[7][0] * x1.w; nb = nb + Bv[7][1] * x1.w;
        *(f32x4*)(hobase + off) = na; *(f32x4*)(hobase + off + 4) = nb;
        const v4u ap = (v4u){pk2(ha.x, ha.y), pk2(ha.z, ha.w), pk2(hb.x, hb.y), pk2(hb.z, hb.w)};
        acc[pf] = MFMA16(__builtin_bit_cast(bf16x8v, ap), bc[ks], acc[pf]); }
    __syncthreads();
    const int tc = r & 7; const float ct = CD[w * 16 + tc], ect = __expf(ct), Dh = F.ssd_D[hd];
    float L[8]; { const f32x4 c0 = *(const LAS f32x4*)(CBm + r * 16), c1 = *(const LAS f32x4*)(CBm + r * 16 + 4); const float cbv[8] = {c0.x, c0.y, c0.z, c0.w, c1.x, c1.y, c1.z, c1.w};
        const f32x4 q0 = *(const LAS f32x4*)(CD + w * 16), q1 = *(const LAS f32x4*)(CD + w * 16 + 4), d0 = *(const LAS f32x4*)(CD + w * 16 + 8), d1 = *(const LAS f32x4*)(CD + w * 16 + 12);
        const float cu[8] = {q0.x, q0.y, q0.z, q0.w, q1.x, q1.y, q1.z, q1.w}, dd[8] = {d0.x, d0.y, d0.z, d0.w, d1.x, d1.y, d1.z, d1.w};
#pragma unroll
        for (int s = 0; s < 8; ++s) L[s] = (s <= tc) ? cbv[s] * __expf(ct - cu[s]) * dd[s] : 0.f; }
    float ss = 0.f; const size_t row = (size_t)(row0 + tc);
#pragma unroll
    for (int pf = 0; pf < 4; ++pf) { const int p4 = 64 * w + 16 * pf + 4 * q;
        f32x4 y = acc[pf] * ect;
#pragma unroll
        for (int s = 0; s < 8; ++s) y = y + *(const LAS f32x4*)(Xs + s * 512 + p4) * L[s];
        const f32x4 xt = *(const LAS f32x4*)(Xs + tc * 512 + p4); const v2u zv = *(const v2u*)(F.PROJ + row * NP + CZ + g * 512 + p4);
        y.x = (y.x + Dh * xt.x) * silu_f(bflo(zv.x)); y.y = (y.y + Dh * xt.y) * silu_f(bfhi(zv.x)); y.z = (y.z + Dh * xt.z) * silu_f(bflo(zv.y)); y.w = (y.w + Dh * xt.w) * silu_f(bfhi(zv.y));
        acc[pf] = y; ss += (y.x * y.x + y.y * y.y) + (y.z * y.z + y.w * y.w); }
    ss += __shfl_xor(ss, 16); ss += __shfl_xor(ss, 32);
    if (q == 0) red[w * 16 + r] = ss;
    __syncthreads();
    float tot = 0.f;
#pragma unroll
    for (int ww = 0; ww < 8; ++ww) tot += red[ww * 16 + r];
    const float rr = rsqrtf(tot * (1.f / 512.f) + EPS);
    if (r < 8) {
#pragma unroll
        for (int pf = 0; pf < 4; ++pf) { const int p4 = g * 512 + 64 * w + 16 * pf + 4 * q; const f32x4 nw = *(const f32x4*)(F.ssd_norm + p4);
            f32x4 o = acc[pf]; o.x *= rr * nw.x; o.y *= rr * nw.y; o.z *= rr * nw.z; o.w *= rr * nw.w;
            *(v2u*)(F.MIXIN + row * DM + 1024 + p4) = pk4(o); } }
    __syncthreads();
}

__device__ __forceinline__ void p2a_chunk_states(Frame& F) {
    for (int idx = F.bid; idx < 768; idx += F.G) { if (idx < 256) { TBEGIN(F, 20); ssd_passA_unit(F, idx); TEND(F, 20); } else { TBEGIN(F, 21); gla_passA_unit(F, idx - 256); TEND(F, 21); } }
}
#ifndef MK_REP_PHASE
#define MK_REP_PHASE (-1)
#endif
__device__ __forceinline__ void p2b_scans_and_sample(Frame& F) {
    TBEGIN(F, 30); for (int rep = 0; rep < (MK_REP_PHASE == 30 ? 2 : 1); ++rep) { gla_scan(F); ssd_scan(F); } TEND(F, 30);
    TBEGIN(F, 31);
    for (int rep = 0; rep < (MK_REP_PHASE == 31 ? 2 : 1); ++rep)
    { f32x4 S[16]; int idx = F.bid;
            if (idx < SB * GH) { const f32x4* s0 = (const f32x4*)(F.st_gla + ((size_t)idx * GK + 16 * F.wave) * GV) + F.lane;
#pragma unroll
                for (int i = 0; i < 16; ++i) S[i] = s0[i * 64]; }
            for (; idx < SB * GH; idx += F.G) { const int nx = idx + F.G; gla_sample_unit(F, idx / GH, idx % GH, S, nx / GH, nx % GH, nx < SB * GH); } }
    TEND(F, 31); TBEGIN(F, 32);
    for (int rep = 0; rep < (MK_REP_PHASE == 32 ? 2 : 1); ++rep)
        for (int idx = F.bid; idx < SB * SG; idx += F.G) ssd_sample_unit(F, idx / SG, idx % SG);
    TEND(F, 32);
}
__device__ __forceinline__ void p2c_outputs(Frame& F) {
    for (int idx = F.bid; idx < 768; idx += F.G) { if (idx < 256) { TBEGIN(F, 40); ssd_passC_unit(F, idx); TEND(F, 40); } else { TBEGIN(F, 41); gla_passC_unit(F, idx - 256); TEND(F, 41); } }
    TBEGIN(F, 42);
    const int gt = F.bid * NTHR + F.tid, NT = F.G * NTHR;
    for (int i = gt; i < (PB + SB) * 3 * SCH; i += NT) { const int c = i % SCH, j = (i / SCH) % 3, s = i / (3 * SCH);
        const int grp = s >= PB, b = grp ? s - PB : s, L = grp ? SL : PL, row0 = grp ? MP + b * SL : b * PL;
        F.out[(grp ? O_SCONV_S : O_SCONV_P) + ((size_t)b * 3 + j) * SCH + c] = bf2f(F.PROJ[(size_t)(row0 + L - 3 + j) * NP + CX + c]); }
    TEND(F, 42);
}

__device__ __forceinline__ void p4_post_mixer(Frame& F) {
    const int gw = F.bid * NWAVES + F.wave, NGW = F.G * NWAVES, lane = F.lane;
    for (int m = gw; m < M; m += NGW) {
        const f32x4* mr = (const f32x4*)(F.MIX + (size_t)m * DM) + lane; const f32x4* xr = (const f32x4*)x_row(F, m) + lane;
        const f32x4* w1 = (const f32x4*)F.n_mix_post + lane; const f32x4* w2 = (const f32x4*)F.n_ffn_pre + lane;
        f32x4 v[8]; float s = 0.f;
#pragma unroll
        for (int j = 0; j < 8; ++j) { v[j] = mr[64 * j]; s += (v[j].x * v[j].x + v[j].y * v[j].y) + (v[j].z * v[j].z + v[j].w * v[j].w); }
        const float r1 = rsqrtf(wave_sum(s) * (1.f / DM) + EPS); float s2 = 0.f;
        f32x4* ho = (f32x4*)(F.out + O_Y + (size_t)m * DM) + lane;
#pragma unroll
        for (int j = 0; j < 8; ++j) { v[j] = xr[64 * j] + v[j] * r1 * w1[64 * j]; ho[64 * j] = v[j]; s2 += (v[j].x * v[j].x + v[j].y * v[j].y) + (v[j].z * v[j].z + v[j].w * v[j].w); }
        const float r2 = rsqrtf(wave_sum(s2) * (1.f / DM) + EPS);
        v2u* o8 = (v2u*)(F.XN + (size_t)m * DM) + lane;
#pragma unroll
        for (int j = 0; j < 8; ++j) { const f32x4 ww = w2[64 * j]; v2u o; o.x = pk2(v[j].x * r2 * ww.x, v[j].y * r2 * ww.y); o.y = pk2(v[j].z * r2 * ww.z, v[j].w * r2 * ww.w); o8[64 * j] = o; }
    }
}
__device__ __forceinline__ void p6_conv_fixup(Frame& F) {
    const int gt = F.bid * NTHR + F.tid, NT = F.G * NTHR;
    constexpr int NQ = FF / 4;
    for (int it = gt; it < 28 * 2 * NQ; it += NT) { const int c = (it % NQ) * 4, rr = (it / NQ) & 1, bi = it / (2 * NQ), pm = (bi / 7) * 8 + 1 + (bi % 7);
        f32x4 o[2];
#pragma unroll
        for (int hf = 0; hf < 2; ++hf) { const int cc = hf * FF + c;
            const f32x4 w0 = *(const f32x4*)(F.fconv_w + cc), w1 = *(const f32x4*)(F.fconv_w + FF2 + cc), w2 = *(const f32x4*)(F.fconv_w + 2 * FF2 + cc), bs = *(const f32x4*)(F.fconv_b + cc);
            const f32x4 um2 = *(const f32x4*)(F.HG + ((size_t)(pm - 1) * 4 + 2 + rr) * FF2 + cc);
            const f32x4 um1 = rr ? *(const f32x4*)(F.HG + ((size_t)pm * 4) * FF2 + cc) : *(const f32x4*)(F.HG + ((size_t)(pm - 1) * 4 + 3) * FF2 + cc);
            const f32x4 u0 = *(const f32x4*)(F.HG + ((size_t)pm * 4 + rr) * FF2 + cc);
            o[hf] = bs + w0 * um2 + w1 * um1 + w2 * u0; }
        v2u pk; pk.x = pk2(silu_f(o[0].x) * o[1].x, silu_f(o[0].y) * o[1].y); pk.y = pk2(silu_f(o[0].z) * o[1].z, silu_f(o[0].w) * o[1].w);
        *(v2u*)(F.ACT + (size_t)(pm * 256 + rr) * FF + c) = pk; }
    for (int i = gt; i < PB * 2 * (FF2 / 4); i += NT) { const int c = (i % (FF2 / 4)) * 4, j = (i / (FF2 / 4)) & 1, b = i / (2 * (FF2 / 4));
        *(f32x4*)(F.out + O_FCONV_P + ((size_t)b * 2 + j) * FF2 + c) = *(const f32x4*)(F.HG + ((size_t)(b * 8 + 7) * 4 + 2 + j) * FF2 + c); }
}
__device__ __forceinline__ void p8_final(Frame& F) {
    const int gw = F.bid * NWAVES + F.wave, NGW = F.G * NWAVES, lane = F.lane;
    for (int m = gw; m < M; m += NGW) {
        const f32x4* fr = (const f32x4*)(F.Fb + (size_t)m * DM) + lane; const f32x4* w1 = (const f32x4*)F.n_ffn_post + lane;
        f32x4* ho = (f32x4*)(F.out + O_Y + (size_t)m * DM) + lane;
        f32x4 v[8]; float s = 0.f;
#pragma unroll
        for (int j = 0; j < 8; ++j) { v[j] = fr[64 * j]; s += (v[j].x * v[j].x + v[j].y * v[j].y) + (v[j].z * v[j].z + v[j].w * v[j].w); }
        const float r1 = rsqrtf(wave_sum(s) * (1.f / DM) + EPS);
#pragma unroll
        for (int j = 0; j < 8; ++j) ho[64 * j] = ho[64 * j] + v[j] * r1 * w1[64 * j];
    }
}

__device__ __forceinline__ pg8::SplitCtx split_ctx(const Frame& F, unsigned char* ws, size_t slab_off, int bank) {
    pg8::SplitCtx X; X.slabs = (pg8::f32x4*)(ws + slab_off); X.cnt = (unsigned*)(ws + WS_CTL) + CW_SPLIT + bank * 1024; X.flag = (volatile LAS unsigned*)(F.lds + MISC_OFF) + 16; return X; }

struct Args { const float* in[25]; float* out; unsigned char* ws; int ph_lo, ph_hi; };
__global__ void __launch_bounds__(NTHR, 2) fwd_kernel(Args args) {
    extern __shared__ __attribute__((aligned(16))) unsigned char lds[];
    Frame F;
    F.lds = (LAS unsigned char*)lds;
    F.tid = threadIdx.x; F.lane = F.tid & 63; F.wave = __builtin_amdgcn_readfirstlane(F.tid >> 6);
    F.G = gridDim.x; F.bid = blockIdx.x;
    unsigned char* ws = args.ws;
    F.x_p = args.in[0]; F.x_s = args.in[1]; F.st_gla = args.in[2]; F.st_ssd = args.in[3]; F.st_sconv = args.in[4]; F.st_fconv = args.in[5];
    F.n_mix_pre = args.in[6]; F.n_mix_post = args.in[7]; F.n_ffn_pre = args.in[8]; F.n_ffn_post = args.in[9]; F.w_in = args.in[10];
    F.w_gate2 = args.in[11]; F.b_gate = args.in[12]; F.gla_norm = args.in[13]; F.sconv_w = args.in[14]; F.sconv_b = args.in[15];
    F.dt_bias = args.in[16]; F.A_log = args.in[17]; F.ssd_D = args.in[18]; F.ssd_norm = args.in[19]; F.w_out = args.in[20];
    F.ffn_w_in = args.in[21]; F.fconv_w = args.in[22]; F.fconv_b = args.in[23]; F.ffn_w_out = args.in[24];
    F.out = args.out;
    F.W1 = (bf16*)(ws + WS_W1); F.WO = (bf16*)(ws + WS_WO); F.WF1 = (bf16*)(ws + WS_WF1); F.WF2 = (bf16*)(ws + WS_WF2);
    F.XN = (bf16*)(ws + WS_XN); F.PROJ = (bf16*)(ws + WS_PROJ); F.MIXIN = (bf16*)(ws + WS_MIXIN); F.ACT = (bf16*)(ws + WS_ACT); F.HG = (float*)(ws + WS_HG);
    F.LRDT = (float*)(ws + WS_LRDT); F.MIX = (float*)(ws + WS_MIX); F.Fb = (float*)(ws + WS_F);
    F.DS = (bf16*)(ws + WS_DS); F.SC = (bf16*)(ws + WS_SC); F.DH = (bf16*)(ws + WS_DH); F.HC = (bf16*)(ws + WS_HC); F.EBL = (float*)(ws + WS_EBL); F.AL = (float*)(ws + WS_AL);
    for (int u = F.tid; u < (LDS_BYTES - LDSCTL_OFF) / 4; u += NTHR) ((LAS unsigned*)(F.lds + LDSCTL_OFF))[u] = 0u;
    __syncthreads();
    const int lo = args.ph_lo, hi = args.ph_hi;
#if !MK_PER_PHASE
    XcdBarrier bar = xcd_barrier_post((unsigned*)(ws + WS_CTL) + CW_BAR, (volatile LAS unsigned*)(F.lds + MISC_OFF) + 8);
#define GRID_BAR() do { if (args.ph_hi > 1000) cg::this_grid().sync(); xcd_barrier(bar); } while (0)
#else
#define GRID_BAR() do { } while (0)
#endif
#define IN(k) (lo <= (k) && (k) < hi)
#define SEAM(k) do { if (IN(k) && IN((k) + 1)) GRID_BAR(); } while (0)
    F.tacc = 0; F.tmark = 0;
#define PHASE(k, ...) do { if (IN(k)) { TBEGIN(F, k); if (MK_REP_PHASE == (k)) { __VA_ARGS__; GRID_BAR(); } __VA_ARGS__; SEAM(k); TEND(F, k); } } while (0)
    PHASE(0, p0_prologue(F));
    PHASE(1, { pg8::Gemm g{F.XN, F.W1, M, N1, DM}; pg8::StaticOrder S; S.init(M, N1, DM, F.G, F.bid, 1);
        pg8::EpiBf16 E{F.PROJ, NP, NP / 256, F.LRDT};
        pg8::gemm_phase<pg8::EpiBf16, pg8::StaticOrder, true, true>(F.lds, g, S, E, split_ctx(F, ws, WS_SLAB, 0));
        if (S.rem && F.bid >= S.rem * S.S) p0_convert_rest(F, F.bid - S.rem * S.S, F.G - S.rem * S.S); else if (!S.rem) p0_convert_rest(F, F.bid, F.G); });
    PHASE(2, p2a_chunk_states(F));
    PHASE(3, p2b_scans_and_sample(F));
    PHASE(4, p2c_outputs(F));
    PHASE(5, { pg8::Gemm g{F.MIXIN, F.WO, M, DM, DM}; pg8::StaticOrder S; S.init(M, DM, DM, F.G, F.bid, 8);
        pg8::EpiF32 E{F.MIX, DM};
        pg8::gemm_phase<pg8::EpiF32, pg8::StaticOrder, true, true>(F.lds, g, S, E, split_ctx(F, ws, WS_SLAB, 1)); });
    PHASE(6, p4_post_mixer(F));
    PHASE(7, { pg8::Gemm g{F.XN, F.WF1, M, FF2, DM}; pg8::StaticOrder S; S.init(M, FF2, DM, F.G, F.bid, 1);
        pg8::EpiConvAct E{F.ACT, F.HG, F.fconv_w, F.fconv_b, F.st_fconv, F.out + O_FCONV_S, (LAS float*)(F.lds + MISC_OFF + 512)};
        pg8::gemm_phase<pg8::EpiConvAct, pg8::StaticOrder, true, true>(F.lds, g, S, E, split_ctx(F, ws, WS_SLAB, 2)); });
    PHASE(8, p6_conv_fixup(F));
    PHASE(9, { pg8::Gemm g{F.ACT, F.WF2, M, DM, FF}; pg8::StaticOrder S; S.init(M, DM, FF, F.G, F.bid, 8);
        pg8::EpiF32 E{F.Fb, DM};
        pg8::gemm_phase<pg8::EpiF32, pg8::StaticOrder, true, true>(F.lds, g, S, E, split_ctx(F, ws, WS_SLAB, 3)); });
    if (IN(10)) { TBEGIN(F, 10); p8_final(F); if (MK_TIME_PHASE == 10) { asm volatile("s_waitcnt vmcnt(0)" ::: "memory"); __syncthreads(); } TEND(F, 10); }
    if (MK_TIME_PHASE >= 0 && F.bid == 0) { const unsigned long long te = __builtin_amdgcn_s_memrealtime(), d = 8ull * F.tacc; while (__builtin_amdgcn_s_memrealtime() - te < d) __builtin_amdgcn_s_sleep(16); }
#undef IN
#undef SEAM
}

extern "C" void kernel_launch(void* const* d_in, const int* in_sizes, int n_in, void* d_out, int out_size, void* d_ws, size_t ws_size, hipStream_t stream) {
    static int grid = 0;
    if (grid == 0) {
        if (n_in != 25 || (size_t)out_size != O_END || ws_size < WS_END) { fprintf(stderr, "kernel_launch: unexpected sizes n_in %d out %d ws %zu (need out %zu ws %zu)\n", n_in, out_size, ws_size, (size_t)O_END, (size_t)WS_END); grid = -1; return; }
        int dev = 0, cus = 0, per_cu = 0;
        hipGetDevice(&dev); hipDeviceGetAttribute(&cus, hipDeviceAttributeMultiprocessorCount, dev);
        if (hipFuncSetAttribute((const void*)fwd_kernel, hipFuncAttributeMaxDynamicSharedMemorySize, LDS_BYTES) != hipSuccess) { fprintf(stderr, "kernel_launch: hipFuncSetAttribute failed\n"); grid = -1; return; }
        hipOccupancyMaxActiveBlocksPerMultiprocessor(&per_cu, (const void*)fwd_kernel, NTHR, LDS_BYTES);
        if (per_cu < 1) { fprintf(stderr, "kernel_launch: occupancy query says %d blocks per CU\n", per_cu); grid = -1; return; }
        grid = cus;
        (void)hipGetLastError();
    }
    if (grid < 0) return;
    Args a{};
    for (int i = 0; i < 25; ++i) a.in[i] = (const float*)d_in[i];
    a.out = (float*)d_out; a.ws = (unsigned char*)d_ws;
#if MK_PER_PHASE
    hipMemsetAsync((char*)d_ws + WS_CTL, 0, CTL_ZERO_BYTES, stream);
    for (int p = 0; p < N_PHASES; ++p) { a.ph_lo = p; a.ph_hi = p + 1; hipLaunchKernelGGL(fwd_kernel, dim3(grid), dim3(NTHR), LDS_BYTES, stream, a); }
#else
    hipMemsetAsync((char*)d_ws + WS_CTL, 0, CTL_ZERO_BYTES, stream);
    a.ph_lo = 0; a.ph_hi = N_PHASES;
    void* kargs[] = {&a};
    hipError_t e = hipLaunchCooperativeKernel((const void*)fwd_kernel, dim3(grid), dim3(NTHR), kargs, LDS_BYTES, stream);
    if (e != hipSuccess) fprintf(stderr, "kernel_launch: cooperative launch failed: %s (grid %d)\n", hipGetErrorString(e), grid);
#endif
}
```

```cpp
#include <hip/hip_runtime.h>
#include <hip/hip_cooperative_groups.h>
#include <cstdio>
#include <cstdint>
namespace cg = cooperative_groups;

#ifndef MK_PER_PHASE
#define MK_PER_PHASE 0
#endif

namespace pg8 {
#define PG8_LAS __attribute__((address_space(3)))
typedef unsigned short bf16_t;
typedef short bf16x8 __attribute__((ext_vector_type(8)));
typedef float f32x4 __attribute__((ext_vector_type(4)));
typedef unsigned u32x4 __attribute__((ext_vector_type(4)));
constexpr int BM = 256, BK = 64, HALF = 128, HTB = HALF * BK * 2  , STAGE_BYTES = 8 * HTB, NXCD = 8, WGM = 8;

__host__ __device__ __forceinline__ int lds_byte(int r, int c) { const int st = (r >> 4) * 2 + (c >> 5), rr = r & 15, cc = c & 31, ob = rr * 64 + cc * 2; return st * 1024 + (ob ^ (((ob >> 9) & 1) << 5)); }
__host__ __device__ __forceinline__ void stage_rc(int b, int& R, int& C) { const int st = b / 1024, sb = b % 1024, swz = sb ^ (((sb >> 9) & 1) << 5); R = (st >> 1) * 16 + swz / 64; C = (st & 1) * 32 + (swz % 64) / 2; }
__host__ __device__ __forceinline__ int perm32(int rho) { const int n = rho >> 4, i = rho & 15; return 8 * (i >> 2) + 4 * n + (i & 3); }

struct Unit { int pm, pn, k0, nk, slice, nsl, tix; };
struct Gemm { const bf16_t* A; const bf16_t* Bt; int M, N, K; };

struct StaticOrder {
    int nM, nN, nwg, G, c, rounds, rem, S, ntK;
    __host__ __device__ __forceinline__ void init(int M, int N, int K, int G_, int c_, int Smax) { nM = M / BM; nN = N / BM; nwg = nM * nN; G = G_; c = c_; ntK = K / BK; rounds = nwg / G; rem = nwg - rounds * G; S = 1;
        if (rem) { while (S < Smax && rem * (S * 2) <= G && (ntK / 2) >= S * 2) S *= 2; } }
    __host__ __device__ __forceinline__ void tile(int L, Unit& u) const {
        int wgid = L; { const int q = nwg / NXCD, r = nwg % NXCD, xcd = wgid % NXCD, off = wgid / NXCD; wgid = (xcd < r ? xcd * (q + 1) : r * (q + 1) + (xcd - r) * q) + off; }
        const int nig = WGM * nN, gid = wgid / nig, fm = gid * WGM, gsz = (nM - fm) < WGM ? (nM - fm) : WGM;
        u.pm = fm + ((wgid % nig) % gsz); u.pn = (wgid % nig) / gsz; }
    __host__ __device__ __forceinline__ bool next(int i, Unit& u) const {
        if (i < rounds) { tile(i * G + c, u); u.k0 = 0; u.nk = ntK; u.slice = 0; u.nsl = 1; u.tix = 0; return true; }
        if (i == rounds && c < rem * S) { const int tix = c % rem, sl = c / rem; tile(rounds * G + tix, u);
            const int pairs = ntK / 2, base = pairs / S, extra = pairs % S, np = base + (sl < extra ? 1 : 0), p0 = sl * base + (sl < extra ? sl : extra);
            u.k0 = 2 * p0; u.nk = 2 * np; u.slice = sl; u.nsl = S; u.tix = tix; return true; }
        return false;
    }
    __device__ __forceinline__ void a_ready(const Unit&) const {}
    __device__ __forceinline__ void done(const Unit&) const {}
};
__device__ __forceinline__ unsigned cvt_pk_bf16(float lo, float hi) { unsigned r; asm volatile("v_cvt_pk_bf16_f32 %0, %1, %2" : "=v"(r) : "v"(lo), "v"(hi)); return r; }
struct SplitCtx { f32x4* slabs; unsigned* cnt; volatile PG8_LAS unsigned* flag; };
__device__ __forceinline__ int split_reduce(f32x4 (&acc)[2][2][4][2], const Unit& u, const SplitCtx& X, int tid) {
    const __amdgpu_buffer_rsrc_t rs = __builtin_amdgcn_make_buffer_rsrc((void*)X.slabs, (short)0, (int)0x7fffffff, 0x00020000);
    typedef unsigned u32x2s __attribute__((ext_vector_type(2)));
    const unsigned mine = (unsigned)((u.tix * u.nsl + u.slice) * 32) * 4096u + (unsigned)tid * 8u;
#pragma unroll
    for (int a = 0; a < 2; ++a)
#pragma unroll
        for (int b = 0; b < 2; ++b)
#pragma unroll
            for (int m = 0; m < 4; ++m)
#pragma unroll
                for (int n = 0; n < 2; ++n) { const f32x4 v = acc[a][b][m][n]; __builtin_amdgcn_raw_buffer_store_b64((u32x2s){cvt_pk_bf16(v.x, v.y), cvt_pk_bf16(v.z, v.w)}, rs, mine + (unsigned)((((a * 2 + b) * 4 + m) * 2 + n) * 4096), 0,   16); }
    asm volatile("s_waitcnt vmcnt(0)" ::: "memory");
    __syncthreads();
    if (tid == 0) {
        unsigned* c = X.cnt + 16 * u.tix;
        (void)__hip_atomic_fetch_add(c, 1u, __ATOMIC_RELAXED, __HIP_MEMORY_SCOPE_AGENT);
        unsigned spins = 0;
        while (__hip_atomic_load(c, __ATOMIC_RELAXED, __HIP_MEMORY_SCOPE_AGENT) < (unsigned)u.nsl) { __builtin_amdgcn_s_sleep(2); if (++spins > (1u << 22)) break; }
        __builtin_amdgcn_fence(__ATOMIC_ACQUIRE, "agent");
        asm volatile("s_waitcnt vmcnt(0)" ::: "memory");
    }
    __syncthreads();
    const int shift = u.nsl == 8 ? 2 : (u.nsl == 4 ? 3 : 4);
    for (int s = 0; s < u.nsl; ++s) { if (s == u.slice) continue;
        const u32x2s* o = (const u32x2s*)X.slabs + ((size_t)(u.tix * u.nsl + s) * 32) * 512 + tid;
#pragma unroll
        for (int a = 0; a < 2; ++a)
#pragma unroll
            for (int b = 0; b < 2; ++b)
#pragma unroll
                for (int m = 0; m < 4; ++m)
#pragma unroll
                    for (int n = 0; n < 2; ++n) { const int r4 = ((a * 2 + b) * 4 + m) * 2 + n; if ((r4 >> shift) == u.slice) { const u32x2s p = o[(size_t)r4 * 512]; acc[a][b][m][n] += (f32x4){__builtin_bit_cast(float, p.x << 16), __builtin_bit_cast(float, p.x & 0xffff0000u), __builtin_bit_cast(float, p.y << 16), __builtin_bit_cast(float, p.y & 0xffff0000u)}; } } }
    return shift;
}


struct EpiF32 {
    static constexpr bool PERM = false, AFTER_DRAIN = false;
    float* C; int ldc;
    __device__ __forceinline__ void operator()(const f32x4 (&acc)[2][2][4][2], const Unit& u, int wr, int wc, int fr, int fq, int shift, int part) const {
        const int row0 = u.pm * BM + wr * 64 + fr, col0 = u.pn * BM + wc * 32 + 4 * fq;
#pragma unroll
        for (int ai = 0; ai < 2; ++ai)
#pragma unroll
            for (int m = 0; m < 4; ++m) { float* rowp = C + (size_t)(row0 + ai * HALF + m * 16) * ldc + col0;
#pragma unroll
                for (int bj = 0; bj < 2; ++bj)
#pragma unroll
                    for (int n = 0; n < 2; ++n) if ((((((ai * 2 + bj) * 4 + m) * 2 + n)) >> shift) == part) *(f32x4*)(rowp + bj * HALF + n * 16) = acc[ai][bj][m][n]; }
    }
};
struct EpiBf16 {
    static constexpr bool PERM = true, AFTER_DRAIN = false;
    bf16_t* O; int ldc; int nfull; float* X;
    __device__ __forceinline__ void operator()(const f32x4 (&acc)[2][2][4][2], const Unit& u, int wr, int wc, int fr, int fq, int shift, int part) const {
        const int row0 = u.pm * BM + wr * 64 + fr;
        if (u.pn < nfull) {
            const int col0 = u.pn * BM + wc * 32 + 8 * fq;
#pragma unroll
            for (int ai = 0; ai < 2; ++ai)
#pragma unroll
                for (int m = 0; m < 4; ++m) { bf16_t* rowp = O + (size_t)(row0 + ai * HALF + m * 16) * ldc + col0;
#pragma unroll
                    for (int bj = 0; bj < 2; ++bj) { if ((((((ai * 2 + bj) * 4 + m) * 2)) >> shift) != part) continue; const f32x4 v0 = acc[ai][bj][m][0], v1 = acc[ai][bj][m][1];
                        u32x4 w; w.x = cvt_pk_bf16(v0[0], v0[1]); w.y = cvt_pk_bf16(v0[2], v0[3]); w.z = cvt_pk_bf16(v1[0], v1[1]); w.w = cvt_pk_bf16(v1[2], v1[3]);
                        *(u32x4*)(rowp + bj * HALF) = w; } }
        } else if (wc == 0) {
#pragma unroll
            for (int ai = 0; ai < 2; ++ai)
#pragma unroll
                for (int m = 0; m < 4; ++m) { if ((((((ai * 2) * 4 + m) * 2)) >> shift) != part) continue; float* rowp = X + (size_t)(row0 + ai * HALF + m * 16) * 32 + 8 * fq;
                    *(f32x4*)(rowp) = acc[ai][0][m][0]; *(f32x4*)(rowp + 4) = acc[ai][0][m][1]; }
        }
    }
};

__device__ __forceinline__ float dpp_ror1(float x) { return __builtin_bit_cast(float, __builtin_amdgcn_update_dpp(0, __builtin_bit_cast(int, x), 0x121, 0xF, 0xF, false)); }
__device__ __forceinline__ float dpp_ror2(float x) { return __builtin_bit_cast(float, __builtin_amdgcn_update_dpp(0, __builtin_bit_cast(int, x), 0x122, 0xF, 0xF, false)); }
struct EpiConvAct {
    static constexpr bool PERM = true, AFTER_DRAIN = false;
    static constexpr int FFD = 5632, FFD2 = 11264, MPR = 8192, NPT = 32;
    bf16_t* ACT; float* HG; const float* cw; const float* cbias; const float* st; float* fconv_s; PG8_LAS float* halo;
    __device__ __forceinline__ void operator()(const f32x4 (&acc)[2][2][4][2], const Unit& u, int wr, int wc, int fr, int fq, int, int) const {
        if (u.pm >= NPT) body<true>(acc, u, wr, wc, fr, fq); else body<false>(acc, u, wr, wc, fr, fq); }
    template <bool sample> __device__ __forceinline__ void body(const f32x4 (&acc)[2][2][4][2], const Unit& u, int wr, int wc, int fr, int fq) const {
        const int pm = u.pm, pn = u.pn, cl = wc * 32 + 8 * fq, c0 = pn * 128 + cl;
        if (fr >= 14) {
#pragma unroll
            for (int ai = 0; ai < 2; ++ai)
#pragma unroll
                for (int bj = 0; bj < 2; ++bj)
#pragma unroll
                    for (int n = 0; n < 2; ++n) *(PG8_LAS f32x4*)(halo + ((ai * 2 + wr) * 2 + (fr - 14)) * 256 + bj * 128 + cl + 4 * n) = acc[ai][bj][3][n];
            if (!sample && wr == 1) {
#pragma unroll
                for (int bj = 0; bj < 2; ++bj)
#pragma unroll
                    for (int n = 0; n < 2; ++n) *(f32x4*)(HG + ((size_t)pm * 4 + 2 + (fr - 14)) * FFD2 + bj * FFD + c0 + 4 * n) = acc[1][bj][3][n]; }
        }
        if (fr < 2 && !sample && wr == 0) {
#pragma unroll
            for (int bj = 0; bj < 2; ++bj)
#pragma unroll
                for (int n = 0; n < 2; ++n) *(f32x4*)(HG + ((size_t)pm * 4 + fr) * FFD2 + bj * FFD + c0 + 4 * n) = acc[0][bj][0][n]; }
        __syncthreads();
        const int t8 = fr & 7;
        typedef unsigned u32x2 __attribute__((ext_vector_type(2)));
        u32x2 pk0[2][4];
#pragma unroll
        for (int n = 0; n < 2; ++n) {
            f32x4 w[2][3], bs[2];
#pragma unroll
            for (int bj = 0; bj < 2; ++bj) { bs[bj] = *(const f32x4*)(cbias + bj * FFD + c0 + 4 * n);
#pragma unroll
                for (int j = 0; j < 3; ++j) w[bj][j] = *(const f32x4*)(cw + j * FFD2 + bj * FFD + c0 + 4 * n); }
#pragma unroll
            for (int ai = 0; ai < 2; ++ai) {
                f32x4 r1p[2], r2p[2];
#pragma unroll
                for (int bj = 0; bj < 2; ++bj) { f32x4 pv = (f32x4){0.f, 0.f, 0.f, 0.f};
                    if (fr >= 14 && (wr == 1 || ai == 1)) { const int pa = (wr == 1) ? ai : 0, pw = (wr == 1) ? 0 : 1; pv = *(const PG8_LAS f32x4*)(halo + ((pa * 2 + pw) * 2 + (fr - 14)) * 256 + bj * 128 + cl + 4 * n); }
#pragma unroll
                    for (int j = 0; j < 4; ++j) { r1p[bj][j] = dpp_ror1(pv[j]); r2p[bj][j] = dpp_ror2(pv[j]); } }
#pragma unroll
                for (int m = 0; m < 4; ++m) { const int row = pm * BM + ai * HALF + wr * 64 + m * 16 + fr;
                    f32x4 o[2];
#pragma unroll
                    for (int bj = 0; bj < 2; ++bj) { const f32x4 cur = acc[ai][bj][m][n]; f32x4 p1, p2;
#pragma unroll
                        for (int j = 0; j < 4; ++j) { const float c1 = dpp_ror1(cur[j]), c2 = dpp_ror2(cur[j]); p1[j] = (fr == 0) ? r1p[bj][j] : c1; p2[j] = (fr < 2) ? r2p[bj][j] : c2; r1p[bj][j] = c1; r2p[bj][j] = c2; }
                        if (sample && t8 < 2) { const int sb = (row - MPR) >> 3; const f32x4 s1 = *(const f32x4*)(st + ((size_t)sb * 2 + 1) * FFD2 + bj * FFD + c0 + 4 * n);
                            if (t8 == 0) { p1 = s1; p2 = *(const f32x4*)(st + ((size_t)sb * 2) * FFD2 + bj * FFD + c0 + 4 * n); } else p2 = s1; }
                        o[bj] = bs[bj] + w[bj][0] * p2 + w[bj][1] * p1 + w[bj][2] * cur; }
                    f32x4 g; g.x = o[0].x * __builtin_amdgcn_rcpf(1.f + __expf(-o[0].x)) * o[1].x; g.y = o[0].y * __builtin_amdgcn_rcpf(1.f + __expf(-o[0].y)) * o[1].y;
                    g.z = o[0].z * __builtin_amdgcn_rcpf(1.f + __expf(-o[0].z)) * o[1].z; g.w = o[0].w * __builtin_amdgcn_rcpf(1.f + __expf(-o[0].w)) * o[1].w;
                    const u32x2 pk = (u32x2){cvt_pk_bf16(g.x, g.y), cvt_pk_bf16(g.z, g.w)};
                    if (n == 0) pk0[ai][m] = pk;
                    else *(u32x4*)(ACT + (size_t)row * FFD + c0) = (u32x4){pk0[ai][m].x, pk0[ai][m].y, pk.x, pk.y};
                    if (sample && t8 >= 6) { const int sb = (row - MPR) >> 3;
#pragma unroll
                        for (int bj = 0; bj < 2; ++bj) *(f32x4*)(fconv_s + ((size_t)sb * 2 + (t8 - 6)) * FFD2 + bj * FFD + c0 + 4 * n) = acc[ai][bj][m][n]; }
                }
            }
        }
    }
};

template <class Epi, class Sched, bool ALIGN_EPI = false, bool SP2 = false>
__device__ __forceinline__ void gemm_phase(PG8_LAS unsigned char* lds, const Gemm g, const Sched& S, const Epi& E, const SplitCtx& X) {
    const int tid = threadIdx.x, wid = __builtin_amdgcn_readfirstlane(tid >> 6), lane = tid & 63, wr = wid >> 2, wc = wid & 3, fr = lane & 15, fq = lane >> 4;
    const int K = g.K;
    unsigned voffA[2], voffB[2];
#pragma unroll
    for (int i = 0; i < 2; ++i) { int R, C; stage_rc(tid * 16 + i * 8192, R, C); const int Rb = Epi::PERM ? ((R & ~31) + perm32(R & 31)) : R;
        voffA[i] = (unsigned)(R * K + C) * 2u; voffB[i] = (unsigned)(Rb * K + C) * 2u; }
    const size_t kstep = (size_t)(BK * 2);
    const size_t hstep = (size_t)HALF * K * 2;
    const size_t tstep = 2 * hstep;
    const unsigned ldsw = (unsigned)wid * 1024u;
    const int aoff = lds_byte(wr * 64 + fr, fq * 8), boff = lds_byte(wc * 32 + fr, fq * 8);
#define PG8_SA(b, h) (((b) * 2 + (h)) * HTB)
#define PG8_SB(b, h) ((4 + (b) * 2 + (h)) * HTB)
#define PG8_STAGE(bufoff, gbase, voff) do { _Pragma("unroll") for (int _i = 0; _i < 2; ++_i) \
        __builtin_amdgcn_global_load_lds((const unsigned*)((const char*)(gbase) + (voff)[_i]), (PG8_LAS unsigned*)(lds + (bufoff) + ldsw + _i * 8192), 16, 0, 0); } while (0)
#define PG8_LDA(dst, b, h) do { _Pragma("unroll") for (int m = 0; m < 4; ++m) _Pragma("unroll") for (int k = 0; k < 2; ++k) dst[m][k] = *(const PG8_LAS bf16x8*)(lds + PG8_SA(b, h) + aoff + m * 2048 + k * 1024); } while (0)
#define PG8_LDB(dst, b, h) do { _Pragma("unroll") for (int n = 0; n < 2; ++n) _Pragma("unroll") for (int k = 0; k < 2; ++k) dst[n][k] = *(const PG8_LAS bf16x8*)(lds + PG8_SB(b, h) + boff + n * 2048 + k * 1024); } while (0)
#define PG8_MMA(ai, bj, At, Bt) do { __builtin_amdgcn_s_setprio(1); _Pragma("unroll") for (int m = 0; m < 4; ++m) _Pragma("unroll") for (int n = 0; n < 2; ++n) _Pragma("unroll") for (int k = 0; k < 2; ++k) \
        acc[ai][bj][m][n] = __builtin_amdgcn_mfma_f32_16x16x32_bf16(Bt[n][k], At[m][k], acc[ai][bj][m][n], 0, 0, 0); __builtin_amdgcn_s_setprio(0); } while (0)
#define PG8_WAIT_V(n) asm volatile("s_waitcnt vmcnt(" #n ")" ::: "memory")
#define PG8_WAIT_L(n) asm volatile("s_waitcnt lgkmcnt(" #n ")" ::: "memory")
#define PG8_BAR __builtin_amdgcn_s_barrier()
#define PG8_SCHED __builtin_amdgcn_sched_barrier(0)
    Unit cur, nxt; int ui = 0;
    if (!S.next(0, cur)) return;
    f32x4 acc[2][2][4][2];
#pragma unroll
    for (int a = 0; a < 2; ++a)
#pragma unroll
        for (int b = 0; b < 2; ++b)
#pragma unroll
            for (int m = 0; m < 4; ++m)
#pragma unroll
                for (int n = 0; n < 2; ++n) acc[a][b][m][n] = (f32x4){0.f, 0.f, 0.f, 0.f};
    bf16x8 At[4][2], B0[2][2], B1[2][2];
    const char* cA = (const char*)g.A + (size_t)cur.pm * tstep + (size_t)cur.k0 * kstep; const char* cB = (const char*)g.Bt + (size_t)cur.pn * tstep + (size_t)cur.k0 * kstep;
    S.a_ready(cur);
    if constexpr (SP2) {
        PG8_STAGE(PG8_SB(0, 0), cB, voffB); PG8_STAGE(PG8_SB(0, 1), cB + hstep, voffB); PG8_STAGE(PG8_SA(0, 0), cA, voffA); PG8_STAGE(PG8_SA(0, 1), cA + hstep, voffA);
        if (wr == 1) PG8_BAR;
        PG8_WAIT_V(2); PG8_BAR;
        PG8_STAGE(PG8_SB(1, 0), cB + kstep, voffB); PG8_STAGE(PG8_SA(1, 0), cA + kstep, voffA); PG8_STAGE(PG8_SB(1, 1), cB + hstep + kstep, voffB);
        PG8_WAIT_V(6); PG8_BAR;
    } else {
        PG8_STAGE(PG8_SB(0, 0), cB, voffB); PG8_STAGE(PG8_SA(0, 0), cA, voffA); PG8_STAGE(PG8_SB(0, 1), cB + hstep, voffB); PG8_STAGE(PG8_SA(0, 1), cA + hstep, voffA);
        if (wr == 1) PG8_BAR;
        PG8_WAIT_V(4); PG8_BAR;
        PG8_STAGE(PG8_SB(1, 0), cB + kstep, voffB); PG8_STAGE(PG8_SA(1, 0), cA + kstep, voffA); PG8_STAGE(PG8_SB(1, 1), cB + hstep + kstep, voffB);
        PG8_WAIT_V(6); PG8_BAR;
    }
    for (;;) {
        const bool has_next = S.next(ui + 1, nxt);
        const char* nA = has_next ? (const char*)g.A + (size_t)nxt.pm * tstep + (size_t)nxt.k0 * kstep : cA; const char* nB = has_next ? (const char*)g.Bt + (size_t)nxt.pn * tstep + (size_t)nxt.k0 * kstep : cB;
        const int nt = cur.nk;
        for (int t = 0; t < nt; t += 2) {
            const bool last = (t == nt - 2);
            const char* a1 = cA + (size_t)(t + 1) * kstep;
            const char* a2 = last ? nA : cA + (size_t)(t + 2) * kstep; const char* b2 = last ? nB : cB + (size_t)(t + 2) * kstep;
            const char* a3 = a2 + kstep; const char* b3 = b2 + kstep;
            if (last && has_next) S.a_ready(nxt);
            if constexpr (SP2) {
            PG8_LDB(B0, 0, 0); PG8_LDB(B1, 0, 1); PG8_SCHED; PG8_LDA(At, 0, 0); PG8_STAGE(PG8_SA(1, 1), a1 + hstep, voffA);
            PG8_WAIT_V(8); PG8_WAIT_L(0); PG8_BAR; PG8_MMA(0, 0, At, B0); PG8_MMA(0, 1, At, B1); PG8_BAR; PG8_SCHED;
            PG8_LDA(At, 0, 1); PG8_STAGE(PG8_SB(0, 0), b2, voffB); PG8_STAGE(PG8_SB(0, 1), b2 + hstep, voffB); PG8_STAGE(PG8_SA(0, 0), a2, voffA);
            PG8_WAIT_V(8); PG8_WAIT_L(0); PG8_BAR; PG8_MMA(1, 0, At, B0); PG8_MMA(1, 1, At, B1); PG8_BAR; PG8_SCHED;
            PG8_LDB(B0, 1, 0); PG8_LDB(B1, 1, 1); PG8_SCHED; PG8_LDA(At, 1, 0); PG8_STAGE(PG8_SA(0, 1), a2 + hstep, voffA);
            PG8_WAIT_V(8); PG8_WAIT_L(0); PG8_BAR; PG8_MMA(0, 0, At, B0); PG8_MMA(0, 1, At, B1); PG8_BAR; PG8_SCHED;
            PG8_LDA(At, 1, 1); PG8_STAGE(PG8_SB(1, 0), b3, voffB); PG8_STAGE(PG8_SB(1, 1), b3 + hstep, voffB); PG8_STAGE(PG8_SA(1, 0), a3, voffA);
            PG8_WAIT_V(8); PG8_WAIT_L(0); PG8_BAR; PG8_MMA(1, 0, At, B0); PG8_MMA(1, 1, At, B1); PG8_BAR; PG8_SCHED;
            } else {
            PG8_LDB(B0, 0, 0); PG8_SCHED; PG8_LDA(At, 0, 0); PG8_STAGE(PG8_SA(1, 1), a1 + hstep, voffA);
            PG8_WAIT_L(8); PG8_BAR; PG8_WAIT_L(0); PG8_MMA(0, 0, At, B0); PG8_BAR; PG8_SCHED;
            PG8_LDB(B1, 0, 1); PG8_STAGE(PG8_SB(0, 0), b2, voffB);
            PG8_BAR; PG8_WAIT_L(0); PG8_MMA(0, 1, At, B1); PG8_BAR;
            PG8_LDA(At, 0, 1); PG8_STAGE(PG8_SA(0, 0), a2, voffA);
            PG8_BAR; PG8_WAIT_L(0); PG8_MMA(1, 0, At, B0); PG8_BAR; PG8_SCHED;
            PG8_STAGE(PG8_SB(0, 1), b2 + hstep, voffB);
            PG8_WAIT_V(6); PG8_BAR; PG8_MMA(1, 1, At, B1); PG8_BAR;
            PG8_LDB(B0, 1, 0); PG8_SCHED; PG8_LDA(At, 1, 0); PG8_STAGE(PG8_SA(0, 1), a2 + hstep, voffA);
            PG8_WAIT_L(8); PG8_BAR; PG8_WAIT_L(0); PG8_MMA(0, 0, At, B0); PG8_BAR; PG8_SCHED;
            PG8_LDB(B1, 1, 1); PG8_STAGE(PG8_SB(1, 0), b3, voffB);
            PG8_BAR; PG8_WAIT_L(0); PG8_MMA(0, 1, At, B1); PG8_BAR;
            PG8_LDA(At, 1, 1); PG8_STAGE(PG8_SA(1, 0), a3, voffA);
            PG8_BAR; PG8_WAIT_L(0); PG8_MMA(1, 0, At, B0); PG8_BAR; PG8_SCHED;
            PG8_STAGE(PG8_SB(1, 1), b3 + hstep, voffB);
            PG8_WAIT_V(6); PG8_BAR; PG8_MMA(1, 1, At, B1); PG8_BAR;
            }
        }
        if constexpr (ALIGN_EPI) { if (wr == 0) PG8_BAR; }
        if constexpr (!Epi::AFTER_DRAIN) { static_assert(ALIGN_EPI, "split_reduce needs the halves aligned"); if (cur.nsl > 1) { const int shift = split_reduce(acc, cur, X, tid); E(acc, cur, wr, wc, fr, fq, shift, cur.slice); } else E(acc, cur, wr, wc, fr, fq, 5, 0); S.done(cur); }
        if (!has_next) break;
#pragma unroll
        for (int a = 0; a < 2; ++a)
#pragma unroll
            for (int b = 0; b < 2; ++b)
#pragma unroll
                for (int m = 0; m < 4; ++m)
#pragma unroll
                    for (int n = 0; n < 2; ++n) acc[a][b][m][n] = (f32x4){0.f, 0.f, 0.f, 0.f};
        cur = nxt; cA = nA; cB = nB; ++ui;
        if constexpr (ALIGN_EPI) { if (wr == 1) PG8_BAR; }
    }
    PG8_WAIT_V(0);
    if constexpr (!ALIGN_EPI) { if (wr == 0) PG8_BAR; }
    PG8_BAR;
    if constexpr (Epi::AFTER_DRAIN) { E.fused(acc, cur, wr, wc, fr, fq, lds, wid, lane); S.done(cur); }
#undef PG8_SA
#undef PG8_SB
#undef PG8_STAGE
#undef PG8_LDA
#undef PG8_LDB
#undef PG8_MMA
#undef PG8_WAIT_V
#undef PG8_WAIT_L
#undef PG8_BAR
#undef PG8_SCHED
}
}

constexpr int NWAVES = 8, NTHR = 512;
constexpr int DM = 2048, PB = 4, PL = 2048, SB = 128, SL = 8;
constexpr int MP = PB * PL, MS = SB * SL, M = MP + MS;
constexpr int GH = 4, GK = 128, GV = 256, GKD = 512, LOWR = 16;
constexpr int SH = 16, SP = 64, SN = 128, SG = 2, SCH = 1536;
constexpr int FF = 5632, FF2 = 11264, INC = 5664;
constexpr int N1 = 5888, NP = 5632;
constexpr int CQ = 0, CK = 512, CV = 1024, CG = 2048, CZ = 3072, CX = 4096;
constexpr float EPS = 1e-6f;
constexpr int N_PHASES = 11;

constexpr size_t O_Y = 0, O_GLA_P = (size_t)M * DM, O_SSD_P = O_GLA_P + (size_t)PB * GH * GK * GV, O_SCONV_P = O_SSD_P + (size_t)PB * SH * SP * SN,
                 O_FCONV_P = O_SCONV_P + (size_t)PB * 3 * SCH, O_GLA_S = O_FCONV_P + (size_t)PB * 2 * FF2, O_SSD_S = O_GLA_S + (size_t)SB * GH * GK * GV,
                 O_SCONV_S = O_SSD_S + (size_t)SB * SH * SP * SN, O_FCONV_S = O_SCONV_S + (size_t)SB * 3 * SCH, O_END = O_FCONV_S + (size_t)SB * 2 * FF2;

constexpr size_t MiB = 1u << 20;
constexpr size_t WS_CTL = 0, CTL_ZERO_BYTES = 64 * 1024;
constexpr size_t WS_WF2 = 1 * MiB;
constexpr size_t WS_W1 = 24 * MiB;
constexpr size_t WS_WO = 48 * MiB;
constexpr size_t WS_WF1 = 56 * MiB;
constexpr size_t WS_XN = 101 * MiB;
constexpr size_t WS_F = 24 * MiB;
constexpr size_t WS_BIG = 141 * MiB;
constexpr size_t WS_PROJ = WS_BIG;
constexpr size_t WS_MIX = WS_BIG;
constexpr size_t WS_ACT = WS_BIG;
constexpr size_t WS_HG = WS_BIG + 104 * MiB;
constexpr size_t WS_LRDT = WS_BIG + 100 * MiB;
constexpr size_t WS_MIXIN = WS_BIG + 104 * MiB;
constexpr size_t WS_DS = WS_XN;
constexpr size_t WS_SC = WS_BIG + 140 * MiB, WS_DH = WS_BIG + 172 * MiB, WS_HC = WS_BIG + 204 * MiB;
constexpr size_t WS_EBL = WS_BIG + 236 * MiB, WS_AL = WS_EBL + 512 * 1024;
constexpr size_t WS_SLAB = WS_BIG + 140 * MiB;
constexpr size_t WS_SLAB_F1 = WS_BIG + 198 * MiB;
constexpr size_t WS_QEG = WS_BIG + 238 * MiB, WS_KEG = WS_BIG + 246 * MiB;
constexpr size_t WS_END = WS_BIG + 254 * MiB;
static_assert(WS_WF2 + (size_t)DM * FF * 2 <= WS_W1 && WS_W1 + (size_t)N1 * DM * 2 <= WS_WO && WS_WO + (size_t)DM * DM * 2 <= WS_WF1 && WS_WF1 + (size_t)FF2 * DM * 2 <= WS_XN && WS_XN + (size_t)M * DM * 2 <= WS_BIG, "ws map 1");
static_assert(WS_F + (size_t)M * DM * 4 <= WS_XN && WS_ACT + (size_t)M * FF * 2 <= WS_HG && WS_PROJ + (size_t)M * NP * 2 <= WS_LRDT && WS_LRDT + (size_t)M * 32 * 4 <= WS_MIXIN && WS_MIXIN + (size_t)M * DM * 2 <= WS_SC && WS_HG + (size_t)32 * 4 * FF2 * 4 <= WS_SC && WS_MIX + (size_t)M * DM * 4 <= WS_LRDT, "ws map 2");
constexpr int CW_BAR = 1024;
constexpr int CW_SPLIT = 8192;

constexpr int RING_BYTES = 131072;
constexpr int SCRATCH_BYTES = 8 * 16640;
constexpr int LDSCTL_OFF = 133632, MISC_OFF = LDSCTL_OFF + 320;
constexpr int LDS_BYTES = 150016;

#ifndef MK_TIME_PHASE
#define MK_TIME_PHASE (-1)
#endif
#define TBEGIN(F, id) do { if (MK_TIME_PHASE == (id)) (F).tmark = __builtin_amdgcn_s_memrealtime(); } while (0)
#define TEND(F, id) do { if (MK_TIME_PHASE == (id)) (F).tacc += __builtin_amdgcn_s_memrealtime() - (F).tmark; } while (0)
#define GAS __attribute__((address_space(1)))
#define LAS __attribute__((address_space(3)))
typedef unsigned short bf16;
typedef unsigned v4u __attribute__((ext_vector_type(4)));
typedef unsigned v2u __attribute__((ext_vector_type(2)));
typedef float f32x4 __attribute__((ext_vector_type(4)));
#define LDS_WAIT() asm volatile("s_waitcnt lgkmcnt(0)" ::: "memory")
#define VM_WAIT() asm volatile("s_waitcnt vmcnt(0)" ::: "memory")
__device__ __forceinline__ unsigned f2bf(float f) { unsigned u = __builtin_bit_cast(unsigned, f); return (u + 0x7fffu + ((u >> 16) & 1u)) >> 16; }
__device__ __forceinline__ unsigned pk2(float lo, float hi) { return f2bf(lo) | (f2bf(hi) << 16); }
__device__ __forceinline__ float bf2f(unsigned short b) { return __builtin_bit_cast(float, (unsigned)b << 16); }
__device__ __forceinline__ float bflo(unsigned w) { return __builtin_bit_cast(float, w << 16); }
__device__ __forceinline__ float bfhi(unsigned w) { return __builtin_bit_cast(float, w & 0xffff0000u); }
__device__ __forceinline__ float silu_f(float x) { return x * __builtin_amdgcn_rcpf(1.f + __expf(-x)); }
__device__ __forceinline__ float softplus_f(float x) { return fmaxf(x, 0.f) + __logf(1.f + __expf(-fabsf(x))); }
__device__ __forceinline__ float logsigmoid_f(float x) { return fminf(x, 0.f) - __logf(1.f + __expf(-fabsf(x))); }
__device__ __forceinline__ float wave_sum(float v) {
#pragma unroll
    for (int o = 1; o < 64; o <<= 1) v += __shfl_xor(v, o);
    return v;
}

#define XB_TMO      128
#define XB_XCNT(j)  (256  + 64 * (j))
#define XB_XSUB(j)  (1280 + 64 * (j))
#define XB_XGEN(j)  (2304 + 64 * (j))
#define XB_TOP      3328
#define XB_TOPGEN   3392
#define XCD_BAR_WORDS 3456
#define XB_SPIN_CAP (1u << 18)

__device__ __forceinline__ unsigned xb_ld(unsigned* p)              { return __hip_atomic_load(p, __ATOMIC_RELAXED, __HIP_MEMORY_SCOPE_AGENT); }
__device__ __forceinline__ unsigned xb_add(unsigned* p, unsigned v) { return __hip_atomic_fetch_add(p, v, __ATOMIC_RELAXED, __HIP_MEMORY_SCOPE_AGENT); }
__device__ __forceinline__ unsigned xb_xcc_id() { return (unsigned)__builtin_amdgcn_s_getreg((3 << 11) | 20) & 0xFu; }
#define XB_SPIN(cond, bar) do { unsigned _sp = 0; while (cond) { __builtin_amdgcn_s_sleep(1); \
    if ((++_sp & 255u) == 0u) { if (xb_ld(&(bar)[XB_TMO])) break; if (_sp > XB_SPIN_CAP) { atomicAdd(&(bar)[XB_TMO], 1u); break; } } } } while (0)

struct XcdBarrier {
    unsigned* bar; unsigned x;
    volatile LAS unsigned* st;
};

__device__ __forceinline__ XcdBarrier xcd_barrier_post(unsigned* bar, volatile LAS unsigned* st) {
    XcdBarrier b; b.bar = bar; b.x = xb_xcc_id(); b.st = st;
    if (threadIdx.x == 0) (void)xb_add(&bar[XB_XCNT(b.x)], 1u);
    return b;
}
__device__ __forceinline__ void xcd_barrier_complete(unsigned* bar, unsigned x, unsigned& nloc, unsigned& nx) {
    const unsigned G = gridDim.x * gridDim.y * gridDim.z;
    unsigned sum, cnt, mine, sp = 0u;
    for (;;) {
        sum = 0u; cnt = 0u; mine = 0u;
#pragma unroll
        for (unsigned j = 0; j < 16; ++j) { const unsigned c = xb_ld(&bar[XB_XCNT(j)]); sum += c; cnt += (c > 0u) ? 1u : 0u; mine = (j == x) ? c : mine; }
        if (sum == G) break;
        __builtin_amdgcn_s_sleep(1);
        if ((++sp & 255u) == 0u) { if (xb_ld(&bar[XB_TMO])) break; if (sp > XB_SPIN_CAP) { atomicAdd(&bar[XB_TMO], 1u); break; } }
    }
    nloc = mine > 0u ? mine : 1u; nx = cnt > 0u ? cnt : 1u;
}

__device__ __forceinline__ void xcd_barrier(const XcdBarrier& b) {
    asm volatile("s_waitcnt vmcnt(0)" ::: "memory");
    __syncthreads();
    if (threadIdx.x == 0) {
        unsigned* bar = b.bar;
        __builtin_amdgcn_s_waitcnt(0);
        unsigned nloc = b.st[0], nx = b.st[1];
        if (nloc == 0u) { xcd_barrier_complete(bar, b.x, nloc, nx); b.st[0] = nloc; b.st[1] = nx; }
        const unsigned old = xb_add(&bar[XB_XSUB(b.x)], 1u);
        const unsigned gen = old / nloc;
        if (old + 1u == (gen + 1u) * nloc) {
            __builtin_amdgcn_fence(__ATOMIC_RELEASE, "agent");
            asm volatile("s_waitcnt vmcnt(0)" ::: "memory");
            const unsigned og = xb_add(&bar[XB_TOP], 1u);
            const unsigned tg = og / nx;
            if (og + 1u == (tg + 1u) * nx) xb_add(&bar[XB_TOPGEN], 1u);
            else XB_SPIN(xb_ld(&bar[XB_TOPGEN]) == tg, bar);
            __builtin_amdgcn_fence(__ATOMIC_ACQUIRE, "agent");
            xb_add(&bar[XB_XGEN(b.x)], 1u);
            asm volatile("s_waitcnt vmcnt(0)" ::: "memory");
        } else {
            XB_SPIN(xb_ld(&bar[XB_XGEN(b.x)]) == gen, bar);
            __builtin_amdgcn_fence(__ATOMIC_ACQUIRE, "agent");
            asm volatile("s_waitcnt vmcnt(0)" ::: "memory");
        }
    }
    __syncthreads();
}

struct Frame {
    LAS unsigned char* lds;
    int tid, lane, wave, G, bid;
    unsigned long long tacc, tmark;
    const float *x_p, *x_s, *st_gla, *st_ssd, *st_sconv, *st_fconv, *n_mix_pre, *n_mix_post, *n_ffn_pre, *n_ffn_post, *w_in, *w_gate2, *b_gate, *gla_norm,
                *sconv_w, *sconv_b, *dt_bias, *A_log, *ssd_D, *ssd_norm, *w_out, *ffn_w_in, *fconv_w, *fconv_b, *ffn_w_out;
    float* out;
    bf16 *W1, *WO, *WF1, *WF2, *XN, *PROJ, *MIXIN, *ACT, *DS, *SC, *DH, *HC, *QEg, *KEg;
    float *LRDT, *MIX, *Fb, *EBL, *AL, *HG;
};
__device__ __forceinline__ const float* x_row(const Frame& F, int row) { return row < MP ? F.x_p + (size_t)row * DM : F.x_s + (size_t)(row - MP) * DM; }

__device__ __forceinline__ int w1_src_col(int n) { return n < 3072 ? n : (n < 5632 ? n + 16 : (n < 5648 ? n - 2560 : (n < 5664 ? n : -1))); }
struct TDesc { const float* W; bf16* WT; int K, Nsrc, Ndst, map, item; };
__device__ __forceinline__ void t_load(const TDesc& d, int lane, f32x4 (&v)[16]) {
    const int nblk = d.Ndst / 64, kb = d.item / nblk, nb = d.item % nblk, k0 = 64 * kb, n0 = 64 * nb;
    int sc = n0 + 4 * (lane & 15); if (d.map == 1) sc = w1_src_col(sc); if (d.map == 2) sc = ((sc >> 7) & 1) * FF + 128 * (sc >> 8) + (sc & 127);
#pragma unroll
    for (int i = 0; i < 16; ++i) { const int kk = 4 * i + (lane >> 4); v[i] = (sc >= 0) ? *(const f32x4*)(d.W + (size_t)(k0 + kk) * d.Nsrc + sc) : (f32x4){0.f, 0.f, 0.f, 0.f}; }
}
__device__ __forceinline__ void t_store(const TDesc& d, int lane, LAS float* scr, const f32x4 (&v)[16]) {
    const int nblk = d.Ndst / 64, kb = d.item / nblk, nb = d.item % nblk, k0 = 64 * kb, n0 = 64 * nb;
#pragma unroll
    for (int i = 0; i < 16; ++i) { const int kk = 4 * i + (lane >> 4); LAS float* p = scr + kk * 65 + 4 * (lane & 15); p[0] = v[i].x; p[1] = v[i].y; p[2] = v[i].z; p[3] = v[i].w; }
    LDS_WAIT(); asm volatile("" ::: "memory");
    const int c = lane & 7;
#pragma unroll
    for (int j = 0; j < 8; ++j) { const int n = (lane >> 3) + 8 * j; const LAS float* s = scr + (8 * c) * 65 + n;
        v4u o; o.x = pk2(s[0 * 65], s[1 * 65]); o.y = pk2(s[2 * 65], s[3 * 65]); o.z = pk2(s[4 * 65], s[5 * 65]); o.w = pk2(s[6 * 65], s[7 * 65]);
        *(v4u*)(d.WT + (size_t)(n0 + n) * d.K + k0 + 8 * c) = o; }
    LDS_WAIT(); asm volatile("" ::: "memory");
}
__device__ __forceinline__ bool t_desc(const Frame& F, int which, int it, TDesc& d) {
    constexpr int I_1 = (DM / 64) * (N1 / 64), I_O = (DM / 64) * (DM / 64), I_F1 = (DM / 64) * (FF2 / 64), I_F2 = (FF / 64) * (DM / 64);
    if (which == 0) { if (it >= I_1) return false; d = TDesc{F.w_in, F.W1, DM, INC, N1, 1, it}; return true; }
    if (it >= I_O + I_F1 + I_F2) return false;
    if (it < I_O) d = TDesc{F.w_out, F.WO, DM, DM, DM, 0, it};
    else if (it < I_O + I_F1) d = TDesc{F.ffn_w_in, F.WF1, DM, FF2, FF2, 2, it - I_O};
    else d = TDesc{F.ffn_w_out, F.WF2, FF, DM, DM, 0, it - I_O - I_F1};
    return true;
}
__device__ __forceinline__ void t_run(const Frame& F, int which, int gw, int NGW) {
    LAS float* scr = (LAS float*)(F.lds + F.wave * 16640);
    TDesc da, db; f32x4 va[16], vb[16]; int it = gw;
    if (!t_desc(F, which, it, da)) return;
    t_load(da, F.lane, va);
    for (;;) {
        const bool hb = t_desc(F, which, it + NGW, db); if (hb) t_load(db, F.lane, vb);
        t_store(da, F.lane, scr, va); if (!hb) break; it += NGW;
        const bool ha = t_desc(F, which, it + NGW, da); if (ha) t_load(da, F.lane, va);
        t_store(db, F.lane, scr, vb); if (!ha) break; it += NGW;
    }
}
__device__ __forceinline__ void rms_row_to_bf16(const float* xrow, const float* w, bf16* orow, int lane) {
    const f32x4* xr = (const f32x4*)xrow + lane; const f32x4* wr = (const f32x4*)w + lane;
    f32x4 v[8]; float s = 0.f;
#pragma unroll
    for (int j = 0; j < 8; ++j) { v[j] = xr[64 * j]; s += (v[j].x * v[j].x + v[j].y * v[j].y) + (v[j].z * v[j].z + v[j].w * v[j].w); }
    const float r = rsqrtf(wave_sum(s) * (1.f / DM) + EPS);
    v2u* o8 = (v2u*)orow + lane;
#pragma unroll
    for (int j = 0; j < 8; ++j) { const f32x4 ww = wr[64 * j]; v2u o; o.x = pk2(v[j].x * r * ww.x, v[j].y * r * ww.y); o.y = pk2(v[j].z * r * ww.z, v[j].w * r * ww.w); o8[64 * j] = o; }
}
__device__ __forceinline__ void p0_prologue(Frame& F) {
    const int gw = F.bid * NWAVES + F.wave, NGW = F.G * NWAVES;
    t_run(F, 0, gw, NGW);
    for (int m = gw; m < M; m += NGW) rms_row_to_bf16(x_row(F, m), F.n_mix_pre, F.XN + (size_t)m * DM, F.lane);
}
__device__ __forceinline__ void p0_convert_rest(Frame& F, int vb, int nb) { t_run(F, 1, vb * NWAVES + F.wave, nb * NWAVES); }

template <int grp> __device__ __forceinline__ void gla_direct_unit(Frame& F, int b, int h) {
    const int tid = F.tid, v = tid & 255, kh = tid >> 8;
    const int L = grp ? SL : PL, row0 = grp ? MP + b * SL : b * PL;
    LAS float* Es = (LAS float*)F.lds; LAS float* Ks = Es + 1024; LAS float* Qs = Ks + 1024; LAS float* Os = Qs + 1024;
    float S[64];
    if (grp) { const float* s0 = F.st_gla + ((size_t)(b * GH + h) * GK + kh * 64) * GV + v;
#pragma unroll
        for (int i = 0; i < 64; ++i) S[i] = s0[(size_t)i * GV]; }
    else {
#pragma unroll
        for (int i = 0; i < 64; ++i) S[i] = 0.f; }
    for (int t0 = 0; t0 < L; t0 += 8) {
        for (int it = tid; it < 1024; it += NTHR) { const int t = it >> 7, k = it & 127, row = row0 + t0 + t, hk = h * GK + k;
            float x = F.b_gate[hk]; const float* lr = F.LRDT + (size_t)row * 32;
#pragma unroll
            for (int j = 0; j < LOWR; ++j) x += lr[j] * F.w_gate2[j * GKD + hk];
            const float lg = logsigmoid_f(x) * (1.f / 16.f);
            Es[it] = __expf(lg); Ks[it] = bf2f(F.PROJ[(size_t)row * NP + CK + hk]); Qs[it] = bf2f(F.PROJ[(size_t)row * NP + CQ + hk]) * 0.08838834764831845f; }
        __syncthreads();
#pragma unroll 1
        for (int t = 0; t < 8; ++t) { const float vv = bf2f(F.PROJ[(size_t)(row0 + t0 + t) * NP + CV + h * GV + v]); float acc = 0.f;
            const LAS float* e = Es + t * 128 + kh * 64; const LAS float* kk = Ks + t * 128 + kh * 64; const LAS float* qq = Qs + t * 128 + kh * 64;
#pragma unroll
            for (int i = 0; i < 64; ++i) { S[i] = e[i] * S[i] + kk[i] * vv; acc += qq[i] * S[i]; }
            Os[(kh * 8 + t) * 256 + v] = acc; }
        __syncthreads();
        { const int t = F.wave, v4 = F.lane * 4, row = row0 + t0 + t;
            const f32x4 a = *(const LAS f32x4*)(Os + t * 256 + v4), c = *(const LAS f32x4*)(Os + (8 + t) * 256 + v4); const f32x4 o = a + c;
            const float ss = wave_sum((o.x * o.x + o.y * o.y) + (o.z * o.z + o.w * o.w)); const float r = rsqrtf(ss * (1.f / GV) + EPS);
            const v2u gw = *(const v2u*)(F.PROJ + (size_t)row * NP + CG + h * GV + v4); const f32x4 nw = *(const f32x4*)(F.gla_norm + v4);
            v2u w; w.x = pk2(o.x * r * nw.x * silu_f(bflo(gw.x)), o.y * r * nw.y * silu_f(bfhi(gw.x))); w.y = pk2(o.z * r * nw.z * silu_f(bflo(gw.y)), o.w * r * nw.w * silu_f(bfhi(gw.y)));
            *(v2u*)(F.MIXIN + (size_t)row * DM + h * GV + v4) = w; }
        __syncthreads();
    }
    float* so = F.out + (grp ? O_GLA_S : O_GLA_P) + ((size_t)(b * GH + h) * GK + kh * 64) * GV + v;
#pragma unroll
    for (int i = 0; i < 64; ++i) so[(size_t)i * GV] = S[i];
}
__device__ __forceinline__ float xbc_raw(const Frame& F, int grp, int b, int row0, int tt, int c) {
    if (tt >= 0) return bf2f(F.PROJ[(size_t)(row0 + tt) * NP + CX + c]);
    return grp ? F.st_sconv[((size_t)b * 3 + (tt + 3)) * SCH + c] : 0.f;
}
template <int grp> __device__ __forceinline__ void ssd_direct_unit(Frame& F, int b, int g) {
    const int tid = F.tid, hd = g * 8 + (tid >> 6), p = tid & 63, ch = g * 512 + tid;
    const int L = grp ? SL : PL, row0 = grp ? MP + b * SL : b * PL;
    LAS float* Bs = (LAS float*)F.lds; LAS float* Cs = Bs + 1024; LAS float* red = Cs + 1024; LAS float* Ys = red + 64;
    float h[128];
    if (grp) { const f32x4* h0 = (const f32x4*)(F.st_ssd + ((size_t)(b * SH + hd) * SP + p) * SN);
#pragma unroll
        for (int i = 0; i < 32; ++i) { const f32x4 q = h0[i]; h[4 * i] = q.x; h[4 * i + 1] = q.y; h[4 * i + 2] = q.z; h[4 * i + 3] = q.w; } }
    else {
#pragma unroll
        for (int i = 0; i < 128; ++i) h[i] = 0.f; }
    const float A = -__expf(F.A_log[hd]), dtb = F.dt_bias[hd], Dh = F.ssd_D[hd], nw = F.ssd_norm[ch];
    const float cb = F.sconv_b[ch], cw0 = F.sconv_w[ch], cw1 = F.sconv_w[SCH + ch], cw2 = F.sconv_w[2 * SCH + ch], cw3 = F.sconv_w[3 * SCH + ch];
    const int c2 = 1024 + (tid < 128 ? g * 128 + tid : 256 + g * 128 + ((tid - 128) & 127));
    float xr0 = xbc_raw(F, grp, b, row0, -3, ch), xr1 = xbc_raw(F, grp, b, row0, -2, ch), xr2 = xbc_raw(F, grp, b, row0, -1, ch);
    for (int t0 = 0; t0 < L; t0 += 8) {
        if (tid < 256) {
            float xr[11]; const float cb2 = F.sconv_b[c2], d0 = F.sconv_w[c2], d1 = F.sconv_w[SCH + c2], d2 = F.sconv_w[2 * SCH + c2], d3 = F.sconv_w[3 * SCH + c2];
#pragma unroll
            for (int i = 0; i < 11; ++i) xr[i] = xbc_raw(F, grp, b, row0, t0 - 3 + i, c2);
#pragma unroll
            for (int t = 0; t < 8; ++t) Bs[(tid >> 7) * 1024 + t * 128 + (tid & 127)] = silu_f(cb2 + d0 * xr[t] + d1 * xr[t + 1] + d2 * xr[t + 2] + d3 * xr[t + 3]);
        }
        __syncthreads();
#pragma unroll 1
        for (int t = 0; t < 8; ++t) { const int row = row0 + t0 + t;
            const float xn = bf2f(F.PROJ[(size_t)row * NP + CX + ch]);
            const float x = silu_f(cb + cw0 * xr0 + cw1 * xr1 + cw2 * xr2 + cw3 * xn); xr0 = xr1; xr1 = xr2; xr2 = xn;
            const float dt = softplus_f(F.LRDT[(size_t)row * 32 + 16 + hd] + dtb), a = __expf(dt * A), dtx = dt * x;
            float acc = 0.f; const LAS float* bb = Bs + t * 128; const LAS float* cc = Cs + t * 128;
#pragma unroll
            for (int nb = 0; nb < 128; nb += 16) {
#pragma unroll
                for (int n = nb; n < nb + 16; ++n) { h[n] = a * h[n] + dtx * bb[n]; acc += h[n] * cc[n]; }
                asm volatile("" ::: "memory"); }
            const float z = bf2f(F.PROJ[(size_t)row * NP + CZ + ch]);
            const float y = (acc + Dh * x) * silu_f(z);
            Ys[t * 512 + tid] = y;
            const float ss = wave_sum(y * y); if (F.lane == 0) red[t * 8 + F.wave] = ss; }
        __syncthreads();
#pragma unroll
        for (int t = 0; t < 8; ++t) { float tot = 0.f;
#pragma unroll
            for (int w = 0; w < 8; ++w) tot += red[t * 8 + w];
            const float r = rsqrtf(tot * (1.f / 512.f) + EPS);
            F.MIXIN[(size_t)(row0 + t0 + t) * DM + 1024 + ch] = (bf16)f2bf(Ys[t * 512 + tid] * r * nw); }
        __syncthreads();
    }
    f32x4* ho = (f32x4*)(F.out + (grp ? O_SSD_S : O_SSD_P) + ((size_t)(b * SH + hd) * SP + p) * SN);
#pragma unroll
    for (int i = 0; i < 32; ++i) ho[i] = (f32x4){h[4 * i], h[4 * i + 1], h[4 * i + 2], h[4 * i + 3]};
}
typedef short bf16x8v __attribute__((ext_vector_type(8)));
typedef short s16x4v __attribute__((ext_vector_type(4)));
constexpr int CH = 64, NCH = PL / CH;
constexpr int QE_ST = 272, KDT_ST = 144, V_ST = 544, ATT_ST = 144, X_ST = 1056, BC_ST = 288;
#define MFMA16(a, b, c) __builtin_amdgcn_mfma_f32_16x16x32_bf16((a), (b), (c), 0, 0, 0)
__device__ __forceinline__ bf16x8v frag_k(const LAS unsigned char* T, int stride, int idx0, int kk0, int r, int q) { return *(const LAS bf16x8v*)(T + (idx0 + r) * stride + (kk0 + 8 * q) * 2); }
__device__ __forceinline__ bf16x8v frag_t(const LAS unsigned char* T, int stride, int kk0, int idx0, int r, int q) {
    const LAS unsigned char* p = T + (kk0 + 8 * q + (r >> 2)) * stride + (idx0 + 4 * (r & 3)) * 2;
    const s16x4v lo = __builtin_amdgcn_ds_read_tr16_b64_v4i16((LAS s16x4v*)p), hi = __builtin_amdgcn_ds_read_tr16_b64_v4i16((LAS s16x4v*)(p + 4 * stride));
    return (bf16x8v){lo[0], lo[1], lo[2], lo[3], hi[0], hi[1], hi[2], hi[3]};
}
__device__ __forceinline__ v2u pk4(const f32x4 v) { v2u o; o.x = pk2(v.x, v.y); o.y = pk2(v.z, v.w); return o; }

struct GlaStage { v4u v[4], qk[4], lr; };
template <int PASS>
__device__ __forceinline__ void gla_stage_load(const Frame& F, int h, int row0, GlaStage& g) {
    const int tid = F.tid;
#pragma unroll
    for (int i = 0; i < 4; ++i) { const int piece = tid + NTHR * i, row = piece >> 5, c16 = piece & 31; g.v[i] = *(const v4u*)(F.PROJ + (size_t)(row0 + row) * NP + CV + h * GV + c16 * 8); }
#pragma unroll
    for (int i = 0; i < 2; ++i) { const int piece = tid + NTHR * i, row = piece >> 4, c16 = piece & 15;
        g.qk[i] = *(const v4u*)(F.PROJ + (size_t)(row0 + row) * NP + CK + h * GK + c16 * 8);
        if (PASS == 1) g.qk[2 + i] = *(const v4u*)(F.PROJ + (size_t)(row0 + row) * NP + CQ + h * GK + c16 * 8); }
    if (tid < 256) g.lr = *(const v4u*)(F.LRDT + (size_t)(row0 + (tid >> 2)) * 32 + (tid & 3) * 4);
}
template <int PASS>
__device__ __forceinline__ void gla_stage_store(const Frame& F, const GlaStage& g, LAS unsigned char* V, LAS unsigned char* Kt, LAS unsigned char* Qt, LAS float* LR) {
    const int tid = F.tid;
#pragma unroll
    for (int i = 0; i < 4; ++i) { const int piece = tid + NTHR * i, row = piece >> 5, c16 = piece & 31; *(LAS v4u*)(V + row * V_ST + c16 * 16) = g.v[i]; }
#pragma unroll
    for (int i = 0; i < 2; ++i) { const int piece = tid + NTHR * i, row = piece >> 4, c16 = piece & 15;
        *(LAS v4u*)(Kt + row * QE_ST + c16 * 16) = g.qk[i]; if (PASS == 1) *(LAS v4u*)(Qt + row * QE_ST + c16 * 16) = g.qk[2 + i]; }
    if (tid < 256) *(LAS v4u*)(LR + (tid >> 2) * 16 + (tid & 3) * 4) = g.lr;
}
template <int PASS>
__device__ __forceinline__ void gla_chunk_elem(Frame& F, int h, LAS unsigned char* Kt, LAS unsigned char* Qt, LAS unsigned char* KDT, const LAS float* LR, LAS float* tot, float* ebl_out) {
    const int tid = F.tid, k = tid & 127, tq = tid >> 7, hk = h * GK + k;
    float w2[16];
#pragma unroll
    for (int j = 0; j < 16; ++j) w2[j] = F.w_gate2[j * GKD + hk];
    const float bg = F.b_gate[hk];
    float lg[16]; float run = 0.f;
#pragma unroll
    for (int i = 0; i < 16; ++i) { const LAS f32x4* lr = (const LAS f32x4*)(LR + (16 * tq + i) * 16); const f32x4 a = lr[0], b = lr[1], c = lr[2], d = lr[3];
        float x = bg + a.x * w2[0] + a.y * w2[1] + a.z * w2[2] + a.w * w2[3] + b.x * w2[4] + b.y * w2[5] + b.z * w2[6] + b.w * w2[7]
                     + c.x * w2[8] + c.y * w2[9] + c.z * w2[10] + c.w * w2[11] + d.x * w2[12] + d.y * w2[13] + d.z * w2[14] + d.w * w2[15];
        run += logsigmoid_f(x) * (1.f / 16.f); lg[i] = run; }
    tot[tq * 128 + k] = run;
    __syncthreads();
    float off = 0.f, all = 0.f;
#pragma unroll
    for (int qq = 0; qq < 4; ++qq) { const float v = tot[qq * 128 + k]; all += v; off += (qq < tq) ? v : 0.f; }
    {
        unsigned pk[8];
#pragma unroll
        for (int i = 0; i < 8; ++i) { const int t = 16 * tq + 2 * i; const float b0 = off + lg[2 * i], b1 = off + lg[2 * i + 1];
            LAS bf16* k0p = (LAS bf16*)(Kt + t * QE_ST + k * 2); LAS bf16* k1p = (LAS bf16*)(Kt + (t + 1) * QE_ST + k * 2);
            LAS bf16* q0p = (LAS bf16*)(Qt + t * QE_ST + k * 2); LAS bf16* q1p = (LAS bf16*)(Qt + (t + 1) * QE_ST + k * 2);
            const float k0 = bf2f(*k0p), k1 = bf2f(*k1p);
            pk[i] = pk2(k0 * __expf(all - b0), k1 * __expf(all - b1));
            *k0p = (bf16)f2bf(k0 * __expf(-b0)); *k1p = (bf16)f2bf(k1 * __expf(-b1));
            *q0p = (bf16)f2bf(bf2f(*q0p) * 0.08838834764831845f * __expf(b0)); *q1p = (bf16)f2bf(bf2f(*q1p) * 0.08838834764831845f * __expf(b1)); }
        LAS v4u* d = (LAS v4u*)(KDT + k * KDT_ST + 32 * tq);
        d[0] = (v4u){pk[0], pk[1], pk[2], pk[3]}; d[1] = (v4u){pk[4], pk[5], pk[6], pk[7]};
        if (tq == 0) ebl_out[k] = __expf(all);
    }
}
__device__ __forceinline__ void gla_passA_unit(Frame& F, int u) {
    const int c = u & 31, bh = u >> 5, b = bh >> 2, h = bh & 3, row0 = b * PL + c * CH;
    LAS unsigned char* KDT = F.lds; LAS unsigned char* V = KDT + 128 * KDT_ST; LAS unsigned char* Kt = V + 64 * V_ST; LAS unsigned char* Qt = Kt + 64 * QE_ST; LAS float* LR = (LAS float*)(Qt + 64 * QE_ST); LAS float* tot = LR + 1024;
    { GlaStage g; gla_stage_load<1>(F, h, row0, g); gla_stage_store<1>(F, g, V, Kt, Qt, LR); }
    __syncthreads();
    gla_chunk_elem<0>(F, h, Kt, Qt, KDT, LR, tot, F.EBL + (size_t)u * 128);
    __syncthreads();
#pragma unroll
    for (int i = 0; i < 2; ++i) { const int piece = F.tid + NTHR * i, row = piece >> 4, c16 = piece & 15;
        *(v4u*)(F.QEg + ((size_t)u * 64 + row) * GK + c16 * 8) = *(const LAS v4u*)(Qt + row * QE_ST + c16 * 16);
        *(v4u*)(F.KEg + ((size_t)u * 64 + row) * GK + c16 * 8) = *(const LAS v4u*)(Kt + row * QE_ST + c16 * 16); }
    const int w = F.wave, r = F.lane & 15, q = F.lane >> 4;
    f32x4 acc[8][2];
#pragma unroll
    for (int kf = 0; kf < 8; ++kf) { acc[kf][0] = (f32x4){0.f, 0.f, 0.f, 0.f}; acc[kf][1] = (f32x4){0.f, 0.f, 0.f, 0.f}; }
#pragma unroll
    for (int ks = 0; ks < 2; ++ks) { const bf16x8v b0 = frag_t(V, V_ST, 32 * ks, 32 * w, r, q), b1 = frag_t(V, V_ST, 32 * ks, 32 * w + 16, r, q);
#pragma unroll
        for (int kf = 0; kf < 8; ++kf) { const bf16x8v a = frag_k(KDT, KDT_ST, 16 * kf, 32 * ks, r, q); acc[kf][0] = MFMA16(a, b0, acc[kf][0]); acc[kf][1] = MFMA16(a, b1, acc[kf][1]); } }
#pragma unroll
    for (int kf = 0; kf < 8; ++kf)
#pragma unroll
        for (int vf = 0; vf < 2; ++vf) *(v2u*)(F.DS + ((size_t)u * GV + 32 * w + 16 * vf + r) * GK + 16 * kf + 4 * q) = pk4(acc[kf][vf]);
    __syncthreads();
}
__device__ __forceinline__ void gla_scan(Frame& F) {
    for (int it = F.bid * NTHR + F.tid; it < PB * GH * GV * 32; it += F.G * NTHR) { const int k4 = it & 31, v = (it >> 5) & 255, bh = it >> 13;
        f32x4 S = (f32x4){0.f, 0.f, 0.f, 0.f};
#pragma unroll 8
        for (int c = 0; c < NCH; ++c) { const int u = bh * NCH + c; const size_t off = ((size_t)u * GV + v) * GK + 4 * k4;
            const v2u d = *(const v2u*)(F.DS + off); const f32x4 e = *(const f32x4*)(F.EBL + (size_t)u * 128 + 4 * k4);
            *(v2u*)(F.SC + off) = pk4(S);
            S.x = e.x * S.x + bflo(d.x); S.y = e.y * S.y + bfhi(d.x); S.z = e.z * S.z + bflo(d.y); S.w = e.w * S.w + bfhi(d.y); }
        float* o = F.out + O_GLA_P + ((size_t)bh * GK + 4 * k4) * GV + v; o[0] = S.x; o[GV] = S.y; o[2 * GV] = S.z; o[3 * GV] = S.w; }
}
__device__ __forceinline__ void gla_passC_unit(Frame& F, int u) {
    const int c = u & 31, bh = u >> 5, b = bh >> 2, h = bh & 3, row0 = b * PL + c * CH;
    LAS unsigned char* QE = F.lds; LAS unsigned char* KE = QE + 64 * QE_ST; LAS unsigned char* V = KE + 64 * QE_ST; LAS unsigned char* ATT = V + 64 * V_ST;
    LAS float* red = (LAS float*)(ATT + 64 * ATT_ST);
    { v4u vv[4], qq[2], kk[2];
#pragma unroll
        for (int i = 0; i < 4; ++i) { const int piece = F.tid + NTHR * i, row = piece >> 5, c16 = piece & 31; vv[i] = *(const v4u*)(F.PROJ + (size_t)(row0 + row) * NP + CV + h * GV + c16 * 8); }
#pragma unroll
        for (int i = 0; i < 2; ++i) { const int piece = F.tid + NTHR * i, row = piece >> 4, c16 = piece & 15;
            qq[i] = *(const v4u*)(F.QEg + ((size_t)u * 64 + row) * GK + c16 * 8); kk[i] = *(const v4u*)(F.KEg + ((size_t)u * 64 + row) * GK + c16 * 8); }
#pragma unroll
        for (int i = 0; i < 4; ++i) { const int piece = F.tid + NTHR * i, row = piece >> 5, c16 = piece & 31; *(LAS v4u*)(V + row * V_ST + c16 * 16) = vv[i]; }
#pragma unroll
        for (int i = 0; i < 2; ++i) { const int piece = F.tid + NTHR * i, row = piece >> 4, c16 = piece & 15;
            *(LAS v4u*)(QE + row * QE_ST + c16 * 16) = qq[i]; *(LAS v4u*)(KE + row * QE_ST + c16 * 16) = kk[i]; } }
    __syncthreads();
    const int w = F.wave, r = F.lane & 15, q = F.lane >> 4;
#pragma unroll
    for (int ff = 0; ff < 2; ++ff) { const int f = 2 * w + ff, sf = f >> 2, tf = f & 3; f32x4 a4 = (f32x4){0.f, 0.f, 0.f, 0.f};
        if (sf <= tf) {
#pragma unroll
            for (int ks = 0; ks < 4; ++ks) a4 = MFMA16(frag_k(KE, QE_ST, 16 * sf, 32 * ks, r, q), frag_k(QE, QE_ST, 16 * tf, 32 * ks, r, q), a4); }
        const int s0 = 16 * sf + 4 * q, t = 16 * tf + r;
        f32x4 m; m.x = (s0 <= t) ? a4.x : 0.f; m.y = (s0 + 1 <= t) ? a4.y : 0.f; m.z = (s0 + 2 <= t) ? a4.z : 0.f; m.w = (s0 + 3 <= t) ? a4.w : 0.f;
        *(LAS v2u*)(ATT + t * ATT_ST + s0 * 2) = pk4(m); }
    __syncthreads();
    const int tf = w & 3, vh = w >> 2;
    f32x4 acc[8];
#pragma unroll
    for (int i = 0; i < 8; ++i) acc[i] = (f32x4){0.f, 0.f, 0.f, 0.f};
    const bf16* Sc = F.SC + ((size_t)u * GV + 128 * vh) * GK;
#pragma unroll
    for (int ks = 0; ks < 4; ++ks) { const bf16x8v bq = frag_k(QE, QE_ST, 16 * tf, 32 * ks, r, q);
#pragma unroll
        for (int i = 0; i < 8; ++i) { const bf16x8v a = *(const bf16x8v*)(Sc + (size_t)(16 * i + r) * GK + 32 * ks + 8 * q); acc[i] = MFMA16(a, bq, acc[i]); } }
#pragma unroll
    for (int ks = 0; ks < 2; ++ks) { const bf16x8v ba = frag_k(ATT, ATT_ST, 16 * tf, 32 * ks, r, q);
#pragma unroll
        for (int i = 0; i < 8; ++i) { const bf16x8v a = frag_t(V, V_ST, 32 * ks, 128 * vh + 16 * i, r, q); acc[i] = MFMA16(a, ba, acc[i]); } }
    float ss = 0.f;
#pragma unroll
    for (int i = 0; i < 8; ++i) ss += (acc[i].x * acc[i].x + acc[i].y * acc[i].y) + (acc[i].z * acc[i].z + acc[i].w * acc[i].w);
    ss += __shfl_xor(ss, 16); ss += __shfl_xor(ss, 32);
    const int t = 16 * tf + r;
    if (q == 0) red[vh * 64 + t] = ss;
    __syncthreads();
    const float rr = rsqrtf((red[t] + red[64 + t]) * (1.f / GV) + EPS); const size_t row = (size_t)(row0 + t);
#pragma unroll
    for (int i = 0; i < 8; ++i) { const int v = 128 * vh + 16 * i + 4 * q;
        const v2u gw = *(const v2u*)(F.PROJ + row * NP + CG + h * GV + v); const f32x4 nw = *(const f32x4*)(F.gla_norm + v);
        f32x4 o; o.x = acc[i].x * rr * nw.x * silu_f(bflo(gw.x)); o.y = acc[i].y * rr * nw.y * silu_f(bfhi(gw.x)); o.z = acc[i].z * rr * nw.z * silu_f(bflo(gw.y)); o.w = acc[i].w * rr * nw.w * silu_f(bfhi(gw.y));
        *(v2u*)(F.MIXIN + row * DM + h * GV + v) = pk4(o); }
    __syncthreads();
}

template <bool SCALE>
__device__ __forceinline__ void ssd_conv_item(Frame& F, int b, int g, int c, int cg, int tb, LAS unsigned char* X, LAS unsigned char* BT, LAS unsigned char* CT, const LAS float* WDEC) {
    const int xc = cg < 64 ? g * 512 + 8 * cg : (cg < 80 ? 1024 + g * 128 + 8 * (cg - 64) : 1280 + g * 128 + 8 * (cg - 80));
    float w[4][8], bias[8];
#pragma unroll
    for (int j = 0; j < 4; ++j) { const f32x4 a = *(const f32x4*)(F.sconv_w + j * SCH + xc), bq = *(const f32x4*)(F.sconv_w + j * SCH + xc + 4);
        w[j][0] = a.x; w[j][1] = a.y; w[j][2] = a.z; w[j][3] = a.w; w[j][4] = bq.x; w[j][5] = bq.y; w[j][6] = bq.z; w[j][7] = bq.w; }
    { const f32x4 a = *(const f32x4*)(F.sconv_b + xc), bq = *(const f32x4*)(F.sconv_b + xc + 4); bias[0] = a.x; bias[1] = a.y; bias[2] = a.z; bias[3] = a.w; bias[4] = bq.x; bias[5] = bq.y; bias[6] = bq.z; bias[7] = bq.w; }
    v4u raw[11];
#pragma unroll
    for (int i = 0; i < 11; ++i) { const int tt = c * CH + tb * 8 - 3 + i;
        raw[i] = (tt >= 0) ? *(const v4u*)(F.PROJ + (size_t)(b * PL + tt) * NP + CX + xc) : (v4u){0u, 0u, 0u, 0u}; }
#pragma unroll
    for (int t = 0; t < 8; ++t) { float o[8];
#pragma unroll
        for (int e = 0; e < 8; ++e) { float a = bias[e];
#pragma unroll
            for (int j = 0; j < 4; ++j) { const unsigned wd = raw[t + j][e >> 1]; a += w[j][e] * ((e & 1) ? bfhi(wd) : bflo(wd)); }
            o[e] = silu_f(a); }
        const int tl = tb * 8 + t;
        if (SCALE && cg < 64) { const float sc = WDEC[(cg >> 3) * 64 + tl];
#pragma unroll
            for (int e = 0; e < 8; ++e) o[e] *= sc; }
        const v4u pkd = (v4u){pk2(o[0], o[1]), pk2(o[2], o[3]), pk2(o[4], o[5]), pk2(o[6], o[7])};
        LAS unsigned char* dst = cg < 64 ? X + tl * X_ST + cg * 16 : (cg < 80 ? BT + tl * BC_ST + (cg - 64) * 16 : CT + tl * BC_ST + (cg - 80) * 16);
        *(LAS v4u*)dst = pkd; }
}
__device__ __forceinline__ float ssd_head_scan(Frame& F, int hd, int row0, float& dt_out, float& last) {
    const float dt = softplus_f(F.LRDT[(size_t)(row0 + F.lane) * 32 + 16 + hd] + F.dt_bias[hd]);
    float cum = dt * (-__expf(F.A_log[hd]));
#pragma unroll
    for (int o = 1; o < 64; o <<= 1) { const float v = __shfl_up(cum, o); cum += (F.lane >= o) ? v : 0.f; }
    dt_out = dt; last = __shfl(cum, 63); return cum;
}
__device__ __forceinline__ void ssd_passA_unit(Frame& F, int u) {
    const int c = u & 31, bg = u >> 5, b = bg >> 1, g = bg & 1, row0 = b * PL + c * CH;
    LAS unsigned char* X = F.lds; LAS unsigned char* BT = X + 64 * X_ST; LAS float* WDEC = (LAS float*)(BT + 64 * BC_ST);
    const int w = F.wave, r = F.lane & 15, q = F.lane >> 4;
    { float dt, last; const float cum = ssd_head_scan(F, g * 8 + w, row0, dt, last);
        WDEC[w * 64 + F.lane] = __expf(last - cum) * dt; if (F.lane == 63) F.AL[(size_t)u * 8 + w] = __expf(last); }
    __syncthreads();
    for (int it = F.tid; it < 80 * 8; it += NTHR) ssd_conv_item<true>(F, b, g, c, it % 80, it / 80, X, BT, nullptr, WDEC);
    __syncthreads();
#pragma unroll 1
    for (int nh = 0; nh < 2; ++nh) {
        f32x4 acc[4][4];
#pragma unroll
        for (int i = 0; i < 4; ++i)
#pragma unroll
            for (int j = 0; j < 4; ++j) acc[i][j] = (f32x4){0.f, 0.f, 0.f, 0.f};
#pragma unroll
        for (int ks = 0; ks < 2; ++ks) { bf16x8v bp[4];
#pragma unroll
            for (int pf = 0; pf < 4; ++pf) bp[pf] = frag_t(X, X_ST, 32 * ks, 64 * w + 16 * pf, r, q);
#pragma unroll
            for (int nf = 0; nf < 4; ++nf) { const bf16x8v a = frag_t(BT, BC_ST, 32 * ks, 64 * nh + 16 * nf, r, q);
#pragma unroll
                for (int pf = 0; pf < 4; ++pf) acc[nf][pf] = MFMA16(a, bp[pf], acc[nf][pf]); } }
#pragma unroll
        for (int nf = 0; nf < 4; ++nf)
#pragma unroll
            for (int pf = 0; pf < 4; ++pf) *(v2u*)(F.DH + (((size_t)u * 8 + w) * SP + 16 * pf + r) * SN + 64 * nh + 16 * nf + 4 * q) = pk4(acc[nf][pf]);
    }
    __syncthreads();
}
__device__ __forceinline__ void ssd_scan(Frame& F) {
    for (int it = F.bid * NTHR + F.tid; it < PB * SH * SP * 32; it += F.G * NTHR) { const int n4 = it & 31, p = (it >> 5) & 63, bhd = it >> 11, b = bhd >> 4, hd = bhd & 15, g = hd >> 3, hl = hd & 7;
        f32x4 H = (f32x4){0.f, 0.f, 0.f, 0.f};
#pragma unroll 8
        for (int c = 0; c < NCH; ++c) { const int u = (b * 2 + g) * NCH + c; const size_t off = (((size_t)u * 8 + hl) * SP + p) * SN + 4 * n4;
            const v2u d = *(const v2u*)(F.DH + off); const float a = F.AL[(size_t)u * 8 + hl];
            *(v2u*)(F.HC + off) = pk4(H);
            H.x = a * H.x + bflo(d.x); H.y = a * H.y + bfhi(d.x); H.z = a * H.z + bflo(d.y); H.w = a * H.w + bfhi(d.y); }
        *(f32x4*)(F.out + O_SSD_P + ((size_t)bhd * SP + p) * SN + 4 * n4) = H; }
}
__device__ __forceinline__ void ssd_passC_unit(Frame& F, int u) {
    const int c = u & 31, bg = u >> 5, b = bg >> 1, g = bg & 1, row0 = b * PL + c * CH;
    LAS unsigned char* X = F.lds; LAS unsigned char* BT = X + 64 * X_ST; LAS unsigned char* CT = BT + 64 * BC_ST; LAS unsigned char* CB = CT + 64 * BC_ST;
    LAS float* DT = (LAS float*)(CB + 64 * ATT_ST); LAS float* CUM = DT + 512; LAS float* red = CUM + 512;
    const int w = F.wave, r = F.lane & 15, q = F.lane >> 4, hd = g * 8 + w;
    { float dt, last; const float cum = ssd_head_scan(F, hd, row0, dt, last); DT[w * 64 + F.lane] = dt; CUM[w * 64 + F.lane] = cum; }
    for (int it = F.tid; it < 96 * 8; it += NTHR) ssd_conv_item<false>(F, b, g, c, it % 96, it / 96, X, BT, CT, nullptr);
    __syncthreads();
#pragma unroll
    for (int ff = 0; ff < 2; ++ff) { const int f = 2 * w + ff, sf = f >> 2, tf = f & 3; f32x4 a4 = (f32x4){0.f, 0.f, 0.f, 0.f};
        if (sf <= tf) {
#pragma unroll
            for (int ks = 0; ks < 4; ++ks) a4 = MFMA16(frag_k(BT, BC_ST, 16 * sf, 32 * ks, r, q), frag_k(CT, BC_ST, 16 * tf, 32 * ks, r, q), a4); }
        *(LAS v2u*)(CB + (16 * tf + r) * ATT_ST + (16 * sf + 4 * q) * 2) = pk4(a4); }
    __syncthreads();
    f32x4 acc[4][4];
#pragma unroll
    for (int i = 0; i < 4; ++i)
#pragma unroll
        for (int j = 0; j < 4; ++j) acc[i][j] = (f32x4){0.f, 0.f, 0.f, 0.f};
    const bf16* Hc = F.HC + ((size_t)u * 8 + w) * SP * SN;
#pragma unroll
    for (int ks = 0; ks < 4; ++ks) { bf16x8v bc[4];
#pragma unroll
        for (int tf = 0; tf < 4; ++tf) bc[tf] = frag_k(CT, BC_ST, 16 * tf, 32 * ks, r, q);
#pragma unroll
        for (int pf = 0; pf < 4; ++pf) { const bf16x8v a = *(const bf16x8v*)(Hc + (size_t)(16 * pf + r) * SN + 32 * ks + 8 * q);
#pragma unroll
            for (int tf = 0; tf < 4; ++tf) acc[pf][tf] = MFMA16(a, bc[tf], acc[pf][tf]); } }
    float ct[4];
#pragma unroll
    for (int tf = 0; tf < 4; ++tf) { ct[tf] = CUM[w * 64 + 16 * tf + r]; const float e = __expf(ct[tf]);
#pragma unroll
        for (int pf = 0; pf < 4; ++pf) acc[pf][tf] = acc[pf][tf] * e; }
#pragma unroll
    for (int ks = 0; ks < 2; ++ks) { bf16x8v ax[4];
#pragma unroll
        for (int pf = 0; pf < 4; ++pf) ax[pf] = frag_t(X, X_ST, 32 * ks, 64 * w + 16 * pf, r, q);
        const int s0 = 32 * ks + 8 * q;
        const f32x4 cs0 = *(const LAS f32x4*)(CUM + w * 64 + s0), cs1 = *(const LAS f32x4*)(CUM + w * 64 + s0 + 4), ds0 = *(const LAS f32x4*)(DT + w * 64 + s0), ds1 = *(const LAS f32x4*)(DT + w * 64 + s0 + 4);
        const float cs[8] = {cs0.x, cs0.y, cs0.z, cs0.w, cs1.x, cs1.y, cs1.z, cs1.w}, ds[8] = {ds0.x, ds0.y, ds0.z, ds0.w, ds1.x, ds1.y, ds1.z, ds1.w};
#pragma unroll
        for (int tf = 0; tf < 4; ++tf) { if (32 * ks > 16 * tf + 15) continue;
            const int t = 16 * tf + r; const v4u cb8 = *(const LAS v4u*)(CB + t * ATT_ST + s0 * 2); float l[8];
#pragma unroll
            for (int e = 0; e < 8; ++e) { const unsigned wd = cb8[e >> 1]; const float cbv = (e & 1) ? bfhi(wd) : bflo(wd); l[e] = (s0 + e <= t) ? cbv * __expf(ct[tf] - cs[e]) * ds[e] : 0.f; }
            const v4u lp = (v4u){pk2(l[0], l[1]), pk2(l[2], l[3]), pk2(l[4], l[5]), pk2(l[6], l[7])}; const bf16x8v bl = __builtin_bit_cast(bf16x8v, lp);
#pragma unroll
            for (int pf = 0; pf < 4; ++pf) acc[pf][tf] = MFMA16(ax[pf], bl, acc[pf][tf]); } }
    const float Dh = F.ssd_D[hd];
#pragma unroll
    for (int tf = 0; tf < 4; ++tf) { const int t = 16 * tf + r; const size_t row = (size_t)(row0 + t); float ss = 0.f;
#pragma unroll
        for (int pf = 0; pf < 4; ++pf) { const int p4 = 64 * w + 16 * pf + 4 * q;
            const v2u xv = *(const LAS v2u*)(X + t * X_ST + p4 * 2); const v2u zv = *(const v2u*)(F.PROJ + row * NP + CZ + g * 512 + p4);
            f32x4 y = acc[pf][tf];
            y.x = (y.x + Dh * bflo(xv.x)) * silu_f(bflo(zv.x)); y.y = (y.y + Dh * bfhi(xv.x)) * silu_f(bfhi(zv.x)); y.z = (y.z + Dh * bflo(xv.y)) * silu_f(bflo(zv.y)); y.w = (y.w + Dh * bfhi(xv.y)) * silu_f(bfhi(zv.y));
            acc[pf][tf] = y; ss += (y.x * y.x + y.y * y.y) + (y.z * y.z + y.w * y.w); }
        ss += __shfl_xor(ss, 16); ss += __shfl_xor(ss, 32);
        if (q == 0) red[w * 64 + t] = ss; }
    __syncthreads();
#pragma unroll
    for (int tf = 0; tf < 4; ++tf) { const int t = 16 * tf + r; const size_t row = (size_t)(row0 + t); float tot = 0.f;
#pragma unroll
        for (int ww = 0; ww < 8; ++ww) tot += red[ww * 64 + t];
        const float rr = rsqrtf(tot * (1.f / 512.f) + EPS);
#pragma unroll
        for (int pf = 0; pf < 4; ++pf) { const int p4 = g * 512 + 64 * w + 16 * pf + 4 * q; const f32x4 nw = *(const f32x4*)(F.ssd_norm + p4);
            f32x4 o = acc[pf][tf]; o.x *= rr * nw.x; o.y *= rr * nw.y; o.z *= rr * nw.z; o.w *= rr * nw.w;
            *(v2u*)(F.MIXIN + row * DM + 1024 + p4) = pk4(o); } }
    __syncthreads();
}

constexpr int ATT8_ST = 80;
__device__ __forceinline__ void gla_sample_unit(Frame& F, int b, int h, f32x4 (&S)[16], int nb, int nh, bool has_next) {
    const int tid = F.tid, w = F.wave, lane = F.lane, r = lane & 15, q = lane >> 4, row0 = MP + b * SL;
    LAS unsigned char* S0b = F.lds;
    LAS unsigned char* Vt = S0b + 128 * V_ST;
    LAS unsigned char* QE = Vt + 32 * V_ST;
    LAS unsigned char* KE = QE + 16 * QE_ST;
    LAS unsigned char* ATT = KE + 16 * QE_ST;
    LAS float* KD = (LAS float*)(ATT + 16 * ATT8_ST);
    LAS float* EL = KD + 1024;
    LAS float* red = EL + 128;
    f32x4 Vf[8];
#pragma unroll
    for (int s = 0; s < 8; ++s) { const v2u vv = *(const v2u*)(F.PROJ + (size_t)(row0 + s) * NP + CV + h * GV + 4 * lane); Vf[s] = (f32x4){bflo(vv.x), bfhi(vv.x), bflo(vv.y), bfhi(vv.y)}; }
    if (tid < 256) { const int t = tid >> 5, c16 = tid & 31; *(LAS v4u*)(Vt + t * V_ST + c16 * 16) = *(const v4u*)(F.PROJ + (size_t)(row0 + t) * NP + CV + h * GV + c16 * 8); }
    for (int i = tid; i < 24 * 32; i += NTHR) *(LAS v4u*)(Vt + (8 + (i >> 5)) * V_ST + (i & 31) * 16) = (v4u){0u, 0u, 0u, 0u};
    { LAS unsigned char* KR = (LAS unsigned char*)(red + 128); LAS unsigned char* QR = KR + 8 * 256; LAS float* LR = (LAS float*)(QR + 8 * 256); LAS float* LG = LR + 128;
        if (tid < 256) { const int which = tid >> 7, j = tid & 127, t = j >> 4, c16 = j & 15;
            *(LAS v4u*)((which ? QR : KR) + t * 256 + c16 * 16) = *(const v4u*)(F.PROJ + (size_t)(row0 + t) * NP + (which ? CQ : CK) + h * GK + c16 * 8); }
        else if (tid < 288) { const int j = tid - 256; *(LAS v4u*)(LR + (j >> 2) * 16 + (j & 3) * 4) = *(const v4u*)(F.LRDT + (size_t)(row0 + (j >> 2)) * 32 + (j & 3) * 4); }
        __syncthreads();
        { const int k = tid & 127, tp = tid >> 7, hk = h * GK + k; const float bg = F.b_gate[hk];
            float w2[16];
#pragma unroll
            for (int j = 0; j < 16; ++j) w2[j] = F.w_gate2[j * GKD + hk];
#pragma unroll
            for (int tt = 0; tt < 2; ++tt) { const int t = 2 * tp + tt; const LAS f32x4* lr = (const LAS f32x4*)(LR + t * 16); const f32x4 a = lr[0], bq = lr[1], c = lr[2], d = lr[3];
                const float x = bg + a.x * w2[0] + a.y * w2[1] + a.z * w2[2] + a.w * w2[3] + bq.x * w2[4] + bq.y * w2[5] + bq.z * w2[6] + bq.w * w2[7]
                              + c.x * w2[8] + c.y * w2[9] + c.z * w2[10] + c.w * w2[11] + d.x * w2[12] + d.y * w2[13] + d.z * w2[14] + d.w * w2[15];
                LG[t * 128 + k] = logsigmoid_f(x) * (1.f / 16.f); } }
        __syncthreads();
        if (tid < 128) { const int k = tid;
            float bcum[8], kv[8]; float run = 0.f;
#pragma unroll
            for (int t = 0; t < 8; ++t) { run += LG[t * 128 + k]; bcum[t] = run; kv[t] = bf2f(*(const LAS bf16*)(KR + t * 256 + k * 2));
                *(LAS bf16*)(QE + t * QE_ST + k * 2) = (bf16)f2bf(bf2f(*(const LAS bf16*)(QR + t * 256 + k * 2)) * 0.08838834764831845f * __expf(run));
                *(LAS bf16*)(KE + t * QE_ST + k * 2) = (bf16)f2bf(kv[t] * __expf(-run)); }
            f32x4 d0, d1; d0.x = kv[0] * __expf(run - bcum[0]); d0.y = kv[1] * __expf(run - bcum[1]); d0.z = kv[2] * __expf(run - bcum[2]); d0.w = kv[3] * __expf(run - bcum[3]);
            d1.x = kv[4] * __expf(run - bcum[4]); d1.y = kv[5] * __expf(run - bcum[5]); d1.z = kv[6] * __expf(run - bcum[6]); d1.w = kv[7];
            *(LAS f32x4*)(KD + k * 8) = d0; *(LAS f32x4*)(KD + k * 8 + 4) = d1; EL[k] = __expf(run); } }
    if (tid < 128) {
    } else if (tid < 384) { const int i = tid - 128, which = i >> 7, j = i & 127;
        *(LAS v4u*)((which ? KE : QE) + (8 + (j >> 4)) * QE_ST + (j & 15) * 16) = (v4u){0u, 0u, 0u, 0u};
    } else if (tid < 384 + 80) { *(LAS v4u*)(ATT + (tid - 384) * 16) = (v4u){0u, 0u, 0u, 0u}; }
#pragma unroll
    for (int i = 0; i < 16; ++i) *(LAS v2u*)(S0b + (16 * w + i) * V_ST + lane * 8) = pk4(S[i]);
    __syncthreads();
    if (w == 0) { f32x4 a4 = (f32x4){0.f, 0.f, 0.f, 0.f};
#pragma unroll
        for (int ks = 0; ks < 4; ++ks) a4 = MFMA16(frag_k(KE, QE_ST, 0, 32 * ks, r, q), frag_k(QE, QE_ST, 0, 32 * ks, r, q), a4);
        const int s0i = 4 * q; f32x4 m; m.x = (s0i <= r) ? a4.x : 0.f; m.y = (s0i + 1 <= r) ? a4.y : 0.f; m.z = (s0i + 2 <= r) ? a4.z : 0.f; m.w = (s0i + 3 <= r) ? a4.w : 0.f;
        if (r >= 8) m = (f32x4){0.f, 0.f, 0.f, 0.f};
        *(LAS v2u*)(ATT + r * ATT8_ST + s0i * 2) = pk4(m); }
    { f32x4* so = (f32x4*)(F.out + O_GLA_S + ((size_t)(b * GH + h) * GK + 16 * w) * GV) + lane;
#pragma unroll
        for (int i = 0; i < 16; ++i) { const int k = 16 * w + i; const float e = EL[k]; const f32x4 k0 = *(const LAS f32x4*)(KD + k * 8), k1 = *(const LAS f32x4*)(KD + k * 8 + 4);
            f32x4 n = S[i] * e; n = n + Vf[0] * k0.x; n = n + Vf[1] * k0.y; n = n + Vf[2] * k0.z; n = n + Vf[3] * k0.w; n = n + Vf[4] * k1.x; n = n + Vf[5] * k1.y; n = n + Vf[6] * k1.z; n = n + Vf[7] * k1.w;
            so[i * 64] = n; } }
    if (has_next) { const f32x4* s1 = (const f32x4*)(F.st_gla + ((size_t)(nb * GH + nh) * GK + 16 * w) * GV) + lane;
#pragma unroll
        for (int i = 0; i < 16; ++i) S[i] = s1[i * 64]; }
    f32x4 acc[2] = {(f32x4){0.f, 0.f, 0.f, 0.f}, (f32x4){0.f, 0.f, 0.f, 0.f}};
#pragma unroll
    for (int ks = 0; ks < 4; ++ks) { const bf16x8v bq = frag_k(QE, QE_ST, 0, 32 * ks, r, q);
#pragma unroll
        for (int vf = 0; vf < 2; ++vf) acc[vf] = MFMA16(frag_t(S0b, V_ST, 32 * ks, 32 * w + 16 * vf, r, q), bq, acc[vf]); }
    __syncthreads();
    { const bf16x8v ba = *(const LAS bf16x8v*)(ATT + r * ATT8_ST + 16 * q);
#pragma unroll
        for (int vf = 0; vf < 2; ++vf) acc[vf] = MFMA16(frag_t(Vt, V_ST, 0, 32 * w + 16 * vf, r, q), ba, acc[vf]); }
    float ss = (acc[0].x * acc[0].x + acc[0].y * acc[0].y) + (acc[0].z * acc[0].z + acc[0].w * acc[0].w) + (acc[1].x * acc[1].x + acc[1].y * acc[1].y) + (acc[1].z * acc[1].z + acc[1].w * acc[1].w);
    ss += __shfl_xor(ss, 16); ss += __shfl_xor(ss, 32);
    if (q == 0) red[w * 16 + r] = ss;
    __syncthreads();
    float tot = 0.f;
#pragma unroll
    for (int ww = 0; ww < 8; ++ww) tot += red[ww * 16 + r];
    const float rr = rsqrtf(tot * (1.f / GV) + EPS);
    if (r < 8) { const size_t row = (size_t)(row0 + r);
#pragma unroll
        for (int vf = 0; vf < 2; ++vf) { const int v = 32 * w + 16 * vf + 4 * q;
            const v2u gw = *(const v2u*)(F.PROJ + row * NP + CG + h * GV + v); const f32x4 nw = *(const f32x4*)(F.gla_norm + v);
            f32x4 o; o.x = acc[vf].x * rr * nw.x * silu_f(bflo(gw.x)); o.y = acc[vf].y * rr * nw.y * silu_f(bfhi(gw.x)); o.z = acc[vf].z * rr * nw.z * silu_f(bflo(gw.y)); o.w = acc[vf].w * rr * nw.w * silu_f(bfhi(gw.y));
            *(v2u*)(F.MIXIN + row * DM + h * GV + v) = pk4(o); } }
    __syncthreads();
}
__device__ __forceinline__ void ssd_sample_unit(Frame& F, int b, int g) {
    const int tid = F.tid, w = F.wave, lane = F.lane, r = lane & 15, q = lane >> 4, row0 = MP + b * SL, hd = g * 8 + w, ch = g * 512 + tid;
    LAS float* Xs = (LAS float*)F.lds;
    LAS float* XW = Xs + 4096;
    LAS float* Bs = XW + 4096;
    LAS unsigned char* Cb = (LAS unsigned char*)(Bs + 1024);
    LAS unsigned char* Bb = Cb + 16 * QE_ST;
    LAS float* CBm = (LAS float*)(Bb + 16 * QE_ST);
    LAS float* CD = CBm + 256;
    LAS float* red = CD + 128;
    const float* h0base = F.st_ssd + ((size_t)(b * SH + hd) * SP) * SN; float* hobase = F.out + O_SSD_S + ((size_t)(b * SH + hd) * SP) * SN;
    f32x4 hbuf[4][2];
#pragma unroll
    for (int i = 0; i < 4; ++i) { const size_t off = (size_t)(16 * (i & 3) + r) * SN + 32 * (i >> 2) + 8 * q; hbuf[i][0] = *(const f32x4*)(h0base + off); hbuf[i][1] = *(const f32x4*)(h0base + off + 4); }
    float dt[8], cum[8]; { const float A = -__expf(F.A_log[hd]), dtb = F.dt_bias[hd]; float run = 0.f;
#pragma unroll
        for (int t = 0; t < 8; ++t) { dt[t] = softplus_f(F.LRDT[(size_t)(row0 + t) * 32 + 16 + hd] + dtb); run += dt[t] * A; cum[t] = run; } }
    const float last = cum[7], elast = __expf(last);
    if (lane < 8) { float cv = cum[0], dv = dt[0];
#pragma unroll
        for (int t = 1; t < 8; ++t) { cv = (lane == t) ? cum[t] : cv; dv = (lane == t) ? dt[t] : dv; }
        CD[w * 16 + lane] = cv; CD[w * 16 + 8 + lane] = dv; }
    { float xr[11]; const float cb = F.sconv_b[ch], c0 = F.sconv_w[ch], c1 = F.sconv_w[SCH + ch], c2 = F.sconv_w[2 * SCH + ch], c3 = F.sconv_w[3 * SCH + ch];
#pragma unroll
        for (int i = 0; i < 11; ++i) xr[i] = xbc_raw(F, 1, b, row0, i - 3, ch);
        float xw[8];
#pragma unroll
        for (int t = 0; t < 8; ++t) { const float x = silu_f(cb + c0 * xr[t] + c1 * xr[t + 1] + c2 * xr[t + 2] + c3 * xr[t + 3]); Xs[t * 512 + tid] = x; xw[t] = x * __expf(last - cum[t]) * dt[t]; }
        *(LAS f32x4*)(XW + tid * 8) = (f32x4){xw[0], xw[1], xw[2], xw[3]}; *(LAS f32x4*)(XW + tid * 8 + 4) = (f32x4){xw[4], xw[5], xw[6], xw[7]}; }
    if (tid < 256) { const int n = tid & 127, isC = tid >> 7, cc = 1024 + isC * 256 + g * 128 + n;
        float xr[11]; const float cb = F.sconv_b[cc], c0 = F.sconv_w[cc], c1 = F.sconv_w[SCH + cc], c2 = F.sconv_w[2 * SCH + cc], c3 = F.sconv_w[3 * SCH + cc];
#pragma unroll
        for (int i = 0; i < 11; ++i) xr[i] = xbc_raw(F, 1, b, row0, i - 3, cc);
#pragma unroll
        for (int t = 0; t < 8; ++t) { const float x = silu_f(cb + c0 * xr[t] + c1 * xr[t + 1] + c2 * xr[t + 2] + c3 * xr[t + 3]);
            if (!isC) Bs[t * 128 + n] = x;
            *(LAS bf16*)((isC ? Cb : Bb) + t * QE_ST + n * 2) = (bf16)f2bf(x); }
    } else { const int i = tid - 256, which = i >> 7, j = i & 127; *(LAS v4u*)((which ? Bb : Cb) + (8 + (j >> 4)) * QE_ST + (j & 15) * 16) = (v4u){0u, 0u, 0u, 0u}; }
    __syncthreads();
    if (w == 0) { f32x4 a4 = (f32x4){0.f, 0.f, 0.f, 0.f};
#pragma unroll
        for (int ks = 0; ks < 4; ++ks) a4 = MFMA16(frag_k(Bb, QE_ST, 0, 32 * ks, r, q), frag_k(Cb, QE_ST, 0, 32 * ks, r, q), a4);
        *(LAS f32x4*)(CBm + r * 16 + 4 * q) = a4; }
    bf16x8v bc[4];
#pragma unroll
    for (int ks = 0; ks < 4; ++ks) bc[ks] = frag_k(Cb, QE_ST, 0, 32 * ks, r, q);
    f32x4 acc[4];
#pragma unroll
    for (int pf = 0; pf < 4; ++pf) acc[pf] = (f32x4){0.f, 0.f, 0.f, 0.f};
    f32x4 Bv[8][2];
#pragma unroll
    for (int st = 0; st < 16; ++st) { const int ks = st >> 2, pf = st & 3;
        if (pf == 0) {
#pragma unroll
            for (int s = 0; s < 8; ++s) { Bv[s][0] = *(const LAS f32x4*)(Bs + s * 128 + 32 * ks + 8 * q); Bv[s][1] = *(const LAS f32x4*)(Bs + s * 128 + 32 * ks + 8 * q + 4); } }
        const int p = 16 * pf + r; const size_t off = (size_t)p * SN + 32 * ks + 8 * q;
        const f32x4 ha = hbuf[st & 3][0], hb = hbuf[st & 3][1];
        if (st + 4 < 16) { const int st2 = st + 4; const size_t off2 = (size_t)(16 * (st2 & 3) + r) * SN + 32 * (st2 >> 2) + 8 * q; hbuf[st & 3][0] = *(const f32x4*)(h0base + off2); hbuf[st & 3][1] = *(const f32x4*)(h0base + off2 + 4); }
        asm volatile("" ::: "memory");
        const f32x4 x0 = *(const LAS f32x4*)(XW + (64 * w + p) * 8), x1 = *(const LAS f32x4*)(XW + (64 * w + p) * 8 + 4);
        f32x4 na = ha * elast, nb = hb * elast;
        na = na + Bv[0][0] * x0.x; nb = nb + Bv[0][1] * x0.x; na = na + Bv[1][0] * x0.y; nb = nb + Bv[1][1] * x0.y; na = na + Bv[2][0] * x0.z; nb = nb + Bv[2][1] * x0.z; na = na + Bv[3][0] * x0.w; nb = nb + Bv[3][1] * x0.w;
        na = na + Bv[4][0] * x1.x; nb = nb + Bv[4][1] * x1.x; na = na + Bv[5][0] * x1.y; nb = nb + Bv[5][1] * x1.y; na = na + Bv[6][0] * x1.z; nb = nb + Bv[6][1] * x1.z; na = na + Bv[7][0] * x1.w; nb = nb + Bv[7][1] * x1.w;
        *(f32x4*)(hobase + off) = na; *(f32x4*)(hobase + off + 4) = nb;
        const v4u ap = (v4u){pk2(ha.x, ha.y), pk2(ha.z, ha.w), pk2(hb.x, hb.y), pk2(hb.z, hb.w)};
        acc[pf] = MFMA16(__builtin_bit_cast(bf16x8v, ap), bc[ks], acc[pf]); }
    __syncthreads();
    const int tc = r & 7; const float ct = CD[w * 16 + tc], ect = __expf(ct), Dh = F.ssd_D[hd];
    float L[8]; { const f32x4 c0 = *(const LAS f32x4*)(CBm + r * 16), c1 = *(const LAS f32x4*)(CBm + r * 16 + 4); const float cbv[8] = {c0.x, c0.y, c0.z, c0.w, c1.x, c1.y, c1.z, c1.w};
        const f32x4 q0 = *(const LAS f32x4*)(CD + w * 16), q1 = *(const LAS f32x4*)(CD + w * 16 + 4), d0 = *(const LAS f32x4*)(CD + w * 16 + 8), d1 = *(const LAS f32x4*)(CD + w * 16 + 12);
        const float cu[8] = {q0.x, q0.y, q0.z, q0.w, q1.x, q1.y, q1.z, q1.w}, dd[8] = {d0.x, d0.y, d0.z, d0.w, d1.x, d1.y, d1.z, d1.w};
#pragma unroll
        for (int s = 0; s < 8; ++s) L[s] = (s <= tc) ? cbv[s] * __expf(ct - cu[s]) * dd[s] : 0.f; }
    float ss = 0.f; const size_t row = (size_t)(row0 + tc);
#pragma unroll
    for (int pf = 0; pf < 4; ++pf) { const int p4 = 64 * w + 16 * pf + 4 * q;
        f32x4 y = acc[pf] * ect;
#pragma unroll
        for (int s = 0; s < 8; ++s) y = y + *(const LAS f32x4*)(Xs + s * 512 + p4) * L[s];
        const f32x4 xt = *(const LAS f32x4*)(Xs + tc * 512 + p4); const v2u zv = *(const v2u*)(F.PROJ + row * NP + CZ + g * 512 + p4);
        y.x = (y.x + Dh * xt.x) * silu_f(bflo(zv.x)); y.y = (y.y + Dh * xt.y) * silu_f(bfhi(zv.x)); y.z = (y.z + Dh * xt.z) * silu_f(bflo(zv.y)); y.w = (y.w + Dh * xt.w) * silu_f(bfhi(zv.y));
        acc[pf] = y; ss += (y.x * y.x + y.y * y.y) + (y.z * y.z + y.w * y.w); }
    ss += __shfl_xor(ss, 16); ss += __shfl_xor(ss, 32);
    if (q == 0) red[w * 16 + r] = ss;
    __syncthreads();
    float tot = 0.f;
#pragma unroll
    for (int ww = 0; ww < 8; ++ww) tot += red[ww * 16 + r];
    const float rr = rsqrtf(tot * (1.f / 512.f) + EPS);
    if (r < 8) {
#pragma unroll
        for (int pf = 0; pf < 4; ++pf) { const int p4 = g * 512 + 64 * w + 16 * pf + 4 * q; const f32x4 nw = *(const f32x4*)(F.ssd_norm + p4);
            f32x4 o = acc[pf]; o.x *= rr * nw.x; o.y *= rr * nw.y; o.z *= rr * nw.z; o.w *= rr * nw.w;
            *(v2u*)(F.MIXIN + row * DM + 1024 + p4) = pk4(o); } }
    __syncthreads();
}

__device__ __forceinline__ void p2a_chunk_states(Frame& F) {
    for (int idx = F.bid; idx < 768; idx += F.G) { if (idx < 256) { TBEGIN(F, 20); ssd_passA_unit(F, idx); TEND(F, 20); } else { TBEGIN(F, 21); gla_passA_unit(F, idx - 256); TEND(F, 21); } }
}
#ifndef MK_REP_PHASE
#define MK_REP_PHASE (-1)
#endif
__device__ __forceinline__ void p2b_scans_and_sample(Frame& F) {
    TBEGIN(F, 30); for (int rep = 0; rep < (MK_REP_PHASE == 30 ? 2 : 1); ++rep) { gla_scan(F); ssd_scan(F); } TEND(F, 30);
    TBEGIN(F, 31);
    for (int rep = 0; rep < (MK_REP_PHASE == 31 ? 2 : 1); ++rep)
    { f32x4 S[16]; int idx = F.bid;
            if (idx < SB * GH) { const f32x4* s0 = (const f32x4*)(F.st_gla + ((size_t)idx * GK + 16 * F.wave) * GV) + F.lane;
#pragma unroll
                for (int i = 0; i < 16; ++i) S[i] = s0[i * 64]; }
            for (; idx < SB * GH; idx += F.G) { const int nx = idx + F.G; gla_sample_unit(F, idx / GH, idx % GH, S, nx / GH, nx % GH, nx < SB * GH); } }
    TEND(F, 31); TBEGIN(F, 32);
    for (int rep = 0; rep < (MK_REP_PHASE == 32 ? 2 : 1); ++rep)
        for (int idx = F.bid; idx < SB * SG; idx += F.G) ssd_sample_unit(F, idx / SG, idx % SG);
    TEND(F, 32);
}
__device__ __forceinline__ void p2c_outputs(Frame& F) {
    for (int idx = F.bid; idx < 768; idx += F.G) { if (idx < 256) { TBEGIN(F, 40); ssd_passC_unit(F, idx); TEND(F, 40); } else { TBEGIN(F, 41); gla_passC_unit(F, idx - 256); TEND(F, 41); } }
    TBEGIN(F, 42);
    const int gt = F.bid * NTHR + F.tid, NT = F.G * NTHR;
    for (int i = gt; i < (PB + SB) * 3 * SCH; i += NT) { const int c = i % SCH, j = (i / SCH) % 3, s = i / (3 * SCH);
        const int grp = s >= PB, b = grp ? s - PB : s, L = grp ? SL : PL, row0 = grp ? MP + b * SL : b * PL;
        F.out[(grp ? O_SCONV_S : O_SCONV_P) + ((size_t)b * 3 + j) * SCH + c] = bf2f(F.PROJ[(size_t)(row0 + L - 3 + j) * NP + CX + c]); }
    TEND(F, 42);
}

__device__ __forceinline__ void p4_post_mixer(Frame& F) {
    const int gw = F.bid * NWAVES + F.wave, NGW = F.G * NWAVES, lane = F.lane;
    for (int m = gw; m < M; m += NGW) {
        const f32x4* mr = (const f32x4*)(F.MIX + (size_t)m * DM) + lane; const f32x4* xr = (const f32x4*)x_row(F, m) + lane;
        const f32x4* w1 = (const f32x4*)F.n_mix_post + lane; const f32x4* w2 = (const f32x4*)F.n_ffn_pre + lane;
        f32x4 v[8]; float s = 0.f;
#pragma unroll
        for (int j = 0; j < 8; ++j) { v[j] = mr[64 * j]; s += (v[j].x * v[j].x + v[j].y * v[j].y) + (v[j].z * v[j].z + v[j].w * v[j].w); }
        const float r1 = rsqrtf(wave_sum(s) * (1.f / DM) + EPS); float s2 = 0.f;
        f32x4* ho = (f32x4*)(F.out + O_Y + (size_t)m * DM) + lane;
#pragma unroll
        for (int j = 0; j < 8; ++j) { v[j] = xr[64 * j] + v[j] * r1 * w1[64 * j]; ho[64 * j] = v[j]; s2 += (v[j].x * v[j].x + v[j].y * v[j].y) + (v[j].z * v[j].z + v[j].w * v[j].w); }
        const float r2 = rsqrtf(wave_sum(s2) * (1.f / DM) + EPS);
        v2u* o8 = (v2u*)(F.XN + (size_t)m * DM) + lane;
#pragma unroll
        for (int j = 0; j < 8; ++j) { const f32x4 ww = w2[64 * j]; v2u o; o.x = pk2(v[j].x * r2 * ww.x, v[j].y * r2 * ww.y); o.y = pk2(v[j].z * r2 * ww.z, v[j].w * r2 * ww.w); o8[64 * j] = o; }
    }
}
__device__ __forceinline__ void p6_conv_fixup(Frame& F) {
    const int gt = F.bid * NTHR + F.tid, NT = F.G * NTHR;
    constexpr int NQ = FF / 4;
    for (int it = gt; it < 28 * 2 * NQ; it += NT) { const int c = (it % NQ) * 4, rr = (it / NQ) & 1, bi = it / (2 * NQ), pm = (bi / 7) * 8 + 1 + (bi % 7);
        f32x4 o[2];
#pragma unroll
        for (int hf = 0; hf < 2; ++hf) { const int cc = hf * FF + c;
            const f32x4 w0 = *(const f32x4*)(F.fconv_w + cc), w1 = *(const f32x4*)(F.fconv_w + FF2 + cc), w2 = *(const f32x4*)(F.fconv_w + 2 * FF2 + cc), bs = *(const f32x4*)(F.fconv_b + cc);
            const f32x4 um2 = *(const f32x4*)(F.HG + ((size_t)(pm - 1) * 4 + 2 + rr) * FF2 + cc);
            const f32x4 um1 = rr ? *(const f32x4*)(F.HG + ((size_t)pm * 4) * FF2 + cc) : *(const f32x4*)(F.HG + ((size_t)(pm - 1) * 4 + 3) * FF2 + cc);
            const f32x4 u0 = *(const f32x4*)(F.HG + ((size_t)pm * 4 + rr) * FF2 + cc);
            o[hf] = bs + w0 * um2 + w1 * um1 + w2 * u0; }
        v2u pk; pk.x = pk2(silu_f(o[0].x) * o[1].x, silu_f(o[0].y) * o[1].y); pk.y = pk2(silu_f(o[0].z) * o[1].z, silu_f(o[0].w) * o[1].w);
        *(v2u*)(F.ACT + (size_t)(pm * 256 + rr) * FF + c) = pk; }
    for (int i = gt; i < PB * 2 * (FF2 / 4); i += NT) { const int c = (i % (FF2 / 4)) * 4, j = (i / (FF2 / 4)) & 1, b = i / (2 * (FF2 / 4));
        *(f32x4*)(F.out + O_FCONV_P + ((size_t)b * 2 + j) * FF2 + c) = *(const f32x4*)(F.HG + ((size_t)(b * 8 + 7) * 4 + 2 + j) * FF2 + c); }
}
__device__ __forceinline__ void p8_final(Frame& F) {
    const int gw = F.bid * NWAVES + F.wave, NGW = F.G * NWAVES, lane = F.lane;
    for (int m = gw; m < M; m += NGW) {
        const f32x4* fr = (const f32x4*)(F.Fb + (size_t)m * DM) + lane; const f32x4* w1 = (const f32x4*)F.n_ffn_post + lane;
        f32x4* ho = (f32x4*)(F.out + O_Y + (size_t)m * DM) + lane;
        f32x4 v[8]; float s = 0.f;
#pragma unroll
        for (int j = 0; j < 8; ++j) { v[j] = fr[64 * j]; s += (v[j].x * v[j].x + v[j].y * v[j].y) + (v[j].z * v[j].z + v[j].w * v[j].w); }
        const float r1 = rsqrtf(wave_sum(s) * (1.f / DM) + EPS);
#pragma unroll
        for (int j = 0; j < 8; ++j) ho[64 * j] = ho[64 * j] + v[j] * r1 * w1[64 * j];
    }
}

__device__ __forceinline__ pg8::SplitCtx split_ctx(const Frame& F, unsigned char* ws, size_t slab_off, int bank) {
    pg8::SplitCtx X; X.slabs = (pg8::f32x4*)(ws + slab_off); X.cnt = (unsigned*)(ws + WS_CTL) + CW_SPLIT + bank * 1024; X.flag = (volatile LAS unsigned*)(F.lds + MISC_OFF) + 16; return X; }

struct Args { const float* in[25]; float* out; unsigned char* ws; int ph_lo, ph_hi; };
__global__ void __launch_bounds__(NTHR, 2) fwd_kernel(Args args) {
    extern __shared__ __attribute__((aligned(16))) unsigned char lds[];
    Frame F;
    F.lds = (LAS unsigned char*)lds;
    F.tid = threadIdx.x; F.lane = F.tid & 63; F.wave = __builtin_amdgcn_readfirstlane(F.tid >> 6);
    F.G = gridDim.x; F.bid = blockIdx.x;
    unsigned char* ws = args.ws;
    F.x_p = args.in[0]; F.x_s = args.in[1]; F.st_gla = args.in[2]; F.st_ssd = args.in[3]; F.st_sconv = args.in[4]; F.st_fconv = args.in[5];
    F.n_mix_pre = args.in[6]; F.n_mix_post = args.in[7]; F.n_ffn_pre = args.in[8]; F.n_ffn_post = args.in[9]; F.w_in = args.in[10];
    F.w_gate2 = args.in[11]; F.b_gate = args.in[12]; F.gla_norm = args.in[13]; F.sconv_w = args.in[14]; F.sconv_b = args.in[15];
    F.dt_bias = args.in[16]; F.A_log = args.in[17]; F.ssd_D = args.in[18]; F.ssd_norm = args.in[19]; F.w_out = args.in[20];
    F.ffn_w_in = args.in[21]; F.fconv_w = args.in[22]; F.fconv_b = args.in[23]; F.ffn_w_out = args.in[24];
    F.out = args.out;
    F.W1 = (bf16*)(ws + WS_W1); F.WO = (bf16*)(ws + WS_WO); F.WF1 = (bf16*)(ws + WS_WF1); F.WF2 = (bf16*)(ws + WS_WF2);
    F.XN = (bf16*)(ws + WS_XN); F.PROJ = (bf16*)(ws + WS_PROJ); F.MIXIN = (bf16*)(ws + WS_MIXIN); F.ACT = (bf16*)(ws + WS_ACT); F.HG = (float*)(ws + WS_HG);
    F.LRDT = (float*)(ws + WS_LRDT); F.MIX = (float*)(ws + WS_MIX); F.Fb = (float*)(ws + WS_F);
    F.DS = (bf16*)(ws + WS_DS); F.SC = (bf16*)(ws + WS_SC); F.DH = (bf16*)(ws + WS_DH); F.HC = (bf16*)(ws + WS_HC); F.EBL = (float*)(ws + WS_EBL); F.AL = (float*)(ws + WS_AL); F.QEg = (bf16*)(ws + WS_QEG); F.KEg = (bf16*)(ws + WS_KEG);
    for (int u = F.tid; u < (LDS_BYTES - LDSCTL_OFF) / 4; u += NTHR) ((LAS unsigned*)(F.lds + LDSCTL_OFF))[u] = 0u;
    __syncthreads();
    const int lo = args.ph_lo, hi = args.ph_hi;
#if !MK_PER_PHASE
    XcdBarrier bar = xcd_barrier_post((unsigned*)(ws + WS_CTL) + CW_BAR, (volatile LAS unsigned*)(F.lds + MISC_OFF) + 8);
#define GRID_BAR() do { if (args.ph_hi > 1000) cg::this_grid().sync(); xcd_barrier(bar); } while (0)
#else
#define GRID_BAR() do { } while (0)
#endif
#define IN(k) (lo <= (k) && (k) < hi)
#define SEAM(k) do { if (IN(k) && IN((k) + 1)) GRID_BAR(); } while (0)
    F.tacc = 0; F.tmark = 0;
#define PHASE(k, ...) do { if (IN(k)) { TBEGIN(F, k); if (MK_REP_PHASE == (k)) { __VA_ARGS__; GRID_BAR(); } __VA_ARGS__; SEAM(k); TEND(F, k); } } while (0)
    PHASE(0, p0_prologue(F));
    PHASE(1, { pg8::Gemm g{F.XN, F.W1, M, N1, DM}; pg8::StaticOrder S; S.init(M, N1, DM, F.G, F.bid, 1);
        pg8::EpiBf16 E{F.PROJ, NP, NP / 256, F.LRDT};
        pg8::gemm_phase<pg8::EpiBf16, pg8::StaticOrder, true, true>(F.lds, g, S, E, split_ctx(F, ws, WS_SLAB, 0));
        if (S.rem && F.bid >= S.rem * S.S) p0_convert_rest(F, F.bid - S.rem * S.S, F.G - S.rem * S.S); else if (!S.rem) p0_convert_rest(F, F.bid, F.G); });
    PHASE(2, p2a_chunk_states(F));
    PHASE(3, p2b_scans_and_sample(F));
    PHASE(4, p2c_outputs(F));
    PHASE(5, { pg8::Gemm g{F.MIXIN, F.WO, M, DM, DM}; pg8::StaticOrder S; S.init(M, DM, DM, F.G, F.bid, 8);
        pg8::EpiF32 E{F.MIX, DM};
        pg8::gemm_phase<pg8::EpiF32, pg8::StaticOrder, true, true>(F.lds, g, S, E, split_ctx(F, ws, WS_SLAB, 1)); });
    PHASE(6, p4_post_mixer(F));
    PHASE(7, { pg8::Gemm g{F.XN, F.WF1, M, FF2, DM}; pg8::StaticOrder S; S.init(M, FF2, DM, F.G, F.bid, 1);
        pg8::EpiConvAct E{F.ACT, F.HG, F.fconv_w, F.fconv_b, F.st_fconv, F.out + O_FCONV_S, (LAS float*)(F.lds + MISC_OFF + 512)};
        pg8::gemm_phase<pg8::EpiConvAct, pg8::StaticOrder, true, true>(F.lds, g, S, E, split_ctx(F, ws, WS_SLAB, 2)); });
    PHASE(8, p6_conv_fixup(F));
    PHASE(9, { pg8::Gemm g{F.ACT, F.WF2, M, DM, FF}; pg8::StaticOrder S; S.init(M, DM, FF, F.G, F.bid, 8);
        pg8::EpiF32 E{F.Fb, DM};
        pg8::gemm_phase<pg8::EpiF32, pg8::StaticOrder, true, true>(F.lds, g, S, E, split_ctx(F, ws, WS_SLAB, 3)); });
    if (IN(10)) { TBEGIN(F, 10); p8_final(F); if (MK_TIME_PHASE == 10) { asm volatile("s_waitcnt vmcnt(0)" ::: "memory"); __syncthreads(); } TEND(F, 10); }
    if (MK_TIME_PHASE >= 0 && F.bid == 0) { const unsigned long long te = __builtin_amdgcn_s_memrealtime(), d = 8ull * F.tacc; while (__builtin_amdgcn_s_memrealtime() - te < d) __builtin_amdgcn_s_sleep(16); }
#undef IN
#undef SEAM
}

extern "C" void kernel_launch(void* const* d_in, const int* in_sizes, int n_in, void* d_out, int out_size, void* d_ws, size_t ws_size, hipStream_t stream) {
    static int grid = 0;
    if (grid == 0) {
        if (n_in != 25 || (size_t)out_size != O_END || ws_size < WS_END) { fprintf(stderr, "kernel_launch: unexpected sizes n_in %d out %d ws %zu (need out %zu ws %zu)\n", n_in, out_size, ws_size, (size_t)O_END, (size_t)WS_END); grid = -1; return; }
        int dev = 0, cus = 0, per_cu = 0;
        hipGetDevice(&dev); hipDeviceGetAttribute(&cus, hipDeviceAttributeMultiprocessorCount, dev);
        if (hipFuncSetAttribute((const void*)fwd_kernel, hipFuncAttributeMaxDynamicSharedMemorySize, LDS_BYTES) != hipSuccess) { fprintf(stderr, "kernel_launch: hipFuncSetAttribute failed\n"); grid = -1; return; }
        hipOccupancyMaxActiveBlocksPerMultiprocessor(&per_cu, (const void*)fwd_kernel, NTHR, LDS_BYTES);
        if (per_cu < 1) { fprintf(stderr, "kernel_launch: occupancy query says %d blocks per CU\n", per_cu); grid = -1; return; }
        grid = cus;
        (void)hipGetLastError();
    }
    if (grid < 0) return;
    Args a{};
    for (int i = 0; i < 25; ++i) a.in[i] = (const float*)d_in[i];
    a.out = (float*)d_out; a.ws = (unsigned char*)d_ws;
#if MK_PER_PHASE
    hipMemsetAsync((char*)d_ws + WS_CTL, 0, CTL_ZERO_BYTES, stream);
    for (int p = 0; p < N_PHASES; ++p) { a.ph_lo = p; a.ph_hi = p + 1; hipLaunchKernelGGL(fwd_kernel, dim3(grid), dim3(NTHR), LDS_BYTES, stream, a); }
#else
    hipMemsetAsync((char*)d_ws + WS_CTL, 0, CTL_ZERO_BYTES, stream);
    a.ph_lo = 0; a.ph_hi = N_PHASES;
    void* kargs[] = {&a};
    hipError_t e = hipLaunchCooperativeKernel((const void*)fwd_kernel, dim3(grid), dim3(NTHR), kargs, LDS_BYTES, stream);
    if (e != hipSuccess) fprintf(stderr, "kernel_launch: cooperative launch failed: %s (grid %d)\n", hipGetErrorString(e), grid);
#endif
}
```

```cpp
#include <hip/hip_runtime.h>
#include <hip/hip_cooperative_groups.h>
#include <cstdio>
#include <cstdint>
namespace cg = cooperative_groups;

#ifndef MK_PER_PHASE
#define MK_PER_PHASE 0
#endif

namespace pg8 {
#define PG8_LAS __attribute__((address_space(3)))
typedef unsigned short bf16_t;
typedef short bf16x8 __attribute__((ext_vector_type(8)));
typedef float f32x4 __attribute__((ext_vector_type(4)));
typedef unsigned u32x4 __attribute__((ext_vector_type(4)));
constexpr int BM = 256, BK = 64, HALF = 128, HTB = HALF * BK * 2  , STAGE_BYTES = 8 * HTB, NXCD = 8, WGM = 8;

__host__ __device__ __forceinline__ int lds_byte(int r, int c) { const int st = (r >> 4) * 2 + (c >> 5), rr = r & 15, cc = c & 31, ob = rr * 64 + cc * 2; return st * 1024 + (ob ^ (((ob >> 9) & 1) << 5)); }
__host__ __device__ __forceinline__ void stage_rc(int b, int& R, int& C) { const int st = b / 1024, sb = b % 1024, swz = sb ^ (((sb >> 9) & 1) << 5); R = (st >> 1) * 16 + swz / 64; C = (st & 1) * 32 + (swz % 64) / 2; }
__host__ __device__ __forceinline__ int perm32(int rho) { const int n = rho >> 4, i = rho & 15; return 8 * (i >> 2) + 4 * n + (i & 3); }

struct Unit { int pm, pn, k0, nk, slice, nsl, tix; };
struct Gemm { const bf16_t* A; const bf16_t* Bt; int M, N, K; };

struct StaticOrder {
    int nM, nN, nwg, G, c, rounds, rem, S, ntK;
    __host__ __device__ __forceinline__ void init(int M, int N, int K, int G_, int c_, int Smax) { nM = M / BM; nN = N / BM; nwg = nM * nN; G = G_; c = c_; ntK = K / BK; rounds = nwg / G; rem = nwg - rounds * G; S = 1;
        if (rem) { while (S < Smax && rem * (S * 2) <= G && (ntK / 2) >= S * 2) S *= 2; } }
    __host__ __device__ __forceinline__ void tile(int L, Unit& u) const {
        int wgid = L; { const int q = nwg / NXCD, r = nwg % NXCD, xcd = wgid % NXCD, off = wgid / NXCD; wgid = (xcd < r ? xcd * (q + 1) : r * (q + 1) + (xcd - r) * q) + off; }
        const int nig = WGM * nN, gid = wgid / nig, fm = gid * WGM, gsz = (nM - fm) < WGM ? (nM - fm) : WGM;
        u.pm = fm + ((wgid % nig) % gsz); u.pn = (wgid % nig) / gsz; }
    __host__ __device__ __forceinline__ bool next(int i, Unit& u) const {
        if (i < rounds) { tile(i * G + c, u); u.k0 = 0; u.nk = ntK; u.slice = 0; u.nsl = 1; u.tix = 0; return true; }
        if (i == rounds && c < rem * S) { const int tix = c % rem, sl = c / rem; tile(rounds * G + tix, u);
            const int pairs = ntK / 2, base = pairs / S, extra = pairs % S, np = base + (sl < extra ? 1 : 0), p0 = sl * base + (sl < extra ? sl : extra);
            u.k0 = 2 * p0; u.nk = 2 * np; u.slice = sl; u.nsl = S; u.tix = tix; return true; }
        return false;
    }
    __device__ __forceinline__ void a_ready(const Unit&) const {}
    __device__ __forceinline__ void done(const Unit&) const {}
};
__device__ __forceinline__ unsigned cvt_pk_bf16(float lo, float hi) { unsigned r; asm volatile("v_cvt_pk_bf16_f32 %0, %1, %2" : "=v"(r) : "v"(lo), "v"(hi)); return r; }
struct SplitCtx { f32x4* slabs; unsigned* cnt; volatile PG8_LAS unsigned* flag; };
__device__ __forceinline__ int split_reduce(f32x4 (&acc)[2][2][4][2], const Unit& u, const SplitCtx& X, int tid) {
    const __amdgpu_buffer_rsrc_t rs = __builtin_amdgcn_make_buffer_rsrc((void*)X.slabs, (short)0, (int)0x7fffffff, 0x00020000);
    typedef unsigned u32x2s __attribute__((ext_vector_type(2)));
    const unsigned mine = (unsigned)((u.tix * u.nsl + u.slice) * 32) * 4096u + (unsigned)tid * 8u;
#pragma unroll
    for (int a = 0; a < 2; ++a)
#pragma unroll
        for (int b = 0; b < 2; ++b)
#pragma unroll
            for (int m = 0; m < 4; ++m)
#pragma unroll
                for (int n = 0; n < 2; ++n) { const f32x4 v = acc[a][b][m][n]; __builtin_amdgcn_raw_buffer_store_b64((u32x2s){cvt_pk_bf16(v.x, v.y), cvt_pk_bf16(v.z, v.w)}, rs, mine + (unsigned)((((a * 2 + b) * 4 + m) * 2 + n) * 4096), 0,   16); }
    asm volatile("s_waitcnt vmcnt(0)" ::: "memory");
    __syncthreads();
    if (tid == 0) {
        unsigned* c = X.cnt + 16 * u.tix;
        (void)__hip_atomic_fetch_add(c, 1u, __ATOMIC_RELAXED, __HIP_MEMORY_SCOPE_AGENT);
        unsigned spins = 0;
        while (__hip_atomic_load(c, __ATOMIC_RELAXED, __HIP_MEMORY_SCOPE_AGENT) < (unsigned)u.nsl) { __builtin_amdgcn_s_sleep(2); if (++spins > (1u << 22)) break; }
        __builtin_amdgcn_fence(__ATOMIC_ACQUIRE, "agent");
        asm volatile("s_waitcnt vmcnt(0)" ::: "memory");
    }
    __syncthreads();
    const int shift = u.nsl == 8 ? 2 : (u.nsl == 4 ? 3 : 4);
    for (int s = 0; s < u.nsl; ++s) { if (s == u.slice) continue;
        const u32x2s* o = (const u32x2s*)X.slabs + ((size_t)(u.tix * u.nsl + s) * 32) * 512 + tid;
#pragma unroll
        for (int a = 0; a < 2; ++a)
#pragma unroll
            for (int b = 0; b < 2; ++b)
#pragma unroll
                for (int m = 0; m < 4; ++m)
#pragma unroll
                    for (int n = 0; n < 2; ++n) { const int r4 = ((a * 2 + b) * 4 + m) * 2 + n; if ((r4 >> shift) == u.slice) { const u32x2s p = o[(size_t)r4 * 512]; acc[a][b][m][n] += (f32x4){__builtin_bit_cast(float, p.x << 16), __builtin_bit_cast(float, p.x & 0xffff0000u), __builtin_bit_cast(float, p.y << 16), __builtin_bit_cast(float, p.y & 0xffff0000u)}; } } }
    return shift;
}


struct EpiF32 {
    static constexpr bool PERM = false, AFTER_DRAIN = false;
    float* C; int ldc;
    __device__ __forceinline__ void operator()(const f32x4 (&acc)[2][2][4][2], const Unit& u, int wr, int wc, int fr, int fq, int shift, int part) const {
        const int row0 = u.pm * BM + wr * 64 + fr, col0 = u.pn * BM + wc * 32 + 4 * fq;
#pragma unroll
        for (int ai = 0; ai < 2; ++ai)
#pragma unroll
            for (int m = 0; m < 4; ++m) { float* rowp = C + (size_t)(row0 + ai * HALF + m * 16) * ldc + col0;
#pragma unroll
                for (int bj = 0; bj < 2; ++bj)
#pragma unroll
                    for (int n = 0; n < 2; ++n) if ((((((ai * 2 + bj) * 4 + m) * 2 + n)) >> shift) == part) *(f32x4*)(rowp + bj * HALF + n * 16) = acc[ai][bj][m][n]; }
    }
};
struct EpiBf16 {
    static constexpr bool PERM = true, AFTER_DRAIN = false;
    bf16_t* O; int ldc; int nfull; float* X;
    __device__ __forceinline__ void operator()(const f32x4 (&acc)[2][2][4][2], const Unit& u, int wr, int wc, int fr, int fq, int shift, int part) const {
        const int row0 = u.pm * BM + wr * 64 + fr;
        if (u.pn < nfull) {
            const int col0 = u.pn * BM + wc * 32 + 8 * fq;
#pragma unroll
            for (int ai = 0; ai < 2; ++ai)
#pragma unroll
                for (int m = 0; m < 4; ++m) { bf16_t* rowp = O + (size_t)(row0 + ai * HALF + m * 16) * ldc + col0;
#pragma unroll
                    for (int bj = 0; bj < 2; ++bj) { if ((((((ai * 2 + bj) * 4 + m) * 2)) >> shift) != part) continue; const f32x4 v0 = acc[ai][bj][m][0], v1 = acc[ai][bj][m][1];
                        u32x4 w; w.x = cvt_pk_bf16(v0[0], v0[1]); w.y = cvt_pk_bf16(v0[2], v0[3]); w.z = cvt_pk_bf16(v1[0], v1[1]); w.w = cvt_pk_bf16(v1[2], v1[3]);
                        *(u32x4*)(rowp + bj * HALF) = w; } }
        } else if (wc == 0) {
#pragma unroll
            for (int ai = 0; ai < 2; ++ai)
#pragma unroll
                for (int m = 0; m < 4; ++m) { if ((((((ai * 2) * 4 + m) * 2)) >> shift) != part) continue; float* rowp = X + (size_t)(row0 + ai * HALF + m * 16) * 32 + 8 * fq;
                    *(f32x4*)(rowp) = acc[ai][0][m][0]; *(f32x4*)(rowp + 4) = acc[ai][0][m][1]; }
        }
    }
};

__device__ __forceinline__ float dpp_ror1(float x) { return __builtin_bit_cast(float, __builtin_amdgcn_update_dpp(0, __builtin_bit_cast(int, x), 0x121, 0xF, 0xF, false)); }
__device__ __forceinline__ float dpp_ror2(float x) { return __builtin_bit_cast(float, __builtin_amdgcn_update_dpp(0, __builtin_bit_cast(int, x), 0x122, 0xF, 0xF, false)); }
struct EpiConvAct {
    static constexpr bool PERM = true, AFTER_DRAIN = false;
    static constexpr int FFD = 5632, FFD2 = 11264, MPR = 8192, NPT = 32;
    bf16_t* ACT; float* HG; const float* cw; const float* cbias; const float* st; float* fconv_s; PG8_LAS float* halo;
    __device__ __forceinline__ void operator()(const f32x4 (&acc)[2][2][4][2], const Unit& u, int wr, int wc, int fr, int fq, int, int) const {
        if (u.pm >= NPT) body<true>(acc, u, wr, wc, fr, fq); else body<false>(acc, u, wr, wc, fr, fq); }
    template <bool sample> __device__ __forceinline__ void body(const f32x4 (&acc)[2][2][4][2], const Unit& u, int wr, int wc, int fr, int fq) const {
        const int pm = u.pm, pn = u.pn, cl = wc * 32 + 8 * fq, c0 = pn * 128 + cl;
        if (fr >= 14) {
#pragma unroll
            for (int ai = 0; ai < 2; ++ai)
#pragma unroll
                for (int bj = 0; bj < 2; ++bj)
#pragma unroll
                    for (int n = 0; n < 2; ++n) *(PG8_LAS f32x4*)(halo + ((ai * 2 + wr) * 2 + (fr - 14)) * 256 + bj * 128 + cl + 4 * n) = acc[ai][bj][3][n];
            if (!sample && wr == 1) {
#pragma unroll
                for (int bj = 0; bj < 2; ++bj)
#pragma unroll
                    for (int n = 0; n < 2; ++n) *(f32x4*)(HG + ((size_t)pm * 4 + 2 + (fr - 14)) * FFD2 + bj * FFD + c0 + 4 * n) = acc[1][bj][3][n]; }
        }
        if (fr < 2 && !sample && wr == 0) {
#pragma unroll
            for (int bj = 0; bj < 2; ++bj)
#pragma unroll
                for (int n = 0; n < 2; ++n) *(f32x4*)(HG + ((size_t)pm * 4 + fr) * FFD2 + bj * FFD + c0 + 4 * n) = acc[0][bj][0][n]; }
        __syncthreads();
        const int t8 = fr & 7;
        typedef unsigned u32x2 __attribute__((ext_vector_type(2)));
        u32x2 pk0[2][4];
#pragma unroll
        for (int n = 0; n < 2; ++n) {
            f32x4 w[2][3], bs[2];
#pragma unroll
            for (int bj = 0; bj < 2; ++bj) { bs[bj] = *(const f32x4*)(cbias + bj * FFD + c0 + 4 * n);
#pragma unroll
                for (int j = 0; j < 3; ++j) w[bj][j] = *(const f32x4*)(cw + j * FFD2 + bj * FFD + c0 + 4 * n); }
#pragma unroll
            for (int ai = 0; ai < 2; ++ai) {
                f32x4 r1p[2], r2p[2];
#pragma unroll
                for (int bj = 0; bj < 2; ++bj) { f32x4 pv = (f32x4){0.f, 0.f, 0.f, 0.f};
                    if (fr >= 14 && (wr == 1 || ai == 1)) { const int pa = (wr == 1) ? ai : 0, pw = (wr == 1) ? 0 : 1; pv = *(const PG8_LAS f32x4*)(halo + ((pa * 2 + pw) * 2 + (fr - 14)) * 256 + bj * 128 + cl + 4 * n); }
#pragma unroll
                    for (int j = 0; j < 4; ++j) { r1p[bj][j] = dpp_ror1(pv[j]); r2p[bj][j] = dpp_ror2(pv[j]); } }
#pragma unroll
                for (int m = 0; m < 4; ++m) { const int row = pm * BM + ai * HALF + wr * 64 + m * 16 + fr;
                    f32x4 o[2];
#pragma unroll
                    for (int bj = 0; bj < 2; ++bj) { const f32x4 cur = acc[ai][bj][m][n]; f32x4 p1, p2;
#pragma unroll
                        for (int j = 0; j < 4; ++j) { const float c1 = dpp_ror1(cur[j]), c2 = dpp_ror2(cur[j]); p1[j] = (fr == 0) ? r1p[bj][j] : c1; p2[j] = (fr < 2) ? r2p[bj][j] : c2; r1p[bj][j] = c1; r2p[bj][j] = c2; }
                        if (sample && t8 < 2) { const int sb = (row - MPR) >> 3; const f32x4 s1 = *(const f32x4*)(st + ((size_t)sb * 2 + 1) * FFD2 + bj * FFD + c0 + 4 * n);
                            if (t8 == 0) { p1 = s1; p2 = *(const f32x4*)(st + ((size_t)sb * 2) * FFD2 + bj * FFD + c0 + 4 * n); } else p2 = s1; }
                        o[bj] = bs[bj] + w[bj][0] * p2 + w[bj][1] * p1 + w[bj][2] * cur; }
                    f32x4 g; g.x = o[0].x * __builtin_amdgcn_rcpf(1.f + __expf(-o[0].x)) * o[1].x; g.y = o[0].y * __builtin_amdgcn_rcpf(1.f + __expf(-o[0].y)) * o[1].y;
                    g.z = o[0].z * __builtin_amdgcn_rcpf(1.f + __expf(-o[0].z)) * o[1].z; g.w = o[0].w * __builtin_amdgcn_rcpf(1.f + __expf(-o[0].w)) * o[1].w;
                    const u32x2 pk = (u32x2){cvt_pk_bf16(g.x, g.y), cvt_pk_bf16(g.z, g.w)};
                    if (n == 0) pk0[ai][m] = pk;
                    else *(u32x4*)(ACT + (size_t)row * FFD + c0) = (u32x4){pk0[ai][m].x, pk0[ai][m].y, pk.x, pk.y};
                    if (sample && t8 >= 6) { const int sb = (row - MPR) >> 3;
#pragma unroll
                        for (int bj = 0; bj < 2; ++bj) *(f32x4*)(fconv_s + ((size_t)sb * 2 + (t8 - 6)) * FFD2 + bj * FFD + c0 + 4 * n) = acc[ai][bj][m][n]; }
                }
            }
        }
    }
};

template <class Epi, class Sched, bool ALIGN_EPI = false, bool SP2 = false>
__device__ __forceinline__ void gemm_phase(PG8_LAS unsigned char* lds, const Gemm g, const Sched& S, const Epi& E, const SplitCtx& X) {
    const int tid = threadIdx.x, wid = __builtin_amdgcn_readfirstlane(tid >> 6), lane = tid & 63, wr = wid >> 2, wc = wid & 3, fr = lane & 15, fq = lane >> 4;
    const int K = g.K;
    unsigned voffA[2], voffB[2];
#pragma unroll
    for (int i = 0; i < 2; ++i) { int R, C; stage_rc(tid * 16 + i * 8192, R, C); const int Rb = Epi::PERM ? ((R & ~31) + perm32(R & 31)) : R;
        voffA[i] = (unsigned)(R * K + C) * 2u; voffB[i] = (unsigned)(Rb * K + C) * 2u; }
    const size_t kstep = (size_t)(BK * 2);
    const size_t hstep = (size_t)HALF * K * 2;
    const size_t tstep = 2 * hstep;
    const unsigned ldsw = (unsigned)wid * 1024u;
    const int aoff = lds_byte(wr * 64 + fr, fq * 8), boff = lds_byte(wc * 32 + fr, fq * 8);
#define PG8_SA(b, h) (((b) * 2 + (h)) * HTB)
#define PG8_SB(b, h) ((4 + (b) * 2 + (h)) * HTB)
#define PG8_STAGE(bufoff, gbase, voff) do { _Pragma("unroll") for (int _i = 0; _i < 2; ++_i) \
        __builtin_amdgcn_global_load_lds((const unsigned*)((const char*)(gbase) + (voff)[_i]), (PG8_LAS unsigned*)(lds + (bufoff) + ldsw + _i * 8192), 16, 0, 0); } while (0)
#define PG8_LDA(dst, b, h) do { _Pragma("unroll") for (int m = 0; m < 4; ++m) _Pragma("unroll") for (int k = 0; k < 2; ++k) dst[m][k] = *(const PG8_LAS bf16x8*)(lds + PG8_SA(b, h) + aoff + m * 2048 + k * 1024); } while (0)
#define PG8_LDB(dst, b, h) do { _Pragma("unroll") for (int n = 0; n < 2; ++n) _Pragma("unroll") for (int k = 0; k < 2; ++k) dst[n][k] = *(const PG8_LAS bf16x8*)(lds + PG8_SB(b, h) + boff + n * 2048 + k * 1024); } while (0)
#define PG8_MMA(ai, bj, At, Bt) do { __builtin_amdgcn_s_setprio(1); _Pragma("unroll") for (int m = 0; m < 4; ++m) _Pragma("unroll") for (int n = 0; n < 2; ++n) _Pragma("unroll") for (int k = 0; k < 2; ++k) \
        acc[ai][bj][m][n] = __builtin_amdgcn_mfma_f32_16x16x32_bf16(Bt[n][k], At[m][k], acc[ai][bj][m][n], 0, 0, 0); __builtin_amdgcn_s_setprio(0); } while (0)
#define PG8_WAIT_V(n) asm volatile("s_waitcnt vmcnt(" #n ")" ::: "memory")
#define PG8_WAIT_L(n) asm volatile("s_waitcnt lgkmcnt(" #n ")" ::: "memory")
#define PG8_BAR __builtin_amdgcn_s_barrier()
#define PG8_SCHED __builtin_amdgcn_sched_barrier(0)
    Unit cur, nxt; int ui = 0;
    if (!S.next(0, cur)) return;
    f32x4 acc[2][2][4][2];
#pragma unroll
    for (int a = 0; a < 2; ++a)
#pragma unroll
        for (int b = 0; b < 2; ++b)
#pragma unroll
            for (int m = 0; m < 4; ++m)
#pragma unroll
                for (int n = 0; n < 2; ++n) acc[a][b][m][n] = (f32x4){0.f, 0.f, 0.f, 0.f};
    bf16x8 At[4][2], B0[2][2], B1[2][2];
    const char* cA = (const char*)g.A + (size_t)cur.pm * tstep + (size_t)cur.k0 * kstep; const char* cB = (const char*)g.Bt + (size_t)cur.pn * tstep + (size_t)cur.k0 * kstep;
    S.a_ready(cur);
    if constexpr (SP2) {
        PG8_STAGE(PG8_SB(0, 0), cB, voffB); PG8_STAGE(PG8_SB(0, 1), cB + hstep, voffB); PG8_STAGE(PG8_SA(0, 0), cA, voffA); PG8_STAGE(PG8_SA(0, 1), cA + hstep, voffA);
        if (wr == 1) PG8_BAR;
        PG8_WAIT_V(2); PG8_BAR;
        PG8_STAGE(PG8_SB(1, 0), cB + kstep, voffB); PG8_STAGE(PG8_SA(1, 0), cA + kstep, voffA); PG8_STAGE(PG8_SB(1, 1), cB + hstep + kstep, voffB);
        PG8_WAIT_V(6); PG8_BAR;
    } else {
        PG8_STAGE(PG8_SB(0, 0), cB, voffB); PG8_STAGE(PG8_SA(0, 0), cA, voffA); PG8_STAGE(PG8_SB(0, 1), cB + hstep, voffB); PG8_STAGE(PG8_SA(0, 1), cA + hstep, voffA);
        if (wr == 1) PG8_BAR;
        PG8_WAIT_V(4); PG8_BAR;
        PG8_STAGE(PG8_SB(1, 0), cB + kstep, voffB); PG8_STAGE(PG8_SA(1, 0), cA + kstep, voffA); PG8_STAGE(PG8_SB(1, 1), cB + hstep + kstep, voffB);
        PG8_WAIT_V(6); PG8_BAR;
    }
    for (;;) {
        const bool has_next = S.next(ui + 1, nxt);
        const char* nA = has_next ? (const char*)g.A + (size_t)nxt.pm * tstep + (size_t)nxt.k0 * kstep : cA; const char* nB = has_next ? (const char*)g.Bt + (size_t)nxt.pn * tstep + (size_t)nxt.k0 * kstep : cB;
        const int nt = cur.nk;
        for (int t = 0; t < nt; t += 2) {
            const bool last = (t == nt - 2);
            const char* a1 = cA + (size_t)(t + 1) * kstep;
            const char* a2 = last ? nA : cA + (size_t)(t + 2) * kstep; const char* b2 = last ? nB : cB + (size_t)(t + 2) * kstep;
            const char* a3 = a2 + kstep; const char* b3 = b2 + kstep;
            if (last && has_next) S.a_ready(nxt);
            if constexpr (SP2) {
            PG8_LDB(B0, 0, 0); PG8_LDB(B1, 0, 1); PG8_SCHED; PG8_LDA(At, 0, 0); PG8_STAGE(PG8_SA(1, 1), a1 + hstep, voffA);
            PG8_WAIT_V(8); PG8_WAIT_L(0); PG8_BAR; PG8_MMA(0, 0, At, B0); PG8_MMA(0, 1, At, B1); PG8_BAR; PG8_SCHED;
            PG8_LDA(At, 0, 1); PG8_STAGE(PG8_SB(0, 0), b2, voffB); PG8_STAGE(PG8_SB(0, 1), b2 + hstep, voffB); PG8_STAGE(PG8_SA(0, 0), a2, voffA);
            PG8_WAIT_V(8); PG8_WAIT_L(0); PG8_BAR; PG8_MMA(1, 0, At, B0); PG8_MMA(1, 1, At, B1); PG8_BAR; PG8_SCHED;
            PG8_LDB(B0, 1, 0); PG8_LDB(B1, 1, 1); PG8_SCHED; PG8_LDA(At, 1, 0); PG8_STAGE(PG8_SA(0, 1), a2 + hstep, voffA);
            PG8_WAIT_V(8); PG8_WAIT_L(0); PG8_BAR; PG8_MMA(0, 0, At, B0); PG8_MMA(0, 1, At, B1); PG8_BAR; PG8_SCHED;
            PG8_LDA(At, 1, 1); PG8_STAGE(PG8_SB(1, 0), b3, voffB); PG8_STAGE(PG8_SB(1, 1), b3 + hstep, voffB); PG8_STAGE(PG8_SA(1, 0), a3, voffA);
            PG8_WAIT_V(8); PG8_WAIT_L(0); PG8_BAR; PG8_MMA(1, 0, At, B0); PG8_MMA(1, 1, At, B1); PG8_BAR; PG8_SCHED;
            } else {
            PG8_LDB(B0, 0, 0); PG8_SCHED; PG8_LDA(At, 0, 0); PG8_STAGE(PG8_SA(1, 1), a1 + hstep, voffA);
            PG8_WAIT_L(8); PG8_BAR; PG8_WAIT_L(0); PG8_MMA(0, 0, At, B0); PG8_BAR; PG8_SCHED;
            PG8_LDB(B1, 0, 1); PG8_STAGE(PG8_SB(0, 0), b2, voffB);
            PG8_BAR; PG8_WAIT_L(0); PG8_MMA(0, 1, At, B1); PG8_BAR;
            PG8_LDA(At, 0, 1); PG8_STAGE(PG8_SA(0, 0), a2, voffA);
            PG8_BAR; PG8_WAIT_L(0); PG8_MMA(1, 0, At, B0); PG8_BAR; PG8_SCHED;
            PG8_STAGE(PG8_SB(0, 1), b2 + hstep, voffB);
            PG8_WAIT_V(6); PG8_BAR; PG8_MMA(1, 1, At, B1); PG8_BAR;
            PG8_LDB(B0, 1, 0); PG8_SCHED; PG8_LDA(At, 1, 0); PG8_STAGE(PG8_SA(0, 1), a2 + hstep, voffA);
            PG8_WAIT_L(8); PG8_BAR; PG8_WAIT_L(0); PG8_MMA(0, 0, At, B0); PG8_BAR; PG8_SCHED;
            PG8_LDB(B1, 1, 1); PG8_STAGE(PG8_SB(1, 0), b3, voffB);
            PG8_BAR; PG8_WAIT_L(0); PG8_MMA(0, 1, At, B1); PG8_BAR;
            PG8_LDA(At, 1, 1); PG8_STAGE(PG8_SA(1, 0), a3, voffA);
            PG8_BAR; PG8_WAIT_L(0); PG8_MMA(1, 0, At, B0); PG8_BAR; PG8_SCHED;
            PG8_STAGE(PG8_SB(1, 1), b3 + hstep, voffB);
            PG8_WAIT_V(6); PG8_BAR; PG8_MMA(1, 1, At, B1); PG8_BAR;
            }
        }
        if constexpr (ALIGN_EPI) { if (wr == 0) PG8_BAR; }
        if constexpr (!Epi::AFTER_DRAIN) { static_assert(ALIGN_EPI, "split_reduce needs the halves aligned"); if (cur.nsl > 1) { const int shift = split_reduce(acc, cur, X, tid); E(acc, cur, wr, wc, fr, fq, shift, cur.slice); } else E(acc, cur, wr, wc, fr, fq, 5, 0); S.done(cur); }
        if (!has_next) break;
#pragma unroll
        for (int a = 0; a < 2; ++a)
#pragma unroll
            for (int b = 0; b < 2; ++b)
#pragma unroll
                for (int m = 0; m < 4; ++m)
#pragma unroll
                    for (int n = 0; n < 2; ++n) acc[a][b][m][n] = (f32x4){0.f, 0.f, 0.f, 0.f};
        cur = nxt; cA = nA; cB = nB; ++ui;
        if constexpr (ALIGN_EPI) { if (wr == 1) PG8_BAR; }
    }
    PG8_WAIT_V(0);
    if constexpr (!ALIGN_EPI) { if (wr == 0) PG8_BAR; }
    PG8_BAR;
    if constexpr (Epi::AFTER_DRAIN) { E.fused(acc, cur, wr, wc, fr, fq, lds, wid, lane); S.done(cur); }
#undef PG8_SA
#undef PG8_SB
#undef PG8_STAGE
#undef PG8_LDA
#undef PG8_LDB
#undef PG8_MMA
#undef PG8_WAIT_V
#undef PG8_WAIT_L
#undef PG8_BAR
#undef PG8_SCHED
}
}

constexpr int NWAVES = 8, NTHR = 512;
constexpr int DM = 2048, PB = 4, PL = 2048, SB = 128, SL = 8;
constexpr int MP = PB * PL, MS = SB * SL, M = MP + MS;
constexpr int GH = 4, GK = 128, GV = 256, GKD = 512, LOWR = 16;
constexpr int SH = 16, SP = 64, SN = 128, SG = 2, SCH = 1536;
constexpr int FF = 5632, FF2 = 11264, INC = 5664;
constexpr int N1 = 5888, NP = 5632;
constexpr int CQ = 0, CK = 512, CV = 1024, CG = 2048, CZ = 3072, CX = 4096;
constexpr float EPS = 1e-6f;
constexpr int N_PHASES = 11;

constexpr size_t O_Y = 0, O_GLA_P = (size_t)M * DM, O_SSD_P = O_GLA_P + (size_t)PB * GH * GK * GV, O_SCONV_P = O_SSD_P + (size_t)PB * SH * SP * SN,
                 O_FCONV_P = O_SCONV_P + (size_t)PB * 3 * SCH, O_GLA_S = O_FCONV_P + (size_t)PB * 2 * FF2, O_SSD_S = O_GLA_S + (size_t)SB * GH * GK * GV,
                 O_SCONV_S = O_SSD_S + (size_t)SB * SH * SP * SN, O_FCONV_S = O_SCONV_S + (size_t)SB * 3 * SCH, O_END = O_FCONV_S + (size_t)SB * 2 * FF2;

constexpr size_t MiB = 1u << 20;
constexpr size_t WS_CTL = 0, CTL_ZERO_BYTES = 64 * 1024;
constexpr size_t WS_WF2 = 1 * MiB;
constexpr size_t WS_W1 = 24 * MiB;
constexpr size_t WS_WO = 48 * MiB;
constexpr size_t WS_WF1 = 56 * MiB;
constexpr size_t WS_XN = 101 * MiB;
constexpr size_t WS_F = 24 * MiB;
constexpr size_t WS_BIG = 141 * MiB;
constexpr size_t WS_PROJ = WS_BIG;
constexpr size_t WS_MIX = WS_BIG;
constexpr size_t WS_ACT = WS_BIG;
constexpr size_t WS_HG = WS_BIG + 104 * MiB;
constexpr size_t WS_LRDT = WS_BIG + 100 * MiB;
constexpr size_t WS_MIXIN = WS_BIG + 104 * MiB;
constexpr size_t WS_DS = WS_XN;
constexpr size_t WS_SC = WS_BIG + 140 * MiB, WS_DH = WS_BIG + 172 * MiB, WS_HC = WS_BIG + 204 * MiB;
constexpr size_t WS_EBL = WS_BIG + 236 * MiB, WS_AL = WS_EBL + 512 * 1024;
constexpr size_t WS_SLAB = WS_BIG + 140 * MiB;
constexpr size_t WS_SLAB_F1 = WS_BIG + 198 * MiB;
constexpr size_t WS_QEG = WS_BIG + 238 * MiB, WS_KEG = WS_BIG + 246 * MiB;
constexpr size_t WS_END = WS_BIG + 254 * MiB;
static_assert(WS_WF2 + (size_t)DM * FF * 2 <= WS_W1 && WS_W1 + (size_t)N1 * DM * 2 <= WS_WO && WS_WO + (size_t)DM * DM * 2 <= WS_WF1 && WS_WF1 + (size_t)FF2 * DM * 2 <= WS_XN && WS_XN + (size_t)M * DM * 2 <= WS_BIG, "ws map 1");
static_assert(WS_F + (size_t)M * DM * 4 <= WS_XN && WS_ACT + (size_t)M * FF * 2 <= WS_HG && WS_PROJ + (size_t)M * NP * 2 <= WS_LRDT && WS_LRDT + (size_t)M * 32 * 4 <= WS_MIXIN && WS_MIXIN + (size_t)M * DM * 2 <= WS_SC && WS_HG + (size_t)32 * 4 * FF2 * 4 <= WS_SC && WS_MIX + (size_t)M * DM * 4 <= WS_LRDT, "ws map 2");
constexpr int CW_BAR = 1024;
constexpr int CW_SPLIT = 8192;

constexpr int RING_BYTES = 131072;
constexpr int SCRATCH_BYTES = 8 * 16640;
constexpr int LDSCTL_OFF = 133632, MISC_OFF = LDSCTL_OFF + 320;
constexpr int LDS_BYTES = 150016;

#ifndef MK_TIME_PHASE
#define MK_TIME_PHASE (-1)
#endif
#define TBEGIN(F, id) do { if (MK_TIME_PHASE == (id)) (F).tmark = __builtin_amdgcn_s_memrealtime(); } while (0)
#define TEND(F, id) do { if (MK_TIME_PHASE == (id)) (F).tacc += __builtin_amdgcn_s_memrealtime() - (F).tmark; } while (0)
#define GAS __attribute__((address_space(1)))
#define LAS __attribute__((address_space(3)))
typedef unsigned short bf16;
typedef unsigned v4u __attribute__((ext_vector_type(4)));
typedef unsigned v2u __attribute__((ext_vector_type(2)));
typedef float f32x4 __attribute__((ext_vector_type(4)));
#define LDS_WAIT() asm volatile("s_waitcnt lgkmcnt(0)" ::: "memory")
#define VM_WAIT() asm volatile("s_waitcnt vmcnt(0)" ::: "memory")
typedef float f32x2c __attribute__((ext_vector_type(2)));
typedef __bf16 bf16x2c __attribute__((ext_vector_type(2)));
__device__ __forceinline__ unsigned f2bf(float f) { return (unsigned)__builtin_bit_cast(unsigned short, (__bf16)f); }
__device__ __forceinline__ unsigned pk2(float lo, float hi) { return __builtin_bit_cast(unsigned, __builtin_convertvector((f32x2c){lo, hi}, bf16x2c)); }
__device__ __forceinline__ float bf2f(unsigned short b) { return __builtin_bit_cast(float, (unsigned)b << 16); }
__device__ __forceinline__ float bflo(unsigned w) { return __builtin_bit_cast(float, w << 16); }
__device__ __forceinline__ float bfhi(unsigned w) { return __builtin_bit_cast(float, w & 0xffff0000u); }
__device__ __forceinline__ float silu_f(float x) { return x * __builtin_amdgcn_rcpf(1.f + __expf(-x)); }
__device__ __forceinline__ float softplus_f(float x) { return fmaxf(x, 0.f) + __logf(1.f + __expf(-fabsf(x))); }
__device__ __forceinline__ float logsigmoid_f(float x) { return fminf(x, 0.f) - __logf(1.f + __expf(-fabsf(x))); }
__device__ __forceinline__ float wave_sum(float v) {
#pragma unroll
    for (int o = 1; o < 64; o <<= 1) v += __shfl_xor(v, o);
    return v;
}

#define XB_TMO      128
#define XB_XCNT(j)  (256  + 64 * (j))
#define XB_XSUB(j)  (1280 + 64 * (j))
#define XB_XGEN(j)  (2304 + 64 * (j))
#define XB_TOP      3328
#define XB_TOPGEN   3392
#define XCD_BAR_WORDS 3456
#define XB_SPIN_CAP (1u << 18)

__device__ __forceinline__ unsigned xb_ld(unsigned* p)              { return __hip_atomic_load(p, __ATOMIC_RELAXED, __HIP_MEMORY_SCOPE_AGENT); }
__device__ __forceinline__ unsigned xb_add(unsigned* p, unsigned v) { return __hip_atomic_fetch_add(p, v, __ATOMIC_RELAXED, __HIP_MEMORY_SCOPE_AGENT); }
__device__ __forceinline__ unsigned xb_xcc_id() { return (unsigned)__builtin_amdgcn_s_getreg((3 << 11) | 20) & 0xFu; }
#define XB_SPIN(cond, bar) do { unsigned _sp = 0; while (cond) { __builtin_amdgcn_s_sleep(1); \
    if ((++_sp & 255u) == 0u) { if (xb_ld(&(bar)[XB_TMO])) break; if (_sp > XB_SPIN_CAP) { atomicAdd(&(bar)[XB_TMO], 1u); break; } } } } while (0)

struct XcdBarrier {
    unsigned* bar; unsigned x;
    volatile LAS unsigned* st;
};

__device__ __forceinline__ XcdBarrier xcd_barrier_post(unsigned* bar, volatile LAS unsigned* st) {
    XcdBarrier b; b.bar = bar; b.x = xb_xcc_id(); b.st = st;
    if (threadIdx.x == 0) (void)xb_add(&bar[XB_XCNT(b.x)], 1u);
    return b;
}
__device__ __forceinline__ void xcd_barrier_complete(unsigned* bar, unsigned x, unsigned& nloc, unsigned& nx) {
    const unsigned G = gridDim.x * gridDim.y * gridDim.z;
    unsigned sum, cnt, mine, sp = 0u;
    for (;;) {
        sum = 0u; cnt = 0u; mine = 0u;
#pragma unroll
        for (unsigned j = 0; j < 16; ++j) { const unsigned c = xb_ld(&bar[XB_XCNT(j)]); sum += c; cnt += (c > 0u) ? 1u : 0u; mine = (j == x) ? c : mine; }
        if (sum == G) break;
        __builtin_amdgcn_s_sleep(1);
        if ((++sp & 255u) == 0u) { if (xb_ld(&bar[XB_TMO])) break; if (sp > XB_SPIN_CAP) { atomicAdd(&bar[XB_TMO], 1u); break; } }
    }
    nloc = mine > 0u ? mine : 1u; nx = cnt > 0u ? cnt : 1u;
}

__device__ __forceinline__ void xcd_barrier(const XcdBarrier& b) {
    asm volatile("s_waitcnt vmcnt(0)" ::: "memory");
    __syncthreads();
    if (threadIdx.x == 0) {
        unsigned* bar = b.bar;
        __builtin_amdgcn_s_waitcnt(0);
        unsigned nloc = b.st[0], nx = b.st[1];
        if (nloc == 0u) { xcd_barrier_complete(bar, b.x, nloc, nx); b.st[0] = nloc; b.st[1] = nx; }
        const unsigned old = xb_add(&bar[XB_XSUB(b.x)], 1u);
        const unsigned gen = old / nloc;
        if (old + 1u == (gen + 1u) * nloc) {
            __builtin_amdgcn_fence(__ATOMIC_RELEASE, "agent");
            asm volatile("s_waitcnt vmcnt(0)" ::: "memory");
            const unsigned og = xb_add(&bar[XB_TOP], 1u);
            const unsigned tg = og / nx;
            if (og + 1u == (tg + 1u) * nx) xb_add(&bar[XB_TOPGEN], 1u);
            else XB_SPIN(xb_ld(&bar[XB_TOPGEN]) == tg, bar);
            __builtin_amdgcn_fence(__ATOMIC_ACQUIRE, "agent");
            xb_add(&bar[XB_XGEN(b.x)], 1u);
            asm volatile("s_waitcnt vmcnt(0)" ::: "memory");
        } else {
            XB_SPIN(xb_ld(&bar[XB_XGEN(b.x)]) == gen, bar);
            __builtin_amdgcn_fence(__ATOMIC_ACQUIRE, "agent");
            asm volatile("s_waitcnt vmcnt(0)" ::: "memory");
        }
    }
    __syncthreads();
}

struct Frame {
    LAS unsigned char* lds;
    int tid, lane, wave, G, bid;
    unsigned long long tacc, tmark;
    const float *x_p, *x_s, *st_gla, *st_ssd, *st_sconv, *st_fconv, *n_mix_pre, *n_mix_post, *n_ffn_pre, *n_ffn_post, *w_in, *w_gate2, *b_gate, *gla_norm,
                *sconv_w, *sconv_b, *dt_bias, *A_log, *ssd_D, *ssd_norm, *w_out, *ffn_w_in, *fconv_w, *fconv_b, *ffn_w_out;
    float* out;
    bf16 *W1, *WO, *WF1, *WF2, *XN, *PROJ, *MIXIN, *ACT, *DS, *SC, *DH, *HC, *QEg, *KEg;
    float *LRDT, *MIX, *Fb, *EBL, *AL, *HG;
};
__device__ __forceinline__ const float* x_row(const Frame& F, int row) { return row < MP ? F.x_p + (size_t)row * DM : F.x_s + (size_t)(row - MP) * DM; }

__device__ __forceinline__ int w1_src_col(int n) { return n < 3072 ? n : (n < 5632 ? n + 16 : (n < 5648 ? n - 2560 : (n < 5664 ? n : -1))); }
struct TDesc { const float* W; bf16* WT; int K, Nsrc, Ndst, map, item; };
__device__ __forceinline__ void t_load(const TDesc& d, int lane, f32x4 (&v)[16]) {
    const int nblk = d.Ndst / 64, kb = d.item / nblk, nb = d.item % nblk, k0 = 64 * kb, n0 = 64 * nb;
    int sc = n0 + 4 * (lane & 15); if (d.map == 1) sc = w1_src_col(sc); if (d.map == 2) sc = ((sc >> 7) & 1) * FF + 128 * (sc >> 8) + (sc & 127);
#pragma unroll
    for (int i = 0; i < 16; ++i) { const int kk = 4 * i + (lane >> 4); v[i] = (sc >= 0) ? *(const f32x4*)(d.W + (size_t)(k0 + kk) * d.Nsrc + sc) : (f32x4){0.f, 0.f, 0.f, 0.f}; }
}
__device__ __forceinline__ void t_store(const TDesc& d, int lane, LAS float* scr, const f32x4 (&v)[16]) {
    const int nblk = d.Ndst / 64, kb = d.item / nblk, nb = d.item % nblk, k0 = 64 * kb, n0 = 64 * nb;
#pragma unroll
    for (int i = 0; i < 16; ++i) { const int kk = 4 * i + (lane >> 4); LAS float* p = scr + kk * 65 + 4 * (lane & 15); p[0] = v[i].x; p[1] = v[i].y; p[2] = v[i].z; p[3] = v[i].w; }
    LDS_WAIT(); asm volatile("" ::: "memory");
    const int c = lane & 7;
#pragma unroll
    for (int j = 0; j < 8; ++j) { const int n = (lane >> 3) + 8 * j; const LAS float* s = scr + (8 * c) * 65 + n;
        v4u o; o.x = pk2(s[0 * 65], s[1 * 65]); o.y = pk2(s[2 * 65], s[3 * 65]); o.z = pk2(s[4 * 65], s[5 * 65]); o.w = pk2(s[6 * 65], s[7 * 65]);
        *(v4u*)(d.WT + (size_t)(n0 + n) * d.K + k0 + 8 * c) = o; }
    LDS_WAIT(); asm volatile("" ::: "memory");
}
__device__ __forceinline__ bool t_desc(const Frame& F, int which, int it, TDesc& d) {
    constexpr int I_1 = (DM / 64) * (N1 / 64), I_O = (DM / 64) * (DM / 64), I_F1 = (DM / 64) * (FF2 / 64), I_F2 = (FF / 64) * (DM / 64);
    if (which == 0) { if (it >= I_1) return false; d = TDesc{F.w_in, F.W1, DM, INC, N1, 1, it}; return true; }
    if (it >= I_O + I_F1 + I_F2) return false;
    if (it < I_O) d = TDesc{F.w_out, F.WO, DM, DM, DM, 0, it};
    else if (it < I_O + I_F1) d = TDesc{F.ffn_w_in, F.WF1, DM, FF2, FF2, 2, it - I_O};
    else d = TDesc{F.ffn_w_out, F.WF2, FF, DM, DM, 0, it - I_O - I_F1};
    return true;
}
__device__ __forceinline__ void t_run(const Frame& F, int which, int gw, int NGW) {
    LAS float* scr = (LAS float*)(F.lds + F.wave * 16640);
    TDesc da, db; f32x4 va[16], vb[16]; int it = gw;
    if (!t_desc(F, which, it, da)) return;
    t_load(da, F.lane, va);
    for (;;) {
        const bool hb = t_desc(F, which, it + NGW, db); if (hb) t_load(db, F.lane, vb);
        t_store(da, F.lane, scr, va); if (!hb) break; it += NGW;
        const bool ha = t_desc(F, which, it + NGW, da); if (ha) t_load(da, F.lane, va);
        t_store(db, F.lane, scr, vb); if (!ha) break; it += NGW;
    }
}
__device__ __forceinline__ void rms_rows2_to_bf16(const float* x0, const float* x1, const float* w, bf16* o0, bf16* o1, int lane) {
    const f32x4* xa = (const f32x4*)x0 + lane; const f32x4* xb = (const f32x4*)x1 + lane; const f32x4* wr = (const f32x4*)w + lane;
    f32x4 va[8], vb[8]; float sa = 0.f, sb = 0.f;
#pragma unroll
    for (int j = 0; j < 8; ++j) va[j] = xa[64 * j];
#pragma unroll
    for (int j = 0; j < 8; ++j) vb[j] = xb[64 * j];
#pragma unroll
    for (int j = 0; j < 8; ++j) { sa += (va[j].x * va[j].x + va[j].y * va[j].y) + (va[j].z * va[j].z + va[j].w * va[j].w); sb += (vb[j].x * vb[j].x + vb[j].y * vb[j].y) + (vb[j].z * vb[j].z + vb[j].w * vb[j].w); }
    const float ra = rsqrtf(wave_sum(sa) * (1.f / DM) + EPS), rb = rsqrtf(wave_sum(sb) * (1.f / DM) + EPS);
    v2u* pa = (v2u*)o0 + lane; v2u* pb = (v2u*)o1 + lane;
#pragma unroll
    for (int j = 0; j < 8; ++j) { const f32x4 ww = wr[64 * j]; v2u o; o.x = pk2(va[j].x * ra * ww.x, va[j].y * ra * ww.y); o.y = pk2(va[j].z * ra * ww.z, va[j].w * ra * ww.w); pa[64 * j] = o;
        o.x = pk2(vb[j].x * rb * ww.x, vb[j].y * rb * ww.y); o.y = pk2(vb[j].z * rb * ww.z, vb[j].w * rb * ww.w); pb[64 * j] = o; }
}
__device__ __forceinline__ void p0_prologue(Frame& F) {
    const int gw = F.bid * NWAVES + F.wave, NGW = F.G * NWAVES;
    t_run(F, 0, gw, NGW);
    for (int m = gw; m < M; m += 2 * NGW) { const int m1 = (m + NGW < M) ? m + NGW : m; rms_rows2_to_bf16(x_row(F, m), x_row(F, m1), F.n_mix_pre, F.XN + (size_t)m * DM, F.XN + (size_t)m1 * DM, F.lane); }
}
__device__ __forceinline__ void p0_convert_rest(Frame& F, int vb, int nb) { t_run(F, 1, vb * NWAVES + F.wave, nb * NWAVES); }

template <int grp> __device__ __forceinline__ void gla_direct_unit(Frame& F, int b, int h) {
    const int tid = F.tid, v = tid & 255, kh = tid >> 8;
    const int L = grp ? SL : PL, row0 = grp ? MP + b * SL : b * PL;
    LAS float* Es = (LAS float*)F.lds; LAS float* Ks = Es + 1024; LAS float* Qs = Ks + 1024; LAS float* Os = Qs + 1024;
    float S[64];
    if (grp) { const float* s0 = F.st_gla + ((size_t)(b * GH + h) * GK + kh * 64) * GV + v;
#pragma unroll
        for (int i = 0; i < 64; ++i) S[i] = s0[(size_t)i * GV]; }
    else {
#pragma unroll
        for (int i = 0; i < 64; ++i) S[i] = 0.f; }
    for (int t0 = 0; t0 < L; t0 += 8) {
        for (int it = tid; it < 1024; it += NTHR) { const int t = it >> 7, k = it & 127, row = row0 + t0 + t, hk = h * GK + k;
            float x = F.b_gate[hk]; const float* lr = F.LRDT + (size_t)row * 32;
#pragma unroll
            for (int j = 0; j < LOWR; ++j) x += lr[j] * F.w_gate2[j * GKD + hk];
            const float lg = logsigmoid_f(x) * (1.f / 16.f);
            Es[it] = __expf(lg); Ks[it] = bf2f(F.PROJ[(size_t)row * NP + CK + hk]); Qs[it] = bf2f(F.PROJ[(size_t)row * NP + CQ + hk]) * 0.08838834764831845f; }
        __syncthreads();
#pragma unroll 1
        for (int t = 0; t < 8; ++t) { const float vv = bf2f(F.PROJ[(size_t)(row0 + t0 + t) * NP + CV + h * GV + v]); float acc = 0.f;
            const LAS float* e = Es + t * 128 + kh * 64; const LAS float* kk = Ks + t * 128 + kh * 64; const LAS float* qq = Qs + t * 128 + kh * 64;
#pragma unroll
            for (int i = 0; i < 64; ++i) { S[i] = e[i] * S[i] + kk[i] * vv; acc += qq[i] * S[i]; }
            Os[(kh * 8 + t) * 256 + v] = acc; }
        __syncthreads();
        { const int t = F.wave, v4 = F.lane * 4, row = row0 + t0 + t;
            const f32x4 a = *(const LAS f32x4*)(Os + t * 256 + v4), c = *(const LAS f32x4*)(Os + (8 + t) * 256 + v4); const f32x4 o = a + c;
            const float ss = wave_sum((o.x * o.x + o.y * o.y) + (o.z * o.z + o.w * o.w)); const float r = rsqrtf(ss * (1.f / GV) + EPS);
            const v2u gw = *(const v2u*)(F.PROJ + (size_t)row * NP + CG + h * GV + v4); const f32x4 nw = *(const f32x4*)(F.gla_norm + v4);
            v2u w; w.x = pk2(o.x * r * nw.x * silu_f(bflo(gw.x)), o.y * r * nw.y * silu_f(bfhi(gw.x))); w.y = pk2(o.z * r * nw.z * silu_f(bflo(gw.y)), o.w * r * nw.w * silu_f(bfhi(gw.y)));
            *(v2u*)(F.MIXIN + (size_t)row * DM + h * GV + v4) = w; }
        __syncthreads();
    }
    float* so = F.out + (grp ? O_GLA_S : O_GLA_P) + ((size_t)(b * GH + h) * GK + kh * 64) * GV + v;
#pragma unroll
    for (int i = 0; i < 64; ++i) so[(size_t)i * GV] = S[i];
}
__device__ __forceinline__ float xbc_raw(const Frame& F, int grp, int b, int row0, int tt, int c) {
    if (tt >= 0) return bf2f(F.PROJ[(size_t)(row0 + tt) * NP + CX + c]);
    return grp ? F.st_sconv[((size_t)b * 3 + (tt + 3)) * SCH + c] : 0.f;
}
template <int grp> __device__ __forceinline__ void ssd_direct_unit(Frame& F, int b, int g) {
    const int tid = F.tid, hd = g * 8 + (tid >> 6), p = tid & 63, ch = g * 512 + tid;
    const int L = grp ? SL : PL, row0 = grp ? MP + b * SL : b * PL;
    LAS float* Bs = (LAS float*)F.lds; LAS float* Cs = Bs + 1024; LAS float* red = Cs + 1024; LAS float* Ys = red + 64;
    float h[128];
    if (grp) { const f32x4* h0 = (const f32x4*)(F.st_ssd + ((size_t)(b * SH + hd) * SP + p) * SN);
#pragma unroll
        for (int i = 0; i < 32; ++i) { const f32x4 q = h0[i]; h[4 * i] = q.x; h[4 * i + 1] = q.y; h[4 * i + 2] = q.z; h[4 * i + 3] = q.w; } }
    else {
#pragma unroll
        for (int i = 0; i < 128; ++i) h[i] = 0.f; }
    const float A = -__expf(F.A_log[hd]), dtb = F.dt_bias[hd], Dh = F.ssd_D[hd], nw = F.ssd_norm[ch];
    const float cb = F.sconv_b[ch], cw0 = F.sconv_w[ch], cw1 = F.sconv_w[SCH + ch], cw2 = F.sconv_w[2 * SCH + ch], cw3 = F.sconv_w[3 * SCH + ch];
    const int c2 = 1024 + (tid < 128 ? g * 128 + tid : 256 + g * 128 + ((tid - 128) & 127));
    float xr0 = xbc_raw(F, grp, b, row0, -3, ch), xr1 = xbc_raw(F, grp, b, row0, -2, ch), xr2 = xbc_raw(F, grp, b, row0, -1, ch);
    for (int t0 = 0; t0 < L; t0 += 8) {
        if (tid < 256) {
            float xr[11]; const float cb2 = F.sconv_b[c2], d0 = F.sconv_w[c2], d1 = F.sconv_w[SCH + c2], d2 = F.sconv_w[2 * SCH + c2], d3 = F.sconv_w[3 * SCH + c2];
#pragma unroll
            for (int i = 0; i < 11; ++i) xr[i] = xbc_raw(F, grp, b, row0, t0 - 3 + i, c2);
#pragma unroll
            for (int t = 0; t < 8; ++t) Bs[(tid >> 7) * 1024 + t * 128 + (tid & 127)] = silu_f(cb2 + d0 * xr[t] + d1 * xr[t + 1] + d2 * xr[t + 2] + d3 * xr[t + 3]);
        }
        __syncthreads();
#pragma unroll 1
        for (int t = 0; t < 8; ++t) { const int row = row0 + t0 + t;
            const float xn = bf2f(F.PROJ[(size_t)row * NP + CX + ch]);
            const float x = silu_f(cb + cw0 * xr0 + cw1 * xr1 + cw2 * xr2 + cw3 * xn); xr0 = xr1; xr1 = xr2; xr2 = xn;
            const float dt = softplus_f(F.LRDT[(size_t)row * 32 + 16 + hd] + dtb), a = __expf(dt * A), dtx = dt * x;
            float acc = 0.f; const LAS float* bb = Bs + t * 128; const LAS float* cc = Cs + t * 128;
#pragma unroll
            for (int nb = 0; nb < 128; nb += 16) {
#pragma unroll
                for (int n = nb; n < nb + 16; ++n) { h[n] = a * h[n] + dtx * bb[n]; acc += h[n] * cc[n]; }
                asm volatile("" ::: "memory"); }
            const float z = bf2f(F.PROJ[(size_t)row * NP + CZ + ch]);
            const float y = (acc + Dh * x) * silu_f(z);
            Ys[t * 512 + tid] = y;
            const float ss = wave_sum(y * y); if (F.lane == 0) red[t * 8 + F.wave] = ss; }
        __syncthreads();
#pragma unroll
        for (int t = 0; t < 8; ++t) { float tot = 0.f;
#pragma unroll
            for (int w = 0; w < 8; ++w) tot += red[t * 8 + w];
            const float r = rsqrtf(tot * (1.f / 512.f) + EPS);
            F.MIXIN[(size_t)(row0 + t0 + t) * DM + 1024 + ch] = (bf16)f2bf(Ys[t * 512 + tid] * r * nw); }
        __syncthreads();
    }
    f32x4* ho = (f32x4*)(F.out + (grp ? O_SSD_S : O_SSD_P) + ((size_t)(b * SH + hd) * SP + p) * SN);
#pragma unroll
    for (int i = 0; i < 32; ++i) ho[i] = (f32x4){h[4 * i], h[4 * i + 1], h[4 * i + 2], h[4 * i + 3]};
}
typedef short bf16x8v __attribute__((ext_vector_type(8)));
typedef short s16x4v __attribute__((ext_vector_type(4)));
constexpr int CH = 64, NCH = PL / CH;
constexpr int QE_ST = 272, KDT_ST = 144, V_ST = 544, ATT_ST = 144, X_ST = 1056, BC_ST = 288;
#define MFMA16(a, b, c) __builtin_amdgcn_mfma_f32_16x16x32_bf16((a), (b), (c), 0, 0, 0)
__device__ __forceinline__ bf16x8v frag_k(const LAS unsigned char* T, int stride, int idx0, int kk0, int r, int q) { return *(const LAS bf16x8v*)(T + (idx0 + r) * stride + (kk0 + 8 * q) * 2); }
__device__ __forceinline__ bf16x8v frag_t(const LAS unsigned char* T, int stride, int kk0, int idx0, int r, int q) {
    const LAS unsigned char* p = T + (kk0 + 8 * q + (r >> 2)) * stride + (idx0 + 4 * (r & 3)) * 2;
    const s16x4v lo = __builtin_amdgcn_ds_read_tr16_b64_v4i16((LAS s16x4v*)p), hi = __builtin_amdgcn_ds_read_tr16_b64_v4i16((LAS s16x4v*)(p + 4 * stride));
    return (bf16x8v){lo[0], lo[1], lo[2], lo[3], hi[0], hi[1], hi[2], hi[3]};
}
__device__ __forceinline__ v2u pk4(const f32x4 v) { v2u o; o.x = pk2(v.x, v.y); o.y = pk2(v.z, v.w); return o; }

struct GlaStage { v4u v[4], qk[4], lr; };
template <int PASS>
__device__ __forceinline__ void gla_stage_load(const Frame& F, int h, int row0, GlaStage& g) {
    const int tid = F.tid;
#pragma unroll
    for (int i = 0; i < 4; ++i) { const int piece = tid + NTHR * i, row = piece >> 5, c16 = piece & 31; g.v[i] = *(const v4u*)(F.PROJ + (size_t)(row0 + row) * NP + CV + h * GV + c16 * 8); }
#pragma unroll
    for (int i = 0; i < 2; ++i) { const int piece = tid + NTHR * i, row = piece >> 4, c16 = piece & 15;
        g.qk[i] = *(const v4u*)(F.PROJ + (size_t)(row0 + row) * NP + CK + h * GK + c16 * 8);
        if (PASS == 1) g.qk[2 + i] = *(const v4u*)(F.PROJ + (size_t)(row0 + row) * NP + CQ + h * GK + c16 * 8); }
    if (tid < 256) g.lr = *(const v4u*)(F.LRDT + (size_t)(row0 + (tid >> 2)) * 32 + (tid & 3) * 4);
}
template <int PASS>
__device__ __forceinline__ void gla_stage_store(const Frame& F, const GlaStage& g, LAS unsigned char* V, LAS unsigned char* Kt, LAS unsigned char* Qt, LAS float* LR) {
    const int tid = F.tid;
#pragma unroll
    for (int i = 0; i < 4; ++i) { const int piece = tid + NTHR * i, row = piece >> 5, c16 = piece & 31; *(LAS v4u*)(V + row * V_ST + c16 * 16) = g.v[i]; }
#pragma unroll
    for (int i = 0; i < 2; ++i) { const int piece = tid + NTHR * i, row = piece >> 4, c16 = piece & 15;
        *(LAS v4u*)(Kt + row * QE_ST + c16 * 16) = g.qk[i]; if (PASS == 1) *(LAS v4u*)(Qt + row * QE_ST + c16 * 16) = g.qk[2 + i]; }
    if (tid < 256) *(LAS v4u*)(LR + (tid >> 2) * 16 + (tid & 3) * 4) = g.lr;
}
template <int PASS>
__device__ __forceinline__ void gla_chunk_elem(Frame& F, int h, LAS unsigned char* Kt, LAS unsigned char* Qt, LAS unsigned char* KDT, const LAS float* LR, LAS float* tot, float* ebl_out) {
    const int tid = F.tid, k = tid & 127, tq = tid >> 7, hk = h * GK + k;
    float w2[16];
#pragma unroll
    for (int j = 0; j < 16; ++j) w2[j] = F.w_gate2[j * GKD + hk];
    const float bg = F.b_gate[hk];
    float lg[16]; float run = 0.f;
#pragma unroll
    for (int i = 0; i < 16; ++i) { const LAS f32x4* lr = (const LAS f32x4*)(LR + (16 * tq + i) * 16); const f32x4 a = lr[0], b = lr[1], c = lr[2], d = lr[3];
        float x = bg + a.x * w2[0] + a.y * w2[1] + a.z * w2[2] + a.w * w2[3] + b.x * w2[4] + b.y * w2[5] + b.z * w2[6] + b.w * w2[7]
                     + c.x * w2[8] + c.y * w2[9] + c.z * w2[10] + c.w * w2[11] + d.x * w2[12] + d.y * w2[13] + d.z * w2[14] + d.w * w2[15];
        run += logsigmoid_f(x) * (1.f / 16.f); lg[i] = run; }
    tot[tq * 128 + k] = run;
    __syncthreads();
    float off = 0.f, all = 0.f;
#pragma unroll
    for (int qq = 0; qq < 4; ++qq) { const float v = tot[qq * 128 + k]; all += v; off += (qq < tq) ? v : 0.f; }
    {
        unsigned pk[8];
#pragma unroll
        for (int i = 0; i < 8; ++i) { const int t = 16 * tq + 2 * i; const float b0 = off + lg[2 * i], b1 = off + lg[2 * i + 1];
            LAS bf16* k0p = (LAS bf16*)(Kt + t * QE_ST + k * 2); LAS bf16* k1p = (LAS bf16*)(Kt + (t + 1) * QE_ST + k * 2);
            LAS bf16* q0p = (LAS bf16*)(Qt + t * QE_ST + k * 2); LAS bf16* q1p = (LAS bf16*)(Qt + (t + 1) * QE_ST + k * 2);
            const float k0 = bf2f(*k0p), k1 = bf2f(*k1p);
            pk[i] = pk2(k0 * __expf(all - b0), k1 * __expf(all - b1));
            *k0p = (bf16)f2bf(k0 * __expf(-b0)); *k1p = (bf16)f2bf(k1 * __expf(-b1));
            *q0p = (bf16)f2bf(bf2f(*q0p) * 0.08838834764831845f * __expf(b0)); *q1p = (bf16)f2bf(bf2f(*q1p) * 0.08838834764831845f * __expf(b1)); }
        LAS v4u* d = (LAS v4u*)(KDT + k * KDT_ST + 32 * tq);
        d[0] = (v4u){pk[0], pk[1], pk[2], pk[3]}; d[1] = (v4u){pk[4], pk[5], pk[6], pk[7]};
        if (tq == 0) ebl_out[k] = __expf(all);
    }
}
__device__ __forceinline__ void gla_passA_unit(Frame& F, int u) {
    const int c = u & 31, bh = u >> 5, b = bh >> 2, h = bh & 3, row0 = b * PL + c * CH;
    LAS unsigned char* KDT = F.lds; LAS unsigned char* V = KDT + 128 * KDT_ST; LAS unsigned char* Kt = V + 64 * V_ST; LAS unsigned char* Qt = Kt + 64 * QE_ST; LAS float* LR = (LAS float*)(Qt + 64 * QE_ST); LAS float* tot = LR + 1024;
    { GlaStage g; gla_stage_load<1>(F, h, row0, g); gla_stage_store<1>(F, g, V, Kt, Qt, LR); }
    __syncthreads();
    gla_chunk_elem<0>(F, h, Kt, Qt, KDT, LR, tot, F.EBL + (size_t)u * 128);
    __syncthreads();
#pragma unroll
    for (int i = 0; i < 2; ++i) { const int piece = F.tid + NTHR * i, row = piece >> 4, c16 = piece & 15;
        *(v4u*)(F.QEg + ((size_t)u * 64 + row) * GK + c16 * 8) = *(const LAS v4u*)(Qt + row * QE_ST + c16 * 16);
        *(v4u*)(F.KEg + ((size_t)u * 64 + row) * GK + c16 * 8) = *(const LAS v4u*)(Kt + row * QE_ST + c16 * 16); }
    const int w = F.wave, r = F.lane & 15, q = F.lane >> 4;
    f32x4 acc[8][2];
#pragma unroll
    for (int kf = 0; kf < 8; ++kf) { acc[kf][0] = (f32x4){0.f, 0.f, 0.f, 0.f}; acc[kf][1] = (f32x4){0.f, 0.f, 0.f, 0.f}; }
#pragma unroll
    for (int ks = 0; ks < 2; ++ks) { const bf16x8v b0 = frag_t(V, V_ST, 32 * ks, 32 * w, r, q), b1 = frag_t(V, V_ST, 32 * ks, 32 * w + 16, r, q);
#pragma unroll
        for (int kf = 0; kf < 8; ++kf) { const bf16x8v a = frag_k(KDT, KDT_ST, 16 * kf, 32 * ks, r, q); acc[kf][0] = MFMA16(a, b0, acc[kf][0]); acc[kf][1] = MFMA16(a, b1, acc[kf][1]); } }
#pragma unroll
    for (int kf = 0; kf < 8; ++kf)
#pragma unroll
        for (int vf = 0; vf < 2; ++vf) *(v2u*)(F.DS + ((size_t)u * GV + 32 * w + 16 * vf + r) * GK + 16 * kf + 4 * q) = pk4(acc[kf][vf]);
    __syncthreads();
}
__device__ __forceinline__ void gla_scan(Frame& F) {
    for (int it = F.bid * NTHR + F.tid; it < PB * GH * GV * 32; it += F.G * NTHR) { const int k4 = it & 31, v = (it >> 5) & 255, bh = it >> 13;
        f32x4 S = (f32x4){0.f, 0.f, 0.f, 0.f};
#pragma unroll 8
        for (int c = 0; c < NCH; ++c) { const int u = bh * NCH + c; const size_t off = ((size_t)u * GV + v) * GK + 4 * k4;
            const v2u d = *(const v2u*)(F.DS + off); const f32x4 e = *(const f32x4*)(F.EBL + (size_t)u * 128 + 4 * k4);
            *(v2u*)(F.SC + off) = pk4(S);
            S.x = e.x * S.x + bflo(d.x); S.y = e.y * S.y + bfhi(d.x); S.z = e.z * S.z + bflo(d.y); S.w = e.w * S.w + bfhi(d.y); }
        float* o = F.out + O_GLA_P + ((size_t)bh * GK + 4 * k4) * GV + v; o[0] = S.x; o[GV] = S.y; o[2 * GV] = S.z; o[3 * GV] = S.w; }
}
__device__ __forceinline__ void gla_passC_unit(Frame& F, int u) {
    const int c = u & 31, bh = u >> 5, b = bh >> 2, h = bh & 3, row0 = b * PL + c * CH;
    LAS unsigned char* QE = F.lds; LAS unsigned char* KE = QE + 64 * QE_ST; LAS unsigned char* V = KE + 64 * QE_ST; LAS unsigned char* ATT = V + 64 * V_ST;
    LAS float* red = (LAS float*)(ATT + 64 * ATT_ST);
    { v4u vv[4], qq[2], kk[2];
#pragma unroll
        for (int i = 0; i < 4; ++i) { const int piece = F.tid + NTHR * i, row = piece >> 5, c16 = piece & 31; vv[i] = *(const v4u*)(F.PROJ + (size_t)(row0 + row) * NP + CV + h * GV + c16 * 8); }
#pragma unroll
        for (int i = 0; i < 2; ++i) { const int piece = F.tid + NTHR * i, row = piece >> 4, c16 = piece & 15;
            qq[i] = *(const v4u*)(F.QEg + ((size_t)u * 64 + row) * GK + c16 * 8); kk[i] = *(const v4u*)(F.KEg + ((size_t)u * 64 + row) * GK + c16 * 8); }
#pragma unroll
        for (int i = 0; i < 4; ++i) { const int piece = F.tid + NTHR * i, row = piece >> 5, c16 = piece & 31; *(LAS v4u*)(V + row * V_ST + c16 * 16) = vv[i]; }
#pragma unroll
        for (int i = 0; i < 2; ++i) { const int piece = F.tid + NTHR * i, row = piece >> 4, c16 = piece & 15;
            *(LAS v4u*)(QE + row * QE_ST + c16 * 16) = qq[i]; *(LAS v4u*)(KE + row * QE_ST + c16 * 16) = kk[i]; } }
    __syncthreads();
    const int w = F.wave, r = F.lane & 15, q = F.lane >> 4;
#pragma unroll
    for (int ff = 0; ff < 2; ++ff) { const int f = 2 * w + ff, sf = f >> 2, tf = f & 3; f32x4 a4 = (f32x4){0.f, 0.f, 0.f, 0.f};
        if (sf <= tf) {
#pragma unroll
            for (int ks = 0; ks < 4; ++ks) a4 = MFMA16(frag_k(KE, QE_ST, 16 * sf, 32 * ks, r, q), frag_k(QE, QE_ST, 16 * tf, 32 * ks, r, q), a4); }
        const int s0 = 16 * sf + 4 * q, t = 16 * tf + r;
        f32x4 m; m.x = (s0 <= t) ? a4.x : 0.f; m.y = (s0 + 1 <= t) ? a4.y : 0.f; m.z = (s0 + 2 <= t) ? a4.z : 0.f; m.w = (s0 + 3 <= t) ? a4.w : 0.f;
        *(LAS v2u*)(ATT + t * ATT_ST + s0 * 2) = pk4(m); }
    __syncthreads();
    const int tf = w & 3, vh = w >> 2;
    f32x4 acc[8];
#pragma unroll
    for (int i = 0; i < 8; ++i) acc[i] = (f32x4){0.f, 0.f, 0.f, 0.f};
    const bf16* Sc = F.SC + ((size_t)u * GV + 128 * vh) * GK;
#pragma unroll
    for (int ks = 0; ks < 4; ++ks) { const bf16x8v bq = frag_k(QE, QE_ST, 16 * tf, 32 * ks, r, q);
#pragma unroll
        for (int i = 0; i < 8; ++i) { const bf16x8v a = *(const bf16x8v*)(Sc + (size_t)(16 * i + r) * GK + 32 * ks + 8 * q); acc[i] = MFMA16(a, bq, acc[i]); } }
#pragma unroll
    for (int ks = 0; ks < 2; ++ks) { const bf16x8v ba = frag_k(ATT, ATT_ST, 16 * tf, 32 * ks, r, q);
#pragma unroll
        for (int i = 0; i < 8; ++i) { const bf16x8v a = frag_t(V, V_ST, 32 * ks, 128 * vh + 16 * i, r, q); acc[i] = MFMA16(a, ba, acc[i]); } }
    float ss = 0.f;
#pragma unroll
    for (int i = 0; i < 8; ++i) ss += (acc[i].x * acc[i].x + acc[i].y * acc[i].y) + (acc[i].z * acc[i].z + acc[i].w * acc[i].w);
    ss += __shfl_xor(ss, 16); ss += __shfl_xor(ss, 32);
    const int t = 16 * tf + r;
    if (q == 0) red[vh * 64 + t] = ss;
    __syncthreads();
    const float rr = rsqrtf((red[t] + red[64 + t]) * (1.f / GV) + EPS); const size_t row = (size_t)(row0 + t);
#pragma unroll
    for (int i = 0; i < 8; ++i) { const int v = 128 * vh + 16 * i + 4 * q;
        const v2u gw = *(const v2u*)(F.PROJ + row * NP + CG + h * GV + v); const f32x4 nw = *(const f32x4*)(F.gla_norm + v);
        f32x4 o; o.x = acc[i].x * rr * nw.x * silu_f(bflo(gw.x)); o.y = acc[i].y * rr * nw.y * silu_f(bfhi(gw.x)); o.z = acc[i].z * rr * nw.z * silu_f(bflo(gw.y)); o.w = acc[i].w * rr * nw.w * silu_f(bfhi(gw.y));
        *(v2u*)(F.MIXIN + row * DM + h * GV + v) = pk4(o); }
    __syncthreads();
}

template <bool SCALE>
__device__ __forceinline__ void ssd_conv_item(Frame& F, int b, int g, int c, int cg, int tb, LAS unsigned char* X, LAS unsigned char* BT, LAS unsigned char* CT, const LAS float* WDEC) {
    const int xc = cg < 64 ? g * 512 + 8 * cg : (cg < 80 ? 1024 + g * 128 + 8 * (cg - 64) : 1280 + g * 128 + 8 * (cg - 80));
    float w[4][8], bias[8];
#pragma unroll
    for (int j = 0; j < 4; ++j) { const f32x4 a = *(const f32x4*)(F.sconv_w + j * SCH + xc), bq = *(const f32x4*)(F.sconv_w + j * SCH + xc + 4);
        w[j][0] = a.x; w[j][1] = a.y; w[j][2] = a.z; w[j][3] = a.w; w[j][4] = bq.x; w[j][5] = bq.y; w[j][6] = bq.z; w[j][7] = bq.w; }
    { const f32x4 a = *(const f32x4*)(F.sconv_b + xc), bq = *(const f32x4*)(F.sconv_b + xc + 4); bias[0] = a.x; bias[1] = a.y; bias[2] = a.z; bias[3] = a.w; bias[4] = bq.x; bias[5] = bq.y; bias[6] = bq.z; bias[7] = bq.w; }
    v4u raw[11];
#pragma unroll
    for (int i = 0; i < 11; ++i) { const int tt = c * CH + tb * 8 - 3 + i;
        raw[i] = (tt >= 0) ? *(const v4u*)(F.PROJ + (size_t)(b * PL + tt) * NP + CX + xc) : (v4u){0u, 0u, 0u, 0u}; }
#pragma unroll
    for (int t = 0; t < 8; ++t) { float o[8];
#pragma unroll
        for (int e = 0; e < 8; ++e) { float a = bias[e];
#pragma unroll
            for (int j = 0; j < 4; ++j) { const unsigned wd = raw[t + j][e >> 1]; a += w[j][e] * ((e & 1) ? bfhi(wd) : bflo(wd)); }
            o[e] = silu_f(a); }
        const int tl = tb * 8 + t;
        if (SCALE && cg < 64) { const float sc = WDEC[(cg >> 3) * 64 + tl];
#pragma unroll
            for (int e = 0; e < 8; ++e) o[e] *= sc; }
        const v4u pkd = (v4u){pk2(o[0], o[1]), pk2(o[2], o[3]), pk2(o[4], o[5]), pk2(o[6], o[7])};
        LAS unsigned char* dst = cg < 64 ? X + tl * X_ST + cg * 16 : (cg < 80 ? BT + tl * BC_ST + (cg - 64) * 16 : CT + tl * BC_ST + (cg - 80) * 16);
        *(LAS v4u*)dst = pkd; }
}
__device__ __forceinline__ float ssd_head_scan(Frame& F, int hd, int row0, float& dt_out, float& last) {
    const float dt = softplus_f(F.LRDT[(size_t)(row0 + F.lane) * 32 + 16 + hd] + F.dt_bias[hd]);
    float cum = dt * (-__expf(F.A_log[hd]));
#pragma unroll
    for (int o = 1; o < 64; o <<= 1) { const float v = __shfl_up(cum, o); cum += (F.lane >= o) ? v : 0.f; }
    dt_out = dt; last = __shfl(cum, 63); return cum;
}
__device__ __forceinline__ void ssd_passA_unit(Frame& F, int u) {
    const int c = u & 31, bg = u >> 5, b = bg >> 1, g = bg & 1, row0 = b * PL + c * CH;
    LAS unsigned char* X = F.lds; LAS unsigned char* BT = X + 64 * X_ST; LAS float* WDEC = (LAS float*)(BT + 64 * BC_ST);
    const int w = F.wave, r = F.lane & 15, q = F.lane >> 4;
    { float dt, last; const float cum = ssd_head_scan(F, g * 8 + w, row0, dt, last);
        WDEC[w * 64 + F.lane] = __expf(last - cum) * dt; if (F.lane == 63) F.AL[(size_t)u * 8 + w] = __expf(last); }
    __syncthreads();
    for (int it = F.tid; it < 80 * 8; it += NTHR) ssd_conv_item<true>(F, b, g, c, it % 80, it / 80, X, BT, nullptr, WDEC);
    __syncthreads();
#pragma unroll 1
    for (int nh = 0; nh < 2; ++nh) {
        f32x4 acc[4][4];
#pragma unroll
        for (int i = 0; i < 4; ++i)
#pragma unroll
            for (int j = 0; j < 4; ++j) acc[i][j] = (f32x4){0.f, 0.f, 0.f, 0.f};
#pragma unroll
        for (int ks = 0; ks < 2; ++ks) { bf16x8v bp[4];
#pragma unroll
            for (int pf = 0; pf < 4; ++pf) bp[pf] = frag_t(X, X_ST, 32 * ks, 64 * w + 16 * pf, r, q);
#pragma unroll
            for (int nf = 0; nf < 4; ++nf) { const bf16x8v a = frag_t(BT, BC_ST, 32 * ks, 64 * nh + 16 * nf, r, q);
#pragma unroll
                for (int pf = 0; pf < 4; ++pf) acc[nf][pf] = MFMA16(a, bp[pf], acc[nf][pf]); } }
#pragma unroll
        for (int nf = 0; nf < 4; ++nf)
#pragma unroll
            for (int pf = 0; pf < 4; ++pf) *(v2u*)(F.DH + (((size_t)u * 8 + w) * SP + 16 * pf + r) * SN + 64 * nh + 16 * nf + 4 * q) = pk4(acc[nf][pf]);
    }
    __syncthreads();
}
__device__ __forceinline__ void ssd_scan(Frame& F) {
    for (int it = F.bid * NTHR + F.tid; it < PB * SH * SP * 32; it += F.G * NTHR) { const int n4 = it & 31, p = (it >> 5) & 63, bhd = it >> 11, b = bhd >> 4, hd = bhd & 15, g = hd >> 3, hl = hd & 7;
        f32x4 H = (f32x4){0.f, 0.f, 0.f, 0.f};
#pragma unroll 8
        for (int c = 0; c < NCH; ++c) { const int u = (b * 2 + g) * NCH + c; const size_t off = (((size_t)u * 8 + hl) * SP + p) * SN + 4 * n4;
            const v2u d = *(const v2u*)(F.DH + off); const float a = F.AL[(size_t)u * 8 + hl];
            *(v2u*)(F.HC + off) = pk4(H);
            H.x = a * H.x + bflo(d.x); H.y = a * H.y + bfhi(d.x); H.z = a * H.z + bflo(d.y); H.w = a * H.w + bfhi(d.y); }
        *(f32x4*)(F.out + O_SSD_P + ((size_t)bhd * SP + p) * SN + 4 * n4) = H; }
}
__device__ __forceinline__ void ssd_passC_unit(Frame& F, int u) {
    const int c = u & 31, bg = u >> 5, b = bg >> 1, g = bg & 1, row0 = b * PL + c * CH;
    LAS unsigned char* X = F.lds; LAS unsigned char* BT = X + 64 * X_ST; LAS unsigned char* CT = BT + 64 * BC_ST; LAS unsigned char* CB = CT + 64 * BC_ST;
    LAS float* DT = (LAS float*)(CB + 64 * ATT_ST); LAS float* CUM = DT + 512; LAS float* red = CUM + 512;
    const int w = F.wave, r = F.lane & 15, q = F.lane >> 4, hd = g * 8 + w;
    { float dt, last; const float cum = ssd_head_scan(F, hd, row0, dt, last); DT[w * 64 + F.lane] = dt; CUM[w * 64 + F.lane] = cum; }
    for (int it = F.tid; it < 96 * 8; it += NTHR) ssd_conv_item<false>(F, b, g, c, it % 96, it / 96, X, BT, CT, nullptr);
    __syncthreads();
#pragma unroll
    for (int ff = 0; ff < 2; ++ff) { const int f = 2 * w + ff, sf = f >> 2, tf = f & 3; f32x4 a4 = (f32x4){0.f, 0.f, 0.f, 0.f};
        if (sf <= tf) {
#pragma unroll
            for (int ks = 0; ks < 4; ++ks) a4 = MFMA16(frag_k(BT, BC_ST, 16 * sf, 32 * ks, r, q), frag_k(CT, BC_ST, 16 * tf, 32 * ks, r, q), a4); }
        *(LAS v2u*)(CB + (16 * tf + r) * ATT_ST + (16 * sf + 4 * q) * 2) = pk4(a4); }
    __syncthreads();
    f32x4 acc[4][4];
#pragma unroll
    for (int i = 0; i < 4; ++i)
#pragma unroll
        for (int j = 0; j < 4; ++j) acc[i][j] = (f32x4){0.f, 0.f, 0.f, 0.f};
    const bf16* Hc = F.HC + ((size_t)u * 8 + w) * SP * SN;
#pragma unroll
    for (int ks = 0; ks < 4; ++ks) { bf16x8v bc[4];
#pragma unroll
        for (int tf = 0; tf < 4; ++tf) bc[tf] = frag_k(CT, BC_ST, 16 * tf, 32 * ks, r, q);
#pragma unroll
        for (int pf = 0; pf < 4; ++pf) { const bf16x8v a = *(const bf16x8v*)(Hc + (size_t)(16 * pf + r) * SN + 32 * ks + 8 * q);
#pragma unroll
            for (int tf = 0; tf < 4; ++tf) acc[pf][tf] = MFMA16(a, bc[tf], acc[pf][tf]); } }
    float ct[4];
#pragma unroll
    for (int tf = 0; tf < 4; ++tf) { ct[tf] = CUM[w * 64 + 16 * tf + r]; const float e = __expf(ct[tf]);
#pragma unroll
        for (int pf = 0; pf < 4; ++pf) acc[pf][tf] = acc[pf][tf] * e; }
#pragma unroll
    for (int ks = 0; ks < 2; ++ks) { bf16x8v ax[4];
#pragma unroll
        for (int pf = 0; pf < 4; ++pf) ax[pf] = frag_t(X, X_ST, 32 * ks, 64 * w + 16 * pf, r, q);
        const int s0 = 32 * ks + 8 * q;
        const f32x4 cs0 = *(const LAS f32x4*)(CUM + w * 64 + s0), cs1 = *(const LAS f32x4*)(CUM + w * 64 + s0 + 4), ds0 = *(const LAS f32x4*)(DT + w * 64 + s0), ds1 = *(const LAS f32x4*)(DT + w * 64 + s0 + 4);
        const float cs[8] = {cs0.x, cs0.y, cs0.z, cs0.w, cs1.x, cs1.y, cs1.z, cs1.w}, ds[8] = {ds0.x, ds0.y, ds0.z, ds0.w, ds1.x, ds1.y, ds1.z, ds1.w};
#pragma unroll
        for (int tf = 0; tf < 4; ++tf) { if (32 * ks > 16 * tf + 15) continue;
            const int t = 16 * tf + r; const v4u cb8 = *(const LAS v4u*)(CB + t * ATT_ST + s0 * 2); float l[8];
#pragma unroll
            for (int e = 0; e < 8; ++e) { const unsigned wd = cb8[e >> 1]; const float cbv = (e & 1) ? bfhi(wd) : bflo(wd); l[e] = (s0 + e <= t) ? cbv * __expf(ct[tf] - cs[e]) * ds[e] : 0.f; }
            const v4u lp = (v4u){pk2(l[0], l[1]), pk2(l[2], l[3]), pk2(l[4], l[5]), pk2(l[6], l[7])}; const bf16x8v bl = __builtin_bit_cast(bf16x8v, lp);
#pragma unroll
            for (int pf = 0; pf < 4; ++pf) acc[pf][tf] = MFMA16(ax[pf], bl, acc[pf][tf]); } }
    const float Dh = F.ssd_D[hd];
#pragma unroll
    for (int tf = 0; tf < 4; ++tf) { const int t = 16 * tf + r; const size_t row = (size_t)(row0 + t); float ss = 0.f;
#pragma unroll
        for (int pf = 0; pf < 4; ++pf) { const int p4 = 64 * w + 16 * pf + 4 * q;
            const v2u xv = *(const LAS v2u*)(X + t * X_ST + p4 * 2); const v2u zv = *(const v2u*)(F.PROJ + row * NP + CZ + g * 512 + p4);
            f32x4 y = acc[pf][tf];
            y.x = (y.x + Dh * bflo(xv.x)) * silu_f(bflo(zv.x)); y.y = (y.y + Dh * bfhi(xv.x)) * silu_f(bfhi(zv.x)); y.z = (y.z + Dh * bflo(xv.y)) * silu_f(bflo(zv.y)); y.w = (y.w + Dh * bfhi(xv.y)) * silu_f(bfhi(zv.y));
            acc[pf][tf] = y; ss += (y.x * y.x + y.y * y.y) + (y.z * y.z + y.w * y.w); }
        ss += __shfl_xor(ss, 16); ss += __shfl_xor(ss, 32);
        if (q == 0) red[w * 64 + t] = ss; }
    __syncthreads();
#pragma unroll
    for (int tf = 0; tf < 4; ++tf) { const int t = 16 * tf + r; const size_t row = (size_t)(row0 + t); float tot = 0.f;
#pragma unroll
        for (int ww = 0; ww < 8; ++ww) tot += red[ww * 64 + t];
        const float rr = rsqrtf(tot * (1.f / 512.f) + EPS);
#pragma unroll
        for (int pf = 0; pf < 4; ++pf) { const int p4 = g * 512 + 64 * w + 16 * pf + 4 * q; const f32x4 nw = *(const f32x4*)(F.ssd_norm + p4);
            f32x4 o = acc[pf][tf]; o.x *= rr * nw.x; o.y *= rr * nw.y; o.z *= rr * nw.z; o.w *= rr * nw.w;
            *(v2u*)(F.MIXIN + row * DM + 1024 + p4) = pk4(o); } }
    __syncthreads();
}

constexpr int ATT8_ST = 80;
__device__ __forceinline__ void gla_sample_unit(Frame& F, int b, int h, f32x4 (&S)[16], int nb, int nh, bool has_next) {
    const int tid = F.tid, w = F.wave, lane = F.lane, r = lane & 15, q = lane >> 4, row0 = MP + b * SL;
    LAS unsigned char* S0b = F.lds;
    LAS unsigned char* Vt = S0b + 128 * V_ST;
    LAS unsigned char* QE = Vt + 32 * V_ST;
    LAS unsigned char* KE = QE + 16 * QE_ST;
    LAS unsigned char* ATT = KE + 16 * QE_ST;
    LAS float* KD = (LAS float*)(ATT + 16 * ATT8_ST);
    LAS float* EL = KD + 1024;
    LAS float* red = EL + 128;
    f32x4 Vf[8];
#pragma unroll
    for (int s = 0; s < 8; ++s) { const v2u vv = *(const v2u*)(F.PROJ + (size_t)(row0 + s) * NP + CV + h * GV + 4 * lane); Vf[s] = (f32x4){bflo(vv.x), bfhi(vv.x), bflo(vv.y), bfhi(vv.y)}; }
    if (tid < 256) { const int t = tid >> 5, c16 = tid & 31; *(LAS v4u*)(Vt + t * V_ST + c16 * 16) = *(const v4u*)(F.PROJ + (size_t)(row0 + t) * NP + CV + h * GV + c16 * 8); }
    for (int i = tid; i < 24 * 32; i += NTHR) *(LAS v4u*)(Vt + (8 + (i >> 5)) * V_ST + (i & 31) * 16) = (v4u){0u, 0u, 0u, 0u};
    { LAS unsigned char* KR = (LAS unsigned char*)(red + 128); LAS unsigned char* QR = KR + 8 * 256; LAS float* LR = (LAS float*)(QR + 8 * 256); LAS float* LG = LR + 128;
        if (tid < 256) { const int which = tid >> 7, j = tid & 127, t = j >> 4, c16 = j & 15;
            *(LAS v4u*)((which ? QR : KR) + t * 256 + c16 * 16) = *(const v4u*)(F.PROJ + (size_t)(row0 + t) * NP + (which ? CQ : CK) + h * GK + c16 * 8); }
        else if (tid < 288) { const int j = tid - 256; *(LAS v4u*)(LR + (j >> 2) * 16 + (j & 3) * 4) = *(const v4u*)(F.LRDT + (size_t)(row0 + (j >> 2)) * 32 + (j & 3) * 4); }
        __syncthreads();
        { const int k = tid & 127, tp = tid >> 7, hk = h * GK + k; const float bg = F.b_gate[hk];
            float w2[16];
#pragma unroll
            for (int j = 0; j < 16; ++j) w2[j] = F.w_gate2[j * GKD + hk];
#pragma unroll
            for (int tt = 0; tt < 2; ++tt) { const int t = 2 * tp + tt; const LAS f32x4* lr = (const LAS f32x4*)(LR + t * 16); const f32x4 a = lr[0], bq = lr[1], c = lr[2], d = lr[3];
                const float x = bg + a.x * w2[0] + a.y * w2[1] + a.z * w2[2] + a.w * w2[3] + bq.x * w2[4] + bq.y * w2[5] + bq.z * w2[6] + bq.w * w2[7]
                              + c.x * w2[8] + c.y * w2[9] + c.z * w2[10] + c.w * w2[11] + d.x * w2[12] + d.y * w2[13] + d.z * w2[14] + d.w * w2[15];
                LG[t * 128 + k] = logsigmoid_f(x) * (1.f / 16.f); } }
        __syncthreads();
        if (tid < 128) { const int k = tid;
            float bcum[8], kv[8]; float run = 0.f;
#pragma unroll
            for (int t = 0; t < 8; ++t) { run += LG[t * 128 + k]; bcum[t] = run; kv[t] = bf2f(*(const LAS bf16*)(KR + t * 256 + k * 2));
                *(LAS bf16*)(QE + t * QE_ST + k * 2) = (bf16)f2bf(bf2f(*(const LAS bf16*)(QR + t * 256 + k * 2)) * 0.08838834764831845f * __expf(run));
                *(LAS bf16*)(KE + t * QE_ST + k * 2) = (bf16)f2bf(kv[t] * __expf(-run)); }
            f32x4 d0, d1; d0.x = kv[0] * __expf(run - bcum[0]); d0.y = kv[1] * __expf(run - bcum[1]); d0.z = kv[2] * __expf(run - bcum[2]); d0.w = kv[3] * __expf(run - bcum[3]);
            d1.x = kv[4] * __expf(run - bcum[4]); d1.y = kv[5] * __expf(run - bcum[5]); d1.z = kv[6] * __expf(run - bcum[6]); d1.w = kv[7];
            *(LAS f32x4*)(KD + k * 8) = d0; *(LAS f32x4*)(KD + k * 8 + 4) = d1; EL[k] = __expf(run); } }
    if (tid < 128) {
    } else if (tid < 384) { const int i = tid - 128, which = i >> 7, j = i & 127;
        *(LAS v4u*)((which ? KE : QE) + (8 + (j >> 4)) * QE_ST + (j & 15) * 16) = (v4u){0u, 0u, 0u, 0u};
    } else if (tid < 384 + 80) { *(LAS v4u*)(ATT + (tid - 384) * 16) = (v4u){0u, 0u, 0u, 0u}; }
#pragma unroll
    for (int i = 0; i < 16; ++i) *(LAS v2u*)(S0b + (16 * w + i) * V_ST + lane * 8) = pk4(S[i]);
    __syncthreads();
    if (w == 0) { f32x4 a4 = (f32x4){0.f, 0.f, 0.f, 0.f};
#pragma unroll
        for (int ks = 0; ks < 4; ++ks) a4 = MFMA16(frag_k(KE, QE_ST, 0, 32 * ks, r, q), frag_k(QE, QE_ST, 0, 32 * ks, r, q), a4);
        const int s0i = 4 * q; f32x4 m; m.x = (s0i <= r) ? a4.x : 0.f; m.y = (s0i + 1 <= r) ? a4.y : 0.f; m.z = (s0i + 2 <= r) ? a4.z : 0.f; m.w = (s0i + 3 <= r) ? a4.w : 0.f;
        if (r >= 8) m = (f32x4){0.f, 0.f, 0.f, 0.f};
        *(LAS v2u*)(ATT + r * ATT8_ST + s0i * 2) = pk4(m); }
    { f32x4* so = (f32x4*)(F.out + O_GLA_S + ((size_t)(b * GH + h) * GK + 16 * w) * GV) + lane;
#pragma unroll
        for (int i = 0; i < 16; ++i) { const int k = 16 * w + i; const float e = EL[k]; const f32x4 k0 = *(const LAS f32x4*)(KD + k * 8), k1 = *(const LAS f32x4*)(KD + k * 8 + 4);
            f32x4 n = S[i] * e; n = n + Vf[0] * k0.x; n = n + Vf[1] * k0.y; n = n + Vf[2] * k0.z; n = n + Vf[3] * k0.w; n = n + Vf[4] * k1.x; n = n + Vf[5] * k1.y; n = n + Vf[6] * k1.z; n = n + Vf[7] * k1.w;
            so[i * 64] = n; } }
    if (has_next) { const f32x4* s1 = (const f32x4*)(F.st_gla + ((size_t)(nb * GH + nh) * GK + 16 * w) * GV) + lane;
#pragma unroll
        for (int i = 0; i < 16; ++i) S[i] = s1[i * 64]; }
    f32x4 acc[2] = {(f32x4){0.f, 0.f, 0.f, 0.f}, (f32x4){0.f, 0.f, 0.f, 0.f}};
#pragma unroll
    for (int ks = 0; ks < 4; ++ks) { const bf16x8v bq = frag_k(QE, QE_ST, 0, 32 * ks, r, q);
#pragma unroll
        for (int vf = 0; vf < 2; ++vf) acc[vf] = MFMA16(frag_t(S0b, V_ST, 32 * ks, 32 * w + 16 * vf, r, q), bq, acc[vf]); }
    __syncthreads();
    { const bf16x8v ba = *(const LAS bf16x8v*)(ATT + r * ATT8_ST + 16 * q);
#pragma unroll
        for (int vf = 0; vf < 2; ++vf) acc[vf] = MFMA16(frag_t(Vt, V_ST, 0, 32 * w + 16 * vf, r, q), ba, acc[vf]); }
    float ss = (acc[0].x * acc[0].x + acc[0].y * acc[0].y) + (acc[0].z * acc[0].z + acc[0].w * acc[0].w) + (acc[1].x * acc[1].x + acc[1].y * acc[1].y) + (acc[1].z * acc[1].z + acc[1].w * acc[1].w);
    ss += __shfl_xor(ss, 16); ss += __shfl_xor(ss, 32);
    if (q == 0) red[w * 16 + r] = ss;
    __syncthreads();
    float tot = 0.f;
#pragma unroll
    for (int ww = 0; ww < 8; ++ww) tot += red[ww * 16 + r];
    const float rr = rsqrtf(tot * (1.f / GV) + EPS);
    if (r < 8) { const size_t row = (size_t)(row0 + r);
#pragma unroll
        for (int vf = 0; vf < 2; ++vf) { const int v = 32 * w + 16 * vf + 4 * q;
            const v2u gw = *(const v2u*)(F.PROJ + row * NP + CG + h * GV + v); const f32x4 nw = *(const f32x4*)(F.gla_norm + v);
            f32x4 o; o.x = acc[vf].x * rr * nw.x * silu_f(bflo(gw.x)); o.y = acc[vf].y * rr * nw.y * silu_f(bfhi(gw.x)); o.z = acc[vf].z * rr * nw.z * silu_f(bflo(gw.y)); o.w = acc[vf].w * rr * nw.w * silu_f(bfhi(gw.y));
            *(v2u*)(F.MIXIN + row * DM + h * GV + v) = pk4(o); } }
    __syncthreads();
}
__device__ __forceinline__ void ssd_sample_unit(Frame& F, int b, int g) {
    const int tid = F.tid, w = F.wave, lane = F.lane, r = lane & 15, q = lane >> 4, row0 = MP + b * SL, hd = g * 8 + w, ch = g * 512 + tid;
    LAS float* Xs = (LAS float*)F.lds;
    LAS float* XW = Xs + 4096;
    LAS float* Bs = XW + 4096;
    LAS unsigned char* Cb = (LAS unsigned char*)(Bs + 1024);
    LAS unsigned char* Bb = Cb + 16 * QE_ST;
    LAS float* CBm = (LAS float*)(Bb + 16 * QE_ST);
    LAS float* CD = CBm + 256;
    LAS float* red = CD + 128;
    const float* h0base = F.st_ssd + ((size_t)(b * SH + hd) * SP) * SN; float* hobase = F.out + O_SSD_S + ((size_t)(b * SH + hd) * SP) * SN;
    f32x4 hbuf[4][2];
#pragma unroll
    for (int i = 0; i < 4; ++i) { const size_t off = (size_t)(16 * (i & 3) + r) * SN + 32 * (i >> 2) + 8 * q; hbuf[i][0] = *(const f32x4*)(h0base + off); hbuf[i][1] = *(const f32x4*)(h0base + off + 4); }
    float dt[8], cum[8]; { const float A = -__expf(F.A_log[hd]), dtb = F.dt_bias[hd]; float run = 0.f;
#pragma unroll
        for (int t = 0; t < 8; ++t) { dt[t] = softplus_f(F.LRDT[(size_t)(row0 + t) * 32 + 16 + hd] + dtb); run += dt[t] * A; cum[t] = run; } }
    const float last = cum[7], elast = __expf(last);
    if (lane < 8) { float cv = cum[0], dv = dt[0];
#pragma unroll
        for (int t = 1; t < 8; ++t) { cv = (lane == t) ? cum[t] : cv; dv = (lane == t) ? dt[t] : dv; }
        CD[w * 16 + lane] = cv; CD[w * 16 + 8 + lane] = dv; }
    { float xr[11]; const float cb = F.sconv_b[ch], c0 = F.sconv_w[ch], c1 = F.sconv_w[SCH + ch], c2 = F.sconv_w[2 * SCH + ch], c3 = F.sconv_w[3 * SCH + ch];
#pragma unroll
        for (int i = 0; i < 11; ++i) xr[i] = xbc_raw(F, 1, b, row0, i - 3, ch);
        float xw[8];
#pragma unroll
        for (int t = 0; t < 8; ++t) { const float x = silu_f(cb + c0 * xr[t] + c1 * xr[t + 1] + c2 * xr[t + 2] + c3 * xr[t + 3]); Xs[t * 512 + tid] = x; xw[t] = x * __expf(last - cum[t]) * dt[t]; }
        *(LAS f32x4*)(XW + tid * 8) = (f32x4){xw[0], xw[1], xw[2], xw[3]}; *(LAS f32x4*)(XW + tid * 8 + 4) = (f32x4){xw[4], xw[5], xw[6], xw[7]}; }
    if (tid < 256) { const int n = tid & 127, isC = tid >> 7, cc = 1024 + isC * 256 + g * 128 + n;
        float xr[11]; const float cb = F.sconv_b[cc], c0 = F.sconv_w[cc], c1 = F.sconv_w[SCH + cc], c2 = F.sconv_w[2 * SCH + cc], c3 = F.sconv_w[3 * SCH + cc];
#pragma unroll
        for (int i = 0; i < 11; ++i) xr[i] = xbc_raw(F, 1, b, row0, i - 3, cc);
#pragma unroll
        for (int t = 0; t < 8; ++t) { const float x = silu_f(cb + c0 * xr[t] + c1 * xr[t + 1] + c2 * xr[t + 2] + c3 * xr[t + 3]);
            if (!isC) Bs[t * 128 + n] = x;
            *(LAS bf16*)((isC ? Cb : Bb) + t * QE_ST + n * 2) = (bf16)f2bf(x); }
    } else { const int i = tid - 256, which = i >> 7, j = i & 127; *(LAS v4u*)((which ? Bb : Cb) + (8 + (j >> 4)) * QE_ST + (j & 15) * 16) = (v4u){0u, 0u, 0u, 0u}; }
    __syncthreads();
    if (w == 0) { f32x4 a4 = (f32x4){0.f, 0.f, 0.f, 0.f};
#pragma unroll
        for (int ks = 0; ks < 4; ++ks) a4 = MFMA16(frag_k(Bb, QE_ST, 0, 32 * ks, r, q), frag_k(Cb, QE_ST, 0, 32 * ks, r, q), a4);
        *(LAS f32x4*)(CBm + r * 16 + 4 * q) = a4; }
    bf16x8v bc[4];
#pragma unroll
    for (int ks = 0; ks < 4; ++ks) bc[ks] = frag_k(Cb, QE_ST, 0, 32 * ks, r, q);
    f32x4 acc[4];
#pragma unroll
    for (int pf = 0; pf < 4; ++pf) acc[pf] = (f32x4){0.f, 0.f, 0.f, 0.f};
    f32x4 Bv[8][2];
#pragma unroll
    for (int st = 0; st < 16; ++st) { const int ks = st >> 2, pf = st & 3;
        if (pf == 0) {
#pragma unroll
            for (int s = 0; s < 8; ++s) { Bv[s][0] = *(const LAS f32x4*)(Bs + s * 128 + 32 * ks + 8 * q); Bv[s][1] = *(const LAS f32x4*)(Bs + s * 128 + 32 * ks + 8 * q + 4); } }
        const int p = 16 * pf + r; const size_t off = (size_t)p * SN + 32 * ks + 8 * q;
        const f32x4 ha = hbuf[st & 3][0], hb = hbuf[st & 3][1];
        if (st + 4 < 16) { const int st2 = st + 4; const size_t off2 = (size_t)(16 * (st2 & 3) + r) * SN + 32 * (st2 >> 2) + 8 * q; hbuf[st & 3][0] = *(const f32x4*)(h0base + off2); hbuf[st & 3][1] = *(const f32x4*)(h0base + off2 + 4); }
        asm volatile("" ::: "memory");
        const f32x4 x0 = *(const LAS f32x4*)(XW + (64 * w + p) * 8), x1 = *(const LAS f32x4*)(XW + (64 * w + p) * 8 + 4);
        f32x4 na = ha * elast, nb = hb * elast;
        na = na + Bv[0][0] * x0.x; nb = nb + Bv[0][1] * x0.x; na = na + Bv[1][0] * x0.y; nb = nb + Bv[1][1] * x0.y; na = na + Bv[2][0] * x0.z; nb = nb + Bv[2][1] * x0.z; na = na + Bv[3][0] * x0.w; nb = nb + Bv[3][1] * x0.w;
        na = na + Bv[4][0] * x1.x; nb = nb + Bv[4][1] * x1.x; na = na + Bv[5][0] * x1.y; nb = nb + Bv[5][1] * x1.y; na = na + Bv[6][0] * x1.z; nb = nb + Bv[6][1] * x1.z; na = na + Bv[7][0] * x1.w; nb = nb + Bv[7][1] * x1.w;
        *(f32x4*)(hobase + off) = na; *(f32x4*)(hobase + off + 4) = nb;
        const v4u ap = (v4u){pk2(ha.x, ha.y), pk2(ha.z, ha.w), pk2(hb.x, hb.y), pk2(hb.z, hb.w)};
        acc[pf] = MFMA16(__builtin_bit_cast(bf16x8v, ap), bc[ks], acc[pf]); }
    __syncthreads();
    const int tc = r & 7; const float ct = CD[w * 16 + tc], ect = __expf(ct), Dh = F.ssd_D[hd];
    float L[8]; { const f32x4 c0 = *(const LAS f32x4*)(CBm + r * 16), c1 = *(const LAS f32x4*)(CBm + r * 16 + 4); const float cbv[8] = {c0.x, c0.y, c0.z, c0.w, c1.x, c1.y, c1.z, c1.w};
        const f32x4 q0 = *(const LAS f32x4*)(CD + w * 16), q1 = *(const LAS f32x4*)(CD + w * 16 + 4), d0 = *(const LAS f32x4*)(CD + w * 16 + 8), d1 = *(const LAS f32x4*)(CD + w * 16 + 12);
        const float cu[8] = {q0.x, q0.y, q0.z, q0.w, q1.x, q1.y, q1.z, q1.w}, dd[8] = {d0.x, d0.y, d0.z, d0.w, d1.x, d1.y, d1.z, d1.w};
#pragma unroll
        for (int s = 0; s < 8; ++s) L[s] = (s <= tc) ? cbv[s] * __expf(ct - cu[s]) * dd[s] : 0.f; }
    float ss = 0.f; const size_t row = (size_t)(row0 + tc);
#pragma unroll
    for (int pf = 0; pf < 4; ++pf) { const int p4 = 64 * w + 16 * pf + 4 * q;
        f32x4 y = acc[pf] * ect;
#pragma unroll
        for (int s = 0; s < 8; ++s) y = y + *(const LAS f32x4*)(Xs + s * 512 + p4) * L[s];
        const f32x4 xt = *(const LAS f32x4*)(Xs + tc * 512 + p4); const v2u zv = *(const v2u*)(F.PROJ + row * NP + CZ + g * 512 + p4);
        y.x = (y.x + Dh * xt.x) * silu_f(bflo(zv.x)); y.y = (y.y + Dh * xt.y) * silu_f(bfhi(zv.x)); y.z = (y.z + Dh * xt.z) * silu_f(bflo(zv.y)); y.w = (y.w + Dh * xt.w) * silu_f(bfhi(zv.y));
        acc[pf] = y; ss += (y.x * y.x + y.y * y.y) + (y.z * y.z + y.w * y.w); }
    ss += __shfl_xor(ss, 16); ss += __shfl_xor(ss, 32);
    if (q == 0) red[w * 16 + r] = ss;
    __syncthreads();
    float tot = 0.f;
#pragma unroll
    for (int ww = 0; ww < 8; ++ww) tot += red[ww * 16 + r];
    const float rr = rsqrtf(tot * (1.f / 512.f) + EPS);
    if (r < 8) {
#pragma unroll
        for (int pf = 0; pf < 4; ++pf) { const int p4 = g * 512 + 64 * w + 16 * pf + 4 * q; const f32x4 nw = *(const f32x4*)(F.ssd_norm + p4);
            f32x4 o = acc[pf]; o.x *= rr * nw.x; o.y *= rr * nw.y; o.z *= rr * nw.z; o.w *= rr * nw.w;
            *(v2u*)(F.MIXIN + row * DM + 1024 + p4) = pk4(o); } }
    __syncthreads();
}

__device__ __forceinline__ void p2a_chunk_states(Frame& F) {
    for (int idx = F.bid; idx < 768; idx += F.G) { if (idx < 256) { TBEGIN(F, 20); ssd_passA_unit(F, idx); TEND(F, 20); } else { TBEGIN(F, 21); gla_passA_unit(F, idx - 256); TEND(F, 21); } }
}
#ifndef MK_REP_PHASE
#define MK_REP_PHASE (-1)
#endif
__device__ __forceinline__ void p2b_scans_and_sample(Frame& F) {
    TBEGIN(F, 30); for (int rep = 0; rep < (MK_REP_PHASE == 30 ? 2 : 1); ++rep) { gla_scan(F); ssd_scan(F); } TEND(F, 30);
    TBEGIN(F, 31);
    for (int rep = 0; rep < (MK_REP_PHASE == 31 ? 2 : 1); ++rep)
    { f32x4 S[16]; int idx = F.bid;
            if (idx < SB * GH) { const f32x4* s0 = (const f32x4*)(F.st_gla + ((size_t)idx * GK + 16 * F.wave) * GV) + F.lane;
#pragma unroll
                for (int i = 0; i < 16; ++i) S[i] = s0[i * 64]; }
            for (; idx < SB * GH; idx += F.G) { const int nx = idx + F.G; gla_sample_unit(F, idx / GH, idx % GH, S, nx / GH, nx % GH, nx < SB * GH); } }
    TEND(F, 31); TBEGIN(F, 32);
    for (int rep = 0; rep < (MK_REP_PHASE == 32 ? 2 : 1); ++rep)
        for (int idx = F.bid; idx < SB * SG; idx += F.G) ssd_sample_unit(F, idx / SG, idx % SG);
    TEND(F, 32);
}
__device__ __forceinline__ void p2c_outputs(Frame& F) {
    for (int idx = F.bid; idx < 768; idx += F.G) { if (idx < 256) { TBEGIN(F, 40); ssd_passC_unit(F, idx); TEND(F, 40); } else { TBEGIN(F, 41); gla_passC_unit(F, idx - 256); TEND(F, 41); } }
    TBEGIN(F, 42);
    const int gt = F.bid * NTHR + F.tid, NT = F.G * NTHR;
    for (int i = gt; i < (PB + SB) * 3 * SCH; i += NT) { const int c = i % SCH, j = (i / SCH) % 3, s = i / (3 * SCH);
        const int grp = s >= PB, b = grp ? s - PB : s, L = grp ? SL : PL, row0 = grp ? MP + b * SL : b * PL;
        F.out[(grp ? O_SCONV_S : O_SCONV_P) + ((size_t)b * 3 + j) * SCH + c] = bf2f(F.PROJ[(size_t)(row0 + L - 3 + j) * NP + CX + c]); }
    TEND(F, 42);
}

__device__ __forceinline__ void p4_post_mixer(Frame& F) {
    const int gw = F.bid * NWAVES + F.wave, NGW = F.G * NWAVES, lane = F.lane;
    for (int m = gw; m < M; m += NGW) {
        const f32x4* mr = (const f32x4*)(F.MIX + (size_t)m * DM) + lane; const f32x4* xr = (const f32x4*)x_row(F, m) + lane;
        const f32x4* w1 = (const f32x4*)F.n_mix_post + lane; const f32x4* w2 = (const f32x4*)F.n_ffn_pre + lane;
        f32x4 v[8]; float s = 0.f;
#pragma unroll
        for (int j = 0; j < 8; ++j) { v[j] = mr[64 * j]; s += (v[j].x * v[j].x + v[j].y * v[j].y) + (v[j].z * v[j].z + v[j].w * v[j].w); }
        const float r1 = rsqrtf(wave_sum(s) * (1.f / DM) + EPS); float s2 = 0.f;
        f32x4* ho = (f32x4*)(F.out + O_Y + (size_t)m * DM) + lane;
#pragma unroll
        for (int j = 0; j < 8; ++j) { v[j] = xr[64 * j] + v[j] * r1 * w1[64 * j]; ho[64 * j] = v[j]; s2 += (v[j].x * v[j].x + v[j].y * v[j].y) + (v[j].z * v[j].z + v[j].w * v[j].w); }
        const float r2 = rsqrtf(wave_sum(s2) * (1.f / DM) + EPS);
        v2u* o8 = (v2u*)(F.XN + (size_t)m * DM) + lane;
#pragma unroll
        for (int j = 0; j < 8; ++j) { const f32x4 ww = w2[64 * j]; v2u o; o.x = pk2(v[j].x * r2 * ww.x, v[j].y * r2 * ww.y); o.y = pk2(v[j].z * r2 * ww.z, v[j].w * r2 * ww.w); o8[64 * j] = o; }
    }
}
__device__ __forceinline__ void p6_conv_fixup(Frame& F) {
    const int gt = F.bid * NTHR + F.tid, NT = F.G * NTHR;
    constexpr int NQ = FF / 4;
    for (int it = gt; it < 28 * 2 * NQ; it += NT) { const int c = (it % NQ) * 4, rr = (it / NQ) & 1, bi = it / (2 * NQ), pm = (bi / 7) * 8 + 1 + (bi % 7);
        f32x4 o[2];
#pragma unroll
        for (int hf = 0; hf < 2; ++hf) { const int cc = hf * FF + c;
            const f32x4 w0 = *(const f32x4*)(F.fconv_w + cc), w1 = *(const f32x4*)(F.fconv_w + FF2 + cc), w2 = *(const f32x4*)(F.fconv_w + 2 * FF2 + cc), bs = *(const f32x4*)(F.fconv_b + cc);
            const f32x4 um2 = *(const f32x4*)(F.HG + ((size_t)(pm - 1) * 4 + 2 + rr) * FF2 + cc);
            const f32x4 um1 = rr ? *(const f32x4*)(F.HG + ((size_t)pm * 4) * FF2 + cc) : *(const f32x4*)(F.HG + ((size_t)(pm - 1) * 4 + 3) * FF2 + cc);
            const f32x4 u0 = *(const f32x4*)(F.HG + ((size_t)pm * 4 + rr) * FF2 + cc);
            o[hf] = bs + w0 * um2 + w1 * um1 + w2 * u0; }
        v2u pk; pk.x = pk2(silu_f(o[0].x) * o[1].x, silu_f(o[0].y) * o[1].y); pk.y = pk2(silu_f(o[0].z) * o[1].z, silu_f(o[0].w) * o[1].w);
        *(v2u*)(F.ACT + (size_t)(pm * 256 + rr) * FF + c) = pk; }
    for (int i = gt; i < PB * 2 * (FF2 / 4); i += NT) { const int c = (i % (FF2 / 4)) * 4, j = (i / (FF2 / 4)) & 1, b = i / (2 * (FF2 / 4));
        *(f32x4*)(F.out + O_FCONV_P + ((size_t)b * 2 + j) * FF2 + c) = *(const f32x4*)(F.HG + ((size_t)(b * 8 + 7) * 4 + 2 + j) * FF2 + c); }
}
__device__ __forceinline__ void p8_final(Frame& F) {
    const int gw = F.bid * NWAVES + F.wave, NGW = F.G * NWAVES, lane = F.lane;
    for (int m = gw; m < M; m += NGW) {
        const f32x4* fr = (const f32x4*)(F.Fb + (size_t)m * DM) + lane; const f32x4* w1 = (const f32x4*)F.n_ffn_post + lane;
        f32x4* ho = (f32x4*)(F.out + O_Y + (size_t)m * DM) + lane;
        f32x4 v[8]; float s = 0.f;
#pragma unroll
        for (int j = 0; j < 8; ++j) { v[j] = fr[64 * j]; s += (v[j].x * v[j].x + v[j].y * v[j].y) + (v[j].z * v[j].z + v[j].w * v[j].w); }
        const float r1 = rsqrtf(wave_sum(s) * (1.f / DM) + EPS);
#pragma unroll
        for (int j = 0; j < 8; ++j) ho[64 * j] = ho[64 * j] + v[j] * r1 * w1[64 * j];
    }
}

__device__ __forceinline__ pg8::SplitCtx split_ctx(const Frame& F, unsigned char* ws, size_t slab_off, int bank) {
    pg8::SplitCtx X; X.slabs = (pg8::f32x4*)(ws + slab_off); X.cnt = (unsigned*)(ws + WS_CTL) + CW_SPLIT + bank * 1024; X.flag = (volatile LAS unsigned*)(F.lds + MISC_OFF) + 16; return X; }

struct Args { const float* in[25]; float* out; unsigned char* ws; int ph_lo, ph_hi; };
__global__ void __launch_bounds__(NTHR, 2) fwd_kernel(Args args) {
    extern __shared__ __attribute__((aligned(16))) unsigned char lds[];
    Frame F;
    F.lds = (LAS unsigned char*)lds;
    F.tid = threadIdx.x; F.lane = F.tid & 63; F.wave = __builtin_amdgcn_readfirstlane(F.tid >> 6);
    F.G = gridDim.x; F.bid = blockIdx.x;
    unsigned char* ws = args.ws;
    F.x_p = args.in[0]; F.x_s = args.in[1]; F.st_gla = args.in[2]; F.st_ssd = args.in[3]; F.st_sconv = args.in[4]; F.st_fconv = args.in[5];
    F.n_mix_pre = args.in[6]; F.n_mix_post = args.in[7]; F.n_ffn_pre = args.in[8]; F.n_ffn_post = args.in[9]; F.w_in = args.in[10];
    F.w_gate2 = args.in[11]; F.b_gate = args.in[12]; F.gla_norm = args.in[13]; F.sconv_w = args.in[14]; F.sconv_b = args.in[15];
    F.dt_bias = args.in[16]; F.A_log = args.in[17]; F.ssd_D = args.in[18]; F.ssd_norm = args.in[19]; F.w_out = args.in[20];
    F.ffn_w_in = args.in[21]; F.fconv_w = args.in[22]; F.fconv_b = args.in[23]; F.ffn_w_out = args.in[24];
    F.out = args.out;
    F.W1 = (bf16*)(ws + WS_W1); F.WO = (bf16*)(ws + WS_WO); F.WF1 = (bf16*)(ws + WS_WF1); F.WF2 = (bf16*)(ws + WS_WF2);
    F.XN = (bf16*)(ws + WS_XN); F.PROJ = (bf16*)(ws + WS_PROJ); F.MIXIN = (bf16*)(ws + WS_MIXIN); F.ACT = (bf16*)(ws + WS_ACT); F.HG = (float*)(ws + WS_HG);
    F.LRDT = (float*)(ws + WS_LRDT); F.MIX = (float*)(ws + WS_MIX); F.Fb = (float*)(ws + WS_F);
    F.DS = (bf16*)(ws + WS_DS); F.SC = (bf16*)(ws + WS_SC); F.DH = (bf16*)(ws + WS_DH); F.HC = (bf16*)(ws + WS_HC); F.EBL = (float*)(ws + WS_EBL); F.AL = (float*)(ws + WS_AL); F.QEg = (bf16*)(ws + WS_QEG); F.KEg = (bf16*)(ws + WS_KEG);
    for (int u = F.tid; u < (LDS_BYTES - LDSCTL_OFF) / 4; u += NTHR) ((LAS unsigned*)(F.lds + LDSCTL_OFF))[u] = 0u;
    __syncthreads();
    const int lo = args.ph_lo, hi = args.ph_hi;
#if !MK_PER_PHASE
    XcdBarrier bar = xcd_barrier_post((unsigned*)(ws + WS_CTL) + CW_BAR, (volatile LAS unsigned*)(F.lds + MISC_OFF) + 8);
#define GRID_BAR() do { if (args.ph_hi > 1000) cg::this_grid().sync(); xcd_barrier(bar); } while (0)
#else
#define GRID_BAR() do { } while (0)
#endif
#define IN(k) (lo <= (k) && (k) < hi)
#define SEAM(k) do { if (IN(k) && IN((k) + 1)) GRID_BAR(); } while (0)
    F.tacc = 0; F.tmark = 0;
#define PHASE(k, ...) do { if (IN(k)) { TBEGIN(F, k); if (MK_REP_PHASE == (k)) { __VA_ARGS__; GRID_BAR(); } __VA_ARGS__; SEAM(k); TEND(F, k); } } while (0)
    PHASE(0, p0_prologue(F));
    PHASE(1, { pg8::Gemm g{F.XN, F.W1, M, N1, DM}; pg8::StaticOrder S; S.init(M, N1, DM, F.G, F.bid, 1);
        pg8::EpiBf16 E{F.PROJ, NP, NP / 256, F.LRDT};
        pg8::gemm_phase<pg8::EpiBf16, pg8::StaticOrder, true, true>(F.lds, g, S, E, split_ctx(F, ws, WS_SLAB, 0));
        if (S.rem && F.bid >= S.rem * S.S) p0_convert_rest(F, F.bid - S.rem * S.S, F.G - S.rem * S.S); else if (!S.rem) p0_convert_rest(F, F.bid, F.G); });
    PHASE(2, p2a_chunk_states(F));
    PHASE(3, p2b_scans_and_sample(F));
    PHASE(4, p2c_outputs(F));
    PHASE(5, { pg8::Gemm g{F.MIXIN, F.WO, M, DM, DM}; pg8::StaticOrder S; S.init(M, DM, DM, F.G, F.bid, 4);
        pg8::EpiF32 E{F.MIX, DM};
        pg8::gemm_phase<pg8::EpiF32, pg8::StaticOrder, true, true>(F.lds, g, S, E, split_ctx(F, ws, WS_SLAB, 1)); });
    PHASE(6, p4_post_mixer(F));
    PHASE(7, { pg8::Gemm g{F.XN, F.WF1, M, FF2, DM}; pg8::StaticOrder S; S.init(M, FF2, DM, F.G, F.bid, 1);
        pg8::EpiConvAct E{F.ACT, F.HG, F.fconv_w, F.fconv_b, F.st_fconv, F.out + O_FCONV_S, (LAS float*)(F.lds + MISC_OFF + 512)};
        pg8::gemm_phase<pg8::EpiConvAct, pg8::StaticOrder, true, true>(F.lds, g, S, E, split_ctx(F, ws, WS_SLAB, 2)); });
    PHASE(8, p6_conv_fixup(F));
    PHASE(9, { pg8::Gemm g{F.ACT, F.WF2, M, DM, FF}; pg8::StaticOrder S; S.init(M, DM, FF, F.G, F.bid, 4);
        pg8::EpiF32 E{F.Fb, DM};
        pg8::gemm_phase<pg8::EpiF32, pg8::StaticOrder, true, true>(F.lds, g, S, E, split_ctx(F, ws, WS_SLAB, 3)); });
    if (IN(10)) { TBEGIN(F, 10); p8_final(F); if (MK_TIME_PHASE == 10) { asm volatile("s_waitcnt vmcnt(0)" ::: "memory"); __syncthreads(); } TEND(F, 10); }
    if (MK_TIME_PHASE >= 0 && F.bid == 0) { const unsigned long long te = __builtin_amdgcn_s_memrealtime(), d = 8ull * F.tacc; while (__builtin_amdgcn_s_memrealtime() - te < d) __builtin_amdgcn_s_sleep(16); }
#undef IN
#undef SEAM
}

extern "C" void kernel_launch(void* const* d_in, const int* in_sizes, int n_in, void* d_out, int out_size, void* d_ws, size_t ws_size, hipStream_t stream) {
    static int grid = 0;
    if (grid == 0) {
        if (n_in != 25 || (size_t)out_size != O_END || ws_size < WS_END) { fprintf(stderr, "kernel_launch: unexpected sizes n_in %d out %d ws %zu (need out %zu ws %zu)\n", n_in, out_size, ws_size, (size_t)O_END, (size_t)WS_END); grid = -1; return; }
        int dev = 0, cus = 0, per_cu = 0;
        hipGetDevice(&dev); hipDeviceGetAttribute(&cus, hipDeviceAttributeMultiprocessorCount, dev);
        if (hipFuncSetAttribute((const void*)fwd_kernel, hipFuncAttributeMaxDynamicSharedMemorySize, LDS_BYTES) != hipSuccess) { fprintf(stderr, "kernel_launch: hipFuncSetAttribute failed\n"); grid = -1; return; }
        hipOccupancyMaxActiveBlocksPerMultiprocessor(&per_cu, (const void*)fwd_kernel, NTHR, LDS_BYTES);
        if (per_cu < 1) { fprintf(stderr, "kernel_launch: occupancy query says %d blocks per CU\n", per_cu); grid = -1; return; }
        grid = cus;
        (void)hipGetLastError();
    }
    if (grid < 0) return;
    Args a{};
    for (int i = 0; i < 25; ++i) a.in[i] = (const float*)d_in[i];
    a.out = (float*)d_out; a.ws = (unsigned char*)d_ws;
#if MK_PER_PHASE
    hipMemsetAsync((char*)d_ws + WS_CTL, 0, CTL_ZERO_BYTES, stream);
    for (int p = 0; p < N_PHASES; ++p) { a.ph_lo = p; a.ph_hi = p + 1; hipLaunchKernelGGL(fwd_kernel, dim3(grid), dim3(NTHR), LDS_BYTES, stream, a); }
#else
    hipMemsetAsync((char*)d_ws + WS_CTL, 0, CTL_ZERO_BYTES, stream);
    a.ph_lo = 0; a.ph_hi = N_PHASES;
    void* kargs[] = {&a};
    hipError_t e = hipLaunchCooperativeKernel((const void*)fwd_kernel, dim3(grid), dim3(NTHR), kargs, LDS_BYTES, stream);
    if (e != hipSuccess) fprintf(stderr, "kernel_launch: cooperative launch failed: %s (grid %d)\n", hipGetErrorString(e), grid);
#endif
}
```

```cpp
#include <hip/hip_runtime.h>
#include <hip/hip_cooperative_groups.h>
#include <cstdio>
#include <cstdint>
namespace cg = cooperative_groups;

#ifndef MK_TIME_PHASE
#define MK_TIME_PHASE (-1)
#endif
#ifndef MK_PER_PHASE
#define MK_PER_PHASE 0
#endif

namespace pg8 {
#define PG8_LAS __attribute__((address_space(3)))
typedef unsigned short bf16_t;
typedef short bf16x8 __attribute__((ext_vector_type(8)));
typedef float f32x4 __attribute__((ext_vector_type(4)));
typedef unsigned u32x4 __attribute__((ext_vector_type(4)));
constexpr int BM = 256, BK = 64, HALF = 128, HTB = HALF * BK * 2  , STAGE_BYTES = 8 * HTB, NXCD = 8, WGM = 8;

__host__ __device__ __forceinline__ int lds_byte(int r, int c) { const int st = (r >> 4) * 2 + (c >> 5), rr = r & 15, cc = c & 31, ob = rr * 64 + cc * 2; return st * 1024 + (ob ^ (((ob >> 9) & 1) << 5)); }
__host__ __device__ __forceinline__ void stage_rc(int b, int& R, int& C) { const int st = b / 1024, sb = b % 1024, swz = sb ^ (((sb >> 9) & 1) << 5); R = (st >> 1) * 16 + swz / 64; C = (st & 1) * 32 + (swz % 64) / 2; }
__host__ __device__ __forceinline__ int perm32(int rho) { const int n = rho >> 4, i = rho & 15; return 8 * (i >> 2) + 4 * n + (i & 3); }

struct Unit { int pm, pn, k0, nk, slice, nsl, tix; };
struct Gemm { const bf16_t* A; const bf16_t* Bt; int M, N, K; };

struct StaticOrder {
    int nM, nN, nwg, G, c, rounds, rem, S, ntK, nSp;
    __host__ __device__ __forceinline__ void init(int M, int N, int K, int G_, int c_, int Smax, int nSp_ = 0) { nM = M / BM; nN = N / BM; nwg = nM * nN; G = G_; c = c_; ntK = K / BK; rounds = nwg / G; rem = nwg - rounds * G; S = 1; nSp = nSp_;
        if (rem) { while (S < Smax && rem * (S * 2) <= G && (ntK / 2) >= S * 2) S *= 2; } }
    __host__ __device__ __forceinline__ void tile(int L, Unit& u) const {
        const int nfirst = nSp * nN;
        if (L < nfirst) { u.pm = nM - nSp + (L % nSp); u.pn = L / nSp; return; }
        const int nMp = nM - nSp, nwp = nMp * nN;
        int wgid = L - nfirst; { const int q = nwp / NXCD, r = nwp % NXCD, xcd = wgid % NXCD, off = wgid / NXCD; wgid = (xcd < r ? xcd * (q + 1) : r * (q + 1) + (xcd - r) * q) + off; }
        const int nig = WGM * nN, gid = wgid / nig, fm = gid * WGM, gsz = (nMp - fm) < WGM ? (nMp - fm) : WGM;
        u.pm = fm + ((wgid % nig) % gsz); u.pn = (wgid % nig) / gsz; }
    __host__ __device__ __forceinline__ bool next(int i, Unit& u) const {
        if (i < rounds) { tile(i * G + c, u); u.k0 = 0; u.nk = ntK; u.slice = 0; u.nsl = 1; u.tix = 0; return true; }
        if (i == rounds && c < rem * S) { const int tix = c % rem, sl = c / rem; tile(rounds * G + tix, u);
            const int pairs = ntK / 2, base = pairs / S, extra = pairs % S, np = base + (sl < extra ? 1 : 0), p0 = sl * base + (sl < extra ? sl : extra);
            u.k0 = 2 * p0; u.nk = 2 * np; u.slice = sl; u.nsl = S; u.tix = tix; return true; }
        return false;
    }
    __device__ __forceinline__ void a_ready(const Unit&) const {}
    __device__ __forceinline__ void done(const Unit&) const {}
};
__device__ __forceinline__ unsigned cvt_pk_bf16(float lo, float hi) { unsigned r; asm volatile("v_cvt_pk_bf16_f32 %0, %1, %2" : "=v"(r) : "v"(lo), "v"(hi)); return r; }
struct SplitCtx { f32x4* slabs; unsigned* cnt; volatile PG8_LAS unsigned* flag; int id; };
__device__ __forceinline__ int split_reduce(f32x4 (&acc)[2][2][4][2], const Unit& u, const SplitCtx& X, int tid) {
    const __amdgpu_buffer_rsrc_t rs = __builtin_amdgcn_make_buffer_rsrc((void*)X.slabs, (short)0, (int)0x7fffffff, 0x00020000);
    typedef unsigned u32x2s __attribute__((ext_vector_type(2)));
    const unsigned mine = (unsigned)((u.tix * u.nsl + u.slice) * 32) * 4096u + (unsigned)tid * 8u;
#pragma unroll
    for (int a = 0; a < 2; ++a)
#pragma unroll
        for (int b = 0; b < 2; ++b)
#pragma unroll
            for (int m = 0; m < 4; ++m)
#pragma unroll
                for (int n = 0; n < 2; ++n) { const f32x4 v = acc[a][b][m][n]; __builtin_amdgcn_raw_buffer_store_b64((u32x2s){cvt_pk_bf16(v.x, v.y), cvt_pk_bf16(v.z, v.w)}, rs, mine + (unsigned)((((a * 2 + b) * 4 + m) * 2 + n) * 4096), 0,   16); }
    asm volatile("s_waitcnt vmcnt(0)" ::: "memory");
    __syncthreads();
    if (tid == 0) {
        unsigned* c = X.cnt + 16 * u.tix;
        (void)__hip_atomic_fetch_add(c, 1u, __ATOMIC_RELAXED, __HIP_MEMORY_SCOPE_AGENT);
        unsigned spins = 0;
        while (__hip_atomic_load(c, __ATOMIC_RELAXED, __HIP_MEMORY_SCOPE_AGENT) < (unsigned)u.nsl) { __builtin_amdgcn_s_sleep(2); if (++spins > (1u << 22)) break; }
        __builtin_amdgcn_fence(__ATOMIC_ACQUIRE, "agent");
        asm volatile("s_waitcnt vmcnt(0)" ::: "memory");
    }
    __syncthreads();
    const int shift = u.nsl == 8 ? 2 : (u.nsl == 4 ? 3 : 4);
    for (int s = 0; s < u.nsl; ++s) { if (s == u.slice) continue;
        const u32x2s* o = (const u32x2s*)X.slabs + ((size_t)(u.tix * u.nsl + s) * 32) * 512 + tid;
#pragma unroll
        for (int a = 0; a < 2; ++a)
#pragma unroll
            for (int b = 0; b < 2; ++b)
#pragma unroll
                for (int m = 0; m < 4; ++m)
#pragma unroll
                    for (int n = 0; n < 2; ++n) { const int r4 = ((a * 2 + b) * 4 + m) * 2 + n; if ((r4 >> shift) == u.slice) { const u32x2s p = o[(size_t)r4 * 512]; acc[a][b][m][n] += (f32x4){__builtin_bit_cast(float, p.x << 16), __builtin_bit_cast(float, p.x & 0xffff0000u), __builtin_bit_cast(float, p.y << 16), __builtin_bit_cast(float, p.y & 0xffff0000u)}; } } }
    return shift;
}


struct EpiF32 {
    static constexpr bool PERM = false, AFTER_DRAIN = false;
    float* C; int ldc;
    __device__ __forceinline__ void operator()(const f32x4 (&acc)[2][2][4][2], const Unit& u, int wr, int wc, int fr, int fq, int shift, int part) const {
        const int row0 = u.pm * BM + wr * 64 + fr, col0 = u.pn * BM + wc * 32 + 4 * fq;
#pragma unroll
        for (int ai = 0; ai < 2; ++ai)
#pragma unroll
            for (int m = 0; m < 4; ++m) { float* rowp = C + (size_t)(row0 + ai * HALF + m * 16) * ldc + col0;
#pragma unroll
                for (int bj = 0; bj < 2; ++bj)
#pragma unroll
                    for (int n = 0; n < 2; ++n) if ((((((ai * 2 + bj) * 4 + m) * 2 + n)) >> shift) == part) *(f32x4*)(rowp + bj * HALF + n * 16) = acc[ai][bj][m][n]; }
    }
};
struct EpiBf16 {
    static constexpr bool PERM = true, AFTER_DRAIN = false;
    bf16_t* O; int ldc; int nfull; float* X;
    __device__ __forceinline__ void operator()(const f32x4 (&acc)[2][2][4][2], const Unit& u, int wr, int wc, int fr, int fq, int shift, int part) const {
        const int row0 = u.pm * BM + wr * 64 + fr;
        if (u.pn < nfull) {
            const int col0 = u.pn * BM + wc * 32 + 8 * fq;
#pragma unroll
            for (int ai = 0; ai < 2; ++ai)
#pragma unroll
                for (int m = 0; m < 4; ++m) { bf16_t* rowp = O + (size_t)(row0 + ai * HALF + m * 16) * ldc + col0;
#pragma unroll
                    for (int bj = 0; bj < 2; ++bj) { if ((((((ai * 2 + bj) * 4 + m) * 2)) >> shift) != part) continue; const f32x4 v0 = acc[ai][bj][m][0], v1 = acc[ai][bj][m][1];
                        u32x4 w; w.x = cvt_pk_bf16(v0[0], v0[1]); w.y = cvt_pk_bf16(v0[2], v0[3]); w.z = cvt_pk_bf16(v1[0], v1[1]); w.w = cvt_pk_bf16(v1[2], v1[3]);
                        *(u32x4*)(rowp + bj * HALF) = w; } }
        } else if (wc == 0) {
#pragma unroll
            for (int ai = 0; ai < 2; ++ai)
#pragma unroll
                for (int m = 0; m < 4; ++m) { if ((((((ai * 2) * 4 + m) * 2)) >> shift) != part) continue; float* rowp = X + (size_t)(row0 + ai * HALF + m * 16) * 32 + 8 * fq;
                    *(f32x4*)(rowp) = acc[ai][0][m][0]; *(f32x4*)(rowp + 4) = acc[ai][0][m][1]; }
        }
    }
};

__device__ __forceinline__ float dpp_ror1(float x) { return __builtin_bit_cast(float, __builtin_amdgcn_update_dpp(0, __builtin_bit_cast(int, x), 0x121, 0xF, 0xF, false)); }
__device__ __forceinline__ float dpp_ror2(float x) { return __builtin_bit_cast(float, __builtin_amdgcn_update_dpp(0, __builtin_bit_cast(int, x), 0x122, 0xF, 0xF, false)); }
struct EpiConvAct {
    static constexpr bool PERM = true, AFTER_DRAIN = false;
    static constexpr int FFD = 5632, FFD2 = 11264, MPR = 8192, NPT = 32;
    bf16_t* ACT; float* HG; const float* cw; const float* cbias; const float* st; float* fconv_s; PG8_LAS float* halo;
    __device__ __forceinline__ void operator()(const f32x4 (&acc)[2][2][4][2], const Unit& u, int wr, int wc, int fr, int fq, int, int) const {
        if (u.pm >= NPT) body<true>(acc, u, wr, wc, fr, fq); else body<false>(acc, u, wr, wc, fr, fq); }
    template <bool sample> __device__ __forceinline__ void body(const f32x4 (&acc)[2][2][4][2], const Unit& u, int wr, int wc, int fr, int fq) const {
        const int pm = u.pm, pn = u.pn, cl = wc * 32 + 8 * fq, c0 = pn * 128 + cl;
        if (fr >= 14) {
#pragma unroll
            for (int ai = 0; ai < 2; ++ai)
#pragma unroll
                for (int bj = 0; bj < 2; ++bj)
#pragma unroll
                    for (int n = 0; n < 2; ++n) *(PG8_LAS f32x4*)(halo + ((ai * 2 + wr) * 2 + (fr - 14)) * 256 + bj * 128 + cl + 4 * n) = acc[ai][bj][3][n];
            if (!sample && wr == 1) {
#pragma unroll
                for (int bj = 0; bj < 2; ++bj)
#pragma unroll
                    for (int n = 0; n < 2; ++n) *(f32x4*)(HG + ((size_t)pm * 4 + 2 + (fr - 14)) * FFD2 + bj * FFD + c0 + 4 * n) = acc[1][bj][3][n]; }
        }
        if (fr < 2 && !sample && wr == 0) {
#pragma unroll
            for (int bj = 0; bj < 2; ++bj)
#pragma unroll
                for (int n = 0; n < 2; ++n) *(f32x4*)(HG + ((size_t)pm * 4 + fr) * FFD2 + bj * FFD + c0 + 4 * n) = acc[0][bj][0][n]; }
        __syncthreads();
        const int t8 = fr & 7;
        typedef unsigned u32x2 __attribute__((ext_vector_type(2)));
        u32x2 pk0[2][4];
#pragma unroll
        for (int n = 0; n < 2; ++n) {
            f32x4 w[2][3], bs[2];
#pragma unroll
            for (int bj = 0; bj < 2; ++bj) { bs[bj] = *(const f32x4*)(cbias + bj * FFD + c0 + 4 * n);
#pragma unroll
                for (int j = 0; j < 3; ++j) w[bj][j] = *(const f32x4*)(cw + j * FFD2 + bj * FFD + c0 + 4 * n); }
#pragma unroll
            for (int ai = 0; ai < 2; ++ai) {
                f32x4 r1p[2], r2p[2];
#pragma unroll
                for (int bj = 0; bj < 2; ++bj) { f32x4 pv = (f32x4){0.f, 0.f, 0.f, 0.f};
                    if (fr >= 14 && (wr == 1 || ai == 1)) { const int pa = (wr == 1) ? ai : 0, pw = (wr == 1) ? 0 : 1; pv = *(const PG8_LAS f32x4*)(halo + ((pa * 2 + pw) * 2 + (fr - 14)) * 256 + bj * 128 + cl + 4 * n); }
#pragma unroll
                    for (int j = 0; j < 4; ++j) { r1p[bj][j] = dpp_ror1(pv[j]); r2p[bj][j] = dpp_ror2(pv[j]); } }
#pragma unroll
                for (int m = 0; m < 4; ++m) { const int row = pm * BM + ai * HALF + wr * 64 + m * 16 + fr;
                    f32x4 o[2];
#pragma unroll
                    for (int bj = 0; bj < 2; ++bj) { const f32x4 cur = acc[ai][bj][m][n]; f32x4 p1, p2;
#pragma unroll
                        for (int j = 0; j < 4; ++j) { const float c1 = dpp_ror1(cur[j]), c2 = dpp_ror2(cur[j]); p1[j] = (fr == 0) ? r1p[bj][j] : c1; p2[j] = (fr < 2) ? r2p[bj][j] : c2; r1p[bj][j] = c1; r2p[bj][j] = c2; }
                        if (sample && t8 < 2) { const int sb = (row - MPR) >> 3; const f32x4 s1 = *(const f32x4*)(st + ((size_t)sb * 2 + 1) * FFD2 + bj * FFD + c0 + 4 * n);
                            if (t8 == 0) { p1 = s1; p2 = *(const f32x4*)(st + ((size_t)sb * 2) * FFD2 + bj * FFD + c0 + 4 * n); } else p2 = s1; }
                        o[bj] = bs[bj] + w[bj][0] * p2 + w[bj][1] * p1 + w[bj][2] * cur; }
                    f32x4 g; g.x = o[0].x * __builtin_amdgcn_rcpf(1.f + __expf(-o[0].x)) * o[1].x; g.y = o[0].y * __builtin_amdgcn_rcpf(1.f + __expf(-o[0].y)) * o[1].y;
                    g.z = o[0].z * __builtin_amdgcn_rcpf(1.f + __expf(-o[0].z)) * o[1].z; g.w = o[0].w * __builtin_amdgcn_rcpf(1.f + __expf(-o[0].w)) * o[1].w;
                    const u32x2 pk = (u32x2){cvt_pk_bf16(g.x, g.y), cvt_pk_bf16(g.z, g.w)};
                    if (n == 0) pk0[ai][m] = pk;
                    else *(u32x4*)(ACT + (size_t)row * FFD + c0) = (u32x4){pk0[ai][m].x, pk0[ai][m].y, pk.x, pk.y};
                    if (sample && t8 >= 6) { const int sb = (row - MPR) >> 3;
#pragma unroll
                        for (int bj = 0; bj < 2; ++bj) *(f32x4*)(fconv_s + ((size_t)sb * 2 + (t8 - 6)) * FFD2 + bj * FFD + c0 + 4 * n) = acc[ai][bj][m][n]; }
                }
            }
        }
    }
};

template <class Epi, class Sched, bool ALIGN_EPI = false, bool SP2 = false>
__device__ __forceinline__ void gemm_phase(PG8_LAS unsigned char* lds, const Gemm g, const Sched& S, const Epi& E, const SplitCtx& X) {
    const int tid = threadIdx.x, wid = __builtin_amdgcn_readfirstlane(tid >> 6), lane = tid & 63, wr = wid >> 2, wc = wid & 3, fr = lane & 15, fq = lane >> 4;
    const int K = g.K;
    unsigned voffA[2], voffB[2];
#pragma unroll
    for (int i = 0; i < 2; ++i) { int R, C; stage_rc(tid * 16 + i * 8192, R, C); const int Rb = Epi::PERM ? ((R & ~31) + perm32(R & 31)) : R;
        voffA[i] = (unsigned)(R * K + C) * 2u; voffB[i] = (unsigned)(Rb * K + C) * 2u; }
    const size_t kstep = (size_t)(BK * 2);
    const size_t hstep = (size_t)HALF * K * 2;
    const size_t tstep = 2 * hstep;
    const unsigned ldsw = (unsigned)wid * 1024u;
    const int aoff = lds_byte(wr * 64 + fr, fq * 8), boff = lds_byte(wc * 32 + fr, fq * 8);
#define PG8_SA(b, h) (((b) * 2 + (h)) * HTB)
#define PG8_SB(b, h) ((4 + (b) * 2 + (h)) * HTB)
#define PG8_STAGE(bufoff, gbase, voff) do { _Pragma("unroll") for (int _i = 0; _i < 2; ++_i) \
        __builtin_amdgcn_global_load_lds((const unsigned*)((const char*)(gbase) + (voff)[_i]), (PG8_LAS unsigned*)(lds + (bufoff) + ldsw + _i * 8192), 16, 0, 0); } while (0)
#define PG8_LDA(dst, b, h) do { _Pragma("unroll") for (int m = 0; m < 4; ++m) _Pragma("unroll") for (int k = 0; k < 2; ++k) dst[m][k] = *(const PG8_LAS bf16x8*)(lds + PG8_SA(b, h) + aoff + m * 2048 + k * 1024); } while (0)
#define PG8_LDB(dst, b, h) do { _Pragma("unroll") for (int n = 0; n < 2; ++n) _Pragma("unroll") for (int k = 0; k < 2; ++k) dst[n][k] = *(const PG8_LAS bf16x8*)(lds + PG8_SB(b, h) + boff + n * 2048 + k * 1024); } while (0)
#define PG8_MMA(ai, bj, At, Bt) do { __builtin_amdgcn_s_setprio(1); _Pragma("unroll") for (int m = 0; m < 4; ++m) _Pragma("unroll") for (int n = 0; n < 2; ++n) _Pragma("unroll") for (int k = 0; k < 2; ++k) \
        acc[ai][bj][m][n] = __builtin_amdgcn_mfma_f32_16x16x32_bf16(Bt[n][k], At[m][k], acc[ai][bj][m][n], 0, 0, 0); __builtin_amdgcn_s_setprio(0); } while (0)
#define PG8_WAIT_V(n) asm volatile("s_waitcnt vmcnt(" #n ")" ::: "memory")
#define PG8_WAIT_L(n) asm volatile("s_waitcnt lgkmcnt(" #n ")" ::: "memory")
#define PG8_BAR __builtin_amdgcn_s_barrier()
#define PG8_SCHED __builtin_amdgcn_sched_barrier(0)
    Unit cur, nxt; int ui = 0;
    if (!S.next(0, cur)) return;
    f32x4 acc[2][2][4][2];
#pragma unroll
    for (int a = 0; a < 2; ++a)
#pragma unroll
        for (int b = 0; b < 2; ++b)
#pragma unroll
            for (int m = 0; m < 4; ++m)
#pragma unroll
                for (int n = 0; n < 2; ++n) acc[a][b][m][n] = (f32x4){0.f, 0.f, 0.f, 0.f};
    bf16x8 At[4][2], B0[2][2], B1[2][2];
    const char* cA = (const char*)g.A + (size_t)cur.pm * tstep + (size_t)cur.k0 * kstep; const char* cB = (const char*)g.Bt + (size_t)cur.pn * tstep + (size_t)cur.k0 * kstep;
    S.a_ready(cur);
    if constexpr (SP2) {
        PG8_STAGE(PG8_SB(0, 0), cB, voffB); PG8_STAGE(PG8_SB(0, 1), cB + hstep, voffB); PG8_STAGE(PG8_SA(0, 0), cA, voffA); PG8_STAGE(PG8_SA(0, 1), cA + hstep, voffA);
        if (wr == 1) PG8_BAR;
        PG8_WAIT_V(2); PG8_BAR;
        PG8_STAGE(PG8_SB(1, 0), cB + kstep, voffB); PG8_STAGE(PG8_SA(1, 0), cA + kstep, voffA); PG8_STAGE(PG8_SB(1, 1), cB + hstep + kstep, voffB);
        PG8_WAIT_V(6); PG8_BAR;
    } else {
        PG8_STAGE(PG8_SB(0, 0), cB, voffB); PG8_STAGE(PG8_SA(0, 0), cA, voffA); PG8_STAGE(PG8_SB(0, 1), cB + hstep, voffB); PG8_STAGE(PG8_SA(0, 1), cA + hstep, voffA);
        if (wr == 1) PG8_BAR;
        PG8_WAIT_V(4); PG8_BAR;
        PG8_STAGE(PG8_SB(1, 0), cB + kstep, voffB); PG8_STAGE(PG8_SA(1, 0), cA + kstep, voffA); PG8_STAGE(PG8_SB(1, 1), cB + hstep + kstep, voffB);
        PG8_WAIT_V(6); PG8_BAR;
    }
    for (;;) {
        const bool has_next = S.next(ui + 1, nxt);
        const char* nA = has_next ? (const char*)g.A + (size_t)nxt.pm * tstep + (size_t)nxt.k0 * kstep : cA; const char* nB = has_next ? (const char*)g.Bt + (size_t)nxt.pn * tstep + (size_t)nxt.k0 * kstep : cB;
        const int nt = cur.nk;
        unsigned long long tsu = 0; if (MK_TIME_PHASE == 50 + X.id && cur.nsl > 1) tsu = __builtin_amdgcn_s_memrealtime();
        for (int t = 0; t < nt; t += 2) {
            const bool last = (t == nt - 2);
            const char* a1 = cA + (size_t)(t + 1) * kstep;
            const char* a2 = last ? nA : cA + (size_t)(t + 2) * kstep; const char* b2 = last ? nB : cB + (size_t)(t + 2) * kstep;
            const char* a3 = a2 + kstep; const char* b3 = b2 + kstep;
            if (last && has_next) S.a_ready(nxt);
            if constexpr (SP2) {
            PG8_LDB(B0, 0, 0); PG8_LDB(B1, 0, 1); PG8_SCHED; PG8_LDA(At, 0, 0); PG8_STAGE(PG8_SA(1, 1), a1 + hstep, voffA);
            PG8_WAIT_V(8); PG8_WAIT_L(0); PG8_BAR; PG8_MMA(0, 0, At, B0); PG8_MMA(0, 1, At, B1); PG8_BAR; PG8_SCHED;
            PG8_LDA(At, 0, 1); PG8_STAGE(PG8_SB(0, 0), b2, voffB); PG8_STAGE(PG8_SB(0, 1), b2 + hstep, voffB); PG8_STAGE(PG8_SA(0, 0), a2, voffA);
            PG8_WAIT_V(8); PG8_WAIT_L(0); PG8_BAR; PG8_MMA(1, 0, At, B0); PG8_MMA(1, 1, At, B1); PG8_BAR; PG8_SCHED;
            PG8_LDB(B0, 1, 0); PG8_LDB(B1, 1, 1); PG8_SCHED; PG8_LDA(At, 1, 0); PG8_STAGE(PG8_SA(0, 1), a2 + hstep, voffA);
            PG8_WAIT_V(8); PG8_WAIT_L(0); PG8_BAR; PG8_MMA(0, 0, At, B0); PG8_MMA(0, 1, At, B1); PG8_BAR; PG8_SCHED;
            PG8_LDA(At, 1, 1); PG8_STAGE(PG8_SB(1, 0), b3, voffB); PG8_STAGE(PG8_SB(1, 1), b3 + hstep, voffB); PG8_STAGE(PG8_SA(1, 0), a3, voffA);
            PG8_WAIT_V(8); PG8_WAIT_L(0); PG8_BAR; PG8_MMA(1, 0, At, B0); PG8_MMA(1, 1, At, B1); PG8_BAR; PG8_SCHED;
            } else {
            PG8_LDB(B0, 0, 0); PG8_SCHED; PG8_LDA(At, 0, 0); PG8_STAGE(PG8_SA(1, 1), a1 + hstep, voffA);
            PG8_WAIT_L(8); PG8_BAR; PG8_WAIT_L(0); PG8_MMA(0, 0, At, B0); PG8_BAR; PG8_SCHED;
            PG8_LDB(B1, 0, 1); PG8_STAGE(PG8_SB(0, 0), b2, voffB);
            PG8_BAR; PG8_WAIT_L(0); PG8_MMA(0, 1, At, B1); PG8_BAR;
            PG8_LDA(At, 0, 1); PG8_STAGE(PG8_SA(0, 0), a2, voffA);
            PG8_BAR; PG8_WAIT_L(0); PG8_MMA(1, 0, At, B0); PG8_BAR; PG8_SCHED;
            PG8_STAGE(PG8_SB(0, 1), b2 + hstep, voffB);
            PG8_WAIT_V(6); PG8_BAR; PG8_MMA(1, 1, At, B1); PG8_BAR;
            PG8_LDB(B0, 1, 0); PG8_SCHED; PG8_LDA(At, 1, 0); PG8_STAGE(PG8_SA(0, 1), a2 + hstep, voffA);
            PG8_WAIT_L(8); PG8_BAR; PG8_WAIT_L(0); PG8_MMA(0, 0, At, B0); PG8_BAR; PG8_SCHED;
            PG8_LDB(B1, 1, 1); PG8_STAGE(PG8_SB(1, 0), b3, voffB);
            PG8_BAR; PG8_WAIT_L(0); PG8_MMA(0, 1, At, B1); PG8_BAR;
            PG8_LDA(At, 1, 1); PG8_STAGE(PG8_SA(1, 0), a3, voffA);
            PG8_BAR; PG8_WAIT_L(0); PG8_MMA(1, 0, At, B0); PG8_BAR; PG8_SCHED;
            PG8_STAGE(PG8_SB(1, 1), b3 + hstep, voffB);
            PG8_WAIT_V(6); PG8_BAR; PG8_MMA(1, 1, At, B1); PG8_BAR;
            }
        }
        if constexpr (ALIGN_EPI) { if (wr == 0) PG8_BAR; }
        if constexpr (!Epi::AFTER_DRAIN) { static_assert(ALIGN_EPI, "split_reduce needs the halves aligned"); if (cur.nsl > 1) { const int shift = split_reduce(acc, cur, X, tid); E(acc, cur, wr, wc, fr, fq, shift, cur.slice); } else { unsigned long long te0 = 0; if (MK_TIME_PHASE == 60 + X.id) te0 = __builtin_amdgcn_s_memrealtime(); E(acc, cur, wr, wc, fr, fq, 5, 0); if (MK_TIME_PHASE == 60 + X.id && tid == 0) { asm volatile("s_waitcnt vmcnt(0)" ::: "memory"); X.flag[2] += (unsigned)(__builtin_amdgcn_s_memrealtime() - te0); } } S.done(cur);
            if (MK_TIME_PHASE == 50 + X.id && cur.nsl > 1 && tid == 0) { asm volatile("s_waitcnt vmcnt(0)" ::: "memory"); const unsigned long long d = __builtin_amdgcn_s_memrealtime() - tsu; X.flag[2] = (unsigned)d; } }
        if (!has_next) break;
#pragma unroll
        for (int a = 0; a < 2; ++a)
#pragma unroll
            for (int b = 0; b < 2; ++b)
#pragma unroll
                for (int m = 0; m < 4; ++m)
#pragma unroll
                    for (int n = 0; n < 2; ++n) acc[a][b][m][n] = (f32x4){0.f, 0.f, 0.f, 0.f};
        cur = nxt; cA = nA; cB = nB; ++ui;
        if constexpr (ALIGN_EPI) { if (wr == 1) PG8_BAR; }
    }
    PG8_WAIT_V(0);
    if constexpr (!ALIGN_EPI) { if (wr == 0) PG8_BAR; }
    PG8_BAR;
    if constexpr (Epi::AFTER_DRAIN) { E.fused(acc, cur, wr, wc, fr, fq, lds, wid, lane); S.done(cur); }
#undef PG8_SA
#undef PG8_SB
#undef PG8_STAGE
#undef PG8_LDA
#undef PG8_LDB
#undef PG8_MMA
#undef PG8_WAIT_V
#undef PG8_WAIT_L
#undef PG8_BAR
#undef PG8_SCHED
}
}

constexpr int NWAVES = 8, NTHR = 512;
constexpr int DM = 2048, PB = 4, PL = 2048, SB = 128, SL = 8;
constexpr int MP = PB * PL, MS = SB * SL, M = MP + MS;
constexpr int GH = 4, GK = 128, GV = 256, GKD = 512, LOWR = 16;
constexpr int SH = 16, SP = 64, SN = 128, SG = 2, SCH = 1536;
constexpr int FF = 5632, FF2 = 11264, INC = 5664;
constexpr int N1 = 5888, NP = 5632;
constexpr int CQ = 0, CK = 512, CV = 1024, CG = 2048, CZ = 3072, CX = 4096;
constexpr float EPS = 1e-6f;
constexpr int N_PHASES = 11;

constexpr size_t O_Y = 0, O_GLA_P = (size_t)M * DM, O_SSD_P = O_GLA_P + (size_t)PB * GH * GK * GV, O_SCONV_P = O_SSD_P + (size_t)PB * SH * SP * SN,
                 O_FCONV_P = O_SCONV_P + (size_t)PB * 3 * SCH, O_GLA_S = O_FCONV_P + (size_t)PB * 2 * FF2, O_SSD_S = O_GLA_S + (size_t)SB * GH * GK * GV,
                 O_SCONV_S = O_SSD_S + (size_t)SB * SH * SP * SN, O_FCONV_S = O_SCONV_S + (size_t)SB * 3 * SCH, O_END = O_FCONV_S + (size_t)SB * 2 * FF2;

constexpr size_t MiB = 1u << 20;
constexpr size_t WS_CTL = 0, CTL_ZERO_BYTES = 64 * 1024;
constexpr size_t WS_WF2 = 1 * MiB;
constexpr size_t WS_W1 = 24 * MiB;
constexpr size_t WS_WO = 48 * MiB;
constexpr size_t WS_WF1 = 56 * MiB;
constexpr size_t WS_XN = 101 * MiB;
constexpr size_t WS_F = 24 * MiB;
constexpr size_t WS_BIG = 141 * MiB;
constexpr size_t WS_PROJ = WS_BIG;
constexpr size_t WS_MIX = WS_BIG;
constexpr size_t WS_ACT = WS_BIG;
constexpr size_t WS_HG = WS_BIG + 104 * MiB;
constexpr size_t WS_LRDT = WS_BIG + 100 * MiB;
constexpr size_t WS_MIXIN = WS_BIG + 104 * MiB;
constexpr size_t WS_DS = WS_XN;
constexpr size_t WS_SC = WS_BIG + 140 * MiB, WS_DH = WS_BIG + 172 * MiB, WS_HC = WS_BIG + 204 * MiB;
constexpr size_t WS_EBL = WS_BIG + 236 * MiB, WS_AL = WS_EBL + 512 * 1024;
constexpr size_t WS_SLAB = WS_BIG + 140 * MiB;
constexpr size_t WS_SLAB_F1 = WS_BIG + 198 * MiB;
constexpr size_t WS_QEG = WS_BIG + 238 * MiB, WS_KEG = WS_BIG + 246 * MiB;
constexpr size_t WS_END = WS_BIG + 254 * MiB;
static_assert(WS_WF2 + (size_t)DM * FF * 2 <= WS_W1 && WS_W1 + (size_t)N1 * DM * 2 <= WS_WO && WS_WO + (size_t)DM * DM * 2 <= WS_WF1 && WS_WF1 + (size_t)FF2 * DM * 2 <= WS_XN && WS_XN + (size_t)M * DM * 2 <= WS_BIG, "ws map 1");
static_assert(WS_F + (size_t)M * DM * 4 <= WS_XN && WS_ACT + (size_t)M * FF * 2 <= WS_HG && WS_PROJ + (size_t)M * NP * 2 <= WS_LRDT && WS_LRDT + (size_t)M * 32 * 4 <= WS_MIXIN && WS_MIXIN + (size_t)M * DM * 2 <= WS_SC && WS_HG + (size_t)32 * 4 * FF2 * 4 <= WS_SC && WS_MIX + (size_t)M * DM * 4 <= WS_LRDT, "ws map 2");
constexpr int CW_BAR = 1024;
constexpr int CW_SPLIT = 8192;

constexpr int RING_BYTES = 131072;
constexpr int SCRATCH_BYTES = 8 * 16640;
constexpr int LDSCTL_OFF = 133632, MISC_OFF = LDSCTL_OFF + 320;
constexpr int LDS_BYTES = 150016;

#ifndef MK_TIME_PHASE
#define MK_TIME_PHASE (-1)
#endif
#define TBEGIN(F, id) do { if (MK_TIME_PHASE == (id)) (F).tmark = __builtin_amdgcn_s_memrealtime(); } while (0)
#define TEND(F, id) do { if (MK_TIME_PHASE == (id)) (F).tacc += __builtin_amdgcn_s_memrealtime() - (F).tmark; } while (0)
#define GAS __attribute__((address_space(1)))
#define LAS __attribute__((address_space(3)))
typedef unsigned short bf16;
typedef unsigned v4u __attribute__((ext_vector_type(4)));
typedef unsigned v2u __attribute__((ext_vector_type(2)));
typedef float f32x4 __attribute__((ext_vector_type(4)));
#define LDS_WAIT() asm volatile("s_waitcnt lgkmcnt(0)" ::: "memory")
#define VM_WAIT() asm volatile("s_waitcnt vmcnt(0)" ::: "memory")
typedef float f32x2c __attribute__((ext_vector_type(2)));
typedef __bf16 bf16x2c __attribute__((ext_vector_type(2)));
__device__ __forceinline__ unsigned f2bf(float f) { return (unsigned)__builtin_bit_cast(unsigned short, (__bf16)f); }
__device__ __forceinline__ unsigned pk2(float lo, float hi) { return __builtin_bit_cast(unsigned, __builtin_convertvector((f32x2c){lo, hi}, bf16x2c)); }
__device__ __forceinline__ float bf2f(unsigned short b) { return __builtin_bit_cast(float, (unsigned)b << 16); }
__device__ __forceinline__ float bflo(unsigned w) { return __builtin_bit_cast(float, w << 16); }
__device__ __forceinline__ float bfhi(unsigned w) { return __builtin_bit_cast(float, w & 0xffff0000u); }
__device__ __forceinline__ float silu_f(float x) { return x * __builtin_amdgcn_rcpf(1.f + __expf(-x)); }
__device__ __forceinline__ float softplus_f(float x) { return fmaxf(x, 0.f) + __logf(1.f + __expf(-fabsf(x))); }
__device__ __forceinline__ float logsigmoid_f(float x) { return fminf(x, 0.f) - __logf(1.f + __expf(-fabsf(x))); }
__device__ __forceinline__ float wave_sum(float v) {
#pragma unroll
    for (int o = 1; o < 64; o <<= 1) v += __shfl_xor(v, o);
    return v;
}

#define XB_TMO      128
#define XB_XCNT(j)  (256  + 64 * (j))
#define XB_XSUB(j)  (1280 + 64 * (j))
#define XB_XGEN(j)  (2304 + 64 * (j))
#define XB_TOP      3328
#define XB_TOPGEN   3392
#define XCD_BAR_WORDS 3456
#define XB_SPIN_CAP (1u << 18)

__device__ __forceinline__ unsigned xb_ld(unsigned* p)              { return __hip_atomic_load(p, __ATOMIC_RELAXED, __HIP_MEMORY_SCOPE_AGENT); }
__device__ __forceinline__ unsigned xb_add(unsigned* p, unsigned v) { return __hip_atomic_fetch_add(p, v, __ATOMIC_RELAXED, __HIP_MEMORY_SCOPE_AGENT); }
__device__ __forceinline__ unsigned xb_xcc_id() { return (unsigned)__builtin_amdgcn_s_getreg((3 << 11) | 20) & 0xFu; }
#define XB_SPIN(cond, bar) do { unsigned _sp = 0; while (cond) { __builtin_amdgcn_s_sleep(1); \
    if ((++_sp & 255u) == 0u) { if (xb_ld(&(bar)[XB_TMO])) break; if (_sp > XB_SPIN_CAP) { atomicAdd(&(bar)[XB_TMO], 1u); break; } } } } while (0)

struct XcdBarrier {
    unsigned* bar; unsigned x;
    volatile LAS unsigned* st;
};

__device__ __forceinline__ XcdBarrier xcd_barrier_post(unsigned* bar, volatile LAS unsigned* st) {
    XcdBarrier b; b.bar = bar; b.x = xb_xcc_id(); b.st = st;
    if (threadIdx.x == 0) (void)xb_add(&bar[XB_XCNT(b.x)], 1u);
    return b;
}
__device__ __forceinline__ void xcd_barrier_complete(unsigned* bar, unsigned x, unsigned& nloc, unsigned& nx) {
    const unsigned G = gridDim.x * gridDim.y * gridDim.z;
    unsigned sum, cnt, mine, sp = 0u;
    for (;;) {
        sum = 0u; cnt = 0u; mine = 0u;
#pragma unroll
        for (unsigned j = 0; j < 16; ++j) { const unsigned c = xb_ld(&bar[XB_XCNT(j)]); sum += c; cnt += (c > 0u) ? 1u : 0u; mine = (j == x) ? c : mine; }
        if (sum == G) break;
        __builtin_amdgcn_s_sleep(1);
        if ((++sp & 255u) == 0u) { if (xb_ld(&bar[XB_TMO])) break; if (sp > XB_SPIN_CAP) { atomicAdd(&bar[XB_TMO], 1u); break; } }
    }
    nloc = mine > 0u ? mine : 1u; nx = cnt > 0u ? cnt : 1u;
}

__device__ __forceinline__ void xcd_barrier(const XcdBarrier& b) {
    asm volatile("s_waitcnt vmcnt(0)" ::: "memory");
    __syncthreads();
    if (threadIdx.x == 0) {
        unsigned* bar = b.bar;
        __builtin_amdgcn_s_waitcnt(0);
        unsigned nloc = b.st[0], nx = b.st[1];
        if (nloc == 0u) { xcd_barrier_complete(bar, b.x, nloc, nx); b.st[0] = nloc; b.st[1] = nx; }
        const unsigned old = xb_add(&bar[XB_XSUB(b.x)], 1u);
        const unsigned gen = old / nloc;
        if (old + 1u == (gen + 1u) * nloc) {
            __builtin_amdgcn_fence(__ATOMIC_RELEASE, "agent");
            asm volatile("s_waitcnt vmcnt(0)" ::: "memory");
            const unsigned og = xb_add(&bar[XB_TOP], 1u);
            const unsigned tg = og / nx;
            if (og + 1u == (tg + 1u) * nx) xb_add(&bar[XB_TOPGEN], 1u);
            else XB_SPIN(xb_ld(&bar[XB_TOPGEN]) == tg, bar);
            __builtin_amdgcn_fence(__ATOMIC_ACQUIRE, "agent");
            xb_add(&bar[XB_XGEN(b.x)], 1u);
            asm volatile("s_waitcnt vmcnt(0)" ::: "memory");
        } else {
            XB_SPIN(xb_ld(&bar[XB_XGEN(b.x)]) == gen, bar);
            __builtin_amdgcn_fence(__ATOMIC_ACQUIRE, "agent");
            asm volatile("s_waitcnt vmcnt(0)" ::: "memory");
        }
    }
    __syncthreads();
}

struct Frame {
    LAS unsigned char* lds;
    int tid, lane, wave, G, bid;
    unsigned long long tacc, tmark;
    const float *x_p, *x_s, *st_gla, *st_ssd, *st_sconv, *st_fconv, *n_mix_pre, *n_mix_post, *n_ffn_pre, *n_ffn_post, *w_in, *w_gate2, *b_gate, *gla_norm,
                *sconv_w, *sconv_b, *dt_bias, *A_log, *ssd_D, *ssd_norm, *w_out, *ffn_w_in, *fconv_w, *fconv_b, *ffn_w_out;
    float* out;
    bf16 *W1, *WO, *WF1, *WF2, *XN, *PROJ, *MIXIN, *ACT, *DS, *SC, *DH, *HC, *QEg, *KEg;
    float *LRDT, *MIX, *Fb, *EBL, *AL, *HG;
};
__device__ __forceinline__ const float* x_row(const Frame& F, int row) { return row < MP ? F.x_p + (size_t)row * DM : F.x_s + (size_t)(row - MP) * DM; }

__device__ __forceinline__ int w1_src_col(int n) { return n < 3072 ? n : (n < 5632 ? n + 16 : (n < 5648 ? n - 2560 : (n < 5664 ? n : -1))); }
struct TDesc { const float* W; bf16* WT; int K, Nsrc, Ndst, map, item; };
__device__ __forceinline__ void t_load(const TDesc& d, int lane, f32x4 (&v)[16]) {
    const int nblk = d.Ndst / 64, kb = d.item / nblk, nb = d.item % nblk, k0 = 64 * kb, n0 = 64 * nb;
    int sc = n0 + 4 * (lane & 15); if (d.map == 1) sc = w1_src_col(sc); if (d.map == 2) sc = ((sc >> 7) & 1) * FF + 128 * (sc >> 8) + (sc & 127);
#pragma unroll
    for (int i = 0; i < 16; ++i) { const int kk = 4 * i + (lane >> 4); v[i] = (sc >= 0) ? *(const f32x4*)(d.W + (size_t)(k0 + kk) * d.Nsrc + sc) : (f32x4){0.f, 0.f, 0.f, 0.f}; }
}
__device__ __forceinline__ void t_store(const TDesc& d, int lane, LAS float* scr, const f32x4 (&v)[16]) {
    const int nblk = d.Ndst / 64, kb = d.item / nblk, nb = d.item % nblk, k0 = 64 * kb, n0 = 64 * nb;
#pragma unroll
    for (int i = 0; i < 16; ++i) { const int kk = 4 * i + (lane >> 4); LAS float* p = scr + kk * 65 + 4 * (lane & 15); p[0] = v[i].x; p[1] = v[i].y; p[2] = v[i].z; p[3] = v[i].w; }
    LDS_WAIT(); asm volatile("" ::: "memory");
    const int c = lane & 7;
#pragma unroll
    for (int j = 0; j < 8; ++j) { const int n = (lane >> 3) + 8 * j; const LAS float* s = scr + (8 * c) * 65 + n;
        v4u o; o.x = pk2(s[0 * 65], s[1 * 65]); o.y = pk2(s[2 * 65], s[3 * 65]); o.z = pk2(s[4 * 65], s[5 * 65]); o.w = pk2(s[6 * 65], s[7 * 65]);
        *(v4u*)(d.WT + (size_t)(n0 + n) * d.K + k0 + 8 * c) = o; }
    LDS_WAIT(); asm volatile("" ::: "memory");
}
__device__ __forceinline__ bool t_desc(const Frame& F, int which, int it, TDesc& d) {
    constexpr int I_1 = (DM / 64) * (N1 / 64), I_O = (DM / 64) * (DM / 64), I_F1 = (DM / 64) * (FF2 / 64), I_F2 = (FF / 64) * (DM / 64);
    if (which == 0) { if (it >= I_1) return false; d = TDesc{F.w_in, F.W1, DM, INC, N1, 1, it}; return true; }
    if (it >= I_O + I_F1 + I_F2) return false;
    if (it < I_O) d = TDesc{F.w_out, F.WO, DM, DM, DM, 0, it};
    else if (it < I_O + I_F1) d = TDesc{F.ffn_w_in, F.WF1, DM, FF2, FF2, 2, it - I_O};
    else d = TDesc{F.ffn_w_out, F.WF2, FF, DM, DM, 0, it - I_O - I_F1};
    return true;
}
__device__ __forceinline__ void t_run(const Frame& F, int which, int gw, int NGW) {
    LAS float* scr = (LAS float*)(F.lds + F.wave * 16640);
    TDesc da, db; f32x4 va[16], vb[16]; int it = gw;
    if (!t_desc(F, which, it, da)) return;
    t_load(da, F.lane, va);
    for (;;) {
        const bool hb = t_desc(F, which, it + NGW, db); if (hb) t_load(db, F.lane, vb);
        t_store(da, F.lane, scr, va); if (!hb) break; it += NGW;
        const bool ha = t_desc(F, which, it + NGW, da); if (ha) t_load(da, F.lane, va);
        t_store(db, F.lane, scr, vb); if (!ha) break; it += NGW;
    }
}
__device__ __forceinline__ void rms_rows2_to_bf16(const float* x0, const float* x1, const float* w, bf16* o0, bf16* o1, int lane) {
    const f32x4* xa = (const f32x4*)x0 + lane; const f32x4* xb = (const f32x4*)x1 + lane; const f32x4* wr = (const f32x4*)w + lane;
    f32x4 va[8], vb[8]; float sa = 0.f, sb = 0.f;
#pragma unroll
    for (int j = 0; j < 8; ++j) va[j] = xa[64 * j];
#pragma unroll
    for (int j = 0; j < 8; ++j) vb[j] = xb[64 * j];
#pragma unroll
    for (int j = 0; j < 8; ++j) { sa += (va[j].x * va[j].x + va[j].y * va[j].y) + (va[j].z * va[j].z + va[j].w * va[j].w); sb += (vb[j].x * vb[j].x + vb[j].y * vb[j].y) + (vb[j].z * vb[j].z + vb[j].w * vb[j].w); }
    const float ra = rsqrtf(wave_sum(sa) * (1.f / DM) + EPS), rb = rsqrtf(wave_sum(sb) * (1.f / DM) + EPS);
    v2u* pa = (v2u*)o0 + lane; v2u* pb = (v2u*)o1 + lane;
#pragma unroll
    for (int j = 0; j < 8; ++j) { const f32x4 ww = wr[64 * j]; v2u o; o.x = pk2(va[j].x * ra * ww.x, va[j].y * ra * ww.y); o.y = pk2(va[j].z * ra * ww.z, va[j].w * ra * ww.w); pa[64 * j] = o;
        o.x = pk2(vb[j].x * rb * ww.x, vb[j].y * rb * ww.y); o.y = pk2(vb[j].z * rb * ww.z, vb[j].w * rb * ww.w); pb[64 * j] = o; }
}
__device__ __forceinline__ void p0_prologue(Frame& F) {
    const int gw = F.bid * NWAVES + F.wave, NGW = F.G * NWAVES;
    t_run(F, 0, gw, NGW);
    for (int m = gw; m < M; m += 2 * NGW) { const int m1 = (m + NGW < M) ? m + NGW : m; rms_rows2_to_bf16(x_row(F, m), x_row(F, m1), F.n_mix_pre, F.XN + (size_t)m * DM, F.XN + (size_t)m1 * DM, F.lane); }
}
__device__ __forceinline__ void p0_convert_rest(Frame& F, int vb, int nb) { t_run(F, 1, vb * NWAVES + F.wave, nb * NWAVES); }

template <int grp> __device__ __forceinline__ void gla_direct_unit(Frame& F, int b, int h) {
    const int tid = F.tid, v = tid & 255, kh = tid >> 8;
    const int L = grp ? SL : PL, row0 = grp ? MP + b * SL : b * PL;
    LAS float* Es = (LAS float*)F.lds; LAS float* Ks = Es + 1024; LAS float* Qs = Ks + 1024; LAS float* Os = Qs + 1024;
    float S[64];
    if (grp) { const float* s0 = F.st_gla + ((size_t)(b * GH + h) * GK + kh * 64) * GV + v;
#pragma unroll
        for (int i = 0; i < 64; ++i) S[i] = s0[(size_t)i * GV]; }
    else {
#pragma unroll
        for (int i = 0; i < 64; ++i) S[i] = 0.f; }
    for (int t0 = 0; t0 < L; t0 += 8) {
        for (int it = tid; it < 1024; it += NTHR) { const int t = it >> 7, k = it & 127, row = row0 + t0 + t, hk = h * GK + k;
            float x = F.b_gate[hk]; const float* lr = F.LRDT + (size_t)row * 32;
#pragma unroll
            for (int j = 0; j < LOWR; ++j) x += lr[j] * F.w_gate2[j * GKD + hk];
            const float lg = logsigmoid_f(x) * (1.f / 16.f);
            Es[it] = __expf(lg); Ks[it] = bf2f(F.PROJ[(size_t)row * NP + CK + hk]); Qs[it] = bf2f(F.PROJ[(size_t)row * NP + CQ + hk]) * 0.08838834764831845f; }
        __syncthreads();
#pragma unroll 1
        for (int t = 0; t < 8; ++t) { const float vv = bf2f(F.PROJ[(size_t)(row0 + t0 + t) * NP + CV + h * GV + v]); float acc = 0.f;
            const LAS float* e = Es + t * 128 + kh * 64; const LAS float* kk = Ks + t * 128 + kh * 64; const LAS float* qq = Qs + t * 128 + kh * 64;
#pragma unroll
            for (int i = 0; i < 64; ++i) { S[i] = e[i] * S[i] + kk[i] * vv; acc += qq[i] * S[i]; }
            Os[(kh * 8 + t) * 256 + v] = acc; }
        __syncthreads();
        { const int t = F.wave, v4 = F.lane * 4, row = row0 + t0 + t;
            const f32x4 a = *(const LAS f32x4*)(Os + t * 256 + v4), c = *(const LAS f32x4*)(Os + (8 + t) * 256 + v4); const f32x4 o = a + c;
            const float ss = wave_sum((o.x * o.x + o.y * o.y) + (o.z * o.z + o.w * o.w)); const float r = rsqrtf(ss * (1.f / GV) + EPS);
            const v2u gw = *(const v2u*)(F.PROJ + (size_t)row * NP + CG + h * GV + v4); const f32x4 nw = *(const f32x4*)(F.gla_norm + v4);
            v2u w; w.x = pk2(o.x * r * nw.x * silu_f(bflo(gw.x)), o.y * r * nw.y * silu_f(bfhi(gw.x))); w.y = pk2(o.z * r * nw.z * silu_f(bflo(gw.y)), o.w * r * nw.w * silu_f(bfhi(gw.y)));
            *(v2u*)(F.MIXIN + (size_t)row * DM + h * GV + v4) = w; }
        __syncthreads();
    }
    float* so = F.out + (grp ? O_GLA_S : O_GLA_P) + ((size_t)(b * GH + h) * GK + kh * 64) * GV + v;
#pragma unroll
    for (int i = 0; i < 64; ++i) so[(size_t)i * GV] = S[i];
}
__device__ __forceinline__ float xbc_raw(const Frame& F, int grp, int b, int row0, int tt, int c) {
    if (tt >= 0) return bf2f(F.PROJ[(size_t)(row0 + tt) * NP + CX + c]);
    return grp ? F.st_sconv[((size_t)b * 3 + (tt + 3)) * SCH + c] : 0.f;
}
template <int grp> __device__ __forceinline__ void ssd_direct_unit(Frame& F, int b, int g) {
    const int tid = F.tid, hd = g * 8 + (tid >> 6), p = tid & 63, ch = g * 512 + tid;
    const int L = grp ? SL : PL, row0 = grp ? MP + b * SL : b * PL;
    LAS float* Bs = (LAS float*)F.lds; LAS float* Cs = Bs + 1024; LAS float* red = Cs + 1024; LAS float* Ys = red + 64;
    float h[128];
    if (grp) { const f32x4* h0 = (const f32x4*)(F.st_ssd + ((size_t)(b * SH + hd) * SP + p) * SN);
#pragma unroll
        for (int i = 0; i < 32; ++i) { const f32x4 q = h0[i]; h[4 * i] = q.x; h[4 * i + 1] = q.y; h[4 * i + 2] = q.z; h[4 * i + 3] = q.w; } }
    else {
#pragma unroll
        for (int i = 0; i < 128; ++i) h[i] = 0.f; }
    const float A = -__expf(F.A_log[hd]), dtb = F.dt_bias[hd], Dh = F.ssd_D[hd], nw = F.ssd_norm[ch];
    const float cb = F.sconv_b[ch], cw0 = F.sconv_w[ch], cw1 = F.sconv_w[SCH + ch], cw2 = F.sconv_w[2 * SCH + ch], cw3 = F.sconv_w[3 * SCH + ch];
    const int c2 = 1024 + (tid < 128 ? g * 128 + tid : 256 + g * 128 + ((tid - 128) & 127));
    float xr0 = xbc_raw(F, grp, b, row0, -3, ch), xr1 = xbc_raw(F, grp, b, row0, -2, ch), xr2 = xbc_raw(F, grp, b, row0, -1, ch);
    for (int t0 = 0; t0 < L; t0 += 8) {
        if (tid < 256) {
            float xr[11]; const float cb2 = F.sconv_b[c2], d0 = F.sconv_w[c2], d1 = F.sconv_w[SCH + c2], d2 = F.sconv_w[2 * SCH + c2], d3 = F.sconv_w[3 * SCH + c2];
#pragma unroll
            for (int i = 0; i < 11; ++i) xr[i] = xbc_raw(F, grp, b, row0, t0 - 3 + i, c2);
#pragma unroll
            for (int t = 0; t < 8; ++t) Bs[(tid >> 7) * 1024 + t * 128 + (tid & 127)] = silu_f(cb2 + d0 * xr[t] + d1 * xr[t + 1] + d2 * xr[t + 2] + d3 * xr[t + 3]);
        }
        __syncthreads();
#pragma unroll 1
        for (int t = 0; t < 8; ++t) { const int row = row0 + t0 + t;
            const float xn = bf2f(F.PROJ[(size_t)row * NP + CX + ch]);
            const float x = silu_f(cb + cw0 * xr0 + cw1 * xr1 + cw2 * xr2 + cw3 * xn); xr0 = xr1; xr1 = xr2; xr2 = xn;
            const float dt = softplus_f(F.LRDT[(size_t)row * 32 + 16 + hd] + dtb), a = __expf(dt * A), dtx = dt * x;
            float acc = 0.f; const LAS float* bb = Bs + t * 128; const LAS float* cc = Cs + t * 128;
#pragma unroll
            for (int nb = 0; nb < 128; nb += 16) {
#pragma unroll
                for (int n = nb; n < nb + 16; ++n) { h[n] = a * h[n] + dtx * bb[n]; acc += h[n] * cc[n]; }
                asm volatile("" ::: "memory"); }
            const float z = bf2f(F.PROJ[(size_t)row * NP + CZ + ch]);
            const float y = (acc + Dh * x) * silu_f(z);
            Ys[t * 512 + tid] = y;
            const float ss = wave_sum(y * y); if (F.lane == 0) red[t * 8 + F.wave] = ss; }
        __syncthreads();
#pragma unroll
        for (int t = 0; t < 8; ++t) { float tot = 0.f;
#pragma unroll
            for (int w = 0; w < 8; ++w) tot += red[t * 8 + w];
            const float r = rsqrtf(tot * (1.f / 512.f) + EPS);
            F.MIXIN[(size_t)(row0 + t0 + t) * DM + 1024 + ch] = (bf16)f2bf(Ys[t * 512 + tid] * r * nw); }
        __syncthreads();
    }
    f32x4* ho = (f32x4*)(F.out + (grp ? O_SSD_S : O_SSD_P) + ((size_t)(b * SH + hd) * SP + p) * SN);
#pragma unroll
    for (int i = 0; i < 32; ++i) ho[i] = (f32x4){h[4 * i], h[4 * i + 1], h[4 * i + 2], h[4 * i + 3]};
}
typedef short bf16x8v __attribute__((ext_vector_type(8)));
typedef short s16x4v __attribute__((ext_vector_type(4)));
constexpr int CH = 64, NCH = PL / CH;
constexpr int QE_ST = 272, KDT_ST = 144, V_ST = 544, ATT_ST = 144, X_ST = 1056, BC_ST = 288;
#define MFMA16(a, b, c) __builtin_amdgcn_mfma_f32_16x16x32_bf16((a), (b), (c), 0, 0, 0)
__device__ __forceinline__ bf16x8v frag_k(const LAS unsigned char* T, int stride, int idx0, int kk0, int r, int q) { return *(const LAS bf16x8v*)(T + (idx0 + r) * stride + (kk0 + 8 * q) * 2); }
__device__ __forceinline__ bf16x8v frag_t(const LAS unsigned char* T, int stride, int kk0, int idx0, int r, int q) {
    const LAS unsigned char* p = T + (kk0 + 8 * q + (r >> 2)) * stride + (idx0 + 4 * (r & 3)) * 2;
    const s16x4v lo = __builtin_amdgcn_ds_read_tr16_b64_v4i16((LAS s16x4v*)p), hi = __builtin_amdgcn_ds_read_tr16_b64_v4i16((LAS s16x4v*)(p + 4 * stride));
    return (bf16x8v){lo[0], lo[1], lo[2], lo[3], hi[0], hi[1], hi[2], hi[3]};
}
__device__ __forceinline__ v2u pk4(const f32x4 v) { v2u o; o.x = pk2(v.x, v.y); o.y = pk2(v.z, v.w); return o; }

struct GlaStage { v4u v[4], qk[4], lr; };
template <int PASS>
__device__ __forceinline__ void gla_stage_load(const Frame& F, int h, int row0, GlaStage& g) {
    const int tid = F.tid;
#pragma unroll
    for (int i = 0; i < 4; ++i) { const int piece = tid + NTHR * i, row = piece >> 5, c16 = piece & 31; g.v[i] = *(const v4u*)(F.PROJ + (size_t)(row0 + row) * NP + CV + h * GV + c16 * 8); }
#pragma unroll
    for (int i = 0; i < 2; ++i) { const int piece = tid + NTHR * i, row = piece >> 4, c16 = piece & 15;
        g.qk[i] = *(const v4u*)(F.PROJ + (size_t)(row0 + row) * NP + CK + h * GK + c16 * 8);
        if (PASS == 1) g.qk[2 + i] = *(const v4u*)(F.PROJ + (size_t)(row0 + row) * NP + CQ + h * GK + c16 * 8); }
    if (tid < 256) g.lr = *(const v4u*)(F.LRDT + (size_t)(row0 + (tid >> 2)) * 32 + (tid & 3) * 4);
}
template <int PASS>
__device__ __forceinline__ void gla_stage_store(const Frame& F, const GlaStage& g, LAS unsigned char* V, LAS unsigned char* Kt, LAS unsigned char* Qt, LAS float* LR) {
    const int tid = F.tid;
#pragma unroll
    for (int i = 0; i < 4; ++i) { const int piece = tid + NTHR * i, row = piece >> 5, c16 = piece & 31; *(LAS v4u*)(V + row * V_ST + c16 * 16) = g.v[i]; }
#pragma unroll
    for (int i = 0; i < 2; ++i) { const int piece = tid + NTHR * i, row = piece >> 4, c16 = piece & 15;
        *(LAS v4u*)(Kt + row * QE_ST + c16 * 16) = g.qk[i]; if (PASS == 1) *(LAS v4u*)(Qt + row * QE_ST + c16 * 16) = g.qk[2 + i]; }
    if (tid < 256) *(LAS v4u*)(LR + (tid >> 2) * 16 + (tid & 3) * 4) = g.lr;
}
template <int PASS>
__device__ __forceinline__ void gla_chunk_elem(Frame& F, int h, LAS unsigned char* Kt, LAS unsigned char* Qt, LAS unsigned char* KDT, const LAS float* LR, LAS float* tot, float* ebl_out) {
    const int tid = F.tid, k = tid & 127, tq = tid >> 7, hk = h * GK + k;
    float w2[16];
#pragma unroll
    for (int j = 0; j < 16; ++j) w2[j] = F.w_gate2[j * GKD + hk];
    const float bg = F.b_gate[hk];
    float lg[16]; float run = 0.f;
#pragma unroll
    for (int i = 0; i < 16; ++i) { const LAS f32x4* lr = (const LAS f32x4*)(LR + (16 * tq + i) * 16); const f32x4 a = lr[0], b = lr[1], c = lr[2], d = lr[3];
        float x = bg + a.x * w2[0] + a.y * w2[1] + a.z * w2[2] + a.w * w2[3] + b.x * w2[4] + b.y * w2[5] + b.z * w2[6] + b.w * w2[7]
                     + c.x * w2[8] + c.y * w2[9] + c.z * w2[10] + c.w * w2[11] + d.x * w2[12] + d.y * w2[13] + d.z * w2[14] + d.w * w2[15];
        run += logsigmoid_f(x) * (1.f / 16.f); lg[i] = run; }
    tot[tq * 128 + k] = run;
    __syncthreads();
    float off = 0.f, all = 0.f;
#pragma unroll
    for (int qq = 0; qq < 4; ++qq) { const float v = tot[qq * 128 + k]; all += v; off += (qq < tq) ? v : 0.f; }
    {
        unsigned pk[8];
#pragma unroll
        for (int i = 0; i < 8; ++i) { const int t = 16 * tq + 2 * i; const float b0 = off + lg[2 * i], b1 = off + lg[2 * i + 1];
            LAS bf16* k0p = (LAS bf16*)(Kt + t * QE_ST + k * 2); LAS bf16* k1p = (LAS bf16*)(Kt + (t + 1) * QE_ST + k * 2);
            LAS bf16* q0p = (LAS bf16*)(Qt + t * QE_ST + k * 2); LAS bf16* q1p = (LAS bf16*)(Qt + (t + 1) * QE_ST + k * 2);
            const float k0 = bf2f(*k0p), k1 = bf2f(*k1p);
            pk[i] = pk2(k0 * __expf(all - b0), k1 * __expf(all - b1));
            *k0p = (bf16)f2bf(k0 * __expf(-b0)); *k1p = (bf16)f2bf(k1 * __expf(-b1));
            *q0p = (bf16)f2bf(bf2f(*q0p) * 0.08838834764831845f * __expf(b0)); *q1p = (bf16)f2bf(bf2f(*q1p) * 0.08838834764831845f * __expf(b1)); }
        LAS v4u* d = (LAS v4u*)(KDT + k * KDT_ST + 32 * tq);
        d[0] = (v4u){pk[0], pk[1], pk[2], pk[3]}; d[1] = (v4u){pk[4], pk[5], pk[6], pk[7]};
        if (tq == 0) ebl_out[k] = __expf(all);
    }
}
__device__ __forceinline__ void gla_passA_unit(Frame& F, int u) {
    const int c = u & 31, bh = u >> 5, b = bh >> 2, h = bh & 3, row0 = b * PL + c * CH;
    LAS unsigned char* KDT = F.lds; LAS unsigned char* V = KDT + 128 * KDT_ST; LAS unsigned char* Kt = V + 64 * V_ST; LAS unsigned char* Qt = Kt + 64 * QE_ST; LAS float* LR = (LAS float*)(Qt + 64 * QE_ST); LAS float* tot = LR + 1024;
    { GlaStage g; gla_stage_load<1>(F, h, row0, g); gla_stage_store<1>(F, g, V, Kt, Qt, LR); }
    __syncthreads();
    gla_chunk_elem<0>(F, h, Kt, Qt, KDT, LR, tot, F.EBL + (size_t)u * 128);
    __syncthreads();
#pragma unroll
    for (int i = 0; i < 2; ++i) { const int piece = F.tid + NTHR * i, row = piece >> 4, c16 = piece & 15;
        *(v4u*)(F.QEg + ((size_t)u * 64 + row) * GK + c16 * 8) = *(const LAS v4u*)(Qt + row * QE_ST + c16 * 16);
        *(v4u*)(F.KEg + ((size_t)u * 64 + row) * GK + c16 * 8) = *(const LAS v4u*)(Kt + row * QE_ST + c16 * 16); }
    const int w = F.wave, r = F.lane & 15, q = F.lane >> 4;
    f32x4 acc[8][2];
#pragma unroll
    for (int kf = 0; kf < 8; ++kf) { acc[kf][0] = (f32x4){0.f, 0.f, 0.f, 0.f}; acc[kf][1] = (f32x4){0.f, 0.f, 0.f, 0.f}; }
#pragma unroll
    for (int ks = 0; ks < 2; ++ks) { const bf16x8v b0 = frag_t(V, V_ST, 32 * ks, 32 * w, r, q), b1 = frag_t(V, V_ST, 32 * ks, 32 * w + 16, r, q);
#pragma unroll
        for (int kf = 0; kf < 8; ++kf) { const bf16x8v a = frag_k(KDT, KDT_ST, 16 * kf, 32 * ks, r, q); acc[kf][0] = MFMA16(a, b0, acc[kf][0]); acc[kf][1] = MFMA16(a, b1, acc[kf][1]); } }
#pragma unroll
    for (int kf = 0; kf < 8; ++kf)
#pragma unroll
        for (int vf = 0; vf < 2; ++vf) *(v2u*)(F.DS + ((size_t)u * GV + 32 * w + 16 * vf + r) * GK + 16 * kf + 4 * q) = pk4(acc[kf][vf]);
    __syncthreads();
}
__device__ __forceinline__ void gla_scan(Frame& F) {
    for (int it = F.bid * NTHR + F.tid; it < PB * GH * GV * 32; it += F.G * NTHR) { const int k4 = it & 31, v = (it >> 5) & 255, bh = it >> 13;
        f32x4 S = (f32x4){0.f, 0.f, 0.f, 0.f};
#pragma unroll 8
        for (int c = 0; c < NCH; ++c) { const int u = bh * NCH + c; const size_t off = ((size_t)u * GV + v) * GK + 4 * k4;
            const v2u d = *(const v2u*)(F.DS + off); const f32x4 e = *(const f32x4*)(F.EBL + (size_t)u * 128 + 4 * k4);
            *(v2u*)(F.SC + off) = pk4(S);
            S.x = e.x * S.x + bflo(d.x); S.y = e.y * S.y + bfhi(d.x); S.z = e.z * S.z + bflo(d.y); S.w = e.w * S.w + bfhi(d.y); }
        float* o = F.out + O_GLA_P + ((size_t)bh * GK + 4 * k4) * GV + v; o[0] = S.x; o[GV] = S.y; o[2 * GV] = S.z; o[3 * GV] = S.w; }
}
__device__ __forceinline__ void gla_passC_unit(Frame& F, int u) {
    const int c = u & 31, bh = u >> 5, b = bh >> 2, h = bh & 3, row0 = b * PL + c * CH;
    LAS unsigned char* QE = F.lds; LAS unsigned char* KE = QE + 64 * QE_ST; LAS unsigned char* V = KE + 64 * QE_ST; LAS unsigned char* ATT = V + 64 * V_ST;
    LAS float* red = (LAS float*)(ATT + 64 * ATT_ST);
    { v4u vv[4], qq[2], kk[2];
#pragma unroll
        for (int i = 0; i < 4; ++i) { const int piece = F.tid + NTHR * i, row = piece >> 5, c16 = piece & 31; vv[i] = *(const v4u*)(F.PROJ + (size_t)(row0 + row) * NP + CV + h * GV + c16 * 8); }
#pragma unroll
        for (int i = 0; i < 2; ++i) { const int piece = F.tid + NTHR * i, row = piece >> 4, c16 = piece & 15;
            qq[i] = *(const v4u*)(F.QEg + ((size_t)u * 64 + row) * GK + c16 * 8); kk[i] = *(const v4u*)(F.KEg + ((size_t)u * 64 + row) * GK + c16 * 8); }
#pragma unroll
        for (int i = 0; i < 4; ++i) { const int piece = F.tid + NTHR * i, row = piece >> 5, c16 = piece & 31; *(LAS v4u*)(V + row * V_ST + c16 * 16) = vv[i]; }
#pragma unroll
        for (int i = 0; i < 2; ++i) { const int piece = F.tid + NTHR * i, row = piece >> 4, c16 = piece & 15;
            *(LAS v4u*)(QE + row * QE_ST + c16 * 16) = qq[i]; *(LAS v4u*)(KE + row * QE_ST + c16 * 16) = kk[i]; } }
    __syncthreads();
    const int w = F.wave, r = F.lane & 15, q = F.lane >> 4;
#pragma unroll
    for (int ff = 0; ff < 2; ++ff) { const int f = 2 * w + ff, sf = f >> 2, tf = f & 3; f32x4 a4 = (f32x4){0.f, 0.f, 0.f, 0.f};
        if (sf <= tf) {
#pragma unroll
            for (int ks = 0; ks < 4; ++ks) a4 = MFMA16(frag_k(KE, QE_ST, 16 * sf, 32 * ks, r, q), frag_k(QE, QE_ST, 16 * tf, 32 * ks, r, q), a4); }
        const int s0 = 16 * sf + 4 * q, t = 16 * tf + r;
        f32x4 m; m.x = (s0 <= t) ? a4.x : 0.f; m.y = (s0 + 1 <= t) ? a4.y : 0.f; m.z = (s0 + 2 <= t) ? a4.z : 0.f; m.w = (s0 + 3 <= t) ? a4.w : 0.f;
        *(LAS v2u*)(ATT + t * ATT_ST + s0 * 2) = pk4(m); }
    __syncthreads();
    const int tf = w & 3, vh = w >> 2;
    f32x4 acc[8];
#pragma unroll
    for (int i = 0; i < 8; ++i) acc[i] = (f32x4){0.f, 0.f, 0.f, 0.f};
    const bf16* Sc = F.SC + ((size_t)u * GV + 128 * vh) * GK;
#pragma unroll
    for (int ks = 0; ks < 4; ++ks) { const bf16x8v bq = frag_k(QE, QE_ST, 16 * tf, 32 * ks, r, q);
#pragma unroll
        for (int i = 0; i < 8; ++i) { const bf16x8v a = *(const bf16x8v*)(Sc + (size_t)(16 * i + r) * GK + 32 * ks + 8 * q); acc[i] = MFMA16(a, bq, acc[i]); } }
#pragma unroll
    for (int ks = 0; ks < 2; ++ks) { const bf16x8v ba = frag_k(ATT, ATT_ST, 16 * tf, 32 * ks, r, q);
#pragma unroll
        for (int i = 0; i < 8; ++i) { const bf16x8v a = frag_t(V, V_ST, 32 * ks, 128 * vh + 16 * i, r, q); acc[i] = MFMA16(a, ba, acc[i]); } }
    float ss = 0.f;
#pragma unroll
    for (int i = 0; i < 8; ++i) ss += (acc[i].x * acc[i].x + acc[i].y * acc[i].y) + (acc[i].z * acc[i].z + acc[i].w * acc[i].w);
    ss += __shfl_xor(ss, 16); ss += __shfl_xor(ss, 32);
    const int t = 16 * tf + r;
    if (q == 0) red[vh * 64 + t] = ss;
    __syncthreads();
    const float rr = rsqrtf((red[t] + red[64 + t]) * (1.f / GV) + EPS); const size_t row = (size_t)(row0 + t);
#pragma unroll
    for (int i = 0; i < 8; ++i) { const int v = 128 * vh + 16 * i + 4 * q;
        const v2u gw = *(const v2u*)(F.PROJ + row * NP + CG + h * GV + v); const f32x4 nw = *(const f32x4*)(F.gla_norm + v);
        f32x4 o; o.x = acc[i].x * rr * nw.x * silu_f(bflo(gw.x)); o.y = acc[i].y * rr * nw.y * silu_f(bfhi(gw.x)); o.z = acc[i].z * rr * nw.z * silu_f(bflo(gw.y)); o.w = acc[i].w * rr * nw.w * silu_f(bfhi(gw.y));
        *(v2u*)(F.MIXIN + row * DM + h * GV + v) = pk4(o); }
    __syncthreads();
}

template <bool SCALE>
__device__ __forceinline__ void ssd_conv_item(Frame& F, int b, int g, int c, int cg, int tb, LAS unsigned char* X, LAS unsigned char* BT, LAS unsigned char* CT, const LAS float* WDEC) {
    const int xc = cg < 64 ? g * 512 + 8 * cg : (cg < 80 ? 1024 + g * 128 + 8 * (cg - 64) : 1280 + g * 128 + 8 * (cg - 80));
    float w[4][8], bias[8];
#pragma unroll
    for (int j = 0; j < 4; ++j) { const f32x4 a = *(const f32x4*)(F.sconv_w + j * SCH + xc), bq = *(const f32x4*)(F.sconv_w + j * SCH + xc + 4);
        w[j][0] = a.x; w[j][1] = a.y; w[j][2] = a.z; w[j][3] = a.w; w[j][4] = bq.x; w[j][5] = bq.y; w[j][6] = bq.z; w[j][7] = bq.w; }
    { const f32x4 a = *(const f32x4*)(F.sconv_b + xc), bq = *(const f32x4*)(F.sconv_b + xc + 4); bias[0] = a.x; bias[1] = a.y; bias[2] = a.z; bias[3] = a.w; bias[4] = bq.x; bias[5] = bq.y; bias[6] = bq.z; bias[7] = bq.w; }
    v4u raw[11];
#pragma unroll
    for (int i = 0; i < 11; ++i) { const int tt = c * CH + tb * 8 - 3 + i;
        raw[i] = (tt >= 0) ? *(const v4u*)(F.PROJ + (size_t)(b * PL + tt) * NP + CX + xc) : (v4u){0u, 0u, 0u, 0u}; }
#pragma unroll
    for (int t = 0; t < 8; ++t) { float o[8];
#pragma unroll
        for (int e = 0; e < 8; ++e) { float a = bias[e];
#pragma unroll
            for (int j = 0; j < 4; ++j) { const unsigned wd = raw[t + j][e >> 1]; a += w[j][e] * ((e & 1) ? bfhi(wd) : bflo(wd)); }
            o[e] = silu_f(a); }
        const int tl = tb * 8 + t;
        if (SCALE && cg < 64) { const float sc = WDEC[(cg >> 3) * 64 + tl];
#pragma unroll
            for (int e = 0; e < 8; ++e) o[e] *= sc; }
        const v4u pkd = (v4u){pk2(o[0], o[1]), pk2(o[2], o[3]), pk2(o[4], o[5]), pk2(o[6], o[7])};
        LAS unsigned char* dst = cg < 64 ? X + tl * X_ST + cg * 16 : (cg < 80 ? BT + tl * BC_ST + (cg - 64) * 16 : CT + tl * BC_ST + (cg - 80) * 16);
        *(LAS v4u*)dst = pkd; }
}
__device__ __forceinline__ float ssd_head_scan(Frame& F, int hd, int row0, float& dt_out, float& last) {
    const float dt = softplus_f(F.LRDT[(size_t)(row0 + F.lane) * 32 + 16 + hd] + F.dt_bias[hd]);
    float cum = dt * (-__expf(F.A_log[hd]));
#pragma unroll
    for (int o = 1; o < 64; o <<= 1) { const float v = __shfl_up(cum, o); cum += (F.lane >= o) ? v : 0.f; }
    dt_out = dt; last = __shfl(cum, 63); return cum;
}
__device__ __forceinline__ void ssd_passA_unit(Frame& F, int u) {
    const int c = u & 31, bg = u >> 5, b = bg >> 1, g = bg & 1, row0 = b * PL + c * CH;
    LAS unsigned char* X = F.lds; LAS unsigned char* BT = X + 64 * X_ST; LAS float* WDEC = (LAS float*)(BT + 64 * BC_ST);
    const int w = F.wave, r = F.lane & 15, q = F.lane >> 4;
    { float dt, last; const float cum = ssd_head_scan(F, g * 8 + w, row0, dt, last);
        WDEC[w * 64 + F.lane] = __expf(last - cum) * dt; if (F.lane == 63) F.AL[(size_t)u * 8 + w] = __expf(last); }
    __syncthreads();
    for (int it = F.tid; it < 80 * 8; it += NTHR) ssd_conv_item<true>(F, b, g, c, it % 80, it / 80, X, BT, nullptr, WDEC);
    __syncthreads();
#pragma unroll 1
    for (int nh = 0; nh < 2; ++nh) {
        f32x4 acc[4][4];
#pragma unroll
        for (int i = 0; i < 4; ++i)
#pragma unroll
            for (int j = 0; j < 4; ++j) acc[i][j] = (f32x4){0.f, 0.f, 0.f, 0.f};
#pragma unroll
        for (int ks = 0; ks < 2; ++ks) { bf16x8v bp[4];
#pragma unroll
            for (int pf = 0; pf < 4; ++pf) bp[pf] = frag_t(X, X_ST, 32 * ks, 64 * w + 16 * pf, r, q);
#pragma unroll
            for (int nf = 0; nf < 4; ++nf) { const bf16x8v a = frag_t(BT, BC_ST, 32 * ks, 64 * nh + 16 * nf, r, q);
#pragma unroll
                for (int pf = 0; pf < 4; ++pf) acc[nf][pf] = MFMA16(a, bp[pf], acc[nf][pf]); } }
#pragma unroll
        for (int nf = 0; nf < 4; ++nf)
#pragma unroll
            for (int pf = 0; pf < 4; ++pf) *(v2u*)(F.DH + (((size_t)u * 8 + w) * SP + 16 * pf + r) * SN + 64 * nh + 16 * nf + 4 * q) = pk4(acc[nf][pf]);
    }
    __syncthreads();
}
__device__ __forceinline__ void ssd_scan(Frame& F) {
    for (int it = F.bid * NTHR + F.tid; it < PB * SH * SP * 32; it += F.G * NTHR) { const int n4 = it & 31, p = (it >> 5) & 63, bhd = it >> 11, b = bhd >> 4, hd = bhd & 15, g = hd >> 3, hl = hd & 7;
        f32x4 H = (f32x4){0.f, 0.f, 0.f, 0.f};
#pragma unroll 8
        for (int c = 0; c < NCH; ++c) { const int u = (b * 2 + g) * NCH + c; const size_t off = (((size_t)u * 8 + hl) * SP + p) * SN + 4 * n4;
            const v2u d = *(const v2u*)(F.DH + off); const float a = F.AL[(size_t)u * 8 + hl];
            *(v2u*)(F.HC + off) = pk4(H);
            H.x = a * H.x + bflo(d.x); H.y = a * H.y + bfhi(d.x); H.z = a * H.z + bflo(d.y); H.w = a * H.w + bfhi(d.y); }
        *(f32x4*)(F.out + O_SSD_P + ((size_t)bhd * SP + p) * SN + 4 * n4) = H; }
}
__device__ __forceinline__ void ssd_passC_unit(Frame& F, int u) {
    const int c = u & 31, bg = u >> 5, b = bg >> 1, g = bg & 1, row0 = b * PL + c * CH;
    LAS unsigned char* X = F.lds; LAS unsigned char* BT = X + 64 * X_ST; LAS unsigned char* CT = BT + 64 * BC_ST; LAS unsigned char* CB = CT + 64 * BC_ST;
    LAS float* DT = (LAS float*)(CB + 64 * ATT_ST); LAS float* CUM = DT + 512; LAS float* red = CUM + 512;
    const int w = F.wave, r = F.lane & 15, q = F.lane >> 4, hd = g * 8 + w;
    { float dt, last; const float cum = ssd_head_scan(F, hd, row0, dt, last); DT[w * 64 + F.lane] = dt; CUM[w * 64 + F.lane] = cum; }
    for (int it = F.tid; it < 96 * 8; it += NTHR) ssd_conv_item<false>(F, b, g, c, it % 96, it / 96, X, BT, CT, nullptr);
    __syncthreads();
#pragma unroll
    for (int ff = 0; ff < 2; ++ff) { const int f = 2 * w + ff, sf = f >> 2, tf = f & 3; f32x4 a4 = (f32x4){0.f, 0.f, 0.f, 0.f};
        if (sf <= tf) {
#pragma unroll
            for (int ks = 0; ks < 4; ++ks) a4 = MFMA16(frag_k(BT, BC_ST, 16 * sf, 32 * ks, r, q), frag_k(CT, BC_ST, 16 * tf, 32 * ks, r, q), a4); }
        *(LAS v2u*)(CB + (16 * tf + r) * ATT_ST + (16 * sf + 4 * q) * 2) = pk4(a4); }
    __syncthreads();
    f32x4 acc[4][4];
#pragma unroll
    for (int i = 0; i < 4; ++i)
#pragma unroll
        for (int j = 0; j < 4; ++j) acc[i][j] = (f32x4){0.f, 0.f, 0.f, 0.f};
    const bf16* Hc = F.HC + ((size_t)u * 8 + w) * SP * SN;
#pragma unroll
    for (int ks = 0; ks < 4; ++ks) { bf16x8v bc[4];
#pragma unroll
        for (int tf = 0; tf < 4; ++tf) bc[tf] = frag_k(CT, BC_ST, 16 * tf, 32 * ks, r, q);
#pragma unroll
        for (int pf = 0; pf < 4; ++pf) { const bf16x8v a = *(const bf16x8v*)(Hc + (size_t)(16 * pf + r) * SN + 32 * ks + 8 * q);
#pragma unroll
            for (int tf = 0; tf < 4; ++tf) acc[pf][tf] = MFMA16(a, bc[tf], acc[pf][tf]); } }
    float ct[4];
#pragma unroll
    for (int tf = 0; tf < 4; ++tf) { ct[tf] = CUM[w * 64 + 16 * tf + r]; const float e = __expf(ct[tf]);
#pragma unroll
        for (int pf = 0; pf < 4; ++pf) acc[pf][tf] = acc[pf][tf] * e; }
#pragma unroll
    for (int ks = 0; ks < 2; ++ks) { bf16x8v ax[4];
#pragma unroll
        for (int pf = 0; pf < 4; ++pf) ax[pf] = frag_t(X, X_ST, 32 * ks, 64 * w + 16 * pf, r, q);
        const int s0 = 32 * ks + 8 * q;
        const f32x4 cs0 = *(const LAS f32x4*)(CUM + w * 64 + s0), cs1 = *(const LAS f32x4*)(CUM + w * 64 + s0 + 4), ds0 = *(const LAS f32x4*)(DT + w * 64 + s0), ds1 = *(const LAS f32x4*)(DT + w * 64 + s0 + 4);
        const float cs[8] = {cs0.x, cs0.y, cs0.z, cs0.w, cs1.x, cs1.y, cs1.z, cs1.w}, ds[8] = {ds0.x, ds0.y, ds0.z, ds0.w, ds1.x, ds1.y, ds1.z, ds1.w};
#pragma unroll
        for (int tf = 0; tf < 4; ++tf) { if (32 * ks > 16 * tf + 15) continue;
            const int t = 16 * tf + r; const v4u cb8 = *(const LAS v4u*)(CB + t * ATT_ST + s0 * 2); float l[8];
#pragma unroll
            for (int e = 0; e < 8; ++e) { const unsigned wd = cb8[e >> 1]; const float cbv = (e & 1) ? bfhi(wd) : bflo(wd); l[e] = (s0 + e <= t) ? cbv * __expf(ct[tf] - cs[e]) * ds[e] : 0.f; }
            const v4u lp = (v4u){pk2(l[0], l[1]), pk2(l[2], l[3]), pk2(l[4], l[5]), pk2(l[6], l[7])}; const bf16x8v bl = __builtin_bit_cast(bf16x8v, lp);
#pragma unroll
            for (int pf = 0; pf < 4; ++pf) acc[pf][tf] = MFMA16(ax[pf], bl, acc[pf][tf]); } }
    const float Dh = F.ssd_D[hd];
#pragma unroll
    for (int tf = 0; tf < 4; ++tf) { const int t = 16 * tf + r; const size_t row = (size_t)(row0 + t); float ss = 0.f;
#pragma unroll
        for (int pf = 0; pf < 4; ++pf) { const int p4 = 64 * w + 16 * pf + 4 * q;
            const v2u xv = *(const LAS v2u*)(X + t * X_ST + p4 * 2); const v2u zv = *(const v2u*)(F.PROJ + row * NP + CZ + g * 512 + p4);
            f32x4 y = acc[pf][tf];
            y.x = (y.x + Dh * bflo(xv.x)) * silu_f(bflo(zv.x)); y.y = (y.y + Dh * bfhi(xv.x)) * silu_f(bfhi(zv.x)); y.z = (y.z + Dh * bflo(xv.y)) * silu_f(bflo(zv.y)); y.w = (y.w + Dh * bfhi(xv.y)) * silu_f(bfhi(zv.y));
            acc[pf][tf] = y; ss += (y.x * y.x + y.y * y.y) + (y.z * y.z + y.w * y.w); }
        ss += __shfl_xor(ss, 16); ss += __shfl_xor(ss, 32);
        if (q == 0) red[w * 64 + t] = ss; }
    __syncthreads();
#pragma unroll
    for (int tf = 0; tf < 4; ++tf) { const int t = 16 * tf + r; const size_t row = (size_t)(row0 + t); float tot = 0.f;
#pragma unroll
        for (int ww = 0; ww < 8; ++ww) tot += red[ww * 64 + t];
        const float rr = rsqrtf(tot * (1.f / 512.f) + EPS);
#pragma unroll
        for (int pf = 0; pf < 4; ++pf) { const int p4 = g * 512 + 64 * w + 16 * pf + 4 * q; const f32x4 nw = *(const f32x4*)(F.ssd_norm + p4);
            f32x4 o = acc[pf][tf]; o.x *= rr * nw.x; o.y *= rr * nw.y; o.z *= rr * nw.z; o.w *= rr * nw.w;
            *(v2u*)(F.MIXIN + row * DM + 1024 + p4) = pk4(o); } }
    __syncthreads();
}

constexpr int ATT8_ST = 80;
__device__ __forceinline__ void gla_sample_unit(Frame& F, int b, int h, f32x4 (&S)[16], int nb, int nh, bool has_next) {
    const int tid = F.tid, w = F.wave, lane = F.lane, r = lane & 15, q = lane >> 4, row0 = MP + b * SL;
    LAS unsigned char* S0b = F.lds;
    LAS unsigned char* Vt = S0b + 128 * V_ST;
    LAS unsigned char* QE = Vt + 32 * V_ST;
    LAS unsigned char* KE = QE + 16 * QE_ST;
    LAS unsigned char* ATT = KE + 16 * QE_ST;
    LAS float* KD = (LAS float*)(ATT + 16 * ATT8_ST);
    LAS float* EL = KD + 1024;
    LAS float* red = EL + 128;
    f32x4 Vf[8];
#pragma unroll
    for (int s = 0; s < 8; ++s) { const v2u vv = *(const v2u*)(F.PROJ + (size_t)(row0 + s) * NP + CV + h * GV + 4 * lane); Vf[s] = (f32x4){bflo(vv.x), bfhi(vv.x), bflo(vv.y), bfhi(vv.y)}; }
    if (tid < 256) { const int t = tid >> 5, c16 = tid & 31; *(LAS v4u*)(Vt + t * V_ST + c16 * 16) = *(const v4u*)(F.PROJ + (size_t)(row0 + t) * NP + CV + h * GV + c16 * 8); }
    for (int i = tid; i < 24 * 32; i += NTHR) *(LAS v4u*)(Vt + (8 + (i >> 5)) * V_ST + (i & 31) * 16) = (v4u){0u, 0u, 0u, 0u};
    { LAS unsigned char* KR = (LAS unsigned char*)(red + 128); LAS unsigned char* QR = KR + 8 * 256; LAS float* LR = (LAS float*)(QR + 8 * 256); LAS float* LG = LR + 128;
        if (tid < 256) { const int which = tid >> 7, j = tid & 127, t = j >> 4, c16 = j & 15;
            *(LAS v4u*)((which ? QR : KR) + t * 256 + c16 * 16) = *(const v4u*)(F.PROJ + (size_t)(row0 + t) * NP + (which ? CQ : CK) + h * GK + c16 * 8); }
        else if (tid < 288) { const int j = tid - 256; *(LAS v4u*)(LR + (j >> 2) * 16 + (j & 3) * 4) = *(const v4u*)(F.LRDT + (size_t)(row0 + (j >> 2)) * 32 + (j & 3) * 4); }
        __syncthreads();
        { const int k = tid & 127, tp = tid >> 7, hk = h * GK + k; const float bg = F.b_gate[hk];
            float w2[16];
#pragma unroll
            for (int j = 0; j < 16; ++j) w2[j] = F.w_gate2[j * GKD + hk];
#pragma unroll
            for (int tt = 0; tt < 2; ++tt) { const int t = 2 * tp + tt; const LAS f32x4* lr = (const LAS f32x4*)(LR + t * 16); const f32x4 a = lr[0], bq = lr[1], c = lr[2], d = lr[3];
                const float x = bg + a.x * w2[0] + a.y * w2[1] + a.z * w2[2] + a.w * w2[3] + bq.x * w2[4] + bq.y * w2[5] + bq.z * w2[6] + bq.w * w2[7]
                              + c.x * w2[8] + c.y * w2[9] + c.z * w2[10] + c.w * w2[11] + d.x * w2[12] + d.y * w2[13] + d.z * w2[14] + d.w * w2[15];
                LG[t * 128 + k] = logsigmoid_f(x) * (1.f / 16.f); } }
        __syncthreads();
        if (tid < 128) { const int k = tid;
            float bcum[8], kv[8]; float run = 0.f;
#pragma unroll
            for (int t = 0; t < 8; ++t) { run += LG[t * 128 + k]; bcum[t] = run; kv[t] = bf2f(*(const LAS bf16*)(KR + t * 256 + k * 2));
                *(LAS bf16*)(QE + t * QE_ST + k * 2) = (bf16)f2bf(bf2f(*(const LAS bf16*)(QR + t * 256 + k * 2)) * 0.08838834764831845f * __expf(run));
                *(LAS bf16*)(KE + t * QE_ST + k * 2) = (bf16)f2bf(kv[t] * __expf(-run)); }
            f32x4 d0, d1; d0.x = kv[0] * __expf(run - bcum[0]); d0.y = kv[1] * __expf(run - bcum[1]); d0.z = kv[2] * __expf(run - bcum[2]); d0.w = kv[3] * __expf(run - bcum[3]);
            d1.x = kv[4] * __expf(run - bcum[4]); d1.y = kv[5] * __expf(run - bcum[5]); d1.z = kv[6] * __expf(run - bcum[6]); d1.w = kv[7];
            *(LAS f32x4*)(KD + k * 8) = d0; *(LAS f32x4*)(KD + k * 8 + 4) = d1; EL[k] = __expf(run); } }
    if (tid < 128) {
    } else if (tid < 384) { const int i = tid - 128, which = i >> 7, j = i & 127;
        *(LAS v4u*)((which ? KE : QE) + (8 + (j >> 4)) * QE_ST + (j & 15) * 16) = (v4u){0u, 0u, 0u, 0u};
    } else if (tid < 384 + 80) { *(LAS v4u*)(ATT + (tid - 384) * 16) = (v4u){0u, 0u, 0u, 0u}; }
#pragma unroll
    for (int i = 0; i < 16; ++i) *(LAS v2u*)(S0b + (16 * w + i) * V_ST + lane * 8) = pk4(S[i]);
    __syncthreads();
    if (w == 0) { f32x4 a4 = (f32x4){0.f, 0.f, 0.f, 0.f};
#pragma unroll
        for (int ks = 0; ks < 4; ++ks) a4 = MFMA16(frag_k(KE, QE_ST, 0, 32 * ks, r, q), frag_k(QE, QE_ST, 0, 32 * ks, r, q), a4);
        const int s0i = 4 * q; f32x4 m; m.x = (s0i <= r) ? a4.x : 0.f; m.y = (s0i + 1 <= r) ? a4.y : 0.f; m.z = (s0i + 2 <= r) ? a4.z : 0.f; m.w = (s0i + 3 <= r) ? a4.w : 0.f;
        if (r >= 8) m = (f32x4){0.f, 0.f, 0.f, 0.f};
        *(LAS v2u*)(ATT + r * ATT8_ST + s0i * 2) = pk4(m); }
    { f32x4* so = (f32x4*)(F.out + O_GLA_S + ((size_t)(b * GH + h) * GK + 16 * w) * GV) + lane;
#pragma unroll
        for (int i = 0; i < 16; ++i) { const int k = 16 * w + i; const float e = EL[k]; const f32x4 k0 = *(const LAS f32x4*)(KD + k * 8), k1 = *(const LAS f32x4*)(KD + k * 8 + 4);
            f32x4 n = S[i] * e; n = n + Vf[0] * k0.x; n = n + Vf[1] * k0.y; n = n + Vf[2] * k0.z; n = n + Vf[3] * k0.w; n = n + Vf[4] * k1.x; n = n + Vf[5] * k1.y; n = n + Vf[6] * k1.z; n = n + Vf[7] * k1.w;
            so[i * 64] = n; } }
    if (has_next) { const f32x4* s1 = (const f32x4*)(F.st_gla + ((size_t)(nb * GH + nh) * GK + 16 * w) * GV) + lane;
#pragma unroll
        for (int i = 0; i < 16; ++i) S[i] = s1[i * 64]; }
    f32x4 acc[2] = {(f32x4){0.f, 0.f, 0.f, 0.f}, (f32x4){0.f, 0.f, 0.f, 0.f}};
#pragma unroll
    for (int ks = 0; ks < 4; ++ks) { const bf16x8v bq = frag_k(QE, QE_ST, 0, 32 * ks, r, q);
#pragma unroll
        for (int vf = 0; vf < 2; ++vf) acc[vf] = MFMA16(frag_t(S0b, V_ST, 32 * ks, 32 * w + 16 * vf, r, q), bq, acc[vf]); }
    __syncthreads();
    { const bf16x8v ba = *(const LAS bf16x8v*)(ATT + r * ATT8_ST + 16 * q);
#pragma unroll
        for (int vf = 0; vf < 2; ++vf) acc[vf] = MFMA16(frag_t(Vt, V_ST, 0, 32 * w + 16 * vf, r, q), ba, acc[vf]); }
    float ss = (acc[0].x * acc[0].x + acc[0].y * acc[0].y) + (acc[0].z * acc[0].z + acc[0].w * acc[0].w) + (acc[1].x * acc[1].x + acc[1].y * acc[1].y) + (acc[1].z * acc[1].z + acc[1].w * acc[1].w);
    ss += __shfl_xor(ss, 16); ss += __shfl_xor(ss, 32);
    if (q == 0) red[w * 16 + r] = ss;
    __syncthreads();
    float tot = 0.f;
#pragma unroll
    for (int ww = 0; ww < 8; ++ww) tot += red[ww * 16 + r];
    const float rr = rsqrtf(tot * (1.f / GV) + EPS);
    if (r < 8) { const size_t row = (size_t)(row0 + r);
#pragma unroll
        for (int vf = 0; vf < 2; ++vf) { const int v = 32 * w + 16 * vf + 4 * q;
            const v2u gw = *(const v2u*)(F.PROJ + row * NP + CG + h * GV + v); const f32x4 nw = *(const f32x4*)(F.gla_norm + v);
            f32x4 o; o.x = acc[vf].x * rr * nw.x * silu_f(bflo(gw.x)); o.y = acc[vf].y * rr * nw.y * silu_f(bfhi(gw.x)); o.z = acc[vf].z * rr * nw.z * silu_f(bflo(gw.y)); o.w = acc[vf].w * rr * nw.w * silu_f(bfhi(gw.y));
            *(v2u*)(F.MIXIN + row * DM + h * GV + v) = pk4(o); } }
    __syncthreads();
}
__device__ __forceinline__ void ssd_sample_unit(Frame& F, int b, int g) {
    const int tid = F.tid, w = F.wave, lane = F.lane, r = lane & 15, q = lane >> 4, row0 = MP + b * SL, hd = g * 8 + w, ch = g * 512 + tid;
    LAS float* Xs = (LAS float*)F.lds;
    LAS float* XW = Xs + 4096;
    LAS float* Bs = XW + 4096;
    LAS unsigned char* Cb = (LAS unsigned char*)(Bs + 1024);
    LAS unsigned char* Bb = Cb + 16 * QE_ST;
    LAS float* CBm = (LAS float*)(Bb + 16 * QE_ST);
    LAS float* CD = CBm + 256;
    LAS float* red = CD + 128;
    const float* h0base = F.st_ssd + ((size_t)(b * SH + hd) * SP) * SN; float* hobase = F.out + O_SSD_S + ((size_t)(b * SH + hd) * SP) * SN;
    f32x4 hbuf[4][2];
#pragma unroll
    for (int i = 0; i < 4; ++i) { const size_t off = (size_t)(16 * (i & 3) + r) * SN + 32 * (i >> 2) + 8 * q; hbuf[i][0] = *(const f32x4*)(h0base + off); hbuf[i][1] = *(const f32x4*)(h0base + off + 4); }
    float dt[8], cum[8]; { const float A = -__expf(F.A_log[hd]), dtb = F.dt_bias[hd]; float run = 0.f;
#pragma unroll
        for (int t = 0; t < 8; ++t) { dt[t] = softplus_f(F.LRDT[(size_t)(row0 + t) * 32 + 16 + hd] + dtb); run += dt[t] * A; cum[t] = run; } }
    const float last = cum[7], elast = __expf(last);
    if (lane < 8) { float cv = cum[0], dv = dt[0];
#pragma unroll
        for (int t = 1; t < 8; ++t) { cv = (lane == t) ? cum[t] : cv; dv = (lane == t) ? dt[t] : dv; }
        CD[w * 16 + lane] = cv; CD[w * 16 + 8 + lane] = dv; }
    { float xr[11]; const float cb = F.sconv_b[ch], c0 = F.sconv_w[ch], c1 = F.sconv_w[SCH + ch], c2 = F.sconv_w[2 * SCH + ch], c3 = F.sconv_w[3 * SCH + ch];
#pragma unroll
        for (int i = 0; i < 11; ++i) xr[i] = xbc_raw(F, 1, b, row0, i - 3, ch);
        float xw[8];
#pragma unroll
        for (int t = 0; t < 8; ++t) { const float x = silu_f(cb + c0 * xr[t] + c1 * xr[t + 1] + c2 * xr[t + 2] + c3 * xr[t + 3]); Xs[t * 512 + tid] = x; xw[t] = x * __expf(last - cum[t]) * dt[t]; }
        *(LAS f32x4*)(XW + tid * 8) = (f32x4){xw[0], xw[1], xw[2], xw[3]}; *(LAS f32x4*)(XW + tid * 8 + 4) = (f32x4){xw[4], xw[5], xw[6], xw[7]}; }
    if (tid < 256) { const int n = tid & 127, isC = tid >> 7, cc = 1024 + isC * 256 + g * 128 + n;
        float xr[11]; const float cb = F.sconv_b[cc], c0 = F.sconv_w[cc], c1 = F.sconv_w[SCH + cc], c2 = F.sconv_w[2 * SCH + cc], c3 = F.sconv_w[3 * SCH + cc];
#pragma unroll
        for (int i = 0; i < 11; ++i) xr[i] = xbc_raw(F, 1, b, row0, i - 3, cc);
#pragma unroll
        for (int t = 0; t < 8; ++t) { const float x = silu_f(cb + c0 * xr[t] + c1 * xr[t + 1] + c2 * xr[t + 2] + c3 * xr[t + 3]);
            if (!isC) Bs[t * 128 + n] = x;
            *(LAS bf16*)((isC ? Cb : Bb) + t * QE_ST + n * 2) = (bf16)f2bf(x); }
    } else { const int i = tid - 256, which = i >> 7, j = i & 127; *(LAS v4u*)((which ? Bb : Cb) + (8 + (j >> 4)) * QE_ST + (j & 15) * 16) = (v4u){0u, 0u, 0u, 0u}; }
    __syncthreads();
    if (w == 0) { f32x4 a4 = (f32x4){0.f, 0.f, 0.f, 0.f};
#pragma unroll
        for (int ks = 0; ks < 4; ++ks) a4 = MFMA16(frag_k(Bb, QE_ST, 0, 32 * ks, r, q), frag_k(Cb, QE_ST, 0, 32 * ks, r, q), a4);
        *(LAS f32x4*)(CBm + r * 16 + 4 * q) = a4; }
    bf16x8v bc[4];
#pragma unroll
    for (int ks = 0; ks < 4; ++ks) bc[ks] = frag_k(Cb, QE_ST, 0, 32 * ks, r, q);
    f32x4 acc[4];
#pragma unroll
    for (int pf = 0; pf < 4; ++pf) acc[pf] = (f32x4){0.f, 0.f, 0.f, 0.f};
    f32x4 Bv[8][2];
#pragma unroll
    for (int st = 0; st < 16; ++st) { const int ks = st >> 2, pf = st & 3;
        if (pf == 0) {
#pragma unroll
            for (int s = 0; s < 8; ++s) { Bv[s][0] = *(const LAS f32x4*)(Bs + s * 128 + 32 * ks + 8 * q); Bv[s][1] = *(const LAS f32x4*)(Bs + s * 128 + 32 * ks + 8 * q + 4); } }
        const int p = 16 * pf + r; const size_t off = (size_t)p * SN + 32 * ks + 8 * q;
        const f32x4 ha = hbuf[st & 3][0], hb = hbuf[st & 3][1];
        if (st + 4 < 16) { const int st2 = st + 4; const size_t off2 = (size_t)(16 * (st2 & 3) + r) * SN + 32 * (st2 >> 2) + 8 * q; hbuf[st & 3][0] = *(const f32x4*)(h0base + off2); hbuf[st & 3][1] = *(const f32x4*)(h0base + off2 + 4); }
        asm volatile("" ::: "memory");
        const f32x4 x0 = *(const LAS f32x4*)(XW + (64 * w + p) * 8), x1 = *(const LAS f32x4*)(XW + (64 * w + p) * 8 + 4);
        f32x4 na = ha * elast, nb = hb * elast;
        na = na + Bv[0][0] * x0.x; nb = nb + Bv[0][1] * x0.x; na = na + Bv[1][0] * x0.y; nb = nb + Bv[1][1] * x0.y; na = na + Bv[2][0] * x0.z; nb = nb + Bv[2][1] * x0.z; na = na + Bv[3][0] * x0.w; nb = nb + Bv[3][1] * x0.w;
        na = na + Bv[4][0] * x1.x; nb = nb + Bv[4][1] * x1.x; na = na + Bv[5][0] * x1.y; nb = nb + Bv[5][1] * x1.y; na = na + Bv[6][0] * x1.z; nb = nb + Bv[6][1] * x1.z; na = na + Bv[7][0] * x1.w; nb = nb + Bv[7][1] * x1.w;
        *(f32x4*)(hobase + off) = na; *(f32x4*)(hobase + off + 4) = nb;
        const v4u ap = (v4u){pk2(ha.x, ha.y), pk2(ha.z, ha.w), pk2(hb.x, hb.y), pk2(hb.z, hb.w)};
        acc[pf] = MFMA16(__builtin_bit_cast(bf16x8v, ap), bc[ks], acc[pf]); }
    __syncthreads();
    const int tc = r & 7; const float ct = CD[w * 16 + tc], ect = __expf(ct), Dh = F.ssd_D[hd];
    float L[8]; { const f32x4 c0 = *(const LAS f32x4*)(CBm + r * 16), c1 = *(const LAS f32x4*)(CBm + r * 16 + 4); const float cbv[8] = {c0.x, c0.y, c0.z, c0.w, c1.x, c1.y, c1.z, c1.w};
        const f32x4 q0 = *(const LAS f32x4*)(CD + w * 16), q1 = *(const LAS f32x4*)(CD + w * 16 + 4), d0 = *(const LAS f32x4*)(CD + w * 16 + 8), d1 = *(const LAS f32x4*)(CD + w * 16 + 12);
        const float cu[8] = {q0.x, q0.y, q0.z, q0.w, q1.x, q1.y, q1.z, q1.w}, dd[8] = {d0.x, d0.y, d0.z, d0.w, d1.x, d1.y, d1.z, d1.w};
#pragma unroll
        for (int s = 0; s < 8; ++s) L[s] = (s <= tc) ? cbv[s] * __expf(ct - cu[s]) * dd[s] : 0.f; }
    float ss = 0.f; const size_t row = (size_t)(row0 + tc);
#pragma unroll
    for (int pf = 0; pf < 4; ++pf) { const int p4 = 64 * w + 16 * pf + 4 * q;
        f32x4 y = acc[pf] * ect;
#pragma unroll
        for (int s = 0; s < 8; ++s) y = y + *(const LAS f32x4*)(Xs + s * 512 + p4) * L[s];
        const f32x4 xt = *(const LAS f32x4*)(Xs + tc * 512 + p4); const v2u zv = *(const v2u*)(F.PROJ + row * NP + CZ + g * 512 + p4);
        y.x = (y.x + Dh * xt.x) * silu_f(bflo(zv.x)); y.y = (y.y + Dh * xt.y) * silu_f(bfhi(zv.x)); y.z = (y.z + Dh * xt.z) * silu_f(bflo(zv.y)); y.w = (y.w + Dh * xt.w) * silu_f(bfhi(zv.y));
        acc[pf] = y; ss += (y.x * y.x + y.y * y.y) + (y.z * y.z + y.w * y.w); }
    ss += __shfl_xor(ss, 16); ss += __shfl_xor(ss, 32);
    if (q == 0) red[w * 16 + r] = ss;
    __syncthreads();
    float tot = 0.f;
#pragma unroll
    for (int ww = 0; ww < 8; ++ww) tot += red[ww * 16 + r];
    const float rr = rsqrtf(tot * (1.f / 512.f) + EPS);
    if (r < 8) {
#pragma unroll
        for (int pf = 0; pf < 4; ++pf) { const int p4 = g * 512 + 64 * w + 16 * pf + 4 * q; const f32x4 nw = *(const f32x4*)(F.ssd_norm + p4);
            f32x4 o = acc[pf]; o.x *= rr * nw.x; o.y *= rr * nw.y; o.z *= rr * nw.z; o.w *= rr * nw.w;
            *(v2u*)(F.MIXIN + row * DM + 1024 + p4) = pk4(o); } }
    __syncthreads();
}

__device__ __forceinline__ void p2a_chunk_states(Frame& F) {
    for (int idx = F.bid; idx < 768; idx += F.G) { if (idx < 256) { TBEGIN(F, 20); ssd_passA_unit(F, idx); TEND(F, 20); } else { TBEGIN(F, 21); gla_passA_unit(F, idx - 256); TEND(F, 21); } }
}
#ifndef MK_REP_PHASE
#define MK_REP_PHASE (-1)
#endif
__device__ __forceinline__ void p2b_scans_and_sample(Frame& F) {
    TBEGIN(F, 30); for (int rep = 0; rep < (MK_REP_PHASE == 30 ? 2 : 1); ++rep) { gla_scan(F); ssd_scan(F); } TEND(F, 30);
    TBEGIN(F, 31);
    for (int rep = 0; rep < (MK_REP_PHASE == 31 ? 2 : 1); ++rep)
    { f32x4 S[16]; int idx = F.bid;
            if (idx < SB * GH) { const f32x4* s0 = (const f32x4*)(F.st_gla + ((size_t)idx * GK + 16 * F.wave) * GV) + F.lane;
#pragma unroll
                for (int i = 0; i < 16; ++i) S[i] = s0[i * 64]; }
            for (; idx < SB * GH; idx += F.G) { const int nx = idx + F.G; gla_sample_unit(F, idx / GH, idx % GH, S, nx / GH, nx % GH, nx < SB * GH); } }
    TEND(F, 31); TBEGIN(F, 32);
    for (int rep = 0; rep < (MK_REP_PHASE == 32 ? 2 : 1); ++rep)
        for (int idx = F.bid; idx < SB * SG; idx += F.G) ssd_sample_unit(F, idx / SG, idx % SG);
    TEND(F, 32);
}
__device__ __forceinline__ void p2c_outputs(Frame& F) {
    for (int idx = F.bid; idx < 768; idx += F.G) { if (idx < 256) { TBEGIN(F, 40); ssd_passC_unit(F, idx); TEND(F, 40); } else { TBEGIN(F, 41); gla_passC_unit(F, idx - 256); TEND(F, 41); } }
    TBEGIN(F, 42);
    const int gt = F.bid * NTHR + F.tid, NT = F.G * NTHR;
    for (int i = gt; i < (PB + SB) * 3 * SCH; i += NT) { const int c = i % SCH, j = (i / SCH) % 3, s = i / (3 * SCH);
        const int grp = s >= PB, b = grp ? s - PB : s, L = grp ? SL : PL, row0 = grp ? MP + b * SL : b * PL;
        F.out[(grp ? O_SCONV_S : O_SCONV_P) + ((size_t)b * 3 + j) * SCH + c] = bf2f(F.PROJ[(size_t)(row0 + L - 3 + j) * NP + CX + c]); }
    TEND(F, 42);
}

__device__ __forceinline__ void p4_post_mixer(Frame& F) {
    const int gw = F.bid * NWAVES + F.wave, NGW = F.G * NWAVES, lane = F.lane;
    for (int m = gw; m < M; m += NGW) {
        const f32x4* mr = (const f32x4*)(F.MIX + (size_t)m * DM) + lane; const f32x4* xr = (const f32x4*)x_row(F, m) + lane;
        const f32x4* w1 = (const f32x4*)F.n_mix_post + lane; const f32x4* w2 = (const f32x4*)F.n_ffn_pre + lane;
        f32x4 v[8]; float s = 0.f;
#pragma unroll
        for (int j = 0; j < 8; ++j) { v[j] = mr[64 * j]; s += (v[j].x * v[j].x + v[j].y * v[j].y) + (v[j].z * v[j].z + v[j].w * v[j].w); }
        const float r1 = rsqrtf(wave_sum(s) * (1.f / DM) + EPS); float s2 = 0.f;
        f32x4* ho = (f32x4*)(F.out + O_Y + (size_t)m * DM) + lane;
#pragma unroll
        for (int j = 0; j < 8; ++j) { v[j] = xr[64 * j] + v[j] * r1 * w1[64 * j]; ho[64 * j] = v[j]; s2 += (v[j].x * v[j].x + v[j].y * v[j].y) + (v[j].z * v[j].z + v[j].w * v[j].w); }
        const float r2 = rsqrtf(wave_sum(s2) * (1.f / DM) + EPS);
        v2u* o8 = (v2u*)(F.XN + (size_t)m * DM) + lane;
#pragma unroll
        for (int j = 0; j < 8; ++j) { const f32x4 ww = w2[64 * j]; v2u o; o.x = pk2(v[j].x * r2 * ww.x, v[j].y * r2 * ww.y); o.y = pk2(v[j].z * r2 * ww.z, v[j].w * r2 * ww.w); o8[64 * j] = o; }
    }
}
__device__ __forceinline__ void p6_conv_fixup(Frame& F) {
    const int gt = F.bid * NTHR + F.tid, NT = F.G * NTHR;
    constexpr int NQ = FF / 4;
    for (int it = gt; it < 28 * 2 * NQ; it += NT) { const int c = (it % NQ) * 4, rr = (it / NQ) & 1, bi = it / (2 * NQ), pm = (bi / 7) * 8 + 1 + (bi % 7);
        f32x4 o[2];
#pragma unroll
        for (int hf = 0; hf < 2; ++hf) { const int cc = hf * FF + c;
            const f32x4 w0 = *(const f32x4*)(F.fconv_w + cc), w1 = *(const f32x4*)(F.fconv_w + FF2 + cc), w2 = *(const f32x4*)(F.fconv_w + 2 * FF2 + cc), bs = *(const f32x4*)(F.fconv_b + cc);
            const f32x4 um2 = *(const f32x4*)(F.HG + ((size_t)(pm - 1) * 4 + 2 + rr) * FF2 + cc);
            const f32x4 um1 = rr ? *(const f32x4*)(F.HG + ((size_t)pm * 4) * FF2 + cc) : *(const f32x4*)(F.HG + ((size_t)(pm - 1) * 4 + 3) * FF2 + cc);
            const f32x4 u0 = *(const f32x4*)(F.HG + ((size_t)pm * 4 + rr) * FF2 + cc);
            o[hf] = bs + w0 * um2 + w1 * um1 + w2 * u0; }
        v2u pk; pk.x = pk2(silu_f(o[0].x) * o[1].x, silu_f(o[0].y) * o[1].y); pk.y = pk2(silu_f(o[0].z) * o[1].z, silu_f(o[0].w) * o[1].w);
        *(v2u*)(F.ACT + (size_t)(pm * 256 + rr) * FF + c) = pk; }
    for (int i = gt; i < PB * 2 * (FF2 / 4); i += NT) { const int c = (i % (FF2 / 4)) * 4, j = (i / (FF2 / 4)) & 1, b = i / (2 * (FF2 / 4));
        *(f32x4*)(F.out + O_FCONV_P + ((size_t)b * 2 + j) * FF2 + c) = *(const f32x4*)(F.HG + ((size_t)(b * 8 + 7) * 4 + 2 + j) * FF2 + c); }
}
__device__ __forceinline__ void p8_final(Frame& F) {
    const int gw = F.bid * NWAVES + F.wave, NGW = F.G * NWAVES, lane = F.lane;
    for (int m = gw; m < M; m += NGW) {
        const f32x4* fr = (const f32x4*)(F.Fb + (size_t)m * DM) + lane; const f32x4* w1 = (const f32x4*)F.n_ffn_post + lane;
        f32x4* ho = (f32x4*)(F.out + O_Y + (size_t)m * DM) + lane;
        f32x4 v[8]; float s = 0.f;
#pragma unroll
        for (int j = 0; j < 8; ++j) { v[j] = fr[64 * j]; s += (v[j].x * v[j].x + v[j].y * v[j].y) + (v[j].z * v[j].z + v[j].w * v[j].w); }
        const float r1 = rsqrtf(wave_sum(s) * (1.f / DM) + EPS);
#pragma unroll
        for (int j = 0; j < 8; ++j) ho[64 * j] = ho[64 * j] + v[j] * r1 * w1[64 * j];
    }
}

__device__ __forceinline__ pg8::SplitCtx split_ctx(const Frame& F, unsigned char* ws, size_t slab_off, int bank) {
    pg8::SplitCtx X; X.slabs = (pg8::f32x4*)(ws + slab_off); X.cnt = (unsigned*)(ws + WS_CTL) + CW_SPLIT + bank * 1024; X.flag = (volatile LAS unsigned*)(F.lds + MISC_OFF) + 16; X.id = bank; return X; }

struct Args { const float* in[25]; float* out; unsigned char* ws; int ph_lo, ph_hi; };
__global__ void __launch_bounds__(NTHR, 2) fwd_kernel(Args args) {
    extern __shared__ __attribute__((aligned(16))) unsigned char lds[];
    Frame F;
    F.lds = (LAS unsigned char*)lds;
    F.tid = threadIdx.x; F.lane = F.tid & 63; F.wave = __builtin_amdgcn_readfirstlane(F.tid >> 6);
    F.G = gridDim.x; F.bid = blockIdx.x;
    unsigned char* ws = args.ws;
    F.x_p = args.in[0]; F.x_s = args.in[1]; F.st_gla = args.in[2]; F.st_ssd = args.in[3]; F.st_sconv = args.in[4]; F.st_fconv = args.in[5];
    F.n_mix_pre = args.in[6]; F.n_mix_post = args.in[7]; F.n_ffn_pre = args.in[8]; F.n_ffn_post = args.in[9]; F.w_in = args.in[10];
    F.w_gate2 = args.in[11]; F.b_gate = args.in[12]; F.gla_norm = args.in[13]; F.sconv_w = args.in[14]; F.sconv_b = args.in[15];
    F.dt_bias = args.in[16]; F.A_log = args.in[17]; F.ssd_D = args.in[18]; F.ssd_norm = args.in[19]; F.w_out = args.in[20];
    F.ffn_w_in = args.in[21]; F.fconv_w = args.in[22]; F.fconv_b = args.in[23]; F.ffn_w_out = args.in[24];
    F.out = args.out;
    F.W1 = (bf16*)(ws + WS_W1); F.WO = (bf16*)(ws + WS_WO); F.WF1 = (bf16*)(ws + WS_WF1); F.WF2 = (bf16*)(ws + WS_WF2);
    F.XN = (bf16*)(ws + WS_XN); F.PROJ = (bf16*)(ws + WS_PROJ); F.MIXIN = (bf16*)(ws + WS_MIXIN); F.ACT = (bf16*)(ws + WS_ACT); F.HG = (float*)(ws + WS_HG);
    F.LRDT = (float*)(ws + WS_LRDT); F.MIX = (float*)(ws + WS_MIX); F.Fb = (float*)(ws + WS_F);
    F.DS = (bf16*)(ws + WS_DS); F.SC = (bf16*)(ws + WS_SC); F.DH = (bf16*)(ws + WS_DH); F.HC = (bf16*)(ws + WS_HC); F.EBL = (float*)(ws + WS_EBL); F.AL = (float*)(ws + WS_AL); F.QEg = (bf16*)(ws + WS_QEG); F.KEg = (bf16*)(ws + WS_KEG);
    for (int u = F.tid; u < (LDS_BYTES - LDSCTL_OFF) / 4; u += NTHR) ((LAS unsigned*)(F.lds + LDSCTL_OFF))[u] = 0u;
    __syncthreads();
    const int lo = args.ph_lo, hi = args.ph_hi;
#if !MK_PER_PHASE
    XcdBarrier bar = xcd_barrier_post((unsigned*)(ws + WS_CTL) + CW_BAR, (volatile LAS unsigned*)(F.lds + MISC_OFF) + 8);
#define GRID_BAR() do { if (args.ph_hi > 1000) cg::this_grid().sync(); xcd_barrier(bar); } while (0)
#else
#define GRID_BAR() do { } while (0)
#endif
#define IN(k) (lo <= (k) && (k) < hi)
#define SEAM(k) do { if (IN(k) && IN((k) + 1)) GRID_BAR(); } while (0)
    F.tacc = 0; F.tmark = 0;
#define PHASE(k, ...) do { if (IN(k)) { TBEGIN(F, k); if (MK_REP_PHASE == (k)) { __VA_ARGS__; GRID_BAR(); } TBEGIN(F, 100 + (k)); __VA_ARGS__; TEND(F, 100 + (k)); SEAM(k); TEND(F, k); } } while (0)
    PHASE(0, p0_prologue(F));
    PHASE(1, { pg8::Gemm g{F.XN, F.W1, M, N1, DM}; pg8::StaticOrder S; S.init(M, N1, DM, F.G, F.bid, 1);
        pg8::EpiBf16 E{F.PROJ, NP, NP / 256, F.LRDT};
        pg8::gemm_phase<pg8::EpiBf16, pg8::StaticOrder, true, true>(F.lds, g, S, E, split_ctx(F, ws, WS_SLAB, 0));
        if (S.rem && F.bid >= S.rem * S.S) p0_convert_rest(F, F.bid - S.rem * S.S, F.G - S.rem * S.S); else if (!S.rem) p0_convert_rest(F, F.bid, F.G); });
    PHASE(2, p2a_chunk_states(F));
    PHASE(3, p2b_scans_and_sample(F));
    PHASE(4, p2c_outputs(F));
    PHASE(5, { pg8::Gemm g{F.MIXIN, F.WO, M, DM, DM}; pg8::StaticOrder S; S.init(M, DM, DM, F.G, F.bid, 4);
        pg8::EpiF32 E{F.MIX, DM};
        pg8::gemm_phase<pg8::EpiF32, pg8::StaticOrder, true, true>(F.lds, g, S, E, split_ctx(F, ws, WS_SLAB, 1)); });
    PHASE(6, p4_post_mixer(F));
    PHASE(7, { pg8::Gemm g{F.XN, F.WF1, M, FF2, DM}; pg8::StaticOrder S; S.init(M, FF2, DM, F.G, F.bid, 1, MS / 256);
        pg8::EpiConvAct E{F.ACT, F.HG, F.fconv_w, F.fconv_b, F.st_fconv, F.out + O_FCONV_S, (LAS float*)(F.lds + MISC_OFF + 512)};
        TBEGIN(F, 70); pg8::gemm_phase<pg8::EpiConvAct, pg8::StaticOrder, true, true>(F.lds, g, S, E, split_ctx(F, ws, WS_SLAB, 2)); TEND(F, 70); });
    PHASE(8, p6_conv_fixup(F));
    PHASE(9, { pg8::Gemm g{F.ACT, F.WF2, M, DM, FF}; pg8::StaticOrder S; S.init(M, DM, FF, F.G, F.bid, 4);
        pg8::EpiF32 E{F.Fb, DM};
        pg8::gemm_phase<pg8::EpiF32, pg8::StaticOrder, true, true>(F.lds, g, S, E, split_ctx(F, ws, WS_SLAB, 3)); });
    if (IN(10)) { TBEGIN(F, 10); p8_final(F); if (MK_TIME_PHASE == 10) { asm volatile("s_waitcnt vmcnt(0)" ::: "memory"); __syncthreads(); } TEND(F, 10); }
    if (MK_TIME_PHASE >= 50 && MK_TIME_PHASE < 70) F.tacc = ((volatile LAS unsigned*)(F.lds + MISC_OFF))[16 + 2];
    if (MK_TIME_PHASE >= 0 && F.bid == 0) { const unsigned long long te = __builtin_amdgcn_s_memrealtime(), d = 8ull * F.tacc; while (__builtin_amdgcn_s_memrealtime() - te < d) __builtin_amdgcn_s_sleep(16); }
#undef IN
#undef SEAM
}

extern "C" void kernel_launch(void* const* d_in, const int* in_sizes, int n_in, void* d_out, int out_size, void* d_ws, size_t ws_size, hipStream_t stream) {
    static int grid = 0;
    if (grid == 0) {
        if (n_in != 25 || (size_t)out_size != O_END || ws_size < WS_END) { fprintf(stderr, "kernel_launch: unexpected sizes n_in %d out %d ws %zu (need out %zu ws %zu)\n", n_in, out_size, ws_size, (size_t)O_END, (size_t)WS_END); grid = -1; return; }
        int dev = 0, cus = 0, per_cu = 0;
        hipGetDevice(&dev); hipDeviceGetAttribute(&cus, hipDeviceAttributeMultiprocessorCount, dev);
        if (hipFuncSetAttribute((const void*)fwd_kernel, hipFuncAttributeMaxDynamicSharedMemorySize, LDS_BYTES) != hipSuccess) { fprintf(stderr, "kernel_launch: hipFuncSetAttribute failed\n"); grid = -1; return; }
        hipOccupancyMaxActiveBlocksPerMultiprocessor(&per_cu, (const void*)fwd_kernel, NTHR, LDS_BYTES);
        if (per_cu < 1) { fprintf(stderr, "kernel_launch: occupancy query says %d blocks per CU\n", per_cu); grid = -1; return; }
        grid = cus;
        (void)hipGetLastError();
    }
    if (grid < 0) return;
    Args a{};
    for (int i = 0; i < 25; ++i) a.in[i] = (const float*)d_in[i];
    a.out = (float*)d_out; a.ws = (unsigned char*)d_ws;
#if MK_PER_PHASE
    hipMemsetAsync((char*)d_ws + WS_CTL, 0, CTL_ZERO_BYTES, stream);
    for (int p = 0; p < N_PHASES; ++p) { a.ph_lo = p; a.ph_hi = p + 1; hipLaunchKernelGGL(fwd_kernel, dim3(grid), dim3(NTHR), LDS_BYTES, stream, a); }
#else
    hipMemsetAsync((char*)d_ws + WS_CTL, 0, CTL_ZERO_BYTES, stream);
    a.ph_lo = 0; a.ph_hi = N_PHASES;
    void* kargs[] = {&a};
    hipError_t e = hipLaunchCooperativeKernel((const void*)fwd_kernel, dim3(grid), dim3(NTHR), kargs, LDS_BYTES, stream);
    if (e != hipSuccess) fprintf(stderr, "kernel_launch: cooperative launch failed: %s (grid %d)\n", hipGetErrorString(e), grid);
#endif
}
```

```cpp
#include <hip/hip_runtime.h>
#include <hip/hip_cooperative_groups.h>
#include <cstdio>
#include <cstdint>
namespace cg = cooperative_groups;

#ifndef MK_TIME_PHASE
#define MK_TIME_PHASE (-1)
#endif
#ifndef MK_PER_PHASE
#define MK_PER_PHASE 0
#endif

namespace pg8 {
#define PG8_LAS __attribute__((address_space(3)))
typedef unsigned short bf16_t;
typedef short bf16x8 __attribute__((ext_vector_type(8)));
typedef float f32x4 __attribute__((ext_vector_type(4)));
typedef unsigned u32x4 __attribute__((ext_vector_type(4)));
constexpr int BM = 256, BK = 64, HALF = 128, HTB = HALF * BK * 2  , STAGE_BYTES = 8 * HTB, NXCD = 8, WGM = 8;

__host__ __device__ __forceinline__ int lds_byte(int r, int c) { const int st = (r >> 4) * 2 + (c >> 5), rr = r & 15, cc = c & 31, ob = rr * 64 + cc * 2; return st * 1024 + (ob ^ (((ob >> 9) & 1) << 5)); }
__host__ __device__ __forceinline__ void stage_rc(int b, int& R, int& C) { const int st = b / 1024, sb = b % 1024, swz = sb ^ (((sb >> 9) & 1) << 5); R = (st >> 1) * 16 + swz / 64; C = (st & 1) * 32 + (swz % 64) / 2; }
__host__ __device__ __forceinline__ int perm32(int rho) { const int n = rho >> 4, i = rho & 15; return 8 * (i >> 2) + 4 * n + (i & 3); }

struct Unit { int pm, pn, k0, nk, slice, nsl, tix; };
struct Gemm { const bf16_t* A; const bf16_t* Bt; int M, N, K; };

struct StaticOrder {
    int nM, nN, nwg, G, c, rounds, rem, S, ntK, nSp;
    __host__ __device__ __forceinline__ void init(int M, int N, int K, int G_, int c_, int Smax, int nSp_ = 0) { nM = M / BM; nN = N / BM; nwg = nM * nN; G = G_; c = c_; ntK = K / BK; rounds = nwg / G; rem = nwg - rounds * G; S = 1; nSp = nSp_;
        if (rem) { while (S < Smax && rem * (S * 2) <= G && (ntK / 2) >= S * 2) S *= 2; } }
    __host__ __device__ __forceinline__ void tile(int L, Unit& u) const {
        const int nfirst = nSp * nN;
        if (L < nfirst) { u.pm = nM - nSp + (L % nSp); u.pn = L / nSp; return; }
        const int nMp = nM - nSp, nwp = nMp * nN;
        int wgid = L - nfirst; { const int q = nwp / NXCD, r = nwp % NXCD, xcd = wgid % NXCD, off = wgid / NXCD; wgid = (xcd < r ? xcd * (q + 1) : r * (q + 1) + (xcd - r) * q) + off; }
        const int nig = WGM * nN, gid = wgid / nig, fm = gid * WGM, gsz = (nMp - fm) < WGM ? (nMp - fm) : WGM;
        u.pm = fm + ((wgid % nig) % gsz); u.pn = (wgid % nig) / gsz; }
    __host__ __device__ __forceinline__ bool next(int i, Unit& u) const {
        if (i < rounds) { tile(i * G + c, u); u.k0 = 0; u.nk = ntK; u.slice = 0; u.nsl = 1; u.tix = 0; return true; }
        if (i == rounds && c < rem * S) { const int tix = c % rem, sl = c / rem; tile(rounds * G + tix, u);
            const int pairs = ntK / 2, base = pairs / S, extra = pairs % S, np = base + (sl < extra ? 1 : 0), p0 = sl * base + (sl < extra ? sl : extra);
            u.k0 = 2 * p0; u.nk = 2 * np; u.slice = sl; u.nsl = S; u.tix = tix; return true; }
        return false;
    }
    __device__ __forceinline__ void a_ready(const Unit&) const {}
    __device__ __forceinline__ void done(const Unit&) const {}
};
__device__ __forceinline__ unsigned cvt_pk_bf16(float lo, float hi) { unsigned r; asm volatile("v_cvt_pk_bf16_f32 %0, %1, %2" : "=v"(r) : "v"(lo), "v"(hi)); return r; }
struct SplitCtx { f32x4* slabs; unsigned* cnt; volatile PG8_LAS unsigned* flag; int id; };
__device__ __forceinline__ int split_reduce(f32x4 (&acc)[2][2][4][2], const Unit& u, const SplitCtx& X, int tid) {
    const __amdgpu_buffer_rsrc_t rs = __builtin_amdgcn_make_buffer_rsrc((void*)X.slabs, (short)0, (int)0x7fffffff, 0x00020000);
    typedef unsigned u32x2s __attribute__((ext_vector_type(2)));
    const unsigned mine = (unsigned)((u.tix * u.nsl + u.slice) * 32) * 4096u + (unsigned)tid * 8u;
#pragma unroll
    for (int a = 0; a < 2; ++a)
#pragma unroll
        for (int b = 0; b < 2; ++b)
#pragma unroll
            for (int m = 0; m < 4; ++m)
#pragma unroll
                for (int n = 0; n < 2; ++n) { const f32x4 v = acc[a][b][m][n]; __builtin_amdgcn_raw_buffer_store_b64((u32x2s){cvt_pk_bf16(v.x, v.y), cvt_pk_bf16(v.z, v.w)}, rs, mine + (unsigned)((((a * 2 + b) * 4 + m) * 2 + n) * 4096), 0,   16); }
    asm volatile("s_waitcnt vmcnt(0)" ::: "memory");
    __syncthreads();
    if (tid == 0) {
        unsigned* c = X.cnt + 16 * u.tix;
        (void)__hip_atomic_fetch_add(c, 1u, __ATOMIC_RELAXED, __HIP_MEMORY_SCOPE_AGENT);
        unsigned spins = 0;
        while (__hip_atomic_load(c, __ATOMIC_RELAXED, __HIP_MEMORY_SCOPE_AGENT) < (unsigned)u.nsl) { __builtin_amdgcn_s_sleep(2); if (++spins > (1u << 22)) break; }
        __builtin_amdgcn_fence(__ATOMIC_ACQUIRE, "agent");
        asm volatile("s_waitcnt vmcnt(0)" ::: "memory");
    }
    __syncthreads();
    const int shift = u.nsl == 8 ? 2 : (u.nsl == 4 ? 3 : 4);
    for (int s = 0; s < u.nsl; ++s) { if (s == u.slice) continue;
        const u32x2s* o = (const u32x2s*)X.slabs + ((size_t)(u.tix * u.nsl + s) * 32) * 512 + tid;
#pragma unroll
        for (int a = 0; a < 2; ++a)
#pragma unroll
            for (int b = 0; b < 2; ++b)
#pragma unroll
                for (int m = 0; m < 4; ++m)
#pragma unroll
                    for (int n = 0; n < 2; ++n) { const int r4 = ((a * 2 + b) * 4 + m) * 2 + n; if ((r4 >> shift) == u.slice) { const u32x2s p = o[(size_t)r4 * 512]; acc[a][b][m][n] += (f32x4){__builtin_bit_cast(float, p.x << 16), __builtin_bit_cast(float, p.x & 0xffff0000u), __builtin_bit_cast(float, p.y << 16), __builtin_bit_cast(float, p.y & 0xffff0000u)}; } } }
    return shift;
}


struct EpiF32 {
    static constexpr bool PERM = false, AFTER_DRAIN = false;
    float* C; int ldc;
    __device__ __forceinline__ void operator()(const f32x4 (&acc)[2][2][4][2], const Unit& u, int wr, int wc, int fr, int fq, int shift, int part) const {
        const int row0 = u.pm * BM + wr * 64 + fr, col0 = u.pn * BM + wc * 32 + 4 * fq;
#pragma unroll
        for (int ai = 0; ai < 2; ++ai)
#pragma unroll
            for (int m = 0; m < 4; ++m) { float* rowp = C + (size_t)(row0 + ai * HALF + m * 16) * ldc + col0;
#pragma unroll
                for (int bj = 0; bj < 2; ++bj)
#pragma unroll
                    for (int n = 0; n < 2; ++n) if ((((((ai * 2 + bj) * 4 + m) * 2 + n)) >> shift) == part) *(f32x4*)(rowp + bj * HALF + n * 16) = acc[ai][bj][m][n]; }
    }
};
struct EpiBf16 {
    static constexpr bool PERM = true, AFTER_DRAIN = false;
    bf16_t* O; int ldc; int nfull; float* X;
    __device__ __forceinline__ void operator()(const f32x4 (&acc)[2][2][4][2], const Unit& u, int wr, int wc, int fr, int fq, int shift, int part) const {
        const int row0 = u.pm * BM + wr * 64 + fr;
        if (u.pn < nfull) {
            const int col0 = u.pn * BM + wc * 32 + 8 * fq;
#pragma unroll
            for (int ai = 0; ai < 2; ++ai)
#pragma unroll
                for (int m = 0; m < 4; ++m) { bf16_t* rowp = O + (size_t)(row0 + ai * HALF + m * 16) * ldc + col0;
#pragma unroll
                    for (int bj = 0; bj < 2; ++bj) { if ((((((ai * 2 + bj) * 4 + m) * 2)) >> shift) != part) continue; const f32x4 v0 = acc[ai][bj][m][0], v1 = acc[ai][bj][m][1];
                        u32x4 w; w.x = cvt_pk_bf16(v0[0], v0[1]); w.y = cvt_pk_bf16(v0[2], v0[3]); w.z = cvt_pk_bf16(v1[0], v1[1]); w.w = cvt_pk_bf16(v1[2], v1[3]);
                        *(u32x4*)(rowp + bj * HALF) = w; } }
        } else if (wc == 0) {
#pragma unroll
            for (int ai = 0; ai < 2; ++ai)
#pragma unroll
                for (int m = 0; m < 4; ++m) { if ((((((ai * 2) * 4 + m) * 2)) >> shift) != part) continue; float* rowp = X + (size_t)(row0 + ai * HALF + m * 16) * 32 + 8 * fq;
                    *(f32x4*)(rowp) = acc[ai][0][m][0]; *(f32x4*)(rowp + 4) = acc[ai][0][m][1]; }
        }
    }
};

__device__ __forceinline__ float dpp_ror1(float x) { return __builtin_bit_cast(float, __builtin_amdgcn_update_dpp(0, __builtin_bit_cast(int, x), 0x121, 0xF, 0xF, false)); }
__device__ __forceinline__ float dpp_ror2(float x) { return __builtin_bit_cast(float, __builtin_amdgcn_update_dpp(0, __builtin_bit_cast(int, x), 0x122, 0xF, 0xF, false)); }
struct EpiConvAct {
    static constexpr bool PERM = true, AFTER_DRAIN = false;
    static constexpr int FFD = 5632, FFD2 = 11264, MPR = 8192, NPT = 32;
    bf16_t* ACT; float* HG; const float* cw; const float* cbias; const float* st; float* fconv_s; PG8_LAS float* halo;
    __device__ __forceinline__ void operator()(const f32x4 (&acc)[2][2][4][2], const Unit& u, int wr, int wc, int fr, int fq, int, int) const {
        if (u.pm >= NPT) body<true>(acc, u, wr, wc, fr, fq); else body<false>(acc, u, wr, wc, fr, fq); }
    template <bool sample> __device__ __forceinline__ void body(const f32x4 (&acc)[2][2][4][2], const Unit& u, int wr, int wc, int fr, int fq) const {
        const int pm = u.pm, pn = u.pn, cl = wc * 32 + 8 * fq, c0 = pn * 128 + cl;
        if (fr >= 14) {
#pragma unroll
            for (int ai = 0; ai < 2; ++ai)
#pragma unroll
                for (int bj = 0; bj < 2; ++bj)
#pragma unroll
                    for (int n = 0; n < 2; ++n) *(PG8_LAS f32x4*)(halo + ((ai * 2 + wr) * 2 + (fr - 14)) * 256 + bj * 128 + cl + 4 * n) = acc[ai][bj][3][n];
            if (!sample && wr == 1) {
#pragma unroll
                for (int bj = 0; bj < 2; ++bj)
#pragma unroll
                    for (int n = 0; n < 2; ++n) *(f32x4*)(HG + ((size_t)pm * 4 + 2 + (fr - 14)) * FFD2 + bj * FFD + c0 + 4 * n) = acc[1][bj][3][n]; }
        }
        if (fr < 2 && !sample && wr == 0) {
#pragma unroll
            for (int bj = 0; bj < 2; ++bj)
#pragma unroll
                for (int n = 0; n < 2; ++n) *(f32x4*)(HG + ((size_t)pm * 4 + fr) * FFD2 + bj * FFD + c0 + 4 * n) = acc[0][bj][0][n]; }
        __syncthreads();
        const int t8 = fr & 7;
        typedef unsigned u32x2 __attribute__((ext_vector_type(2)));
        u32x2 pk0[2][4];
#pragma unroll
        for (int n = 0; n < 2; ++n) {
            f32x4 w[2][3], bs[2];
#pragma unroll
            for (int bj = 0; bj < 2; ++bj) { bs[bj] = *(const f32x4*)(cbias + bj * FFD + c0 + 4 * n);
#pragma unroll
                for (int j = 0; j < 3; ++j) w[bj][j] = *(const f32x4*)(cw + j * FFD2 + bj * FFD + c0 + 4 * n); }
#pragma unroll
            for (int ai = 0; ai < 2; ++ai) {
                f32x4 r1p[2], r2p[2];
#pragma unroll
                for (int bj = 0; bj < 2; ++bj) { f32x4 pv = (f32x4){0.f, 0.f, 0.f, 0.f};
                    if (fr >= 14 && (wr == 1 || ai == 1)) { const int pa = (wr == 1) ? ai : 0, pw = (wr == 1) ? 0 : 1; pv = *(const PG8_LAS f32x4*)(halo + ((pa * 2 + pw) * 2 + (fr - 14)) * 256 + bj * 128 + cl + 4 * n); }
#pragma unroll
                    for (int j = 0; j < 4; ++j) { r1p[bj][j] = dpp_ror1(pv[j]); r2p[bj][j] = dpp_ror2(pv[j]); } }
#pragma unroll
                for (int m = 0; m < 4; ++m) { const int row = pm * BM + ai * HALF + wr * 64 + m * 16 + fr;
                    f32x4 o[2];
#pragma unroll
                    for (int bj = 0; bj < 2; ++bj) { const f32x4 cur = acc[ai][bj][m][n]; f32x4 p1, p2;
#pragma unroll
                        for (int j = 0; j < 4; ++j) { const float c1 = dpp_ror1(cur[j]), c2 = dpp_ror2(cur[j]); p1[j] = (fr == 0) ? r1p[bj][j] : c1; p2[j] = (fr < 2) ? r2p[bj][j] : c2; r1p[bj][j] = c1; r2p[bj][j] = c2; }
                        if (sample && t8 < 2) { const int sb = (row - MPR) >> 3; const f32x4 s1 = *(const f32x4*)(st + ((size_t)sb * 2 + 1) * FFD2 + bj * FFD + c0 + 4 * n);
                            if (t8 == 0) { p1 = s1; p2 = *(const f32x4*)(st + ((size_t)sb * 2) * FFD2 + bj * FFD + c0 + 4 * n); } else p2 = s1; }
                        o[bj] = bs[bj] + w[bj][0] * p2 + w[bj][1] * p1 + w[bj][2] * cur; }
                    f32x4 g; g.x = o[0].x * __builtin_amdgcn_rcpf(1.f + __expf(-o[0].x)) * o[1].x; g.y = o[0].y * __builtin_amdgcn_rcpf(1.f + __expf(-o[0].y)) * o[1].y;
                    g.z = o[0].z * __builtin_amdgcn_rcpf(1.f + __expf(-o[0].z)) * o[1].z; g.w = o[0].w * __builtin_amdgcn_rcpf(1.f + __expf(-o[0].w)) * o[1].w;
                    const u32x2 pk = (u32x2){cvt_pk_bf16(g.x, g.y), cvt_pk_bf16(g.z, g.w)};
                    if (n == 0) pk0[ai][m] = pk;
                    else *(u32x4*)(ACT + (size_t)row * FFD + c0) = (u32x4){pk0[ai][m].x, pk0[ai][m].y, pk.x, pk.y};
                    if (sample && t8 >= 6) { const int sb = (row - MPR) >> 3;
#pragma unroll
                        for (int bj = 0; bj < 2; ++bj) *(f32x4*)(fconv_s + ((size_t)sb * 2 + (t8 - 6)) * FFD2 + bj * FFD + c0 + 4 * n) = acc[ai][bj][m][n]; }
                }
            }
        }
    }
};

template <class Epi, class Sched, bool ALIGN_EPI = false, bool SP2 = false>
__device__ __forceinline__ void gemm_phase(PG8_LAS unsigned char* lds, const Gemm g, const Sched& S, const Epi& E, const SplitCtx& X) {
    const int tid = threadIdx.x, wid = __builtin_amdgcn_readfirstlane(tid >> 6), lane = tid & 63, wr = wid >> 2, wc = wid & 3, fr = lane & 15, fq = lane >> 4;
    const int K = g.K;
    unsigned voffA[2], voffB[2];
#pragma unroll
    for (int i = 0; i < 2; ++i) { int R, C; stage_rc(tid * 16 + i * 8192, R, C); const int Rb = Epi::PERM ? ((R & ~31) + perm32(R & 31)) : R;
        voffA[i] = (unsigned)(R * K + C) * 2u; voffB[i] = (unsigned)(Rb * K + C) * 2u; }
    const size_t kstep = (size_t)(BK * 2);
    const size_t hstep = (size_t)HALF * K * 2;
    const size_t tstep = 2 * hstep;
    const unsigned ldsw = (unsigned)wid * 1024u;
    const int aoff = lds_byte(wr * 64 + fr, fq * 8), boff = lds_byte(wc * 32 + fr, fq * 8);
#define PG8_SA(b, h) (((b) * 2 + (h)) * HTB)
#define PG8_SB(b, h) ((4 + (b) * 2 + (h)) * HTB)
#define PG8_STAGE(bufoff, gbase, voff) do { _Pragma("unroll") for (int _i = 0; _i < 2; ++_i) \
        __builtin_amdgcn_global_load_lds((const unsigned*)((const char*)(gbase) + (voff)[_i]), (PG8_LAS unsigned*)(lds + (bufoff) + ldsw + _i * 8192), 16, 0, 0); } while (0)
#define PG8_LDA(dst, b, h) do { _Pragma("unroll") for (int m = 0; m < 4; ++m) _Pragma("unroll") for (int k = 0; k < 2; ++k) dst[m][k] = *(const PG8_LAS bf16x8*)(lds + PG8_SA(b, h) + aoff + m * 2048 + k * 1024); } while (0)
#define PG8_LDB(dst, b, h) do { _Pragma("unroll") for (int n = 0; n < 2; ++n) _Pragma("unroll") for (int k = 0; k < 2; ++k) dst[n][k] = *(const PG8_LAS bf16x8*)(lds + PG8_SB(b, h) + boff + n * 2048 + k * 1024); } while (0)
#define PG8_MMA(ai, bj, At, Bt) do { __builtin_amdgcn_s_setprio(1); _Pragma("unroll") for (int m = 0; m < 4; ++m) _Pragma("unroll") for (int n = 0; n < 2; ++n) _Pragma("unroll") for (int k = 0; k < 2; ++k) \
        acc[ai][bj][m][n] = __builtin_amdgcn_mfma_f32_16x16x32_bf16(Bt[n][k], At[m][k], acc[ai][bj][m][n], 0, 0, 0); __builtin_amdgcn_s_setprio(0); } while (0)
#define PG8_WAIT_V(n) asm volatile("s_waitcnt vmcnt(" #n ")" ::: "memory")
#define PG8_WAIT_L(n) asm volatile("s_waitcnt lgkmcnt(" #n ")" ::: "memory")
#define PG8_BAR __builtin_amdgcn_s_barrier()
#define PG8_SCHED __builtin_amdgcn_sched_barrier(0)
    Unit cur, nxt; int ui = 0;
    if (!S.next(0, cur)) return;
    f32x4 acc[2][2][4][2];
#pragma unroll
    for (int a = 0; a < 2; ++a)
#pragma unroll
        for (int b = 0; b < 2; ++b)
#pragma unroll
            for (int m = 0; m < 4; ++m)
#pragma unroll
                for (int n = 0; n < 2; ++n) acc[a][b][m][n] = (f32x4){0.f, 0.f, 0.f, 0.f};
    bf16x8 At[4][2], B0[2][2], B1[2][2];
    const char* cA = (const char*)g.A + (size_t)cur.pm * tstep + (size_t)cur.k0 * kstep; const char* cB = (const char*)g.Bt + (size_t)cur.pn * tstep + (size_t)cur.k0 * kstep;
    S.a_ready(cur);
    if constexpr (SP2) {
        PG8_STAGE(PG8_SB(0, 0), cB, voffB); PG8_STAGE(PG8_SB(0, 1), cB + hstep, voffB); PG8_STAGE(PG8_SA(0, 0), cA, voffA); PG8_STAGE(PG8_SA(0, 1), cA + hstep, voffA);
        if (wr == 1) PG8_BAR;
        PG8_WAIT_V(2); PG8_BAR;
        PG8_STAGE(PG8_SB(1, 0), cB + kstep, voffB); PG8_STAGE(PG8_SA(1, 0), cA + kstep, voffA); PG8_STAGE(PG8_SB(1, 1), cB + hstep + kstep, voffB);
        PG8_WAIT_V(6); PG8_BAR;
    } else {
        PG8_STAGE(PG8_SB(0, 0), cB, voffB); PG8_STAGE(PG8_SA(0, 0), cA, voffA); PG8_STAGE(PG8_SB(0, 1), cB + hstep, voffB); PG8_STAGE(PG8_SA(0, 1), cA + hstep, voffA);
        if (wr == 1) PG8_BAR;
        PG8_WAIT_V(4); PG8_BAR;
        PG8_STAGE(PG8_SB(1, 0), cB + kstep, voffB); PG8_STAGE(PG8_SA(1, 0), cA + kstep, voffA); PG8_STAGE(PG8_SB(1, 1), cB + hstep + kstep, voffB);
        PG8_WAIT_V(6); PG8_BAR;
    }
    for (;;) {
        const bool has_next = S.next(ui + 1, nxt);
        const char* nA = has_next ? (const char*)g.A + (size_t)nxt.pm * tstep + (size_t)nxt.k0 * kstep : cA; const char* nB = has_next ? (const char*)g.Bt + (size_t)nxt.pn * tstep + (size_t)nxt.k0 * kstep : cB;
        const int nt = cur.nk;
        unsigned long long tsu = 0; if (MK_TIME_PHASE == 50 + X.id && cur.nsl > 1) tsu = __builtin_amdgcn_s_memrealtime();
        for (int t = 0; t < nt; t += 2) {
            const bool last = (t == nt - 2);
            const char* a1 = cA + (size_t)(t + 1) * kstep;
            const char* a2 = last ? nA : cA + (size_t)(t + 2) * kstep; const char* b2 = last ? nB : cB + (size_t)(t + 2) * kstep;
            const char* a3 = a2 + kstep; const char* b3 = b2 + kstep;
            if (last && has_next) S.a_ready(nxt);
            if constexpr (SP2) {
            PG8_LDB(B0, 0, 0); PG8_LDB(B1, 0, 1); PG8_SCHED; PG8_LDA(At, 0, 0); PG8_STAGE(PG8_SA(1, 1), a1 + hstep, voffA);
            PG8_WAIT_V(8); PG8_WAIT_L(0); PG8_BAR; PG8_MMA(0, 0, At, B0); PG8_MMA(0, 1, At, B1); PG8_BAR; PG8_SCHED;
            PG8_LDA(At, 0, 1); PG8_STAGE(PG8_SB(0, 0), b2, voffB); PG8_STAGE(PG8_SB(0, 1), b2 + hstep, voffB); PG8_STAGE(PG8_SA(0, 0), a2, voffA);
            PG8_WAIT_V(8); PG8_WAIT_L(0); PG8_BAR; PG8_MMA(1, 0, At, B0); PG8_MMA(1, 1, At, B1); PG8_BAR; PG8_SCHED;
            PG8_LDB(B0, 1, 0); PG8_LDB(B1, 1, 1); PG8_SCHED; PG8_LDA(At, 1, 0); PG8_STAGE(PG8_SA(0, 1), a2 + hstep, voffA);
            PG8_WAIT_V(8); PG8_WAIT_L(0); PG8_BAR; PG8_MMA(0, 0, At, B0); PG8_MMA(0, 1, At, B1); PG8_BAR; PG8_SCHED;
            PG8_LDA(At, 1, 1); PG8_STAGE(PG8_SB(1, 0), b3, voffB); PG8_STAGE(PG8_SB(1, 1), b3 + hstep, voffB); PG8_STAGE(PG8_SA(1, 0), a3, voffA);
            PG8_WAIT_V(8); PG8_WAIT_L(0); PG8_BAR; PG8_MMA(1, 0, At, B0); PG8_MMA(1, 1, At, B1); PG8_BAR; PG8_SCHED;
            } else {
            PG8_LDB(B0, 0, 0); PG8_SCHED; PG8_LDA(At, 0, 0); PG8_STAGE(PG8_SA(1, 1), a1 + hstep, voffA);
            PG8_WAIT_L(8); PG8_BAR; PG8_WAIT_L(0); PG8_MMA(0, 0, At, B0); PG8_BAR; PG8_SCHED;
            PG8_LDB(B1, 0, 1); PG8_STAGE(PG8_SB(0, 0), b2, voffB);
            PG8_BAR; PG8_WAIT_L(0); PG8_MMA(0, 1, At, B1); PG8_BAR;
            PG8_LDA(At, 0, 1); PG8_STAGE(PG8_SA(0, 0), a2, voffA);
            PG8_BAR; PG8_WAIT_L(0); PG8_MMA(1, 0, At, B0); PG8_BAR; PG8_SCHED;
            PG8_STAGE(PG8_SB(0, 1), b2 + hstep, voffB);
            PG8_WAIT_V(6); PG8_BAR; PG8_MMA(1, 1, At, B1); PG8_BAR;
            PG8_LDB(B0, 1, 0); PG8_SCHED; PG8_LDA(At, 1, 0); PG8_STAGE(PG8_SA(0, 1), a2 + hstep, voffA);
            PG8_WAIT_L(8); PG8_BAR; PG8_WAIT_L(0); PG8_MMA(0, 0, At, B0); PG8_BAR; PG8_SCHED;
            PG8_LDB(B1, 1, 1); PG8_STAGE(PG8_SB(1, 0), b3, voffB);
            PG8_BAR; PG8_WAIT_L(0); PG8_MMA(0, 1, At, B1); PG8_BAR;
            PG8_LDA(At, 1, 1); PG8_STAGE(PG8_SA(1, 0), a3, voffA);
            PG8_BAR; PG8_WAIT_L(0); PG8_MMA(1, 0, At, B0); PG8_BAR; PG8_SCHED;
            PG8_STAGE(PG8_SB(1, 1), b3 + hstep, voffB);
            PG8_WAIT_V(6); PG8_BAR; PG8_MMA(1, 1, At, B1); PG8_BAR;
            }
        }
        if constexpr (ALIGN_EPI) { if (wr == 0) PG8_BAR; }
        if constexpr (!Epi::AFTER_DRAIN) { static_assert(ALIGN_EPI, "split_reduce needs the halves aligned"); if (cur.nsl > 1) { const int shift = split_reduce(acc, cur, X, tid); E(acc, cur, wr, wc, fr, fq, shift, cur.slice); } else { unsigned long long te0 = 0; if (MK_TIME_PHASE == 60 + X.id) te0 = __builtin_amdgcn_s_memrealtime(); E(acc, cur, wr, wc, fr, fq, 5, 0); if (MK_TIME_PHASE == 60 + X.id && tid == 0) { asm volatile("s_waitcnt vmcnt(0)" ::: "memory"); X.flag[2] += (unsigned)(__builtin_amdgcn_s_memrealtime() - te0); } } S.done(cur);
            if (MK_TIME_PHASE == 50 + X.id && cur.nsl > 1 && tid == 0) { asm volatile("s_waitcnt vmcnt(0)" ::: "memory"); const unsigned long long d = __builtin_amdgcn_s_memrealtime() - tsu; X.flag[2] = (unsigned)d; } }
        if (!has_next) break;
#pragma unroll
        for (int a = 0; a < 2; ++a)
#pragma unroll
            for (int b = 0; b < 2; ++b)
#pragma unroll
                for (int m = 0; m < 4; ++m)
#pragma unroll
                    for (int n = 0; n < 2; ++n) acc[a][b][m][n] = (f32x4){0.f, 0.f, 0.f, 0.f};
        cur = nxt; cA = nA; cB = nB; ++ui;
        if constexpr (ALIGN_EPI) { if (wr == 1) PG8_BAR; }
    }
    PG8_WAIT_V(0);
    if constexpr (!ALIGN_EPI) { if (wr == 0) PG8_BAR; }
    PG8_BAR;
    if constexpr (Epi::AFTER_DRAIN) { E.fused(acc, cur, wr, wc, fr, fq, lds, wid, lane); S.done(cur); }
#undef PG8_SA
#undef PG8_SB
#undef PG8_STAGE
#undef PG8_LDA
#undef PG8_LDB
#undef PG8_MMA
#undef PG8_WAIT_V
#undef PG8_WAIT_L
#undef PG8_BAR
#undef PG8_SCHED
}
}

constexpr int NWAVES = 8, NTHR = 512;
constexpr int DM = 2048, PB = 4, PL = 2048, SB = 128, SL = 8;
constexpr int MP = PB * PL, MS = SB * SL, M = MP + MS;
constexpr int GH = 4, GK = 128, GV = 256, GKD = 512, LOWR = 16;
constexpr int SH = 16, SP = 64, SN = 128, SG = 2, SCH = 1536;
constexpr int FF = 5632, FF2 = 11264, INC = 5664;
constexpr int N1 = 5888, NP = 5632;
constexpr int CQ = 0, CK = 512, CV = 1024, CG = 2048, CZ = 3072, CX = 4096;
constexpr float EPS = 1e-6f;
constexpr int N_PHASES = 11;

constexpr size_t O_Y = 0, O_GLA_P = (size_t)M * DM, O_SSD_P = O_GLA_P + (size_t)PB * GH * GK * GV, O_SCONV_P = O_SSD_P + (size_t)PB * SH * SP * SN,
                 O_FCONV_P = O_SCONV_P + (size_t)PB * 3 * SCH, O_GLA_S = O_FCONV_P + (size_t)PB * 2 * FF2, O_SSD_S = O_GLA_S + (size_t)SB * GH * GK * GV,
                 O_SCONV_S = O_SSD_S + (size_t)SB * SH * SP * SN, O_FCONV_S = O_SCONV_S + (size_t)SB * 3 * SCH, O_END = O_FCONV_S + (size_t)SB * 2 * FF2;

constexpr size_t MiB = 1u << 20;
constexpr size_t WS_CTL = 0, CTL_ZERO_BYTES = 64 * 1024;
constexpr size_t WS_WF2 = 1 * MiB;
constexpr size_t WS_W1 = 24 * MiB;
constexpr size_t WS_WO = 48 * MiB;
constexpr size_t WS_WF1 = 56 * MiB;
constexpr size_t WS_XN = 101 * MiB;
constexpr size_t WS_F = 24 * MiB;
constexpr size_t WS_BIG = 141 * MiB;
constexpr size_t WS_PROJ = WS_BIG;
constexpr size_t WS_MIX = WS_BIG;
constexpr size_t WS_ACT = WS_BIG;
constexpr size_t WS_HG = WS_BIG + 104 * MiB;
constexpr size_t WS_LRDT = WS_BIG + 100 * MiB;
constexpr size_t WS_MIXIN = WS_BIG + 104 * MiB;
constexpr size_t WS_DS = WS_XN;
constexpr size_t WS_SC = WS_BIG + 140 * MiB, WS_DH = WS_BIG + 172 * MiB, WS_HC = WS_BIG + 204 * MiB;
constexpr size_t WS_EBL = WS_BIG + 236 * MiB, WS_AL = WS_EBL + 512 * 1024;
constexpr size_t WS_SLAB = WS_BIG + 140 * MiB;
constexpr size_t WS_SLAB_F1 = WS_BIG + 198 * MiB;
constexpr size_t WS_QEG = WS_BIG + 238 * MiB, WS_KEG = WS_BIG + 246 * MiB;
constexpr size_t WS_END = WS_BIG + 254 * MiB;
static_assert(WS_WF2 + (size_t)DM * FF * 2 <= WS_W1 && WS_W1 + (size_t)N1 * DM * 2 <= WS_WO && WS_WO + (size_t)DM * DM * 2 <= WS_WF1 && WS_WF1 + (size_t)FF2 * DM * 2 <= WS_XN && WS_XN + (size_t)M * DM * 2 <= WS_BIG, "ws map 1");
static_assert(WS_F + (size_t)M * DM * 4 <= WS_XN && WS_ACT + (size_t)M * FF * 2 <= WS_HG && WS_PROJ + (size_t)M * NP * 2 <= WS_LRDT && WS_LRDT + (size_t)M * 32 * 4 <= WS_MIXIN && WS_MIXIN + (size_t)M * DM * 2 <= WS_SC && WS_HG + (size_t)32 * 4 * FF2 * 4 <= WS_SC && WS_MIX + (size_t)M * DM * 4 <= WS_LRDT, "ws map 2");
constexpr int CW_BAR = 1024;
constexpr int CW_SPLIT = 8192;

constexpr int RING_BYTES = 131072;
constexpr int SCRATCH_BYTES = 8 * 16640;
constexpr int LDSCTL_OFF = 133632, MISC_OFF = LDSCTL_OFF + 320;
constexpr int LDS_BYTES = 150016;

#ifndef MK_TIME_PHASE
#define MK_TIME_PHASE (-1)
#endif
#define TBEGIN(F, id) do { if (MK_TIME_PHASE == (id)) (F).tmark = __builtin_amdgcn_s_memrealtime(); } while (0)
#define TEND(F, id) do { if (MK_TIME_PHASE == (id)) (F).tacc += __builtin_amdgcn_s_memrealtime() - (F).tmark; } while (0)
#define GAS __attribute__((address_space(1)))
#define LAS __attribute__((address_space(3)))
typedef unsigned short bf16;
typedef unsigned v4u __attribute__((ext_vector_type(4)));
typedef unsigned v2u __attribute__((ext_vector_type(2)));
typedef float f32x4 __attribute__((ext_vector_type(4)));
#define LDS_WAIT() asm volatile("s_waitcnt lgkmcnt(0)" ::: "memory")
#define VM_WAIT() asm volatile("s_waitcnt vmcnt(0)" ::: "memory")
typedef float f32x2c __attribute__((ext_vector_type(2)));
typedef __bf16 bf16x2c __attribute__((ext_vector_type(2)));
__device__ __forceinline__ unsigned f2bf(float f) { return (unsigned)__builtin_bit_cast(unsigned short, (__bf16)f); }
__device__ __forceinline__ unsigned pk2(float lo, float hi) { return __builtin_bit_cast(unsigned, __builtin_convertvector((f32x2c){lo, hi}, bf16x2c)); }
__device__ __forceinline__ float bf2f(unsigned short b) { return __builtin_bit_cast(float, (unsigned)b << 16); }
__device__ __forceinline__ float bflo(unsigned w) { return __builtin_bit_cast(float, w << 16); }
__device__ __forceinline__ float bfhi(unsigned w) { return __builtin_bit_cast(float, w & 0xffff0000u); }
__device__ __forceinline__ float silu_f(float x) { return x * __builtin_amdgcn_rcpf(1.f + __expf(-x)); }
__device__ __forceinline__ float softplus_f(float x) { return fmaxf(x, 0.f) + __logf(1.f + __expf(-fabsf(x))); }
__device__ __forceinline__ float logsigmoid_f(float x) { return fminf(x, 0.f) - __logf(1.f + __expf(-fabsf(x))); }
__device__ __forceinline__ float wave_sum(float v) {
#pragma unroll
    for (int o = 1; o < 64; o <<= 1) v += __shfl_xor(v, o);
    return v;
}

#define XB_TMO      128
#define XB_XCNT(j)  (256  + 64 * (j))
#define XB_XSUB(j)  (1280 + 64 * (j))
#define XB_XGEN(j)  (2304 + 64 * (j))
#define XB_TOP      3328
#define XB_TOPGEN   3392
#define XCD_BAR_WORDS 3456
#define XB_SPIN_CAP (1u << 18)

__device__ __forceinline__ unsigned xb_ld(unsigned* p)              { return __hip_atomic_load(p, __ATOMIC_RELAXED, __HIP_MEMORY_SCOPE_AGENT); }
__device__ __forceinline__ unsigned xb_add(unsigned* p, unsigned v) { return __hip_atomic_fetch_add(p, v, __ATOMIC_RELAXED, __HIP_MEMORY_SCOPE_AGENT); }
__device__ __forceinline__ unsigned xb_xcc_id() { return (unsigned)__builtin_amdgcn_s_getreg((3 << 11) | 20) & 0xFu; }
#define XB_SPIN(cond, bar) do { unsigned _sp = 0; while (cond) { __builtin_amdgcn_s_sleep(1); \
    if ((++_sp & 255u) == 0u) { if (xb_ld(&(bar)[XB_TMO])) break; if (_sp > XB_SPIN_CAP) { atomicAdd(&(bar)[XB_TMO], 1u); break; } } } } while (0)

struct XcdBarrier {
    unsigned* bar; unsigned x;
    volatile LAS unsigned* st;
};

__device__ __forceinline__ XcdBarrier xcd_barrier_post(unsigned* bar, volatile LAS unsigned* st) {
    XcdBarrier b; b.bar = bar; b.x = xb_xcc_id(); b.st = st;
    if (threadIdx.x == 0) (void)xb_add(&bar[XB_XCNT(b.x)], 1u);
    return b;
}
__device__ __forceinline__ void xcd_barrier_complete(unsigned* bar, unsigned x, unsigned& nloc, unsigned& nx) {
    const unsigned G = gridDim.x * gridDim.y * gridDim.z;
    unsigned sum, cnt, mine, sp = 0u;
    for (;;) {
        sum = 0u; cnt = 0u; mine = 0u;
#pragma unroll
        for (unsigned j = 0; j < 16; ++j) { const unsigned c = xb_ld(&bar[XB_XCNT(j)]); sum += c; cnt += (c > 0u) ? 1u : 0u; mine = (j == x) ? c : mine; }
        if (sum == G) break;
        __builtin_amdgcn_s_sleep(1);
        if ((++sp & 255u) == 0u) { if (xb_ld(&bar[XB_TMO])) break; if (sp > XB_SPIN_CAP) { atomicAdd(&bar[XB_TMO], 1u); break; } }
    }
    nloc = mine > 0u ? mine : 1u; nx = cnt > 0u ? cnt : 1u;
}

__device__ __forceinline__ void xcd_barrier(const XcdBarrier& b) {
    asm volatile("s_waitcnt vmcnt(0)" ::: "memory");
    __syncthreads();
    if (threadIdx.x == 0) {
        unsigned* bar = b.bar;
        __builtin_amdgcn_s_waitcnt(0);
        unsigned nloc = b.st[0], nx = b.st[1];
        if (nloc == 0u) { xcd_barrier_complete(bar, b.x, nloc, nx); b.st[0] = nloc; b.st[1] = nx; }
        const unsigned old = xb_add(&bar[XB_XSUB(b.x)], 1u);
        const unsigned gen = old / nloc;
        if (old + 1u == (gen + 1u) * nloc) {
            __builtin_amdgcn_fence(__ATOMIC_RELEASE, "agent");
            asm volatile("s_waitcnt vmcnt(0)" ::: "memory");
            const unsigned og = xb_add(&bar[XB_TOP], 1u);
            const unsigned tg = og / nx;
            if (og + 1u == (tg + 1u) * nx) xb_add(&bar[XB_TOPGEN], 1u);
            else XB_SPIN(xb_ld(&bar[XB_TOPGEN]) == tg, bar);
            __builtin_amdgcn_fence(__ATOMIC_ACQUIRE, "agent");
            xb_add(&bar[XB_XGEN(b.x)], 1u);
            asm volatile("s_waitcnt vmcnt(0)" ::: "memory");
        } else {
            XB_SPIN(xb_ld(&bar[XB_XGEN(b.x)]) == gen, bar);
            __builtin_amdgcn_fence(__ATOMIC_ACQUIRE, "agent");
            asm volatile("s_waitcnt vmcnt(0)" ::: "memory");
        }
    }
    __syncthreads();
}

struct Frame {
    LAS unsigned char* lds;
    int tid, lane, wave, G, bid;
    unsigned long long tacc, tmark;
    const float *x_p, *x_s, *st_gla, *st_ssd, *st_sconv, *st_fconv, *n_mix_pre, *n_mix_post, *n_ffn_pre, *n_ffn_post, *w_in, *w_gate2, *b_gate, *gla_norm,
                *sconv_w, *sconv_b, *dt_bias, *A_log, *ssd_D, *ssd_norm, *w_out, *ffn_w_in, *fconv_w, *fconv_b, *ffn_w_out;
    float* out;
    bf16 *W1, *WO, *WF1, *WF2, *XN, *PROJ, *MIXIN, *ACT, *DS, *SC, *DH, *HC, *QEg, *KEg;
    float *LRDT, *MIX, *Fb, *EBL, *AL, *HG;
};
__device__ __forceinline__ const float* x_row(const Frame& F, int row) { return row < MP ? F.x_p + (size_t)row * DM : F.x_s + (size_t)(row - MP) * DM; }

__device__ __forceinline__ int w1_src_col(int n) { return n < 3072 ? n : (n < 5632 ? n + 16 : (n < 5648 ? n - 2560 : (n < 5664 ? n : -1))); }
struct TDesc { const float* W; bf16* WT; int K, Nsrc, Ndst, map, item; };
__device__ __forceinline__ void t_load(const TDesc& d, int lane, f32x4 (&v)[16]) {
    const int nblk = d.Ndst / 64, kb = d.item / nblk, nb = d.item % nblk, k0 = 64 * kb, n0 = 64 * nb;
    int sc = n0 + 4 * (lane & 15); if (d.map == 1) sc = w1_src_col(sc); if (d.map == 2) sc = ((sc >> 7) & 1) * FF + 128 * (sc >> 8) + (sc & 127);
#pragma unroll
    for (int i = 0; i < 16; ++i) { const int kk = 4 * i + (lane >> 4); v[i] = (sc >= 0) ? *(const f32x4*)(d.W + (size_t)(k0 + kk) * d.Nsrc + sc) : (f32x4){0.f, 0.f, 0.f, 0.f}; }
}
__device__ __forceinline__ void t_store(const TDesc& d, int lane, LAS float* scr, const f32x4 (&v)[16]) {
    const int nblk = d.Ndst / 64, kb = d.item / nblk, nb = d.item % nblk, k0 = 64 * kb, n0 = 64 * nb;
#pragma unroll
    for (int i = 0; i < 16; ++i) { const int kk = 4 * i + (lane >> 4); LAS float* p = scr + kk * 65 + 4 * (lane & 15); p[0] = v[i].x; p[1] = v[i].y; p[2] = v[i].z; p[3] = v[i].w; }
    LDS_WAIT(); asm volatile("" ::: "memory");
    const int c = lane & 7;
#pragma unroll
    for (int j = 0; j < 8; ++j) { const int n = (lane >> 3) + 8 * j; const LAS float* s = scr + (8 * c) * 65 + n;
        v4u o; o.x = pk2(s[0 * 65], s[1 * 65]); o.y = pk2(s[2 * 65], s[3 * 65]); o.z = pk2(s[4 * 65], s[5 * 65]); o.w = pk2(s[6 * 65], s[7 * 65]);
        *(v4u*)(d.WT + (size_t)(n0 + n) * d.K + k0 + 8 * c) = o; }
    LDS_WAIT(); asm volatile("" ::: "memory");
}
__device__ __forceinline__ bool t_desc(const Frame& F, int which, int it, TDesc& d) {
    constexpr int I_1 = (DM / 64) * (N1 / 64), I_O = (DM / 64) * (DM / 64), I_F1 = (DM / 64) * (FF2 / 64), I_F2 = (FF / 64) * (DM / 64);
    if (which == 0) { if (it >= I_1) return false; d = TDesc{F.w_in, F.W1, DM, INC, N1, 1, it}; return true; }
    if (it >= I_O + I_F1 + I_F2) return false;
    if (it < I_O) d = TDesc{F.w_out, F.WO, DM, DM, DM, 0, it};
    else if (it < I_O + I_F1) d = TDesc{F.ffn_w_in, F.WF1, DM, FF2, FF2, 2, it - I_O};
    else d = TDesc{F.ffn_w_out, F.WF2, FF, DM, DM, 0, it - I_O - I_F1};
    return true;
}
__device__ __forceinline__ void t_run(const Frame& F, int which, int gw, int NGW) {
    LAS float* scr = (LAS float*)(F.lds + F.wave * 16640);
    TDesc da, db; f32x4 va[16], vb[16]; int it = gw;
    if (!t_desc(F, which, it, da)) return;
    t_load(da, F.lane, va);
    for (;;) {
        const bool hb = t_desc(F, which, it + NGW, db); if (hb) t_load(db, F.lane, vb);
        t_store(da, F.lane, scr, va); if (!hb) break; it += NGW;
        const bool ha = t_desc(F, which, it + NGW, da); if (ha) t_load(da, F.lane, va);
        t_store(db, F.lane, scr, vb); if (!ha) break; it += NGW;
    }
}
__device__ __forceinline__ void rms_rows2_to_bf16(const float* x0, const float* x1, const float* w, bf16* o0, bf16* o1, int lane) {
    const f32x4* xa = (const f32x4*)x0 + lane; const f32x4* xb = (const f32x4*)x1 + lane; const f32x4* wr = (const f32x4*)w + lane;
    f32x4 va[8], vb[8]; float sa = 0.f, sb = 0.f;
#pragma unroll
    for (int j = 0; j < 8; ++j) va[j] = xa[64 * j];
#pragma unroll
    for (int j = 0; j < 8; ++j) vb[j] = xb[64 * j];
#pragma unroll
    for (int j = 0; j < 8; ++j) { sa += (va[j].x * va[j].x + va[j].y * va[j].y) + (va[j].z * va[j].z + va[j].w * va[j].w); sb += (vb[j].x * vb[j].x + vb[j].y * vb[j].y) + (vb[j].z * vb[j].z + vb[j].w * vb[j].w); }
    const float ra = rsqrtf(wave_sum(sa) * (1.f / DM) + EPS), rb = rsqrtf(wave_sum(sb) * (1.f / DM) + EPS);
    v2u* pa = (v2u*)o0 + lane; v2u* pb = (v2u*)o1 + lane;
#pragma unroll
    for (int j = 0; j < 8; ++j) { const f32x4 ww = wr[64 * j]; v2u o; o.x = pk2(va[j].x * ra * ww.x, va[j].y * ra * ww.y); o.y = pk2(va[j].z * ra * ww.z, va[j].w * ra * ww.w); pa[64 * j] = o;
        o.x = pk2(vb[j].x * rb * ww.x, vb[j].y * rb * ww.y); o.y = pk2(vb[j].z * rb * ww.z, vb[j].w * rb * ww.w); pb[64 * j] = o; }
}
__device__ __forceinline__ void p0_prologue(Frame& F) {
    const int gw = F.bid * NWAVES + F.wave, NGW = F.G * NWAVES;
    t_run(F, 0, gw, NGW);
    for (int m = gw; m < M; m += 2 * NGW) { const int m1 = (m + NGW < M) ? m + NGW : m; rms_rows2_to_bf16(x_row(F, m), x_row(F, m1), F.n_mix_pre, F.XN + (size_t)m * DM, F.XN + (size_t)m1 * DM, F.lane); }
}
__device__ __forceinline__ void p0_convert_rest(Frame& F, int vb, int nb) { t_run(F, 1, vb * NWAVES + F.wave, nb * NWAVES); }

template <int grp> __device__ __forceinline__ void gla_direct_unit(Frame& F, int b, int h) {
    const int tid = F.tid, v = tid & 255, kh = tid >> 8;
    const int L = grp ? SL : PL, row0 = grp ? MP + b * SL : b * PL;
    LAS float* Es = (LAS float*)F.lds; LAS float* Ks = Es + 1024; LAS float* Qs = Ks + 1024; LAS float* Os = Qs + 1024;
    float S[64];
    if (grp) { const float* s0 = F.st_gla + ((size_t)(b * GH + h) * GK + kh * 64) * GV + v;
#pragma unroll
        for (int i = 0; i < 64; ++i) S[i] = s0[(size_t)i * GV]; }
    else {
#pragma unroll
        for (int i = 0; i < 64; ++i) S[i] = 0.f; }
    for (int t0 = 0; t0 < L; t0 += 8) {
        for (int it = tid; it < 1024; it += NTHR) { const int t = it >> 7, k = it & 127, row = row0 + t0 + t, hk = h * GK + k;
            float x = F.b_gate[hk]; const float* lr = F.LRDT + (size_t)row * 32;
#pragma unroll
            for (int j = 0; j < LOWR; ++j) x += lr[j] * F.w_gate2[j * GKD + hk];
            const float lg = logsigmoid_f(x) * (1.f / 16.f);
            Es[it] = __expf(lg); Ks[it] = bf2f(F.PROJ[(size_t)row * NP + CK + hk]); Qs[it] = bf2f(F.PROJ[(size_t)row * NP + CQ + hk]) * 0.08838834764831845f; }
        __syncthreads();
#pragma unroll 1
        for (int t = 0; t < 8; ++t) { const float vv = bf2f(F.PROJ[(size_t)(row0 + t0 + t) * NP + CV + h * GV + v]); float acc = 0.f;
            const LAS float* e = Es + t * 128 + kh * 64; const LAS float* kk = Ks + t * 128 + kh * 64; const LAS float* qq = Qs + t * 128 + kh * 64;
#pragma unroll
            for (int i = 0; i < 64; ++i) { S[i] = e[i] * S[i] + kk[i] * vv; acc += qq[i] * S[i]; }
            Os[(kh * 8 + t) * 256 + v] = acc; }
        __syncthreads();
        { const int t = F.wave, v4 = F.lane * 4, row = row0 + t0 + t;
            const f32x4 a = *(const LAS f32x4*)(Os + t * 256 + v4), c = *(const LAS f32x4*)(Os + (8 + t) * 256 + v4); const f32x4 o = a + c;
            const float ss = wave_sum((o.x * o.x + o.y * o.y) + (o.z * o.z + o.w * o.w)); const float r = rsqrtf(ss * (1.f / GV) + EPS);
            const v2u gw = *(const v2u*)(F.PROJ + (size_t)row * NP + CG + h * GV + v4); const f32x4 nw = *(const f32x4*)(F.gla_norm + v4);
            v2u w; w.x = pk2(o.x * r * nw.x * silu_f(bflo(gw.x)), o.y * r * nw.y * silu_f(bfhi(gw.x))); w.y = pk2(o.z * r * nw.z * silu_f(bflo(gw.y)), o.w * r * nw.w * silu_f(bfhi(gw.y)));
            *(v2u*)(F.MIXIN + (size_t)row * DM + h * GV + v4) = w; }
        __syncthreads();
    }
    float* so = F.out + (grp ? O_GLA_S : O_GLA_P) + ((size_t)(b * GH + h) * GK + kh * 64) * GV + v;
#pragma unroll
    for (int i = 0; i < 64; ++i) so[(size_t)i * GV] = S[i];
}
__device__ __forceinline__ float xbc_raw(const Frame& F, int grp, int b, int row0, int tt, int c) {
    if (tt >= 0) return bf2f(F.PROJ[(size_t)(row0 + tt) * NP + CX + c]);
    return grp ? F.st_sconv[((size_t)b * 3 + (tt + 3)) * SCH + c] : 0.f;
}
template <int grp> __device__ __forceinline__ void ssd_direct_unit(Frame& F, int b, int g) {
    const int tid = F.tid, hd = g * 8 + (tid >> 6), p = tid & 63, ch = g * 512 + tid;
    const int L = grp ? SL : PL, row0 = grp ? MP + b * SL : b * PL;
    LAS float* Bs = (LAS float*)F.lds; LAS float* Cs = Bs + 1024; LAS float* red = Cs + 1024; LAS float* Ys = red + 64;
    float h[128];
    if (grp) { const f32x4* h0 = (const f32x4*)(F.st_ssd + ((size_t)(b * SH + hd) * SP + p) * SN);
#pragma unroll
        for (int i = 0; i < 32; ++i) { const f32x4 q = h0[i]; h[4 * i] = q.x; h[4 * i + 1] = q.y; h[4 * i + 2] = q.z; h[4 * i + 3] = q.w; } }
    else {
#pragma unroll
        for (int i = 0; i < 128; ++i) h[i] = 0.f; }
    const float A = -__expf(F.A_log[hd]), dtb = F.dt_bias[hd], Dh = F.ssd_D[hd], nw = F.ssd_norm[ch];
    const float cb = F.sconv_b[ch], cw0 = F.sconv_w[ch], cw1 = F.sconv_w[SCH + ch], cw2 = F.sconv_w[2 * SCH + ch], cw3 = F.sconv_w[3 * SCH + ch];
    const int c2 = 1024 + (tid < 128 ? g * 128 + tid : 256 + g * 128 + ((tid - 128) & 127));
    float xr0 = xbc_raw(F, grp, b, row0, -3, ch), xr1 = xbc_raw(F, grp, b, row0, -2, ch), xr2 = xbc_raw(F, grp, b, row0, -1, ch);
    for (int t0 = 0; t0 < L; t0 += 8) {
        if (tid < 256) {
            float xr[11]; const float cb2 = F.sconv_b[c2], d0 = F.sconv_w[c2], d1 = F.sconv_w[SCH + c2], d2 = F.sconv_w[2 * SCH + c2], d3 = F.sconv_w[3 * SCH + c2];
#pragma unroll
            for (int i = 0; i < 11; ++i) xr[i] = xbc_raw(F, grp, b, row0, t0 - 3 + i, c2);
#pragma unroll
            for (int t = 0; t < 8; ++t) Bs[(tid >> 7) * 1024 + t * 128 + (tid & 127)] = silu_f(cb2 + d0 * xr[t] + d1 * xr[t + 1] + d2 * xr[t + 2] + d3 * xr[t + 3]);
        }
        __syncthreads();
#pragma unroll 1
        for (int t = 0; t < 8; ++t) { const int row = row0 + t0 + t;
            const float xn = bf2f(F.PROJ[(size_t)row * NP + CX + ch]);
            const float x = silu_f(cb + cw0 * xr0 + cw1 * xr1 + cw2 * xr2 + cw3 * xn); xr0 = xr1; xr1 = xr2; xr2 = xn;
            const float dt = softplus_f(F.LRDT[(size_t)row * 32 + 16 + hd] + dtb), a = __expf(dt * A), dtx = dt * x;
            float acc = 0.f; const LAS float* bb = Bs + t * 128; const LAS float* cc = Cs + t * 128;
#pragma unroll
            for (int nb = 0; nb < 128; nb += 16) {
#pragma unroll
                for (int n = nb; n < nb + 16; ++n) { h[n] = a * h[n] + dtx * bb[n]; acc += h[n] * cc[n]; }
                asm volatile("" ::: "memory"); }
            const float z = bf2f(F.PROJ[(size_t)row * NP + CZ + ch]);
            const float y = (acc + Dh * x) * silu_f(z);
            Ys[t * 512 + tid] = y;
            const float ss = wave_sum(y * y); if (F.lane == 0) red[t * 8 + F.wave] = ss; }
        __syncthreads();
#pragma unroll
        for (int t = 0; t < 8; ++t) { float tot = 0.f;
#pragma unroll
            for (int w = 0; w < 8; ++w) tot += red[t * 8 + w];
            const float r = rsqrtf(tot * (1.f / 512.f) + EPS);
            F.MIXIN[(size_t)(row0 + t0 + t) * DM + 1024 + ch] = (bf16)f2bf(Ys[t * 512 + tid] * r * nw); }
        __syncthreads();
    }
    f32x4* ho = (f32x4*)(F.out + (grp ? O_SSD_S : O_SSD_P) + ((size_t)(b * SH + hd) * SP + p) * SN);
#pragma unroll
    for (int i = 0; i < 32; ++i) ho[i] = (f32x4){h[4 * i], h[4 * i + 1], h[4 * i + 2], h[4 * i + 3]};
}
typedef short bf16x8v __attribute__((ext_vector_type(8)));
typedef short s16x4v __attribute__((ext_vector_type(4)));
constexpr int CH = 64, NCH = PL / CH;
constexpr int QE_ST = 272, KDT_ST = 144, V_ST = 544, ATT_ST = 144, X_ST = 1056, BC_ST = 288;
#define MFMA16(a, b, c) __builtin_amdgcn_mfma_f32_16x16x32_bf16((a), (b), (c), 0, 0, 0)
__device__ __forceinline__ bf16x8v frag_k(const LAS unsigned char* T, int stride, int idx0, int kk0, int r, int q) { return *(const LAS bf16x8v*)(T + (idx0 + r) * stride + (kk0 + 8 * q) * 2); }
__device__ __forceinline__ bf16x8v frag_t(const LAS unsigned char* T, int stride, int kk0, int idx0, int r, int q) {
    const LAS unsigned char* p = T + (kk0 + 8 * q + (r >> 2)) * stride + (idx0 + 4 * (r & 3)) * 2;
    const s16x4v lo = __builtin_amdgcn_ds_read_tr16_b64_v4i16((LAS s16x4v*)p), hi = __builtin_amdgcn_ds_read_tr16_b64_v4i16((LAS s16x4v*)(p + 4 * stride));
    return (bf16x8v){lo[0], lo[1], lo[2], lo[3], hi[0], hi[1], hi[2], hi[3]};
}
__device__ __forceinline__ v2u pk4(const f32x4 v) { v2u o; o.x = pk2(v.x, v.y); o.y = pk2(v.z, v.w); return o; }

struct GlaStage { v4u v[4], qk[4], lr; };
template <int PASS>
__device__ __forceinline__ void gla_stage_load(const Frame& F, int h, int row0, GlaStage& g) {
    const int tid = F.tid;
#pragma unroll
    for (int i = 0; i < 4; ++i) { const int piece = tid + NTHR * i, row = piece >> 5, c16 = piece & 31; g.v[i] = *(const v4u*)(F.PROJ + (size_t)(row0 + row) * NP + CV + h * GV + c16 * 8); }
#pragma unroll
    for (int i = 0; i < 2; ++i) { const int piece = tid + NTHR * i, row = piece >> 4, c16 = piece & 15;
        g.qk[i] = *(const v4u*)(F.PROJ + (size_t)(row0 + row) * NP + CK + h * GK + c16 * 8);
        if (PASS == 1) g.qk[2 + i] = *(const v4u*)(F.PROJ + (size_t)(row0 + row) * NP + CQ + h * GK + c16 * 8); }
    if (tid < 256) g.lr = *(const v4u*)(F.LRDT + (size_t)(row0 + (tid >> 2)) * 32 + (tid & 3) * 4);
}
template <int PASS>
__device__ __forceinline__ void gla_stage_store(const Frame& F, const GlaStage& g, LAS unsigned char* V, LAS unsigned char* Kt, LAS unsigned char* Qt, LAS float* LR) {
    const int tid = F.tid;
#pragma unroll
    for (int i = 0; i < 4; ++i) { const int piece = tid + NTHR * i, row = piece >> 5, c16 = piece & 31; *(LAS v4u*)(V + row * V_ST + c16 * 16) = g.v[i]; }
#pragma unroll
    for (int i = 0; i < 2; ++i) { const int piece = tid + NTHR * i, row = piece >> 4, c16 = piece & 15;
        *(LAS v4u*)(Kt + row * QE_ST + c16 * 16) = g.qk[i]; if (PASS == 1) *(LAS v4u*)(Qt + row * QE_ST + c16 * 16) = g.qk[2 + i]; }
    if (tid < 256) *(LAS v4u*)(LR + (tid >> 2) * 16 + (tid & 3) * 4) = g.lr;
}
template <int PASS>
__device__ __forceinline__ void gla_chunk_elem(Frame& F, int h, LAS unsigned char* Kt, LAS unsigned char* Qt, LAS unsigned char* KDT, const LAS float* LR, LAS float* tot, float* ebl_out) {
    const int tid = F.tid, k = tid & 127, tq = tid >> 7, hk = h * GK + k;
    float w2[16];
#pragma unroll
    for (int j = 0; j < 16; ++j) w2[j] = F.w_gate2[j * GKD + hk];
    const float bg = F.b_gate[hk];
    float lg[16]; float run = 0.f;
#pragma unroll
    for (int i = 0; i < 16; ++i) { const LAS f32x4* lr = (const LAS f32x4*)(LR + (16 * tq + i) * 16); const f32x4 a = lr[0], b = lr[1], c = lr[2], d = lr[3];
        float x = bg + a.x * w2[0] + a.y * w2[1] + a.z * w2[2] + a.w * w2[3] + b.x * w2[4] + b.y * w2[5] + b.z * w2[6] + b.w * w2[7]
                     + c.x * w2[8] + c.y * w2[9] + c.z * w2[10] + c.w * w2[11] + d.x * w2[12] + d.y * w2[13] + d.z * w2[14] + d.w * w2[15];
        run += logsigmoid_f(x) * (1.f / 16.f); lg[i] = run; }
    tot[tq * 128 + k] = run;
    __syncthreads();
    float off = 0.f, all = 0.f;
#pragma unroll
    for (int qq = 0; qq < 4; ++qq) { const float v = tot[qq * 128 + k]; all += v; off += (qq < tq) ? v : 0.f; }
    {
        unsigned pk[8];
#pragma unroll
        for (int i = 0; i < 8; ++i) { const int t = 16 * tq + 2 * i; const float b0 = off + lg[2 * i], b1 = off + lg[2 * i + 1];
            LAS bf16* k0p = (LAS bf16*)(Kt + t * QE_ST + k * 2); LAS bf16* k1p = (LAS bf16*)(Kt + (t + 1) * QE_ST + k * 2);
            LAS bf16* q0p = (LAS bf16*)(Qt + t * QE_ST + k * 2); LAS bf16* q1p = (LAS bf16*)(Qt + (t + 1) * QE_ST + k * 2);
            const float k0 = bf2f(*k0p), k1 = bf2f(*k1p);
            pk[i] = pk2(k0 * __expf(all - b0), k1 * __expf(all - b1));
            *k0p = (bf16)f2bf(k0 * __expf(-b0)); *k1p = (bf16)f2bf(k1 * __expf(-b1));
            *q0p = (bf16)f2bf(bf2f(*q0p) * 0.08838834764831845f * __expf(b0)); *q1p = (bf16)f2bf(bf2f(*q1p) * 0.08838834764831845f * __expf(b1)); }
        LAS v4u* d = (LAS v4u*)(KDT + k * KDT_ST + 32 * tq);
        d[0] = (v4u){pk[0], pk[1], pk[2], pk[3]}; d[1] = (v4u){pk[4], pk[5], pk[6], pk[7]};
        if (tq == 0) ebl_out[k] = __expf(all);
    }
}
__device__ __forceinline__ void gla_passA_unit(Frame& F, int u) {
    const int c = u & 31, bh = u >> 5, b = bh >> 2, h = bh & 3, row0 = b * PL + c * CH;
    LAS unsigned char* KDT = F.lds; LAS unsigned char* V = KDT + 128 * KDT_ST; LAS unsigned char* Kt = V + 64 * V_ST; LAS unsigned char* Qt = Kt + 64 * QE_ST; LAS float* LR = (LAS float*)(Qt + 64 * QE_ST); LAS float* tot = LR + 1024;
    { GlaStage g; gla_stage_load<1>(F, h, row0, g); gla_stage_store<1>(F, g, V, Kt, Qt, LR); }
    __syncthreads();
    gla_chunk_elem<0>(F, h, Kt, Qt, KDT, LR, tot, F.EBL + (size_t)u * 128);
    __syncthreads();
#pragma unroll
    for (int i = 0; i < 2; ++i) { const int piece = F.tid + NTHR * i, row = piece >> 4, c16 = piece & 15;
        *(v4u*)(F.QEg + ((size_t)u * 64 + row) * GK + c16 * 8) = *(const LAS v4u*)(Qt + row * QE_ST + c16 * 16);
        *(v4u*)(F.KEg + ((size_t)u * 64 + row) * GK + c16 * 8) = *(const LAS v4u*)(Kt + row * QE_ST + c16 * 16); }
    const int w = F.wave, r = F.lane & 15, q = F.lane >> 4;
    f32x4 acc[8][2];
#pragma unroll
    for (int kf = 0; kf < 8; ++kf) { acc[kf][0] = (f32x4){0.f, 0.f, 0.f, 0.f}; acc[kf][1] = (f32x4){0.f, 0.f, 0.f, 0.f}; }
#pragma unroll
    for (int ks = 0; ks < 2; ++ks) { const bf16x8v b0 = frag_t(V, V_ST, 32 * ks, 32 * w, r, q), b1 = frag_t(V, V_ST, 32 * ks, 32 * w + 16, r, q);
#pragma unroll
        for (int kf = 0; kf < 8; ++kf) { const bf16x8v a = frag_k(KDT, KDT_ST, 16 * kf, 32 * ks, r, q); acc[kf][0] = MFMA16(a, b0, acc[kf][0]); acc[kf][1] = MFMA16(a, b1, acc[kf][1]); } }
#pragma unroll
    for (int kf = 0; kf < 8; ++kf)
#pragma unroll
        for (int vf = 0; vf < 2; ++vf) *(v2u*)(F.DS + ((size_t)u * GV + 32 * w + 16 * vf + r) * GK + 16 * kf + 4 * q) = pk4(acc[kf][vf]);
    __syncthreads();
}
__device__ __forceinline__ void gla_scan(Frame& F) {
    for (int it = F.bid * NTHR + F.tid; it < PB * GH * GV * 32; it += F.G * NTHR) { const int k4 = it & 31, v = (it >> 5) & 255, bh = it >> 13;
        f32x4 S = (f32x4){0.f, 0.f, 0.f, 0.f};
#pragma unroll 8
        for (int c = 0; c < NCH; ++c) { const int u = bh * NCH + c; const size_t off = ((size_t)u * GV + v) * GK + 4 * k4;
            const v2u d = *(const v2u*)(F.DS + off); const f32x4 e = *(const f32x4*)(F.EBL + (size_t)u * 128 + 4 * k4);
            *(v2u*)(F.SC + off) = pk4(S);
            S.x = e.x * S.x + bflo(d.x); S.y = e.y * S.y + bfhi(d.x); S.z = e.z * S.z + bflo(d.y); S.w = e.w * S.w + bfhi(d.y); }
        float* o = F.out + O_GLA_P + ((size_t)bh * GK + 4 * k4) * GV + v; o[0] = S.x; o[GV] = S.y; o[2 * GV] = S.z; o[3 * GV] = S.w; }
}
__device__ __forceinline__ void gla_passC_unit(Frame& F, int u) {
    const int c = u & 31, bh = u >> 5, b = bh >> 2, h = bh & 3, row0 = b * PL + c * CH;
    LAS unsigned char* QE = F.lds; LAS unsigned char* KE = QE + 64 * QE_ST; LAS unsigned char* V = KE + 64 * QE_ST; LAS unsigned char* ATT = V + 64 * V_ST;
    LAS float* red = (LAS float*)(ATT + 64 * ATT_ST);
    const int w = F.wave, r = F.lane & 15, q = F.lane >> 4, tf = w & 3, vh = w >> 2;
    bf16x8v scf[2][8];
    const bf16* Sc = F.SC + ((size_t)u * GV + 128 * vh) * GK;
#pragma unroll
    for (int ks = 0; ks < 2; ++ks)
#pragma unroll
        for (int i = 0; i < 8; ++i) scf[ks][i] = *(const bf16x8v*)(Sc + (size_t)(16 * i + r) * GK + 32 * ks + 8 * q);
    v2u gwv[8];
#pragma unroll
    for (int i = 0; i < 8; ++i) gwv[i] = *(const v2u*)(F.PROJ + (size_t)(row0 + 16 * tf + r) * NP + CG + h * GV + 128 * vh + 16 * i + 4 * q);
    { v4u vv[4], qq[2], kk[2];
#pragma unroll
        for (int i = 0; i < 4; ++i) { const int piece = F.tid + NTHR * i, row = piece >> 5, c16 = piece & 31; vv[i] = *(const v4u*)(F.PROJ + (size_t)(row0 + row) * NP + CV + h * GV + c16 * 8); }
#pragma unroll
        for (int i = 0; i < 2; ++i) { const int piece = F.tid + NTHR * i, row = piece >> 4, c16 = piece & 15;
            qq[i] = *(const v4u*)(F.QEg + ((size_t)u * 64 + row) * GK + c16 * 8); kk[i] = *(const v4u*)(F.KEg + ((size_t)u * 64 + row) * GK + c16 * 8); }
#pragma unroll
        for (int i = 0; i < 4; ++i) { const int piece = F.tid + NTHR * i, row = piece >> 5, c16 = piece & 31; *(LAS v4u*)(V + row * V_ST + c16 * 16) = vv[i]; }
#pragma unroll
        for (int i = 0; i < 2; ++i) { const int piece = F.tid + NTHR * i, row = piece >> 4, c16 = piece & 15;
            *(LAS v4u*)(QE + row * QE_ST + c16 * 16) = qq[i]; *(LAS v4u*)(KE + row * QE_ST + c16 * 16) = kk[i]; } }
    __syncthreads();
    f32x4 acc[8];
#pragma unroll
    for (int i = 0; i < 8; ++i) acc[i] = (f32x4){0.f, 0.f, 0.f, 0.f};
#pragma unroll
    for (int ks = 0; ks < 2; ++ks) { const bf16x8v bq = frag_k(QE, QE_ST, 16 * tf, 32 * ks, r, q);
#pragma unroll
        for (int i = 0; i < 8; ++i) acc[i] = MFMA16(scf[ks][i], bq, acc[i]); }
#pragma unroll
    for (int ks = 0; ks < 2; ++ks)
#pragma unroll
        for (int i = 0; i < 8; ++i) scf[ks][i] = *(const bf16x8v*)(Sc + (size_t)(16 * i + r) * GK + 32 * (ks + 2) + 8 * q);
#pragma unroll
    for (int ff = 0; ff < 2; ++ff) { const int f = 2 * w + ff, sf = f >> 2, tf = f & 3; f32x4 a4 = (f32x4){0.f, 0.f, 0.f, 0.f};
        if (sf <= tf) {
#pragma unroll
            for (int ks = 0; ks < 4; ++ks) a4 = MFMA16(frag_k(KE, QE_ST, 16 * sf, 32 * ks, r, q), frag_k(QE, QE_ST, 16 * tf, 32 * ks, r, q), a4); }
        const int s0 = 16 * sf + 4 * q, t = 16 * tf + r;
        f32x4 m; m.x = (s0 <= t) ? a4.x : 0.f; m.y = (s0 + 1 <= t) ? a4.y : 0.f; m.z = (s0 + 2 <= t) ? a4.z : 0.f; m.w = (s0 + 3 <= t) ? a4.w : 0.f;
        *(LAS v2u*)(ATT + t * ATT_ST + s0 * 2) = pk4(m); }
    __syncthreads();
#pragma unroll
    for (int ks = 0; ks < 2; ++ks) { const bf16x8v bq = frag_k(QE, QE_ST, 16 * tf, 32 * (ks + 2), r, q);
#pragma unroll
        for (int i = 0; i < 8; ++i) acc[i] = MFMA16(scf[ks][i], bq, acc[i]); }
#pragma unroll
    for (int ks = 0; ks < 2; ++ks) { const bf16x8v ba = frag_k(ATT, ATT_ST, 16 * tf, 32 * ks, r, q);
#pragma unroll
        for (int i = 0; i < 8; ++i) { const bf16x8v a = frag_t(V, V_ST, 32 * ks, 128 * vh + 16 * i, r, q); acc[i] = MFMA16(a, ba, acc[i]); } }
    float ss = 0.f;
#pragma unroll
    for (int i = 0; i < 8; ++i) ss += (acc[i].x * acc[i].x + acc[i].y * acc[i].y) + (acc[i].z * acc[i].z + acc[i].w * acc[i].w);
    ss += __shfl_xor(ss, 16); ss += __shfl_xor(ss, 32);
    const int t = 16 * tf + r;
    if (q == 0) red[vh * 64 + t] = ss;
    __syncthreads();
    const float rr = rsqrtf((red[t] + red[64 + t]) * (1.f / GV) + EPS); const size_t row = (size_t)(row0 + t);
#pragma unroll
    for (int i = 0; i < 8; ++i) { const int v = 128 * vh + 16 * i + 4 * q;
        const v2u gw = gwv[i]; const f32x4 nw = *(const f32x4*)(F.gla_norm + v);
        f32x4 o; o.x = acc[i].x * rr * nw.x * silu_f(bflo(gw.x)); o.y = acc[i].y * rr * nw.y * silu_f(bfhi(gw.x)); o.z = acc[i].z * rr * nw.z * silu_f(bflo(gw.y)); o.w = acc[i].w * rr * nw.w * silu_f(bfhi(gw.y));
        *(v2u*)(F.MIXIN + row * DM + h * GV + v) = pk4(o); }
    __syncthreads();
}

template <bool SCALE>
__device__ __forceinline__ void ssd_conv_item(Frame& F, int b, int g, int c, int cg, int tb, LAS unsigned char* X, LAS unsigned char* BT, LAS unsigned char* CT, const LAS float* WDEC) {
    const int xc = cg < 64 ? g * 512 + 8 * cg : (cg < 80 ? 1024 + g * 128 + 8 * (cg - 64) : 1280 + g * 128 + 8 * (cg - 80));
    float w[4][8], bias[8];
#pragma unroll
    for (int j = 0; j < 4; ++j) { const f32x4 a = *(const f32x4*)(F.sconv_w + j * SCH + xc), bq = *(const f32x4*)(F.sconv_w + j * SCH + xc + 4);
        w[j][0] = a.x; w[j][1] = a.y; w[j][2] = a.z; w[j][3] = a.w; w[j][4] = bq.x; w[j][5] = bq.y; w[j][6] = bq.z; w[j][7] = bq.w; }
    { const f32x4 a = *(const f32x4*)(F.sconv_b + xc), bq = *(const f32x4*)(F.sconv_b + xc + 4); bias[0] = a.x; bias[1] = a.y; bias[2] = a.z; bias[3] = a.w; bias[4] = bq.x; bias[5] = bq.y; bias[6] = bq.z; bias[7] = bq.w; }
    v4u raw[11];
#pragma unroll
    for (int i = 0; i < 11; ++i) { const int tt = c * CH + tb * 8 - 3 + i;
        raw[i] = (tt >= 0) ? *(const v4u*)(F.PROJ + (size_t)(b * PL + tt) * NP + CX + xc) : (v4u){0u, 0u, 0u, 0u}; }
#pragma unroll
    for (int t = 0; t < 8; ++t) { float o[8];
#pragma unroll
        for (int e = 0; e < 8; ++e) { float a = bias[e];
#pragma unroll
            for (int j = 0; j < 4; ++j) { const unsigned wd = raw[t + j][e >> 1]; a += w[j][e] * ((e & 1) ? bfhi(wd) : bflo(wd)); }
            o[e] = silu_f(a); }
        const int tl = tb * 8 + t;
        if (SCALE && cg < 64) { const float sc = WDEC[(cg >> 3) * 64 + tl];
#pragma unroll
            for (int e = 0; e < 8; ++e) o[e] *= sc; }
        const v4u pkd = (v4u){pk2(o[0], o[1]), pk2(o[2], o[3]), pk2(o[4], o[5]), pk2(o[6], o[7])};
        LAS unsigned char* dst = cg < 64 ? X + tl * X_ST + cg * 16 : (cg < 80 ? BT + tl * BC_ST + (cg - 64) * 16 : CT + tl * BC_ST + (cg - 80) * 16);
        *(LAS v4u*)dst = pkd; }
}
__device__ __forceinline__ float ssd_head_scan(Frame& F, int hd, int row0, float& dt_out, float& last) {
    const float dt = softplus_f(F.LRDT[(size_t)(row0 + F.lane) * 32 + 16 + hd] + F.dt_bias[hd]);
    float cum = dt * (-__expf(F.A_log[hd]));
#pragma unroll
    for (int o = 1; o < 64; o <<= 1) { const float v = __shfl_up(cum, o); cum += (F.lane >= o) ? v : 0.f; }
    dt_out = dt; last = __shfl(cum, 63); return cum;
}
__device__ __forceinline__ void ssd_passA_unit(Frame& F, int u) {
    const int c = u & 31, bg = u >> 5, b = bg >> 1, g = bg & 1, row0 = b * PL + c * CH;
    LAS unsigned char* X = F.lds; LAS unsigned char* BT = X + 64 * X_ST; LAS float* WDEC = (LAS float*)(BT + 64 * BC_ST);
    const int w = F.wave, r = F.lane & 15, q = F.lane >> 4;
    { float dt, last; const float cum = ssd_head_scan(F, g * 8 + w, row0, dt, last);
        WDEC[w * 64 + F.lane] = __expf(last - cum) * dt; if (F.lane == 63) F.AL[(size_t)u * 8 + w] = __expf(last); }
    __syncthreads();
    for (int it = F.tid; it < 80 * 8; it += NTHR) ssd_conv_item<true>(F, b, g, c, it % 80, it / 80, X, BT, nullptr, WDEC);
    __syncthreads();
#pragma unroll 1
    for (int nh = 0; nh < 2; ++nh) {
        f32x4 acc[4][4];
#pragma unroll
        for (int i = 0; i < 4; ++i)
#pragma unroll
            for (int j = 0; j < 4; ++j) acc[i][j] = (f32x4){0.f, 0.f, 0.f, 0.f};
#pragma unroll
        for (int ks = 0; ks < 2; ++ks) { bf16x8v bp[4];
#pragma unroll
            for (int pf = 0; pf < 4; ++pf) bp[pf] = frag_t(X, X_ST, 32 * ks, 64 * w + 16 * pf, r, q);
#pragma unroll
            for (int nf = 0; nf < 4; ++nf) { const bf16x8v a = frag_t(BT, BC_ST, 32 * ks, 64 * nh + 16 * nf, r, q);
#pragma unroll
                for (int pf = 0; pf < 4; ++pf) acc[nf][pf] = MFMA16(a, bp[pf], acc[nf][pf]); } }
#pragma unroll
        for (int nf = 0; nf < 4; ++nf)
#pragma unroll
            for (int pf = 0; pf < 4; ++pf) *(v2u*)(F.DH + (((size_t)u * 8 + w) * SP + 16 * pf + r) * SN + 64 * nh + 16 * nf + 4 * q) = pk4(acc[nf][pf]);
    }
    __syncthreads();
}
__device__ __forceinline__ void ssd_scan(Frame& F) {
    for (int it = F.bid * NTHR + F.tid; it < PB * SH * SP * 32; it += F.G * NTHR) { const int n4 = it & 31, p = (it >> 5) & 63, bhd = it >> 11, b = bhd >> 4, hd = bhd & 15, g = hd >> 3, hl = hd & 7;
        f32x4 H = (f32x4){0.f, 0.f, 0.f, 0.f};
#pragma unroll 8
        for (int c = 0; c < NCH; ++c) { const int u = (b * 2 + g) * NCH + c; const size_t off = (((size_t)u * 8 + hl) * SP + p) * SN + 4 * n4;
            const v2u d = *(const v2u*)(F.DH + off); const float a = F.AL[(size_t)u * 8 + hl];
            *(v2u*)(F.HC + off) = pk4(H);
            H.x = a * H.x + bflo(d.x); H.y = a * H.y + bfhi(d.x); H.z = a * H.z + bflo(d.y); H.w = a * H.w + bfhi(d.y); }
        *(f32x4*)(F.out + O_SSD_P + ((size_t)bhd * SP + p) * SN + 4 * n4) = H; }
}
__device__ __forceinline__ void ssd_passC_unit(Frame& F, int u) {
    const int c = u & 31, bg = u >> 5, b = bg >> 1, g = bg & 1, row0 = b * PL + c * CH;
    LAS unsigned char* X = F.lds; LAS unsigned char* BT = X + 64 * X_ST; LAS unsigned char* CT = BT + 64 * BC_ST; LAS unsigned char* CB = CT + 64 * BC_ST;
    LAS float* DT = (LAS float*)(CB + 64 * ATT_ST); LAS float* CUM = DT + 512; LAS float* red = CUM + 512;
    const int w = F.wave, r = F.lane & 15, q = F.lane >> 4, hd = g * 8 + w;
    bf16x8v hcf[4][4];
    const bf16* Hc0 = F.HC + ((size_t)u * 8 + w) * SP * SN;
#pragma unroll
    for (int ks = 0; ks < 2; ++ks)
#pragma unroll
        for (int pf = 0; pf < 4; ++pf) hcf[ks][pf] = *(const bf16x8v*)(Hc0 + (size_t)(16 * pf + r) * SN + 32 * ks + 8 * q);
    { float dt, last; const float cum = ssd_head_scan(F, hd, row0, dt, last); DT[w * 64 + F.lane] = dt; CUM[w * 64 + F.lane] = cum; }
    for (int it = F.tid; it < 96 * 8; it += NTHR) ssd_conv_item<false>(F, b, g, c, it % 96, it / 96, X, BT, CT, nullptr);
#pragma unroll
    for (int ks = 2; ks < 4; ++ks)
#pragma unroll
        for (int pf = 0; pf < 4; ++pf) hcf[ks][pf] = *(const bf16x8v*)(Hc0 + (size_t)(16 * pf + r) * SN + 32 * ks + 8 * q);
    __syncthreads();
#pragma unroll
    for (int ff = 0; ff < 2; ++ff) { const int f = 2 * w + ff, sf = f >> 2, tf = f & 3; f32x4 a4 = (f32x4){0.f, 0.f, 0.f, 0.f};
        if (sf <= tf) {
#pragma unroll
            for (int ks = 0; ks < 4; ++ks) a4 = MFMA16(frag_k(BT, BC_ST, 16 * sf, 32 * ks, r, q), frag_k(CT, BC_ST, 16 * tf, 32 * ks, r, q), a4); }
        *(LAS v2u*)(CB + (16 * tf + r) * ATT_ST + (16 * sf + 4 * q) * 2) = pk4(a4); }
    __syncthreads();
    f32x4 acc[4][4];
#pragma unroll
    for (int i = 0; i < 4; ++i)
#pragma unroll
        for (int j = 0; j < 4; ++j) acc[i][j] = (f32x4){0.f, 0.f, 0.f, 0.f};
#pragma unroll
    for (int ks = 0; ks < 4; ++ks) { bf16x8v bc[4];
#pragma unroll
        for (int tf = 0; tf < 4; ++tf) bc[tf] = frag_k(CT, BC_ST, 16 * tf, 32 * ks, r, q);
#pragma unroll
        for (int pf = 0; pf < 4; ++pf) {
#pragma unroll
            for (int tf = 0; tf < 4; ++tf) acc[pf][tf] = MFMA16(hcf[ks][pf], bc[tf], acc[pf][tf]); } }
    float ct[4];
#pragma unroll
    for (int tf = 0; tf < 4; ++tf) { ct[tf] = CUM[w * 64 + 16 * tf + r]; const float e = __expf(ct[tf]);
#pragma unroll
        for (int pf = 0; pf < 4; ++pf) acc[pf][tf] = acc[pf][tf] * e; }
#pragma unroll
    for (int ks = 0; ks < 2; ++ks) { bf16x8v ax[4];
#pragma unroll
        for (int pf = 0; pf < 4; ++pf) ax[pf] = frag_t(X, X_ST, 32 * ks, 64 * w + 16 * pf, r, q);
        const int s0 = 32 * ks + 8 * q;
        const f32x4 cs0 = *(const LAS f32x4*)(CUM + w * 64 + s0), cs1 = *(const LAS f32x4*)(CUM + w * 64 + s0 + 4), ds0 = *(const LAS f32x4*)(DT + w * 64 + s0), ds1 = *(const LAS f32x4*)(DT + w * 64 + s0 + 4);
        const float cs[8] = {cs0.x, cs0.y, cs0.z, cs0.w, cs1.x, cs1.y, cs1.z, cs1.w}, ds[8] = {ds0.x, ds0.y, ds0.z, ds0.w, ds1.x, ds1.y, ds1.z, ds1.w};
#pragma unroll
        for (int tf = 0; tf < 4; ++tf) { if (32 * ks > 16 * tf + 15) continue;
            const int t = 16 * tf + r; const v4u cb8 = *(const LAS v4u*)(CB + t * ATT_ST + s0 * 2); float l[8];
#pragma unroll
            for (int e = 0; e < 8; ++e) { const unsigned wd = cb8[e >> 1]; const float cbv = (e & 1) ? bfhi(wd) : bflo(wd); l[e] = (s0 + e <= t) ? cbv * __expf(ct[tf] - cs[e]) * ds[e] : 0.f; }
            const v4u lp = (v4u){pk2(l[0], l[1]), pk2(l[2], l[3]), pk2(l[4], l[5]), pk2(l[6], l[7])}; const bf16x8v bl = __builtin_bit_cast(bf16x8v, lp);
#pragma unroll
            for (int pf = 0; pf < 4; ++pf) acc[pf][tf] = MFMA16(ax[pf], bl, acc[pf][tf]); } }
    const float Dh = F.ssd_D[hd];
#pragma unroll
    for (int tf = 0; tf < 4; ++tf) { const int t = 16 * tf + r; const size_t row = (size_t)(row0 + t); float ss = 0.f;
#pragma unroll
        for (int pf = 0; pf < 4; ++pf) { const int p4 = 64 * w + 16 * pf + 4 * q;
            const v2u xv = *(const LAS v2u*)(X + t * X_ST + p4 * 2); const v2u zv = *(const v2u*)(F.PROJ + row * NP + CZ + g * 512 + p4);
            f32x4 y = acc[pf][tf];
            y.x = (y.x + Dh * bflo(xv.x)) * silu_f(bflo(zv.x)); y.y = (y.y + Dh * bfhi(xv.x)) * silu_f(bfhi(zv.x)); y.z = (y.z + Dh * bflo(xv.y)) * silu_f(bflo(zv.y)); y.w = (y.w + Dh * bfhi(xv.y)) * silu_f(bfhi(zv.y));
            acc[pf][tf] = y; ss += (y.x * y.x + y.y * y.y) + (y.z * y.z + y.w * y.w); }
        ss += __shfl_xor(ss, 16); ss += __shfl_xor(ss, 32);
        if (q == 0) red[w * 64 + t] = ss; }
    __syncthreads();
#pragma unroll
    for (int tf = 0; tf < 4; ++tf) { const int t = 16 * tf + r; const size_t row = (size_t)(row0 + t); float tot = 0.f;
#pragma unroll
        for (int ww = 0; ww < 8; ++ww) tot += red[ww * 64 + t];
        const float rr = rsqrtf(tot * (1.f / 512.f) + EPS);
#pragma unroll
        for (int pf = 0; pf < 4; ++pf) { const int p4 = g * 512 + 64 * w + 16 * pf + 4 * q; const f32x4 nw = *(const f32x4*)(F.ssd_norm + p4);
            f32x4 o = acc[pf][tf]; o.x *= rr * nw.x; o.y *= rr * nw.y; o.z *= rr * nw.z; o.w *= rr * nw.w;
            *(v2u*)(F.MIXIN + row * DM + 1024 + p4) = pk4(o); } }
    __syncthreads();
}

constexpr int ATT8_ST = 80;
__device__ __forceinline__ void gla_sample_unit(Frame& F, int b, int h, f32x4 (&S)[16], int nb, int nh, bool has_next) {
    const int tid = F.tid, w = F.wave, lane = F.lane, r = lane & 15, q = lane >> 4, row0 = MP + b * SL;
    LAS unsigned char* S0b = F.lds;
    LAS unsigned char* Vt = S0b + 128 * V_ST;
    LAS unsigned char* QE = Vt + 32 * V_ST;
    LAS unsigned char* KE = QE + 16 * QE_ST;
    LAS unsigned char* ATT = KE + 16 * QE_ST;
    LAS float* KD = (LAS float*)(ATT + 16 * ATT8_ST);
    LAS float* EL = KD + 1024;
    LAS float* red = EL + 128;
    f32x4 Vf[8];
#pragma unroll
    for (int s = 0; s < 8; ++s) { const v2u vv = *(const v2u*)(F.PROJ + (size_t)(row0 + s) * NP + CV + h * GV + 4 * lane); Vf[s] = (f32x4){bflo(vv.x), bfhi(vv.x), bflo(vv.y), bfhi(vv.y)}; }
    if (tid < 256) { const int t = tid >> 5, c16 = tid & 31; *(LAS v4u*)(Vt + t * V_ST + c16 * 16) = *(const v4u*)(F.PROJ + (size_t)(row0 + t) * NP + CV + h * GV + c16 * 8); }
    for (int i = tid; i < 24 * 32; i += NTHR) *(LAS v4u*)(Vt + (8 + (i >> 5)) * V_ST + (i & 31) * 16) = (v4u){0u, 0u, 0u, 0u};
    { LAS unsigned char* KR = (LAS unsigned char*)(red + 128); LAS unsigned char* QR = KR + 8 * 256; LAS float* LR = (LAS float*)(QR + 8 * 256); LAS float* LG = LR + 128;
        if (tid < 256) { const int which = tid >> 7, j = tid & 127, t = j >> 4, c16 = j & 15;
            *(LAS v4u*)((which ? QR : KR) + t * 256 + c16 * 16) = *(const v4u*)(F.PROJ + (size_t)(row0 + t) * NP + (which ? CQ : CK) + h * GK + c16 * 8); }
        else if (tid < 288) { const int j = tid - 256; *(LAS v4u*)(LR + (j >> 2) * 16 + (j & 3) * 4) = *(const v4u*)(F.LRDT + (size_t)(row0 + (j >> 2)) * 32 + (j & 3) * 4); }
        __syncthreads();
        { const int k = tid & 127, tp = tid >> 7, hk = h * GK + k; const float bg = F.b_gate[hk];
            float w2[16];
#pragma unroll
            for (int j = 0; j < 16; ++j) w2[j] = F.w_gate2[j * GKD + hk];
#pragma unroll
            for (int tt = 0; tt < 2; ++tt) { const int t = 2 * tp + tt; const LAS f32x4* lr = (const LAS f32x4*)(LR + t * 16); const f32x4 a = lr[0], bq = lr[1], c = lr[2], d = lr[3];
                const float x = bg + a.x * w2[0] + a.y * w2[1] + a.z * w2[2] + a.w * w2[3] + bq.x * w2[4] + bq.y * w2[5] + bq.z * w2[6] + bq.w * w2[7]
                              + c.x * w2[8] + c.y * w2[9] + c.z * w2[10] + c.w * w2[11] + d.x * w2[12] + d.y * w2[13] + d.z * w2[14] + d.w * w2[15];
                LG[t * 128 + k] = logsigmoid_f(x) * (1.f / 16.f); } }
        __syncthreads();
        if (tid < 128) { const int k = tid;
            float bcum[8], kv[8]; float run = 0.f;
#pragma unroll
            for (int t = 0; t < 8; ++t) { run += LG[t * 128 + k]; bcum[t] = run; kv[t] = bf2f(*(const LAS bf16*)(KR + t * 256 + k * 2));
                *(LAS bf16*)(QE + t * QE_ST + k * 2) = (bf16)f2bf(bf2f(*(const LAS bf16*)(QR + t * 256 + k * 2)) * 0.08838834764831845f * __expf(run));
                *(LAS bf16*)(KE + t * QE_ST + k * 2) = (bf16)f2bf(kv[t] * __expf(-run)); }
            f32x4 d0, d1; d0.x = kv[0] * __expf(run - bcum[0]); d0.y = kv[1] * __expf(run - bcum[1]); d0.z = kv[2] * __expf(run - bcum[2]); d0.w = kv[3] * __expf(run - bcum[3]);
            d1.x = kv[4] * __expf(run - bcum[4]); d1.y = kv[5] * __expf(run - bcum[5]); d1.z = kv[6] * __expf(run - bcum[6]); d1.w = kv[7];
            *(LAS f32x4*)(KD + k * 8) = d0; *(LAS f32x4*)(KD + k * 8 + 4) = d1; EL[k] = __expf(run); } }
    if (tid < 128) {
    } else if (tid < 384) { const int i = tid - 128, which = i >> 7, j = i & 127;
        *(LAS v4u*)((which ? KE : QE) + (8 + (j >> 4)) * QE_ST + (j & 15) * 16) = (v4u){0u, 0u, 0u, 0u};
    } else if (tid < 384 + 80) { *(LAS v4u*)(ATT + (tid - 384) * 16) = (v4u){0u, 0u, 0u, 0u}; }
#pragma unroll
    for (int i = 0; i < 16; ++i) *(LAS v2u*)(S0b + (16 * w + i) * V_ST + lane * 8) = pk4(S[i]);
    __syncthreads();
    if (w == 0) { f32x4 a4 = (f32x4){0.f, 0.f, 0.f, 0.f};
#pragma unroll
        for (int ks = 0; ks < 4; ++ks) a4 = MFMA16(frag_k(KE, QE_ST, 0, 32 * ks, r, q), frag_k(QE, QE_ST, 0, 32 * ks, r, q), a4);
        const int s0i = 4 * q; f32x4 m; m.x = (s0i <= r) ? a4.x : 0.f; m.y = (s0i + 1 <= r) ? a4.y : 0.f; m.z = (s0i + 2 <= r) ? a4.z : 0.f; m.w = (s0i + 3 <= r) ? a4.w : 0.f;
        if (r >= 8) m = (f32x4){0.f, 0.f, 0.f, 0.f};
        *(LAS v2u*)(ATT + r * ATT8_ST + s0i * 2) = pk4(m); }
    { f32x4* so = (f32x4*)(F.out + O_GLA_S + ((size_t)(b * GH + h) * GK + 16 * w) * GV) + lane;
#pragma unroll
        for (int i = 0; i < 16; ++i) { const int k = 16 * w + i; const float e = EL[k]; const f32x4 k0 = *(const LAS f32x4*)(KD + k * 8), k1 = *(const LAS f32x4*)(KD + k * 8 + 4);
            f32x4 n = S[i] * e; n = n + Vf[0] * k0.x; n = n + Vf[1] * k0.y; n = n + Vf[2] * k0.z; n = n + Vf[3] * k0.w; n = n + Vf[4] * k1.x; n = n + Vf[5] * k1.y; n = n + Vf[6] * k1.z; n = n + Vf[7] * k1.w;
            so[i * 64] = n; } }
    if (has_next) { const f32x4* s1 = (const f32x4*)(F.st_gla + ((size_t)(nb * GH + nh) * GK + 16 * w) * GV) + lane;
#pragma unroll
        for (int i = 0; i < 16; ++i) S[i] = s1[i * 64]; }
    f32x4 acc[2] = {(f32x4){0.f, 0.f, 0.f, 0.f}, (f32x4){0.f, 0.f, 0.f, 0.f}};
#pragma unroll
    for (int ks = 0; ks < 4; ++ks) { const bf16x8v bq = frag_k(QE, QE_ST, 0, 32 * ks, r, q);
#pragma unroll
        for (int vf = 0; vf < 2; ++vf) acc[vf] = MFMA16(frag_t(S0b, V_ST, 32 * ks, 32 * w + 16 * vf, r, q), bq, acc[vf]); }
    __syncthreads();
    { const bf16x8v ba = *(const LAS bf16x8v*)(ATT + r * ATT8_ST + 16 * q);
#pragma unroll
        for (int vf = 0; vf < 2; ++vf) acc[vf] = MFMA16(frag_t(Vt, V_ST, 0, 32 * w + 16 * vf, r, q), ba, acc[vf]); }
    float ss = (acc[0].x * acc[0].x + acc[0].y * acc[0].y) + (acc[0].z * acc[0].z + acc[0].w * acc[0].w) + (acc[1].x * acc[1].x + acc[1].y * acc[1].y) + (acc[1].z * acc[1].z + acc[1].w * acc[1].w);
    ss += __shfl_xor(ss, 16); ss += __shfl_xor(ss, 32);
    if (q == 0) red[w * 16 + r] = ss;
    __syncthreads();
    float tot = 0.f;
#pragma unroll
    for (int ww = 0; ww < 8; ++ww) tot += red[ww * 16 + r];
    const float rr = rsqrtf(tot * (1.f / GV) + EPS);
    if (r < 8) { const size_t row = (size_t)(row0 + r);
#pragma unroll
        for (int vf = 0; vf < 2; ++vf) { const int v = 32 * w + 16 * vf + 4 * q;
            const v2u gw = *(const v2u*)(F.PROJ + row * NP + CG + h * GV + v); const f32x4 nw = *(const f32x4*)(F.gla_norm + v);
            f32x4 o; o.x = acc[vf].x * rr * nw.x * silu_f(bflo(gw.x)); o.y = acc[vf].y * rr * nw.y * silu_f(bfhi(gw.x)); o.z = acc[vf].z * rr * nw.z * silu_f(bflo(gw.y)); o.w = acc[vf].w * rr * nw.w * silu_f(bfhi(gw.y));
            *(v2u*)(F.MIXIN + row * DM + h * GV + v) = pk4(o); } }
    __syncthreads();
}
__device__ __forceinline__ void ssd_sample_unit(Frame& F, int b, int g) {
    const int tid = F.tid, w = F.wave, lane = F.lane, r = lane & 15, q = lane >> 4, row0 = MP + b * SL, hd = g * 8 + w, ch = g * 512 + tid;
    LAS float* Xs = (LAS float*)F.lds;
    LAS float* XW = Xs + 4096;
    LAS float* Bs = XW + 4096;
    LAS unsigned char* Cb = (LAS unsigned char*)(Bs + 1024);
    LAS unsigned char* Bb = Cb + 16 * QE_ST;
    LAS float* CBm = (LAS float*)(Bb + 16 * QE_ST);
    LAS float* CD = CBm + 256;
    LAS float* red = CD + 128;
    const float* h0base = F.st_ssd + ((size_t)(b * SH + hd) * SP) * SN; float* hobase = F.out + O_SSD_S + ((size_t)(b * SH + hd) * SP) * SN;
    f32x4 hbuf[4][2];
#pragma unroll
    for (int i = 0; i < 4; ++i) { const size_t off = (size_t)(16 * (i & 3) + r) * SN + 32 * (i >> 2) + 8 * q; hbuf[i][0] = *(const f32x4*)(h0base + off); hbuf[i][1] = *(const f32x4*)(h0base + off + 4); }
    float dt[8], cum[8]; { const float A = -__expf(F.A_log[hd]), dtb = F.dt_bias[hd]; float run = 0.f;
#pragma unroll
        for (int t = 0; t < 8; ++t) { dt[t] = softplus_f(F.LRDT[(size_t)(row0 + t) * 32 + 16 + hd] + dtb); run += dt[t] * A; cum[t] = run; } }
    const float last = cum[7], elast = __expf(last);
    if (lane < 8) { float cv = cum[0], dv = dt[0];
#pragma unroll
        for (int t = 1; t < 8; ++t) { cv = (lane == t) ? cum[t] : cv; dv = (lane == t) ? dt[t] : dv; }
        CD[w * 16 + lane] = cv; CD[w * 16 + 8 + lane] = dv; }
    { float xr[11]; const float cb = F.sconv_b[ch], c0 = F.sconv_w[ch], c1 = F.sconv_w[SCH + ch], c2 = F.sconv_w[2 * SCH + ch], c3 = F.sconv_w[3 * SCH + ch];
#pragma unroll
        for (int i = 0; i < 11; ++i) xr[i] = xbc_raw(F, 1, b, row0, i - 3, ch);
        float xw[8];
#pragma unroll
        for (int t = 0; t < 8; ++t) { const float x = silu_f(cb + c0 * xr[t] + c1 * xr[t + 1] + c2 * xr[t + 2] + c3 * xr[t + 3]); Xs[t * 512 + tid] = x; xw[t] = x * __expf(last - cum[t]) * dt[t]; }
        *(LAS f32x4*)(XW + tid * 8) = (f32x4){xw[0], xw[1], xw[2], xw[3]}; *(LAS f32x4*)(XW + tid * 8 + 4) = (f32x4){xw[4], xw[5], xw[6], xw[7]}; }
    if (tid < 256) { const int n = tid & 127, isC = tid >> 7, cc = 1024 + isC * 256 + g * 128 + n;
        float xr[11]; const float cb = F.sconv_b[cc], c0 = F.sconv_w[cc], c1 = F.sconv_w[SCH + cc], c2 = F.sconv_w[2 * SCH + cc], c3 = F.sconv_w[3 * SCH + cc];
#pragma unroll
        for (int i = 0; i < 11; ++i) xr[i] = xbc_raw(F, 1, b, row0, i - 3, cc);
#pragma unroll
        for (int t = 0; t < 8; ++t) { const float x = silu_f(cb + c0 * xr[t] + c1 * xr[t + 1] + c2 * xr[t + 2] + c3 * xr[t + 3]);
            if (!isC) Bs[t * 128 + n] = x;
            *(LAS bf16*)((isC ? Cb : Bb) + t * QE_ST + n * 2) = (bf16)f2bf(x); }
    } else { const int i = tid - 256, which = i >> 7, j = i & 127; *(LAS v4u*)((which ? Bb : Cb) + (8 + (j >> 4)) * QE_ST + (j & 15) * 16) = (v4u){0u, 0u, 0u, 0u}; }
    __syncthreads();
    if (w == 0) { f32x4 a4 = (f32x4){0.f, 0.f, 0.f, 0.f};
#pragma unroll
        for (int ks = 0; ks < 4; ++ks) a4 = MFMA16(frag_k(Bb, QE_ST, 0, 32 * ks, r, q), frag_k(Cb, QE_ST, 0, 32 * ks, r, q), a4);
        *(LAS f32x4*)(CBm + r * 16 + 4 * q) = a4; }
    bf16x8v bc[4];
#pragma unroll
    for (int ks = 0; ks < 4; ++ks) bc[ks] = frag_k(Cb, QE_ST, 0, 32 * ks, r, q);
    f32x4 acc[4];
#pragma unroll
    for (int pf = 0; pf < 4; ++pf) acc[pf] = (f32x4){0.f, 0.f, 0.f, 0.f};
    f32x4 Bv[8][2];
#pragma unroll
    for (int st = 0; st < 16; ++st) { const int ks = st >> 2, pf = st & 3;
        if (pf == 0) {
#pragma unroll
            for (int s = 0; s < 8; ++s) { Bv[s][0] = *(const LAS f32x4*)(Bs + s * 128 + 32 * ks + 8 * q); Bv[s][1] = *(const LAS f32x4*)(Bs + s * 128 + 32 * ks + 8 * q + 4); } }
        const int p = 16 * pf + r; const size_t off = (size_t)p * SN + 32 * ks + 8 * q;
        const f32x4 ha = hbuf[st & 3][0], hb = hbuf[st & 3][1];
        if (st + 4 < 16) { const int st2 = st + 4; const size_t off2 = (size_t)(16 * (st2 & 3) + r) * SN + 32 * (st2 >> 2) + 8 * q; hbuf[st & 3][0] = *(const f32x4*)(h0base + off2); hbuf[st & 3][1] = *(const f32x4*)(h0base + off2 + 4); }
        asm volatile("" ::: "memory");
        const f32x4 x0 = *(const LAS f32x4*)(XW + (64 * w + p) * 8), x1 = *(const LAS f32x4*)(XW + (64 * w + p) * 8 + 4);
        f32x4 na = ha * elast, nb = hb * elast;
        na = na + Bv[0][0] * x0.x; nb = nb + Bv[0][1] * x0.x; na = na + Bv[1][0] * x0.y; nb = nb + Bv[1][1] * x0.y; na = na + Bv[2][0] * x0.z; nb = nb + Bv[2][1] * x0.z; na = na + Bv[3][0] * x0.w; nb = nb + Bv[3][1] * x0.w;
        na = na + Bv[4][0] * x1.x; nb = nb + Bv[4][1] * x1.x; na = na + Bv[5][0] * x1.y; nb = nb + Bv[5][1] * x1.y; na = na + Bv[6][0] * x1.z; nb = nb + Bv[6][1] * x1.z; na = na + Bv[7][0] * x1.w; nb = nb + Bv[7][1] * x1.w;
        *(f32x4*)(hobase + off) = na; *(f32x4*)(hobase + off + 4) = nb;
        const v4u ap = (v4u){pk2(ha.x, ha.y), pk2(ha.z, ha.w), pk2(hb.x, hb.y), pk2(hb.z, hb.w)};
        acc[pf] = MFMA16(__builtin_bit_cast(bf16x8v, ap), bc[ks], acc[pf]); }
    __syncthreads();
    const int tc = r & 7; const float ct = CD[w * 16 + tc], ect = __expf(ct), Dh = F.ssd_D[hd];
    float L[8]; { const f32x4 c0 = *(const LAS f32x4*)(CBm + r * 16), c1 = *(const LAS f32x4*)(CBm + r * 16 + 4); const float cbv[8] = {c0.x, c0.y, c0.z, c0.w, c1.x, c1.y, c1.z, c1.w};
        const f32x4 q0 = *(const LAS f32x4*)(CD + w * 16), q1 = *(const LAS f32x4*)(CD + w * 16 + 4), d0 = *(const LAS f32x4*)(CD + w * 16 + 8), d1 = *(const LAS f32x4*)(CD + w * 16 + 12);
        const float cu[8] = {q0.x, q0.y, q0.z, q0.w, q1.x, q1.y, q1.z, q1.w}, dd[8] = {d0.x, d0.y, d0.z, d0.w, d1.x, d1.y, d1.z, d1.w};
#pragma unroll
        for (int s = 0; s < 8; ++s) L[s] = (s <= tc) ? cbv[s] * __expf(ct - cu[s]) * dd[s] : 0.f; }
    float ss = 0.f; const size_t row = (size_t)(row0 + tc);
#pragma unroll
    for (int pf = 0; pf < 4; ++pf) { const int p4 = 64 * w + 16 * pf + 4 * q;
        f32x4 y = acc[pf] * ect;
#pragma unroll
        for (int s = 0; s < 8; ++s) y = y + *(const LAS f32x4*)(Xs + s * 512 + p4) * L[s];
        const f32x4 xt = *(const LAS f32x4*)(Xs + tc * 512 + p4); const v2u zv = *(const v2u*)(F.PROJ + row * NP + CZ + g * 512 + p4);
        y.x = (y.x + Dh * xt.x) * silu_f(bflo(zv.x)); y.y = (y.y + Dh * xt.y) * silu_f(bfhi(zv.x)); y.z = (y.z + Dh * xt.z) * silu_f(bflo(zv.y)); y.w = (y.w + Dh * xt.w) * silu_f(bfhi(zv.y));
        acc[pf] = y; ss += (y.x * y.x + y.y * y.y) + (y.z * y.z + y.w * y.w); }
    ss += __shfl_xor(ss, 16); ss += __shfl_xor(ss, 32);
    if (q == 0) red[w * 16 + r] = ss;
    __syncthreads();
    float tot = 0.f;
#pragma unroll
    for (int ww = 0; ww < 8; ++ww) tot += red[ww * 16 + r];
    const float rr = rsqrtf(tot * (1.f / 512.f) + EPS);
    if (r < 8) {
#pragma unroll
        for (int pf = 0; pf < 4; ++pf) { const int p4 = g * 512 + 64 * w + 16 * pf + 4 * q; const f32x4 nw = *(const f32x4*)(F.ssd_norm + p4);
            f32x4 o = acc[pf]; o.x *= rr * nw.x; o.y *= rr * nw.y; o.z *= rr * nw.z; o.w *= rr * nw.w;
            *(v2u*)(F.MIXIN + row * DM + 1024 + p4) = pk4(o); } }
    __syncthreads();
}

__device__ __forceinline__ void p2a_chunk_states(Frame& F) {
    for (int idx = F.bid; idx < 768; idx += F.G) { if (idx < 256) { TBEGIN(F, 20); ssd_passA_unit(F, idx); TEND(F, 20); } else { TBEGIN(F, 21); gla_passA_unit(F, idx - 256); TEND(F, 21); } }
}
#ifndef MK_REP_PHASE
#define MK_REP_PHASE (-1)
#endif
__device__ __forceinline__ void p2b_scans_and_sample(Frame& F) {
    TBEGIN(F, 30); for (int rep = 0; rep < (MK_REP_PHASE == 30 ? 2 : 1); ++rep) { gla_scan(F); ssd_scan(F); } TEND(F, 30);
    TBEGIN(F, 31);
    for (int rep = 0; rep < (MK_REP_PHASE == 31 ? 2 : 1); ++rep)
    { f32x4 S[16]; int idx = F.bid;
            if (idx < SB * GH) { const f32x4* s0 = (const f32x4*)(F.st_gla + ((size_t)idx * GK + 16 * F.wave) * GV) + F.lane;
#pragma unroll
                for (int i = 0; i < 16; ++i) S[i] = s0[i * 64]; }
            for (; idx < SB * GH; idx += F.G) { const int nx = idx + F.G; gla_sample_unit(F, idx / GH, idx % GH, S, nx / GH, nx % GH, nx < SB * GH); } }
    TEND(F, 31); TBEGIN(F, 32);
    for (int rep = 0; rep < (MK_REP_PHASE == 32 ? 2 : 1); ++rep)
        for (int idx = F.bid; idx < SB * SG; idx += F.G) ssd_sample_unit(F, idx / SG, idx % SG);
    TEND(F, 32);
}
__device__ __forceinline__ void p2c_outputs(Frame& F) {
    for (int idx = F.bid; idx < 768; idx += F.G) { if (idx < 256) { TBEGIN(F, 40); ssd_passC_unit(F, idx); TEND(F, 40); } else { TBEGIN(F, 41); gla_passC_unit(F, idx - 256); TEND(F, 41); } }
    TBEGIN(F, 42);
    const int gt = F.bid * NTHR + F.tid, NT = F.G * NTHR;
    for (int i = gt; i < (PB + SB) * 3 * SCH; i += NT) { const int c = i % SCH, j = (i / SCH) % 3, s = i / (3 * SCH);
        const int grp = s >= PB, b = grp ? s - PB : s, L = grp ? SL : PL, row0 = grp ? MP + b * SL : b * PL;
        F.out[(grp ? O_SCONV_S : O_SCONV_P) + ((size_t)b * 3 + j) * SCH + c] = bf2f(F.PROJ[(size_t)(row0 + L - 3 + j) * NP + CX + c]); }
    TEND(F, 42);
}

__device__ __forceinline__ void p4_post_mixer(Frame& F) {
    const int gw = F.bid * NWAVES + F.wave, NGW = F.G * NWAVES, lane = F.lane;
    for (int m = gw; m < M; m += NGW) {
        const v2u* mr = (const v2u*)((const bf16*)F.MIX + (size_t)m * DM) + lane; const f32x4* xr = (const f32x4*)x_row(F, m) + lane;
        const f32x4* w1 = (const f32x4*)F.n_mix_post + lane; const f32x4* w2 = (const f32x4*)F.n_ffn_pre + lane;
        f32x4 v[8]; float s = 0.f;
#pragma unroll
        for (int j = 0; j < 8; ++j) { const v2u p = mr[64 * j]; v[j] = (f32x4){bflo(p.x), bfhi(p.x), bflo(p.y), bfhi(p.y)}; s += (v[j].x * v[j].x + v[j].y * v[j].y) + (v[j].z * v[j].z + v[j].w * v[j].w); }
        const float r1 = rsqrtf(wave_sum(s) * (1.f / DM) + EPS); float s2 = 0.f;
        f32x4* ho = (f32x4*)(F.out + O_Y + (size_t)m * DM) + lane;
#pragma unroll
        for (int j = 0; j < 8; ++j) { v[j] = xr[64 * j] + v[j] * r1 * w1[64 * j]; ho[64 * j] = v[j]; s2 += (v[j].x * v[j].x + v[j].y * v[j].y) + (v[j].z * v[j].z + v[j].w * v[j].w); }
        const float r2 = rsqrtf(wave_sum(s2) * (1.f / DM) + EPS);
        v2u* o8 = (v2u*)(F.XN + (size_t)m * DM) + lane;
#pragma unroll
        for (int j = 0; j < 8; ++j) { const f32x4 ww = w2[64 * j]; v2u o; o.x = pk2(v[j].x * r2 * ww.x, v[j].y * r2 * ww.y); o.y = pk2(v[j].z * r2 * ww.z, v[j].w * r2 * ww.w); o8[64 * j] = o; }
    }
}
__device__ __forceinline__ void p6_conv_fixup(Frame& F) {
    const int gt = F.bid * NTHR + F.tid, NT = F.G * NTHR;
    constexpr int NQ = FF / 4;
    for (int it = gt; it < 28 * 2 * NQ; it += NT) { const int c = (it % NQ) * 4, rr = (it / NQ) & 1, bi = it / (2 * NQ), pm = (bi / 7) * 8 + 1 + (bi % 7);
        f32x4 o[2];
#pragma unroll
        for (int hf = 0; hf < 2; ++hf) { const int cc = hf * FF + c;
            const f32x4 w0 = *(const f32x4*)(F.fconv_w + cc), w1 = *(const f32x4*)(F.fconv_w + FF2 + cc), w2 = *(const f32x4*)(F.fconv_w + 2 * FF2 + cc), bs = *(const f32x4*)(F.fconv_b + cc);
            const f32x4 um2 = *(const f32x4*)(F.HG + ((size_t)(pm - 1) * 4 + 2 + rr) * FF2 + cc);
            const f32x4 um1 = rr ? *(const f32x4*)(F.HG + ((size_t)pm * 4) * FF2 + cc) : *(const f32x4*)(F.HG + ((size_t)(pm - 1) * 4 + 3) * FF2 + cc);
            const f32x4 u0 = *(const f32x4*)(F.HG + ((size_t)pm * 4 + rr) * FF2 + cc);
            o[hf] = bs + w0 * um2 + w1 * um1 + w2 * u0; }
        v2u pk; pk.x = pk2(silu_f(o[0].x) * o[1].x, silu_f(o[0].y) * o[1].y); pk.y = pk2(silu_f(o[0].z) * o[1].z, silu_f(o[0].w) * o[1].w);
        *(v2u*)(F.ACT + (size_t)(pm * 256 + rr) * FF + c) = pk; }
    for (int i = gt; i < PB * 2 * (FF2 / 4); i += NT) { const int c = (i % (FF2 / 4)) * 4, j = (i / (FF2 / 4)) & 1, b = i / (2 * (FF2 / 4));
        *(f32x4*)(F.out + O_FCONV_P + ((size_t)b * 2 + j) * FF2 + c) = *(const f32x4*)(F.HG + ((size_t)(b * 8 + 7) * 4 + 2 + j) * FF2 + c); }
}
__device__ __forceinline__ void p8_final(Frame& F) {
    const int gw = F.bid * NWAVES + F.wave, NGW = F.G * NWAVES, lane = F.lane;
    for (int m = gw; m < M; m += NGW) {
        const v2u* fr = (const v2u*)((const bf16*)F.Fb + (size_t)m * DM) + lane; const f32x4* w1 = (const f32x4*)F.n_ffn_post + lane;
        f32x4* ho = (f32x4*)(F.out + O_Y + (size_t)m * DM) + lane;
        f32x4 v[8]; float s = 0.f;
#pragma unroll
        for (int j = 0; j < 8; ++j) { const v2u p = fr[64 * j]; v[j] = (f32x4){bflo(p.x), bfhi(p.x), bflo(p.y), bfhi(p.y)}; s += (v[j].x * v[j].x + v[j].y * v[j].y) + (v[j].z * v[j].z + v[j].w * v[j].w); }
        const float r1 = rsqrtf(wave_sum(s) * (1.f / DM) + EPS);
#pragma unroll
        for (int j = 0; j < 8; ++j) ho[64 * j] = ho[64 * j] + v[j] * r1 * w1[64 * j];
    }
}

__device__ __forceinline__ pg8::SplitCtx split_ctx(const Frame& F, unsigned char* ws, size_t slab_off, int bank) {
    pg8::SplitCtx X; X.slabs = (pg8::f32x4*)(ws + slab_off); X.cnt = (unsigned*)(ws + WS_CTL) + CW_SPLIT + bank * 1024; X.flag = (volatile LAS unsigned*)(F.lds + MISC_OFF) + 16; X.id = bank; return X; }

struct Args { const float* in[25]; float* out; unsigned char* ws; int ph_lo, ph_hi; };
__global__ void __launch_bounds__(NTHR, 2) fwd_kernel(Args args) {
    extern __shared__ __attribute__((aligned(16))) unsigned char lds[];
    Frame F;
    F.lds = (LAS unsigned char*)lds;
    F.tid = threadIdx.x; F.lane = F.tid & 63; F.wave = __builtin_amdgcn_readfirstlane(F.tid >> 6);
    F.G = gridDim.x; F.bid = blockIdx.x;
    unsigned char* ws = args.ws;
    F.x_p = args.in[0]; F.x_s = args.in[1]; F.st_gla = args.in[2]; F.st_ssd = args.in[3]; F.st_sconv = args.in[4]; F.st_fconv = args.in[5];
    F.n_mix_pre = args.in[6]; F.n_mix_post = args.in[7]; F.n_ffn_pre = args.in[8]; F.n_ffn_post = args.in[9]; F.w_in = args.in[10];
    F.w_gate2 = args.in[11]; F.b_gate = args.in[12]; F.gla_norm = args.in[13]; F.sconv_w = args.in[14]; F.sconv_b = args.in[15];
    F.dt_bias = args.in[16]; F.A_log = args.in[17]; F.ssd_D = args.in[18]; F.ssd_norm = args.in[19]; F.w_out = args.in[20];
    F.ffn_w_in = args.in[21]; F.fconv_w = args.in[22]; F.fconv_b = args.in[23]; F.ffn_w_out = args.in[24];
    F.out = args.out;
    F.W1 = (bf16*)(ws + WS_W1); F.WO = (bf16*)(ws + WS_WO); F.WF1 = (bf16*)(ws + WS_WF1); F.WF2 = (bf16*)(ws + WS_WF2);
    F.XN = (bf16*)(ws + WS_XN); F.PROJ = (bf16*)(ws + WS_PROJ); F.MIXIN = (bf16*)(ws + WS_MIXIN); F.ACT = (bf16*)(ws + WS_ACT); F.HG = (float*)(ws + WS_HG);
    F.LRDT = (float*)(ws + WS_LRDT); F.MIX = (float*)(ws + WS_MIX); F.Fb = (float*)(ws + WS_F);
    F.DS = (bf16*)(ws + WS_DS); F.SC = (bf16*)(ws + WS_SC); F.DH = (bf16*)(ws + WS_DH); F.HC = (bf16*)(ws + WS_HC); F.EBL = (float*)(ws + WS_EBL); F.AL = (float*)(ws + WS_AL); F.QEg = (bf16*)(ws + WS_QEG); F.KEg = (bf16*)(ws + WS_KEG);
    for (int u = F.tid; u < (LDS_BYTES - LDSCTL_OFF) / 4; u += NTHR) ((LAS unsigned*)(F.lds + LDSCTL_OFF))[u] = 0u;
    __syncthreads();
    const int lo = args.ph_lo, hi = args.ph_hi;
#if !MK_PER_PHASE
    XcdBarrier bar = xcd_barrier_post((unsigned*)(ws + WS_CTL) + CW_BAR, (volatile LAS unsigned*)(F.lds + MISC_OFF) + 8);
#define GRID_BAR() do { if (args.ph_hi > 1000) cg::this_grid().sync(); xcd_barrier(bar); } while (0)
#else
#define GRID_BAR() do { } while (0)
#endif
#define IN(k) (lo <= (k) && (k) < hi)
#define SEAM(k) do { if (IN(k) && IN((k) + 1)) GRID_BAR(); } while (0)
    F.tacc = 0; F.tmark = 0;
#define PHASE(k, ...) do { if (IN(k)) { TBEGIN(F, k); if (MK_REP_PHASE == (k)) { __VA_ARGS__; GRID_BAR(); } TBEGIN(F, 100 + (k)); __VA_ARGS__; TEND(F, 100 + (k)); SEAM(k); TEND(F, k); } } while (0)
    PHASE(0, p0_prologue(F));
    PHASE(1, { pg8::Gemm g{F.XN, F.W1, M, N1, DM}; pg8::StaticOrder S; S.init(M, N1, DM, F.G, F.bid, 1);
        pg8::EpiBf16 E{F.PROJ, NP, NP / 256, F.LRDT};
        pg8::gemm_phase<pg8::EpiBf16, pg8::StaticOrder, true, true>(F.lds, g, S, E, split_ctx(F, ws, WS_SLAB, 0));
        if (S.rem && F.bid >= S.rem * S.S) p0_convert_rest(F, F.bid - S.rem * S.S, F.G - S.rem * S.S); else if (!S.rem) p0_convert_rest(F, F.bid, F.G); });
    PHASE(2, p2a_chunk_states(F));
    PHASE(3, p2b_scans_and_sample(F));
    PHASE(4, p2c_outputs(F));
    PHASE(5, { pg8::Gemm g{F.MIXIN, F.WO, M, DM, DM}; pg8::StaticOrder S; S.init(M, DM, DM, F.G, F.bid, 4);
        pg8::EpiBf16 E{(bf16*)F.MIX, DM, DM / 256, nullptr};
        pg8::gemm_phase<pg8::EpiBf16, pg8::StaticOrder, true, true>(F.lds, g, S, E, split_ctx(F, ws, WS_SLAB, 1)); });
    PHASE(6, p4_post_mixer(F));
    PHASE(7, { pg8::Gemm g{F.XN, F.WF1, M, FF2, DM}; pg8::StaticOrder S; S.init(M, FF2, DM, F.G, F.bid, 1, MS / 256);
        pg8::EpiConvAct E{F.ACT, F.HG, F.fconv_w, F.fconv_b, F.st_fconv, F.out + O_FCONV_S, (LAS float*)(F.lds + MISC_OFF + 512)};
        TBEGIN(F, 70); pg8::gemm_phase<pg8::EpiConvAct, pg8::StaticOrder, true, true>(F.lds, g, S, E, split_ctx(F, ws, WS_SLAB, 2)); TEND(F, 70); });
    PHASE(8, p6_conv_fixup(F));
    PHASE(9, { pg8::Gemm g{F.ACT, F.WF2, M, DM, FF}; pg8::StaticOrder S; S.init(M, DM, FF, F.G, F.bid, 4);
        pg8::EpiBf16 E{(bf16*)F.Fb, DM, DM / 256, nullptr};
        pg8::gemm_phase<pg8::EpiBf16, pg8::StaticOrder, true, true>(F.lds, g, S, E, split_ctx(F, ws, WS_SLAB, 3)); });
    if (IN(10)) { TBEGIN(F, 10); p8_final(F); if (MK_TIME_PHASE == 10) { asm volatile("s_waitcnt vmcnt(0)" ::: "memory"); __syncthreads(); } TEND(F, 10); }
    if (MK_TIME_PHASE >= 50 && MK_TIME_PHASE < 70) F.tacc = ((volatile LAS unsigned*)(F.lds + MISC_OFF))[16 + 2];
    if (MK_TIME_PHASE >= 0 && F.bid == 0) { const unsigned long long te = __builtin_amdgcn_s_memrealtime(), d = 8ull * F.tacc; while (__builtin_amdgcn_s_memrealtime() - te < d) __builtin_amdgcn_s_sleep(16); }
#undef IN
#undef SEAM
}

extern "C" void kernel_launch(void* const* d_in, const int* in_sizes, int n_in, void* d_out, int out_size, void* d_ws, size_t ws_size, hipStream_t stream) {
    static int grid = 0;
    if (grid == 0) {
        if (n_in != 25 || (size_t)out_size != O_END || ws_size < WS_END) { fprintf(stderr, "kernel_launch: unexpected sizes n_in %d out %d ws %zu (need out %zu ws %zu)\n", n_in, out_size, ws_size, (size_t)O_END, (size_t)WS_END); grid = -1; return; }
        int dev = 0, cus = 0, per_cu = 0;
        hipGetDevice(&dev); hipDeviceGetAttribute(&cus, hipDeviceAttributeMultiprocessorCount, dev);
        if (hipFuncSetAttribute((const void*)fwd_kernel, hipFuncAttributeMaxDynamicSharedMemorySize, LDS_BYTES) != hipSuccess) { fprintf(stderr, "kernel_launch: hipFuncSetAttribute failed\n"); grid = -1; return; }
        hipOccupancyMaxActiveBlocksPerMultiprocessor(&per_cu, (const void*)fwd_kernel, NTHR, LDS_BYTES);
        if (per_cu < 1) { fprintf(stderr, "kernel_launch: occupancy query says %d blocks per CU\n", per_cu); grid = -1; return; }
        grid = cus;
        (void)hipGetLastError();
    }
    if (grid < 0) return;
    Args a{};
    for (int i = 0; i < 25; ++i) a.in[i] = (const float*)d_in[i];
    a.out = (float*)d_out; a.ws = (unsigned char*)d_ws;
#if MK_PER_PHASE
    hipMemsetAsync((char*)d_ws + WS_CTL, 0, CTL_ZERO_BYTES, stream);
    for (int p = 0; p < N_PHASES; ++p) { a.ph_lo = p; a.ph_hi = p + 1; hipLaunchKernelGGL(fwd_kernel, dim3(grid), dim3(NTHR), LDS_BYTES, stream, a); }
#else
    hipMemsetAsync((char*)d_ws + WS_CTL, 0, CTL_ZERO_BYTES, stream);
    a.ph_lo = 0; a.ph_hi = N_PHASES;
    void* kargs[] = {&a};
    hipError_t e = hipLaunchCooperativeKernel((const void*)fwd_kernel, dim3(grid), dim3(NTHR), kargs, LDS_BYTES, stream);
    if (e != hipSuccess) fprintf(stderr, "kernel_launch: cooperative launch failed: %s (grid %d)\n", hipGetErrorString(e), grid);
#endif
}
```

```cpp
#include <hip/hip_runtime.h>
#include <hip/hip_cooperative_groups.h>
#include <cstdio>
#include <cstdint>
namespace cg = cooperative_groups;

#ifndef MK_TIME_PHASE
#define MK_TIME_PHASE (-1)
#endif
#ifndef MK_PER_PHASE
#define MK_PER_PHASE 0
#endif

namespace pg8 {
#define PG8_LAS __attribute__((address_space(3)))
typedef unsigned short bf16_t;
typedef short bf16x8 __attribute__((ext_vector_type(8)));
typedef float f32x4 __attribute__((ext_vector_type(4)));
typedef unsigned u32x4 __attribute__((ext_vector_type(4)));
constexpr int BM = 256, BK = 64, HALF = 128, HTB = HALF * BK * 2  , STAGE_BYTES = 8 * HTB, NXCD = 8, WGM = 8;

__host__ __device__ __forceinline__ int lds_byte(int r, int c) { const int st = (r >> 4) * 2 + (c >> 5), rr = r & 15, cc = c & 31, ob = rr * 64 + cc * 2; return st * 1024 + (ob ^ (((ob >> 9) & 1) << 5)); }
__host__ __device__ __forceinline__ void stage_rc(int b, int& R, int& C) { const int st = b / 1024, sb = b % 1024, swz = sb ^ (((sb >> 9) & 1) << 5); R = (st >> 1) * 16 + swz / 64; C = (st & 1) * 32 + (swz % 64) / 2; }
__host__ __device__ __forceinline__ int perm32(int rho) { const int n = rho >> 4, i = rho & 15; return 8 * (i >> 2) + 4 * n + (i & 3); }

struct Unit { int pm, pn, k0, nk, slice, nsl, tix; };
struct Gemm { const bf16_t* A; const bf16_t* Bt; int M, N, K; };

struct StaticOrder {
    int nM, nN, nwg, G, c, rounds, rem, S, ntK, nSp;
    __host__ __device__ __forceinline__ void init(int M, int N, int K, int G_, int c_, int Smax, int nSp_ = 0) { nM = M / BM; nN = N / BM; nwg = nM * nN; G = G_; c = c_; ntK = K / BK; rounds = nwg / G; rem = nwg - rounds * G; S = 1; nSp = nSp_;
        if (rem) { while (S < Smax && rem * (S * 2) <= G && (ntK / 2) >= S * 2) S *= 2; } }
    __host__ __device__ __forceinline__ void tile(int L, Unit& u) const {
        const int nfirst = nSp * nN;
        if (L < nfirst) { u.pm = nM - nSp + (L % nSp); u.pn = L / nSp; return; }
        const int nMp = nM - nSp, nwp = nMp * nN;
        int wgid = L - nfirst; { const int q = nwp / NXCD, r = nwp % NXCD, xcd = wgid % NXCD, off = wgid / NXCD; wgid = (xcd < r ? xcd * (q + 1) : r * (q + 1) + (xcd - r) * q) + off; }
        const int nig = WGM * nN, gid = wgid / nig, fm = gid * WGM, gsz = (nMp - fm) < WGM ? (nMp - fm) : WGM;
        u.pm = fm + ((wgid % nig) % gsz); u.pn = (wgid % nig) / gsz; }
    __host__ __device__ __forceinline__ bool next(int i, Unit& u) const {
        if (i < rounds) { tile(i * G + c, u); u.k0 = 0; u.nk = ntK; u.slice = 0; u.nsl = 1; u.tix = 0; return true; }
        if (i == rounds && c < rem * S) { const int tix = c % rem, sl = c / rem; tile(rounds * G + tix, u);
            const int pairs = ntK / 2, base = pairs / S, extra = pairs % S, np = base + (sl < extra ? 1 : 0), p0 = sl * base + (sl < extra ? sl : extra);
            u.k0 = 2 * p0; u.nk = 2 * np; u.slice = sl; u.nsl = S; u.tix = tix; return true; }
        return false;
    }
    __device__ __forceinline__ void a_ready(const Unit&) const {}
    __device__ __forceinline__ void done(const Unit&) const {}
};
__device__ __forceinline__ unsigned cvt_pk_bf16(float lo, float hi) { unsigned r; asm volatile("v_cvt_pk_bf16_f32 %0, %1, %2" : "=v"(r) : "v"(lo), "v"(hi)); return r; }
struct SplitCtx { f32x4* slabs; unsigned* cnt; volatile PG8_LAS unsigned* flag; int id; };
__device__ __forceinline__ int split_reduce(f32x4 (&acc)[2][2][4][2], const Unit& u, const SplitCtx& X, int tid) {
    const __amdgpu_buffer_rsrc_t rs = __builtin_amdgcn_make_buffer_rsrc((void*)X.slabs, (short)0, (int)0x7fffffff, 0x00020000);
    typedef unsigned u32x2s __attribute__((ext_vector_type(2)));
    const unsigned mine = (unsigned)((u.tix * u.nsl + u.slice) * 32) * 4096u + (unsigned)tid * 8u;
#pragma unroll
    for (int a = 0; a < 2; ++a)
#pragma unroll
        for (int b = 0; b < 2; ++b)
#pragma unroll
            for (int m = 0; m < 4; ++m)
#pragma unroll
                for (int n = 0; n < 2; ++n) { const f32x4 v = acc[a][b][m][n]; __builtin_amdgcn_raw_buffer_store_b64((u32x2s){cvt_pk_bf16(v.x, v.y), cvt_pk_bf16(v.z, v.w)}, rs, mine + (unsigned)((((a * 2 + b) * 4 + m) * 2 + n) * 4096), 0,   16); }
    asm volatile("s_waitcnt vmcnt(0)" ::: "memory");
    __syncthreads();
    if (tid == 0) {
        unsigned* c = X.cnt + 16 * u.tix;
        (void)__hip_atomic_fetch_add(c, 1u, __ATOMIC_RELAXED, __HIP_MEMORY_SCOPE_AGENT);
        unsigned spins = 0;
        while (__hip_atomic_load(c, __ATOMIC_RELAXED, __HIP_MEMORY_SCOPE_AGENT) < (unsigned)u.nsl) { __builtin_amdgcn_s_sleep(2); if (++spins > (1u << 22)) break; }
        __builtin_amdgcn_fence(__ATOMIC_ACQUIRE, "agent");
        asm volatile("s_waitcnt vmcnt(0)" ::: "memory");
    }
    __syncthreads();
    const int shift = u.nsl == 8 ? 2 : (u.nsl == 4 ? 3 : 4);
    for (int s = 0; s < u.nsl; ++s) { if (s == u.slice) continue;
        const u32x2s* o = (const u32x2s*)X.slabs + ((size_t)(u.tix * u.nsl + s) * 32) * 512 + tid;
#pragma unroll
        for (int a = 0; a < 2; ++a)
#pragma unroll
            for (int b = 0; b < 2; ++b)
#pragma unroll
                for (int m = 0; m < 4; ++m)
#pragma unroll
                    for (int n = 0; n < 2; ++n) { const int r4 = ((a * 2 + b) * 4 + m) * 2 + n; if ((r4 >> shift) == u.slice) { const u32x2s p = o[(size_t)r4 * 512]; acc[a][b][m][n] += (f32x4){__builtin_bit_cast(float, p.x << 16), __builtin_bit_cast(float, p.x & 0xffff0000u), __builtin_bit_cast(float, p.y << 16), __builtin_bit_cast(float, p.y & 0xffff0000u)}; } } }
    return shift;
}


struct EpiF32 {
    static constexpr bool PERM = false, AFTER_DRAIN = false;
    float* C; int ldc;
    __device__ __forceinline__ void operator()(const f32x4 (&acc)[2][2][4][2], const Unit& u, int wr, int wc, int fr, int fq, int shift, int part) const {
        const int row0 = u.pm * BM + wr * 64 + fr, col0 = u.pn * BM + wc * 32 + 4 * fq;
#pragma unroll
        for (int ai = 0; ai < 2; ++ai)
#pragma unroll
            for (int m = 0; m < 4; ++m) { float* rowp = C + (size_t)(row0 + ai * HALF + m * 16) * ldc + col0;
#pragma unroll
                for (int bj = 0; bj < 2; ++bj)
#pragma unroll
                    for (int n = 0; n < 2; ++n) if ((((((ai * 2 + bj) * 4 + m) * 2 + n)) >> shift) == part) *(f32x4*)(rowp + bj * HALF + n * 16) = acc[ai][bj][m][n]; }
    }
};
struct EpiBf16 {
    static constexpr bool PERM = true, AFTER_DRAIN = false;
    bf16_t* O; int ldc; int nfull; float* X;
    __device__ __forceinline__ void operator()(const f32x4 (&acc)[2][2][4][2], const Unit& u, int wr, int wc, int fr, int fq, int shift, int part) const {
        const int row0 = u.pm * BM + wr * 64 + fr;
        if (u.pn < nfull) {
            const int col0 = u.pn * BM + wc * 32 + 8 * fq;
#pragma unroll
            for (int ai = 0; ai < 2; ++ai)
#pragma unroll
                for (int m = 0; m < 4; ++m) { bf16_t* rowp = O + (size_t)(row0 + ai * HALF + m * 16) * ldc + col0;
#pragma unroll
                    for (int bj = 0; bj < 2; ++bj) { if ((((((ai * 2 + bj) * 4 + m) * 2)) >> shift) != part) continue; const f32x4 v0 = acc[ai][bj][m][0], v1 = acc[ai][bj][m][1];
                        u32x4 w; w.x = cvt_pk_bf16(v0[0], v0[1]); w.y = cvt_pk_bf16(v0[2], v0[3]); w.z = cvt_pk_bf16(v1[0], v1[1]); w.w = cvt_pk_bf16(v1[2], v1[3]);
                        *(u32x4*)(rowp + bj * HALF) = w; } }
        } else if (wc == 0) {
#pragma unroll
            for (int ai = 0; ai < 2; ++ai)
#pragma unroll
                for (int m = 0; m < 4; ++m) { if ((((((ai * 2) * 4 + m) * 2)) >> shift) != part) continue; float* rowp = X + (size_t)(row0 + ai * HALF + m * 16) * 32 + 8 * fq;
                    *(f32x4*)(rowp) = acc[ai][0][m][0]; *(f32x4*)(rowp + 4) = acc[ai][0][m][1]; }
        }
    }
};

__device__ __forceinline__ float dpp_ror1(float x) { return __builtin_bit_cast(float, __builtin_amdgcn_update_dpp(0, __builtin_bit_cast(int, x), 0x121, 0xF, 0xF, false)); }
__device__ __forceinline__ float dpp_ror2(float x) { return __builtin_bit_cast(float, __builtin_amdgcn_update_dpp(0, __builtin_bit_cast(int, x), 0x122, 0xF, 0xF, false)); }
struct EpiConvAct {
    static constexpr bool PERM = true, AFTER_DRAIN = false;
    static constexpr int FFD = 5632, FFD2 = 11264, MPR = 8192, NPT = 32;
    bf16_t* ACT; float* HG; const float* cw; const float* cbias; const float* st; float* fconv_s; PG8_LAS float* halo;
    __device__ __forceinline__ void operator()(const f32x4 (&acc)[2][2][4][2], const Unit& u, int wr, int wc, int fr, int fq, int, int) const {
        if (u.pm >= NPT) body<true>(acc, u, wr, wc, fr, fq); else body<false>(acc, u, wr, wc, fr, fq); }
    template <bool sample> __device__ __forceinline__ void body(const f32x4 (&acc)[2][2][4][2], const Unit& u, int wr, int wc, int fr, int fq) const {
        const int pm = u.pm, pn = u.pn, cl = wc * 32 + 8 * fq, c0 = pn * 128 + cl;
        if (fr >= 14) {
#pragma unroll
            for (int ai = 0; ai < 2; ++ai)
#pragma unroll
                for (int bj = 0; bj < 2; ++bj)
#pragma unroll
                    for (int n = 0; n < 2; ++n) *(PG8_LAS f32x4*)(halo + ((ai * 2 + wr) * 2 + (fr - 14)) * 256 + bj * 128 + cl + 4 * n) = acc[ai][bj][3][n];
            if (!sample && wr == 1) {
#pragma unroll
                for (int bj = 0; bj < 2; ++bj)
#pragma unroll
                    for (int n = 0; n < 2; ++n) *(f32x4*)(HG + ((size_t)pm * 4 + 2 + (fr - 14)) * FFD2 + bj * FFD + c0 + 4 * n) = acc[1][bj][3][n]; }
        }
        if (fr < 2 && !sample && wr == 0) {
#pragma unroll
            for (int bj = 0; bj < 2; ++bj)
#pragma unroll
                for (int n = 0; n < 2; ++n) *(f32x4*)(HG + ((size_t)pm * 4 + fr) * FFD2 + bj * FFD + c0 + 4 * n) = acc[0][bj][0][n]; }
        __syncthreads();
        const int t8 = fr & 7;
        typedef unsigned u32x2 __attribute__((ext_vector_type(2)));
        u32x2 pk0[2][4];
#pragma unroll
        for (int n = 0; n < 2; ++n) {
            f32x4 w[2][3], bs[2];
#pragma unroll
            for (int bj = 0; bj < 2; ++bj) { bs[bj] = *(const f32x4*)(cbias + bj * FFD + c0 + 4 * n);
#pragma unroll
                for (int j = 0; j < 3; ++j) w[bj][j] = *(const f32x4*)(cw + j * FFD2 + bj * FFD + c0 + 4 * n); }
#pragma unroll
            for (int ai = 0; ai < 2; ++ai) {
                f32x4 r1p[2], r2p[2];
#pragma unroll
                for (int bj = 0; bj < 2; ++bj) { f32x4 pv = (f32x4){0.f, 0.f, 0.f, 0.f};
                    if (fr >= 14 && (wr == 1 || ai == 1)) { const int pa = (wr == 1) ? ai : 0, pw = (wr == 1) ? 0 : 1; pv = *(const PG8_LAS f32x4*)(halo + ((pa * 2 + pw) * 2 + (fr - 14)) * 256 + bj * 128 + cl + 4 * n); }
#pragma unroll
                    for (int j = 0; j < 4; ++j) { r1p[bj][j] = dpp_ror1(pv[j]); r2p[bj][j] = dpp_ror2(pv[j]); } }
#pragma unroll
                for (int m = 0; m < 4; ++m) { const int row = pm * BM + ai * HALF + wr * 64 + m * 16 + fr;
                    f32x4 o[2];
#pragma unroll
                    for (int bj = 0; bj < 2; ++bj) { const f32x4 cur = acc[ai][bj][m][n]; f32x4 p1, p2;
#pragma unroll
                        for (int j = 0; j < 4; ++j) { const float c1 = dpp_ror1(cur[j]), c2 = dpp_ror2(cur[j]); p1[j] = (fr == 0) ? r1p[bj][j] : c1; p2[j] = (fr < 2) ? r2p[bj][j] : c2; r1p[bj][j] = c1; r2p[bj][j] = c2; }
                        if (sample && t8 < 2) { const int sb = (row - MPR) >> 3; const f32x4 s1 = *(const f32x4*)(st + ((size_t)sb * 2 + 1) * FFD2 + bj * FFD + c0 + 4 * n);
                            if (t8 == 0) { p1 = s1; p2 = *(const f32x4*)(st + ((size_t)sb * 2) * FFD2 + bj * FFD + c0 + 4 * n); } else p2 = s1; }
                        o[bj] = bs[bj] + w[bj][0] * p2 + w[bj][1] * p1 + w[bj][2] * cur; }
                    f32x4 g; g.x = o[0].x * __builtin_amdgcn_rcpf(1.f + __expf(-o[0].x)) * o[1].x; g.y = o[0].y * __builtin_amdgcn_rcpf(1.f + __expf(-o[0].y)) * o[1].y;
                    g.z = o[0].z * __builtin_amdgcn_rcpf(1.f + __expf(-o[0].z)) * o[1].z; g.w = o[0].w * __builtin_amdgcn_rcpf(1.f + __expf(-o[0].w)) * o[1].w;
                    const u32x2 pk = (u32x2){cvt_pk_bf16(g.x, g.y), cvt_pk_bf16(g.z, g.w)};
                    if (n == 0) pk0[ai][m] = pk;
                    else *(u32x4*)(ACT + (size_t)row * FFD + c0) = (u32x4){pk0[ai][m].x, pk0[ai][m].y, pk.x, pk.y};
                    if (sample && t8 >= 6) { const int sb = (row - MPR) >> 3;
#pragma unroll
                        for (int bj = 0; bj < 2; ++bj) *(f32x4*)(fconv_s + ((size_t)sb * 2 + (t8 - 6)) * FFD2 + bj * FFD + c0 + 4 * n) = acc[ai][bj][m][n]; }
                }
            }
        }
    }
};

template <class Epi, class Sched, bool ALIGN_EPI = false, bool SP2 = false>
__device__ __forceinline__ void gemm_phase(PG8_LAS unsigned char* lds, const Gemm g, const Sched& S, const Epi& E, const SplitCtx& X) {
    const int tid = threadIdx.x, wid = __builtin_amdgcn_readfirstlane(tid >> 6), lane = tid & 63, wr = wid >> 2, wc = wid & 3, fr = lane & 15, fq = lane >> 4;
    const int K = g.K;
    unsigned voffA[2], voffB[2];
#pragma unroll
    for (int i = 0; i < 2; ++i) { int R, C; stage_rc(tid * 16 + i * 8192, R, C); const int Rb = Epi::PERM ? ((R & ~31) + perm32(R & 31)) : R;
        voffA[i] = (unsigned)(R * K + C) * 2u; voffB[i] = (unsigned)(Rb * K + C) * 2u; }
    const size_t kstep = (size_t)(BK * 2);
    const size_t hstep = (size_t)HALF * K * 2;
    const size_t tstep = 2 * hstep;
    const unsigned ldsw = (unsigned)wid * 1024u;
    const int aoff = lds_byte(wr * 64 + fr, fq * 8), boff = lds_byte(wc * 32 + fr, fq * 8);
#define PG8_SA(b, h) (((b) * 2 + (h)) * HTB)
#define PG8_SB(b, h) ((4 + (b) * 2 + (h)) * HTB)
#define PG8_STAGE(bufoff, gbase, voff) do { _Pragma("unroll") for (int _i = 0; _i < 2; ++_i) \
        __builtin_amdgcn_global_load_lds((const unsigned*)((const char*)(gbase) + (voff)[_i]), (PG8_LAS unsigned*)(lds + (bufoff) + ldsw + _i * 8192), 16, 0, 0); } while (0)
#define PG8_LDA(dst, b, h) do { _Pragma("unroll") for (int m = 0; m < 4; ++m) _Pragma("unroll") for (int k = 0; k < 2; ++k) dst[m][k] = *(const PG8_LAS bf16x8*)(lds + PG8_SA(b, h) + aoff + m * 2048 + k * 1024); } while (0)
#define PG8_LDB(dst, b, h) do { _Pragma("unroll") for (int n = 0; n < 2; ++n) _Pragma("unroll") for (int k = 0; k < 2; ++k) dst[n][k] = *(const PG8_LAS bf16x8*)(lds + PG8_SB(b, h) + boff + n * 2048 + k * 1024); } while (0)
#define PG8_MMA(ai, bj, At, Bt) do { __builtin_amdgcn_s_setprio(1); _Pragma("unroll") for (int m = 0; m < 4; ++m) _Pragma("unroll") for (int n = 0; n < 2; ++n) _Pragma("unroll") for (int k = 0; k < 2; ++k) \
        acc[ai][bj][m][n] = __builtin_amdgcn_mfma_f32_16x16x32_bf16(Bt[n][k], At[m][k], acc[ai][bj][m][n], 0, 0, 0); __builtin_amdgcn_s_setprio(0); } while (0)
#define PG8_WAIT_V(n) asm volatile("s_waitcnt vmcnt(" #n ")" ::: "memory")
#define PG8_WAIT_L(n) asm volatile("s_waitcnt lgkmcnt(" #n ")" ::: "memory")
#define PG8_BAR __builtin_amdgcn_s_barrier()
#define PG8_SCHED __builtin_amdgcn_sched_barrier(0)
    Unit cur, nxt; int ui = 0;
    if (!S.next(0, cur)) return;
    f32x4 acc[2][2][4][2];
#pragma unroll
    for (int a = 0; a < 2; ++a)
#pragma unroll
        for (int b = 0; b < 2; ++b)
#pragma unroll
            for (int m = 0; m < 4; ++m)
#pragma unroll
                for (int n = 0; n < 2; ++n) acc[a][b][m][n] = (f32x4){0.f, 0.f, 0.f, 0.f};
    bf16x8 At[4][2], B0[2][2], B1[2][2];
    const char* cA = (const char*)g.A + (size_t)cur.pm * tstep + (size_t)cur.k0 * kstep; const char* cB = (const char*)g.Bt + (size_t)cur.pn * tstep + (size_t)cur.k0 * kstep;
    S.a_ready(cur);
    if constexpr (SP2) {
        PG8_STAGE(PG8_SB(0, 0), cB, voffB); PG8_STAGE(PG8_SB(0, 1), cB + hstep, voffB); PG8_STAGE(PG8_SA(0, 0), cA, voffA); PG8_STAGE(PG8_SA(0, 1), cA + hstep, voffA);
        if (wr == 1) PG8_BAR;
        PG8_WAIT_V(2); PG8_BAR;
        PG8_STAGE(PG8_SB(1, 0), cB + kstep, voffB); PG8_STAGE(PG8_SA(1, 0), cA + kstep, voffA); PG8_STAGE(PG8_SB(1, 1), cB + hstep + kstep, voffB);
        PG8_WAIT_V(6); PG8_BAR;
    } else {
        PG8_STAGE(PG8_SB(0, 0), cB, voffB); PG8_STAGE(PG8_SA(0, 0), cA, voffA); PG8_STAGE(PG8_SB(0, 1), cB + hstep, voffB); PG8_STAGE(PG8_SA(0, 1), cA + hstep, voffA);
        if (wr == 1) PG8_BAR;
        PG8_WAIT_V(4); PG8_BAR;
        PG8_STAGE(PG8_SB(1, 0), cB + kstep, voffB); PG8_STAGE(PG8_SA(1, 0), cA + kstep, voffA); PG8_STAGE(PG8_SB(1, 1), cB + hstep + kstep, voffB);
        PG8_WAIT_V(6); PG8_BAR;
    }
    for (;;) {
        const bool has_next = S.next(ui + 1, nxt);
        const char* nA = has_next ? (const char*)g.A + (size_t)nxt.pm * tstep + (size_t)nxt.k0 * kstep : cA; const char* nB = has_next ? (const char*)g.Bt + (size_t)nxt.pn * tstep + (size_t)nxt.k0 * kstep : cB;
        const int nt = cur.nk;
        unsigned long long tsu = 0; if (MK_TIME_PHASE == 50 + X.id && cur.nsl > 1) tsu = __builtin_amdgcn_s_memrealtime();
        for (int t = 0; t < nt; t += 2) {
            const bool last = (t == nt - 2);
            const char* a1 = cA + (size_t)(t + 1) * kstep;
            const char* a2 = last ? nA : cA + (size_t)(t + 2) * kstep; const char* b2 = last ? nB : cB + (size_t)(t + 2) * kstep;
            const char* a3 = a2 + kstep; const char* b3 = b2 + kstep;
            if (last && has_next) S.a_ready(nxt);
            if constexpr (SP2) {
            PG8_LDB(B0, 0, 0); PG8_LDB(B1, 0, 1); PG8_SCHED; PG8_LDA(At, 0, 0); PG8_STAGE(PG8_SA(1, 1), a1 + hstep, voffA);
            PG8_WAIT_V(8); PG8_WAIT_L(0); PG8_BAR; PG8_MMA(0, 0, At, B0); PG8_MMA(0, 1, At, B1); PG8_BAR; PG8_SCHED;
            PG8_LDA(At, 0, 1); PG8_STAGE(PG8_SB(0, 0), b2, voffB); PG8_STAGE(PG8_SB(0, 1), b2 + hstep, voffB); PG8_STAGE(PG8_SA(0, 0), a2, voffA);
            PG8_WAIT_V(8); PG8_WAIT_L(0); PG8_BAR; PG8_MMA(1, 0, At, B0); PG8_MMA(1, 1, At, B1); PG8_BAR; PG8_SCHED;
            PG8_LDB(B0, 1, 0); PG8_LDB(B1, 1, 1); PG8_SCHED; PG8_LDA(At, 1, 0); PG8_STAGE(PG8_SA(0, 1), a2 + hstep, voffA);
            PG8_WAIT_V(8); PG8_WAIT_L(0); PG8_BAR; PG8_MMA(0, 0, At, B0); PG8_MMA(0, 1, At, B1); PG8_BAR; PG8_SCHED;
            PG8_LDA(At, 1, 1); PG8_STAGE(PG8_SB(1, 0), b3, voffB); PG8_STAGE(PG8_SB(1, 1), b3 + hstep, voffB); PG8_STAGE(PG8_SA(1, 0), a3, voffA);
            PG8_WAIT_V(8); PG8_WAIT_L(0); PG8_BAR; PG8_MMA(1, 0, At, B0); PG8_MMA(1, 1, At, B1); PG8_BAR; PG8_SCHED;
            } else {
            PG8_LDB(B0, 0, 0); PG8_SCHED; PG8_LDA(At, 0, 0); PG8_STAGE(PG8_SA(1, 1), a1 + hstep, voffA);
            PG8_WAIT_L(8); PG8_BAR; PG8_WAIT_L(0); PG8_MMA(0, 0, At, B0); PG8_BAR; PG8_SCHED;
            PG8_LDB(B1, 0, 1); PG8_STAGE(PG8_SB(0, 0), b2, voffB);
            PG8_BAR; PG8_WAIT_L(0); PG8_MMA(0, 1, At, B1); PG8_BAR;
            PG8_LDA(At, 0, 1); PG8_STAGE(PG8_SA(0, 0), a2, voffA);
            PG8_BAR; PG8_WAIT_L(0); PG8_MMA(1, 0, At, B0); PG8_BAR; PG8_SCHED;
            PG8_STAGE(PG8_SB(0, 1), b2 + hstep, voffB);
            PG8_WAIT_V(6); PG8_BAR; PG8_MMA(1, 1, At, B1); PG8_BAR;
            PG8_LDB(B0, 1, 0); PG8_SCHED; PG8_LDA(At, 1, 0); PG8_STAGE(PG8_SA(0, 1), a2 + hstep, voffA);
            PG8_WAIT_L(8); PG8_BAR; PG8_WAIT_L(0); PG8_MMA(0, 0, At, B0); PG8_BAR; PG8_SCHED;
            PG8_LDB(B1, 1, 1); PG8_STAGE(PG8_SB(1, 0), b3, voffB);
            PG8_BAR; PG8_WAIT_L(0); PG8_MMA(0, 1, At, B1); PG8_BAR;
            PG8_LDA(At, 1, 1); PG8_STAGE(PG8_SA(1, 0), a3, voffA);
            PG8_BAR; PG8_WAIT_L(0); PG8_MMA(1, 0, At, B0); PG8_BAR; PG8_SCHED;
            PG8_STAGE(PG8_SB(1, 1), b3 + hstep, voffB);
            PG8_WAIT_V(6); PG8_BAR; PG8_MMA(1, 1, At, B1); PG8_BAR;
            }
        }
        if constexpr (ALIGN_EPI) { if (wr == 0) PG8_BAR; }
        if constexpr (!Epi::AFTER_DRAIN) { static_assert(ALIGN_EPI, "split_reduce needs the halves aligned"); if (cur.nsl > 1) { const int shift = split_reduce(acc, cur, X, tid); E(acc, cur, wr, wc, fr, fq, shift, cur.slice); } else { unsigned long long te0 = 0; if (MK_TIME_PHASE == 60 + X.id) te0 = __builtin_amdgcn_s_memrealtime(); E(acc, cur, wr, wc, fr, fq, 5, 0); if (MK_TIME_PHASE == 60 + X.id && tid == 0) { asm volatile("s_waitcnt vmcnt(0)" ::: "memory"); X.flag[2] += (unsigned)(__builtin_amdgcn_s_memrealtime() - te0); } } S.done(cur);
            if (MK_TIME_PHASE == 50 + X.id && cur.nsl > 1 && tid == 0) { asm volatile("s_waitcnt vmcnt(0)" ::: "memory"); const unsigned long long d = __builtin_amdgcn_s_memrealtime() - tsu; X.flag[2] = (unsigned)d; } }
        if (!has_next) break;
#pragma unroll
        for (int a = 0; a < 2; ++a)
#pragma unroll
            for (int b = 0; b < 2; ++b)
#pragma unroll
                for (int m = 0; m < 4; ++m)
#pragma unroll
                    for (int n = 0; n < 2; ++n) acc[a][b][m][n] = (f32x4){0.f, 0.f, 0.f, 0.f};
        cur = nxt; cA = nA; cB = nB; ++ui;
        if constexpr (ALIGN_EPI) { if (wr == 1) PG8_BAR; }
    }
    PG8_WAIT_V(0);
    if constexpr (!ALIGN_EPI) { if (wr == 0) PG8_BAR; }
    PG8_BAR;
    if constexpr (Epi::AFTER_DRAIN) { E.fused(acc, cur, wr, wc, fr, fq, lds, wid, lane); S.done(cur); }
#undef PG8_SA
#undef PG8_SB
#undef PG8_STAGE
#undef PG8_LDA
#undef PG8_LDB
#undef PG8_MMA
#undef PG8_WAIT_V
#undef PG8_WAIT_L
#undef PG8_BAR
#undef PG8_SCHED
}
}

constexpr int NWAVES = 8, NTHR = 512;
constexpr int DM = 2048, PB = 4, PL = 2048, SB = 128, SL = 8;
constexpr int MP = PB * PL, MS = SB * SL, M = MP + MS;
constexpr int GH = 4, GK = 128, GV = 256, GKD = 512, LOWR = 16;
constexpr int SH = 16, SP = 64, SN = 128, SG = 2, SCH = 1536;
constexpr int FF = 5632, FF2 = 11264, INC = 5664;
constexpr int N1 = 5888, NP = 5632;
constexpr int CQ = 0, CK = 512, CV = 1024, CG = 2048, CZ = 3072, CX = 4096;
constexpr float EPS = 1e-6f;
constexpr int N_PHASES = 11;

constexpr size_t O_Y = 0, O_GLA_P = (size_t)M * DM, O_SSD_P = O_GLA_P + (size_t)PB * GH * GK * GV, O_SCONV_P = O_SSD_P + (size_t)PB * SH * SP * SN,
                 O_FCONV_P = O_SCONV_P + (size_t)PB * 3 * SCH, O_GLA_S = O_FCONV_P + (size_t)PB * 2 * FF2, O_SSD_S = O_GLA_S + (size_t)SB * GH * GK * GV,
                 O_SCONV_S = O_SSD_S + (size_t)SB * SH * SP * SN, O_FCONV_S = O_SCONV_S + (size_t)SB * 3 * SCH, O_END = O_FCONV_S + (size_t)SB * 2 * FF2;

constexpr size_t MiB = 1u << 20;
constexpr size_t WS_CTL = 0, CTL_ZERO_BYTES = 64 * 1024;
constexpr size_t WS_WF2 = 1 * MiB;
constexpr size_t WS_W1 = 24 * MiB;
constexpr size_t WS_WO = 48 * MiB;
constexpr size_t WS_WF1 = 56 * MiB;
constexpr size_t WS_XN = 101 * MiB;
constexpr size_t WS_F = 24 * MiB;
constexpr size_t WS_BIG = 141 * MiB;
constexpr size_t WS_PROJ = WS_BIG;
constexpr size_t WS_MIX = WS_BIG;
constexpr size_t WS_ACT = WS_BIG;
constexpr size_t WS_HG = WS_BIG + 104 * MiB;
constexpr size_t WS_LRDT = WS_BIG + 100 * MiB;
constexpr size_t WS_MIXIN = WS_BIG + 104 * MiB;
constexpr size_t WS_DS = WS_XN;
constexpr size_t WS_SC = WS_BIG + 140 * MiB, WS_DH = WS_BIG + 172 * MiB, WS_HC = WS_BIG + 204 * MiB;
constexpr size_t WS_EBL = WS_BIG + 236 * MiB, WS_AL = WS_EBL + 512 * 1024;
constexpr size_t WS_SLAB = WS_BIG + 140 * MiB;
constexpr size_t WS_SLAB_F1 = WS_BIG + 198 * MiB;
constexpr size_t WS_QEG = WS_BIG + 238 * MiB, WS_KEG = WS_BIG + 246 * MiB;
constexpr size_t WS_END = WS_BIG + 254 * MiB;
static_assert(WS_WF2 + (size_t)DM * FF * 2 <= WS_W1 && WS_W1 + (size_t)N1 * DM * 2 <= WS_WO && WS_WO + (size_t)DM * DM * 2 <= WS_WF1 && WS_WF1 + (size_t)FF2 * DM * 2 <= WS_XN && WS_XN + (size_t)M * DM * 2 <= WS_BIG, "ws map 1");
static_assert(WS_F + (size_t)M * DM * 4 <= WS_XN && WS_ACT + (size_t)M * FF * 2 <= WS_HG && WS_PROJ + (size_t)M * NP * 2 <= WS_LRDT && WS_LRDT + (size_t)M * 32 * 4 <= WS_MIXIN && WS_MIXIN + (size_t)M * DM * 2 <= WS_SC && WS_HG + (size_t)32 * 4 * FF2 * 4 <= WS_SC && WS_MIX + (size_t)M * DM * 4 <= WS_LRDT, "ws map 2");
constexpr int CW_BAR = 1024;
constexpr int CW_SPLIT = 8192;

constexpr int RING_BYTES = 131072;
constexpr int SCRATCH_BYTES = 8 * 16640;
constexpr int LDSCTL_OFF = 133632, MISC_OFF = LDSCTL_OFF + 320;
constexpr int LDS_BYTES = 150016;

#ifndef MK_TIME_PHASE
#define MK_TIME_PHASE (-1)
#endif
#define TBEGIN(F, id) do { if (MK_TIME_PHASE == (id)) (F).tmark = __builtin_amdgcn_s_memrealtime(); } while (0)
#define TEND(F, id) do { if (MK_TIME_PHASE == (id)) (F).tacc += __builtin_amdgcn_s_memrealtime() - (F).tmark; } while (0)
#define GAS __attribute__((address_space(1)))
#define LAS __attribute__((address_space(3)))
typedef unsigned short bf16;
typedef unsigned v4u __attribute__((ext_vector_type(4)));
typedef unsigned v2u __attribute__((ext_vector_type(2)));
typedef float f32x4 __attribute__((ext_vector_type(4)));
#define LDS_WAIT() asm volatile("s_waitcnt lgkmcnt(0)" ::: "memory")
#define VM_WAIT() asm volatile("s_waitcnt vmcnt(0)" ::: "memory")
typedef float f32x2c __attribute__((ext_vector_type(2)));
typedef __bf16 bf16x2c __attribute__((ext_vector_type(2)));
__device__ __forceinline__ unsigned f2bf(float f) { return (unsigned)__builtin_bit_cast(unsigned short, (__bf16)f); }
__device__ __forceinline__ unsigned pk2(float lo, float hi) { return __builtin_bit_cast(unsigned, __builtin_convertvector((f32x2c){lo, hi}, bf16x2c)); }
__device__ __forceinline__ float bf2f(unsigned short b) { return __builtin_bit_cast(float, (unsigned)b << 16); }
__device__ __forceinline__ float bflo(unsigned w) { return __builtin_bit_cast(float, w << 16); }
__device__ __forceinline__ float bfhi(unsigned w) { return __builtin_bit_cast(float, w & 0xffff0000u); }
__device__ __forceinline__ float silu_f(float x) { return x * __builtin_amdgcn_rcpf(1.f + __expf(-x)); }
__device__ __forceinline__ float softplus_f(float x) { return fmaxf(x, 0.f) + __logf(1.f + __expf(-fabsf(x))); }
__device__ __forceinline__ float logsigmoid_f(float x) { return fminf(x, 0.f) - __logf(1.f + __expf(-fabsf(x))); }
__device__ __forceinline__ float wave_sum(float v) {
#pragma unroll
    for (int o = 1; o < 64; o <<= 1) v += __shfl_xor(v, o);
    return v;
}

#define XB_TMO      128
#define XB_XCNT(j)  (256  + 64 * (j))
#define XB_XSUB(j)  (1280 + 64 * (j))
#define XB_XGEN(j)  (2304 + 64 * (j))
#define XB_TOP      3328
#define XB_TOPGEN   3392
#define XCD_BAR_WORDS 3456
#define XB_SPIN_CAP (1u << 18)

__device__ __forceinline__ unsigned xb_ld(unsigned* p)              { return __hip_atomic_load(p, __ATOMIC_RELAXED, __HIP_MEMORY_SCOPE_AGENT); }
__device__ __forceinline__ unsigned xb_add(unsigned* p, unsigned v) { return __hip_atomic_fetch_add(p, v, __ATOMIC_RELAXED, __HIP_MEMORY_SCOPE_AGENT); }
__device__ __forceinline__ unsigned xb_xcc_id() { return (unsigned)__builtin_amdgcn_s_getreg((3 << 11) | 20) & 0xFu; }
#define XB_SPIN(cond, bar) do { unsigned _sp = 0; while (cond) { __builtin_amdgcn_s_sleep(1); \
    if ((++_sp & 255u) == 0u) { if (xb_ld(&(bar)[XB_TMO])) break; if (_sp > XB_SPIN_CAP) { atomicAdd(&(bar)[XB_TMO], 1u); break; } } } } while (0)

struct XcdBarrier {
    unsigned* bar; unsigned x;
    volatile LAS unsigned* st;
};

__device__ __forceinline__ XcdBarrier xcd_barrier_post(unsigned* bar, volatile LAS unsigned* st) {
    XcdBarrier b; b.bar = bar; b.x = xb_xcc_id(); b.st = st;
    if (threadIdx.x == 0) (void)xb_add(&bar[XB_XCNT(b.x)], 1u);
    return b;
}
__device__ __forceinline__ void xcd_barrier_complete(unsigned* bar, unsigned x, unsigned& nloc, unsigned& nx) {
    const unsigned G = gridDim.x * gridDim.y * gridDim.z;
    unsigned sum, cnt, mine, sp = 0u;
    for (;;) {
        sum = 0u; cnt = 0u; mine = 0u;
#pragma unroll
        for (unsigned j = 0; j < 16; ++j) { const unsigned c = xb_ld(&bar[XB_XCNT(j)]); sum += c; cnt += (c > 0u) ? 1u : 0u; mine = (j == x) ? c : mine; }
        if (sum == G) break;
        __builtin_amdgcn_s_sleep(1);
        if ((++sp & 255u) == 0u) { if (xb_ld(&bar[XB_TMO])) break; if (sp > XB_SPIN_CAP) { atomicAdd(&bar[XB_TMO], 1u); break; } }
    }
    nloc = mine > 0u ? mine : 1u; nx = cnt > 0u ? cnt : 1u;
}

__device__ __forceinline__ void xcd_barrier(const XcdBarrier& b) {
    asm volatile("s_waitcnt vmcnt(0)" ::: "memory");
    __syncthreads();
    if (threadIdx.x == 0) {
        unsigned* bar = b.bar;
        __builtin_amdgcn_s_waitcnt(0);
        unsigned nloc = b.st[0], nx = b.st[1];
        if (nloc == 0u) { xcd_barrier_complete(bar, b.x, nloc, nx); b.st[0] = nloc; b.st[1] = nx; }
        const unsigned old = xb_add(&bar[XB_XSUB(b.x)], 1u);
        const unsigned gen = old / nloc;
        if (old + 1u == (gen + 1u) * nloc) {
            __builtin_amdgcn_fence(__ATOMIC_RELEASE, "agent");
            asm volatile("s_waitcnt vmcnt(0)" ::: "memory");
            const unsigned og = xb_add(&bar[XB_TOP], 1u);
            const unsigned tg = og / nx;
            if (og + 1u == (tg + 1u) * nx) xb_add(&bar[XB_TOPGEN], 1u);
            else XB_SPIN(xb_ld(&bar[XB_TOPGEN]) == tg, bar);
            __builtin_amdgcn_fence(__ATOMIC_ACQUIRE, "agent");
            xb_add(&bar[XB_XGEN(b.x)], 1u);
            asm volatile("s_waitcnt vmcnt(0)" ::: "memory");
        } else {
            XB_SPIN(xb_ld(&bar[XB_XGEN(b.x)]) == gen, bar);
            __builtin_amdgcn_fence(__ATOMIC_ACQUIRE, "agent");
            asm volatile("s_waitcnt vmcnt(0)" ::: "memory");
        }
    }
    __syncthreads();
}

struct Frame {
    LAS unsigned char* lds;
    int tid, lane, wave, G, bid;
    unsigned long long tacc, tmark;
    const float *x_p, *x_s, *st_gla, *st_ssd, *st_sconv, *st_fconv, *n_mix_pre, *n_mix_post, *n_ffn_pre, *n_ffn_post, *w_in, *w_gate2, *b_gate, *gla_norm,
                *sconv_w, *sconv_b, *dt_bias, *A_log, *ssd_D, *ssd_norm, *w_out, *ffn_w_in, *fconv_w, *fconv_b, *ffn_w_out;
    float* out;
    bf16 *W1, *WO, *WF1, *WF2, *XN, *PROJ, *MIXIN, *ACT, *DS, *SC, *DH, *HC, *QEg, *KEg;
    float *LRDT, *MIX, *Fb, *EBL, *AL, *HG;
};
__device__ __forceinline__ const float* x_row(const Frame& F, int row) { return row < MP ? F.x_p + (size_t)row * DM : F.x_s + (size_t)(row - MP) * DM; }

__device__ __forceinline__ int w1_src_col(int n) { return n < 3072 ? n : (n < 5632 ? n + 16 : (n < 5648 ? n - 2560 : (n < 5664 ? n : -1))); }
struct TDesc { const float* W; bf16* WT; int K, Nsrc, Ndst, map, item; };
__device__ __forceinline__ void t_load(const TDesc& d, int lane, f32x4 (&v)[16]) {
    const int nblk = d.Ndst / 64, kb = d.item / nblk, nb = d.item % nblk, k0 = 64 * kb, n0 = 64 * nb;
    int sc = n0 + 4 * (lane & 15); if (d.map == 1) sc = w1_src_col(sc); if (d.map == 2) sc = ((sc >> 7) & 1) * FF + 128 * (sc >> 8) + (sc & 127);
#pragma unroll
    for (int i = 0; i < 16; ++i) { const int kk = 4 * i + (lane >> 4); v[i] = (sc >= 0) ? *(const f32x4*)(d.W + (size_t)(k0 + kk) * d.Nsrc + sc) : (f32x4){0.f, 0.f, 0.f, 0.f}; }
}
__device__ __forceinline__ void t_store(const TDesc& d, int lane, LAS float* scr, const f32x4 (&v)[16]) {
    const int nblk = d.Ndst / 64, kb = d.item / nblk, nb = d.item % nblk, k0 = 64 * kb, n0 = 64 * nb;
#pragma unroll
    for (int i = 0; i < 16; ++i) { const int kk = 4 * i + (lane >> 4); LAS float* p = scr + kk * 65 + 4 * (lane & 15); p[0] = v[i].x; p[1] = v[i].y; p[2] = v[i].z; p[3] = v[i].w; }
    LDS_WAIT(); asm volatile("" ::: "memory");
    const int c = lane & 7;
#pragma unroll
    for (int j = 0; j < 8; ++j) { const int n = (lane >> 3) + 8 * j; const LAS float* s = scr + (8 * c) * 65 + n;
        v4u o; o.x = pk2(s[0 * 65], s[1 * 65]); o.y = pk2(s[2 * 65], s[3 * 65]); o.z = pk2(s[4 * 65], s[5 * 65]); o.w = pk2(s[6 * 65], s[7 * 65]);
        *(v4u*)(d.WT + (size_t)(n0 + n) * d.K + k0 + 8 * c) = o; }
    LDS_WAIT(); asm volatile("" ::: "memory");
}
__device__ __forceinline__ bool t_desc(const Frame& F, int which, int it, TDesc& d) {
    constexpr int I_1 = (DM / 64) * (N1 / 64), I_O = (DM / 64) * (DM / 64), I_F1 = (DM / 64) * (FF2 / 64), I_F2 = (FF / 64) * (DM / 64);
    if (which == 0) { if (it >= I_1) return false; d = TDesc{F.w_in, F.W1, DM, INC, N1, 1, it}; return true; }
    if (which == 2) { if (it >= I_F2) return false; d = TDesc{F.ffn_w_out, F.WF2, FF, DM, DM, 0, it}; return true; }
    if (it >= I_O + I_F1) return false;
    if (it < I_O) d = TDesc{F.w_out, F.WO, DM, DM, DM, 0, it};
    else d = TDesc{F.ffn_w_in, F.WF1, DM, FF2, FF2, 2, it - I_O};
    return true;
}
__device__ __forceinline__ void t_run(const Frame& F, int which, int gw, int NGW) {
    LAS float* scr = (LAS float*)(F.lds + F.wave * 16640);
    TDesc da, db; f32x4 va[16], vb[16]; int it = gw;
    if (!t_desc(F, which, it, da)) return;
    t_load(da, F.lane, va);
    for (;;) {
        const bool hb = t_desc(F, which, it + NGW, db); if (hb) t_load(db, F.lane, vb);
        t_store(da, F.lane, scr, va); if (!hb) break; it += NGW;
        const bool ha = t_desc(F, which, it + NGW, da); if (ha) t_load(da, F.lane, va);
        t_store(db, F.lane, scr, vb); if (!ha) break; it += NGW;
    }
}
__device__ __forceinline__ void rms_rows2_to_bf16(const float* x0, const float* x1, const float* w, bf16* o0, bf16* o1, int lane) {
    const f32x4* xa = (const f32x4*)x0 + lane; const f32x4* xb = (const f32x4*)x1 + lane; const f32x4* wr = (const f32x4*)w + lane;
    f32x4 va[8], vb[8]; float sa = 0.f, sb = 0.f;
#pragma unroll
    for (int j = 0; j < 8; ++j) va[j] = xa[64 * j];
#pragma unroll
    for (int j = 0; j < 8; ++j) vb[j] = xb[64 * j];
#pragma unroll
    for (int j = 0; j < 8; ++j) { sa += (va[j].x * va[j].x + va[j].y * va[j].y) + (va[j].z * va[j].z + va[j].w * va[j].w); sb += (vb[j].x * vb[j].x + vb[j].y * vb[j].y) + (vb[j].z * vb[j].z + vb[j].w * vb[j].w); }
    const float ra = rsqrtf(wave_sum(sa) * (1.f / DM) + EPS), rb = rsqrtf(wave_sum(sb) * (1.f / DM) + EPS);
    v2u* pa = (v2u*)o0 + lane; v2u* pb = (v2u*)o1 + lane;
#pragma unroll
    for (int j = 0; j < 8; ++j) { const f32x4 ww = wr[64 * j]; v2u o; o.x = pk2(va[j].x * ra * ww.x, va[j].y * ra * ww.y); o.y = pk2(va[j].z * ra * ww.z, va[j].w * ra * ww.w); pa[64 * j] = o;
        o.x = pk2(vb[j].x * rb * ww.x, vb[j].y * rb * ww.y); o.y = pk2(vb[j].z * rb * ww.z, vb[j].w * rb * ww.w); pb[64 * j] = o; }
}
__device__ __forceinline__ void p0_prologue(Frame& F) {
    const int gw = F.bid * NWAVES + F.wave, NGW = F.G * NWAVES;
    t_run(F, 0, gw, NGW);
    for (int m = gw; m < M; m += 2 * NGW) { const int m1 = (m + NGW < M) ? m + NGW : m; rms_rows2_to_bf16(x_row(F, m), x_row(F, m1), F.n_mix_pre, F.XN + (size_t)m * DM, F.XN + (size_t)m1 * DM, F.lane); }
}
__device__ __forceinline__ void p0_convert_rest(Frame& F, int vb, int nb) { t_run(F, 1, vb * NWAVES + F.wave, nb * NWAVES); }

template <int grp> __device__ __forceinline__ void gla_direct_unit(Frame& F, int b, int h) {
    const int tid = F.tid, v = tid & 255, kh = tid >> 8;
    const int L = grp ? SL : PL, row0 = grp ? MP + b * SL : b * PL;
    LAS float* Es = (LAS float*)F.lds; LAS float* Ks = Es + 1024; LAS float* Qs = Ks + 1024; LAS float* Os = Qs + 1024;
    float S[64];
    if (grp) { const float* s0 = F.st_gla + ((size_t)(b * GH + h) * GK + kh * 64) * GV + v;
#pragma unroll
        for (int i = 0; i < 64; ++i) S[i] = s0[(size_t)i * GV]; }
    else {
#pragma unroll
        for (int i = 0; i < 64; ++i) S[i] = 0.f; }
    for (int t0 = 0; t0 < L; t0 += 8) {
        for (int it = tid; it < 1024; it += NTHR) { const int t = it >> 7, k = it & 127, row = row0 + t0 + t, hk = h * GK + k;
            float x = F.b_gate[hk]; const float* lr = F.LRDT + (size_t)row * 32;
#pragma unroll
            for (int j = 0; j < LOWR; ++j) x += lr[j] * F.w_gate2[j * GKD + hk];
            const float lg = logsigmoid_f(x) * (1.f / 16.f);
            Es[it] = __expf(lg); Ks[it] = bf2f(F.PROJ[(size_t)row * NP + CK + hk]); Qs[it] = bf2f(F.PROJ[(size_t)row * NP + CQ + hk]) * 0.08838834764831845f; }
        __syncthreads();
#pragma unroll 1
        for (int t = 0; t < 8; ++t) { const float vv = bf2f(F.PROJ[(size_t)(row0 + t0 + t) * NP + CV + h * GV + v]); float acc = 0.f;
            const LAS float* e = Es + t * 128 + kh * 64; const LAS float* kk = Ks + t * 128 + kh * 64; const LAS float* qq = Qs + t * 128 + kh * 64;
#pragma unroll
            for (int i = 0; i < 64; ++i) { S[i] = e[i] * S[i] + kk[i] * vv; acc += qq[i] * S[i]; }
            Os[(kh * 8 + t) * 256 + v] = acc; }
        __syncthreads();
        { const int t = F.wave, v4 = F.lane * 4, row = row0 + t0 + t;
            const f32x4 a = *(const LAS f32x4*)(Os + t * 256 + v4), c = *(const LAS f32x4*)(Os + (8 + t) * 256 + v4); const f32x4 o = a + c;
            const float ss = wave_sum((o.x * o.x + o.y * o.y) + (o.z * o.z + o.w * o.w)); const float r = rsqrtf(ss * (1.f / GV) + EPS);
            const v2u gw = *(const v2u*)(F.PROJ + (size_t)row * NP + CG + h * GV + v4); const f32x4 nw = *(const f32x4*)(F.gla_norm + v4);
            v2u w; w.x = pk2(o.x * r * nw.x * silu_f(bflo(gw.x)), o.y * r * nw.y * silu_f(bfhi(gw.x))); w.y = pk2(o.z * r * nw.z * silu_f(bflo(gw.y)), o.w * r * nw.w * silu_f(bfhi(gw.y)));
            *(v2u*)(F.MIXIN + (size_t)row * DM + h * GV + v4) = w; }
        __syncthreads();
    }
    float* so = F.out + (grp ? O_GLA_S : O_GLA_P) + ((size_t)(b * GH + h) * GK + kh * 64) * GV + v;
#pragma unroll
    for (int i = 0; i < 64; ++i) so[(size_t)i * GV] = S[i];
}
__device__ __forceinline__ float xbc_raw(const Frame& F, int grp, int b, int row0, int tt, int c) {
    if (tt >= 0) return bf2f(F.PROJ[(size_t)(row0 + tt) * NP + CX + c]);
    return grp ? F.st_sconv[((size_t)b * 3 + (tt + 3)) * SCH + c] : 0.f;
}
template <int grp> __device__ __forceinline__ void ssd_direct_unit(Frame& F, int b, int g) {
    const int tid = F.tid, hd = g * 8 + (tid >> 6), p = tid & 63, ch = g * 512 + tid;
    const int L = grp ? SL : PL, row0 = grp ? MP + b * SL : b * PL;
    LAS float* Bs = (LAS float*)F.lds; LAS float* Cs = Bs + 1024; LAS float* red = Cs + 1024; LAS float* Ys = red + 64;
    float h[128];
    if (grp) { const f32x4* h0 = (const f32x4*)(F.st_ssd + ((size_t)(b * SH + hd) * SP + p) * SN);
#pragma unroll
        for (int i = 0; i < 32; ++i) { const f32x4 q = h0[i]; h[4 * i] = q.x; h[4 * i + 1] = q.y; h[4 * i + 2] = q.z; h[4 * i + 3] = q.w; } }
    else {
#pragma unroll
        for (int i = 0; i < 128; ++i) h[i] = 0.f; }
    const float A = -__expf(F.A_log[hd]), dtb = F.dt_bias[hd], Dh = F.ssd_D[hd], nw = F.ssd_norm[ch];
    const float cb = F.sconv_b[ch], cw0 = F.sconv_w[ch], cw1 = F.sconv_w[SCH + ch], cw2 = F.sconv_w[2 * SCH + ch], cw3 = F.sconv_w[3 * SCH + ch];
    const int c2 = 1024 + (tid < 128 ? g * 128 + tid : 256 + g * 128 + ((tid - 128) & 127));
    float xr0 = xbc_raw(F, grp, b, row0, -3, ch), xr1 = xbc_raw(F, grp, b, row0, -2, ch), xr2 = xbc_raw(F, grp, b, row0, -1, ch);
    for (int t0 = 0; t0 < L; t0 += 8) {
        if (tid < 256) {
            float xr[11]; const float cb2 = F.sconv_b[c2], d0 = F.sconv_w[c2], d1 = F.sconv_w[SCH + c2], d2 = F.sconv_w[2 * SCH + c2], d3 = F.sconv_w[3 * SCH + c2];
#pragma unroll
            for (int i = 0; i < 11; ++i) xr[i] = xbc_raw(F, grp, b, row0, t0 - 3 + i, c2);
#pragma unroll
            for (int t = 0; t < 8; ++t) Bs[(tid >> 7) * 1024 + t * 128 + (tid & 127)] = silu_f(cb2 + d0 * xr[t] + d1 * xr[t + 1] + d2 * xr[t + 2] + d3 * xr[t + 3]);
        }
        __syncthreads();
#pragma unroll 1
        for (int t = 0; t < 8; ++t) { const int row = row0 + t0 + t;
            const float xn = bf2f(F.PROJ[(size_t)row * NP + CX + ch]);
            const float x = silu_f(cb + cw0 * xr0 + cw1 * xr1 + cw2 * xr2 + cw3 * xn); xr0 = xr1; xr1 = xr2; xr2 = xn;
            const float dt = softplus_f(F.LRDT[(size_t)row * 32 + 16 + hd] + dtb), a = __expf(dt * A), dtx = dt * x;
            float acc = 0.f; const LAS float* bb = Bs + t * 128; const LAS float* cc = Cs + t * 128;
#pragma unroll
            for (int nb = 0; nb < 128; nb += 16) {
#pragma unroll
                for (int n = nb; n < nb + 16; ++n) { h[n] = a * h[n] + dtx * bb[n]; acc += h[n] * cc[n]; }
                asm volatile("" ::: "memory"); }
            const float z = bf2f(F.PROJ[(size_t)row * NP + CZ + ch]);
            const float y = (acc + Dh * x) * silu_f(z);
            Ys[t * 512 + tid] = y;
            const float ss = wave_sum(y * y); if (F.lane == 0) red[t * 8 + F.wave] = ss; }
        __syncthreads();
#pragma unroll
        for (int t = 0; t < 8; ++t) { float tot = 0.f;
#pragma unroll
            for (int w = 0; w < 8; ++w) tot += red[t * 8 + w];
            const float r = rsqrtf(tot * (1.f / 512.f) + EPS);
            F.MIXIN[(size_t)(row0 + t0 + t) * DM + 1024 + ch] = (bf16)f2bf(Ys[t * 512 + tid] * r * nw); }
        __syncthreads();
    }
    f32x4* ho = (f32x4*)(F.out + (grp ? O_SSD_S : O_SSD_P) + ((size_t)(b * SH + hd) * SP + p) * SN);
#pragma unroll
    for (int i = 0; i < 32; ++i) ho[i] = (f32x4){h[4 * i], h[4 * i + 1], h[4 * i + 2], h[4 * i + 3]};
}
typedef short bf16x8v __attribute__((ext_vector_type(8)));
typedef short s16x4v __attribute__((ext_vector_type(4)));
constexpr int CH = 64, NCH = PL / CH;
constexpr int QE_ST = 272, KDT_ST = 144, V_ST = 544, ATT_ST = 144, X_ST = 1056, BC_ST = 288;
#define MFMA16(a, b, c) __builtin_amdgcn_mfma_f32_16x16x32_bf16((a), (b), (c), 0, 0, 0)
__device__ __forceinline__ bf16x8v frag_k(const LAS unsigned char* T, int stride, int idx0, int kk0, int r, int q) { return *(const LAS bf16x8v*)(T + (idx0 + r) * stride + (kk0 + 8 * q) * 2); }
__device__ __forceinline__ bf16x8v frag_t(const LAS unsigned char* T, int stride, int kk0, int idx0, int r, int q) {
    const LAS unsigned char* p = T + (kk0 + 8 * q + (r >> 2)) * stride + (idx0 + 4 * (r & 3)) * 2;
    const s16x4v lo = __builtin_amdgcn_ds_read_tr16_b64_v4i16((LAS s16x4v*)p), hi = __builtin_amdgcn_ds_read_tr16_b64_v4i16((LAS s16x4v*)(p + 4 * stride));
    return (bf16x8v){lo[0], lo[1], lo[2], lo[3], hi[0], hi[1], hi[2], hi[3]};
}
__device__ __forceinline__ v2u pk4(const f32x4 v) { v2u o; o.x = pk2(v.x, v.y); o.y = pk2(v.z, v.w); return o; }

struct GlaStage { v4u v[4], qk[4], lr; };
template <int PASS>
__device__ __forceinline__ void gla_stage_load(const Frame& F, int h, int row0, GlaStage& g) {
    const int tid = F.tid;
#pragma unroll
    for (int i = 0; i < 4; ++i) { const int piece = tid + NTHR * i, row = piece >> 5, c16 = piece & 31; g.v[i] = *(const v4u*)(F.PROJ + (size_t)(row0 + row) * NP + CV + h * GV + c16 * 8); }
#pragma unroll
    for (int i = 0; i < 2; ++i) { const int piece = tid + NTHR * i, row = piece >> 4, c16 = piece & 15;
        g.qk[i] = *(const v4u*)(F.PROJ + (size_t)(row0 + row) * NP + CK + h * GK + c16 * 8);
        if (PASS == 1) g.qk[2 + i] = *(const v4u*)(F.PROJ + (size_t)(row0 + row) * NP + CQ + h * GK + c16 * 8); }
    if (tid < 256) g.lr = *(const v4u*)(F.LRDT + (size_t)(row0 + (tid >> 2)) * 32 + (tid & 3) * 4);
}
template <int PASS>
__device__ __forceinline__ void gla_stage_store(const Frame& F, const GlaStage& g, LAS unsigned char* V, LAS unsigned char* Kt, LAS unsigned char* Qt, LAS float* LR) {
    const int tid = F.tid;
#pragma unroll
    for (int i = 0; i < 4; ++i) { const int piece = tid + NTHR * i, row = piece >> 5, c16 = piece & 31; *(LAS v4u*)(V + row * V_ST + c16 * 16) = g.v[i]; }
#pragma unroll
    for (int i = 0; i < 2; ++i) { const int piece = tid + NTHR * i, row = piece >> 4, c16 = piece & 15;
        *(LAS v4u*)(Kt + row * QE_ST + c16 * 16) = g.qk[i]; if (PASS == 1) *(LAS v4u*)(Qt + row * QE_ST + c16 * 16) = g.qk[2 + i]; }
    if (tid < 256) *(LAS v4u*)(LR + (tid >> 2) * 16 + (tid & 3) * 4) = g.lr;
}
template <int PASS>
__device__ __forceinline__ void gla_chunk_elem(Frame& F, int h, LAS unsigned char* Kt, LAS unsigned char* Qt, LAS unsigned char* KDT, const LAS float* LR, LAS float* tot, float* ebl_out) {
    const int tid = F.tid, k = tid & 127, tq = tid >> 7, hk = h * GK + k;
    float w2[16];
#pragma unroll
    for (int j = 0; j < 16; ++j) w2[j] = F.w_gate2[j * GKD + hk];
    const float bg = F.b_gate[hk];
    float lg[16]; float run = 0.f;
#pragma unroll
    for (int i = 0; i < 16; ++i) { const LAS f32x4* lr = (const LAS f32x4*)(LR + (16 * tq + i) * 16); const f32x4 a = lr[0], b = lr[1], c = lr[2], d = lr[3];
        float x = bg + a.x * w2[0] + a.y * w2[1] + a.z * w2[2] + a.w * w2[3] + b.x * w2[4] + b.y * w2[5] + b.z * w2[6] + b.w * w2[7]
                     + c.x * w2[8] + c.y * w2[9] + c.z * w2[10] + c.w * w2[11] + d.x * w2[12] + d.y * w2[13] + d.z * w2[14] + d.w * w2[15];
        run += logsigmoid_f(x) * (1.f / 16.f); lg[i] = run; }
    tot[tq * 128 + k] = run;
    __syncthreads();
    float off = 0.f, all = 0.f;
#pragma unroll
    for (int qq = 0; qq < 4; ++qq) { const float v = tot[qq * 128 + k]; all += v; off += (qq < tq) ? v : 0.f; }
    {
        unsigned pk[8];
#pragma unroll
        for (int i = 0; i < 8; ++i) { const int t = 16 * tq + 2 * i; const float b0 = off + lg[2 * i], b1 = off + lg[2 * i + 1];
            LAS bf16* k0p = (LAS bf16*)(Kt + t * QE_ST + k * 2); LAS bf16* k1p = (LAS bf16*)(Kt + (t + 1) * QE_ST + k * 2);
            LAS bf16* q0p = (LAS bf16*)(Qt + t * QE_ST + k * 2); LAS bf16* q1p = (LAS bf16*)(Qt + (t + 1) * QE_ST + k * 2);
            const float k0 = bf2f(*k0p), k1 = bf2f(*k1p);
            pk[i] = pk2(k0 * __expf(all - b0), k1 * __expf(all - b1));
            *k0p = (bf16)f2bf(k0 * __expf(-b0)); *k1p = (bf16)f2bf(k1 * __expf(-b1));
            *q0p = (bf16)f2bf(bf2f(*q0p) * 0.08838834764831845f * __expf(b0)); *q1p = (bf16)f2bf(bf2f(*q1p) * 0.08838834764831845f * __expf(b1)); }
        LAS v4u* d = (LAS v4u*)(KDT + k * KDT_ST + 32 * tq);
        d[0] = (v4u){pk[0], pk[1], pk[2], pk[3]}; d[1] = (v4u){pk[4], pk[5], pk[6], pk[7]};
        if (tq == 0) ebl_out[k] = __expf(all);
    }
}
__device__ __forceinline__ void gla_passA_unit(Frame& F, int u) {
    const int c = u & 31, bh = u >> 5, b = bh >> 2, h = bh & 3, row0 = b * PL + c * CH;
    LAS unsigned char* KDT = F.lds; LAS unsigned char* V = KDT + 128 * KDT_ST; LAS unsigned char* Kt = V + 64 * V_ST; LAS unsigned char* Qt = Kt + 64 * QE_ST; LAS float* LR = (LAS float*)(Qt + 64 * QE_ST); LAS float* tot = LR + 1024;
    { GlaStage g; gla_stage_load<1>(F, h, row0, g); gla_stage_store<1>(F, g, V, Kt, Qt, LR); }
    __syncthreads();
    gla_chunk_elem<0>(F, h, Kt, Qt, KDT, LR, tot, F.EBL + (size_t)u * 128);
    __syncthreads();
#pragma unroll
    for (int i = 0; i < 2; ++i) { const int piece = F.tid + NTHR * i, row = piece >> 4, c16 = piece & 15;
        *(v4u*)(F.QEg + ((size_t)u * 64 + row) * GK + c16 * 8) = *(const LAS v4u*)(Qt + row * QE_ST + c16 * 16);
        *(v4u*)(F.KEg + ((size_t)u * 64 + row) * GK + c16 * 8) = *(const LAS v4u*)(Kt + row * QE_ST + c16 * 16); }
    const int w = F.wave, r = F.lane & 15, q = F.lane >> 4;
    f32x4 acc[8][2];
#pragma unroll
    for (int kf = 0; kf < 8; ++kf) { acc[kf][0] = (f32x4){0.f, 0.f, 0.f, 0.f}; acc[kf][1] = (f32x4){0.f, 0.f, 0.f, 0.f}; }
#pragma unroll
    for (int ks = 0; ks < 2; ++ks) { const bf16x8v b0 = frag_t(V, V_ST, 32 * ks, 32 * w, r, q), b1 = frag_t(V, V_ST, 32 * ks, 32 * w + 16, r, q);
#pragma unroll
        for (int kf = 0; kf < 8; ++kf) { const bf16x8v a = frag_k(KDT, KDT_ST, 16 * kf, 32 * ks, r, q); acc[kf][0] = MFMA16(a, b0, acc[kf][0]); acc[kf][1] = MFMA16(a, b1, acc[kf][1]); } }
#pragma unroll
    for (int kf = 0; kf < 8; ++kf)
#pragma unroll
        for (int vf = 0; vf < 2; ++vf) *(v2u*)(F.DS + ((size_t)u * GV + 32 * w + 16 * vf + r) * GK + 16 * kf + 4 * q) = pk4(acc[kf][vf]);
    __syncthreads();
}
__device__ __forceinline__ void gla_scan(Frame& F) {
    for (int it = F.bid * NTHR + F.tid; it < PB * GH * GV * 32; it += F.G * NTHR) { const int k4 = it & 31, v = (it >> 5) & 255, bh = it >> 13;
        f32x4 S = (f32x4){0.f, 0.f, 0.f, 0.f};
#pragma unroll 8
        for (int c = 0; c < NCH; ++c) { const int u = bh * NCH + c; const size_t off = ((size_t)u * GV + v) * GK + 4 * k4;
            const v2u d = *(const v2u*)(F.DS + off); const f32x4 e = *(const f32x4*)(F.EBL + (size_t)u * 128 + 4 * k4);
            *(v2u*)(F.SC + off) = pk4(S);
            S.x = e.x * S.x + bflo(d.x); S.y = e.y * S.y + bfhi(d.x); S.z = e.z * S.z + bflo(d.y); S.w = e.w * S.w + bfhi(d.y); }
        float* o = F.out + O_GLA_P + ((size_t)bh * GK + 4 * k4) * GV + v; o[0] = S.x; o[GV] = S.y; o[2 * GV] = S.z; o[3 * GV] = S.w; }
}
__device__ __forceinline__ void gla_passC_unit(Frame& F, int u) {
    const int c = u & 31, bh = u >> 5, b = bh >> 2, h = bh & 3, row0 = b * PL + c * CH;
    LAS unsigned char* QE = F.lds; LAS unsigned char* KE = QE + 64 * QE_ST; LAS unsigned char* V = KE + 64 * QE_ST; LAS unsigned char* ATT = V + 64 * V_ST;
    LAS float* red = (LAS float*)(ATT + 64 * ATT_ST);
    const int w = F.wave, r = F.lane & 15, q = F.lane >> 4, tf = w & 3, vh = w >> 2;
    bf16x8v scf[2][8];
    const bf16* Sc = F.SC + ((size_t)u * GV + 128 * vh) * GK;
#pragma unroll
    for (int ks = 0; ks < 2; ++ks)
#pragma unroll
        for (int i = 0; i < 8; ++i) scf[ks][i] = *(const bf16x8v*)(Sc + (size_t)(16 * i + r) * GK + 32 * ks + 8 * q);
    v2u gwv[8];
#pragma unroll
    for (int i = 0; i < 8; ++i) gwv[i] = *(const v2u*)(F.PROJ + (size_t)(row0 + 16 * tf + r) * NP + CG + h * GV + 128 * vh + 16 * i + 4 * q);
    { v4u vv[4], qq[2], kk[2];
#pragma unroll
        for (int i = 0; i < 4; ++i) { const int piece = F.tid + NTHR * i, row = piece >> 5, c16 = piece & 31; vv[i] = *(const v4u*)(F.PROJ + (size_t)(row0 + row) * NP + CV + h * GV + c16 * 8); }
#pragma unroll
        for (int i = 0; i < 2; ++i) { const int piece = F.tid + NTHR * i, row = piece >> 4, c16 = piece & 15;
            qq[i] = *(const v4u*)(F.QEg + ((size_t)u * 64 + row) * GK + c16 * 8); kk[i] = *(const v4u*)(F.KEg + ((size_t)u * 64 + row) * GK + c16 * 8); }
#pragma unroll
        for (int i = 0; i < 4; ++i) { const int piece = F.tid + NTHR * i, row = piece >> 5, c16 = piece & 31; *(LAS v4u*)(V + row * V_ST + c16 * 16) = vv[i]; }
#pragma unroll
        for (int i = 0; i < 2; ++i) { const int piece = F.tid + NTHR * i, row = piece >> 4, c16 = piece & 15;
            *(LAS v4u*)(QE + row * QE_ST + c16 * 16) = qq[i]; *(LAS v4u*)(KE + row * QE_ST + c16 * 16) = kk[i]; } }
    __syncthreads();
    f32x4 acc[8];
#pragma unroll
    for (int i = 0; i < 8; ++i) acc[i] = (f32x4){0.f, 0.f, 0.f, 0.f};
#pragma unroll
    for (int ks = 0; ks < 2; ++ks) { const bf16x8v bq = frag_k(QE, QE_ST, 16 * tf, 32 * ks, r, q);
#pragma unroll
        for (int i = 0; i < 8; ++i) acc[i] = MFMA16(scf[ks][i], bq, acc[i]); }
#pragma unroll
    for (int ks = 0; ks < 2; ++ks)
#pragma unroll
        for (int i = 0; i < 8; ++i) scf[ks][i] = *(const bf16x8v*)(Sc + (size_t)(16 * i + r) * GK + 32 * (ks + 2) + 8 * q);
#pragma unroll
    for (int ff = 0; ff < 2; ++ff) { const int f = 2 * w + ff, sf = f >> 2, tf = f & 3; f32x4 a4 = (f32x4){0.f, 0.f, 0.f, 0.f};
        if (sf <= tf) {
#pragma unroll
            for (int ks = 0; ks < 4; ++ks) a4 = MFMA16(frag_k(KE, QE_ST, 16 * sf, 32 * ks, r, q), frag_k(QE, QE_ST, 16 * tf, 32 * ks, r, q), a4); }
        const int s0 = 16 * sf + 4 * q, t = 16 * tf + r;
        f32x4 m; m.x = (s0 <= t) ? a4.x : 0.f; m.y = (s0 + 1 <= t) ? a4.y : 0.f; m.z = (s0 + 2 <= t) ? a4.z : 0.f; m.w = (s0 + 3 <= t) ? a4.w : 0.f;
        *(LAS v2u*)(ATT + t * ATT_ST + s0 * 2) = pk4(m); }
    __syncthreads();
#pragma unroll
    for (int ks = 0; ks < 2; ++ks) { const bf16x8v bq = frag_k(QE, QE_ST, 16 * tf, 32 * (ks + 2), r, q);
#pragma unroll
        for (int i = 0; i < 8; ++i) acc[i] = MFMA16(scf[ks][i], bq, acc[i]); }
#pragma unroll
    for (int ks = 0; ks < 2; ++ks) { const bf16x8v ba = frag_k(ATT, ATT_ST, 16 * tf, 32 * ks, r, q);
#pragma unroll
        for (int i = 0; i < 8; ++i) { const bf16x8v a = frag_t(V, V_ST, 32 * ks, 128 * vh + 16 * i, r, q); acc[i] = MFMA16(a, ba, acc[i]); } }
    float ss = 0.f;
#pragma unroll
    for (int i = 0; i < 8; ++i) ss += (acc[i].x * acc[i].x + acc[i].y * acc[i].y) + (acc[i].z * acc[i].z + acc[i].w * acc[i].w);
    ss += __shfl_xor(ss, 16); ss += __shfl_xor(ss, 32);
    const int t = 16 * tf + r;
    if (q == 0) red[vh * 64 + t] = ss;
    __syncthreads();
    const float rr = rsqrtf((red[t] + red[64 + t]) * (1.f / GV) + EPS); const size_t row = (size_t)(row0 + t);
#pragma unroll
    for (int i = 0; i < 8; ++i) { const int v = 128 * vh + 16 * i + 4 * q;
        const v2u gw = gwv[i]; const f32x4 nw = *(const f32x4*)(F.gla_norm + v);
        f32x4 o; o.x = acc[i].x * rr * nw.x * silu_f(bflo(gw.x)); o.y = acc[i].y * rr * nw.y * silu_f(bfhi(gw.x)); o.z = acc[i].z * rr * nw.z * silu_f(bflo(gw.y)); o.w = acc[i].w * rr * nw.w * silu_f(bfhi(gw.y));
        *(v2u*)(F.MIXIN + row * DM + h * GV + v) = pk4(o); }
    __syncthreads();
}

template <bool SCALE>
__device__ __forceinline__ void ssd_conv_item(Frame& F, int b, int g, int c, int cg, int tb, LAS unsigned char* X, LAS unsigned char* BT, LAS unsigned char* CT, const LAS float* WDEC) {
    const int xc = cg < 64 ? g * 512 + 8 * cg : (cg < 80 ? 1024 + g * 128 + 8 * (cg - 64) : 1280 + g * 128 + 8 * (cg - 80));
    float w[4][8], bias[8];
#pragma unroll
    for (int j = 0; j < 4; ++j) { const f32x4 a = *(const f32x4*)(F.sconv_w + j * SCH + xc), bq = *(const f32x4*)(F.sconv_w + j * SCH + xc + 4);
        w[j][0] = a.x; w[j][1] = a.y; w[j][2] = a.z; w[j][3] = a.w; w[j][4] = bq.x; w[j][5] = bq.y; w[j][6] = bq.z; w[j][7] = bq.w; }
    { const f32x4 a = *(const f32x4*)(F.sconv_b + xc), bq = *(const f32x4*)(F.sconv_b + xc + 4); bias[0] = a.x; bias[1] = a.y; bias[2] = a.z; bias[3] = a.w; bias[4] = bq.x; bias[5] = bq.y; bias[6] = bq.z; bias[7] = bq.w; }
    v4u raw[11];
#pragma unroll
    for (int i = 0; i < 11; ++i) { const int tt = c * CH + tb * 8 - 3 + i;
        raw[i] = (tt >= 0) ? *(const v4u*)(F.PROJ + (size_t)(b * PL + tt) * NP + CX + xc) : (v4u){0u, 0u, 0u, 0u}; }
#pragma unroll
    for (int t = 0; t < 8; ++t) { float o[8];
#pragma unroll
        for (int e = 0; e < 8; ++e) { float a = bias[e];
#pragma unroll
            for (int j = 0; j < 4; ++j) { const unsigned wd = raw[t + j][e >> 1]; a += w[j][e] * ((e & 1) ? bfhi(wd) : bflo(wd)); }
            o[e] = silu_f(a); }
        const int tl = tb * 8 + t;
        if (SCALE && cg < 64) { const float sc = WDEC[(cg >> 3) * 64 + tl];
#pragma unroll
            for (int e = 0; e < 8; ++e) o[e] *= sc; }
        const v4u pkd = (v4u){pk2(o[0], o[1]), pk2(o[2], o[3]), pk2(o[4], o[5]), pk2(o[6], o[7])};
        LAS unsigned char* dst = cg < 64 ? X + tl * X_ST + cg * 16 : (cg < 80 ? BT + tl * BC_ST + (cg - 64) * 16 : CT + tl * BC_ST + (cg - 80) * 16);
        *(LAS v4u*)dst = pkd; }
}
__device__ __forceinline__ float ssd_head_scan(Frame& F, int hd, int row0, float& dt_out, float& last) {
    const float dt = softplus_f(F.LRDT[(size_t)(row0 + F.lane) * 32 + 16 + hd] + F.dt_bias[hd]);
    float cum = dt * (-__expf(F.A_log[hd]));
#pragma unroll
    for (int o = 1; o < 64; o <<= 1) { const float v = __shfl_up(cum, o); cum += (F.lane >= o) ? v : 0.f; }
    dt_out = dt; last = __shfl(cum, 63); return cum;
}
__device__ __forceinline__ void ssd_passA_unit(Frame& F, int u) {
    const int c = u & 31, bg = u >> 5, b = bg >> 1, g = bg & 1, row0 = b * PL + c * CH;
    LAS unsigned char* X = F.lds; LAS unsigned char* BT = X + 64 * X_ST; LAS float* WDEC = (LAS float*)(BT + 64 * BC_ST);
    const int w = F.wave, r = F.lane & 15, q = F.lane >> 4;
    { float dt, last; const float cum = ssd_head_scan(F, g * 8 + w, row0, dt, last);
        WDEC[w * 64 + F.lane] = __expf(last - cum) * dt; if (F.lane == 63) F.AL[(size_t)u * 8 + w] = __expf(last); }
    __syncthreads();
    for (int it = F.tid; it < 80 * 8; it += NTHR) ssd_conv_item<true>(F, b, g, c, it % 80, it / 80, X, BT, nullptr, WDEC);
    __syncthreads();
#pragma unroll 1
    for (int nh = 0; nh < 2; ++nh) {
        f32x4 acc[4][4];
#pragma unroll
        for (int i = 0; i < 4; ++i)
#pragma unroll
            for (int j = 0; j < 4; ++j) acc[i][j] = (f32x4){0.f, 0.f, 0.f, 0.f};
#pragma unroll
        for (int ks = 0; ks < 2; ++ks) { bf16x8v bp[4];
#pragma unroll
            for (int pf = 0; pf < 4; ++pf) bp[pf] = frag_t(X, X_ST, 32 * ks, 64 * w + 16 * pf, r, q);
#pragma unroll
            for (int nf = 0; nf < 4; ++nf) { const bf16x8v a = frag_t(BT, BC_ST, 32 * ks, 64 * nh + 16 * nf, r, q);
#pragma unroll
                for (int pf = 0; pf < 4; ++pf) acc[nf][pf] = MFMA16(a, bp[pf], acc[nf][pf]); } }
#pragma unroll
        for (int nf = 0; nf < 4; ++nf)
#pragma unroll
            for (int pf = 0; pf < 4; ++pf) *(v2u*)(F.DH + (((size_t)u * 8 + w) * SP + 16 * pf + r) * SN + 64 * nh + 16 * nf + 4 * q) = pk4(acc[nf][pf]);
    }
    __syncthreads();
}
__device__ __forceinline__ void ssd_scan(Frame& F) {
    for (int it = F.bid * NTHR + F.tid; it < PB * SH * SP * 32; it += F.G * NTHR) { const int n4 = it & 31, p = (it >> 5) & 63, bhd = it >> 11, b = bhd >> 4, hd = bhd & 15, g = hd >> 3, hl = hd & 7;
        f32x4 H = (f32x4){0.f, 0.f, 0.f, 0.f};
#pragma unroll 8
        for (int c = 0; c < NCH; ++c) { const int u = (b * 2 + g) * NCH + c; const size_t off = (((size_t)u * 8 + hl) * SP + p) * SN + 4 * n4;
            const v2u d = *(const v2u*)(F.DH + off); const float a = F.AL[(size_t)u * 8 + hl];
            *(v2u*)(F.HC + off) = pk4(H);
            H.x = a * H.x + bflo(d.x); H.y = a * H.y + bfhi(d.x); H.z = a * H.z + bflo(d.y); H.w = a * H.w + bfhi(d.y); }
        *(f32x4*)(F.out + O_SSD_P + ((size_t)bhd * SP + p) * SN + 4 * n4) = H; }
}
__device__ __forceinline__ void ssd_passC_unit(Frame& F, int u) {
    const int c = u & 31, bg = u >> 5, b = bg >> 1, g = bg & 1, row0 = b * PL + c * CH;
    LAS unsigned char* X = F.lds; LAS unsigned char* BT = X + 64 * X_ST; LAS unsigned char* CT = BT + 64 * BC_ST; LAS unsigned char* CB = CT + 64 * BC_ST;
    LAS float* DT = (LAS float*)(CB + 64 * ATT_ST); LAS float* CUM = DT + 512; LAS float* red = CUM + 512;
    const int w = F.wave, r = F.lane & 15, q = F.lane >> 4, hd = g * 8 + w;
    bf16x8v hcf[4][4];
    const bf16* Hc0 = F.HC + ((size_t)u * 8 + w) * SP * SN;
#pragma unroll
    for (int ks = 0; ks < 2; ++ks)
#pragma unroll
        for (int pf = 0; pf < 4; ++pf) hcf[ks][pf] = *(const bf16x8v*)(Hc0 + (size_t)(16 * pf + r) * SN + 32 * ks + 8 * q);
    { float dt, last; const float cum = ssd_head_scan(F, hd, row0, dt, last); DT[w * 64 + F.lane] = dt; CUM[w * 64 + F.lane] = cum; }
    for (int it = F.tid; it < 96 * 8; it += NTHR) ssd_conv_item<false>(F, b, g, c, it % 96, it / 96, X, BT, CT, nullptr);
#pragma unroll
    for (int ks = 2; ks < 4; ++ks)
#pragma unroll
        for (int pf = 0; pf < 4; ++pf) hcf[ks][pf] = *(const bf16x8v*)(Hc0 + (size_t)(16 * pf + r) * SN + 32 * ks + 8 * q);
    __syncthreads();
#pragma unroll
    for (int ff = 0; ff < 2; ++ff) { const int f = 2 * w + ff, sf = f >> 2, tf = f & 3; f32x4 a4 = (f32x4){0.f, 0.f, 0.f, 0.f};
        if (sf <= tf) {
#pragma unroll
            for (int ks = 0; ks < 4; ++ks) a4 = MFMA16(frag_k(BT, BC_ST, 16 * sf, 32 * ks, r, q), frag_k(CT, BC_ST, 16 * tf, 32 * ks, r, q), a4); }
        *(LAS v2u*)(CB + (16 * tf + r) * ATT_ST + (16 * sf + 4 * q) * 2) = pk4(a4); }
    __syncthreads();
    f32x4 acc[4][4];
#pragma unroll
    for (int i = 0; i < 4; ++i)
#pragma unroll
        for (int j = 0; j < 4; ++j) acc[i][j] = (f32x4){0.f, 0.f, 0.f, 0.f};
#pragma unroll
    for (int ks = 0; ks < 4; ++ks) { bf16x8v bc[4];
#pragma unroll
        for (int tf = 0; tf < 4; ++tf) bc[tf] = frag_k(CT, BC_ST, 16 * tf, 32 * ks, r, q);
#pragma unroll
        for (int pf = 0; pf < 4; ++pf) {
#pragma unroll
            for (int tf = 0; tf < 4; ++tf) acc[pf][tf] = MFMA16(hcf[ks][pf], bc[tf], acc[pf][tf]); } }
    float ct[4];
#pragma unroll
    for (int tf = 0; tf < 4; ++tf) { ct[tf] = CUM[w * 64 + 16 * tf + r]; const float e = __expf(ct[tf]);
#pragma unroll
        for (int pf = 0; pf < 4; ++pf) acc[pf][tf] = acc[pf][tf] * e; }
#pragma unroll
    for (int ks = 0; ks < 2; ++ks) { bf16x8v ax[4];
#pragma unroll
        for (int pf = 0; pf < 4; ++pf) ax[pf] = frag_t(X, X_ST, 32 * ks, 64 * w + 16 * pf, r, q);
        const int s0 = 32 * ks + 8 * q;
        const f32x4 cs0 = *(const LAS f32x4*)(CUM + w * 64 + s0), cs1 = *(const LAS f32x4*)(CUM + w * 64 + s0 + 4), ds0 = *(const LAS f32x4*)(DT + w * 64 + s0), ds1 = *(const LAS f32x4*)(DT + w * 64 + s0 + 4);
        const float cs[8] = {cs0.x, cs0.y, cs0.z, cs0.w, cs1.x, cs1.y, cs1.z, cs1.w}, ds[8] = {ds0.x, ds0.y, ds0.z, ds0.w, ds1.x, ds1.y, ds1.z, ds1.w};
#pragma unroll
        for (int tf = 0; tf < 4; ++tf) { if (32 * ks > 16 * tf + 15) continue;
            const int t = 16 * tf + r; const v4u cb8 = *(const LAS v4u*)(CB + t * ATT_ST + s0 * 2); float l[8];
#pragma unroll
            for (int e = 0; e < 8; ++e) { const unsigned wd = cb8[e >> 1]; const float cbv = (e & 1) ? bfhi(wd) : bflo(wd); l[e] = (s0 + e <= t) ? cbv * __expf(ct[tf] - cs[e]) * ds[e] : 0.f; }
            const v4u lp = (v4u){pk2(l[0], l[1]), pk2(l[2], l[3]), pk2(l[4], l[5]), pk2(l[6], l[7])}; const bf16x8v bl = __builtin_bit_cast(bf16x8v, lp);
#pragma unroll
            for (int pf = 0; pf < 4; ++pf) acc[pf][tf] = MFMA16(ax[pf], bl, acc[pf][tf]); } }
    const float Dh = F.ssd_D[hd];
#pragma unroll
    for (int tf = 0; tf < 4; ++tf) { const int t = 16 * tf + r; const size_t row = (size_t)(row0 + t); float ss = 0.f;
#pragma unroll
        for (int pf = 0; pf < 4; ++pf) { const int p4 = 64 * w + 16 * pf + 4 * q;
            const v2u xv = *(const LAS v2u*)(X + t * X_ST + p4 * 2); const v2u zv = *(const v2u*)(F.PROJ + row * NP + CZ + g * 512 + p4);
            f32x4 y = acc[pf][tf];
            y.x = (y.x + Dh * bflo(xv.x)) * silu_f(bflo(zv.x)); y.y = (y.y + Dh * bfhi(xv.x)) * silu_f(bfhi(zv.x)); y.z = (y.z + Dh * bflo(xv.y)) * silu_f(bflo(zv.y)); y.w = (y.w + Dh * bfhi(xv.y)) * silu_f(bfhi(zv.y));
            acc[pf][tf] = y; ss += (y.x * y.x + y.y * y.y) + (y.z * y.z + y.w * y.w); }
        ss += __shfl_xor(ss, 16); ss += __shfl_xor(ss, 32);
        if (q == 0) red[w * 64 + t] = ss; }
    __syncthreads();
#pragma unroll
    for (int tf = 0; tf < 4; ++tf) { const int t = 16 * tf + r; const size_t row = (size_t)(row0 + t); float tot = 0.f;
#pragma unroll
        for (int ww = 0; ww < 8; ++ww) tot += red[ww * 64 + t];
        const float rr = rsqrtf(tot * (1.f / 512.f) + EPS);
#pragma unroll
        for (int pf = 0; pf < 4; ++pf) { const int p4 = g * 512 + 64 * w + 16 * pf + 4 * q; const f32x4 nw = *(const f32x4*)(F.ssd_norm + p4);
            f32x4 o = acc[pf][tf]; o.x *= rr * nw.x; o.y *= rr * nw.y; o.z *= rr * nw.z; o.w *= rr * nw.w;
            *(v2u*)(F.MIXIN + row * DM + 1024 + p4) = pk4(o); } }
    __syncthreads();
}

constexpr int ATT8_ST = 80;
__device__ __forceinline__ void gla_sample_unit(Frame& F, int b, int h, f32x4 (&S)[16], int nb, int nh, bool has_next) {
    const int tid = F.tid, w = F.wave, lane = F.lane, r = lane & 15, q = lane >> 4, row0 = MP + b * SL;
    LAS unsigned char* S0b = F.lds;
    LAS unsigned char* Vt = S0b + 128 * V_ST;
    LAS unsigned char* QE = Vt + 32 * V_ST;
    LAS unsigned char* KE = QE + 16 * QE_ST;
    LAS unsigned char* ATT = KE + 16 * QE_ST;
    LAS float* KD = (LAS float*)(ATT + 16 * ATT8_ST);
    LAS float* EL = KD + 1024;
    LAS float* red = EL + 128;
    f32x4 Vf[8];
#pragma unroll
    for (int s = 0; s < 8; ++s) { const v2u vv = *(const v2u*)(F.PROJ + (size_t)(row0 + s) * NP + CV + h * GV + 4 * lane); Vf[s] = (f32x4){bflo(vv.x), bfhi(vv.x), bflo(vv.y), bfhi(vv.y)}; }
    if (tid < 256) { const int t = tid >> 5, c16 = tid & 31; *(LAS v4u*)(Vt + t * V_ST + c16 * 16) = *(const v4u*)(F.PROJ + (size_t)(row0 + t) * NP + CV + h * GV + c16 * 8); }
    for (int i = tid; i < 24 * 32; i += NTHR) *(LAS v4u*)(Vt + (8 + (i >> 5)) * V_ST + (i & 31) * 16) = (v4u){0u, 0u, 0u, 0u};
    { LAS unsigned char* KR = (LAS unsigned char*)(red + 128); LAS unsigned char* QR = KR + 8 * 256; LAS float* LR = (LAS float*)(QR + 8 * 256); LAS float* LG = LR + 128;
        if (tid < 256) { const int which = tid >> 7, j = tid & 127, t = j >> 4, c16 = j & 15;
            *(LAS v4u*)((which ? QR : KR) + t * 256 + c16 * 16) = *(const v4u*)(F.PROJ + (size_t)(row0 + t) * NP + (which ? CQ : CK) + h * GK + c16 * 8); }
        else if (tid < 288) { const int j = tid - 256; *(LAS v4u*)(LR + (j >> 2) * 16 + (j & 3) * 4) = *(const v4u*)(F.LRDT + (size_t)(row0 + (j >> 2)) * 32 + (j & 3) * 4); }
        __syncthreads();
        { const int k = tid & 127, tp = tid >> 7, hk = h * GK + k; const float bg = F.b_gate[hk];
            float w2[16];
#pragma unroll
            for (int j = 0; j < 16; ++j) w2[j] = F.w_gate2[j * GKD + hk];
#pragma unroll
            for (int tt = 0; tt < 2; ++tt) { const int t = 2 * tp + tt; const LAS f32x4* lr = (const LAS f32x4*)(LR + t * 16); const f32x4 a = lr[0], bq = lr[1], c = lr[2], d = lr[3];
                const float x = bg + a.x * w2[0] + a.y * w2[1] + a.z * w2[2] + a.w * w2[3] + bq.x * w2[4] + bq.y * w2[5] + bq.z * w2[6] + bq.w * w2[7]
                              + c.x * w2[8] + c.y * w2[9] + c.z * w2[10] + c.w * w2[11] + d.x * w2[12] + d.y * w2[13] + d.z * w2[14] + d.w * w2[15];
                LG[t * 128 + k] = logsigmoid_f(x) * (1.f / 16.f); } }
        __syncthreads();
        if (tid < 128) { const int k = tid;
            float bcum[8], kv[8]; float run = 0.f;
#pragma unroll
            for (int t = 0; t < 8; ++t) { run += LG[t * 128 + k]; bcum[t] = run; kv[t] = bf2f(*(const LAS bf16*)(KR + t * 256 + k * 2));
                *(LAS bf16*)(QE + t * QE_ST + k * 2) = (bf16)f2bf(bf2f(*(const LAS bf16*)(QR + t * 256 + k * 2)) * 0.08838834764831845f * __expf(run));
                *(LAS bf16*)(KE + t * QE_ST + k * 2) = (bf16)f2bf(kv[t] * __expf(-run)); }
            f32x4 d0, d1; d0.x = kv[0] * __expf(run - bcum[0]); d0.y = kv[1] * __expf(run - bcum[1]); d0.z = kv[2] * __expf(run - bcum[2]); d0.w = kv[3] * __expf(run - bcum[3]);
            d1.x = kv[4] * __expf(run - bcum[4]); d1.y = kv[5] * __expf(run - bcum[5]); d1.z = kv[6] * __expf(run - bcum[6]); d1.w = kv[7];
            *(LAS f32x4*)(KD + k * 8) = d0; *(LAS f32x4*)(KD + k * 8 + 4) = d1; EL[k] = __expf(run); } }
    if (tid < 128) {
    } else if (tid < 384) { const int i = tid - 128, which = i >> 7, j = i & 127;
        *(LAS v4u*)((which ? KE : QE) + (8 + (j >> 4)) * QE_ST + (j & 15) * 16) = (v4u){0u, 0u, 0u, 0u};
    } else if (tid < 384 + 80) { *(LAS v4u*)(ATT + (tid - 384) * 16) = (v4u){0u, 0u, 0u, 0u}; }
#pragma unroll
    for (int i = 0; i < 16; ++i) *(LAS v2u*)(S0b + (16 * w + i) * V_ST + lane * 8) = pk4(S[i]);
    __syncthreads();
    if (w == 0) { f32x4 a4 = (f32x4){0.f, 0.f, 0.f, 0.f};
#pragma unroll
        for (int ks = 0; ks < 4; ++ks) a4 = MFMA16(frag_k(KE, QE_ST, 0, 32 * ks, r, q), frag_k(QE, QE_ST, 0, 32 * ks, r, q), a4);
        const int s0i = 4 * q; f32x4 m; m.x = (s0i <= r) ? a4.x : 0.f; m.y = (s0i + 1 <= r) ? a4.y : 0.f; m.z = (s0i + 2 <= r) ? a4.z : 0.f; m.w = (s0i + 3 <= r) ? a4.w : 0.f;
        if (r >= 8) m = (f32x4){0.f, 0.f, 0.f, 0.f};
        *(LAS v2u*)(ATT + r * ATT8_ST + s0i * 2) = pk4(m); }
    { f32x4* so = (f32x4*)(F.out + O_GLA_S + ((size_t)(b * GH + h) * GK + 16 * w) * GV) + lane;
#pragma unroll
        for (int i = 0; i < 16; ++i) { const int k = 16 * w + i; const float e = EL[k]; const f32x4 k0 = *(const LAS f32x4*)(KD + k * 8), k1 = *(const LAS f32x4*)(KD + k * 8 + 4);
            f32x4 n = S[i] * e; n = n + Vf[0] * k0.x; n = n + Vf[1] * k0.y; n = n + Vf[2] * k0.z; n = n + Vf[3] * k0.w; n = n + Vf[4] * k1.x; n = n + Vf[5] * k1.y; n = n + Vf[6] * k1.z; n = n + Vf[7] * k1.w;
            so[i * 64] = n; } }
    if (has_next) { const f32x4* s1 = (const f32x4*)(F.st_gla + ((size_t)(nb * GH + nh) * GK + 16 * w) * GV) + lane;
#pragma unroll
        for (int i = 0; i < 16; ++i) S[i] = s1[i * 64]; }
    f32x4 acc[2] = {(f32x4){0.f, 0.f, 0.f, 0.f}, (f32x4){0.f, 0.f, 0.f, 0.f}};
#pragma unroll
    for (int ks = 0; ks < 4; ++ks) { const bf16x8v bq = frag_k(QE, QE_ST, 0, 32 * ks, r, q);
#pragma unroll
        for (int vf = 0; vf < 2; ++vf) acc[vf] = MFMA16(frag_t(S0b, V_ST, 32 * ks, 32 * w + 16 * vf, r, q), bq, acc[vf]); }
    __syncthreads();
    { const bf16x8v ba = *(const LAS bf16x8v*)(ATT + r * ATT8_ST + 16 * q);
#pragma unroll
        for (int vf = 0; vf < 2; ++vf) acc[vf] = MFMA16(frag_t(Vt, V_ST, 0, 32 * w + 16 * vf, r, q), ba, acc[vf]); }
    float ss = (acc[0].x * acc[0].x + acc[0].y * acc[0].y) + (acc[0].z * acc[0].z + acc[0].w * acc[0].w) + (acc[1].x * acc[1].x + acc[1].y * acc[1].y) + (acc[1].z * acc[1].z + acc[1].w * acc[1].w);
    ss += __shfl_xor(ss, 16); ss += __shfl_xor(ss, 32);
    if (q == 0) red[w * 16 + r] = ss;
    __syncthreads();
    float tot = 0.f;
#pragma unroll
    for (int ww = 0; ww < 8; ++ww) tot += red[ww * 16 + r];
    const float rr = rsqrtf(tot * (1.f / GV) + EPS);
    if (r < 8) { const size_t row = (size_t)(row0 + r);
#pragma unroll
        for (int vf = 0; vf < 2; ++vf) { const int v = 32 * w + 16 * vf + 4 * q;
            const v2u gw = *(const v2u*)(F.PROJ + row * NP + CG + h * GV + v); const f32x4 nw = *(const f32x4*)(F.gla_norm + v);
            f32x4 o; o.x = acc[vf].x * rr * nw.x * silu_f(bflo(gw.x)); o.y = acc[vf].y * rr * nw.y * silu_f(bfhi(gw.x)); o.z = acc[vf].z * rr * nw.z * silu_f(bflo(gw.y)); o.w = acc[vf].w * rr * nw.w * silu_f(bfhi(gw.y));
            *(v2u*)(F.MIXIN + row * DM + h * GV + v) = pk4(o); } }
    __syncthreads();
}
__device__ __forceinline__ void ssd_sample_unit(Frame& F, int b, int g) {
    const int tid = F.tid, w = F.wave, lane = F.lane, r = lane & 15, q = lane >> 4, row0 = MP + b * SL, hd = g * 8 + w, ch = g * 512 + tid;
    LAS float* Xs = (LAS float*)F.lds;
    LAS float* XW = Xs + 4096;
    LAS float* Bs = XW + 4096;
    LAS unsigned char* Cb = (LAS unsigned char*)(Bs + 1024);
    LAS unsigned char* Bb = Cb + 16 * QE_ST;
    LAS float* CBm = (LAS float*)(Bb + 16 * QE_ST);
    LAS float* CD = CBm + 256;
    LAS float* red = CD + 128;
    const float* h0base = F.st_ssd + ((size_t)(b * SH + hd) * SP) * SN; float* hobase = F.out + O_SSD_S + ((size_t)(b * SH + hd) * SP) * SN;
    f32x4 hbuf[4][2];
#pragma unroll
    for (int i = 0; i < 4; ++i) { const size_t off = (size_t)(16 * (i & 3) + r) * SN + 32 * (i >> 2) + 8 * q; hbuf[i][0] = *(const f32x4*)(h0base + off); hbuf[i][1] = *(const f32x4*)(h0base + off + 4); }
    float dt[8], cum[8]; { const float A = -__expf(F.A_log[hd]), dtb = F.dt_bias[hd]; float run = 0.f;
#pragma unroll
        for (int t = 0; t < 8; ++t) { dt[t] = softplus_f(F.LRDT[(size_t)(row0 + t) * 32 + 16 + hd] + dtb); run += dt[t] * A; cum[t] = run; } }
    const float last = cum[7], elast = __expf(last);
    if (lane < 8) { float cv = cum[0], dv = dt[0];
#pragma unroll
        for (int t = 1; t < 8; ++t) { cv = (lane == t) ? cum[t] : cv; dv = (lane == t) ? dt[t] : dv; }
        CD[w * 16 + lane] = cv; CD[w * 16 + 8 + lane] = dv; }
    { float xr[11]; const float cb = F.sconv_b[ch], c0 = F.sconv_w[ch], c1 = F.sconv_w[SCH + ch], c2 = F.sconv_w[2 * SCH + ch], c3 = F.sconv_w[3 * SCH + ch];
#pragma unroll
        for (int i = 0; i < 11; ++i) xr[i] = xbc_raw(F, 1, b, row0, i - 3, ch);
        float xw[8];
#pragma unroll
        for (int t = 0; t < 8; ++t) { const float x = silu_f(cb + c0 * xr[t] + c1 * xr[t + 1] + c2 * xr[t + 2] + c3 * xr[t + 3]); Xs[t * 512 + tid] = x; xw[t] = x * __expf(last - cum[t]) * dt[t]; }
        *(LAS f32x4*)(XW + tid * 8) = (f32x4){xw[0], xw[1], xw[2], xw[3]}; *(LAS f32x4*)(XW + tid * 8 + 4) = (f32x4){xw[4], xw[5], xw[6], xw[7]}; }
    if (tid < 256) { const int n = tid & 127, isC = tid >> 7, cc = 1024 + isC * 256 + g * 128 + n;
        float xr[11]; const float cb = F.sconv_b[cc], c0 = F.sconv_w[cc], c1 = F.sconv_w[SCH + cc], c2 = F.sconv_w[2 * SCH + cc], c3 = F.sconv_w[3 * SCH + cc];
#pragma unroll
        for (int i = 0; i < 11; ++i) xr[i] = xbc_raw(F, 1, b, row0, i - 3, cc);
#pragma unroll
        for (int t = 0; t < 8; ++t) { const float x = silu_f(cb + c0 * xr[t] + c1 * xr[t + 1] + c2 * xr[t + 2] + c3 * xr[t + 3]);
            if (!isC) Bs[t * 128 + n] = x;
            *(LAS bf16*)((isC ? Cb : Bb) + t * QE_ST + n * 2) = (bf16)f2bf(x); }
    } else { const int i = tid - 256, which = i >> 7, j = i & 127; *(LAS v4u*)((which ? Bb : Cb) + (8 + (j >> 4)) * QE_ST + (j & 15) * 16) = (v4u){0u, 0u, 0u, 0u}; }
    __syncthreads();
    if (w == 0) { f32x4 a4 = (f32x4){0.f, 0.f, 0.f, 0.f};
#pragma unroll
        for (int ks = 0; ks < 4; ++ks) a4 = MFMA16(frag_k(Bb, QE_ST, 0, 32 * ks, r, q), frag_k(Cb, QE_ST, 0, 32 * ks, r, q), a4);
        *(LAS f32x4*)(CBm + r * 16 + 4 * q) = a4; }
    bf16x8v bc[4];
#pragma unroll
    for (int ks = 0; ks < 4; ++ks) bc[ks] = frag_k(Cb, QE_ST, 0, 32 * ks, r, q);
    f32x4 acc[4];
#pragma unroll
    for (int pf = 0; pf < 4; ++pf) acc[pf] = (f32x4){0.f, 0.f, 0.f, 0.f};
    f32x4 Bv[8][2];
#pragma unroll
    for (int st = 0; st < 16; ++st) { const int ks = st >> 2, pf = st & 3;
        if (pf == 0) {
#pragma unroll
            for (int s = 0; s < 8; ++s) { Bv[s][0] = *(const LAS f32x4*)(Bs + s * 128 + 32 * ks + 8 * q); Bv[s][1] = *(const LAS f32x4*)(Bs + s * 128 + 32 * ks + 8 * q + 4); } }
        const int p = 16 * pf + r; const size_t off = (size_t)p * SN + 32 * ks + 8 * q;
        const f32x4 ha = hbuf[st & 3][0], hb = hbuf[st & 3][1];
        if (st + 4 < 16) { const int st2 = st + 4; const size_t off2 = (size_t)(16 * (st2 & 3) + r) * SN + 32 * (st2 >> 2) + 8 * q; hbuf[st & 3][0] = *(const f32x4*)(h0base + off2); hbuf[st & 3][1] = *(const f32x4*)(h0base + off2 + 4); }
        asm volatile("" ::: "memory");
        const f32x4 x0 = *(const LAS f32x4*)(XW + (64 * w + p) * 8), x1 = *(const LAS f32x4*)(XW + (64 * w + p) * 8 + 4);
        f32x4 na = ha * elast, nb = hb * elast;
        na = na + Bv[0][0] * x0.x; nb = nb + Bv[0][1] * x0.x; na = na + Bv[1][0] * x0.y; nb = nb + Bv[1][1] * x0.y; na = na + Bv[2][0] * x0.z; nb = nb + Bv[2][1] * x0.z; na = na + Bv[3][0] * x0.w; nb = nb + Bv[3][1] * x0.w;
        na = na + Bv[4][0] * x1.x; nb = nb + Bv[4][1] * x1.x; na = na + Bv[5][0] * x1.y; nb = nb + Bv[5][1] * x1.y; na = na + Bv[6][0] * x1.z; nb = nb + Bv[6][1] * x1.z; na = na + Bv[7][0] * x1.w; nb = nb + Bv[7][1] * x1.w;
        *(f32x4*)(hobase + off) = na; *(f32x4*)(hobase + off + 4) = nb;
        const v4u ap = (v4u){pk2(ha.x, ha.y), pk2(ha.z, ha.w), pk2(hb.x, hb.y), pk2(hb.z, hb.w)};
        acc[pf] = MFMA16(__builtin_bit_cast(bf16x8v, ap), bc[ks], acc[pf]); }
    __syncthreads();
    const int tc = r & 7; const float ct = CD[w * 16 + tc], ect = __expf(ct), Dh = F.ssd_D[hd];
    float L[8]; { const f32x4 c0 = *(const LAS f32x4*)(CBm + r * 16), c1 = *(const LAS f32x4*)(CBm + r * 16 + 4); const float cbv[8] = {c0.x, c0.y, c0.z, c0.w, c1.x, c1.y, c1.z, c1.w};
        const f32x4 q0 = *(const LAS f32x4*)(CD + w * 16), q1 = *(const LAS f32x4*)(CD + w * 16 + 4), d0 = *(const LAS f32x4*)(CD + w * 16 + 8), d1 = *(const LAS f32x4*)(CD + w * 16 + 12);
        const float cu[8] = {q0.x, q0.y, q0.z, q0.w, q1.x, q1.y, q1.z, q1.w}, dd[8] = {d0.x, d0.y, d0.z, d0.w, d1.x, d1.y, d1.z, d1.w};
#pragma unroll
        for (int s = 0; s < 8; ++s) L[s] = (s <= tc) ? cbv[s] * __expf(ct - cu[s]) * dd[s] : 0.f; }
    float ss = 0.f; const size_t row = (size_t)(row0 + tc);
#pragma unroll
    for (int pf = 0; pf < 4; ++pf) { const int p4 = 64 * w + 16 * pf + 4 * q;
        f32x4 y = acc[pf] * ect;
#pragma unroll
        for (int s = 0; s < 8; ++s) y = y + *(const LAS f32x4*)(Xs + s * 512 + p4) * L[s];
        const f32x4 xt = *(const LAS f32x4*)(Xs + tc * 512 + p4); const v2u zv = *(const v2u*)(F.PROJ + row * NP + CZ + g * 512 + p4);
        y.x = (y.x + Dh * xt.x) * silu_f(bflo(zv.x)); y.y = (y.y + Dh * xt.y) * silu_f(bfhi(zv.x)); y.z = (y.z + Dh * xt.z) * silu_f(bflo(zv.y)); y.w = (y.w + Dh * xt.w) * silu_f(bfhi(zv.y));
        acc[pf] = y; ss += (y.x * y.x + y.y * y.y) + (y.z * y.z + y.w * y.w); }
    ss += __shfl_xor(ss, 16); ss += __shfl_xor(ss, 32);
    if (q == 0) red[w * 16 + r] = ss;
    __syncthreads();
    float tot = 0.f;
#pragma unroll
    for (int ww = 0; ww < 8; ++ww) tot += red[ww * 16 + r];
    const float rr = rsqrtf(tot * (1.f / 512.f) + EPS);
    if (r < 8) {
#pragma unroll
        for (int pf = 0; pf < 4; ++pf) { const int p4 = g * 512 + 64 * w + 16 * pf + 4 * q; const f32x4 nw = *(const f32x4*)(F.ssd_norm + p4);
            f32x4 o = acc[pf]; o.x *= rr * nw.x; o.y *= rr * nw.y; o.z *= rr * nw.z; o.w *= rr * nw.w;
            *(v2u*)(F.MIXIN + row * DM + 1024 + p4) = pk4(o); } }
    __syncthreads();
}

__device__ __forceinline__ void p2a_chunk_states(Frame& F) {
    for (int idx = F.bid; idx < 768; idx += F.G) { if (idx < 256) { TBEGIN(F, 20); ssd_passA_unit(F, idx); TEND(F, 20); } else { TBEGIN(F, 21); gla_passA_unit(F, idx - 256); TEND(F, 21); } }
}
#ifndef MK_REP_PHASE
#define MK_REP_PHASE (-1)
#endif
__device__ __forceinline__ void p2b_scans_and_sample(Frame& F) {
    TBEGIN(F, 30); for (int rep = 0; rep < (MK_REP_PHASE == 30 ? 2 : 1); ++rep) { gla_scan(F); ssd_scan(F); } TEND(F, 30);
    TBEGIN(F, 31);
    for (int rep = 0; rep < (MK_REP_PHASE == 31 ? 2 : 1); ++rep)
    { f32x4 S[16]; int idx = F.bid;
            if (idx < SB * GH) { const f32x4* s0 = (const f32x4*)(F.st_gla + ((size_t)idx * GK + 16 * F.wave) * GV) + F.lane;
#pragma unroll
                for (int i = 0; i < 16; ++i) S[i] = s0[i * 64]; }
            for (; idx < SB * GH; idx += F.G) { const int nx = idx + F.G; gla_sample_unit(F, idx / GH, idx % GH, S, nx / GH, nx % GH, nx < SB * GH); } }
    TEND(F, 31); TBEGIN(F, 32);
    for (int rep = 0; rep < (MK_REP_PHASE == 32 ? 2 : 1); ++rep)
        for (int idx = F.bid; idx < SB * SG; idx += F.G) ssd_sample_unit(F, idx / SG, idx % SG);
    TEND(F, 32);
}
__device__ __forceinline__ void p2c_outputs(Frame& F) {
    for (int idx = F.bid; idx < 768; idx += F.G) { if (idx < 256) { TBEGIN(F, 40); ssd_passC_unit(F, idx); TEND(F, 40); } else { TBEGIN(F, 41); gla_passC_unit(F, idx - 256); TEND(F, 41); } }
    TBEGIN(F, 42);
    const int gt = F.bid * NTHR + F.tid, NT = F.G * NTHR;
    for (int i = gt; i < (PB + SB) * 3 * SCH; i += NT) { const int c = i % SCH, j = (i / SCH) % 3, s = i / (3 * SCH);
        const int grp = s >= PB, b = grp ? s - PB : s, L = grp ? SL : PL, row0 = grp ? MP + b * SL : b * PL;
        F.out[(grp ? O_SCONV_S : O_SCONV_P) + ((size_t)b * 3 + j) * SCH + c] = bf2f(F.PROJ[(size_t)(row0 + L - 3 + j) * NP + CX + c]); }
    TEND(F, 42);
}

__device__ __forceinline__ void p4_post_mixer(Frame& F) {
    const int gw = F.bid * NWAVES + F.wave, NGW = F.G * NWAVES, lane = F.lane;
    for (int m = gw; m < M; m += NGW) {
        const v2u* mr = (const v2u*)((const bf16*)F.MIX + (size_t)m * DM) + lane; const f32x4* xr = (const f32x4*)x_row(F, m) + lane;
        const f32x4* w1 = (const f32x4*)F.n_mix_post + lane; const f32x4* w2 = (const f32x4*)F.n_ffn_pre + lane;
        f32x4 v[8]; float s = 0.f;
#pragma unroll
        for (int j = 0; j < 8; ++j) { const v2u p = mr[64 * j]; v[j] = (f32x4){bflo(p.x), bfhi(p.x), bflo(p.y), bfhi(p.y)}; s += (v[j].x * v[j].x + v[j].y * v[j].y) + (v[j].z * v[j].z + v[j].w * v[j].w); }
        const float r1 = rsqrtf(wave_sum(s) * (1.f / DM) + EPS); float s2 = 0.f;
        f32x4* ho = (f32x4*)(F.out + O_Y + (size_t)m * DM) + lane;
#pragma unroll
        for (int j = 0; j < 8; ++j) { v[j] = xr[64 * j] + v[j] * r1 * w1[64 * j]; ho[64 * j] = v[j]; s2 += (v[j].x * v[j].x + v[j].y * v[j].y) + (v[j].z * v[j].z + v[j].w * v[j].w); }
        const float r2 = rsqrtf(wave_sum(s2) * (1.f / DM) + EPS);
        v2u* o8 = (v2u*)(F.XN + (size_t)m * DM) + lane;
#pragma unroll
        for (int j = 0; j < 8; ++j) { const f32x4 ww = w2[64 * j]; v2u o; o.x = pk2(v[j].x * r2 * ww.x, v[j].y * r2 * ww.y); o.y = pk2(v[j].z * r2 * ww.z, v[j].w * r2 * ww.w); o8[64 * j] = o; }
    }
}
__device__ __forceinline__ void p6_conv_fixup(Frame& F) {
    const int gt = F.bid * NTHR + F.tid, NT = F.G * NTHR;
    constexpr int NQ = FF / 4;
    for (int it = gt; it < 28 * 2 * NQ; it += NT) { const int c = (it % NQ) * 4, rr = (it / NQ) & 1, bi = it / (2 * NQ), pm = (bi / 7) * 8 + 1 + (bi % 7);
        f32x4 o[2];
#pragma unroll
        for (int hf = 0; hf < 2; ++hf) { const int cc = hf * FF + c;
            const f32x4 w0 = *(const f32x4*)(F.fconv_w + cc), w1 = *(const f32x4*)(F.fconv_w + FF2 + cc), w2 = *(const f32x4*)(F.fconv_w + 2 * FF2 + cc), bs = *(const f32x4*)(F.fconv_b + cc);
            const f32x4 um2 = *(const f32x4*)(F.HG + ((size_t)(pm - 1) * 4 + 2 + rr) * FF2 + cc);
            const f32x4 um1 = rr ? *(const f32x4*)(F.HG + ((size_t)pm * 4) * FF2 + cc) : *(const f32x4*)(F.HG + ((size_t)(pm - 1) * 4 + 3) * FF2 + cc);
            const f32x4 u0 = *(const f32x4*)(F.HG + ((size_t)pm * 4 + rr) * FF2 + cc);
            o[hf] = bs + w0 * um2 + w1 * um1 + w2 * u0; }
        v2u pk; pk.x = pk2(silu_f(o[0].x) * o[1].x, silu_f(o[0].y) * o[1].y); pk.y = pk2(silu_f(o[0].z) * o[1].z, silu_f(o[0].w) * o[1].w);
        *(v2u*)(F.ACT + (size_t)(pm * 256 + rr) * FF + c) = pk; }
    for (int i = gt; i < PB * 2 * (FF2 / 4); i += NT) { const int c = (i % (FF2 / 4)) * 4, j = (i / (FF2 / 4)) & 1, b = i / (2 * (FF2 / 4));
        *(f32x4*)(F.out + O_FCONV_P + ((size_t)b * 2 + j) * FF2 + c) = *(const f32x4*)(F.HG + ((size_t)(b * 8 + 7) * 4 + 2 + j) * FF2 + c); }
}
__device__ __forceinline__ void p8_final(Frame& F) {
    const int gw = F.bid * NWAVES + F.wave, NGW = F.G * NWAVES, lane = F.lane;
    for (int m = gw; m < M; m += NGW) {
        const v2u* fr = (const v2u*)((const bf16*)F.Fb + (size_t)m * DM) + lane; const f32x4* w1 = (const f32x4*)F.n_ffn_post + lane;
        f32x4* ho = (f32x4*)(F.out + O_Y + (size_t)m * DM) + lane;
        f32x4 v[8]; float s = 0.f;
#pragma unroll
        for (int j = 0; j < 8; ++j) { const v2u p = fr[64 * j]; v[j] = (f32x4){bflo(p.x), bfhi(p.x), bflo(p.y), bfhi(p.y)}; s += (v[j].x * v[j].x + v[j].y * v[j].y) + (v[j].z * v[j].z + v[j].w * v[j].w); }
        const float r1 = rsqrtf(wave_sum(s) * (1.f / DM) + EPS);
#pragma unroll
        for (int j = 0; j < 8; ++j) ho[64 * j] = ho[64 * j] + v[j] * r1 * w1[64 * j];
    }
}

__device__ __forceinline__ pg8::SplitCtx split_ctx(const Frame& F, unsigned char* ws, size_t slab_off, int bank) {
    pg8::SplitCtx X; X.slabs = (pg8::f32x4*)(ws + slab_off); X.cnt = (unsigned*)(ws + WS_CTL) + CW_SPLIT + bank * 1024; X.flag = (volatile LAS unsigned*)(F.lds + MISC_OFF) + 16; X.id = bank; return X; }

struct Args { const float* in[25]; float* out; unsigned char* ws; int ph_lo, ph_hi; };
__global__ void __launch_bounds__(NTHR, 2) fwd_kernel(Args args) {
    extern __shared__ __attribute__((aligned(16))) unsigned char lds[];
    Frame F;
    F.lds = (LAS unsigned char*)lds;
    F.tid = threadIdx.x; F.lane = F.tid & 63; F.wave = __builtin_amdgcn_readfirstlane(F.tid >> 6);
    F.G = gridDim.x; F.bid = blockIdx.x;
    unsigned char* ws = args.ws;
    F.x_p = args.in[0]; F.x_s = args.in[1]; F.st_gla = args.in[2]; F.st_ssd = args.in[3]; F.st_sconv = args.in[4]; F.st_fconv = args.in[5];
    F.n_mix_pre = args.in[6]; F.n_mix_post = args.in[7]; F.n_ffn_pre = args.in[8]; F.n_ffn_post = args.in[9]; F.w_in = args.in[10];
    F.w_gate2 = args.in[11]; F.b_gate = args.in[12]; F.gla_norm = args.in[13]; F.sconv_w = args.in[14]; F.sconv_b = args.in[15];
    F.dt_bias = args.in[16]; F.A_log = args.in[17]; F.ssd_D = args.in[18]; F.ssd_norm = args.in[19]; F.w_out = args.in[20];
    F.ffn_w_in = args.in[21]; F.fconv_w = args.in[22]; F.fconv_b = args.in[23]; F.ffn_w_out = args.in[24];
    F.out = args.out;
    F.W1 = (bf16*)(ws + WS_W1); F.WO = (bf16*)(ws + WS_WO); F.WF1 = (bf16*)(ws + WS_WF1); F.WF2 = (bf16*)(ws + WS_WF2);
    F.XN = (bf16*)(ws + WS_XN); F.PROJ = (bf16*)(ws + WS_PROJ); F.MIXIN = (bf16*)(ws + WS_MIXIN); F.ACT = (bf16*)(ws + WS_ACT); F.HG = (float*)(ws + WS_HG);
    F.LRDT = (float*)(ws + WS_LRDT); F.MIX = (float*)(ws + WS_MIX); F.Fb = (float*)(ws + WS_F);
    F.DS = (bf16*)(ws + WS_DS); F.SC = (bf16*)(ws + WS_SC); F.DH = (bf16*)(ws + WS_DH); F.HC = (bf16*)(ws + WS_HC); F.EBL = (float*)(ws + WS_EBL); F.AL = (float*)(ws + WS_AL); F.QEg = (bf16*)(ws + WS_QEG); F.KEg = (bf16*)(ws + WS_KEG);
    for (int u = F.tid; u < (LDS_BYTES - LDSCTL_OFF) / 4; u += NTHR) ((LAS unsigned*)(F.lds + LDSCTL_OFF))[u] = 0u;
    __syncthreads();
    const int lo = args.ph_lo, hi = args.ph_hi;
#if !MK_PER_PHASE
    XcdBarrier bar = xcd_barrier_post((unsigned*)(ws + WS_CTL) + CW_BAR, (volatile LAS unsigned*)(F.lds + MISC_OFF) + 8);
#define GRID_BAR() do { if (args.ph_hi > 1000) cg::this_grid().sync(); xcd_barrier(bar); } while (0)
#else
#define GRID_BAR() do { } while (0)
#endif
#define IN(k) (lo <= (k) && (k) < hi)
#define SEAM(k) do { if (IN(k) && IN((k) + 1)) GRID_BAR(); } while (0)
    F.tacc = 0; F.tmark = 0;
#define PHASE(k, ...) do { if (IN(k)) { TBEGIN(F, k); if (MK_REP_PHASE == (k)) { __VA_ARGS__; GRID_BAR(); } TBEGIN(F, 100 + (k)); __VA_ARGS__; TEND(F, 100 + (k)); SEAM(k); TEND(F, k); } } while (0)
    PHASE(0, p0_prologue(F));
    PHASE(1, { pg8::Gemm g{F.XN, F.W1, M, N1, DM}; pg8::StaticOrder S; S.init(M, N1, DM, F.G, F.bid, 1);
        pg8::EpiBf16 E{F.PROJ, NP, NP / 256, F.LRDT};
        pg8::gemm_phase<pg8::EpiBf16, pg8::StaticOrder, true, true>(F.lds, g, S, E, split_ctx(F, ws, WS_SLAB, 0));
        if (S.rem && F.bid >= S.rem * S.S) p0_convert_rest(F, F.bid - S.rem * S.S, F.G - S.rem * S.S); else if (!S.rem) p0_convert_rest(F, F.bid, F.G); });
    PHASE(2, p2a_chunk_states(F));
    PHASE(3, p2b_scans_and_sample(F));
    PHASE(4, p2c_outputs(F));
    PHASE(5, { pg8::Gemm g{F.MIXIN, F.WO, M, DM, DM}; pg8::StaticOrder S; S.init(M, DM, DM, F.G, F.bid, 4);
        pg8::EpiBf16 E{(bf16*)F.MIX, DM, DM / 256, nullptr};
        pg8::gemm_phase<pg8::EpiBf16, pg8::StaticOrder, true, true>(F.lds, g, S, E, split_ctx(F, ws, WS_SLAB, 1)); });
    PHASE(6, p4_post_mixer(F));
    PHASE(7, { pg8::Gemm g{F.XN, F.WF1, M, FF2, DM}; pg8::StaticOrder S; S.init(M, FF2, DM, F.G, F.bid, 1, MS / 256);
        pg8::EpiConvAct E{F.ACT, F.HG, F.fconv_w, F.fconv_b, F.st_fconv, F.out + O_FCONV_S, (LAS float*)(F.lds + MISC_OFF + 512)};
        pg8::gemm_phase<pg8::EpiConvAct, pg8::StaticOrder, true, true>(F.lds, g, S, E, split_ctx(F, ws, WS_SLAB, 2));
        if (S.rem && F.bid >= S.rem * S.S) t_run(F, 2, (F.bid - S.rem * S.S) * NWAVES + F.wave, (F.G - S.rem * S.S) * NWAVES); else if (!S.rem) t_run(F, 2, F.bid * NWAVES + F.wave, F.G * NWAVES); });
    PHASE(8, p6_conv_fixup(F));
    PHASE(9, { pg8::Gemm g{F.ACT, F.WF2, M, DM, FF}; pg8::StaticOrder S; S.init(M, DM, FF, F.G, F.bid, 4);
        pg8::EpiBf16 E{(bf16*)F.Fb, DM, DM / 256, nullptr};
        pg8::gemm_phase<pg8::EpiBf16, pg8::StaticOrder, true, true>(F.lds, g, S, E, split_ctx(F, ws, WS_SLAB, 3)); });
    if (IN(10)) { TBEGIN(F, 10); p8_final(F); if (MK_TIME_PHASE == 10) { asm volatile("s_waitcnt vmcnt(0)" ::: "memory"); __syncthreads(); } TEND(F, 10); }
    if (MK_TIME_PHASE >= 50 && MK_TIME_PHASE < 70) F.tacc = ((volatile LAS unsigned*)(F.lds + MISC_OFF))[16 + 2];
    if (MK_TIME_PHASE >= 0 && F.bid == 0) { const unsigned long long te = __builtin_amdgcn_s_memrealtime(), d = 8ull * F.tacc; while (__builtin_amdgcn_s_memrealtime() - te < d) __builtin_amdgcn_s_sleep(16); }
#undef IN
#undef SEAM
}

extern "C" void kernel_launch(void* const* d_in, const int* in_sizes, int n_in, void* d_out, int out_size, void* d_ws, size_t ws_size, hipStream_t stream) {
    static int grid = 0;
    if (grid == 0) {
        if (n_in != 25 || (size_t)out_size != O_END || ws_size < WS_END) { fprintf(stderr, "kernel_launch: unexpected sizes n_in %d out %d ws %zu (need out %zu ws %zu)\n", n_in, out_size, ws_size, (size_t)O_END, (size_t)WS_END); grid = -1; return; }
        int dev = 0, cus = 0, per_cu = 0;
        hipGetDevice(&dev); hipDeviceGetAttribute(&cus, hipDeviceAttributeMultiprocessorCount, dev);
        if (hipFuncSetAttribute((const void*)fwd_kernel, hipFuncAttributeMaxDynamicSharedMemorySize, LDS_BYTES) != hipSuccess) { fprintf(stderr, "kernel_launch: hipFuncSetAttribute failed\n"); grid = -1; return; }
        hipOccupancyMaxActiveBlocksPerMultiprocessor(&per_cu, (const void*)fwd_kernel, NTHR, LDS_BYTES);
        if (per_cu < 1) { fprintf(stderr, "kernel_launch: occupancy query says %d blocks per CU\n", per_cu); grid = -1; return; }
        grid = cus;
        (void)hipGetLastError();
    }
    if (grid < 0) return;
    Args a{};
    for (int i = 0; i < 25; ++i) a.in[i] = (const float*)d_in[i];
    a.out = (float*)d_out; a.ws = (unsigned char*)d_ws;
#if MK_PER_PHASE
    hipMemsetAsync((char*)d_ws + WS_CTL, 0, CTL_ZERO_BYTES, stream);
    for (int p = 0; p < N_PHASES; ++p) { a.ph_lo = p; a.ph_hi = p + 1; hipLaunchKernelGGL(fwd_kernel, dim3(grid), dim3(NTHR), LDS_BYTES, stream, a); }
#else
    hipMemsetAsync((char*)d_ws + WS_CTL, 0, CTL_ZERO_BYTES, stream);
    a.ph_lo = 0; a.ph_hi = N_PHASES;
    void* kargs[] = {&a};
    hipError_t e = hipLaunchCooperativeKernel((const void*)fwd_kernel, dim3(grid), dim3(NTHR), kargs, LDS_BYTES, stream);
    if (e != hipSuccess) fprintf(stderr, "kernel_launch: cooperative launch failed: %s (grid %d)\n", hipGetErrorString(e), grid);
#endif
}
```

```cpp
#include <hip/hip_runtime.h>
#include <hip/hip_cooperative_groups.h>
#include <cstdio>
#include <cstdint>
namespace cg = cooperative_groups;

#ifndef MK_TIME_PHASE
#define MK_TIME_PHASE (-1)
#endif
#ifndef MK_PER_PHASE
#define MK_PER_PHASE 0
#endif

namespace pg8 {
#define PG8_LAS __attribute__((address_space(3)))
typedef unsigned short bf16_t;
typedef short bf16x8 __attribute__((ext_vector_type(8)));
typedef float f32x4 __attribute__((ext_vector_type(4)));
typedef unsigned u32x4 __attribute__((ext_vector_type(4)));
constexpr int BM = 256, BK = 64, HALF = 128, HTB = HALF * BK * 2  , STAGE_BYTES = 8 * HTB, NXCD = 8, WGM = 8;

__host__ __device__ __forceinline__ int lds_byte(int r, int c) { const int st = (r >> 4) * 2 + (c >> 5), rr = r & 15, cc = c & 31, ob = rr * 64 + cc * 2; return st * 1024 + (ob ^ (((ob >> 9) & 1) << 5)); }
__host__ __device__ __forceinline__ void stage_rc(int b, int& R, int& C) { const int st = b / 1024, sb = b % 1024, swz = sb ^ (((sb >> 9) & 1) << 5); R = (st >> 1) * 16 + swz / 64; C = (st & 1) * 32 + (swz % 64) / 2; }
__host__ __device__ __forceinline__ int perm32(int rho) { const int n = rho >> 4, i = rho & 15; return 8 * (i >> 2) + 4 * n + (i & 3); }

struct Unit { int pm, pn, k0, nk, slice, nsl, tix; };
struct Gemm { const bf16_t* A; const bf16_t* Bt; int M, N, K; };

struct StaticOrder {
    int nM, nN, nwg, G, c, rounds, rem, S, ntK, nSp;
    __host__ __device__ __forceinline__ void init(int M, int N, int K, int G_, int c_, int Smax, int nSp_ = 0) { nM = M / BM; nN = N / BM; nwg = nM * nN; G = G_; c = c_; ntK = K / BK; rounds = nwg / G; rem = nwg - rounds * G; S = 1; nSp = nSp_;
        if (rem) { while (S < Smax && rem * (S * 2) <= G && (ntK / 2) >= S * 2) S *= 2; } }
    __host__ __device__ __forceinline__ void tile(int L, Unit& u) const {
        const int nfirst = nSp * nN;
        if (L < nfirst) { u.pm = nM - nSp + (L % nSp); u.pn = L / nSp; return; }
        const int nMp = nM - nSp, nwp = nMp * nN;
        int wgid = L - nfirst; { const int q = nwp / NXCD, r = nwp % NXCD, xcd = wgid % NXCD, off = wgid / NXCD; wgid = (xcd < r ? xcd * (q + 1) : r * (q + 1) + (xcd - r) * q) + off; }
        const int nig = WGM * nN, gid = wgid / nig, fm = gid * WGM, gsz = (nMp - fm) < WGM ? (nMp - fm) : WGM;
        u.pm = fm + ((wgid % nig) % gsz); u.pn = (wgid % nig) / gsz; }
    __host__ __device__ __forceinline__ bool next(int i, Unit& u) const {
        if (i < rounds) { tile(i * G + c, u); u.k0 = 0; u.nk = ntK; u.slice = 0; u.nsl = 1; u.tix = 0; return true; }
        if (i == rounds && c < rem * S) { const int tix = c % rem, sl = c / rem; tile(rounds * G + tix, u);
            const int pairs = ntK / 2, base = pairs / S, extra = pairs % S, np = base + (sl < extra ? 1 : 0), p0 = sl * base + (sl < extra ? sl : extra);
            u.k0 = 2 * p0; u.nk = 2 * np; u.slice = sl; u.nsl = S; u.tix = tix; return true; }
        return false;
    }
    __device__ __forceinline__ void a_ready(const Unit&) const {}
    __device__ __forceinline__ void done(const Unit&) const {}
};
__device__ __forceinline__ unsigned cvt_pk_bf16(float lo, float hi) { unsigned r; asm volatile("v_cvt_pk_bf16_f32 %0, %1, %2" : "=v"(r) : "v"(lo), "v"(hi)); return r; }
struct SplitCtx { f32x4* slabs; unsigned* cnt; volatile PG8_LAS unsigned* flag; int id; };
__device__ __forceinline__ int split_reduce(f32x4 (&acc)[2][2][4][2], const Unit& u, const SplitCtx& X, int tid) {
    const __amdgpu_buffer_rsrc_t rs = __builtin_amdgcn_make_buffer_rsrc((void*)X.slabs, (short)0, (int)0x7fffffff, 0x00020000);
    typedef unsigned u32x2s __attribute__((ext_vector_type(2)));
    const unsigned mine = (unsigned)((u.tix * u.nsl + u.slice) * 32) * 4096u + (unsigned)tid * 8u;
#pragma unroll
    for (int a = 0; a < 2; ++a)
#pragma unroll
        for (int b = 0; b < 2; ++b)
#pragma unroll
            for (int m = 0; m < 4; ++m)
#pragma unroll
                for (int n = 0; n < 2; ++n) { const f32x4 v = acc[a][b][m][n]; __builtin_amdgcn_raw_buffer_store_b64((u32x2s){cvt_pk_bf16(v.x, v.y), cvt_pk_bf16(v.z, v.w)}, rs, mine + (unsigned)((((a * 2 + b) * 4 + m) * 2 + n) * 4096), 0,   16); }
    asm volatile("s_waitcnt vmcnt(0)" ::: "memory");
    __syncthreads();
    if (tid == 0) {
        unsigned* c = X.cnt + 16 * u.tix;
        (void)__hip_atomic_fetch_add(c, 1u, __ATOMIC_RELAXED, __HIP_MEMORY_SCOPE_AGENT);
        unsigned spins = 0;
        while (__hip_atomic_load(c, __ATOMIC_RELAXED, __HIP_MEMORY_SCOPE_AGENT) < (unsigned)u.nsl) { __builtin_amdgcn_s_sleep(2); if (++spins > (1u << 22)) break; }
        __builtin_amdgcn_fence(__ATOMIC_ACQUIRE, "agent");
        asm volatile("s_waitcnt vmcnt(0)" ::: "memory");
    }
    __syncthreads();
    const int shift = u.nsl == 8 ? 2 : (u.nsl == 4 ? 3 : 4);
    for (int s = 0; s < u.nsl; ++s) { if (s == u.slice) continue;
        const u32x2s* o = (const u32x2s*)X.slabs + ((size_t)(u.tix * u.nsl + s) * 32) * 512 + tid;
#pragma unroll
        for (int a = 0; a < 2; ++a)
#pragma unroll
            for (int b = 0; b < 2; ++b)
#pragma unroll
                for (int m = 0; m < 4; ++m)
#pragma unroll
                    for (int n = 0; n < 2; ++n) { const int r4 = ((a * 2 + b) * 4 + m) * 2 + n; if ((r4 >> shift) == u.slice) { const u32x2s p = o[(size_t)r4 * 512]; acc[a][b][m][n] += (f32x4){__builtin_bit_cast(float, p.x << 16), __builtin_bit_cast(float, p.x & 0xffff0000u), __builtin_bit_cast(float, p.y << 16), __builtin_bit_cast(float, p.y & 0xffff0000u)}; } } }
    return shift;
}


struct EpiF32 {
    static constexpr bool PERM = false, AFTER_DRAIN = false;
    float* C; int ldc;
    __device__ __forceinline__ void operator()(const f32x4 (&acc)[2][2][4][2], const Unit& u, int wr, int wc, int fr, int fq, int shift, int part) const {
        const int row0 = u.pm * BM + wr * 64 + fr, col0 = u.pn * BM + wc * 32 + 4 * fq;
#pragma unroll
        for (int ai = 0; ai < 2; ++ai)
#pragma unroll
            for (int m = 0; m < 4; ++m) { float* rowp = C + (size_t)(row0 + ai * HALF + m * 16) * ldc + col0;
#pragma unroll
                for (int bj = 0; bj < 2; ++bj)
#pragma unroll
                    for (int n = 0; n < 2; ++n) if ((((((ai * 2 + bj) * 4 + m) * 2 + n)) >> shift) == part) *(f32x4*)(rowp + bj * HALF + n * 16) = acc[ai][bj][m][n]; }
    }
};
struct EpiBf16 {
    static constexpr bool PERM = true, AFTER_DRAIN = false;
    bf16_t* O; int ldc; int nfull; float* X;
    __device__ __forceinline__ void operator()(const f32x4 (&acc)[2][2][4][2], const Unit& u, int wr, int wc, int fr, int fq, int shift, int part) const {
        const int row0 = u.pm * BM + wr * 64 + fr;
        if (u.pn < nfull) {
            const int col0 = u.pn * BM + wc * 32 + 8 * fq;
#pragma unroll
            for (int ai = 0; ai < 2; ++ai)
#pragma unroll
                for (int m = 0; m < 4; ++m) { bf16_t* rowp = O + (size_t)(row0 + ai * HALF + m * 16) * ldc + col0;
#pragma unroll
                    for (int bj = 0; bj < 2; ++bj) { if ((((((ai * 2 + bj) * 4 + m) * 2)) >> shift) != part) continue; const f32x4 v0 = acc[ai][bj][m][0], v1 = acc[ai][bj][m][1];
                        u32x4 w; w.x = cvt_pk_bf16(v0[0], v0[1]); w.y = cvt_pk_bf16(v0[2], v0[3]); w.z = cvt_pk_bf16(v1[0], v1[1]); w.w = cvt_pk_bf16(v1[2], v1[3]);
                        *(u32x4*)(rowp + bj * HALF) = w; } }
        } else if (wc == 0) {
#pragma unroll
            for (int ai = 0; ai < 2; ++ai)
#pragma unroll
                for (int m = 0; m < 4; ++m) { if ((((((ai * 2) * 4 + m) * 2)) >> shift) != part) continue; float* rowp = X + (size_t)(row0 + ai * HALF + m * 16) * 32 + 8 * fq;
                    *(f32x4*)(rowp) = acc[ai][0][m][0]; *(f32x4*)(rowp + 4) = acc[ai][0][m][1]; }
        }
    }
};

__device__ __forceinline__ float dpp_ror1(float x) { return __builtin_bit_cast(float, __builtin_amdgcn_update_dpp(0, __builtin_bit_cast(int, x), 0x121, 0xF, 0xF, false)); }
__device__ __forceinline__ float dpp_ror2(float x) { return __builtin_bit_cast(float, __builtin_amdgcn_update_dpp(0, __builtin_bit_cast(int, x), 0x122, 0xF, 0xF, false)); }
struct EpiConvAct {
    static constexpr bool PERM = true, AFTER_DRAIN = false;
    static constexpr int FFD = 5632, FFD2 = 11264, MPR = 8192, NPT = 32;
    bf16_t* ACT; float* HG; const float* cw; const float* cbias; const float* st; float* fconv_s; PG8_LAS float* halo;
    __device__ __forceinline__ void operator()(const f32x4 (&acc)[2][2][4][2], const Unit& u, int wr, int wc, int fr, int fq, int, int) const {
        if (u.pm >= NPT) body<true>(acc, u, wr, wc, fr, fq); else body<false>(acc, u, wr, wc, fr, fq); }
    template <bool sample> __device__ __forceinline__ void body(const f32x4 (&acc)[2][2][4][2], const Unit& u, int wr, int wc, int fr, int fq) const {
        const int pm = u.pm, pn = u.pn, cl = wc * 32 + 8 * fq, c0 = pn * 128 + cl;
        if (fr >= 14) {
#pragma unroll
            for (int ai = 0; ai < 2; ++ai)
#pragma unroll
                for (int bj = 0; bj < 2; ++bj)
#pragma unroll
                    for (int n = 0; n < 2; ++n) *(PG8_LAS f32x4*)(halo + ((ai * 2 + wr) * 2 + (fr - 14)) * 256 + bj * 128 + cl + 4 * n) = acc[ai][bj][3][n];
            if (!sample && wr == 1) {
#pragma unroll
                for (int bj = 0; bj < 2; ++bj)
#pragma unroll
                    for (int n = 0; n < 2; ++n) *(f32x4*)(HG + ((size_t)pm * 4 + 2 + (fr - 14)) * FFD2 + bj * FFD + c0 + 4 * n) = acc[1][bj][3][n]; }
        }
        if (fr < 2 && !sample && wr == 0) {
#pragma unroll
            for (int bj = 0; bj < 2; ++bj)
#pragma unroll
                for (int n = 0; n < 2; ++n) *(f32x4*)(HG + ((size_t)pm * 4 + fr) * FFD2 + bj * FFD + c0 + 4 * n) = acc[0][bj][0][n]; }
        __syncthreads();
        const int t8 = fr & 7;
        typedef unsigned u32x2 __attribute__((ext_vector_type(2)));
        u32x2 pk0[2][4];
#pragma unroll
        for (int n = 0; n < 2; ++n) {
            f32x4 w[2][3], bs[2];
#pragma unroll
            for (int bj = 0; bj < 2; ++bj) { bs[bj] = *(const f32x4*)(cbias + bj * FFD + c0 + 4 * n);
#pragma unroll
                for (int j = 0; j < 3; ++j) w[bj][j] = *(const f32x4*)(cw + j * FFD2 + bj * FFD + c0 + 4 * n); }
#pragma unroll
            for (int ai = 0; ai < 2; ++ai) {
                f32x4 r1p[2], r2p[2];
#pragma unroll
                for (int bj = 0; bj < 2; ++bj) { f32x4 pv = (f32x4){0.f, 0.f, 0.f, 0.f};
                    if (fr >= 14 && (wr == 1 || ai == 1)) { const int pa = (wr == 1) ? ai : 0, pw = (wr == 1) ? 0 : 1; pv = *(const PG8_LAS f32x4*)(halo + ((pa * 2 + pw) * 2 + (fr - 14)) * 256 + bj * 128 + cl + 4 * n); }
#pragma unroll
                    for (int j = 0; j < 4; ++j) { r1p[bj][j] = dpp_ror1(pv[j]); r2p[bj][j] = dpp_ror2(pv[j]); } }
#pragma unroll
                for (int m = 0; m < 4; ++m) { const int row = pm * BM + ai * HALF + wr * 64 + m * 16 + fr;
                    f32x4 o[2];
#pragma unroll
                    for (int bj = 0; bj < 2; ++bj) { const f32x4 cur = acc[ai][bj][m][n]; f32x4 p1, p2;
#pragma unroll
                        for (int j = 0; j < 4; ++j) { const float c1 = dpp_ror1(cur[j]), c2 = dpp_ror2(cur[j]); p1[j] = (fr == 0) ? r1p[bj][j] : c1; p2[j] = (fr < 2) ? r2p[bj][j] : c2; r1p[bj][j] = c1; r2p[bj][j] = c2; }
                        if (sample && t8 < 2) { const int sb = (row - MPR) >> 3; const f32x4 s1 = *(const f32x4*)(st + ((size_t)sb * 2 + 1) * FFD2 + bj * FFD + c0 + 4 * n);
                            if (t8 == 0) { p1 = s1; p2 = *(const f32x4*)(st + ((size_t)sb * 2) * FFD2 + bj * FFD + c0 + 4 * n); } else p2 = s1; }
                        o[bj] = bs[bj] + w[bj][0] * p2 + w[bj][1] * p1 + w[bj][2] * cur; }
                    f32x4 g; g.x = o[0].x * __builtin_amdgcn_rcpf(1.f + __expf(-o[0].x)) * o[1].x; g.y = o[0].y * __builtin_amdgcn_rcpf(1.f + __expf(-o[0].y)) * o[1].y;
                    g.z = o[0].z * __builtin_amdgcn_rcpf(1.f + __expf(-o[0].z)) * o[1].z; g.w = o[0].w * __builtin_amdgcn_rcpf(1.f + __expf(-o[0].w)) * o[1].w;
                    const u32x2 pk = (u32x2){cvt_pk_bf16(g.x, g.y), cvt_pk_bf16(g.z, g.w)};
                    if (n == 0) pk0[ai][m] = pk;
                    else *(u32x4*)(ACT + (size_t)row * FFD + c0) = (u32x4){pk0[ai][m].x, pk0[ai][m].y, pk.x, pk.y};
                    if (sample && t8 >= 6) { const int sb = (row - MPR) >> 3;
#pragma unroll
                        for (int bj = 0; bj < 2; ++bj) *(f32x4*)(fconv_s + ((size_t)sb * 2 + (t8 - 6)) * FFD2 + bj * FFD + c0 + 4 * n) = acc[ai][bj][m][n]; }
                }
            }
        }
    }
};

template <class Epi, class Sched, bool ALIGN_EPI = false, bool SP2 = false>
__device__ __forceinline__ void gemm_phase(PG8_LAS unsigned char* lds, const Gemm g, const Sched& S, const Epi& E, const SplitCtx& X) {
    const int tid = threadIdx.x, wid = __builtin_amdgcn_readfirstlane(tid >> 6), lane = tid & 63, wr = wid >> 2, wc = wid & 3, fr = lane & 15, fq = lane >> 4;
    const int K = g.K;
    unsigned voffA[2], voffB[2];
#pragma unroll
    for (int i = 0; i < 2; ++i) { int R, C; stage_rc(tid * 16 + i * 8192, R, C); const int Rb = Epi::PERM ? ((R & ~31) + perm32(R & 31)) : R;
        voffA[i] = (unsigned)(R * K + C) * 2u; voffB[i] = (unsigned)(Rb * K + C) * 2u; }
    const size_t kstep = (size_t)(BK * 2);
    const size_t hstep = (size_t)HALF * K * 2;
    const size_t tstep = 2 * hstep;
    const unsigned ldsw = (unsigned)wid * 1024u;
    const int aoff = lds_byte(wr * 64 + fr, fq * 8), boff = lds_byte(wc * 32 + fr, fq * 8);
#define PG8_SA(b, h) (((b) * 2 + (h)) * HTB)
#define PG8_SB(b, h) ((4 + (b) * 2 + (h)) * HTB)
#define PG8_STAGE(bufoff, gbase, voff) do { _Pragma("unroll") for (int _i = 0; _i < 2; ++_i) \
        __builtin_amdgcn_global_load_lds((const unsigned*)((const char*)(gbase) + (voff)[_i]), (PG8_LAS unsigned*)(lds + (bufoff) + ldsw + _i * 8192), 16, 0, 0); } while (0)
#define PG8_LDA(dst, b, h) do { _Pragma("unroll") for (int m = 0; m < 4; ++m) _Pragma("unroll") for (int k = 0; k < 2; ++k) dst[m][k] = *(const PG8_LAS bf16x8*)(lds + PG8_SA(b, h) + aoff + m * 2048 + k * 1024); } while (0)
#define PG8_LDB(dst, b, h) do { _Pragma("unroll") for (int n = 0; n < 2; ++n) _Pragma("unroll") for (int k = 0; k < 2; ++k) dst[n][k] = *(const PG8_LAS bf16x8*)(lds + PG8_SB(b, h) + boff + n * 2048 + k * 1024); } while (0)
#define PG8_MMA(ai, bj, At, Bt) do { __builtin_amdgcn_s_setprio(1); _Pragma("unroll") for (int m = 0; m < 4; ++m) _Pragma("unroll") for (int n = 0; n < 2; ++n) _Pragma("unroll") for (int k = 0; k < 2; ++k) \
        acc[ai][bj][m][n] = __builtin_amdgcn_mfma_f32_16x16x32_bf16(Bt[n][k], At[m][k], acc[ai][bj][m][n], 0, 0, 0); __builtin_amdgcn_s_setprio(0); } while (0)
#define PG8_WAIT_V(n) asm volatile("s_waitcnt vmcnt(" #n ")" ::: "memory")
#define PG8_WAIT_L(n) asm volatile("s_waitcnt lgkmcnt(" #n ")" ::: "memory")
#define PG8_BAR __builtin_amdgcn_s_barrier()
#define PG8_SCHED __builtin_amdgcn_sched_barrier(0)
    Unit cur, nxt; int ui = 0;
    if (!S.next(0, cur)) return;
    f32x4 acc[2][2][4][2];
#pragma unroll
    for (int a = 0; a < 2; ++a)
#pragma unroll
        for (int b = 0; b < 2; ++b)
#pragma unroll
            for (int m = 0; m < 4; ++m)
#pragma unroll
                for (int n = 0; n < 2; ++n) acc[a][b][m][n] = (f32x4){0.f, 0.f, 0.f, 0.f};
    bf16x8 At[4][2], B0[2][2], B1[2][2];
    const char* cA = (const char*)g.A + (size_t)cur.pm * tstep + (size_t)cur.k0 * kstep; const char* cB = (const char*)g.Bt + (size_t)cur.pn * tstep + (size_t)cur.k0 * kstep;
    S.a_ready(cur);
    if constexpr (SP2) {
        PG8_STAGE(PG8_SB(0, 0), cB, voffB); PG8_STAGE(PG8_SB(0, 1), cB + hstep, voffB); PG8_STAGE(PG8_SA(0, 0), cA, voffA); PG8_STAGE(PG8_SA(0, 1), cA + hstep, voffA);
        if (wr == 1) PG8_BAR;
        PG8_WAIT_V(2); PG8_BAR;
        PG8_STAGE(PG8_SB(1, 0), cB + kstep, voffB); PG8_STAGE(PG8_SA(1, 0), cA + kstep, voffA); PG8_STAGE(PG8_SB(1, 1), cB + hstep + kstep, voffB);
        PG8_WAIT_V(6); PG8_BAR;
    } else {
        PG8_STAGE(PG8_SB(0, 0), cB, voffB); PG8_STAGE(PG8_SA(0, 0), cA, voffA); PG8_STAGE(PG8_SB(0, 1), cB + hstep, voffB); PG8_STAGE(PG8_SA(0, 1), cA + hstep, voffA);
        if (wr == 1) PG8_BAR;
        PG8_WAIT_V(4); PG8_BAR;
        PG8_STAGE(PG8_SB(1, 0), cB + kstep, voffB); PG8_STAGE(PG8_SA(1, 0), cA + kstep, voffA); PG8_STAGE(PG8_SB(1, 1), cB + hstep + kstep, voffB);
        PG8_WAIT_V(6); PG8_BAR;
    }
    for (;;) {
        const bool has_next = S.next(ui + 1, nxt);
        const char* nA = has_next ? (const char*)g.A + (size_t)nxt.pm * tstep + (size_t)nxt.k0 * kstep : cA; const char* nB = has_next ? (const char*)g.Bt + (size_t)nxt.pn * tstep + (size_t)nxt.k0 * kstep : cB;
        const int nt = cur.nk;
        unsigned long long tsu = 0; if (MK_TIME_PHASE == 50 + X.id && cur.nsl > 1) tsu = __builtin_amdgcn_s_memrealtime();
        for (int t = 0; t < nt; t += 2) {
            const bool last = (t == nt - 2);
            const char* a1 = cA + (size_t)(t + 1) * kstep;
            const char* a2 = last ? nA : cA + (size_t)(t + 2) * kstep; const char* b2 = last ? nB : cB + (size_t)(t + 2) * kstep;
            const char* a3 = a2 + kstep; const char* b3 = b2 + kstep;
            if (last && has_next) S.a_ready(nxt);
            if constexpr (SP2) {
            PG8_LDB(B0, 0, 0); PG8_LDB(B1, 0, 1); PG8_SCHED; PG8_LDA(At, 0, 0); PG8_STAGE(PG8_SA(1, 1), a1 + hstep, voffA);
            PG8_WAIT_V(8); PG8_WAIT_L(0); PG8_BAR; PG8_MMA(0, 0, At, B0); PG8_MMA(0, 1, At, B1); PG8_BAR; PG8_SCHED;
            PG8_LDA(At, 0, 1); PG8_STAGE(PG8_SB(0, 0), b2, voffB); PG8_STAGE(PG8_SB(0, 1), b2 + hstep, voffB); PG8_STAGE(PG8_SA(0, 0), a2, voffA);
            PG8_WAIT_V(8); PG8_WAIT_L(0); PG8_BAR; PG8_MMA(1, 0, At, B0); PG8_MMA(1, 1, At, B1); PG8_BAR; PG8_SCHED;
            PG8_LDB(B0, 1, 0); PG8_LDB(B1, 1, 1); PG8_SCHED; PG8_LDA(At, 1, 0); PG8_STAGE(PG8_SA(0, 1), a2 + hstep, voffA);
            PG8_WAIT_V(8); PG8_WAIT_L(0); PG8_BAR; PG8_MMA(0, 0, At, B0); PG8_MMA(0, 1, At, B1); PG8_BAR; PG8_SCHED;
            PG8_LDA(At, 1, 1); PG8_STAGE(PG8_SB(1, 0), b3, voffB); PG8_STAGE(PG8_SB(1, 1), b3 + hstep, voffB); PG8_STAGE(PG8_SA(1, 0), a3, voffA);
            PG8_WAIT_V(8); PG8_WAIT_L(0); PG8_BAR; PG8_MMA(1, 0, At, B0); PG8_MMA(1, 1, At, B1); PG8_BAR; PG8_SCHED;
            } else {
            PG8_LDB(B0, 0, 0); PG8_SCHED; PG8_LDA(At, 0, 0); PG8_STAGE(PG8_SA(1, 1), a1 + hstep, voffA);
            PG8_WAIT_L(8); PG8_BAR; PG8_WAIT_L(0); PG8_MMA(0, 0, At, B0); PG8_BAR; PG8_SCHED;
            PG8_LDB(B1, 0, 1); PG8_STAGE(PG8_SB(0, 0), b2, voffB);
            PG8_BAR; PG8_WAIT_L(0); PG8_MMA(0, 1, At, B1); PG8_BAR;
            PG8_LDA(At, 0, 1); PG8_STAGE(PG8_SA(0, 0), a2, voffA);
            PG8_BAR; PG8_WAIT_L(0); PG8_MMA(1, 0, At, B0); PG8_BAR; PG8_SCHED;
            PG8_STAGE(PG8_SB(0, 1), b2 + hstep, voffB);
            PG8_WAIT_V(6); PG8_BAR; PG8_MMA(1, 1, At, B1); PG8_BAR;
            PG8_LDB(B0, 1, 0); PG8_SCHED; PG8_LDA(At, 1, 0); PG8_STAGE(PG8_SA(0, 1), a2 + hstep, voffA);
            PG8_WAIT_L(8); PG8_BAR; PG8_WAIT_L(0); PG8_MMA(0, 0, At, B0); PG8_BAR; PG8_SCHED;
            PG8_LDB(B1, 1, 1); PG8_STAGE(PG8_SB(1, 0), b3, voffB);
            PG8_BAR; PG8_WAIT_L(0); PG8_MMA(0, 1, At, B1); PG8_BAR;
            PG8_LDA(At, 1, 1); PG8_STAGE(PG8_SA(1, 0), a3, voffA);
            PG8_BAR; PG8_WAIT_L(0); PG8_MMA(1, 0, At, B0); PG8_BAR; PG8_SCHED;
            PG8_STAGE(PG8_SB(1, 1), b3 + hstep, voffB);
            PG8_WAIT_V(6); PG8_BAR; PG8_MMA(1, 1, At, B1); PG8_BAR;
            }
        }
        if constexpr (ALIGN_EPI) { if (wr == 0) PG8_BAR; }
        if constexpr (!Epi::AFTER_DRAIN) { static_assert(ALIGN_EPI, "split_reduce needs the halves aligned"); if (cur.nsl > 1) { const int shift = split_reduce(acc, cur, X, tid); E(acc, cur, wr, wc, fr, fq, shift, cur.slice); } else { unsigned long long te0 = 0; if (MK_TIME_PHASE == 60 + X.id) te0 = __builtin_amdgcn_s_memrealtime(); E(acc, cur, wr, wc, fr, fq, 5, 0); if (MK_TIME_PHASE == 60 + X.id && tid == 0) { asm volatile("s_waitcnt vmcnt(0)" ::: "memory"); X.flag[2] += (unsigned)(__builtin_amdgcn_s_memrealtime() - te0); } } S.done(cur);
            if (MK_TIME_PHASE == 50 + X.id && cur.nsl > 1 && tid == 0) { asm volatile("s_waitcnt vmcnt(0)" ::: "memory"); const unsigned long long d = __builtin_amdgcn_s_memrealtime() - tsu; X.flag[2] = (unsigned)d; } }
        if (!has_next) break;
#pragma unroll
        for (int a = 0; a < 2; ++a)
#pragma unroll
            for (int b = 0; b < 2; ++b)
#pragma unroll
                for (int m = 0; m < 4; ++m)
#pragma unroll
                    for (int n = 0; n < 2; ++n) acc[a][b][m][n] = (f32x4){0.f, 0.f, 0.f, 0.f};
        cur = nxt; cA = nA; cB = nB; ++ui;
        if constexpr (ALIGN_EPI) { if (wr == 1) PG8_BAR; }
    }
    PG8_WAIT_V(0);
    if constexpr (!ALIGN_EPI) { if (wr == 0) PG8_BAR; }
    PG8_BAR;
    if constexpr (Epi::AFTER_DRAIN) { E.fused(acc, cur, wr, wc, fr, fq, lds, wid, lane); S.done(cur); }
#undef PG8_SA
#undef PG8_SB
#undef PG8_STAGE
#undef PG8_LDA
#undef PG8_LDB
#undef PG8_MMA
#undef PG8_WAIT_V
#undef PG8_WAIT_L
#undef PG8_BAR
#undef PG8_SCHED
}
}

constexpr int NWAVES = 8, NTHR = 512;
constexpr int DM = 2048, PB = 4, PL = 2048, SB = 128, SL = 8;
constexpr int MP = PB * PL, MS = SB * SL, M = MP + MS;
constexpr int GH = 4, GK = 128, GV = 256, GKD = 512, LOWR = 16;
constexpr int SH = 16, SP = 64, SN = 128, SG = 2, SCH = 1536;
constexpr int FF = 5632, FF2 = 11264, INC = 5664;
constexpr int N1 = 5888, NP = 5632;
constexpr int CQ = 0, CK = 512, CV = 1024, CG = 2048, CZ = 3072, CX = 4096;
constexpr float EPS = 1e-6f;
constexpr int N_PHASES = 11;

constexpr size_t O_Y = 0, O_GLA_P = (size_t)M * DM, O_SSD_P = O_GLA_P + (size_t)PB * GH * GK * GV, O_SCONV_P = O_SSD_P + (size_t)PB * SH * SP * SN,
                 O_FCONV_P = O_SCONV_P + (size_t)PB * 3 * SCH, O_GLA_S = O_FCONV_P + (size_t)PB * 2 * FF2, O_SSD_S = O_GLA_S + (size_t)SB * GH * GK * GV,
                 O_SCONV_S = O_SSD_S + (size_t)SB * SH * SP * SN, O_FCONV_S = O_SCONV_S + (size_t)SB * 3 * SCH, O_END = O_FCONV_S + (size_t)SB * 2 * FF2;

constexpr size_t MiB = 1u << 20;
constexpr size_t WS_CTL = 0, CTL_ZERO_BYTES = 64 * 1024;
constexpr size_t WS_WF2 = 1 * MiB;
constexpr size_t WS_W1 = 24 * MiB;
constexpr size_t WS_WO = 48 * MiB;
constexpr size_t WS_WF1 = 56 * MiB;
constexpr size_t WS_XN = 101 * MiB;
constexpr size_t WS_F = 24 * MiB;
constexpr size_t WS_BIG = 141 * MiB;
constexpr size_t WS_PROJ = WS_BIG;
constexpr size_t WS_MIX = WS_BIG;
constexpr size_t WS_ACT = WS_BIG;
constexpr size_t WS_HG = WS_BIG + 104 * MiB;
constexpr size_t WS_LRDT = WS_BIG + 100 * MiB;
constexpr size_t WS_MIXIN = WS_BIG + 104 * MiB;
constexpr size_t WS_DS = WS_XN;
constexpr size_t WS_SC = WS_BIG + 140 * MiB, WS_DH = WS_BIG + 172 * MiB, WS_HC = WS_BIG + 204 * MiB;
constexpr size_t WS_EBL = WS_BIG + 236 * MiB, WS_AL = WS_EBL + 512 * 1024;
constexpr size_t WS_SLAB = WS_BIG + 140 * MiB;
constexpr size_t WS_SLAB_F1 = WS_BIG + 198 * MiB;
constexpr size_t WS_QEG = WS_BIG + 238 * MiB, WS_KEG = WS_BIG + 246 * MiB;
constexpr size_t WS_END = WS_BIG + 254 * MiB;
static_assert(WS_WF2 + (size_t)DM * FF * 2 <= WS_W1 && WS_W1 + (size_t)N1 * DM * 2 <= WS_WO && WS_WO + (size_t)DM * DM * 2 <= WS_WF1 && WS_WF1 + (size_t)FF2 * DM * 2 <= WS_XN && WS_XN + (size_t)M * DM * 2 <= WS_BIG, "ws map 1");
static_assert(WS_F + (size_t)M * DM * 4 <= WS_XN && WS_ACT + (size_t)M * FF * 2 <= WS_HG && WS_PROJ + (size_t)M * NP * 2 <= WS_LRDT && WS_LRDT + (size_t)M * 32 * 4 <= WS_MIXIN && WS_MIXIN + (size_t)M * DM * 2 <= WS_SC && WS_HG + (size_t)32 * 4 * FF2 * 4 <= WS_SC && WS_MIX + (size_t)M * DM * 4 <= WS_LRDT, "ws map 2");
constexpr int CW_BAR = 1024;
constexpr int CW_SPLIT = 8192;

constexpr int RING_BYTES = 131072;
constexpr int SCRATCH_BYTES = 8 * 16640;
constexpr int LDSCTL_OFF = 133632, MISC_OFF = LDSCTL_OFF + 320;
constexpr int LDS_BYTES = 150016;

#ifndef MK_TIME_PHASE
#define MK_TIME_PHASE (-1)
#endif
#define TBEGIN(F, id) do { if (MK_TIME_PHASE == (id)) (F).tmark = __builtin_amdgcn_s_memrealtime(); } while (0)
#define TEND(F, id) do { if (MK_TIME_PHASE == (id)) (F).tacc += __builtin_amdgcn_s_memrealtime() - (F).tmark; } while (0)
#define GAS __attribute__((address_space(1)))
#define LAS __attribute__((address_space(3)))
typedef unsigned short bf16;
typedef unsigned v4u __attribute__((ext_vector_type(4)));
typedef unsigned v2u __attribute__((ext_vector_type(2)));
typedef float f32x4 __attribute__((ext_vector_type(4)));
#define LDS_WAIT() asm volatile("s_waitcnt lgkmcnt(0)" ::: "memory")
#define VM_WAIT() asm volatile("s_waitcnt vmcnt(0)" ::: "memory")
typedef float f32x2c __attribute__((ext_vector_type(2)));
typedef __bf16 bf16x2c __attribute__((ext_vector_type(2)));
__device__ __forceinline__ unsigned f2bf(float f) { return (unsigned)__builtin_bit_cast(unsigned short, (__bf16)f); }
__device__ __forceinline__ unsigned pk2(float lo, float hi) { return __builtin_bit_cast(unsigned, __builtin_convertvector((f32x2c){lo, hi}, bf16x2c)); }
__device__ __forceinline__ float bf2f(unsigned short b) { return __builtin_bit_cast(float, (unsigned)b << 16); }
__device__ __forceinline__ float bflo(unsigned w) { return __builtin_bit_cast(float, w << 16); }
__device__ __forceinline__ float bfhi(unsigned w) { return __builtin_bit_cast(float, w & 0xffff0000u); }
__device__ __forceinline__ float silu_f(float x) { return x * __builtin_amdgcn_rcpf(1.f + __expf(-x)); }
__device__ __forceinline__ float softplus_f(float x) { return fmaxf(x, 0.f) + __logf(1.f + __expf(-fabsf(x))); }
__device__ __forceinline__ float logsigmoid_f(float x) { return fminf(x, 0.f) - __logf(1.f + __expf(-fabsf(x))); }
__device__ __forceinline__ float wave_sum(float v) {
#pragma unroll
    for (int o = 1; o < 64; o <<= 1) v += __shfl_xor(v, o);
    return v;
}

#define XB_TMO      128
#define XB_XCNT(j)  (256  + 64 * (j))
#define XB_XSUB(j)  (1280 + 64 * (j))
#define XB_XGEN(j)  (2304 + 64 * (j))
#define XB_TOP      3328
#define XB_TOPGEN   3392
#define XCD_BAR_WORDS 3456
#define XB_SPIN_CAP (1u << 18)

__device__ __forceinline__ unsigned xb_ld(unsigned* p)              { return __hip_atomic_load(p, __ATOMIC_RELAXED, __HIP_MEMORY_SCOPE_AGENT); }
__device__ __forceinline__ unsigned xb_add(unsigned* p, unsigned v) { return __hip_atomic_fetch_add(p, v, __ATOMIC_RELAXED, __HIP_MEMORY_SCOPE_AGENT); }
__device__ __forceinline__ unsigned xb_xcc_id() { return (unsigned)__builtin_amdgcn_s_getreg((3 << 11) | 20) & 0xFu; }
#define XB_SPIN(cond, bar) do { unsigned _sp = 0; while (cond) { __builtin_amdgcn_s_sleep(1); \
    if ((++_sp & 255u) == 0u) { if (xb_ld(&(bar)[XB_TMO])) break; if (_sp > XB_SPIN_CAP) { atomicAdd(&(bar)[XB_TMO], 1u); break; } } } } while (0)

struct XcdBarrier {
    unsigned* bar; unsigned x;
    volatile LAS unsigned* st;
};

__device__ __forceinline__ XcdBarrier xcd_barrier_post(unsigned* bar, volatile LAS unsigned* st) {
    XcdBarrier b; b.bar = bar; b.x = xb_xcc_id(); b.st = st;
    if (threadIdx.x == 0) (void)xb_add(&bar[XB_XCNT(b.x)], 1u);
    return b;
}
__device__ __forceinline__ void xcd_barrier_complete(unsigned* bar, unsigned x, unsigned& nloc, unsigned& nx) {
    const unsigned G = gridDim.x * gridDim.y * gridDim.z;
    unsigned sum, cnt, mine, sp = 0u;
    for (;;) {
        sum = 0u; cnt = 0u; mine = 0u;
#pragma unroll
        for (unsigned j = 0; j < 16; ++j) { const unsigned c = xb_ld(&bar[XB_XCNT(j)]); sum += c; cnt += (c > 0u) ? 1u : 0u; mine = (j == x) ? c : mine; }
        if (sum == G) break;
        __builtin_amdgcn_s_sleep(1);
        if ((++sp & 255u) == 0u) { if (xb_ld(&bar[XB_TMO])) break; if (sp > XB_SPIN_CAP) { atomicAdd(&bar[XB_TMO], 1u); break; } }
    }
    nloc = mine > 0u ? mine : 1u; nx = cnt > 0u ? cnt : 1u;
}

__device__ __forceinline__ void xcd_barrier(const XcdBarrier& b) {
    asm volatile("s_waitcnt vmcnt(0)" ::: "memory");
    __syncthreads();
    if (threadIdx.x == 0) {
        unsigned* bar = b.bar;
        __builtin_amdgcn_s_waitcnt(0);
        unsigned nloc = b.st[0], nx = b.st[1];
        if (nloc == 0u) { xcd_barrier_complete(bar, b.x, nloc, nx); b.st[0] = nloc; b.st[1] = nx; }
        const unsigned old = xb_add(&bar[XB_XSUB(b.x)], 1u);
        const unsigned gen = old / nloc;
        if (old + 1u == (gen + 1u) * nloc) {
            __builtin_amdgcn_fence(__ATOMIC_RELEASE, "agent");
            asm volatile("s_waitcnt vmcnt(0)" ::: "memory");
            const unsigned og = xb_add(&bar[XB_TOP], 1u);
            const unsigned tg = og / nx;
            if (og + 1u == (tg + 1u) * nx) xb_add(&bar[XB_TOPGEN], 1u);
            else XB_SPIN(xb_ld(&bar[XB_TOPGEN]) == tg, bar);
            __builtin_amdgcn_fence(__ATOMIC_ACQUIRE, "agent");
            xb_add(&bar[XB_XGEN(b.x)], 1u);
            asm volatile("s_waitcnt vmcnt(0)" ::: "memory");
        } else {
            XB_SPIN(xb_ld(&bar[XB_XGEN(b.x)]) == gen, bar);
            __builtin_amdgcn_fence(__ATOMIC_ACQUIRE, "agent");
            asm volatile("s_waitcnt vmcnt(0)" ::: "memory");
        }
    }
    __syncthreads();
}

struct Frame {
    LAS unsigned char* lds;
    int tid, lane, wave, G, bid;
    unsigned long long tacc, tmark;
    const float *x_p, *x_s, *st_gla, *st_ssd, *st_sconv, *st_fconv, *n_mix_pre, *n_mix_post, *n_ffn_pre, *n_ffn_post, *w_in, *w_gate2, *b_gate, *gla_norm,
                *sconv_w, *sconv_b, *dt_bias, *A_log, *ssd_D, *ssd_norm, *w_out, *ffn_w_in, *fconv_w, *fconv_b, *ffn_w_out;
    float* out;
    bf16 *W1, *WO, *WF1, *WF2, *XN, *PROJ, *MIXIN, *ACT, *DS, *SC, *DH, *HC, *QEg, *KEg;
    float *LRDT, *MIX, *Fb, *EBL, *AL, *HG;
};
__device__ __forceinline__ const float* x_row(const Frame& F, int row) { return row < MP ? F.x_p + (size_t)row * DM : F.x_s + (size_t)(row - MP) * DM; }

__device__ __forceinline__ int w1_src_col(int n) { return n < 3072 ? n : (n < 5632 ? n + 16 : (n < 5648 ? n - 2560 : (n < 5664 ? n : -1))); }
struct TDesc { const float* W; bf16* WT; int K, Nsrc, Ndst, map, item; };
__device__ __forceinline__ void t_load(const TDesc& d, int lane, f32x4 (&v)[16]) {
    const int nblk = d.Ndst / 64, kb = d.item / nblk, nb = d.item % nblk, k0 = 64 * kb, n0 = 64 * nb;
    int sc = n0 + 4 * (lane & 15); if (d.map == 1) sc = w1_src_col(sc); if (d.map == 2) sc = ((sc >> 7) & 1) * FF + 128 * (sc >> 8) + (sc & 127);
#pragma unroll
    for (int i = 0; i < 16; ++i) { const int kk = 4 * i + (lane >> 4); v[i] = (sc >= 0) ? *(const f32x4*)(d.W + (size_t)(k0 + kk) * d.Nsrc + sc) : (f32x4){0.f, 0.f, 0.f, 0.f}; }
}
__device__ __forceinline__ void t_store(const TDesc& d, int lane, LAS float* scr, const f32x4 (&v)[16]) {
    const int nblk = d.Ndst / 64, kb = d.item / nblk, nb = d.item % nblk, k0 = 64 * kb, n0 = 64 * nb;
#pragma unroll
    for (int i = 0; i < 16; ++i) { const int kk = 4 * i + (lane >> 4); LAS float* p = scr + kk * 65 + 4 * (lane & 15); p[0] = v[i].x; p[1] = v[i].y; p[2] = v[i].z; p[3] = v[i].w; }
    LDS_WAIT(); asm volatile("" ::: "memory");
    const int c = lane & 7;
#pragma unroll
    for (int j = 0; j < 8; ++j) { const int n = (lane >> 3) + 8 * j; const LAS float* s = scr + (8 * c) * 65 + n;
        v4u o; o.x = pk2(s[0 * 65], s[1 * 65]); o.y = pk2(s[2 * 65], s[3 * 65]); o.z = pk2(s[4 * 65], s[5 * 65]); o.w = pk2(s[6 * 65], s[7 * 65]);
        *(v4u*)(d.WT + (size_t)(n0 + n) * d.K + k0 + 8 * c) = o; }
    LDS_WAIT(); asm volatile("" ::: "memory");
}
__device__ __forceinline__ bool t_desc(const Frame& F, int which, int it, TDesc& d) {
    constexpr int I_1 = (DM / 64) * (N1 / 64), I_O = (DM / 64) * (DM / 64), I_F1 = (DM / 64) * (FF2 / 64), I_F2 = (FF / 64) * (DM / 64);
    if (which == 0) { if (it >= I_1) return false; d = TDesc{F.w_in, F.W1, DM, INC, N1, 1, it}; return true; }
    if (which == 2) { if (it >= I_F2) return false; d = TDesc{F.ffn_w_out, F.WF2, FF, DM, DM, 0, it}; return true; }
    if (it >= I_O + I_F1) return false;
    if (it < I_O) d = TDesc{F.w_out, F.WO, DM, DM, DM, 0, it};
    else d = TDesc{F.ffn_w_in, F.WF1, DM, FF2, FF2, 2, it - I_O};
    return true;
}
__device__ __forceinline__ void t_run(const Frame& F, int which, int gw, int NGW) {
    LAS float* scr = (LAS float*)(F.lds + F.wave * 16640);
    TDesc da, db; f32x4 va[16], vb[16]; int it = gw;
    if (!t_desc(F, which, it, da)) return;
    t_load(da, F.lane, va);
    for (;;) {
        const bool hb = t_desc(F, which, it + NGW, db); if (hb) t_load(db, F.lane, vb);
        t_store(da, F.lane, scr, va); if (!hb) break; it += NGW;
        const bool ha = t_desc(F, which, it + NGW, da); if (ha) t_load(da, F.lane, va);
        t_store(db, F.lane, scr, vb); if (!ha) break; it += NGW;
    }
}
struct RmRows { f32x4 a[8], b[8]; };
__device__ __forceinline__ void rm_load(const Frame& F, int m0, int m1, int lane, RmRows& R) {
    const f32x4* xa = (const f32x4*)x_row(F, m0) + lane; const f32x4* xb = (const f32x4*)x_row(F, m1) + lane;
#pragma unroll
    for (int j = 0; j < 8; ++j) R.a[j] = xa[64 * j];
#pragma unroll
    for (int j = 0; j < 8; ++j) R.b[j] = xb[64 * j];
}
__device__ __forceinline__ void rm_finish(const Frame& F, int m0, int m1, int lane, const RmRows& R) {
    const f32x4* wr = (const f32x4*)F.n_mix_pre + lane; float sa = 0.f, sb = 0.f;
#pragma unroll
    for (int j = 0; j < 8; ++j) { sa += (R.a[j].x * R.a[j].x + R.a[j].y * R.a[j].y) + (R.a[j].z * R.a[j].z + R.a[j].w * R.a[j].w); sb += (R.b[j].x * R.b[j].x + R.b[j].y * R.b[j].y) + (R.b[j].z * R.b[j].z + R.b[j].w * R.b[j].w); }
    const float ra = rsqrtf(wave_sum(sa) * (1.f / DM) + EPS), rb = rsqrtf(wave_sum(sb) * (1.f / DM) + EPS);
    v2u* pa = (v2u*)(F.XN + (size_t)m0 * DM) + lane; v2u* pb = (v2u*)(F.XN + (size_t)m1 * DM) + lane;
#pragma unroll
    for (int j = 0; j < 8; ++j) { const f32x4 ww = wr[64 * j]; v2u o; o.x = pk2(R.a[j].x * ra * ww.x, R.a[j].y * ra * ww.y); o.y = pk2(R.a[j].z * ra * ww.z, R.a[j].w * ra * ww.w); pa[64 * j] = o;
        o.x = pk2(R.b[j].x * rb * ww.x, R.b[j].y * rb * ww.y); o.y = pk2(R.b[j].z * rb * ww.z, R.b[j].w * rb * ww.w); pb[64 * j] = o; }
}
__device__ __forceinline__ void rm_run(const Frame& F, int gw, int NGW) {
    RmRows A, B; int m = gw; const int st = 2 * NGW;
    if (m >= M) return;
#define RM_M1(mm) (((mm) + NGW < M) ? (mm) + NGW : (mm))
    rm_load(F, m, RM_M1(m), F.lane, A);
    for (;;) {
        const bool hb = m + st < M; if (hb) rm_load(F, m + st, RM_M1(m + st), F.lane, B);
        rm_finish(F, m, RM_M1(m), F.lane, A); if (!hb) break; m += st;
        const bool ha = m + st < M; if (ha) rm_load(F, m + st, RM_M1(m + st), F.lane, A);
        rm_finish(F, m, RM_M1(m), F.lane, B); if (!ha) break; m += st;
    }
#undef RM_M1
}
__device__ __forceinline__ void p0_prologue(Frame& F) {
    const int gw = F.bid * NWAVES + F.wave, NGW = F.G * NWAVES;
    t_run(F, 0, gw, NGW);
    rm_run(F, gw, NGW);
}
__device__ __forceinline__ void p0_convert_rest(Frame& F, int vb, int nb) { t_run(F, 1, vb * NWAVES + F.wave, nb * NWAVES); }

template <int grp> __device__ __forceinline__ void gla_direct_unit(Frame& F, int b, int h) {
    const int tid = F.tid, v = tid & 255, kh = tid >> 8;
    const int L = grp ? SL : PL, row0 = grp ? MP + b * SL : b * PL;
    LAS float* Es = (LAS float*)F.lds; LAS float* Ks = Es + 1024; LAS float* Qs = Ks + 1024; LAS float* Os = Qs + 1024;
    float S[64];
    if (grp) { const float* s0 = F.st_gla + ((size_t)(b * GH + h) * GK + kh * 64) * GV + v;
#pragma unroll
        for (int i = 0; i < 64; ++i) S[i] = s0[(size_t)i * GV]; }
    else {
#pragma unroll
        for (int i = 0; i < 64; ++i) S[i] = 0.f; }
    for (int t0 = 0; t0 < L; t0 += 8) {
        for (int it = tid; it < 1024; it += NTHR) { const int t = it >> 7, k = it & 127, row = row0 + t0 + t, hk = h * GK + k;
            float x = F.b_gate[hk]; const float* lr = F.LRDT + (size_t)row * 32;
#pragma unroll
            for (int j = 0; j < LOWR; ++j) x += lr[j] * F.w_gate2[j * GKD + hk];
            const float lg = logsigmoid_f(x) * (1.f / 16.f);
            Es[it] = __expf(lg); Ks[it] = bf2f(F.PROJ[(size_t)row * NP + CK + hk]); Qs[it] = bf2f(F.PROJ[(size_t)row * NP + CQ + hk]) * 0.08838834764831845f; }
        __syncthreads();
#pragma unroll 1
        for (int t = 0; t < 8; ++t) { const float vv = bf2f(F.PROJ[(size_t)(row0 + t0 + t) * NP + CV + h * GV + v]); float acc = 0.f;
            const LAS float* e = Es + t * 128 + kh * 64; const LAS float* kk = Ks + t * 128 + kh * 64; const LAS float* qq = Qs + t * 128 + kh * 64;
#pragma unroll
            for (int i = 0; i < 64; ++i) { S[i] = e[i] * S[i] + kk[i] * vv; acc += qq[i] * S[i]; }
            Os[(kh * 8 + t) * 256 + v] = acc; }
        __syncthreads();
        { const int t = F.wave, v4 = F.lane * 4, row = row0 + t0 + t;
            const f32x4 a = *(const LAS f32x4*)(Os + t * 256 + v4), c = *(const LAS f32x4*)(Os + (8 + t) * 256 + v4); const f32x4 o = a + c;
            const float ss = wave_sum((o.x * o.x + o.y * o.y) + (o.z * o.z + o.w * o.w)); const float r = rsqrtf(ss * (1.f / GV) + EPS);
            const v2u gw = *(const v2u*)(F.PROJ + (size_t)row * NP + CG + h * GV + v4); const f32x4 nw = *(const f32x4*)(F.gla_norm + v4);
            v2u w; w.x = pk2(o.x * r * nw.x * silu_f(bflo(gw.x)), o.y * r * nw.y * silu_f(bfhi(gw.x))); w.y = pk2(o.z * r * nw.z * silu_f(bflo(gw.y)), o.w * r * nw.w * silu_f(bfhi(gw.y)));
            *(v2u*)(F.MIXIN + (size_t)row * DM + h * GV + v4) = w; }
        __syncthreads();
    }
    float* so = F.out + (grp ? O_GLA_S : O_GLA_P) + ((size_t)(b * GH + h) * GK + kh * 64) * GV + v;
#pragma unroll
    for (int i = 0; i < 64; ++i) so[(size_t)i * GV] = S[i];
}
__device__ __forceinline__ float xbc_raw(const Frame& F, int grp, int b, int row0, int tt, int c) {
    if (tt >= 0) return bf2f(F.PROJ[(size_t)(row0 + tt) * NP + CX + c]);
    return grp ? F.st_sconv[((size_t)b * 3 + (tt + 3)) * SCH + c] : 0.f;
}
template <int grp> __device__ __forceinline__ void ssd_direct_unit(Frame& F, int b, int g) {
    const int tid = F.tid, hd = g * 8 + (tid >> 6), p = tid & 63, ch = g * 512 + tid;
    const int L = grp ? SL : PL, row0 = grp ? MP + b * SL : b * PL;
    LAS float* Bs = (LAS float*)F.lds; LAS float* Cs = Bs + 1024; LAS float* red = Cs + 1024; LAS float* Ys = red + 64;
    float h[128];
    if (grp) { const f32x4* h0 = (const f32x4*)(F.st_ssd + ((size_t)(b * SH + hd) * SP + p) * SN);
#pragma unroll
        for (int i = 0; i < 32; ++i) { const f32x4 q = h0[i]; h[4 * i] = q.x; h[4 * i + 1] = q.y; h[4 * i + 2] = q.z; h[4 * i + 3] = q.w; } }
    else {
#pragma unroll
        for (int i = 0; i < 128; ++i) h[i] = 0.f; }
    const float A = -__expf(F.A_log[hd]), dtb = F.dt_bias[hd], Dh = F.ssd_D[hd], nw = F.ssd_norm[ch];
    const float cb = F.sconv_b[ch], cw0 = F.sconv_w[ch], cw1 = F.sconv_w[SCH + ch], cw2 = F.sconv_w[2 * SCH + ch], cw3 = F.sconv_w[3 * SCH + ch];
    const int c2 = 1024 + (tid < 128 ? g * 128 + tid : 256 + g * 128 + ((tid - 128) & 127));
    float xr0 = xbc_raw(F, grp, b, row0, -3, ch), xr1 = xbc_raw(F, grp, b, row0, -2, ch), xr2 = xbc_raw(F, grp, b, row0, -1, ch);
    for (int t0 = 0; t0 < L; t0 += 8) {
        if (tid < 256) {
            float xr[11]; const float cb2 = F.sconv_b[c2], d0 = F.sconv_w[c2], d1 = F.sconv_w[SCH + c2], d2 = F.sconv_w[2 * SCH + c2], d3 = F.sconv_w[3 * SCH + c2];
#pragma unroll
            for (int i = 0; i < 11; ++i) xr[i] = xbc_raw(F, grp, b, row0, t0 - 3 + i, c2);
#pragma unroll
            for (int t = 0; t < 8; ++t) Bs[(tid >> 7) * 1024 + t * 128 + (tid & 127)] = silu_f(cb2 + d0 * xr[t] + d1 * xr[t + 1] + d2 * xr[t + 2] + d3 * xr[t + 3]);
        }
        __syncthreads();
#pragma unroll 1
        for (int t = 0; t < 8; ++t) { const int row = row0 + t0 + t;
            const float xn = bf2f(F.PROJ[(size_t)row * NP + CX + ch]);
            const float x = silu_f(cb + cw0 * xr0 + cw1 * xr1 + cw2 * xr2 + cw3 * xn); xr0 = xr1; xr1 = xr2; xr2 = xn;
            const float dt = softplus_f(F.LRDT[(size_t)row * 32 + 16 + hd] + dtb), a = __expf(dt * A), dtx = dt * x;
            float acc = 0.f; const LAS float* bb = Bs + t * 128; const LAS float* cc = Cs + t * 128;
#pragma unroll
            for (int nb = 0; nb < 128; nb += 16) {
#pragma unroll
                for (int n = nb; n < nb + 16; ++n) { h[n] = a * h[n] + dtx * bb[n]; acc += h[n] * cc[n]; }
                asm volatile("" ::: "memory"); }
            const float z = bf2f(F.PROJ[(size_t)row * NP + CZ + ch]);
            const float y = (acc + Dh * x) * silu_f(z);
            Ys[t * 512 + tid] = y;
            const float ss = wave_sum(y * y); if (F.lane == 0) red[t * 8 + F.wave] = ss; }
        __syncthreads();
#pragma unroll
        for (int t = 0; t < 8; ++t) { float tot = 0.f;
#pragma unroll
            for (int w = 0; w < 8; ++w) tot += red[t * 8 + w];
            const float r = rsqrtf(tot * (1.f / 512.f) + EPS);
            F.MIXIN[(size_t)(row0 + t0 + t) * DM + 1024 + ch] = (bf16)f2bf(Ys[t * 512 + tid] * r * nw); }
        __syncthreads();
    }
    f32x4* ho = (f32x4*)(F.out + (grp ? O_SSD_S : O_SSD_P) + ((size_t)(b * SH + hd) * SP + p) * SN);
#pragma unroll
    for (int i = 0; i < 32; ++i) ho[i] = (f32x4){h[4 * i], h[4 * i + 1], h[4 * i + 2], h[4 * i + 3]};
}
typedef short bf16x8v __attribute__((ext_vector_type(8)));
typedef short s16x4v __attribute__((ext_vector_type(4)));
constexpr int CH = 64, NCH = PL / CH;
constexpr int QE_ST = 272, KDT_ST = 144, V_ST = 544, ATT_ST = 144, X_ST = 1056, BC_ST = 288;
#define MFMA16(a, b, c) __builtin_amdgcn_mfma_f32_16x16x32_bf16((a), (b), (c), 0, 0, 0)
__device__ __forceinline__ bf16x8v frag_k(const LAS unsigned char* T, int stride, int idx0, int kk0, int r, int q) { return *(const LAS bf16x8v*)(T + (idx0 + r) * stride + (kk0 + 8 * q) * 2); }
__device__ __forceinline__ bf16x8v frag_t(const LAS unsigned char* T, int stride, int kk0, int idx0, int r, int q) {
    const LAS unsigned char* p = T + (kk0 + 8 * q + (r >> 2)) * stride + (idx0 + 4 * (r & 3)) * 2;
    const s16x4v lo = __builtin_amdgcn_ds_read_tr16_b64_v4i16((LAS s16x4v*)p), hi = __builtin_amdgcn_ds_read_tr16_b64_v4i16((LAS s16x4v*)(p + 4 * stride));
    return (bf16x8v){lo[0], lo[1], lo[2], lo[3], hi[0], hi[1], hi[2], hi[3]};
}
__device__ __forceinline__ v2u pk4(const f32x4 v) { v2u o; o.x = pk2(v.x, v.y); o.y = pk2(v.z, v.w); return o; }

struct GlaStage { v4u v[4], qk[4], lr; };
template <int PASS>
__device__ __forceinline__ void gla_stage_load(const Frame& F, int h, int row0, GlaStage& g) {
    const int tid = F.tid;
#pragma unroll
    for (int i = 0; i < 4; ++i) { const int piece = tid + NTHR * i, row = piece >> 5, c16 = piece & 31; g.v[i] = *(const v4u*)(F.PROJ + (size_t)(row0 + row) * NP + CV + h * GV + c16 * 8); }
#pragma unroll
    for (int i = 0; i < 2; ++i) { const int piece = tid + NTHR * i, row = piece >> 4, c16 = piece & 15;
        g.qk[i] = *(const v4u*)(F.PROJ + (size_t)(row0 + row) * NP + CK + h * GK + c16 * 8);
        if (PASS == 1) g.qk[2 + i] = *(const v4u*)(F.PROJ + (size_t)(row0 + row) * NP + CQ + h * GK + c16 * 8); }
    if (tid < 256) g.lr = *(const v4u*)(F.LRDT + (size_t)(row0 + (tid >> 2)) * 32 + (tid & 3) * 4);
}
template <int PASS>
__device__ __forceinline__ void gla_stage_store(const Frame& F, const GlaStage& g, LAS unsigned char* V, LAS unsigned char* Kt, LAS unsigned char* Qt, LAS float* LR) {
    const int tid = F.tid;
#pragma unroll
    for (int i = 0; i < 4; ++i) { const int piece = tid + NTHR * i, row = piece >> 5, c16 = piece & 31; *(LAS v4u*)(V + row * V_ST + c16 * 16) = g.v[i]; }
#pragma unroll
    for (int i = 0; i < 2; ++i) { const int piece = tid + NTHR * i, row = piece >> 4, c16 = piece & 15;
        *(LAS v4u*)(Kt + row * QE_ST + c16 * 16) = g.qk[i]; if (PASS == 1) *(LAS v4u*)(Qt + row * QE_ST + c16 * 16) = g.qk[2 + i]; }
    if (tid < 256) *(LAS v4u*)(LR + (tid >> 2) * 16 + (tid & 3) * 4) = g.lr;
}
template <int PASS>
__device__ __forceinline__ void gla_chunk_elem(Frame& F, int h, LAS unsigned char* Kt, LAS unsigned char* Qt, LAS unsigned char* KDT, const LAS float* LR, LAS float* tot, float* ebl_out) {
    const int tid = F.tid, k = tid & 127, tq = tid >> 7, hk = h * GK + k;
    float w2[16];
#pragma unroll
    for (int j = 0; j < 16; ++j) w2[j] = F.w_gate2[j * GKD + hk];
    const float bg = F.b_gate[hk];
    float lg[16]; float run = 0.f;
#pragma unroll
    for (int i = 0; i < 16; ++i) { const LAS f32x4* lr = (const LAS f32x4*)(LR + (16 * tq + i) * 16); const f32x4 a = lr[0], b = lr[1], c = lr[2], d = lr[3];
        float x = bg + a.x * w2[0] + a.y * w2[1] + a.z * w2[2] + a.w * w2[3] + b.x * w2[4] + b.y * w2[5] + b.z * w2[6] + b.w * w2[7]
                     + c.x * w2[8] + c.y * w2[9] + c.z * w2[10] + c.w * w2[11] + d.x * w2[12] + d.y * w2[13] + d.z * w2[14] + d.w * w2[15];
        run += logsigmoid_f(x) * (1.f / 16.f); lg[i] = run; }
    tot[tq * 128 + k] = run;
    __syncthreads();
    float off = 0.f, all = 0.f;
#pragma unroll
    for (int qq = 0; qq < 4; ++qq) { const float v = tot[qq * 128 + k]; all += v; off += (qq < tq) ? v : 0.f; }
    {
        unsigned pk[8];
#pragma unroll
        for (int i = 0; i < 8; ++i) { const int t = 16 * tq + 2 * i; const float b0 = off + lg[2 * i], b1 = off + lg[2 * i + 1];
            LAS bf16* k0p = (LAS bf16*)(Kt + t * QE_ST + k * 2); LAS bf16* k1p = (LAS bf16*)(Kt + (t + 1) * QE_ST + k * 2);
            LAS bf16* q0p = (LAS bf16*)(Qt + t * QE_ST + k * 2); LAS bf16* q1p = (LAS bf16*)(Qt + (t + 1) * QE_ST + k * 2);
            const float k0 = bf2f(*k0p), k1 = bf2f(*k1p);
            pk[i] = pk2(k0 * __expf(all - b0), k1 * __expf(all - b1));
            *k0p = (bf16)f2bf(k0 * __expf(-b0)); *k1p = (bf16)f2bf(k1 * __expf(-b1));
            *q0p = (bf16)f2bf(bf2f(*q0p) * 0.08838834764831845f * __expf(b0)); *q1p = (bf16)f2bf(bf2f(*q1p) * 0.08838834764831845f * __expf(b1)); }
        LAS v4u* d = (LAS v4u*)(KDT + k * KDT_ST + 32 * tq);
        d[0] = (v4u){pk[0], pk[1], pk[2], pk[3]}; d[1] = (v4u){pk[4], pk[5], pk[6], pk[7]};
        if (tq == 0) ebl_out[k] = __expf(all);
    }
}
__device__ __forceinline__ void gla_passA_unit(Frame& F, int u) {
    const int c = u & 31, bh = u >> 5, b = bh >> 2, h = bh & 3, row0 = b * PL + c * CH;
    LAS unsigned char* KDT = F.lds; LAS unsigned char* V = KDT + 128 * KDT_ST; LAS unsigned char* Kt = V + 64 * V_ST; LAS unsigned char* Qt = Kt + 64 * QE_ST; LAS float* LR = (LAS float*)(Qt + 64 * QE_ST); LAS float* tot = LR + 1024;
    { GlaStage g; gla_stage_load<1>(F, h, row0, g); gla_stage_store<1>(F, g, V, Kt, Qt, LR); }
    __syncthreads();
    gla_chunk_elem<0>(F, h, Kt, Qt, KDT, LR, tot, F.EBL + (size_t)u * 128);
    __syncthreads();
#pragma unroll
    for (int i = 0; i < 2; ++i) { const int piece = F.tid + NTHR * i, row = piece >> 4, c16 = piece & 15;
        *(v4u*)(F.QEg + ((size_t)u * 64 + row) * GK + c16 * 8) = *(const LAS v4u*)(Qt + row * QE_ST + c16 * 16);
        *(v4u*)(F.KEg + ((size_t)u * 64 + row) * GK + c16 * 8) = *(const LAS v4u*)(Kt + row * QE_ST + c16 * 16); }
    const int w = F.wave, r = F.lane & 15, q = F.lane >> 4;
    f32x4 acc[8][2];
#pragma unroll
    for (int kf = 0; kf < 8; ++kf) { acc[kf][0] = (f32x4){0.f, 0.f, 0.f, 0.f}; acc[kf][1] = (f32x4){0.f, 0.f, 0.f, 0.f}; }
#pragma unroll
    for (int ks = 0; ks < 2; ++ks) { const bf16x8v b0 = frag_t(V, V_ST, 32 * ks, 32 * w, r, q), b1 = frag_t(V, V_ST, 32 * ks, 32 * w + 16, r, q);
#pragma unroll
        for (int kf = 0; kf < 8; ++kf) { const bf16x8v a = frag_k(KDT, KDT_ST, 16 * kf, 32 * ks, r, q); acc[kf][0] = MFMA16(a, b0, acc[kf][0]); acc[kf][1] = MFMA16(a, b1, acc[kf][1]); } }
#pragma unroll
    for (int kf = 0; kf < 8; ++kf)
#pragma unroll
        for (int vf = 0; vf < 2; ++vf) *(v2u*)(F.DS + ((size_t)u * GV + 32 * w + 16 * vf + r) * GK + 16 * kf + 4 * q) = pk4(acc[kf][vf]);
    __syncthreads();
}
__device__ __forceinline__ void gla_scan(Frame& F) {
    for (int it = F.bid * NTHR + F.tid; it < PB * GH * GV * 32; it += F.G * NTHR) { const int k4 = it & 31, v = (it >> 5) & 255, bh = it >> 13;
        f32x4 S = (f32x4){0.f, 0.f, 0.f, 0.f};
#pragma unroll 8
        for (int c = 0; c < NCH; ++c) { const int u = bh * NCH + c; const size_t off = ((size_t)u * GV + v) * GK + 4 * k4;
            const v2u d = *(const v2u*)(F.DS + off); const f32x4 e = *(const f32x4*)(F.EBL + (size_t)u * 128 + 4 * k4);
            *(v2u*)(F.SC + off) = pk4(S);
            S.x = e.x * S.x + bflo(d.x); S.y = e.y * S.y + bfhi(d.x); S.z = e.z * S.z + bflo(d.y); S.w = e.w * S.w + bfhi(d.y); }
        float* o = F.out + O_GLA_P + ((size_t)bh * GK + 4 * k4) * GV + v; o[0] = S.x; o[GV] = S.y; o[2 * GV] = S.z; o[3 * GV] = S.w; }
}
__device__ __forceinline__ void gla_passC_unit(Frame& F, int u) {
    const int c = u & 31, bh = u >> 5, b = bh >> 2, h = bh & 3, row0 = b * PL + c * CH;
    LAS unsigned char* QE = F.lds; LAS unsigned char* KE = QE + 64 * QE_ST; LAS unsigned char* V = KE + 64 * QE_ST; LAS unsigned char* ATT = V + 64 * V_ST;
    LAS float* red = (LAS float*)(ATT + 64 * ATT_ST);
    const int w = F.wave, r = F.lane & 15, q = F.lane >> 4, tf = w & 3, vh = w >> 2;
    bf16x8v scf[2][8];
    const bf16* Sc = F.SC + ((size_t)u * GV + 128 * vh) * GK;
#pragma unroll
    for (int ks = 0; ks < 2; ++ks)
#pragma unroll
        for (int i = 0; i < 8; ++i) scf[ks][i] = *(const bf16x8v*)(Sc + (size_t)(16 * i + r) * GK + 32 * ks + 8 * q);
    v2u gwv[8];
#pragma unroll
    for (int i = 0; i < 8; ++i) gwv[i] = *(const v2u*)(F.PROJ + (size_t)(row0 + 16 * tf + r) * NP + CG + h * GV + 128 * vh + 16 * i + 4 * q);
    { v4u vv[4], qq[2], kk[2];
#pragma unroll
        for (int i = 0; i < 4; ++i) { const int piece = F.tid + NTHR * i, row = piece >> 5, c16 = piece & 31; vv[i] = *(const v4u*)(F.PROJ + (size_t)(row0 + row) * NP + CV + h * GV + c16 * 8); }
#pragma unroll
        for (int i = 0; i < 2; ++i) { const int piece = F.tid + NTHR * i, row = piece >> 4, c16 = piece & 15;
            qq[i] = *(const v4u*)(F.QEg + ((size_t)u * 64 + row) * GK + c16 * 8); kk[i] = *(const v4u*)(F.KEg + ((size_t)u * 64 + row) * GK + c16 * 8); }
#pragma unroll
        for (int i = 0; i < 4; ++i) { const int piece = F.tid + NTHR * i, row = piece >> 5, c16 = piece & 31; *(LAS v4u*)(V + row * V_ST + c16 * 16) = vv[i]; }
#pragma unroll
        for (int i = 0; i < 2; ++i) { const int piece = F.tid + NTHR * i, row = piece >> 4, c16 = piece & 15;
            *(LAS v4u*)(QE + row * QE_ST + c16 * 16) = qq[i]; *(LAS v4u*)(KE + row * QE_ST + c16 * 16) = kk[i]; } }
    __syncthreads();
    f32x4 acc[8];
#pragma unroll
    for (int i = 0; i < 8; ++i) acc[i] = (f32x4){0.f, 0.f, 0.f, 0.f};
#pragma unroll
    for (int ks = 0; ks < 2; ++ks) { const bf16x8v bq = frag_k(QE, QE_ST, 16 * tf, 32 * ks, r, q);
#pragma unroll
        for (int i = 0; i < 8; ++i) acc[i] = MFMA16(scf[ks][i], bq, acc[i]); }
#pragma unroll
    for (int ks = 0; ks < 2; ++ks)
#pragma unroll
        for (int i = 0; i < 8; ++i) scf[ks][i] = *(const bf16x8v*)(Sc + (size_t)(16 * i + r) * GK + 32 * (ks + 2) + 8 * q);
#pragma unroll
    for (int ff = 0; ff < 2; ++ff) { const int f = 2 * w + ff, sf = f >> 2, tf = f & 3; f32x4 a4 = (f32x4){0.f, 0.f, 0.f, 0.f};
        if (sf <= tf) {
#pragma unroll
            for (int ks = 0; ks < 4; ++ks) a4 = MFMA16(frag_k(KE, QE_ST, 16 * sf, 32 * ks, r, q), frag_k(QE, QE_ST, 16 * tf, 32 * ks, r, q), a4); }
        const int s0 = 16 * sf + 4 * q, t = 16 * tf + r;
        f32x4 m; m.x = (s0 <= t) ? a4.x : 0.f; m.y = (s0 + 1 <= t) ? a4.y : 0.f; m.z = (s0 + 2 <= t) ? a4.z : 0.f; m.w = (s0 + 3 <= t) ? a4.w : 0.f;
        *(LAS v2u*)(ATT + t * ATT_ST + s0 * 2) = pk4(m); }
    __syncthreads();
#pragma unroll
    for (int ks = 0; ks < 2; ++ks) { const bf16x8v bq = frag_k(QE, QE_ST, 16 * tf, 32 * (ks + 2), r, q);
#pragma unroll
        for (int i = 0; i < 8; ++i) acc[i] = MFMA16(scf[ks][i], bq, acc[i]); }
#pragma unroll
    for (int ks = 0; ks < 2; ++ks) { const bf16x8v ba = frag_k(ATT, ATT_ST, 16 * tf, 32 * ks, r, q);
#pragma unroll
        for (int i = 0; i < 8; ++i) { const bf16x8v a = frag_t(V, V_ST, 32 * ks, 128 * vh + 16 * i, r, q); acc[i] = MFMA16(a, ba, acc[i]); } }
    float ss = 0.f;
#pragma unroll
    for (int i = 0; i < 8; ++i) ss += (acc[i].x * acc[i].x + acc[i].y * acc[i].y) + (acc[i].z * acc[i].z + acc[i].w * acc[i].w);
    ss += __shfl_xor(ss, 16); ss += __shfl_xor(ss, 32);
    const int t = 16 * tf + r;
    if (q == 0) red[vh * 64 + t] = ss;
    __syncthreads();
    const float rr = rsqrtf((red[t] + red[64 + t]) * (1.f / GV) + EPS); const size_t row = (size_t)(row0 + t);
#pragma unroll
    for (int i = 0; i < 8; ++i) { const int v = 128 * vh + 16 * i + 4 * q;
        const v2u gw = gwv[i]; const f32x4 nw = *(const f32x4*)(F.gla_norm + v);
        f32x4 o; o.x = acc[i].x * rr * nw.x * silu_f(bflo(gw.x)); o.y = acc[i].y * rr * nw.y * silu_f(bfhi(gw.x)); o.z = acc[i].z * rr * nw.z * silu_f(bflo(gw.y)); o.w = acc[i].w * rr * nw.w * silu_f(bfhi(gw.y));
        *(v2u*)(F.MIXIN + row * DM + h * GV + v) = pk4(o); }
    __syncthreads();
}

template <bool SCALE>
__device__ __forceinline__ void ssd_conv_item(Frame& F, int b, int g, int c, int cg, int tb, LAS unsigned char* X, LAS unsigned char* BT, LAS unsigned char* CT, const LAS float* WDEC) {
    const int xc = cg < 64 ? g * 512 + 8 * cg : (cg < 80 ? 1024 + g * 128 + 8 * (cg - 64) : 1280 + g * 128 + 8 * (cg - 80));
    float w[4][8], bias[8];
#pragma unroll
    for (int j = 0; j < 4; ++j) { const f32x4 a = *(const f32x4*)(F.sconv_w + j * SCH + xc), bq = *(const f32x4*)(F.sconv_w + j * SCH + xc + 4);
        w[j][0] = a.x; w[j][1] = a.y; w[j][2] = a.z; w[j][3] = a.w; w[j][4] = bq.x; w[j][5] = bq.y; w[j][6] = bq.z; w[j][7] = bq.w; }
    { const f32x4 a = *(const f32x4*)(F.sconv_b + xc), bq = *(const f32x4*)(F.sconv_b + xc + 4); bias[0] = a.x; bias[1] = a.y; bias[2] = a.z; bias[3] = a.w; bias[4] = bq.x; bias[5] = bq.y; bias[6] = bq.z; bias[7] = bq.w; }
    v4u raw[11];
#pragma unroll
    for (int i = 0; i < 11; ++i) { const int tt = c * CH + tb * 8 - 3 + i;
        raw[i] = (tt >= 0) ? *(const v4u*)(F.PROJ + (size_t)(b * PL + tt) * NP + CX + xc) : (v4u){0u, 0u, 0u, 0u}; }
#pragma unroll
    for (int t = 0; t < 8; ++t) { float o[8];
#pragma unroll
        for (int e = 0; e < 8; ++e) { float a = bias[e];
#pragma unroll
            for (int j = 0; j < 4; ++j) { const unsigned wd = raw[t + j][e >> 1]; a += w[j][e] * ((e & 1) ? bfhi(wd) : bflo(wd)); }
            o[e] = silu_f(a); }
        const int tl = tb * 8 + t;
        if (SCALE && cg < 64) { const float sc = WDEC[(cg >> 3) * 64 + tl];
#pragma unroll
            for (int e = 0; e < 8; ++e) o[e] *= sc; }
        const v4u pkd = (v4u){pk2(o[0], o[1]), pk2(o[2], o[3]), pk2(o[4], o[5]), pk2(o[6], o[7])};
        LAS unsigned char* dst = cg < 64 ? X + tl * X_ST + cg * 16 : (cg < 80 ? BT + tl * BC_ST + (cg - 64) * 16 : CT + tl * BC_ST + (cg - 80) * 16);
        *(LAS v4u*)dst = pkd; }
}
__device__ __forceinline__ float ssd_head_scan(Frame& F, int hd, int row0, float& dt_out, float& last) {
    const float dt = softplus_f(F.LRDT[(size_t)(row0 + F.lane) * 32 + 16 + hd] + F.dt_bias[hd]);
    float cum = dt * (-__expf(F.A_log[hd]));
#pragma unroll
    for (int o = 1; o < 64; o <<= 1) { const float v = __shfl_up(cum, o); cum += (F.lane >= o) ? v : 0.f; }
    dt_out = dt; last = __shfl(cum, 63); return cum;
}
__device__ __forceinline__ void ssd_passA_unit(Frame& F, int u) {
    const int c = u & 31, bg = u >> 5, b = bg >> 1, g = bg & 1, row0 = b * PL + c * CH;
    LAS unsigned char* X = F.lds; LAS unsigned char* BT = X + 64 * X_ST; LAS float* WDEC = (LAS float*)(BT + 64 * BC_ST);
    const int w = F.wave, r = F.lane & 15, q = F.lane >> 4;
    { float dt, last; const float cum = ssd_head_scan(F, g * 8 + w, row0, dt, last);
        WDEC[w * 64 + F.lane] = __expf(last - cum) * dt; if (F.lane == 63) F.AL[(size_t)u * 8 + w] = __expf(last); }
    __syncthreads();
    for (int it = F.tid; it < 80 * 8; it += NTHR) ssd_conv_item<true>(F, b, g, c, it % 80, it / 80, X, BT, nullptr, WDEC);
    __syncthreads();
#pragma unroll 1
    for (int nh = 0; nh < 2; ++nh) {
        f32x4 acc[4][4];
#pragma unroll
        for (int i = 0; i < 4; ++i)
#pragma unroll
            for (int j = 0; j < 4; ++j) acc[i][j] = (f32x4){0.f, 0.f, 0.f, 0.f};
#pragma unroll
        for (int ks = 0; ks < 2; ++ks) { bf16x8v bp[4];
#pragma unroll
            for (int pf = 0; pf < 4; ++pf) bp[pf] = frag_t(X, X_ST, 32 * ks, 64 * w + 16 * pf, r, q);
#pragma unroll
            for (int nf = 0; nf < 4; ++nf) { const bf16x8v a = frag_t(BT, BC_ST, 32 * ks, 64 * nh + 16 * nf, r, q);
#pragma unroll
                for (int pf = 0; pf < 4; ++pf) acc[nf][pf] = MFMA16(a, bp[pf], acc[nf][pf]); } }
#pragma unroll
        for (int nf = 0; nf < 4; ++nf)
#pragma unroll
            for (int pf = 0; pf < 4; ++pf) *(v2u*)(F.DH + (((size_t)u * 8 + w) * SP + 16 * pf + r) * SN + 64 * nh + 16 * nf + 4 * q) = pk4(acc[nf][pf]);
    }
    __syncthreads();
}
__device__ __forceinline__ void ssd_scan(Frame& F) {
    for (int it = F.bid * NTHR + F.tid; it < PB * SH * SP * 32; it += F.G * NTHR) { const int n4 = it & 31, p = (it >> 5) & 63, bhd = it >> 11, b = bhd >> 4, hd = bhd & 15, g = hd >> 3, hl = hd & 7;
        f32x4 H = (f32x4){0.f, 0.f, 0.f, 0.f};
#pragma unroll 8
        for (int c = 0; c < NCH; ++c) { const int u = (b * 2 + g) * NCH + c; const size_t off = (((size_t)u * 8 + hl) * SP + p) * SN + 4 * n4;
            const v2u d = *(const v2u*)(F.DH + off); const float a = F.AL[(size_t)u * 8 + hl];
            *(v2u*)(F.HC + off) = pk4(H);
            H.x = a * H.x + bflo(d.x); H.y = a * H.y + bfhi(d.x); H.z = a * H.z + bflo(d.y); H.w = a * H.w + bfhi(d.y); }
        *(f32x4*)(F.out + O_SSD_P + ((size_t)bhd * SP + p) * SN + 4 * n4) = H; }
}
__device__ __forceinline__ void ssd_passC_unit(Frame& F, int u) {
    const int c = u & 31, bg = u >> 5, b = bg >> 1, g = bg & 1, row0 = b * PL + c * CH;
    LAS unsigned char* X = F.lds; LAS unsigned char* BT = X + 64 * X_ST; LAS unsigned char* CT = BT + 64 * BC_ST; LAS unsigned char* CB = CT + 64 * BC_ST;
    LAS float* DT = (LAS float*)(CB + 64 * ATT_ST); LAS float* CUM = DT + 512; LAS float* red = CUM + 512;
    const int w = F.wave, r = F.lane & 15, q = F.lane >> 4, hd = g * 8 + w;
    bf16x8v hcf[4][4];
    const bf16* Hc0 = F.HC + ((size_t)u * 8 + w) * SP * SN;
#pragma unroll
    for (int ks = 0; ks < 2; ++ks)
#pragma unroll
        for (int pf = 0; pf < 4; ++pf) hcf[ks][pf] = *(const bf16x8v*)(Hc0 + (size_t)(16 * pf + r) * SN + 32 * ks + 8 * q);
    { float dt, last; const float cum = ssd_head_scan(F, hd, row0, dt, last); DT[w * 64 + F.lane] = dt; CUM[w * 64 + F.lane] = cum; }
    for (int it = F.tid; it < 96 * 8; it += NTHR) ssd_conv_item<false>(F, b, g, c, it % 96, it / 96, X, BT, CT, nullptr);
#pragma unroll
    for (int ks = 2; ks < 4; ++ks)
#pragma unroll
        for (int pf = 0; pf < 4; ++pf) hcf[ks][pf] = *(const bf16x8v*)(Hc0 + (size_t)(16 * pf + r) * SN + 32 * ks + 8 * q);
    __syncthreads();
#pragma unroll
    for (int ff = 0; ff < 2; ++ff) { const int f = 2 * w + ff, sf = f >> 2, tf = f & 3; f32x4 a4 = (f32x4){0.f, 0.f, 0.f, 0.f};
        if (sf <= tf) {
#pragma unroll
            for (int ks = 0; ks < 4; ++ks) a4 = MFMA16(frag_k(BT, BC_ST, 16 * sf, 32 * ks, r, q), frag_k(CT, BC_ST, 16 * tf, 32 * ks, r, q), a4); }
        *(LAS v2u*)(CB + (16 * tf + r) * ATT_ST + (16 * sf + 4 * q) * 2) = pk4(a4); }
    __syncthreads();
    f32x4 acc[4][4];
#pragma unroll
    for (int i = 0; i < 4; ++i)
#pragma unroll
        for (int j = 0; j < 4; ++j) acc[i][j] = (f32x4){0.f, 0.f, 0.f, 0.f};
#pragma unroll
    for (int ks = 0; ks < 4; ++ks) { bf16x8v bc[4];
#pragma unroll
        for (int tf = 0; tf < 4; ++tf) bc[tf] = frag_k(CT, BC_ST, 16 * tf, 32 * ks, r, q);
#pragma unroll
        for (int pf = 0; pf < 4; ++pf) {
#pragma unroll
            for (int tf = 0; tf < 4; ++tf) acc[pf][tf] = MFMA16(hcf[ks][pf], bc[tf], acc[pf][tf]); } }
    float ct[4];
#pragma unroll
    for (int tf = 0; tf < 4; ++tf) { ct[tf] = CUM[w * 64 + 16 * tf + r]; const float e = __expf(ct[tf]);
#pragma unroll
        for (int pf = 0; pf < 4; ++pf) acc[pf][tf] = acc[pf][tf] * e; }
#pragma unroll
    for (int ks = 0; ks < 2; ++ks) { bf16x8v ax[4];
#pragma unroll
        for (int pf = 0; pf < 4; ++pf) ax[pf] = frag_t(X, X_ST, 32 * ks, 64 * w + 16 * pf, r, q);
        const int s0 = 32 * ks + 8 * q;
        const f32x4 cs0 = *(const LAS f32x4*)(CUM + w * 64 + s0), cs1 = *(const LAS f32x4*)(CUM + w * 64 + s0 + 4), ds0 = *(const LAS f32x4*)(DT + w * 64 + s0), ds1 = *(const LAS f32x4*)(DT + w * 64 + s0 + 4);
        const float cs[8] = {cs0.x, cs0.y, cs0.z, cs0.w, cs1.x, cs1.y, cs1.z, cs1.w}, ds[8] = {ds0.x, ds0.y, ds0.z, ds0.w, ds1.x, ds1.y, ds1.z, ds1.w};
#pragma unroll
        for (int tf = 0; tf < 4; ++tf) { if (32 * ks > 16 * tf + 15) continue;
            const int t = 16 * tf + r; const v4u cb8 = *(const LAS v4u*)(CB + t * ATT_ST + s0 * 2); float l[8];
#pragma unroll
            for (int e = 0; e < 8; ++e) { const unsigned wd = cb8[e >> 1]; const float cbv = (e & 1) ? bfhi(wd) : bflo(wd); l[e] = (s0 + e <= t) ? cbv * __expf(ct[tf] - cs[e]) * ds[e] : 0.f; }
            const v4u lp = (v4u){pk2(l[0], l[1]), pk2(l[2], l[3]), pk2(l[4], l[5]), pk2(l[6], l[7])}; const bf16x8v bl = __builtin_bit_cast(bf16x8v, lp);
#pragma unroll
            for (int pf = 0; pf < 4; ++pf) acc[pf][tf] = MFMA16(ax[pf], bl, acc[pf][tf]); } }
    const float Dh = F.ssd_D[hd];
#pragma unroll
    for (int tf = 0; tf < 4; ++tf) { const int t = 16 * tf + r; const size_t row = (size_t)(row0 + t); float ss = 0.f;
#pragma unroll
        for (int pf = 0; pf < 4; ++pf) { const int p4 = 64 * w + 16 * pf + 4 * q;
            const v2u xv = *(const LAS v2u*)(X + t * X_ST + p4 * 2); const v2u zv = *(const v2u*)(F.PROJ + row * NP + CZ + g * 512 + p4);
            f32x4 y = acc[pf][tf];
            y.x = (y.x + Dh * bflo(xv.x)) * silu_f(bflo(zv.x)); y.y = (y.y + Dh * bfhi(xv.x)) * silu_f(bfhi(zv.x)); y.z = (y.z + Dh * bflo(xv.y)) * silu_f(bflo(zv.y)); y.w = (y.w + Dh * bfhi(xv.y)) * silu_f(bfhi(zv.y));
            acc[pf][tf] = y; ss += (y.x * y.x + y.y * y.y) + (y.z * y.z + y.w * y.w); }
        ss += __shfl_xor(ss, 16); ss += __shfl_xor(ss, 32);
        if (q == 0) red[w * 64 + t] = ss; }
    __syncthreads();
#pragma unroll
    for (int tf = 0; tf < 4; ++tf) { const int t = 16 * tf + r; const size_t row = (size_t)(row0 + t); float tot = 0.f;
#pragma unroll
        for (int ww = 0; ww < 8; ++ww) tot += red[ww * 64 + t];
        const float rr = rsqrtf(tot * (1.f / 512.f) + EPS);
#pragma unroll
        for (int pf = 0; pf < 4; ++pf) { const int p4 = g * 512 + 64 * w + 16 * pf + 4 * q; const f32x4 nw = *(const f32x4*)(F.ssd_norm + p4);
            f32x4 o = acc[pf][tf]; o.x *= rr * nw.x; o.y *= rr * nw.y; o.z *= rr * nw.z; o.w *= rr * nw.w;
            *(v2u*)(F.MIXIN + row * DM + 1024 + p4) = pk4(o); } }
    __syncthreads();
}

constexpr int ATT8_ST = 80;
__device__ __forceinline__ void gla_sample_unit(Frame& F, int b, int h, f32x4 (&S)[16], int nb, int nh, bool has_next) {
    const int tid = F.tid, w = F.wave, lane = F.lane, r = lane & 15, q = lane >> 4, row0 = MP + b * SL;
    LAS unsigned char* S0b = F.lds;
    LAS unsigned char* Vt = S0b + 128 * V_ST;
    LAS unsigned char* QE = Vt + 32 * V_ST;
    LAS unsigned char* KE = QE + 16 * QE_ST;
    LAS unsigned char* ATT = KE + 16 * QE_ST;
    LAS float* KD = (LAS float*)(ATT + 16 * ATT8_ST);
    LAS float* EL = KD + 1024;
    LAS float* red = EL + 128;
    f32x4 Vf[8];
#pragma unroll
    for (int s = 0; s < 8; ++s) { const v2u vv = *(const v2u*)(F.PROJ + (size_t)(row0 + s) * NP + CV + h * GV + 4 * lane); Vf[s] = (f32x4){bflo(vv.x), bfhi(vv.x), bflo(vv.y), bfhi(vv.y)}; }
    if (tid < 256) { const int t = tid >> 5, c16 = tid & 31; *(LAS v4u*)(Vt + t * V_ST + c16 * 16) = *(const v4u*)(F.PROJ + (size_t)(row0 + t) * NP + CV + h * GV + c16 * 8); }
    for (int i = tid; i < 24 * 32; i += NTHR) *(LAS v4u*)(Vt + (8 + (i >> 5)) * V_ST + (i & 31) * 16) = (v4u){0u, 0u, 0u, 0u};
    { LAS unsigned char* KR = (LAS unsigned char*)(red + 128); LAS unsigned char* QR = KR + 8 * 256; LAS float* LR = (LAS float*)(QR + 8 * 256); LAS float* LG = LR + 128;
        if (tid < 256) { const int which = tid >> 7, j = tid & 127, t = j >> 4, c16 = j & 15;
            *(LAS v4u*)((which ? QR : KR) + t * 256 + c16 * 16) = *(const v4u*)(F.PROJ + (size_t)(row0 + t) * NP + (which ? CQ : CK) + h * GK + c16 * 8); }
        else if (tid < 288) { const int j = tid - 256; *(LAS v4u*)(LR + (j >> 2) * 16 + (j & 3) * 4) = *(const v4u*)(F.LRDT + (size_t)(row0 + (j >> 2)) * 32 + (j & 3) * 4); }
        __syncthreads();
        { const int k = tid & 127, tp = tid >> 7, hk = h * GK + k; const float bg = F.b_gate[hk];
            float w2[16];
#pragma unroll
            for (int j = 0; j < 16; ++j) w2[j] = F.w_gate2[j * GKD + hk];
#pragma unroll
            for (int tt = 0; tt < 2; ++tt) { const int t = 2 * tp + tt; const LAS f32x4* lr = (const LAS f32x4*)(LR + t * 16); const f32x4 a = lr[0], bq = lr[1], c = lr[2], d = lr[3];
                const float x = bg + a.x * w2[0] + a.y * w2[1] + a.z * w2[2] + a.w * w2[3] + bq.x * w2[4] + bq.y * w2[5] + bq.z * w2[6] + bq.w * w2[7]
                              + c.x * w2[8] + c.y * w2[9] + c.z * w2[10] + c.w * w2[11] + d.x * w2[12] + d.y * w2[13] + d.z * w2[14] + d.w * w2[15];
                LG[t * 128 + k] = logsigmoid_f(x) * (1.f / 16.f); } }
        __syncthreads();
        if (tid < 128) { const int k = tid;
            float bcum[8], kv[8]; float run = 0.f;
#pragma unroll
            for (int t = 0; t < 8; ++t) { run += LG[t * 128 + k]; bcum[t] = run; kv[t] = bf2f(*(const LAS bf16*)(KR + t * 256 + k * 2));
                *(LAS bf16*)(QE + t * QE_ST + k * 2) = (bf16)f2bf(bf2f(*(const LAS bf16*)(QR + t * 256 + k * 2)) * 0.08838834764831845f * __expf(run));
                *(LAS bf16*)(KE + t * QE_ST + k * 2) = (bf16)f2bf(kv[t] * __expf(-run)); }
            f32x4 d0, d1; d0.x = kv[0] * __expf(run - bcum[0]); d0.y = kv[1] * __expf(run - bcum[1]); d0.z = kv[2] * __expf(run - bcum[2]); d0.w = kv[3] * __expf(run - bcum[3]);
            d1.x = kv[4] * __expf(run - bcum[4]); d1.y = kv[5] * __expf(run - bcum[5]); d1.z = kv[6] * __expf(run - bcum[6]); d1.w = kv[7];
            *(LAS f32x4*)(KD + k * 8) = d0; *(LAS f32x4*)(KD + k * 8 + 4) = d1; EL[k] = __expf(run); } }
    if (tid < 128) {
    } else if (tid < 384) { const int i = tid - 128, which = i >> 7, j = i & 127;
        *(LAS v4u*)((which ? KE : QE) + (8 + (j >> 4)) * QE_ST + (j & 15) * 16) = (v4u){0u, 0u, 0u, 0u};
    } else if (tid < 384 + 80) { *(LAS v4u*)(ATT + (tid - 384) * 16) = (v4u){0u, 0u, 0u, 0u}; }
#pragma unroll
    for (int i = 0; i < 16; ++i) *(LAS v2u*)(S0b + (16 * w + i) * V_ST + lane * 8) = pk4(S[i]);
    __syncthreads();
    if (w == 0) { f32x4 a4 = (f32x4){0.f, 0.f, 0.f, 0.f};
#pragma unroll
        for (int ks = 0; ks < 4; ++ks) a4 = MFMA16(frag_k(KE, QE_ST, 0, 32 * ks, r, q), frag_k(QE, QE_ST, 0, 32 * ks, r, q), a4);
        const int s0i = 4 * q; f32x4 m; m.x = (s0i <= r) ? a4.x : 0.f; m.y = (s0i + 1 <= r) ? a4.y : 0.f; m.z = (s0i + 2 <= r) ? a4.z : 0.f; m.w = (s0i + 3 <= r) ? a4.w : 0.f;
        if (r >= 8) m = (f32x4){0.f, 0.f, 0.f, 0.f};
        *(LAS v2u*)(ATT + r * ATT8_ST + s0i * 2) = pk4(m); }
    { f32x4* so = (f32x4*)(F.out + O_GLA_S + ((size_t)(b * GH + h) * GK + 16 * w) * GV) + lane;
#pragma unroll
        for (int i = 0; i < 16; ++i) { const int k = 16 * w + i; const float e = EL[k]; const f32x4 k0 = *(const LAS f32x4*)(KD + k * 8), k1 = *(const LAS f32x4*)(KD + k * 8 + 4);
            f32x4 n = S[i] * e; n = n + Vf[0] * k0.x; n = n + Vf[1] * k0.y; n = n + Vf[2] * k0.z; n = n + Vf[3] * k0.w; n = n + Vf[4] * k1.x; n = n + Vf[5] * k1.y; n = n + Vf[6] * k1.z; n = n + Vf[7] * k1.w;
            so[i * 64] = n; } }
    if (has_next) { const f32x4* s1 = (const f32x4*)(F.st_gla + ((size_t)(nb * GH + nh) * GK + 16 * w) * GV) + lane;
#pragma unroll
        for (int i = 0; i < 16; ++i) S[i] = s1[i * 64]; }
    f32x4 acc[2] = {(f32x4){0.f, 0.f, 0.f, 0.f}, (f32x4){0.f, 0.f, 0.f, 0.f}};
#pragma unroll
    for (int ks = 0; ks < 4; ++ks) { const bf16x8v bq = frag_k(QE, QE_ST, 0, 32 * ks, r, q);
#pragma unroll
        for (int vf = 0; vf < 2; ++vf) acc[vf] = MFMA16(frag_t(S0b, V_ST, 32 * ks, 32 * w + 16 * vf, r, q), bq, acc[vf]); }
    __syncthreads();
    { const bf16x8v ba = *(const LAS bf16x8v*)(ATT + r * ATT8_ST + 16 * q);
#pragma unroll
        for (int vf = 0; vf < 2; ++vf) acc[vf] = MFMA16(frag_t(Vt, V_ST, 0, 32 * w + 16 * vf, r, q), ba, acc[vf]); }
    float ss = (acc[0].x * acc[0].x + acc[0].y * acc[0].y) + (acc[0].z * acc[0].z + acc[0].w * acc[0].w) + (acc[1].x * acc[1].x + acc[1].y * acc[1].y) + (acc[1].z * acc[1].z + acc[1].w * acc[1].w);
    ss += __shfl_xor(ss, 16); ss += __shfl_xor(ss, 32);
    if (q == 0) red[w * 16 + r] = ss;
    __syncthreads();
    float tot = 0.f;
#pragma unroll
    for (int ww = 0; ww < 8; ++ww) tot += red[ww * 16 + r];
    const float rr = rsqrtf(tot * (1.f / GV) + EPS);
    if (r < 8) { const size_t row = (size_t)(row0 + r);
#pragma unroll
        for (int vf = 0; vf < 2; ++vf) { const int v = 32 * w + 16 * vf + 4 * q;
            const v2u gw = *(const v2u*)(F.PROJ + row * NP + CG + h * GV + v); const f32x4 nw = *(const f32x4*)(F.gla_norm + v);
            f32x4 o; o.x = acc[vf].x * rr * nw.x * silu_f(bflo(gw.x)); o.y = acc[vf].y * rr * nw.y * silu_f(bfhi(gw.x)); o.z = acc[vf].z * rr * nw.z * silu_f(bflo(gw.y)); o.w = acc[vf].w * rr * nw.w * silu_f(bfhi(gw.y));
            *(v2u*)(F.MIXIN + row * DM + h * GV + v) = pk4(o); } }
    __syncthreads();
}
__device__ __forceinline__ void ssd_sample_unit(Frame& F, int b, int g) {
    const int tid = F.tid, w = F.wave, lane = F.lane, r = lane & 15, q = lane >> 4, row0 = MP + b * SL, hd = g * 8 + w, ch = g * 512 + tid;
    LAS float* Xs = (LAS float*)F.lds;
    LAS float* XW = Xs + 4096;
    LAS float* Bs = XW + 4096;
    LAS unsigned char* Cb = (LAS unsigned char*)(Bs + 1024);
    LAS unsigned char* Bb = Cb + 16 * QE_ST;
    LAS float* CBm = (LAS float*)(Bb + 16 * QE_ST);
    LAS float* CD = CBm + 256;
    LAS float* red = CD + 128;
    const float* h0base = F.st_ssd + ((size_t)(b * SH + hd) * SP) * SN; float* hobase = F.out + O_SSD_S + ((size_t)(b * SH + hd) * SP) * SN;
    f32x4 hbuf[4][2];
#pragma unroll
    for (int i = 0; i < 4; ++i) { const size_t off = (size_t)(16 * (i & 3) + r) * SN + 32 * (i >> 2) + 8 * q; hbuf[i][0] = *(const f32x4*)(h0base + off); hbuf[i][1] = *(const f32x4*)(h0base + off + 4); }
    float dt[8], cum[8]; { const float A = -__expf(F.A_log[hd]), dtb = F.dt_bias[hd]; float run = 0.f;
#pragma unroll
        for (int t = 0; t < 8; ++t) { dt[t] = softplus_f(F.LRDT[(size_t)(row0 + t) * 32 + 16 + hd] + dtb); run += dt[t] * A; cum[t] = run; } }
    const float last = cum[7], elast = __expf(last);
    if (lane < 8) { float cv = cum[0], dv = dt[0];
#pragma unroll
        for (int t = 1; t < 8; ++t) { cv = (lane == t) ? cum[t] : cv; dv = (lane == t) ? dt[t] : dv; }
        CD[w * 16 + lane] = cv; CD[w * 16 + 8 + lane] = dv; }
    { float xr[11]; const float cb = F.sconv_b[ch], c0 = F.sconv_w[ch], c1 = F.sconv_w[SCH + ch], c2 = F.sconv_w[2 * SCH + ch], c3 = F.sconv_w[3 * SCH + ch];
#pragma unroll
        for (int i = 0; i < 11; ++i) xr[i] = xbc_raw(F, 1, b, row0, i - 3, ch);
        float xw[8];
#pragma unroll
        for (int t = 0; t < 8; ++t) { const float x = silu_f(cb + c0 * xr[t] + c1 * xr[t + 1] + c2 * xr[t + 2] + c3 * xr[t + 3]); Xs[t * 512 + tid] = x; xw[t] = x * __expf(last - cum[t]) * dt[t]; }
        *(LAS f32x4*)(XW + tid * 8) = (f32x4){xw[0], xw[1], xw[2], xw[3]}; *(LAS f32x4*)(XW + tid * 8 + 4) = (f32x4){xw[4], xw[5], xw[6], xw[7]}; }
    if (tid < 256) { const int n = tid & 127, isC = tid >> 7, cc = 1024 + isC * 256 + g * 128 + n;
        float xr[11]; const float cb = F.sconv_b[cc], c0 = F.sconv_w[cc], c1 = F.sconv_w[SCH + cc], c2 = F.sconv_w[2 * SCH + cc], c3 = F.sconv_w[3 * SCH + cc];
#pragma unroll
        for (int i = 0; i < 11; ++i) xr[i] = xbc_raw(F, 1, b, row0, i - 3, cc);
#pragma unroll
        for (int t = 0; t < 8; ++t) { const float x = silu_f(cb + c0 * xr[t] + c1 * xr[t + 1] + c2 * xr[t + 2] + c3 * xr[t + 3]);
            if (!isC) Bs[t * 128 + n] = x;
            *(LAS bf16*)((isC ? Cb : Bb) + t * QE_ST + n * 2) = (bf16)f2bf(x); }
    } else { const int i = tid - 256, which = i >> 7, j = i & 127; *(LAS v4u*)((which ? Bb : Cb) + (8 + (j >> 4)) * QE_ST + (j & 15) * 16) = (v4u){0u, 0u, 0u, 0u}; }
    __syncthreads();
    if (w == 0) { f32x4 a4 = (f32x4){0.f, 0.f, 0.f, 0.f};
#pragma unroll
        for (int ks = 0; ks < 4; ++ks) a4 = MFMA16(frag_k(Bb, QE_ST, 0, 32 * ks, r, q), frag_k(Cb, QE_ST, 0, 32 * ks, r, q), a4);
        *(LAS f32x4*)(CBm + r * 16 + 4 * q) = a4; }
    bf16x8v bc[4];
#pragma unroll
    for (int ks = 0; ks < 4; ++ks) bc[ks] = frag_k(Cb, QE_ST, 0, 32 * ks, r, q);
    f32x4 acc[4];
#pragma unroll
    for (int pf = 0; pf < 4; ++pf) acc[pf] = (f32x4){0.f, 0.f, 0.f, 0.f};
    f32x4 Bv[8][2];
#pragma unroll
    for (int st = 0; st < 16; ++st) { const int ks = st >> 2, pf = st & 3;
        if (pf == 0) {
#pragma unroll
            for (int s = 0; s < 8; ++s) { Bv[s][0] = *(const LAS f32x4*)(Bs + s * 128 + 32 * ks + 8 * q); Bv[s][1] = *(const LAS f32x4*)(Bs + s * 128 + 32 * ks + 8 * q + 4); } }
        const int p = 16 * pf + r; const size_t off = (size_t)p * SN + 32 * ks + 8 * q;
        const f32x4 ha = hbuf[st & 3][0], hb = hbuf[st & 3][1];
        if (st + 4 < 16) { const int st2 = st + 4; const size_t off2 = (size_t)(16 * (st2 & 3) + r) * SN + 32 * (st2 >> 2) + 8 * q; hbuf[st & 3][0] = *(const f32x4*)(h0base + off2); hbuf[st & 3][1] = *(const f32x4*)(h0base + off2 + 4); }
        asm volatile("" ::: "memory");
        const f32x4 x0 = *(const LAS f32x4*)(XW + (64 * w + p) * 8), x1 = *(const LAS f32x4*)(XW + (64 * w + p) * 8 + 4);
        f32x4 na = ha * elast, nb = hb * elast;
        na = na + Bv[0][0] * x0.x; nb = nb + Bv[0][1] * x0.x; na = na + Bv[1][0] * x0.y; nb = nb + Bv[1][1] * x0.y; na = na + Bv[2][0] * x0.z; nb = nb + Bv[2][1] * x0.z; na = na + Bv[3][0] * x0.w; nb = nb + Bv[3][1] * x0.w;
        na = na + Bv[4][0] * x1.x; nb = nb + Bv[4][1] * x1.x; na = na + Bv[5][0] * x1.y; nb = nb + Bv[5][1] * x1.y; na = na + Bv[6][0] * x1.z; nb = nb + Bv[6][1] * x1.z; na = na + Bv[7][0] * x1.w; nb = nb + Bv[7][1] * x1.w;
        *(f32x4*)(hobase + off) = na; *(f32x4*)(hobase + off + 4) = nb;
        const v4u ap = (v4u){pk2(ha.x, ha.y), pk2(ha.z, ha.w), pk2(hb.x, hb.y), pk2(hb.z, hb.w)};
        acc[pf] = MFMA16(__builtin_bit_cast(bf16x8v, ap), bc[ks], acc[pf]); }
    __syncthreads();
    const int tc = r & 7; const float ct = CD[w * 16 + tc], ect = __expf(ct), Dh = F.ssd_D[hd];
    float L[8]; { const f32x4 c0 = *(const LAS f32x4*)(CBm + r * 16), c1 = *(const LAS f32x4*)(CBm + r * 16 + 4); const float cbv[8] = {c0.x, c0.y, c0.z, c0.w, c1.x, c1.y, c1.z, c1.w};
        const f32x4 q0 = *(const LAS f32x4*)(CD + w * 16), q1 = *(const LAS f32x4*)(CD + w * 16 + 4), d0 = *(const LAS f32x4*)(CD + w * 16 + 8), d1 = *(const LAS f32x4*)(CD + w * 16 + 12);
        const float cu[8] = {q0.x, q0.y, q0.z, q0.w, q1.x, q1.y, q1.z, q1.w}, dd[8] = {d0.x, d0.y, d0.z, d0.w, d1.x, d1.y, d1.z, d1.w};
#pragma unroll
        for (int s = 0; s < 8; ++s) L[s] = (s <= tc) ? cbv[s] * __expf(ct - cu[s]) * dd[s] : 0.f; }
    float ss = 0.f; const size_t row = (size_t)(row0 + tc);
#pragma unroll
    for (int pf = 0; pf < 4; ++pf) { const int p4 = 64 * w + 16 * pf + 4 * q;
        f32x4 y = acc[pf] * ect;
#pragma unroll
        for (int s = 0; s < 8; ++s) y = y + *(const LAS f32x4*)(Xs + s * 512 + p4) * L[s];
        const f32x4 xt = *(const LAS f32x4*)(Xs + tc * 512 + p4); const v2u zv = *(const v2u*)(F.PROJ + row * NP + CZ + g * 512 + p4);
        y.x = (y.x + Dh * xt.x) * silu_f(bflo(zv.x)); y.y = (y.y + Dh * xt.y) * silu_f(bfhi(zv.x)); y.z = (y.z + Dh * xt.z) * silu_f(bflo(zv.y)); y.w = (y.w + Dh * xt.w) * silu_f(bfhi(zv.y));
        acc[pf] = y; ss += (y.x * y.x + y.y * y.y) + (y.z * y.z + y.w * y.w); }
    ss += __shfl_xor(ss, 16); ss += __shfl_xor(ss, 32);
    if (q == 0) red[w * 16 + r] = ss;
    __syncthreads();
    float tot = 0.f;
#pragma unroll
    for (int ww = 0; ww < 8; ++ww) tot += red[ww * 16 + r];
    const float rr = rsqrtf(tot * (1.f / 512.f) + EPS);
    if (r < 8) {
#pragma unroll
        for (int pf = 0; pf < 4; ++pf) { const int p4 = g * 512 + 64 * w + 16 * pf + 4 * q; const f32x4 nw = *(const f32x4*)(F.ssd_norm + p4);
            f32x4 o = acc[pf]; o.x *= rr * nw.x; o.y *= rr * nw.y; o.z *= rr * nw.z; o.w *= rr * nw.w;
            *(v2u*)(F.MIXIN + row * DM + 1024 + p4) = pk4(o); } }
    __syncthreads();
}

__device__ __forceinline__ void p2a_chunk_states(Frame& F) {
    for (int idx = F.bid; idx < 768; idx += F.G) { if (idx < 256) { TBEGIN(F, 20); ssd_passA_unit(F, idx); TEND(F, 20); } else { TBEGIN(F, 21); gla_passA_unit(F, idx - 256); TEND(F, 21); } }
}
#ifndef MK_REP_PHASE
#define MK_REP_PHASE (-1)
#endif
__device__ __forceinline__ void p2b_scans_and_sample(Frame& F) {
    TBEGIN(F, 30); for (int rep = 0; rep < (MK_REP_PHASE == 30 ? 2 : 1); ++rep) { gla_scan(F); ssd_scan(F); } TEND(F, 30);
    TBEGIN(F, 31);
    for (int rep = 0; rep < (MK_REP_PHASE == 31 ? 2 : 1); ++rep)
    { f32x4 S[16]; int idx = F.bid;
            if (idx < SB * GH) { const f32x4* s0 = (const f32x4*)(F.st_gla + ((size_t)idx * GK + 16 * F.wave) * GV) + F.lane;
#pragma unroll
                for (int i = 0; i < 16; ++i) S[i] = s0[i * 64]; }
            for (; idx < SB * GH; idx += F.G) { const int nx = idx + F.G; gla_sample_unit(F, idx / GH, idx % GH, S, nx / GH, nx % GH, nx < SB * GH); } }
    TEND(F, 31); TBEGIN(F, 32);
    for (int rep = 0; rep < (MK_REP_PHASE == 32 ? 2 : 1); ++rep)
        for (int idx = F.bid; idx < SB * SG; idx += F.G) ssd_sample_unit(F, idx / SG, idx % SG);
    TEND(F, 32);
}
__device__ __forceinline__ void p2c_outputs(Frame& F) {
    for (int idx = F.bid; idx < 768; idx += F.G) { if (idx < 256) { TBEGIN(F, 40); ssd_passC_unit(F, idx); TEND(F, 40); } else { TBEGIN(F, 41); gla_passC_unit(F, idx - 256); TEND(F, 41); } }
    TBEGIN(F, 42);
    const int gt = F.bid * NTHR + F.tid, NT = F.G * NTHR;
    for (int i = gt; i < (PB + SB) * 3 * SCH; i += NT) { const int c = i % SCH, j = (i / SCH) % 3, s = i / (3 * SCH);
        const int grp = s >= PB, b = grp ? s - PB : s, L = grp ? SL : PL, row0 = grp ? MP + b * SL : b * PL;
        F.out[(grp ? O_SCONV_S : O_SCONV_P) + ((size_t)b * 3 + j) * SCH + c] = bf2f(F.PROJ[(size_t)(row0 + L - 3 + j) * NP + CX + c]); }
    TEND(F, 42);
}

struct PmRow { v2u mx[8]; f32x4 x[8]; };
__device__ __forceinline__ void pm_load(const Frame& F, int m, int lane, PmRow& R) {
    const v2u* mr = (const v2u*)((const bf16*)F.MIX + (size_t)m * DM) + lane; const f32x4* xr = (const f32x4*)x_row(F, m) + lane;
#pragma unroll
    for (int j = 0; j < 8; ++j) R.mx[j] = mr[64 * j];
#pragma unroll
    for (int j = 0; j < 8; ++j) R.x[j] = xr[64 * j];
}
__device__ __forceinline__ void pm_finish(const Frame& F, int m, int lane, const PmRow& R) {
    const f32x4* w1 = (const f32x4*)F.n_mix_post + lane; const f32x4* w2 = (const f32x4*)F.n_ffn_pre + lane;
    f32x4 v[8]; float s = 0.f;
#pragma unroll
    for (int j = 0; j < 8; ++j) { const v2u p = R.mx[j]; v[j] = (f32x4){bflo(p.x), bfhi(p.x), bflo(p.y), bfhi(p.y)}; s += (v[j].x * v[j].x + v[j].y * v[j].y) + (v[j].z * v[j].z + v[j].w * v[j].w); }
    const float r1 = rsqrtf(wave_sum(s) * (1.f / DM) + EPS); float s2 = 0.f;
    f32x4* ho = (f32x4*)(F.out + O_Y + (size_t)m * DM) + lane;
#pragma unroll
    for (int j = 0; j < 8; ++j) { v[j] = R.x[j] + v[j] * r1 * w1[64 * j]; ho[64 * j] = v[j]; s2 += (v[j].x * v[j].x + v[j].y * v[j].y) + (v[j].z * v[j].z + v[j].w * v[j].w); }
    const float r2 = rsqrtf(wave_sum(s2) * (1.f / DM) + EPS);
    v2u* o8 = (v2u*)(F.XN + (size_t)m * DM) + lane;
#pragma unroll
    for (int j = 0; j < 8; ++j) { const f32x4 ww = w2[64 * j]; v2u o; o.x = pk2(v[j].x * r2 * ww.x, v[j].y * r2 * ww.y); o.y = pk2(v[j].z * r2 * ww.z, v[j].w * r2 * ww.w); o8[64 * j] = o; }
}
__device__ __forceinline__ void p4_post_mixer(Frame& F) {
    const int gw = F.bid * NWAVES + F.wave, NGW = F.G * NWAVES, lane = F.lane;
    PmRow A, B; int m = gw;
    if (m >= M) return;
    pm_load(F, m, lane, A);
    for (;;) {
        const bool hb = m + NGW < M; if (hb) pm_load(F, m + NGW, lane, B);
        pm_finish(F, m, lane, A); if (!hb) break; m += NGW;
        const bool ha = m + NGW < M; if (ha) pm_load(F, m + NGW, lane, A);
        pm_finish(F, m, lane, B); if (!ha) break; m += NGW;
    }
}
__device__ __forceinline__ void p6_conv_fixup(Frame& F) {
    const int gt = F.bid * NTHR + F.tid, NT = F.G * NTHR;
    constexpr int NQ = FF / 4;
    for (int it = gt; it < 28 * 2 * NQ; it += NT) { const int c = (it % NQ) * 4, rr = (it / NQ) & 1, bi = it / (2 * NQ), pm = (bi / 7) * 8 + 1 + (bi % 7);
        f32x4 o[2];
#pragma unroll
        for (int hf = 0; hf < 2; ++hf) { const int cc = hf * FF + c;
            const f32x4 w0 = *(const f32x4*)(F.fconv_w + cc), w1 = *(const f32x4*)(F.fconv_w + FF2 + cc), w2 = *(const f32x4*)(F.fconv_w + 2 * FF2 + cc), bs = *(const f32x4*)(F.fconv_b + cc);
            const f32x4 um2 = *(const f32x4*)(F.HG + ((size_t)(pm - 1) * 4 + 2 + rr) * FF2 + cc);
            const f32x4 um1 = rr ? *(const f32x4*)(F.HG + ((size_t)pm * 4) * FF2 + cc) : *(const f32x4*)(F.HG + ((size_t)(pm - 1) * 4 + 3) * FF2 + cc);
            const f32x4 u0 = *(const f32x4*)(F.HG + ((size_t)pm * 4 + rr) * FF2 + cc);
            o[hf] = bs + w0 * um2 + w1 * um1 + w2 * u0; }
        v2u pk; pk.x = pk2(silu_f(o[0].x) * o[1].x, silu_f(o[0].y) * o[1].y); pk.y = pk2(silu_f(o[0].z) * o[1].z, silu_f(o[0].w) * o[1].w);
        *(v2u*)(F.ACT + (size_t)(pm * 256 + rr) * FF + c) = pk; }
    for (int i = gt; i < PB * 2 * (FF2 / 4); i += NT) { const int c = (i % (FF2 / 4)) * 4, j = (i / (FF2 / 4)) & 1, b = i / (2 * (FF2 / 4));
        *(f32x4*)(F.out + O_FCONV_P + ((size_t)b * 2 + j) * FF2 + c) = *(const f32x4*)(F.HG + ((size_t)(b * 8 + 7) * 4 + 2 + j) * FF2 + c); }
}
struct FnRow { v2u f[8]; f32x4 h[8]; };
__device__ __forceinline__ void fn_load(const Frame& F, int m, int lane, FnRow& R) {
    const v2u* fr = (const v2u*)((const bf16*)F.Fb + (size_t)m * DM) + lane; const f32x4* ho = (const f32x4*)(F.out + O_Y + (size_t)m * DM) + lane;
#pragma unroll
    for (int j = 0; j < 8; ++j) R.f[j] = fr[64 * j];
#pragma unroll
    for (int j = 0; j < 8; ++j) R.h[j] = ho[64 * j];
}
__device__ __forceinline__ void fn_finish(const Frame& F, int m, int lane, const FnRow& R) {
    const f32x4* w1 = (const f32x4*)F.n_ffn_post + lane; f32x4* ho = (f32x4*)(F.out + O_Y + (size_t)m * DM) + lane;
    f32x4 v[8]; float s = 0.f;
#pragma unroll
    for (int j = 0; j < 8; ++j) { const v2u p = R.f[j]; v[j] = (f32x4){bflo(p.x), bfhi(p.x), bflo(p.y), bfhi(p.y)}; s += (v[j].x * v[j].x + v[j].y * v[j].y) + (v[j].z * v[j].z + v[j].w * v[j].w); }
    const float r1 = rsqrtf(wave_sum(s) * (1.f / DM) + EPS);
#pragma unroll
    for (int j = 0; j < 8; ++j) ho[64 * j] = R.h[j] + v[j] * r1 * w1[64 * j];
}
__device__ __forceinline__ void p8_final(Frame& F) {
    const int gw = F.bid * NWAVES + F.wave, NGW = F.G * NWAVES, lane = F.lane;
    FnRow A, B; int m = gw;
    if (m >= M) return;
    fn_load(F, m, lane, A);
    for (;;) {
        const bool hb = m + NGW < M; if (hb) fn_load(F, m + NGW, lane, B);
        fn_finish(F, m, lane, A); if (!hb) break; m += NGW;
        const bool ha = m + NGW < M; if (ha) fn_load(F, m + NGW, lane, A);
        fn_finish(F, m, lane, B); if (!ha) break; m += NGW;
    }
}
__device__ __forceinline__ pg8::SplitCtx split_ctx(const Frame& F, unsigned char* ws, size_t slab_off, int bank) {
    pg8::SplitCtx X; X.slabs = (pg8::f32x4*)(ws + slab_off); X.cnt = (unsigned*)(ws + WS_CTL) + CW_SPLIT + bank * 1024; X.flag = (volatile LAS unsigned*)(F.lds + MISC_OFF) + 16; X.id = bank; return X; }

struct Args { const float* in[25]; float* out; unsigned char* ws; int ph_lo, ph_hi; };
__global__ void __launch_bounds__(NTHR, 2) fwd_kernel(Args args) {
    extern __shared__ __attribute__((aligned(16))) unsigned char lds[];
    Frame F;
    F.lds = (LAS unsigned char*)lds;
    F.tid = threadIdx.x; F.lane = F.tid & 63; F.wave = __builtin_amdgcn_readfirstlane(F.tid >> 6);
    F.G = gridDim.x; F.bid = blockIdx.x;
    unsigned char* ws = args.ws;
    F.x_p = args.in[0]; F.x_s = args.in[1]; F.st_gla = args.in[2]; F.st_ssd = args.in[3]; F.st_sconv = args.in[4]; F.st_fconv = args.in[5];
    F.n_mix_pre = args.in[6]; F.n_mix_post = args.in[7]; F.n_ffn_pre = args.in[8]; F.n_ffn_post = args.in[9]; F.w_in = args.in[10];
    F.w_gate2 = args.in[11]; F.b_gate = args.in[12]; F.gla_norm = args.in[13]; F.sconv_w = args.in[14]; F.sconv_b = args.in[15];
    F.dt_bias = args.in[16]; F.A_log = args.in[17]; F.ssd_D = args.in[18]; F.ssd_norm = args.in[19]; F.w_out = args.in[20];
    F.ffn_w_in = args.in[21]; F.fconv_w = args.in[22]; F.fconv_b = args.in[23]; F.ffn_w_out = args.in[24];
    F.out = args.out;
    F.W1 = (bf16*)(ws + WS_W1); F.WO = (bf16*)(ws + WS_WO); F.WF1 = (bf16*)(ws + WS_WF1); F.WF2 = (bf16*)(ws + WS_WF2);
    F.XN = (bf16*)(ws + WS_XN); F.PROJ = (bf16*)(ws + WS_PROJ); F.MIXIN = (bf16*)(ws + WS_MIXIN); F.ACT = (bf16*)(ws + WS_ACT); F.HG = (float*)(ws + WS_HG);
    F.LRDT = (float*)(ws + WS_LRDT); F.MIX = (float*)(ws + WS_MIX); F.Fb = (float*)(ws + WS_F);
    F.DS = (bf16*)(ws + WS_DS); F.SC = (bf16*)(ws + WS_SC); F.DH = (bf16*)(ws + WS_DH); F.HC = (bf16*)(ws + WS_HC); F.EBL = (float*)(ws + WS_EBL); F.AL = (float*)(ws + WS_AL); F.QEg = (bf16*)(ws + WS_QEG); F.KEg = (bf16*)(ws + WS_KEG);
    for (int u = F.tid; u < (LDS_BYTES - LDSCTL_OFF) / 4; u += NTHR) ((LAS unsigned*)(F.lds + LDSCTL_OFF))[u] = 0u;
    __syncthreads();
    const int lo = args.ph_lo, hi = args.ph_hi;
#if !MK_PER_PHASE
    XcdBarrier bar = xcd_barrier_post((unsigned*)(ws + WS_CTL) + CW_BAR, (volatile LAS unsigned*)(F.lds + MISC_OFF) + 8);
#define GRID_BAR() do { if (args.ph_hi > 1000) cg::this_grid().sync(); xcd_barrier(bar); } while (0)
#else
#define GRID_BAR() do { } while (0)
#endif
#define IN(k) (lo <= (k) && (k) < hi)
#define SEAM(k) do { if (IN(k) && IN((k) + 1)) GRID_BAR(); } while (0)
    F.tacc = 0; F.tmark = 0;
#define PHASE(k, ...) do { if (IN(k)) { TBEGIN(F, k); if (MK_REP_PHASE == (k)) { __VA_ARGS__; GRID_BAR(); } TBEGIN(F, 100 + (k)); __VA_ARGS__; TEND(F, 100 + (k)); SEAM(k); TEND(F, k); } } while (0)
    PHASE(0, p0_prologue(F));
    PHASE(1, { pg8::Gemm g{F.XN, F.W1, M, N1, DM}; pg8::StaticOrder S; S.init(M, N1, DM, F.G, F.bid, 1);
        pg8::EpiBf16 E{F.PROJ, NP, NP / 256, F.LRDT};
        pg8::gemm_phase<pg8::EpiBf16, pg8::StaticOrder, true, true>(F.lds, g, S, E, split_ctx(F, ws, WS_SLAB, 0));
        if (S.rem && F.bid >= S.rem * S.S) p0_convert_rest(F, F.bid - S.rem * S.S, F.G - S.rem * S.S); else if (!S.rem) p0_convert_rest(F, F.bid, F.G); });
    PHASE(2, p2a_chunk_states(F));
    PHASE(3, p2b_scans_and_sample(F));
    PHASE(4, p2c_outputs(F));
    PHASE(5, { pg8::Gemm g{F.MIXIN, F.WO, M, DM, DM}; pg8::StaticOrder S; S.init(M, DM, DM, F.G, F.bid, 4);
        pg8::EpiBf16 E{(bf16*)F.MIX, DM, DM / 256, nullptr};
        pg8::gemm_phase<pg8::EpiBf16, pg8::StaticOrder, true, true>(F.lds, g, S, E, split_ctx(F, ws, WS_SLAB, 1)); });
    PHASE(6, p4_post_mixer(F));
    PHASE(7, { pg8::Gemm g{F.XN, F.WF1, M, FF2, DM}; pg8::StaticOrder S; S.init(M, FF2, DM, F.G, F.bid, 1, MS / 256);
        pg8::EpiConvAct E{F.ACT, F.HG, F.fconv_w, F.fconv_b, F.st_fconv, F.out + O_FCONV_S, (LAS float*)(F.lds + MISC_OFF + 512)};
        pg8::gemm_phase<pg8::EpiConvAct, pg8::StaticOrder, true, true>(F.lds, g, S, E, split_ctx(F, ws, WS_SLAB, 2));
        if (S.rem && F.bid >= S.rem * S.S) t_run(F, 2, (F.bid - S.rem * S.S) * NWAVES + F.wave, (F.G - S.rem * S.S) * NWAVES); else if (!S.rem) t_run(F, 2, F.bid * NWAVES + F.wave, F.G * NWAVES); });
    PHASE(8, p6_conv_fixup(F));
    PHASE(9, { pg8::Gemm g{F.ACT, F.WF2, M, DM, FF}; pg8::StaticOrder S; S.init(M, DM, FF, F.G, F.bid, 4);
        pg8::EpiBf16 E{(bf16*)F.Fb, DM, DM / 256, nullptr};
        pg8::gemm_phase<pg8::EpiBf16, pg8::StaticOrder, true, true>(F.lds, g, S, E, split_ctx(F, ws, WS_SLAB, 3)); });
    if (IN(10)) { TBEGIN(F, 10); p8_final(F); if (MK_TIME_PHASE == 10) { asm volatile("s_waitcnt vmcnt(0)" ::: "memory"); __syncthreads(); } TEND(F, 10); }
    if (MK_TIME_PHASE >= 50 && MK_TIME_PHASE < 70) F.tacc = ((volatile LAS unsigned*)(F.lds + MISC_OFF))[16 + 2];
    if (MK_TIME_PHASE >= 0 && F.bid == 0) { const unsigned long long te = __builtin_amdgcn_s_memrealtime(), d = 8ull * F.tacc; while (__builtin_amdgcn_s_memrealtime() - te < d) __builtin_amdgcn_s_sleep(16); }
#undef IN
#undef SEAM
}

extern "C" void kernel_launch(void* const* d_in, const int* in_sizes, int n_in, void* d_out, int out_size, void* d_ws, size_t ws_size, hipStream_t stream) {
    static int grid = 0;
    if (grid == 0) {
        if (n_in != 25 || (size_t)out_size != O_END || ws_size < WS_END) { fprintf(stderr, "kernel_launch: unexpected sizes n_in %d out %d ws %zu (need out %zu ws %zu)\n", n_in, out_size, ws_size, (size_t)O_END, (size_t)WS_END); grid = -1; return; }
        int dev = 0, cus = 0, per_cu = 0;
        hipGetDevice(&dev); hipDeviceGetAttribute(&cus, hipDeviceAttributeMultiprocessorCount, dev);
        if (hipFuncSetAttribute((const void*)fwd_kernel, hipFuncAttributeMaxDynamicSharedMemorySize, LDS_BYTES) != hipSuccess) { fprintf(stderr, "kernel_launch: hipFuncSetAttribute failed\n"); grid = -1; return; }
        hipOccupancyMaxActiveBlocksPerMultiprocessor(&per_cu, (const void*)fwd_kernel, NTHR, LDS_BYTES);
        if (per_cu < 1) { fprintf(stderr, "kernel_launch: occupancy query says %d blocks per CU\n", per_cu); grid = -1; return; }
        grid = cus;
        (void)hipGetLastError();
    }
    if (grid < 0) return;
    Args a{};
    for (int i = 0; i < 25; ++i) a.in[i] = (const float*)d_in[i];
    a.out = (float*)d_out; a.ws = (unsigned char*)d_ws;
#if MK_PER_PHASE
    hipMemsetAsync((char*)d_ws + WS_CTL, 0, CTL_ZERO_BYTES, stream);
    for (int p = 0; p < N_PHASES; ++p) { a.ph_lo = p; a.ph_hi = p + 1; hipLaunchKernelGGL(fwd_kernel, dim3(grid), dim3(NTHR), LDS_BYTES, stream, a); }
#else
    hipMemsetAsync((char*)d_ws + WS_CTL, 0, CTL_ZERO_BYTES, stream);
    a.ph_lo = 0; a.ph_hi = N_PHASES;
    void* kargs[] = {&a};
    hipError_t e = hipLaunchCooperativeKernel((const void*)fwd_kernel, dim3(grid), dim3(NTHR), kargs, LDS_BYTES, stream);
    if (e != hipSuccess) fprintf(stderr, "kernel_launch: cooperative launch failed: %s (grid %d)\n", hipGetErrorString(e), grid);
#endif
}
```

```cpp
#include <hip/hip_runtime.h>
#include <hip/hip_cooperative_groups.h>
#include <cstdio>
#include <cstdint>
namespace cg = cooperative_groups;

#ifndef MK_TIME_PHASE
#define MK_TIME_PHASE (-1)
#endif
#ifndef MK_PER_PHASE
#define MK_PER_PHASE 0
#endif

namespace pg8 {
#define PG8_LAS __attribute__((address_space(3)))
typedef unsigned short bf16_t;
typedef short bf16x8 __attribute__((ext_vector_type(8)));
typedef float f32x4 __attribute__((ext_vector_type(4)));
typedef unsigned u32x4 __attribute__((ext_vector_type(4)));
constexpr int BM = 256, BK = 64, HALF = 128, HTB = HALF * BK * 2  , STAGE_BYTES = 8 * HTB, NXCD = 8, WGM = 8;

__host__ __device__ __forceinline__ int lds_byte(int r, int c) { const int st = (r >> 4) * 2 + (c >> 5), rr = r & 15, cc = c & 31, ob = rr * 64 + cc * 2; return st * 1024 + (ob ^ (((ob >> 9) & 1) << 5)); }
__host__ __device__ __forceinline__ void stage_rc(int b, int& R, int& C) { const int st = b / 1024, sb = b % 1024, swz = sb ^ (((sb >> 9) & 1) << 5); R = (st >> 1) * 16 + swz / 64; C = (st & 1) * 32 + (swz % 64) / 2; }
__host__ __device__ __forceinline__ int perm32(int rho) { const int n = rho >> 4, i = rho & 15; return 8 * (i >> 2) + 4 * n + (i & 3); }

struct Unit { int pm, pn, k0, nk, slice, nsl, tix; };
struct Gemm { const bf16_t* A; const bf16_t* Bt; int M, N, K; };

struct StaticOrder {
    int nM, nN, nwg, G, c, rounds, rem, S, ntK, nSp;
    __host__ __device__ __forceinline__ void init(int M, int N, int K, int G_, int c_, int Smax, int nSp_ = 0) { nM = M / BM; nN = N / BM; nwg = nM * nN; G = G_; c = c_; ntK = K / BK; rounds = nwg / G; rem = nwg - rounds * G; S = 1; nSp = nSp_;
        if (rem) { while (S < Smax && rem * (S * 2) <= G && (ntK / 2) >= S * 2) S *= 2; if (Smax == 4 && S != 4) S = 1; } }
    __host__ __device__ __forceinline__ void tile(int L, Unit& u) const {
        const int nfirst = nSp * nN;
        if (L >= rem && L < rem + nfirst) { const int Ls = L - rem; u.pm = nM - nSp + (Ls % nSp); u.pn = Ls / nSp; return; }
        const int nMp = nM - nSp, nwp = nMp * nN;
        int wgid = (L < rem) ? L : L - nfirst; { const int q = nwp / NXCD, r = nwp % NXCD, xcd = wgid % NXCD, off = wgid / NXCD; wgid = (xcd < r ? xcd * (q + 1) : r * (q + 1) + (xcd - r) * q) + off; }
        const int nig = WGM * nN, gid = wgid / nig, fm = gid * WGM, gsz = (nMp - fm) < WGM ? (nMp - fm) : WGM;
        u.pm = fm + ((wgid % nig) % gsz); u.pn = (wgid % nig) / gsz; }
    __host__ __device__ __forceinline__ bool next(int i, Unit& u) const {
        if (i < rounds) { tile(i * G + c, u); u.k0 = 0; u.nk = ntK; u.slice = 0; u.nsl = 1; u.tix = 0; return true; }
        if (i == rounds && c < rem * S) { const int tix = c % rem, sl = c / rem; tile(rounds * G + tix, u);
            const int pairs = ntK / 2, base = pairs / S, extra = pairs % S, np = base + (sl < extra ? 1 : 0), p0 = sl * base + (sl < extra ? sl : extra);
            u.k0 = 2 * p0; u.nk = 2 * np; u.slice = sl; u.nsl = S; u.tix = tix; return true; }
        return false;
    }
    __device__ __forceinline__ void a_ready(const Unit&) const {}
    __device__ __forceinline__ void done(const Unit&) const {}
};
__device__ __forceinline__ unsigned cvt_pk_bf16(float lo, float hi) { unsigned r; asm volatile("v_cvt_pk_bf16_f32 %0, %1, %2" : "=v"(r) : "v"(lo), "v"(hi)); return r; }
struct SplitCtx { f32x4* slabs; unsigned* cnt; volatile PG8_LAS unsigned* flag; int id; };
typedef unsigned u32x2s __attribute__((ext_vector_type(2)));
#define PG8_PIN8(p, i) asm volatile("" : "+v"(p[i]), "+v"(p[i + 1]), "+v"(p[i + 2]), "+v"(p[i + 3]), "+v"(p[i + 4]), "+v"(p[i + 5]), "+v"(p[i + 6]), "+v"(p[i + 7]) :: "memory")
__device__ __forceinline__ void slab_store(const f32x4 (&acc)[2][2][4][2], const __amdgpu_buffer_rsrc_t rs, unsigned mine) {
#pragma unroll
    for (int a = 0; a < 2; ++a)
#pragma unroll
        for (int b = 0; b < 2; ++b)
#pragma unroll
            for (int m = 0; m < 4; ++m)
#pragma unroll
                for (int n = 0; n < 2; ++n) { const f32x4 v = acc[a][b][m][n]; __builtin_amdgcn_raw_buffer_store_b64((u32x2s){cvt_pk_bf16(v.x, v.y), cvt_pk_bf16(v.z, v.w)}, rs, mine + (unsigned)((((a * 2 + b) * 4 + m) * 2 + n) * 4096), 0,   16); }
}
__device__ __forceinline__ void slab_add(f32x4 (&acc)[2][2][4][2], const __amdgpu_buffer_rsrc_t rs, unsigned ob) {
    u32x2s p[32];
#pragma unroll
    for (int r4 = 0; r4 < 32; ++r4) p[r4] = __builtin_amdgcn_raw_buffer_load_b64(rs, ob + (unsigned)(r4 * 4096), 0,   16);
    PG8_PIN8(p, 0); PG8_PIN8(p, 8); PG8_PIN8(p, 16); PG8_PIN8(p, 24);
#pragma unroll
    for (int a = 0; a < 2; ++a)
#pragma unroll
        for (int b = 0; b < 2; ++b)
#pragma unroll
            for (int m = 0; m < 4; ++m)
#pragma unroll
                for (int n = 0; n < 2; ++n) { const u32x2s q = p[((a * 2 + b) * 4 + m) * 2 + n];
                    acc[a][b][m][n] += (f32x4){__builtin_bit_cast(float, q.x << 16), __builtin_bit_cast(float, q.x & 0xffff0000u), __builtin_bit_cast(float, q.y << 16), __builtin_bit_cast(float, q.y & 0xffff0000u)}; }
}
__device__ __forceinline__ void split_arrive_wait(const Unit& u, const SplitCtx& X, int tid, bool add, unsigned need) {
    asm volatile("s_waitcnt vmcnt(0)" ::: "memory");
    __syncthreads();
    if (tid == 0) {
        unsigned* c = X.cnt + 16 * u.tix;
        if (add) (void)__hip_atomic_fetch_add(c, 1u, __ATOMIC_RELAXED, __HIP_MEMORY_SCOPE_AGENT);
        if (need) { unsigned spins = 0;
            while (__hip_atomic_load(c, __ATOMIC_RELAXED, __HIP_MEMORY_SCOPE_AGENT) < need) { __builtin_amdgcn_s_sleep(2); if (++spins > (1u << 22)) break; }
            asm volatile("s_waitcnt vmcnt(0)" ::: "memory"); }
    }
    __syncthreads();
}
#define PG8_PIN4(p, i) asm volatile("" : "+v"(p[i]), "+v"(p[i + 1]), "+v"(p[i + 2]), "+v"(p[i + 3]) :: "memory")
template <int NSL, int SL>
__device__ __forceinline__ void slab_add_share(f32x4 (&acc)[2][2][4][2], const __amdgpu_buffer_rsrc_t rs, int tix, int tid) {
    constexpr int PER = 32 / NSL, NL = (NSL - 1) * PER;
    asm volatile("; share %0 of %1 begins" :: "n"(SL), "n"(NSL));
    u32x2s p[NL];
#pragma unroll
    for (int t = 0; t < NSL - 1; ++t) { const int s = t < SL ? t : t + 1;
#pragma unroll
        for (int j = 0; j < PER; ++j) p[t * PER + j] = __builtin_amdgcn_raw_buffer_load_b64(rs, (unsigned)((tix * NSL + s) * 32 + SL * PER + j) * 4096u + (unsigned)tid * 8u, 0,   16); }
    PG8_PIN4(p, 0); PG8_PIN4(p, 4); PG8_PIN4(p, 8); PG8_PIN4(p, 12);
    if constexpr (NL > 16) { PG8_PIN4(p, 16); PG8_PIN4(p, 20); }
    if constexpr (NL > 24) PG8_PIN4(p, 24);
#pragma unroll
    for (int t = 0; t < NSL - 1; ++t)
#pragma unroll
        for (int a = 0; a < 2; ++a)
#pragma unroll
            for (int b = 0; b < 2; ++b)
#pragma unroll
                for (int m = 0; m < 4; ++m)
#pragma unroll
                    for (int n = 0; n < 2; ++n) { const int r4 = ((a * 2 + b) * 4 + m) * 2 + n;
                        if (r4 / PER == SL) { const u32x2s q = p[t * PER + r4 % PER];
                            acc[a][b][m][n] += (f32x4){__builtin_bit_cast(float, q.x << 16), __builtin_bit_cast(float, q.x & 0xffff0000u), __builtin_bit_cast(float, q.y << 16), __builtin_bit_cast(float, q.y & 0xffff0000u)}; } }
    asm volatile("; share %0 of %1 ends" :: "n"(SL), "n"(NSL));
}
template <int NSL>
__device__ __forceinline__ void slab_add_dispatch(f32x4 (&acc)[2][2][4][2], const __amdgpu_buffer_rsrc_t rs, int tix, int slice, int tid) {
    if constexpr (NSL >= 2) { if (slice == 0) slab_add_share<NSL, 0>(acc, rs, tix, tid); else if (slice == 1) slab_add_share<NSL, 1>(acc, rs, tix, tid); }
    if constexpr (NSL >= 4) { if (slice == 2) slab_add_share<NSL, 2>(acc, rs, tix, tid); else if (slice == 3) slab_add_share<NSL, 3>(acc, rs, tix, tid); }
    if constexpr (NSL >= 8) { if (slice == 4) slab_add_share<NSL, 4>(acc, rs, tix, tid); else if (slice == 5) slab_add_share<NSL, 5>(acc, rs, tix, tid);
                              else if (slice == 6) slab_add_share<NSL, 6>(acc, rs, tix, tid); else if (slice == 7) slab_add_share<NSL, 7>(acc, rs, tix, tid); }
}
__device__ __forceinline__ int split_reduce(f32x4 (&acc)[2][2][4][2], const Unit& u, const SplitCtx& X, int tid) {
    const __amdgpu_buffer_rsrc_t rs = __builtin_amdgcn_make_buffer_rsrc((void*)X.slabs, (short)0, (int)0x7fffffff, 0x00020000);
    slab_store(acc, rs, (unsigned)((u.tix * u.nsl + u.slice) * 32) * 4096u + (unsigned)tid * 8u);
    split_arrive_wait(u, X, tid, true, (unsigned)u.nsl);
    slab_add_dispatch<4>(acc, rs, u.tix, u.slice, tid); return 3;
}
__device__ __forceinline__ bool split_gather(f32x4 (&acc)[2][2][4][2], const Unit& u, const SplitCtx& X, int tid) {
    const __amdgpu_buffer_rsrc_t rs = __builtin_amdgcn_make_buffer_rsrc((void*)X.slabs, (short)0, (int)0x7fffffff, 0x00020000);
    if (u.slice != 0) { slab_store(acc, rs, (unsigned)((u.tix * u.nsl + u.slice) * 32) * 4096u + (unsigned)tid * 8u); split_arrive_wait(u, X, tid, true, 0u); return false; }
    split_arrive_wait(u, X, tid, false, (unsigned)(u.nsl - 1));
    for (int s = 1; s < u.nsl; ++s) slab_add(acc, rs, (unsigned)((u.tix * u.nsl + s) * 32) * 4096u + (unsigned)tid * 8u);
    return true;
}


struct EpiF32 {
    static constexpr bool PERM = false, AFTER_DRAIN = false, GATHER = false;
    float* C; int ldc;
    __device__ __forceinline__ void operator()(const f32x4 (&acc)[2][2][4][2], const Unit& u, int wr, int wc, int fr, int fq, int shift, int part) const {
        const int row0 = u.pm * BM + wr * 64 + fr, col0 = u.pn * BM + wc * 32 + 4 * fq;
#pragma unroll
        for (int ai = 0; ai < 2; ++ai)
#pragma unroll
            for (int m = 0; m < 4; ++m) { float* rowp = C + (size_t)(row0 + ai * HALF + m * 16) * ldc + col0;
#pragma unroll
                for (int bj = 0; bj < 2; ++bj)
#pragma unroll
                    for (int n = 0; n < 2; ++n) if ((((((ai * 2 + bj) * 4 + m) * 2 + n)) >> shift) == part) *(f32x4*)(rowp + bj * HALF + n * 16) = acc[ai][bj][m][n]; }
    }
};
struct EpiBf16 {
    static constexpr bool PERM = true, AFTER_DRAIN = false, GATHER = false;
    bf16_t* O; int ldc; int nfull; float* X;
    __device__ __forceinline__ void operator()(const f32x4 (&acc)[2][2][4][2], const Unit& u, int wr, int wc, int fr, int fq, int shift, int part) const {
        const int row0 = u.pm * BM + wr * 64 + fr;
        if (u.pn < nfull) {
            const int col0 = u.pn * BM + wc * 32 + 8 * fq;
#pragma unroll
            for (int ai = 0; ai < 2; ++ai)
#pragma unroll
                for (int m = 0; m < 4; ++m) { bf16_t* rowp = O + (size_t)(row0 + ai * HALF + m * 16) * ldc + col0;
#pragma unroll
                    for (int bj = 0; bj < 2; ++bj) { if ((((((ai * 2 + bj) * 4 + m) * 2)) >> shift) != part) continue; const f32x4 v0 = acc[ai][bj][m][0], v1 = acc[ai][bj][m][1];
                        u32x4 w; w.x = cvt_pk_bf16(v0[0], v0[1]); w.y = cvt_pk_bf16(v0[2], v0[3]); w.z = cvt_pk_bf16(v1[0], v1[1]); w.w = cvt_pk_bf16(v1[2], v1[3]);
                        *(u32x4*)(rowp + bj * HALF) = w; } }
        } else if (wc == 0) {
#pragma unroll
            for (int ai = 0; ai < 2; ++ai)
#pragma unroll
                for (int m = 0; m < 4; ++m) { if ((((((ai * 2) * 4 + m) * 2)) >> shift) != part) continue; float* rowp = X + (size_t)(row0 + ai * HALF + m * 16) * 32 + 8 * fq;
                    *(f32x4*)(rowp) = acc[ai][0][m][0]; *(f32x4*)(rowp + 4) = acc[ai][0][m][1]; }
        }
    }
};

__device__ __forceinline__ float dpp_ror1(float x) { return __builtin_bit_cast(float, __builtin_amdgcn_update_dpp(0, __builtin_bit_cast(int, x), 0x121, 0xF, 0xF, false)); }
__device__ __forceinline__ float dpp_ror2(float x) { return __builtin_bit_cast(float, __builtin_amdgcn_update_dpp(0, __builtin_bit_cast(int, x), 0x122, 0xF, 0xF, false)); }
struct EpiConvAct {
    static constexpr bool PERM = true, AFTER_DRAIN = false, GATHER = true;
    static constexpr int FFD = 5632, FFD2 = 11264, MPR = 8192, NPT = 32;
    bf16_t* ACT; float* HG; const float* cw; const float* cbias; const float* st; float* fconv_s; PG8_LAS float* halo;
    __device__ __forceinline__ void operator()(const f32x4 (&acc)[2][2][4][2], const Unit& u, int wr, int wc, int fr, int fq, int, int) const {
        if (u.pm >= NPT) body<true>(acc, u, wr, wc, fr, fq); else body<false>(acc, u, wr, wc, fr, fq); }
    template <bool sample> __device__ __forceinline__ void body(const f32x4 (&acc)[2][2][4][2], const Unit& u, int wr, int wc, int fr, int fq) const {
        const int pm = u.pm, pn = u.pn, cl = wc * 32 + 8 * fq, c0 = pn * 128 + cl;
        PG8_LAS float* cwl = halo + 2048; const int tix = (wr * 4 + wc) * 64 + fq * 16 + fr; f32x4 wv = (f32x4){0.f, 0.f, 0.f, 0.f};
        if (tix < 256) { const int row = tix >> 6, q4 = tix & 63; wv = *(const f32x4*)((row < 3 ? cw + row * FFD2 : cbias) + (q4 >> 5) * FFD + pn * 128 + (q4 & 31) * 4); }
        if (fr >= 14) {
#pragma unroll
            for (int ai = 0; ai < 2; ++ai)
#pragma unroll
                for (int bj = 0; bj < 2; ++bj)
#pragma unroll
                    for (int n = 0; n < 2; ++n) *(PG8_LAS f32x4*)(halo + ((ai * 2 + wr) * 2 + (fr - 14)) * 256 + bj * 128 + cl + 4 * n) = acc[ai][bj][3][n];
            if (!sample && wr == 1) {
#pragma unroll
                for (int bj = 0; bj < 2; ++bj)
#pragma unroll
                    for (int n = 0; n < 2; ++n) *(f32x4*)(HG + ((size_t)pm * 4 + 2 + (fr - 14)) * FFD2 + bj * FFD + c0 + 4 * n) = acc[1][bj][3][n]; }
        }
        if (fr < 2 && !sample && wr == 0) {
#pragma unroll
            for (int bj = 0; bj < 2; ++bj)
#pragma unroll
                for (int n = 0; n < 2; ++n) *(f32x4*)(HG + ((size_t)pm * 4 + fr) * FFD2 + bj * FFD + c0 + 4 * n) = acc[0][bj][0][n]; }
        if (tix < 256) *(PG8_LAS f32x4*)(cwl + 4 * tix) = wv;
        __syncthreads();
        const int t8 = fr & 7;
        typedef unsigned u32x2 __attribute__((ext_vector_type(2)));
        u32x2 pk0[2][4];
#pragma unroll
        for (int n = 0; n < 2; ++n) {
            f32x4 w[2][3], bs[2];
#pragma unroll
            for (int bj = 0; bj < 2; ++bj) { bs[bj] = *(const PG8_LAS f32x4*)(cwl + 3 * 256 + bj * 128 + cl + 4 * n);
#pragma unroll
                for (int j = 0; j < 3; ++j) w[bj][j] = *(const PG8_LAS f32x4*)(cwl + j * 256 + bj * 128 + cl + 4 * n); }
#pragma unroll
            for (int ai = 0; ai < 2; ++ai) {
                f32x4 r1p[2], r2p[2];
#pragma unroll
                for (int bj = 0; bj < 2; ++bj) { f32x4 pv = (f32x4){0.f, 0.f, 0.f, 0.f};
                    if (fr >= 14 && (wr == 1 || ai == 1)) { const int pa = (wr == 1) ? ai : 0, pw = (wr == 1) ? 0 : 1; pv = *(const PG8_LAS f32x4*)(halo + ((pa * 2 + pw) * 2 + (fr - 14)) * 256 + bj * 128 + cl + 4 * n); }
#pragma unroll
                    for (int j = 0; j < 4; ++j) { r1p[bj][j] = dpp_ror1(pv[j]); r2p[bj][j] = dpp_ror2(pv[j]); } }
#pragma unroll
                for (int m = 0; m < 4; ++m) { const int row = pm * BM + ai * HALF + wr * 64 + m * 16 + fr;
                    f32x4 o[2];
#pragma unroll
                    for (int bj = 0; bj < 2; ++bj) { const f32x4 cur = acc[ai][bj][m][n]; f32x4 p1, p2;
#pragma unroll
                        for (int j = 0; j < 4; ++j) { const float c1 = dpp_ror1(cur[j]), c2 = dpp_ror2(cur[j]); p1[j] = (fr == 0) ? r1p[bj][j] : c1; p2[j] = (fr < 2) ? r2p[bj][j] : c2; r1p[bj][j] = c1; r2p[bj][j] = c2; }
                        if (sample && t8 < 2) { const int sb = (row - MPR) >> 3; const f32x4 s1 = *(const f32x4*)(st + ((size_t)sb * 2 + 1) * FFD2 + bj * FFD + c0 + 4 * n);
                            if (t8 == 0) { p1 = s1; p2 = *(const f32x4*)(st + ((size_t)sb * 2) * FFD2 + bj * FFD + c0 + 4 * n); } else p2 = s1; }
                        o[bj] = bs[bj] + w[bj][0] * p2 + w[bj][1] * p1 + w[bj][2] * cur; }
                    f32x4 g; g.x = o[0].x * __builtin_amdgcn_rcpf(1.f + __expf(-o[0].x)) * o[1].x; g.y = o[0].y * __builtin_amdgcn_rcpf(1.f + __expf(-o[0].y)) * o[1].y;
                    g.z = o[0].z * __builtin_amdgcn_rcpf(1.f + __expf(-o[0].z)) * o[1].z; g.w = o[0].w * __builtin_amdgcn_rcpf(1.f + __expf(-o[0].w)) * o[1].w;
                    const u32x2 pk = (u32x2){cvt_pk_bf16(g.x, g.y), cvt_pk_bf16(g.z, g.w)};
                    if (n == 0) pk0[ai][m] = pk;
                    else *(u32x4*)(ACT + (size_t)row * FFD + c0) = (u32x4){pk0[ai][m].x, pk0[ai][m].y, pk.x, pk.y};
                    if (sample && t8 >= 6) { const int sb = (row - MPR) >> 3;
#pragma unroll
                        for (int bj = 0; bj < 2; ++bj) *(f32x4*)(fconv_s + ((size_t)sb * 2 + (t8 - 6)) * FFD2 + bj * FFD + c0 + 4 * n) = acc[ai][bj][m][n]; }
                }
            }
        }
    }
};

template <class Epi, class Sched, bool ALIGN_EPI = false, bool SP2 = false>
__device__ __forceinline__ void gemm_phase(PG8_LAS unsigned char* lds, const Gemm g, const Sched& S, const Epi& E, const SplitCtx& X) {
    const int tid = threadIdx.x, wid = __builtin_amdgcn_readfirstlane(tid >> 6), lane = tid & 63, wr = wid >> 2, wc = wid & 3, fr = lane & 15, fq = lane >> 4;
    const int K = g.K;
    unsigned voffA[2], voffB[2];
#pragma unroll
    for (int i = 0; i < 2; ++i) { int R, C; stage_rc(tid * 16 + i * 8192, R, C); const int Rb = Epi::PERM ? ((R & ~31) + perm32(R & 31)) : R;
        voffA[i] = (unsigned)(R * K + C) * 2u; voffB[i] = (unsigned)(Rb * K + C) * 2u; }
    const size_t kstep = (size_t)(BK * 2);
    const size_t hstep = (size_t)HALF * K * 2;
    const size_t tstep = 2 * hstep;
    const unsigned ldsw = (unsigned)wid * 1024u;
    const int aoff = lds_byte(wr * 64 + fr, fq * 8), boff = lds_byte(wc * 32 + fr, fq * 8);
#define PG8_SA(b, h) (((b) * 2 + (h)) * HTB)
#define PG8_SB(b, h) ((4 + (b) * 2 + (h)) * HTB)
#define PG8_STAGE(bufoff, gbase, voff) do { _Pragma("unroll") for (int _i = 0; _i < 2; ++_i) \
        __builtin_amdgcn_global_load_lds((const unsigned*)((const char*)(gbase) + (voff)[_i]), (PG8_LAS unsigned*)(lds + (bufoff) + ldsw + _i * 8192), 16, 0, 0); } while (0)
#define PG8_LDA(dst, b, h) do { _Pragma("unroll") for (int m = 0; m < 4; ++m) _Pragma("unroll") for (int k = 0; k < 2; ++k) dst[m][k] = *(const PG8_LAS bf16x8*)(lds + PG8_SA(b, h) + aoff + m * 2048 + k * 1024); } while (0)
#define PG8_LDB(dst, b, h) do { _Pragma("unroll") for (int n = 0; n < 2; ++n) _Pragma("unroll") for (int k = 0; k < 2; ++k) dst[n][k] = *(const PG8_LAS bf16x8*)(lds + PG8_SB(b, h) + boff + n * 2048 + k * 1024); } while (0)
#define PG8_MMA(ai, bj, At, Bt) do { __builtin_amdgcn_s_setprio(1); _Pragma("unroll") for (int m = 0; m < 4; ++m) _Pragma("unroll") for (int n = 0; n < 2; ++n) _Pragma("unroll") for (int k = 0; k < 2; ++k) \
        acc[ai][bj][m][n] = __builtin_amdgcn_mfma_f32_16x16x32_bf16(Bt[n][k], At[m][k], acc[ai][bj][m][n], 0, 0, 0); __builtin_amdgcn_s_setprio(0); } while (0)
#define PG8_WAIT_V(n) asm volatile("s_waitcnt vmcnt(" #n ")" ::: "memory")
#define PG8_WAIT_L(n) asm volatile("s_waitcnt lgkmcnt(" #n ")" ::: "memory")
#define PG8_BAR __builtin_amdgcn_s_barrier()
#define PG8_SCHED __builtin_amdgcn_sched_barrier(0)
    Unit cur, nxt; int ui = 0;
    if (!S.next(0, cur)) return;
    f32x4 acc[2][2][4][2];
#pragma unroll
    for (int a = 0; a < 2; ++a)
#pragma unroll
        for (int b = 0; b < 2; ++b)
#pragma unroll
            for (int m = 0; m < 4; ++m)
#pragma unroll
                for (int n = 0; n < 2; ++n) acc[a][b][m][n] = (f32x4){0.f, 0.f, 0.f, 0.f};
    bf16x8 At[4][2], B0[2][2], B1[2][2];
    const char* cA = (const char*)g.A + (size_t)cur.pm * tstep + (size_t)cur.k0 * kstep; const char* cB = (const char*)g.Bt + (size_t)cur.pn * tstep + (size_t)cur.k0 * kstep;
    S.a_ready(cur);
    if constexpr (SP2) {
        PG8_STAGE(PG8_SB(0, 0), cB, voffB); PG8_STAGE(PG8_SB(0, 1), cB + hstep, voffB); PG8_STAGE(PG8_SA(0, 0), cA, voffA); PG8_STAGE(PG8_SA(0, 1), cA + hstep, voffA);
        if (wr == 1) PG8_BAR;
        PG8_WAIT_V(2); PG8_BAR;
        PG8_STAGE(PG8_SB(1, 0), cB + kstep, voffB); PG8_STAGE(PG8_SA(1, 0), cA + kstep, voffA); PG8_STAGE(PG8_SB(1, 1), cB + hstep + kstep, voffB);
        PG8_WAIT_V(6); PG8_BAR;
    } else {
        PG8_STAGE(PG8_SB(0, 0), cB, voffB); PG8_STAGE(PG8_SA(0, 0), cA, voffA); PG8_STAGE(PG8_SB(0, 1), cB + hstep, voffB); PG8_STAGE(PG8_SA(0, 1), cA + hstep, voffA);
        if (wr == 1) PG8_BAR;
        PG8_WAIT_V(4); PG8_BAR;
        PG8_STAGE(PG8_SB(1, 0), cB + kstep, voffB); PG8_STAGE(PG8_SA(1, 0), cA + kstep, voffA); PG8_STAGE(PG8_SB(1, 1), cB + hstep + kstep, voffB);
        PG8_WAIT_V(6); PG8_BAR;
    }
    for (;;) {
        const bool has_next = S.next(ui + 1, nxt);
        const char* nA = has_next ? (const char*)g.A + (size_t)nxt.pm * tstep + (size_t)nxt.k0 * kstep : cA; const char* nB = has_next ? (const char*)g.Bt + (size_t)nxt.pn * tstep + (size_t)nxt.k0 * kstep : cB;
        const int nt = cur.nk;
        unsigned long long tsu = 0; if (MK_TIME_PHASE == 50 + X.id && cur.nsl > 1) tsu = __builtin_amdgcn_s_memrealtime();
        for (int t = 0; t < nt; t += 2) {
            const bool last = (t == nt - 2);
            const char* a1 = cA + (size_t)(t + 1) * kstep;
            const char* a2 = last ? nA : cA + (size_t)(t + 2) * kstep; const char* b2 = last ? nB : cB + (size_t)(t + 2) * kstep;
            const char* a3 = a2 + kstep; const char* b3 = b2 + kstep;
            if (last && has_next) S.a_ready(nxt);
            if constexpr (SP2) {
            PG8_LDB(B0, 0, 0); PG8_LDB(B1, 0, 1); PG8_SCHED; PG8_LDA(At, 0, 0); PG8_STAGE(PG8_SA(1, 1), a1 + hstep, voffA);
            PG8_WAIT_V(8); PG8_WAIT_L(0); PG8_BAR; PG8_MMA(0, 0, At, B0); PG8_MMA(0, 1, At, B1); PG8_BAR; PG8_SCHED;
            PG8_LDA(At, 0, 1); PG8_STAGE(PG8_SB(0, 0), b2, voffB); PG8_STAGE(PG8_SB(0, 1), b2 + hstep, voffB); PG8_STAGE(PG8_SA(0, 0), a2, voffA);
            PG8_WAIT_V(8); PG8_WAIT_L(0); PG8_BAR; PG8_MMA(1, 0, At, B0); PG8_MMA(1, 1, At, B1); PG8_BAR; PG8_SCHED;
            PG8_LDB(B0, 1, 0); PG8_LDB(B1, 1, 1); PG8_SCHED; PG8_LDA(At, 1, 0); PG8_STAGE(PG8_SA(0, 1), a2 + hstep, voffA);
            PG8_WAIT_V(8); PG8_WAIT_L(0); PG8_BAR; PG8_MMA(0, 0, At, B0); PG8_MMA(0, 1, At, B1); PG8_BAR; PG8_SCHED;
            PG8_LDA(At, 1, 1); PG8_STAGE(PG8_SB(1, 0), b3, voffB); PG8_STAGE(PG8_SB(1, 1), b3 + hstep, voffB); PG8_STAGE(PG8_SA(1, 0), a3, voffA);
            PG8_WAIT_V(8); PG8_WAIT_L(0); PG8_BAR; PG8_MMA(1, 0, At, B0); PG8_MMA(1, 1, At, B1); PG8_BAR; PG8_SCHED;
            } else {
            PG8_LDB(B0, 0, 0); PG8_SCHED; PG8_LDA(At, 0, 0); PG8_STAGE(PG8_SA(1, 1), a1 + hstep, voffA);
            PG8_WAIT_L(8); PG8_BAR; PG8_WAIT_L(0); PG8_MMA(0, 0, At, B0); PG8_BAR; PG8_SCHED;
            PG8_LDB(B1, 0, 1); PG8_STAGE(PG8_SB(0, 0), b2, voffB);
            PG8_BAR; PG8_WAIT_L(0); PG8_MMA(0, 1, At, B1); PG8_BAR;
            PG8_LDA(At, 0, 1); PG8_STAGE(PG8_SA(0, 0), a2, voffA);
            PG8_BAR; PG8_WAIT_L(0); PG8_MMA(1, 0, At, B0); PG8_BAR; PG8_SCHED;
            PG8_STAGE(PG8_SB(0, 1), b2 + hstep, voffB);
            PG8_WAIT_V(6); PG8_BAR; PG8_MMA(1, 1, At, B1); PG8_BAR;
            PG8_LDB(B0, 1, 0); PG8_SCHED; PG8_LDA(At, 1, 0); PG8_STAGE(PG8_SA(0, 1), a2 + hstep, voffA);
            PG8_WAIT_L(8); PG8_BAR; PG8_WAIT_L(0); PG8_MMA(0, 0, At, B0); PG8_BAR; PG8_SCHED;
            PG8_LDB(B1, 1, 1); PG8_STAGE(PG8_SB(1, 0), b3, voffB);
            PG8_BAR; PG8_WAIT_L(0); PG8_MMA(0, 1, At, B1); PG8_BAR;
            PG8_LDA(At, 1, 1); PG8_STAGE(PG8_SA(1, 0), a3, voffA);
            PG8_BAR; PG8_WAIT_L(0); PG8_MMA(1, 0, At, B0); PG8_BAR; PG8_SCHED;
            PG8_STAGE(PG8_SB(1, 1), b3 + hstep, voffB);
            PG8_WAIT_V(6); PG8_BAR; PG8_MMA(1, 1, At, B1); PG8_BAR;
            }
        }
        if constexpr (ALIGN_EPI) { if (wr == 0) PG8_BAR; }
        if constexpr (!Epi::AFTER_DRAIN) { static_assert(ALIGN_EPI, "split_reduce needs the halves aligned"); bool run_epi = true; if constexpr (Epi::GATHER) { if (cur.nsl > 1) run_epi = split_gather(acc, cur, X, tid); } if (!Epi::GATHER && cur.nsl > 1) { const int shift = split_reduce(acc, cur, X, tid); E(acc, cur, wr, wc, fr, fq, shift, cur.slice); } else if (run_epi) { unsigned long long te0 = 0; if (MK_TIME_PHASE == 60 + X.id) te0 = __builtin_amdgcn_s_memrealtime(); E(acc, cur, wr, wc, fr, fq, 5, 0); if (MK_TIME_PHASE == 60 + X.id && tid == 0) { asm volatile("s_waitcnt vmcnt(0)" ::: "memory"); X.flag[2] += (unsigned)(__builtin_amdgcn_s_memrealtime() - te0); } } S.done(cur);
            if (MK_TIME_PHASE == 50 + X.id && cur.nsl > 1 && tid == 0) { asm volatile("s_waitcnt vmcnt(0)" ::: "memory"); const unsigned long long d = __builtin_amdgcn_s_memrealtime() - tsu; X.flag[2] = (unsigned)d; } }
        if (!has_next) break;
#pragma unroll
        for (int a = 0; a < 2; ++a)
#pragma unroll
            for (int b = 0; b < 2; ++b)
#pragma unroll
                for (int m = 0; m < 4; ++m)
#pragma unroll
                    for (int n = 0; n < 2; ++n) acc[a][b][m][n] = (f32x4){0.f, 0.f, 0.f, 0.f};
        cur = nxt; cA = nA; cB = nB; ++ui;
        if constexpr (ALIGN_EPI) { if (wr == 1) PG8_BAR; }
    }
    PG8_WAIT_V(0);
    if constexpr (!ALIGN_EPI) { if (wr == 0) PG8_BAR; }
    PG8_BAR;
    if constexpr (Epi::AFTER_DRAIN) { E.fused(acc, cur, wr, wc, fr, fq, lds, wid, lane); S.done(cur); }
#undef PG8_SA
#undef PG8_SB
#undef PG8_STAGE
#undef PG8_LDA
#undef PG8_LDB
#undef PG8_MMA
#undef PG8_WAIT_V
#undef PG8_WAIT_L
#undef PG8_BAR
#undef PG8_SCHED
}
}

constexpr int NWAVES = 8, NTHR = 512;
constexpr int DM = 2048, PB = 4, PL = 2048, SB = 128, SL = 8;
constexpr int MP = PB * PL, MS = SB * SL, M = MP + MS;
constexpr int GH = 4, GK = 128, GV = 256, GKD = 512, LOWR = 16;
constexpr int SH = 16, SP = 64, SN = 128, SG = 2, SCH = 1536;
constexpr int FF = 5632, FF2 = 11264, INC = 5664;
constexpr int N1 = 5888, NP = 5632;
constexpr int CQ = 0, CK = 512, CV = 1024, CG = 2048, CZ = 3072, CX = 4096;
constexpr float EPS = 1e-6f;
constexpr int N_PHASES = 11;

constexpr size_t O_Y = 0, O_GLA_P = (size_t)M * DM, O_SSD_P = O_GLA_P + (size_t)PB * GH * GK * GV, O_SCONV_P = O_SSD_P + (size_t)PB * SH * SP * SN,
                 O_FCONV_P = O_SCONV_P + (size_t)PB * 3 * SCH, O_GLA_S = O_FCONV_P + (size_t)PB * 2 * FF2, O_SSD_S = O_GLA_S + (size_t)SB * GH * GK * GV,
                 O_SCONV_S = O_SSD_S + (size_t)SB * SH * SP * SN, O_FCONV_S = O_SCONV_S + (size_t)SB * 3 * SCH, O_END = O_FCONV_S + (size_t)SB * 2 * FF2;

constexpr size_t MiB = 1u << 20;
constexpr size_t WS_CTL = 0, CTL_ZERO_BYTES = 64 * 1024;
constexpr size_t WS_WF2 = 1 * MiB;
constexpr size_t WS_W1 = 24 * MiB;
constexpr size_t WS_WO = 48 * MiB;
constexpr size_t WS_WF1 = 56 * MiB;
constexpr size_t WS_XN = 101 * MiB;
constexpr size_t WS_F = 24 * MiB;
constexpr size_t WS_BIG = 141 * MiB;
constexpr size_t WS_PROJ = WS_BIG;
constexpr size_t WS_MIX = WS_BIG;
constexpr size_t WS_ACT = WS_BIG;
constexpr size_t WS_H = WS_BIG + 204 * MiB;
constexpr size_t WS_HG = WS_BIG + 104 * MiB;
constexpr size_t WS_LRDT = WS_BIG + 100 * MiB;
constexpr size_t WS_MIXIN = WS_BIG + 104 * MiB;
constexpr size_t WS_DS = WS_XN;
constexpr size_t WS_SC = WS_BIG + 140 * MiB, WS_DH = WS_BIG + 172 * MiB, WS_HC = WS_BIG + 204 * MiB;
constexpr size_t WS_EBL = WS_BIG + 236 * MiB, WS_AL = WS_EBL + 512 * 1024;
constexpr size_t WS_SLAB = WS_BIG + 140 * MiB;
constexpr size_t WS_SLAB_F1 = WS_BIG + 198 * MiB;
constexpr size_t WS_QEG = WS_BIG + 238 * MiB, WS_KEG = WS_BIG + 246 * MiB;
constexpr size_t WS_END = WS_BIG + 254 * MiB;
static_assert(WS_WF2 + (size_t)DM * FF * 2 <= WS_W1 && WS_W1 + (size_t)N1 * DM * 2 <= WS_WO && WS_WO + (size_t)DM * DM * 2 <= WS_WF1 && WS_WF1 + (size_t)FF2 * DM * 2 <= WS_XN && WS_XN + (size_t)M * DM * 2 <= WS_BIG, "ws map 1");
static_assert(WS_F + (size_t)M * DM * 4 <= WS_XN && WS_ACT + (size_t)M * FF * 2 <= WS_HG && WS_PROJ + (size_t)M * NP * 2 <= WS_LRDT && WS_LRDT + (size_t)M * 32 * 4 <= WS_MIXIN && WS_MIXIN + (size_t)M * DM * 2 <= WS_SC && WS_HG + (size_t)32 * 4 * FF2 * 4 <= WS_SC && WS_MIX + (size_t)M * DM * 4 <= WS_LRDT, "ws map 2");
constexpr int CW_BAR = 1024;
constexpr int CW_SPLIT = 8192;

constexpr int RING_BYTES = 131072;
constexpr int SCRATCH_BYTES = 8 * 16640;
constexpr int LDSCTL_OFF = 133632, MISC_OFF = LDSCTL_OFF + 320;
constexpr int LDS_BYTES = 150016;

#ifndef MK_TIME_PHASE
#define MK_TIME_PHASE (-1)
#endif
#define TBEGIN(F, id) do { if (MK_TIME_PHASE == (id)) (F).tmark = __builtin_amdgcn_s_memrealtime(); } while (0)
#define TEND(F, id) do { if (MK_TIME_PHASE == (id)) (F).tacc += __builtin_amdgcn_s_memrealtime() - (F).tmark; } while (0)
#define GAS __attribute__((address_space(1)))
#define LAS __attribute__((address_space(3)))
typedef unsigned short bf16;
typedef unsigned v4u __attribute__((ext_vector_type(4)));
typedef unsigned v2u __attribute__((ext_vector_type(2)));
typedef float f32x4 __attribute__((ext_vector_type(4)));
#define NT_LD(p) __builtin_nontemporal_load(p)
#define NT_ST(v, p) __builtin_nontemporal_store((v), (p))
#define LDS_WAIT() asm volatile("s_waitcnt lgkmcnt(0)" ::: "memory")
#define VM_WAIT() asm volatile("s_waitcnt vmcnt(0)" ::: "memory")
typedef float f32x2c __attribute__((ext_vector_type(2)));
typedef __bf16 bf16x2c __attribute__((ext_vector_type(2)));
__device__ __forceinline__ unsigned f2bf(float f) { return (unsigned)__builtin_bit_cast(unsigned short, (__bf16)f); }
__device__ __forceinline__ unsigned pk2(float lo, float hi) { return __builtin_bit_cast(unsigned, __builtin_convertvector((f32x2c){lo, hi}, bf16x2c)); }
__device__ __forceinline__ float bf2f(unsigned short b) { return __builtin_bit_cast(float, (unsigned)b << 16); }
__device__ __forceinline__ float bflo(unsigned w) { return __builtin_bit_cast(float, w << 16); }
__device__ __forceinline__ float bfhi(unsigned w) { return __builtin_bit_cast(float, w & 0xffff0000u); }
__device__ __forceinline__ float silu_f(float x) { return x * __builtin_amdgcn_rcpf(1.f + __expf(-x)); }
__device__ __forceinline__ float softplus_f(float x) { return fmaxf(x, 0.f) + __logf(1.f + __expf(-fabsf(x))); }
__device__ __forceinline__ float logsigmoid_f(float x) { return fminf(x, 0.f) - __logf(1.f + __expf(-fabsf(x))); }
__device__ __forceinline__ float wave_sum(float v) {
#pragma unroll
    for (int o = 1; o < 64; o <<= 1) v += __shfl_xor(v, o);
    return v;
}

#define XB_TMO      128
#define XB_XCNT(j)  (256  + 64 * (j))
#define XB_XSUB(j)  (1280 + 64 * (j))
#define XB_XGEN(j)  (2304 + 64 * (j))
#define XB_TOP      3328
#define XB_TOPGEN   3392
#define XCD_BAR_WORDS 3456
#define XB_SPIN_CAP (1u << 18)

__device__ __forceinline__ unsigned xb_ld(unsigned* p)              { return __hip_atomic_load(p, __ATOMIC_RELAXED, __HIP_MEMORY_SCOPE_AGENT); }
__device__ __forceinline__ unsigned xb_add(unsigned* p, unsigned v) { return __hip_atomic_fetch_add(p, v, __ATOMIC_RELAXED, __HIP_MEMORY_SCOPE_AGENT); }
__device__ __forceinline__ unsigned xb_xcc_id() { return (unsigned)__builtin_amdgcn_s_getreg((3 << 11) | 20) & 0xFu; }
#define XB_SPIN(cond, bar) do { unsigned _sp = 0; while (cond) { __builtin_amdgcn_s_sleep(1); \
    if ((++_sp & 255u) == 0u) { if (xb_ld(&(bar)[XB_TMO])) break; if (_sp > XB_SPIN_CAP) { atomicAdd(&(bar)[XB_TMO], 1u); break; } } } } while (0)

struct XcdBarrier {
    unsigned* bar; unsigned x;
    volatile LAS unsigned* st;
};

__device__ __forceinline__ XcdBarrier xcd_barrier_post(unsigned* bar, volatile LAS unsigned* st) {
    XcdBarrier b; b.bar = bar; b.x = xb_xcc_id(); b.st = st;
    if (threadIdx.x == 0) (void)xb_add(&bar[XB_XCNT(b.x)], 1u);
    return b;
}
__device__ __forceinline__ void xcd_barrier_complete(unsigned* bar, unsigned x, unsigned& nloc, unsigned& nx) {
    const unsigned G = gridDim.x * gridDim.y * gridDim.z;
    unsigned sum, cnt, mine, sp = 0u;
    for (;;) {
        sum = 0u; cnt = 0u; mine = 0u;
#pragma unroll
        for (unsigned j = 0; j < 16; ++j) { const unsigned c = xb_ld(&bar[XB_XCNT(j)]); sum += c; cnt += (c > 0u) ? 1u : 0u; mine = (j == x) ? c : mine; }
        if (sum == G) break;
        __builtin_amdgcn_s_sleep(1);
        if ((++sp & 255u) == 0u) { if (xb_ld(&bar[XB_TMO])) break; if (sp > XB_SPIN_CAP) { atomicAdd(&bar[XB_TMO], 1u); break; } }
    }
    nloc = mine > 0u ? mine : 1u; nx = cnt > 0u ? cnt : 1u;
}

__device__ __forceinline__ void xcd_barrier(const XcdBarrier& b) {
    asm volatile("s_waitcnt vmcnt(0)" ::: "memory");
    __syncthreads();
    if (threadIdx.x == 0) {
        unsigned* bar = b.bar;
        __builtin_amdgcn_s_waitcnt(0);
        unsigned nloc = b.st[0], nx = b.st[1];
        if (nloc == 0u) { xcd_barrier_complete(bar, b.x, nloc, nx); b.st[0] = nloc; b.st[1] = nx; }
        const unsigned old = xb_add(&bar[XB_XSUB(b.x)], 1u);
        const unsigned gen = old / nloc;
        if (old + 1u == (gen + 1u) * nloc) {
            __builtin_amdgcn_fence(__ATOMIC_RELEASE, "agent");
            asm volatile("s_waitcnt vmcnt(0)" ::: "memory");
            const unsigned og = xb_add(&bar[XB_TOP], 1u);
            const unsigned tg = og / nx;
            if (og + 1u == (tg + 1u) * nx) xb_add(&bar[XB_TOPGEN], 1u);
            else XB_SPIN(xb_ld(&bar[XB_TOPGEN]) == tg, bar);
            __builtin_amdgcn_fence(__ATOMIC_ACQUIRE, "agent");
            xb_add(&bar[XB_XGEN(b.x)], 1u);
            asm volatile("s_waitcnt vmcnt(0)" ::: "memory");
        } else {
            XB_SPIN(xb_ld(&bar[XB_XGEN(b.x)]) == gen, bar);
            __builtin_amdgcn_fence(__ATOMIC_ACQUIRE, "agent");
            asm volatile("s_waitcnt vmcnt(0)" ::: "memory");
        }
    }
    __syncthreads();
}

struct Frame {
    LAS unsigned char* lds;
    int tid, lane, wave, G, bid;
    unsigned long long tacc, tmark;
    const float *x_p, *x_s, *st_gla, *st_ssd, *st_sconv, *st_fconv, *n_mix_pre, *n_mix_post, *n_ffn_pre, *n_ffn_post, *w_in, *w_gate2, *b_gate, *gla_norm,
                *sconv_w, *sconv_b, *dt_bias, *A_log, *ssd_D, *ssd_norm, *w_out, *ffn_w_in, *fconv_w, *fconv_b, *ffn_w_out;
    float* out;
    bf16 *W1, *WO, *WF1, *WF2, *XN, *PROJ, *MIXIN, *ACT, *DS, *SC, *DH, *HC, *QEg, *KEg, *Hb;
    float *LRDT, *MIX, *Fb, *EBL, *AL, *HG;
};
__device__ __forceinline__ const float* x_row(const Frame& F, int row) { return row < MP ? F.x_p + (size_t)row * DM : F.x_s + (size_t)(row - MP) * DM; }

__device__ __forceinline__ int w1_src_col(int n) { return n < 3072 ? n : (n < 5632 ? n + 16 : (n < 5648 ? n - 2560 : (n < 5664 ? n : -1))); }
struct TDesc { const float* W; bf16* WT; int K, Nsrc, Ndst, map, item; };
__device__ __forceinline__ void t_load(const TDesc& d, int lane, f32x4 (&v)[16]) {
    const int nblk = d.Ndst / 64, kb = d.item / nblk, nb = d.item % nblk, k0 = 64 * kb, n0 = 64 * nb;
    int sc = n0 + 4 * (lane & 15); if (d.map == 1) sc = w1_src_col(sc); if (d.map == 2) sc = ((sc >> 7) & 1) * FF + 128 * (sc >> 8) + (sc & 127);
#pragma unroll
    for (int i = 0; i < 16; ++i) { const int kk = 4 * i + (lane >> 4); v[i] = (sc >= 0) ? NT_LD((const f32x4*)(d.W + (size_t)(k0 + kk) * d.Nsrc + sc)) : (f32x4){0.f, 0.f, 0.f, 0.f}; }
}
__device__ __forceinline__ void t_store(const TDesc& d, int lane, LAS float* scr, const f32x4 (&v)[16]) {
    const int nblk = d.Ndst / 64, kb = d.item / nblk, nb = d.item % nblk, k0 = 64 * kb, n0 = 64 * nb;
#pragma unroll
    for (int i = 0; i < 16; ++i) { const int kk = 4 * i + (lane >> 4); LAS float* p = scr + kk * 65 + 4 * (lane & 15); p[0] = v[i].x; p[1] = v[i].y; p[2] = v[i].z; p[3] = v[i].w; }
    LDS_WAIT(); asm volatile("" ::: "memory");
    const int c = lane & 7;
#pragma unroll
    for (int j = 0; j < 8; ++j) { const int n = (lane >> 3) + 8 * j; const LAS float* s = scr + (8 * c) * 65 + n;
        v4u o; o.x = pk2(s[0 * 65], s[1 * 65]); o.y = pk2(s[2 * 65], s[3 * 65]); o.z = pk2(s[4 * 65], s[5 * 65]); o.w = pk2(s[6 * 65], s[7 * 65]);
        if (d.map == 1) *(v4u*)(d.WT + (size_t)(n0 + n) * d.K + k0 + 8 * c) = o; else NT_ST(o, (v4u*)(d.WT + (size_t)(n0 + n) * d.K + k0 + 8 * c)); }
    LDS_WAIT(); asm volatile("" ::: "memory");
}
__device__ __forceinline__ bool t_desc(const Frame& F, int which, int it, TDesc& d) {
    constexpr int I_1 = (DM / 64) * (N1 / 64), I_O = (DM / 64) * (DM / 64), I_F1 = (DM / 64) * (FF2 / 64), I_F2 = (FF / 64) * (DM / 64);
    if (which == 0) { if (it >= I_1) return false; d = TDesc{F.w_in, F.W1, DM, INC, N1, 1, it}; return true; }
    if (which == 2) { if (it >= I_F2) return false; d = TDesc{F.ffn_w_out, F.WF2, FF, DM, DM, 0, it}; return true; }
    if (it >= I_O + I_F1) return false;
    if (it < I_O) d = TDesc{F.w_out, F.WO, DM, DM, DM, 0, it};
    else d = TDesc{F.ffn_w_in, F.WF1, DM, FF2, FF2, 2, it - I_O};
    return true;
}
__device__ __forceinline__ void t_run(const Frame& F, int which, int gw, int NGW) {
    LAS float* scr = (LAS float*)(F.lds + F.wave * 16640);
    TDesc da, db; f32x4 va[16], vb[16]; int it = gw;
    if (!t_desc(F, which, it, da)) return;
    t_load(da, F.lane, va);
    for (;;) {
        const bool hb = t_desc(F, which, it + NGW, db); if (hb) t_load(db, F.lane, vb);
        t_store(da, F.lane, scr, va); if (!hb) break; it += NGW;
        const bool ha = t_desc(F, which, it + NGW, da); if (ha) t_load(da, F.lane, va);
        t_store(db, F.lane, scr, vb); if (!ha) break; it += NGW;
    }
}
__device__ __forceinline__ void stage_norm_w(const Frame& F, const float* w, LAS float* dst) { for (int i = F.tid; i < DM / 4; i += NTHR) *(LAS f32x4*)(dst + 4 * i) = *(const f32x4*)(w + 4 * i); }
struct RmRows { f32x4 a[8], b[8]; };
__device__ __forceinline__ void rm_load(const Frame& F, int m0, int m1, int lane, RmRows& R) {
    const f32x4* xa = (const f32x4*)x_row(F, m0) + lane; const f32x4* xb = (const f32x4*)x_row(F, m1) + lane;
#pragma unroll
    for (int j = 0; j < 8; ++j) R.a[j] = NT_LD(xa + 64 * j);
#pragma unroll
    for (int j = 0; j < 8; ++j) R.b[j] = NT_LD(xb + 64 * j);
}
__device__ __forceinline__ void rm_finish(const Frame& F, int m0, int m1, int lane, const RmRows& R) {
    const LAS f32x4* wr = (const LAS f32x4*)(F.lds + MISC_OFF + 512) + lane; float sa = 0.f, sb = 0.f;
#pragma unroll
    for (int j = 0; j < 8; ++j) { sa += (R.a[j].x * R.a[j].x + R.a[j].y * R.a[j].y) + (R.a[j].z * R.a[j].z + R.a[j].w * R.a[j].w); sb += (R.b[j].x * R.b[j].x + R.b[j].y * R.b[j].y) + (R.b[j].z * R.b[j].z + R.b[j].w * R.b[j].w); }
    const float ra = rsqrtf(wave_sum(sa) * (1.f / DM) + EPS), rb = rsqrtf(wave_sum(sb) * (1.f / DM) + EPS);
    v2u* pa = (v2u*)(F.XN + (size_t)m0 * DM) + lane; v2u* pb = (v2u*)(F.XN + (size_t)m1 * DM) + lane;
#pragma unroll
    for (int j = 0; j < 8; ++j) { const f32x4 ww = wr[64 * j]; v2u o; o.x = pk2(R.a[j].x * ra * ww.x, R.a[j].y * ra * ww.y); o.y = pk2(R.a[j].z * ra * ww.z, R.a[j].w * ra * ww.w); pa[64 * j] = o;
        o.x = pk2(R.b[j].x * rb * ww.x, R.b[j].y * rb * ww.y); o.y = pk2(R.b[j].z * rb * ww.z, R.b[j].w * rb * ww.w); pb[64 * j] = o; }
}
__device__ __forceinline__ void rm_run(const Frame& F, int gw, int NGW) {
    RmRows A, B; int m = gw; const int st = 2 * NGW;
    if (m >= M) return;
#define RM_M1(mm) (((mm) + NGW < M) ? (mm) + NGW : (mm))
    rm_load(F, m, RM_M1(m), F.lane, A);
    for (;;) {
        const bool hb = m + st < M; if (hb) rm_load(F, m + st, RM_M1(m + st), F.lane, B);
        rm_finish(F, m, RM_M1(m), F.lane, A); if (!hb) break; m += st;
        const bool ha = m + st < M; if (ha) rm_load(F, m + st, RM_M1(m + st), F.lane, A);
        rm_finish(F, m, RM_M1(m), F.lane, B); if (!ha) break; m += st;
    }
#undef RM_M1
}
__device__ __forceinline__ void p0_prologue(Frame& F) {
    const int gw = F.wave * F.G + F.bid, NGW = F.G * NWAVES;
    stage_norm_w(F, F.n_mix_pre, (LAS float*)(F.lds + MISC_OFF + 512)); __syncthreads();
    t_run(F, 0, gw, NGW);
    rm_run(F, gw, NGW);
}
__device__ __forceinline__ void p0_convert_rest(Frame& F, int vb, int nb) { t_run(F, 1, F.wave * nb + vb, nb * NWAVES); }

template <int grp> __device__ __forceinline__ void gla_direct_unit(Frame& F, int b, int h) {
    const int tid = F.tid, v = tid & 255, kh = tid >> 8;
    const int L = grp ? SL : PL, row0 = grp ? MP + b * SL : b * PL;
    LAS float* Es = (LAS float*)F.lds; LAS float* Ks = Es + 1024; LAS float* Qs = Ks + 1024; LAS float* Os = Qs + 1024;
    float S[64];
    if (grp) { const float* s0 = F.st_gla + ((size_t)(b * GH + h) * GK + kh * 64) * GV + v;
#pragma unroll
        for (int i = 0; i < 64; ++i) S[i] = s0[(size_t)i * GV]; }
    else {
#pragma unroll
        for (int i = 0; i < 64; ++i) S[i] = 0.f; }
    for (int t0 = 0; t0 < L; t0 += 8) {
        for (int it = tid; it < 1024; it += NTHR) { const int t = it >> 7, k = it & 127, row = row0 + t0 + t, hk = h * GK + k;
            float x = F.b_gate[hk]; const float* lr = F.LRDT + (size_t)row * 32;
#pragma unroll
            for (int j = 0; j < LOWR; ++j) x += lr[j] * F.w_gate2[j * GKD + hk];
            const float lg = logsigmoid_f(x) * (1.f / 16.f);
            Es[it] = __expf(lg); Ks[it] = bf2f(F.PROJ[(size_t)row * NP + CK + hk]); Qs[it] = bf2f(F.PROJ[(size_t)row * NP + CQ + hk]) * 0.08838834764831845f; }
        __syncthreads();
#pragma unroll 1
        for (int t = 0; t < 8; ++t) { const float vv = bf2f(F.PROJ[(size_t)(row0 + t0 + t) * NP + CV + h * GV + v]); float acc = 0.f;
            const LAS float* e = Es + t * 128 + kh * 64; const LAS float* kk = Ks + t * 128 + kh * 64; const LAS float* qq = Qs + t * 128 + kh * 64;
#pragma unroll
            for (int i = 0; i < 64; ++i) { S[i] = e[i] * S[i] + kk[i] * vv; acc += qq[i] * S[i]; }
            Os[(kh * 8 + t) * 256 + v] = acc; }
        __syncthreads();
        { const int t = F.wave, v4 = F.lane * 4, row = row0 + t0 + t;
            const f32x4 a = *(const LAS f32x4*)(Os + t * 256 + v4), c = *(const LAS f32x4*)(Os + (8 + t) * 256 + v4); const f32x4 o = a + c;
            const float ss = wave_sum((o.x * o.x + o.y * o.y) + (o.z * o.z + o.w * o.w)); const float r = rsqrtf(ss * (1.f / GV) + EPS);
            const v2u gw = *(const v2u*)(F.PROJ + (size_t)row * NP + CG + h * GV + v4); const f32x4 nw = *(const f32x4*)(F.gla_norm + v4);
            v2u w; w.x = pk2(o.x * r * nw.x * silu_f(bflo(gw.x)), o.y * r * nw.y * silu_f(bfhi(gw.x))); w.y = pk2(o.z * r * nw.z * silu_f(bflo(gw.y)), o.w * r * nw.w * silu_f(bfhi(gw.y)));
            *(v2u*)(F.MIXIN + (size_t)row * DM + h * GV + v4) = w; }
        __syncthreads();
    }
    float* so = F.out + (grp ? O_GLA_S : O_GLA_P) + ((size_t)(b * GH + h) * GK + kh * 64) * GV + v;
#pragma unroll
    for (int i = 0; i < 64; ++i) so[(size_t)i * GV] = S[i];
}
__device__ __forceinline__ float xbc_raw(const Frame& F, int grp, int b, int row0, int tt, int c) {
    if (tt >= 0) return bf2f(F.PROJ[(size_t)(row0 + tt) * NP + CX + c]);
    return grp ? F.st_sconv[((size_t)b * 3 + (tt + 3)) * SCH + c] : 0.f;
}
template <int grp> __device__ __forceinline__ void ssd_direct_unit(Frame& F, int b, int g) {
    const int tid = F.tid, hd = g * 8 + (tid >> 6), p = tid & 63, ch = g * 512 + tid;
    const int L = grp ? SL : PL, row0 = grp ? MP + b * SL : b * PL;
    LAS float* Bs = (LAS float*)F.lds; LAS float* Cs = Bs + 1024; LAS float* red = Cs + 1024; LAS float* Ys = red + 64;
    float h[128];
    if (grp) { const f32x4* h0 = (const f32x4*)(F.st_ssd + ((size_t)(b * SH + hd) * SP + p) * SN);
#pragma unroll
        for (int i = 0; i < 32; ++i) { const f32x4 q = h0[i]; h[4 * i] = q.x; h[4 * i + 1] = q.y; h[4 * i + 2] = q.z; h[4 * i + 3] = q.w; } }
    else {
#pragma unroll
        for (int i = 0; i < 128; ++i) h[i] = 0.f; }
    const float A = -__expf(F.A_log[hd]), dtb = F.dt_bias[hd], Dh = F.ssd_D[hd], nw = F.ssd_norm[ch];
    const float cb = F.sconv_b[ch], cw0 = F.sconv_w[ch], cw1 = F.sconv_w[SCH + ch], cw2 = F.sconv_w[2 * SCH + ch], cw3 = F.sconv_w[3 * SCH + ch];
    const int c2 = 1024 + (tid < 128 ? g * 128 + tid : 256 + g * 128 + ((tid - 128) & 127));
    float xr0 = xbc_raw(F, grp, b, row0, -3, ch), xr1 = xbc_raw(F, grp, b, row0, -2, ch), xr2 = xbc_raw(F, grp, b, row0, -1, ch);
    for (int t0 = 0; t0 < L; t0 += 8) {
        if (tid < 256) {
            float xr[11]; const float cb2 = F.sconv_b[c2], d0 = F.sconv_w[c2], d1 = F.sconv_w[SCH + c2], d2 = F.sconv_w[2 * SCH + c2], d3 = F.sconv_w[3 * SCH + c2];
#pragma unroll
            for (int i = 0; i < 11; ++i) xr[i] = xbc_raw(F, grp, b, row0, t0 - 3 + i, c2);
#pragma unroll
            for (int t = 0; t < 8; ++t) Bs[(tid >> 7) * 1024 + t * 128 + (tid & 127)] = silu_f(cb2 + d0 * xr[t] + d1 * xr[t + 1] + d2 * xr[t + 2] + d3 * xr[t + 3]);
        }
        __syncthreads();
#pragma unroll 1
        for (int t = 0; t < 8; ++t) { const int row = row0 + t0 + t;
            const float xn = bf2f(F.PROJ[(size_t)row * NP + CX + ch]);
            const float x = silu_f(cb + cw0 * xr0 + cw1 * xr1 + cw2 * xr2 + cw3 * xn); xr0 = xr1; xr1 = xr2; xr2 = xn;
            const float dt = softplus_f(F.LRDT[(size_t)row * 32 + 16 + hd] + dtb), a = __expf(dt * A), dtx = dt * x;
            float acc = 0.f; const LAS float* bb = Bs + t * 128; const LAS float* cc = Cs + t * 128;
#pragma unroll
            for (int nb = 0; nb < 128; nb += 16) {
#pragma unroll
                for (int n = nb; n < nb + 16; ++n) { h[n] = a * h[n] + dtx * bb[n]; acc += h[n] * cc[n]; }
                asm volatile("" ::: "memory"); }
            const float z = bf2f(F.PROJ[(size_t)row * NP + CZ + ch]);
            const float y = (acc + Dh * x) * silu_f(z);
            Ys[t * 512 + tid] = y;
            const float ss = wave_sum(y * y); if (F.lane == 0) red[t * 8 + F.wave] = ss; }
        __syncthreads();
#pragma unroll
        for (int t = 0; t < 8; ++t) { float tot = 0.f;
#pragma unroll
            for (int w = 0; w < 8; ++w) tot += red[t * 8 + w];
            const float r = rsqrtf(tot * (1.f / 512.f) + EPS);
            F.MIXIN[(size_t)(row0 + t0 + t) * DM + 1024 + ch] = (bf16)f2bf(Ys[t * 512 + tid] * r * nw); }
        __syncthreads();
    }
    f32x4* ho = (f32x4*)(F.out + (grp ? O_SSD_S : O_SSD_P) + ((size_t)(b * SH + hd) * SP + p) * SN);
#pragma unroll
    for (int i = 0; i < 32; ++i) ho[i] = (f32x4){h[4 * i], h[4 * i + 1], h[4 * i + 2], h[4 * i + 3]};
}
typedef short bf16x8v __attribute__((ext_vector_type(8)));
typedef short s16x4v __attribute__((ext_vector_type(4)));
constexpr int CH = 64, NCH = PL / CH;
constexpr int QE_ST = 272, KDT_ST = 144, V_ST = 544, ATT_ST = 144, X_ST = 1056, BC_ST = 288;
#define MFMA16(a, b, c) __builtin_amdgcn_mfma_f32_16x16x32_bf16((a), (b), (c), 0, 0, 0)
__device__ __forceinline__ bf16x8v frag_k(const LAS unsigned char* T, int stride, int idx0, int kk0, int r, int q) { return *(const LAS bf16x8v*)(T + (idx0 + r) * stride + (kk0 + 8 * q) * 2); }
__device__ __forceinline__ bf16x8v frag_t(const LAS unsigned char* T, int stride, int kk0, int idx0, int r, int q) {
    const LAS unsigned char* p = T + (kk0 + 8 * q + (r >> 2)) * stride + (idx0 + 4 * (r & 3)) * 2;
    const s16x4v lo = __builtin_amdgcn_ds_read_tr16_b64_v4i16((LAS s16x4v*)p), hi = __builtin_amdgcn_ds_read_tr16_b64_v4i16((LAS s16x4v*)(p + 4 * stride));
    return (bf16x8v){lo[0], lo[1], lo[2], lo[3], hi[0], hi[1], hi[2], hi[3]};
}
__device__ __forceinline__ v2u pk4(const f32x4 v) { v2u o; o.x = pk2(v.x, v.y); o.y = pk2(v.z, v.w); return o; }

struct GlaStage { v4u v[4], qk[4], lr; };
template <int PASS>
__device__ __forceinline__ void gla_stage_load(const Frame& F, int h, int row0, GlaStage& g) {
    const int tid = F.tid;
#pragma unroll
    for (int i = 0; i < 4; ++i) { const int piece = tid + NTHR * i, row = piece >> 5, c16 = piece & 31; g.v[i] = *(const v4u*)(F.PROJ + (size_t)(row0 + row) * NP + CV + h * GV + c16 * 8); }
#pragma unroll
    for (int i = 0; i < 2; ++i) { const int piece = tid + NTHR * i, row = piece >> 4, c16 = piece & 15;
        g.qk[i] = *(const v4u*)(F.PROJ + (size_t)(row0 + row) * NP + CK + h * GK + c16 * 8);
        if (PASS == 1) g.qk[2 + i] = *(const v4u*)(F.PROJ + (size_t)(row0 + row) * NP + CQ + h * GK + c16 * 8); }
    if (tid < 256) g.lr = *(const v4u*)(F.LRDT + (size_t)(row0 + (tid >> 2)) * 32 + (tid & 3) * 4);
}
template <int PASS>
__device__ __forceinline__ void gla_stage_store(const Frame& F, const GlaStage& g, LAS unsigned char* V, LAS unsigned char* Kt, LAS unsigned char* Qt, LAS float* LR) {
    const int tid = F.tid;
#pragma unroll
    for (int i = 0; i < 4; ++i) { const int piece = tid + NTHR * i, row = piece >> 5, c16 = piece & 31; *(LAS v4u*)(V + row * V_ST + c16 * 16) = g.v[i]; }
#pragma unroll
    for (int i = 0; i < 2; ++i) { const int piece = tid + NTHR * i, row = piece >> 4, c16 = piece & 15;
        *(LAS v4u*)(Kt + row * QE_ST + c16 * 16) = g.qk[i]; if (PASS == 1) *(LAS v4u*)(Qt + row * QE_ST + c16 * 16) = g.qk[2 + i]; }
    if (tid < 256) *(LAS v4u*)(LR + (tid >> 2) * 16 + (tid & 3) * 4) = g.lr;
}
template <int PASS>
__device__ __forceinline__ void gla_chunk_elem(Frame& F, int h, LAS unsigned char* Kt, LAS unsigned char* Qt, LAS unsigned char* KDT, const LAS float* LR, LAS float* tot, float* ebl_out) {
    const int tid = F.tid, k = tid & 127, tq = tid >> 7, hk = h * GK + k;
    float w2[16];
#pragma unroll
    for (int j = 0; j < 16; ++j) w2[j] = F.w_gate2[j * GKD + hk];
    const float bg = F.b_gate[hk];
    float lg[16]; float run = 0.f;
#pragma unroll
    for (int i = 0; i < 16; ++i) { const LAS f32x4* lr = (const LAS f32x4*)(LR + (16 * tq + i) * 16); const f32x4 a = lr[0], b = lr[1], c = lr[2], d = lr[3];
        float x = bg + a.x * w2[0] + a.y * w2[1] + a.z * w2[2] + a.w * w2[3] + b.x * w2[4] + b.y * w2[5] + b.z * w2[6] + b.w * w2[7]
                     + c.x * w2[8] + c.y * w2[9] + c.z * w2[10] + c.w * w2[11] + d.x * w2[12] + d.y * w2[13] + d.z * w2[14] + d.w * w2[15];
        run += logsigmoid_f(x) * (1.f / 16.f); lg[i] = run; }
    tot[tq * 128 + k] = run;
    __syncthreads();
    float off = 0.f, all = 0.f;
#pragma unroll
    for (int qq = 0; qq < 4; ++qq) { const float v = tot[qq * 128 + k]; all += v; off += (qq < tq) ? v : 0.f; }
    {
        unsigned pk[8];
#pragma unroll
        for (int i = 0; i < 8; ++i) { const int t = 16 * tq + 2 * i; const float b0 = off + lg[2 * i], b1 = off + lg[2 * i + 1];
            LAS bf16* k0p = (LAS bf16*)(Kt + t * QE_ST + k * 2); LAS bf16* k1p = (LAS bf16*)(Kt + (t + 1) * QE_ST + k * 2);
            LAS bf16* q0p = (LAS bf16*)(Qt + t * QE_ST + k * 2); LAS bf16* q1p = (LAS bf16*)(Qt + (t + 1) * QE_ST + k * 2);
            const float k0 = bf2f(*k0p), k1 = bf2f(*k1p);
            pk[i] = pk2(k0 * __expf(all - b0), k1 * __expf(all - b1));
            *k0p = (bf16)f2bf(k0 * __expf(-b0)); *k1p = (bf16)f2bf(k1 * __expf(-b1));
            *q0p = (bf16)f2bf(bf2f(*q0p) * 0.08838834764831845f * __expf(b0)); *q1p = (bf16)f2bf(bf2f(*q1p) * 0.08838834764831845f * __expf(b1)); }
        LAS v4u* d = (LAS v4u*)(KDT + k * KDT_ST + 32 * tq);
        d[0] = (v4u){pk[0], pk[1], pk[2], pk[3]}; d[1] = (v4u){pk[4], pk[5], pk[6], pk[7]};
        if (tq == 0) ebl_out[k] = __expf(all);
    }
}
__device__ __forceinline__ void gla_passA_unit(Frame& F, int u) {
    const int c = u & 31, bh = u >> 5, b = bh >> 2, h = bh & 3, row0 = b * PL + c * CH;
    LAS unsigned char* KDT = F.lds; LAS unsigned char* V = KDT + 128 * KDT_ST; LAS unsigned char* Kt = V + 64 * V_ST; LAS unsigned char* Qt = Kt + 64 * QE_ST; LAS float* LR = (LAS float*)(Qt + 64 * QE_ST); LAS float* tot = LR + 1024;
    { GlaStage g; gla_stage_load<1>(F, h, row0, g); gla_stage_store<1>(F, g, V, Kt, Qt, LR); }
    __syncthreads();
    gla_chunk_elem<0>(F, h, Kt, Qt, KDT, LR, tot, F.EBL + (size_t)u * 128);
    __syncthreads();
#pragma unroll
    for (int i = 0; i < 2; ++i) { const int piece = F.tid + NTHR * i, row = piece >> 4, c16 = piece & 15;
        *(v4u*)(F.QEg + ((size_t)u * 64 + row) * GK + c16 * 8) = *(const LAS v4u*)(Qt + row * QE_ST + c16 * 16);
        *(v4u*)(F.KEg + ((size_t)u * 64 + row) * GK + c16 * 8) = *(const LAS v4u*)(Kt + row * QE_ST + c16 * 16); }
    const int w = F.wave, r = F.lane & 15, q = F.lane >> 4;
    f32x4 acc[8][2];
#pragma unroll
    for (int kf = 0; kf < 8; ++kf) { acc[kf][0] = (f32x4){0.f, 0.f, 0.f, 0.f}; acc[kf][1] = (f32x4){0.f, 0.f, 0.f, 0.f}; }
#pragma unroll
    for (int ks = 0; ks < 2; ++ks) { const bf16x8v b0 = frag_t(V, V_ST, 32 * ks, 32 * w, r, q), b1 = frag_t(V, V_ST, 32 * ks, 32 * w + 16, r, q);
#pragma unroll
        for (int kf = 0; kf < 8; ++kf) { const bf16x8v a = frag_k(KDT, KDT_ST, 16 * kf, 32 * ks, r, q); acc[kf][0] = MFMA16(a, b0, acc[kf][0]); acc[kf][1] = MFMA16(a, b1, acc[kf][1]); } }
#pragma unroll
    for (int kf = 0; kf < 8; ++kf)
#pragma unroll
        for (int vf = 0; vf < 2; ++vf) *(v2u*)(F.DS + ((size_t)u * GV + 32 * w + 16 * vf + r) * GK + 16 * kf + 4 * q) = pk4(acc[kf][vf]);
    __syncthreads();
}
__device__ __forceinline__ void gla_scan(Frame& F) {
    for (int it = F.bid * NTHR + F.tid; it < PB * GH * GV * 32; it += F.G * NTHR) { const int k4 = it & 31, v = (it >> 5) & 255, bh = __builtin_amdgcn_readfirstlane(it >> 13);
        const unsigned toff = (unsigned)(v * GK + 4 * k4) * 2u; constexpr size_t CSTB = (size_t)GV * GK * 2;
        const char* ds0 = (const char*)(F.DS + (size_t)bh * NCH * GV * GK); char* sc0 = (char*)(F.SC + (size_t)bh * NCH * GV * GK);
        f32x4 S = (f32x4){0.f, 0.f, 0.f, 0.f};
        v2u d[NCH];
#pragma unroll
        for (int c = 0; c < NCH; ++c) d[c] = NT_LD((const v2u*)(ds0 + c * CSTB + toff));
        LAS float* El = (LAS float*)F.lds;
        __syncthreads();
        for (int i = F.tid; i < NCH * 32; i += NTHR) *(LAS f32x4*)(El + 4 * i) = *(const f32x4*)(F.EBL + (size_t)bh * NCH * 128 + 4 * i);
        __syncthreads();
#pragma unroll
        for (int c = 0; c < NCH; ++c) { const f32x4 e = *(const LAS f32x4*)(El + c * 128 + 4 * k4);
            *(v2u*)(sc0 + c * CSTB + toff) = pk4(S);
            S.x = e.x * S.x + bflo(d[c].x); S.y = e.y * S.y + bfhi(d[c].x); S.z = e.z * S.z + bflo(d[c].y); S.w = e.w * S.w + bfhi(d[c].y); }
        float* o = F.out + O_GLA_P + ((size_t)bh * GK + 4 * k4) * GV + v; NT_ST(S.x, o); NT_ST(S.y, o + GV); NT_ST(S.z, o + 2 * GV); NT_ST(S.w, o + 3 * GV); }
}
__device__ __forceinline__ void gla_passC_unit(Frame& F, int u) {
    const int c = u & 31, bh = u >> 5, b = bh >> 2, h = bh & 3, row0 = b * PL + c * CH;
    LAS unsigned char* QE = F.lds; LAS unsigned char* KE = QE + 64 * QE_ST; LAS unsigned char* V = KE + 64 * QE_ST; LAS unsigned char* ATT = V + 64 * V_ST;
    LAS float* red = (LAS float*)(ATT + 64 * ATT_ST);
    const int w = F.wave, r = F.lane & 15, q = F.lane >> 4, tf = w & 3, vh = w >> 2;
    bf16x8v scf[2][8];
    const bf16* Sc = F.SC + ((size_t)u * GV + 128 * vh) * GK;
#pragma unroll
    for (int ks = 0; ks < 2; ++ks)
#pragma unroll
        for (int i = 0; i < 8; ++i) scf[ks][i] = NT_LD((const bf16x8v*)(Sc + (size_t)(16 * i + r) * GK + 32 * ks + 8 * q));
    v2u gwv[8];
#pragma unroll
    for (int i = 0; i < 8; ++i) gwv[i] = *(const v2u*)(F.PROJ + (size_t)(row0 + 16 * tf + r) * NP + CG + h * GV + 128 * vh + 16 * i + 4 * q);
    { v4u vv[4], qq[2], kk[2];
#pragma unroll
        for (int i = 0; i < 4; ++i) { const int piece = F.tid + NTHR * i, row = piece >> 5, c16 = piece & 31; vv[i] = *(const v4u*)(F.PROJ + (size_t)(row0 + row) * NP + CV + h * GV + c16 * 8); }
#pragma unroll
        for (int i = 0; i < 2; ++i) { const int piece = F.tid + NTHR * i, row = piece >> 4, c16 = piece & 15;
            qq[i] = NT_LD((const v4u*)(F.QEg + ((size_t)u * 64 + row) * GK + c16 * 8)); kk[i] = NT_LD((const v4u*)(F.KEg + ((size_t)u * 64 + row) * GK + c16 * 8)); }
#pragma unroll
        for (int i = 0; i < 4; ++i) { const int piece = F.tid + NTHR * i, row = piece >> 5, c16 = piece & 31; *(LAS v4u*)(V + row * V_ST + c16 * 16) = vv[i]; }
#pragma unroll
        for (int i = 0; i < 2; ++i) { const int piece = F.tid + NTHR * i, row = piece >> 4, c16 = piece & 15;
            *(LAS v4u*)(QE + row * QE_ST + c16 * 16) = qq[i]; *(LAS v4u*)(KE + row * QE_ST + c16 * 16) = kk[i]; } }
    __syncthreads();
    f32x4 acc[8];
#pragma unroll
    for (int i = 0; i < 8; ++i) acc[i] = (f32x4){0.f, 0.f, 0.f, 0.f};
#pragma unroll
    for (int ks = 0; ks < 2; ++ks) { const bf16x8v bq = frag_k(QE, QE_ST, 16 * tf, 32 * ks, r, q);
#pragma unroll
        for (int i = 0; i < 8; ++i) acc[i] = MFMA16(scf[ks][i], bq, acc[i]); }
#pragma unroll
    for (int ks = 0; ks < 2; ++ks)
#pragma unroll
        for (int i = 0; i < 8; ++i) scf[ks][i] = NT_LD((const bf16x8v*)(Sc + (size_t)(16 * i + r) * GK + 32 * (ks + 2) + 8 * q));
#pragma unroll
    for (int ff = 0; ff < 2; ++ff) { const int f = 2 * w + ff, sf = f >> 2, tf = f & 3; f32x4 a4 = (f32x4){0.f, 0.f, 0.f, 0.f};
        if (sf <= tf) {
#pragma unroll
            for (int ks = 0; ks < 4; ++ks) a4 = MFMA16(frag_k(KE, QE_ST, 16 * sf, 32 * ks, r, q), frag_k(QE, QE_ST, 16 * tf, 32 * ks, r, q), a4); }
        const int s0 = 16 * sf + 4 * q, t = 16 * tf + r;
        f32x4 m; m.x = (s0 <= t) ? a4.x : 0.f; m.y = (s0 + 1 <= t) ? a4.y : 0.f; m.z = (s0 + 2 <= t) ? a4.z : 0.f; m.w = (s0 + 3 <= t) ? a4.w : 0.f;
        *(LAS v2u*)(ATT + t * ATT_ST + s0 * 2) = pk4(m); }
    __syncthreads();
#pragma unroll
    for (int ks = 0; ks < 2; ++ks) { const bf16x8v bq = frag_k(QE, QE_ST, 16 * tf, 32 * (ks + 2), r, q);
#pragma unroll
        for (int i = 0; i < 8; ++i) acc[i] = MFMA16(scf[ks][i], bq, acc[i]); }
#pragma unroll
    for (int ks = 0; ks < 2; ++ks) { const bf16x8v ba = frag_k(ATT, ATT_ST, 16 * tf, 32 * ks, r, q);
#pragma unroll
        for (int i = 0; i < 8; ++i) { const bf16x8v a = frag_t(V, V_ST, 32 * ks, 128 * vh + 16 * i, r, q); acc[i] = MFMA16(a, ba, acc[i]); } }
    float ss = 0.f;
#pragma unroll
    for (int i = 0; i < 8; ++i) ss += (acc[i].x * acc[i].x + acc[i].y * acc[i].y) + (acc[i].z * acc[i].z + acc[i].w * acc[i].w);
    ss += __shfl_xor(ss, 16); ss += __shfl_xor(ss, 32);
    const int t = 16 * tf + r;
    if (q == 0) red[vh * 64 + t] = ss;
    f32x4 nwv[8];
#pragma unroll
    for (int i = 0; i < 8; ++i) nwv[i] = *(const f32x4*)(F.gla_norm + 128 * vh + 16 * i + 4 * q);
    __syncthreads();
    const float rr = rsqrtf((red[t] + red[64 + t]) * (1.f / GV) + EPS); const size_t row = (size_t)(row0 + t);
#pragma unroll
    for (int i = 0; i < 8; ++i) { const int v = 128 * vh + 16 * i + 4 * q;
        const v2u gw = gwv[i]; const f32x4 nw = nwv[i];
        f32x4 o; o.x = acc[i].x * rr * nw.x * silu_f(bflo(gw.x)); o.y = acc[i].y * rr * nw.y * silu_f(bfhi(gw.x)); o.z = acc[i].z * rr * nw.z * silu_f(bflo(gw.y)); o.w = acc[i].w * rr * nw.w * silu_f(bfhi(gw.y));
        *(v2u*)(F.MIXIN + row * DM + h * GV + v) = pk4(o); }
    __syncthreads();
}

template <bool SCALE>
__device__ __forceinline__ void ssd_conv_item(Frame& F, int b, int g, int c, int cg, int tb, LAS unsigned char* X, LAS unsigned char* BT, LAS unsigned char* CT, const LAS float* WDEC) {
    const int xc = cg < 64 ? g * 512 + 8 * cg : (cg < 80 ? 1024 + g * 128 + 8 * (cg - 64) : 1280 + g * 128 + 8 * (cg - 80));
    float w[4][8], bias[8];
#pragma unroll
    for (int j = 0; j < 4; ++j) { const f32x4 a = *(const f32x4*)(F.sconv_w + j * SCH + xc), bq = *(const f32x4*)(F.sconv_w + j * SCH + xc + 4);
        w[j][0] = a.x; w[j][1] = a.y; w[j][2] = a.z; w[j][3] = a.w; w[j][4] = bq.x; w[j][5] = bq.y; w[j][6] = bq.z; w[j][7] = bq.w; }
    { const f32x4 a = *(const f32x4*)(F.sconv_b + xc), bq = *(const f32x4*)(F.sconv_b + xc + 4); bias[0] = a.x; bias[1] = a.y; bias[2] = a.z; bias[3] = a.w; bias[4] = bq.x; bias[5] = bq.y; bias[6] = bq.z; bias[7] = bq.w; }
    v4u raw[11];
#pragma unroll
    for (int i = 0; i < 11; ++i) { const int tt = c * CH + tb * 8 - 3 + i;
        raw[i] = (tt >= 0) ? *(const v4u*)(F.PROJ + (size_t)(b * PL + tt) * NP + CX + xc) : (v4u){0u, 0u, 0u, 0u}; }
#pragma unroll
    for (int t = 0; t < 8; ++t) { float o[8];
#pragma unroll
        for (int e = 0; e < 8; ++e) { float a = bias[e];
#pragma unroll
            for (int j = 0; j < 4; ++j) { const unsigned wd = raw[t + j][e >> 1]; a += w[j][e] * ((e & 1) ? bfhi(wd) : bflo(wd)); }
            o[e] = silu_f(a); }
        const int tl = tb * 8 + t;
        if (SCALE && cg < 64) { const float sc = WDEC[(cg >> 3) * 64 + tl];
#pragma unroll
            for (int e = 0; e < 8; ++e) o[e] *= sc; }
        const v4u pkd = (v4u){pk2(o[0], o[1]), pk2(o[2], o[3]), pk2(o[4], o[5]), pk2(o[6], o[7])};
        LAS unsigned char* dst = cg < 64 ? X + tl * X_ST + cg * 16 : (cg < 80 ? BT + tl * BC_ST + (cg - 64) * 16 : CT + tl * BC_ST + (cg - 80) * 16);
        *(LAS v4u*)dst = pkd; }
}
__device__ __forceinline__ float ssd_head_scan(Frame& F, int hd, int row0, float& dt_out, float& last) {
    const float dt = softplus_f(F.LRDT[(size_t)(row0 + F.lane) * 32 + 16 + hd] + F.dt_bias[hd]);
    float cum = dt * (-__expf(F.A_log[hd]));
#pragma unroll
    for (int o = 1; o < 64; o <<= 1) { const float v = __shfl_up(cum, o); cum += (F.lane >= o) ? v : 0.f; }
    dt_out = dt; last = __shfl(cum, 63); return cum;
}
__device__ __forceinline__ void ssd_passA_unit(Frame& F, int u) {
    const int c = u & 31, bg = u >> 5, b = bg >> 1, g = bg & 1, row0 = b * PL + c * CH;
    LAS unsigned char* X = F.lds; LAS unsigned char* BT = X + 64 * X_ST; LAS float* WDEC = (LAS float*)(BT + 64 * BC_ST);
    const int w = F.wave, r = F.lane & 15, q = F.lane >> 4;
    { float dt, last; const float cum = ssd_head_scan(F, g * 8 + w, row0, dt, last);
        WDEC[w * 64 + F.lane] = __expf(last - cum) * dt; if (F.lane == 63) F.AL[(size_t)u * 8 + w] = __expf(last); }
    __syncthreads();
    for (int it = F.tid; it < 80 * 8; it += NTHR) ssd_conv_item<true>(F, b, g, c, it % 80, it / 80, X, BT, nullptr, WDEC);
    __syncthreads();
#pragma unroll 1
    for (int nh = 0; nh < 2; ++nh) {
        f32x4 acc[4][4];
#pragma unroll
        for (int i = 0; i < 4; ++i)
#pragma unroll
            for (int j = 0; j < 4; ++j) acc[i][j] = (f32x4){0.f, 0.f, 0.f, 0.f};
#pragma unroll
        for (int ks = 0; ks < 2; ++ks) { bf16x8v bp[4];
#pragma unroll
            for (int pf = 0; pf < 4; ++pf) bp[pf] = frag_t(X, X_ST, 32 * ks, 64 * w + 16 * pf, r, q);
#pragma unroll
            for (int nf = 0; nf < 4; ++nf) { const bf16x8v a = frag_t(BT, BC_ST, 32 * ks, 64 * nh + 16 * nf, r, q);
#pragma unroll
                for (int pf = 0; pf < 4; ++pf) acc[nf][pf] = MFMA16(a, bp[pf], acc[nf][pf]); } }
#pragma unroll
        for (int nf = 0; nf < 4; ++nf)
#pragma unroll
            for (int pf = 0; pf < 4; ++pf) *(v2u*)(F.DH + (((size_t)u * 8 + w) * SP + 16 * pf + r) * SN + 64 * nh + 16 * nf + 4 * q) = pk4(acc[nf][pf]);
    }
    __syncthreads();
}
__device__ __forceinline__ void ssd_scan(Frame& F) {
    for (int it = F.bid * NTHR + F.tid; it < PB * SH * SP * 32; it += F.G * NTHR) { const int n4 = it & 31, p = (it >> 5) & 63, bhd = __builtin_amdgcn_readfirstlane(it >> 11), b = bhd >> 4, hd = bhd & 15, g = hd >> 3, hl = hd & 7;
        const unsigned toff = (unsigned)(p * SN + 4 * n4) * 2u; constexpr size_t CSTB = (size_t)8 * SP * SN * 2;
        const size_t e0 = ((size_t)((b * 2 + g) * NCH) * 8 + hl) * SP * SN;
        const char* dh0 = (const char*)(F.DH + e0); char* hc0 = (char*)(F.HC + e0); const float* al0 = F.AL + (size_t)((b * 2 + g) * NCH) * 8 + hl;
        f32x4 H = (f32x4){0.f, 0.f, 0.f, 0.f};
        v2u d[NCH]; float a[NCH];
#pragma unroll
        for (int c = 0; c < NCH; ++c) { d[c] = NT_LD((const v2u*)(dh0 + c * CSTB + toff)); a[c] = al0[c * 8]; }
#pragma unroll
        for (int c = 0; c < NCH; ++c) {
            *(v2u*)(hc0 + c * CSTB + toff) = pk4(H);
            H.x = a[c] * H.x + bflo(d[c].x); H.y = a[c] * H.y + bfhi(d[c].x); H.z = a[c] * H.z + bflo(d[c].y); H.w = a[c] * H.w + bfhi(d[c].y); }
        NT_ST(H, (f32x4*)(F.out + O_SSD_P + ((size_t)bhd * SP + p) * SN + 4 * n4)); }
}
__device__ __forceinline__ void ssd_passC_unit(Frame& F, int u) {
    const int c = u & 31, bg = u >> 5, b = bg >> 1, g = bg & 1, row0 = b * PL + c * CH;
    LAS unsigned char* X = F.lds; LAS unsigned char* BT = X + 64 * X_ST; LAS unsigned char* CT = BT + 64 * BC_ST; LAS unsigned char* CB = CT + 64 * BC_ST;
    LAS float* DT = (LAS float*)(CB + 64 * ATT_ST); LAS float* CUM = DT + 512; LAS float* red = CUM + 512;
    const int w = F.wave, r = F.lane & 15, q = F.lane >> 4, hd = g * 8 + w;
    bf16x8v hcf[4][4];
    const bf16* Hc0 = F.HC + ((size_t)u * 8 + w) * SP * SN;
#pragma unroll
    for (int ks = 0; ks < 2; ++ks)
#pragma unroll
        for (int pf = 0; pf < 4; ++pf) hcf[ks][pf] = NT_LD((const bf16x8v*)(Hc0 + (size_t)(16 * pf + r) * SN + 32 * ks + 8 * q));
    { float dt, last; const float cum = ssd_head_scan(F, hd, row0, dt, last); DT[w * 64 + F.lane] = dt; CUM[w * 64 + F.lane] = cum; }
    for (int it = F.tid; it < 96 * 8; it += NTHR) ssd_conv_item<false>(F, b, g, c, it % 96, it / 96, X, BT, CT, nullptr);
#pragma unroll
    for (int ks = 2; ks < 4; ++ks)
#pragma unroll
        for (int pf = 0; pf < 4; ++pf) hcf[ks][pf] = NT_LD((const bf16x8v*)(Hc0 + (size_t)(16 * pf + r) * SN + 32 * ks + 8 * q));
    __syncthreads();
#pragma unroll
    for (int ff = 0; ff < 2; ++ff) { const int f = 2 * w + ff, sf = f >> 2, tf = f & 3; f32x4 a4 = (f32x4){0.f, 0.f, 0.f, 0.f};
        if (sf <= tf) {
#pragma unroll
            for (int ks = 0; ks < 4; ++ks) a4 = MFMA16(frag_k(BT, BC_ST, 16 * sf, 32 * ks, r, q), frag_k(CT, BC_ST, 16 * tf, 32 * ks, r, q), a4); }
        *(LAS v2u*)(CB + (16 * tf + r) * ATT_ST + (16 * sf + 4 * q) * 2) = pk4(a4); }
    __syncthreads();
    v2u zpre[4][4];
#pragma unroll
    for (int tf = 0; tf < 4; ++tf)
#pragma unroll
        for (int pf = 0; pf < 4; ++pf) zpre[tf][pf] = *(const v2u*)(F.PROJ + (size_t)(row0 + 16 * tf + r) * NP + CZ + g * 512 + 64 * w + 16 * pf + 4 * q);
    f32x4 acc[4][4];
#pragma unroll
    for (int i = 0; i < 4; ++i)
#pragma unroll
        for (int j = 0; j < 4; ++j) acc[i][j] = (f32x4){0.f, 0.f, 0.f, 0.f};
#pragma unroll
    for (int ks = 0; ks < 4; ++ks) { bf16x8v bc[4];
#pragma unroll
        for (int tf = 0; tf < 4; ++tf) bc[tf] = frag_k(CT, BC_ST, 16 * tf, 32 * ks, r, q);
#pragma unroll
        for (int pf = 0; pf < 4; ++pf) {
#pragma unroll
            for (int tf = 0; tf < 4; ++tf) acc[pf][tf] = MFMA16(hcf[ks][pf], bc[tf], acc[pf][tf]); } }
    float ct[4];
#pragma unroll
    for (int tf = 0; tf < 4; ++tf) { ct[tf] = CUM[w * 64 + 16 * tf + r]; const float e = __expf(ct[tf]);
#pragma unroll
        for (int pf = 0; pf < 4; ++pf) acc[pf][tf] = acc[pf][tf] * e; }
#pragma unroll
    for (int ks = 0; ks < 2; ++ks) { bf16x8v ax[4];
#pragma unroll
        for (int pf = 0; pf < 4; ++pf) ax[pf] = frag_t(X, X_ST, 32 * ks, 64 * w + 16 * pf, r, q);
        const int s0 = 32 * ks + 8 * q;
        const f32x4 cs0 = *(const LAS f32x4*)(CUM + w * 64 + s0), cs1 = *(const LAS f32x4*)(CUM + w * 64 + s0 + 4), ds0 = *(const LAS f32x4*)(DT + w * 64 + s0), ds1 = *(const LAS f32x4*)(DT + w * 64 + s0 + 4);
        const float cs[8] = {cs0.x, cs0.y, cs0.z, cs0.w, cs1.x, cs1.y, cs1.z, cs1.w}, ds[8] = {ds0.x, ds0.y, ds0.z, ds0.w, ds1.x, ds1.y, ds1.z, ds1.w};
#pragma unroll
        for (int tf = 0; tf < 4; ++tf) { if (32 * ks > 16 * tf + 15) continue;
            const int t = 16 * tf + r; const v4u cb8 = *(const LAS v4u*)(CB + t * ATT_ST + s0 * 2); float l[8];
#pragma unroll
            for (int e = 0; e < 8; ++e) { const unsigned wd = cb8[e >> 1]; const float cbv = (e & 1) ? bfhi(wd) : bflo(wd); l[e] = (s0 + e <= t) ? cbv * __expf(ct[tf] - cs[e]) * ds[e] : 0.f; }
            const v4u lp = (v4u){pk2(l[0], l[1]), pk2(l[2], l[3]), pk2(l[4], l[5]), pk2(l[6], l[7])}; const bf16x8v bl = __builtin_bit_cast(bf16x8v, lp);
#pragma unroll
            for (int pf = 0; pf < 4; ++pf) acc[pf][tf] = MFMA16(ax[pf], bl, acc[pf][tf]); } }
    const float Dh = F.ssd_D[hd];
#pragma unroll
    for (int tf = 0; tf < 4; ++tf) { const int t = 16 * tf + r; const size_t row = (size_t)(row0 + t); float ss = 0.f;
#pragma unroll
        for (int pf = 0; pf < 4; ++pf) { const int p4 = 64 * w + 16 * pf + 4 * q;
            const v2u xv = *(const LAS v2u*)(X + t * X_ST + p4 * 2); const v2u zv = zpre[tf][pf];
            f32x4 y = acc[pf][tf];
            y.x = (y.x + Dh * bflo(xv.x)) * silu_f(bflo(zv.x)); y.y = (y.y + Dh * bfhi(xv.x)) * silu_f(bfhi(zv.x)); y.z = (y.z + Dh * bflo(xv.y)) * silu_f(bflo(zv.y)); y.w = (y.w + Dh * bfhi(xv.y)) * silu_f(bfhi(zv.y));
            acc[pf][tf] = y; ss += (y.x * y.x + y.y * y.y) + (y.z * y.z + y.w * y.w); }
        ss += __shfl_xor(ss, 16); ss += __shfl_xor(ss, 32);
        if (q == 0) red[w * 64 + t] = ss; }
    f32x4 nwv[4];
#pragma unroll
    for (int pf = 0; pf < 4; ++pf) nwv[pf] = *(const f32x4*)(F.ssd_norm + g * 512 + 64 * w + 16 * pf + 4 * q);
    __syncthreads();
#pragma unroll
    for (int tf = 0; tf < 4; ++tf) { const int t = 16 * tf + r; const size_t row = (size_t)(row0 + t); float tot = 0.f;
#pragma unroll
        for (int ww = 0; ww < 8; ++ww) tot += red[ww * 64 + t];
        const float rr = rsqrtf(tot * (1.f / 512.f) + EPS);
#pragma unroll
        for (int pf = 0; pf < 4; ++pf) { const int p4 = g * 512 + 64 * w + 16 * pf + 4 * q; const f32x4 nw = nwv[pf];
            f32x4 o = acc[pf][tf]; o.x *= rr * nw.x; o.y *= rr * nw.y; o.z *= rr * nw.z; o.w *= rr * nw.w;
            *(v2u*)(F.MIXIN + row * DM + 1024 + p4) = pk4(o); } }
    __syncthreads();
}

constexpr int ATT8_ST = 80;
__device__ __forceinline__ void gla_sample_unit(Frame& F, int b, int h, f32x4 (&S)[16], int nb, int nh, bool has_next) {
    const int tid = F.tid, w = F.wave, lane = F.lane, r = lane & 15, q = lane >> 4, row0 = MP + b * SL;
    LAS unsigned char* S0b = F.lds;
    LAS unsigned char* Vt = S0b + 128 * V_ST;
    LAS unsigned char* QE = Vt + 32 * V_ST;
    LAS unsigned char* KE = QE + 16 * QE_ST;
    LAS unsigned char* ATT = KE + 16 * QE_ST;
    LAS float* KD = (LAS float*)(ATT + 16 * ATT8_ST);
    LAS float* EL = KD + 1024;
    LAS float* red = EL + 128;
    f32x4 Vf[8];
#pragma unroll
    for (int s = 0; s < 8; ++s) { const v2u vv = *(const v2u*)(F.PROJ + (size_t)(row0 + s) * NP + CV + h * GV + 4 * lane); Vf[s] = (f32x4){bflo(vv.x), bfhi(vv.x), bflo(vv.y), bfhi(vv.y)}; }
    if (tid < 256) { const int t = tid >> 5, c16 = tid & 31; *(LAS v4u*)(Vt + t * V_ST + c16 * 16) = *(const v4u*)(F.PROJ + (size_t)(row0 + t) * NP + CV + h * GV + c16 * 8); }
    for (int i = tid; i < 24 * 32; i += NTHR) *(LAS v4u*)(Vt + (8 + (i >> 5)) * V_ST + (i & 31) * 16) = (v4u){0u, 0u, 0u, 0u};
    { LAS unsigned char* KR = (LAS unsigned char*)(red + 128); LAS unsigned char* QR = KR + 8 * 256; LAS float* LR = (LAS float*)(QR + 8 * 256); LAS float* LG = LR + 128;
        if (tid < 256) { const int which = tid >> 7, j = tid & 127, t = j >> 4, c16 = j & 15;
            *(LAS v4u*)((which ? QR : KR) + t * 256 + c16 * 16) = *(const v4u*)(F.PROJ + (size_t)(row0 + t) * NP + (which ? CQ : CK) + h * GK + c16 * 8); }
        else if (tid < 288) { const int j = tid - 256; *(LAS v4u*)(LR + (j >> 2) * 16 + (j & 3) * 4) = *(const v4u*)(F.LRDT + (size_t)(row0 + (j >> 2)) * 32 + (j & 3) * 4); }
        __syncthreads();
        { const int k = tid & 127, tp = tid >> 7, hk = h * GK + k; const float bg = F.b_gate[hk];
            float w2[16];
#pragma unroll
            for (int j = 0; j < 16; ++j) w2[j] = F.w_gate2[j * GKD + hk];
#pragma unroll
            for (int tt = 0; tt < 2; ++tt) { const int t = 2 * tp + tt; const LAS f32x4* lr = (const LAS f32x4*)(LR + t * 16); const f32x4 a = lr[0], bq = lr[1], c = lr[2], d = lr[3];
                const float x = bg + a.x * w2[0] + a.y * w2[1] + a.z * w2[2] + a.w * w2[3] + bq.x * w2[4] + bq.y * w2[5] + bq.z * w2[6] + bq.w * w2[7]
                              + c.x * w2[8] + c.y * w2[9] + c.z * w2[10] + c.w * w2[11] + d.x * w2[12] + d.y * w2[13] + d.z * w2[14] + d.w * w2[15];
                LG[t * 128 + k] = logsigmoid_f(x) * (1.f / 16.f); } }
        __syncthreads();
        if (tid < 128) { const int k = tid;
            float bcum[8], kv[8]; float run = 0.f;
#pragma unroll
            for (int t = 0; t < 8; ++t) { run += LG[t * 128 + k]; bcum[t] = run; kv[t] = bf2f(*(const LAS bf16*)(KR + t * 256 + k * 2));
                *(LAS bf16*)(QE + t * QE_ST + k * 2) = (bf16)f2bf(bf2f(*(const LAS bf16*)(QR + t * 256 + k * 2)) * 0.08838834764831845f * __expf(run));
                *(LAS bf16*)(KE + t * QE_ST + k * 2) = (bf16)f2bf(kv[t] * __expf(-run)); }
            f32x4 d0, d1; d0.x = kv[0] * __expf(run - bcum[0]); d0.y = kv[1] * __expf(run - bcum[1]); d0.z = kv[2] * __expf(run - bcum[2]); d0.w = kv[3] * __expf(run - bcum[3]);
            d1.x = kv[4] * __expf(run - bcum[4]); d1.y = kv[5] * __expf(run - bcum[5]); d1.z = kv[6] * __expf(run - bcum[6]); d1.w = kv[7];
            *(LAS f32x4*)(KD + k * 8) = d0; *(LAS f32x4*)(KD + k * 8 + 4) = d1; EL[k] = __expf(run); } }
    if (tid < 128) {
    } else if (tid < 384) { const int i = tid - 128, which = i >> 7, j = i & 127;
        *(LAS v4u*)((which ? KE : QE) + (8 + (j >> 4)) * QE_ST + (j & 15) * 16) = (v4u){0u, 0u, 0u, 0u};
    } else if (tid < 384 + 80) { *(LAS v4u*)(ATT + (tid - 384) * 16) = (v4u){0u, 0u, 0u, 0u}; }
#pragma unroll
    for (int i = 0; i < 16; ++i) *(LAS v2u*)(S0b + (16 * w + i) * V_ST + lane * 8) = pk4(S[i]);
    __syncthreads();
    if (w == 0) { f32x4 a4 = (f32x4){0.f, 0.f, 0.f, 0.f};
#pragma unroll
        for (int ks = 0; ks < 4; ++ks) a4 = MFMA16(frag_k(KE, QE_ST, 0, 32 * ks, r, q), frag_k(QE, QE_ST, 0, 32 * ks, r, q), a4);
        const int s0i = 4 * q; f32x4 m; m.x = (s0i <= r) ? a4.x : 0.f; m.y = (s0i + 1 <= r) ? a4.y : 0.f; m.z = (s0i + 2 <= r) ? a4.z : 0.f; m.w = (s0i + 3 <= r) ? a4.w : 0.f;
        if (r >= 8) m = (f32x4){0.f, 0.f, 0.f, 0.f};
        *(LAS v2u*)(ATT + r * ATT8_ST + s0i * 2) = pk4(m); }
    { f32x4* so = (f32x4*)(F.out + O_GLA_S + ((size_t)(b * GH + h) * GK + 16 * w) * GV) + lane;
#pragma unroll
        for (int i = 0; i < 16; ++i) { const int k = 16 * w + i; const float e = EL[k]; const f32x4 k0 = *(const LAS f32x4*)(KD + k * 8), k1 = *(const LAS f32x4*)(KD + k * 8 + 4);
            f32x4 n = S[i] * e; n = n + Vf[0] * k0.x; n = n + Vf[1] * k0.y; n = n + Vf[2] * k0.z; n = n + Vf[3] * k0.w; n = n + Vf[4] * k1.x; n = n + Vf[5] * k1.y; n = n + Vf[6] * k1.z; n = n + Vf[7] * k1.w;
            NT_ST(n, so + i * 64); } }
    if (has_next) { const f32x4* s1 = (const f32x4*)(F.st_gla + ((size_t)(nb * GH + nh) * GK + 16 * w) * GV) + lane;
#pragma unroll
        for (int i = 0; i < 16; ++i) S[i] = NT_LD(s1 + i * 64); }
    f32x4 acc[2] = {(f32x4){0.f, 0.f, 0.f, 0.f}, (f32x4){0.f, 0.f, 0.f, 0.f}};
#pragma unroll
    for (int ks = 0; ks < 4; ++ks) { const bf16x8v bq = frag_k(QE, QE_ST, 0, 32 * ks, r, q);
#pragma unroll
        for (int vf = 0; vf < 2; ++vf) acc[vf] = MFMA16(frag_t(S0b, V_ST, 32 * ks, 32 * w + 16 * vf, r, q), bq, acc[vf]); }
    __syncthreads();
    { const bf16x8v ba = *(const LAS bf16x8v*)(ATT + r * ATT8_ST + 16 * q);
#pragma unroll
        for (int vf = 0; vf < 2; ++vf) acc[vf] = MFMA16(frag_t(Vt, V_ST, 0, 32 * w + 16 * vf, r, q), ba, acc[vf]); }
    float ss = (acc[0].x * acc[0].x + acc[0].y * acc[0].y) + (acc[0].z * acc[0].z + acc[0].w * acc[0].w) + (acc[1].x * acc[1].x + acc[1].y * acc[1].y) + (acc[1].z * acc[1].z + acc[1].w * acc[1].w);
    ss += __shfl_xor(ss, 16); ss += __shfl_xor(ss, 32);
    if (q == 0) red[w * 16 + r] = ss;
    __syncthreads();
    float tot = 0.f;
#pragma unroll
    for (int ww = 0; ww < 8; ++ww) tot += red[ww * 16 + r];
    const float rr = rsqrtf(tot * (1.f / GV) + EPS);
    if (r < 8) { const size_t row = (size_t)(row0 + r);
        v2u gws[2]; f32x4 nws[2];
#pragma unroll
        for (int vf = 0; vf < 2; ++vf) { const int v = 32 * w + 16 * vf + 4 * q; gws[vf] = *(const v2u*)(F.PROJ + row * NP + CG + h * GV + v); nws[vf] = *(const f32x4*)(F.gla_norm + v); }
#pragma unroll
        for (int vf = 0; vf < 2; ++vf) { const int v = 32 * w + 16 * vf + 4 * q;
            const v2u gw = gws[vf]; const f32x4 nw = nws[vf];
            f32x4 o; o.x = acc[vf].x * rr * nw.x * silu_f(bflo(gw.x)); o.y = acc[vf].y * rr * nw.y * silu_f(bfhi(gw.x)); o.z = acc[vf].z * rr * nw.z * silu_f(bflo(gw.y)); o.w = acc[vf].w * rr * nw.w * silu_f(bfhi(gw.y));
            *(v2u*)(F.MIXIN + row * DM + h * GV + v) = pk4(o); } }
    __syncthreads();
}
__device__ __forceinline__ void ssd_sample_unit(Frame& F, int b, int g) {
    const int tid = F.tid, w = F.wave, lane = F.lane, r = lane & 15, q = lane >> 4, row0 = MP + b * SL, hd = g * 8 + w, ch = g * 512 + tid;
    LAS float* Xs = (LAS float*)F.lds;
    LAS float* XW = Xs + 4096;
    LAS float* Bs = XW + 4096;
    LAS unsigned char* Cb = (LAS unsigned char*)(Bs + 1024);
    LAS unsigned char* Bb = Cb + 16 * QE_ST;
    LAS float* CBm = (LAS float*)(Bb + 16 * QE_ST);
    LAS float* CD = CBm + 256;
    LAS float* red = CD + 128;
    const float* h0base = F.st_ssd + ((size_t)(b * SH + hd) * SP) * SN; float* hobase = F.out + O_SSD_S + ((size_t)(b * SH + hd) * SP) * SN;
    f32x4 hbuf[4][2];
#pragma unroll
    for (int i = 0; i < 4; ++i) { const size_t off = (size_t)(16 * (i & 3) + r) * SN + 32 * (i >> 2) + 8 * q; hbuf[i][0] = NT_LD((const f32x4*)(h0base + off)); hbuf[i][1] = NT_LD((const f32x4*)(h0base + off + 4)); }
    float dt[8], cum[8]; { const float A = -__expf(F.A_log[hd]), dtb = F.dt_bias[hd]; float run = 0.f;
#pragma unroll
        for (int t = 0; t < 8; ++t) dt[t] = F.LRDT[(size_t)(row0 + t) * 32 + 16 + hd];
        asm volatile("" : "+v"(dt[0]), "+v"(dt[1]), "+v"(dt[2]), "+v"(dt[3]), "+v"(dt[4]), "+v"(dt[5]), "+v"(dt[6]), "+v"(dt[7]));
#pragma unroll
        for (int t = 0; t < 8; ++t) { dt[t] = softplus_f(dt[t] + dtb); run += dt[t] * A; cum[t] = run; } }
    const float last = cum[7], elast = __expf(last);
    if (lane < 8) { float cv = cum[0], dv = dt[0];
#pragma unroll
        for (int t = 1; t < 8; ++t) { cv = (lane == t) ? cum[t] : cv; dv = (lane == t) ? dt[t] : dv; }
        CD[w * 16 + lane] = cv; CD[w * 16 + 8 + lane] = dv; }
    { float xr[11]; const float cb = F.sconv_b[ch], c0 = F.sconv_w[ch], c1 = F.sconv_w[SCH + ch], c2 = F.sconv_w[2 * SCH + ch], c3 = F.sconv_w[3 * SCH + ch];
#pragma unroll
        for (int i = 0; i < 11; ++i) xr[i] = xbc_raw(F, 1, b, row0, i - 3, ch);
        float xw[8];
#pragma unroll
        for (int t = 0; t < 8; ++t) { const float x = silu_f(cb + c0 * xr[t] + c1 * xr[t + 1] + c2 * xr[t + 2] + c3 * xr[t + 3]); Xs[t * 512 + tid] = x; xw[t] = x * __expf(last - cum[t]) * dt[t]; }
        *(LAS f32x4*)(XW + tid * 8) = (f32x4){xw[0], xw[1], xw[2], xw[3]}; *(LAS f32x4*)(XW + tid * 8 + 4) = (f32x4){xw[4], xw[5], xw[6], xw[7]}; }
    if (tid < 256) { const int n = tid & 127, isC = tid >> 7, cc = 1024 + isC * 256 + g * 128 + n;
        float xr[11]; const float cb = F.sconv_b[cc], c0 = F.sconv_w[cc], c1 = F.sconv_w[SCH + cc], c2 = F.sconv_w[2 * SCH + cc], c3 = F.sconv_w[3 * SCH + cc];
#pragma unroll
        for (int i = 0; i < 11; ++i) xr[i] = xbc_raw(F, 1, b, row0, i - 3, cc);
#pragma unroll
        for (int t = 0; t < 8; ++t) { const float x = silu_f(cb + c0 * xr[t] + c1 * xr[t + 1] + c2 * xr[t + 2] + c3 * xr[t + 3]);
            if (!isC) Bs[t * 128 + n] = x;
            *(LAS bf16*)((isC ? Cb : Bb) + t * QE_ST + n * 2) = (bf16)f2bf(x); }
    } else { const int i = tid - 256, which = i >> 7, j = i & 127; *(LAS v4u*)((which ? Bb : Cb) + (8 + (j >> 4)) * QE_ST + (j & 15) * 16) = (v4u){0u, 0u, 0u, 0u}; }
    __syncthreads();
    if (w == 0) { f32x4 a4 = (f32x4){0.f, 0.f, 0.f, 0.f};
#pragma unroll
        for (int ks = 0; ks < 4; ++ks) a4 = MFMA16(frag_k(Bb, QE_ST, 0, 32 * ks, r, q), frag_k(Cb, QE_ST, 0, 32 * ks, r, q), a4);
        *(LAS f32x4*)(CBm + r * 16 + 4 * q) = a4; }
    bf16x8v bc[4];
#pragma unroll
    for (int ks = 0; ks < 4; ++ks) bc[ks] = frag_k(Cb, QE_ST, 0, 32 * ks, r, q);
    f32x4 acc[4];
#pragma unroll
    for (int pf = 0; pf < 4; ++pf) acc[pf] = (f32x4){0.f, 0.f, 0.f, 0.f};
    f32x4 Bv[8][2];
#pragma unroll
    for (int st = 0; st < 16; ++st) { const int ks = st >> 2, pf = st & 3;
        if (pf == 0) {
#pragma unroll
            for (int s = 0; s < 8; ++s) { Bv[s][0] = *(const LAS f32x4*)(Bs + s * 128 + 32 * ks + 8 * q); Bv[s][1] = *(const LAS f32x4*)(Bs + s * 128 + 32 * ks + 8 * q + 4); } }
        const int p = 16 * pf + r; const size_t off = (size_t)p * SN + 32 * ks + 8 * q;
        const f32x4 ha = hbuf[st & 3][0], hb = hbuf[st & 3][1];
        if (st + 4 < 16) { const int st2 = st + 4; const size_t off2 = (size_t)(16 * (st2 & 3) + r) * SN + 32 * (st2 >> 2) + 8 * q; hbuf[st & 3][0] = NT_LD((const f32x4*)(h0base + off2)); hbuf[st & 3][1] = NT_LD((const f32x4*)(h0base + off2 + 4)); }
        asm volatile("" ::: "memory");
        const f32x4 x0 = *(const LAS f32x4*)(XW + (64 * w + p) * 8), x1 = *(const LAS f32x4*)(XW + (64 * w + p) * 8 + 4);
        f32x4 na = ha * elast, nb = hb * elast;
        na = na + Bv[0][0] * x0.x; nb = nb + Bv[0][1] * x0.x; na = na + Bv[1][0] * x0.y; nb = nb + Bv[1][1] * x0.y; na = na + Bv[2][0] * x0.z; nb = nb + Bv[2][1] * x0.z; na = na + Bv[3][0] * x0.w; nb = nb + Bv[3][1] * x0.w;
        na = na + Bv[4][0] * x1.x; nb = nb + Bv[4][1] * x1.x; na = na + Bv[5][0] * x1.y; nb = nb + Bv[5][1] * x1.y; na = na + Bv[6][0] * x1.z; nb = nb + Bv[6][1] * x1.z; na = na + Bv[7][0] * x1.w; nb = nb + Bv[7][1] * x1.w;
        NT_ST(na, (f32x4*)(hobase + off)); NT_ST(nb, (f32x4*)(hobase + off + 4));
        const v4u ap = (v4u){pk2(ha.x, ha.y), pk2(ha.z, ha.w), pk2(hb.x, hb.y), pk2(hb.z, hb.w)};
        acc[pf] = MFMA16(__builtin_bit_cast(bf16x8v, ap), bc[ks], acc[pf]); }
    __syncthreads();
    const int tc = r & 7; const float ct = CD[w * 16 + tc], ect = __expf(ct), Dh = F.ssd_D[hd];
    float L[8]; { const f32x4 c0 = *(const LAS f32x4*)(CBm + r * 16), c1 = *(const LAS f32x4*)(CBm + r * 16 + 4); const float cbv[8] = {c0.x, c0.y, c0.z, c0.w, c1.x, c1.y, c1.z, c1.w};
        const f32x4 q0 = *(const LAS f32x4*)(CD + w * 16), q1 = *(const LAS f32x4*)(CD + w * 16 + 4), d0 = *(const LAS f32x4*)(CD + w * 16 + 8), d1 = *(const LAS f32x4*)(CD + w * 16 + 12);
        const float cu[8] = {q0.x, q0.y, q0.z, q0.w, q1.x, q1.y, q1.z, q1.w}, dd[8] = {d0.x, d0.y, d0.z, d0.w, d1.x, d1.y, d1.z, d1.w};
#pragma unroll
        for (int s = 0; s < 8; ++s) L[s] = (s <= tc) ? cbv[s] * __expf(ct - cu[s]) * dd[s] : 0.f; }
    float ss = 0.f; const size_t row = (size_t)(row0 + tc);
#pragma unroll
    for (int pf = 0; pf < 4; ++pf) { const int p4 = 64 * w + 16 * pf + 4 * q;
        f32x4 y = acc[pf] * ect;
#pragma unroll
        for (int s = 0; s < 8; ++s) y = y + *(const LAS f32x4*)(Xs + s * 512 + p4) * L[s];
        const f32x4 xt = *(const LAS f32x4*)(Xs + tc * 512 + p4); const v2u zv = *(const v2u*)(F.PROJ + row * NP + CZ + g * 512 + p4);
        y.x = (y.x + Dh * xt.x) * silu_f(bflo(zv.x)); y.y = (y.y + Dh * xt.y) * silu_f(bfhi(zv.x)); y.z = (y.z + Dh * xt.z) * silu_f(bflo(zv.y)); y.w = (y.w + Dh * xt.w) * silu_f(bfhi(zv.y));
        acc[pf] = y; ss += (y.x * y.x + y.y * y.y) + (y.z * y.z + y.w * y.w); }
    ss += __shfl_xor(ss, 16); ss += __shfl_xor(ss, 32);
    if (q == 0) red[w * 16 + r] = ss;
    __syncthreads();
    float tot = 0.f;
#pragma unroll
    for (int ww = 0; ww < 8; ++ww) tot += red[ww * 16 + r];
    const float rr = rsqrtf(tot * (1.f / 512.f) + EPS);
    if (r < 8) {
        f32x4 nws[4];
#pragma unroll
        for (int pf = 0; pf < 4; ++pf) nws[pf] = *(const f32x4*)(F.ssd_norm + g * 512 + 64 * w + 16 * pf + 4 * q);
#pragma unroll
        for (int pf = 0; pf < 4; ++pf) { const int p4 = g * 512 + 64 * w + 16 * pf + 4 * q; const f32x4 nw = nws[pf];
            f32x4 o = acc[pf]; o.x *= rr * nw.x; o.y *= rr * nw.y; o.z *= rr * nw.z; o.w *= rr * nw.w;
            *(v2u*)(F.MIXIN + row * DM + 1024 + p4) = pk4(o); } }
    __syncthreads();
}

__device__ __forceinline__ void p2a_chunk_states(Frame& F) {
    for (int idx = F.bid; idx < 768; idx += F.G) { if (idx < 256) { TBEGIN(F, 20); ssd_passA_unit(F, idx); TEND(F, 20); } else { TBEGIN(F, 21); gla_passA_unit(F, idx - 256); TEND(F, 21); } }
}
#ifndef MK_REP_PHASE
#define MK_REP_PHASE (-1)
#endif
__device__ __forceinline__ void p2b_scans_and_sample(Frame& F) {
    TBEGIN(F, 30); for (int rep = 0; rep < (MK_REP_PHASE == 30 ? 2 : 1); ++rep) { gla_scan(F); ssd_scan(F); } TEND(F, 30);
    TBEGIN(F, 31);
    for (int rep = 0; rep < (MK_REP_PHASE == 31 ? 2 : 1); ++rep)
    { f32x4 S[16]; int idx = F.bid;
            if (idx < SB * GH) { const f32x4* s0 = (const f32x4*)(F.st_gla + ((size_t)idx * GK + 16 * F.wave) * GV) + F.lane;
#pragma unroll
                for (int i = 0; i < 16; ++i) S[i] = NT_LD(s0 + i * 64); }
            for (; idx < SB * GH; idx += F.G) { const int nx = idx + F.G; gla_sample_unit(F, idx / GH, idx % GH, S, nx / GH, nx % GH, nx < SB * GH); } }
    TEND(F, 31); TBEGIN(F, 32);
    for (int rep = 0; rep < (MK_REP_PHASE == 32 ? 2 : 1); ++rep)
        for (int idx = F.bid; idx < SB * SG; idx += F.G) ssd_sample_unit(F, idx / SG, idx % SG);
    TEND(F, 32);
}
__device__ __forceinline__ void p2c_outputs(Frame& F) {
    for (int idx = F.bid; idx < 768; idx += F.G) { if (idx < 256) { TBEGIN(F, 40); ssd_passC_unit(F, idx); TEND(F, 40); } else { TBEGIN(F, 41); gla_passC_unit(F, idx - 256); TEND(F, 41); } }
    TBEGIN(F, 42);
    const int gt = F.bid * NTHR + F.tid, NT = F.G * NTHR;
    for (int i = gt; i < (PB + SB) * 3 * (SCH / 8); i += NT) { const int c = (i % (SCH / 8)) * 8, j = (i / (SCH / 8)) % 3, s = i / (3 * (SCH / 8));
        const int grp = s >= PB, b = grp ? s - PB : s, L = grp ? SL : PL, row0 = grp ? MP + b * SL : b * PL;
        const v4u p = *(const v4u*)(F.PROJ + (size_t)(row0 + L - 3 + j) * NP + CX + c); f32x4* o = (f32x4*)(F.out + (grp ? O_SCONV_S : O_SCONV_P) + ((size_t)b * 3 + j) * SCH + c);
        o[0] = (f32x4){bflo(p.x), bfhi(p.x), bflo(p.y), bfhi(p.y)}; o[1] = (f32x4){bflo(p.z), bfhi(p.z), bflo(p.w), bfhi(p.w)}; }
    TEND(F, 42);
}

struct PmRow { v2u mx[8]; f32x4 x[8]; };
__device__ __forceinline__ void pm_load(const Frame& F, int m, int lane, PmRow& R) {
    const v2u* mr = (const v2u*)((const bf16*)F.MIX + (size_t)m * DM) + lane; const f32x4* xr = (const f32x4*)x_row(F, m) + lane;
#pragma unroll
    for (int j = 0; j < 8; ++j) R.mx[j] = NT_LD(mr + 64 * j);
#pragma unroll
    for (int j = 0; j < 8; ++j) R.x[j] = NT_LD(xr + 64 * j);
}
__device__ __forceinline__ void pm_finish(const Frame& F, int m, int lane, const PmRow& R) {
    const LAS f32x4* w1 = (const LAS f32x4*)F.lds + lane; const LAS f32x4* w2 = w1 + DM / 4;
    f32x4 v[8]; float s = 0.f;
#pragma unroll
    for (int j = 0; j < 8; ++j) { const v2u p = R.mx[j]; v[j] = (f32x4){bflo(p.x), bfhi(p.x), bflo(p.y), bfhi(p.y)}; s += (v[j].x * v[j].x + v[j].y * v[j].y) + (v[j].z * v[j].z + v[j].w * v[j].w); }
    const float r1 = rsqrtf(wave_sum(s) * (1.f / DM) + EPS); float s2 = 0.f;
    v2u* ho = (v2u*)(F.Hb + (size_t)m * DM) + lane;
    asm volatile("" ::: "memory");
#pragma unroll
    for (int j = 0; j < 8; ++j) { v[j] = R.x[j] + v[j] * r1 * w1[64 * j]; { v2u hp; hp.x = pk2(v[j].x, v[j].y); hp.y = pk2(v[j].z, v[j].w); NT_ST(hp, ho + 64 * j); }     s2 += (v[j].x * v[j].x + v[j].y * v[j].y) + (v[j].z * v[j].z + v[j].w * v[j].w); }
    const float r2 = rsqrtf(wave_sum(s2) * (1.f / DM) + EPS);
    v2u* o8 = (v2u*)(F.XN + (size_t)m * DM) + lane;
    asm volatile("" ::: "memory");
#pragma unroll
    for (int j = 0; j < 8; ++j) { const f32x4 ww = w2[64 * j]; v2u o; o.x = pk2(v[j].x * r2 * ww.x, v[j].y * r2 * ww.y); o.y = pk2(v[j].z * r2 * ww.z, v[j].w * r2 * ww.w); o8[64 * j] = o; }
}
__device__ __forceinline__ void p4_post_mixer(Frame& F) {
    const int gw = F.wave * F.G + F.bid, NGW = F.G * NWAVES, lane = F.lane;
    stage_norm_w(F, F.n_mix_post, (LAS float*)F.lds); stage_norm_w(F, F.n_ffn_pre, (LAS float*)F.lds + DM); __syncthreads();
    PmRow A, B, C; int m = gw;
    if (m >= M) return;
    pm_load(F, m, lane, A);
    if (m + NGW < M) pm_load(F, m + NGW, lane, B);
    for (;;) {
        if (m + 2 * NGW < M) pm_load(F, m + 2 * NGW, lane, C);
        pm_finish(F, m, lane, A); m += NGW; if (m >= M) break;
        if (m + 2 * NGW < M) pm_load(F, m + 2 * NGW, lane, A);
        pm_finish(F, m, lane, B); m += NGW; if (m >= M) break;
        if (m + 2 * NGW < M) pm_load(F, m + 2 * NGW, lane, B);
        pm_finish(F, m, lane, C); m += NGW; if (m >= M) break;
    }
}
__device__ __forceinline__ void p6_conv_fixup(Frame& F) {
    const int gt = F.bid * NTHR + F.tid, NT = F.G * NTHR;
    constexpr int NQ = FF / 4;
    for (int it = gt; it < 28 * 2 * NQ; it += NT) { const int c = (it % NQ) * 4, rr = (it / NQ) & 1, bi = it / (2 * NQ), pm = (bi / 7) * 8 + 1 + (bi % 7);
        f32x4 o[2];
#pragma unroll
        for (int hf = 0; hf < 2; ++hf) { const int cc = hf * FF + c;
            const f32x4 w0 = *(const f32x4*)(F.fconv_w + cc), w1 = *(const f32x4*)(F.fconv_w + FF2 + cc), w2 = *(const f32x4*)(F.fconv_w + 2 * FF2 + cc), bs = *(const f32x4*)(F.fconv_b + cc);
            const f32x4 um2 = *(const f32x4*)(F.HG + ((size_t)(pm - 1) * 4 + 2 + rr) * FF2 + cc);
            const f32x4 um1 = rr ? *(const f32x4*)(F.HG + ((size_t)pm * 4) * FF2 + cc) : *(const f32x4*)(F.HG + ((size_t)(pm - 1) * 4 + 3) * FF2 + cc);
            const f32x4 u0 = *(const f32x4*)(F.HG + ((size_t)pm * 4 + rr) * FF2 + cc);
            o[hf] = bs + w0 * um2 + w1 * um1 + w2 * u0; }
        v2u pk; pk.x = pk2(silu_f(o[0].x) * o[1].x, silu_f(o[0].y) * o[1].y); pk.y = pk2(silu_f(o[0].z) * o[1].z, silu_f(o[0].w) * o[1].w);
        *(v2u*)(F.ACT + (size_t)(pm * 256 + rr) * FF + c) = pk; }
    for (int i = gt; i < PB * 2 * (FF2 / 4); i += NT) { const int c = (i % (FF2 / 4)) * 4, j = (i / (FF2 / 4)) & 1, b = i / (2 * (FF2 / 4));
        *(f32x4*)(F.out + O_FCONV_P + ((size_t)b * 2 + j) * FF2 + c) = *(const f32x4*)(F.HG + ((size_t)(b * 8 + 7) * 4 + 2 + j) * FF2 + c); }
}
struct FnRow { v2u f[8]; v2u h[8]; };
__device__ __forceinline__ void fn_load(const Frame& F, int m, int lane, FnRow& R) {
    const v2u* fr = (const v2u*)((const bf16*)F.Fb + (size_t)m * DM) + lane; const v2u* ho = (const v2u*)(F.Hb + (size_t)m * DM) + lane;
#pragma unroll
    for (int j = 0; j < 8; ++j) R.f[j] = NT_LD(fr + 64 * j);
#pragma unroll
    for (int j = 0; j < 8; ++j) R.h[j] = NT_LD(ho + 64 * j);
}
__device__ __forceinline__ void fn_finish(const Frame& F, int m, int lane, const FnRow& R) {
    const LAS f32x4* w1 = (const LAS f32x4*)F.lds + lane; f32x4* ho = (f32x4*)(F.out + O_Y + (size_t)m * DM) + lane;
    f32x4 v[8]; float s = 0.f;
#pragma unroll
    for (int j = 0; j < 8; ++j) { const v2u p = R.f[j]; v[j] = (f32x4){bflo(p.x), bfhi(p.x), bflo(p.y), bfhi(p.y)}; s += (v[j].x * v[j].x + v[j].y * v[j].y) + (v[j].z * v[j].z + v[j].w * v[j].w); }
    const float r1 = rsqrtf(wave_sum(s) * (1.f / DM) + EPS);
#pragma unroll
    for (int j = 0; j < 8; ++j) { const v2u hp = R.h[j]; const f32x4 yv = (f32x4){bflo(hp.x), bfhi(hp.x), bflo(hp.y), bfhi(hp.y)} + v[j] * r1 * w1[64 * j]; NT_ST(yv, ho + 64 * j); }
}
__device__ __forceinline__ void p8_final(Frame& F) {
    const int gw = F.wave * F.G + F.bid, NGW = F.G * NWAVES, lane = F.lane;
    stage_norm_w(F, F.n_ffn_post, (LAS float*)F.lds); __syncthreads();
    FnRow A, B, C; int m = gw;
    if (m >= M) return;
    fn_load(F, m, lane, A);
    if (m + NGW < M) fn_load(F, m + NGW, lane, B);
    for (;;) {
        if (m + 2 * NGW < M) fn_load(F, m + 2 * NGW, lane, C);
        fn_finish(F, m, lane, A); m += NGW; if (m >= M) break;
        if (m + 2 * NGW < M) fn_load(F, m + 2 * NGW, lane, A);
        fn_finish(F, m, lane, B); m += NGW; if (m >= M) break;
        if (m + 2 * NGW < M) fn_load(F, m + 2 * NGW, lane, B);
        fn_finish(F, m, lane, C); m += NGW; if (m >= M) break;
    }
}
__device__ __forceinline__ pg8::SplitCtx split_ctx(const Frame& F, unsigned char* ws, size_t slab_off, int bank) {
    pg8::SplitCtx X; X.slabs = (pg8::f32x4*)(ws + slab_off); X.cnt = (unsigned*)(ws + WS_CTL) + CW_SPLIT + bank * 1024; X.flag = (volatile LAS unsigned*)(F.lds + MISC_OFF) + 16; X.id = bank; return X; }

struct Args { const float* in[25]; float* out; unsigned char* ws; int ph_lo, ph_hi; };
__global__ void __launch_bounds__(NTHR, 2) fwd_kernel(Args args) {
    extern __shared__ __attribute__((aligned(16))) unsigned char lds[];
    Frame F;
    F.lds = (LAS unsigned char*)lds;
    F.tid = threadIdx.x; F.lane = F.tid & 63; F.wave = __builtin_amdgcn_readfirstlane(F.tid >> 6);
    F.G = gridDim.x; F.bid = blockIdx.x;
    unsigned char* ws = args.ws;
    F.x_p = args.in[0]; F.x_s = args.in[1]; F.st_gla = args.in[2]; F.st_ssd = args.in[3]; F.st_sconv = args.in[4]; F.st_fconv = args.in[5];
    F.n_mix_pre = args.in[6]; F.n_mix_post = args.in[7]; F.n_ffn_pre = args.in[8]; F.n_ffn_post = args.in[9]; F.w_in = args.in[10];
    F.w_gate2 = args.in[11]; F.b_gate = args.in[12]; F.gla_norm = args.in[13]; F.sconv_w = args.in[14]; F.sconv_b = args.in[15];
    F.dt_bias = args.in[16]; F.A_log = args.in[17]; F.ssd_D = args.in[18]; F.ssd_norm = args.in[19]; F.w_out = args.in[20];
    F.ffn_w_in = args.in[21]; F.fconv_w = args.in[22]; F.fconv_b = args.in[23]; F.ffn_w_out = args.in[24];
    F.out = args.out;
    F.W1 = (bf16*)(ws + WS_W1); F.WO = (bf16*)(ws + WS_WO); F.WF1 = (bf16*)(ws + WS_WF1); F.WF2 = (bf16*)(ws + WS_WF2);
    F.XN = (bf16*)(ws + WS_XN); F.PROJ = (bf16*)(ws + WS_PROJ); F.MIXIN = (bf16*)(ws + WS_MIXIN); F.ACT = (bf16*)(ws + WS_ACT); F.HG = (float*)(ws + WS_HG);
    F.LRDT = (float*)(ws + WS_LRDT); F.MIX = (float*)(ws + WS_MIX); F.Fb = (float*)(ws + WS_F);
    F.DS = (bf16*)(ws + WS_DS); F.SC = (bf16*)(ws + WS_SC); F.DH = (bf16*)(ws + WS_DH); F.HC = (bf16*)(ws + WS_HC); F.EBL = (float*)(ws + WS_EBL); F.AL = (float*)(ws + WS_AL); F.QEg = (bf16*)(ws + WS_QEG); F.KEg = (bf16*)(ws + WS_KEG); F.Hb = (bf16*)(ws + WS_H);
    for (int u = F.tid; u < (LDS_BYTES - LDSCTL_OFF) / 4; u += NTHR) ((LAS unsigned*)(F.lds + LDSCTL_OFF))[u] = 0u;
    __syncthreads();
    const int lo = args.ph_lo, hi = args.ph_hi;
#if !MK_PER_PHASE
    XcdBarrier bar = xcd_barrier_post((unsigned*)(ws + WS_CTL) + CW_BAR, (volatile LAS unsigned*)(F.lds + MISC_OFF) + 8);
#define GRID_BAR() do { if (args.ph_hi > 1000) cg::this_grid().sync(); xcd_barrier(bar); } while (0)
#else
#define GRID_BAR() do { } while (0)
#endif
#define IN(k) (lo <= (k) && (k) < hi)
#define SEAM(k) do { if (IN(k) && IN((k) + 1)) GRID_BAR(); } while (0)
    F.tacc = 0; F.tmark = 0;
#define PHASE(k, ...) do { if (IN(k)) { TBEGIN(F, k); if (MK_REP_PHASE == (k)) { __VA_ARGS__; GRID_BAR(); } TBEGIN(F, 100 + (k)); __VA_ARGS__; TEND(F, 100 + (k)); SEAM(k); TEND(F, k); } } while (0)
    PHASE(0, p0_prologue(F));
    PHASE(1, { pg8::Gemm g{F.XN, F.W1, M, N1, DM}; pg8::StaticOrder S; S.init(M, N1, DM, F.G, F.bid, 1);
        pg8::EpiBf16 E{F.PROJ, NP, NP / 256, F.LRDT};
        pg8::gemm_phase<pg8::EpiBf16, pg8::StaticOrder, true, true>(F.lds, g, S, E, split_ctx(F, ws, WS_SLAB, 0));
        if (S.rem && F.bid >= S.rem * S.S) p0_convert_rest(F, F.bid - S.rem * S.S, F.G - S.rem * S.S); else if (!S.rem) p0_convert_rest(F, F.bid, F.G); });
    PHASE(2, p2a_chunk_states(F));
    PHASE(3, p2b_scans_and_sample(F));
    PHASE(4, p2c_outputs(F));
    PHASE(5, { pg8::Gemm g{F.MIXIN, F.WO, M, DM, DM}; pg8::StaticOrder S; S.init(M, DM, DM, F.G, F.bid, 4);
        pg8::EpiBf16 E{(bf16*)F.MIX, DM, DM / 256, nullptr};
        pg8::gemm_phase<pg8::EpiBf16, pg8::StaticOrder, true, true>(F.lds, g, S, E, split_ctx(F, ws, WS_SLAB, 1)); });
    PHASE(6, p4_post_mixer(F));
    PHASE(7, { pg8::Gemm g{F.XN, F.WF1, M, FF2, DM}; pg8::StaticOrder S; S.init(M, FF2, DM, F.G, F.bid, 1, MS / 256);
        pg8::EpiConvAct E{F.ACT, F.HG, F.fconv_w, F.fconv_b, F.st_fconv, F.out + O_FCONV_S, (LAS float*)(F.lds + MISC_OFF + 512)};
        pg8::gemm_phase<pg8::EpiConvAct, pg8::StaticOrder, true, true>(F.lds, g, S, E, split_ctx(F, ws, WS_SLAB, 2));
        if (S.rem && F.bid >= S.rem * S.S) t_run(F, 2, F.wave * (F.G - S.rem * S.S) + (F.bid - S.rem * S.S), (F.G - S.rem * S.S) * NWAVES); else if (!S.rem) t_run(F, 2, F.wave * F.G + F.bid, F.G * NWAVES); });
    PHASE(8, p6_conv_fixup(F));
    PHASE(9, { pg8::Gemm g{F.ACT, F.WF2, M, DM, FF}; pg8::StaticOrder S; S.init(M, DM, FF, F.G, F.bid, 4);
        pg8::EpiBf16 E{(bf16*)F.Fb, DM, DM / 256, nullptr};
        pg8::gemm_phase<pg8::EpiBf16, pg8::StaticOrder, true, true>(F.lds, g, S, E, split_ctx(F, ws, WS_SLAB, 3)); });
    if (IN(10)) { TBEGIN(F, 10); p8_final(F); if (MK_TIME_PHASE == 10) { asm volatile("s_waitcnt vmcnt(0)" ::: "memory"); __syncthreads(); } TEND(F, 10); }
    if (MK_TIME_PHASE >= 50 && MK_TIME_PHASE < 70) F.tacc = ((volatile LAS unsigned*)(F.lds + MISC_OFF))[16 + 2];
    if (MK_TIME_PHASE >= 0 && F.bid == 0) { const unsigned long long te = __builtin_amdgcn_s_memrealtime(), d = 8ull * F.tacc; while (__builtin_amdgcn_s_memrealtime() - te < d) __builtin_amdgcn_s_sleep(16); }
#undef IN
#undef SEAM
}

extern "C" void kernel_launch(void* const* d_in, const int* in_sizes, int n_in, void* d_out, int out_size, void* d_ws, size_t ws_size, hipStream_t stream) {
    static int grid = 0;
    if (grid == 0) {
        if (n_in != 25 || (size_t)out_size != O_END || ws_size < WS_END) { fprintf(stderr, "kernel_launch: unexpected sizes n_in %d out %d ws %zu (need out %zu ws %zu)\n", n_in, out_size, ws_size, (size_t)O_END, (size_t)WS_END); grid = -1; return; }
        int dev = 0, cus = 0, per_cu = 0;
        hipGetDevice(&dev); hipDeviceGetAttribute(&cus, hipDeviceAttributeMultiprocessorCount, dev);
        if (hipFuncSetAttribute((const void*)fwd_kernel, hipFuncAttributeMaxDynamicSharedMemorySize, LDS_BYTES) != hipSuccess) { fprintf(stderr, "kernel_launch: hipFuncSetAttribute failed\n"); grid = -1; return; }
        hipOccupancyMaxActiveBlocksPerMultiprocessor(&per_cu, (const void*)fwd_kernel, NTHR, LDS_BYTES);
        if (per_cu < 1) { fprintf(stderr, "kernel_launch: occupancy query says %d blocks per CU\n", per_cu); grid = -1; return; }
        grid = cus;
        (void)hipGetLastError();
    }
    if (grid < 0) return;
    Args a{};
    for (int i = 0; i < 25; ++i) a.in[i] = (const float*)d_in[i];
    a.out = (float*)d_out; a.ws = (unsigned char*)d_ws;
#if MK_PER_PHASE
    hipMemsetAsync((char*)d_ws + WS_CTL, 0, CTL_ZERO_BYTES, stream);
    for (int p = 0; p < N_PHASES; ++p) { a.ph_lo = p; a.ph_hi = p + 1; hipLaunchKernelGGL(fwd_kernel, dim3(grid), dim3(NTHR), LDS_BYTES, stream, a); }
#else
    hipMemsetAsync((char*)d_ws + WS_CTL, 0, CTL_ZERO_BYTES, stream);
    a.ph_lo = 0; a.ph_hi = N_PHASES;
    void* kargs[] = {&a};
    hipError_t e = hipLaunchCooperativeKernel((const void*)fwd_kernel, dim3(grid), dim3(NTHR), kargs, LDS_BYTES, stream);
    if (e != hipSuccess) fprintf(stderr, "kernel_launch: cooperative launch failed: %s (grid %d)\n", hipGetErrorString(e), grid);
#endif
}
```
